# Optimizing an MI355X kernel written in HIP

```python
import math
import jax, jax.numpy as jnp
from jax import lax
import numpy as np

D_MODEL = 1024
BATCH = 8
SEQ = 2048
DEPTH = 1

CHUNK = 64
N_META = 16
LEAD_PAD = 112
QBLOCK = 128
MIX_WIDTH = D_MODEL
RET_HEADS = 4
RET_DIM = MIX_WIDTH // 2 // RET_HEADS
DSA_HEADS = 8
DSA_OUT_DIM = MIX_WIDTH // 2 // DSA_HEADS
DSA_KV_DIM = 128
DSA_QK_DIM = DSA_KV_DIM
IDX_HEADS = 8
IDX_DIM = 64
DSA_TOPK_MAX = 256
ROPE_THETA = 10000.0
PEER_HEADS = 8
PEER_NKEYS = 128
PEER_N_EXPERTS = PEER_NKEYS * PEER_NKEYS
PEER_KEY_DIM = 256
PEER_TOPK = 16
PEER_BLOCK = 128
EPS = 1e-6
NEG = -1e30

SPLIT_SIZES = (RET_HEADS * RET_DIM,) * 4 + (DSA_HEADS * DSA_QK_DIM, DSA_KV_DIM, DSA_KV_DIM,
                                            IDX_HEADS * IDX_DIM, IDX_DIM, IDX_HEADS)
IN_WIDTH = sum(SPLIT_SIZES)

kernel_name = "hybrid_retention_dsa_peer_meta"


def rmsnorm(x, g):
    xf = x.astype(jnp.float32)
    y = xf * lax.rsqrt(jnp.mean(xf * xf, axis=-1, keepdims=True) + EPS)
    return (y * g.astype(jnp.float32)).astype(x.dtype)


def rope(x, pos):
    d = x.shape[-1]
    inv = ROPE_THETA ** (-jnp.arange(0, d // 2, dtype=jnp.float32) * 2.0 / d)
    ang = pos.astype(jnp.float32)[:, None] * inv[None, :]
    ang = ang.reshape((ang.shape[0],) + (1,) * (x.ndim - 3) + (d // 2,))
    cos = jnp.cos(ang).astype(x.dtype)
    sin = jnp.sin(ang).astype(x.dtype)
    x1, x2 = jnp.split(x, 2, axis=-1)
    return jnp.concatenate([x1 * cos - x2 * sin, x2 * cos + x1 * sin], axis=-1)


def retention(q, k, v, g):
    B, Tp, H, dh = q.shape
    NC = Tp // CHUNK
    log_gamma = jnp.log(1.0 - 2.0 ** (-5.0 - jnp.arange(H, dtype=jnp.float32)))
    i = jnp.arange(CHUNK, dtype=jnp.float32)
    dmat = jnp.exp(log_gamma[:, None, None] * jnp.abs(i[:, None] - i[None, :]))
    zeta = jnp.exp(log_gamma[:, None] * (CHUNK - 1.0 - i)[None, :])
    xi = jnp.exp(log_gamma[:, None] * (i + 1.0)[None, :])
    g_chunk = jnp.exp(log_gamma * CHUNK)
    qc = q.reshape(B, NC, CHUNK, H, dh)
    kc = k.reshape(B, NC, CHUNK, H, dh)
    vc = v.reshape(B, NC, CHUNK, H, dh)
    s = jnp.einsum('bnihd,bnjhd->bnhij', qc, kc) * dmat.astype(q.dtype)
    o_intra = jnp.einsum('bnhij,bnjhe->bnihe', s, vc)
    u = jnp.einsum('bnjhd,bnjhe,hj->nbhde', kc, vc, zeta.astype(q.dtype))
    gc = g_chunk.astype(u.dtype)[None, :, None, None]

    def step(r, u_n):
        return gc * r + u_n, r

    _, r_prev = lax.scan(step, jnp.zeros(u.shape[1:], u.dtype), u)
    o_cross = jnp.einsum('bnihd,hi,nbhde->bnihe', qc, xi.astype(q.dtype), r_prev)
    o = (o_intra + o_cross).reshape(B, Tp, H, dh).astype(jnp.float32)
    mu = jnp.mean(o, axis=-1, keepdims=True)
    var = jnp.mean(jnp.square(o - mu), axis=-1, keepdims=True)
    on = (o - mu) * lax.rsqrt(var + EPS)
    gate = jax.nn.silu(g.astype(jnp.float32))
    return (gate * on).reshape(B, Tp, H * dh).astype(q.dtype)


def gather_rows(t, idx):
    return jax.vmap(lambda tb, ib: tb[ib])(t, idx)


def dsa_attention(q, k, v, qi, ki, wi, topk):
    B, Tp, H, _ = q.shape
    NB = Tp // QBLOCK
    kpos = jnp.arange(Tp)
    kchunk = kpos // CHUNK
    kreal = kpos >= LEAD_PAD

    def to_blocks(t):
        return jnp.moveaxis(t.reshape((B, NB, QBLOCK) + t.shape[2:]), 1, 0)

    def block(args):
        qb, qib, wib, b = args
        qchunk = (b * QBLOCK + jnp.arange(QBLOCK)) // CHUNK
        allowed = kreal[None, :] & (kchunk[None, :] <= qchunk[:, None])
        isc = jax.nn.relu(jnp.einsum('bqhd,bkd->bqhk', qib, ki).astype(jnp.float32))
        isc = jnp.einsum('bqhk,bqh->bqk', isc, wib.astype(jnp.float32))
        isc = jnp.where(allowed[None], isc, NEG)
        _, sel = lax.top_k(isc, topk)
        sel_ok = allowed[jnp.arange(QBLOCK)[None, :, None], sel]
        k_sel = gather_rows(k, sel)
        v_sel = gather_rows(v, sel)
        s = jnp.einsum('bqhd,bqkd->bqhk', qb, k_sel).astype(jnp.float32)
        s = jnp.where(sel_ok[:, :, None, :], s, NEG)
        p = jax.nn.softmax(s, axis=-1).astype(v.dtype)
        return jnp.einsum('bqhk,bqkd->bqhd', p, v_sel)

    o = lax.map(block, (to_blocks(q), to_blocks(qi), to_blocks(wi), jnp.arange(NB)))
    return jnp.moveaxis(o, 0, 1).reshape(B, Tp, H, v.shape[-1])


def token_mixer(hn, w_in, w_uv, w_out):
    B, T, _ = hn.shape
    n_frames = T - N_META
    topk = min(DSA_TOPK_MAX, n_frames // 4)
    hp = jnp.pad(hn, ((0, 0), (LEAD_PAD, 0), (0, 0)))
    Tp = T + LEAD_PAD
    pos = jnp.arange(Tp) - LEAD_PAD
    proj = hp @ w_in
    cuts = [int(c) for c in np.cumsum(SPLIT_SIZES)[:-1]]
    rq, rk, rv, rg, dq, dk, dv, iq, ik, iw = jnp.split(proj, cuts, axis=-1)
    rhead = (B, Tp, RET_HEADS, RET_DIM)
    rq = rope(rq.reshape(rhead), pos)
    rk = rope(rk.reshape(rhead), pos) * (RET_DIM ** -0.5)
    ret = retention(rq, rk, rv.reshape(rhead), rg.reshape(rhead))
    dq = rope(dq.reshape(B, Tp, DSA_HEADS, DSA_QK_DIM), pos) * (DSA_QK_DIM ** -0.5)
    dk = rope(dk, pos)
    iq = rope(iq.reshape(B, Tp, IDX_HEADS, IDX_DIM), pos) * (IDX_DIM ** -0.5)
    ik = rope(ik, pos)
    iw = iw * (IDX_HEADS ** -0.5)
    att = dsa_attention(dq, dk, dv, iq, ik, iw, topk)
    att = jnp.einsum('bthc,hcd->bthd', att, w_uv).reshape(B, Tp, DSA_HEADS * DSA_OUT_DIM)
    mixed = jnp.concatenate([ret, att], axis=-1)[:, LEAD_PAD:]
    return mixed @ w_out


def peer(x, w_q, sub_keys, u_emb, v_emb):
    N, D = x.shape
    q = jnp.einsum('nd,dhk->nhk', x, w_q)
    q1, q2 = jnp.split(q, 2, axis=-1)
    s1 = jnp.einsum('nhk,hmk->nhm', q1, sub_keys[:, 0]).astype(jnp.float32)
    s2 = jnp.einsum('nhk,hmk->nhm', q2, sub_keys[:, 1]).astype(jnp.float32)
    v1, i1 = lax.top_k(s1, PEER_TOPK)
    v2, i2 = lax.top_k(s2, PEER_TOPK)
    cand = (v1[..., :, None] + v2[..., None, :]).reshape(N, PEER_HEADS, PEER_TOPK * PEER_TOPK)
    cidx = (i1[..., :, None] * PEER_NKEYS + i2[..., None, :]).reshape(N, PEER_HEADS, PEER_TOPK * PEER_TOPK)
    sc, sel = lax.top_k(cand, PEER_TOPK)
    eidx = jnp.take_along_axis(cidx, sel, axis=-1).reshape(N, PEER_HEADS * PEER_TOPK)
    gate = jax.nn.softmax(sc, axis=-1).reshape(N, PEER_HEADS * PEER_TOPK).astype(x.dtype)
    n_pad = (-N) % PEER_BLOCK
    nb = (N + n_pad) // PEER_BLOCK
    xb = jnp.pad(x, ((0, n_pad), (0, 0))).reshape(nb, PEER_BLOCK, D)
    eb = jnp.pad(eidx, ((0, n_pad), (0, 0))).reshape(nb, PEER_BLOCK, -1)
    gb = jnp.pad(gate, ((0, n_pad), (0, 0))).reshape(nb, PEER_BLOCK, -1)

    def block(args):
        xk, ek, gk = args
        a = jnp.einsum('nd,ned->ne', xk, u_emb[ek])
        coef = jax.nn.gelu(a, approximate=False) * gk
        return jnp.einsum('ne,ned->nd', coef, v_emb[ek])

    out = lax.map(block, (xb, eb, gb)).reshape(nb * PEER_BLOCK, D)
    return out[:N]


def setup_inputs(seed: int = 0) -> dict:
    key = jax.random.key(seed)
    ks = jax.random.split(key, 12)
    f32 = jnp.float32
    x = jax.random.normal(ks[0], (BATCH, SEQ, D_MODEL), f32)
    meta_tokens = jax.random.normal(ks[1], (N_META, D_MODEL), f32)
    norm_mix = 1.0 + 0.02 * jax.random.normal(ks[2], (DEPTH, D_MODEL), f32)
    w_in = jax.random.normal(ks[3], (DEPTH, D_MODEL, IN_WIDTH), f32) * D_MODEL ** -0.5
    w_uv = jax.random.normal(ks[4], (DEPTH, DSA_HEADS, DSA_KV_DIM, DSA_OUT_DIM), f32) * DSA_KV_DIM ** -0.5
    w_out = jax.random.normal(ks[5], (DEPTH, MIX_WIDTH, D_MODEL), f32) * MIX_WIDTH ** -0.5
    norm_ffn = 1.0 + 0.02 * jax.random.normal(ks[6], (DEPTH, D_MODEL), f32)
    peer_wq = jax.random.normal(ks[7], (DEPTH, D_MODEL, PEER_HEADS, PEER_KEY_DIM), f32) * D_MODEL ** -0.5
    peer_subkeys = jax.random.normal(ks[8], (DEPTH, PEER_HEADS, 2, PEER_NKEYS, PEER_KEY_DIM // 2), f32) * (PEER_KEY_DIM // 2) ** -0.5
    peer_u = jax.random.normal(ks[9], (DEPTH, PEER_N_EXPERTS, D_MODEL), f32) * D_MODEL ** -0.5
    peer_v = jax.random.normal(ks[10], (DEPTH, PEER_N_EXPERTS, D_MODEL), f32) * PEER_HEADS ** -0.5
    norm_final = 1.0 + 0.02 * jax.random.normal(ks[11], (D_MODEL,), f32)
    return {"x": x, "meta_tokens": meta_tokens, "norm_mix": norm_mix, "w_in": w_in,
            "w_uv": w_uv, "w_out": w_out, "norm_ffn": norm_ffn, "peer_wq": peer_wq,
            "peer_subkeys": peer_subkeys, "peer_u": peer_u, "peer_v": peer_v,
            "norm_final": norm_final}


def reference(x, meta_tokens, norm_mix, w_in, w_uv, w_out, norm_ffn, peer_wq, peer_subkeys,
              peer_u, peer_v, norm_final):
    B, S, D = x.shape
    meta = jnp.broadcast_to(meta_tokens.astype(x.dtype)[None], (B, N_META, D))
    h = jnp.concatenate([meta, x], axis=1)
    for l in range(DEPTH):
        h = h + token_mixer(rmsnorm(h, norm_mix[l]), w_in[l], w_uv[l], w_out[l])
        hn = rmsnorm(h, norm_ffn[l])
        h = h + peer(hn.reshape(-1, D), peer_wq[l], peer_subkeys[l], peer_u[l], peer_v[l]).reshape(h.shape)
    h = rmsnorm(h, norm_final)
    return h[:, N_META:]
```

```cpp
#include <hip/hip_runtime.h>
#include <stdint.h>
#include <stdio.h>

#ifndef MK_LAUNCHES
#define MK_LAUNCHES 0
#endif

#define DI __device__ __forceinline__
typedef unsigned short bf16_t;
typedef short bf16x8 __attribute__((ext_vector_type(8)));
typedef float f32x4 __attribute__((ext_vector_type(4)));
typedef unsigned u32x4 __attribute__((ext_vector_type(4)));

constexpr int NB = 8, SEQ = 2048, NMETA = 16, TT = 2064, DM = 1024, INW = 3912;
constexpr int MROWS = NB * TT;
constexpr int MPAD = 16640;
constexpr int NF = NB * SEQ;
constexpr int C_RQ = 0, C_RK = 512, C_RV = 1024, C_RG = 1536, C_DQ = 2048, C_DK = 3072, C_DV = 3200, C_IQ = 3328, C_IK = 3840, C_IW = 3904;
constexpr int NTHREADS = 512, NWAVES = 8;
constexpr int LDS_BYTES = 163840;
constexpr int LDS_BAR_OFF = 163840 - 256;

constexpr size_t al256(size_t x) { return (x + 255) & ~(size_t)255; }
constexpr size_t OFF_BAR = 0;
constexpr size_t OFF_COS128 = 16384;
constexpr size_t OFF_SIN128 = OFF_COS128 + al256((size_t)TT * 64 * 4);
constexpr size_t OFF_COS64 = OFF_SIN128 + al256((size_t)TT * 64 * 4);
constexpr size_t OFF_SIN64 = OFF_COS64 + al256((size_t)TT * 32 * 4);
constexpr size_t OFF_WINT = OFF_SIN64 + al256((size_t)TT * 32 * 4);
constexpr size_t OFF_WOUTT = OFF_WINT + (size_t)4096 * 1024 * 2;
constexpr size_t OFF_WQT = OFF_WOUTT + (size_t)1024 * 1024 * 2;
constexpr size_t OFF_HN = OFF_WQT + (size_t)2048 * 1024 * 2;
constexpr size_t OFF_BIG = OFF_HN + (size_t)MPAD * 1024 * 2;
constexpr size_t BIG_BYTES = (size_t)NF * 2048 * 4;
constexpr size_t OFF_ST = OFF_BIG + al256(BIG_BYTES);
constexpr size_t ST_BYTES = (size_t)32 * 34 * 16384 * 4;
constexpr size_t WS_END = OFF_ST + ST_BYTES;
static_assert(BIG_BYTES >= (size_t)MPAD * INW * 2, "big region");
static_assert(WS_END <= (size_t)268435456, "workspace");

struct Params {
    const float *x, *meta, *norm_mix, *w_in, *w_uv, *w_out, *norm_ffn, *wq, *sk, *pu, *pv, *norm_final;
    float* out; char* ws; int lo, hi, pad0, pad1;
};

DI float bf2f(bf16_t v) { return __uint_as_float(((unsigned)v) << 16); }
DI bf16_t f2bf(float f) { unsigned u = __float_as_uint(f); u += 0x7fffu + ((u >> 16) & 1u); return (bf16_t)(u >> 16); }
DI float wave_sum(float v) {
#pragma unroll
    for (int o = 32; o > 0; o >>= 1) v += __shfl_xor(v, o);
    return v;
}
DI float wave_max(float v) {
#pragma unroll
    for (int o = 32; o > 0; o >>= 1) v = fmaxf(v, __shfl_xor(v, o));
    return v;
}
DI unsigned long long wave_max_u64(unsigned long long v) {
#pragma unroll
    for (int o = 32; o > 0; o >>= 1) {
        const unsigned hi = __shfl_xor((unsigned)(v >> 32), o), lo = __shfl_xor((unsigned)v, o);
        const unsigned long long w = ((unsigned long long)hi << 32) | lo;
        v = w > v ? w : v;
    }
    return v;
}
DI unsigned fkey(float x) { const unsigned u = __float_as_uint(x); return (u & 0x80000000u) ? ~u : (u | 0x80000000u); }
DI float funkey(unsigned k) { const unsigned u = (k & 0x80000000u) ? (k & 0x7fffffffu) : ~k; return __uint_as_float(u); }
DI void lds_fence() { asm volatile("s_waitcnt lgkmcnt(0)" ::: "memory"); }
DI void unpack8(const u32x4& r, float (&v)[8]) {
    v[0] = __uint_as_float(r.x << 16); v[1] = __uint_as_float(r.x & 0xffff0000u);
    v[2] = __uint_as_float(r.y << 16); v[3] = __uint_as_float(r.y & 0xffff0000u);
    v[4] = __uint_as_float(r.z << 16); v[5] = __uint_as_float(r.z & 0xffff0000u);
    v[6] = __uint_as_float(r.w << 16); v[7] = __uint_as_float(r.w & 0xffff0000u);
}

#define XB_TMO      128
#define XB_XCNT(j)  (256  + 64 * (j))
#define XB_XSUB(j)  (1280 + 64 * (j))
#define XB_XGEN(j)  (2304 + 64 * (j))
#define XB_TOP      3328
#define XB_TOPGEN   3392
#define XCD_BAR_WORDS 3456
#define XB_SPIN_CAP (1u << 20)
#define LAS __attribute__((address_space(3)))

DI unsigned xb_ld(unsigned* p)              { return __hip_atomic_load(p, __ATOMIC_RELAXED, __HIP_MEMORY_SCOPE_AGENT); }
DI unsigned xb_add(unsigned* p, unsigned v) { return __hip_atomic_fetch_add(p, v, __ATOMIC_RELAXED, __HIP_MEMORY_SCOPE_AGENT); }
DI unsigned xb_xcc_id() { return (unsigned)__builtin_amdgcn_s_getreg((3 << 11) | 20) & 0xFu; }
#define XB_SPIN(cond, bar) do { unsigned _sp = 0; while (cond) { __builtin_amdgcn_s_sleep(1); \
    if ((++_sp & 255u) == 0u) { if (xb_ld(&(bar)[XB_TMO])) break; if (_sp > XB_SPIN_CAP) { atomicAdd(&(bar)[XB_TMO], 1u); break; } } } } while (0)

struct XcdBarrier { unsigned* bar; unsigned x; volatile LAS unsigned* st; };

DI XcdBarrier xcd_barrier_post(unsigned* bar, volatile LAS unsigned* st) {
    XcdBarrier b; b.bar = bar; b.x = xb_xcc_id(); b.st = st;
    if (threadIdx.x == 0) (void)xb_add(&bar[XB_XCNT(b.x)], 1u);
    return b;
}
DI void xcd_barrier_complete(unsigned* bar, unsigned x, unsigned& nloc, unsigned& nx) {
    const unsigned G = gridDim.x * gridDim.y * gridDim.z;
    unsigned sum, cnt, mine, sp = 0u;
    for (;;) {
        sum = 0u; cnt = 0u; mine = 0u;
#pragma unroll
        for (unsigned j = 0; j < 16; ++j) { const unsigned c = xb_ld(&bar[XB_XCNT(j)]); sum += c; cnt += (c > 0u) ? 1u : 0u; mine = (j == x) ? c : mine; }
        if (sum == G) break;
        __builtin_amdgcn_s_sleep(1);
        if ((++sp & 255u) == 0u) { if (xb_ld(&bar[XB_TMO])) break; if (sp > XB_SPIN_CAP) { atomicAdd(&bar[XB_TMO], 1u); break; } }
    }
    nloc = mine > 0u ? mine : 1u; nx = cnt > 0u ? cnt : 1u;
}
DI void xcd_barrier(const XcdBarrier& b) {
    asm volatile("s_waitcnt vmcnt(0)" ::: "memory");
    __syncthreads();
    if (threadIdx.x == 0) {
        unsigned* bar = b.bar;
        __builtin_amdgcn_s_waitcnt(0);
        unsigned nloc = b.st[0], nx = b.st[1];
        if (nloc == 0u) { xcd_barrier_complete(bar, b.x, nloc, nx); b.st[0] = nloc; b.st[1] = nx; }
        const unsigned old = xb_add(&bar[XB_XSUB(b.x)], 1u);
        const unsigned gen = old / nloc;
        if (old + 1u == (gen + 1u) * nloc) {
            __builtin_amdgcn_fence(__ATOMIC_RELEASE, "agent");
            asm volatile("s_waitcnt vmcnt(0)" ::: "memory");
            const unsigned og = xb_add(&bar[XB_TOP], 1u);
            const unsigned tg = og / nx;
            if (og + 1u == (tg + 1u) * nx) xb_add(&bar[XB_TOPGEN], 1u);
            else XB_SPIN(xb_ld(&bar[XB_TOPGEN]) == tg, bar);
            __builtin_amdgcn_fence(__ATOMIC_ACQUIRE, "agent");
            xb_add(&bar[XB_XGEN(b.x)], 1u);
            asm volatile("s_waitcnt vmcnt(0)" ::: "memory");
        } else {
            XB_SPIN(xb_ld(&bar[XB_XGEN(b.x)]) == gen, bar);
            __builtin_amdgcn_fence(__ATOMIC_ACQUIRE, "agent");
            asm volatile("s_waitcnt vmcnt(0)" ::: "memory");
        }
    }
    __syncthreads();
}

constexpr int BM = 256, BK = 64, HALF = 128, NXCD = 8, WGM = 8, HT = HALF * BK;
DI int lds_byte(int r, int c) {
    int st = (r >> 4) * 2 + (c >> 5), rr = r & 15, cc = c & 31, ob = rr * 64 + cc * 2;
    return st * 1024 + (ob ^ (((ob >> 9) & 1) << 5));
}
DI void stage_rc(int b, int& R, int& C) {
    int st = b / 1024, sb = b % 1024, swz = sb ^ (((sb >> 9) & 1) << 5);
    R = (st >> 1) * 16 + swz / 64; C = (st & 1) * 32 + (swz % 64) / 2;
}

#define SA(b,h) (shm+((b)*2+(h))*HT)
#define SB(b,h) (shm+(4+(b)*2+(h))*HT)
#define STAGE_X(T,P,BASE,br,kt) do{long _g=(long)(br)*K+(long)(kt)*BK; \
    for(int _i=0;_i<2;++_i){int _b=(T)*16+_i*8192;int _r,_c;stage_rc(_b,_r,_c); \
      __builtin_amdgcn_global_load_lds((const unsigned*)(BASE+_g+(long)_r*K+_c), \
        (LAS unsigned*)((LAS char*)(P)+_b),16,0,0);}}while(0)
#define STAGE(P,BASE,br,kt) STAGE_X(threadIdx.x,P,BASE,br,kt)
#define LDA(dst,b,h) for(int m=0;m<4;++m)for(int k=0;k<2;++k) \
    dst[m][k]=*reinterpret_cast<const LAS bf16x8*>((LAS char*)SA(b,h)+lds_byte(wr*64+m*16+fr,k*32+fq*8))
#define LDB(dst,b,h) for(int n=0;n<2;++n)for(int k=0;k<2;++k) \
    dst[n][k]=*reinterpret_cast<const LAS bf16x8*>((LAS char*)SB(b,h)+lds_byte(wc*32+n*16+fr,k*32+fq*8))
#define MMA(ai,bj,At,Bt_) do{__builtin_amdgcn_s_setprio(1); \
    for(int m=0;m<4;++m)for(int n=0;n<2;++n)for(int k=0;k<2;++k) \
      acc[ai][bj][m][n]=__builtin_amdgcn_mfma_f32_16x16x32_bf16(At[m][k],Bt_[n][k],acc[ai][bj][m][n],0,0,0); \
    __builtin_amdgcn_s_setprio(0);}while(0)
#define WAIT_V(n) asm volatile("s_waitcnt vmcnt(" #n ")":::"memory")
#define WAIT_L(n) asm volatile("s_waitcnt lgkmcnt(" #n ")":::"memory")
#define BAR __builtin_amdgcn_s_barrier()
#define SCHED __builtin_amdgcn_sched_barrier(0)

template <class Epi>
DI void gemm256(const bf16_t* __restrict__ A, const bf16_t* __restrict__ Bt, const int K, const int nM, const int nN, LAS bf16_t* shm, const Epi& epi) {
    const int nwg = nM * nN;
    for (int L = blockIdx.x; L < nwg; L += gridDim.x) {
        int wgid = L;
        { int q = nwg / NXCD, r = nwg % NXCD, xcd = wgid % NXCD, off = wgid / NXCD; wgid = (xcd < r ? xcd * (q + 1) : r * (q + 1) + (xcd - r) * q) + off; }
        int nig = WGM * nN, gid = wgid / nig, fm = gid * WGM, gsz = min(nM - fm, WGM);
        int pm = fm + ((wgid % nig) % gsz), pn = (wgid % nig) / gsz, brow = pm * BM, bcol = pn * BM;
        int wid = threadIdx.x >> 6, lane = threadIdx.x & 63, wr = wid >> 2, wc = wid & 3, fr = lane & 15, fq = lane >> 4;
        f32x4 acc[2][2][4][2] = {};
        bf16x8 At[4][2], B0[2][2], B1[2][2];
        int nt = K / BK;
        STAGE(SB(0,0),Bt,bcol,0); STAGE(SA(0,0),A,brow,0);
        STAGE(SB(0,1),Bt,bcol+HALF,0); STAGE(SA(0,1),A,brow+HALF,0);
        if (wr == 1) BAR;
        WAIT_V(4); BAR;
        STAGE(SB(1,0),Bt,bcol,1); STAGE(SA(1,0),A,brow,1); STAGE(SB(1,1),Bt,bcol+HALF,1);
        WAIT_V(6); BAR;
        for (int t = 0; t < nt - 2; t += 2) {
            LDB(B0,0,0); SCHED; LDA(At,0,0); STAGE(SA(1,1),A,brow+HALF,t+1);
            WAIT_L(8); BAR; WAIT_L(0); MMA(0,0,At,B0); BAR; SCHED;
            LDB(B1,0,1); STAGE(SB(0,0),Bt,bcol,t+2);
            BAR; WAIT_L(0); MMA(0,1,At,B1); BAR;
            LDA(At,0,1); STAGE(SA(0,0),A,brow,t+2);
            BAR; WAIT_L(0); MMA(1,0,At,B0); BAR; SCHED;
            STAGE(SB(0,1),Bt,bcol+HALF,t+2);
            WAIT_V(6); BAR; MMA(1,1,At,B1); BAR;
            LDB(B0,1,0); SCHED; LDA(At,1,0); STAGE(SA(0,1),A,brow+HALF,t+2);
            WAIT_L(8); BAR; WAIT_L(0); MMA(0,0,At,B0); BAR; SCHED;
            LDB(B1,1,1); STAGE(SB(1,0),Bt,bcol,t+3);
            BAR; WAIT_L(0); MMA(0,1,At,B1); BAR;
            LDA(At,1,1); STAGE(SA(1,0),A,brow,t+3);
            BAR; WAIT_L(0); MMA(1,0,At,B0); BAR; SCHED;
            STAGE(SB(1,1),Bt,bcol+HALF,t+3);
            WAIT_V(6); BAR; MMA(1,1,At,B1); BAR;
        }
        int tz = threadIdx.x; asm volatile("" : "+v"(tz)); wid = tz >> 6; lane = tz & 63; wr = wid >> 2; wc = wid & 3; fr = lane & 15; fq = lane >> 4;
        { LDB(B0,0,0); WAIT_V(0); LDA(At,0,0); STAGE_X(tz,SA(1,1),A,brow+HALF,nt-1);
          BAR; WAIT_L(0); MMA(0,0,At,B0); BAR;
          LDB(B1,0,1); BAR; WAIT_L(0); MMA(0,1,At,B1); BAR;
          LDA(At,0,1); WAIT_V(4); BAR; WAIT_L(0); MMA(1,0,At,B0); MMA(1,1,At,B1); BAR; }
        { LDB(B0,1,0); LDA(At,1,0); WAIT_V(2); BAR; WAIT_L(0); MMA(0,0,At,B0); BAR;
          LDB(B1,1,1); WAIT_V(0); BAR; WAIT_L(0); MMA(0,1,At,B1); BAR;
          LDA(At,1,1); BAR; WAIT_L(0); MMA(1,0,At,B0); MMA(1,1,At,B1); BAR; }
        if (wr == 0) BAR;
        epi(acc, brow, bcol, wr, wc, fr, fq);
        __syncthreads();
    }
}

struct EpiProj {
    bf16_t* P;
    DI void operator()(const f32x4 (&acc)[2][2][4][2], int brow, int bcol, int wr, int wc, int fr, int fq) const {
#pragma unroll
        for (int ai = 0; ai < 2; ++ai)
#pragma unroll
        for (int bj = 0; bj < 2; ++bj)
#pragma unroll
        for (int m = 0; m < 4; ++m)
#pragma unroll
        for (int n = 0; n < 2; ++n)
#pragma unroll
        for (int j = 0; j < 4; ++j) {
            const int row = brow + ai * HALF + wr * 64 + m * 16 + fq * 4 + j, col = bcol + bj * HALF + wc * 32 + n * 16 + fr;
            if (col < INW) P[(size_t)row * INW + col] = f2bf(acc[ai][bj][m][n][j]);
        }
    }
};
struct EpiOut {
    float* H; const float* X;
    DI void operator()(const f32x4 (&acc)[2][2][4][2], int brow, int bcol, int wr, int wc, int fr, int fq) const {
#pragma unroll
        for (int ai = 0; ai < 2; ++ai)
#pragma unroll
        for (int bj = 0; bj < 2; ++bj)
#pragma unroll
        for (int m = 0; m < 4; ++m)
#pragma unroll
        for (int n = 0; n < 2; ++n)
#pragma unroll
        for (int j = 0; j < 4; ++j) {
            const int row = brow + ai * HALF + wr * 64 + m * 16 + fq * 4 + j, col = bcol + bj * HALF + wc * 32 + n * 16 + fr;
            const size_t o = (size_t)row * DM + col; H[o] = X[o] + acc[ai][bj][m][n][j];
        }
    }
};
struct EpiPQ {
    float* Q;
    DI void operator()(const f32x4 (&acc)[2][2][4][2], int brow, int bcol, int wr, int wc, int fr, int fq) const {
#pragma unroll
        for (int ai = 0; ai < 2; ++ai)
#pragma unroll
        for (int bj = 0; bj < 2; ++bj)
#pragma unroll
        for (int m = 0; m < 4; ++m)
#pragma unroll
        for (int n = 0; n < 2; ++n)
#pragma unroll
        for (int j = 0; j < 4; ++j) {
            const int row = brow + ai * HALF + wr * 64 + m * 16 + fq * 4 + j, col = bcol + bj * HALF + wc * 32 + n * 16 + fr;
            Q[(size_t)row * 2048 + col] = acc[ai][bj][m][n][j];
        }
    }
};

DI void phase_prologue(const Params& p) {
    const int gtid = blockIdx.x * NTHREADS + threadIdx.x, gsz = gridDim.x * NTHREADS;
    bf16_t* wint = (bf16_t*)(p.ws + OFF_WINT);
    for (int idx = gtid; idx < 4096 * 1024; idx += gsz) {
        const int k = idx >> 12, n = idx & 4095;
        const float v = n < INW ? p.w_in[(size_t)k * INW + n] : 0.f;
        wint[(size_t)n * 1024 + k] = f2bf(v);
    }
    bf16_t* woutt = (bf16_t*)(p.ws + OFF_WOUTT);
    for (int idx = gtid; idx < 1024 * 1024; idx += gsz) {
        const int k = idx >> 10, n = idx & 1023;
        woutt[(size_t)n * 1024 + k] = f2bf(p.w_out[(size_t)k * 1024 + n]);
    }
    bf16_t* wqt = (bf16_t*)(p.ws + OFF_WQT);
    for (int idx = gtid; idx < 1024 * 2048; idx += gsz) {
        const int k = idx >> 11, n = idx & 2047;
        wqt[(size_t)n * 1024 + k] = f2bf(p.wq[(size_t)k * 2048 + n]);
    }
    float* c128 = (float*)(p.ws + OFF_COS128); float* s128 = (float*)(p.ws + OFF_SIN128);
    for (int idx = gtid; idx < TT * 64; idx += gsz) {
        const int pos = idx >> 6, j = idx & 63;
        const float inv = powf(10000.f, -(float)j * 2.0f / 128.f);
        const float ang = (float)pos * inv;
        float s, c; sincosf(ang, &s, &c);
        c128[idx] = c; s128[idx] = s;
    }
    float* c64 = (float*)(p.ws + OFF_COS64); float* s64 = (float*)(p.ws + OFF_SIN64);
    for (int idx = gtid; idx < TT * 32; idx += gsz) {
        const int pos = idx >> 5, j = idx & 31;
        const float inv = powf(10000.f, -(float)j * 2.0f / 64.f);
        const float ang = (float)pos * inv;
        float s, c; sincosf(ang, &s, &c);
        c64[idx] = c; s64[idx] = s;
    }
    bf16_t* hn = (bf16_t*)(p.ws + OFF_HN);
    const int wave = threadIdx.x >> 6, lane = threadIdx.x & 63;
    for (int row = blockIdx.x * NWAVES + wave; row < MPAD; row += gridDim.x * NWAVES) {
        bf16_t* o = hn + (size_t)row * DM;
        if (row >= MROWS) {
            for (int i = 0; i < 4; ++i) *(uint2*)(o + i * 256 + lane * 4) = make_uint2(0u, 0u);
            continue;
        }
        const int b = row / TT, t = row % TT;
        const float* src = t < NMETA ? p.meta + (size_t)t * DM : p.x + ((size_t)b * SEQ + (t - NMETA)) * DM;
        float4 v[4]; float ss = 0.f;
#pragma unroll
        for (int i = 0; i < 4; ++i) { v[i] = *(const float4*)(src + i * 256 + lane * 4); ss += v[i].x * v[i].x + v[i].y * v[i].y + v[i].z * v[i].z + v[i].w * v[i].w; }
        ss = wave_sum(ss);
        const float rstd = rsqrtf(ss * (1.f / DM) + 1e-6f);
#pragma unroll
        for (int i = 0; i < 4; ++i) {
            const float4 g = *(const float4*)(p.norm_mix + i * 256 + lane * 4);
            uint2 w;
            w.x = (unsigned)f2bf(v[i].x * rstd * g.x) | ((unsigned)f2bf(v[i].y * rstd * g.y) << 16);
            w.y = (unsigned)f2bf(v[i].z * rstd * g.z) | ((unsigned)f2bf(v[i].w * rstd * g.w) << 16);
            *(uint2*)(o + i * 256 + lane * 4) = w;
        }
    }
}

DI void phase_rope(const Params& p) {
    bf16_t* proj = (bf16_t*)(p.ws + OFF_BIG);
    const float* c128 = (const float*)(p.ws + OFF_COS128); const float* s128 = (const float*)(p.ws + OFF_SIN128);
    const float* c64 = (const float*)(p.ws + OFF_COS64); const float* s64 = (const float*)(p.ws + OFF_SIN64);
    const int gtid = blockIdx.x * NTHREADS + threadIdx.x, gsz = gridDim.x * NTHREADS;
    const int total = MROWS * 1384;
    for (int idx = gtid; idx < total; idx += gsz) {
        const int row = idx / 1384, it = idx % 1384;
        const int t = row % TT;
        bf16_t* pr = proj + (size_t)row * INW;
        int c1, half, j; float scale; bool big;
        if (it < 256)       { c1 = C_RQ + (it >> 6) * 128 + (it & 63); half = 64; j = it & 63; scale = 1.f; big = true; }
        else if (it < 512)  { const int i2 = it - 256;  c1 = C_RK + (i2 >> 6) * 128 + (i2 & 63); half = 64; j = i2 & 63; scale = 0.08838834764831845f; big = true; }
        else if (it < 1024) { const int i2 = it - 512;  c1 = C_DQ + (i2 >> 6) * 128 + (i2 & 63); half = 64; j = i2 & 63; scale = 0.08838834764831845f; big = true; }
        else if (it < 1088) { const int i2 = it - 1024; c1 = C_DK + i2; half = 64; j = i2; scale = 1.f; big = true; }
        else if (it < 1344) { const int i2 = it - 1088; c1 = C_IQ + (i2 >> 5) * 64 + (i2 & 31); half = 32; j = i2 & 31; scale = 0.125f; big = false; }
        else if (it < 1376) { const int i2 = it - 1344; c1 = C_IK + i2; half = 32; j = i2; scale = 1.f; big = false; }
        else { const int c = C_IW + (it - 1376); pr[c] = f2bf(bf2f(pr[c]) * 0.35355339059327373f); continue; }
        const float cs = big ? c128[t * 64 + j] : c64[t * 32 + j];
        const float sn = big ? s128[t * 64 + j] : s64[t * 32 + j];
        const float x1 = bf2f(pr[c1]), x2 = bf2f(pr[c1 + half]);
        pr[c1] = f2bf((x1 * cs - x2 * sn) * scale);
        pr[c1 + half] = f2bf((x2 * cs + x1 * sn) * scale);
    }
}

DI void phase_ret_state(const Params& p, LAS char* smem) {
    const bf16_t* proj = (const bf16_t*)(p.ws + OFF_BIG);
    float* ST = (float*)(p.ws + OFF_ST);
    LAS bf16_t* sK = (LAS bf16_t*)smem; LAS bf16_t* sV = sK + 64 * 128;
    for (int unit = blockIdx.x; unit < 1024; unit += gridDim.x) {
        const int c = 1 + (unit & 31), bh = unit >> 5, h = bh & 3, b = bh >> 2;
        for (int i = threadIdx.x; i < 64 * 16; i += NTHREADS) {
            const int j = i >> 4, ch = i & 15; const int t = 64 * c + j - 112;
            u32x4 kv = {0u, 0u, 0u, 0u}, vv = {0u, 0u, 0u, 0u};
            if (t >= 0) { const bf16_t* pr = proj + (size_t)(b * TT + t) * INW; kv = *(const u32x4*)(pr + C_RK + h * 128 + ch * 8); vv = *(const u32x4*)(pr + C_RV + h * 128 + ch * 8); }
            *(LAS u32x4*)(sK + j * 128 + ch * 8) = kv; *(LAS u32x4*)(sV + j * 128 + ch * 8) = vv;
        }
        __syncthreads();
        const float lg = logf(1.f - exp2f(-5.f - (float)h));
        const int e = threadIdx.x >> 2, d0 = (threadIdx.x & 3) * 32;
        float acc[32];
#pragma unroll
        for (int dd = 0; dd < 32; ++dd) acc[dd] = 0.f;
        for (int j = 0; j < 64; ++j) {
            const float z = expf(lg * (float)(63 - j)) * bf2f(sV[j * 128 + e]);
#pragma unroll
            for (int d8 = 0; d8 < 4; ++d8) {
                const u32x4 raw = *(const LAS u32x4*)(sK + j * 128 + d0 + d8 * 8); float kv[8]; unpack8(raw, kv);
#pragma unroll
                for (int x = 0; x < 8; ++x) acc[d8 * 8 + x] += z * kv[x];
            }
        }
        float* st = ST + ((size_t)(bh * 34 + c) * 128 + e) * 128 + d0;
#pragma unroll
        for (int d4 = 0; d4 < 8; ++d4) *(float4*)(st + d4 * 4) = make_float4(acc[d4 * 4], acc[d4 * 4 + 1], acc[d4 * 4 + 2], acc[d4 * 4 + 3]);
        __syncthreads();
    }
}

constexpr int DSA_WAVE_LDS = 2176 * 4 + 1024 * 4 + 256 * 4 + 64;
DI void phase_dsa(const Params& p, LAS char* smem) {
    const bf16_t* proj = (const bf16_t*)(p.ws + OFF_BIG);
    bf16_t* mixed = (bf16_t*)(p.ws + OFF_HN);
    const int wave = threadIdx.x >> 6, lane = threadIdx.x & 63;
    LAS float* sSc = (LAS float*)(smem + wave * DSA_WAVE_LDS);
    LAS float* sQ = sSc + 2176;
    LAS int* sSel = (LAS int*)(sQ + 1024);
    LAS float* sIw = (LAS float*)(sSel + 256);
    const unsigned long long lt_mask = (1ull << lane) - 1ull;
    for (int q = blockIdx.x * NWAVES + wave; q < NF; q += gridDim.x * NWAVES) {
        const int b = q >> 11, s = q & 2047, t = NMETA + s;
        const int nk = 80 + 64 * (s >> 6);
        const bf16_t* prow = proj + (size_t)(b * TT + t) * INW;
        for (int i = lane; i < 512; i += 64) sQ[i] = bf2f(prow[C_IQ + i]);
        if (lane < 8) sIw[lane] = bf2f(prow[C_IW + lane]);
        lds_fence();
        const bf16_t* ikbase = proj + (size_t)(b * TT) * INW + C_IK;
        const int nj = (nk + 63) >> 6;
        for (int jj = 0; jj < nj; ++jj) {
            const int k = jj * 64 + lane;
            float sc = 0.f;
            if (k < nk) {
                const bf16_t* kr = ikbase + (size_t)k * INW;
                float a[8];
#pragma unroll
                for (int h = 0; h < 8; ++h) a[h] = 0.f;
#pragma unroll 1
                for (int d8 = 0; d8 < 8; ++d8) {
                    const u32x4 raw = *(const u32x4*)(kr + d8 * 8); float kv[8]; unpack8(raw, kv);
#pragma unroll
                    for (int h = 0; h < 8; ++h) {
                        const f32x4 q0 = *(const LAS f32x4*)(sQ + h * 64 + d8 * 8), q1 = *(const LAS f32x4*)(sQ + h * 64 + d8 * 8 + 4);
                        a[h] += kv[0] * q0[0] + kv[1] * q0[1] + kv[2] * q0[2] + kv[3] * q0[3] + kv[4] * q1[0] + kv[5] * q1[1] + kv[6] * q1[2] + kv[7] * q1[3];
                    }
                }
#pragma unroll
                for (int h = 0; h < 8; ++h) sc += fmaxf(a[h], 0.f) * sIw[h];
                sc += 0.0f;
            }
            sSc[k] = sc;
        }
        lds_fence();
        int L;
        if (nk <= 256) {
            for (int i = lane; i < nk; i += 64) sSel[i] = i;
            L = nk;
        } else {
            unsigned Tkey = 0u;
            for (int bit = 31; bit >= 0; --bit) {
                const unsigned cand = Tkey | (1u << bit);
                int cnt = 0;
                for (int jj = 0; jj < nj; ++jj) {
                    const int k = jj * 64 + lane;
                    const unsigned key = (k < nk) ? fkey(sSc[k]) : 0u;
                    cnt += __popcll(__ballot(key >= cand));
                }
                if (cnt >= 256) Tkey = cand;
            }
            int cgt = 0;
            for (int jj = 0; jj < nj; ++jj) {
                const int k = jj * 64 + lane;
                const unsigned key = (k < nk) ? fkey(sSc[k]) : 0u;
                cgt += __popcll(__ballot(key > Tkey));
            }
            const int need = 256 - cgt;
            int pos = 0, eqseen = 0;
            for (int jj = 0; jj < nj; ++jj) {
                const int k = jj * 64 + lane;
                const unsigned key = (k < nk) ? fkey(sSc[k]) : 0u;
                const bool gt = key > Tkey, eq = (key == Tkey);
                const unsigned long long eqm = __ballot(eq);
                const int myeq = eqseen + __popcll(eqm & lt_mask);
                const bool sel = gt || (eq && myeq < need);
                const unsigned long long sm = __ballot(sel);
                if (sel) sSel[pos + __popcll(sm & lt_mask)] = k;
                pos += __popcll(sm); eqseen += __popcll(eqm);
            }
            L = 256;
        }
        lds_fence();
        for (int i = lane; i < 1024; i += 64) sQ[i] = bf2f(prow[C_DQ + i]);
        lds_fence();
        float sc[8][4];
        const bf16_t* dkbase = proj + (size_t)(b * TT) * INW + C_DK;
#pragma unroll
        for (int il = 0; il < 4; ++il) {
            const int i = lane + 64 * il; const bool ok = i < L; const int key = ok ? sSel[i] : 0;
            const bf16_t* kr = dkbase + (size_t)key * INW;
            float a[8];
#pragma unroll
            for (int h = 0; h < 8; ++h) a[h] = 0.f;
#pragma unroll 1
            for (int d8 = 0; d8 < 16; ++d8) {
                const u32x4 raw = *(const u32x4*)(kr + d8 * 8); float kv[8]; unpack8(raw, kv);
#pragma unroll
                for (int h = 0; h < 8; ++h) {
                    const f32x4 q0 = *(const LAS f32x4*)(sQ + h * 128 + d8 * 8), q1 = *(const LAS f32x4*)(sQ + h * 128 + d8 * 8 + 4);
                    a[h] += kv[0] * q0[0] + kv[1] * q0[1] + kv[2] * q0[2] + kv[3] * q0[3] + kv[4] * q1[0] + kv[5] * q1[1] + kv[6] * q1[2] + kv[7] * q1[3];
                }
            }
#pragma unroll
            for (int h = 0; h < 8; ++h) sc[h][il] = ok ? a[h] : -INFINITY;
        }
#pragma unroll
        for (int h = 0; h < 8; ++h) {
            float m = fmaxf(fmaxf(sc[h][0], sc[h][1]), fmaxf(sc[h][2], sc[h][3]));
            m = wave_max(m);
            float e[4], sum = 0.f;
#pragma unroll
            for (int il = 0; il < 4; ++il) { e[il] = expf(sc[h][il] - m); sum += e[il]; }
            sum = wave_sum(sum);
            const float inv = 1.f / sum;
#pragma unroll
            for (int il = 0; il < 4; ++il) sSc[h * 256 + lane + 64 * il] = e[il] * inv;
        }
        lds_fence();
        float o[8][2];
#pragma unroll
        for (int h = 0; h < 8; ++h) { o[h][0] = 0.f; o[h][1] = 0.f; }
        const bf16_t* dvbase = proj + (size_t)(b * TT) * INW + C_DV;
        for (int i = 0; i < L; ++i) {
            const int key = sSel[i];
            const float v0 = bf2f(dvbase[(size_t)key * INW + lane]), v1 = bf2f(dvbase[(size_t)key * INW + 64 + lane]);
#pragma unroll
            for (int h = 0; h < 8; ++h) { const float pv = sSc[h * 256 + i]; o[h][0] += pv * v0; o[h][1] += pv * v1; }
        }
        lds_fence();
#pragma unroll
        for (int h = 0; h < 8; ++h) { sQ[h * 128 + lane] = o[h][0]; sQ[h * 128 + 64 + lane] = o[h][1]; }
        lds_fence();
        for (int h = 0; h < 8; ++h) {
            float acc = 0.f;
            const float* wu = p.w_uv + (size_t)h * 128 * 64 + lane;
            for (int c = 0; c < 128; ++c) acc += sQ[h * 128 + c] * wu[c * 64];
            mixed[(size_t)q * DM + 512 + h * 64 + lane] = f2bf(acc);
        }
        lds_fence();
    }
}

DI void phase_ret_scan(const Params& p) {
    float* ST = (float*)(p.ws + OFF_ST);
    const int gtid = blockIdx.x * NTHREADS + threadIdx.x, gsz = gridDim.x * NTHREADS;
    for (int idx = gtid; idx < 32 * 16384; idx += gsz) {
        const int bh = idx >> 14, el = idx & 16383, h = bh & 3;
        const float gc = expf(logf(1.f - exp2f(-5.f - (float)h)) * 64.f);
        float* base = ST + (size_t)bh * 34 * 16384 + el;
        float r = 0.f;
        for (int c = 1; c < 34; ++c) {
            const float u = c < 33 ? base[(size_t)c * 16384] : 0.f;
            base[(size_t)c * 16384] = r;
            r = gc * r + u;
        }
    }
}

DI void phase_ret_out(const Params& p, LAS char* smem) {
    const bf16_t* proj = (const bf16_t*)(p.ws + OFF_BIG);
    const float* ST = (const float*)(p.ws + OFF_ST);
    bf16_t* mixed = (bf16_t*)(p.ws + OFF_HN);
    LAS bf16_t* sQ = (LAS bf16_t*)smem; LAS bf16_t* sK = sQ + 64 * 128; LAS bf16_t* sV = sK + 64 * 128;
    LAS float* sS = (LAS float*)(sV + 64 * 128);
    LAS float* sR = sS + 64 * 65;
    for (int unit = blockIdx.x; unit < 1024; unit += gridDim.x) {
        const int c = 2 + (unit & 31), bh = unit >> 5, h = bh & 3, b = bh >> 2;
        for (int i = threadIdx.x; i < 64 * 16; i += NTHREADS) {
            const int j = i >> 4, ch = i & 15; const int t = 64 * c + j - 112;
            const bf16_t* pr = proj + (size_t)(b * TT + t) * INW;
            *(LAS u32x4*)(sQ + j * 128 + ch * 8) = *(const u32x4*)(pr + C_RQ + h * 128 + ch * 8);
            *(LAS u32x4*)(sK + j * 128 + ch * 8) = *(const u32x4*)(pr + C_RK + h * 128 + ch * 8);
            *(LAS u32x4*)(sV + j * 128 + ch * 8) = *(const u32x4*)(pr + C_RV + h * 128 + ch * 8);
        }
        const float* R = ST + (size_t)(bh * 34 + c) * 16384;
        for (int i = threadIdx.x; i < 16384; i += NTHREADS) sR[(i >> 7) * 129 + (i & 127)] = R[i];
        __syncthreads();
        const float lg = logf(1.f - exp2f(-5.f - (float)h));
        const int i = threadIdx.x >> 3, g8 = threadIdx.x & 7;
        {
            float sacc[8];
#pragma unroll
            for (int jj = 0; jj < 8; ++jj) sacc[jj] = 0.f;
            for (int d = 0; d < 128; ++d) {
                const float qv = bf2f(sQ[i * 128 + d]);
#pragma unroll
                for (int jj = 0; jj < 8; ++jj) sacc[jj] += qv * bf2f(sK[(jj * 8 + g8) * 128 + d]);
            }
#pragma unroll
            for (int jj = 0; jj < 8; ++jj) { const int j = jj * 8 + g8; const int df = i > j ? i - j : j - i; sS[i * 65 + j] = sacc[jj] * expf(lg * (float)df); }
        }
        __syncthreads();
        float o[16];
#pragma unroll
        for (int ee = 0; ee < 16; ++ee) o[ee] = 0.f;
        for (int j = 0; j < 64; ++j) {
            const float sv = sS[i * 65 + j];
#pragma unroll
            for (int ee = 0; ee < 16; ++ee) o[ee] += sv * bf2f(sV[j * 128 + ee * 8 + g8]);
        }
        const float xi = expf(lg * (float)(i + 1));
        for (int d = 0; d < 128; ++d) {
            const float qv = bf2f(sQ[i * 128 + d]) * xi;
#pragma unroll
            for (int ee = 0; ee < 16; ++ee) o[ee] += qv * sR[(ee * 8 + g8) * 129 + d];
        }
        float sum = 0.f;
#pragma unroll
        for (int ee = 0; ee < 16; ++ee) sum += o[ee];
        sum += __shfl_xor(sum, 1); sum += __shfl_xor(sum, 2); sum += __shfl_xor(sum, 4);
        const float mu = sum * (1.f / 128.f);
        float var = 0.f;
#pragma unroll
        for (int ee = 0; ee < 16; ++ee) { const float dlt = o[ee] - mu; var += dlt * dlt; }
        var += __shfl_xor(var, 1); var += __shfl_xor(var, 2); var += __shfl_xor(var, 4);
        const float rs = rsqrtf(var * (1.f / 128.f) + 1e-6f);
        const int t = 64 * c + i - 112, srow = t - NMETA;
        const bf16_t* pg = proj + (size_t)(b * TT + t) * INW + C_RG + h * 128;
        bf16_t* po = mixed + (size_t)(b * SEQ + srow) * DM + h * 128;
#pragma unroll
        for (int ee = 0; ee < 16; ++ee) {
            const int e = ee * 8 + g8;
            const float g = bf2f(pg[e]);
            const float gate = g / (1.f + expf(-g));
            po[e] = f2bf(gate * (o[ee] - mu) * rs);
        }
        __syncthreads();
    }
}

DI void phase_norm2(const Params& p) {
    bf16_t* hn2 = (bf16_t*)(p.ws + OFF_HN);
    const int wave = threadIdx.x >> 6, lane = threadIdx.x & 63;
    for (int row = blockIdx.x * NWAVES + wave; row < NF; row += gridDim.x * NWAVES) {
        const float* src = p.out + (size_t)row * DM; bf16_t* o = hn2 + (size_t)row * DM;
        float4 v[4]; float ss = 0.f;
#pragma unroll
        for (int i = 0; i < 4; ++i) { v[i] = *(const float4*)(src + i * 256 + lane * 4); ss += v[i].x * v[i].x + v[i].y * v[i].y + v[i].z * v[i].z + v[i].w * v[i].w; }
        ss = wave_sum(ss);
        const float rstd = rsqrtf(ss * (1.f / DM) + 1e-6f);
#pragma unroll
        for (int i = 0; i < 4; ++i) {
            const float4 g = *(const float4*)(p.norm_ffn + i * 256 + lane * 4);
            uint2 w;
            w.x = (unsigned)f2bf(v[i].x * rstd * g.x) | ((unsigned)f2bf(v[i].y * rstd * g.y) << 16);
            w.y = (unsigned)f2bf(v[i].z * rstd * g.z) | ((unsigned)f2bf(v[i].w * rstd * g.w) << 16);
            *(uint2*)(o + i * 256 + lane * 4) = w;
        }
    }
}

DI void top16_of_128(float sa, float sb, int lane, float& outv, int& outi) {
    outv = 0.f; outi = 0;
    for (int r = 0; r < 16; ++r) {
        const unsigned long long ka = ((unsigned long long)fkey(sa) << 32) | (unsigned)(0xFFFFFFFFu - (unsigned)lane);
        const unsigned long long kb = ((unsigned long long)fkey(sb) << 32) | (unsigned)(0xFFFFFFFFu - (unsigned)(lane + 64));
        const unsigned long long w = wave_max_u64(ka > kb ? ka : kb);
        const int idx = (int)(0xFFFFFFFFu - (unsigned)w);
        const float val = funkey((unsigned)(w >> 32));
        if (lane == r) { outv = val; outi = idx; }
        if (idx == lane) sa = -INFINITY;
        if (idx == lane + 64) sb = -INFINITY;
    }
}
constexpr int PSEL_WAVE_LDS = 256 * 4 + 64 * 4;
DI void phase_peer_select(const Params& p, LAS char* smem) {
    const float* PQ = (const float*)(p.ws + OFF_BIG);
    int* EIDX = (int*)(p.ws + OFF_ST); float* GATE = (float*)(p.ws + OFF_ST + (size_t)NF * 128 * 4);
    const int wave = threadIdx.x >> 6, lane = threadIdx.x & 63;
    LAS float* sq = (LAS float*)(smem + wave * PSEL_WAVE_LDS);
    LAS float* sv1 = sq + 256; LAS int* si1 = (LAS int*)(sv1 + 16); LAS float* sv2 = (LAS float*)(si1 + 16); LAS int* si2 = (LAS int*)(sv2 + 16);
    for (int n = blockIdx.x * NWAVES + wave; n < NF; n += gridDim.x * NWAVES) {
        for (int h = 0; h < 8; ++h) {
            for (int i = lane; i < 256; i += 64) sq[i] = PQ[(size_t)n * 2048 + h * 256 + i];
            lds_fence();
            const float* k1 = p.sk + (size_t)((h * 2 + 0) * 128) * 128; const float* k2 = p.sk + (size_t)((h * 2 + 1) * 128) * 128;
            float s1a = 0.f, s1b = 0.f, s2a = 0.f, s2b = 0.f;
            for (int k4 = 0; k4 < 32; ++k4) {
                const f32x4 qa = *(const LAS f32x4*)(sq + k4 * 4), qb = *(const LAS f32x4*)(sq + 128 + k4 * 4);
                const float4 a = *(const float4*)(k1 + (size_t)lane * 128 + k4 * 4), bq = *(const float4*)(k1 + (size_t)(lane + 64) * 128 + k4 * 4);
                const float4 c = *(const float4*)(k2 + (size_t)lane * 128 + k4 * 4), d = *(const float4*)(k2 + (size_t)(lane + 64) * 128 + k4 * 4);
                s1a += qa[0] * a.x + qa[1] * a.y + qa[2] * a.z + qa[3] * a.w;
                s1b += qa[0] * bq.x + qa[1] * bq.y + qa[2] * bq.z + qa[3] * bq.w;
                s2a += qb[0] * c.x + qb[1] * c.y + qb[2] * c.z + qb[3] * c.w;
                s2b += qb[0] * d.x + qb[1] * d.y + qb[2] * d.z + qb[3] * d.w;
            }
            float v1, v2; int i1, i2;
            top16_of_128(s1a, s1b, lane, v1, i1);
            top16_of_128(s2a, s2b, lane, v2, i2);
            if (lane < 16) { sv1[lane] = v1; si1[lane] = i1; sv2[lane] = v2; si2[lane] = i2; }
            lds_fence();
            float cv[4];
#pragma unroll
            for (int x = 0; x < 4; ++x) { const int c = lane + 64 * x; cv[x] = sv1[c >> 4] + sv2[c & 15]; }
            float mysc = 0.f; int myc = 0; float topv = 0.f;
            for (int r = 0; r < 16; ++r) {
                unsigned long long best = 0ull;
#pragma unroll
                for (int x = 0; x < 4; ++x) {
                    const unsigned long long kx = ((unsigned long long)fkey(cv[x]) << 32) | (unsigned)(0xFFFFFFFFu - (unsigned)(lane + 64 * x));
                    best = kx > best ? kx : best;
                }
                const unsigned long long w = wave_max_u64(best);
                const int cidx = (int)(0xFFFFFFFFu - (unsigned)w);
                const float val = funkey((unsigned)(w >> 32));
                if (r == 0) topv = val;
                if (lane == r) { mysc = val; myc = cidx; }
#pragma unroll
                for (int x = 0; x < 4; ++x) if (cidx == lane + 64 * x) cv[x] = -INFINITY;
            }
            const float e = lane < 16 ? expf(mysc - topv) : 0.f;
            const float sum = wave_sum(e);
            if (lane < 16) {
                const int eidx = si1[myc >> 4] * 128 + si2[myc & 15];
                EIDX[(size_t)n * 128 + h * 16 + lane] = eidx;
                GATE[(size_t)n * 128 + h * 16 + lane] = e / sum;
            }
            lds_fence();
        }
    }
}

DI void phase_peer_out(const Params& p) {
    const int* EIDX = (const int*)(p.ws + OFF_ST); const float* GATE = (const float*)(p.ws + OFF_ST + (size_t)NF * 128 * 4);
    const int wave = threadIdx.x >> 6, lane = threadIdx.x & 63;
    for (int n = blockIdx.x * NWAVES + wave; n < NF; n += gridDim.x * NWAVES) {
        float* row = p.out + (size_t)n * DM;
        float4 hv[4], hn[4]; float ss = 0.f;
#pragma unroll
        for (int i = 0; i < 4; ++i) { hv[i] = *(const float4*)(row + i * 256 + lane * 4); ss += hv[i].x * hv[i].x + hv[i].y * hv[i].y + hv[i].z * hv[i].z + hv[i].w * hv[i].w; }
        ss = wave_sum(ss);
        const float rstd = rsqrtf(ss * (1.f / DM) + 1e-6f);
#pragma unroll
        for (int i = 0; i < 4; ++i) {
            const float4 g = *(const float4*)(p.norm_ffn + i * 256 + lane * 4);
            hn[i] = make_float4(hv[i].x * rstd * g.x, hv[i].y * rstd * g.y, hv[i].z * rstd * g.z, hv[i].w * rstd * g.w);
        }
        float4 acc[4];
#pragma unroll
        for (int i = 0; i < 4; ++i) acc[i] = make_float4(0.f, 0.f, 0.f, 0.f);
        for (int slot = 0; slot < 128; ++slot) {
            const int e = EIDX[(size_t)n * 128 + slot]; const float gt = GATE[(size_t)n * 128 + slot];
            const float* ur = p.pu + (size_t)e * DM; const float* vr = p.pv + (size_t)e * DM;
            float d = 0.f; float4 vv[4];
#pragma unroll
            for (int i = 0; i < 4; ++i) {
                const float4 u4 = *(const float4*)(ur + i * 256 + lane * 4);
                vv[i] = *(const float4*)(vr + i * 256 + lane * 4);
                d += u4.x * hn[i].x + u4.y * hn[i].y + u4.z * hn[i].z + u4.w * hn[i].w;
            }
            d = wave_sum(d);
            const float coef = 0.5f * d * (1.f + erff(d * 0.70710678118654752f)) * gt;
#pragma unroll
            for (int i = 0; i < 4; ++i) { acc[i].x += coef * vv[i].x; acc[i].y += coef * vv[i].y; acc[i].z += coef * vv[i].z; acc[i].w += coef * vv[i].w; }
        }
        float s2 = 0.f;
#pragma unroll
        for (int i = 0; i < 4; ++i) {
            acc[i].x += hv[i].x; acc[i].y += hv[i].y; acc[i].z += hv[i].z; acc[i].w += hv[i].w;
            s2 += acc[i].x * acc[i].x + acc[i].y * acc[i].y + acc[i].z * acc[i].z + acc[i].w * acc[i].w;
        }
        s2 = wave_sum(s2);
        const float r2 = rsqrtf(s2 * (1.f / DM) + 1e-6f);
#pragma unroll
        for (int i = 0; i < 4; ++i) {
            const float4 g = *(const float4*)(p.norm_final + i * 256 + lane * 4);
            *(float4*)(row + i * 256 + lane * 4) = make_float4(acc[i].x * r2 * g.x, acc[i].y * r2 * g.y, acc[i].z * r2 * g.z, acc[i].w * r2 * g.w);
        }
    }
}

constexpr int NPHASES = 10;
__global__ void __launch_bounds__(NTHREADS, 2) mk_forward(Params p) {
    extern __shared__ __attribute__((aligned(16))) char dyn_smem[];
    LAS char* smem = (LAS char*)dyn_smem;
    const bool multi = (p.hi - p.lo) > 1;
    XcdBarrier bar; bar.bar = (unsigned*)(p.ws + OFF_BAR); bar.x = 0; bar.st = (volatile LAS unsigned*)(smem + LDS_BAR_OFF);
    if (multi) {
        if (threadIdx.x == 0) { const u32x4 z = {0u, 0u, 0u, 0u}; *(LAS u32x4*)(smem + LDS_BAR_OFF) = z; }
        __syncthreads();
        bar = xcd_barrier_post((unsigned*)(p.ws + OFF_BAR), (volatile LAS unsigned*)(smem + LDS_BAR_OFF));
    }
#ifndef PHMASK
#define PHMASK 0xFFFF
#endif
#define PH_ON(i) (((PHMASK >> (i)) & 1) && p.lo <= (i) && (i) < p.hi)
#define PH_SYNC(i) do { if (multi && (i) + 1 < p.hi) xcd_barrier(bar); } while (0)
    if (PH_ON(0)) { phase_prologue(p); PH_SYNC(0); }
    if (PH_ON(1)) { EpiProj e; e.P = (bf16_t*)(p.ws + OFF_BIG); gemm256((const bf16_t*)(p.ws + OFF_HN), (const bf16_t*)(p.ws + OFF_WINT), 1024, MPAD / 256, 4096 / 256, (LAS bf16_t*)smem, e); PH_SYNC(1); }
    if (PH_ON(2)) { phase_rope(p); PH_SYNC(2); }
    if (PH_ON(3)) { phase_ret_state(p, smem); phase_dsa(p, smem); PH_SYNC(3); }
    if (PH_ON(4)) { phase_ret_scan(p); PH_SYNC(4); }
    if (PH_ON(5)) { phase_ret_out(p, smem); PH_SYNC(5); }
    if (PH_ON(6)) { EpiOut e; e.H = p.out; e.X = p.x; gemm256((const bf16_t*)(p.ws + OFF_HN), (const bf16_t*)(p.ws + OFF_WOUTT), 1024, NF / 256, 1024 / 256, (LAS bf16_t*)smem, e); PH_SYNC(6); }
    if (PH_ON(7)) { phase_norm2(p); PH_SYNC(7); }
    if (PH_ON(8)) { EpiPQ e; e.Q = (float*)(p.ws + OFF_BIG); gemm256((const bf16_t*)(p.ws + OFF_HN), (const bf16_t*)(p.ws + OFF_WQT), 1024, NF / 256, 2048 / 256, (LAS bf16_t*)smem, e); PH_SYNC(8); }
    if (PH_ON(9)) { phase_peer_select(p, smem); PH_SYNC(9); }
    if (PH_ON(10)) { phase_peer_out(p); }
}

extern "C" void kernel_launch(void* const* d_in, const int* in_sizes, int n_in, void* d_out, int out_size, void* d_ws, size_t ws_size, hipStream_t stream) {
    static int grid = 0;
    if (grid == 0) {
        if (n_in != 12 || out_size != NF * DM || ws_size < WS_END) { fprintf(stderr, "kernel_launch: unexpected shapes (n_in %d out %d ws %zu need %zu)\n", n_in, out_size, ws_size, (size_t)WS_END); grid = -1; return; }
        int dev = 0, cus = 0, per_cu = 0;
        if (hipGetDevice(&dev) != hipSuccess || hipDeviceGetAttribute(&cus, hipDeviceAttributeMultiprocessorCount, dev) != hipSuccess) { grid = -1; return; }
        if (hipFuncSetAttribute((const void*)mk_forward, hipFuncAttributeMaxDynamicSharedMemorySize, LDS_BYTES) != hipSuccess) { fprintf(stderr, "kernel_launch: hipFuncSetAttribute failed\n"); grid = -1; return; }
        if (hipOccupancyMaxActiveBlocksPerMultiprocessor(&per_cu, (const void*)mk_forward, NTHREADS, LDS_BYTES) != hipSuccess || per_cu < 1)
            fprintf(stderr, "kernel_launch: occupancy query reports %d blocks per CU\n", per_cu);
        (void)hipGetLastError();
        grid = cus > 0 ? cus : 256;
    }
    if (grid < 0) return;
    Params p{};
    p.x = (const float*)d_in[0]; p.meta = (const float*)d_in[1]; p.norm_mix = (const float*)d_in[2]; p.w_in = (const float*)d_in[3];
    p.w_uv = (const float*)d_in[4]; p.w_out = (const float*)d_in[5]; p.norm_ffn = (const float*)d_in[6]; p.wq = (const float*)d_in[7];
    p.sk = (const float*)d_in[8]; p.pu = (const float*)d_in[9]; p.pv = (const float*)d_in[10]; p.norm_final = (const float*)d_in[11];
    p.out = (float*)d_out; p.ws = (char*)d_ws; p.pad0 = 0; p.pad1 = 0;
    (void)hipMemsetAsync((char*)d_ws + OFF_BAR, 0, 16384, stream);
#if MK_LAUNCHES == 1
    p.lo = 0; p.hi = NPHASES + 1;
    hipLaunchKernelGGL(mk_forward, dim3(grid), dim3(NTHREADS), LDS_BYTES, stream, p);
#else
    for (int ph = 0; ph <= NPHASES; ++ph) { p.lo = ph; p.hi = ph + 1; hipLaunchKernelGGL(mk_forward, dim3(grid), dim3(NTHREADS), LDS_BYTES, stream, p); }
#endif
}
```

```cpp
#include <hip/hip_runtime.h>
#include <stdint.h>
#include <stdio.h>

#ifndef MK_LAUNCHES
#define MK_LAUNCHES 1
#endif

#define DI __device__ __forceinline__
typedef unsigned short bf16_t;
typedef short bf16x8 __attribute__((ext_vector_type(8)));
typedef float f32x4 __attribute__((ext_vector_type(4)));
typedef unsigned u32x4 __attribute__((ext_vector_type(4)));

constexpr int NB = 8, SEQ = 2048, NMETA = 16, TT = 2064, DM = 1024, INW = 3912;
constexpr int MROWS = NB * TT;
constexpr int MPAD = 16640;
constexpr int NF = NB * SEQ;
constexpr int C_RQ = 0, C_RK = 512, C_RV = 1024, C_RG = 1536, C_DQ = 2048, C_DK = 3072, C_DV = 3200, C_IQ = 3328, C_IK = 3840, C_IW = 3904;
constexpr int NTHREADS = 512, NWAVES = 8;
constexpr int LDS_BYTES = 163840;
constexpr int LDS_BAR_OFF = 163840 - 256;

constexpr size_t al256(size_t x) { return (x + 255) & ~(size_t)255; }
constexpr size_t OFF_BAR = 0;
constexpr size_t OFF_COS128 = 16384;
constexpr size_t OFF_SIN128 = OFF_COS128 + al256((size_t)TT * 64 * 4);
constexpr size_t OFF_COS64 = OFF_SIN128 + al256((size_t)TT * 64 * 4);
constexpr size_t OFF_SIN64 = OFF_COS64 + al256((size_t)TT * 32 * 4);
constexpr size_t OFF_WINT = OFF_SIN64 + al256((size_t)TT * 32 * 4);
constexpr size_t OFF_WOUTT = OFF_WINT + (size_t)4096 * 1024 * 2;
constexpr size_t OFF_WQT = OFF_WOUTT + (size_t)1024 * 1024 * 2;
constexpr size_t OFF_HN = OFF_WQT + (size_t)2048 * 1024 * 2;
constexpr size_t OFF_BIG = OFF_HN + (size_t)MPAD * 1024 * 2;
constexpr size_t BIG_BYTES = (size_t)NF * 2048 * 4;
constexpr size_t OFF_ST = OFF_BIG + al256(BIG_BYTES);
constexpr size_t ST_BYTES = (size_t)32 * 34 * 16384 * 4;
constexpr size_t WS_END = OFF_ST + ST_BYTES;
static_assert(BIG_BYTES >= (size_t)MPAD * INW * 2, "big region");
static_assert(WS_END <= (size_t)268435456, "workspace");

struct Params {
    const float *x, *meta, *norm_mix, *w_in, *w_uv, *w_out, *norm_ffn, *wq, *sk, *pu, *pv, *norm_final;
    float* out; char* ws; int lo, hi, pad0, pad1;
};

DI float bf2f(bf16_t v) { return __uint_as_float(((unsigned)v) << 16); }
DI bf16_t f2bf(float f) { unsigned u = __float_as_uint(f); u += 0x7fffu + ((u >> 16) & 1u); return (bf16_t)(u >> 16); }
DI float wave_sum(float v) {
#pragma unroll
    for (int o = 32; o > 0; o >>= 1) v += __shfl_xor(v, o);
    return v;
}
DI float wave_max(float v) {
#pragma unroll
    for (int o = 32; o > 0; o >>= 1) v = fmaxf(v, __shfl_xor(v, o));
    return v;
}
DI unsigned long long wave_max_u64(unsigned long long v) {
#pragma unroll
    for (int o = 32; o > 0; o >>= 1) {
        const unsigned hi = __shfl_xor((unsigned)(v >> 32), o), lo = __shfl_xor((unsigned)v, o);
        const unsigned long long w = ((unsigned long long)hi << 32) | lo;
        v = w > v ? w : v;
    }
    return v;
}
DI unsigned fkey(float x) { const unsigned u = __float_as_uint(x); return (u & 0x80000000u) ? ~u : (u | 0x80000000u); }
DI float funkey(unsigned k) { const unsigned u = (k & 0x80000000u) ? (k & 0x7fffffffu) : ~k; return __uint_as_float(u); }
DI void lds_fence() { asm volatile("s_waitcnt lgkmcnt(0)" ::: "memory"); }
DI void unpack8(const u32x4& r, float (&v)[8]) {
    v[0] = __uint_as_float(r.x << 16); v[1] = __uint_as_float(r.x & 0xffff0000u);
    v[2] = __uint_as_float(r.y << 16); v[3] = __uint_as_float(r.y & 0xffff0000u);
    v[4] = __uint_as_float(r.z << 16); v[5] = __uint_as_float(r.z & 0xffff0000u);
    v[6] = __uint_as_float(r.w << 16); v[7] = __uint_as_float(r.w & 0xffff0000u);
}

#define XB_TMO      128
#define XB_XCNT(j)  (256  + 64 * (j))
#define XB_XSUB(j)  (1280 + 64 * (j))
#define XB_XGEN(j)  (2304 + 64 * (j))
#define XB_TOP      3328
#define XB_TOPGEN   3392
#define XCD_BAR_WORDS 3456
#define XB_SPIN_CAP (1u << 20)
#define LAS __attribute__((address_space(3)))

DI unsigned xb_ld(unsigned* p)              { return __hip_atomic_load(p, __ATOMIC_RELAXED, __HIP_MEMORY_SCOPE_AGENT); }
DI unsigned xb_add(unsigned* p, unsigned v) { return __hip_atomic_fetch_add(p, v, __ATOMIC_RELAXED, __HIP_MEMORY_SCOPE_AGENT); }
DI unsigned xb_xcc_id() { return (unsigned)__builtin_amdgcn_s_getreg((3 << 11) | 20) & 0xFu; }
#define XB_SPIN(cond, bar) do { unsigned _sp = 0; while (cond) { __builtin_amdgcn_s_sleep(1); \
    if ((++_sp & 255u) == 0u) { if (xb_ld(&(bar)[XB_TMO])) break; if (_sp > XB_SPIN_CAP) { atomicAdd(&(bar)[XB_TMO], 1u); break; } } } } while (0)

struct XcdBarrier { unsigned* bar; unsigned x; volatile LAS unsigned* st; };

DI XcdBarrier xcd_barrier_post(unsigned* bar, volatile LAS unsigned* st) {
    XcdBarrier b; b.bar = bar; b.x = xb_xcc_id(); b.st = st;
    if (threadIdx.x == 0) (void)xb_add(&bar[XB_XCNT(b.x)], 1u);
    return b;
}
DI void xcd_barrier_complete(unsigned* bar, unsigned x, unsigned& nloc, unsigned& nx) {
    const unsigned G = gridDim.x * gridDim.y * gridDim.z;
    unsigned sum, cnt, mine, sp = 0u;
    for (;;) {
        sum = 0u; cnt = 0u; mine = 0u;
#pragma unroll
        for (unsigned j = 0; j < 16; ++j) { const unsigned c = xb_ld(&bar[XB_XCNT(j)]); sum += c; cnt += (c > 0u) ? 1u : 0u; mine = (j == x) ? c : mine; }
        if (sum == G) break;
        __builtin_amdgcn_s_sleep(1);
        if ((++sp & 255u) == 0u) { if (xb_ld(&bar[XB_TMO])) break; if (sp > XB_SPIN_CAP) { atomicAdd(&bar[XB_TMO], 1u); break; } }
    }
    nloc = mine > 0u ? mine : 1u; nx = cnt > 0u ? cnt : 1u;
}
DI void xcd_barrier(const XcdBarrier& b) {
    asm volatile("s_waitcnt vmcnt(0)" ::: "memory");
    __syncthreads();
    if (threadIdx.x == 0) {
        unsigned* bar = b.bar;
        __builtin_amdgcn_s_waitcnt(0);
        unsigned nloc = b.st[0], nx = b.st[1];
        if (nloc == 0u) { xcd_barrier_complete(bar, b.x, nloc, nx); b.st[0] = nloc; b.st[1] = nx; }
        const unsigned old = xb_add(&bar[XB_XSUB(b.x)], 1u);
        const unsigned gen = old / nloc;
        if (old + 1u == (gen + 1u) * nloc) {
            __builtin_amdgcn_fence(__ATOMIC_RELEASE, "agent");
            asm volatile("s_waitcnt vmcnt(0)" ::: "memory");
            const unsigned og = xb_add(&bar[XB_TOP], 1u);
            const unsigned tg = og / nx;
            if (og + 1u == (tg + 1u) * nx) xb_add(&bar[XB_TOPGEN], 1u);
            else XB_SPIN(xb_ld(&bar[XB_TOPGEN]) == tg, bar);
            __builtin_amdgcn_fence(__ATOMIC_ACQUIRE, "agent");
            xb_add(&bar[XB_XGEN(b.x)], 1u);
            asm volatile("s_waitcnt vmcnt(0)" ::: "memory");
        } else {
            XB_SPIN(xb_ld(&bar[XB_XGEN(b.x)]) == gen, bar);
            __builtin_amdgcn_fence(__ATOMIC_ACQUIRE, "agent");
            asm volatile("s_waitcnt vmcnt(0)" ::: "memory");
        }
    }
    __syncthreads();
}

constexpr int BM = 256, BK = 64, HALF = 128, NXCD = 8, WGM = 8, HT = HALF * BK;
DI int lds_byte(int r, int c) {
    int st = (r >> 4) * 2 + (c >> 5), rr = r & 15, cc = c & 31, ob = rr * 64 + cc * 2;
    return st * 1024 + (ob ^ (((ob >> 9) & 1) << 5));
}
DI void stage_rc(int b, int& R, int& C) {
    int st = b / 1024, sb = b % 1024, swz = sb ^ (((sb >> 9) & 1) << 5);
    R = (st >> 1) * 16 + swz / 64; C = (st & 1) * 32 + (swz % 64) / 2;
}

#define SA(b,h) (shm+((b)*2+(h))*HT)
#define SB(b,h) (shm+(4+(b)*2+(h))*HT)
#define STAGE_X(T,P,BASE,br,kt) do{long _g=(long)(br)*K+(long)(kt)*BK; \
    for(int _i=0;_i<2;++_i){int _b=(T)*16+_i*8192;int _r,_c;stage_rc(_b,_r,_c); \
      __builtin_amdgcn_global_load_lds((const unsigned*)(BASE+_g+(long)_r*K+_c), \
        (LAS unsigned*)((LAS char*)(P)+_b),16,0,0);}}while(0)
#define STAGE(P,BASE,br,kt) STAGE_X(threadIdx.x,P,BASE,br,kt)
#define LDA(dst,b,h) for(int m=0;m<4;++m)for(int k=0;k<2;++k) \
    dst[m][k]=*reinterpret_cast<const LAS bf16x8*>((LAS char*)SA(b,h)+lds_byte(wr*64+m*16+fr,k*32+fq*8))
#define LDB(dst,b,h) for(int n=0;n<2;++n)for(int k=0;k<2;++k) \
    dst[n][k]=*reinterpret_cast<const LAS bf16x8*>((LAS char*)SB(b,h)+lds_byte(wc*32+n*16+fr,k*32+fq*8))
#define MMA(ai,bj,At,Bt_) do{__builtin_amdgcn_s_setprio(1); \
    for(int m=0;m<4;++m)for(int n=0;n<2;++n)for(int k=0;k<2;++k) \
      acc[ai][bj][m][n]=__builtin_amdgcn_mfma_f32_16x16x32_bf16(At[m][k],Bt_[n][k],acc[ai][bj][m][n],0,0,0); \
    __builtin_amdgcn_s_setprio(0);}while(0)
#define WAIT_V(n) asm volatile("s_waitcnt vmcnt(" #n ")":::"memory")
#define WAIT_L(n) asm volatile("s_waitcnt lgkmcnt(" #n ")":::"memory")
#define BAR __builtin_amdgcn_s_barrier()
#define SCHED __builtin_amdgcn_sched_barrier(0)

template <class Epi>
DI void gemm256(const bf16_t* __restrict__ A, const bf16_t* __restrict__ Bt, const int K, const int nM, const int nN, LAS bf16_t* shm, const Epi& epi) {
    const int nwg = nM * nN;
    for (int L = blockIdx.x; L < nwg; L += gridDim.x) {
        int wgid = L;
        { int q = nwg / NXCD, r = nwg % NXCD, xcd = wgid % NXCD, off = wgid / NXCD; wgid = (xcd < r ? xcd * (q + 1) : r * (q + 1) + (xcd - r) * q) + off; }
        int nig = WGM * nN, gid = wgid / nig, fm = gid * WGM, gsz = min(nM - fm, WGM);
        int pm = fm + ((wgid % nig) % gsz), pn = (wgid % nig) / gsz, brow = pm * BM, bcol = pn * BM;
        int wid = threadIdx.x >> 6, lane = threadIdx.x & 63, wr = wid >> 2, wc = wid & 3, fr = lane & 15, fq = lane >> 4;
        f32x4 acc[2][2][4][2] = {};
        bf16x8 At[4][2], B0[2][2], B1[2][2];
        int nt = K / BK;
        STAGE(SB(0,0),Bt,bcol,0); STAGE(SA(0,0),A,brow,0);
        STAGE(SB(0,1),Bt,bcol+HALF,0); STAGE(SA(0,1),A,brow+HALF,0);
        if (wr == 1) BAR;
        WAIT_V(4); BAR;
        STAGE(SB(1,0),Bt,bcol,1); STAGE(SA(1,0),A,brow,1); STAGE(SB(1,1),Bt,bcol+HALF,1);
        WAIT_V(6); BAR;
        for (int t = 0; t < nt - 2; t += 2) {
            LDB(B0,0,0); SCHED; LDA(At,0,0); STAGE(SA(1,1),A,brow+HALF,t+1);
            WAIT_L(8); BAR; WAIT_L(0); MMA(0,0,At,B0); BAR; SCHED;
            LDB(B1,0,1); STAGE(SB(0,0),Bt,bcol,t+2);
            BAR; WAIT_L(0); MMA(0,1,At,B1); BAR;
            LDA(At,0,1); STAGE(SA(0,0),A,brow,t+2);
            BAR; WAIT_L(0); MMA(1,0,At,B0); BAR; SCHED;
            STAGE(SB(0,1),Bt,bcol+HALF,t+2);
            WAIT_V(6); BAR; MMA(1,1,At,B1); BAR;
            LDB(B0,1,0); SCHED; LDA(At,1,0); STAGE(SA(0,1),A,brow+HALF,t+2);
            WAIT_L(8); BAR; WAIT_L(0); MMA(0,0,At,B0); BAR; SCHED;
            LDB(B1,1,1); STAGE(SB(1,0),Bt,bcol,t+3);
            BAR; WAIT_L(0); MMA(0,1,At,B1); BAR;
            LDA(At,1,1); STAGE(SA(1,0),A,brow,t+3);
            BAR; WAIT_L(0); MMA(1,0,At,B0); BAR; SCHED;
            STAGE(SB(1,1),Bt,bcol+HALF,t+3);
            WAIT_V(6); BAR; MMA(1,1,At,B1); BAR;
        }
        int tz = threadIdx.x; asm volatile("" : "+v"(tz)); wid = tz >> 6; lane = tz & 63; wr = wid >> 2; wc = wid & 3; fr = lane & 15; fq = lane >> 4;
        { LDB(B0,0,0); WAIT_V(0); LDA(At,0,0); STAGE_X(tz,SA(1,1),A,brow+HALF,nt-1);
          BAR; WAIT_L(0); MMA(0,0,At,B0); BAR;
          LDB(B1,0,1); BAR; WAIT_L(0); MMA(0,1,At,B1); BAR;
          LDA(At,0,1); WAIT_V(4); BAR; WAIT_L(0); MMA(1,0,At,B0); MMA(1,1,At,B1); BAR; }
        { LDB(B0,1,0); LDA(At,1,0); WAIT_V(2); BAR; WAIT_L(0); MMA(0,0,At,B0); BAR;
          LDB(B1,1,1); WAIT_V(0); BAR; WAIT_L(0); MMA(0,1,At,B1); BAR;
          LDA(At,1,1); BAR; WAIT_L(0); MMA(1,0,At,B0); MMA(1,1,At,B1); BAR; }
        if (wr == 0) BAR;
        epi(acc, brow, bcol, wr, wc, fr, fq);
        __syncthreads();
    }
}

struct EpiProj {
    bf16_t* P;
    DI void operator()(const f32x4 (&acc)[2][2][4][2], int brow, int bcol, int wr, int wc, int fr, int fq) const {
#pragma unroll
        for (int ai = 0; ai < 2; ++ai)
#pragma unroll
        for (int bj = 0; bj < 2; ++bj)
#pragma unroll
        for (int m = 0; m < 4; ++m)
#pragma unroll
        for (int n = 0; n < 2; ++n)
#pragma unroll
        for (int j = 0; j < 4; ++j) {
            const int row = brow + ai * HALF + wr * 64 + m * 16 + fq * 4 + j, col = bcol + bj * HALF + wc * 32 + n * 16 + fr;
            if (col < INW) P[(size_t)row * INW + col] = f2bf(acc[ai][bj][m][n][j]);
        }
    }
};
struct EpiOut {
    float* H; const float* X;
    DI void operator()(const f32x4 (&acc)[2][2][4][2], int brow, int bcol, int wr, int wc, int fr, int fq) const {
#pragma unroll
        for (int ai = 0; ai < 2; ++ai)
#pragma unroll
        for (int bj = 0; bj < 2; ++bj)
#pragma unroll
        for (int m = 0; m < 4; ++m)
#pragma unroll
        for (int n = 0; n < 2; ++n)
#pragma unroll
        for (int j = 0; j < 4; ++j) {
            const int row = brow + ai * HALF + wr * 64 + m * 16 + fq * 4 + j, col = bcol + bj * HALF + wc * 32 + n * 16 + fr;
            const size_t o = (size_t)row * DM + col; H[o] = X[o] + acc[ai][bj][m][n][j];
        }
    }
};
struct EpiPQ {
    float* Q;
    DI void operator()(const f32x4 (&acc)[2][2][4][2], int brow, int bcol, int wr, int wc, int fr, int fq) const {
#pragma unroll
        for (int ai = 0; ai < 2; ++ai)
#pragma unroll
        for (int bj = 0; bj < 2; ++bj)
#pragma unroll
        for (int m = 0; m < 4; ++m)
#pragma unroll
        for (int n = 0; n < 2; ++n)
#pragma unroll
        for (int j = 0; j < 4; ++j) {
            const int row = brow + ai * HALF + wr * 64 + m * 16 + fq * 4 + j, col = bcol + bj * HALF + wc * 32 + n * 16 + fr;
            Q[(size_t)row * 2048 + col] = acc[ai][bj][m][n][j];
        }
    }
};

DI void phase_prologue(const Params& p) {
    const int gtid = blockIdx.x * NTHREADS + threadIdx.x, gsz = gridDim.x * NTHREADS;
    bf16_t* wint = (bf16_t*)(p.ws + OFF_WINT);
    for (int idx = gtid; idx < 4096 * 1024; idx += gsz) {
        const int k = idx >> 12, n = idx & 4095;
        const float v = n < INW ? p.w_in[(size_t)k * INW + n] : 0.f;
        wint[(size_t)n * 1024 + k] = f2bf(v);
    }
    bf16_t* woutt = (bf16_t*)(p.ws + OFF_WOUTT);
    for (int idx = gtid; idx < 1024 * 1024; idx += gsz) {
        const int k = idx >> 10, n = idx & 1023;
        woutt[(size_t)n * 1024 + k] = f2bf(p.w_out[(size_t)k * 1024 + n]);
    }
    bf16_t* wqt = (bf16_t*)(p.ws + OFF_WQT);
    for (int idx = gtid; idx < 1024 * 2048; idx += gsz) {
        const int k = idx >> 11, n = idx & 2047;
        wqt[(size_t)n * 1024 + k] = f2bf(p.wq[(size_t)k * 2048 + n]);
    }
    float* c128 = (float*)(p.ws + OFF_COS128); float* s128 = (float*)(p.ws + OFF_SIN128);
    for (int idx = gtid; idx < TT * 64; idx += gsz) {
        const int pos = idx >> 6, j = idx & 63;
        const float inv = powf(10000.f, -(float)j * 2.0f / 128.f);
        const float ang = (float)pos * inv;
        float s, c; sincosf(ang, &s, &c);
        c128[idx] = c; s128[idx] = s;
    }
    float* c64 = (float*)(p.ws + OFF_COS64); float* s64 = (float*)(p.ws + OFF_SIN64);
    for (int idx = gtid; idx < TT * 32; idx += gsz) {
        const int pos = idx >> 5, j = idx & 31;
        const float inv = powf(10000.f, -(float)j * 2.0f / 64.f);
        const float ang = (float)pos * inv;
        float s, c; sincosf(ang, &s, &c);
        c64[idx] = c; s64[idx] = s;
    }
    bf16_t* hn = (bf16_t*)(p.ws + OFF_HN);
    const int wave = threadIdx.x >> 6, lane = threadIdx.x & 63;
    for (int row = blockIdx.x * NWAVES + wave; row < MPAD; row += gridDim.x * NWAVES) {
        bf16_t* o = hn + (size_t)row * DM;
        if (row >= MROWS) {
            for (int i = 0; i < 4; ++i) *(uint2*)(o + i * 256 + lane * 4) = make_uint2(0u, 0u);
            continue;
        }
        const int b = row / TT, t = row % TT;
        const float* src = t < NMETA ? p.meta + (size_t)t * DM : p.x + ((size_t)b * SEQ + (t - NMETA)) * DM;
        float4 v[4]; float ss = 0.f;
#pragma unroll
        for (int i = 0; i < 4; ++i) { v[i] = *(const float4*)(src + i * 256 + lane * 4); ss += v[i].x * v[i].x + v[i].y * v[i].y + v[i].z * v[i].z + v[i].w * v[i].w; }
        ss = wave_sum(ss);
        const float rstd = rsqrtf(ss * (1.f / DM) + 1e-6f);
#pragma unroll
        for (int i = 0; i < 4; ++i) {
            const float4 g = *(const float4*)(p.norm_mix + i * 256 + lane * 4);
            uint2 w;
            w.x = (unsigned)f2bf(v[i].x * rstd * g.x) | ((unsigned)f2bf(v[i].y * rstd * g.y) << 16);
            w.y = (unsigned)f2bf(v[i].z * rstd * g.z) | ((unsigned)f2bf(v[i].w * rstd * g.w) << 16);
            *(uint2*)(o + i * 256 + lane * 4) = w;
        }
    }
}

DI void phase_rope(const Params& p) {
    bf16_t* proj = (bf16_t*)(p.ws + OFF_BIG);
    const float* c128 = (const float*)(p.ws + OFF_COS128); const float* s128 = (const float*)(p.ws + OFF_SIN128);
    const float* c64 = (const float*)(p.ws + OFF_COS64); const float* s64 = (const float*)(p.ws + OFF_SIN64);
    const int gtid = blockIdx.x * NTHREADS + threadIdx.x, gsz = gridDim.x * NTHREADS;
    const int total = MROWS * 1384;
    for (int idx = gtid; idx < total; idx += gsz) {
        const int row = idx / 1384, it = idx % 1384;
        const int t = row % TT;
        bf16_t* pr = proj + (size_t)row * INW;
        int c1, half, j; float scale; bool big;
        if (it < 256)       { c1 = C_RQ + (it >> 6) * 128 + (it & 63); half = 64; j = it & 63; scale = 1.f; big = true; }
        else if (it < 512)  { const int i2 = it - 256;  c1 = C_RK + (i2 >> 6) * 128 + (i2 & 63); half = 64; j = i2 & 63; scale = 0.08838834764831845f; big = true; }
        else if (it < 1024) { const int i2 = it - 512;  c1 = C_DQ + (i2 >> 6) * 128 + (i2 & 63); half = 64; j = i2 & 63; scale = 0.08838834764831845f; big = true; }
        else if (it < 1088) { const int i2 = it - 1024; c1 = C_DK + i2; half = 64; j = i2; scale = 1.f; big = true; }
        else if (it < 1344) { const int i2 = it - 1088; c1 = C_IQ + (i2 >> 5) * 64 + (i2 & 31); half = 32; j = i2 & 31; scale = 0.125f; big = false; }
        else if (it < 1376) { const int i2 = it - 1344; c1 = C_IK + i2; half = 32; j = i2; scale = 1.f; big = false; }
        else { const int c = C_IW + (it - 1376); pr[c] = f2bf(bf2f(pr[c]) * 0.35355339059327373f); continue; }
        const float cs = big ? c128[t * 64 + j] : c64[t * 32 + j];
        const float sn = big ? s128[t * 64 + j] : s64[t * 32 + j];
        const float x1 = bf2f(pr[c1]), x2 = bf2f(pr[c1 + half]);
        pr[c1] = f2bf((x1 * cs - x2 * sn) * scale);
        pr[c1 + half] = f2bf((x2 * cs + x1 * sn) * scale);
    }
}

DI void phase_ret_state(const Params& p, LAS char* smem) {
    const bf16_t* proj = (const bf16_t*)(p.ws + OFF_BIG);
    float* ST = (float*)(p.ws + OFF_ST);
    LAS bf16_t* sK = (LAS bf16_t*)smem; LAS bf16_t* sV = sK + 64 * 128;
    for (int unit = blockIdx.x; unit < 1024; unit += gridDim.x) {
        const int c = 1 + (unit & 31), bh = unit >> 5, h = bh & 3, b = bh >> 2;
        for (int i = threadIdx.x; i < 64 * 16; i += NTHREADS) {
            const int j = i >> 4, ch = i & 15; const int t = 64 * c + j - 112;
            u32x4 kv = {0u, 0u, 0u, 0u}, vv = {0u, 0u, 0u, 0u};
            if (t >= 0) { const bf16_t* pr = proj + (size_t)(b * TT + t) * INW; kv = *(const u32x4*)(pr + C_RK + h * 128 + ch * 8); vv = *(const u32x4*)(pr + C_RV + h * 128 + ch * 8); }
            *(LAS u32x4*)(sK + j * 128 + ch * 8) = kv; *(LAS u32x4*)(sV + j * 128 + ch * 8) = vv;
        }
        __syncthreads();
        const float lg = logf(1.f - exp2f(-5.f - (float)h));
        const int e = threadIdx.x >> 2, d0 = (threadIdx.x & 3) * 32;
        float acc[32];
#pragma unroll
        for (int dd = 0; dd < 32; ++dd) acc[dd] = 0.f;
        for (int j = 0; j < 64; ++j) {
            const float z = expf(lg * (float)(63 - j)) * bf2f(sV[j * 128 + e]);
#pragma unroll
            for (int d8 = 0; d8 < 4; ++d8) {
                const u32x4 raw = *(const LAS u32x4*)(sK + j * 128 + d0 + d8 * 8); float kv[8]; unpack8(raw, kv);
#pragma unroll
                for (int x = 0; x < 8; ++x) acc[d8 * 8 + x] += z * kv[x];
            }
        }
        float* st = ST + ((size_t)(bh * 34 + c) * 128 + e) * 128 + d0;
#pragma unroll
        for (int d4 = 0; d4 < 8; ++d4) *(float4*)(st + d4 * 4) = make_float4(acc[d4 * 4], acc[d4 * 4 + 1], acc[d4 * 4 + 2], acc[d4 * 4 + 3]);
        __syncthreads();
    }
}

constexpr int DSA_WAVE_LDS = 2176 * 4 + 1024 * 4 + 256 * 4 + 64;
DI void phase_dsa(const Params& p, LAS char* smem) {
    const bf16_t* proj = (const bf16_t*)(p.ws + OFF_BIG);
    bf16_t* mixed = (bf16_t*)(p.ws + OFF_HN);
    const int wave = threadIdx.x >> 6, lane = threadIdx.x & 63;
    LAS float* sSc = (LAS float*)(smem + wave * DSA_WAVE_LDS);
    LAS float* sQ = sSc + 2176;
    LAS int* sSel = (LAS int*)(sQ + 1024);
    LAS float* sIw = (LAS float*)(sSel + 256);
    const unsigned long long lt_mask = (1ull << lane) - 1ull;
    for (int q = blockIdx.x * NWAVES + wave; q < NF; q += gridDim.x * NWAVES) {
        const int b = q >> 11, s = q & 2047, t = NMETA + s;
        const int nk = 80 + 64 * (s >> 6);
        const bf16_t* prow = proj + (size_t)(b * TT + t) * INW;
        for (int i = lane; i < 512; i += 64) sQ[i] = bf2f(prow[C_IQ + i]);
        if (lane < 8) sIw[lane] = bf2f(prow[C_IW + lane]);
        lds_fence();
        const bf16_t* ikbase = proj + (size_t)(b * TT) * INW + C_IK;
        const int nj = (nk + 63) >> 6;
        for (int jj = 0; jj < nj; ++jj) {
            const int k = jj * 64 + lane;
            float sc = 0.f;
            if (k < nk) {
                const bf16_t* kr = ikbase + (size_t)k * INW;
                float a[8];
#pragma unroll
                for (int h = 0; h < 8; ++h) a[h] = 0.f;
#pragma unroll 1
                for (int d8 = 0; d8 < 8; ++d8) {
                    const u32x4 raw = *(const u32x4*)(kr + d8 * 8); float kv[8]; unpack8(raw, kv);
#pragma unroll
                    for (int h = 0; h < 8; ++h) {
                        const f32x4 q0 = *(const LAS f32x4*)(sQ + h * 64 + d8 * 8), q1 = *(const LAS f32x4*)(sQ + h * 64 + d8 * 8 + 4);
                        a[h] += kv[0] * q0[0] + kv[1] * q0[1] + kv[2] * q0[2] + kv[3] * q0[3] + kv[4] * q1[0] + kv[5] * q1[1] + kv[6] * q1[2] + kv[7] * q1[3];
                    }
                }
#pragma unroll
                for (int h = 0; h < 8; ++h) sc += fmaxf(a[h], 0.f) * sIw[h];
                sc += 0.0f;
            }
            sSc[k] = sc;
        }
        lds_fence();
        int L;
        if (nk <= 256) {
            for (int i = lane; i < nk; i += 64) sSel[i] = i;
            L = nk;
        } else {
            unsigned Tkey = 0u;
            for (int bit = 31; bit >= 0; --bit) {
                const unsigned cand = Tkey | (1u << bit);
                int cnt = 0;
                for (int jj = 0; jj < nj; ++jj) {
                    const int k = jj * 64 + lane;
                    const unsigned key = (k < nk) ? fkey(sSc[k]) : 0u;
                    cnt += __popcll(__ballot(key >= cand));
                }
                if (cnt >= 256) Tkey = cand;
            }
            int cgt = 0;
            for (int jj = 0; jj < nj; ++jj) {
                const int k = jj * 64 + lane;
                const unsigned key = (k < nk) ? fkey(sSc[k]) : 0u;
                cgt += __popcll(__ballot(key > Tkey));
            }
            const int need = 256 - cgt;
            int pos = 0, eqseen = 0;
            for (int jj = 0; jj < nj; ++jj) {
                const int k = jj * 64 + lane;
                const unsigned key = (k < nk) ? fkey(sSc[k]) : 0u;
                const bool gt = key > Tkey, eq = (key == Tkey);
                const unsigned long long eqm = __ballot(eq);
                const int myeq = eqseen + __popcll(eqm & lt_mask);
                const bool sel = gt || (eq && myeq < need);
                const unsigned long long sm = __ballot(sel);
                if (sel) sSel[pos + __popcll(sm & lt_mask)] = k;
                pos += __popcll(sm); eqseen += __popcll(eqm);
            }
            L = 256;
        }
        lds_fence();
        for (int i = lane; i < 1024; i += 64) sQ[i] = bf2f(prow[C_DQ + i]);
        lds_fence();
        float sc[8][4];
        const bf16_t* dkbase = proj + (size_t)(b * TT) * INW + C_DK;
#pragma unroll
        for (int il = 0; il < 4; ++il) {
            const int i = lane + 64 * il; const bool ok = i < L; const int key = ok ? sSel[i] : 0;
            const bf16_t* kr = dkbase + (size_t)key * INW;
            float a[8];
#pragma unroll
            for (int h = 0; h < 8; ++h) a[h] = 0.f;
#pragma unroll 1
            for (int d8 = 0; d8 < 16; ++d8) {
                const u32x4 raw = *(const u32x4*)(kr + d8 * 8); float kv[8]; unpack8(raw, kv);
#pragma unroll
                for (int h = 0; h < 8; ++h) {
                    const f32x4 q0 = *(const LAS f32x4*)(sQ + h * 128 + d8 * 8), q1 = *(const LAS f32x4*)(sQ + h * 128 + d8 * 8 + 4);
                    a[h] += kv[0] * q0[0] + kv[1] * q0[1] + kv[2] * q0[2] + kv[3] * q0[3] + kv[4] * q1[0] + kv[5] * q1[1] + kv[6] * q1[2] + kv[7] * q1[3];
                }
            }
#pragma unroll
            for (int h = 0; h < 8; ++h) sc[h][il] = ok ? a[h] : -INFINITY;
        }
#pragma unroll
        for (int h = 0; h < 8; ++h) {
            float m = fmaxf(fmaxf(sc[h][0], sc[h][1]), fmaxf(sc[h][2], sc[h][3]));
            m = wave_max(m);
            float e[4], sum = 0.f;
#pragma unroll
            for (int il = 0; il < 4; ++il) { e[il] = expf(sc[h][il] - m); sum += e[il]; }
            sum = wave_sum(sum);
            const float inv = 1.f / sum;
#pragma unroll
            for (int il = 0; il < 4; ++il) sSc[h * 256 + lane + 64 * il] = e[il] * inv;
        }
        lds_fence();
        float o[8][2];
#pragma unroll
        for (int h = 0; h < 8; ++h) { o[h][0] = 0.f; o[h][1] = 0.f; }
        const bf16_t* dvbase = proj + (size_t)(b * TT) * INW + C_DV;
        for (int i = 0; i < L; ++i) {
            const int key = sSel[i];
            const float v0 = bf2f(dvbase[(size_t)key * INW + lane]), v1 = bf2f(dvbase[(size_t)key * INW + 64 + lane]);
#pragma unroll
            for (int h = 0; h < 8; ++h) { const float pv = sSc[h * 256 + i]; o[h][0] += pv * v0; o[h][1] += pv * v1; }
        }
        lds_fence();
#pragma unroll
        for (int h = 0; h < 8; ++h) { sQ[h * 128 + lane] = o[h][0]; sQ[h * 128 + 64 + lane] = o[h][1]; }
        lds_fence();
        for (int h = 0; h < 8; ++h) {
            float acc = 0.f;
            const float* wu = p.w_uv + (size_t)h * 128 * 64 + lane;
            for (int c = 0; c < 128; ++c) acc += sQ[h * 128 + c] * wu[c * 64];
            mixed[(size_t)q * DM + 512 + h * 64 + lane] = f2bf(acc);
        }
        lds_fence();
    }
}

DI void phase_ret_scan(const Params& p) {
    float* ST = (float*)(p.ws + OFF_ST);
    const int gtid = blockIdx.x * NTHREADS + threadIdx.x, gsz = gridDim.x * NTHREADS;
    for (int idx = gtid; idx < 32 * 16384; idx += gsz) {
        const int bh = idx >> 14, el = idx & 16383, h = bh & 3;
        const float gc = expf(logf(1.f - exp2f(-5.f - (float)h)) * 64.f);
        float* base = ST + (size_t)bh * 34 * 16384 + el;
        float r = 0.f;
        for (int c = 1; c < 34; ++c) {
            const float u = c < 33 ? base[(size_t)c * 16384] : 0.f;
            base[(size_t)c * 16384] = r;
            r = gc * r + u;
        }
    }
}

DI void phase_ret_out(const Params& p, LAS char* smem) {
    const bf16_t* proj = (const bf16_t*)(p.ws + OFF_BIG);
    const float* ST = (const float*)(p.ws + OFF_ST);
    bf16_t* mixed = (bf16_t*)(p.ws + OFF_HN);
    LAS bf16_t* sQ = (LAS bf16_t*)smem; LAS bf16_t* sK = sQ + 64 * 128; LAS bf16_t* sV = sK + 64 * 128;
    LAS float* sS = (LAS float*)(sV + 64 * 128);
    LAS float* sR = sS + 64 * 65;
    for (int unit = blockIdx.x; unit < 1024; unit += gridDim.x) {
        const int c = 2 + (unit & 31), bh = unit >> 5, h = bh & 3, b = bh >> 2;
        for (int i = threadIdx.x; i < 64 * 16; i += NTHREADS) {
            const int j = i >> 4, ch = i & 15; const int t = 64 * c + j - 112;
            const bf16_t* pr = proj + (size_t)(b * TT + t) * INW;
            *(LAS u32x4*)(sQ + j * 128 + ch * 8) = *(const u32x4*)(pr + C_RQ + h * 128 + ch * 8);
            *(LAS u32x4*)(sK + j * 128 + ch * 8) = *(const u32x4*)(pr + C_RK + h * 128 + ch * 8);
            *(LAS u32x4*)(sV + j * 128 + ch * 8) = *(const u32x4*)(pr + C_RV + h * 128 + ch * 8);
        }
        const float* R = ST + (size_t)(bh * 34 + c) * 16384;
        for (int i = threadIdx.x; i < 16384; i += NTHREADS) sR[(i >> 7) * 129 + (i & 127)] = R[i];
        __syncthreads();
        const float lg = logf(1.f - exp2f(-5.f - (float)h));
        const int i = threadIdx.x >> 3, g8 = threadIdx.x & 7;
        {
            float sacc[8];
#pragma unroll
            for (int jj = 0; jj < 8; ++jj) sacc[jj] = 0.f;
            for (int d = 0; d < 128; ++d) {
                const float qv = bf2f(sQ[i * 128 + d]);
#pragma unroll
                for (int jj = 0; jj < 8; ++jj) sacc[jj] += qv * bf2f(sK[(jj * 8 + g8) * 128 + d]);
            }
#pragma unroll
            for (int jj = 0; jj < 8; ++jj) { const int j = jj * 8 + g8; const int df = i > j ? i - j : j - i; sS[i * 65 + j] = sacc[jj] * expf(lg * (float)df); }
        }
        __syncthreads();
        float o[16];
#pragma unroll
        for (int ee = 0; ee < 16; ++ee) o[ee] = 0.f;
        for (int j = 0; j < 64; ++j) {
            const float sv = sS[i * 65 + j];
#pragma unroll
            for (int ee = 0; ee < 16; ++ee) o[ee] += sv * bf2f(sV[j * 128 + ee * 8 + g8]);
        }
        const float xi = expf(lg * (float)(i + 1));
        for (int d = 0; d < 128; ++d) {
            const float qv = bf2f(sQ[i * 128 + d]) * xi;
#pragma unroll
            for (int ee = 0; ee < 16; ++ee) o[ee] += qv * sR[(ee * 8 + g8) * 129 + d];
        }
        float sum = 0.f;
#pragma unroll
        for (int ee = 0; ee < 16; ++ee) sum += o[ee];
        sum += __shfl_xor(sum, 1); sum += __shfl_xor(sum, 2); sum += __shfl_xor(sum, 4);
        const float mu = sum * (1.f / 128.f);
        float var = 0.f;
#pragma unroll
        for (int ee = 0; ee < 16; ++ee) { const float dlt = o[ee] - mu; var += dlt * dlt; }
        var += __shfl_xor(var, 1); var += __shfl_xor(var, 2); var += __shfl_xor(var, 4);
        const float rs = rsqrtf(var * (1.f / 128.f) + 1e-6f);
        const int t = 64 * c + i - 112, srow = t - NMETA;
        const bf16_t* pg = proj + (size_t)(b * TT + t) * INW + C_RG + h * 128;
        bf16_t* po = mixed + (size_t)(b * SEQ + srow) * DM + h * 128;
#pragma unroll
        for (int ee = 0; ee < 16; ++ee) {
            const int e = ee * 8 + g8;
            const float g = bf2f(pg[e]);
            const float gate = g / (1.f + expf(-g));
            po[e] = f2bf(gate * (o[ee] - mu) * rs);
        }
        __syncthreads();
    }
}

DI void phase_norm2(const Params& p) {
    bf16_t* hn2 = (bf16_t*)(p.ws + OFF_HN);
    const int wave = threadIdx.x >> 6, lane = threadIdx.x & 63;
    for (int row = blockIdx.x * NWAVES + wave; row < NF; row += gridDim.x * NWAVES) {
        const float* src = p.out + (size_t)row * DM; bf16_t* o = hn2 + (size_t)row * DM;
        float4 v[4]; float ss = 0.f;
#pragma unroll
        for (int i = 0; i < 4; ++i) { v[i] = *(const float4*)(src + i * 256 + lane * 4); ss += v[i].x * v[i].x + v[i].y * v[i].y + v[i].z * v[i].z + v[i].w * v[i].w; }
        ss = wave_sum(ss);
        const float rstd = rsqrtf(ss * (1.f / DM) + 1e-6f);
#pragma unroll
        for (int i = 0; i < 4; ++i) {
            const float4 g = *(const float4*)(p.norm_ffn + i * 256 + lane * 4);
            uint2 w;
            w.x = (unsigned)f2bf(v[i].x * rstd * g.x) | ((unsigned)f2bf(v[i].y * rstd * g.y) << 16);
            w.y = (unsigned)f2bf(v[i].z * rstd * g.z) | ((unsigned)f2bf(v[i].w * rstd * g.w) << 16);
            *(uint2*)(o + i * 256 + lane * 4) = w;
        }
    }
}

DI void top16_of_128(float sa, float sb, int lane, float& outv, int& outi) {
    outv = 0.f; outi = 0;
    for (int r = 0; r < 16; ++r) {
        const unsigned long long ka = ((unsigned long long)fkey(sa) << 32) | (unsigned)(0xFFFFFFFFu - (unsigned)lane);
        const unsigned long long kb = ((unsigned long long)fkey(sb) << 32) | (unsigned)(0xFFFFFFFFu - (unsigned)(lane + 64));
        const unsigned long long w = wave_max_u64(ka > kb ? ka : kb);
        const int idx = (int)(0xFFFFFFFFu - (unsigned)w);
        const float val = funkey((unsigned)(w >> 32));
        if (lane == r) { outv = val; outi = idx; }
        if (idx == lane) sa = -INFINITY;
        if (idx == lane + 64) sb = -INFINITY;
    }
}
constexpr int PSEL_WAVE_LDS = 256 * 4 + 64 * 4;
DI void phase_peer_select(const Params& p, LAS char* smem) {
    const float* PQ = (const float*)(p.ws + OFF_BIG);
    int* EIDX = (int*)(p.ws + OFF_ST); float* GATE = (float*)(p.ws + OFF_ST + (size_t)NF * 128 * 4);
    const int wave = threadIdx.x >> 6, lane = threadIdx.x & 63;
    LAS float* sq = (LAS float*)(smem + wave * PSEL_WAVE_LDS);
    LAS float* sv1 = sq + 256; LAS int* si1 = (LAS int*)(sv1 + 16); LAS float* sv2 = (LAS float*)(si1 + 16); LAS int* si2 = (LAS int*)(sv2 + 16);
    for (int n = blockIdx.x * NWAVES + wave; n < NF; n += gridDim.x * NWAVES) {
        for (int h = 0; h < 8; ++h) {
            for (int i = lane; i < 256; i += 64) sq[i] = PQ[(size_t)n * 2048 + h * 256 + i];
            lds_fence();
            const float* k1 = p.sk + (size_t)((h * 2 + 0) * 128) * 128; const float* k2 = p.sk + (size_t)((h * 2 + 1) * 128) * 128;
            float s1a = 0.f, s1b = 0.f, s2a = 0.f, s2b = 0.f;
            for (int k4 = 0; k4 < 32; ++k4) {
                const f32x4 qa = *(const LAS f32x4*)(sq + k4 * 4), qb = *(const LAS f32x4*)(sq + 128 + k4 * 4);
                const float4 a = *(const float4*)(k1 + (size_t)lane * 128 + k4 * 4), bq = *(const float4*)(k1 + (size_t)(lane + 64) * 128 + k4 * 4);
                const float4 c = *(const float4*)(k2 + (size_t)lane * 128 + k4 * 4), d = *(const float4*)(k2 + (size_t)(lane + 64) * 128 + k4 * 4);
                s1a += qa[0] * a.x + qa[1] * a.y + qa[2] * a.z + qa[3] * a.w;
                s1b += qa[0] * bq.x + qa[1] * bq.y + qa[2] * bq.z + qa[3] * bq.w;
                s2a += qb[0] * c.x + qb[1] * c.y + qb[2] * c.z + qb[3] * c.w;
                s2b += qb[0] * d.x + qb[1] * d.y + qb[2] * d.z + qb[3] * d.w;
            }
            float v1, v2; int i1, i2;
            top16_of_128(s1a, s1b, lane, v1, i1);
            top16_of_128(s2a, s2b, lane, v2, i2);
            if (lane < 16) { sv1[lane] = v1; si1[lane] = i1; sv2[lane] = v2; si2[lane] = i2; }
            lds_fence();
            float cv[4];
#pragma unroll
            for (int x = 0; x < 4; ++x) { const int c = lane + 64 * x; cv[x] = sv1[c >> 4] + sv2[c & 15]; }
            float mysc = 0.f; int myc = 0; float topv = 0.f;
            for (int r = 0; r < 16; ++r) {
                unsigned long long best = 0ull;
#pragma unroll
                for (int x = 0; x < 4; ++x) {
                    const unsigned long long kx = ((unsigned long long)fkey(cv[x]) << 32) | (unsigned)(0xFFFFFFFFu - (unsigned)(lane + 64 * x));
                    best = kx > best ? kx : best;
                }
                const unsigned long long w = wave_max_u64(best);
                const int cidx = (int)(0xFFFFFFFFu - (unsigned)w);
                const float val = funkey((unsigned)(w >> 32));
                if (r == 0) topv = val;
                if (lane == r) { mysc = val; myc = cidx; }
#pragma unroll
                for (int x = 0; x < 4; ++x) if (cidx == lane + 64 * x) cv[x] = -INFINITY;
            }
            const float e = lane < 16 ? expf(mysc - topv) : 0.f;
            const float sum = wave_sum(e);
            if (lane < 16) {
                const int eidx = si1[myc >> 4] * 128 + si2[myc & 15];
                EIDX[(size_t)n * 128 + h * 16 + lane] = eidx;
                GATE[(size_t)n * 128 + h * 16 + lane] = e / sum;
            }
            lds_fence();
        }
    }
}

DI void phase_peer_out(const Params& p) {
    const int* EIDX = (const int*)(p.ws + OFF_ST); const float* GATE = (const float*)(p.ws + OFF_ST + (size_t)NF * 128 * 4);
    const int wave = threadIdx.x >> 6, lane = threadIdx.x & 63;
    for (int n = blockIdx.x * NWAVES + wave; n < NF; n += gridDim.x * NWAVES) {
        float* row = p.out + (size_t)n * DM;
        float4 hv[4], hn[4]; float ss = 0.f;
#pragma unroll
        for (int i = 0; i < 4; ++i) { hv[i] = *(const float4*)(row + i * 256 + lane * 4); ss += hv[i].x * hv[i].x + hv[i].y * hv[i].y + hv[i].z * hv[i].z + hv[i].w * hv[i].w; }
        ss = wave_sum(ss);
        const float rstd = rsqrtf(ss * (1.f / DM) + 1e-6f);
#pragma unroll
        for (int i = 0; i < 4; ++i) {
            const float4 g = *(const float4*)(p.norm_ffn + i * 256 + lane * 4);
            hn[i] = make_float4(hv[i].x * rstd * g.x, hv[i].y * rstd * g.y, hv[i].z * rstd * g.z, hv[i].w * rstd * g.w);
        }
        float4 acc[4];
#pragma unroll
        for (int i = 0; i < 4; ++i) acc[i] = make_float4(0.f, 0.f, 0.f, 0.f);
        for (int slot = 0; slot < 128; ++slot) {
            const int e = EIDX[(size_t)n * 128 + slot]; const float gt = GATE[(size_t)n * 128 + slot];
            const float* ur = p.pu + (size_t)e * DM; const float* vr = p.pv + (size_t)e * DM;
            float d = 0.f; float4 vv[4];
#pragma unroll
            for (int i = 0; i < 4; ++i) {
                const float4 u4 = *(const float4*)(ur + i * 256 + lane * 4);
                vv[i] = *(const float4*)(vr + i * 256 + lane * 4);
                d += u4.x * hn[i].x + u4.y * hn[i].y + u4.z * hn[i].z + u4.w * hn[i].w;
            }
            d = wave_sum(d);
            const float coef = 0.5f * d * (1.f + erff(d * 0.70710678118654752f)) * gt;
#pragma unroll
            for (int i = 0; i < 4; ++i) { acc[i].x += coef * vv[i].x; acc[i].y += coef * vv[i].y; acc[i].z += coef * vv[i].z; acc[i].w += coef * vv[i].w; }
        }
        float s2 = 0.f;
#pragma unroll
        for (int i = 0; i < 4; ++i) {
            acc[i].x += hv[i].x; acc[i].y += hv[i].y; acc[i].z += hv[i].z; acc[i].w += hv[i].w;
            s2 += acc[i].x * acc[i].x + acc[i].y * acc[i].y + acc[i].z * acc[i].z + acc[i].w * acc[i].w;
        }
        s2 = wave_sum(s2);
        const float r2 = rsqrtf(s2 * (1.f / DM) + 1e-6f);
#pragma unroll
        for (int i = 0; i < 4; ++i) {
            const float4 g = *(const float4*)(p.norm_final + i * 256 + lane * 4);
            *(float4*)(row + i * 256 + lane * 4) = make_float4(acc[i].x * r2 * g.x, acc[i].y * r2 * g.y, acc[i].z * r2 * g.z, acc[i].w * r2 * g.w);
        }
    }
}

constexpr int NPHASES = 10;
__global__ void __launch_bounds__(NTHREADS, 2) mk_forward(Params p) {
    extern __shared__ __attribute__((aligned(16))) char dyn_smem[];
    LAS char* smem = (LAS char*)dyn_smem;
    const bool multi = (p.hi - p.lo) > 1;
    XcdBarrier bar; bar.bar = (unsigned*)(p.ws + OFF_BAR); bar.x = 0; bar.st = (volatile LAS unsigned*)(smem + LDS_BAR_OFF);
    if (multi) {
        if (threadIdx.x == 0) { const u32x4 z = {0u, 0u, 0u, 0u}; *(LAS u32x4*)(smem + LDS_BAR_OFF) = z; }
        __syncthreads();
        bar = xcd_barrier_post((unsigned*)(p.ws + OFF_BAR), (volatile LAS unsigned*)(smem + LDS_BAR_OFF));
    }
#ifndef PHMASK
#define PHMASK 0xFFFF
#endif
#define PH_ON(i) (((PHMASK >> (i)) & 1) && p.lo <= (i) && (i) < p.hi)
#define PH_SYNC(i) do { if (multi && (i) + 1 < p.hi) xcd_barrier(bar); } while (0)
    if (PH_ON(0)) { phase_prologue(p); PH_SYNC(0); }
    if (PH_ON(1)) { EpiProj e; e.P = (bf16_t*)(p.ws + OFF_BIG); gemm256((const bf16_t*)(p.ws + OFF_HN), (const bf16_t*)(p.ws + OFF_WINT), 1024, MPAD / 256, 4096 / 256, (LAS bf16_t*)smem, e); PH_SYNC(1); }
    if (PH_ON(2)) { phase_rope(p); PH_SYNC(2); }
    if (PH_ON(3)) { phase_ret_state(p, smem); phase_dsa(p, smem); PH_SYNC(3); }
    if (PH_ON(4)) { phase_ret_scan(p); PH_SYNC(4); }
    if (PH_ON(5)) { phase_ret_out(p, smem); PH_SYNC(5); }
    if (PH_ON(6)) { EpiOut e; e.H = p.out; e.X = p.x; gemm256((const bf16_t*)(p.ws + OFF_HN), (const bf16_t*)(p.ws + OFF_WOUTT), 1024, NF / 256, 1024 / 256, (LAS bf16_t*)smem, e); PH_SYNC(6); }
    if (PH_ON(7)) { phase_norm2(p); PH_SYNC(7); }
    if (PH_ON(8)) { EpiPQ e; e.Q = (float*)(p.ws + OFF_BIG); gemm256((const bf16_t*)(p.ws + OFF_HN), (const bf16_t*)(p.ws + OFF_WQT), 1024, NF / 256, 2048 / 256, (LAS bf16_t*)smem, e); PH_SYNC(8); }
    if (PH_ON(9)) { phase_peer_select(p, smem); PH_SYNC(9); }
    if (PH_ON(10)) { phase_peer_out(p); }
}

extern "C" void kernel_launch(void* const* d_in, const int* in_sizes, int n_in, void* d_out, int out_size, void* d_ws, size_t ws_size, hipStream_t stream) {
    static int grid = 0;
    if (grid == 0) {
        if (n_in != 12 || out_size != NF * DM || ws_size < WS_END) { fprintf(stderr, "kernel_launch: unexpected shapes (n_in %d out %d ws %zu need %zu)\n", n_in, out_size, ws_size, (size_t)WS_END); grid = -1; return; }
        int dev = 0, cus = 0, per_cu = 0;
        if (hipGetDevice(&dev) != hipSuccess || hipDeviceGetAttribute(&cus, hipDeviceAttributeMultiprocessorCount, dev) != hipSuccess) { grid = -1; return; }
        if (hipFuncSetAttribute((const void*)mk_forward, hipFuncAttributeMaxDynamicSharedMemorySize, LDS_BYTES) != hipSuccess) { fprintf(stderr, "kernel_launch: hipFuncSetAttribute failed\n"); grid = -1; return; }
        if (hipOccupancyMaxActiveBlocksPerMultiprocessor(&per_cu, (const void*)mk_forward, NTHREADS, LDS_BYTES) != hipSuccess || per_cu < 1)
            fprintf(stderr, "kernel_launch: occupancy query reports %d blocks per CU\n", per_cu);
        (void)hipGetLastError();
        grid = cus > 0 ? cus : 256;
    }
    if (grid < 0) return;
    Params p{};
    p.x = (const float*)d_in[0]; p.meta = (const float*)d_in[1]; p.norm_mix = (const float*)d_in[2]; p.w_in = (const float*)d_in[3];
    p.w_uv = (const float*)d_in[4]; p.w_out = (const float*)d_in[5]; p.norm_ffn = (const float*)d_in[6]; p.wq = (const float*)d_in[7];
    p.sk = (const float*)d_in[8]; p.pu = (const float*)d_in[9]; p.pv = (const float*)d_in[10]; p.norm_final = (const float*)d_in[11];
    p.out = (float*)d_out; p.ws = (char*)d_ws; p.pad0 = 0; p.pad1 = 0;
    (void)hipMemsetAsync((char*)d_ws + OFF_BAR, 0, 16384, stream);
#if MK_LAUNCHES == 1
    p.lo = 0; p.hi = NPHASES + 1;
    hipLaunchKernelGGL(mk_forward, dim3(grid), dim3(NTHREADS), LDS_BYTES, stream, p);
#else
    for (int ph = 0; ph <= NPHASES; ++ph) { p.lo = ph; p.hi = ph + 1; hipLaunchKernelGGL(mk_forward, dim3(grid), dim3(NTHREADS), LDS_BYTES, stream, p); }
#endif
}
```

```cpp
#include <hip/hip_runtime.h>
#include <stdint.h>
#include <stdio.h>

#ifndef MK_LAUNCHES
#define MK_LAUNCHES 1
#endif

#define DI __device__ __forceinline__
typedef unsigned short bf16_t;
typedef short bf16x8 __attribute__((ext_vector_type(8)));
typedef float f32x4 __attribute__((ext_vector_type(4)));
typedef unsigned u32x4 __attribute__((ext_vector_type(4)));

constexpr int NB = 8, SEQ = 2048, NMETA = 16, TT = 2064, DM = 1024, INW = 3912;
constexpr int MROWS = NB * TT;
constexpr int MPAD = 16640;
constexpr int NF = NB * SEQ;
constexpr int C_RQ = 0, C_RK = 512, C_RV = 1024, C_RG = 1536, C_DQ = 2048, C_DK = 3072, C_DV = 3200, C_IQ = 3328, C_IK = 3840, C_IW = 3904;
constexpr int NTHREADS = 512, NWAVES = 8;
constexpr int LDS_BYTES = 163840;
constexpr int LDS_BAR_OFF = 163840 - 256;

constexpr size_t al256(size_t x) { return (x + 255) & ~(size_t)255; }
constexpr size_t OFF_BAR = 0;
constexpr size_t OFF_COS128 = 16384;
constexpr size_t OFF_SIN128 = OFF_COS128 + al256((size_t)TT * 64 * 4);
constexpr size_t OFF_COS64 = OFF_SIN128 + al256((size_t)TT * 64 * 4);
constexpr size_t OFF_SIN64 = OFF_COS64 + al256((size_t)TT * 32 * 4);
constexpr size_t OFF_WINT = OFF_SIN64 + al256((size_t)TT * 32 * 4);
constexpr size_t OFF_WOUTT = OFF_WINT + (size_t)4096 * 1024 * 2;
constexpr size_t OFF_WQT = OFF_WOUTT + (size_t)1024 * 1024 * 2;
constexpr size_t OFF_SKH = OFF_WQT + (size_t)2048 * 1024 * 2;
constexpr size_t OFF_SKL = OFF_SKH + (size_t)2048 * 128 * 2;
constexpr size_t OFF_HN = OFF_SKL + (size_t)2048 * 128 * 2;
constexpr size_t OFF_BIG = OFF_HN + (size_t)MPAD * 1024 * 2;
constexpr size_t BIG_BYTES = (size_t)NF * 2048 * 4;
constexpr size_t OFF_ST = OFF_BIG + al256(BIG_BYTES);
constexpr size_t ST_BYTES = (size_t)32 * 34 * 16384 * 4;
constexpr size_t WS_END = OFF_ST + ST_BYTES;
constexpr size_t OFF_EIDX = OFF_ST, OFF_GATE = OFF_ST + (size_t)NF * 128 * 4;
constexpr size_t OFF_U16 = OFF_ST + (size_t)NF * 128 * 8;
constexpr size_t OFF_V16 = OFF_HN;
static_assert(OFF_U16 + (size_t)16384 * 1024 * 2 <= WS_END, "u16");
static_assert(BIG_BYTES >= (size_t)MPAD * INW * 2, "big region");
static_assert(WS_END <= (size_t)268435456, "workspace");

struct Params {
    const float *x, *meta, *norm_mix, *w_in, *w_uv, *w_out, *norm_ffn, *wq, *sk, *pu, *pv, *norm_final;
    float* out; char* ws; int lo, hi, pad0, pad1;
};

DI float bf2f(bf16_t v) { return __uint_as_float(((unsigned)v) << 16); }
DI bf16_t f2bf(float f) { unsigned u = __float_as_uint(f); u += 0x7fffu + ((u >> 16) & 1u); return (bf16_t)(u >> 16); }
DI float wave_sum(float v) {
#pragma unroll
    for (int o = 32; o > 0; o >>= 1) v += __shfl_xor(v, o);
    return v;
}
DI float wave_max(float v) {
#pragma unroll
    for (int o = 32; o > 0; o >>= 1) v = fmaxf(v, __shfl_xor(v, o));
    return v;
}
DI unsigned long long wave_max_u64(unsigned long long v) {
#pragma unroll
    for (int o = 32; o > 0; o >>= 1) {
        const unsigned hi = __shfl_xor((unsigned)(v >> 32), o), lo = __shfl_xor((unsigned)v, o);
        const unsigned long long w = ((unsigned long long)hi << 32) | lo;
        v = w > v ? w : v;
    }
    return v;
}
DI unsigned fkey(float x) { const unsigned u = __float_as_uint(x); return (u & 0x80000000u) ? ~u : (u | 0x80000000u); }
DI float funkey(unsigned k) { const unsigned u = (k & 0x80000000u) ? (k & 0x7fffffffu) : ~k; return __uint_as_float(u); }
DI void lds_fence() { asm volatile("s_waitcnt lgkmcnt(0)" ::: "memory"); }
DI void unpack8(const u32x4& r, float (&v)[8]) {
    v[0] = __uint_as_float(r.x << 16); v[1] = __uint_as_float(r.x & 0xffff0000u);
    v[2] = __uint_as_float(r.y << 16); v[3] = __uint_as_float(r.y & 0xffff0000u);
    v[4] = __uint_as_float(r.z << 16); v[5] = __uint_as_float(r.z & 0xffff0000u);
    v[6] = __uint_as_float(r.w << 16); v[7] = __uint_as_float(r.w & 0xffff0000u);
}

#define XB_TMO      128
#define XB_XCNT(j)  (256  + 64 * (j))
#define XB_XSUB(j)  (1280 + 64 * (j))
#define XB_XGEN(j)  (2304 + 64 * (j))
#define XB_TOP      3328
#define XB_TOPGEN   3392
#define XCD_BAR_WORDS 3456
#define XB_SPIN_CAP (1u << 20)
#define LAS __attribute__((address_space(3)))

DI unsigned xb_ld(unsigned* p)              { return __hip_atomic_load(p, __ATOMIC_RELAXED, __HIP_MEMORY_SCOPE_AGENT); }
DI unsigned xb_add(unsigned* p, unsigned v) { return __hip_atomic_fetch_add(p, v, __ATOMIC_RELAXED, __HIP_MEMORY_SCOPE_AGENT); }
DI unsigned xb_xcc_id() { return (unsigned)__builtin_amdgcn_s_getreg((3 << 11) | 20) & 0xFu; }
#define XB_SPIN(cond, bar) do { unsigned _sp = 0; while (cond) { __builtin_amdgcn_s_sleep(1); \
    if ((++_sp & 255u) == 0u) { if (xb_ld(&(bar)[XB_TMO])) break; if (_sp > XB_SPIN_CAP) { atomicAdd(&(bar)[XB_TMO], 1u); break; } } } } while (0)

struct XcdBarrier { unsigned* bar; unsigned x; volatile LAS unsigned* st; };

DI XcdBarrier xcd_barrier_post(unsigned* bar, volatile LAS unsigned* st) {
    XcdBarrier b; b.bar = bar; b.x = xb_xcc_id(); b.st = st;
    if (threadIdx.x == 0) (void)xb_add(&bar[XB_XCNT(b.x)], 1u);
    return b;
}
DI void xcd_barrier_complete(unsigned* bar, unsigned x, unsigned& nloc, unsigned& nx) {
    const unsigned G = gridDim.x * gridDim.y * gridDim.z;
    unsigned sum, cnt, mine, sp = 0u;
    for (;;) {
        sum = 0u; cnt = 0u; mine = 0u;
#pragma unroll
        for (unsigned j = 0; j < 16; ++j) { const unsigned c = xb_ld(&bar[XB_XCNT(j)]); sum += c; cnt += (c > 0u) ? 1u : 0u; mine = (j == x) ? c : mine; }
        if (sum == G) break;
        __builtin_amdgcn_s_sleep(1);
        if ((++sp & 255u) == 0u) { if (xb_ld(&bar[XB_TMO])) break; if (sp > XB_SPIN_CAP) { atomicAdd(&bar[XB_TMO], 1u); break; } }
    }
    nloc = mine > 0u ? mine : 1u; nx = cnt > 0u ? cnt : 1u;
}
DI void xcd_barrier(const XcdBarrier& b) {
    asm volatile("s_waitcnt vmcnt(0)" ::: "memory");
    __syncthreads();
    if (threadIdx.x == 0) {
        unsigned* bar = b.bar;
        __builtin_amdgcn_s_waitcnt(0);
        unsigned nloc = b.st[0], nx = b.st[1];
        if (nloc == 0u) { xcd_barrier_complete(bar, b.x, nloc, nx); b.st[0] = nloc; b.st[1] = nx; }
        const unsigned old = xb_add(&bar[XB_XSUB(b.x)], 1u);
        const unsigned gen = old / nloc;
        if (old + 1u == (gen + 1u) * nloc) {
            __builtin_amdgcn_fence(__ATOMIC_RELEASE, "agent");
            asm volatile("s_waitcnt vmcnt(0)" ::: "memory");
            const unsigned og = xb_add(&bar[XB_TOP], 1u);
            const unsigned tg = og / nx;
            if (og + 1u == (tg + 1u) * nx) xb_add(&bar[XB_TOPGEN], 1u);
            else XB_SPIN(xb_ld(&bar[XB_TOPGEN]) == tg, bar);
            __builtin_amdgcn_fence(__ATOMIC_ACQUIRE, "agent");
            xb_add(&bar[XB_XGEN(b.x)], 1u);
            asm volatile("s_waitcnt vmcnt(0)" ::: "memory");
        } else {
            XB_SPIN(xb_ld(&bar[XB_XGEN(b.x)]) == gen, bar);
            __builtin_amdgcn_fence(__ATOMIC_ACQUIRE, "agent");
            asm volatile("s_waitcnt vmcnt(0)" ::: "memory");
        }
    }
    __syncthreads();
}

constexpr int BM = 256, BK = 64, HALF = 128, NXCD = 8, WGM = 8, HT = HALF * BK;
DI int lds_byte(int r, int c) {
    int st = (r >> 4) * 2 + (c >> 5), rr = r & 15, cc = c & 31, ob = rr * 64 + cc * 2;
    return st * 1024 + (ob ^ (((ob >> 9) & 1) << 5));
}
DI void stage_rc(int b, int& R, int& C) {
    int st = b / 1024, sb = b % 1024, swz = sb ^ (((sb >> 9) & 1) << 5);
    R = (st >> 1) * 16 + swz / 64; C = (st & 1) * 32 + (swz % 64) / 2;
}

#define SA(b,h) (shm+((b)*2+(h))*HT)
#define SB(b,h) (shm+(4+(b)*2+(h))*HT)
#define STAGE_X(T,P,BASE,br,kt) do{long _g=(long)(br)*K+(long)(kt)*BK; \
    for(int _i=0;_i<2;++_i){int _b=(T)*16+_i*8192;int _r,_c;stage_rc(_b,_r,_c); \
      __builtin_amdgcn_global_load_lds((const unsigned*)(BASE+_g+(long)_r*K+_c), \
        (LAS unsigned*)((LAS char*)(P)+_b),16,0,0);}}while(0)
#define STAGE(P,BASE,br,kt) STAGE_X(threadIdx.x,P,BASE,br,kt)
#define LDA(dst,b,h) for(int m=0;m<4;++m)for(int k=0;k<2;++k) \
    dst[m][k]=*reinterpret_cast<const LAS bf16x8*>((LAS char*)SA(b,h)+lds_byte(wr*64+m*16+fr,k*32+fq*8))
#define LDB(dst,b,h) for(int n=0;n<2;++n)for(int k=0;k<2;++k) \
    dst[n][k]=*reinterpret_cast<const LAS bf16x8*>((LAS char*)SB(b,h)+lds_byte(wc*32+n*16+fr,k*32+fq*8))
#define MMA(ai,bj,At,Bt_) do{__builtin_amdgcn_s_setprio(1); \
    for(int m=0;m<4;++m)for(int n=0;n<2;++n)for(int k=0;k<2;++k) \
      acc[ai][bj][m][n]=__builtin_amdgcn_mfma_f32_16x16x32_bf16(At[m][k],Bt_[n][k],acc[ai][bj][m][n],0,0,0); \
    __builtin_amdgcn_s_setprio(0);}while(0)
#define WAIT_V(n) asm volatile("s_waitcnt vmcnt(" #n ")":::"memory")
#define WAIT_L(n) asm volatile("s_waitcnt lgkmcnt(" #n ")":::"memory")
#define BAR __builtin_amdgcn_s_barrier()
#define SCHED __builtin_amdgcn_sched_barrier(0)

template <class Epi>
DI void gemm256(const bf16_t* __restrict__ A, const bf16_t* __restrict__ Bt, const int K, const int nM, const int nN, LAS bf16_t* shm, const Epi& epi) {
    const int nwg = nM * nN;
    for (int L = blockIdx.x; L < nwg; L += gridDim.x) {
        int wgid = L;
        { int q = nwg / NXCD, r = nwg % NXCD, xcd = wgid % NXCD, off = wgid / NXCD; wgid = (xcd < r ? xcd * (q + 1) : r * (q + 1) + (xcd - r) * q) + off; }
        int nig = WGM * nN, gid = wgid / nig, fm = gid * WGM, gsz = min(nM - fm, WGM);
        int pm = fm + ((wgid % nig) % gsz), pn = (wgid % nig) / gsz, brow = pm * BM, bcol = pn * BM;
        int wid = threadIdx.x >> 6, lane = threadIdx.x & 63, wr = wid >> 2, wc = wid & 3, fr = lane & 15, fq = lane >> 4;
        f32x4 acc[2][2][4][2] = {};
        bf16x8 At[4][2], B0[2][2], B1[2][2];
        int nt = K / BK;
        STAGE(SB(0,0),Bt,bcol,0); STAGE(SA(0,0),A,brow,0);
        STAGE(SB(0,1),Bt,bcol+HALF,0); STAGE(SA(0,1),A,brow+HALF,0);
        if (wr == 1) BAR;
        WAIT_V(4); BAR;
        STAGE(SB(1,0),Bt,bcol,1); STAGE(SA(1,0),A,brow,1); STAGE(SB(1,1),Bt,bcol+HALF,1);
        WAIT_V(6); BAR;
        for (int t = 0; t < nt - 2; t += 2) {
            LDB(B0,0,0); SCHED; LDA(At,0,0); STAGE(SA(1,1),A,brow+HALF,t+1);
            WAIT_L(8); BAR; WAIT_L(0); MMA(0,0,At,B0); BAR; SCHED;
            LDB(B1,0,1); STAGE(SB(0,0),Bt,bcol,t+2);
            BAR; WAIT_L(0); MMA(0,1,At,B1); BAR;
            LDA(At,0,1); STAGE(SA(0,0),A,brow,t+2);
            BAR; WAIT_L(0); MMA(1,0,At,B0); BAR; SCHED;
            STAGE(SB(0,1),Bt,bcol+HALF,t+2);
            WAIT_V(6); BAR; MMA(1,1,At,B1); BAR;
            LDB(B0,1,0); SCHED; LDA(At,1,0); STAGE(SA(0,1),A,brow+HALF,t+2);
            WAIT_L(8); BAR; WAIT_L(0); MMA(0,0,At,B0); BAR; SCHED;
            LDB(B1,1,1); STAGE(SB(1,0),Bt,bcol,t+3);
            BAR; WAIT_L(0); MMA(0,1,At,B1); BAR;
            LDA(At,1,1); STAGE(SA(1,0),A,brow,t+3);
            BAR; WAIT_L(0); MMA(1,0,At,B0); BAR; SCHED;
            STAGE(SB(1,1),Bt,bcol+HALF,t+3);
            WAIT_V(6); BAR; MMA(1,1,At,B1); BAR;
        }
        int tz = threadIdx.x; asm volatile("" : "+v"(tz)); wid = tz >> 6; lane = tz & 63; wr = wid >> 2; wc = wid & 3; fr = lane & 15; fq = lane >> 4;
        { LDB(B0,0,0); WAIT_V(0); LDA(At,0,0); STAGE_X(tz,SA(1,1),A,brow+HALF,nt-1);
          BAR; WAIT_L(0); MMA(0,0,At,B0); BAR;
          LDB(B1,0,1); BAR; WAIT_L(0); MMA(0,1,At,B1); BAR;
          LDA(At,0,1); WAIT_V(4); BAR; WAIT_L(0); MMA(1,0,At,B0); MMA(1,1,At,B1); BAR; }
        { LDB(B0,1,0); LDA(At,1,0); WAIT_V(2); BAR; WAIT_L(0); MMA(0,0,At,B0); BAR;
          LDB(B1,1,1); WAIT_V(0); BAR; WAIT_L(0); MMA(0,1,At,B1); BAR;
          LDA(At,1,1); BAR; WAIT_L(0); MMA(1,0,At,B0); MMA(1,1,At,B1); BAR; }
        if (wr == 0) BAR;
        epi(acc, brow, bcol, wr, wc, fr, fq);
        __syncthreads();
    }
}

struct EpiProj {
    bf16_t* P;
    DI void operator()(const f32x4 (&acc)[2][2][4][2], int brow, int bcol, int wr, int wc, int fr, int fq) const {
#pragma unroll
        for (int ai = 0; ai < 2; ++ai)
#pragma unroll
        for (int bj = 0; bj < 2; ++bj)
#pragma unroll
        for (int m = 0; m < 4; ++m)
#pragma unroll
        for (int n = 0; n < 2; ++n)
#pragma unroll
        for (int j = 0; j < 4; ++j) {
            const int row = brow + ai * HALF + wr * 64 + m * 16 + fq * 4 + j, col = bcol + bj * HALF + wc * 32 + n * 16 + fr;
            if (col < INW) P[(size_t)row * INW + col] = f2bf(acc[ai][bj][m][n][j]);
        }
    }
};
struct EpiOut {
    float* H; const float* X;
    DI void operator()(const f32x4 (&acc)[2][2][4][2], int brow, int bcol, int wr, int wc, int fr, int fq) const {
#pragma unroll
        for (int ai = 0; ai < 2; ++ai)
#pragma unroll
        for (int bj = 0; bj < 2; ++bj)
#pragma unroll
        for (int m = 0; m < 4; ++m)
#pragma unroll
        for (int n = 0; n < 2; ++n)
#pragma unroll
        for (int j = 0; j < 4; ++j) {
            const int row = brow + ai * HALF + wr * 64 + m * 16 + fq * 4 + j, col = bcol + bj * HALF + wc * 32 + n * 16 + fr;
            const size_t o = (size_t)row * DM + col; H[o] = X[o] + acc[ai][bj][m][n][j];
        }
    }
};
struct EpiPQ {
    float* Q;
    DI void operator()(const f32x4 (&acc)[2][2][4][2], int brow, int bcol, int wr, int wc, int fr, int fq) const {
#pragma unroll
        for (int ai = 0; ai < 2; ++ai)
#pragma unroll
        for (int bj = 0; bj < 2; ++bj)
#pragma unroll
        for (int m = 0; m < 4; ++m)
#pragma unroll
        for (int n = 0; n < 2; ++n)
#pragma unroll
        for (int j = 0; j < 4; ++j) {
            const int row = brow + ai * HALF + wr * 64 + m * 16 + fq * 4 + j, col = bcol + bj * HALF + wc * 32 + n * 16 + fr;
            Q[(size_t)row * 2048 + col] = acc[ai][bj][m][n][j];
        }
    }
};

DI void phase_prologue(const Params& p) {
    const int gtid = blockIdx.x * NTHREADS + threadIdx.x, gsz = gridDim.x * NTHREADS;
    bf16_t* wint = (bf16_t*)(p.ws + OFF_WINT);
    for (int idx = gtid; idx < 4096 * 1024; idx += gsz) {
        const int k = idx >> 12, n = idx & 4095;
        const float v = n < INW ? p.w_in[(size_t)k * INW + n] : 0.f;
        wint[(size_t)n * 1024 + k] = f2bf(v);
    }
    bf16_t* woutt = (bf16_t*)(p.ws + OFF_WOUTT);
    for (int idx = gtid; idx < 1024 * 1024; idx += gsz) {
        const int k = idx >> 10, n = idx & 1023;
        woutt[(size_t)n * 1024 + k] = f2bf(p.w_out[(size_t)k * 1024 + n]);
    }
    bf16_t* wqt = (bf16_t*)(p.ws + OFF_WQT);
    for (int idx = gtid; idx < 1024 * 2048; idx += gsz) {
        const int k = idx >> 11, n = idx & 2047;
        wqt[(size_t)n * 1024 + k] = f2bf(p.wq[(size_t)k * 2048 + n]);
    }
    bf16_t* skh = (bf16_t*)(p.ws + OFF_SKH); bf16_t* skl = (bf16_t*)(p.ws + OFF_SKL);
    for (int idx = gtid; idx < 2048 * 128; idx += gsz) {
        const float v = p.sk[idx]; const bf16_t hi = f2bf(v);
        skh[idx] = hi; skl[idx] = f2bf(v - bf2f(hi));
    }
    float* c128 = (float*)(p.ws + OFF_COS128); float* s128 = (float*)(p.ws + OFF_SIN128);
    for (int idx = gtid; idx < TT * 64; idx += gsz) {
        const int pos = idx >> 6, j = idx & 63;
        const float inv = powf(10000.f, -(float)j * 2.0f / 128.f);
        const float ang = (float)pos * inv;
        float s, c; sincosf(ang, &s, &c);
        c128[idx] = c; s128[idx] = s;
    }
    float* c64 = (float*)(p.ws + OFF_COS64); float* s64 = (float*)(p.ws + OFF_SIN64);
    for (int idx = gtid; idx < TT * 32; idx += gsz) {
        const int pos = idx >> 5, j = idx & 31;
        const float inv = powf(10000.f, -(float)j * 2.0f / 64.f);
        const float ang = (float)pos * inv;
        float s, c; sincosf(ang, &s, &c);
        c64[idx] = c; s64[idx] = s;
    }
    bf16_t* hn = (bf16_t*)(p.ws + OFF_HN);
    const int wave = threadIdx.x >> 6, lane = threadIdx.x & 63;
    for (int row = blockIdx.x * NWAVES + wave; row < MPAD; row += gridDim.x * NWAVES) {
        bf16_t* o = hn + (size_t)row * DM;
        if (row >= MROWS) {
            for (int i = 0; i < 4; ++i) *(uint2*)(o + i * 256 + lane * 4) = make_uint2(0u, 0u);
            continue;
        }
        const int b = row / TT, t = row % TT;
        const float* src = t < NMETA ? p.meta + (size_t)t * DM : p.x + ((size_t)b * SEQ + (t - NMETA)) * DM;
        float4 v[4]; float ss = 0.f;
#pragma unroll
        for (int i = 0; i < 4; ++i) { v[i] = *(const float4*)(src + i * 256 + lane * 4); ss += v[i].x * v[i].x + v[i].y * v[i].y + v[i].z * v[i].z + v[i].w * v[i].w; }
        ss = wave_sum(ss);
        const float rstd = rsqrtf(ss * (1.f / DM) + 1e-6f);
#pragma unroll
        for (int i = 0; i < 4; ++i) {
            const float4 g = *(const float4*)(p.norm_mix + i * 256 + lane * 4);
            uint2 w;
            w.x = (unsigned)f2bf(v[i].x * rstd * g.x) | ((unsigned)f2bf(v[i].y * rstd * g.y) << 16);
            w.y = (unsigned)f2bf(v[i].z * rstd * g.z) | ((unsigned)f2bf(v[i].w * rstd * g.w) << 16);
            *(uint2*)(o + i * 256 + lane * 4) = w;
        }
    }
}

DI void phase_rope(const Params& p) {
    bf16_t* proj = (bf16_t*)(p.ws + OFF_BIG);
    const float* c128 = (const float*)(p.ws + OFF_COS128); const float* s128 = (const float*)(p.ws + OFF_SIN128);
    const float* c64 = (const float*)(p.ws + OFF_COS64); const float* s64 = (const float*)(p.ws + OFF_SIN64);
    const int gtid = blockIdx.x * NTHREADS + threadIdx.x, gsz = gridDim.x * NTHREADS;
    const int total = MROWS * 1384;
    for (int idx = gtid; idx < total; idx += gsz) {
        const int row = idx / 1384, it = idx % 1384;
        const int t = row % TT;
        bf16_t* pr = proj + (size_t)row * INW;
        int c1, half, j; float scale; bool big;
        if (it < 256)       { c1 = C_RQ + (it >> 6) * 128 + (it & 63); half = 64; j = it & 63; scale = 1.f; big = true; }
        else if (it < 512)  { const int i2 = it - 256;  c1 = C_RK + (i2 >> 6) * 128 + (i2 & 63); half = 64; j = i2 & 63; scale = 0.08838834764831845f; big = true; }
        else if (it < 1024) { const int i2 = it - 512;  c1 = C_DQ + (i2 >> 6) * 128 + (i2 & 63); half = 64; j = i2 & 63; scale = 0.08838834764831845f; big = true; }
        else if (it < 1088) { const int i2 = it - 1024; c1 = C_DK + i2; half = 64; j = i2; scale = 1.f; big = true; }
        else if (it < 1344) { const int i2 = it - 1088; c1 = C_IQ + (i2 >> 5) * 64 + (i2 & 31); half = 32; j = i2 & 31; scale = 0.125f; big = false; }
        else if (it < 1376) { const int i2 = it - 1344; c1 = C_IK + i2; half = 32; j = i2; scale = 1.f; big = false; }
        else { const int c = C_IW + (it - 1376); pr[c] = f2bf(bf2f(pr[c]) * 0.35355339059327373f); continue; }
        const float cs = big ? c128[t * 64 + j] : c64[t * 32 + j];
        const float sn = big ? s128[t * 64 + j] : s64[t * 32 + j];
        const float x1 = bf2f(pr[c1]), x2 = bf2f(pr[c1 + half]);
        pr[c1] = f2bf((x1 * cs - x2 * sn) * scale);
        pr[c1 + half] = f2bf((x2 * cs + x1 * sn) * scale);
    }
}

DI void phase_ret_state(const Params& p, LAS char* smem) {
    const bf16_t* proj = (const bf16_t*)(p.ws + OFF_BIG);
    float* ST = (float*)(p.ws + OFF_ST);
    LAS bf16_t* sK = (LAS bf16_t*)smem; LAS bf16_t* sV = sK + 64 * 128;
    for (int unit = blockIdx.x; unit < 1024; unit += gridDim.x) {
        const int c = 1 + (unit & 31), bh = unit >> 5, h = bh & 3, b = bh >> 2;
        for (int i = threadIdx.x; i < 64 * 16; i += NTHREADS) {
            const int j = i >> 4, ch = i & 15; const int t = 64 * c + j - 112;
            u32x4 kv = {0u, 0u, 0u, 0u}, vv = {0u, 0u, 0u, 0u};
            if (t >= 0) { const bf16_t* pr = proj + (size_t)(b * TT + t) * INW; kv = *(const u32x4*)(pr + C_RK + h * 128 + ch * 8); vv = *(const u32x4*)(pr + C_RV + h * 128 + ch * 8); }
            *(LAS u32x4*)(sK + j * 128 + ch * 8) = kv; *(LAS u32x4*)(sV + j * 128 + ch * 8) = vv;
        }
        __syncthreads();
        const float lg = logf(1.f - exp2f(-5.f - (float)h));
        const int e = threadIdx.x >> 2, d0 = (threadIdx.x & 3) * 32;
        float acc[32];
#pragma unroll
        for (int dd = 0; dd < 32; ++dd) acc[dd] = 0.f;
        for (int j = 0; j < 64; ++j) {
            const float z = expf(lg * (float)(63 - j)) * bf2f(sV[j * 128 + e]);
#pragma unroll
            for (int d8 = 0; d8 < 4; ++d8) {
                const u32x4 raw = *(const LAS u32x4*)(sK + j * 128 + d0 + d8 * 8); float kv[8]; unpack8(raw, kv);
#pragma unroll
                for (int x = 0; x < 8; ++x) acc[d8 * 8 + x] += z * kv[x];
            }
        }
        float* st = ST + ((size_t)(bh * 34 + c) * 128 + e) * 128 + d0;
#pragma unroll
        for (int d4 = 0; d4 < 8; ++d4) *(float4*)(st + d4 * 4) = make_float4(acc[d4 * 4], acc[d4 * 4 + 1], acc[d4 * 4 + 2], acc[d4 * 4 + 3]);
        __syncthreads();
    }
}

constexpr int DSA_WAVE_LDS = 2176 * 4 + 1024 * 4 + 256 * 4 + 64;
DI void phase_dsa(const Params& p, LAS char* smem) {
    const bf16_t* proj = (const bf16_t*)(p.ws + OFF_BIG);
    bf16_t* mixed = (bf16_t*)(p.ws + OFF_HN);
    const int wave = threadIdx.x >> 6, lane = threadIdx.x & 63;
    LAS float* sSc = (LAS float*)(smem + wave * DSA_WAVE_LDS);
    LAS float* sQ = sSc + 2176;
    LAS int* sSel = (LAS int*)(sQ + 1024);
    LAS float* sIw = (LAS float*)(sSel + 256);
    const unsigned long long lt_mask = (1ull << lane) - 1ull;
    for (int q = blockIdx.x * NWAVES + wave; q < NF; q += gridDim.x * NWAVES) {
        const int b = q >> 11, s = q & 2047, t = NMETA + s;
        const int nk = 80 + 64 * (s >> 6);
        const bf16_t* prow = proj + (size_t)(b * TT + t) * INW;
        for (int i = lane; i < 512; i += 64) sQ[i] = bf2f(prow[C_IQ + i]);
        if (lane < 8) sIw[lane] = bf2f(prow[C_IW + lane]);
        lds_fence();
        const bf16_t* ikbase = proj + (size_t)(b * TT) * INW + C_IK;
        const int nj = (nk + 63) >> 6;
        for (int jj = 0; jj < nj; ++jj) {
            const int k = jj * 64 + lane;
            float sc = 0.f;
            if (k < nk) {
                const bf16_t* kr = ikbase + (size_t)k * INW;
                float a[8];
#pragma unroll
                for (int h = 0; h < 8; ++h) a[h] = 0.f;
#pragma unroll 1
                for (int d8 = 0; d8 < 8; ++d8) {
                    const u32x4 raw = *(const u32x4*)(kr + d8 * 8); float kv[8]; unpack8(raw, kv);
#pragma unroll
                    for (int h = 0; h < 8; ++h) {
                        const f32x4 q0 = *(const LAS f32x4*)(sQ + h * 64 + d8 * 8), q1 = *(const LAS f32x4*)(sQ + h * 64 + d8 * 8 + 4);
                        a[h] += kv[0] * q0[0] + kv[1] * q0[1] + kv[2] * q0[2] + kv[3] * q0[3] + kv[4] * q1[0] + kv[5] * q1[1] + kv[6] * q1[2] + kv[7] * q1[3];
                    }
                }
#pragma unroll
                for (int h = 0; h < 8; ++h) sc += fmaxf(a[h], 0.f) * sIw[h];
                sc += 0.0f;
            }
            sSc[k] = sc;
        }
        lds_fence();
        int L;
        if (nk <= 256) {
            for (int i = lane; i < nk; i += 64) sSel[i] = i;
            L = nk;
        } else {
            unsigned Tkey = 0u;
            for (int bit = 31; bit >= 0; --bit) {
                const unsigned cand = Tkey | (1u << bit);
                int cnt = 0;
                for (int jj = 0; jj < nj; ++jj) {
                    const int k = jj * 64 + lane;
                    const unsigned key = (k < nk) ? fkey(sSc[k]) : 0u;
                    cnt += __popcll(__ballot(key >= cand));
                }
                if (cnt >= 256) Tkey = cand;
            }
            int cgt = 0;
            for (int jj = 0; jj < nj; ++jj) {
                const int k = jj * 64 + lane;
                const unsigned key = (k < nk) ? fkey(sSc[k]) : 0u;
                cgt += __popcll(__ballot(key > Tkey));
            }
            const int need = 256 - cgt;
            int pos = 0, eqseen = 0;
            for (int jj = 0; jj < nj; ++jj) {
                const int k = jj * 64 + lane;
                const unsigned key = (k < nk) ? fkey(sSc[k]) : 0u;
                const bool gt = key > Tkey, eq = (key == Tkey);
                const unsigned long long eqm = __ballot(eq);
                const int myeq = eqseen + __popcll(eqm & lt_mask);
                const bool sel = gt || (eq && myeq < need);
                const unsigned long long sm = __ballot(sel);
                if (sel) sSel[pos + __popcll(sm & lt_mask)] = k;
                pos += __popcll(sm); eqseen += __popcll(eqm);
            }
            L = 256;
        }
        lds_fence();
        for (int i = lane; i < 1024; i += 64) sQ[i] = bf2f(prow[C_DQ + i]);
        lds_fence();
        float sc[8][4];
        const bf16_t* dkbase = proj + (size_t)(b * TT) * INW + C_DK;
#pragma unroll
        for (int il = 0; il < 4; ++il) {
            const int i = lane + 64 * il; const bool ok = i < L; const int key = ok ? sSel[i] : 0;
            const bf16_t* kr = dkbase + (size_t)key * INW;
            float a[8];
#pragma unroll
            for (int h = 0; h < 8; ++h) a[h] = 0.f;
#pragma unroll 1
            for (int d8 = 0; d8 < 16; ++d8) {
                const u32x4 raw = *(const u32x4*)(kr + d8 * 8); float kv[8]; unpack8(raw, kv);
#pragma unroll
                for (int h = 0; h < 8; ++h) {
                    const f32x4 q0 = *(const LAS f32x4*)(sQ + h * 128 + d8 * 8), q1 = *(const LAS f32x4*)(sQ + h * 128 + d8 * 8 + 4);
                    a[h] += kv[0] * q0[0] + kv[1] * q0[1] + kv[2] * q0[2] + kv[3] * q0[3] + kv[4] * q1[0] + kv[5] * q1[1] + kv[6] * q1[2] + kv[7] * q1[3];
                }
            }
#pragma unroll
            for (int h = 0; h < 8; ++h) sc[h][il] = ok ? a[h] : -INFINITY;
        }
#pragma unroll
        for (int h = 0; h < 8; ++h) {
            float m = fmaxf(fmaxf(sc[h][0], sc[h][1]), fmaxf(sc[h][2], sc[h][3]));
            m = wave_max(m);
            float e[4], sum = 0.f;
#pragma unroll
            for (int il = 0; il < 4; ++il) { e[il] = expf(sc[h][il] - m); sum += e[il]; }
            sum = wave_sum(sum);
            const float inv = 1.f / sum;
#pragma unroll
            for (int il = 0; il < 4; ++il) sSc[h * 256 + lane + 64 * il] = e[il] * inv;
        }
        lds_fence();
        float o[8][2];
#pragma unroll
        for (int h = 0; h < 8; ++h) { o[h][0] = 0.f; o[h][1] = 0.f; }
        const bf16_t* dvbase = proj + (size_t)(b * TT) * INW + C_DV;
        for (int i = 0; i < L; ++i) {
            const int key = sSel[i];
            const float v0 = bf2f(dvbase[(size_t)key * INW + lane]), v1 = bf2f(dvbase[(size_t)key * INW + 64 + lane]);
#pragma unroll
            for (int h = 0; h < 8; ++h) { const float pv = sSc[h * 256 + i]; o[h][0] += pv * v0; o[h][1] += pv * v1; }
        }
        lds_fence();
#pragma unroll
        for (int h = 0; h < 8; ++h) { sQ[h * 128 + lane] = o[h][0]; sQ[h * 128 + 64 + lane] = o[h][1]; }
        lds_fence();
        for (int h = 0; h < 8; ++h) {
            float acc = 0.f;
            const float* wu = p.w_uv + (size_t)h * 128 * 64 + lane;
            for (int c = 0; c < 128; ++c) acc += sQ[h * 128 + c] * wu[c * 64];
            mixed[(size_t)q * DM + 512 + h * 64 + lane] = f2bf(acc);
        }
        lds_fence();
    }
}

DI void phase_ret_scan(const Params& p) {
    float* ST = (float*)(p.ws + OFF_ST);
    const int gtid = blockIdx.x * NTHREADS + threadIdx.x, gsz = gridDim.x * NTHREADS;
    for (int idx = gtid; idx < 32 * 16384; idx += gsz) {
        const int bh = idx >> 14, el = idx & 16383, h = bh & 3;
        const float gc = expf(logf(1.f - exp2f(-5.f - (float)h)) * 64.f);
        float* base = ST + (size_t)bh * 34 * 16384 + el;
        float r = 0.f;
        for (int c = 1; c < 34; ++c) {
            const float u = c < 33 ? base[(size_t)c * 16384] : 0.f;
            base[(size_t)c * 16384] = r;
            r = gc * r + u;
        }
    }
}

DI void phase_ret_out(const Params& p, LAS char* smem) {
    const bf16_t* proj = (const bf16_t*)(p.ws + OFF_BIG);
    const float* ST = (const float*)(p.ws + OFF_ST);
    bf16_t* mixed = (bf16_t*)(p.ws + OFF_HN);
    LAS bf16_t* sQ = (LAS bf16_t*)smem; LAS bf16_t* sK = sQ + 64 * 128; LAS bf16_t* sV = sK + 64 * 128;
    LAS float* sS = (LAS float*)(sV + 64 * 128);
    LAS float* sR = sS + 64 * 65;
    for (int unit = blockIdx.x; unit < 1024; unit += gridDim.x) {
        const int c = 2 + (unit & 31), bh = unit >> 5, h = bh & 3, b = bh >> 2;
        for (int i = threadIdx.x; i < 64 * 16; i += NTHREADS) {
            const int j = i >> 4, ch = i & 15; const int t = 64 * c + j - 112;
            const bf16_t* pr = proj + (size_t)(b * TT + t) * INW;
            *(LAS u32x4*)(sQ + j * 128 + ch * 8) = *(const u32x4*)(pr + C_RQ + h * 128 + ch * 8);
            *(LAS u32x4*)(sK + j * 128 + ch * 8) = *(const u32x4*)(pr + C_RK + h * 128 + ch * 8);
            *(LAS u32x4*)(sV + j * 128 + ch * 8) = *(const u32x4*)(pr + C_RV + h * 128 + ch * 8);
        }
        const float* R = ST + (size_t)(bh * 34 + c) * 16384;
        for (int i = threadIdx.x; i < 16384; i += NTHREADS) sR[(i >> 7) * 129 + (i & 127)] = R[i];
        __syncthreads();
        const float lg = logf(1.f - exp2f(-5.f - (float)h));
        const int i = threadIdx.x >> 3, g8 = threadIdx.x & 7;
        {
            float sacc[8];
#pragma unroll
            for (int jj = 0; jj < 8; ++jj) sacc[jj] = 0.f;
            for (int d = 0; d < 128; ++d) {
                const float qv = bf2f(sQ[i * 128 + d]);
#pragma unroll
                for (int jj = 0; jj < 8; ++jj) sacc[jj] += qv * bf2f(sK[(jj * 8 + g8) * 128 + d]);
            }
#pragma unroll
            for (int jj = 0; jj < 8; ++jj) { const int j = jj * 8 + g8; const int df = i > j ? i - j : j - i; sS[i * 65 + j] = sacc[jj] * expf(lg * (float)df); }
        }
        __syncthreads();
        float o[16];
#pragma unroll
        for (int ee = 0; ee < 16; ++ee) o[ee] = 0.f;
        for (int j = 0; j < 64; ++j) {
            const float sv = sS[i * 65 + j];
#pragma unroll
            for (int ee = 0; ee < 16; ++ee) o[ee] += sv * bf2f(sV[j * 128 + ee * 8 + g8]);
        }
        const float xi = expf(lg * (float)(i + 1));
        for (int d = 0; d < 128; ++d) {
            const float qv = bf2f(sQ[i * 128 + d]) * xi;
#pragma unroll
            for (int ee = 0; ee < 16; ++ee) o[ee] += qv * sR[(ee * 8 + g8) * 129 + d];
        }
        float sum = 0.f;
#pragma unroll
        for (int ee = 0; ee < 16; ++ee) sum += o[ee];
        sum += __shfl_xor(sum, 1); sum += __shfl_xor(sum, 2); sum += __shfl_xor(sum, 4);
        const float mu = sum * (1.f / 128.f);
        float var = 0.f;
#pragma unroll
        for (int ee = 0; ee < 16; ++ee) { const float dlt = o[ee] - mu; var += dlt * dlt; }
        var += __shfl_xor(var, 1); var += __shfl_xor(var, 2); var += __shfl_xor(var, 4);
        const float rs = rsqrtf(var * (1.f / 128.f) + 1e-6f);
        const int t = 64 * c + i - 112, srow = t - NMETA;
        const bf16_t* pg = proj + (size_t)(b * TT + t) * INW + C_RG + h * 128;
        bf16_t* po = mixed + (size_t)(b * SEQ + srow) * DM + h * 128;
#pragma unroll
        for (int ee = 0; ee < 16; ++ee) {
            const int e = ee * 8 + g8;
            const float g = bf2f(pg[e]);
            const float gate = g / (1.f + expf(-g));
            po[e] = f2bf(gate * (o[ee] - mu) * rs);
        }
        __syncthreads();
    }
}

DI void phase_norm2(const Params& p) {
    bf16_t* hn2 = (bf16_t*)(p.ws + OFF_HN);
    const int wave = threadIdx.x >> 6, lane = threadIdx.x & 63;
    for (int row = blockIdx.x * NWAVES + wave; row < NF; row += gridDim.x * NWAVES) {
        const float* src = p.out + (size_t)row * DM; bf16_t* o = hn2 + (size_t)row * DM;
        float4 v[4]; float ss = 0.f;
#pragma unroll
        for (int i = 0; i < 4; ++i) { v[i] = *(const float4*)(src + i * 256 + lane * 4); ss += v[i].x * v[i].x + v[i].y * v[i].y + v[i].z * v[i].z + v[i].w * v[i].w; }
        ss = wave_sum(ss);
        const float rstd = rsqrtf(ss * (1.f / DM) + 1e-6f);
#pragma unroll
        for (int i = 0; i < 4; ++i) {
            const float4 g = *(const float4*)(p.norm_ffn + i * 256 + lane * 4);
            uint2 w;
            w.x = (unsigned)f2bf(v[i].x * rstd * g.x) | ((unsigned)f2bf(v[i].y * rstd * g.y) << 16);
            w.y = (unsigned)f2bf(v[i].z * rstd * g.z) | ((unsigned)f2bf(v[i].w * rstd * g.w) << 16);
            *(uint2*)(o + i * 256 + lane * 4) = w;
        }
    }
}

typedef float f32x16 __attribute__((ext_vector_type(16)));
DI bf16x8 pack_hi8(const float (&x)[8], float (&rem)[8]) {
    bf16x8 r;
#pragma unroll
    for (int j = 0; j < 8; ++j) { const bf16_t h = f2bf(x[j]); r[j] = (short)h; rem[j] = x[j] - bf2f(h); }
    return r;
}
DI bf16x8 pack8(const float (&x)[8]) {
    bf16x8 r;
#pragma unroll
    for (int j = 0; j < 8; ++j) r[j] = (short)f2bf(x[j]);
    return r;
}
constexpr int PSEL_WAVE_LDS = 32 * 2 * 16 * 8 + 32 * 16 * 8;
DI void phase_peer_select(const Params& p, LAS char* smem) {
    const float* PQ = (const float*)(p.ws + OFF_BIG);
    const bf16_t* SKH = (const bf16_t*)(p.ws + OFF_SKH); const bf16_t* SKL = (const bf16_t*)(p.ws + OFF_SKL);
    int* EIDX = (int*)(p.ws + OFF_EIDX); float* GATE = (float*)(p.ws + OFF_GATE);
    const int wave = threadIdx.x >> 6, lane = threadIdx.x & 63, r = lane & 31, hh = lane >> 5;
    LAS float* lv = (LAS float*)(smem + wave * PSEL_WAVE_LDS);
    LAS int* li = (LAS int*)(lv + 32 * 2 * 16);
    LAS float* cs = (LAS float*)(li + 32 * 2 * 16);
    LAS int* cab = (LAS int*)(cs + 32 * 16);
    for (int task = blockIdx.x * NWAVES + wave; task < (NF / 32) * 8; task += gridDim.x * NWAVES) {
        const int tile = task >> 3, h = task & 7;
        const int n = tile * 32 + r;
        for (int half = 0; half < 2; ++half) {
            f32x16 acc[4];
#pragma unroll
            for (int mb = 0; mb < 4; ++mb)
#pragma unroll
                for (int i = 0; i < 16; ++i) acc[mb][i] = 0.f;
            const float* qrow = PQ + (size_t)n * 2048 + h * 256 + half * 128 + 8 * hh;
            const bf16_t* kh = SKH + (size_t)((h * 2 + half) * 128 + r) * 128 + 8 * hh;
            const bf16_t* kl = SKL + (size_t)((h * 2 + half) * 128 + r) * 128 + 8 * hh;
#pragma unroll 2
            for (int ks = 0; ks < 8; ++ks) {
                const float4 q0 = *(const float4*)(qrow + ks * 16), q1 = *(const float4*)(qrow + ks * 16 + 4);
                float qf[8] = {q0.x, q0.y, q0.z, q0.w, q1.x, q1.y, q1.z, q1.w}, qr[8];
                const bf16x8 bh = pack_hi8(qf, qr); const bf16x8 bl = pack8(qr);
#pragma unroll
                for (int mb = 0; mb < 4; ++mb) {
                    const bf16x8 ah = *(const bf16x8*)(kh + (size_t)mb * 32 * 128 + ks * 16);
                    const bf16x8 al = *(const bf16x8*)(kl + (size_t)mb * 32 * 128 + ks * 16);
                    acc[mb] = __builtin_amdgcn_mfma_f32_32x32x16_bf16(ah, bh, acc[mb], 0, 0, 0);
                    acc[mb] = __builtin_amdgcn_mfma_f32_32x32x16_bf16(ah, bl, acc[mb], 0, 0, 0);
                    acc[mb] = __builtin_amdgcn_mfma_f32_32x32x16_bf16(al, bh, acc[mb], 0, 0, 0);
                }
            }
            float mprev = INFINITY;
#pragma unroll 1
            for (int it = 0; it < 16; ++it) {
                float m = -INFINITY;
#pragma unroll
                for (int mb = 0; mb < 4; ++mb)
#pragma unroll
                    for (int i = 0; i < 16; ++i) { const float v = acc[mb][i]; m = fmaxf(m, v < mprev ? v : -INFINITY); }
                m = fmaxf(m, __shfl_xor(m, 32));
                mprev = m;
            }
            const float T = mprev;
            int cnt = 0;
#pragma unroll
            for (int mb = 0; mb < 4; ++mb)
#pragma unroll
                for (int i = 0; i < 16; ++i) cnt += (acc[mb][i] >= T) ? 1 : 0;
            const int pc = __shfl_xor(cnt, 32);
            int pos = hh ? pc : 0;
            LAS float* lvp = lv + (r * 2 + half) * 16; LAS int* lip = li + (r * 2 + half) * 16;
#pragma unroll
            for (int mb = 0; mb < 4; ++mb)
#pragma unroll
                for (int i = 0; i < 16; ++i) {
                    const float v = acc[mb][i];
                    if (v >= T) { if (pos < 16) { lvp[pos] = v; lip[pos] = mb * 32 + (i & 3) + 8 * (i >> 2) + 4 * hh; } ++pos; }
                }
        }
        lds_fence();
        float cand[8][16];
        {
            float v1[8], v2[16];
#pragma unroll
            for (int a = 0; a < 8; ++a) v1[a] = lv[(r * 2 + 0) * 16 + 8 * hh + a];
#pragma unroll
            for (int b = 0; b < 16; ++b) v2[b] = lv[(r * 2 + 1) * 16 + b];
#pragma unroll
            for (int a = 0; a < 8; ++a)
#pragma unroll
                for (int b = 0; b < 16; ++b) cand[a][b] = v1[a] + v2[b];
        }
        float mprev = INFINITY;
#pragma unroll 1
        for (int it = 0; it < 16; ++it) {
            float m = -INFINITY;
#pragma unroll
            for (int a = 0; a < 8; ++a)
#pragma unroll
                for (int b = 0; b < 16; ++b) { const float v = cand[a][b]; m = fmaxf(m, v < mprev ? v : -INFINITY); }
            m = fmaxf(m, __shfl_xor(m, 32));
            mprev = m;
        }
        const float Tc = mprev;
        int cnt = 0;
#pragma unroll
        for (int a = 0; a < 8; ++a)
#pragma unroll
            for (int b = 0; b < 16; ++b) cnt += (cand[a][b] >= Tc) ? 1 : 0;
        const int pc = __shfl_xor(cnt, 32);
        int pos = hh ? pc : 0;
#pragma unroll
        for (int a = 0; a < 8; ++a)
#pragma unroll
            for (int b = 0; b < 16; ++b) {
                const float v = cand[a][b];
                if (v >= Tc) { if (pos < 16) { cs[r * 16 + pos] = v; cab[r * 16 + pos] = (8 * hh + a) * 16 + b; } ++pos; }
            }
        lds_fence();
        float scv[16]; float mx = -INFINITY;
#pragma unroll
        for (int i = 0; i < 16; ++i) { scv[i] = cs[r * 16 + i]; mx = fmaxf(mx, scv[i]); }
        float sum = 0.f;
#pragma unroll
        for (int i = 0; i < 16; ++i) { scv[i] = expf(scv[i] - mx); sum += scv[i]; }
        const float inv = 1.f / sum;
#pragma unroll
        for (int i = 0; i < 16; ++i) {
            if ((i >> 3) == hh) {
                const int ab = cab[r * 16 + i];
                const int e = li[(r * 2 + 0) * 16 + (ab >> 4)] * 128 + li[(r * 2 + 1) * 16 + (ab & 15)];
                EIDX[(size_t)n * 128 + h * 16 + i] = e;
                GATE[(size_t)n * 128 + h * 16 + i] = scv[i] * inv;
            }
        }
        lds_fence();
    }
}

DI void phase_convert_tables(const Params& p) {
    const int gtid = blockIdx.x * NTHREADS + threadIdx.x, gsz = gridDim.x * NTHREADS;
    u32x4* U16 = (u32x4*)(p.ws + OFF_U16); u32x4* V16 = (u32x4*)(p.ws + OFF_V16);
    const int items = 16384 * 1024 / 8;
    for (int idx = gtid; idx < 2 * items; idx += gsz) {
        const bool isv = idx >= items; const int i = isv ? idx - items : idx;
        const float4* src = (const float4*)(isv ? p.pv : p.pu) + (size_t)i * 2;
        const float4 a = src[0], b = src[1];
        u32x4 o;
        o[0] = (unsigned)f2bf(a.x) | ((unsigned)f2bf(a.y) << 16); o[1] = (unsigned)f2bf(a.z) | ((unsigned)f2bf(a.w) << 16);
        o[2] = (unsigned)f2bf(b.x) | ((unsigned)f2bf(b.y) << 16); o[3] = (unsigned)f2bf(b.z) | ((unsigned)f2bf(b.w) << 16);
        (isv ? V16 : U16)[i] = o;
    }
}

DI void phase_peer_out(const Params& p) {
    const int* EIDX = (const int*)(p.ws + OFF_EIDX); const float* GATE = (const float*)(p.ws + OFF_GATE);
    const bf16_t* U16 = (const bf16_t*)(p.ws + OFF_U16); const bf16_t* V16 = (const bf16_t*)(p.ws + OFF_V16);
    const int wave = threadIdx.x >> 6, lane = threadIdx.x & 63;
    for (int n = blockIdx.x * NWAVES + wave; n < NF; n += gridDim.x * NWAVES) {
        float* row = p.out + (size_t)n * DM;
        float hv[16], hn[16]; float ss = 0.f;
#pragma unroll
        for (int i = 0; i < 2; ++i) {
            const float4 a = *(const float4*)(row + i * 512 + lane * 8), b = *(const float4*)(row + i * 512 + lane * 8 + 4);
            hv[i * 8 + 0] = a.x; hv[i * 8 + 1] = a.y; hv[i * 8 + 2] = a.z; hv[i * 8 + 3] = a.w;
            hv[i * 8 + 4] = b.x; hv[i * 8 + 5] = b.y; hv[i * 8 + 6] = b.z; hv[i * 8 + 7] = b.w;
        }
#pragma unroll
        for (int i = 0; i < 16; ++i) ss += hv[i] * hv[i];
        ss = wave_sum(ss);
        const float rstd = rsqrtf(ss * (1.f / DM) + 1e-6f);
#pragma unroll
        for (int i = 0; i < 2; ++i) {
            const float4 a = *(const float4*)(p.norm_ffn + i * 512 + lane * 8), b = *(const float4*)(p.norm_ffn + i * 512 + lane * 8 + 4);
            hn[i * 8 + 0] = hv[i * 8 + 0] * rstd * a.x; hn[i * 8 + 1] = hv[i * 8 + 1] * rstd * a.y; hn[i * 8 + 2] = hv[i * 8 + 2] * rstd * a.z; hn[i * 8 + 3] = hv[i * 8 + 3] * rstd * a.w;
            hn[i * 8 + 4] = hv[i * 8 + 4] * rstd * b.x; hn[i * 8 + 5] = hv[i * 8 + 5] * rstd * b.y; hn[i * 8 + 6] = hv[i * 8 + 6] * rstd * b.z; hn[i * 8 + 7] = hv[i * 8 + 7] * rstd * b.w;
        }
        float acc[16];
#pragma unroll
        for (int i = 0; i < 16; ++i) acc[i] = 0.f;
        const int e_lo = EIDX[(size_t)n * 128 + lane], e_hi = EIDX[(size_t)n * 128 + 64 + lane];
        const float g_lo = GATE[(size_t)n * 128 + lane], g_hi = GATE[(size_t)n * 128 + 64 + lane];
#pragma unroll 1
        for (int s0 = 0; s0 < 128; s0 += 4) {
            u32x4 ub[4][2], vb[4][2]; float gt[4];
#pragma unroll
            for (int k = 0; k < 4; ++k) {
                const int slot = s0 + k;
                const int e = slot < 64 ? __builtin_amdgcn_readlane(e_lo, slot & 63) : __builtin_amdgcn_readlane(e_hi, slot & 63);
                gt[k] = __int_as_float(slot < 64 ? __builtin_amdgcn_readlane(__float_as_int(g_lo), slot & 63) : __builtin_amdgcn_readlane(__float_as_int(g_hi), slot & 63));
                const u32x4* ur = (const u32x4*)(U16 + (size_t)e * DM); const u32x4* vr = (const u32x4*)(V16 + (size_t)e * DM);
                ub[k][0] = ur[lane]; ub[k][1] = ur[64 + lane]; vb[k][0] = vr[lane]; vb[k][1] = vr[64 + lane];
            }
            float d[4];
#pragma unroll
            for (int k = 0; k < 4; ++k) {
                float u0[8], u1[8]; unpack8(ub[k][0], u0); unpack8(ub[k][1], u1);
                float t = 0.f;
#pragma unroll
                for (int i = 0; i < 8; ++i) t += u0[i] * hn[i] + u1[i] * hn[8 + i];
                d[k] = t;
            }
#pragma unroll
            for (int o = 32; o > 0; o >>= 1) {
#pragma unroll
                for (int k = 0; k < 4; ++k) d[k] += __shfl_xor(d[k], o);
            }
#pragma unroll
            for (int k = 0; k < 4; ++k) {
                const float coef = 0.5f * d[k] * (1.f + erff(d[k] * 0.70710678118654752f)) * gt[k];
                float v0[8], v1[8]; unpack8(vb[k][0], v0); unpack8(vb[k][1], v1);
#pragma unroll
                for (int i = 0; i < 8; ++i) { acc[i] += coef * v0[i]; acc[8 + i] += coef * v1[i]; }
            }
        }
        float s2 = 0.f;
#pragma unroll
        for (int i = 0; i < 16; ++i) { acc[i] += hv[i]; s2 += acc[i] * acc[i]; }
        s2 = wave_sum(s2);
        const float r2 = rsqrtf(s2 * (1.f / DM) + 1e-6f);
#pragma unroll
        for (int i = 0; i < 2; ++i) {
            const float4 a = *(const float4*)(p.norm_final + i * 512 + lane * 8), b = *(const float4*)(p.norm_final + i * 512 + lane * 8 + 4);
            *(float4*)(row + i * 512 + lane * 8) = make_float4(acc[i * 8 + 0] * r2 * a.x, acc[i * 8 + 1] * r2 * a.y, acc[i * 8 + 2] * r2 * a.z, acc[i * 8 + 3] * r2 * a.w);
            *(float4*)(row + i * 512 + lane * 8 + 4) = make_float4(acc[i * 8 + 4] * r2 * b.x, acc[i * 8 + 5] * r2 * b.y, acc[i * 8 + 6] * r2 * b.z, acc[i * 8 + 7] * r2 * b.w);
        }
    }
}

constexpr int NPHASES = 10;
__global__ void __launch_bounds__(NTHREADS, 2) mk_forward(Params p) {
    extern __shared__ __attribute__((aligned(16))) char dyn_smem[];
    LAS char* smem = (LAS char*)dyn_smem;
    const bool multi = (p.hi - p.lo) > 1;
    XcdBarrier bar; bar.bar = (unsigned*)(p.ws + OFF_BAR); bar.x = 0; bar.st = (volatile LAS unsigned*)(smem + LDS_BAR_OFF);
    if (multi) {
        if (threadIdx.x == 0) { const u32x4 z = {0u, 0u, 0u, 0u}; *(LAS u32x4*)(smem + LDS_BAR_OFF) = z; }
        __syncthreads();
        bar = xcd_barrier_post((unsigned*)(p.ws + OFF_BAR), (volatile LAS unsigned*)(smem + LDS_BAR_OFF));
    }
#ifndef PHMASK
#define PHMASK 0xFFFF
#endif
#define PH_ON(i) (((PHMASK >> (i)) & 1) && p.lo <= (i) && (i) < p.hi)
#define PH_SYNC(i) do { if (multi && (i) + 1 < p.hi) xcd_barrier(bar); } while (0)
#ifndef REPEAT_MASK
#define REPEAT_MASK 0
#endif
#define PH_REP(i) for (int rep_ = 0; rep_ < 1 + ((REPEAT_MASK >> (i)) & 1); ++rep_)
    if (PH_ON(0)) { PH_REP(0) phase_prologue(p); PH_SYNC(0); }
    if (PH_ON(1)) { PH_REP(1) { EpiProj e; e.P = (bf16_t*)(p.ws + OFF_BIG); gemm256((const bf16_t*)(p.ws + OFF_HN), (const bf16_t*)(p.ws + OFF_WINT), 1024, MPAD / 256, 4096 / 256, (LAS bf16_t*)smem, e); } PH_SYNC(1); }
    if (PH_ON(2)) { phase_rope(p); PH_SYNC(2); }
    if (PH_ON(3)) { PH_REP(3) { phase_ret_state(p, smem); phase_dsa(p, smem); } PH_SYNC(3); }
    if (PH_ON(4)) { phase_ret_scan(p); PH_SYNC(4); }
    if (PH_ON(5)) { PH_REP(5) phase_ret_out(p, smem); PH_SYNC(5); }
    if (PH_ON(6)) { PH_REP(6) { EpiOut e; e.H = p.out; e.X = p.x; gemm256((const bf16_t*)(p.ws + OFF_HN), (const bf16_t*)(p.ws + OFF_WOUTT), 1024, NF / 256, 1024 / 256, (LAS bf16_t*)smem, e); } PH_SYNC(6); }
    if (PH_ON(7)) { PH_REP(7) phase_norm2(p); PH_SYNC(7); }
    if (PH_ON(8)) { PH_REP(8) { EpiPQ e; e.Q = (float*)(p.ws + OFF_BIG); gemm256((const bf16_t*)(p.ws + OFF_HN), (const bf16_t*)(p.ws + OFF_WQT), 1024, NF / 256, 2048 / 256, (LAS bf16_t*)smem, e); } PH_SYNC(8); }
    if (PH_ON(9)) { PH_REP(9) { phase_peer_select(p, smem); phase_convert_tables(p); } PH_SYNC(9); }
    if (PH_ON(10)) { phase_peer_out(p); }
}

extern "C" void kernel_launch(void* const* d_in, const int* in_sizes, int n_in, void* d_out, int out_size, void* d_ws, size_t ws_size, hipStream_t stream) {
    static int grid = 0;
    if (grid == 0) {
        if (n_in != 12 || out_size != NF * DM || ws_size < WS_END) { fprintf(stderr, "kernel_launch: unexpected shapes (n_in %d out %d ws %zu need %zu)\n", n_in, out_size, ws_size, (size_t)WS_END); grid = -1; return; }
        int dev = 0, cus = 0, per_cu = 0;
        if (hipGetDevice(&dev) != hipSuccess || hipDeviceGetAttribute(&cus, hipDeviceAttributeMultiprocessorCount, dev) != hipSuccess) { grid = -1; return; }
        if (hipFuncSetAttribute((const void*)mk_forward, hipFuncAttributeMaxDynamicSharedMemorySize, LDS_BYTES) != hipSuccess) { fprintf(stderr, "kernel_launch: hipFuncSetAttribute failed\n"); grid = -1; return; }
        if (hipOccupancyMaxActiveBlocksPerMultiprocessor(&per_cu, (const void*)mk_forward, NTHREADS, LDS_BYTES) != hipSuccess || per_cu < 1)
            fprintf(stderr, "kernel_launch: occupancy query reports %d blocks per CU\n", per_cu);
        (void)hipGetLastError();
        grid = cus > 0 ? cus : 256;
    }
    if (grid < 0) return;
    Params p{};
    p.x = (const float*)d_in[0]; p.meta = (const float*)d_in[1]; p.norm_mix = (const float*)d_in[2]; p.w_in = (const float*)d_in[3];
    p.w_uv = (const float*)d_in[4]; p.w_out = (const float*)d_in[5]; p.norm_ffn = (const float*)d_in[6]; p.wq = (const float*)d_in[7];
    p.sk = (const float*)d_in[8]; p.pu = (const float*)d_in[9]; p.pv = (const float*)d_in[10]; p.norm_final = (const float*)d_in[11];
    p.out = (float*)d_out; p.ws = (char*)d_ws; p.pad0 = 0; p.pad1 = 0;
    (void)hipMemsetAsync((char*)d_ws + OFF_BAR, 0, 16384, stream);
#if MK_LAUNCHES == 1
    p.lo = 0; p.hi = NPHASES + 1;
    hipLaunchKernelGGL(mk_forward, dim3(grid), dim3(NTHREADS), LDS_BYTES, stream, p);
#else
    for (int ph = 0; ph <= NPHASES; ++ph) { p.lo = ph; p.hi = ph + 1; hipLaunchKernelGGL(mk_forward, dim3(grid), dim3(NTHREADS), LDS_BYTES, stream, p); }
#endif
}
```

```cpp
#include <hip/hip_runtime.h>
#include <stdint.h>
#include <stdio.h>

#ifndef MK_LAUNCHES
#define MK_LAUNCHES 1
#endif

#define DI __device__ __forceinline__
typedef unsigned short bf16_t;
typedef short bf16x8 __attribute__((ext_vector_type(8)));
typedef float f32x4 __attribute__((ext_vector_type(4)));
typedef unsigned u32x4 __attribute__((ext_vector_type(4)));

constexpr int NB = 8, SEQ = 2048, NMETA = 16, TT = 2064, DM = 1024, INW = 3912;
constexpr int MROWS = NB * TT;
constexpr int MPAD = 16640;
constexpr int NF = NB * SEQ;
constexpr int C_RQ = 0, C_RK = 512, C_RV = 1024, C_RG = 1536, C_DQ = 2048, C_DK = 3072, C_DV = 3200, C_IQ = 3328, C_IK = 3840, C_IW = 3904;
constexpr int NTHREADS = 512, NWAVES = 8;
constexpr int LDS_BYTES = 163840;
constexpr int LDS_BAR_OFF = 163840 - 256;

constexpr size_t al256(size_t x) { return (x + 255) & ~(size_t)255; }
constexpr size_t OFF_BAR = 0;
constexpr size_t OFF_COS128 = 16384;
constexpr size_t OFF_SIN128 = OFF_COS128 + al256((size_t)TT * 64 * 4);
constexpr size_t OFF_COS64 = OFF_SIN128 + al256((size_t)TT * 64 * 4);
constexpr size_t OFF_SIN64 = OFF_COS64 + al256((size_t)TT * 32 * 4);
constexpr size_t OFF_WINT = OFF_SIN64 + al256((size_t)TT * 32 * 4);
constexpr size_t OFF_WOUTT = OFF_WINT + (size_t)4096 * 1024 * 2;
constexpr size_t OFF_WQT = OFF_WOUTT + (size_t)1024 * 1024 * 2;
constexpr size_t OFF_SKH = OFF_WQT + (size_t)2048 * 1024 * 2;
constexpr size_t OFF_SKL = OFF_SKH + (size_t)2048 * 128 * 2;
constexpr int TTP = 2112;
constexpr size_t OFF_WUVT = OFF_SKL + (size_t)2048 * 128 * 2;
constexpr size_t OFF_DVT = OFF_WUVT + (size_t)8 * 64 * 128 * 2;
constexpr size_t OFF_HN = OFF_DVT + (size_t)NB * 128 * TTP * 2;
constexpr size_t OFF_BIG = OFF_HN + (size_t)MPAD * 1024 * 2;
constexpr size_t BIG_BYTES = (size_t)NF * 2048 * 4;
constexpr size_t OFF_ST = OFF_BIG + al256(BIG_BYTES);
constexpr size_t ST_BYTES = (size_t)32 * 34 * 16384 * 4;
constexpr size_t WS_END = OFF_ST + ST_BYTES;
constexpr size_t OFF_EIDX = OFF_ST, OFF_GATE = OFF_ST + (size_t)NF * 128 * 4;
constexpr size_t OFF_U16 = OFF_ST + (size_t)NF * 128 * 8;
constexpr size_t OFF_V16 = OFF_HN;
static_assert(OFF_U16 + (size_t)16384 * 1024 * 2 <= WS_END, "u16");
static_assert(BIG_BYTES >= (size_t)MPAD * INW * 2, "big region");
static_assert(WS_END <= (size_t)268435456, "workspace");

struct Params {
    const float *x, *meta, *norm_mix, *w_in, *w_uv, *w_out, *norm_ffn, *wq, *sk, *pu, *pv, *norm_final;
    float* out; char* ws; int lo, hi, pad0, pad1;
};

DI float bf2f(bf16_t v) { return __uint_as_float(((unsigned)v) << 16); }
DI bf16_t f2bf(float f) { unsigned u = __float_as_uint(f); u += 0x7fffu + ((u >> 16) & 1u); return (bf16_t)(u >> 16); }
DI float wave_sum(float v) {
#pragma unroll
    for (int o = 32; o > 0; o >>= 1) v += __shfl_xor(v, o);
    return v;
}
DI float wave_max(float v) {
#pragma unroll
    for (int o = 32; o > 0; o >>= 1) v = fmaxf(v, __shfl_xor(v, o));
    return v;
}
DI unsigned long long wave_max_u64(unsigned long long v) {
#pragma unroll
    for (int o = 32; o > 0; o >>= 1) {
        const unsigned hi = __shfl_xor((unsigned)(v >> 32), o), lo = __shfl_xor((unsigned)v, o);
        const unsigned long long w = ((unsigned long long)hi << 32) | lo;
        v = w > v ? w : v;
    }
    return v;
}
DI unsigned fkey(float x) { const unsigned u = __float_as_uint(x); return (u & 0x80000000u) ? ~u : (u | 0x80000000u); }
DI float funkey(unsigned k) { const unsigned u = (k & 0x80000000u) ? (k & 0x7fffffffu) : ~k; return __uint_as_float(u); }
DI void lds_fence() { asm volatile("s_waitcnt lgkmcnt(0)" ::: "memory"); }
DI void unpack8(const u32x4& r, float (&v)[8]) {
    v[0] = __uint_as_float(r.x << 16); v[1] = __uint_as_float(r.x & 0xffff0000u);
    v[2] = __uint_as_float(r.y << 16); v[3] = __uint_as_float(r.y & 0xffff0000u);
    v[4] = __uint_as_float(r.z << 16); v[5] = __uint_as_float(r.z & 0xffff0000u);
    v[6] = __uint_as_float(r.w << 16); v[7] = __uint_as_float(r.w & 0xffff0000u);
}

#define XB_TMO      128
#define XB_XCNT(j)  (256  + 64 * (j))
#define XB_XSUB(j)  (1280 + 64 * (j))
#define XB_XGEN(j)  (2304 + 64 * (j))
#define XB_TOP      3328
#define XB_TOPGEN   3392
#define XCD_BAR_WORDS 3456
#define XB_SPIN_CAP (1u << 20)
#define LAS __attribute__((address_space(3)))

DI unsigned xb_ld(unsigned* p)              { return __hip_atomic_load(p, __ATOMIC_RELAXED, __HIP_MEMORY_SCOPE_AGENT); }
DI unsigned xb_add(unsigned* p, unsigned v) { return __hip_atomic_fetch_add(p, v, __ATOMIC_RELAXED, __HIP_MEMORY_SCOPE_AGENT); }
DI unsigned xb_xcc_id() { return (unsigned)__builtin_amdgcn_s_getreg((3 << 11) | 20) & 0xFu; }
#define XB_SPIN(cond, bar) do { unsigned _sp = 0; while (cond) { __builtin_amdgcn_s_sleep(1); \
    if ((++_sp & 255u) == 0u) { if (xb_ld(&(bar)[XB_TMO])) break; if (_sp > XB_SPIN_CAP) { atomicAdd(&(bar)[XB_TMO], 1u); break; } } } } while (0)

struct XcdBarrier { unsigned* bar; unsigned x; volatile LAS unsigned* st; };

DI XcdBarrier xcd_barrier_post(unsigned* bar, volatile LAS unsigned* st) {
    XcdBarrier b; b.bar = bar; b.x = xb_xcc_id(); b.st = st;
    if (threadIdx.x == 0) (void)xb_add(&bar[XB_XCNT(b.x)], 1u);
    return b;
}
DI void xcd_barrier_complete(unsigned* bar, unsigned x, unsigned& nloc, unsigned& nx) {
    const unsigned G = gridDim.x * gridDim.y * gridDim.z;
    unsigned sum, cnt, mine, sp = 0u;
    for (;;) {
        sum = 0u; cnt = 0u; mine = 0u;
#pragma unroll
        for (unsigned j = 0; j < 16; ++j) { const unsigned c = xb_ld(&bar[XB_XCNT(j)]); sum += c; cnt += (c > 0u) ? 1u : 0u; mine = (j == x) ? c : mine; }
        if (sum == G) break;
        __builtin_amdgcn_s_sleep(1);
        if ((++sp & 255u) == 0u) { if (xb_ld(&bar[XB_TMO])) break; if (sp > XB_SPIN_CAP) { atomicAdd(&bar[XB_TMO], 1u); break; } }
    }
    nloc = mine > 0u ? mine : 1u; nx = cnt > 0u ? cnt : 1u;
}
DI void xcd_barrier(const XcdBarrier& b) {
    asm volatile("s_waitcnt vmcnt(0)" ::: "memory");
    __syncthreads();
    if (threadIdx.x == 0) {
        unsigned* bar = b.bar;
        __builtin_amdgcn_s_waitcnt(0);
        unsigned nloc = b.st[0], nx = b.st[1];
        if (nloc == 0u) { xcd_barrier_complete(bar, b.x, nloc, nx); b.st[0] = nloc; b.st[1] = nx; }
        const unsigned old = xb_add(&bar[XB_XSUB(b.x)], 1u);
        const unsigned gen = old / nloc;
        if (old + 1u == (gen + 1u) * nloc) {
            __builtin_amdgcn_fence(__ATOMIC_RELEASE, "agent");
            asm volatile("s_waitcnt vmcnt(0)" ::: "memory");
            const unsigned og = xb_add(&bar[XB_TOP], 1u);
            const unsigned tg = og / nx;
            if (og + 1u == (tg + 1u) * nx) xb_add(&bar[XB_TOPGEN], 1u);
            else XB_SPIN(xb_ld(&bar[XB_TOPGEN]) == tg, bar);
            __builtin_amdgcn_fence(__ATOMIC_ACQUIRE, "agent");
            xb_add(&bar[XB_XGEN(b.x)], 1u);
            asm volatile("s_waitcnt vmcnt(0)" ::: "memory");
        } else {
            XB_SPIN(xb_ld(&bar[XB_XGEN(b.x)]) == gen, bar);
            __builtin_amdgcn_fence(__ATOMIC_ACQUIRE, "agent");
            asm volatile("s_waitcnt vmcnt(0)" ::: "memory");
        }
    }
    __syncthreads();
}

constexpr int BM = 256, BK = 64, HALF = 128, NXCD = 8, WGM = 8, HT = HALF * BK;
DI int lds_byte(int r, int c) {
    int st = (r >> 4) * 2 + (c >> 5), rr = r & 15, cc = c & 31, ob = rr * 64 + cc * 2;
    return st * 1024 + (ob ^ (((ob >> 9) & 1) << 5));
}
DI void stage_rc(int b, int& R, int& C) {
    int st = b / 1024, sb = b % 1024, swz = sb ^ (((sb >> 9) & 1) << 5);
    R = (st >> 1) * 16 + swz / 64; C = (st & 1) * 32 + (swz % 64) / 2;
}

#define SA(b,h) (shm+((b)*2+(h))*HT)
#define SB(b,h) (shm+(4+(b)*2+(h))*HT)
#define STAGE_X(T,P,BASE,br,kt) do{long _g=(long)(br)*K+(long)(kt)*BK; \
    for(int _i=0;_i<2;++_i){int _b=(T)*16+_i*8192;int _r,_c;stage_rc(_b,_r,_c); \
      __builtin_amdgcn_global_load_lds((const unsigned*)(BASE+_g+(long)_r*K+_c), \
        (LAS unsigned*)((LAS char*)(P)+_b),16,0,0);}}while(0)
#define STAGE(P,BASE,br,kt) STAGE_X(threadIdx.x,P,BASE,br,kt)
#define LDA(dst,b,h) for(int m=0;m<4;++m)for(int k=0;k<2;++k) \
    dst[m][k]=*reinterpret_cast<const LAS bf16x8*>((LAS char*)SA(b,h)+lds_byte(wr*64+m*16+fr,k*32+fq*8))
#define LDB(dst,b,h) for(int n=0;n<2;++n)for(int k=0;k<2;++k) \
    dst[n][k]=*reinterpret_cast<const LAS bf16x8*>((LAS char*)SB(b,h)+lds_byte(wc*32+n*16+fr,k*32+fq*8))
#define MMA(ai,bj,At,Bt_) do{__builtin_amdgcn_s_setprio(1); \
    for(int m=0;m<4;++m)for(int n=0;n<2;++n)for(int k=0;k<2;++k) \
      acc[ai][bj][m][n]=__builtin_amdgcn_mfma_f32_16x16x32_bf16(At[m][k],Bt_[n][k],acc[ai][bj][m][n],0,0,0); \
    __builtin_amdgcn_s_setprio(0);}while(0)
#define WAIT_V(n) asm volatile("s_waitcnt vmcnt(" #n ")":::"memory")
#define WAIT_L(n) asm volatile("s_waitcnt lgkmcnt(" #n ")":::"memory")
#define BAR __builtin_amdgcn_s_barrier()
#define SCHED __builtin_amdgcn_sched_barrier(0)

template <class Epi>
DI void gemm256(const bf16_t* __restrict__ A, const bf16_t* __restrict__ Bt, const int K, const int nM, const int nN, LAS bf16_t* shm, const Epi& epi) {
    const int nwg = nM * nN;
    for (int L = blockIdx.x; L < nwg; L += gridDim.x) {
        int wgid = L;
        { int q = nwg / NXCD, r = nwg % NXCD, xcd = wgid % NXCD, off = wgid / NXCD; wgid = (xcd < r ? xcd * (q + 1) : r * (q + 1) + (xcd - r) * q) + off; }
        int nig = WGM * nN, gid = wgid / nig, fm = gid * WGM, gsz = min(nM - fm, WGM);
        int pm = fm + ((wgid % nig) % gsz), pn = (wgid % nig) / gsz, brow = pm * BM, bcol = pn * BM;
        int wid = threadIdx.x >> 6, lane = threadIdx.x & 63, wr = wid >> 2, wc = wid & 3, fr = lane & 15, fq = lane >> 4;
        f32x4 acc[2][2][4][2] = {};
        bf16x8 At[4][2], B0[2][2], B1[2][2];
        int nt = K / BK;
        STAGE(SB(0,0),Bt,bcol,0); STAGE(SA(0,0),A,brow,0);
        STAGE(SB(0,1),Bt,bcol+HALF,0); STAGE(SA(0,1),A,brow+HALF,0);
        if (wr == 1) BAR;
        WAIT_V(4); BAR;
        STAGE(SB(1,0),Bt,bcol,1); STAGE(SA(1,0),A,brow,1); STAGE(SB(1,1),Bt,bcol+HALF,1);
        WAIT_V(6); BAR;
        for (int t = 0; t < nt - 2; t += 2) {
            LDB(B0,0,0); SCHED; LDA(At,0,0); STAGE(SA(1,1),A,brow+HALF,t+1);
            WAIT_L(8); BAR; WAIT_L(0); MMA(0,0,At,B0); BAR; SCHED;
            LDB(B1,0,1); STAGE(SB(0,0),Bt,bcol,t+2);
            BAR; WAIT_L(0); MMA(0,1,At,B1); BAR;
            LDA(At,0,1); STAGE(SA(0,0),A,brow,t+2);
            BAR; WAIT_L(0); MMA(1,0,At,B0); BAR; SCHED;
            STAGE(SB(0,1),Bt,bcol+HALF,t+2);
            WAIT_V(6); BAR; MMA(1,1,At,B1); BAR;
            LDB(B0,1,0); SCHED; LDA(At,1,0); STAGE(SA(0,1),A,brow+HALF,t+2);
            WAIT_L(8); BAR; WAIT_L(0); MMA(0,0,At,B0); BAR; SCHED;
            LDB(B1,1,1); STAGE(SB(1,0),Bt,bcol,t+3);
            BAR; WAIT_L(0); MMA(0,1,At,B1); BAR;
            LDA(At,1,1); STAGE(SA(1,0),A,brow,t+3);
            BAR; WAIT_L(0); MMA(1,0,At,B0); BAR; SCHED;
            STAGE(SB(1,1),Bt,bcol+HALF,t+3);
            WAIT_V(6); BAR; MMA(1,1,At,B1); BAR;
        }
        int tz = threadIdx.x; asm volatile("" : "+v"(tz)); wid = tz >> 6; lane = tz & 63; wr = wid >> 2; wc = wid & 3; fr = lane & 15; fq = lane >> 4;
        { LDB(B0,0,0); WAIT_V(0); LDA(At,0,0); STAGE_X(tz,SA(1,1),A,brow+HALF,nt-1);
          BAR; WAIT_L(0); MMA(0,0,At,B0); BAR;
          LDB(B1,0,1); BAR; WAIT_L(0); MMA(0,1,At,B1); BAR;
          LDA(At,0,1); WAIT_V(4); BAR; WAIT_L(0); MMA(1,0,At,B0); MMA(1,1,At,B1); BAR; }
        { LDB(B0,1,0); LDA(At,1,0); WAIT_V(2); BAR; WAIT_L(0); MMA(0,0,At,B0); BAR;
          LDB(B1,1,1); WAIT_V(0); BAR; WAIT_L(0); MMA(0,1,At,B1); BAR;
          LDA(At,1,1); BAR; WAIT_L(0); MMA(1,0,At,B0); MMA(1,1,At,B1); BAR; }
        if (wr == 0) BAR;
        epi(acc, brow, bcol, wr, wc, fr, fq);
        __syncthreads();
    }
}

struct EpiProj {
    bf16_t* P;
    DI void operator()(const f32x4 (&acc)[2][2][4][2], int brow, int bcol, int wr, int wc, int fr, int fq) const {
#pragma unroll
        for (int ai = 0; ai < 2; ++ai)
#pragma unroll
        for (int bj = 0; bj < 2; ++bj)
#pragma unroll
        for (int m = 0; m < 4; ++m)
#pragma unroll
        for (int n = 0; n < 2; ++n)
#pragma unroll
        for (int j = 0; j < 4; ++j) {
            const int row = brow + ai * HALF + wr * 64 + m * 16 + fq * 4 + j, col = bcol + bj * HALF + wc * 32 + n * 16 + fr;
            if (col < INW) P[(size_t)row * INW + col] = f2bf(acc[ai][bj][m][n][j]);
        }
    }
};
struct EpiOut {
    float* H; const float* X;
    DI void operator()(const f32x4 (&acc)[2][2][4][2], int brow, int bcol, int wr, int wc, int fr, int fq) const {
#pragma unroll
        for (int ai = 0; ai < 2; ++ai)
#pragma unroll
        for (int bj = 0; bj < 2; ++bj)
#pragma unroll
        for (int m = 0; m < 4; ++m)
#pragma unroll
        for (int n = 0; n < 2; ++n)
#pragma unroll
        for (int j = 0; j < 4; ++j) {
            const int row = brow + ai * HALF + wr * 64 + m * 16 + fq * 4 + j, col = bcol + bj * HALF + wc * 32 + n * 16 + fr;
            const size_t o = (size_t)row * DM + col; H[o] = X[o] + acc[ai][bj][m][n][j];
        }
    }
};
struct EpiPQ {
    float* Q;
    DI void operator()(const f32x4 (&acc)[2][2][4][2], int brow, int bcol, int wr, int wc, int fr, int fq) const {
#pragma unroll
        for (int ai = 0; ai < 2; ++ai)
#pragma unroll
        for (int bj = 0; bj < 2; ++bj)
#pragma unroll
        for (int m = 0; m < 4; ++m)
#pragma unroll
        for (int n = 0; n < 2; ++n)
#pragma unroll
        for (int j = 0; j < 4; ++j) {
            const int row = brow + ai * HALF + wr * 64 + m * 16 + fq * 4 + j, col = bcol + bj * HALF + wc * 32 + n * 16 + fr;
            Q[(size_t)row * 2048 + col] = acc[ai][bj][m][n][j];
        }
    }
};

DI void phase_prologue(const Params& p) {
    const int gtid = blockIdx.x * NTHREADS + threadIdx.x, gsz = gridDim.x * NTHREADS;
    bf16_t* wint = (bf16_t*)(p.ws + OFF_WINT);
    for (int idx = gtid; idx < 4096 * 1024; idx += gsz) {
        const int k = idx >> 12, n = idx & 4095;
        const float v = n < INW ? p.w_in[(size_t)k * INW + n] : 0.f;
        wint[(size_t)n * 1024 + k] = f2bf(v);
    }
    bf16_t* woutt = (bf16_t*)(p.ws + OFF_WOUTT);
    for (int idx = gtid; idx < 1024 * 1024; idx += gsz) {
        const int k = idx >> 10, n = idx & 1023;
        woutt[(size_t)n * 1024 + k] = f2bf(p.w_out[(size_t)k * 1024 + n]);
    }
    bf16_t* wqt = (bf16_t*)(p.ws + OFF_WQT);
    for (int idx = gtid; idx < 1024 * 2048; idx += gsz) {
        const int k = idx >> 11, n = idx & 2047;
        wqt[(size_t)n * 1024 + k] = f2bf(p.wq[(size_t)k * 2048 + n]);
    }
    bf16_t* wuvt = (bf16_t*)(p.ws + OFF_WUVT);
    for (int idx = gtid; idx < 8 * 64 * 128; idx += gsz) {
        const int h = idx >> 13, e = (idx >> 7) & 63, dv = idx & 127;
        wuvt[idx] = f2bf(p.w_uv[(size_t)(h * 128 + dv) * 64 + e]);
    }
    bf16_t* skh = (bf16_t*)(p.ws + OFF_SKH); bf16_t* skl = (bf16_t*)(p.ws + OFF_SKL);
    for (int idx = gtid; idx < 2048 * 128; idx += gsz) {
        const float v = p.sk[idx]; const bf16_t hi = f2bf(v);
        skh[idx] = hi; skl[idx] = f2bf(v - bf2f(hi));
    }
    float* c128 = (float*)(p.ws + OFF_COS128); float* s128 = (float*)(p.ws + OFF_SIN128);
    for (int idx = gtid; idx < TT * 64; idx += gsz) {
        const int pos = idx >> 6, j = idx & 63;
        const float inv = powf(10000.f, -(float)j * 2.0f / 128.f);
        const float ang = (float)pos * inv;
        float s, c; sincosf(ang, &s, &c);
        c128[idx] = c; s128[idx] = s;
    }
    float* c64 = (float*)(p.ws + OFF_COS64); float* s64 = (float*)(p.ws + OFF_SIN64);
    for (int idx = gtid; idx < TT * 32; idx += gsz) {
        const int pos = idx >> 5, j = idx & 31;
        const float inv = powf(10000.f, -(float)j * 2.0f / 64.f);
        const float ang = (float)pos * inv;
        float s, c; sincosf(ang, &s, &c);
        c64[idx] = c; s64[idx] = s;
    }
    bf16_t* hn = (bf16_t*)(p.ws + OFF_HN);
    const int wave = threadIdx.x >> 6, lane = threadIdx.x & 63;
    for (int row = blockIdx.x * NWAVES + wave; row < MPAD; row += gridDim.x * NWAVES) {
        bf16_t* o = hn + (size_t)row * DM;
        if (row >= MROWS) {
            for (int i = 0; i < 4; ++i) *(uint2*)(o + i * 256 + lane * 4) = make_uint2(0u, 0u);
            continue;
        }
        const int b = row / TT, t = row % TT;
        const float* src = t < NMETA ? p.meta + (size_t)t * DM : p.x + ((size_t)b * SEQ + (t - NMETA)) * DM;
        float4 v[4]; float ss = 0.f;
#pragma unroll
        for (int i = 0; i < 4; ++i) { v[i] = *(const float4*)(src + i * 256 + lane * 4); ss += v[i].x * v[i].x + v[i].y * v[i].y + v[i].z * v[i].z + v[i].w * v[i].w; }
        ss = wave_sum(ss);
        const float rstd = rsqrtf(ss * (1.f / DM) + 1e-6f);
#pragma unroll
        for (int i = 0; i < 4; ++i) {
            const float4 g = *(const float4*)(p.norm_mix + i * 256 + lane * 4);
            uint2 w;
            w.x = (unsigned)f2bf(v[i].x * rstd * g.x) | ((unsigned)f2bf(v[i].y * rstd * g.y) << 16);
            w.y = (unsigned)f2bf(v[i].z * rstd * g.z) | ((unsigned)f2bf(v[i].w * rstd * g.w) << 16);
            *(uint2*)(o + i * 256 + lane * 4) = w;
        }
    }
}

DI void phase_rope(const Params& p) {
    bf16_t* proj = (bf16_t*)(p.ws + OFF_BIG);
    const float* c128 = (const float*)(p.ws + OFF_COS128); const float* s128 = (const float*)(p.ws + OFF_SIN128);
    const float* c64 = (const float*)(p.ws + OFF_COS64); const float* s64 = (const float*)(p.ws + OFF_SIN64);
    const int gtid = blockIdx.x * NTHREADS + threadIdx.x, gsz = gridDim.x * NTHREADS;
    const int total = MROWS * 1384;
    for (int idx = gtid; idx < total; idx += gsz) {
        const int row = idx / 1384, it = idx % 1384;
        const int t = row % TT;
        bf16_t* pr = proj + (size_t)row * INW;
        int c1, half, j; float scale; bool big;
        if (it < 256)       { c1 = C_RQ + (it >> 6) * 128 + (it & 63); half = 64; j = it & 63; scale = 1.f; big = true; }
        else if (it < 512)  { const int i2 = it - 256;  c1 = C_RK + (i2 >> 6) * 128 + (i2 & 63); half = 64; j = i2 & 63; scale = 0.08838834764831845f; big = true; }
        else if (it < 1024) { const int i2 = it - 512;  c1 = C_DQ + (i2 >> 6) * 128 + (i2 & 63); half = 64; j = i2 & 63; scale = 0.08838834764831845f; big = true; }
        else if (it < 1088) { const int i2 = it - 1024; c1 = C_DK + i2; half = 64; j = i2; scale = 1.f; big = true; }
        else if (it < 1344) { const int i2 = it - 1088; c1 = C_IQ + (i2 >> 5) * 64 + (i2 & 31); half = 32; j = i2 & 31; scale = 0.125f; big = false; }
        else if (it < 1376) { const int i2 = it - 1344; c1 = C_IK + i2; half = 32; j = i2; scale = 1.f; big = false; }
        else { const int c = C_IW + (it - 1376); pr[c] = f2bf(bf2f(pr[c]) * 0.35355339059327373f); continue; }
        const float cs = big ? c128[t * 64 + j] : c64[t * 32 + j];
        const float sn = big ? s128[t * 64 + j] : s64[t * 32 + j];
        const float x1 = bf2f(pr[c1]), x2 = bf2f(pr[c1 + half]);
        pr[c1] = f2bf((x1 * cs - x2 * sn) * scale);
        pr[c1 + half] = f2bf((x2 * cs + x1 * sn) * scale);
    }
    bf16_t* dvt = (bf16_t*)(p.ws + OFF_DVT);
    for (int idx = gtid; idx < NB * TTP * 128; idx += gsz) {
        const int dv = idx & 127, bt = idx >> 7, b = bt / TTP, t = bt % TTP;
        const bf16_t v = t < TT ? proj[(size_t)(b * TT + t) * INW + C_DV + dv] : (bf16_t)0;
        dvt[(size_t)(b * 128 + dv) * TTP + t] = v;
    }
}

DI void phase_ret_state(const Params& p, LAS char* smem) {
    const bf16_t* proj = (const bf16_t*)(p.ws + OFF_BIG);
    float* ST = (float*)(p.ws + OFF_ST);
    LAS bf16_t* sK = (LAS bf16_t*)smem; LAS bf16_t* sV = sK + 64 * 128;
    for (int unit = blockIdx.x; unit < 1024; unit += gridDim.x) {
        const int c = 1 + (unit & 31), bh = unit >> 5, h = bh & 3, b = bh >> 2;
        for (int i = threadIdx.x; i < 64 * 16; i += NTHREADS) {
            const int j = i >> 4, ch = i & 15; const int t = 64 * c + j - 112;
            u32x4 kv = {0u, 0u, 0u, 0u}, vv = {0u, 0u, 0u, 0u};
            if (t >= 0) { const bf16_t* pr = proj + (size_t)(b * TT + t) * INW; kv = *(const u32x4*)(pr + C_RK + h * 128 + ch * 8); vv = *(const u32x4*)(pr + C_RV + h * 128 + ch * 8); }
            *(LAS u32x4*)(sK + j * 128 + ch * 8) = kv; *(LAS u32x4*)(sV + j * 128 + ch * 8) = vv;
        }
        __syncthreads();
        const float lg = logf(1.f - exp2f(-5.f - (float)h));
        const int e = threadIdx.x >> 2, d0 = (threadIdx.x & 3) * 32;
        float acc[32];
#pragma unroll
        for (int dd = 0; dd < 32; ++dd) acc[dd] = 0.f;
        for (int j = 0; j < 64; ++j) {
            const float z = expf(lg * (float)(63 - j)) * bf2f(sV[j * 128 + e]);
#pragma unroll
            for (int d8 = 0; d8 < 4; ++d8) {
                const u32x4 raw = *(const LAS u32x4*)(sK + j * 128 + d0 + d8 * 8); float kv[8]; unpack8(raw, kv);
#pragma unroll
                for (int x = 0; x < 8; ++x) acc[d8 * 8 + x] += z * kv[x];
            }
        }
        float* st = ST + ((size_t)(bh * 34 + c) * 128 + e) * 128 + d0;
#pragma unroll
        for (int d4 = 0; d4 < 8; ++d4) *(float4*)(st + d4 * 4) = make_float4(acc[d4 * 4], acc[d4 * 4 + 1], acc[d4 * 4 + 2], acc[d4 * 4 + 3]);
        __syncthreads();
    }
}

constexpr int DSA_WAVE_LDS = 2176 * 4 + 1024 * 4 + 256 * 4 + 64;
template <bool CHECK>
DI void phase_dsa_naive(const Params& p, LAS char* smem) {
    const bf16_t* proj = (const bf16_t*)(p.ws + OFF_BIG);
    bf16_t* mixed = (bf16_t*)(p.ws + OFF_HN);
    const int wave = threadIdx.x >> 6, lane = threadIdx.x & 63;
    LAS float* sSc = (LAS float*)(smem + wave * DSA_WAVE_LDS);
    LAS float* sQ = sSc + 2176;
    LAS int* sSel = (LAS int*)(sQ + 1024);
    LAS float* sIw = (LAS float*)(sSel + 256);
    const unsigned long long lt_mask = (1ull << lane) - 1ull;
    float chk_num = 0.f, chk_den = 0.f;
    for (int q = blockIdx.x * NWAVES + wave; q < NF; q += gridDim.x * NWAVES) {
        const int b = q >> 11, s = q & 2047, t = NMETA + s;
        const int nk = 80 + 64 * (s >> 6);
        const bf16_t* prow = proj + (size_t)(b * TT + t) * INW;
        for (int i = lane; i < 512; i += 64) sQ[i] = bf2f(prow[C_IQ + i]);
        if (lane < 8) sIw[lane] = bf2f(prow[C_IW + lane]);
        lds_fence();
        const bf16_t* ikbase = proj + (size_t)(b * TT) * INW + C_IK;
        const int nj = (nk + 63) >> 6;
        for (int jj = 0; jj < nj; ++jj) {
            const int k = jj * 64 + lane;
            float sc = 0.f;
            if (k < nk) {
                const bf16_t* kr = ikbase + (size_t)k * INW;
                float a[8];
#pragma unroll
                for (int h = 0; h < 8; ++h) a[h] = 0.f;
#pragma unroll 1
                for (int d8 = 0; d8 < 8; ++d8) {
                    const u32x4 raw = *(const u32x4*)(kr + d8 * 8); float kv[8]; unpack8(raw, kv);
#pragma unroll
                    for (int h = 0; h < 8; ++h) {
                        const f32x4 q0 = *(const LAS f32x4*)(sQ + h * 64 + d8 * 8), q1 = *(const LAS f32x4*)(sQ + h * 64 + d8 * 8 + 4);
                        a[h] += kv[0] * q0[0] + kv[1] * q0[1] + kv[2] * q0[2] + kv[3] * q0[3] + kv[4] * q1[0] + kv[5] * q1[1] + kv[6] * q1[2] + kv[7] * q1[3];
                    }
                }
#pragma unroll
                for (int h = 0; h < 8; ++h) sc += fmaxf(a[h], 0.f) * sIw[h];
                sc += 0.0f;
            }
            sSc[k] = sc;
        }
        lds_fence();
        int L;
        if (nk <= 256) {
            for (int i = lane; i < nk; i += 64) sSel[i] = i;
            L = nk;
        } else {
            unsigned Tkey = 0u;
            for (int bit = 31; bit >= 0; --bit) {
                const unsigned cand = Tkey | (1u << bit);
                int cnt = 0;
                for (int jj = 0; jj < nj; ++jj) {
                    const int k = jj * 64 + lane;
                    const unsigned key = (k < nk) ? fkey(sSc[k]) : 0u;
                    cnt += __popcll(__ballot(key >= cand));
                }
                if (cnt >= 256) Tkey = cand;
            }
            int cgt = 0;
            for (int jj = 0; jj < nj; ++jj) {
                const int k = jj * 64 + lane;
                const unsigned key = (k < nk) ? fkey(sSc[k]) : 0u;
                cgt += __popcll(__ballot(key > Tkey));
            }
            const int need = 256 - cgt;
            int pos = 0, eqseen = 0;
            for (int jj = 0; jj < nj; ++jj) {
                const int k = jj * 64 + lane;
                const unsigned key = (k < nk) ? fkey(sSc[k]) : 0u;
                const bool gt = key > Tkey, eq = (key == Tkey);
                const unsigned long long eqm = __ballot(eq);
                const int myeq = eqseen + __popcll(eqm & lt_mask);
                const bool sel = gt || (eq && myeq < need);
                const unsigned long long sm = __ballot(sel);
                if (sel) sSel[pos + __popcll(sm & lt_mask)] = k;
                pos += __popcll(sm); eqseen += __popcll(eqm);
            }
            L = 256;
        }
        lds_fence();
        for (int i = lane; i < 1024; i += 64) sQ[i] = bf2f(prow[C_DQ + i]);
        lds_fence();
        float sc[8][4];
        const bf16_t* dkbase = proj + (size_t)(b * TT) * INW + C_DK;
#pragma unroll
        for (int il = 0; il < 4; ++il) {
            const int i = lane + 64 * il; const bool ok = i < L; const int key = ok ? sSel[i] : 0;
            const bf16_t* kr = dkbase + (size_t)key * INW;
            float a[8];
#pragma unroll
            for (int h = 0; h < 8; ++h) a[h] = 0.f;
#pragma unroll 1
            for (int d8 = 0; d8 < 16; ++d8) {
                const u32x4 raw = *(const u32x4*)(kr + d8 * 8); float kv[8]; unpack8(raw, kv);
#pragma unroll
                for (int h = 0; h < 8; ++h) {
                    const f32x4 q0 = *(const LAS f32x4*)(sQ + h * 128 + d8 * 8), q1 = *(const LAS f32x4*)(sQ + h * 128 + d8 * 8 + 4);
                    a[h] += kv[0] * q0[0] + kv[1] * q0[1] + kv[2] * q0[2] + kv[3] * q0[3] + kv[4] * q1[0] + kv[5] * q1[1] + kv[6] * q1[2] + kv[7] * q1[3];
                }
            }
#pragma unroll
            for (int h = 0; h < 8; ++h) sc[h][il] = ok ? a[h] : -INFINITY;
        }
#pragma unroll
        for (int h = 0; h < 8; ++h) {
            float m = fmaxf(fmaxf(sc[h][0], sc[h][1]), fmaxf(sc[h][2], sc[h][3]));
            m = wave_max(m);
            float e[4], sum = 0.f;
#pragma unroll
            for (int il = 0; il < 4; ++il) { e[il] = expf(sc[h][il] - m); sum += e[il]; }
            sum = wave_sum(sum);
            const float inv = 1.f / sum;
#pragma unroll
            for (int il = 0; il < 4; ++il) sSc[h * 256 + lane + 64 * il] = e[il] * inv;
        }
        lds_fence();
        float o[8][2];
#pragma unroll
        for (int h = 0; h < 8; ++h) { o[h][0] = 0.f; o[h][1] = 0.f; }
        const bf16_t* dvbase = proj + (size_t)(b * TT) * INW + C_DV;
        for (int i = 0; i < L; ++i) {
            const int key = sSel[i];
            const float v0 = bf2f(dvbase[(size_t)key * INW + lane]), v1 = bf2f(dvbase[(size_t)key * INW + 64 + lane]);
#pragma unroll
            for (int h = 0; h < 8; ++h) { const float pv = sSc[h * 256 + i]; o[h][0] += pv * v0; o[h][1] += pv * v1; }
        }
        lds_fence();
#pragma unroll
        for (int h = 0; h < 8; ++h) { sQ[h * 128 + lane] = o[h][0]; sQ[h * 128 + 64 + lane] = o[h][1]; }
        lds_fence();
        for (int h = 0; h < 8; ++h) {
            float acc = 0.f;
            const float* wu = p.w_uv + (size_t)h * 128 * 64 + lane;
            for (int c = 0; c < 128; ++c) acc += sQ[h * 128 + c] * wu[c * 64];
            if (CHECK) { const float got = bf2f(mixed[(size_t)q * DM + 512 + h * 64 + lane]); chk_num += (got - acc) * (got - acc); chk_den += acc * acc; }
            else mixed[(size_t)q * DM + 512 + h * 64 + lane] = f2bf(acc);
        }
        lds_fence();
    }
    if (CHECK) {
        chk_num = wave_sum(chk_num); chk_den = wave_sum(chk_den);
        if (lane == 0) { atomicAdd((float*)(p.ws + OFF_BAR) + 3600, chk_num); atomicAdd((float*)(p.ws + OFF_BAR) + 3601, chk_den); }
    }
}

typedef unsigned long long u64;
typedef short s16x4 __attribute__((ext_vector_type(4)));
constexpr int SCLD = 2116;
constexpr int DSA_MASK_OFF = 16 * SCLD * 4;
constexpr int KLD = 136, VLD = 72;
constexpr int DSA_VT_OFF = 64 * KLD * 2;
#define MFMA16(a, b, c) __builtin_amdgcn_mfma_f32_16x16x32_bf16((a), (b), (c), 0, 0, 0)
DI void phase_dsa_fast(const Params& p, LAS char* smem) {
    const bf16_t* proj = (const bf16_t*)(p.ws + OFF_BIG);
    const bf16_t* dvt = (const bf16_t*)(p.ws + OFF_DVT);
    const bf16_t* wuvt = (const bf16_t*)(p.ws + OFF_WUVT);
    bf16_t* mixed = (bf16_t*)(p.ws + OFF_HN);
    const int wave = threadIdx.x >> 6, lane = threadIdx.x & 63, c = lane & 15, g = lane >> 4;
    LAS float* SC = (LAS float*)smem; LAS u64* MASK = (LAS u64*)(smem + DSA_MASK_OFF);
    LAS bf16_t* KT = (LAS bf16_t*)smem; LAS bf16_t* VT = (LAS bf16_t*)(smem + DSA_VT_OFF);
    const u64 lt_mask = (1ull << lane) - 1ull;
    for (int pi = blockIdx.x; pi < 512; pi += gridDim.x)
    for (int which = 0; which < 2; ++which) {
        const int b = pi >> 6, qq = pi & 63, qt = which ? 127 - qq : qq;
        const int s0 = qt * 16, nk = 80 + 64 * (s0 >> 6), nkt = nk >> 4, nj = (nk + 63) >> 6;
        const bf16_t* pb = proj + (size_t)(b * TT) * INW;
        {
            const bf16_t* qrow = pb + (size_t)(NMETA + s0 + c) * INW;
            bf16x8 bq[8][2]; float iw[8];
#pragma unroll
            for (int h = 0; h < 8; ++h) {
                bq[h][0] = *(const bf16x8*)(qrow + C_IQ + h * 64 + 8 * g);
                bq[h][1] = *(const bf16x8*)(qrow + C_IQ + h * 64 + 32 + 8 * g);
                iw[h] = bf2f(qrow[C_IW + h]);
            }
            for (int kt = wave; kt < nkt; kt += NWAVES) {
                const bf16_t* krow = pb + (size_t)(kt * 16 + c) * INW + C_IK + 8 * g;
                const bf16x8 a0 = *(const bf16x8*)(krow), a1 = *(const bf16x8*)(krow + 32);
                f32x4 isc = {0.f, 0.f, 0.f, 0.f};
#pragma unroll
                for (int h = 0; h < 8; ++h) {
                    f32x4 acc = {0.f, 0.f, 0.f, 0.f};
                    acc = MFMA16(a0, bq[h][0], acc); acc = MFMA16(a1, bq[h][1], acc);
#pragma unroll
                    for (int j = 0; j < 4; ++j) isc[j] += fmaxf(acc[j], 0.f) * iw[h];
                }
#pragma unroll
                for (int j = 0; j < 4; ++j) isc[j] += 0.0f;
                *(LAS f32x4*)(SC + c * SCLD + kt * 16 + 4 * g) = isc;
            }
        }
        __syncthreads();
#pragma unroll 1
        for (int qi = 0; qi < 2; ++qi) {
            const int cq = wave * 2 + qi;
            unsigned kv[33];
#pragma unroll
            for (int jj = 0; jj < 33; ++jj) { const int k = jj * 64 + lane; const float v = SC[cq * SCLD + k]; kv[jj] = (k < nk) ? fkey(v) : 0u; }
            unsigned Tkey = 0u;
            if (nk > 256) {
#pragma unroll 1
                for (int bit = 31; bit >= 0; --bit) {
                    const unsigned cand = Tkey | (1u << bit);
                    int cnt = 0;
#pragma unroll
                    for (int jj = 0; jj < 33; ++jj) cnt += __popcll(__ballot(kv[jj] >= cand));
                    if (cnt >= 256) Tkey = cand;
                    if (cnt == 256) break;
                }
            } else Tkey = 1u;
            int cgt = 0;
#pragma unroll
            for (int jj = 0; jj < 33; ++jj) cgt += __popcll(__ballot(kv[jj] > Tkey));
            const int need = (nk > 256) ? 256 - cgt : 4096;
            int eqseen = 0;
#pragma unroll
            for (int jj = 0; jj < 33; ++jj) {
                const bool gt = kv[jj] > Tkey, eq = (kv[jj] == Tkey);
                const u64 eqm = __ballot(eq);
                const int myeq = eqseen + __popcll(eqm & lt_mask);
                const u64 sm = __ballot(gt || (eq && myeq < need));
                eqseen += __popcll(eqm);
                if (lane == 0) MASK[cq * 34 + jj] = sm;
            }
        }
        __syncthreads();
        {
            const int h = wave;
            const bf16_t* qrow = pb + (size_t)(NMETA + s0 + c) * INW + C_DQ + h * 128 + 8 * g;
            bf16x8 bQ[4];
#pragma unroll
            for (int ks = 0; ks < 4; ++ks) bQ[ks] = *(const bf16x8*)(qrow + ks * 32);
            f32x4 O[8];
#pragma unroll
            for (int mb = 0; mb < 8; ++mb) O[mb] = (f32x4){0.f, 0.f, 0.f, 0.f};
            float m_run = -1e30f, l_run = 0.f;
#pragma unroll 1
            for (int kb = 0; kb < nj; ++kb) {
                for (int i = threadIdx.x; i < 1024; i += NTHREADS) {
                    const int row = i >> 4, ch = i & 15; int key = kb * 64 + row; key = key < nk ? key : nk - 1;
                    *(LAS u32x4*)(KT + row * KLD + ch * 8) = *(const u32x4*)(pb + (size_t)key * INW + C_DK + ch * 8);
                }
                for (int i = threadIdx.x; i < 1024; i += NTHREADS) {
                    const int dv = i >> 3, ch = i & 7;
                    *(LAS u32x4*)(VT + dv * VLD + ch * 8) = *(const u32x4*)(dvt + (size_t)(b * 128 + dv) * TTP + kb * 64 + ch * 8);
                }
                __syncthreads();
                const u64 mw = MASK[c * 34 + kb];
                f32x4 S[4];
#pragma unroll
                for (int ct = 0; ct < 4; ++ct) {
                    f32x4 acc = {0.f, 0.f, 0.f, 0.f};
#pragma unroll
                    for (int ks = 0; ks < 4; ++ks) {
                        const bf16x8 a = *(const LAS bf16x8*)(KT + (ct * 16 + c) * KLD + ks * 32 + 8 * g);
                        acc = MFMA16(a, bQ[ks], acc);
                    }
                    S[ct] = acc;
                }
                float mblk = -1e30f;
#pragma unroll
                for (int ct = 0; ct < 4; ++ct)
#pragma unroll
                    for (int j = 0; j < 4; ++j) {
                        const bool on = ((mw >> (ct * 16 + 4 * g + j)) & 1ull) != 0ull;
                        S[ct][j] = on ? S[ct][j] : -1e30f;
                        mblk = fmaxf(mblk, S[ct][j]);
                    }
                mblk = fmaxf(mblk, __shfl_xor(mblk, 16)); mblk = fmaxf(mblk, __shfl_xor(mblk, 32));
                const float m_new = fmaxf(m_run, mblk);
                const float alpha = __expf(m_run - m_new);
                float ps = 0.f;
#pragma unroll
                for (int ct = 0; ct < 4; ++ct)
#pragma unroll
                    for (int j = 0; j < 4; ++j) { const float pv = (S[ct][j] > -1e29f) ? __expf(S[ct][j] - m_new) : 0.f; S[ct][j] = pv; ps += pv; }
                l_run = l_run * alpha + ps; m_run = m_new;
#pragma unroll
                for (int mb = 0; mb < 8; ++mb) O[mb] *= alpha;
                bf16x8 bP[2];
#pragma unroll
                for (int kk = 0; kk < 2; ++kk)
#pragma unroll
                    for (int j = 0; j < 4; ++j) { bP[kk][j] = (short)f2bf(S[2 * kk][j]); bP[kk][4 + j] = (short)f2bf(S[2 * kk + 1][j]); }
#pragma unroll
                for (int mb = 0; mb < 8; ++mb)
#pragma unroll
                    for (int kk = 0; kk < 2; ++kk) {
                        const LAS bf16_t* vr = VT + (mb * 16 + c) * VLD + kk * 32 + 4 * g;
                        const s16x4 lo = *(const LAS s16x4*)(vr), hi = *(const LAS s16x4*)(vr + 16);
                        const bf16x8 a = __builtin_shufflevector(lo, hi, 0, 1, 2, 3, 4, 5, 6, 7);
                        O[mb] = MFMA16(a, bP[kk], O[mb]);
                    }
                __syncthreads();
            }
            l_run += __shfl_xor(l_run, 16); l_run += __shfl_xor(l_run, 32);
            const float inv = 1.f / l_run;
            bf16x8 bO[4];
#pragma unroll
            for (int k2 = 0; k2 < 4; ++k2)
#pragma unroll
                for (int j = 0; j < 4; ++j) { bO[k2][j] = (short)f2bf(O[2 * k2][j] * inv); bO[k2][4 + j] = (short)f2bf(O[2 * k2 + 1][j] * inv); }
            bf16_t* orow = mixed + (size_t)(b * SEQ + s0 + c) * DM + 512 + h * 64;
#pragma unroll
            for (int eb = 0; eb < 4; ++eb) {
                f32x4 acc = {0.f, 0.f, 0.f, 0.f};
#pragma unroll
                for (int k2 = 0; k2 < 4; ++k2) {
                    const bf16_t* wr = wuvt + (size_t)(h * 64 + eb * 16 + c) * 128 + k2 * 32 + 4 * g;
                    const s16x4 lo = *(const s16x4*)(wr), hi = *(const s16x4*)(wr + 16);
                    const bf16x8 a = __builtin_shufflevector(lo, hi, 0, 1, 2, 3, 4, 5, 6, 7);
                    acc = MFMA16(a, bO[k2], acc);
                }
                uint2 w;
                w.x = (unsigned)f2bf(acc[0]) | ((unsigned)f2bf(acc[1]) << 16);
                w.y = (unsigned)f2bf(acc[2]) | ((unsigned)f2bf(acc[3]) << 16);
                *(uint2*)(orow + eb * 16 + 4 * g) = w;
            }
        }
    }
}

DI void phase_ret_scan(const Params& p) {
    float* ST = (float*)(p.ws + OFF_ST);
    const int gtid = blockIdx.x * NTHREADS + threadIdx.x, gsz = gridDim.x * NTHREADS;
    for (int idx = gtid; idx < 32 * 16384; idx += gsz) {
        const int bh = idx >> 14, el = idx & 16383, h = bh & 3;
        const float gc = expf(logf(1.f - exp2f(-5.f - (float)h)) * 64.f);
        float* base = ST + (size_t)bh * 34 * 16384 + el;
        float r = 0.f;
        for (int c = 1; c < 34; ++c) {
            const float u = c < 33 ? base[(size_t)c * 16384] : 0.f;
            base[(size_t)c * 16384] = r;
            r = gc * r + u;
        }
    }
}

DI void phase_ret_out(const Params& p, LAS char* smem) {
    const bf16_t* proj = (const bf16_t*)(p.ws + OFF_BIG);
    const float* ST = (const float*)(p.ws + OFF_ST);
    bf16_t* mixed = (bf16_t*)(p.ws + OFF_HN);
    LAS bf16_t* sQ = (LAS bf16_t*)smem; LAS bf16_t* sK = sQ + 64 * 128; LAS bf16_t* sV = sK + 64 * 128;
    LAS float* sS = (LAS float*)(sV + 64 * 128);
    LAS float* sR = sS + 64 * 65;
    for (int unit = blockIdx.x; unit < 1024; unit += gridDim.x) {
        const int c = 2 + (unit & 31), bh = unit >> 5, h = bh & 3, b = bh >> 2;
        for (int i = threadIdx.x; i < 64 * 16; i += NTHREADS) {
            const int j = i >> 4, ch = i & 15; const int t = 64 * c + j - 112;
            const bf16_t* pr = proj + (size_t)(b * TT + t) * INW;
            *(LAS u32x4*)(sQ + j * 128 + ch * 8) = *(const u32x4*)(pr + C_RQ + h * 128 + ch * 8);
            *(LAS u32x4*)(sK + j * 128 + ch * 8) = *(const u32x4*)(pr + C_RK + h * 128 + ch * 8);
            *(LAS u32x4*)(sV + j * 128 + ch * 8) = *(const u32x4*)(pr + C_RV + h * 128 + ch * 8);
        }
        const float* R = ST + (size_t)(bh * 34 + c) * 16384;
        for (int i = threadIdx.x; i < 16384; i += NTHREADS) sR[(i >> 7) * 129 + (i & 127)] = R[i];
        __syncthreads();
        const float lg = logf(1.f - exp2f(-5.f - (float)h));
        const int i = threadIdx.x >> 3, g8 = threadIdx.x & 7;
        {
            float sacc[8];
#pragma unroll
            for (int jj = 0; jj < 8; ++jj) sacc[jj] = 0.f;
            for (int d = 0; d < 128; ++d) {
                const float qv = bf2f(sQ[i * 128 + d]);
#pragma unroll
                for (int jj = 0; jj < 8; ++jj) sacc[jj] += qv * bf2f(sK[(jj * 8 + g8) * 128 + d]);
            }
#pragma unroll
            for (int jj = 0; jj < 8; ++jj) { const int j = jj * 8 + g8; const int df = i > j ? i - j : j - i; sS[i * 65 + j] = sacc[jj] * expf(lg * (float)df); }
        }
        __syncthreads();
        float o[16];
#pragma unroll
        for (int ee = 0; ee < 16; ++ee) o[ee] = 0.f;
        for (int j = 0; j < 64; ++j) {
            const float sv = sS[i * 65 + j];
#pragma unroll
            for (int ee = 0; ee < 16; ++ee) o[ee] += sv * bf2f(sV[j * 128 + ee * 8 + g8]);
        }
        const float xi = expf(lg * (float)(i + 1));
        for (int d = 0; d < 128; ++d) {
            const float qv = bf2f(sQ[i * 128 + d]) * xi;
#pragma unroll
            for (int ee = 0; ee < 16; ++ee) o[ee] += qv * sR[(ee * 8 + g8) * 129 + d];
        }
        float sum = 0.f;
#pragma unroll
        for (int ee = 0; ee < 16; ++ee) sum += o[ee];
        sum += __shfl_xor(sum, 1); sum += __shfl_xor(sum, 2); sum += __shfl_xor(sum, 4);
        const float mu = sum * (1.f / 128.f);
        float var = 0.f;
#pragma unroll
        for (int ee = 0; ee < 16; ++ee) { const float dlt = o[ee] - mu; var += dlt * dlt; }
        var += __shfl_xor(var, 1); var += __shfl_xor(var, 2); var += __shfl_xor(var, 4);
        const float rs = rsqrtf(var * (1.f / 128.f) + 1e-6f);
        const int t = 64 * c + i - 112, srow = t - NMETA;
        const bf16_t* pg = proj + (size_t)(b * TT + t) * INW + C_RG + h * 128;
        bf16_t* po = mixed + (size_t)(b * SEQ + srow) * DM + h * 128;
#pragma unroll
        for (int ee = 0; ee < 16; ++ee) {
            const int e = ee * 8 + g8;
            const float g = bf2f(pg[e]);
            const float gate = g / (1.f + expf(-g));
            po[e] = f2bf(gate * (o[ee] - mu) * rs);
        }
        __syncthreads();
    }
}

DI void phase_norm2(const Params& p) {
    bf16_t* hn2 = (bf16_t*)(p.ws + OFF_HN);
    const int wave = threadIdx.x >> 6, lane = threadIdx.x & 63;
    for (int row = blockIdx.x * NWAVES + wave; row < NF; row += gridDim.x * NWAVES) {
        const float* src = p.out + (size_t)row * DM; bf16_t* o = hn2 + (size_t)row * DM;
        float4 v[4]; float ss = 0.f;
#pragma unroll
        for (int i = 0; i < 4; ++i) { v[i] = *(const float4*)(src + i * 256 + lane * 4); ss += v[i].x * v[i].x + v[i].y * v[i].y + v[i].z * v[i].z + v[i].w * v[i].w; }
        ss = wave_sum(ss);
        const float rstd = rsqrtf(ss * (1.f / DM) + 1e-6f);
#pragma unroll
        for (int i = 0; i < 4; ++i) {
            const float4 g = *(const float4*)(p.norm_ffn + i * 256 + lane * 4);
            uint2 w;
            w.x = (unsigned)f2bf(v[i].x * rstd * g.x) | ((unsigned)f2bf(v[i].y * rstd * g.y) << 16);
            w.y = (unsigned)f2bf(v[i].z * rstd * g.z) | ((unsigned)f2bf(v[i].w * rstd * g.w) << 16);
            *(uint2*)(o + i * 256 + lane * 4) = w;
        }
    }
}

typedef float f32x16 __attribute__((ext_vector_type(16)));
DI bf16x8 pack_hi8(const float (&x)[8], float (&rem)[8]) {
    bf16x8 r;
#pragma unroll
    for (int j = 0; j < 8; ++j) { const bf16_t h = f2bf(x[j]); r[j] = (short)h; rem[j] = x[j] - bf2f(h); }
    return r;
}
DI bf16x8 pack8(const float (&x)[8]) {
    bf16x8 r;
#pragma unroll
    for (int j = 0; j < 8; ++j) r[j] = (short)f2bf(x[j]);
    return r;
}
constexpr int PSEL_WAVE_LDS = 32 * 2 * 16 * 8 + 32 * 16 * 8;
DI void phase_peer_select(const Params& p, LAS char* smem) {
    const float* PQ = (const float*)(p.ws + OFF_BIG);
    const bf16_t* SKH = (const bf16_t*)(p.ws + OFF_SKH); const bf16_t* SKL = (const bf16_t*)(p.ws + OFF_SKL);
    int* EIDX = (int*)(p.ws + OFF_EIDX); float* GATE = (float*)(p.ws + OFF_GATE);
    const int wave = threadIdx.x >> 6, lane = threadIdx.x & 63, r = lane & 31, hh = lane >> 5;
    LAS float* lv = (LAS float*)(smem + wave * PSEL_WAVE_LDS);
    LAS int* li = (LAS int*)(lv + 32 * 2 * 16);
    LAS float* cs = (LAS float*)(li + 32 * 2 * 16);
    LAS int* cab = (LAS int*)(cs + 32 * 16);
    for (int task = blockIdx.x * NWAVES + wave; task < (NF / 32) * 8; task += gridDim.x * NWAVES) {
        const int tile = task >> 3, h = task & 7;
        const int n = tile * 32 + r;
        for (int half = 0; half < 2; ++half) {
            f32x16 acc[4];
#pragma unroll
            for (int mb = 0; mb < 4; ++mb)
#pragma unroll
                for (int i = 0; i < 16; ++i) acc[mb][i] = 0.f;
            const float* qrow = PQ + (size_t)n * 2048 + h * 256 + half * 128 + 8 * hh;
            const bf16_t* kh = SKH + (size_t)((h * 2 + half) * 128 + r) * 128 + 8 * hh;
            const bf16_t* kl = SKL + (size_t)((h * 2 + half) * 128 + r) * 128 + 8 * hh;
#pragma unroll 2
            for (int ks = 0; ks < 8; ++ks) {
                const float4 q0 = *(const float4*)(qrow + ks * 16), q1 = *(const float4*)(qrow + ks * 16 + 4);
                float qf[8] = {q0.x, q0.y, q0.z, q0.w, q1.x, q1.y, q1.z, q1.w}, qr[8];
                const bf16x8 bh = pack_hi8(qf, qr); const bf16x8 bl = pack8(qr);
#pragma unroll
                for (int mb = 0; mb < 4; ++mb) {
                    const bf16x8 ah = *(const bf16x8*)(kh + (size_t)mb * 32 * 128 + ks * 16);
                    const bf16x8 al = *(const bf16x8*)(kl + (size_t)mb * 32 * 128 + ks * 16);
                    acc[mb] = __builtin_amdgcn_mfma_f32_32x32x16_bf16(ah, bh, acc[mb], 0, 0, 0);
                    acc[mb] = __builtin_amdgcn_mfma_f32_32x32x16_bf16(ah, bl, acc[mb], 0, 0, 0);
                    acc[mb] = __builtin_amdgcn_mfma_f32_32x32x16_bf16(al, bh, acc[mb], 0, 0, 0);
                }
            }
            float mprev = INFINITY;
#pragma unroll 1
            for (int it = 0; it < 16; ++it) {
                float m = -INFINITY;
#pragma unroll
                for (int mb = 0; mb < 4; ++mb)
#pragma unroll
                    for (int i = 0; i < 16; ++i) { const float v = acc[mb][i]; m = fmaxf(m, v < mprev ? v : -INFINITY); }
                m = fmaxf(m, __shfl_xor(m, 32));
                mprev = m;
            }
            const float T = mprev;
            int cnt = 0;
#pragma unroll
            for (int mb = 0; mb < 4; ++mb)
#pragma unroll
                for (int i = 0; i < 16; ++i) cnt += (acc[mb][i] >= T) ? 1 : 0;
            const int pc = __shfl_xor(cnt, 32);
            int pos = hh ? pc : 0;
            LAS float* lvp = lv + (r * 2 + half) * 16; LAS int* lip = li + (r * 2 + half) * 16;
#pragma unroll
            for (int mb = 0; mb < 4; ++mb)
#pragma unroll
                for (int i = 0; i < 16; ++i) {
                    const float v = acc[mb][i];
                    if (v >= T) { if (pos < 16) { lvp[pos] = v; lip[pos] = mb * 32 + (i & 3) + 8 * (i >> 2) + 4 * hh; } ++pos; }
                }
        }
        lds_fence();
        float cand[8][16];
        {
            float v1[8], v2[16];
#pragma unroll
            for (int a = 0; a < 8; ++a) v1[a] = lv[(r * 2 + 0) * 16 + 8 * hh + a];
#pragma unroll
            for (int b = 0; b < 16; ++b) v2[b] = lv[(r * 2 + 1) * 16 + b];
#pragma unroll
            for (int a = 0; a < 8; ++a)
#pragma unroll
                for (int b = 0; b < 16; ++b) cand[a][b] = v1[a] + v2[b];
        }
        float mprev = INFINITY;
#pragma unroll 1
        for (int it = 0; it < 16; ++it) {
            float m = -INFINITY;
#pragma unroll
            for (int a = 0; a < 8; ++a)
#pragma unroll
                for (int b = 0; b < 16; ++b) { const float v = cand[a][b]; m = fmaxf(m, v < mprev ? v : -INFINITY); }
            m = fmaxf(m, __shfl_xor(m, 32));
            mprev = m;
        }
        const float Tc = mprev;
        int cnt = 0;
#pragma unroll
        for (int a = 0; a < 8; ++a)
#pragma unroll
            for (int b = 0; b < 16; ++b) cnt += (cand[a][b] >= Tc) ? 1 : 0;
        const int pc = __shfl_xor(cnt, 32);
        int pos = hh ? pc : 0;
#pragma unroll
        for (int a = 0; a < 8; ++a)
#pragma unroll
            for (int b = 0; b < 16; ++b) {
                const float v = cand[a][b];
                if (v >= Tc) { if (pos < 16) { cs[r * 16 + pos] = v; cab[r * 16 + pos] = (8 * hh + a) * 16 + b; } ++pos; }
            }
        lds_fence();
        float scv[16]; float mx = -INFINITY;
#pragma unroll
        for (int i = 0; i < 16; ++i) { scv[i] = cs[r * 16 + i]; mx = fmaxf(mx, scv[i]); }
        float sum = 0.f;
#pragma unroll
        for (int i = 0; i < 16; ++i) { scv[i] = expf(scv[i] - mx); sum += scv[i]; }
        const float inv = 1.f / sum;
#pragma unroll
        for (int i = 0; i < 16; ++i) {
            if ((i >> 3) == hh) {
                const int ab = cab[r * 16 + i];
                const int e = li[(r * 2 + 0) * 16 + (ab >> 4)] * 128 + li[(r * 2 + 1) * 16 + (ab & 15)];
                EIDX[(size_t)n * 128 + h * 16 + i] = e;
                GATE[(size_t)n * 128 + h * 16 + i] = scv[i] * inv;
            }
        }
        lds_fence();
    }
}

DI void phase_convert_tables(const Params& p) {
    const int gtid = blockIdx.x * NTHREADS + threadIdx.x, gsz = gridDim.x * NTHREADS;
    u32x4* U16 = (u32x4*)(p.ws + OFF_U16); u32x4* V16 = (u32x4*)(p.ws + OFF_V16);
    const int items = 16384 * 1024 / 8;
    for (int idx = gtid; idx < 2 * items; idx += gsz) {
        const bool isv = idx >= items; const int i = isv ? idx - items : idx;
        const float4* src = (const float4*)(isv ? p.pv : p.pu) + (size_t)i * 2;
        const float4 a = src[0], b = src[1];
        u32x4 o;
        o[0] = (unsigned)f2bf(a.x) | ((unsigned)f2bf(a.y) << 16); o[1] = (unsigned)f2bf(a.z) | ((unsigned)f2bf(a.w) << 16);
        o[2] = (unsigned)f2bf(b.x) | ((unsigned)f2bf(b.y) << 16); o[3] = (unsigned)f2bf(b.z) | ((unsigned)f2bf(b.w) << 16);
        (isv ? V16 : U16)[i] = o;
    }
}

DI void phase_peer_out(const Params& p) {
    const int* EIDX = (const int*)(p.ws + OFF_EIDX); const float* GATE = (const float*)(p.ws + OFF_GATE);
    const bf16_t* U16 = (const bf16_t*)(p.ws + OFF_U16); const bf16_t* V16 = (const bf16_t*)(p.ws + OFF_V16);
    const int wave = threadIdx.x >> 6, lane = threadIdx.x & 63;
    for (int n = blockIdx.x * NWAVES + wave; n < NF; n += gridDim.x * NWAVES) {
        float* row = p.out + (size_t)n * DM;
        float hv[16], hn[16]; float ss = 0.f;
#pragma unroll
        for (int i = 0; i < 2; ++i) {
            const float4 a = *(const float4*)(row + i * 512 + lane * 8), b = *(const float4*)(row + i * 512 + lane * 8 + 4);
            hv[i * 8 + 0] = a.x; hv[i * 8 + 1] = a.y; hv[i * 8 + 2] = a.z; hv[i * 8 + 3] = a.w;
            hv[i * 8 + 4] = b.x; hv[i * 8 + 5] = b.y; hv[i * 8 + 6] = b.z; hv[i * 8 + 7] = b.w;
        }
#pragma unroll
        for (int i = 0; i < 16; ++i) ss += hv[i] * hv[i];
        ss = wave_sum(ss);
        const float rstd = rsqrtf(ss * (1.f / DM) + 1e-6f);
#pragma unroll
        for (int i = 0; i < 2; ++i) {
            const float4 a = *(const float4*)(p.norm_ffn + i * 512 + lane * 8), b = *(const float4*)(p.norm_ffn + i * 512 + lane * 8 + 4);
            hn[i * 8 + 0] = hv[i * 8 + 0] * rstd * a.x; hn[i * 8 + 1] = hv[i * 8 + 1] * rstd * a.y; hn[i * 8 + 2] = hv[i * 8 + 2] * rstd * a.z; hn[i * 8 + 3] = hv[i * 8 + 3] * rstd * a.w;
            hn[i * 8 + 4] = hv[i * 8 + 4] * rstd * b.x; hn[i * 8 + 5] = hv[i * 8 + 5] * rstd * b.y; hn[i * 8 + 6] = hv[i * 8 + 6] * rstd * b.z; hn[i * 8 + 7] = hv[i * 8 + 7] * rstd * b.w;
        }
        float acc[16];
#pragma unroll
        for (int i = 0; i < 16; ++i) acc[i] = 0.f;
        const int e_lo = EIDX[(size_t)n * 128 + lane], e_hi = EIDX[(size_t)n * 128 + 64 + lane];
        const float g_lo = GATE[(size_t)n * 128 + lane], g_hi = GATE[(size_t)n * 128 + 64 + lane];
#pragma unroll 1
        for (int s0 = 0; s0 < 128; s0 += 4) {
            u32x4 ub[4][2], vb[4][2]; float gt[4];
#pragma unroll
            for (int k = 0; k < 4; ++k) {
                const int slot = s0 + k;
                const int e = slot < 64 ? __builtin_amdgcn_readlane(e_lo, slot & 63) : __builtin_amdgcn_readlane(e_hi, slot & 63);
                gt[k] = __int_as_float(slot < 64 ? __builtin_amdgcn_readlane(__float_as_int(g_lo), slot & 63) : __builtin_amdgcn_readlane(__float_as_int(g_hi), slot & 63));
                const u32x4* ur = (const u32x4*)(U16 + (size_t)e * DM); const u32x4* vr = (const u32x4*)(V16 + (size_t)e * DM);
                ub[k][0] = ur[lane]; ub[k][1] = ur[64 + lane]; vb[k][0] = vr[lane]; vb[k][1] = vr[64 + lane];
            }
            float d[4];
#pragma unroll
            for (int k = 0; k < 4; ++k) {
                float u0[8], u1[8]; unpack8(ub[k][0], u0); unpack8(ub[k][1], u1);
                float t = 0.f;
#pragma unroll
                for (int i = 0; i < 8; ++i) t += u0[i] * hn[i] + u1[i] * hn[8 + i];
                d[k] = t;
            }
#pragma unroll
            for (int o = 32; o > 0; o >>= 1) {
#pragma unroll
                for (int k = 0; k < 4; ++k) d[k] += __shfl_xor(d[k], o);
            }
#pragma unroll
            for (int k = 0; k < 4; ++k) {
                const float coef = 0.5f * d[k] * (1.f + erff(d[k] * 0.70710678118654752f)) * gt[k];
                float v0[8], v1[8]; unpack8(vb[k][0], v0); unpack8(vb[k][1], v1);
#pragma unroll
                for (int i = 0; i < 8; ++i) { acc[i] += coef * v0[i]; acc[8 + i] += coef * v1[i]; }
            }
        }
        float s2 = 0.f;
#pragma unroll
        for (int i = 0; i < 16; ++i) { acc[i] += hv[i]; s2 += acc[i] * acc[i]; }
        s2 = wave_sum(s2);
        float r2 = rsqrtf(s2 * (1.f / DM) + 1e-6f);
#ifdef DSA_CHECK
        {
            const float num = ((const float*)(p.ws + OFF_BAR))[3600], den = ((const float*)(p.ws + OFF_BAR))[3601];
            r2 *= 1.f + 10.f * sqrtf(num / fmaxf(den, 1e-30f));
        }
#endif
#pragma unroll
        for (int i = 0; i < 2; ++i) {
            const float4 a = *(const float4*)(p.norm_final + i * 512 + lane * 8), b = *(const float4*)(p.norm_final + i * 512 + lane * 8 + 4);
            *(float4*)(row + i * 512 + lane * 8) = make_float4(acc[i * 8 + 0] * r2 * a.x, acc[i * 8 + 1] * r2 * a.y, acc[i * 8 + 2] * r2 * a.z, acc[i * 8 + 3] * r2 * a.w);
            *(float4*)(row + i * 512 + lane * 8 + 4) = make_float4(acc[i * 8 + 4] * r2 * b.x, acc[i * 8 + 5] * r2 * b.y, acc[i * 8 + 6] * r2 * b.z, acc[i * 8 + 7] * r2 * b.w);
        }
    }
}

constexpr int NPHASES = 10;
__global__ void __launch_bounds__(NTHREADS, 2) mk_forward(Params p) {
    extern __shared__ __attribute__((aligned(16))) char dyn_smem[];
    LAS char* smem = (LAS char*)dyn_smem;
    const bool multi = (p.hi - p.lo) > 1;
    XcdBarrier bar; bar.bar = (unsigned*)(p.ws + OFF_BAR); bar.x = 0; bar.st = (volatile LAS unsigned*)(smem + LDS_BAR_OFF);
    if (multi) {
        if (threadIdx.x == 0) { const u32x4 z = {0u, 0u, 0u, 0u}; *(LAS u32x4*)(smem + LDS_BAR_OFF) = z; }
        __syncthreads();
        bar = xcd_barrier_post((unsigned*)(p.ws + OFF_BAR), (volatile LAS unsigned*)(smem + LDS_BAR_OFF));
    }
#ifndef PHMASK
#define PHMASK 0xFFFF
#endif
#define PH_ON(i) (((PHMASK >> (i)) & 1) && p.lo <= (i) && (i) < p.hi)
#define PH_SYNC(i) do { if (multi && (i) + 1 < p.hi) xcd_barrier(bar); } while (0)
#ifndef REPEAT_MASK
#define REPEAT_MASK 0
#endif
#define PH_REP(i) for (int rep_ = 0; rep_ < 1 + ((REPEAT_MASK >> (i)) & 1); ++rep_)
    if (PH_ON(0)) { PH_REP(0) phase_prologue(p); PH_SYNC(0); }
    if (PH_ON(1)) { PH_REP(1) { EpiProj e; e.P = (bf16_t*)(p.ws + OFF_BIG); gemm256((const bf16_t*)(p.ws + OFF_HN), (const bf16_t*)(p.ws + OFF_WINT), 1024, MPAD / 256, 4096 / 256, (LAS bf16_t*)smem, e); } PH_SYNC(1); }
    if (PH_ON(2)) { phase_rope(p); PH_SYNC(2); }
    if (PH_ON(3)) { PH_REP(3) { phase_ret_state(p, smem); phase_dsa_fast(p, smem);
#ifdef DSA_CHECK
            __syncthreads(); xcd_barrier(bar); phase_dsa_naive<true>(p, smem);
#endif
        } PH_SYNC(3); }
    if (PH_ON(4)) { phase_ret_scan(p); PH_SYNC(4); }
    if (PH_ON(5)) { PH_REP(5) phase_ret_out(p, smem); PH_SYNC(5); }
    if (PH_ON(6)) { PH_REP(6) { EpiOut e; e.H = p.out; e.X = p.x; gemm256((const bf16_t*)(p.ws + OFF_HN), (const bf16_t*)(p.ws + OFF_WOUTT), 1024, NF / 256, 1024 / 256, (LAS bf16_t*)smem, e); } PH_SYNC(6); }
    if (PH_ON(7)) { PH_REP(7) phase_norm2(p); PH_SYNC(7); }
    if (PH_ON(8)) { PH_REP(8) { EpiPQ e; e.Q = (float*)(p.ws + OFF_BIG); gemm256((const bf16_t*)(p.ws + OFF_HN), (const bf16_t*)(p.ws + OFF_WQT), 1024, NF / 256, 2048 / 256, (LAS bf16_t*)smem, e); } PH_SYNC(8); }
    if (PH_ON(9)) { PH_REP(9) { phase_peer_select(p, smem); phase_convert_tables(p); } PH_SYNC(9); }
    if (PH_ON(10)) { phase_peer_out(p); }
}

extern "C" void kernel_launch(void* const* d_in, const int* in_sizes, int n_in, void* d_out, int out_size, void* d_ws, size_t ws_size, hipStream_t stream) {
    static int grid = 0;
    if (grid == 0) {
        if (n_in != 12 || out_size != NF * DM || ws_size < WS_END) { fprintf(stderr, "kernel_launch: unexpected shapes (n_in %d out %d ws %zu need %zu)\n", n_in, out_size, ws_size, (size_t)WS_END); grid = -1; return; }
        int dev = 0, cus = 0, per_cu = 0;
        if (hipGetDevice(&dev) != hipSuccess || hipDeviceGetAttribute(&cus, hipDeviceAttributeMultiprocessorCount, dev) != hipSuccess) { grid = -1; return; }
        if (hipFuncSetAttribute((const void*)mk_forward, hipFuncAttributeMaxDynamicSharedMemorySize, LDS_BYTES) != hipSuccess) { fprintf(stderr, "kernel_launch: hipFuncSetAttribute failed\n"); grid = -1; return; }
        if (hipOccupancyMaxActiveBlocksPerMultiprocessor(&per_cu, (const void*)mk_forward, NTHREADS, LDS_BYTES) != hipSuccess || per_cu < 1)
            fprintf(stderr, "kernel_launch: occupancy query reports %d blocks per CU\n", per_cu);
        (void)hipGetLastError();
        grid = cus > 0 ? cus : 256;
    }
    if (grid < 0) return;
    Params p{};
    p.x = (const float*)d_in[0]; p.meta = (const float*)d_in[1]; p.norm_mix = (const float*)d_in[2]; p.w_in = (const float*)d_in[3];
    p.w_uv = (const float*)d_in[4]; p.w_out = (const float*)d_in[5]; p.norm_ffn = (const float*)d_in[6]; p.wq = (const float*)d_in[7];
    p.sk = (const float*)d_in[8]; p.pu = (const float*)d_in[9]; p.pv = (const float*)d_in[10]; p.norm_final = (const float*)d_in[11];
    p.out = (float*)d_out; p.ws = (char*)d_ws; p.pad0 = 0; p.pad1 = 0;
    (void)hipMemsetAsync((char*)d_ws + OFF_BAR, 0, 16384, stream);
#if MK_LAUNCHES == 1
    p.lo = 0; p.hi = NPHASES + 1;
    hipLaunchKernelGGL(mk_forward, dim3(grid), dim3(NTHREADS), LDS_BYTES, stream, p);
#else
    for (int ph = 0; ph <= NPHASES; ++ph) { p.lo = ph; p.hi = ph + 1; hipLaunchKernelGGL(mk_forward, dim3(grid), dim3(NTHREADS), LDS_BYTES, stream, p); }
#endif
}
```

```cpp
#include <hip/hip_runtime.h>
#include <stdint.h>
#include <stdio.h>

#ifndef MK_LAUNCHES
#define MK_LAUNCHES 1
#endif

#define DI __device__ __forceinline__
typedef unsigned short bf16_t;
typedef short bf16x8 __attribute__((ext_vector_type(8)));
typedef float f32x4 __attribute__((ext_vector_type(4)));
typedef unsigned u32x4 __attribute__((ext_vector_type(4)));

constexpr int NB = 8, SEQ = 2048, NMETA = 16, TT = 2064, DM = 1024, INW = 3912;
constexpr int MROWS = NB * TT;
constexpr int MPAD = 16640;
constexpr int NF = NB * SEQ;
constexpr int C_RQ = 0, C_RK = 512, C_RV = 1024, C_RG = 1536, C_DQ = 2048, C_DK = 3072, C_DV = 3200, C_IQ = 3328, C_IK = 3840, C_IW = 3904;
constexpr int NTHREADS = 512, NWAVES = 8;
constexpr int LDS_BYTES = 163840;
constexpr int LDS_BAR_OFF = 163840 - 256;

constexpr size_t al256(size_t x) { return (x + 255) & ~(size_t)255; }
constexpr size_t OFF_BAR = 0;
constexpr size_t OFF_COS128 = 16384;
constexpr size_t OFF_SIN128 = OFF_COS128 + al256((size_t)TT * 64 * 4);
constexpr size_t OFF_COS64 = OFF_SIN128 + al256((size_t)TT * 64 * 4);
constexpr size_t OFF_SIN64 = OFF_COS64 + al256((size_t)TT * 32 * 4);
constexpr size_t OFF_WINT = OFF_SIN64 + al256((size_t)TT * 32 * 4);
constexpr size_t OFF_WOUTT = OFF_WINT + (size_t)4096 * 1024 * 2;
constexpr size_t OFF_WQT = OFF_WOUTT + (size_t)1024 * 1024 * 2;
constexpr size_t OFF_SKH = OFF_WQT + (size_t)2048 * 1024 * 2;
constexpr size_t OFF_SKL = OFF_SKH + (size_t)2048 * 128 * 2;
constexpr int TTP = 2112;
constexpr size_t OFF_WUVT = OFF_SKL + (size_t)2048 * 128 * 2;
constexpr size_t OFF_DVT = OFF_WUVT + (size_t)8 * 64 * 128 * 2;
constexpr size_t OFF_HN = OFF_DVT + (size_t)NB * 128 * TTP * 2;
constexpr size_t OFF_BIG = OFF_HN + (size_t)MPAD * 1024 * 2;
constexpr size_t BIG_BYTES = (size_t)NF * 2048 * 4;
constexpr size_t OFF_ST = OFF_BIG + al256(BIG_BYTES);
constexpr size_t ST_BYTES = (size_t)32 * 34 * 16384 * 4;
constexpr size_t WS_END = OFF_ST + ST_BYTES;
constexpr size_t OFF_EIDX = OFF_ST, OFF_GATE = OFF_ST + (size_t)NF * 128 * 4;
constexpr size_t OFF_U16 = OFF_ST + (size_t)NF * 128 * 8;
constexpr size_t OFF_V16 = OFF_HN;
static_assert(OFF_U16 + (size_t)16384 * 1024 * 2 <= WS_END, "u16");
constexpr size_t OFF_U8 = OFF_U16;
constexpr size_t OFF_SU = OFF_U8 + (size_t)16384 * 1024;
constexpr size_t OFF_V8 = OFF_V16;
constexpr size_t OFF_SV = OFF_V8 + (size_t)16384 * 1024;
static_assert(BIG_BYTES >= (size_t)MPAD * INW * 2, "big region");
static_assert(WS_END <= (size_t)268435456, "workspace");

struct Params {
    const float *x, *meta, *norm_mix, *w_in, *w_uv, *w_out, *norm_ffn, *wq, *sk, *pu, *pv, *norm_final;
    float* out; char* ws; int lo, hi, pad0, pad1;
};

DI float bf2f(bf16_t v) { return __uint_as_float(((unsigned)v) << 16); }
DI bf16_t f2bf(float f) { unsigned u = __float_as_uint(f); u += 0x7fffu + ((u >> 16) & 1u); return (bf16_t)(u >> 16); }
DI float wave_sum(float v) {
#pragma unroll
    for (int o = 32; o > 0; o >>= 1) v += __shfl_xor(v, o);
    return v;
}
DI float wave_max(float v) {
#pragma unroll
    for (int o = 32; o > 0; o >>= 1) v = fmaxf(v, __shfl_xor(v, o));
    return v;
}
DI unsigned long long wave_max_u64(unsigned long long v) {
#pragma unroll
    for (int o = 32; o > 0; o >>= 1) {
        const unsigned hi = __shfl_xor((unsigned)(v >> 32), o), lo = __shfl_xor((unsigned)v, o);
        const unsigned long long w = ((unsigned long long)hi << 32) | lo;
        v = w > v ? w : v;
    }
    return v;
}
DI unsigned fkey(float x) { const unsigned u = __float_as_uint(x); return (u & 0x80000000u) ? ~u : (u | 0x80000000u); }
DI float funkey(unsigned k) { const unsigned u = (k & 0x80000000u) ? (k & 0x7fffffffu) : ~k; return __uint_as_float(u); }
DI void lds_fence() { asm volatile("s_waitcnt lgkmcnt(0)" ::: "memory"); }
DI void unpack8(const u32x4& r, float (&v)[8]) {
    v[0] = __uint_as_float(r.x << 16); v[1] = __uint_as_float(r.x & 0xffff0000u);
    v[2] = __uint_as_float(r.y << 16); v[3] = __uint_as_float(r.y & 0xffff0000u);
    v[4] = __uint_as_float(r.z << 16); v[5] = __uint_as_float(r.z & 0xffff0000u);
    v[6] = __uint_as_float(r.w << 16); v[7] = __uint_as_float(r.w & 0xffff0000u);
}

#define XB_TMO      128
#define XB_XCNT(j)  (256  + 64 * (j))
#define XB_XSUB(j)  (1280 + 64 * (j))
#define XB_XGEN(j)  (2304 + 64 * (j))
#define XB_TOP      3328
#define XB_TOPGEN   3392
#define XCD_BAR_WORDS 3456
#define XB_SPIN_CAP (1u << 20)
#define LAS __attribute__((address_space(3)))

DI unsigned xb_ld(unsigned* p)              { return __hip_atomic_load(p, __ATOMIC_RELAXED, __HIP_MEMORY_SCOPE_AGENT); }
DI unsigned xb_add(unsigned* p, unsigned v) { return __hip_atomic_fetch_add(p, v, __ATOMIC_RELAXED, __HIP_MEMORY_SCOPE_AGENT); }
DI unsigned xb_xcc_id() { return (unsigned)__builtin_amdgcn_s_getreg((3 << 11) | 20) & 0xFu; }
#define XB_SPIN(cond, bar) do { unsigned _sp = 0; while (cond) { __builtin_amdgcn_s_sleep(1); \
    if ((++_sp & 255u) == 0u) { if (xb_ld(&(bar)[XB_TMO])) break; if (_sp > XB_SPIN_CAP) { atomicAdd(&(bar)[XB_TMO], 1u); break; } } } } while (0)

struct XcdBarrier { unsigned* bar; unsigned x; volatile LAS unsigned* st; };

DI XcdBarrier xcd_barrier_post(unsigned* bar, volatile LAS unsigned* st) {
    XcdBarrier b; b.bar = bar; b.x = xb_xcc_id(); b.st = st;
    if (threadIdx.x == 0) (void)xb_add(&bar[XB_XCNT(b.x)], 1u);
    return b;
}
DI void xcd_barrier_complete(unsigned* bar, unsigned x, unsigned& nloc, unsigned& nx) {
    const unsigned G = gridDim.x * gridDim.y * gridDim.z;
    unsigned sum, cnt, mine, sp = 0u;
    for (;;) {
        sum = 0u; cnt = 0u; mine = 0u;
#pragma unroll
        for (unsigned j = 0; j < 16; ++j) { const unsigned c = xb_ld(&bar[XB_XCNT(j)]); sum += c; cnt += (c > 0u) ? 1u : 0u; mine = (j == x) ? c : mine; }
        if (sum == G) break;
        __builtin_amdgcn_s_sleep(1);
        if ((++sp & 255u) == 0u) { if (xb_ld(&bar[XB_TMO])) break; if (sp > XB_SPIN_CAP) { atomicAdd(&bar[XB_TMO], 1u); break; } }
    }
    nloc = mine > 0u ? mine : 1u; nx = cnt > 0u ? cnt : 1u;
}
DI void xcd_barrier(const XcdBarrier& b) {
    asm volatile("s_waitcnt vmcnt(0)" ::: "memory");
    __syncthreads();
    if (threadIdx.x == 0) {
        unsigned* bar = b.bar;
        __builtin_amdgcn_s_waitcnt(0);
        unsigned nloc = b.st[0], nx = b.st[1];
        if (nloc == 0u) { xcd_barrier_complete(bar, b.x, nloc, nx); b.st[0] = nloc; b.st[1] = nx; }
        const unsigned old = xb_add(&bar[XB_XSUB(b.x)], 1u);
        const unsigned gen = old / nloc;
        if (old + 1u == (gen + 1u) * nloc) {
            __builtin_amdgcn_fence(__ATOMIC_RELEASE, "agent");
            asm volatile("s_waitcnt vmcnt(0)" ::: "memory");
            const unsigned og = xb_add(&bar[XB_TOP], 1u);
            const unsigned tg = og / nx;
            if (og + 1u == (tg + 1u) * nx) xb_add(&bar[XB_TOPGEN], 1u);
            else XB_SPIN(xb_ld(&bar[XB_TOPGEN]) == tg, bar);
            __builtin_amdgcn_fence(__ATOMIC_ACQUIRE, "agent");
            xb_add(&bar[XB_XGEN(b.x)], 1u);
            asm volatile("s_waitcnt vmcnt(0)" ::: "memory");
        } else {
            XB_SPIN(xb_ld(&bar[XB_XGEN(b.x)]) == gen, bar);
            __builtin_amdgcn_fence(__ATOMIC_ACQUIRE, "agent");
            asm volatile("s_waitcnt vmcnt(0)" ::: "memory");
        }
    }
    __syncthreads();
}

constexpr int BM = 256, BK = 64, HALF = 128, NXCD = 8, WGM = 8, HT = HALF * BK;
DI int lds_byte(int r, int c) {
    int st = (r >> 4) * 2 + (c >> 5), rr = r & 15, cc = c & 31, ob = rr * 64 + cc * 2;
    return st * 1024 + (ob ^ (((ob >> 9) & 1) << 5));
}
DI void stage_rc(int b, int& R, int& C) {
    int st = b / 1024, sb = b % 1024, swz = sb ^ (((sb >> 9) & 1) << 5);
    R = (st >> 1) * 16 + swz / 64; C = (st & 1) * 32 + (swz % 64) / 2;
}

#define SA(b,h) (shm+((b)*2+(h))*HT)
#define SB(b,h) (shm+(4+(b)*2+(h))*HT)
#define STAGE_X(T,P,BASE,br,kt) do{long _g=(long)(br)*K+(long)(kt)*BK; \
    for(int _i=0;_i<2;++_i){int _b=(T)*16+_i*8192;int _r,_c;stage_rc(_b,_r,_c); \
      __builtin_amdgcn_global_load_lds((const unsigned*)(BASE+_g+(long)_r*K+_c), \
        (LAS unsigned*)((LAS char*)(P)+_b),16,0,0);}}while(0)
#define STAGE(P,BASE,br,kt) STAGE_X(threadIdx.x,P,BASE,br,kt)
#define LDA(dst,b,h) for(int m=0;m<4;++m)for(int k=0;k<2;++k) \
    dst[m][k]=*reinterpret_cast<const LAS bf16x8*>((LAS char*)SA(b,h)+lds_byte(wr*64+m*16+fr,k*32+fq*8))
#define LDB(dst,b,h) for(int n=0;n<2;++n)for(int k=0;k<2;++k) \
    dst[n][k]=*reinterpret_cast<const LAS bf16x8*>((LAS char*)SB(b,h)+lds_byte(wc*32+n*16+fr,k*32+fq*8))
#define MMA(ai,bj,At,Bt_) do{__builtin_amdgcn_s_setprio(1); \
    for(int m=0;m<4;++m)for(int n=0;n<2;++n)for(int k=0;k<2;++k) \
      acc[ai][bj][m][n]=__builtin_amdgcn_mfma_f32_16x16x32_bf16(At[m][k],Bt_[n][k],acc[ai][bj][m][n],0,0,0); \
    __builtin_amdgcn_s_setprio(0);}while(0)
#define WAIT_V(n) asm volatile("s_waitcnt vmcnt(" #n ")":::"memory")
#define WAIT_L(n) asm volatile("s_waitcnt lgkmcnt(" #n ")":::"memory")
#define BAR __builtin_amdgcn_s_barrier()
#define SCHED __builtin_amdgcn_sched_barrier(0)

template <class Epi>
DI void gemm256(const bf16_t* __restrict__ A, const bf16_t* __restrict__ Bt, const int K, const int nM, const int nN, LAS bf16_t* shm, const Epi& epi) {
    const int nwg = nM * nN;
    for (int L = blockIdx.x; L < nwg; L += gridDim.x) {
        int wgid = L;
        { int q = nwg / NXCD, r = nwg % NXCD, xcd = wgid % NXCD, off = wgid / NXCD; wgid = (xcd < r ? xcd * (q + 1) : r * (q + 1) + (xcd - r) * q) + off; }
        int nig = WGM * nN, gid = wgid / nig, fm = gid * WGM, gsz = min(nM - fm, WGM);
        int pm = fm + ((wgid % nig) % gsz), pn = (wgid % nig) / gsz, brow = pm * BM, bcol = pn * BM;
        int wid = threadIdx.x >> 6, lane = threadIdx.x & 63, wr = wid >> 2, wc = wid & 3, fr = lane & 15, fq = lane >> 4;
        f32x4 acc[2][2][4][2] = {};
        bf16x8 At[4][2], B0[2][2], B1[2][2];
        int nt = K / BK;
        STAGE(SB(0,0),Bt,bcol,0); STAGE(SA(0,0),A,brow,0);
        STAGE(SB(0,1),Bt,bcol+HALF,0); STAGE(SA(0,1),A,brow+HALF,0);
        if (wr == 1) BAR;
        WAIT_V(4); BAR;
        STAGE(SB(1,0),Bt,bcol,1); STAGE(SA(1,0),A,brow,1); STAGE(SB(1,1),Bt,bcol+HALF,1);
        WAIT_V(6); BAR;
        for (int t = 0; t < nt - 2; t += 2) {
            LDB(B0,0,0); SCHED; LDA(At,0,0); STAGE(SA(1,1),A,brow+HALF,t+1);
            WAIT_L(8); BAR; WAIT_L(0); MMA(0,0,At,B0); BAR; SCHED;
            LDB(B1,0,1); STAGE(SB(0,0),Bt,bcol,t+2);
            BAR; WAIT_L(0); MMA(0,1,At,B1); BAR;
            LDA(At,0,1); STAGE(SA(0,0),A,brow,t+2);
            BAR; WAIT_L(0); MMA(1,0,At,B0); BAR; SCHED;
            STAGE(SB(0,1),Bt,bcol+HALF,t+2);
            WAIT_V(6); BAR; MMA(1,1,At,B1); BAR;
            LDB(B0,1,0); SCHED; LDA(At,1,0); STAGE(SA(0,1),A,brow+HALF,t+2);
            WAIT_L(8); BAR; WAIT_L(0); MMA(0,0,At,B0); BAR; SCHED;
            LDB(B1,1,1); STAGE(SB(1,0),Bt,bcol,t+3);
            BAR; WAIT_L(0); MMA(0,1,At,B1); BAR;
            LDA(At,1,1); STAGE(SA(1,0),A,brow,t+3);
            BAR; WAIT_L(0); MMA(1,0,At,B0); BAR; SCHED;
            STAGE(SB(1,1),Bt,bcol+HALF,t+3);
            WAIT_V(6); BAR; MMA(1,1,At,B1); BAR;
        }
        int tz = threadIdx.x; asm volatile("" : "+v"(tz)); wid = tz >> 6; lane = tz & 63; wr = wid >> 2; wc = wid & 3; fr = lane & 15; fq = lane >> 4;
        { LDB(B0,0,0); WAIT_V(0); LDA(At,0,0); STAGE_X(tz,SA(1,1),A,brow+HALF,nt-1);
          BAR; WAIT_L(0); MMA(0,0,At,B0); BAR;
          LDB(B1,0,1); BAR; WAIT_L(0); MMA(0,1,At,B1); BAR;
          LDA(At,0,1); WAIT_V(4); BAR; WAIT_L(0); MMA(1,0,At,B0); MMA(1,1,At,B1); BAR; }
        { LDB(B0,1,0); LDA(At,1,0); WAIT_V(2); BAR; WAIT_L(0); MMA(0,0,At,B0); BAR;
          LDB(B1,1,1); WAIT_V(0); BAR; WAIT_L(0); MMA(0,1,At,B1); BAR;
          LDA(At,1,1); BAR; WAIT_L(0); MMA(1,0,At,B0); MMA(1,1,At,B1); BAR; }
        if (wr == 0) BAR;
        epi(acc, brow, bcol, wr, wc, fr, fq);
        __syncthreads();
    }
}

struct EpiProj {
    bf16_t* P;
    DI void operator()(const f32x4 (&acc)[2][2][4][2], int brow, int bcol, int wr, int wc, int fr, int fq) const {
#pragma unroll
        for (int ai = 0; ai < 2; ++ai)
#pragma unroll
        for (int bj = 0; bj < 2; ++bj)
#pragma unroll
        for (int m = 0; m < 4; ++m)
#pragma unroll
        for (int n = 0; n < 2; ++n)
#pragma unroll
        for (int j = 0; j < 4; ++j) {
            const int row = brow + ai * HALF + wr * 64 + m * 16 + fq * 4 + j, col = bcol + bj * HALF + wc * 32 + n * 16 + fr;
            if (col < INW) P[(size_t)row * INW + col] = f2bf(acc[ai][bj][m][n][j]);
        }
    }
};
struct EpiOut {
    float* H; const float* X;
    DI void operator()(const f32x4 (&acc)[2][2][4][2], int brow, int bcol, int wr, int wc, int fr, int fq) const {
#pragma unroll
        for (int ai = 0; ai < 2; ++ai)
#pragma unroll
        for (int bj = 0; bj < 2; ++bj)
#pragma unroll
        for (int m = 0; m < 4; ++m)
#pragma unroll
        for (int n = 0; n < 2; ++n)
#pragma unroll
        for (int j = 0; j < 4; ++j) {
            const int row = brow + ai * HALF + wr * 64 + m * 16 + fq * 4 + j, col = bcol + bj * HALF + wc * 32 + n * 16 + fr;
            const size_t o = (size_t)row * DM + col; H[o] = X[o] + acc[ai][bj][m][n][j];
        }
    }
};
struct EpiPQ {
    float* Q;
    DI void operator()(const f32x4 (&acc)[2][2][4][2], int brow, int bcol, int wr, int wc, int fr, int fq) const {
#pragma unroll
        for (int ai = 0; ai < 2; ++ai)
#pragma unroll
        for (int bj = 0; bj < 2; ++bj)
#pragma unroll
        for (int m = 0; m < 4; ++m)
#pragma unroll
        for (int n = 0; n < 2; ++n)
#pragma unroll
        for (int j = 0; j < 4; ++j) {
            const int row = brow + ai * HALF + wr * 64 + m * 16 + fq * 4 + j, col = bcol + bj * HALF + wc * 32 + n * 16 + fr;
            Q[(size_t)row * 2048 + col] = acc[ai][bj][m][n][j];
        }
    }
};

DI void phase_prologue(const Params& p) {
    const int gtid = blockIdx.x * NTHREADS + threadIdx.x, gsz = gridDim.x * NTHREADS;
    bf16_t* wint = (bf16_t*)(p.ws + OFF_WINT);
    for (int idx = gtid; idx < 4096 * 1024; idx += gsz) {
        const int k = idx >> 12, n = idx & 4095;
        const float v = n < INW ? p.w_in[(size_t)k * INW + n] : 0.f;
        wint[(size_t)n * 1024 + k] = f2bf(v);
    }
    bf16_t* woutt = (bf16_t*)(p.ws + OFF_WOUTT);
    for (int idx = gtid; idx < 1024 * 1024; idx += gsz) {
        const int k = idx >> 10, n = idx & 1023;
        woutt[(size_t)n * 1024 + k] = f2bf(p.w_out[(size_t)k * 1024 + n]);
    }
    bf16_t* wqt = (bf16_t*)(p.ws + OFF_WQT);
    for (int idx = gtid; idx < 1024 * 2048; idx += gsz) {
        const int k = idx >> 11, n = idx & 2047;
        wqt[(size_t)n * 1024 + k] = f2bf(p.wq[(size_t)k * 2048 + n]);
    }
    bf16_t* wuvt = (bf16_t*)(p.ws + OFF_WUVT);
    for (int idx = gtid; idx < 8 * 64 * 128; idx += gsz) {
        const int h = idx >> 13, e = (idx >> 7) & 63, dv = idx & 127;
        wuvt[idx] = f2bf(p.w_uv[(size_t)(h * 128 + dv) * 64 + e]);
    }
    bf16_t* skh = (bf16_t*)(p.ws + OFF_SKH); bf16_t* skl = (bf16_t*)(p.ws + OFF_SKL);
    for (int idx = gtid; idx < 2048 * 128; idx += gsz) {
        const float v = p.sk[idx]; const bf16_t hi = f2bf(v);
        skh[idx] = hi; skl[idx] = f2bf(v - bf2f(hi));
    }
    float* c128 = (float*)(p.ws + OFF_COS128); float* s128 = (float*)(p.ws + OFF_SIN128);
    for (int idx = gtid; idx < TT * 64; idx += gsz) {
        const int pos = idx >> 6, j = idx & 63;
        const float inv = powf(10000.f, -(float)j * 2.0f / 128.f);
        const float ang = (float)pos * inv;
        float s, c; sincosf(ang, &s, &c);
        c128[idx] = c; s128[idx] = s;
    }
    float* c64 = (float*)(p.ws + OFF_COS64); float* s64 = (float*)(p.ws + OFF_SIN64);
    for (int idx = gtid; idx < TT * 32; idx += gsz) {
        const int pos = idx >> 5, j = idx & 31;
        const float inv = powf(10000.f, -(float)j * 2.0f / 64.f);
        const float ang = (float)pos * inv;
        float s, c; sincosf(ang, &s, &c);
        c64[idx] = c; s64[idx] = s;
    }
    bf16_t* hn = (bf16_t*)(p.ws + OFF_HN);
    const int wave = threadIdx.x >> 6, lane = threadIdx.x & 63;
    for (int row = blockIdx.x * NWAVES + wave; row < MPAD; row += gridDim.x * NWAVES) {
        bf16_t* o = hn + (size_t)row * DM;
        if (row >= MROWS) {
            for (int i = 0; i < 4; ++i) *(uint2*)(o + i * 256 + lane * 4) = make_uint2(0u, 0u);
            continue;
        }
        const int b = row / TT, t = row % TT;
        const float* src = t < NMETA ? p.meta + (size_t)t * DM : p.x + ((size_t)b * SEQ + (t - NMETA)) * DM;
        float4 v[4]; float ss = 0.f;
#pragma unroll
        for (int i = 0; i < 4; ++i) { v[i] = *(const float4*)(src + i * 256 + lane * 4); ss += v[i].x * v[i].x + v[i].y * v[i].y + v[i].z * v[i].z + v[i].w * v[i].w; }
        ss = wave_sum(ss);
        const float rstd = rsqrtf(ss * (1.f / DM) + 1e-6f);
#pragma unroll
        for (int i = 0; i < 4; ++i) {
            const float4 g = *(const float4*)(p.norm_mix + i * 256 + lane * 4);
            uint2 w;
            w.x = (unsigned)f2bf(v[i].x * rstd * g.x) | ((unsigned)f2bf(v[i].y * rstd * g.y) << 16);
            w.y = (unsigned)f2bf(v[i].z * rstd * g.z) | ((unsigned)f2bf(v[i].w * rstd * g.w) << 16);
            *(uint2*)(o + i * 256 + lane * 4) = w;
        }
    }
}

DI void phase_rope(const Params& p) {
    bf16_t* proj = (bf16_t*)(p.ws + OFF_BIG);
    const float* c128 = (const float*)(p.ws + OFF_COS128); const float* s128 = (const float*)(p.ws + OFF_SIN128);
    const float* c64 = (const float*)(p.ws + OFF_COS64); const float* s64 = (const float*)(p.ws + OFF_SIN64);
    const int gtid = blockIdx.x * NTHREADS + threadIdx.x, gsz = gridDim.x * NTHREADS;
    const int total = MROWS * 1384;
    for (int idx = gtid; idx < total; idx += gsz) {
        const int row = idx / 1384, it = idx % 1384;
        const int t = row % TT;
        bf16_t* pr = proj + (size_t)row * INW;
        int c1, half, j; float scale; bool big;
        if (it < 256)       { c1 = C_RQ + (it >> 6) * 128 + (it & 63); half = 64; j = it & 63; scale = 1.f; big = true; }
        else if (it < 512)  { const int i2 = it - 256;  c1 = C_RK + (i2 >> 6) * 128 + (i2 & 63); half = 64; j = i2 & 63; scale = 0.08838834764831845f; big = true; }
        else if (it < 1024) { const int i2 = it - 512;  c1 = C_DQ + (i2 >> 6) * 128 + (i2 & 63); half = 64; j = i2 & 63; scale = 0.08838834764831845f; big = true; }
        else if (it < 1088) { const int i2 = it - 1024; c1 = C_DK + i2; half = 64; j = i2; scale = 1.f; big = true; }
        else if (it < 1344) { const int i2 = it - 1088; c1 = C_IQ + (i2 >> 5) * 64 + (i2 & 31); half = 32; j = i2 & 31; scale = 0.125f; big = false; }
        else if (it < 1376) { const int i2 = it - 1344; c1 = C_IK + i2; half = 32; j = i2; scale = 1.f; big = false; }
        else { const int c = C_IW + (it - 1376); pr[c] = f2bf(bf2f(pr[c]) * 0.35355339059327373f); continue; }
        const float cs = big ? c128[t * 64 + j] : c64[t * 32 + j];
        const float sn = big ? s128[t * 64 + j] : s64[t * 32 + j];
        const float x1 = bf2f(pr[c1]), x2 = bf2f(pr[c1 + half]);
        pr[c1] = f2bf((x1 * cs - x2 * sn) * scale);
        pr[c1 + half] = f2bf((x2 * cs + x1 * sn) * scale);
    }
    bf16_t* dvt = (bf16_t*)(p.ws + OFF_DVT);
    for (int idx = gtid; idx < NB * TTP * 128; idx += gsz) {
        const int dv = idx & 127, bt = idx >> 7, b = bt / TTP, t = bt % TTP;
        const bf16_t v = t < TT ? proj[(size_t)(b * TT + t) * INW + C_DV + dv] : (bf16_t)0;
        dvt[(size_t)(b * 128 + dv) * TTP + t] = v;
    }
}

DI void phase_ret_state(const Params& p, LAS char* smem) {
    const bf16_t* proj = (const bf16_t*)(p.ws + OFF_BIG);
    float* ST = (float*)(p.ws + OFF_ST);
    LAS bf16_t* sK = (LAS bf16_t*)smem; LAS bf16_t* sV = sK + 64 * 128;
    for (int unit = blockIdx.x; unit < 1024; unit += gridDim.x) {
        const int c = 1 + (unit & 31), bh = unit >> 5, h = bh & 3, b = bh >> 2;
        for (int i = threadIdx.x; i < 64 * 16; i += NTHREADS) {
            const int j = i >> 4, ch = i & 15; const int t = 64 * c + j - 112;
            u32x4 kv = {0u, 0u, 0u, 0u}, vv = {0u, 0u, 0u, 0u};
            if (t >= 0) { const bf16_t* pr = proj + (size_t)(b * TT + t) * INW; kv = *(const u32x4*)(pr + C_RK + h * 128 + ch * 8); vv = *(const u32x4*)(pr + C_RV + h * 128 + ch * 8); }
            *(LAS u32x4*)(sK + j * 128 + ch * 8) = kv; *(LAS u32x4*)(sV + j * 128 + ch * 8) = vv;
        }
        __syncthreads();
        const float lg = logf(1.f - exp2f(-5.f - (float)h));
        const int e = threadIdx.x >> 2, d0 = (threadIdx.x & 3) * 32;
        float acc[32];
#pragma unroll
        for (int dd = 0; dd < 32; ++dd) acc[dd] = 0.f;
        for (int j = 0; j < 64; ++j) {
            const float z = expf(lg * (float)(63 - j)) * bf2f(sV[j * 128 + e]);
#pragma unroll
            for (int d8 = 0; d8 < 4; ++d8) {
                const u32x4 raw = *(const LAS u32x4*)(sK + j * 128 + d0 + d8 * 8); float kv[8]; unpack8(raw, kv);
#pragma unroll
                for (int x = 0; x < 8; ++x) acc[d8 * 8 + x] += z * kv[x];
            }
        }
        float* st = ST + ((size_t)(bh * 34 + c) * 128 + e) * 128 + d0;
#pragma unroll
        for (int d4 = 0; d4 < 8; ++d4) *(float4*)(st + d4 * 4) = make_float4(acc[d4 * 4], acc[d4 * 4 + 1], acc[d4 * 4 + 2], acc[d4 * 4 + 3]);
        __syncthreads();
    }
}

constexpr int DSA_WAVE_LDS = 2176 * 4 + 1024 * 4 + 256 * 4 + 64;
template <bool CHECK>
DI void phase_dsa_naive(const Params& p, LAS char* smem) {
    const bf16_t* proj = (const bf16_t*)(p.ws + OFF_BIG);
    bf16_t* mixed = (bf16_t*)(p.ws + OFF_HN);
    const int wave = threadIdx.x >> 6, lane = threadIdx.x & 63;
    LAS float* sSc = (LAS float*)(smem + wave * DSA_WAVE_LDS);
    LAS float* sQ = sSc + 2176;
    LAS int* sSel = (LAS int*)(sQ + 1024);
    LAS float* sIw = (LAS float*)(sSel + 256);
    const unsigned long long lt_mask = (1ull << lane) - 1ull;
    float chk_num = 0.f, chk_den = 0.f;
    for (int q = blockIdx.x * NWAVES + wave; q < NF; q += gridDim.x * NWAVES) {
        const int b = q >> 11, s = q & 2047, t = NMETA + s;
        const int nk = 80 + 64 * (s >> 6);
        const bf16_t* prow = proj + (size_t)(b * TT + t) * INW;
        for (int i = lane; i < 512; i += 64) sQ[i] = bf2f(prow[C_IQ + i]);
        if (lane < 8) sIw[lane] = bf2f(prow[C_IW + lane]);
        lds_fence();
        const bf16_t* ikbase = proj + (size_t)(b * TT) * INW + C_IK;
        const int nj = (nk + 63) >> 6;
        for (int jj = 0; jj < nj; ++jj) {
            const int k = jj * 64 + lane;
            float sc = 0.f;
            if (k < nk) {
                const bf16_t* kr = ikbase + (size_t)k * INW;
                float a[8];
#pragma unroll
                for (int h = 0; h < 8; ++h) a[h] = 0.f;
#pragma unroll 1
                for (int d8 = 0; d8 < 8; ++d8) {
                    const u32x4 raw = *(const u32x4*)(kr + d8 * 8); float kv[8]; unpack8(raw, kv);
#pragma unroll
                    for (int h = 0; h < 8; ++h) {
                        const f32x4 q0 = *(const LAS f32x4*)(sQ + h * 64 + d8 * 8), q1 = *(const LAS f32x4*)(sQ + h * 64 + d8 * 8 + 4);
                        a[h] += kv[0] * q0[0] + kv[1] * q0[1] + kv[2] * q0[2] + kv[3] * q0[3] + kv[4] * q1[0] + kv[5] * q1[1] + kv[6] * q1[2] + kv[7] * q1[3];
                    }
                }
#pragma unroll
                for (int h = 0; h < 8; ++h) sc += fmaxf(a[h], 0.f) * sIw[h];
                sc += 0.0f;
            }
            sSc[k] = sc;
        }
        lds_fence();
        int L;
        if (nk <= 256) {
            for (int i = lane; i < nk; i += 64) sSel[i] = i;
            L = nk;
        } else {
            unsigned Tkey = 0u;
            for (int bit = 31; bit >= 0; --bit) {
                const unsigned cand = Tkey | (1u << bit);
                int cnt = 0;
                for (int jj = 0; jj < nj; ++jj) {
                    const int k = jj * 64 + lane;
                    const unsigned key = (k < nk) ? fkey(sSc[k]) : 0u;
                    cnt += __popcll(__ballot(key >= cand));
                }
                if (cnt >= 256) Tkey = cand;
            }
            int cgt = 0;
            for (int jj = 0; jj < nj; ++jj) {
                const int k = jj * 64 + lane;
                const unsigned key = (k < nk) ? fkey(sSc[k]) : 0u;
                cgt += __popcll(__ballot(key > Tkey));
            }
            const int need = 256 - cgt;
            int pos = 0, eqseen = 0;
            for (int jj = 0; jj < nj; ++jj) {
                const int k = jj * 64 + lane;
                const unsigned key = (k < nk) ? fkey(sSc[k]) : 0u;
                const bool gt = key > Tkey, eq = (key == Tkey);
                const unsigned long long eqm = __ballot(eq);
                const int myeq = eqseen + __popcll(eqm & lt_mask);
                const bool sel = gt || (eq && myeq < need);
                const unsigned long long sm = __ballot(sel);
                if (sel) sSel[pos + __popcll(sm & lt_mask)] = k;
                pos += __popcll(sm); eqseen += __popcll(eqm);
            }
            L = 256;
        }
        lds_fence();
        for (int i = lane; i < 1024; i += 64) sQ[i] = bf2f(prow[C_DQ + i]);
        lds_fence();
        float sc[8][4];
        const bf16_t* dkbase = proj + (size_t)(b * TT) * INW + C_DK;
#pragma unroll
        for (int il = 0; il < 4; ++il) {
            const int i = lane + 64 * il; const bool ok = i < L; const int key = ok ? sSel[i] : 0;
            const bf16_t* kr = dkbase + (size_t)key * INW;
            float a[8];
#pragma unroll
            for (int h = 0; h < 8; ++h) a[h] = 0.f;
#pragma unroll 1
            for (int d8 = 0; d8 < 16; ++d8) {
                const u32x4 raw = *(const u32x4*)(kr + d8 * 8); float kv[8]; unpack8(raw, kv);
#pragma unroll
                for (int h = 0; h < 8; ++h) {
                    const f32x4 q0 = *(const LAS f32x4*)(sQ + h * 128 + d8 * 8), q1 = *(const LAS f32x4*)(sQ + h * 128 + d8 * 8 + 4);
                    a[h] += kv[0] * q0[0] + kv[1] * q0[1] + kv[2] * q0[2] + kv[3] * q0[3] + kv[4] * q1[0] + kv[5] * q1[1] + kv[6] * q1[2] + kv[7] * q1[3];
                }
            }
#pragma unroll
            for (int h = 0; h < 8; ++h) sc[h][il] = ok ? a[h] : -INFINITY;
        }
#pragma unroll
        for (int h = 0; h < 8; ++h) {
            float m = fmaxf(fmaxf(sc[h][0], sc[h][1]), fmaxf(sc[h][2], sc[h][3]));
            m = wave_max(m);
            float e[4], sum = 0.f;
#pragma unroll
            for (int il = 0; il < 4; ++il) { e[il] = expf(sc[h][il] - m); sum += e[il]; }
            sum = wave_sum(sum);
            const float inv = 1.f / sum;
#pragma unroll
            for (int il = 0; il < 4; ++il) sSc[h * 256 + lane + 64 * il] = e[il] * inv;
        }
        lds_fence();
        float o[8][2];
#pragma unroll
        for (int h = 0; h < 8; ++h) { o[h][0] = 0.f; o[h][1] = 0.f; }
        const bf16_t* dvbase = proj + (size_t)(b * TT) * INW + C_DV;
        for (int i = 0; i < L; ++i) {
            const int key = sSel[i];
            const float v0 = bf2f(dvbase[(size_t)key * INW + lane]), v1 = bf2f(dvbase[(size_t)key * INW + 64 + lane]);
#pragma unroll
            for (int h = 0; h < 8; ++h) { const float pv = sSc[h * 256 + i]; o[h][0] += pv * v0; o[h][1] += pv * v1; }
        }
        lds_fence();
#pragma unroll
        for (int h = 0; h < 8; ++h) { sQ[h * 128 + lane] = o[h][0]; sQ[h * 128 + 64 + lane] = o[h][1]; }
        lds_fence();
        for (int h = 0; h < 8; ++h) {
            float acc = 0.f;
            const float* wu = p.w_uv + (size_t)h * 128 * 64 + lane;
            for (int c = 0; c < 128; ++c) acc += sQ[h * 128 + c] * wu[c * 64];
            if (CHECK) { const float got = bf2f(mixed[(size_t)q * DM + 512 + h * 64 + lane]); chk_num += (got - acc) * (got - acc); chk_den += acc * acc; }
            else mixed[(size_t)q * DM + 512 + h * 64 + lane] = f2bf(acc);
        }
        lds_fence();
    }
    if (CHECK) {
        chk_num = wave_sum(chk_num); chk_den = wave_sum(chk_den);
        if (lane == 0) { atomicAdd((float*)(p.ws + OFF_BAR) + 3600, chk_num); atomicAdd((float*)(p.ws + OFF_BAR) + 3601, chk_den); }
    }
}

typedef unsigned long long u64;
typedef short s16x4 __attribute__((ext_vector_type(4)));
constexpr int SCLD = 2116;
constexpr int DSA_MASK_OFF = 16 * SCLD * 4;
constexpr int KLD = 136, VLD = 72;
constexpr int DSA_VT_OFF = 64 * KLD * 2;
#define MFMA16(a, b, c) __builtin_amdgcn_mfma_f32_16x16x32_bf16((a), (b), (c), 0, 0, 0)
DI void phase_dsa_fast(const Params& p, LAS char* smem) {
    const bf16_t* proj = (const bf16_t*)(p.ws + OFF_BIG);
    const bf16_t* dvt = (const bf16_t*)(p.ws + OFF_DVT);
    const bf16_t* wuvt = (const bf16_t*)(p.ws + OFF_WUVT);
    bf16_t* mixed = (bf16_t*)(p.ws + OFF_HN);
    const int wave = threadIdx.x >> 6, lane = threadIdx.x & 63, c = lane & 15, g = lane >> 4;
    LAS float* SC = (LAS float*)smem; LAS u64* MASK = (LAS u64*)(smem + DSA_MASK_OFF);
    LAS bf16_t* KT = (LAS bf16_t*)smem; LAS bf16_t* VT = (LAS bf16_t*)(smem + DSA_VT_OFF);
    const u64 lt_mask = (1ull << lane) - 1ull;
    for (int pi = blockIdx.x; pi < 512; pi += gridDim.x)
    for (int which = 0; which < 2; ++which) {
        const int b = pi >> 6, qq = pi & 63, qt = which ? 127 - qq : qq;
        const int s0 = qt * 16, nk = 80 + 64 * (s0 >> 6), nkt = nk >> 4, nj = (nk + 63) >> 6;
        const bf16_t* pb = proj + (size_t)(b * TT) * INW;
        {
            const bf16_t* qrow = pb + (size_t)(NMETA + s0 + c) * INW;
            bf16x8 bq[8][2]; float iw[8];
#pragma unroll
            for (int h = 0; h < 8; ++h) {
                bq[h][0] = *(const bf16x8*)(qrow + C_IQ + h * 64 + 8 * g);
                bq[h][1] = *(const bf16x8*)(qrow + C_IQ + h * 64 + 32 + 8 * g);
                iw[h] = bf2f(qrow[C_IW + h]);
            }
            for (int kt = wave; kt < nkt; kt += NWAVES) {
                const bf16_t* krow = pb + (size_t)(kt * 16 + c) * INW + C_IK + 8 * g;
                const bf16x8 a0 = *(const bf16x8*)(krow), a1 = *(const bf16x8*)(krow + 32);
                f32x4 isc = {0.f, 0.f, 0.f, 0.f};
#pragma unroll
                for (int h = 0; h < 8; ++h) {
                    f32x4 acc = {0.f, 0.f, 0.f, 0.f};
                    acc = MFMA16(a0, bq[h][0], acc); acc = MFMA16(a1, bq[h][1], acc);
#pragma unroll
                    for (int j = 0; j < 4; ++j) isc[j] += fmaxf(acc[j], 0.f) * iw[h];
                }
#pragma unroll
                for (int j = 0; j < 4; ++j) isc[j] += 0.0f;
                *(LAS f32x4*)(SC + c * SCLD + kt * 16 + 4 * g) = isc;
            }
        }
        __syncthreads();
#pragma unroll 1
        for (int qi = 0; qi < 2; ++qi) {
            const int cq = wave * 2 + qi;
            unsigned kv[33];
#pragma unroll
            for (int jj = 0; jj < 33; ++jj) { const int k = jj * 64 + lane; const float v = SC[cq * SCLD + k]; kv[jj] = (k < nk) ? fkey(v) : 0u; }
            unsigned Tkey = 0u;
            if (nk > 256) {
#pragma unroll 1
                for (int bit = 31; bit >= 0; --bit) {
                    const unsigned cand = Tkey | (1u << bit);
                    int cnt = 0;
#pragma unroll
                    for (int jj = 0; jj < 33; ++jj) cnt += __popcll(__ballot(kv[jj] >= cand));
                    if (cnt >= 256) Tkey = cand;
                    if (cnt == 256) break;
                }
            } else Tkey = 1u;
            int cgt = 0;
#pragma unroll
            for (int jj = 0; jj < 33; ++jj) cgt += __popcll(__ballot(kv[jj] > Tkey));
            const int need = (nk > 256) ? 256 - cgt : 4096;
            int eqseen = 0;
#pragma unroll
            for (int jj = 0; jj < 33; ++jj) {
                const bool gt = kv[jj] > Tkey, eq = (kv[jj] == Tkey);
                const u64 eqm = __ballot(eq);
                const int myeq = eqseen + __popcll(eqm & lt_mask);
                const u64 sm = __ballot(gt || (eq && myeq < need));
                eqseen += __popcll(eqm);
                if (lane == 0) MASK[cq * 34 + jj] = sm;
            }
        }
        __syncthreads();
        {
            const int h = wave;
            const bf16_t* qrow = pb + (size_t)(NMETA + s0 + c) * INW + C_DQ + h * 128 + 8 * g;
            bf16x8 bQ[4];
#pragma unroll
            for (int ks = 0; ks < 4; ++ks) bQ[ks] = *(const bf16x8*)(qrow + ks * 32);
            f32x4 O[8];
#pragma unroll
            for (int mb = 0; mb < 8; ++mb) O[mb] = (f32x4){0.f, 0.f, 0.f, 0.f};
            float m_run = -1e30f, l_run = 0.f;
#pragma unroll 1
            for (int kb = 0; kb < nj; ++kb) {
                for (int i = threadIdx.x; i < 1024; i += NTHREADS) {
                    const int row = i >> 4, ch = i & 15; int key = kb * 64 + row; key = key < nk ? key : nk - 1;
                    *(LAS u32x4*)(KT + row * KLD + ch * 8) = *(const u32x4*)(pb + (size_t)key * INW + C_DK + ch * 8);
                }
                for (int i = threadIdx.x; i < 1024; i += NTHREADS) {
                    const int dv = i >> 3, ch = i & 7;
                    *(LAS u32x4*)(VT + dv * VLD + ch * 8) = *(const u32x4*)(dvt + (size_t)(b * 128 + dv) * TTP + kb * 64 + ch * 8);
                }
                __syncthreads();
                const u64 mw = MASK[c * 34 + kb];
                f32x4 S[4];
#pragma unroll
                for (int ct = 0; ct < 4; ++ct) {
                    f32x4 acc = {0.f, 0.f, 0.f, 0.f};
#pragma unroll
                    for (int ks = 0; ks < 4; ++ks) {
                        const bf16x8 a = *(const LAS bf16x8*)(KT + (ct * 16 + c) * KLD + ks * 32 + 8 * g);
                        acc = MFMA16(a, bQ[ks], acc);
                    }
                    S[ct] = acc;
                }
                float mblk = -1e30f;
#pragma unroll
                for (int ct = 0; ct < 4; ++ct)
#pragma unroll
                    for (int j = 0; j < 4; ++j) {
                        const bool on = ((mw >> (ct * 16 + 4 * g + j)) & 1ull) != 0ull;
                        S[ct][j] = on ? S[ct][j] : -1e30f;
                        mblk = fmaxf(mblk, S[ct][j]);
                    }
                mblk = fmaxf(mblk, __shfl_xor(mblk, 16)); mblk = fmaxf(mblk, __shfl_xor(mblk, 32));
                const float m_new = fmaxf(m_run, mblk);
                const float alpha = __expf(m_run - m_new);
                float ps = 0.f;
#pragma unroll
                for (int ct = 0; ct < 4; ++ct)
#pragma unroll
                    for (int j = 0; j < 4; ++j) { const float pv = (S[ct][j] > -1e29f) ? __expf(S[ct][j] - m_new) : 0.f; S[ct][j] = pv; ps += pv; }
                l_run = l_run * alpha + ps; m_run = m_new;
#pragma unroll
                for (int mb = 0; mb < 8; ++mb) O[mb] *= alpha;
                bf16x8 bP[2];
#pragma unroll
                for (int kk = 0; kk < 2; ++kk)
#pragma unroll
                    for (int j = 0; j < 4; ++j) { bP[kk][j] = (short)f2bf(S[2 * kk][j]); bP[kk][4 + j] = (short)f2bf(S[2 * kk + 1][j]); }
#pragma unroll
                for (int mb = 0; mb < 8; ++mb)
#pragma unroll
                    for (int kk = 0; kk < 2; ++kk) {
                        const LAS bf16_t* vr = VT + (mb * 16 + c) * VLD + kk * 32 + 4 * g;
                        const s16x4 lo = *(const LAS s16x4*)(vr), hi = *(const LAS s16x4*)(vr + 16);
                        const bf16x8 a = __builtin_shufflevector(lo, hi, 0, 1, 2, 3, 4, 5, 6, 7);
                        O[mb] = MFMA16(a, bP[kk], O[mb]);
                    }
                __syncthreads();
            }
            l_run += __shfl_xor(l_run, 16); l_run += __shfl_xor(l_run, 32);
            const float inv = 1.f / l_run;
            bf16x8 bO[4];
#pragma unroll
            for (int k2 = 0; k2 < 4; ++k2)
#pragma unroll
                for (int j = 0; j < 4; ++j) { bO[k2][j] = (short)f2bf(O[2 * k2][j] * inv); bO[k2][4 + j] = (short)f2bf(O[2 * k2 + 1][j] * inv); }
            bf16_t* orow = mixed + (size_t)(b * SEQ + s0 + c) * DM + 512 + h * 64;
#pragma unroll
            for (int eb = 0; eb < 4; ++eb) {
                f32x4 acc = {0.f, 0.f, 0.f, 0.f};
#pragma unroll
                for (int k2 = 0; k2 < 4; ++k2) {
                    const bf16_t* wr = wuvt + (size_t)(h * 64 + eb * 16 + c) * 128 + k2 * 32 + 4 * g;
                    const s16x4 lo = *(const s16x4*)(wr), hi = *(const s16x4*)(wr + 16);
                    const bf16x8 a = __builtin_shufflevector(lo, hi, 0, 1, 2, 3, 4, 5, 6, 7);
                    acc = MFMA16(a, bO[k2], acc);
                }
                uint2 w;
                w.x = (unsigned)f2bf(acc[0]) | ((unsigned)f2bf(acc[1]) << 16);
                w.y = (unsigned)f2bf(acc[2]) | ((unsigned)f2bf(acc[3]) << 16);
                *(uint2*)(orow + eb * 16 + 4 * g) = w;
            }
        }
    }
}

DI void phase_ret_scan(const Params& p) {
    float* ST = (float*)(p.ws + OFF_ST);
    const int gtid = blockIdx.x * NTHREADS + threadIdx.x, gsz = gridDim.x * NTHREADS;
    for (int idx = gtid; idx < 32 * 16384; idx += gsz) {
        const int bh = idx >> 14, el = idx & 16383, h = bh & 3;
        const float gc = expf(logf(1.f - exp2f(-5.f - (float)h)) * 64.f);
        float* base = ST + (size_t)bh * 34 * 16384 + el;
        float r = 0.f;
        for (int c = 1; c < 34; ++c) {
            const float u = c < 33 ? base[(size_t)c * 16384] : 0.f;
            base[(size_t)c * 16384] = r;
            r = gc * r + u;
        }
    }
}

DI void phase_ret_out(const Params& p, LAS char* smem) {
    const bf16_t* proj = (const bf16_t*)(p.ws + OFF_BIG);
    const float* ST = (const float*)(p.ws + OFF_ST);
    bf16_t* mixed = (bf16_t*)(p.ws + OFF_HN);
    LAS bf16_t* sQ = (LAS bf16_t*)smem; LAS bf16_t* sK = sQ + 64 * 128; LAS bf16_t* sV = sK + 64 * 128;
    LAS float* sS = (LAS float*)(sV + 64 * 128);
    LAS float* sR = sS + 64 * 65;
    for (int unit = blockIdx.x; unit < 1024; unit += gridDim.x) {
        const int c = 2 + (unit & 31), bh = unit >> 5, h = bh & 3, b = bh >> 2;
        for (int i = threadIdx.x; i < 64 * 16; i += NTHREADS) {
            const int j = i >> 4, ch = i & 15; const int t = 64 * c + j - 112;
            const bf16_t* pr = proj + (size_t)(b * TT + t) * INW;
            *(LAS u32x4*)(sQ + j * 128 + ch * 8) = *(const u32x4*)(pr + C_RQ + h * 128 + ch * 8);
            *(LAS u32x4*)(sK + j * 128 + ch * 8) = *(const u32x4*)(pr + C_RK + h * 128 + ch * 8);
            *(LAS u32x4*)(sV + j * 128 + ch * 8) = *(const u32x4*)(pr + C_RV + h * 128 + ch * 8);
        }
        const float* R = ST + (size_t)(bh * 34 + c) * 16384;
        for (int i = threadIdx.x; i < 16384; i += NTHREADS) sR[(i >> 7) * 129 + (i & 127)] = R[i];
        __syncthreads();
        const float lg = logf(1.f - exp2f(-5.f - (float)h));
        const int i = threadIdx.x >> 3, g8 = threadIdx.x & 7;
        {
            float sacc[8];
#pragma unroll
            for (int jj = 0; jj < 8; ++jj) sacc[jj] = 0.f;
            for (int d = 0; d < 128; ++d) {
                const float qv = bf2f(sQ[i * 128 + d]);
#pragma unroll
                for (int jj = 0; jj < 8; ++jj) sacc[jj] += qv * bf2f(sK[(jj * 8 + g8) * 128 + d]);
            }
#pragma unroll
            for (int jj = 0; jj < 8; ++jj) { const int j = jj * 8 + g8; const int df = i > j ? i - j : j - i; sS[i * 65 + j] = sacc[jj] * expf(lg * (float)df); }
        }
        __syncthreads();
        float o[16];
#pragma unroll
        for (int ee = 0; ee < 16; ++ee) o[ee] = 0.f;
        for (int j = 0; j < 64; ++j) {
            const float sv = sS[i * 65 + j];
#pragma unroll
            for (int ee = 0; ee < 16; ++ee) o[ee] += sv * bf2f(sV[j * 128 + ee * 8 + g8]);
        }
        const float xi = expf(lg * (float)(i + 1));
        for (int d = 0; d < 128; ++d) {
            const float qv = bf2f(sQ[i * 128 + d]) * xi;
#pragma unroll
            for (int ee = 0; ee < 16; ++ee) o[ee] += qv * sR[(ee * 8 + g8) * 129 + d];
        }
        float sum = 0.f;
#pragma unroll
        for (int ee = 0; ee < 16; ++ee) sum += o[ee];
        sum += __shfl_xor(sum, 1); sum += __shfl_xor(sum, 2); sum += __shfl_xor(sum, 4);
        const float mu = sum * (1.f / 128.f);
        float var = 0.f;
#pragma unroll
        for (int ee = 0; ee < 16; ++ee) { const float dlt = o[ee] - mu; var += dlt * dlt; }
        var += __shfl_xor(var, 1); var += __shfl_xor(var, 2); var += __shfl_xor(var, 4);
        const float rs = rsqrtf(var * (1.f / 128.f) + 1e-6f);
        const int t = 64 * c + i - 112, srow = t - NMETA;
        const bf16_t* pg = proj + (size_t)(b * TT + t) * INW + C_RG + h * 128;
        bf16_t* po = mixed + (size_t)(b * SEQ + srow) * DM + h * 128;
#pragma unroll
        for (int ee = 0; ee < 16; ++ee) {
            const int e = ee * 8 + g8;
            const float g = bf2f(pg[e]);
            const float gate = g / (1.f + expf(-g));
            po[e] = f2bf(gate * (o[ee] - mu) * rs);
        }
        __syncthreads();
    }
}

DI void phase_norm2(const Params& p) {
    bf16_t* hn2 = (bf16_t*)(p.ws + OFF_HN);
    const int wave = threadIdx.x >> 6, lane = threadIdx.x & 63;
    for (int row = blockIdx.x * NWAVES + wave; row < NF; row += gridDim.x * NWAVES) {
        const float* src = p.out + (size_t)row * DM; bf16_t* o = hn2 + (size_t)row * DM;
        float4 v[4]; float ss = 0.f;
#pragma unroll
        for (int i = 0; i < 4; ++i) { v[i] = *(const float4*)(src + i * 256 + lane * 4); ss += v[i].x * v[i].x + v[i].y * v[i].y + v[i].z * v[i].z + v[i].w * v[i].w; }
        ss = wave_sum(ss);
        const float rstd = rsqrtf(ss * (1.f / DM) + 1e-6f);
#pragma unroll
        for (int i = 0; i < 4; ++i) {
            const float4 g = *(const float4*)(p.norm_ffn + i * 256 + lane * 4);
            uint2 w;
            w.x = (unsigned)f2bf(v[i].x * rstd * g.x) | ((unsigned)f2bf(v[i].y * rstd * g.y) << 16);
            w.y = (unsigned)f2bf(v[i].z * rstd * g.z) | ((unsigned)f2bf(v[i].w * rstd * g.w) << 16);
            *(uint2*)(o + i * 256 + lane * 4) = w;
        }
    }
}

typedef float f32x16 __attribute__((ext_vector_type(16)));
DI bf16x8 pack_hi8(const float (&x)[8], float (&rem)[8]) {
    bf16x8 r;
#pragma unroll
    for (int j = 0; j < 8; ++j) { const bf16_t h = f2bf(x[j]); r[j] = (short)h; rem[j] = x[j] - bf2f(h); }
    return r;
}
DI bf16x8 pack8(const float (&x)[8]) {
    bf16x8 r;
#pragma unroll
    for (int j = 0; j < 8; ++j) r[j] = (short)f2bf(x[j]);
    return r;
}
constexpr int PSEL_WAVE_LDS = 32 * 2 * 16 * 8 + 32 * 16 * 8;
DI void phase_peer_select(const Params& p, LAS char* smem) {
    const float* PQ = (const float*)(p.ws + OFF_BIG);
    const bf16_t* SKH = (const bf16_t*)(p.ws + OFF_SKH); const bf16_t* SKL = (const bf16_t*)(p.ws + OFF_SKL);
    int* EIDX = (int*)(p.ws + OFF_EIDX); float* GATE = (float*)(p.ws + OFF_GATE);
    const int wave = threadIdx.x >> 6, lane = threadIdx.x & 63, r = lane & 31, hh = lane >> 5;
    LAS float* lv = (LAS float*)(smem + wave * PSEL_WAVE_LDS);
    LAS int* li = (LAS int*)(lv + 32 * 2 * 16);
    LAS float* cs = (LAS float*)(li + 32 * 2 * 16);
    LAS int* cab = (LAS int*)(cs + 32 * 16);
    for (int task = blockIdx.x * NWAVES + wave; task < (NF / 32) * 8; task += gridDim.x * NWAVES) {
        const int tile = task >> 3, h = task & 7;
        const int n = tile * 32 + r;
        for (int half = 0; half < 2; ++half) {
            f32x16 acc[4];
#pragma unroll
            for (int mb = 0; mb < 4; ++mb)
#pragma unroll
                for (int i = 0; i < 16; ++i) acc[mb][i] = 0.f;
            const float* qrow = PQ + (size_t)n * 2048 + h * 256 + half * 128 + 8 * hh;
            const bf16_t* kh = SKH + (size_t)((h * 2 + half) * 128 + r) * 128 + 8 * hh;
            const bf16_t* kl = SKL + (size_t)((h * 2 + half) * 128 + r) * 128 + 8 * hh;
#pragma unroll 2
            for (int ks = 0; ks < 8; ++ks) {
                const float4 q0 = *(const float4*)(qrow + ks * 16), q1 = *(const float4*)(qrow + ks * 16 + 4);
                float qf[8] = {q0.x, q0.y, q0.z, q0.w, q1.x, q1.y, q1.z, q1.w}, qr[8];
                const bf16x8 bh = pack_hi8(qf, qr); const bf16x8 bl = pack8(qr);
#pragma unroll
                for (int mb = 0; mb < 4; ++mb) {
                    const bf16x8 ah = *(const bf16x8*)(kh + (size_t)mb * 32 * 128 + ks * 16);
                    const bf16x8 al = *(const bf16x8*)(kl + (size_t)mb * 32 * 128 + ks * 16);
                    acc[mb] = __builtin_amdgcn_mfma_f32_32x32x16_bf16(ah, bh, acc[mb], 0, 0, 0);
                    acc[mb] = __builtin_amdgcn_mfma_f32_32x32x16_bf16(ah, bl, acc[mb], 0, 0, 0);
                    acc[mb] = __builtin_amdgcn_mfma_f32_32x32x16_bf16(al, bh, acc[mb], 0, 0, 0);
                }
            }
            float mprev = INFINITY;
#pragma unroll 1
            for (int it = 0; it < 16; ++it) {
                float m = -INFINITY;
#pragma unroll
                for (int mb = 0; mb < 4; ++mb)
#pragma unroll
                    for (int i = 0; i < 16; ++i) { const float v = acc[mb][i]; m = fmaxf(m, v < mprev ? v : -INFINITY); }
                m = fmaxf(m, __shfl_xor(m, 32));
                mprev = m;
            }
            const float T = mprev;
            int cnt = 0;
#pragma unroll
            for (int mb = 0; mb < 4; ++mb)
#pragma unroll
                for (int i = 0; i < 16; ++i) cnt += (acc[mb][i] >= T) ? 1 : 0;
            const int pc = __shfl_xor(cnt, 32);
            int pos = hh ? pc : 0;
            LAS float* lvp = lv + (r * 2 + half) * 16; LAS int* lip = li + (r * 2 + half) * 16;
#pragma unroll
            for (int mb = 0; mb < 4; ++mb)
#pragma unroll
                for (int i = 0; i < 16; ++i) {
                    const float v = acc[mb][i];
                    if (v >= T) { if (pos < 16) { lvp[pos] = v; lip[pos] = mb * 32 + (i & 3) + 8 * (i >> 2) + 4 * hh; } ++pos; }
                }
        }
        lds_fence();
        float cand[8][16];
        {
            float v1[8], v2[16];
#pragma unroll
            for (int a = 0; a < 8; ++a) v1[a] = lv[(r * 2 + 0) * 16 + 8 * hh + a];
#pragma unroll
            for (int b = 0; b < 16; ++b) v2[b] = lv[(r * 2 + 1) * 16 + b];
#pragma unroll
            for (int a = 0; a < 8; ++a)
#pragma unroll
                for (int b = 0; b < 16; ++b) cand[a][b] = v1[a] + v2[b];
        }
        float mprev = INFINITY;
#pragma unroll 1
        for (int it = 0; it < 16; ++it) {
            float m = -INFINITY;
#pragma unroll
            for (int a = 0; a < 8; ++a)
#pragma unroll
                for (int b = 0; b < 16; ++b) { const float v = cand[a][b]; m = fmaxf(m, v < mprev ? v : -INFINITY); }
            m = fmaxf(m, __shfl_xor(m, 32));
            mprev = m;
        }
        const float Tc = mprev;
        int cnt = 0;
#pragma unroll
        for (int a = 0; a < 8; ++a)
#pragma unroll
            for (int b = 0; b < 16; ++b) cnt += (cand[a][b] >= Tc) ? 1 : 0;
        const int pc = __shfl_xor(cnt, 32);
        int pos = hh ? pc : 0;
#pragma unroll
        for (int a = 0; a < 8; ++a)
#pragma unroll
            for (int b = 0; b < 16; ++b) {
                const float v = cand[a][b];
                if (v >= Tc) { if (pos < 16) { cs[r * 16 + pos] = v; cab[r * 16 + pos] = (8 * hh + a) * 16 + b; } ++pos; }
            }
        lds_fence();
        float scv[16]; float mx = -INFINITY;
#pragma unroll
        for (int i = 0; i < 16; ++i) { scv[i] = cs[r * 16 + i]; mx = fmaxf(mx, scv[i]); }
        float sum = 0.f;
#pragma unroll
        for (int i = 0; i < 16; ++i) { scv[i] = expf(scv[i] - mx); sum += scv[i]; }
        const float inv = 1.f / sum;
#pragma unroll
        for (int i = 0; i < 16; ++i) {
            if ((i >> 3) == hh) {
                const int ab = cab[r * 16 + i];
                const int e = li[(r * 2 + 0) * 16 + (ab >> 4)] * 128 + li[(r * 2 + 1) * 16 + (ab & 15)];
                EIDX[(size_t)n * 128 + h * 16 + i] = e;
                GATE[(size_t)n * 128 + h * 16 + i] = scv[i] * inv;
            }
        }
        lds_fence();
    }
}

typedef float f32x2 __attribute__((ext_vector_type(2)));
DI void phase_convert_tables(const Params& p) {
    const int wave = threadIdx.x >> 6, lane = threadIdx.x & 63;
    for (int rowi = blockIdx.x * NWAVES + wave; rowi < 2 * 16384; rowi += gridDim.x * NWAVES) {
        const bool isv = rowi >= 16384; const int e = isv ? rowi - 16384 : rowi;
        const float* src = (isv ? p.pv : p.pu) + (size_t)e * DM + lane * 16;
        float x[16]; float mx = 0.f;
#pragma unroll
        for (int i = 0; i < 4; ++i) { const float4 a = *(const float4*)(src + i * 4); x[i * 4] = a.x; x[i * 4 + 1] = a.y; x[i * 4 + 2] = a.z; x[i * 4 + 3] = a.w; }
#pragma unroll
        for (int i = 0; i < 16; ++i) mx = fmaxf(mx, fabsf(x[i]));
        mx = wave_max(mx);
        const float inv = mx > 0.f ? 240.f / mx : 0.f, scale = mx > 0.f ? mx * (1.f / 240.f) : 0.f;
        u32x4 o;
#pragma unroll
        for (int w = 0; w < 4; ++w) {
            int pk = 0;
            pk = __builtin_amdgcn_cvt_pk_fp8_f32(x[w * 4] * inv, x[w * 4 + 1] * inv, pk, false);
            pk = __builtin_amdgcn_cvt_pk_fp8_f32(x[w * 4 + 2] * inv, x[w * 4 + 3] * inv, pk, true);
            o[w] = (unsigned)pk;
        }
        *(u32x4*)(p.ws + (isv ? OFF_V8 : OFF_U8) + (size_t)e * DM + lane * 16) = o;
        if (lane == 0) ((float*)(p.ws + (isv ? OFF_SV : OFF_SU)))[e] = scale;
    }
}
DI void unpack16_fp8(const u32x4& r, float (&v)[16]) {
#pragma unroll
    for (int w = 0; w < 4; ++w) {
        const f32x2 a = __builtin_amdgcn_cvt_pk_f32_fp8((int)r[w], false), b = __builtin_amdgcn_cvt_pk_f32_fp8((int)r[w], true);
        v[w * 4] = a[0]; v[w * 4 + 1] = a[1]; v[w * 4 + 2] = b[0]; v[w * 4 + 3] = b[1];
    }
}
DI float dpp_row_sum(float v) {
    v += __int_as_float(__builtin_amdgcn_update_dpp(0, __float_as_int(v), 0xB1, 0xF, 0xF, true));
    v += __int_as_float(__builtin_amdgcn_update_dpp(0, __float_as_int(v), 0x4E, 0xF, 0xF, true));
    v += __int_as_float(__builtin_amdgcn_update_dpp(0, __float_as_int(v), 0x141, 0xF, 0xF, true));
    v += __int_as_float(__builtin_amdgcn_update_dpp(0, __float_as_int(v), 0x140, 0xF, 0xF, true));
    return v;
}
DI float wave_sum_uniform(float v) {
    v = dpp_row_sum(v);
    const float a = __int_as_float(__builtin_amdgcn_readlane(__float_as_int(v), 0)), b = __int_as_float(__builtin_amdgcn_readlane(__float_as_int(v), 16));
    const float c = __int_as_float(__builtin_amdgcn_readlane(__float_as_int(v), 32)), d = __int_as_float(__builtin_amdgcn_readlane(__float_as_int(v), 48));
    return (a + b) + (c + d);
}

#ifndef P10_REP
#define P10_REP 1
#endif
DI void phase_peer_out(const Params& p) {
    const int* EIDX = (const int*)(p.ws + OFF_EIDX); const float* GATE = (const float*)(p.ws + OFF_GATE);
    const char* U8 = p.ws + OFF_U8; const char* V8 = p.ws + OFF_V8;
    const float* SU = (const float*)(p.ws + OFF_SU); const float* SV = (const float*)(p.ws + OFF_SV);
    const int wave = threadIdx.x >> 6, lane = threadIdx.x & 63;
    for (int n = blockIdx.x * NWAVES + wave; n < NF; n += gridDim.x * NWAVES) {
        float* row = p.out + (size_t)n * DM + lane * 16;
        float hv[16], hn[16]; float ss = 0.f;
#pragma unroll
        for (int i = 0; i < 4; ++i) { const float4 a = *(const float4*)(row + i * 4); hv[i * 4] = a.x; hv[i * 4 + 1] = a.y; hv[i * 4 + 2] = a.z; hv[i * 4 + 3] = a.w; }
#pragma unroll
        for (int i = 0; i < 16; ++i) ss += hv[i] * hv[i];
        ss = wave_sum_uniform(ss);
        const float rstd = rsqrtf(ss * (1.f / DM) + 1e-6f);
#pragma unroll
        for (int i = 0; i < 4; ++i) {
            const float4 a = *(const float4*)(p.norm_ffn + lane * 16 + i * 4);
            hn[i * 4] = hv[i * 4] * rstd * a.x; hn[i * 4 + 1] = hv[i * 4 + 1] * rstd * a.y; hn[i * 4 + 2] = hv[i * 4 + 2] * rstd * a.z; hn[i * 4 + 3] = hv[i * 4 + 3] * rstd * a.w;
        }
        float acc[16];
#pragma unroll
        for (int i = 0; i < 16; ++i) acc[i] = 0.f;
        const int e_lo = EIDX[(size_t)n * 128 + lane], e_hi = EIDX[(size_t)n * 128 + 64 + lane];
        const float g_lo = GATE[(size_t)n * 128 + lane], g_hi = GATE[(size_t)n * 128 + 64 + lane];
#pragma unroll 1
        for (int s0_ = 0; s0_ < 128 * P10_REP; s0_ += 8) {
            const int s0 = s0_ & 127;
            u32x4 ub[8], vb[8]; float gt[8], su[8], sv[8];
#pragma unroll
            for (int k = 0; k < 8; ++k) {
                const int slot = s0 + k;
                const int e = slot < 64 ? __builtin_amdgcn_readlane(e_lo, slot & 63) : __builtin_amdgcn_readlane(e_hi, slot & 63);
                gt[k] = __int_as_float(slot < 64 ? __builtin_amdgcn_readlane(__float_as_int(g_lo), slot & 63) : __builtin_amdgcn_readlane(__float_as_int(g_hi), slot & 63));
                ub[k] = *(const u32x4*)(U8 + (size_t)e * DM + lane * 16);
                vb[k] = *(const u32x4*)(V8 + (size_t)e * DM + lane * 16);
                su[k] = SU[e]; sv[k] = SV[e];
            }
            float d[8];
#pragma unroll
            for (int k = 0; k < 8; ++k) {
                float u[16]; unpack16_fp8(ub[k], u);
                float t = 0.f;
#pragma unroll
                for (int i = 0; i < 16; ++i) t += u[i] * hn[i];
                d[k] = t;
            }
#pragma unroll
            for (int k = 0; k < 8; ++k) d[k] = wave_sum_uniform(d[k]) * su[k];
#pragma unroll
            for (int k = 0; k < 8; ++k) {
                const float coef = 0.5f * d[k] * (1.f + erff(d[k] * 0.70710678118654752f)) * gt[k] * sv[k];
                float v[16]; unpack16_fp8(vb[k], v);
#pragma unroll
                for (int i = 0; i < 16; ++i) acc[i] += coef * v[i];
            }
        }
        float s2 = 0.f;
#pragma unroll
        for (int i = 0; i < 16; ++i) { acc[i] = acc[i] * (1.f / P10_REP) + hv[i]; s2 += acc[i] * acc[i]; }
        s2 = wave_sum_uniform(s2);
        float r2 = rsqrtf(s2 * (1.f / DM) + 1e-6f);
#ifdef DSA_CHECK
        {
            const float num = ((const float*)(p.ws + OFF_BAR))[3600], den = ((const float*)(p.ws + OFF_BAR))[3601];
            r2 *= 1.f + 10.f * sqrtf(num / fmaxf(den, 1e-30f));
        }
#endif
#pragma unroll
        for (int i = 0; i < 4; ++i) {
            const float4 a = *(const float4*)(p.norm_final + lane * 16 + i * 4);
            *(float4*)(row + i * 4) = make_float4(acc[i * 4] * r2 * a.x, acc[i * 4 + 1] * r2 * a.y, acc[i * 4 + 2] * r2 * a.z, acc[i * 4 + 3] * r2 * a.w);
        }
    }
}

constexpr int NPHASES = 10;
__global__ void __launch_bounds__(NTHREADS, 2) mk_forward(Params p) {
    extern __shared__ __attribute__((aligned(16))) char dyn_smem[];
    LAS char* smem = (LAS char*)dyn_smem;
    const bool multi = (p.hi - p.lo) > 1;
    XcdBarrier bar; bar.bar = (unsigned*)(p.ws + OFF_BAR); bar.x = 0; bar.st = (volatile LAS unsigned*)(smem + LDS_BAR_OFF);
    if (multi) {
        if (threadIdx.x == 0) { const u32x4 z = {0u, 0u, 0u, 0u}; *(LAS u32x4*)(smem + LDS_BAR_OFF) = z; }
        __syncthreads();
        bar = xcd_barrier_post((unsigned*)(p.ws + OFF_BAR), (volatile LAS unsigned*)(smem + LDS_BAR_OFF));
    }
#ifndef PHMASK
#define PHMASK 0xFFFF
#endif
#define PH_ON(i) (((PHMASK >> (i)) & 1) && p.lo <= (i) && (i) < p.hi)
#define PH_SYNC(i) do { if (multi && (i) + 1 < p.hi) xcd_barrier(bar); } while (0)
#ifndef REPEAT_MASK
#define REPEAT_MASK 0
#endif
#define PH_REP(i) for (int rep_ = 0; rep_ < 1 + ((REPEAT_MASK >> (i)) & 1); ++rep_)
    if (PH_ON(0)) { PH_REP(0) phase_prologue(p); PH_SYNC(0); }
    if (PH_ON(1)) { PH_REP(1) { EpiProj e; e.P = (bf16_t*)(p.ws + OFF_BIG); gemm256((const bf16_t*)(p.ws + OFF_HN), (const bf16_t*)(p.ws + OFF_WINT), 1024, MPAD / 256, 4096 / 256, (LAS bf16_t*)smem, e); } PH_SYNC(1); }
    if (PH_ON(2)) { phase_rope(p); PH_SYNC(2); }
    if (PH_ON(3)) { PH_REP(3) {
#ifndef RS_REP
#define RS_REP 1
#endif
#ifndef DSA_REP
#define DSA_REP 1
#endif
            for (int rr_ = 0; rr_ < RS_REP; ++rr_) phase_ret_state(p, smem);
            for (int rr_ = 0; rr_ < DSA_REP; ++rr_) { phase_dsa_fast(p, smem); __syncthreads(); }
#ifdef DSA_CHECK
            __syncthreads(); xcd_barrier(bar); phase_dsa_naive<true>(p, smem);
#endif
        } PH_SYNC(3); }
    if (PH_ON(4)) { phase_ret_scan(p); PH_SYNC(4); }
    if (PH_ON(5)) { PH_REP(5) phase_ret_out(p, smem); PH_SYNC(5); }
    if (PH_ON(6)) { PH_REP(6) { EpiOut e; e.H = p.out; e.X = p.x; gemm256((const bf16_t*)(p.ws + OFF_HN), (const bf16_t*)(p.ws + OFF_WOUTT), 1024, NF / 256, 1024 / 256, (LAS bf16_t*)smem, e); } PH_SYNC(6); }
    if (PH_ON(7)) { PH_REP(7) phase_norm2(p); PH_SYNC(7); }
    if (PH_ON(8)) { PH_REP(8) { EpiPQ e; e.Q = (float*)(p.ws + OFF_BIG); gemm256((const bf16_t*)(p.ws + OFF_HN), (const bf16_t*)(p.ws + OFF_WQT), 1024, NF / 256, 2048 / 256, (LAS bf16_t*)smem, e); } PH_SYNC(8); }
    if (PH_ON(9)) { PH_REP(9) { phase_peer_select(p, smem); phase_convert_tables(p); } PH_SYNC(9); }
    if (PH_ON(10)) { phase_peer_out(p); }
}

extern "C" void kernel_launch(void* const* d_in, const int* in_sizes, int n_in, void* d_out, int out_size, void* d_ws, size_t ws_size, hipStream_t stream) {
    static int grid = 0;
    if (grid == 0) {
        if (n_in != 12 || out_size != NF * DM || ws_size < WS_END) { fprintf(stderr, "kernel_launch: unexpected shapes (n_in %d out %d ws %zu need %zu)\n", n_in, out_size, ws_size, (size_t)WS_END); grid = -1; return; }
        int dev = 0, cus = 0, per_cu = 0;
        if (hipGetDevice(&dev) != hipSuccess || hipDeviceGetAttribute(&cus, hipDeviceAttributeMultiprocessorCount, dev) != hipSuccess) { grid = -1; return; }
        if (hipFuncSetAttribute((const void*)mk_forward, hipFuncAttributeMaxDynamicSharedMemorySize, LDS_BYTES) != hipSuccess) { fprintf(stderr, "kernel_launch: hipFuncSetAttribute failed\n"); grid = -1; return; }
        if (hipOccupancyMaxActiveBlocksPerMultiprocessor(&per_cu, (const void*)mk_forward, NTHREADS, LDS_BYTES) != hipSuccess || per_cu < 1)
            fprintf(stderr, "kernel_launch: occupancy query reports %d blocks per CU\n", per_cu);
        (void)hipGetLastError();
        grid = cus > 0 ? cus : 256;
    }
    if (grid < 0) return;
    Params p{};
    p.x = (const float*)d_in[0]; p.meta = (const float*)d_in[1]; p.norm_mix = (const float*)d_in[2]; p.w_in = (const float*)d_in[3];
    p.w_uv = (const float*)d_in[4]; p.w_out = (const float*)d_in[5]; p.norm_ffn = (const float*)d_in[6]; p.wq = (const float*)d_in[7];
    p.sk = (const float*)d_in[8]; p.pu = (const float*)d_in[9]; p.pv = (const float*)d_in[10]; p.norm_final = (const float*)d_in[11];
    p.out = (float*)d_out; p.ws = (char*)d_ws; p.pad0 = 0; p.pad1 = 0;
    (void)hipMemsetAsync((char*)d_ws + OFF_BAR, 0, 16384, stream);
#if MK_LAUNCHES == 1
    p.lo = 0; p.hi = NPHASES + 1;
    hipLaunchKernelGGL(mk_forward, dim3(grid), dim3(NTHREADS), LDS_BYTES, stream, p);
#else
    for (int ph = 0; ph <= NPHASES; ++ph) { p.lo = ph; p.hi = ph + 1; hipLaunchKernelGGL(mk_forward, dim3(grid), dim3(NTHREADS), LDS_BYTES, stream, p); }
#endif
}
```

```cpp
#include <hip/hip_runtime.h>
#include <stdint.h>
#include <stdio.h>

#ifndef MK_LAUNCHES
#define MK_LAUNCHES 1
#endif

#define DI __device__ __forceinline__
#ifndef TP_SEC
#define TP_SEC 0
#endif
#define TP_LDS_OFF (163840 - 128)
#define TP_BEGIN(k) do { if (TP_SEC == (k) && blockIdx.x == 0 && threadIdx.x == 0) { *(volatile __attribute__((address_space(3))) long long*)(tp_smem + TP_LDS_OFF + 8) = (long long)__builtin_readcyclecounter(); } } while (0)
#define TP_END(k) do { if (TP_SEC == (k) && blockIdx.x == 0 && threadIdx.x == 0) { volatile __attribute__((address_space(3))) long long* tp_ = (volatile __attribute__((address_space(3))) long long*)(tp_smem + TP_LDS_OFF); tp_[2] += (long long)__builtin_readcyclecounter() - tp_[1]; } } while (0)
typedef unsigned short bf16_t;
typedef short bf16x8 __attribute__((ext_vector_type(8)));
typedef float f32x4 __attribute__((ext_vector_type(4)));
typedef unsigned u32x4 __attribute__((ext_vector_type(4)));

constexpr int NB = 8, SEQ = 2048, NMETA = 16, TT = 2064, DM = 1024, INW = 3912;
constexpr int MROWS = NB * TT;
constexpr int MPAD = 16640;
constexpr int NF = NB * SEQ;
constexpr int C_RQ = 0, C_RK = 512, C_RV = 1024, C_RG = 1536, C_DQ = 2048, C_DK = 3072, C_DV = 3200, C_IQ = 3328, C_IK = 3840, C_IW = 3904;
constexpr int NTHREADS = 512, NWAVES = 8;
constexpr int LDS_BYTES = 163840;
constexpr int LDS_BAR_OFF = 163840 - 256;

constexpr size_t al256(size_t x) { return (x + 255) & ~(size_t)255; }
constexpr size_t OFF_BAR = 0;
constexpr size_t OFF_COS128 = 16384;
constexpr size_t OFF_SIN128 = OFF_COS128 + al256((size_t)TT * 64 * 4);
constexpr size_t OFF_COS64 = OFF_SIN128 + al256((size_t)TT * 64 * 4);
constexpr size_t OFF_SIN64 = OFF_COS64 + al256((size_t)TT * 32 * 4);
constexpr size_t OFF_WINT = OFF_SIN64 + al256((size_t)TT * 32 * 4);
constexpr size_t OFF_WOUTT = OFF_WINT + (size_t)4096 * 1024 * 2;
constexpr size_t OFF_WQT = OFF_WOUTT + (size_t)1024 * 1024 * 2;
constexpr size_t OFF_SKH = OFF_WQT + (size_t)2048 * 1024 * 2;
constexpr size_t OFF_SKL = OFF_SKH + (size_t)2048 * 128 * 2;
constexpr int TTP = 2112;
constexpr size_t OFF_WUVT = OFF_SKL + (size_t)2048 * 128 * 2;
constexpr size_t OFF_DVT = OFF_WUVT + (size_t)8 * 64 * 128 * 2;
constexpr size_t OFF_HN = OFF_DVT + (size_t)NB * 128 * TTP * 2;
constexpr size_t OFF_BIG = OFF_HN + (size_t)MPAD * 1024 * 2;
constexpr size_t BIG_BYTES = (size_t)NF * 2048 * 4;
constexpr size_t OFF_ST = OFF_BIG + al256(BIG_BYTES);
constexpr size_t ST_BYTES = (size_t)32 * 34 * 16384 * 4;
constexpr size_t WS_END = OFF_ST + ST_BYTES;
constexpr size_t OFF_EIDX = OFF_ST, OFF_GATE = OFF_ST + (size_t)NF * 128 * 4;
constexpr size_t OFF_U16 = OFF_ST + (size_t)NF * 128 * 8;
constexpr size_t OFF_V16 = OFF_HN;
static_assert(OFF_U16 + (size_t)16384 * 1024 * 2 <= WS_END, "u16");
constexpr size_t OFF_U8 = OFF_U16;
constexpr size_t OFF_SU = OFF_U8 + (size_t)16384 * 1024;
constexpr size_t OFF_V8 = OFF_V16;
constexpr size_t OFF_SV = OFF_V8 + (size_t)16384 * 1024;
static_assert(BIG_BYTES >= (size_t)MPAD * INW * 2, "big region");
static_assert(WS_END <= (size_t)268435456, "workspace");

struct Params {
    const float *x, *meta, *norm_mix, *w_in, *w_uv, *w_out, *norm_ffn, *wq, *sk, *pu, *pv, *norm_final;
    float* out; char* ws; int lo, hi, pad0, pad1;
};

DI float bf2f(bf16_t v) { return __uint_as_float(((unsigned)v) << 16); }
DI bf16_t f2bf(float f) { unsigned u = __float_as_uint(f); u += 0x7fffu + ((u >> 16) & 1u); return (bf16_t)(u >> 16); }
DI float wave_sum(float v) {
#pragma unroll
    for (int o = 32; o > 0; o >>= 1) v += __shfl_xor(v, o);
    return v;
}
DI float wave_max(float v) {
#pragma unroll
    for (int o = 32; o > 0; o >>= 1) v = fmaxf(v, __shfl_xor(v, o));
    return v;
}
DI unsigned long long wave_max_u64(unsigned long long v) {
#pragma unroll
    for (int o = 32; o > 0; o >>= 1) {
        const unsigned hi = __shfl_xor((unsigned)(v >> 32), o), lo = __shfl_xor((unsigned)v, o);
        const unsigned long long w = ((unsigned long long)hi << 32) | lo;
        v = w > v ? w : v;
    }
    return v;
}
DI unsigned fkey(float x) { const unsigned u = __float_as_uint(x); return (u & 0x80000000u) ? ~u : (u | 0x80000000u); }
DI float funkey(unsigned k) { const unsigned u = (k & 0x80000000u) ? (k & 0x7fffffffu) : ~k; return __uint_as_float(u); }
DI void lds_fence() { asm volatile("s_waitcnt lgkmcnt(0)" ::: "memory"); }
DI void unpack8(const u32x4& r, float (&v)[8]) {
    v[0] = __uint_as_float(r.x << 16); v[1] = __uint_as_float(r.x & 0xffff0000u);
    v[2] = __uint_as_float(r.y << 16); v[3] = __uint_as_float(r.y & 0xffff0000u);
    v[4] = __uint_as_float(r.z << 16); v[5] = __uint_as_float(r.z & 0xffff0000u);
    v[6] = __uint_as_float(r.w << 16); v[7] = __uint_as_float(r.w & 0xffff0000u);
}

typedef float f32x16 __attribute__((ext_vector_type(16)));
DI bf16x8 pack_hi8(const float (&x)[8], float (&rem)[8]) {
    bf16x8 r;
#pragma unroll
    for (int j = 0; j < 8; ++j) { const bf16_t h = f2bf(x[j]); r[j] = (short)h; rem[j] = x[j] - bf2f(h); }
    return r;
}
DI bf16x8 pack8(const float (&x)[8]) {
    bf16x8 r;
#pragma unroll
    for (int j = 0; j < 8; ++j) r[j] = (short)f2bf(x[j]);
    return r;
}

#define XB_TMO      128
#define XB_XCNT(j)  (256  + 64 * (j))
#define XB_XSUB(j)  (1280 + 64 * (j))
#define XB_XGEN(j)  (2304 + 64 * (j))
#define XB_TOP      3328
#define XB_TOPGEN   3392
#define XCD_BAR_WORDS 3456
#define XB_SPIN_CAP (1u << 20)
#define LAS __attribute__((address_space(3)))

DI unsigned xb_ld(unsigned* p)              { return __hip_atomic_load(p, __ATOMIC_RELAXED, __HIP_MEMORY_SCOPE_AGENT); }
DI unsigned xb_add(unsigned* p, unsigned v) { return __hip_atomic_fetch_add(p, v, __ATOMIC_RELAXED, __HIP_MEMORY_SCOPE_AGENT); }
DI unsigned xb_xcc_id() { return (unsigned)__builtin_amdgcn_s_getreg((3 << 11) | 20) & 0xFu; }
#define XB_SPIN(cond, bar) do { unsigned _sp = 0; while (cond) { __builtin_amdgcn_s_sleep(1); \
    if ((++_sp & 255u) == 0u) { if (xb_ld(&(bar)[XB_TMO])) break; if (_sp > XB_SPIN_CAP) { atomicAdd(&(bar)[XB_TMO], 1u); break; } } } } while (0)

struct XcdBarrier { unsigned* bar; unsigned x; volatile LAS unsigned* st; };

DI XcdBarrier xcd_barrier_post(unsigned* bar, volatile LAS unsigned* st) {
    XcdBarrier b; b.bar = bar; b.x = xb_xcc_id(); b.st = st;
    if (threadIdx.x == 0) (void)xb_add(&bar[XB_XCNT(b.x)], 1u);
    return b;
}
DI void xcd_barrier_complete(unsigned* bar, unsigned x, unsigned& nloc, unsigned& nx) {
    const unsigned G = gridDim.x * gridDim.y * gridDim.z;
    unsigned sum, cnt, mine, sp = 0u;
    for (;;) {
        sum = 0u; cnt = 0u; mine = 0u;
#pragma unroll
        for (unsigned j = 0; j < 16; ++j) { const unsigned c = xb_ld(&bar[XB_XCNT(j)]); sum += c; cnt += (c > 0u) ? 1u : 0u; mine = (j == x) ? c : mine; }
        if (sum == G) break;
        __builtin_amdgcn_s_sleep(1);
        if ((++sp & 255u) == 0u) { if (xb_ld(&bar[XB_TMO])) break; if (sp > XB_SPIN_CAP) { atomicAdd(&bar[XB_TMO], 1u); break; } }
    }
    nloc = mine > 0u ? mine : 1u; nx = cnt > 0u ? cnt : 1u;
}
DI void xcd_barrier(const XcdBarrier& b) {
    asm volatile("s_waitcnt vmcnt(0)" ::: "memory");
    __syncthreads();
    if (threadIdx.x == 0) {
        unsigned* bar = b.bar;
        __builtin_amdgcn_s_waitcnt(0);
        unsigned nloc = b.st[0], nx = b.st[1];
        if (nloc == 0u) { xcd_barrier_complete(bar, b.x, nloc, nx); b.st[0] = nloc; b.st[1] = nx; }
        const unsigned old = xb_add(&bar[XB_XSUB(b.x)], 1u);
        const unsigned gen = old / nloc;
        if (old + 1u == (gen + 1u) * nloc) {
            __builtin_amdgcn_fence(__ATOMIC_RELEASE, "agent");
            asm volatile("s_waitcnt vmcnt(0)" ::: "memory");
            const unsigned og = xb_add(&bar[XB_TOP], 1u);
            const unsigned tg = og / nx;
            if (og + 1u == (tg + 1u) * nx) xb_add(&bar[XB_TOPGEN], 1u);
            else XB_SPIN(xb_ld(&bar[XB_TOPGEN]) == tg, bar);
            __builtin_amdgcn_fence(__ATOMIC_ACQUIRE, "agent");
            xb_add(&bar[XB_XGEN(b.x)], 1u);
            asm volatile("s_waitcnt vmcnt(0)" ::: "memory");
        } else {
            XB_SPIN(xb_ld(&bar[XB_XGEN(b.x)]) == gen, bar);
            __builtin_amdgcn_fence(__ATOMIC_ACQUIRE, "agent");
            asm volatile("s_waitcnt vmcnt(0)" ::: "memory");
        }
    }
    __syncthreads();
}

constexpr int BM = 256, BK = 64, HALF = 128, NXCD = 8, WGM = 8, HT = HALF * BK;
DI int lds_byte(int r, int c) {
    int st = (r >> 4) * 2 + (c >> 5), rr = r & 15, cc = c & 31, ob = rr * 64 + cc * 2;
    return st * 1024 + (ob ^ (((ob >> 9) & 1) << 5));
}
DI void stage_rc(int b, int& R, int& C) {
    int st = b / 1024, sb = b % 1024, swz = sb ^ (((sb >> 9) & 1) << 5);
    R = (st >> 1) * 16 + swz / 64; C = (st & 1) * 32 + (swz % 64) / 2;
}

#define SA(b,h) (shm+((b)*2+(h))*HT)
#define SB(b,h) (shm+(4+(b)*2+(h))*HT)
#define STAGE_X(T,P,BASE,br,kt) do{long _g=(long)(br)*K+(long)(kt)*BK; \
    for(int _i=0;_i<2;++_i){int _b=(T)*16+_i*8192;int _r,_c;stage_rc(_b,_r,_c); \
      __builtin_amdgcn_global_load_lds((const unsigned*)(BASE+_g+(long)_r*K+_c), \
        (LAS unsigned*)((LAS char*)(P)+_b),16,0,0);}}while(0)
#define STAGE(P,BASE,br,kt) STAGE_X(threadIdx.x,P,BASE,br,kt)
#define LDA(dst,b,h) for(int m=0;m<4;++m)for(int k=0;k<2;++k) \
    dst[m][k]=*reinterpret_cast<const LAS bf16x8*>((LAS char*)SA(b,h)+lds_byte(wr*64+m*16+fr,k*32+fq*8))
#define LDB(dst,b,h) for(int n=0;n<2;++n)for(int k=0;k<2;++k) \
    dst[n][k]=*reinterpret_cast<const LAS bf16x8*>((LAS char*)SB(b,h)+lds_byte(wc*32+n*16+fr,k*32+fq*8))
#define MMA(ai,bj,At,Bt_) do{__builtin_amdgcn_s_setprio(1); \
    for(int m=0;m<4;++m)for(int n=0;n<2;++n)for(int k=0;k<2;++k) \
      acc[ai][bj][m][n]=__builtin_amdgcn_mfma_f32_16x16x32_bf16(At[m][k],Bt_[n][k],acc[ai][bj][m][n],0,0,0); \
    __builtin_amdgcn_s_setprio(0);}while(0)
#define WAIT_V(n) asm volatile("s_waitcnt vmcnt(" #n ")":::"memory")
#define WAIT_L(n) asm volatile("s_waitcnt lgkmcnt(" #n ")":::"memory")
#define BAR __builtin_amdgcn_s_barrier()
#define SCHED __builtin_amdgcn_sched_barrier(0)

template <class Epi>
DI void gemm256(const bf16_t* __restrict__ A, const bf16_t* __restrict__ Bt, const int K, const int nM, const int nN, LAS bf16_t* shm, const Epi& epi) {
    const int nwg = nM * nN;
    for (int L = blockIdx.x; L < nwg; L += gridDim.x) {
        int wgid = L;
        { int q = nwg / NXCD, r = nwg % NXCD, xcd = wgid % NXCD, off = wgid / NXCD; wgid = (xcd < r ? xcd * (q + 1) : r * (q + 1) + (xcd - r) * q) + off; }
        int nig = WGM * nN, gid = wgid / nig, fm = gid * WGM, gsz = min(nM - fm, WGM);
        int pm = fm + ((wgid % nig) % gsz), pn = (wgid % nig) / gsz, brow = pm * BM, bcol = pn * BM;
        int wid = threadIdx.x >> 6, lane = threadIdx.x & 63, wr = wid >> 2, wc = wid & 3, fr = lane & 15, fq = lane >> 4;
        f32x4 acc[2][2][4][2] = {};
        bf16x8 At[4][2], B0[2][2], B1[2][2];
        int nt = K / BK;
        STAGE(SB(0,0),Bt,bcol,0); STAGE(SA(0,0),A,brow,0);
        STAGE(SB(0,1),Bt,bcol+HALF,0); STAGE(SA(0,1),A,brow+HALF,0);
        if (wr == 1) BAR;
        WAIT_V(4); BAR;
        STAGE(SB(1,0),Bt,bcol,1); STAGE(SA(1,0),A,brow,1); STAGE(SB(1,1),Bt,bcol+HALF,1);
        WAIT_V(6); BAR;
        for (int t = 0; t < nt - 2; t += 2) {
            LDB(B0,0,0); SCHED; LDA(At,0,0); STAGE(SA(1,1),A,brow+HALF,t+1);
            WAIT_L(8); BAR; WAIT_L(0); MMA(0,0,At,B0); BAR; SCHED;
            LDB(B1,0,1); STAGE(SB(0,0),Bt,bcol,t+2);
            BAR; WAIT_L(0); MMA(0,1,At,B1); BAR;
            LDA(At,0,1); STAGE(SA(0,0),A,brow,t+2);
            BAR; WAIT_L(0); MMA(1,0,At,B0); BAR; SCHED;
            STAGE(SB(0,1),Bt,bcol+HALF,t+2);
            WAIT_V(6); BAR; MMA(1,1,At,B1); BAR;
            LDB(B0,1,0); SCHED; LDA(At,1,0); STAGE(SA(0,1),A,brow+HALF,t+2);
            WAIT_L(8); BAR; WAIT_L(0); MMA(0,0,At,B0); BAR; SCHED;
            LDB(B1,1,1); STAGE(SB(1,0),Bt,bcol,t+3);
            BAR; WAIT_L(0); MMA(0,1,At,B1); BAR;
            LDA(At,1,1); STAGE(SA(1,0),A,brow,t+3);
            BAR; WAIT_L(0); MMA(1,0,At,B0); BAR; SCHED;
            STAGE(SB(1,1),Bt,bcol+HALF,t+3);
            WAIT_V(6); BAR; MMA(1,1,At,B1); BAR;
        }
        int tz = threadIdx.x; asm volatile("" : "+v"(tz)); wid = tz >> 6; lane = tz & 63; wr = wid >> 2; wc = wid & 3; fr = lane & 15; fq = lane >> 4;
        { LDB(B0,0,0); WAIT_V(0); LDA(At,0,0); STAGE_X(tz,SA(1,1),A,brow+HALF,nt-1);
          BAR; WAIT_L(0); MMA(0,0,At,B0); BAR;
          LDB(B1,0,1); BAR; WAIT_L(0); MMA(0,1,At,B1); BAR;
          LDA(At,0,1); WAIT_V(4); BAR; WAIT_L(0); MMA(1,0,At,B0); MMA(1,1,At,B1); BAR; }
        { LDB(B0,1,0); LDA(At,1,0); WAIT_V(2); BAR; WAIT_L(0); MMA(0,0,At,B0); BAR;
          LDB(B1,1,1); WAIT_V(0); BAR; WAIT_L(0); MMA(0,1,At,B1); BAR;
          LDA(At,1,1); BAR; WAIT_L(0); MMA(1,0,At,B0); MMA(1,1,At,B1); BAR; }
        if (wr == 0) BAR;
        epi(acc, brow, bcol, wr, wc, fr, fq);
        __syncthreads();
    }
}

struct EpiProj {
    bf16_t* P;
    DI void operator()(const f32x4 (&acc)[2][2][4][2], int brow, int bcol, int wr, int wc, int fr, int fq) const {
#pragma unroll
        for (int ai = 0; ai < 2; ++ai)
#pragma unroll
        for (int bj = 0; bj < 2; ++bj)
#pragma unroll
        for (int m = 0; m < 4; ++m)
#pragma unroll
        for (int n = 0; n < 2; ++n)
#pragma unroll
        for (int j = 0; j < 4; ++j) {
            const int row = brow + ai * HALF + wr * 64 + m * 16 + fq * 4 + j, col = bcol + bj * HALF + wc * 32 + n * 16 + fr;
            if (col < INW) P[(size_t)row * INW + col] = f2bf(acc[ai][bj][m][n][j]);
        }
    }
};
struct EpiOut {
    float* H; const float* X;
    DI void operator()(const f32x4 (&acc)[2][2][4][2], int brow, int bcol, int wr, int wc, int fr, int fq) const {
#pragma unroll
        for (int ai = 0; ai < 2; ++ai)
#pragma unroll
        for (int bj = 0; bj < 2; ++bj)
#pragma unroll
        for (int m = 0; m < 4; ++m)
#pragma unroll
        for (int n = 0; n < 2; ++n)
#pragma unroll
        for (int j = 0; j < 4; ++j) {
            const int row = brow + ai * HALF + wr * 64 + m * 16 + fq * 4 + j, col = bcol + bj * HALF + wc * 32 + n * 16 + fr;
            const size_t o = (size_t)row * DM + col; H[o] = X[o] + acc[ai][bj][m][n][j];
        }
    }
};
struct EpiPQ {
    float* Q;
    DI void operator()(const f32x4 (&acc)[2][2][4][2], int brow, int bcol, int wr, int wc, int fr, int fq) const {
#pragma unroll
        for (int ai = 0; ai < 2; ++ai)
#pragma unroll
        for (int bj = 0; bj < 2; ++bj)
#pragma unroll
        for (int m = 0; m < 4; ++m)
#pragma unroll
        for (int n = 0; n < 2; ++n)
#pragma unroll
        for (int j = 0; j < 4; ++j) {
            const int row = brow + ai * HALF + wr * 64 + m * 16 + fq * 4 + j, col = bcol + bj * HALF + wc * 32 + n * 16 + fr;
            Q[(size_t)row * 2048 + col] = acc[ai][bj][m][n][j];
        }
    }
};

DI void phase_prologue(const Params& p) {
    const int gtid = blockIdx.x * NTHREADS + threadIdx.x, gsz = gridDim.x * NTHREADS;
    bf16_t* wint = (bf16_t*)(p.ws + OFF_WINT);
    for (int idx = gtid; idx < 4096 * 1024; idx += gsz) {
        const int k = idx >> 12, n = idx & 4095;
        const float v = n < INW ? p.w_in[(size_t)k * INW + n] : 0.f;
        wint[(size_t)n * 1024 + k] = f2bf(v);
    }
    bf16_t* woutt = (bf16_t*)(p.ws + OFF_WOUTT);
    for (int idx = gtid; idx < 1024 * 1024; idx += gsz) {
        const int k = idx >> 10, n = idx & 1023;
        woutt[(size_t)n * 1024 + k] = f2bf(p.w_out[(size_t)k * 1024 + n]);
    }
    bf16_t* wqt = (bf16_t*)(p.ws + OFF_WQT);
    for (int idx = gtid; idx < 1024 * 2048; idx += gsz) {
        const int k = idx >> 11, n = idx & 2047;
        wqt[(size_t)n * 1024 + k] = f2bf(p.wq[(size_t)k * 2048 + n]);
    }
    bf16_t* wuvt = (bf16_t*)(p.ws + OFF_WUVT);
    for (int idx = gtid; idx < 8 * 64 * 128; idx += gsz) {
        const int h = idx >> 13, e = (idx >> 7) & 63, dv = idx & 127;
        wuvt[idx] = f2bf(p.w_uv[(size_t)(h * 128 + dv) * 64 + e]);
    }
    bf16_t* skh = (bf16_t*)(p.ws + OFF_SKH); bf16_t* skl = (bf16_t*)(p.ws + OFF_SKL);
    for (int idx = gtid; idx < 2048 * 128; idx += gsz) {
        const float v = p.sk[idx]; const bf16_t hi = f2bf(v);
        skh[idx] = hi; skl[idx] = f2bf(v - bf2f(hi));
    }
    float* c128 = (float*)(p.ws + OFF_COS128); float* s128 = (float*)(p.ws + OFF_SIN128);
    for (int idx = gtid; idx < TT * 64; idx += gsz) {
        const int pos = idx >> 6, j = idx & 63;
        const float inv = powf(10000.f, -(float)j * 2.0f / 128.f);
        const float ang = (float)pos * inv;
        float s, c; sincosf(ang, &s, &c);
        c128[idx] = c; s128[idx] = s;
    }
    float* c64 = (float*)(p.ws + OFF_COS64); float* s64 = (float*)(p.ws + OFF_SIN64);
    for (int idx = gtid; idx < TT * 32; idx += gsz) {
        const int pos = idx >> 5, j = idx & 31;
        const float inv = powf(10000.f, -(float)j * 2.0f / 64.f);
        const float ang = (float)pos * inv;
        float s, c; sincosf(ang, &s, &c);
        c64[idx] = c; s64[idx] = s;
    }
    bf16_t* hn = (bf16_t*)(p.ws + OFF_HN);
    const int wave = threadIdx.x >> 6, lane = threadIdx.x & 63;
    for (int row = blockIdx.x * NWAVES + wave; row < MPAD; row += gridDim.x * NWAVES) {
        bf16_t* o = hn + (size_t)row * DM;
        if (row >= MROWS) {
            for (int i = 0; i < 4; ++i) *(uint2*)(o + i * 256 + lane * 4) = make_uint2(0u, 0u);
            continue;
        }
        const int b = row / TT, t = row % TT;
        const float* src = t < NMETA ? p.meta + (size_t)t * DM : p.x + ((size_t)b * SEQ + (t - NMETA)) * DM;
        float4 v[4]; float ss = 0.f;
#pragma unroll
        for (int i = 0; i < 4; ++i) { v[i] = *(const float4*)(src + i * 256 + lane * 4); ss += v[i].x * v[i].x + v[i].y * v[i].y + v[i].z * v[i].z + v[i].w * v[i].w; }
        ss = wave_sum(ss);
        const float rstd = rsqrtf(ss * (1.f / DM) + 1e-6f);
#pragma unroll
        for (int i = 0; i < 4; ++i) {
            const float4 g = *(const float4*)(p.norm_mix + i * 256 + lane * 4);
            uint2 w;
            w.x = (unsigned)f2bf(v[i].x * rstd * g.x) | ((unsigned)f2bf(v[i].y * rstd * g.y) << 16);
            w.y = (unsigned)f2bf(v[i].z * rstd * g.z) | ((unsigned)f2bf(v[i].w * rstd * g.w) << 16);
            *(uint2*)(o + i * 256 + lane * 4) = w;
        }
    }
}

DI void rope8(bf16_t* p1, bf16_t* p2, const float* ct, const float* st, float scale) {
    const u32x4 r1 = *(const u32x4*)p1, r2 = *(const u32x4*)p2;
    float x1[8], x2[8]; unpack8(r1, x1); unpack8(r2, x2);
    const float4 c0 = *(const float4*)ct, c1 = *(const float4*)(ct + 4), s0 = *(const float4*)st, s1 = *(const float4*)(st + 4);
    const float cs[8] = {c0.x, c0.y, c0.z, c0.w, c1.x, c1.y, c1.z, c1.w}, sn[8] = {s0.x, s0.y, s0.z, s0.w, s1.x, s1.y, s1.z, s1.w};
    u32x4 o1, o2;
#pragma unroll
    for (int i = 0; i < 4; ++i) {
        const float a0 = (x1[2 * i] * cs[2 * i] - x2[2 * i] * sn[2 * i]) * scale, a1 = (x1[2 * i + 1] * cs[2 * i + 1] - x2[2 * i + 1] * sn[2 * i + 1]) * scale;
        const float b0 = (x2[2 * i] * cs[2 * i] + x1[2 * i] * sn[2 * i]) * scale, b1 = (x2[2 * i + 1] * cs[2 * i + 1] + x1[2 * i + 1] * sn[2 * i + 1]) * scale;
        o1[i] = (unsigned)f2bf(a0) | ((unsigned)f2bf(a1) << 16); o2[i] = (unsigned)f2bf(b0) | ((unsigned)f2bf(b1) << 16);
    }
    *(u32x4*)p1 = o1; *(u32x4*)p2 = o2;
}
DI void phase_rope(const Params& p, LAS char* smem) {
    bf16_t* proj = (bf16_t*)(p.ws + OFF_BIG);
    const float* c128 = (const float*)(p.ws + OFF_COS128); const float* s128 = (const float*)(p.ws + OFF_SIN128);
    const float* c64 = (const float*)(p.ws + OFF_COS64); const float* s64 = (const float*)(p.ws + OFF_SIN64);
    const int gtid = blockIdx.x * NTHREADS + threadIdx.x, gsz = gridDim.x * NTHREADS;
    const int total = MROWS * 173;
    for (int idx = gtid; idx < total; idx += gsz) {
        const int row = idx / 173, it = idx - row * 173;
        const int t = row % TT;
        bf16_t* pr = proj + (size_t)row * INW;
        if (it < 32)       { const int hd = it >> 3, j = (it & 7) * 8;          rope8(pr + C_RQ + hd * 128 + j, pr + C_RQ + hd * 128 + 64 + j, c128 + t * 64 + j, s128 + t * 64 + j, 1.f); }
        else if (it < 64)  { const int i2 = it - 32, hd = i2 >> 3, j = (i2 & 7) * 8;  rope8(pr + C_RK + hd * 128 + j, pr + C_RK + hd * 128 + 64 + j, c128 + t * 64 + j, s128 + t * 64 + j, 0.08838834764831845f); }
        else if (it < 128) { const int i2 = it - 64, hd = i2 >> 3, j = (i2 & 7) * 8;  rope8(pr + C_DQ + hd * 128 + j, pr + C_DQ + hd * 128 + 64 + j, c128 + t * 64 + j, s128 + t * 64 + j, 0.08838834764831845f); }
        else if (it < 136) { const int j = (it - 128) * 8;                          rope8(pr + C_DK + j, pr + C_DK + 64 + j, c128 + t * 64 + j, s128 + t * 64 + j, 1.f); }
        else if (it < 168) { const int i2 = it - 136, hd = i2 >> 2, j = (i2 & 3) * 8; rope8(pr + C_IQ + hd * 64 + j, pr + C_IQ + hd * 64 + 32 + j, c64 + t * 32 + j, s64 + t * 32 + j, 0.125f); }
        else if (it < 172) { const int j = (it - 168) * 8;                          rope8(pr + C_IK + j, pr + C_IK + 32 + j, c64 + t * 32 + j, s64 + t * 32 + j, 1.f); }
        else {
            const u32x4 r = *(const u32x4*)(pr + C_IW); float v[8]; unpack8(r, v); u32x4 o;
#pragma unroll
            for (int i = 0; i < 4; ++i) o[i] = (unsigned)f2bf(v[2 * i] * 0.35355339059327373f) | ((unsigned)f2bf(v[2 * i + 1] * 0.35355339059327373f) << 16);
            *(u32x4*)(pr + C_IW) = o;
        }
    }
    bf16_t* dvt = (bf16_t*)(p.ws + OFF_DVT);
    LAS bf16_t* tile = (LAS bf16_t*)smem;
    for (int unit = blockIdx.x; unit < NB * (TTP / 64); unit += gridDim.x) {
        const int b = unit / (TTP / 64), t0 = (unit % (TTP / 64)) * 64;
        for (int i = threadIdx.x; i < 64 * 16; i += NTHREADS) {
            const int tr = i >> 4, ch = i & 15, t = t0 + tr;
            u32x4 v = {0u, 0u, 0u, 0u};
            if (t < TT) v = *(const u32x4*)(proj + (size_t)(b * TT + t) * INW + C_DV + ch * 8);
            *(LAS u32x4*)(tile + tr * 136 + ch * 8) = v;
        }
        __syncthreads();
        for (int i = threadIdx.x; i < 128 * 8; i += NTHREADS) {
            const int dv = i >> 3, ch = i & 7;
            u32x4 o;
#pragma unroll
            for (int w = 0; w < 4; ++w) o[w] = (unsigned)tile[(ch * 8 + 2 * w) * 136 + dv] | ((unsigned)tile[(ch * 8 + 2 * w + 1) * 136 + dv] << 16);
            *(u32x4*)(dvt + (size_t)(b * 128 + dv) * TTP + t0 + ch * 8) = o;
        }
        __syncthreads();
    }
}

DI void phase_ret_state(const Params& p, LAS char* smem) {
    const bf16_t* proj = (const bf16_t*)(p.ws + OFF_BIG);
    float* ST = (float*)(p.ws + OFF_ST);
    LAS bf16_t* sK = (LAS bf16_t*)smem; LAS bf16_t* sV = sK + 64 * 128;
    for (int unit = blockIdx.x; unit < 1024; unit += gridDim.x) {
        const int c = 1 + (unit & 31), bh = unit >> 5, h = bh & 3, b = bh >> 2;
        for (int i = threadIdx.x; i < 64 * 16; i += NTHREADS) {
            const int j = i >> 4, ch = i & 15; const int t = 64 * c + j - 112;
            u32x4 kv = {0u, 0u, 0u, 0u}, vv = {0u, 0u, 0u, 0u};
            if (t >= 0) { const bf16_t* pr = proj + (size_t)(b * TT + t) * INW; kv = *(const u32x4*)(pr + C_RK + h * 128 + ch * 8); vv = *(const u32x4*)(pr + C_RV + h * 128 + ch * 8); }
            *(LAS u32x4*)(sK + j * 128 + ch * 8) = kv; *(LAS u32x4*)(sV + j * 128 + ch * 8) = vv;
        }
        __syncthreads();
        const float lg = logf(1.f - exp2f(-5.f - (float)h));
        const int e = threadIdx.x >> 2, d0 = (threadIdx.x & 3) * 32;
        float acc[32];
#pragma unroll
        for (int dd = 0; dd < 32; ++dd) acc[dd] = 0.f;
        for (int j = 0; j < 64; ++j) {
            const float z = expf(lg * (float)(63 - j)) * bf2f(sV[j * 128 + e]);
#pragma unroll
            for (int d8 = 0; d8 < 4; ++d8) {
                const u32x4 raw = *(const LAS u32x4*)(sK + j * 128 + d0 + d8 * 8); float kv[8]; unpack8(raw, kv);
#pragma unroll
                for (int x = 0; x < 8; ++x) acc[d8 * 8 + x] += z * kv[x];
            }
        }
        float* st = ST + ((size_t)(bh * 34 + c) * 128 + e) * 128 + d0;
#pragma unroll
        for (int d4 = 0; d4 < 8; ++d4) *(float4*)(st + d4 * 4) = make_float4(acc[d4 * 4], acc[d4 * 4 + 1], acc[d4 * 4 + 2], acc[d4 * 4 + 3]);
        __syncthreads();
    }
}

constexpr int DSA_WAVE_LDS = 2176 * 4 + 1024 * 4 + 256 * 4 + 64;
template <bool CHECK>
DI void phase_dsa_naive(const Params& p, LAS char* smem) {
    const bf16_t* proj = (const bf16_t*)(p.ws + OFF_BIG);
    bf16_t* mixed = (bf16_t*)(p.ws + OFF_HN);
    const int wave = threadIdx.x >> 6, lane = threadIdx.x & 63;
    LAS float* sSc = (LAS float*)(smem + wave * DSA_WAVE_LDS);
    LAS float* sQ = sSc + 2176;
    LAS int* sSel = (LAS int*)(sQ + 1024);
    LAS float* sIw = (LAS float*)(sSel + 256);
    const unsigned long long lt_mask = (1ull << lane) - 1ull;
    float chk_num = 0.f, chk_den = 0.f;
    for (int q = blockIdx.x * NWAVES + wave; q < NF; q += gridDim.x * NWAVES) {
        const int b = q >> 11, s = q & 2047, t = NMETA + s;
        const int nk = 80 + 64 * (s >> 6);
        const bf16_t* prow = proj + (size_t)(b * TT + t) * INW;
        for (int i = lane; i < 512; i += 64) sQ[i] = bf2f(prow[C_IQ + i]);
        if (lane < 8) sIw[lane] = bf2f(prow[C_IW + lane]);
        lds_fence();
        const bf16_t* ikbase = proj + (size_t)(b * TT) * INW + C_IK;
        const int nj = (nk + 63) >> 6;
        for (int jj = 0; jj < nj; ++jj) {
            const int k = jj * 64 + lane;
            float sc = 0.f;
            if (k < nk) {
                const bf16_t* kr = ikbase + (size_t)k * INW;
                float a[8];
#pragma unroll
                for (int h = 0; h < 8; ++h) a[h] = 0.f;
#pragma unroll 1
                for (int d8 = 0; d8 < 8; ++d8) {
                    const u32x4 raw = *(const u32x4*)(kr + d8 * 8); float kv[8]; unpack8(raw, kv);
#pragma unroll
                    for (int h = 0; h < 8; ++h) {
                        const f32x4 q0 = *(const LAS f32x4*)(sQ + h * 64 + d8 * 8), q1 = *(const LAS f32x4*)(sQ + h * 64 + d8 * 8 + 4);
                        a[h] += kv[0] * q0[0] + kv[1] * q0[1] + kv[2] * q0[2] + kv[3] * q0[3] + kv[4] * q1[0] + kv[5] * q1[1] + kv[6] * q1[2] + kv[7] * q1[3];
                    }
                }
#pragma unroll
                for (int h = 0; h < 8; ++h) sc += fmaxf(a[h], 0.f) * sIw[h];
                sc += 0.0f;
            }
            sSc[k] = sc;
        }
        lds_fence();
        int L;
        if (nk <= 256) {
            for (int i = lane; i < nk; i += 64) sSel[i] = i;
            L = nk;
        } else {
            unsigned Tkey = 0u;
            for (int bit = 31; bit >= 0; --bit) {
                const unsigned cand = Tkey | (1u << bit);
                int cnt = 0;
                for (int jj = 0; jj < nj; ++jj) {
                    const int k = jj * 64 + lane;
                    const unsigned key = (k < nk) ? fkey(sSc[k]) : 0u;
                    cnt += __popcll(__ballot(key >= cand));
                }
                if (cnt >= 256) Tkey = cand;
            }
            int cgt = 0;
            for (int jj = 0; jj < nj; ++jj) {
                const int k = jj * 64 + lane;
                const unsigned key = (k < nk) ? fkey(sSc[k]) : 0u;
                cgt += __popcll(__ballot(key > Tkey));
            }
            const int need = 256 - cgt;
            int pos = 0, eqseen = 0;
            for (int jj = 0; jj < nj; ++jj) {
                const int k = jj * 64 + lane;
                const unsigned key = (k < nk) ? fkey(sSc[k]) : 0u;
                const bool gt = key > Tkey, eq = (key == Tkey);
                const unsigned long long eqm = __ballot(eq);
                const int myeq = eqseen + __popcll(eqm & lt_mask);
                const bool sel = gt || (eq && myeq < need);
                const unsigned long long sm = __ballot(sel);
                if (sel) sSel[pos + __popcll(sm & lt_mask)] = k;
                pos += __popcll(sm); eqseen += __popcll(eqm);
            }
            L = 256;
        }
        lds_fence();
        for (int i = lane; i < 1024; i += 64) sQ[i] = bf2f(prow[C_DQ + i]);
        lds_fence();
        float sc[8][4];
        const bf16_t* dkbase = proj + (size_t)(b * TT) * INW + C_DK;
#pragma unroll
        for (int il = 0; il < 4; ++il) {
            const int i = lane + 64 * il; const bool ok = i < L; const int key = ok ? sSel[i] : 0;
            const bf16_t* kr = dkbase + (size_t)key * INW;
            float a[8];
#pragma unroll
            for (int h = 0; h < 8; ++h) a[h] = 0.f;
#pragma unroll 1
            for (int d8 = 0; d8 < 16; ++d8) {
                const u32x4 raw = *(const u32x4*)(kr + d8 * 8); float kv[8]; unpack8(raw, kv);
#pragma unroll
                for (int h = 0; h < 8; ++h) {
                    const f32x4 q0 = *(const LAS f32x4*)(sQ + h * 128 + d8 * 8), q1 = *(const LAS f32x4*)(sQ + h * 128 + d8 * 8 + 4);
                    a[h] += kv[0] * q0[0] + kv[1] * q0[1] + kv[2] * q0[2] + kv[3] * q0[3] + kv[4] * q1[0] + kv[5] * q1[1] + kv[6] * q1[2] + kv[7] * q1[3];
                }
            }
#pragma unroll
            for (int h = 0; h < 8; ++h) sc[h][il] = ok ? a[h] : -INFINITY;
        }
#pragma unroll
        for (int h = 0; h < 8; ++h) {
            float m = fmaxf(fmaxf(sc[h][0], sc[h][1]), fmaxf(sc[h][2], sc[h][3]));
            m = wave_max(m);
            float e[4], sum = 0.f;
#pragma unroll
            for (int il = 0; il < 4; ++il) { e[il] = expf(sc[h][il] - m); sum += e[il]; }
            sum = wave_sum(sum);
            const float inv = 1.f / sum;
#pragma unroll
            for (int il = 0; il < 4; ++il) sSc[h * 256 + lane + 64 * il] = e[il] * inv;
        }
        lds_fence();
        float o[8][2];
#pragma unroll
        for (int h = 0; h < 8; ++h) { o[h][0] = 0.f; o[h][1] = 0.f; }
        const bf16_t* dvbase = proj + (size_t)(b * TT) * INW + C_DV;
        for (int i = 0; i < L; ++i) {
            const int key = sSel[i];
            const float v0 = bf2f(dvbase[(size_t)key * INW + lane]), v1 = bf2f(dvbase[(size_t)key * INW + 64 + lane]);
#pragma unroll
            for (int h = 0; h < 8; ++h) { const float pv = sSc[h * 256 + i]; o[h][0] += pv * v0; o[h][1] += pv * v1; }
        }
        lds_fence();
#pragma unroll
        for (int h = 0; h < 8; ++h) { sQ[h * 128 + lane] = o[h][0]; sQ[h * 128 + 64 + lane] = o[h][1]; }
        lds_fence();
        for (int h = 0; h < 8; ++h) {
            float acc = 0.f;
            const float* wu = p.w_uv + (size_t)h * 128 * 64 + lane;
            for (int c = 0; c < 128; ++c) acc += sQ[h * 128 + c] * wu[c * 64];
            if (CHECK) { const float got = bf2f(mixed[(size_t)q * DM + 512 + h * 64 + lane]); chk_num += (got - acc) * (got - acc); chk_den += acc * acc; }
            else mixed[(size_t)q * DM + 512 + h * 64 + lane] = f2bf(acc);
        }
        lds_fence();
    }
    if (CHECK) {
        chk_num = wave_sum(chk_num); chk_den = wave_sum(chk_den);
        if (lane == 0) { atomicAdd((float*)(p.ws + OFF_BAR) + 3600, chk_num); atomicAdd((float*)(p.ws + OFF_BAR) + 3601, chk_den); }
    }
}

typedef unsigned long long u64;
typedef short s16x4 __attribute__((ext_vector_type(4)));
constexpr int SCLD = 2116;
constexpr int DSA_MASK_OFF = 16 * SCLD * 4;
constexpr int KLD = 136, VLD = 72;
constexpr int DSA_VT_OFF = 64 * KLD * 2;
#define MFMA16(a, b, c) __builtin_amdgcn_mfma_f32_16x16x32_bf16((a), (b), (c), 0, 0, 0)
DI void phase_dsa_fast(const Params& p, LAS char* smem) {
    const bf16_t* proj = (const bf16_t*)(p.ws + OFF_BIG);
    const bf16_t* dvt = (const bf16_t*)(p.ws + OFF_DVT);
    const bf16_t* wuvt = (const bf16_t*)(p.ws + OFF_WUVT);
    bf16_t* mixed = (bf16_t*)(p.ws + OFF_HN);
    const int wave = threadIdx.x >> 6, lane = threadIdx.x & 63, c = lane & 15, g = lane >> 4;
    LAS float* SC = (LAS float*)smem; LAS u64* MASK = (LAS u64*)(smem + DSA_MASK_OFF);
    LAS bf16_t* KT = (LAS bf16_t*)smem; LAS bf16_t* VT = (LAS bf16_t*)(smem + DSA_VT_OFF);
    const u64 lt_mask = (1ull << lane) - 1ull;
    for (int pi = blockIdx.x; pi < 512; pi += gridDim.x)
    for (int which = 0; which < 2; ++which) {
        const int b = pi >> 6, qq = pi & 63, qt = which ? 127 - qq : qq;
        const int s0 = qt * 16, nk = 80 + 64 * (s0 >> 6), nkt = nk >> 4, nj = (nk + 63) >> 6;
        const bf16_t* pb = proj + (size_t)(b * TT) * INW;
        LAS char* tp_smem = smem; TP_BEGIN(1);
        {
            const bf16_t* qrow = pb + (size_t)(NMETA + s0 + c) * INW;
            bf16x8 bq[8][2]; float iw[8];
#pragma unroll
            for (int h = 0; h < 8; ++h) {
                bq[h][0] = *(const bf16x8*)(qrow + C_IQ + h * 64 + 8 * g);
                bq[h][1] = *(const bf16x8*)(qrow + C_IQ + h * 64 + 32 + 8 * g);
                iw[h] = bf2f(qrow[C_IW + h]);
            }
            bf16x8 a0n = {0, 0, 0, 0, 0, 0, 0, 0}, a1n = {0, 0, 0, 0, 0, 0, 0, 0};
            if (wave < nkt) { const bf16_t* krow = pb + (size_t)(wave * 16 + c) * INW + C_IK + 8 * g; a0n = *(const bf16x8*)(krow); a1n = *(const bf16x8*)(krow + 32); }
            for (int kt = wave; kt < nkt; kt += NWAVES) {
                const bf16x8 a0 = a0n, a1 = a1n;
                if (kt + NWAVES < nkt) { const bf16_t* krow = pb + (size_t)((kt + NWAVES) * 16 + c) * INW + C_IK + 8 * g; a0n = *(const bf16x8*)(krow); a1n = *(const bf16x8*)(krow + 32); }
                f32x4 isc = {0.f, 0.f, 0.f, 0.f};
#pragma unroll
                for (int h = 0; h < 8; ++h) {
                    f32x4 acc = {0.f, 0.f, 0.f, 0.f};
                    acc = MFMA16(a0, bq[h][0], acc); acc = MFMA16(a1, bq[h][1], acc);
#pragma unroll
                    for (int j = 0; j < 4; ++j) isc[j] += fmaxf(acc[j], 0.f) * iw[h];
                }
#pragma unroll
                for (int j = 0; j < 4; ++j) isc[j] += 0.0f;
                *(LAS f32x4*)(SC + c * SCLD + kt * 16 + 4 * g) = isc;
            }
        }
        __syncthreads(); TP_END(1); TP_BEGIN(2);
#pragma unroll 1
        for (int qi = 0; qi < 2; ++qi) {
            const int cq = wave * 2 + qi;
            unsigned kv[33];
#pragma unroll
            for (int jj = 0; jj < 33; ++jj) { const int k = jj * 64 + lane; const float v = SC[cq * SCLD + k]; kv[jj] = (k < nk) ? fkey(v) : 0u; }
            unsigned Tkey = 0u;
            if (nk > 256) {
#pragma unroll 1
                for (int bit = 31; bit >= 0; --bit) {
                    const unsigned cand = Tkey | (1u << bit);
                    int cnt = 0;
#pragma unroll
                    for (int jj = 0; jj < 33; ++jj) cnt += __popcll(__ballot(kv[jj] >= cand));
                    if (cnt >= 256) Tkey = cand;
                    if (cnt == 256) break;
                }
            } else Tkey = 1u;
            int cgt = 0;
#pragma unroll
            for (int jj = 0; jj < 33; ++jj) cgt += __popcll(__ballot(kv[jj] > Tkey));
            const int need = (nk > 256) ? 256 - cgt : 4096;
            int eqseen = 0;
#pragma unroll
            for (int jj = 0; jj < 33; ++jj) {
                const bool gt = kv[jj] > Tkey, eq = (kv[jj] == Tkey);
                const u64 eqm = __ballot(eq);
                const int myeq = eqseen + __popcll(eqm & lt_mask);
                const u64 sm = __ballot(gt || (eq && myeq < need));
                eqseen += __popcll(eqm);
                if (lane == 0) MASK[cq * 34 + jj] = sm;
            }
        }
        __syncthreads(); TP_END(2); TP_BEGIN(3);
        {
            const int h = wave;
            const bf16_t* qrow = pb + (size_t)(NMETA + s0 + c) * INW + C_DQ + h * 128 + 8 * g;
            bf16x8 bQ[4];
#pragma unroll
            for (int ks = 0; ks < 4; ++ks) bQ[ks] = *(const bf16x8*)(qrow + ks * 32);
            f32x4 O[8];
#pragma unroll
            for (int mb = 0; mb < 8; ++mb) O[mb] = (f32x4){0.f, 0.f, 0.f, 0.f};
            float m_run = -1e30f, l_run = 0.f;
            const int krow_t = threadIdx.x >> 4, kch_t = threadIdx.x & 15, vdv_t = threadIdx.x >> 3, vch_t = threadIdx.x & 7;
            const bf16_t* vsrc = dvt + (size_t)(b * 128 + vdv_t) * TTP + vch_t * 8;
            u32x4 pk0, pk1, pv0, pv1;
            {
                int k0 = krow_t, k1 = 32 + krow_t; k0 = k0 < nk ? k0 : nk - 1; k1 = k1 < nk ? k1 : nk - 1;
                pk0 = *(const u32x4*)(pb + (size_t)k0 * INW + C_DK + kch_t * 8); pk1 = *(const u32x4*)(pb + (size_t)k1 * INW + C_DK + kch_t * 8);
                pv0 = *(const u32x4*)(vsrc); pv1 = *(const u32x4*)(vsrc + (size_t)64 * TTP);
            }
#pragma unroll 1
            for (int kb = 0; kb < nj; ++kb) {
                *(LAS u32x4*)(KT + krow_t * KLD + kch_t * 8) = pk0; *(LAS u32x4*)(KT + (32 + krow_t) * KLD + kch_t * 8) = pk1;
                *(LAS u32x4*)(VT + vdv_t * VLD + vch_t * 8) = pv0; *(LAS u32x4*)(VT + (64 + vdv_t) * VLD + vch_t * 8) = pv1;
                __syncthreads();
                if (kb + 1 < nj) {
                    int k0 = (kb + 1) * 64 + krow_t, k1 = k0 + 32; k0 = k0 < nk ? k0 : nk - 1; k1 = k1 < nk ? k1 : nk - 1;
                    pk0 = *(const u32x4*)(pb + (size_t)k0 * INW + C_DK + kch_t * 8); pk1 = *(const u32x4*)(pb + (size_t)k1 * INW + C_DK + kch_t * 8);
                    pv0 = *(const u32x4*)(vsrc + (kb + 1) * 64); pv1 = *(const u32x4*)(vsrc + (size_t)64 * TTP + (kb + 1) * 64);
                }
                const u64 mw = MASK[c * 34 + kb];
                f32x4 S[4];
#pragma unroll
                for (int ct = 0; ct < 4; ++ct) {
                    f32x4 acc = {0.f, 0.f, 0.f, 0.f};
#pragma unroll
                    for (int ks = 0; ks < 4; ++ks) {
                        const bf16x8 a = *(const LAS bf16x8*)(KT + (ct * 16 + c) * KLD + ks * 32 + 8 * g);
                        acc = MFMA16(a, bQ[ks], acc);
                    }
                    S[ct] = acc;
                }
                float mblk = -1e30f;
#pragma unroll
                for (int ct = 0; ct < 4; ++ct)
#pragma unroll
                    for (int j = 0; j < 4; ++j) {
                        const bool on = ((mw >> (ct * 16 + 4 * g + j)) & 1ull) != 0ull;
                        S[ct][j] = on ? S[ct][j] : -1e30f;
                        mblk = fmaxf(mblk, S[ct][j]);
                    }
                mblk = fmaxf(mblk, __shfl_xor(mblk, 16)); mblk = fmaxf(mblk, __shfl_xor(mblk, 32));
                const float m_new = fmaxf(m_run, mblk);
                const float alpha = __expf(m_run - m_new);
                float ps = 0.f;
#pragma unroll
                for (int ct = 0; ct < 4; ++ct)
#pragma unroll
                    for (int j = 0; j < 4; ++j) { const float pv = (S[ct][j] > -1e29f) ? __expf(S[ct][j] - m_new) : 0.f; S[ct][j] = pv; ps += pv; }
                l_run = l_run * alpha + ps; m_run = m_new;
#pragma unroll
                for (int mb = 0; mb < 8; ++mb) O[mb] *= alpha;
                bf16x8 bP[2];
#pragma unroll
                for (int kk = 0; kk < 2; ++kk)
#pragma unroll
                    for (int j = 0; j < 4; ++j) { bP[kk][j] = (short)f2bf(S[2 * kk][j]); bP[kk][4 + j] = (short)f2bf(S[2 * kk + 1][j]); }
#pragma unroll
                for (int mb = 0; mb < 8; ++mb)
#pragma unroll
                    for (int kk = 0; kk < 2; ++kk) {
                        const LAS bf16_t* vr = VT + (mb * 16 + c) * VLD + kk * 32 + 4 * g;
                        const s16x4 lo = *(const LAS s16x4*)(vr), hi = *(const LAS s16x4*)(vr + 16);
                        const bf16x8 a = __builtin_shufflevector(lo, hi, 0, 1, 2, 3, 4, 5, 6, 7);
                        O[mb] = MFMA16(a, bP[kk], O[mb]);
                    }
                __syncthreads();
            }
            TP_END(3); TP_BEGIN(4);
            l_run += __shfl_xor(l_run, 16); l_run += __shfl_xor(l_run, 32);
            const float inv = 1.f / l_run;
            bf16x8 bO[4];
#pragma unroll
            for (int k2 = 0; k2 < 4; ++k2)
#pragma unroll
                for (int j = 0; j < 4; ++j) { bO[k2][j] = (short)f2bf(O[2 * k2][j] * inv); bO[k2][4 + j] = (short)f2bf(O[2 * k2 + 1][j] * inv); }
            bf16_t* orow = mixed + (size_t)(b * SEQ + s0 + c) * DM + 512 + h * 64;
            int zofs = 0; asm volatile("" : "+v"(zofs));
#pragma unroll
            for (int eb = 0; eb < 4; ++eb) {
                f32x4 acc = {0.f, 0.f, 0.f, 0.f};
#pragma unroll
                for (int k2 = 0; k2 < 4; ++k2) {
                    const bf16_t* wr = wuvt + (size_t)(h * 64 + eb * 16 + c) * 128 + k2 * 32 + 4 * g + zofs;
                    const s16x4 lo = *(const s16x4*)(wr), hi = *(const s16x4*)(wr + 16);
                    const bf16x8 a = __builtin_shufflevector(lo, hi, 0, 1, 2, 3, 4, 5, 6, 7);
                    acc = MFMA16(a, bO[k2], acc);
                }
                uint2 w;
                w.x = (unsigned)f2bf(acc[0]) | ((unsigned)f2bf(acc[1]) << 16);
                w.y = (unsigned)f2bf(acc[2]) | ((unsigned)f2bf(acc[3]) << 16);
                *(uint2*)(orow + eb * 16 + 4 * g) = w;
            }
            TP_END(4);
        }
    }
}

DI void phase_ret_scan(const Params& p) {
    float* ST = (float*)(p.ws + OFF_ST);
    const int gtid = blockIdx.x * NTHREADS + threadIdx.x, gsz = gridDim.x * NTHREADS;
    for (int idx = gtid; idx < 32 * 16384; idx += gsz) {
        const int bh = idx >> 14, el = idx & 16383, h = bh & 3;
        const float gc = expf(logf(1.f - exp2f(-5.f - (float)h)) * 64.f);
        float* base = ST + (size_t)bh * 34 * 16384 + el;
        float r = 0.f;
        for (int c = 1; c < 34; ++c) {
            const float u = c < 33 ? base[(size_t)c * 16384] : 0.f;
            base[(size_t)c * 16384] = r;
            r = gc * r + u;
        }
    }
}

DI void phase_ret_out(const Params& p, LAS char* smem) {
    const bf16_t* proj = (const bf16_t*)(p.ws + OFF_BIG);
    const float* ST = (const float*)(p.ws + OFF_ST);
    bf16_t* mixed = (bf16_t*)(p.ws + OFF_HN);
    LAS bf16_t* sQ = (LAS bf16_t*)smem; LAS bf16_t* sK = sQ + 64 * 128; LAS bf16_t* sV = sK + 64 * 128;
    LAS float* sS = (LAS float*)(sV + 64 * 128);
    LAS float* sR = sS + 64 * 65;
    for (int unit = blockIdx.x; unit < 1024; unit += gridDim.x) {
        const int c = 2 + (unit & 31), bh = unit >> 5, h = bh & 3, b = bh >> 2;
        for (int i = threadIdx.x; i < 64 * 16; i += NTHREADS) {
            const int j = i >> 4, ch = i & 15; const int t = 64 * c + j - 112;
            const bf16_t* pr = proj + (size_t)(b * TT + t) * INW;
            *(LAS u32x4*)(sQ + j * 128 + ch * 8) = *(const u32x4*)(pr + C_RQ + h * 128 + ch * 8);
            *(LAS u32x4*)(sK + j * 128 + ch * 8) = *(const u32x4*)(pr + C_RK + h * 128 + ch * 8);
            *(LAS u32x4*)(sV + j * 128 + ch * 8) = *(const u32x4*)(pr + C_RV + h * 128 + ch * 8);
        }
        const float* R = ST + (size_t)(bh * 34 + c) * 16384;
        for (int i = threadIdx.x; i < 16384; i += NTHREADS) sR[(i >> 7) * 129 + (i & 127)] = R[i];
        __syncthreads();
        const float lg = logf(1.f - exp2f(-5.f - (float)h));
        const int i = threadIdx.x >> 3, g8 = threadIdx.x & 7;
        {
            float sacc[8];
#pragma unroll
            for (int jj = 0; jj < 8; ++jj) sacc[jj] = 0.f;
            for (int d = 0; d < 128; ++d) {
                const float qv = bf2f(sQ[i * 128 + d]);
#pragma unroll
                for (int jj = 0; jj < 8; ++jj) sacc[jj] += qv * bf2f(sK[(jj * 8 + g8) * 128 + d]);
            }
#pragma unroll
            for (int jj = 0; jj < 8; ++jj) { const int j = jj * 8 + g8; const int df = i > j ? i - j : j - i; sS[i * 65 + j] = sacc[jj] * expf(lg * (float)df); }
        }
        __syncthreads();
        float o[16];
#pragma unroll
        for (int ee = 0; ee < 16; ++ee) o[ee] = 0.f;
        for (int j = 0; j < 64; ++j) {
            const float sv = sS[i * 65 + j];
#pragma unroll
            for (int ee = 0; ee < 16; ++ee) o[ee] += sv * bf2f(sV[j * 128 + ee * 8 + g8]);
        }
        const float xi = expf(lg * (float)(i + 1));
        for (int d = 0; d < 128; ++d) {
            const float qv = bf2f(sQ[i * 128 + d]) * xi;
#pragma unroll
            for (int ee = 0; ee < 16; ++ee) o[ee] += qv * sR[(ee * 8 + g8) * 129 + d];
        }
        float sum = 0.f;
#pragma unroll
        for (int ee = 0; ee < 16; ++ee) sum += o[ee];
        sum += __shfl_xor(sum, 1); sum += __shfl_xor(sum, 2); sum += __shfl_xor(sum, 4);
        const float mu = sum * (1.f / 128.f);
        float var = 0.f;
#pragma unroll
        for (int ee = 0; ee < 16; ++ee) { const float dlt = o[ee] - mu; var += dlt * dlt; }
        var += __shfl_xor(var, 1); var += __shfl_xor(var, 2); var += __shfl_xor(var, 4);
        const float rs = rsqrtf(var * (1.f / 128.f) + 1e-6f);
        const int t = 64 * c + i - 112, srow = t - NMETA;
        const bf16_t* pg = proj + (size_t)(b * TT + t) * INW + C_RG + h * 128;
        bf16_t* po = mixed + (size_t)(b * SEQ + srow) * DM + h * 128;
#pragma unroll
        for (int ee = 0; ee < 16; ++ee) {
            const int e = ee * 8 + g8;
            const float g = bf2f(pg[e]);
            const float gate = g / (1.f + expf(-g));
            po[e] = f2bf(gate * (o[ee] - mu) * rs);
        }
        __syncthreads();
    }
}

#define MFMA32(a, b, c) __builtin_amdgcn_mfma_f32_32x32x16_bf16((a), (b), (c), 0, 0, 0)
constexpr int RLD = 136, RTLD = 72;
DI void phase_ret_state_mfma(const Params& p, LAS char* smem) {
    const bf16_t* proj = (const bf16_t*)(p.ws + OFF_BIG);
    float* ST = (float*)(p.ws + OFF_ST);
    LAS bf16_t* sVT = (LAS bf16_t*)smem; LAS bf16_t* sKT = sVT + 128 * RTLD;
    const int wave = threadIdx.x >> 6, lane = threadIdx.x & 63, r = lane & 31, hh = lane >> 5;
    for (int unit = blockIdx.x; unit < 1024; unit += gridDim.x) {
        const int c = 1 + (unit & 31), bh = unit >> 5, h = bh & 3, b = bh >> 2;
        const float lg = logf(1.f - exp2f(-5.f - (float)h));
        {
            const int j = threadIdx.x >> 3, ch = threadIdx.x & 7, t = 64 * c + j - 112;
            const float z = expf(lg * (float)(63 - j));
#pragma unroll
            for (int q = 0; q < 2; ++q) {
                const int cc = ch + 8 * q;
                u32x4 kv = {0u, 0u, 0u, 0u}, vv = {0u, 0u, 0u, 0u};
                if (t >= 0) { const bf16_t* pr = proj + (size_t)(b * TT + t) * INW; kv = *(const u32x4*)(pr + C_RK + h * 128 + cc * 8); vv = *(const u32x4*)(pr + C_RV + h * 128 + cc * 8); }
                float vf[8]; unpack8(vv, vf);
#pragma unroll
                for (int x = 0; x < 8; ++x) {
                    sKT[(cc * 8 + x) * RTLD + j] = (bf16_t)((kv[x >> 1] >> ((x & 1) * 16)) & 0xffffu);
                    sVT[(cc * 8 + x) * RTLD + j] = f2bf(vf[x] * z);
                }
            }
        }
        __syncthreads();
        const int mb = wave >> 1;
#pragma unroll
        for (int q = 0; q < 2; ++q) {
            const int nb = (wave & 1) * 2 + q;
            f32x16 acc;
#pragma unroll
            for (int i = 0; i < 16; ++i) acc[i] = 0.f;
#pragma unroll
            for (int ks = 0; ks < 4; ++ks) {
                const bf16x8 a = *(const LAS bf16x8*)(sVT + (mb * 32 + r) * RTLD + ks * 16 + 8 * hh);
                const bf16x8 bb = *(const LAS bf16x8*)(sKT + (nb * 32 + r) * RTLD + ks * 16 + 8 * hh);
                acc = MFMA32(a, bb, acc);
            }
            float* st = ST + (size_t)(bh * 34 + c) * 16384 + nb * 32 + r;
#pragma unroll
            for (int i = 0; i < 16; ++i) st[(size_t)(mb * 32 + (i & 3) + 8 * (i >> 2) + 4 * hh) * 128] = acc[i];
        }
        __syncthreads();
    }
}
DI void phase_ret_out_mfma(const Params& p, LAS char* smem) {
    const bf16_t* proj = (const bf16_t*)(p.ws + OFF_BIG);
    const float* ST = (const float*)(p.ws + OFF_ST);
    bf16_t* mixed = (bf16_t*)(p.ws + OFF_HN);
    LAS bf16_t* sQ = (LAS bf16_t*)smem; LAS bf16_t* sK = sQ + 64 * RLD; LAS bf16_t* sVT = sK + 64 * RLD;
    LAS float* sGN = (LAS float*)(sVT + 128 * RTLD);
    const int wave = threadIdx.x >> 6, lane = threadIdx.x & 63, r = lane & 31, hh = lane >> 5;
    const int ib = wave & 1, eb = wave >> 1;
    for (int unit = blockIdx.x; unit < 1024; unit += gridDim.x) {
        const int c = 2 + (unit & 31), bh = unit >> 5, h = bh & 3, b = bh >> 2;
        const float lg = logf(1.f - exp2f(-5.f - (float)h));
        for (int i = threadIdx.x; i < 64 * 16; i += NTHREADS) {
            const int j = i >> 4, ch = i & 15; const int t = 64 * c + j - 112;
            const bf16_t* pr = proj + (size_t)(b * TT + t) * INW;
            *(LAS u32x4*)(sQ + j * RLD + ch * 8) = *(const u32x4*)(pr + C_RQ + h * 128 + ch * 8);
            *(LAS u32x4*)(sK + j * RLD + ch * 8) = *(const u32x4*)(pr + C_RK + h * 128 + ch * 8);
            const u32x4 vv = *(const u32x4*)(pr + C_RV + h * 128 + ch * 8);
#pragma unroll
            for (int x = 0; x < 8; ++x) sVT[(ch * 8 + x) * RTLD + j] = (bf16_t)((vv[x >> 1] >> ((x & 1) * 16)) & 0xffffu);
        }
        __syncthreads();
        f32x16 acc;
#pragma unroll
        for (int i = 0; i < 16; ++i) acc[i] = 0.f;
        {
            const float* R = ST + (size_t)(bh * 34 + c) * 16384 + (size_t)(eb * 32 + r) * 128 + 8 * hh;
#pragma unroll
            for (int ks = 0; ks < 8; ++ks) {
                const float4 r0 = *(const float4*)(R + ks * 16), r1 = *(const float4*)(R + ks * 16 + 4);
                const float rf[8] = {r0.x, r0.y, r0.z, r0.w, r1.x, r1.y, r1.z, r1.w};
                const bf16x8 a = pack8(rf);
                const bf16x8 bq = *(const LAS bf16x8*)(sQ + (ib * 32 + r) * RLD + ks * 16 + 8 * hh);
                acc = MFMA32(a, bq, acc);
            }
            const float xi = expf(lg * (float)(ib * 32 + r + 1));
#pragma unroll
            for (int i = 0; i < 16; ++i) acc[i] *= xi;
        }
#pragma unroll
        for (int jb = 0; jb < 2; ++jb) {
            f32x16 st;
#pragma unroll
            for (int i = 0; i < 16; ++i) st[i] = 0.f;
#pragma unroll
            for (int ks = 0; ks < 8; ++ks) {
                const bf16x8 a = *(const LAS bf16x8*)(sK + (jb * 32 + r) * RLD + ks * 16 + 8 * hh);
                const bf16x8 bq = *(const LAS bf16x8*)(sQ + (ib * 32 + r) * RLD + ks * 16 + 8 * hh);
                st = MFMA32(a, bq, st);
            }
            const int icol = ib * 32 + r;
#pragma unroll
            for (int i = 0; i < 16; ++i) {
                const int j = jb * 32 + (i & 3) + 8 * (i >> 2) + 4 * hh; const int df = icol > j ? icol - j : j - icol;
                st[i] *= expf(lg * (float)df);
            }
#pragma unroll
            for (int s2 = 0; s2 < 2; ++s2) {
                bf16x8 bp;
#pragma unroll
                for (int x = 0; x < 8; ++x) bp[x] = (short)f2bf(st[8 * s2 + x]);
                const LAS bf16_t* vr = sVT + (eb * 32 + r) * RTLD + jb * 32 + 16 * s2 + 4 * hh;
                const s16x4 lo = *(const LAS s16x4*)(vr), hi = *(const LAS s16x4*)(vr + 8);
                const bf16x8 a = __builtin_shufflevector(lo, hi, 0, 1, 2, 3, 4, 5, 6, 7);
                acc = MFMA32(a, bp, acc);
            }
        }
        float s1 = 0.f, s2 = 0.f;
#pragma unroll
        for (int i = 0; i < 16; ++i) { s1 += acc[i]; s2 += acc[i] * acc[i]; }
        s1 += __shfl_xor(s1, 32); s2 += __shfl_xor(s2, 32);
        if (hh == 0) { sGN[(eb * 64 + ib * 32 + r) * 2] = s1; sGN[(eb * 64 + ib * 32 + r) * 2 + 1] = s2; }
        __syncthreads();
        float S1 = 0.f, S2 = 0.f;
#pragma unroll
        for (int e4 = 0; e4 < 4; ++e4) { S1 += sGN[(e4 * 64 + ib * 32 + r) * 2]; S2 += sGN[(e4 * 64 + ib * 32 + r) * 2 + 1]; }
        const float mu = S1 * (1.f / 128.f), var = fmaxf(S2 * (1.f / 128.f) - mu * mu, 0.f), rs = rsqrtf(var + 1e-6f);
        const int t = 64 * c + ib * 32 + r - 112, srow = t - NMETA;
        const bf16_t* pg = proj + (size_t)(b * TT + t) * INW + C_RG + h * 128 + eb * 32 + 4 * hh;
        bf16_t* po = mixed + (size_t)(b * SEQ + srow) * DM + h * 128 + eb * 32 + 4 * hh;
#pragma unroll
        for (int g4 = 0; g4 < 4; ++g4) {
            const uint2 graw = *(const uint2*)(pg + 8 * g4);
            const float gv[4] = {__uint_as_float(graw.x << 16), __uint_as_float(graw.x & 0xffff0000u), __uint_as_float(graw.y << 16), __uint_as_float(graw.y & 0xffff0000u)};
            float o[4];
#pragma unroll
            for (int x = 0; x < 4; ++x) { const float gate = gv[x] / (1.f + expf(-gv[x])); o[x] = gate * (acc[4 * g4 + x] - mu) * rs; }
            uint2 w; w.x = (unsigned)f2bf(o[0]) | ((unsigned)f2bf(o[1]) << 16); w.y = (unsigned)f2bf(o[2]) | ((unsigned)f2bf(o[3]) << 16);
            *(uint2*)(po + 8 * g4) = w;
        }
        __syncthreads();
    }
}

DI void phase_norm2(const Params& p) {
    bf16_t* hn2 = (bf16_t*)(p.ws + OFF_HN);
    const int wave = threadIdx.x >> 6, lane = threadIdx.x & 63;
    for (int row = blockIdx.x * NWAVES + wave; row < NF; row += gridDim.x * NWAVES) {
        const float* src = p.out + (size_t)row * DM; bf16_t* o = hn2 + (size_t)row * DM;
        float4 v[4]; float ss = 0.f;
#pragma unroll
        for (int i = 0; i < 4; ++i) { v[i] = *(const float4*)(src + i * 256 + lane * 4); ss += v[i].x * v[i].x + v[i].y * v[i].y + v[i].z * v[i].z + v[i].w * v[i].w; }
        ss = wave_sum(ss);
        const float rstd = rsqrtf(ss * (1.f / DM) + 1e-6f);
#pragma unroll
        for (int i = 0; i < 4; ++i) {
            const float4 g = *(const float4*)(p.norm_ffn + i * 256 + lane * 4);
            uint2 w;
            w.x = (unsigned)f2bf(v[i].x * rstd * g.x) | ((unsigned)f2bf(v[i].y * rstd * g.y) << 16);
            w.y = (unsigned)f2bf(v[i].z * rstd * g.z) | ((unsigned)f2bf(v[i].w * rstd * g.w) << 16);
            *(uint2*)(o + i * 256 + lane * 4) = w;
        }
    }
}

constexpr int PSEL_WAVE_LDS = 32 * 2 * 16 * 8 + 32 * 16 * 8;
DI void phase_peer_select(const Params& p, LAS char* smem) {
    const float* PQ = (const float*)(p.ws + OFF_BIG);
    const bf16_t* SKH = (const bf16_t*)(p.ws + OFF_SKH); const bf16_t* SKL = (const bf16_t*)(p.ws + OFF_SKL);
    int* EIDX = (int*)(p.ws + OFF_EIDX); float* GATE = (float*)(p.ws + OFF_GATE);
    const int wave = threadIdx.x >> 6, lane = threadIdx.x & 63, r = lane & 31, hh = lane >> 5;
    LAS float* lv = (LAS float*)(smem + wave * PSEL_WAVE_LDS);
    LAS int* li = (LAS int*)(lv + 32 * 2 * 16);
    LAS float* cs = (LAS float*)(li + 32 * 2 * 16);
    LAS int* cab = (LAS int*)(cs + 32 * 16);
    for (int task = blockIdx.x * NWAVES + wave; task < (NF / 32) * 8; task += gridDim.x * NWAVES) {
        const int tile = task >> 3, h = task & 7;
        const int n = tile * 32 + r;
        for (int half = 0; half < 2; ++half) {
            f32x16 acc[4];
#pragma unroll
            for (int mb = 0; mb < 4; ++mb)
#pragma unroll
                for (int i = 0; i < 16; ++i) acc[mb][i] = 0.f;
            const float* qrow = PQ + (size_t)n * 2048 + h * 256 + half * 128 + 8 * hh;
            const bf16_t* kh = SKH + (size_t)((h * 2 + half) * 128 + r) * 128 + 8 * hh;
            const bf16_t* kl = SKL + (size_t)((h * 2 + half) * 128 + r) * 128 + 8 * hh;
#pragma unroll 2
            for (int ks = 0; ks < 8; ++ks) {
                const float4 q0 = *(const float4*)(qrow + ks * 16), q1 = *(const float4*)(qrow + ks * 16 + 4);
                float qf[8] = {q0.x, q0.y, q0.z, q0.w, q1.x, q1.y, q1.z, q1.w}, qr[8];
                const bf16x8 bh = pack_hi8(qf, qr); const bf16x8 bl = pack8(qr);
#pragma unroll
                for (int mb = 0; mb < 4; ++mb) {
                    const bf16x8 ah = *(const bf16x8*)(kh + (size_t)mb * 32 * 128 + ks * 16);
                    const bf16x8 al = *(const bf16x8*)(kl + (size_t)mb * 32 * 128 + ks * 16);
                    acc[mb] = __builtin_amdgcn_mfma_f32_32x32x16_bf16(ah, bh, acc[mb], 0, 0, 0);
                    acc[mb] = __builtin_amdgcn_mfma_f32_32x32x16_bf16(ah, bl, acc[mb], 0, 0, 0);
                    acc[mb] = __builtin_amdgcn_mfma_f32_32x32x16_bf16(al, bh, acc[mb], 0, 0, 0);
                }
            }
            float mprev = INFINITY;
#pragma unroll 1
            for (int it = 0; it < 16; ++it) {
                float m = -INFINITY;
#pragma unroll
                for (int mb = 0; mb < 4; ++mb)
#pragma unroll
                    for (int i = 0; i < 16; ++i) { const float v = acc[mb][i]; m = fmaxf(m, v < mprev ? v : -INFINITY); }
                m = fmaxf(m, __shfl_xor(m, 32));
                mprev = m;
            }
            const float T = mprev;
            int cnt = 0;
#pragma unroll
            for (int mb = 0; mb < 4; ++mb)
#pragma unroll
                for (int i = 0; i < 16; ++i) cnt += (acc[mb][i] >= T) ? 1 : 0;
            const int pc = __shfl_xor(cnt, 32);
            int pos = hh ? pc : 0;
            LAS float* lvp = lv + (r * 2 + half) * 16; LAS int* lip = li + (r * 2 + half) * 16;
#pragma unroll
            for (int mb = 0; mb < 4; ++mb)
#pragma unroll
                for (int i = 0; i < 16; ++i) {
                    const float v = acc[mb][i];
                    if (v >= T) { if (pos < 16) { lvp[pos] = v; lip[pos] = mb * 32 + (i & 3) + 8 * (i >> 2) + 4 * hh; } ++pos; }
                }
        }
        lds_fence();
        float v1[8], v2[16];
#pragma unroll
        for (int a = 0; a < 8; ++a) v1[a] = lv[(r * 2 + 0) * 16 + 8 * hh + a];
#pragma unroll
        for (int b = 0; b < 16; ++b) v2[b] = lv[(r * 2 + 1) * 16 + b];
        float mprev = INFINITY;
#pragma unroll 1
        for (int it = 0; it < 16; ++it) {
            float m = -INFINITY;
#pragma unroll
            for (int a = 0; a < 8; ++a)
#pragma unroll
                for (int b = 0; b < 16; ++b) { const float v = v1[a] + v2[b]; m = fmaxf(m, v < mprev ? v : -INFINITY); }
            m = fmaxf(m, __shfl_xor(m, 32));
            mprev = m;
        }
        const float Tc = mprev;
        int cnt = 0;
#pragma unroll
        for (int a = 0; a < 8; ++a)
#pragma unroll
            for (int b = 0; b < 16; ++b) cnt += (v1[a] + v2[b] >= Tc) ? 1 : 0;
        const int pc = __shfl_xor(cnt, 32);
        int pos = hh ? pc : 0;
#pragma unroll
        for (int a = 0; a < 8; ++a)
#pragma unroll
            for (int b = 0; b < 16; ++b) {
                const float v = v1[a] + v2[b];
                if (v >= Tc) { if (pos < 16) { cs[r * 16 + pos] = v; cab[r * 16 + pos] = (8 * hh + a) * 16 + b; } ++pos; }
            }
        lds_fence();
        float scv[16]; float mx = -INFINITY;
#pragma unroll
        for (int i = 0; i < 16; ++i) { scv[i] = cs[r * 16 + i]; mx = fmaxf(mx, scv[i]); }
        float sum = 0.f;
#pragma unroll
        for (int i = 0; i < 16; ++i) { scv[i] = expf(scv[i] - mx); sum += scv[i]; }
        const float inv = 1.f / sum;
#pragma unroll
        for (int i = 0; i < 16; ++i) {
            if ((i >> 3) == hh) {
                const int ab = cab[r * 16 + i];
                const int e = li[(r * 2 + 0) * 16 + (ab >> 4)] * 128 + li[(r * 2 + 1) * 16 + (ab & 15)];
                EIDX[(size_t)n * 128 + h * 16 + i] = e;
                GATE[(size_t)n * 128 + h * 16 + i] = scv[i] * inv;
            }
        }
        lds_fence();
    }
}

typedef float f32x2 __attribute__((ext_vector_type(2)));
DI void phase_convert_tables(const Params& p) {
    const int wave = threadIdx.x >> 6, lane = threadIdx.x & 63;
    for (int rowi = blockIdx.x * NWAVES + wave; rowi < 2 * 16384; rowi += gridDim.x * NWAVES) {
        const bool isv = rowi >= 16384; const int e = isv ? rowi - 16384 : rowi;
        const float* src = (isv ? p.pv : p.pu) + (size_t)e * DM + lane * 16;
        float x[16]; float mx = 0.f;
#pragma unroll
        for (int i = 0; i < 4; ++i) { const float4 a = *(const float4*)(src + i * 4); x[i * 4] = a.x; x[i * 4 + 1] = a.y; x[i * 4 + 2] = a.z; x[i * 4 + 3] = a.w; }
#pragma unroll
        for (int i = 0; i < 16; ++i) mx = fmaxf(mx, fabsf(x[i]));
        mx = wave_max(mx);
        const float inv = mx > 0.f ? 240.f / mx : 0.f, scale = mx > 0.f ? mx * (1.f / 240.f) : 0.f;
        u32x4 o;
#pragma unroll
        for (int w = 0; w < 4; ++w) {
            int pk = 0;
            pk = __builtin_amdgcn_cvt_pk_fp8_f32(x[w * 4] * inv, x[w * 4 + 1] * inv, pk, false);
            pk = __builtin_amdgcn_cvt_pk_fp8_f32(x[w * 4 + 2] * inv, x[w * 4 + 3] * inv, pk, true);
            o[w] = (unsigned)pk;
        }
        *(u32x4*)(p.ws + (isv ? OFF_V8 : OFF_U8) + (size_t)e * DM + lane * 16) = o;
        if (lane == 0) ((float*)(p.ws + (isv ? OFF_SV : OFF_SU)))[e] = scale;
    }
}
DI void unpack16_fp8(const u32x4& r, float (&v)[16]) {
#pragma unroll
    for (int w = 0; w < 4; ++w) {
        const f32x2 a = __builtin_amdgcn_cvt_pk_f32_fp8((int)r[w], false), b = __builtin_amdgcn_cvt_pk_f32_fp8((int)r[w], true);
        v[w * 4] = a[0]; v[w * 4 + 1] = a[1]; v[w * 4 + 2] = b[0]; v[w * 4 + 3] = b[1];
    }
}
DI float dpp_row_sum(float v) {
    v += __int_as_float(__builtin_amdgcn_update_dpp(0, __float_as_int(v), 0xB1, 0xF, 0xF, true));
    v += __int_as_float(__builtin_amdgcn_update_dpp(0, __float_as_int(v), 0x4E, 0xF, 0xF, true));
    v += __int_as_float(__builtin_amdgcn_update_dpp(0, __float_as_int(v), 0x141, 0xF, 0xF, true));
    v += __int_as_float(__builtin_amdgcn_update_dpp(0, __float_as_int(v), 0x140, 0xF, 0xF, true));
    return v;
}
DI float wave_sum_uniform(float v) {
    v = dpp_row_sum(v);
    const float a = __int_as_float(__builtin_amdgcn_readlane(__float_as_int(v), 0)), b = __int_as_float(__builtin_amdgcn_readlane(__float_as_int(v), 16));
    const float c = __int_as_float(__builtin_amdgcn_readlane(__float_as_int(v), 32)), d = __int_as_float(__builtin_amdgcn_readlane(__float_as_int(v), 48));
    return (a + b) + (c + d);
}

#ifndef P10_REP
#define P10_REP 1
#endif
DI void phase_peer_out(const Params& p) {
    const int* EIDX = (const int*)(p.ws + OFF_EIDX); const float* GATE = (const float*)(p.ws + OFF_GATE);
    const char* U8 = p.ws + OFF_U8; const char* V8 = p.ws + OFF_V8;
    const float* SU = (const float*)(p.ws + OFF_SU); const float* SV = (const float*)(p.ws + OFF_SV);
    const int wave = threadIdx.x >> 6, lane = threadIdx.x & 63;
    for (int n = blockIdx.x * NWAVES + wave; n < NF; n += gridDim.x * NWAVES) {
        float* row = p.out + (size_t)n * DM + lane * 16;
        float hv[16], hn[16]; float ss = 0.f;
#pragma unroll
        for (int i = 0; i < 4; ++i) { const float4 a = *(const float4*)(row + i * 4); hv[i * 4] = a.x; hv[i * 4 + 1] = a.y; hv[i * 4 + 2] = a.z; hv[i * 4 + 3] = a.w; }
#pragma unroll
        for (int i = 0; i < 16; ++i) ss += hv[i] * hv[i];
        ss = wave_sum_uniform(ss);
        const float rstd = rsqrtf(ss * (1.f / DM) + 1e-6f);
#pragma unroll
        for (int i = 0; i < 4; ++i) {
            const float4 a = *(const float4*)(p.norm_ffn + lane * 16 + i * 4);
            hn[i * 4] = hv[i * 4] * rstd * a.x; hn[i * 4 + 1] = hv[i * 4 + 1] * rstd * a.y; hn[i * 4 + 2] = hv[i * 4 + 2] * rstd * a.z; hn[i * 4 + 3] = hv[i * 4 + 3] * rstd * a.w;
        }
        float acc[16];
#pragma unroll
        for (int i = 0; i < 16; ++i) acc[i] = 0.f;
        const int e_lo = EIDX[(size_t)n * 128 + lane], e_hi = EIDX[(size_t)n * 128 + 64 + lane];
        const float g_lo = GATE[(size_t)n * 128 + lane], g_hi = GATE[(size_t)n * 128 + 64 + lane];
#pragma unroll 1
        for (int s0_ = 0; s0_ < 128 * P10_REP; s0_ += 8) {
            const int s0 = s0_ & 127;
            u32x4 ub[8], vb[8]; float gt[8], su[8], sv[8];
#pragma unroll
            for (int k = 0; k < 8; ++k) {
                const int slot = s0 + k;
                const int e = slot < 64 ? __builtin_amdgcn_readlane(e_lo, slot & 63) : __builtin_amdgcn_readlane(e_hi, slot & 63);
                gt[k] = __int_as_float(slot < 64 ? __builtin_amdgcn_readlane(__float_as_int(g_lo), slot & 63) : __builtin_amdgcn_readlane(__float_as_int(g_hi), slot & 63));
                ub[k] = *(const u32x4*)(U8 + (size_t)e * DM + lane * 16);
                vb[k] = *(const u32x4*)(V8 + (size_t)e * DM + lane * 16);
                su[k] = SU[e]; sv[k] = SV[e];
            }
            float d[8];
#pragma unroll
            for (int k = 0; k < 8; ++k) {
                float u[16]; unpack16_fp8(ub[k], u);
                float t = 0.f;
#pragma unroll
                for (int i = 0; i < 16; ++i) t += u[i] * hn[i];
                d[k] = t;
            }
#pragma unroll
            for (int k = 0; k < 8; ++k) d[k] = wave_sum_uniform(d[k]) * su[k];
#pragma unroll
            for (int k = 0; k < 8; ++k) {
                const float coef = 0.5f * d[k] * (1.f + erff(d[k] * 0.70710678118654752f)) * gt[k] * sv[k];
                float v[16]; unpack16_fp8(vb[k], v);
#pragma unroll
                for (int i = 0; i < 16; ++i) acc[i] += coef * v[i];
            }
        }
        float s2 = 0.f;
#pragma unroll
        for (int i = 0; i < 16; ++i) { acc[i] = acc[i] * (1.f / P10_REP) + hv[i]; s2 += acc[i] * acc[i]; }
        s2 = wave_sum_uniform(s2);
        float r2 = rsqrtf(s2 * (1.f / DM) + 1e-6f);
#if TP_SEC
        r2 *= 1.f + 0.5f * ((const float*)(p.ws + OFF_BAR))[3602];
#endif
#ifdef DSA_CHECK
        {
            const float num = ((const float*)(p.ws + OFF_BAR))[3600], den = ((const float*)(p.ws + OFF_BAR))[3601];
            r2 *= 1.f + 10.f * sqrtf(num / fmaxf(den, 1e-30f));
        }
#endif
#pragma unroll
        for (int i = 0; i < 4; ++i) {
            const float4 a = *(const float4*)(p.norm_final + lane * 16 + i * 4);
            *(float4*)(row + i * 4) = make_float4(acc[i * 4] * r2 * a.x, acc[i * 4 + 1] * r2 * a.y, acc[i * 4 + 2] * r2 * a.z, acc[i * 4 + 3] * r2 * a.w);
        }
    }
}

constexpr int NPHASES = 10;
__global__ void __launch_bounds__(NTHREADS, 2) mk_forward(Params p) {
    extern __shared__ __attribute__((aligned(16))) char dyn_smem[];
    LAS char* smem = (LAS char*)dyn_smem;
    const bool multi = (p.hi - p.lo) > 1;
    LAS char* tp_smem = smem;
    if (TP_SEC && blockIdx.x == 0 && threadIdx.x == 0) { volatile LAS long long* tp_ = (volatile LAS long long*)(smem + TP_LDS_OFF); tp_[0] = (long long)__builtin_readcyclecounter(); tp_[2] = 0; }
    XcdBarrier bar; bar.bar = (unsigned*)(p.ws + OFF_BAR); bar.x = 0; bar.st = (volatile LAS unsigned*)(smem + LDS_BAR_OFF);
    if (multi) {
        if (threadIdx.x == 0) { const u32x4 z = {0u, 0u, 0u, 0u}; *(LAS u32x4*)(smem + LDS_BAR_OFF) = z; }
        __syncthreads();
        bar = xcd_barrier_post((unsigned*)(p.ws + OFF_BAR), (volatile LAS unsigned*)(smem + LDS_BAR_OFF));
    }
#ifndef PHMASK
#define PHMASK 0xFFFF
#endif
#define PH_ON(i) (((PHMASK >> (i)) & 1) && p.lo <= (i) && (i) < p.hi)
#define PH_SYNC(i) do { if (multi && (i) + 1 < p.hi) { TP_BEGIN(7); xcd_barrier(bar); TP_END(7); } } while (0)
#ifndef REPEAT_MASK
#define REPEAT_MASK 0
#endif
#define PH_REP(i) for (int rep_ = 0; rep_ < 1 + ((REPEAT_MASK >> (i)) & 1); ++rep_)
    if (PH_ON(0)) { TP_BEGIN(8); PH_REP(0) phase_prologue(p); TP_END(8); PH_SYNC(0); }
    if (PH_ON(1)) { TP_BEGIN(9); PH_REP(1) { EpiProj e; e.P = (bf16_t*)(p.ws + OFF_BIG); gemm256((const bf16_t*)(p.ws + OFF_HN), (const bf16_t*)(p.ws + OFF_WINT), 1024, MPAD / 256, 4096 / 256, (LAS bf16_t*)smem, e); } TP_END(9); PH_SYNC(1); }
    if (PH_ON(2)) { TP_BEGIN(5); phase_rope(p, smem); TP_END(5); PH_SYNC(2); }
    if (PH_ON(3)) { PH_REP(3) {
#ifndef RS_REP
#define RS_REP 1
#endif
#ifndef DSA_REP
#define DSA_REP 1
#endif
            for (int rr_ = 0; rr_ < RS_REP; ++rr_) phase_ret_state_mfma(p, smem);
            for (int rr_ = 0; rr_ < DSA_REP; ++rr_) { phase_dsa_fast(p, smem); __syncthreads(); }
#ifdef DSA_CHECK
            __syncthreads(); xcd_barrier(bar); phase_dsa_naive<true>(p, smem);
#endif
        } PH_SYNC(3); }
    if (PH_ON(4)) { TP_BEGIN(6); phase_ret_scan(p); TP_END(6); PH_SYNC(4); }
    if (PH_ON(5)) { PH_REP(5) phase_ret_out_mfma(p, smem); PH_SYNC(5); }
    if (PH_ON(6)) { PH_REP(6) { EpiOut e; e.H = p.out; e.X = p.x; gemm256((const bf16_t*)(p.ws + OFF_HN), (const bf16_t*)(p.ws + OFF_WOUTT), 1024, NF / 256, 1024 / 256, (LAS bf16_t*)smem, e); } PH_SYNC(6); }
    if (PH_ON(7)) { PH_REP(7) phase_norm2(p); PH_SYNC(7); }
    if (PH_ON(8)) { PH_REP(8) { EpiPQ e; e.Q = (float*)(p.ws + OFF_BIG); gemm256((const bf16_t*)(p.ws + OFF_HN), (const bf16_t*)(p.ws + OFF_WQT), 1024, NF / 256, 2048 / 256, (LAS bf16_t*)smem, e); } PH_SYNC(8); }
    if (PH_ON(9)) { PH_REP(9) { phase_peer_select(p, smem); phase_convert_tables(p); }
        if (TP_SEC && blockIdx.x == 0 && threadIdx.x == 0) { volatile LAS long long* tp_ = (volatile LAS long long*)(smem + TP_LDS_OFF); const float fr = (float)tp_[2] / (float)((long long)__builtin_readcyclecounter() - tp_[0]); ((float*)(p.ws + OFF_BAR))[3602] = fr; }
        PH_SYNC(9); }
    if (PH_ON(10)) { phase_peer_out(p); }
}

extern "C" void kernel_launch(void* const* d_in, const int* in_sizes, int n_in, void* d_out, int out_size, void* d_ws, size_t ws_size, hipStream_t stream) {
    static int grid = 0;
    if (grid == 0) {
        if (n_in != 12 || out_size != NF * DM || ws_size < WS_END) { fprintf(stderr, "kernel_launch: unexpected shapes (n_in %d out %d ws %zu need %zu)\n", n_in, out_size, ws_size, (size_t)WS_END); grid = -1; return; }
        int dev = 0, cus = 0, per_cu = 0;
        if (hipGetDevice(&dev) != hipSuccess || hipDeviceGetAttribute(&cus, hipDeviceAttributeMultiprocessorCount, dev) != hipSuccess) { grid = -1; return; }
        if (hipFuncSetAttribute((const void*)mk_forward, hipFuncAttributeMaxDynamicSharedMemorySize, LDS_BYTES) != hipSuccess) { fprintf(stderr, "kernel_launch: hipFuncSetAttribute failed\n"); grid = -1; return; }
        if (hipOccupancyMaxActiveBlocksPerMultiprocessor(&per_cu, (const void*)mk_forward, NTHREADS, LDS_BYTES) != hipSuccess || per_cu < 1)
            fprintf(stderr, "kernel_launch: occupancy query reports %d blocks per CU\n", per_cu);
        (void)hipGetLastError();
        grid = cus > 0 ? cus : 256;
    }
    if (grid < 0) return;
    Params p{};
    p.x = (const float*)d_in[0]; p.meta = (const float*)d_in[1]; p.norm_mix = (const float*)d_in[2]; p.w_in = (const float*)d_in[3];
    p.w_uv = (const float*)d_in[4]; p.w_out = (const float*)d_in[5]; p.norm_ffn = (const float*)d_in[6]; p.wq = (const float*)d_in[7];
    p.sk = (const float*)d_in[8]; p.pu = (const float*)d_in[9]; p.pv = (const float*)d_in[10]; p.norm_final = (const float*)d_in[11];
    p.out = (float*)d_out; p.ws = (char*)d_ws; p.pad0 = 0; p.pad1 = 0;
    (void)hipMemsetAsync((char*)d_ws + OFF_BAR, 0, 16384, stream);
#if MK_LAUNCHES == 1
    p.lo = 0; p.hi = NPHASES + 1;
    hipLaunchKernelGGL(mk_forward, dim3(grid), dim3(NTHREADS), LDS_BYTES, stream, p);
#else
    for (int ph = 0; ph <= NPHASES; ++ph) { p.lo = ph; p.hi = ph + 1; hipLaunchKernelGGL(mk_forward, dim3(grid), dim3(NTHREADS), LDS_BYTES, stream, p); }
#endif
}
```

```cpp
#include <hip/hip_runtime.h>
#include <stdint.h>
#include <stdio.h>

#ifndef MK_LAUNCHES
#define MK_LAUNCHES 1
#endif

#define DI __device__ __forceinline__
#ifndef TP_SEC
#define TP_SEC 0
#endif
#define TP_LDS_OFF (163840 - 128)
#define TP_BEGIN(k) do { if (TP_SEC == (k) && blockIdx.x == 0 && threadIdx.x == 0) { *(volatile __attribute__((address_space(3))) long long*)(tp_smem + TP_LDS_OFF + 8) = (long long)__builtin_readcyclecounter(); } } while (0)
#define TP_END(k) do { if (TP_SEC == (k) && blockIdx.x == 0 && threadIdx.x == 0) { volatile __attribute__((address_space(3))) long long* tp_ = (volatile __attribute__((address_space(3))) long long*)(tp_smem + TP_LDS_OFF); tp_[2] += (long long)__builtin_readcyclecounter() - tp_[1]; } } while (0)
typedef unsigned short bf16_t;
typedef short bf16x8 __attribute__((ext_vector_type(8)));
typedef float f32x4 __attribute__((ext_vector_type(4)));
typedef unsigned u32x4 __attribute__((ext_vector_type(4)));

constexpr int NB = 8, SEQ = 2048, NMETA = 16, TT = 2064, DM = 1024, INW = 3912;
constexpr int MROWS = NB * TT;
constexpr int MPAD = 16640;
constexpr int NF = NB * SEQ;
constexpr int C_RQ = 0, C_RK = 512, C_RV = 1024, C_RG = 1536, C_DQ = 2048, C_DK = 3072, C_DV = 3200, C_IQ = 3328, C_IK = 3840, C_IW = 3904;
constexpr int NTHREADS = 512, NWAVES = 8;
constexpr int LDS_BYTES = 163840;
constexpr int LDS_BAR_OFF = 163840 - 256;

constexpr size_t al256(size_t x) { return (x + 255) & ~(size_t)255; }
constexpr size_t OFF_BAR = 0;
constexpr size_t OFF_COS128 = 16384;
constexpr size_t OFF_SIN128 = OFF_COS128 + al256((size_t)TT * 64 * 4);
constexpr size_t OFF_COS64 = OFF_SIN128 + al256((size_t)TT * 64 * 4);
constexpr size_t OFF_SIN64 = OFF_COS64 + al256((size_t)TT * 32 * 4);
constexpr size_t OFF_WINT = OFF_SIN64 + al256((size_t)TT * 32 * 4);
constexpr size_t OFF_WOUTT = OFF_WINT + (size_t)4096 * 1024 * 2;
constexpr size_t OFF_WQT = OFF_WOUTT + (size_t)1024 * 1024 * 2;
constexpr size_t OFF_SKH = OFF_WQT + (size_t)2048 * 1024 * 2;
constexpr size_t OFF_SKL = OFF_SKH + (size_t)2048 * 128 * 2;
constexpr int TTP = 2112;
constexpr size_t OFF_WUVT = OFF_SKL + (size_t)2048 * 128 * 2;
constexpr size_t OFF_DVT = OFF_WUVT + (size_t)8 * 64 * 128 * 2;
constexpr size_t OFF_HN = OFF_DVT + (size_t)NB * 128 * TTP * 2;
constexpr size_t OFF_BIG = OFF_HN + (size_t)MPAD * 1024 * 2;
constexpr size_t BIG_BYTES = (size_t)NF * 2048 * 4;
constexpr size_t OFF_ST = OFF_BIG + al256(BIG_BYTES);
constexpr size_t ST_BYTES = (size_t)32 * 34 * 16384 * 4;
constexpr size_t WS_END = OFF_ST + ST_BYTES;
constexpr size_t OFF_EIDX = OFF_ST, OFF_GATE = OFF_ST + (size_t)NF * 128 * 4;
constexpr size_t OFF_U16 = OFF_ST + (size_t)NF * 128 * 8;
constexpr size_t OFF_V16 = OFF_HN;
static_assert(OFF_U16 + (size_t)16384 * 1024 * 2 <= WS_END, "u16");
constexpr size_t OFF_U8 = OFF_U16;
constexpr size_t OFF_SU = OFF_U8 + (size_t)16384 * 1024;
constexpr size_t OFF_V8 = OFF_V16;
constexpr size_t OFF_SV = OFF_V8 + (size_t)16384 * 1024;
static_assert(BIG_BYTES >= (size_t)MPAD * INW * 2, "big region");
static_assert(WS_END <= (size_t)268435456, "workspace");

struct Params {
    const float *x, *meta, *norm_mix, *w_in, *w_uv, *w_out, *norm_ffn, *wq, *sk, *pu, *pv, *norm_final;
    float* out; char* ws; int lo, hi, pad0, pad1;
};

DI float bf2f(bf16_t v) { return __uint_as_float(((unsigned)v) << 16); }
typedef float f32x2_t __attribute__((ext_vector_type(2)));
typedef __bf16 bf16x2_t __attribute__((ext_vector_type(2)));
DI bf16_t f2bf(float f) { const __bf16 h = (__bf16)f; return __builtin_bit_cast(unsigned short, h); }
DI unsigned pk2bf(float a, float b) { const f32x2_t v = {a, b}; const bf16x2_t h = __builtin_convertvector(v, bf16x2_t); return __builtin_bit_cast(unsigned, h); }
DI float wave_sum(float v) {
#pragma unroll
    for (int o = 32; o > 0; o >>= 1) v += __shfl_xor(v, o);
    return v;
}
DI float wave_max(float v) {
#pragma unroll
    for (int o = 32; o > 0; o >>= 1) v = fmaxf(v, __shfl_xor(v, o));
    return v;
}
DI unsigned long long wave_max_u64(unsigned long long v) {
#pragma unroll
    for (int o = 32; o > 0; o >>= 1) {
        const unsigned hi = __shfl_xor((unsigned)(v >> 32), o), lo = __shfl_xor((unsigned)v, o);
        const unsigned long long w = ((unsigned long long)hi << 32) | lo;
        v = w > v ? w : v;
    }
    return v;
}
DI unsigned fkey(float x) { const unsigned u = __float_as_uint(x); return (u & 0x80000000u) ? ~u : (u | 0x80000000u); }
DI float funkey(unsigned k) { const unsigned u = (k & 0x80000000u) ? (k & 0x7fffffffu) : ~k; return __uint_as_float(u); }
DI void lds_fence() { asm volatile("s_waitcnt lgkmcnt(0)" ::: "memory"); }
DI void unpack8(const u32x4& r, float (&v)[8]) {
    v[0] = __uint_as_float(r.x << 16); v[1] = __uint_as_float(r.x & 0xffff0000u);
    v[2] = __uint_as_float(r.y << 16); v[3] = __uint_as_float(r.y & 0xffff0000u);
    v[4] = __uint_as_float(r.z << 16); v[5] = __uint_as_float(r.z & 0xffff0000u);
    v[6] = __uint_as_float(r.w << 16); v[7] = __uint_as_float(r.w & 0xffff0000u);
}

typedef float f32x16 __attribute__((ext_vector_type(16)));
DI bf16x8 pack8(const float (&x)[8]) {
    u32x4 r;
#pragma unroll
    for (int j = 0; j < 4; ++j) r[j] = pk2bf(x[2 * j], x[2 * j + 1]);
    return __builtin_bit_cast(bf16x8, r);
}
DI bf16x8 pack_hi8(const float (&x)[8], float (&rem)[8]) {
    u32x4 r;
#pragma unroll
    for (int j = 0; j < 4; ++j) { r[j] = pk2bf(x[2 * j], x[2 * j + 1]); rem[2 * j] = x[2 * j] - __uint_as_float(r[j] << 16); rem[2 * j + 1] = x[2 * j + 1] - __uint_as_float(r[j] & 0xffff0000u); }
    return __builtin_bit_cast(bf16x8, r);
}

DI float dpp_row_sum(float v) {
    v += __int_as_float(__builtin_amdgcn_update_dpp(0, __float_as_int(v), 0xB1, 0xF, 0xF, true));
    v += __int_as_float(__builtin_amdgcn_update_dpp(0, __float_as_int(v), 0x4E, 0xF, 0xF, true));
    v += __int_as_float(__builtin_amdgcn_update_dpp(0, __float_as_int(v), 0x141, 0xF, 0xF, true));
    v += __int_as_float(__builtin_amdgcn_update_dpp(0, __float_as_int(v), 0x140, 0xF, 0xF, true));
    return v;
}
DI float wave_sum_uniform(float v) {
    v = dpp_row_sum(v);
    const float a = __int_as_float(__builtin_amdgcn_readlane(__float_as_int(v), 0)), b = __int_as_float(__builtin_amdgcn_readlane(__float_as_int(v), 16));
    const float c = __int_as_float(__builtin_amdgcn_readlane(__float_as_int(v), 32)), d = __int_as_float(__builtin_amdgcn_readlane(__float_as_int(v), 48));
    return (a + b) + (c + d);
}

DI int wave_sum_int(int v) {
    v += __builtin_amdgcn_update_dpp(0, v, 0xB1, 0xF, 0xF, true);
    v += __builtin_amdgcn_update_dpp(0, v, 0x4E, 0xF, 0xF, true);
    v += __builtin_amdgcn_update_dpp(0, v, 0x141, 0xF, 0xF, true);
    v += __builtin_amdgcn_update_dpp(0, v, 0x140, 0xF, 0xF, true);
    return (__builtin_amdgcn_readlane(v, 0) + __builtin_amdgcn_readlane(v, 16)) + (__builtin_amdgcn_readlane(v, 32) + __builtin_amdgcn_readlane(v, 48));
}

#define XB_TMO      128
#define XB_XCNT(j)  (256  + 64 * (j))
#define XB_XSUB(j)  (1280 + 64 * (j))
#define XB_XGEN(j)  (2304 + 64 * (j))
#define XB_TOP      3328
#define XB_TOPGEN   3392
#define XCD_BAR_WORDS 3456
#define XB_SPIN_CAP (1u << 20)
#define LAS __attribute__((address_space(3)))

DI unsigned xb_ld(unsigned* p)              { return __hip_atomic_load(p, __ATOMIC_RELAXED, __HIP_MEMORY_SCOPE_AGENT); }
DI unsigned xb_add(unsigned* p, unsigned v) { return __hip_atomic_fetch_add(p, v, __ATOMIC_RELAXED, __HIP_MEMORY_SCOPE_AGENT); }
DI unsigned xb_xcc_id() { return (unsigned)__builtin_amdgcn_s_getreg((3 << 11) | 20) & 0xFu; }
#define XB_SPIN(cond, bar) do { unsigned _sp = 0; while (cond) { __builtin_amdgcn_s_sleep(1); \
    if ((++_sp & 255u) == 0u) { if (xb_ld(&(bar)[XB_TMO])) break; if (_sp > XB_SPIN_CAP) { atomicAdd(&(bar)[XB_TMO], 1u); break; } } } } while (0)

struct XcdBarrier { unsigned* bar; unsigned x; volatile LAS unsigned* st; };

DI XcdBarrier xcd_barrier_post(unsigned* bar, volatile LAS unsigned* st) {
    XcdBarrier b; b.bar = bar; b.x = xb_xcc_id(); b.st = st;
    if (threadIdx.x == 0) (void)xb_add(&bar[XB_XCNT(b.x)], 1u);
    return b;
}
DI void xcd_barrier_complete(unsigned* bar, unsigned x, unsigned& nloc, unsigned& nx) {
    const unsigned G = gridDim.x * gridDim.y * gridDim.z;
    unsigned sum, cnt, mine, sp = 0u;
    for (;;) {
        sum = 0u; cnt = 0u; mine = 0u;
#pragma unroll
        for (unsigned j = 0; j < 16; ++j) { const unsigned c = xb_ld(&bar[XB_XCNT(j)]); sum += c; cnt += (c > 0u) ? 1u : 0u; mine = (j == x) ? c : mine; }
        if (sum == G) break;
        __builtin_amdgcn_s_sleep(1);
        if ((++sp & 255u) == 0u) { if (xb_ld(&bar[XB_TMO])) break; if (sp > XB_SPIN_CAP) { atomicAdd(&bar[XB_TMO], 1u); break; } }
    }
    nloc = mine > 0u ? mine : 1u; nx = cnt > 0u ? cnt : 1u;
}
DI void xcd_barrier(const XcdBarrier& b) {
    asm volatile("s_waitcnt vmcnt(0)" ::: "memory");
    __syncthreads();
    if (threadIdx.x == 0) {
        unsigned* bar = b.bar;
        __builtin_amdgcn_s_waitcnt(0);
        unsigned nloc = b.st[0], nx = b.st[1];
        if (nloc == 0u) { xcd_barrier_complete(bar, b.x, nloc, nx); b.st[0] = nloc; b.st[1] = nx; }
        const unsigned old = xb_add(&bar[XB_XSUB(b.x)], 1u);
        const unsigned gen = old / nloc;
        if (old + 1u == (gen + 1u) * nloc) {
            __builtin_amdgcn_fence(__ATOMIC_RELEASE, "agent");
            asm volatile("s_waitcnt vmcnt(0)" ::: "memory");
            const unsigned og = xb_add(&bar[XB_TOP], 1u);
            const unsigned tg = og / nx;
            if (og + 1u == (tg + 1u) * nx) xb_add(&bar[XB_TOPGEN], 1u);
            else XB_SPIN(xb_ld(&bar[XB_TOPGEN]) == tg, bar);
            __builtin_amdgcn_fence(__ATOMIC_ACQUIRE, "agent");
            xb_add(&bar[XB_XGEN(b.x)], 1u);
            asm volatile("s_waitcnt vmcnt(0)" ::: "memory");
        } else {
            XB_SPIN(xb_ld(&bar[XB_XGEN(b.x)]) == gen, bar);
            __builtin_amdgcn_fence(__ATOMIC_ACQUIRE, "agent");
            asm volatile("s_waitcnt vmcnt(0)" ::: "memory");
        }
    }
    __syncthreads();
}

constexpr int BM = 256, BK = 64, HALF = 128, NXCD = 8, WGM = 8, HT = HALF * BK;
DI int lds_byte(int r, int c) {
    int st = (r >> 4) * 2 + (c >> 5), rr = r & 15, cc = c & 31, ob = rr * 64 + cc * 2;
    return st * 1024 + (ob ^ (((ob >> 9) & 1) << 5));
}
DI void stage_rc(int b, int& R, int& C) {
    int st = b / 1024, sb = b % 1024, swz = sb ^ (((sb >> 9) & 1) << 5);
    R = (st >> 1) * 16 + swz / 64; C = (st & 1) * 32 + (swz % 64) / 2;
}

#define SA(b,h) (shm+((b)*2+(h))*HT)
#define SB(b,h) (shm+(4+(b)*2+(h))*HT)
#define STAGE_X(T,P,BASE,br,kt) do{long _g=(long)(br)*K+(long)(kt)*BK; \
    for(int _i=0;_i<2;++_i){int _b=(T)*16+_i*8192;int _r,_c;stage_rc(_b,_r,_c); \
      __builtin_amdgcn_global_load_lds((const unsigned*)(BASE+_g+(long)_r*K+_c), \
        (LAS unsigned*)((LAS char*)(P)+_b),16,0,0);}}while(0)
#define STAGE(P,BASE,br,kt) STAGE_X(threadIdx.x,P,BASE,br,kt)
#define LDA(dst,b,h) for(int m=0;m<4;++m)for(int k=0;k<2;++k) \
    dst[m][k]=*reinterpret_cast<const LAS bf16x8*>((LAS char*)SA(b,h)+lds_byte(wr*64+m*16+fr,k*32+fq*8))
#define LDB(dst,b,h) for(int n=0;n<2;++n)for(int k=0;k<2;++k) \
    dst[n][k]=*reinterpret_cast<const LAS bf16x8*>((LAS char*)SB(b,h)+lds_byte(wc*32+n*16+fr,k*32+fq*8))
#define MMA(ai,bj,At,Bt_) do{__builtin_amdgcn_s_setprio(1); \
    for(int m=0;m<4;++m)for(int n=0;n<2;++n)for(int k=0;k<2;++k) \
      acc[ai][bj][m][n]=__builtin_amdgcn_mfma_f32_16x16x32_bf16(At[m][k],Bt_[n][k],acc[ai][bj][m][n],0,0,0); \
    __builtin_amdgcn_s_setprio(0);}while(0)
#define WAIT_V(n) asm volatile("s_waitcnt vmcnt(" #n ")":::"memory")
#define WAIT_L(n) asm volatile("s_waitcnt lgkmcnt(" #n ")":::"memory")
#define BAR __builtin_amdgcn_s_barrier()
#define SCHED __builtin_amdgcn_sched_barrier(0)

template <class Epi>
DI void gemm256(const bf16_t* __restrict__ A, const bf16_t* __restrict__ Bt, const int K, const int nM, const int nN, LAS bf16_t* shm, const Epi& epi) {
    const int nwg = nM * nN;
    for (int L = blockIdx.x; L < nwg; L += gridDim.x) {
        int wgid = L;
        { int q = nwg / NXCD, r = nwg % NXCD, xcd = wgid % NXCD, off = wgid / NXCD; wgid = (xcd < r ? xcd * (q + 1) : r * (q + 1) + (xcd - r) * q) + off; }
        int nig = WGM * nN, gid = wgid / nig, fm = gid * WGM, gsz = min(nM - fm, WGM);
        int pm = fm + ((wgid % nig) % gsz), pn = (wgid % nig) / gsz, brow = pm * BM, bcol = pn * BM;
        int wid = threadIdx.x >> 6, lane = threadIdx.x & 63, wr = wid >> 2, wc = wid & 3, fr = lane & 15, fq = lane >> 4;
        f32x4 acc[2][2][4][2] = {};
        bf16x8 At[4][2], B0[2][2], B1[2][2];
        int nt = K / BK;
        STAGE(SB(0,0),Bt,bcol,0); STAGE(SA(0,0),A,brow,0);
        STAGE(SB(0,1),Bt,bcol+HALF,0); STAGE(SA(0,1),A,brow+HALF,0);
        if (wr == 1) BAR;
        WAIT_V(4); BAR;
        STAGE(SB(1,0),Bt,bcol,1); STAGE(SA(1,0),A,brow,1); STAGE(SB(1,1),Bt,bcol+HALF,1);
        WAIT_V(6); BAR;
        for (int t = 0; t < nt - 2; t += 2) {
            LDB(B0,0,0); SCHED; LDA(At,0,0); STAGE(SA(1,1),A,brow+HALF,t+1);
            WAIT_L(8); BAR; WAIT_L(0); MMA(0,0,At,B0); BAR; SCHED;
            LDB(B1,0,1); STAGE(SB(0,0),Bt,bcol,t+2);
            BAR; WAIT_L(0); MMA(0,1,At,B1); BAR;
            LDA(At,0,1); STAGE(SA(0,0),A,brow,t+2);
            BAR; WAIT_L(0); MMA(1,0,At,B0); BAR; SCHED;
            STAGE(SB(0,1),Bt,bcol+HALF,t+2);
            WAIT_V(6); BAR; MMA(1,1,At,B1); BAR;
            LDB(B0,1,0); SCHED; LDA(At,1,0); STAGE(SA(0,1),A,brow+HALF,t+2);
            WAIT_L(8); BAR; WAIT_L(0); MMA(0,0,At,B0); BAR; SCHED;
            LDB(B1,1,1); STAGE(SB(1,0),Bt,bcol,t+3);
            BAR; WAIT_L(0); MMA(0,1,At,B1); BAR;
            LDA(At,1,1); STAGE(SA(1,0),A,brow,t+3);
            BAR; WAIT_L(0); MMA(1,0,At,B0); BAR; SCHED;
            STAGE(SB(1,1),Bt,bcol+HALF,t+3);
            WAIT_V(6); BAR; MMA(1,1,At,B1); BAR;
        }
        int tz = threadIdx.x; asm volatile("" : "+v"(tz)); wid = tz >> 6; lane = tz & 63; wr = wid >> 2; wc = wid & 3; fr = lane & 15; fq = lane >> 4;
        { LDB(B0,0,0); WAIT_V(0); LDA(At,0,0); STAGE_X(tz,SA(1,1),A,brow+HALF,nt-1);
          BAR; WAIT_L(0); MMA(0,0,At,B0); BAR;
          LDB(B1,0,1); BAR; WAIT_L(0); MMA(0,1,At,B1); BAR;
          LDA(At,0,1); WAIT_V(4); BAR; WAIT_L(0); MMA(1,0,At,B0); MMA(1,1,At,B1); BAR; }
        { LDB(B0,1,0); LDA(At,1,0); WAIT_V(2); BAR; WAIT_L(0); MMA(0,0,At,B0); BAR;
          LDB(B1,1,1); WAIT_V(0); BAR; WAIT_L(0); MMA(0,1,At,B1); BAR;
          LDA(At,1,1); BAR; WAIT_L(0); MMA(1,0,At,B0); MMA(1,1,At,B1); BAR; }
        if (wr == 0) BAR;
        epi(acc, brow, bcol, wr, wc, fr, fq);
        __syncthreads();
    }
}

struct EpiProj {
    bf16_t* P;
    DI void operator()(const f32x4 (&acc)[2][2][4][2], int brow, int bcol, int wr, int wc, int fr, int fq) const {
#pragma unroll
        for (int ai = 0; ai < 2; ++ai)
#pragma unroll
        for (int bj = 0; bj < 2; ++bj)
#pragma unroll
        for (int m = 0; m < 4; ++m)
#pragma unroll
        for (int n = 0; n < 2; ++n)
#pragma unroll
        for (int j = 0; j < 4; ++j) {
            const int row = brow + ai * HALF + wr * 64 + m * 16 + fq * 4 + j, col = bcol + bj * HALF + wc * 32 + n * 16 + fr;
            if (col < INW) P[(size_t)row * INW + col] = f2bf(acc[ai][bj][m][n][j]);
        }
    }
};
struct EpiOut {
    float* H; const float* X;
    DI void operator()(const f32x4 (&acc)[2][2][4][2], int brow, int bcol, int wr, int wc, int fr, int fq) const {
#pragma unroll
        for (int ai = 0; ai < 2; ++ai)
#pragma unroll
        for (int bj = 0; bj < 2; ++bj)
#pragma unroll
        for (int m = 0; m < 4; ++m)
#pragma unroll
        for (int n = 0; n < 2; ++n)
#pragma unroll
        for (int j = 0; j < 4; ++j) {
            const int row = brow + ai * HALF + wr * 64 + m * 16 + fq * 4 + j, col = bcol + bj * HALF + wc * 32 + n * 16 + fr;
            const size_t o = (size_t)row * DM + col; H[o] = X[o] + acc[ai][bj][m][n][j];
        }
    }
};
struct EpiPQ {
    float* Q;
    DI void operator()(const f32x4 (&acc)[2][2][4][2], int brow, int bcol, int wr, int wc, int fr, int fq) const {
#pragma unroll
        for (int ai = 0; ai < 2; ++ai)
#pragma unroll
        for (int bj = 0; bj < 2; ++bj)
#pragma unroll
        for (int m = 0; m < 4; ++m)
#pragma unroll
        for (int n = 0; n < 2; ++n)
#pragma unroll
        for (int j = 0; j < 4; ++j) {
            const int row = brow + ai * HALF + wr * 64 + m * 16 + fq * 4 + j, col = bcol + bj * HALF + wc * 32 + n * 16 + fr;
            Q[(size_t)row * 2048 + col] = acc[ai][bj][m][n][j];
        }
    }
};

DI void phase_prologue(const Params& p) {
    const int gtid = blockIdx.x * NTHREADS + threadIdx.x, gsz = gridDim.x * NTHREADS;
    bf16_t* wint = (bf16_t*)(p.ws + OFF_WINT);
    for (int idx = gtid; idx < 4096 * 1024; idx += gsz) {
        const int k = idx >> 12, n = idx & 4095;
        const float v = n < INW ? p.w_in[(size_t)k * INW + n] : 0.f;
        wint[(size_t)n * 1024 + k] = f2bf(v);
    }
    bf16_t* woutt = (bf16_t*)(p.ws + OFF_WOUTT);
    for (int idx = gtid; idx < 1024 * 1024; idx += gsz) {
        const int k = idx >> 10, n = idx & 1023;
        woutt[(size_t)n * 1024 + k] = f2bf(p.w_out[(size_t)k * 1024 + n]);
    }
    bf16_t* wqt = (bf16_t*)(p.ws + OFF_WQT);
    for (int idx = gtid; idx < 1024 * 2048; idx += gsz) {
        const int k = idx >> 11, n = idx & 2047;
        wqt[(size_t)n * 1024 + k] = f2bf(p.wq[(size_t)k * 2048 + n]);
    }
    bf16_t* wuvt = (bf16_t*)(p.ws + OFF_WUVT);
    for (int idx = gtid; idx < 8 * 64 * 128; idx += gsz) {
        const int h = idx >> 13, e = (idx >> 7) & 63, dv = idx & 127;
        wuvt[idx] = f2bf(p.w_uv[(size_t)(h * 128 + dv) * 64 + e]);
    }
    bf16_t* skh = (bf16_t*)(p.ws + OFF_SKH); bf16_t* skl = (bf16_t*)(p.ws + OFF_SKL);
    for (int idx = gtid; idx < 2048 * 128; idx += gsz) {
        const float v = p.sk[idx]; const bf16_t hi = f2bf(v);
        skh[idx] = hi; skl[idx] = f2bf(v - bf2f(hi));
    }
    float* c128 = (float*)(p.ws + OFF_COS128); float* s128 = (float*)(p.ws + OFF_SIN128);
    for (int idx = gtid; idx < TT * 64; idx += gsz) {
        const int pos = idx >> 6, j = idx & 63;
        const float inv = powf(10000.f, -(float)j * 2.0f / 128.f);
        const float ang = (float)pos * inv;
        float s, c; sincosf(ang, &s, &c);
        c128[idx] = c; s128[idx] = s;
    }
    float* c64 = (float*)(p.ws + OFF_COS64); float* s64 = (float*)(p.ws + OFF_SIN64);
    for (int idx = gtid; idx < TT * 32; idx += gsz) {
        const int pos = idx >> 5, j = idx & 31;
        const float inv = powf(10000.f, -(float)j * 2.0f / 64.f);
        const float ang = (float)pos * inv;
        float s, c; sincosf(ang, &s, &c);
        c64[idx] = c; s64[idx] = s;
    }
    bf16_t* hn = (bf16_t*)(p.ws + OFF_HN);
    const int wave = threadIdx.x >> 6, lane = threadIdx.x & 63;
    for (int row = blockIdx.x * NWAVES + wave; row < MPAD; row += gridDim.x * NWAVES) {
        bf16_t* o = hn + (size_t)row * DM;
        if (row >= MROWS) {
            for (int i = 0; i < 4; ++i) *(uint2*)(o + i * 256 + lane * 4) = make_uint2(0u, 0u);
            continue;
        }
        const int b = row / TT, t = row % TT;
        const float* src = t < NMETA ? p.meta + (size_t)t * DM : p.x + ((size_t)b * SEQ + (t - NMETA)) * DM;
        float4 v[4]; float ss = 0.f;
#pragma unroll
        for (int i = 0; i < 4; ++i) { v[i] = *(const float4*)(src + i * 256 + lane * 4); ss += v[i].x * v[i].x + v[i].y * v[i].y + v[i].z * v[i].z + v[i].w * v[i].w; }
        ss = wave_sum(ss);
        const float rstd = rsqrtf(ss * (1.f / DM) + 1e-6f);
#pragma unroll
        for (int i = 0; i < 4; ++i) {
            const float4 g = *(const float4*)(p.norm_mix + i * 256 + lane * 4);
            uint2 w;
            w.x = (unsigned)f2bf(v[i].x * rstd * g.x) | ((unsigned)f2bf(v[i].y * rstd * g.y) << 16);
            w.y = (unsigned)f2bf(v[i].z * rstd * g.z) | ((unsigned)f2bf(v[i].w * rstd * g.w) << 16);
            *(uint2*)(o + i * 256 + lane * 4) = w;
        }
    }
}

DI void rope8(bf16_t* p1, bf16_t* p2, const float* ct, const float* st, float scale) {
    const u32x4 r1 = *(const u32x4*)p1, r2 = *(const u32x4*)p2;
    float x1[8], x2[8]; unpack8(r1, x1); unpack8(r2, x2);
    const float4 c0 = *(const float4*)ct, c1 = *(const float4*)(ct + 4), s0 = *(const float4*)st, s1 = *(const float4*)(st + 4);
    const float cs[8] = {c0.x, c0.y, c0.z, c0.w, c1.x, c1.y, c1.z, c1.w}, sn[8] = {s0.x, s0.y, s0.z, s0.w, s1.x, s1.y, s1.z, s1.w};
    u32x4 o1, o2;
#pragma unroll
    for (int i = 0; i < 4; ++i) {
        const float a0 = (x1[2 * i] * cs[2 * i] - x2[2 * i] * sn[2 * i]) * scale, a1 = (x1[2 * i + 1] * cs[2 * i + 1] - x2[2 * i + 1] * sn[2 * i + 1]) * scale;
        const float b0 = (x2[2 * i] * cs[2 * i] + x1[2 * i] * sn[2 * i]) * scale, b1 = (x2[2 * i + 1] * cs[2 * i + 1] + x1[2 * i + 1] * sn[2 * i + 1]) * scale;
        o1[i] = (unsigned)f2bf(a0) | ((unsigned)f2bf(a1) << 16); o2[i] = (unsigned)f2bf(b0) | ((unsigned)f2bf(b1) << 16);
    }
    *(u32x4*)p1 = o1; *(u32x4*)p2 = o2;
}
DI void phase_rope(const Params& p, LAS char* smem) {
    bf16_t* proj = (bf16_t*)(p.ws + OFF_BIG);
    const float* c128 = (const float*)(p.ws + OFF_COS128); const float* s128 = (const float*)(p.ws + OFF_SIN128);
    const float* c64 = (const float*)(p.ws + OFF_COS64); const float* s64 = (const float*)(p.ws + OFF_SIN64);
    const int gtid = blockIdx.x * NTHREADS + threadIdx.x, gsz = gridDim.x * NTHREADS;
    const int total = MROWS * 173;
    for (int idx = gtid; idx < total; idx += gsz) {
        const int row = idx / 173, it = idx - row * 173;
        const int t = row % TT;
        bf16_t* pr = proj + (size_t)row * INW;
        if (it < 32)       { const int hd = it >> 3, j = (it & 7) * 8;          rope8(pr + C_RQ + hd * 128 + j, pr + C_RQ + hd * 128 + 64 + j, c128 + t * 64 + j, s128 + t * 64 + j, 1.f); }
        else if (it < 64)  { const int i2 = it - 32, hd = i2 >> 3, j = (i2 & 7) * 8;  rope8(pr + C_RK + hd * 128 + j, pr + C_RK + hd * 128 + 64 + j, c128 + t * 64 + j, s128 + t * 64 + j, 0.08838834764831845f); }
        else if (it < 128) { const int i2 = it - 64, hd = i2 >> 3, j = (i2 & 7) * 8;  rope8(pr + C_DQ + hd * 128 + j, pr + C_DQ + hd * 128 + 64 + j, c128 + t * 64 + j, s128 + t * 64 + j, 0.08838834764831845f * 1.4426950408889634f); }
        else if (it < 136) { const int j = (it - 128) * 8;                          rope8(pr + C_DK + j, pr + C_DK + 64 + j, c128 + t * 64 + j, s128 + t * 64 + j, 1.f); }
        else if (it < 168) { const int i2 = it - 136, hd = i2 >> 2, j = (i2 & 3) * 8; rope8(pr + C_IQ + hd * 64 + j, pr + C_IQ + hd * 64 + 32 + j, c64 + t * 32 + j, s64 + t * 32 + j, 0.125f); }
        else if (it < 172) { const int j = (it - 168) * 8;                          rope8(pr + C_IK + j, pr + C_IK + 32 + j, c64 + t * 32 + j, s64 + t * 32 + j, 1.f); }
        else {
            const u32x4 r = *(const u32x4*)(pr + C_IW); float v[8]; unpack8(r, v); u32x4 o;
#pragma unroll
            for (int i = 0; i < 4; ++i) o[i] = (unsigned)f2bf(v[2 * i] * 0.35355339059327373f) | ((unsigned)f2bf(v[2 * i + 1] * 0.35355339059327373f) << 16);
            *(u32x4*)(pr + C_IW) = o;
        }
    }
    bf16_t* dvt = (bf16_t*)(p.ws + OFF_DVT);
    LAS bf16_t* tile = (LAS bf16_t*)smem;
    for (int unit = blockIdx.x; unit < NB * (TTP / 64); unit += gridDim.x) {
        const int b = unit / (TTP / 64), t0 = (unit % (TTP / 64)) * 64;
        for (int i = threadIdx.x; i < 64 * 16; i += NTHREADS) {
            const int tr = i >> 4, ch = i & 15, t = t0 + tr;
            u32x4 v = {0u, 0u, 0u, 0u};
            if (t < TT) v = *(const u32x4*)(proj + (size_t)(b * TT + t) * INW + C_DV + ch * 8);
            *(LAS u32x4*)(tile + tr * 136 + ch * 8) = v;
        }
        __syncthreads();
        for (int i = threadIdx.x; i < 128 * 8; i += NTHREADS) {
            const int dv = i >> 3, ch = i & 7;
            u32x4 o;
#pragma unroll
            for (int w = 0; w < 4; ++w) o[w] = (unsigned)tile[(ch * 8 + 2 * w) * 136 + dv] | ((unsigned)tile[(ch * 8 + 2 * w + 1) * 136 + dv] << 16);
            *(u32x4*)(dvt + (size_t)(b * 128 + dv) * TTP + t0 + ch * 8) = o;
        }
        __syncthreads();
    }
}

DI void phase_ret_state(const Params& p, LAS char* smem) {
    const bf16_t* proj = (const bf16_t*)(p.ws + OFF_BIG);
    float* ST = (float*)(p.ws + OFF_ST);
    LAS bf16_t* sK = (LAS bf16_t*)smem; LAS bf16_t* sV = sK + 64 * 128;
    for (int unit = blockIdx.x; unit < 1024; unit += gridDim.x) {
        const int c = 1 + (unit & 31), bh = unit >> 5, h = bh & 3, b = bh >> 2;
        for (int i = threadIdx.x; i < 64 * 16; i += NTHREADS) {
            const int j = i >> 4, ch = i & 15; const int t = 64 * c + j - 112;
            u32x4 kv = {0u, 0u, 0u, 0u}, vv = {0u, 0u, 0u, 0u};
            if (t >= 0) { const bf16_t* pr = proj + (size_t)(b * TT + t) * INW; kv = *(const u32x4*)(pr + C_RK + h * 128 + ch * 8); vv = *(const u32x4*)(pr + C_RV + h * 128 + ch * 8); }
            *(LAS u32x4*)(sK + j * 128 + ch * 8) = kv; *(LAS u32x4*)(sV + j * 128 + ch * 8) = vv;
        }
        __syncthreads();
        const float lg = logf(1.f - exp2f(-5.f - (float)h));
        const int e = threadIdx.x >> 2, d0 = (threadIdx.x & 3) * 32;
        float acc[32];
#pragma unroll
        for (int dd = 0; dd < 32; ++dd) acc[dd] = 0.f;
        for (int j = 0; j < 64; ++j) {
            const float z = expf(lg * (float)(63 - j)) * bf2f(sV[j * 128 + e]);
#pragma unroll
            for (int d8 = 0; d8 < 4; ++d8) {
                const u32x4 raw = *(const LAS u32x4*)(sK + j * 128 + d0 + d8 * 8); float kv[8]; unpack8(raw, kv);
#pragma unroll
                for (int x = 0; x < 8; ++x) acc[d8 * 8 + x] += z * kv[x];
            }
        }
        float* st = ST + ((size_t)(bh * 34 + c) * 128 + e) * 128 + d0;
#pragma unroll
        for (int d4 = 0; d4 < 8; ++d4) *(float4*)(st + d4 * 4) = make_float4(acc[d4 * 4], acc[d4 * 4 + 1], acc[d4 * 4 + 2], acc[d4 * 4 + 3]);
        __syncthreads();
    }
}

constexpr int DSA_WAVE_LDS = 2176 * 4 + 1024 * 4 + 256 * 4 + 64;
template <bool CHECK>
DI void phase_dsa_naive(const Params& p, LAS char* smem) {
    const bf16_t* proj = (const bf16_t*)(p.ws + OFF_BIG);
    bf16_t* mixed = (bf16_t*)(p.ws + OFF_HN);
    const int wave = threadIdx.x >> 6, lane = threadIdx.x & 63;
    LAS float* sSc = (LAS float*)(smem + wave * DSA_WAVE_LDS);
    LAS float* sQ = sSc + 2176;
    LAS int* sSel = (LAS int*)(sQ + 1024);
    LAS float* sIw = (LAS float*)(sSel + 256);
    const unsigned long long lt_mask = (1ull << lane) - 1ull;
    float chk_num = 0.f, chk_den = 0.f;
    for (int q = blockIdx.x * NWAVES + wave; q < NF; q += gridDim.x * NWAVES) {
        const int b = q >> 11, s = q & 2047, t = NMETA + s;
        const int nk = 80 + 64 * (s >> 6);
        const bf16_t* prow = proj + (size_t)(b * TT + t) * INW;
        for (int i = lane; i < 512; i += 64) sQ[i] = bf2f(prow[C_IQ + i]);
        if (lane < 8) sIw[lane] = bf2f(prow[C_IW + lane]);
        lds_fence();
        const bf16_t* ikbase = proj + (size_t)(b * TT) * INW + C_IK;
        const int nj = (nk + 63) >> 6;
        for (int jj = 0; jj < nj; ++jj) {
            const int k = jj * 64 + lane;
            float sc = 0.f;
            if (k < nk) {
                const bf16_t* kr = ikbase + (size_t)k * INW;
                float a[8];
#pragma unroll
                for (int h = 0; h < 8; ++h) a[h] = 0.f;
#pragma unroll 1
                for (int d8 = 0; d8 < 8; ++d8) {
                    const u32x4 raw = *(const u32x4*)(kr + d8 * 8); float kv[8]; unpack8(raw, kv);
#pragma unroll
                    for (int h = 0; h < 8; ++h) {
                        const f32x4 q0 = *(const LAS f32x4*)(sQ + h * 64 + d8 * 8), q1 = *(const LAS f32x4*)(sQ + h * 64 + d8 * 8 + 4);
                        a[h] += kv[0] * q0[0] + kv[1] * q0[1] + kv[2] * q0[2] + kv[3] * q0[3] + kv[4] * q1[0] + kv[5] * q1[1] + kv[6] * q1[2] + kv[7] * q1[3];
                    }
                }
#pragma unroll
                for (int h = 0; h < 8; ++h) sc += fmaxf(a[h], 0.f) * sIw[h];
                sc += 0.0f;
            }
            sSc[k] = sc;
        }
        lds_fence();
        int L;
        if (nk <= 256) {
            for (int i = lane; i < nk; i += 64) sSel[i] = i;
            L = nk;
        } else {
            unsigned Tkey = 0u;
            for (int bit = 31; bit >= 0; --bit) {
                const unsigned cand = Tkey | (1u << bit);
                int cnt = 0;
                for (int jj = 0; jj < nj; ++jj) {
                    const int k = jj * 64 + lane;
                    const unsigned key = (k < nk) ? fkey(sSc[k]) : 0u;
                    cnt += __popcll(__ballot(key >= cand));
                }
                if (cnt >= 256) Tkey = cand;
            }
            int cgt = 0;
            for (int jj = 0; jj < nj; ++jj) {
                const int k = jj * 64 + lane;
                const unsigned key = (k < nk) ? fkey(sSc[k]) : 0u;
                cgt += __popcll(__ballot(key > Tkey));
            }
            const int need = 256 - cgt;
            int pos = 0, eqseen = 0;
            for (int jj = 0; jj < nj; ++jj) {
                const int k = jj * 64 + lane;
                const unsigned key = (k < nk) ? fkey(sSc[k]) : 0u;
                const bool gt = key > Tkey, eq = (key == Tkey);
                const unsigned long long eqm = __ballot(eq);
                const int myeq = eqseen + __popcll(eqm & lt_mask);
                const bool sel = gt || (eq && myeq < need);
                const unsigned long long sm = __ballot(sel);
                if (sel) sSel[pos + __popcll(sm & lt_mask)] = k;
                pos += __popcll(sm); eqseen += __popcll(eqm);
            }
            L = 256;
        }
        lds_fence();
        for (int i = lane; i < 1024; i += 64) sQ[i] = bf2f(prow[C_DQ + i]);
        lds_fence();
        float sc[8][4];
        const bf16_t* dkbase = proj + (size_t)(b * TT) * INW + C_DK;
#pragma unroll
        for (int il = 0; il < 4; ++il) {
            const int i = lane + 64 * il; const bool ok = i < L; const int key = ok ? sSel[i] : 0;
            const bf16_t* kr = dkbase + (size_t)key * INW;
            float a[8];
#pragma unroll
            for (int h = 0; h < 8; ++h) a[h] = 0.f;
#pragma unroll 1
            for (int d8 = 0; d8 < 16; ++d8) {
                const u32x4 raw = *(const u32x4*)(kr + d8 * 8); float kv[8]; unpack8(raw, kv);
#pragma unroll
                for (int h = 0; h < 8; ++h) {
                    const f32x4 q0 = *(const LAS f32x4*)(sQ + h * 128 + d8 * 8), q1 = *(const LAS f32x4*)(sQ + h * 128 + d8 * 8 + 4);
                    a[h] += kv[0] * q0[0] + kv[1] * q0[1] + kv[2] * q0[2] + kv[3] * q0[3] + kv[4] * q1[0] + kv[5] * q1[1] + kv[6] * q1[2] + kv[7] * q1[3];
                }
            }
#pragma unroll
            for (int h = 0; h < 8; ++h) sc[h][il] = ok ? a[h] : -INFINITY;
        }
#pragma unroll
        for (int h = 0; h < 8; ++h) {
            float m = fmaxf(fmaxf(sc[h][0], sc[h][1]), fmaxf(sc[h][2], sc[h][3]));
            m = wave_max(m);
            float e[4], sum = 0.f;
#pragma unroll
            for (int il = 0; il < 4; ++il) { e[il] = exp2f(sc[h][il] - m); sum += e[il]; }
            sum = wave_sum(sum);
            const float inv = 1.f / sum;
#pragma unroll
            for (int il = 0; il < 4; ++il) sSc[h * 256 + lane + 64 * il] = e[il] * inv;
        }
        lds_fence();
        float o[8][2];
#pragma unroll
        for (int h = 0; h < 8; ++h) { o[h][0] = 0.f; o[h][1] = 0.f; }
        const bf16_t* dvbase = proj + (size_t)(b * TT) * INW + C_DV;
        for (int i = 0; i < L; ++i) {
            const int key = sSel[i];
            const float v0 = bf2f(dvbase[(size_t)key * INW + lane]), v1 = bf2f(dvbase[(size_t)key * INW + 64 + lane]);
#pragma unroll
            for (int h = 0; h < 8; ++h) { const float pv = sSc[h * 256 + i]; o[h][0] += pv * v0; o[h][1] += pv * v1; }
        }
        lds_fence();
#pragma unroll
        for (int h = 0; h < 8; ++h) { sQ[h * 128 + lane] = o[h][0]; sQ[h * 128 + 64 + lane] = o[h][1]; }
        lds_fence();
        for (int h = 0; h < 8; ++h) {
            float acc = 0.f;
            const float* wu = p.w_uv + (size_t)h * 128 * 64 + lane;
            for (int c = 0; c < 128; ++c) acc += sQ[h * 128 + c] * wu[c * 64];
            if (CHECK) { const float got = bf2f(mixed[(size_t)q * DM + 512 + h * 64 + lane]); chk_num += (got - acc) * (got - acc); chk_den += acc * acc; }
            else mixed[(size_t)q * DM + 512 + h * 64 + lane] = f2bf(acc);
        }
        lds_fence();
    }
    if (CHECK) {
        chk_num = wave_sum(chk_num); chk_den = wave_sum(chk_den);
        if (lane == 0) { atomicAdd((float*)(p.ws + OFF_BAR) + 3600, chk_num); atomicAdd((float*)(p.ws + OFF_BAR) + 3601, chk_den); }
    }
}

typedef unsigned long long u64;
typedef short s16x4 __attribute__((ext_vector_type(4)));
constexpr int SCLD = 2116;
constexpr int DSA_MASK_OFF = 16 * SCLD * 4;
constexpr int KLD = 136, VLD = 72;
constexpr int DSA_VT_OFF = 64 * KLD * 2;
#define MFMA16(a, b, c) __builtin_amdgcn_mfma_f32_16x16x32_bf16((a), (b), (c), 0, 0, 0)
DI void phase_dsa_fast(const Params& p, LAS char* smem) {
    const bf16_t* proj = (const bf16_t*)(p.ws + OFF_BIG);
    const bf16_t* dvt = (const bf16_t*)(p.ws + OFF_DVT);
    const bf16_t* wuvt = (const bf16_t*)(p.ws + OFF_WUVT);
    bf16_t* mixed = (bf16_t*)(p.ws + OFF_HN);
    const int wave = threadIdx.x >> 6, lane = threadIdx.x & 63, c = lane & 15, g = lane >> 4;
    LAS float* SC = (LAS float*)smem; LAS u64* MASK = (LAS u64*)(smem + DSA_MASK_OFF);
    LAS bf16_t* KT = (LAS bf16_t*)smem; LAS bf16_t* VT = (LAS bf16_t*)(smem + DSA_VT_OFF);
    const u64 lt_mask = (1ull << lane) - 1ull;
    for (int pi = blockIdx.x; pi < 512; pi += gridDim.x)
    for (int which = 0; which < 2; ++which) {
        const int b = pi >> 6, qq = pi & 63, qt = which ? 127 - qq : qq;
        const int s0 = qt * 16, nk = 80 + 64 * (s0 >> 6), nkt = nk >> 4, nj = (nk + 63) >> 6;
        const bf16_t* pb = proj + (size_t)(b * TT) * INW;
        LAS char* tp_smem = smem; TP_BEGIN(1);
        {
            const bf16_t* qrow = pb + (size_t)(NMETA + s0 + c) * INW;
            bf16x8 bq[8][2]; float iw[8];
#pragma unroll
            for (int h = 0; h < 8; ++h) {
                bq[h][0] = *(const bf16x8*)(qrow + C_IQ + h * 64 + 8 * g);
                bq[h][1] = *(const bf16x8*)(qrow + C_IQ + h * 64 + 32 + 8 * g);
                iw[h] = bf2f(qrow[C_IW + h]);
            }
            bf16x8 a0n = {0, 0, 0, 0, 0, 0, 0, 0}, a1n = {0, 0, 0, 0, 0, 0, 0, 0};
            if (wave < nkt) { const bf16_t* krow = pb + (size_t)(wave * 16 + c) * INW + C_IK + 8 * g; a0n = *(const bf16x8*)(krow); a1n = *(const bf16x8*)(krow + 32); }
            for (int kt = wave; kt < nkt; kt += NWAVES) {
                const bf16x8 a0 = a0n, a1 = a1n;
                if (kt + NWAVES < nkt) { const bf16_t* krow = pb + (size_t)((kt + NWAVES) * 16 + c) * INW + C_IK + 8 * g; a0n = *(const bf16x8*)(krow); a1n = *(const bf16x8*)(krow + 32); }
                f32x4 isc = {0.f, 0.f, 0.f, 0.f};
#pragma unroll
                for (int h = 0; h < 8; ++h) {
                    f32x4 acc = {0.f, 0.f, 0.f, 0.f};
                    acc = MFMA16(a0, bq[h][0], acc); acc = MFMA16(a1, bq[h][1], acc);
#pragma unroll
                    for (int j = 0; j < 4; ++j) isc[j] += fmaxf(acc[j], 0.f) * iw[h];
                }
#pragma unroll
                for (int j = 0; j < 4; ++j) isc[j] += 0.0f;
                *(LAS f32x4*)(SC + c * SCLD + kt * 16 + 4 * g) = isc;
            }
        }
        __syncthreads(); TP_END(1); TP_BEGIN(2);
#pragma unroll 1
        for (int qi = 0; qi < 2; ++qi) {
            const int cq = wave * 2 + qi;
            unsigned kv[33];
#pragma unroll
            for (int jj = 0; jj < 33; ++jj) { const int k = jj * 64 + lane; const float v = SC[cq * SCLD + k]; kv[jj] = (k < nk) ? fkey(v) : 0u; }
            unsigned Tkey = 1u;
            if (nk > 256) {
                Tkey = 0u;
#pragma unroll 1
                for (int bit = 31; bit >= 0; --bit) {
                    const unsigned cand = Tkey | (1u << bit);
                    int nl = 0;
#pragma unroll
                    for (int jj = 0; jj < 11; ++jj) nl += (kv[jj] >= cand) ? 1 : 0;
                    if (nj > 11) {
#pragma unroll
                        for (int jj = 11; jj < 22; ++jj) nl += (kv[jj] >= cand) ? 1 : 0;
                    }
                    if (nj > 22) {
#pragma unroll
                        for (int jj = 22; jj < 33; ++jj) nl += (kv[jj] >= cand) ? 1 : 0;
                    }
                    const int cnt = wave_sum_int(nl);
                    if (cnt >= 256) Tkey = cand;
                    if (cnt == 256) break;
                }
            }
            int cgl = 0;
#pragma unroll
            for (int jj = 0; jj < 33; ++jj) cgl += (kv[jj] > Tkey) ? 1 : 0;
            const int cgt = wave_sum_int(cgl);
            const int need = (nk > 256) ? 256 - cgt : 4096;
            int eqseen = 0;
#pragma unroll
            for (int jj = 0; jj < 33; ++jj) {
                const bool gt = kv[jj] > Tkey, eq = (kv[jj] == Tkey);
                const u64 eqm = __ballot(eq);
                const int myeq = eqseen + __popcll(eqm & lt_mask);
                const u64 sm = __ballot(gt || (eq && myeq < need));
                eqseen += __popcll(eqm);
                if (lane == 0) MASK[cq * 34 + jj] = sm;
            }
        }
        __syncthreads(); TP_END(2); TP_BEGIN(3);
        {
            const int h = wave;
            const bf16_t* qrow = pb + (size_t)(NMETA + s0 + c) * INW + C_DQ + h * 128 + 8 * g;
            bf16x8 bQ[4];
#pragma unroll
            for (int ks = 0; ks < 4; ++ks) bQ[ks] = *(const bf16x8*)(qrow + ks * 32);
            f32x4 O[8];
#pragma unroll
            for (int mb = 0; mb < 8; ++mb) O[mb] = (f32x4){0.f, 0.f, 0.f, 0.f};
            float m_run = -1e30f, l_run = 0.f;
            const int krow_t = threadIdx.x >> 4, kch_t = threadIdx.x & 15, vdv_t = threadIdx.x >> 3, vch_t = threadIdx.x & 7;
            const bf16_t* vsrc = dvt + (size_t)(b * 128 + vdv_t) * TTP + vch_t * 8;
            u32x4 pk0, pk1, pv0, pv1;
            {
                int k0 = krow_t, k1 = 32 + krow_t; k0 = k0 < nk ? k0 : nk - 1; k1 = k1 < nk ? k1 : nk - 1;
                pk0 = *(const u32x4*)(pb + (size_t)k0 * INW + C_DK + kch_t * 8); pk1 = *(const u32x4*)(pb + (size_t)k1 * INW + C_DK + kch_t * 8);
                pv0 = *(const u32x4*)(vsrc); pv1 = *(const u32x4*)(vsrc + (size_t)64 * TTP);
            }
#pragma unroll 1
            for (int kb = 0; kb < nj; ++kb) {
                *(LAS u32x4*)(KT + krow_t * KLD + kch_t * 8) = pk0; *(LAS u32x4*)(KT + (32 + krow_t) * KLD + kch_t * 8) = pk1;
                *(LAS u32x4*)(VT + vdv_t * VLD + vch_t * 8) = pv0; *(LAS u32x4*)(VT + (64 + vdv_t) * VLD + vch_t * 8) = pv1;
                __syncthreads();
                if (kb + 1 < nj) {
                    int k0 = (kb + 1) * 64 + krow_t, k1 = k0 + 32; k0 = k0 < nk ? k0 : nk - 1; k1 = k1 < nk ? k1 : nk - 1;
                    pk0 = *(const u32x4*)(pb + (size_t)k0 * INW + C_DK + kch_t * 8); pk1 = *(const u32x4*)(pb + (size_t)k1 * INW + C_DK + kch_t * 8);
                    pv0 = *(const u32x4*)(vsrc + (kb + 1) * 64); pv1 = *(const u32x4*)(vsrc + (size_t)64 * TTP + (kb + 1) * 64);
                }
                const u64 mw = MASK[c * 34 + kb];
                f32x4 S[4];
#pragma unroll
                for (int ct = 0; ct < 4; ++ct) {
                    f32x4 acc = {0.f, 0.f, 0.f, 0.f};
#pragma unroll
                    for (int ks = 0; ks < 4; ++ks) {
                        const bf16x8 a = *(const LAS bf16x8*)(KT + (ct * 16 + c) * KLD + ks * 32 + 8 * g);
                        acc = MFMA16(a, bQ[ks], acc);
                    }
                    S[ct] = acc;
                }
                const u64 mws = mw >> (4 * g);
                const unsigned mlo = (unsigned)mws, mhi = (unsigned)(mws >> 32);
                float mblk = -1e30f;
#pragma unroll
                for (int ct = 0; ct < 4; ++ct) {
                    const unsigned bits = ((ct & 2) ? mhi : mlo) >> ((ct & 1) * 16);
#pragma unroll
                    for (int j = 0; j < 4; ++j) {
                        S[ct][j] = ((bits >> j) & 1u) ? S[ct][j] : -1e30f;
                        mblk = fmaxf(mblk, S[ct][j]);
                    }
                }
                mblk = fmaxf(mblk, __shfl_xor(mblk, 16)); mblk = fmaxf(mblk, __shfl_xor(mblk, 32));
                const float m_new = fmaxf(m_run, mblk);
                float ps = 0.f;
#pragma unroll
                for (int ct = 0; ct < 4; ++ct)
#pragma unroll
                    for (int j = 0; j < 4; ++j) { const float pv = (S[ct][j] > -1e29f) ? __builtin_amdgcn_exp2f(S[ct][j] - m_new) : 0.f; S[ct][j] = pv; ps += pv; }
                if (__ballot(m_new != m_run) != 0ull) {
                    const float alpha = __builtin_amdgcn_exp2f(m_run - m_new);
                    l_run *= alpha;
#pragma unroll
                    for (int mb = 0; mb < 8; ++mb) O[mb] *= alpha;
                }
                l_run += ps; m_run = m_new;
                bf16x8 bP[2];
#pragma unroll
                for (int kk = 0; kk < 2; ++kk) {
                    u32x4 t4;
                    t4[0] = pk2bf(S[2 * kk][0], S[2 * kk][1]); t4[1] = pk2bf(S[2 * kk][2], S[2 * kk][3]);
                    t4[2] = pk2bf(S[2 * kk + 1][0], S[2 * kk + 1][1]); t4[3] = pk2bf(S[2 * kk + 1][2], S[2 * kk + 1][3]);
                    bP[kk] = __builtin_bit_cast(bf16x8, t4);
                }
#pragma unroll
                for (int mb = 0; mb < 8; ++mb)
#pragma unroll
                    for (int kk = 0; kk < 2; ++kk) {
                        const LAS bf16_t* vr = VT + (mb * 16 + c) * VLD + kk * 32 + 4 * g;
                        const s16x4 lo = *(const LAS s16x4*)(vr), hi = *(const LAS s16x4*)(vr + 16);
                        const bf16x8 a = __builtin_shufflevector(lo, hi, 0, 1, 2, 3, 4, 5, 6, 7);
                        O[mb] = MFMA16(a, bP[kk], O[mb]);
                    }
                __syncthreads();
            }
            TP_END(3); TP_BEGIN(4);
            l_run += __shfl_xor(l_run, 16); l_run += __shfl_xor(l_run, 32);
            const float inv = 1.f / l_run;
            bf16x8 bO[4];
#pragma unroll
            for (int k2 = 0; k2 < 4; ++k2)
#pragma unroll
                for (int j = 0; j < 4; ++j) { bO[k2][j] = (short)f2bf(O[2 * k2][j] * inv); bO[k2][4 + j] = (short)f2bf(O[2 * k2 + 1][j] * inv); }
            bf16_t* orow = mixed + (size_t)(b * SEQ + s0 + c) * DM + 512 + h * 64;
            int zofs = 0; asm volatile("" : "+v"(zofs));
#pragma unroll
            for (int eb = 0; eb < 4; ++eb) {
                f32x4 acc = {0.f, 0.f, 0.f, 0.f};
#pragma unroll
                for (int k2 = 0; k2 < 4; ++k2) {
                    const bf16_t* wr = wuvt + (size_t)(h * 64 + eb * 16 + c) * 128 + k2 * 32 + 4 * g + zofs;
                    const s16x4 lo = *(const s16x4*)(wr), hi = *(const s16x4*)(wr + 16);
                    const bf16x8 a = __builtin_shufflevector(lo, hi, 0, 1, 2, 3, 4, 5, 6, 7);
                    acc = MFMA16(a, bO[k2], acc);
                }
                uint2 w;
                w.x = (unsigned)f2bf(acc[0]) | ((unsigned)f2bf(acc[1]) << 16);
                w.y = (unsigned)f2bf(acc[2]) | ((unsigned)f2bf(acc[3]) << 16);
                *(uint2*)(orow + eb * 16 + 4 * g) = w;
            }
            TP_END(4);
        }
    }
}

DI void phase_ret_scan(const Params& p) {
    float* ST = (float*)(p.ws + OFF_ST);
    const int gtid = blockIdx.x * NTHREADS + threadIdx.x, gsz = gridDim.x * NTHREADS;
    for (int idx = gtid; idx < 32 * 16384; idx += gsz) {
        const int bh = idx >> 14, el = idx & 16383, h = bh & 3;
        const float gc = expf(logf(1.f - exp2f(-5.f - (float)h)) * 64.f);
        float* base = ST + (size_t)bh * 34 * 16384 + el;
        float r = 0.f;
        for (int c = 1; c < 34; ++c) {
            const float u = c < 33 ? base[(size_t)c * 16384] : 0.f;
            base[(size_t)c * 16384] = r;
            r = gc * r + u;
        }
    }
}

DI void phase_ret_out(const Params& p, LAS char* smem) {
    const bf16_t* proj = (const bf16_t*)(p.ws + OFF_BIG);
    const float* ST = (const float*)(p.ws + OFF_ST);
    bf16_t* mixed = (bf16_t*)(p.ws + OFF_HN);
    LAS bf16_t* sQ = (LAS bf16_t*)smem; LAS bf16_t* sK = sQ + 64 * 128; LAS bf16_t* sV = sK + 64 * 128;
    LAS float* sS = (LAS float*)(sV + 64 * 128);
    LAS float* sR = sS + 64 * 65;
    for (int unit = blockIdx.x; unit < 1024; unit += gridDim.x) {
        const int c = 2 + (unit & 31), bh = unit >> 5, h = bh & 3, b = bh >> 2;
        for (int i = threadIdx.x; i < 64 * 16; i += NTHREADS) {
            const int j = i >> 4, ch = i & 15; const int t = 64 * c + j - 112;
            const bf16_t* pr = proj + (size_t)(b * TT + t) * INW;
            *(LAS u32x4*)(sQ + j * 128 + ch * 8) = *(const u32x4*)(pr + C_RQ + h * 128 + ch * 8);
            *(LAS u32x4*)(sK + j * 128 + ch * 8) = *(const u32x4*)(pr + C_RK + h * 128 + ch * 8);
            *(LAS u32x4*)(sV + j * 128 + ch * 8) = *(const u32x4*)(pr + C_RV + h * 128 + ch * 8);
        }
        const float* R = ST + (size_t)(bh * 34 + c) * 16384;
        for (int i = threadIdx.x; i < 16384; i += NTHREADS) sR[(i >> 7) * 129 + (i & 127)] = R[i];
        __syncthreads();
        const float lg = logf(1.f - exp2f(-5.f - (float)h));
        const int i = threadIdx.x >> 3, g8 = threadIdx.x & 7;
        {
            float sacc[8];
#pragma unroll
            for (int jj = 0; jj < 8; ++jj) sacc[jj] = 0.f;
            for (int d = 0; d < 128; ++d) {
                const float qv = bf2f(sQ[i * 128 + d]);
#pragma unroll
                for (int jj = 0; jj < 8; ++jj) sacc[jj] += qv * bf2f(sK[(jj * 8 + g8) * 128 + d]);
            }
#pragma unroll
            for (int jj = 0; jj < 8; ++jj) { const int j = jj * 8 + g8; const int df = i > j ? i - j : j - i; sS[i * 65 + j] = sacc[jj] * expf(lg * (float)df); }
        }
        __syncthreads();
        float o[16];
#pragma unroll
        for (int ee = 0; ee < 16; ++ee) o[ee] = 0.f;
        for (int j = 0; j < 64; ++j) {
            const float sv = sS[i * 65 + j];
#pragma unroll
            for (int ee = 0; ee < 16; ++ee) o[ee] += sv * bf2f(sV[j * 128 + ee * 8 + g8]);
        }
        const float xi = expf(lg * (float)(i + 1));
        for (int d = 0; d < 128; ++d) {
            const float qv = bf2f(sQ[i * 128 + d]) * xi;
#pragma unroll
            for (int ee = 0; ee < 16; ++ee) o[ee] += qv * sR[(ee * 8 + g8) * 129 + d];
        }
        float sum = 0.f;
#pragma unroll
        for (int ee = 0; ee < 16; ++ee) sum += o[ee];
        sum += __shfl_xor(sum, 1); sum += __shfl_xor(sum, 2); sum += __shfl_xor(sum, 4);
        const float mu = sum * (1.f / 128.f);
        float var = 0.f;
#pragma unroll
        for (int ee = 0; ee < 16; ++ee) { const float dlt = o[ee] - mu; var += dlt * dlt; }
        var += __shfl_xor(var, 1); var += __shfl_xor(var, 2); var += __shfl_xor(var, 4);
        const float rs = rsqrtf(var * (1.f / 128.f) + 1e-6f);
        const int t = 64 * c + i - 112, srow = t - NMETA;
        const bf16_t* pg = proj + (size_t)(b * TT + t) * INW + C_RG + h * 128;
        bf16_t* po = mixed + (size_t)(b * SEQ + srow) * DM + h * 128;
#pragma unroll
        for (int ee = 0; ee < 16; ++ee) {
            const int e = ee * 8 + g8;
            const float g = bf2f(pg[e]);
            const float gate = g / (1.f + expf(-g));
            po[e] = f2bf(gate * (o[ee] - mu) * rs);
        }
        __syncthreads();
    }
}

#define MFMA32(a, b, c) __builtin_amdgcn_mfma_f32_32x32x16_bf16((a), (b), (c), 0, 0, 0)
constexpr int RLD = 136, RTLD = 72;
DI void phase_ret_state_mfma(const Params& p, LAS char* smem) {
    const bf16_t* proj = (const bf16_t*)(p.ws + OFF_BIG);
    float* ST = (float*)(p.ws + OFF_ST);
    LAS bf16_t* sVT = (LAS bf16_t*)smem; LAS bf16_t* sKT = sVT + 128 * RTLD;
    const int wave = threadIdx.x >> 6, lane = threadIdx.x & 63, r = lane & 31, hh = lane >> 5;
    for (int unit = blockIdx.x; unit < 1024; unit += gridDim.x) {
        const int c = 1 + (unit & 31), bh = unit >> 5, h = bh & 3, b = bh >> 2;
        const float lg = logf(1.f - exp2f(-5.f - (float)h));
        {
            const int j = threadIdx.x >> 3, ch = threadIdx.x & 7, t = 64 * c + j - 112;
            const float z = expf(lg * (float)(63 - j));
#pragma unroll
            for (int q = 0; q < 2; ++q) {
                const int cc = ch + 8 * q;
                u32x4 kv = {0u, 0u, 0u, 0u}, vv = {0u, 0u, 0u, 0u};
                if (t >= 0) { const bf16_t* pr = proj + (size_t)(b * TT + t) * INW; kv = *(const u32x4*)(pr + C_RK + h * 128 + cc * 8); vv = *(const u32x4*)(pr + C_RV + h * 128 + cc * 8); }
                float vf[8]; unpack8(vv, vf);
#pragma unroll
                for (int x = 0; x < 8; ++x) {
                    sKT[(cc * 8 + x) * RTLD + j] = (bf16_t)((kv[x >> 1] >> ((x & 1) * 16)) & 0xffffu);
                    sVT[(cc * 8 + x) * RTLD + j] = f2bf(vf[x] * z);
                }
            }
        }
        __syncthreads();
        const int mb = wave >> 1;
#pragma unroll
        for (int q = 0; q < 2; ++q) {
            const int nb = (wave & 1) * 2 + q;
            f32x16 acc;
#pragma unroll
            for (int i = 0; i < 16; ++i) acc[i] = 0.f;
#pragma unroll
            for (int ks = 0; ks < 4; ++ks) {
                const bf16x8 a = *(const LAS bf16x8*)(sVT + (mb * 32 + r) * RTLD + ks * 16 + 8 * hh);
                const bf16x8 bb = *(const LAS bf16x8*)(sKT + (nb * 32 + r) * RTLD + ks * 16 + 8 * hh);
                acc = MFMA32(a, bb, acc);
            }
            float* st = ST + (size_t)(bh * 34 + c) * 16384 + nb * 32 + r;
#pragma unroll
            for (int i = 0; i < 16; ++i) st[(size_t)(mb * 32 + (i & 3) + 8 * (i >> 2) + 4 * hh) * 128] = acc[i];
        }
        __syncthreads();
    }
}
DI void phase_ret_out_mfma(const Params& p, LAS char* smem) {
    const bf16_t* proj = (const bf16_t*)(p.ws + OFF_BIG);
    const float* ST = (const float*)(p.ws + OFF_ST);
    bf16_t* mixed = (bf16_t*)(p.ws + OFF_HN);
    LAS bf16_t* sQ = (LAS bf16_t*)smem; LAS bf16_t* sK = sQ + 64 * RLD; LAS bf16_t* sVT = sK + 64 * RLD;
    LAS float* sGN = (LAS float*)(sVT + 128 * RTLD);
    const int wave = threadIdx.x >> 6, lane = threadIdx.x & 63, r = lane & 31, hh = lane >> 5;
    const int ib = wave & 1, eb = wave >> 1;
    for (int unit = blockIdx.x; unit < 1024; unit += gridDim.x) {
        const int c = 2 + (unit & 31), bh = unit >> 5, h = bh & 3, b = bh >> 2;
        const float lg = logf(1.f - exp2f(-5.f - (float)h));
        for (int i = threadIdx.x; i < 64 * 16; i += NTHREADS) {
            const int j = i >> 4, ch = i & 15; const int t = 64 * c + j - 112;
            const bf16_t* pr = proj + (size_t)(b * TT + t) * INW;
            *(LAS u32x4*)(sQ + j * RLD + ch * 8) = *(const u32x4*)(pr + C_RQ + h * 128 + ch * 8);
            *(LAS u32x4*)(sK + j * RLD + ch * 8) = *(const u32x4*)(pr + C_RK + h * 128 + ch * 8);
            const u32x4 vv = *(const u32x4*)(pr + C_RV + h * 128 + ch * 8);
#pragma unroll
            for (int x = 0; x < 8; ++x) sVT[(ch * 8 + x) * RTLD + j] = (bf16_t)((vv[x >> 1] >> ((x & 1) * 16)) & 0xffffu);
        }
        __syncthreads();
        f32x16 acc;
#pragma unroll
        for (int i = 0; i < 16; ++i) acc[i] = 0.f;
        {
            const float* R = ST + (size_t)(bh * 34 + c) * 16384 + (size_t)(eb * 32 + r) * 128 + 8 * hh;
#pragma unroll
            for (int ks = 0; ks < 8; ++ks) {
                const float4 r0 = *(const float4*)(R + ks * 16), r1 = *(const float4*)(R + ks * 16 + 4);
                const float rf[8] = {r0.x, r0.y, r0.z, r0.w, r1.x, r1.y, r1.z, r1.w};
                const bf16x8 a = pack8(rf);
                const bf16x8 bq = *(const LAS bf16x8*)(sQ + (ib * 32 + r) * RLD + ks * 16 + 8 * hh);
                acc = MFMA32(a, bq, acc);
            }
            const float xi = expf(lg * (float)(ib * 32 + r + 1));
#pragma unroll
            for (int i = 0; i < 16; ++i) acc[i] *= xi;
        }
#pragma unroll
        for (int jb = 0; jb < 2; ++jb) {
            f32x16 st;
#pragma unroll
            for (int i = 0; i < 16; ++i) st[i] = 0.f;
#pragma unroll
            for (int ks = 0; ks < 8; ++ks) {
                const bf16x8 a = *(const LAS bf16x8*)(sK + (jb * 32 + r) * RLD + ks * 16 + 8 * hh);
                const bf16x8 bq = *(const LAS bf16x8*)(sQ + (ib * 32 + r) * RLD + ks * 16 + 8 * hh);
                st = MFMA32(a, bq, st);
            }
            const int icol = ib * 32 + r;
#pragma unroll
            for (int i = 0; i < 16; ++i) {
                const int j = jb * 32 + (i & 3) + 8 * (i >> 2) + 4 * hh; const int df = icol > j ? icol - j : j - icol;
                st[i] *= expf(lg * (float)df);
            }
#pragma unroll
            for (int s2 = 0; s2 < 2; ++s2) {
                bf16x8 bp;
#pragma unroll
                for (int x = 0; x < 8; ++x) bp[x] = (short)f2bf(st[8 * s2 + x]);
                const LAS bf16_t* vr = sVT + (eb * 32 + r) * RTLD + jb * 32 + 16 * s2 + 4 * hh;
                const s16x4 lo = *(const LAS s16x4*)(vr), hi = *(const LAS s16x4*)(vr + 8);
                const bf16x8 a = __builtin_shufflevector(lo, hi, 0, 1, 2, 3, 4, 5, 6, 7);
                acc = MFMA32(a, bp, acc);
            }
        }
        float s1 = 0.f, s2 = 0.f;
#pragma unroll
        for (int i = 0; i < 16; ++i) { s1 += acc[i]; s2 += acc[i] * acc[i]; }
        s1 += __shfl_xor(s1, 32); s2 += __shfl_xor(s2, 32);
        if (hh == 0) { sGN[(eb * 64 + ib * 32 + r) * 2] = s1; sGN[(eb * 64 + ib * 32 + r) * 2 + 1] = s2; }
        __syncthreads();
        float S1 = 0.f, S2 = 0.f;
#pragma unroll
        for (int e4 = 0; e4 < 4; ++e4) { S1 += sGN[(e4 * 64 + ib * 32 + r) * 2]; S2 += sGN[(e4 * 64 + ib * 32 + r) * 2 + 1]; }
        const float mu = S1 * (1.f / 128.f), var = fmaxf(S2 * (1.f / 128.f) - mu * mu, 0.f), rs = rsqrtf(var + 1e-6f);
        const int t = 64 * c + ib * 32 + r - 112, srow = t - NMETA;
        const bf16_t* pg = proj + (size_t)(b * TT + t) * INW + C_RG + h * 128 + eb * 32 + 4 * hh;
        bf16_t* po = mixed + (size_t)(b * SEQ + srow) * DM + h * 128 + eb * 32 + 4 * hh;
#pragma unroll
        for (int g4 = 0; g4 < 4; ++g4) {
            const uint2 graw = *(const uint2*)(pg + 8 * g4);
            const float gv[4] = {__uint_as_float(graw.x << 16), __uint_as_float(graw.x & 0xffff0000u), __uint_as_float(graw.y << 16), __uint_as_float(graw.y & 0xffff0000u)};
            float o[4];
#pragma unroll
            for (int x = 0; x < 4; ++x) { const float gate = gv[x] / (1.f + expf(-gv[x])); o[x] = gate * (acc[4 * g4 + x] - mu) * rs; }
            uint2 w; w.x = (unsigned)f2bf(o[0]) | ((unsigned)f2bf(o[1]) << 16); w.y = (unsigned)f2bf(o[2]) | ((unsigned)f2bf(o[3]) << 16);
            *(uint2*)(po + 8 * g4) = w;
        }
        __syncthreads();
    }
}

DI void phase_norm2(const Params& p) {
    bf16_t* hn2 = (bf16_t*)(p.ws + OFF_HN);
    const int wave = threadIdx.x >> 6, lane = threadIdx.x & 63;
    for (int row = blockIdx.x * NWAVES + wave; row < NF; row += gridDim.x * NWAVES) {
        const float* src = p.out + (size_t)row * DM; bf16_t* o = hn2 + (size_t)row * DM;
        float4 v[4]; float ss = 0.f;
#pragma unroll
        for (int i = 0; i < 4; ++i) { v[i] = *(const float4*)(src + i * 256 + lane * 4); ss += v[i].x * v[i].x + v[i].y * v[i].y + v[i].z * v[i].z + v[i].w * v[i].w; }
        ss = wave_sum(ss);
        const float rstd = rsqrtf(ss * (1.f / DM) + 1e-6f);
#pragma unroll
        for (int i = 0; i < 4; ++i) {
            const float4 g = *(const float4*)(p.norm_ffn + i * 256 + lane * 4);
            uint2 w;
            w.x = (unsigned)f2bf(v[i].x * rstd * g.x) | ((unsigned)f2bf(v[i].y * rstd * g.y) << 16);
            w.y = (unsigned)f2bf(v[i].z * rstd * g.z) | ((unsigned)f2bf(v[i].w * rstd * g.w) << 16);
            *(uint2*)(o + i * 256 + lane * 4) = w;
        }
    }
}

constexpr int PSEL_WAVE_LDS = 32 * 2 * 16 * 8 + 32 * 16 * 8;
DI void phase_peer_select(const Params& p, LAS char* smem) {
    const float* PQ = (const float*)(p.ws + OFF_BIG);
    const bf16_t* SKH = (const bf16_t*)(p.ws + OFF_SKH); const bf16_t* SKL = (const bf16_t*)(p.ws + OFF_SKL);
    int* EIDX = (int*)(p.ws + OFF_EIDX); float* GATE = (float*)(p.ws + OFF_GATE);
    const int wave = threadIdx.x >> 6, lane = threadIdx.x & 63, r = lane & 31, hh = lane >> 5;
    LAS float* lv = (LAS float*)(smem + wave * PSEL_WAVE_LDS);
    LAS int* li = (LAS int*)(lv + 32 * 2 * 16);
    LAS float* cs = (LAS float*)(li + 32 * 2 * 16);
    LAS int* cab = (LAS int*)(cs + 32 * 16);
    for (int task = blockIdx.x * NWAVES + wave; task < (NF / 32) * 8; task += gridDim.x * NWAVES) {
        const int tile = task >> 3, h = task & 7;
        const int n = tile * 32 + r;
        for (int half = 0; half < 2; ++half) {
            f32x16 acc[4];
#pragma unroll
            for (int mb = 0; mb < 4; ++mb)
#pragma unroll
                for (int i = 0; i < 16; ++i) acc[mb][i] = 0.f;
            const float* qrow = PQ + (size_t)n * 2048 + h * 256 + half * 128 + 8 * hh;
            const bf16_t* kh = SKH + (size_t)((h * 2 + half) * 128 + r) * 128 + 8 * hh;
            const bf16_t* kl = SKL + (size_t)((h * 2 + half) * 128 + r) * 128 + 8 * hh;
#pragma unroll 1
            for (int ks = 0; ks < 8; ++ks) {
                const float4 q0 = *(const float4*)(qrow + ks * 16), q1 = *(const float4*)(qrow + ks * 16 + 4);
                float qf[8] = {q0.x, q0.y, q0.z, q0.w, q1.x, q1.y, q1.z, q1.w}, qr[8];
                const bf16x8 bh = pack_hi8(qf, qr); const bf16x8 bl = pack8(qr);
#pragma unroll
                for (int mb = 0; mb < 4; ++mb) {
                    const bf16x8 ah = *(const bf16x8*)(kh + (size_t)mb * 32 * 128 + ks * 16);
                    const bf16x8 al = *(const bf16x8*)(kl + (size_t)mb * 32 * 128 + ks * 16);
                    acc[mb] = __builtin_amdgcn_mfma_f32_32x32x16_bf16(ah, bh, acc[mb], 0, 0, 0);
                    acc[mb] = __builtin_amdgcn_mfma_f32_32x32x16_bf16(ah, bl, acc[mb], 0, 0, 0);
                    acc[mb] = __builtin_amdgcn_mfma_f32_32x32x16_bf16(al, bh, acc[mb], 0, 0, 0);
                }
            }
            float mprev = INFINITY;
#pragma unroll 1
            for (int it = 0; it < 16; ++it) {
                float m = -INFINITY;
#pragma unroll
                for (int mb = 0; mb < 4; ++mb)
#pragma unroll
                    for (int i = 0; i < 16; ++i) { const float v = acc[mb][i]; m = fmaxf(m, v < mprev ? v : -INFINITY); }
                m = fmaxf(m, __shfl_xor(m, 32));
                mprev = m;
            }
            const float T = mprev;
            int cnt = 0;
#pragma unroll
            for (int mb = 0; mb < 4; ++mb)
#pragma unroll
                for (int i = 0; i < 16; ++i) cnt += (acc[mb][i] >= T) ? 1 : 0;
            const int pc = __shfl_xor(cnt, 32);
            int pos = hh ? pc : 0;
            LAS float* lvp = lv + (r * 2 + half) * 16; LAS int* lip = li + (r * 2 + half) * 16;
#pragma unroll
            for (int mb = 0; mb < 4; ++mb)
#pragma unroll
                for (int i = 0; i < 16; ++i) {
                    const float v = acc[mb][i];
                    if (v >= T) { if (pos < 16) { lvp[pos] = v; lip[pos] = mb * 32 + (i & 3) + 8 * (i >> 2) + 4 * hh; } ++pos; }
                }
        }
        lds_fence();
        float v1[8], v2[16];
#pragma unroll
        for (int a = 0; a < 8; ++a) v1[a] = lv[(r * 2 + 0) * 16 + 8 * hh + a];
#pragma unroll
        for (int b = 0; b < 16; ++b) v2[b] = lv[(r * 2 + 1) * 16 + b];
        float mprev = INFINITY;
#pragma unroll 1
        for (int it = 0; it < 16; ++it) {
            float m = -INFINITY;
#pragma unroll
            for (int a = 0; a < 8; ++a)
#pragma unroll
                for (int b = 0; b < 16; ++b) { const float v = v1[a] + v2[b]; m = fmaxf(m, v < mprev ? v : -INFINITY); }
            m = fmaxf(m, __shfl_xor(m, 32));
            mprev = m;
        }
        const float Tc = mprev;
        int cnt = 0;
#pragma unroll
        for (int a = 0; a < 8; ++a)
#pragma unroll
            for (int b = 0; b < 16; ++b) cnt += (v1[a] + v2[b] >= Tc) ? 1 : 0;
        const int pc = __shfl_xor(cnt, 32);
        int pos = hh ? pc : 0;
#pragma unroll
        for (int a = 0; a < 8; ++a)
#pragma unroll
            for (int b = 0; b < 16; ++b) {
                const float v = v1[a] + v2[b];
                if (v >= Tc) { if (pos < 16) { cs[r * 16 + pos] = v; cab[r * 16 + pos] = (8 * hh + a) * 16 + b; } ++pos; }
            }
        lds_fence();
        float scv[16]; float mx = -INFINITY;
#pragma unroll
        for (int i = 0; i < 16; ++i) { scv[i] = cs[r * 16 + i]; mx = fmaxf(mx, scv[i]); }
        float sum = 0.f;
#pragma unroll
        for (int i = 0; i < 16; ++i) { scv[i] = expf(scv[i] - mx); sum += scv[i]; }
        const float inv = 1.f / sum;
#pragma unroll
        for (int i = 0; i < 16; ++i) {
            if ((i >> 3) == hh) {
                const int ab = cab[r * 16 + i];
                const int e = li[(r * 2 + 0) * 16 + (ab >> 4)] * 128 + li[(r * 2 + 1) * 16 + (ab & 15)];
                EIDX[(size_t)n * 128 + h * 16 + i] = e;
                GATE[(size_t)n * 128 + h * 16 + i] = scv[i] * inv;
            }
        }
        lds_fence();
    }
}

typedef float f32x2 __attribute__((ext_vector_type(2)));
DI void phase_convert_tables(const Params& p) {
    const int wave = threadIdx.x >> 6, lane = threadIdx.x & 63;
    for (int rowi = blockIdx.x * NWAVES + wave; rowi < 2 * 16384; rowi += gridDim.x * NWAVES) {
        const bool isv = rowi >= 16384; const int e = isv ? rowi - 16384 : rowi;
        const float* src = (isv ? p.pv : p.pu) + (size_t)e * DM + lane * 16;
        float x[16]; float mx = 0.f;
#pragma unroll
        for (int i = 0; i < 4; ++i) { const float4 a = *(const float4*)(src + i * 4); x[i * 4] = a.x; x[i * 4 + 1] = a.y; x[i * 4 + 2] = a.z; x[i * 4 + 3] = a.w; }
#pragma unroll
        for (int i = 0; i < 16; ++i) mx = fmaxf(mx, fabsf(x[i]));
        mx = wave_max(mx);
        const float inv = mx > 0.f ? 240.f / mx : 0.f, scale = mx > 0.f ? mx * (1.f / 240.f) : 0.f;
        u32x4 o;
#pragma unroll
        for (int w = 0; w < 4; ++w) {
            int pk = 0;
            pk = __builtin_amdgcn_cvt_pk_fp8_f32(x[w * 4] * inv, x[w * 4 + 1] * inv, pk, false);
            pk = __builtin_amdgcn_cvt_pk_fp8_f32(x[w * 4 + 2] * inv, x[w * 4 + 3] * inv, pk, true);
            o[w] = (unsigned)pk;
        }
        *(u32x4*)(p.ws + (isv ? OFF_V8 : OFF_U8) + (size_t)e * DM + lane * 16) = o;
        if (lane == 0) ((float*)(p.ws + (isv ? OFF_SV : OFF_SU)))[e] = scale;
    }
}
DI void unpack16_fp8(const u32x4& r, float (&v)[16]) {
#pragma unroll
    for (int w = 0; w < 4; ++w) {
        const f32x2 a = __builtin_amdgcn_cvt_pk_f32_fp8((int)r[w], false), b = __builtin_amdgcn_cvt_pk_f32_fp8((int)r[w], true);
        v[w * 4] = a[0]; v[w * 4 + 1] = a[1]; v[w * 4 + 2] = b[0]; v[w * 4 + 3] = b[1];
    }
}
#ifndef P10_REP
#define P10_REP 1
#endif
DI void phase_peer_out(const Params& p) {
    const int* EIDX = (const int*)(p.ws + OFF_EIDX); const float* GATE = (const float*)(p.ws + OFF_GATE);
    const char* U8 = p.ws + OFF_U8; const char* V8 = p.ws + OFF_V8;
    const float* SU = (const float*)(p.ws + OFF_SU); const float* SV = (const float*)(p.ws + OFF_SV);
    const int wave = threadIdx.x >> 6, lane = threadIdx.x & 63;
    for (int n = blockIdx.x * NWAVES + wave; n < NF; n += gridDim.x * NWAVES) {
        float* row = p.out + (size_t)n * DM + lane * 16;
        float hv[16], hn[16]; float ss = 0.f;
#pragma unroll
        for (int i = 0; i < 4; ++i) { const float4 a = *(const float4*)(row + i * 4); hv[i * 4] = a.x; hv[i * 4 + 1] = a.y; hv[i * 4 + 2] = a.z; hv[i * 4 + 3] = a.w; }
#pragma unroll
        for (int i = 0; i < 16; ++i) ss += hv[i] * hv[i];
        ss = wave_sum_uniform(ss);
        const float rstd = rsqrtf(ss * (1.f / DM) + 1e-6f);
#pragma unroll
        for (int i = 0; i < 4; ++i) {
            const float4 a = *(const float4*)(p.norm_ffn + lane * 16 + i * 4);
            hn[i * 4] = hv[i * 4] * rstd * a.x; hn[i * 4 + 1] = hv[i * 4 + 1] * rstd * a.y; hn[i * 4 + 2] = hv[i * 4 + 2] * rstd * a.z; hn[i * 4 + 3] = hv[i * 4 + 3] * rstd * a.w;
        }
        float acc[16];
#pragma unroll
        for (int i = 0; i < 16; ++i) acc[i] = 0.f;
        const int e_lo = EIDX[(size_t)n * 128 + lane], e_hi = EIDX[(size_t)n * 128 + 64 + lane];
        const float g_lo = GATE[(size_t)n * 128 + lane], g_hi = GATE[(size_t)n * 128 + 64 + lane];
#pragma unroll 1
        for (int s0_ = 0; s0_ < 128 * P10_REP; s0_ += 8) {
            const int s0 = s0_ & 127;
            u32x4 ub[8], vb[8]; float gt[8], su[8], sv[8];
#pragma unroll
            for (int k = 0; k < 8; ++k) {
                const int slot = s0 + k;
                const int e = slot < 64 ? __builtin_amdgcn_readlane(e_lo, slot & 63) : __builtin_amdgcn_readlane(e_hi, slot & 63);
                gt[k] = __int_as_float(slot < 64 ? __builtin_amdgcn_readlane(__float_as_int(g_lo), slot & 63) : __builtin_amdgcn_readlane(__float_as_int(g_hi), slot & 63));
                ub[k] = *(const u32x4*)(U8 + (size_t)e * DM + lane * 16);
                vb[k] = *(const u32x4*)(V8 + (size_t)e * DM + lane * 16);
                su[k] = SU[e]; sv[k] = SV[e];
            }
            float d[8];
#pragma unroll
            for (int k = 0; k < 8; ++k) {
                float u[16]; unpack16_fp8(ub[k], u);
                float t = 0.f;
#pragma unroll
                for (int i = 0; i < 16; ++i) t += u[i] * hn[i];
                d[k] = t;
            }
#pragma unroll
            for (int k = 0; k < 8; ++k) d[k] = wave_sum_uniform(d[k]) * su[k];
#pragma unroll
            for (int k = 0; k < 8; ++k) {
                const float coef = 0.5f * d[k] * (1.f + erff(d[k] * 0.70710678118654752f)) * gt[k] * sv[k];
                float v[16]; unpack16_fp8(vb[k], v);
#pragma unroll
                for (int i = 0; i < 16; ++i) acc[i] += coef * v[i];
            }
        }
        float s2 = 0.f;
#pragma unroll
        for (int i = 0; i < 16; ++i) { acc[i] = acc[i] * (1.f / P10_REP) + hv[i]; s2 += acc[i] * acc[i]; }
        s2 = wave_sum_uniform(s2);
        float r2 = rsqrtf(s2 * (1.f / DM) + 1e-6f);
#if TP_SEC
        r2 *= 1.f + 0.5f * ((const float*)(p.ws + OFF_BAR))[3602];
#endif
#ifdef DSA_CHECK
        {
            const float num = ((const float*)(p.ws + OFF_BAR))[3600], den = ((const float*)(p.ws + OFF_BAR))[3601];
            r2 *= 1.f + 10.f * sqrtf(num / fmaxf(den, 1e-30f));
        }
#endif
#pragma unroll
        for (int i = 0; i < 4; ++i) {
            const float4 a = *(const float4*)(p.norm_final + lane * 16 + i * 4);
            *(float4*)(row + i * 4) = make_float4(acc[i * 4] * r2 * a.x, acc[i * 4 + 1] * r2 * a.y, acc[i * 4 + 2] * r2 * a.z, acc[i * 4 + 3] * r2 * a.w);
        }
    }
}

constexpr int NPHASES = 10;
__global__ void __launch_bounds__(NTHREADS, 2) mk_forward(Params p) {
    extern __shared__ __attribute__((aligned(16))) char dyn_smem[];
    LAS char* smem = (LAS char*)dyn_smem;
    const bool multi = (p.hi - p.lo) > 1;
    LAS char* tp_smem = smem;
    if (TP_SEC && blockIdx.x == 0 && threadIdx.x == 0) { volatile LAS long long* tp_ = (volatile LAS long long*)(smem + TP_LDS_OFF); tp_[0] = (long long)__builtin_readcyclecounter(); tp_[2] = 0; }
    XcdBarrier bar; bar.bar = (unsigned*)(p.ws + OFF_BAR); bar.x = 0; bar.st = (volatile LAS unsigned*)(smem + LDS_BAR_OFF);
    if (multi) {
        if (threadIdx.x == 0) { const u32x4 z = {0u, 0u, 0u, 0u}; *(LAS u32x4*)(smem + LDS_BAR_OFF) = z; }
        __syncthreads();
        bar = xcd_barrier_post((unsigned*)(p.ws + OFF_BAR), (volatile LAS unsigned*)(smem + LDS_BAR_OFF));
    }
#ifndef PHMASK
#define PHMASK 0xFFFF
#endif
#define PH_ON(i) (((PHMASK >> (i)) & 1) && p.lo <= (i) && (i) < p.hi)
#define PH_SYNC(i) do { if (multi && (i) + 1 < p.hi) { TP_BEGIN(7); xcd_barrier(bar); TP_END(7); } } while (0)
#ifndef REPEAT_MASK
#define REPEAT_MASK 0
#endif
#define PH_REP(i) for (int rep_ = 0; rep_ < 1 + ((REPEAT_MASK >> (i)) & 1); ++rep_)
    if (PH_ON(0)) { TP_BEGIN(8); PH_REP(0) phase_prologue(p); TP_END(8); PH_SYNC(0); }
    if (PH_ON(1)) { TP_BEGIN(9); PH_REP(1) { EpiProj e; e.P = (bf16_t*)(p.ws + OFF_BIG); gemm256((const bf16_t*)(p.ws + OFF_HN), (const bf16_t*)(p.ws + OFF_WINT), 1024, MPAD / 256, 4096 / 256, (LAS bf16_t*)smem, e); } TP_END(9); PH_SYNC(1); }
    if (PH_ON(2)) { TP_BEGIN(5); phase_rope(p, smem); TP_END(5); PH_SYNC(2); }
    if (PH_ON(3)) { PH_REP(3) {
#ifndef RS_REP
#define RS_REP 1
#endif
#ifndef DSA_REP
#define DSA_REP 1
#endif
            for (int rr_ = 0; rr_ < RS_REP; ++rr_) phase_ret_state_mfma(p, smem);
            for (int rr_ = 0; rr_ < DSA_REP; ++rr_) { phase_dsa_fast(p, smem); __syncthreads(); }
#ifdef DSA_CHECK
            __syncthreads(); xcd_barrier(bar); phase_dsa_naive<true>(p, smem);
#endif
        } PH_SYNC(3); }
    if (PH_ON(4)) { TP_BEGIN(6); phase_ret_scan(p); TP_END(6); PH_SYNC(4); }
    if (PH_ON(5)) { PH_REP(5) phase_ret_out_mfma(p, smem); PH_SYNC(5); }
    if (PH_ON(6)) { PH_REP(6) { EpiOut e; e.H = p.out; e.X = p.x; gemm256((const bf16_t*)(p.ws + OFF_HN), (const bf16_t*)(p.ws + OFF_WOUTT), 1024, NF / 256, 1024 / 256, (LAS bf16_t*)smem, e); } PH_SYNC(6); }
    if (PH_ON(7)) { PH_REP(7) phase_norm2(p); PH_SYNC(7); }
    if (PH_ON(8)) { PH_REP(8) { EpiPQ e; e.Q = (float*)(p.ws + OFF_BIG); gemm256((const bf16_t*)(p.ws + OFF_HN), (const bf16_t*)(p.ws + OFF_WQT), 1024, NF / 256, 2048 / 256, (LAS bf16_t*)smem, e); } PH_SYNC(8); }
    if (PH_ON(9)) { PH_REP(9) { phase_peer_select(p, smem); phase_convert_tables(p); }
        if (TP_SEC && blockIdx.x == 0 && threadIdx.x == 0) { volatile LAS long long* tp_ = (volatile LAS long long*)(smem + TP_LDS_OFF); const float fr = (float)tp_[2] / (float)((long long)__builtin_readcyclecounter() - tp_[0]); ((float*)(p.ws + OFF_BAR))[3602] = fr; }
        PH_SYNC(9); }
    if (PH_ON(10)) { phase_peer_out(p); }
}

extern "C" void kernel_launch(void* const* d_in, const int* in_sizes, int n_in, void* d_out, int out_size, void* d_ws, size_t ws_size, hipStream_t stream) {
    static int grid = 0;
    if (grid == 0) {
        if (n_in != 12 || out_size != NF * DM || ws_size < WS_END) { fprintf(stderr, "kernel_launch: unexpected shapes (n_in %d out %d ws %zu need %zu)\n", n_in, out_size, ws_size, (size_t)WS_END); grid = -1; return; }
        int dev = 0, cus = 0, per_cu = 0;
        if (hipGetDevice(&dev) != hipSuccess || hipDeviceGetAttribute(&cus, hipDeviceAttributeMultiprocessorCount, dev) != hipSuccess) { grid = -1; return; }
        if (hipFuncSetAttribute((const void*)mk_forward, hipFuncAttributeMaxDynamicSharedMemorySize, LDS_BYTES) != hipSuccess) { fprintf(stderr, "kernel_launch: hipFuncSetAttribute failed\n"); grid = -1; return; }
        if (hipOccupancyMaxActiveBlocksPerMultiprocessor(&per_cu, (const void*)mk_forward, NTHREADS, LDS_BYTES) != hipSuccess || per_cu < 1)
            fprintf(stderr, "kernel_launch: occupancy query reports %d blocks per CU\n", per_cu);
        (void)hipGetLastError();
        grid = cus > 0 ? cus : 256;
    }
    if (grid < 0) return;
    Params p{};
    p.x = (const float*)d_in[0]; p.meta = (const float*)d_in[1]; p.norm_mix = (const float*)d_in[2]; p.w_in = (const float*)d_in[3];
    p.w_uv = (const float*)d_in[4]; p.w_out = (const float*)d_in[5]; p.norm_ffn = (const float*)d_in[6]; p.wq = (const float*)d_in[7];
    p.sk = (const float*)d_in[8]; p.pu = (const float*)d_in[9]; p.pv = (const float*)d_in[10]; p.norm_final = (const float*)d_in[11];
    p.out = (float*)d_out; p.ws = (char*)d_ws; p.pad0 = 0; p.pad1 = 0;
    (void)hipMemsetAsync((char*)d_ws + OFF_BAR, 0, 16384, stream);
#if MK_LAUNCHES == 1
    p.lo = 0; p.hi = NPHASES + 1;
    hipLaunchKernelGGL(mk_forward, dim3(grid), dim3(NTHREADS), LDS_BYTES, stream, p);
#else
    for (int ph = 0; ph <= NPHASES; ++ph) { p.lo = ph; p.hi = ph + 1; hipLaunchKernelGGL(mk_forward, dim3(grid), dim3(NTHREADS), LDS_BYTES, stream, p); }
#endif
}
```

```cpp
#include <hip/hip_runtime.h>
#include <stdint.h>
#include <stdio.h>

#ifndef MK_LAUNCHES
#define MK_LAUNCHES 1
#endif

#define DI __device__ __forceinline__
#ifndef TP_SEC
#define TP_SEC 0
#endif
#define TP_LDS_OFF (163840 - 128)
#define TP_BEGIN(k) do { if (TP_SEC == (k) && blockIdx.x == 0 && threadIdx.x == 0) { *(volatile __attribute__((address_space(3))) long long*)(tp_smem + TP_LDS_OFF + 8) = (long long)__builtin_readcyclecounter(); } } while (0)
#define TP_END(k) do { if (TP_SEC == (k) && blockIdx.x == 0 && threadIdx.x == 0) { volatile __attribute__((address_space(3))) long long* tp_ = (volatile __attribute__((address_space(3))) long long*)(tp_smem + TP_LDS_OFF); tp_[2] += (long long)__builtin_readcyclecounter() - tp_[1]; } } while (0)
typedef unsigned short bf16_t;
typedef short bf16x8 __attribute__((ext_vector_type(8)));
typedef float f32x4 __attribute__((ext_vector_type(4)));
typedef unsigned u32x4 __attribute__((ext_vector_type(4)));

constexpr int NB = 8, SEQ = 2048, NMETA = 16, TT = 2064, DM = 1024, INW = 3912;
constexpr int MROWS = NB * TT;
constexpr int MPAD = 16640;
constexpr int NF = NB * SEQ;
constexpr int C_RQ = 0, C_RK = 512, C_RV = 1024, C_RG = 1536, C_DQ = 2048, C_DK = 3072, C_DV = 3200, C_IQ = 3328, C_IK = 3840, C_IW = 3904;
constexpr int NTHREADS = 512, NWAVES = 8;
constexpr int LDS_BYTES = 163840;
constexpr int LDS_BAR_OFF = 163840 - 256;

constexpr size_t al256(size_t x) { return (x + 255) & ~(size_t)255; }
constexpr size_t OFF_BAR = 0;
constexpr size_t OFF_COS128 = 16384;
constexpr size_t OFF_SIN128 = OFF_COS128 + al256((size_t)TT * 64 * 4);
constexpr size_t OFF_COS64 = OFF_SIN128 + al256((size_t)TT * 64 * 4);
constexpr size_t OFF_SIN64 = OFF_COS64 + al256((size_t)TT * 32 * 4);
constexpr size_t OFF_WINT = OFF_SIN64 + al256((size_t)TT * 32 * 4);
constexpr size_t OFF_WOUTT = OFF_WINT + (size_t)4096 * 1024 * 2;
constexpr size_t OFF_WQT = OFF_WOUTT + (size_t)1024 * 1024 * 2;
constexpr size_t OFF_SKH = OFF_WQT + (size_t)2048 * 1024 * 2;
constexpr size_t OFF_SKL = OFF_SKH + (size_t)2048 * 128 * 2;
constexpr int TTP = 2112;
constexpr size_t OFF_WUVT = OFF_SKL + (size_t)2048 * 128 * 2;
constexpr size_t OFF_DVT = OFF_WUVT + (size_t)8 * 64 * 128 * 2;
constexpr size_t OFF_HN = OFF_DVT + (size_t)NB * 128 * TTP * 2;
constexpr size_t OFF_BIG = OFF_HN + (size_t)MPAD * 1024 * 2;
constexpr size_t BIG_BYTES = (size_t)NF * 2048 * 4;
constexpr size_t OFF_ST = OFF_BIG + al256(BIG_BYTES);
constexpr size_t ST_BYTES = (size_t)32 * 34 * 16384 * 4;
constexpr size_t WS_END = OFF_ST + ST_BYTES;
constexpr size_t OFF_EIDX = OFF_ST, OFF_GATE = OFF_ST + (size_t)NF * 128 * 4;
constexpr size_t OFF_U16 = OFF_ST + (size_t)NF * 128 * 8;
constexpr size_t OFF_V16 = OFF_HN;
static_assert(OFF_U16 + (size_t)16384 * 1024 * 2 <= WS_END, "u16");
constexpr size_t OFF_U8 = OFF_U16;
constexpr size_t OFF_SU = OFF_U8 + (size_t)16384 * 1024;
constexpr size_t OFF_V8 = OFF_V16;
constexpr size_t OFF_SV = OFF_V8 + (size_t)16384 * 1024;
static_assert(BIG_BYTES >= (size_t)MPAD * INW * 2, "big region");
static_assert(WS_END <= (size_t)268435456, "workspace");

struct Params {
    const float *x, *meta, *norm_mix, *w_in, *w_uv, *w_out, *norm_ffn, *wq, *sk, *pu, *pv, *norm_final;
    float* out; char* ws; int lo, hi, pad0, pad1;
};

DI float bf2f(bf16_t v) { return __uint_as_float(((unsigned)v) << 16); }
typedef float f32x2_t __attribute__((ext_vector_type(2)));
typedef __bf16 bf16x2_t __attribute__((ext_vector_type(2)));
DI bf16_t f2bf(float f) { const __bf16 h = (__bf16)f; return __builtin_bit_cast(unsigned short, h); }
DI unsigned pk2bf(float a, float b) { const f32x2_t v = {a, b}; const bf16x2_t h = __builtin_convertvector(v, bf16x2_t); return __builtin_bit_cast(unsigned, h); }
DI float wave_sum(float v) {
#pragma unroll
    for (int o = 32; o > 0; o >>= 1) v += __shfl_xor(v, o);
    return v;
}
DI float wave_max(float v) {
#pragma unroll
    for (int o = 32; o > 0; o >>= 1) v = fmaxf(v, __shfl_xor(v, o));
    return v;
}
DI unsigned long long wave_max_u64(unsigned long long v) {
#pragma unroll
    for (int o = 32; o > 0; o >>= 1) {
        const unsigned hi = __shfl_xor((unsigned)(v >> 32), o), lo = __shfl_xor((unsigned)v, o);
        const unsigned long long w = ((unsigned long long)hi << 32) | lo;
        v = w > v ? w : v;
    }
    return v;
}
DI unsigned fkey(float x) { const unsigned u = __float_as_uint(x); return (u & 0x80000000u) ? ~u : (u | 0x80000000u); }
DI float funkey(unsigned k) { const unsigned u = (k & 0x80000000u) ? (k & 0x7fffffffu) : ~k; return __uint_as_float(u); }
DI void lds_fence() { asm volatile("s_waitcnt lgkmcnt(0)" ::: "memory"); }
DI void unpack8(const u32x4& r, float (&v)[8]) {
    v[0] = __uint_as_float(r.x << 16); v[1] = __uint_as_float(r.x & 0xffff0000u);
    v[2] = __uint_as_float(r.y << 16); v[3] = __uint_as_float(r.y & 0xffff0000u);
    v[4] = __uint_as_float(r.z << 16); v[5] = __uint_as_float(r.z & 0xffff0000u);
    v[6] = __uint_as_float(r.w << 16); v[7] = __uint_as_float(r.w & 0xffff0000u);
}

typedef float f32x16 __attribute__((ext_vector_type(16)));
DI bf16x8 pack8(const float (&x)[8]) {
    u32x4 r;
#pragma unroll
    for (int j = 0; j < 4; ++j) r[j] = pk2bf(x[2 * j], x[2 * j + 1]);
    return __builtin_bit_cast(bf16x8, r);
}
DI bf16x8 pack_hi8(const float (&x)[8], float (&rem)[8]) {
    u32x4 r;
#pragma unroll
    for (int j = 0; j < 4; ++j) { r[j] = pk2bf(x[2 * j], x[2 * j + 1]); rem[2 * j] = x[2 * j] - __uint_as_float(r[j] << 16); rem[2 * j + 1] = x[2 * j + 1] - __uint_as_float(r[j] & 0xffff0000u); }
    return __builtin_bit_cast(bf16x8, r);
}

DI float dpp_row_sum(float v) {
    v += __int_as_float(__builtin_amdgcn_update_dpp(0, __float_as_int(v), 0xB1, 0xF, 0xF, true));
    v += __int_as_float(__builtin_amdgcn_update_dpp(0, __float_as_int(v), 0x4E, 0xF, 0xF, true));
    v += __int_as_float(__builtin_amdgcn_update_dpp(0, __float_as_int(v), 0x141, 0xF, 0xF, true));
    v += __int_as_float(__builtin_amdgcn_update_dpp(0, __float_as_int(v), 0x140, 0xF, 0xF, true));
    return v;
}
DI float wave_sum_uniform(float v) {
    v = dpp_row_sum(v);
    const float a = __int_as_float(__builtin_amdgcn_readlane(__float_as_int(v), 0)), b = __int_as_float(__builtin_amdgcn_readlane(__float_as_int(v), 16));
    const float c = __int_as_float(__builtin_amdgcn_readlane(__float_as_int(v), 32)), d = __int_as_float(__builtin_amdgcn_readlane(__float_as_int(v), 48));
    return (a + b) + (c + d);
}

DI int wave_sum_int(int v) {
    v += __builtin_amdgcn_update_dpp(0, v, 0xB1, 0xF, 0xF, true);
    v += __builtin_amdgcn_update_dpp(0, v, 0x4E, 0xF, 0xF, true);
    v += __builtin_amdgcn_update_dpp(0, v, 0x141, 0xF, 0xF, true);
    v += __builtin_amdgcn_update_dpp(0, v, 0x140, 0xF, 0xF, true);
    return (__builtin_amdgcn_readlane(v, 0) + __builtin_amdgcn_readlane(v, 16)) + (__builtin_amdgcn_readlane(v, 32) + __builtin_amdgcn_readlane(v, 48));
}

#define XB_TMO      128
#define XB_XCNT(j)  (256  + 64 * (j))
#define XB_XSUB(j)  (1280 + 64 * (j))
#define XB_XGEN(j)  (2304 + 64 * (j))
#define XB_TOP      3328
#define XB_TOPGEN   3392
#define XCD_BAR_WORDS 3456
#define XB_SPIN_CAP (1u << 20)
#define LAS __attribute__((address_space(3)))

DI unsigned xb_ld(unsigned* p)              { return __hip_atomic_load(p, __ATOMIC_RELAXED, __HIP_MEMORY_SCOPE_AGENT); }
DI unsigned xb_add(unsigned* p, unsigned v) { return __hip_atomic_fetch_add(p, v, __ATOMIC_RELAXED, __HIP_MEMORY_SCOPE_AGENT); }
DI unsigned xb_xcc_id() { return (unsigned)__builtin_amdgcn_s_getreg((3 << 11) | 20) & 0xFu; }
#define XB_SPIN(cond, bar) do { unsigned _sp = 0; while (cond) { __builtin_amdgcn_s_sleep(1); \
    if ((++_sp & 255u) == 0u) { if (xb_ld(&(bar)[XB_TMO])) break; if (_sp > XB_SPIN_CAP) { atomicAdd(&(bar)[XB_TMO], 1u); break; } } } } while (0)

struct XcdBarrier { unsigned* bar; unsigned x; volatile LAS unsigned* st; };

DI XcdBarrier xcd_barrier_post(unsigned* bar, volatile LAS unsigned* st) {
    XcdBarrier b; b.bar = bar; b.x = xb_xcc_id(); b.st = st;
    if (threadIdx.x == 0) (void)xb_add(&bar[XB_XCNT(b.x)], 1u);
    return b;
}
DI void xcd_barrier_complete(unsigned* bar, unsigned x, unsigned& nloc, unsigned& nx) {
    const unsigned G = gridDim.x * gridDim.y * gridDim.z;
    unsigned sum, cnt, mine, sp = 0u;
    for (;;) {
        sum = 0u; cnt = 0u; mine = 0u;
#pragma unroll
        for (unsigned j = 0; j < 16; ++j) { const unsigned c = xb_ld(&bar[XB_XCNT(j)]); sum += c; cnt += (c > 0u) ? 1u : 0u; mine = (j == x) ? c : mine; }
        if (sum == G) break;
        __builtin_amdgcn_s_sleep(1);
        if ((++sp & 255u) == 0u) { if (xb_ld(&bar[XB_TMO])) break; if (sp > XB_SPIN_CAP) { atomicAdd(&bar[XB_TMO], 1u); break; } }
    }
    nloc = mine > 0u ? mine : 1u; nx = cnt > 0u ? cnt : 1u;
}
DI void xcd_barrier(const XcdBarrier& b) {
    asm volatile("s_waitcnt vmcnt(0)" ::: "memory");
    __syncthreads();
    if (threadIdx.x == 0) {
        unsigned* bar = b.bar;
        __builtin_amdgcn_s_waitcnt(0);
        unsigned nloc = b.st[0], nx = b.st[1];
        if (nloc == 0u) { xcd_barrier_complete(bar, b.x, nloc, nx); b.st[0] = nloc; b.st[1] = nx; }
        const unsigned old = xb_add(&bar[XB_XSUB(b.x)], 1u);
        const unsigned gen = old / nloc;
        if (old + 1u == (gen + 1u) * nloc) {
            __builtin_amdgcn_fence(__ATOMIC_RELEASE, "agent");
            asm volatile("s_waitcnt vmcnt(0)" ::: "memory");
            const unsigned og = xb_add(&bar[XB_TOP], 1u);
            const unsigned tg = og / nx;
            if (og + 1u == (tg + 1u) * nx) xb_add(&bar[XB_TOPGEN], 1u);
            else XB_SPIN(xb_ld(&bar[XB_TOPGEN]) == tg, bar);
            __builtin_amdgcn_fence(__ATOMIC_ACQUIRE, "agent");
            xb_add(&bar[XB_XGEN(b.x)], 1u);
            asm volatile("s_waitcnt vmcnt(0)" ::: "memory");
        } else {
            XB_SPIN(xb_ld(&bar[XB_XGEN(b.x)]) == gen, bar);
            __builtin_amdgcn_fence(__ATOMIC_ACQUIRE, "agent");
            asm volatile("s_waitcnt vmcnt(0)" ::: "memory");
        }
    }
    __syncthreads();
}

constexpr int BM = 256, BK = 64, HALF = 128, NXCD = 8, WGM = 8, HT = HALF * BK;
DI int lds_byte(int r, int c) {
    int st = (r >> 4) * 2 + (c >> 5), rr = r & 15, cc = c & 31, ob = rr * 64 + cc * 2;
    return st * 1024 + (ob ^ (((ob >> 9) & 1) << 5));
}
DI void stage_rc(int b, int& R, int& C) {
    int st = b / 1024, sb = b % 1024, swz = sb ^ (((sb >> 9) & 1) << 5);
    R = (st >> 1) * 16 + swz / 64; C = (st & 1) * 32 + (swz % 64) / 2;
}

#define SA(b,h) (shm+((b)*2+(h))*HT)
#define SB(b,h) (shm+(4+(b)*2+(h))*HT)
#define STAGE_X(T,P,BASE,br,kt) do{long _g=(long)(br)*K+(long)(kt)*BK; \
    for(int _i=0;_i<2;++_i){int _b=(T)*16+_i*8192;int _r,_c;stage_rc(_b,_r,_c); \
      __builtin_amdgcn_global_load_lds((const unsigned*)(BASE+_g+(long)_r*K+_c), \
        (LAS unsigned*)((LAS char*)(P)+_b),16,0,0);}}while(0)
#define STAGE(P,BASE,br,kt) STAGE_X(threadIdx.x,P,BASE,br,kt)
#define LDA(dst,b,h) for(int m=0;m<4;++m)for(int k=0;k<2;++k) \
    dst[m][k]=*reinterpret_cast<const LAS bf16x8*>((LAS char*)SA(b,h)+lds_byte(wr*64+m*16+fr,k*32+fq*8))
#define LDB(dst,b,h) for(int n=0;n<2;++n)for(int k=0;k<2;++k) \
    dst[n][k]=*reinterpret_cast<const LAS bf16x8*>((LAS char*)SB(b,h)+lds_byte(wc*32+n*16+fr,k*32+fq*8))
#define MMA(ai,bj,At,Bt_) do{__builtin_amdgcn_s_setprio(1); \
    for(int m=0;m<4;++m)for(int n=0;n<2;++n)for(int k=0;k<2;++k) \
      acc[ai][bj][m][n]=TRANS?__builtin_amdgcn_mfma_f32_16x16x32_bf16(Bt_[n][k],At[m][k],acc[ai][bj][m][n],0,0,0):__builtin_amdgcn_mfma_f32_16x16x32_bf16(At[m][k],Bt_[n][k],acc[ai][bj][m][n],0,0,0); \
    __builtin_amdgcn_s_setprio(0);}while(0)
#define WAIT_V(n) asm volatile("s_waitcnt vmcnt(" #n ")":::"memory")
#define WAIT_L(n) asm volatile("s_waitcnt lgkmcnt(" #n ")":::"memory")
#define BAR __builtin_amdgcn_s_barrier()
#define SCHED __builtin_amdgcn_sched_barrier(0)

template <bool TRANS, class Epi>
DI void gemm256(const bf16_t* __restrict__ A, const bf16_t* __restrict__ Bt, const int K, const int nM, const int nN, LAS bf16_t* shm, const Epi& epi) {
    const int nwg = nM * nN;
    for (int L = blockIdx.x; L < nwg; L += gridDim.x) {
        int wgid = L;
        { int q = nwg / NXCD, r = nwg % NXCD, xcd = wgid % NXCD, off = wgid / NXCD; wgid = (xcd < r ? xcd * (q + 1) : r * (q + 1) + (xcd - r) * q) + off; }
        int nig = WGM * nN, gid = wgid / nig, fm = gid * WGM, gsz = min(nM - fm, WGM);
        int pm = fm + ((wgid % nig) % gsz), pn = (wgid % nig) / gsz, brow = pm * BM, bcol = pn * BM;
        int wid = threadIdx.x >> 6, lane = threadIdx.x & 63, wr = wid >> 2, wc = wid & 3, fr = lane & 15, fq = lane >> 4;
        f32x4 acc[2][2][4][2] = {};
        bf16x8 At[4][2], B0[2][2], B1[2][2];
        int nt = K / BK;
        STAGE(SB(0,0),Bt,bcol,0); STAGE(SA(0,0),A,brow,0);
        STAGE(SB(0,1),Bt,bcol+HALF,0); STAGE(SA(0,1),A,brow+HALF,0);
        if (wr == 1) BAR;
        WAIT_V(4); BAR;
        STAGE(SB(1,0),Bt,bcol,1); STAGE(SA(1,0),A,brow,1); STAGE(SB(1,1),Bt,bcol+HALF,1);
        WAIT_V(6); BAR;
        for (int t = 0; t < nt - 2; t += 2) {
            LDB(B0,0,0); SCHED; LDA(At,0,0); STAGE(SA(1,1),A,brow+HALF,t+1);
            WAIT_L(8); BAR; WAIT_L(0); MMA(0,0,At,B0); BAR; SCHED;
            LDB(B1,0,1); STAGE(SB(0,0),Bt,bcol,t+2);
            BAR; WAIT_L(0); MMA(0,1,At,B1); BAR;
            LDA(At,0,1); STAGE(SA(0,0),A,brow,t+2);
            BAR; WAIT_L(0); MMA(1,0,At,B0); BAR; SCHED;
            STAGE(SB(0,1),Bt,bcol+HALF,t+2);
            WAIT_V(6); BAR; MMA(1,1,At,B1); BAR;
            LDB(B0,1,0); SCHED; LDA(At,1,0); STAGE(SA(0,1),A,brow+HALF,t+2);
            WAIT_L(8); BAR; WAIT_L(0); MMA(0,0,At,B0); BAR; SCHED;
            LDB(B1,1,1); STAGE(SB(1,0),Bt,bcol,t+3);
            BAR; WAIT_L(0); MMA(0,1,At,B1); BAR;
            LDA(At,1,1); STAGE(SA(1,0),A,brow,t+3);
            BAR; WAIT_L(0); MMA(1,0,At,B0); BAR; SCHED;
            STAGE(SB(1,1),Bt,bcol+HALF,t+3);
            WAIT_V(6); BAR; MMA(1,1,At,B1); BAR;
        }
        int tz = threadIdx.x; asm volatile("" : "+v"(tz)); wid = tz >> 6; lane = tz & 63; wr = wid >> 2; wc = wid & 3; fr = lane & 15; fq = lane >> 4;
        { LDB(B0,0,0); WAIT_V(0); LDA(At,0,0); STAGE_X(tz,SA(1,1),A,brow+HALF,nt-1);
          BAR; WAIT_L(0); MMA(0,0,At,B0); BAR;
          LDB(B1,0,1); BAR; WAIT_L(0); MMA(0,1,At,B1); BAR;
          LDA(At,0,1); WAIT_V(4); BAR; WAIT_L(0); MMA(1,0,At,B0); MMA(1,1,At,B1); BAR; }
        { LDB(B0,1,0); LDA(At,1,0); WAIT_V(2); BAR; WAIT_L(0); MMA(0,0,At,B0); BAR;
          LDB(B1,1,1); WAIT_V(0); BAR; WAIT_L(0); MMA(0,1,At,B1); BAR;
          LDA(At,1,1); BAR; WAIT_L(0); MMA(1,0,At,B0); MMA(1,1,At,B1); BAR; }
        if (wr == 0) BAR;
        epi(acc, brow, bcol, wr, wc, fr, fq);
        __syncthreads();
    }
}

struct EpiProj {
    bf16_t* P;
    DI void operator()(const f32x4 (&acc)[2][2][4][2], int brow, int bcol, int wr, int wc, int fr, int fq) const {
#pragma unroll
        for (int ai = 0; ai < 2; ++ai)
#pragma unroll
        for (int bj = 0; bj < 2; ++bj)
#pragma unroll
        for (int m = 0; m < 4; ++m)
#pragma unroll
        for (int n = 0; n < 2; ++n)
#pragma unroll
        for (int j = 0; j < 4; ++j) {
            const int row = brow + ai * HALF + wr * 64 + m * 16 + fq * 4 + j, col = bcol + bj * HALF + wc * 32 + n * 16 + fr;
            if (col < INW) P[(size_t)row * INW + col] = f2bf(acc[ai][bj][m][n][j]);
        }
    }
};
struct EpiOut {
    float* H; const float* X;
    DI void operator()(const f32x4 (&acc)[2][2][4][2], int brow, int bcol, int wr, int wc, int fr, int fq) const {
#pragma unroll
        for (int ai = 0; ai < 2; ++ai)
#pragma unroll
        for (int bj = 0; bj < 2; ++bj)
#pragma unroll
        for (int m = 0; m < 4; ++m)
#pragma unroll
        for (int n = 0; n < 2; ++n)
#pragma unroll
        for (int j = 0; j < 4; ++j) {
            const int row = brow + ai * HALF + wr * 64 + m * 16 + fq * 4 + j, col = bcol + bj * HALF + wc * 32 + n * 16 + fr;
            const size_t o = (size_t)row * DM + col; H[o] = X[o] + acc[ai][bj][m][n][j];
        }
    }
};
struct EpiPQ {
    float* Q;
    DI void operator()(const f32x4 (&acc)[2][2][4][2], int brow, int bcol, int wr, int wc, int fr, int fq) const {
#pragma unroll
        for (int ai = 0; ai < 2; ++ai)
#pragma unroll
        for (int bj = 0; bj < 2; ++bj)
#pragma unroll
        for (int m = 0; m < 4; ++m)
#pragma unroll
        for (int n = 0; n < 2; ++n)
#pragma unroll
        for (int j = 0; j < 4; ++j) {
            const int row = brow + ai * HALF + wr * 64 + m * 16 + fq * 4 + j, col = bcol + bj * HALF + wc * 32 + n * 16 + fr;
            Q[(size_t)row * 2048 + col] = acc[ai][bj][m][n][j];
        }
    }
};

DI void phase_prologue(const Params& p) {
    const int gtid = blockIdx.x * NTHREADS + threadIdx.x, gsz = gridDim.x * NTHREADS;
    bf16_t* wint = (bf16_t*)(p.ws + OFF_WINT);
    for (int idx = gtid; idx < 4096 * 1024; idx += gsz) {
        const int k = idx >> 12, n = idx & 4095;
        const float v = n < INW ? p.w_in[(size_t)k * INW + n] : 0.f;
        wint[(size_t)n * 1024 + k] = f2bf(v);
    }
    bf16_t* woutt = (bf16_t*)(p.ws + OFF_WOUTT);
    for (int idx = gtid; idx < 1024 * 1024; idx += gsz) {
        const int k = idx >> 10, n = idx & 1023;
        woutt[(size_t)n * 1024 + k] = f2bf(p.w_out[(size_t)k * 1024 + n]);
    }
    {
        bf16_t* wst = (bf16_t*)(p.ws + OFF_WQT);
        const int wave_ = threadIdx.x >> 6, lane_ = threadIdx.x & 63, r = lane_ & 31, hh = lane_ >> 5;
        for (int task = blockIdx.x * NWAVES + wave_; task < 16 * 32; task += gridDim.x * NWAVES) {
            const int hf = task >> 5, k0 = (task & 31) * 32;
            f32x16 acc[4];
#pragma unroll
            for (int nb = 0; nb < 4; ++nb)
#pragma unroll
                for (int i = 0; i < 16; ++i) acc[nb][i] = 0.f;
            const float* arow = p.wq + (size_t)(k0 + r) * 2048 + hf * 128 + 8 * hh;
            const float* brow = p.sk + (size_t)(hf * 128 + r) * 128 + 8 * hh;
#pragma unroll 1
            for (int ks = 0; ks < 8; ++ks) {
                const float4 a0 = *(const float4*)(arow + ks * 16), a1 = *(const float4*)(arow + ks * 16 + 4);
                const float af[8] = {a0.x, a0.y, a0.z, a0.w, a1.x, a1.y, a1.z, a1.w}; float ar[8];
                const bf16x8 ah = pack_hi8(af, ar); const bf16x8 al = pack8(ar);
#pragma unroll
                for (int nb = 0; nb < 4; ++nb) {
                    const float4 b0 = *(const float4*)(brow + (size_t)nb * 32 * 128 + ks * 16), b1 = *(const float4*)(brow + (size_t)nb * 32 * 128 + ks * 16 + 4);
                    const float bf_[8] = {b0.x, b0.y, b0.z, b0.w, b1.x, b1.y, b1.z, b1.w}; float br[8];
                    const bf16x8 bh = pack_hi8(bf_, br); const bf16x8 bl = pack8(br);
                    acc[nb] = __builtin_amdgcn_mfma_f32_32x32x16_bf16(ah, bh, acc[nb], 0, 0, 0);
                    acc[nb] = __builtin_amdgcn_mfma_f32_32x32x16_bf16(ah, bl, acc[nb], 0, 0, 0);
                    acc[nb] = __builtin_amdgcn_mfma_f32_32x32x16_bf16(al, bh, acc[nb], 0, 0, 0);
                }
            }
#pragma unroll
            for (int nb = 0; nb < 4; ++nb) {
                bf16_t* orow = wst + (size_t)(hf * 128 + nb * 32 + r) * 1024 + k0 + 4 * hh;
#pragma unroll
                for (int g4 = 0; g4 < 4; ++g4) { uint2 w; w.x = pk2bf(acc[nb][4 * g4], acc[nb][4 * g4 + 1]); w.y = pk2bf(acc[nb][4 * g4 + 2], acc[nb][4 * g4 + 3]); *(uint2*)(orow + 8 * g4) = w; }
            }
        }
    }
    bf16_t* wuvt = (bf16_t*)(p.ws + OFF_WUVT);
    for (int idx = gtid; idx < 8 * 64 * 128; idx += gsz) {
        const int h = idx >> 13, e = (idx >> 7) & 63, dv = idx & 127;
        wuvt[idx] = f2bf(p.w_uv[(size_t)(h * 128 + dv) * 64 + e]);
    }
    float* c128 = (float*)(p.ws + OFF_COS128); float* s128 = (float*)(p.ws + OFF_SIN128);
    for (int idx = gtid; idx < TT * 64; idx += gsz) {
        const int pos = idx >> 6, j = idx & 63;
        const float inv = powf(10000.f, -(float)j * 2.0f / 128.f);
        const float ang = (float)pos * inv;
        float s, c; sincosf(ang, &s, &c);
        c128[idx] = c; s128[idx] = s;
    }
    float* c64 = (float*)(p.ws + OFF_COS64); float* s64 = (float*)(p.ws + OFF_SIN64);
    for (int idx = gtid; idx < TT * 32; idx += gsz) {
        const int pos = idx >> 5, j = idx & 31;
        const float inv = powf(10000.f, -(float)j * 2.0f / 64.f);
        const float ang = (float)pos * inv;
        float s, c; sincosf(ang, &s, &c);
        c64[idx] = c; s64[idx] = s;
    }
    bf16_t* hn = (bf16_t*)(p.ws + OFF_HN);
    const int wave = threadIdx.x >> 6, lane = threadIdx.x & 63;
    for (int row = blockIdx.x * NWAVES + wave; row < MPAD; row += gridDim.x * NWAVES) {
        bf16_t* o = hn + (size_t)row * DM;
        if (row >= MROWS) {
            for (int i = 0; i < 4; ++i) *(uint2*)(o + i * 256 + lane * 4) = make_uint2(0u, 0u);
            continue;
        }
        const int b = row / TT, t = row % TT;
        const float* src = t < NMETA ? p.meta + (size_t)t * DM : p.x + ((size_t)b * SEQ + (t - NMETA)) * DM;
        float4 v[4]; float ss = 0.f;
#pragma unroll
        for (int i = 0; i < 4; ++i) { v[i] = *(const float4*)(src + i * 256 + lane * 4); ss += v[i].x * v[i].x + v[i].y * v[i].y + v[i].z * v[i].z + v[i].w * v[i].w; }
        ss = wave_sum(ss);
        const float rstd = rsqrtf(ss * (1.f / DM) + 1e-6f);
#pragma unroll
        for (int i = 0; i < 4; ++i) {
            const float4 g = *(const float4*)(p.norm_mix + i * 256 + lane * 4);
            uint2 w;
            w.x = (unsigned)f2bf(v[i].x * rstd * g.x) | ((unsigned)f2bf(v[i].y * rstd * g.y) << 16);
            w.y = (unsigned)f2bf(v[i].z * rstd * g.z) | ((unsigned)f2bf(v[i].w * rstd * g.w) << 16);
            *(uint2*)(o + i * 256 + lane * 4) = w;
        }
    }
}

DI void rope8(bf16_t* p1, bf16_t* p2, const float* ct, const float* st, float scale) {
    const u32x4 r1 = *(const u32x4*)p1, r2 = *(const u32x4*)p2;
    float x1[8], x2[8]; unpack8(r1, x1); unpack8(r2, x2);
    const float4 c0 = *(const float4*)ct, c1 = *(const float4*)(ct + 4), s0 = *(const float4*)st, s1 = *(const float4*)(st + 4);
    const float cs[8] = {c0.x, c0.y, c0.z, c0.w, c1.x, c1.y, c1.z, c1.w}, sn[8] = {s0.x, s0.y, s0.z, s0.w, s1.x, s1.y, s1.z, s1.w};
    u32x4 o1, o2;
#pragma unroll
    for (int i = 0; i < 4; ++i) {
        const float a0 = (x1[2 * i] * cs[2 * i] - x2[2 * i] * sn[2 * i]) * scale, a1 = (x1[2 * i + 1] * cs[2 * i + 1] - x2[2 * i + 1] * sn[2 * i + 1]) * scale;
        const float b0 = (x2[2 * i] * cs[2 * i] + x1[2 * i] * sn[2 * i]) * scale, b1 = (x2[2 * i + 1] * cs[2 * i + 1] + x1[2 * i + 1] * sn[2 * i + 1]) * scale;
        o1[i] = (unsigned)f2bf(a0) | ((unsigned)f2bf(a1) << 16); o2[i] = (unsigned)f2bf(b0) | ((unsigned)f2bf(b1) << 16);
    }
    *(u32x4*)p1 = o1; *(u32x4*)p2 = o2;
}
DI void phase_rope(const Params& p, LAS char* smem) {
    bf16_t* proj = (bf16_t*)(p.ws + OFF_BIG);
    const float* c128 = (const float*)(p.ws + OFF_COS128); const float* s128 = (const float*)(p.ws + OFF_SIN128);
    const float* c64 = (const float*)(p.ws + OFF_COS64); const float* s64 = (const float*)(p.ws + OFF_SIN64);
    const int gtid = blockIdx.x * NTHREADS + threadIdx.x, gsz = gridDim.x * NTHREADS;
    const int total = MROWS * 173;
    for (int idx = gtid; idx < total; idx += gsz) {
        const int row = idx / 173, it = idx - row * 173;
        const int t = row % TT;
        bf16_t* pr = proj + (size_t)row * INW;
        if (it < 32)       { const int hd = it >> 3, j = (it & 7) * 8;          rope8(pr + C_RQ + hd * 128 + j, pr + C_RQ + hd * 128 + 64 + j, c128 + t * 64 + j, s128 + t * 64 + j, 1.f); }
        else if (it < 64)  { const int i2 = it - 32, hd = i2 >> 3, j = (i2 & 7) * 8;  rope8(pr + C_RK + hd * 128 + j, pr + C_RK + hd * 128 + 64 + j, c128 + t * 64 + j, s128 + t * 64 + j, 0.08838834764831845f); }
        else if (it < 128) { const int i2 = it - 64, hd = i2 >> 3, j = (i2 & 7) * 8;  rope8(pr + C_DQ + hd * 128 + j, pr + C_DQ + hd * 128 + 64 + j, c128 + t * 64 + j, s128 + t * 64 + j, 0.08838834764831845f * 1.4426950408889634f); }
        else if (it < 136) { const int j = (it - 128) * 8;                          rope8(pr + C_DK + j, pr + C_DK + 64 + j, c128 + t * 64 + j, s128 + t * 64 + j, 1.f); }
        else if (it < 168) { const int i2 = it - 136, hd = i2 >> 2, j = (i2 & 3) * 8; rope8(pr + C_IQ + hd * 64 + j, pr + C_IQ + hd * 64 + 32 + j, c64 + t * 32 + j, s64 + t * 32 + j, 0.125f); }
        else if (it < 172) { const int j = (it - 168) * 8;                          rope8(pr + C_IK + j, pr + C_IK + 32 + j, c64 + t * 32 + j, s64 + t * 32 + j, 1.f); }
        else {
            const u32x4 r = *(const u32x4*)(pr + C_IW); float v[8]; unpack8(r, v); u32x4 o;
#pragma unroll
            for (int i = 0; i < 4; ++i) o[i] = (unsigned)f2bf(v[2 * i] * 0.35355339059327373f) | ((unsigned)f2bf(v[2 * i + 1] * 0.35355339059327373f) << 16);
            *(u32x4*)(pr + C_IW) = o;
        }
    }
    bf16_t* dvt = (bf16_t*)(p.ws + OFF_DVT);
    LAS bf16_t* tile = (LAS bf16_t*)smem;
    for (int unit = blockIdx.x; unit < NB * (TTP / 64); unit += gridDim.x) {
        const int b = unit / (TTP / 64), t0 = (unit % (TTP / 64)) * 64;
        for (int i = threadIdx.x; i < 64 * 16; i += NTHREADS) {
            const int tr = i >> 4, ch = i & 15, t = t0 + tr;
            u32x4 v = {0u, 0u, 0u, 0u};
            if (t < TT) v = *(const u32x4*)(proj + (size_t)(b * TT + t) * INW + C_DV + ch * 8);
            *(LAS u32x4*)(tile + tr * 136 + ch * 8) = v;
        }
        __syncthreads();
        for (int i = threadIdx.x; i < 128 * 8; i += NTHREADS) {
            const int dv = i >> 3, ch = i & 7;
            u32x4 o;
#pragma unroll
            for (int w = 0; w < 4; ++w) o[w] = (unsigned)tile[(ch * 8 + 2 * w) * 136 + dv] | ((unsigned)tile[(ch * 8 + 2 * w + 1) * 136 + dv] << 16);
            *(u32x4*)(dvt + (size_t)(b * 128 + dv) * TTP + t0 + ch * 8) = o;
        }
        __syncthreads();
    }
}

DI void phase_ret_state(const Params& p, LAS char* smem) {
    const bf16_t* proj = (const bf16_t*)(p.ws + OFF_BIG);
    float* ST = (float*)(p.ws + OFF_ST);
    LAS bf16_t* sK = (LAS bf16_t*)smem; LAS bf16_t* sV = sK + 64 * 128;
    for (int unit = blockIdx.x; unit < 1024; unit += gridDim.x) {
        const int c = 1 + (unit & 31), bh = unit >> 5, h = bh & 3, b = bh >> 2;
        for (int i = threadIdx.x; i < 64 * 16; i += NTHREADS) {
            const int j = i >> 4, ch = i & 15; const int t = 64 * c + j - 112;
            u32x4 kv = {0u, 0u, 0u, 0u}, vv = {0u, 0u, 0u, 0u};
            if (t >= 0) { const bf16_t* pr = proj + (size_t)(b * TT + t) * INW; kv = *(const u32x4*)(pr + C_RK + h * 128 + ch * 8); vv = *(const u32x4*)(pr + C_RV + h * 128 + ch * 8); }
            *(LAS u32x4*)(sK + j * 128 + ch * 8) = kv; *(LAS u32x4*)(sV + j * 128 + ch * 8) = vv;
        }
        __syncthreads();
        const float lg = logf(1.f - exp2f(-5.f - (float)h));
        const int e = threadIdx.x >> 2, d0 = (threadIdx.x & 3) * 32;
        float acc[32];
#pragma unroll
        for (int dd = 0; dd < 32; ++dd) acc[dd] = 0.f;
        for (int j = 0; j < 64; ++j) {
            const float z = expf(lg * (float)(63 - j)) * bf2f(sV[j * 128 + e]);
#pragma unroll
            for (int d8 = 0; d8 < 4; ++d8) {
                const u32x4 raw = *(const LAS u32x4*)(sK + j * 128 + d0 + d8 * 8); float kv[8]; unpack8(raw, kv);
#pragma unroll
                for (int x = 0; x < 8; ++x) acc[d8 * 8 + x] += z * kv[x];
            }
        }
        float* st = ST + ((size_t)(bh * 34 + c) * 128 + e) * 128 + d0;
#pragma unroll
        for (int d4 = 0; d4 < 8; ++d4) *(float4*)(st + d4 * 4) = make_float4(acc[d4 * 4], acc[d4 * 4 + 1], acc[d4 * 4 + 2], acc[d4 * 4 + 3]);
        __syncthreads();
    }
}

constexpr int DSA_WAVE_LDS = 2176 * 4 + 1024 * 4 + 256 * 4 + 64;
template <bool CHECK>
DI void phase_dsa_naive(const Params& p, LAS char* smem) {
    const bf16_t* proj = (const bf16_t*)(p.ws + OFF_BIG);
    bf16_t* mixed = (bf16_t*)(p.ws + OFF_HN);
    const int wave = threadIdx.x >> 6, lane = threadIdx.x & 63;
    LAS float* sSc = (LAS float*)(smem + wave * DSA_WAVE_LDS);
    LAS float* sQ = sSc + 2176;
    LAS int* sSel = (LAS int*)(sQ + 1024);
    LAS float* sIw = (LAS float*)(sSel + 256);
    const unsigned long long lt_mask = (1ull << lane) - 1ull;
    float chk_num = 0.f, chk_den = 0.f;
    for (int q = blockIdx.x * NWAVES + wave; q < NF; q += gridDim.x * NWAVES) {
        const int b = q >> 11, s = q & 2047, t = NMETA + s;
        const int nk = 80 + 64 * (s >> 6);
        const bf16_t* prow = proj + (size_t)(b * TT + t) * INW;
        for (int i = lane; i < 512; i += 64) sQ[i] = bf2f(prow[C_IQ + i]);
        if (lane < 8) sIw[lane] = bf2f(prow[C_IW + lane]);
        lds_fence();
        const bf16_t* ikbase = proj + (size_t)(b * TT) * INW + C_IK;
        const int nj = (nk + 63) >> 6;
        for (int jj = 0; jj < nj; ++jj) {
            const int k = jj * 64 + lane;
            float sc = 0.f;
            if (k < nk) {
                const bf16_t* kr = ikbase + (size_t)k * INW;
                float a[8];
#pragma unroll
                for (int h = 0; h < 8; ++h) a[h] = 0.f;
#pragma unroll 1
                for (int d8 = 0; d8 < 8; ++d8) {
                    const u32x4 raw = *(const u32x4*)(kr + d8 * 8); float kv[8]; unpack8(raw, kv);
#pragma unroll
                    for (int h = 0; h < 8; ++h) {
                        const f32x4 q0 = *(const LAS f32x4*)(sQ + h * 64 + d8 * 8), q1 = *(const LAS f32x4*)(sQ + h * 64 + d8 * 8 + 4);
                        a[h] += kv[0] * q0[0] + kv[1] * q0[1] + kv[2] * q0[2] + kv[3] * q0[3] + kv[4] * q1[0] + kv[5] * q1[1] + kv[6] * q1[2] + kv[7] * q1[3];
                    }
                }
#pragma unroll
                for (int h = 0; h < 8; ++h) sc += fmaxf(a[h], 0.f) * sIw[h];
                sc += 0.0f;
            }
            sSc[k] = sc;
        }
        lds_fence();
        int L;
        if (nk <= 256) {
            for (int i = lane; i < nk; i += 64) sSel[i] = i;
            L = nk;
        } else {
            unsigned Tkey = 0u;
            for (int bit = 31; bit >= 0; --bit) {
                const unsigned cand = Tkey | (1u << bit);
                int cnt = 0;
                for (int jj = 0; jj < nj; ++jj) {
                    const int k = jj * 64 + lane;
                    const unsigned key = (k < nk) ? fkey(sSc[k]) : 0u;
                    cnt += __popcll(__ballot(key >= cand));
                }
                if (cnt >= 256) Tkey = cand;
            }
            int cgt = 0;
            for (int jj = 0; jj < nj; ++jj) {
                const int k = jj * 64 + lane;
                const unsigned key = (k < nk) ? fkey(sSc[k]) : 0u;
                cgt += __popcll(__ballot(key > Tkey));
            }
            const int need = 256 - cgt;
            int pos = 0, eqseen = 0;
            for (int jj = 0; jj < nj; ++jj) {
                const int k = jj * 64 + lane;
                const unsigned key = (k < nk) ? fkey(sSc[k]) : 0u;
                const bool gt = key > Tkey, eq = (key == Tkey);
                const unsigned long long eqm = __ballot(eq);
                const int myeq = eqseen + __popcll(eqm & lt_mask);
                const bool sel = gt || (eq && myeq < need);
                const unsigned long long sm = __ballot(sel);
                if (sel) sSel[pos + __popcll(sm & lt_mask)] = k;
                pos += __popcll(sm); eqseen += __popcll(eqm);
            }
            L = 256;
        }
        lds_fence();
        for (int i = lane; i < 1024; i += 64) sQ[i] = bf2f(prow[C_DQ + i]);
        lds_fence();
        float sc[8][4];
        const bf16_t* dkbase = proj + (size_t)(b * TT) * INW + C_DK;
#pragma unroll
        for (int il = 0; il < 4; ++il) {
            const int i = lane + 64 * il; const bool ok = i < L; const int key = ok ? sSel[i] : 0;
            const bf16_t* kr = dkbase + (size_t)key * INW;
            float a[8];
#pragma unroll
            for (int h = 0; h < 8; ++h) a[h] = 0.f;
#pragma unroll 1
            for (int d8 = 0; d8 < 16; ++d8) {
                const u32x4 raw = *(const u32x4*)(kr + d8 * 8); float kv[8]; unpack8(raw, kv);
#pragma unroll
                for (int h = 0; h < 8; ++h) {
                    const f32x4 q0 = *(const LAS f32x4*)(sQ + h * 128 + d8 * 8), q1 = *(const LAS f32x4*)(sQ + h * 128 + d8 * 8 + 4);
                    a[h] += kv[0] * q0[0] + kv[1] * q0[1] + kv[2] * q0[2] + kv[3] * q0[3] + kv[4] * q1[0] + kv[5] * q1[1] + kv[6] * q1[2] + kv[7] * q1[3];
                }
            }
#pragma unroll
            for (int h = 0; h < 8; ++h) sc[h][il] = ok ? a[h] : -INFINITY;
        }
#pragma unroll
        for (int h = 0; h < 8; ++h) {
            float m = fmaxf(fmaxf(sc[h][0], sc[h][1]), fmaxf(sc[h][2], sc[h][3]));
            m = wave_max(m);
            float e[4], sum = 0.f;
#pragma unroll
            for (int il = 0; il < 4; ++il) { e[il] = exp2f(sc[h][il] - m); sum += e[il]; }
            sum = wave_sum(sum);
            const float inv = 1.f / sum;
#pragma unroll
            for (int il = 0; il < 4; ++il) sSc[h * 256 + lane + 64 * il] = e[il] * inv;
        }
        lds_fence();
        float o[8][2];
#pragma unroll
        for (int h = 0; h < 8; ++h) { o[h][0] = 0.f; o[h][1] = 0.f; }
        const bf16_t* dvbase = proj + (size_t)(b * TT) * INW + C_DV;
        for (int i = 0; i < L; ++i) {
            const int key = sSel[i];
            const float v0 = bf2f(dvbase[(size_t)key * INW + lane]), v1 = bf2f(dvbase[(size_t)key * INW + 64 + lane]);
#pragma unroll
            for (int h = 0; h < 8; ++h) { const float pv = sSc[h * 256 + i]; o[h][0] += pv * v0; o[h][1] += pv * v1; }
        }
        lds_fence();
#pragma unroll
        for (int h = 0; h < 8; ++h) { sQ[h * 128 + lane] = o[h][0]; sQ[h * 128 + 64 + lane] = o[h][1]; }
        lds_fence();
        for (int h = 0; h < 8; ++h) {
            float acc = 0.f;
            const float* wu = p.w_uv + (size_t)h * 128 * 64 + lane;
            for (int c = 0; c < 128; ++c) acc += sQ[h * 128 + c] * wu[c * 64];
            if (CHECK) { const float got = bf2f(mixed[(size_t)q * DM + 512 + h * 64 + lane]); chk_num += (got - acc) * (got - acc); chk_den += acc * acc; }
            else mixed[(size_t)q * DM + 512 + h * 64 + lane] = f2bf(acc);
        }
        lds_fence();
    }
    if (CHECK) {
        chk_num = wave_sum(chk_num); chk_den = wave_sum(chk_den);
        if (lane == 0) { atomicAdd((float*)(p.ws + OFF_BAR) + 3600, chk_num); atomicAdd((float*)(p.ws + OFF_BAR) + 3601, chk_den); }
    }
}

typedef unsigned long long u64;
typedef short s16x4 __attribute__((ext_vector_type(4)));
constexpr int SCLD = 2116;
constexpr int DSA_MASK_OFF = 16 * SCLD * 4;
constexpr int KLD = 136, VLD = 72;
constexpr int DSA_VT_OFF = 64 * KLD * 2;
#define MFMA16(a, b, c) __builtin_amdgcn_mfma_f32_16x16x32_bf16((a), (b), (c), 0, 0, 0)
DI void phase_dsa_fast(const Params& p, LAS char* smem) {
    const bf16_t* proj = (const bf16_t*)(p.ws + OFF_BIG);
    const bf16_t* dvt = (const bf16_t*)(p.ws + OFF_DVT);
    const bf16_t* wuvt = (const bf16_t*)(p.ws + OFF_WUVT);
    bf16_t* mixed = (bf16_t*)(p.ws + OFF_HN);
    const int wave = threadIdx.x >> 6, lane = threadIdx.x & 63, c = lane & 15, g = lane >> 4;
    LAS float* SC = (LAS float*)smem; LAS u64* MASK = (LAS u64*)(smem + DSA_MASK_OFF);
    LAS bf16_t* KT = (LAS bf16_t*)smem; LAS bf16_t* VT = (LAS bf16_t*)(smem + DSA_VT_OFF);
    const u64 lt_mask = (1ull << lane) - 1ull;
    for (int pi = blockIdx.x; pi < 512; pi += gridDim.x)
    for (int which = 0; which < 2; ++which) {
        const int b = pi >> 6, qq = pi & 63, qt = which ? 127 - qq : qq;
        const int s0 = qt * 16, nk = 80 + 64 * (s0 >> 6), nkt = nk >> 4, nj = (nk + 63) >> 6;
        const bf16_t* pb = proj + (size_t)(b * TT) * INW;
        LAS char* tp_smem = smem; TP_BEGIN(1);
        {
            const bf16_t* qrow = pb + (size_t)(NMETA + s0 + c) * INW;
            bf16x8 bq[8][2]; float iw[8];
#pragma unroll
            for (int h = 0; h < 8; ++h) {
                bq[h][0] = *(const bf16x8*)(qrow + C_IQ + h * 64 + 8 * g);
                bq[h][1] = *(const bf16x8*)(qrow + C_IQ + h * 64 + 32 + 8 * g);
                iw[h] = bf2f(qrow[C_IW + h]);
            }
            bf16x8 a0n = {0, 0, 0, 0, 0, 0, 0, 0}, a1n = {0, 0, 0, 0, 0, 0, 0, 0};
            if (wave < nkt) { const bf16_t* krow = pb + (size_t)(wave * 16 + c) * INW + C_IK + 8 * g; a0n = *(const bf16x8*)(krow); a1n = *(const bf16x8*)(krow + 32); }
            for (int kt = wave; kt < nkt; kt += NWAVES) {
                const bf16x8 a0 = a0n, a1 = a1n;
                if (kt + NWAVES < nkt) { const bf16_t* krow = pb + (size_t)((kt + NWAVES) * 16 + c) * INW + C_IK + 8 * g; a0n = *(const bf16x8*)(krow); a1n = *(const bf16x8*)(krow + 32); }
                f32x4 isc = {0.f, 0.f, 0.f, 0.f};
#pragma unroll
                for (int h = 0; h < 8; ++h) {
                    f32x4 acc = {0.f, 0.f, 0.f, 0.f};
                    acc = MFMA16(a0, bq[h][0], acc); acc = MFMA16(a1, bq[h][1], acc);
#pragma unroll
                    for (int j = 0; j < 4; ++j) isc[j] += fmaxf(acc[j], 0.f) * iw[h];
                }
#pragma unroll
                for (int j = 0; j < 4; ++j) isc[j] += 0.0f;
                *(LAS f32x4*)(SC + c * SCLD + kt * 16 + 4 * g) = isc;
            }
            {
                const int tail = ((nj <= 11 ? 11 : (nj <= 22 ? 22 : 33)) << 6) - nk;
                for (int i = threadIdx.x; i < 16 * tail; i += NTHREADS) { const int qq_ = i / tail; SC[qq_ * SCLD + nk + (i - qq_ * tail)] = -3.0e38f; }
            }
        }
        __syncthreads(); TP_END(1); TP_BEGIN(2);
#pragma unroll 1
        for (int qi = 0; qi < 2; ++qi) {
            const int cq = wave * 2 + qi;
            unsigned kv[33];
#pragma unroll
            for (int jj = 0; jj < 11; ++jj) kv[jj] = fkey(SC[cq * SCLD + jj * 64 + lane]);
            if (nj > 11) {
#pragma unroll
                for (int jj = 11; jj < 22; ++jj) kv[jj] = fkey(SC[cq * SCLD + jj * 64 + lane]);
            } else {
#pragma unroll
                for (int jj = 11; jj < 22; ++jj) kv[jj] = 0u;
            }
            if (nj > 22) {
#pragma unroll
                for (int jj = 22; jj < 33; ++jj) kv[jj] = fkey(SC[cq * SCLD + jj * 64 + lane]);
            } else {
#pragma unroll
                for (int jj = 22; jj < 33; ++jj) kv[jj] = 0u;
            }
            unsigned Tkey = 1u;
            if (nk > 256) {
                Tkey = 0u;
#pragma unroll 1
                for (int bit = 31; bit >= 0; --bit) {
                    const unsigned cand = Tkey | (1u << bit);
                    int nl = 0;
#pragma unroll
                    for (int jj = 0; jj < 11; ++jj) nl += (kv[jj] >= cand) ? 1 : 0;
                    if (nj > 11) {
#pragma unroll
                        for (int jj = 11; jj < 22; ++jj) nl += (kv[jj] >= cand) ? 1 : 0;
                    }
                    if (nj > 22) {
#pragma unroll
                        for (int jj = 22; jj < 33; ++jj) nl += (kv[jj] >= cand) ? 1 : 0;
                    }
                    const int cnt = wave_sum_int(nl);
                    if (cnt >= 256) Tkey = cand;
                    if (cnt == 256) break;
                }
            }
            int cgl = 0;
#pragma unroll
            for (int jj = 0; jj < 33; ++jj) cgl += (kv[jj] > Tkey) ? 1 : 0;
            const int cgt = wave_sum_int(cgl);
            const int need = (nk > 256) ? 256 - cgt : 4096;
            int eqseen = 0;
#pragma unroll 1
            for (int jj = 0; jj < nj; ++jj) {
                const int k = jj * 64 + lane; const float v = SC[cq * SCLD + k];
                const unsigned key = (k < nk) ? fkey(v) : 0u;
                const bool gt = key > Tkey, eq = (key == Tkey);
                const u64 eqm = __ballot(eq);
                const int myeq = eqseen + __popcll(eqm & lt_mask);
                const u64 sm = __ballot(gt || (eq && myeq < need));
                eqseen += __popcll(eqm);
                if (lane == 0) MASK[cq * 34 + jj] = sm;
            }
        }
        __syncthreads(); TP_END(2); TP_BEGIN(3);
        {
            const int h = wave;
            const bf16_t* qrow = pb + (size_t)(NMETA + s0 + c) * INW + C_DQ + h * 128 + 8 * g;
            bf16x8 bQ[4];
#pragma unroll
            for (int ks = 0; ks < 4; ++ks) bQ[ks] = *(const bf16x8*)(qrow + ks * 32);
            f32x4 O[8];
#pragma unroll
            for (int mb = 0; mb < 8; ++mb) O[mb] = (f32x4){0.f, 0.f, 0.f, 0.f};
            float m_run = -1e30f, l_run = 0.f;
            const int krow_t = threadIdx.x >> 4, kch_t = threadIdx.x & 15, vdv_t = threadIdx.x >> 3, vch_t = threadIdx.x & 7;
            const bf16_t* vsrc = dvt + (size_t)(b * 128 + vdv_t) * TTP + vch_t * 8;
            u32x4 pk0, pk1, pv0, pv1;
            {
                int k0 = krow_t, k1 = 32 + krow_t; k0 = k0 < nk ? k0 : nk - 1; k1 = k1 < nk ? k1 : nk - 1;
                pk0 = *(const u32x4*)(pb + (size_t)k0 * INW + C_DK + kch_t * 8); pk1 = *(const u32x4*)(pb + (size_t)k1 * INW + C_DK + kch_t * 8);
                pv0 = *(const u32x4*)(vsrc); pv1 = *(const u32x4*)(vsrc + (size_t)64 * TTP);
            }
#pragma unroll 1
            for (int kb = 0; kb < nj; ++kb) {
                *(LAS u32x4*)(KT + krow_t * KLD + kch_t * 8) = pk0; *(LAS u32x4*)(KT + (32 + krow_t) * KLD + kch_t * 8) = pk1;
                *(LAS u32x4*)(VT + vdv_t * VLD + vch_t * 8) = pv0; *(LAS u32x4*)(VT + (64 + vdv_t) * VLD + vch_t * 8) = pv1;
                __syncthreads();
                if (kb + 1 < nj) {
                    int k0 = (kb + 1) * 64 + krow_t, k1 = k0 + 32; k0 = k0 < nk ? k0 : nk - 1; k1 = k1 < nk ? k1 : nk - 1;
                    pk0 = *(const u32x4*)(pb + (size_t)k0 * INW + C_DK + kch_t * 8); pk1 = *(const u32x4*)(pb + (size_t)k1 * INW + C_DK + kch_t * 8);
                    pv0 = *(const u32x4*)(vsrc + (kb + 1) * 64); pv1 = *(const u32x4*)(vsrc + (size_t)64 * TTP + (kb + 1) * 64);
                }
                const u64 mw = MASK[c * 34 + kb];
                f32x4 S[4];
#pragma unroll
                for (int ct = 0; ct < 4; ++ct) {
                    f32x4 acc = {0.f, 0.f, 0.f, 0.f};
#pragma unroll
                    for (int ks = 0; ks < 4; ++ks) {
                        const bf16x8 a = *(const LAS bf16x8*)(KT + (ct * 16 + c) * KLD + ks * 32 + 8 * g);
                        acc = MFMA16(a, bQ[ks], acc);
                    }
                    S[ct] = acc;
                }
                const u64 mws = mw >> (4 * g);
                const unsigned mlo = (unsigned)mws, mhi = (unsigned)(mws >> 32);
                float mblk = -1e30f;
#pragma unroll
                for (int ct = 0; ct < 4; ++ct) {
                    const unsigned bits = ((ct & 2) ? mhi : mlo) >> ((ct & 1) * 16);
#pragma unroll
                    for (int j = 0; j < 4; ++j) {
                        S[ct][j] = ((bits >> j) & 1u) ? S[ct][j] : -1e30f;
                        mblk = fmaxf(mblk, S[ct][j]);
                    }
                }
                mblk = fmaxf(mblk, __shfl_xor(mblk, 16)); mblk = fmaxf(mblk, __shfl_xor(mblk, 32));
                const float m_new = fmaxf(m_run, mblk);
                float ps = 0.f;
#pragma unroll
                for (int ct = 0; ct < 4; ++ct)
#pragma unroll
                    for (int j = 0; j < 4; ++j) { const float pv = (S[ct][j] > -1e29f) ? __builtin_amdgcn_exp2f(S[ct][j] - m_new) : 0.f; S[ct][j] = pv; ps += pv; }
                if (__ballot(m_new != m_run) != 0ull) {
                    const float alpha = __builtin_amdgcn_exp2f(m_run - m_new);
                    l_run *= alpha;
#pragma unroll
                    for (int mb = 0; mb < 8; ++mb) O[mb] *= alpha;
                }
                l_run += ps; m_run = m_new;
                bf16x8 bP[2];
#pragma unroll
                for (int kk = 0; kk < 2; ++kk) {
                    u32x4 t4;
                    t4[0] = pk2bf(S[2 * kk][0], S[2 * kk][1]); t4[1] = pk2bf(S[2 * kk][2], S[2 * kk][3]);
                    t4[2] = pk2bf(S[2 * kk + 1][0], S[2 * kk + 1][1]); t4[3] = pk2bf(S[2 * kk + 1][2], S[2 * kk + 1][3]);
                    bP[kk] = __builtin_bit_cast(bf16x8, t4);
                }
#pragma unroll
                for (int mb = 0; mb < 8; ++mb)
#pragma unroll
                    for (int kk = 0; kk < 2; ++kk) {
                        const LAS bf16_t* vr = VT + (mb * 16 + c) * VLD + kk * 32 + 4 * g;
                        const s16x4 lo = *(const LAS s16x4*)(vr), hi = *(const LAS s16x4*)(vr + 16);
                        const bf16x8 a = __builtin_shufflevector(lo, hi, 0, 1, 2, 3, 4, 5, 6, 7);
                        O[mb] = MFMA16(a, bP[kk], O[mb]);
                    }
                __syncthreads();
            }
            TP_END(3); TP_BEGIN(4);
            l_run += __shfl_xor(l_run, 16); l_run += __shfl_xor(l_run, 32);
            const float inv = 1.f / l_run;
            bf16x8 bO[4];
#pragma unroll
            for (int k2 = 0; k2 < 4; ++k2)
#pragma unroll
                for (int j = 0; j < 4; ++j) { bO[k2][j] = (short)f2bf(O[2 * k2][j] * inv); bO[k2][4 + j] = (short)f2bf(O[2 * k2 + 1][j] * inv); }
            bf16_t* orow = mixed + (size_t)(b * SEQ + s0 + c) * DM + 512 + h * 64;
            int zofs = 0; asm volatile("" : "+v"(zofs));
#pragma unroll
            for (int eb = 0; eb < 4; ++eb) {
                f32x4 acc = {0.f, 0.f, 0.f, 0.f};
#pragma unroll
                for (int k2 = 0; k2 < 4; ++k2) {
                    const bf16_t* wr = wuvt + (size_t)(h * 64 + eb * 16 + c) * 128 + k2 * 32 + 4 * g + zofs;
                    const s16x4 lo = *(const s16x4*)(wr), hi = *(const s16x4*)(wr + 16);
                    const bf16x8 a = __builtin_shufflevector(lo, hi, 0, 1, 2, 3, 4, 5, 6, 7);
                    acc = MFMA16(a, bO[k2], acc);
                }
                uint2 w;
                w.x = (unsigned)f2bf(acc[0]) | ((unsigned)f2bf(acc[1]) << 16);
                w.y = (unsigned)f2bf(acc[2]) | ((unsigned)f2bf(acc[3]) << 16);
                *(uint2*)(orow + eb * 16 + 4 * g) = w;
            }
            TP_END(4);
        }
    }
}

DI void phase_ret_scan(const Params& p) {
    float* ST = (float*)(p.ws + OFF_ST);
    const int gtid = blockIdx.x * NTHREADS + threadIdx.x, gsz = gridDim.x * NTHREADS;
    for (int idx = gtid; idx < 32 * 16384; idx += gsz) {
        const int bh = idx >> 14, el = idx & 16383, h = bh & 3;
        const float gc = expf(logf(1.f - exp2f(-5.f - (float)h)) * 64.f);
        float* base = ST + (size_t)bh * 34 * 16384 + el;
        float r = 0.f;
        for (int c = 1; c < 34; ++c) {
            const float u = c < 33 ? base[(size_t)c * 16384] : 0.f;
            base[(size_t)c * 16384] = r;
            r = gc * r + u;
        }
    }
}

DI void phase_ret_out(const Params& p, LAS char* smem) {
    const bf16_t* proj = (const bf16_t*)(p.ws + OFF_BIG);
    const float* ST = (const float*)(p.ws + OFF_ST);
    bf16_t* mixed = (bf16_t*)(p.ws + OFF_HN);
    LAS bf16_t* sQ = (LAS bf16_t*)smem; LAS bf16_t* sK = sQ + 64 * 128; LAS bf16_t* sV = sK + 64 * 128;
    LAS float* sS = (LAS float*)(sV + 64 * 128);
    LAS float* sR = sS + 64 * 65;
    for (int unit = blockIdx.x; unit < 1024; unit += gridDim.x) {
        const int c = 2 + (unit & 31), bh = unit >> 5, h = bh & 3, b = bh >> 2;
        for (int i = threadIdx.x; i < 64 * 16; i += NTHREADS) {
            const int j = i >> 4, ch = i & 15; const int t = 64 * c + j - 112;
            const bf16_t* pr = proj + (size_t)(b * TT + t) * INW;
            *(LAS u32x4*)(sQ + j * 128 + ch * 8) = *(const u32x4*)(pr + C_RQ + h * 128 + ch * 8);
            *(LAS u32x4*)(sK + j * 128 + ch * 8) = *(const u32x4*)(pr + C_RK + h * 128 + ch * 8);
            *(LAS u32x4*)(sV + j * 128 + ch * 8) = *(const u32x4*)(pr + C_RV + h * 128 + ch * 8);
        }
        const float* R = ST + (size_t)(bh * 34 + c) * 16384;
        for (int i = threadIdx.x; i < 16384; i += NTHREADS) sR[(i >> 7) * 129 + (i & 127)] = R[i];
        __syncthreads();
        const float lg = logf(1.f - exp2f(-5.f - (float)h));
        const int i = threadIdx.x >> 3, g8 = threadIdx.x & 7;
        {
            float sacc[8];
#pragma unroll
            for (int jj = 0; jj < 8; ++jj) sacc[jj] = 0.f;
            for (int d = 0; d < 128; ++d) {
                const float qv = bf2f(sQ[i * 128 + d]);
#pragma unroll
                for (int jj = 0; jj < 8; ++jj) sacc[jj] += qv * bf2f(sK[(jj * 8 + g8) * 128 + d]);
            }
#pragma unroll
            for (int jj = 0; jj < 8; ++jj) { const int j = jj * 8 + g8; const int df = i > j ? i - j : j - i; sS[i * 65 + j] = sacc[jj] * expf(lg * (float)df); }
        }
        __syncthreads();
        float o[16];
#pragma unroll
        for (int ee = 0; ee < 16; ++ee) o[ee] = 0.f;
        for (int j = 0; j < 64; ++j) {
            const float sv = sS[i * 65 + j];
#pragma unroll
            for (int ee = 0; ee < 16; ++ee) o[ee] += sv * bf2f(sV[j * 128 + ee * 8 + g8]);
        }
        const float xi = expf(lg * (float)(i + 1));
        for (int d = 0; d < 128; ++d) {
            const float qv = bf2f(sQ[i * 128 + d]) * xi;
#pragma unroll
            for (int ee = 0; ee < 16; ++ee) o[ee] += qv * sR[(ee * 8 + g8) * 129 + d];
        }
        float sum = 0.f;
#pragma unroll
        for (int ee = 0; ee < 16; ++ee) sum += o[ee];
        sum += __shfl_xor(sum, 1); sum += __shfl_xor(sum, 2); sum += __shfl_xor(sum, 4);
        const float mu = sum * (1.f / 128.f);
        float var = 0.f;
#pragma unroll
        for (int ee = 0; ee < 16; ++ee) { const float dlt = o[ee] - mu; var += dlt * dlt; }
        var += __shfl_xor(var, 1); var += __shfl_xor(var, 2); var += __shfl_xor(var, 4);
        const float rs = rsqrtf(var * (1.f / 128.f) + 1e-6f);
        const int t = 64 * c + i - 112, srow = t - NMETA;
        const bf16_t* pg = proj + (size_t)(b * TT + t) * INW + C_RG + h * 128;
        bf16_t* po = mixed + (size_t)(b * SEQ + srow) * DM + h * 128;
#pragma unroll
        for (int ee = 0; ee < 16; ++ee) {
            const int e = ee * 8 + g8;
            const float g = bf2f(pg[e]);
            const float gate = g / (1.f + expf(-g));
            po[e] = f2bf(gate * (o[ee] - mu) * rs);
        }
        __syncthreads();
    }
}

#define MFMA32(a, b, c) __builtin_amdgcn_mfma_f32_32x32x16_bf16((a), (b), (c), 0, 0, 0)
constexpr int RLD = 136, RTLD = 72;
DI void phase_ret_state_mfma(const Params& p, LAS char* smem) {
    const bf16_t* proj = (const bf16_t*)(p.ws + OFF_BIG);
    float* ST = (float*)(p.ws + OFF_ST);
    LAS bf16_t* sVT = (LAS bf16_t*)smem; LAS bf16_t* sKT = sVT + 128 * RTLD;
    const int wave = threadIdx.x >> 6, lane = threadIdx.x & 63, r = lane & 31, hh = lane >> 5;
    for (int unit = blockIdx.x; unit < 1024; unit += gridDim.x) {
        const int c = 1 + (unit & 31), bh = unit >> 5, h = bh & 3, b = bh >> 2;
        const float lg = logf(1.f - exp2f(-5.f - (float)h));
        {
            const int j = threadIdx.x >> 3, ch = threadIdx.x & 7, t = 64 * c + j - 112;
            const float z = expf(lg * (float)(63 - j));
#pragma unroll
            for (int q = 0; q < 2; ++q) {
                const int cc = ch + 8 * q;
                u32x4 kv = {0u, 0u, 0u, 0u}, vv = {0u, 0u, 0u, 0u};
                if (t >= 0) { const bf16_t* pr = proj + (size_t)(b * TT + t) * INW; kv = *(const u32x4*)(pr + C_RK + h * 128 + cc * 8); vv = *(const u32x4*)(pr + C_RV + h * 128 + cc * 8); }
                float vf[8]; unpack8(vv, vf);
#pragma unroll
                for (int x = 0; x < 8; ++x) {
                    sKT[(cc * 8 + x) * RTLD + j] = (bf16_t)((kv[x >> 1] >> ((x & 1) * 16)) & 0xffffu);
                    sVT[(cc * 8 + x) * RTLD + j] = f2bf(vf[x] * z);
                }
            }
        }
        __syncthreads();
        const int mb = wave >> 1;
#pragma unroll
        for (int q = 0; q < 2; ++q) {
            const int nb = (wave & 1) * 2 + q;
            f32x16 acc;
#pragma unroll
            for (int i = 0; i < 16; ++i) acc[i] = 0.f;
#pragma unroll
            for (int ks = 0; ks < 4; ++ks) {
                const bf16x8 a = *(const LAS bf16x8*)(sVT + (mb * 32 + r) * RTLD + ks * 16 + 8 * hh);
                const bf16x8 bb = *(const LAS bf16x8*)(sKT + (nb * 32 + r) * RTLD + ks * 16 + 8 * hh);
                acc = MFMA32(a, bb, acc);
            }
            float* st = ST + (size_t)(bh * 34 + c) * 16384 + nb * 32 + r;
#pragma unroll
            for (int i = 0; i < 16; ++i) st[(size_t)(mb * 32 + (i & 3) + 8 * (i >> 2) + 4 * hh) * 128] = acc[i];
        }
        __syncthreads();
    }
}
DI void phase_ret_out_mfma(const Params& p, LAS char* smem) {
    const bf16_t* proj = (const bf16_t*)(p.ws + OFF_BIG);
    const float* ST = (const float*)(p.ws + OFF_ST);
    bf16_t* mixed = (bf16_t*)(p.ws + OFF_HN);
    LAS bf16_t* sQ = (LAS bf16_t*)smem; LAS bf16_t* sK = sQ + 64 * RLD; LAS bf16_t* sVT = sK + 64 * RLD;
    LAS float* sGN = (LAS float*)(sVT + 128 * RTLD);
    const int wave = threadIdx.x >> 6, lane = threadIdx.x & 63, r = lane & 31, hh = lane >> 5;
    const int ib = wave & 1, eb = wave >> 1;
    for (int unit = blockIdx.x; unit < 1024; unit += gridDim.x) {
        const int c = 2 + (unit & 31), bh = unit >> 5, h = bh & 3, b = bh >> 2;
        const float lg = logf(1.f - exp2f(-5.f - (float)h));
        for (int i = threadIdx.x; i < 64 * 16; i += NTHREADS) {
            const int j = i >> 4, ch = i & 15; const int t = 64 * c + j - 112;
            const bf16_t* pr = proj + (size_t)(b * TT + t) * INW;
            *(LAS u32x4*)(sQ + j * RLD + ch * 8) = *(const u32x4*)(pr + C_RQ + h * 128 + ch * 8);
            *(LAS u32x4*)(sK + j * RLD + ch * 8) = *(const u32x4*)(pr + C_RK + h * 128 + ch * 8);
            const u32x4 vv = *(const u32x4*)(pr + C_RV + h * 128 + ch * 8);
#pragma unroll
            for (int x = 0; x < 8; ++x) sVT[(ch * 8 + x) * RTLD + j] = (bf16_t)((vv[x >> 1] >> ((x & 1) * 16)) & 0xffffu);
        }
        __syncthreads();
        f32x16 acc;
#pragma unroll
        for (int i = 0; i < 16; ++i) acc[i] = 0.f;
        {
            const float* R = ST + (size_t)(bh * 34 + c) * 16384 + (size_t)(eb * 32 + r) * 128 + 8 * hh;
#pragma unroll
            for (int ks = 0; ks < 8; ++ks) {
                const float4 r0 = *(const float4*)(R + ks * 16), r1 = *(const float4*)(R + ks * 16 + 4);
                const float rf[8] = {r0.x, r0.y, r0.z, r0.w, r1.x, r1.y, r1.z, r1.w};
                const bf16x8 a = pack8(rf);
                const bf16x8 bq = *(const LAS bf16x8*)(sQ + (ib * 32 + r) * RLD + ks * 16 + 8 * hh);
                acc = MFMA32(a, bq, acc);
            }
            const float xi = expf(lg * (float)(ib * 32 + r + 1));
#pragma unroll
            for (int i = 0; i < 16; ++i) acc[i] *= xi;
        }
#pragma unroll
        for (int jb = 0; jb < 2; ++jb) {
            f32x16 st;
#pragma unroll
            for (int i = 0; i < 16; ++i) st[i] = 0.f;
#pragma unroll
            for (int ks = 0; ks < 8; ++ks) {
                const bf16x8 a = *(const LAS bf16x8*)(sK + (jb * 32 + r) * RLD + ks * 16 + 8 * hh);
                const bf16x8 bq = *(const LAS bf16x8*)(sQ + (ib * 32 + r) * RLD + ks * 16 + 8 * hh);
                st = MFMA32(a, bq, st);
            }
            const int icol = ib * 32 + r;
#pragma unroll
            for (int i = 0; i < 16; ++i) {
                const int j = jb * 32 + (i & 3) + 8 * (i >> 2) + 4 * hh; const int df = icol > j ? icol - j : j - icol;
                st[i] *= expf(lg * (float)df);
            }
#pragma unroll
            for (int s2 = 0; s2 < 2; ++s2) {
                bf16x8 bp;
#pragma unroll
                for (int x = 0; x < 8; ++x) bp[x] = (short)f2bf(st[8 * s2 + x]);
                const LAS bf16_t* vr = sVT + (eb * 32 + r) * RTLD + jb * 32 + 16 * s2 + 4 * hh;
                const s16x4 lo = *(const LAS s16x4*)(vr), hi = *(const LAS s16x4*)(vr + 8);
                const bf16x8 a = __builtin_shufflevector(lo, hi, 0, 1, 2, 3, 4, 5, 6, 7);
                acc = MFMA32(a, bp, acc);
            }
        }
        float s1 = 0.f, s2 = 0.f;
#pragma unroll
        for (int i = 0; i < 16; ++i) { s1 += acc[i]; s2 += acc[i] * acc[i]; }
        s1 += __shfl_xor(s1, 32); s2 += __shfl_xor(s2, 32);
        if (hh == 0) { sGN[(eb * 64 + ib * 32 + r) * 2] = s1; sGN[(eb * 64 + ib * 32 + r) * 2 + 1] = s2; }
        __syncthreads();
        float S1 = 0.f, S2 = 0.f;
#pragma unroll
        for (int e4 = 0; e4 < 4; ++e4) { S1 += sGN[(e4 * 64 + ib * 32 + r) * 2]; S2 += sGN[(e4 * 64 + ib * 32 + r) * 2 + 1]; }
        const float mu = S1 * (1.f / 128.f), var = fmaxf(S2 * (1.f / 128.f) - mu * mu, 0.f), rs = rsqrtf(var + 1e-6f);
        const int t = 64 * c + ib * 32 + r - 112, srow = t - NMETA;
        const bf16_t* pg = proj + (size_t)(b * TT + t) * INW + C_RG + h * 128 + eb * 32 + 4 * hh;
        bf16_t* po = mixed + (size_t)(b * SEQ + srow) * DM + h * 128 + eb * 32 + 4 * hh;
#pragma unroll
        for (int g4 = 0; g4 < 4; ++g4) {
            const uint2 graw = *(const uint2*)(pg + 8 * g4);
            const float gv[4] = {__uint_as_float(graw.x << 16), __uint_as_float(graw.x & 0xffff0000u), __uint_as_float(graw.y << 16), __uint_as_float(graw.y & 0xffff0000u)};
            float o[4];
#pragma unroll
            for (int x = 0; x < 4; ++x) { const float gate = gv[x] / (1.f + expf(-gv[x])); o[x] = gate * (acc[4 * g4 + x] - mu) * rs; }
            uint2 w; w.x = (unsigned)f2bf(o[0]) | ((unsigned)f2bf(o[1]) << 16); w.y = (unsigned)f2bf(o[2]) | ((unsigned)f2bf(o[3]) << 16);
            *(uint2*)(po + 8 * g4) = w;
        }
        __syncthreads();
    }
}

DI void phase_norm2(const Params& p) {
    bf16_t* hn2 = (bf16_t*)(p.ws + OFF_HN);
    const int wave = threadIdx.x >> 6, lane = threadIdx.x & 63;
    for (int row = blockIdx.x * NWAVES + wave; row < NF; row += gridDim.x * NWAVES) {
        const float* src = p.out + (size_t)row * DM; bf16_t* o = hn2 + (size_t)row * DM;
        float4 v[4]; float ss = 0.f;
#pragma unroll
        for (int i = 0; i < 4; ++i) { v[i] = *(const float4*)(src + i * 256 + lane * 4); ss += v[i].x * v[i].x + v[i].y * v[i].y + v[i].z * v[i].z + v[i].w * v[i].w; }
        ss = wave_sum(ss);
        const float rstd = rsqrtf(ss * (1.f / DM) + 1e-6f);
#pragma unroll
        for (int i = 0; i < 4; ++i) {
            const float4 g = *(const float4*)(p.norm_ffn + i * 256 + lane * 4);
            uint2 w;
            w.x = (unsigned)f2bf(v[i].x * rstd * g.x) | ((unsigned)f2bf(v[i].y * rstd * g.y) << 16);
            w.y = (unsigned)f2bf(v[i].z * rstd * g.z) | ((unsigned)f2bf(v[i].w * rstd * g.w) << 16);
            *(uint2*)(o + i * 256 + lane * 4) = w;
        }
    }
}

constexpr int PSEL_WAVE_LDS = 32 * 2 * 16 * 8 + 32 * 16 * 8;
DI void phase_peer_select(const Params& p, LAS char* smem) {
    const float* PQ = (const float*)(p.ws + OFF_BIG);
    int* EIDX = (int*)(p.ws + OFF_EIDX); float* GATE = (float*)(p.ws + OFF_GATE);
    const int wave = threadIdx.x >> 6, lane = threadIdx.x & 63, r = lane & 31, hh = lane >> 5;
    LAS float* lv = (LAS float*)(smem + wave * PSEL_WAVE_LDS);
    LAS int* li = (LAS int*)(lv + 32 * 2 * 16);
    LAS float* cs = (LAS float*)(li + 32 * 2 * 16);
    LAS int* cab = (LAS int*)(cs + 32 * 16);
    for (int task = blockIdx.x * NWAVES + wave; task < (NF / 32) * 8; task += gridDim.x * NWAVES) {
        const int tile = task >> 3, h = task & 7;
        const int n = tile * 32 + r;
#pragma unroll 1
        for (int half = 0; half < 2; ++half) {
            f32x16 acc[4];
            {
                const float* srow = PQ + (size_t)n * 2048 + h * 256 + half * 128 + hh * 64;
#pragma unroll
                for (int mb = 0; mb < 4; ++mb)
#pragma unroll
                    for (int q = 0; q < 4; ++q) { const float4 a = *(const float4*)(srow + mb * 16 + q * 4); acc[mb][q * 4] = a.x; acc[mb][q * 4 + 1] = a.y; acc[mb][q * 4 + 2] = a.z; acc[mb][q * 4 + 3] = a.w; }
            }
            float mprev = INFINITY;
#pragma unroll 1
            for (int it = 0; it < 16; ++it) {
                float m = -INFINITY;
#pragma unroll
                for (int mb = 0; mb < 4; ++mb)
#pragma unroll
                    for (int i = 0; i < 16; ++i) { const float v = acc[mb][i]; m = fmaxf(m, v < mprev ? v : -INFINITY); }
                m = fmaxf(m, __shfl_xor(m, 32));
                mprev = m;
            }
            const float T = mprev;
            int cnt = 0;
#pragma unroll
            for (int mb = 0; mb < 4; ++mb)
#pragma unroll
                for (int i = 0; i < 16; ++i) cnt += (acc[mb][i] >= T) ? 1 : 0;
            const int pc = __shfl_xor(cnt, 32);
            int pos = hh ? pc : 0;
            LAS float* lvp = lv + (r * 2 + half) * 16; LAS int* lip = li + (r * 2 + half) * 16;
#pragma unroll
            for (int mb = 0; mb < 4; ++mb)
#pragma unroll
                for (int i = 0; i < 16; ++i) {
                    const float v = acc[mb][i];
                    if (v >= T) { if (pos < 16) { lvp[pos] = v; lip[pos] = hh * 64 + mb * 16 + i; } ++pos; }
                }
        }
        lds_fence();
        float v1[8], v2[16];
#pragma unroll
        for (int a = 0; a < 8; ++a) v1[a] = lv[(r * 2 + 0) * 16 + 8 * hh + a];
#pragma unroll
        for (int b = 0; b < 16; ++b) v2[b] = lv[(r * 2 + 1) * 16 + b];
        float mprev = INFINITY;
#pragma unroll 1
        for (int it = 0; it < 16; ++it) {
            float m = -INFINITY;
#pragma unroll
            for (int a = 0; a < 8; ++a)
#pragma unroll
                for (int b = 0; b < 16; ++b) { const float v = v1[a] + v2[b]; m = fmaxf(m, v < mprev ? v : -INFINITY); }
            m = fmaxf(m, __shfl_xor(m, 32));
            mprev = m;
        }
        const float Tc = mprev;
        int cnt = 0;
#pragma unroll
        for (int a = 0; a < 8; ++a)
#pragma unroll
            for (int b = 0; b < 16; ++b) cnt += (v1[a] + v2[b] >= Tc) ? 1 : 0;
        const int pc = __shfl_xor(cnt, 32);
        int pos = hh ? pc : 0;
#pragma unroll
        for (int a = 0; a < 8; ++a)
#pragma unroll
            for (int b = 0; b < 16; ++b) {
                const float v = v1[a] + v2[b];
                if (v >= Tc) { if (pos < 16) { cs[r * 16 + pos] = v; cab[r * 16 + pos] = (8 * hh + a) * 16 + b; } ++pos; }
            }
        lds_fence();
        float scv[16]; float mx = -INFINITY;
#pragma unroll
        for (int i = 0; i < 16; ++i) { scv[i] = cs[r * 16 + i]; mx = fmaxf(mx, scv[i]); }
        float sum = 0.f;
#pragma unroll
        for (int i = 0; i < 16; ++i) { scv[i] = expf(scv[i] - mx); sum += scv[i]; }
        const float inv = 1.f / sum;
#pragma unroll
        for (int i = 0; i < 16; ++i) {
            if ((i >> 3) == hh) {
                const int ab = cab[r * 16 + i];
                const int e = li[(r * 2 + 0) * 16 + (ab >> 4)] * 128 + li[(r * 2 + 1) * 16 + (ab & 15)];
                EIDX[(size_t)n * 128 + h * 16 + i] = e;
                GATE[(size_t)n * 128 + h * 16 + i] = scv[i] * inv;
            }
        }
        lds_fence();
    }
}

typedef float f32x2 __attribute__((ext_vector_type(2)));
DI void phase_convert_tables(const Params& p) {
    const int wave = threadIdx.x >> 6, lane = threadIdx.x & 63;
    for (int rowi = blockIdx.x * NWAVES + wave; rowi < 2 * 16384; rowi += gridDim.x * NWAVES) {
        const bool isv = rowi >= 16384; const int e = isv ? rowi - 16384 : rowi;
        const float* src = (isv ? p.pv : p.pu) + (size_t)e * DM + lane * 16;
        float x[16]; float mx = 0.f;
#pragma unroll
        for (int i = 0; i < 4; ++i) { const float4 a = *(const float4*)(src + i * 4); x[i * 4] = a.x; x[i * 4 + 1] = a.y; x[i * 4 + 2] = a.z; x[i * 4 + 3] = a.w; }
#pragma unroll
        for (int i = 0; i < 16; ++i) mx = fmaxf(mx, fabsf(x[i]));
        mx = wave_max(mx);
        const float top = isv ? 240.f : 127.f;
        const float inv = mx > 0.f ? top / mx : 0.f, scale = mx > 0.f ? mx / top : 0.f;
        u32x4 o;
        if (isv) {
#pragma unroll
            for (int w = 0; w < 4; ++w) {
                int pk = 0;
                pk = __builtin_amdgcn_cvt_pk_fp8_f32(x[w * 4] * inv, x[w * 4 + 1] * inv, pk, false);
                pk = __builtin_amdgcn_cvt_pk_fp8_f32(x[w * 4 + 2] * inv, x[w * 4 + 3] * inv, pk, true);
                o[w] = (unsigned)pk;
            }
        } else {
#pragma unroll
            for (int w = 0; w < 4; ++w) {
                unsigned pk = 0u;
#pragma unroll
                for (int b = 0; b < 4; ++b) { const int q = (int)rintf(x[w * 4 + b] * inv); pk |= ((unsigned)q & 0xffu) << (8 * b); }
                o[w] = pk;
            }
        }
        *(u32x4*)(p.ws + (isv ? OFF_V8 : OFF_U8) + (size_t)e * DM + lane * 16) = o;
        if (lane == 0) ((float*)(p.ws + (isv ? OFF_SV : OFF_SU)))[e] = scale;
    }
}
DI void unpack16_fp8(const u32x4& r, float (&v)[16]) {
#pragma unroll
    for (int w = 0; w < 4; ++w) {
        const f32x2 a = __builtin_amdgcn_cvt_pk_f32_fp8((int)r[w], false), b = __builtin_amdgcn_cvt_pk_f32_fp8((int)r[w], true);
        v[w * 4] = a[0]; v[w * 4 + 1] = a[1]; v[w * 4 + 2] = b[0]; v[w * 4 + 3] = b[1];
    }
}
#ifndef P10_REP
#define P10_REP 1
#endif
DI void phase_peer_out(const Params& p) {
    const int* EIDX = (const int*)(p.ws + OFF_EIDX); const float* GATE = (const float*)(p.ws + OFF_GATE);
    const char* U8 = p.ws + OFF_U8; const char* V8 = p.ws + OFF_V8;
    const float* SU = (const float*)(p.ws + OFF_SU); const float* SV = (const float*)(p.ws + OFF_SV);
    const int wave = threadIdx.x >> 6, lane = threadIdx.x & 63;
    for (int n = blockIdx.x * NWAVES + wave; n < NF; n += gridDim.x * NWAVES) {
        float* row = p.out + (size_t)n * DM + lane * 16;
        float hv[16], hn[16]; float ss = 0.f;
#pragma unroll
        for (int i = 0; i < 4; ++i) { const float4 a = *(const float4*)(row + i * 4); hv[i * 4] = a.x; hv[i * 4 + 1] = a.y; hv[i * 4 + 2] = a.z; hv[i * 4 + 3] = a.w; }
#pragma unroll
        for (int i = 0; i < 16; ++i) ss += hv[i] * hv[i];
        ss = wave_sum_uniform(ss);
        const float rstd = rsqrtf(ss * (1.f / DM) + 1e-6f);
#pragma unroll
        for (int i = 0; i < 4; ++i) {
            const float4 a = *(const float4*)(p.norm_ffn + lane * 16 + i * 4);
            hn[i * 4] = hv[i * 4] * rstd * a.x; hn[i * 4 + 1] = hv[i * 4 + 1] * rstd * a.y; hn[i * 4 + 2] = hv[i * 4 + 2] * rstd * a.z; hn[i * 4 + 3] = hv[i * 4 + 3] * rstd * a.w;
        }
        float acc[16];
#pragma unroll
        for (int i = 0; i < 16; ++i) acc[i] = 0.f;
        const int e_lo = EIDX[(size_t)n * 128 + lane], e_hi = EIDX[(size_t)n * 128 + 64 + lane];
        const float g_lo = GATE[(size_t)n * 128 + lane], g_hi = GATE[(size_t)n * 128 + 64 + lane];
#pragma unroll 1
        for (int s0_ = 0; s0_ < 128 * P10_REP; s0_ += 8) {
            const int s0 = s0_ & 127;
            u32x4 ub[8], vb[8]; float gt[8], su[8], sv[8];
#pragma unroll
            for (int k = 0; k < 8; ++k) {
                const int slot = s0 + k;
                const int e = slot < 64 ? __builtin_amdgcn_readlane(e_lo, slot & 63) : __builtin_amdgcn_readlane(e_hi, slot & 63);
                gt[k] = __int_as_float(slot < 64 ? __builtin_amdgcn_readlane(__float_as_int(g_lo), slot & 63) : __builtin_amdgcn_readlane(__float_as_int(g_hi), slot & 63));
                ub[k] = *(const u32x4*)(U8 + (size_t)e * DM + lane * 16);
                vb[k] = *(const u32x4*)(V8 + (size_t)e * DM + lane * 16);
                su[k] = SU[e]; sv[k] = SV[e];
            }
            float d[8];
#pragma unroll
            for (int k = 0; k < 8; ++k) {
                float u[16]; unpack16_fp8(ub[k], u);
                float t = 0.f;
#pragma unroll
                for (int i = 0; i < 16; ++i) t += u[i] * hn[i];
                d[k] = t;
            }
#pragma unroll
            for (int k = 0; k < 8; ++k) d[k] = wave_sum_uniform(d[k]) * su[k];
#pragma unroll
            for (int k = 0; k < 8; ++k) {
                const float coef = 0.5f * d[k] * (1.f + erff(d[k] * 0.70710678118654752f)) * gt[k] * sv[k];
                float v[16]; unpack16_fp8(vb[k], v);
#pragma unroll
                for (int i = 0; i < 16; ++i) acc[i] += coef * v[i];
            }
        }
        float s2 = 0.f;
#pragma unroll
        for (int i = 0; i < 16; ++i) { acc[i] = acc[i] * (1.f / P10_REP) + hv[i]; s2 += acc[i] * acc[i]; }
        s2 = wave_sum_uniform(s2);
        float r2 = rsqrtf(s2 * (1.f / DM) + 1e-6f);
#if TP_SEC
        r2 *= 1.f + 0.5f * ((const float*)(p.ws + OFF_BAR))[3602];
#endif
#ifdef DSA_CHECK
        {
            const float num = ((const float*)(p.ws + OFF_BAR))[3600], den = ((const float*)(p.ws + OFF_BAR))[3601];
            r2 *= 1.f + 10.f * sqrtf(num / fmaxf(den, 1e-30f));
        }
#endif
#pragma unroll
        for (int i = 0; i < 4; ++i) {
            const float4 a = *(const float4*)(p.norm_final + lane * 16 + i * 4);
            *(float4*)(row + i * 4) = make_float4(acc[i * 4] * r2 * a.x, acc[i * 4 + 1] * r2 * a.y, acc[i * 4 + 2] * r2 * a.z, acc[i * 4 + 3] * r2 * a.w);
        }
    }
}

#ifndef SWB
#define SWB 4
#endif
#ifndef TG
#define TG 2
#endif
constexpr int SW_NP = TG * 128, SW_PL = SW_NP / 64;
constexpr int SW_WAVE_LDS = 64 * 4 + SW_NP * 4 + SW_NP * 4;
#if TG == 2
#define SW_CASES(tl, STMT) if ((tl) == 0) { constexpr int T_ = 0; STMT } else { constexpr int T_ = 1; STMT }
#else
#define SW_CASES(tl, STMT) switch (tl) { case 0: { constexpr int T_ = 0; STMT } break; case 1: { constexpr int T_ = 1; STMT } break; case 2: { constexpr int T_ = 2; STMT } break; default: { constexpr int T_ = 3; STMT } break; }
#endif
DI void phase_peer_out_sweep(const Params& p, LAS char* smem) {
    const int* EIDX = (const int*)(p.ws + OFF_EIDX); const float* GATE = (const float*)(p.ws + OFF_GATE);
    const char* U8 = p.ws + OFF_U8; const char* V8 = p.ws + OFF_V8;
    const float* SU = (const float*)(p.ws + OFF_SU); const float* SV = (const float*)(p.ws + OFF_SV);
    const int wave = threadIdx.x >> 6, lane = threadIdx.x & 63;
    LAS int* cnt = (LAS int*)(smem + wave * SW_WAVE_LDS); LAS int* off = cnt + 32;
    LAS int* list_e = off + 32; LAS float* list_g = (LAS float*)(list_e + SW_NP);
    for (int grp = blockIdx.x * NWAVES + wave; grp < NF / TG; grp += gridDim.x * NWAVES) {
        const int n0 = grp * TG;
        float hn[TG][16], acc[TG][16];
#pragma unroll
        for (int tl = 0; tl < TG; ++tl) {
            const float* row = p.out + (size_t)(n0 + tl) * DM + lane * 16;
            float ss = 0.f;
#pragma unroll
            for (int i = 0; i < 4; ++i) { const float4 a = *(const float4*)(row + i * 4); hn[tl][i * 4] = a.x; hn[tl][i * 4 + 1] = a.y; hn[tl][i * 4 + 2] = a.z; hn[tl][i * 4 + 3] = a.w; }
#pragma unroll
            for (int i = 0; i < 16; ++i) ss += hn[tl][i] * hn[tl][i];
            ss = wave_sum_uniform(ss);
            const float rstd = rsqrtf(ss * (1.f / DM) + 1e-6f);
#pragma unroll
            for (int i = 0; i < 4; ++i) {
                const float4 a = *(const float4*)(p.norm_ffn + lane * 16 + i * 4);
                hn[tl][i * 4] *= rstd * a.x; hn[tl][i * 4 + 1] *= rstd * a.y; hn[tl][i * 4 + 2] *= rstd * a.z; hn[tl][i * 4 + 3] *= rstd * a.w;
            }
#pragma unroll
            for (int i = 0; i < 16; ++i) acc[tl][i] = 0.f;
        }
        if (lane < 32) cnt[lane] = 0;
        lds_fence();
        {
            int ek[SW_PL], rk[SW_PL]; float gk[SW_PL];
#pragma unroll
            for (int k = 0; k < SW_PL; ++k) {
                const size_t o = (size_t)(n0 + (k >> 1)) * 128 + (k & 1) * 64 + lane;
                ek[k] = EIDX[o]; gk[k] = GATE[o];
            }
#pragma unroll
            for (int k = 0; k < SW_PL; ++k) rk[k] = __hip_atomic_fetch_add(&cnt[ek[k] >> 9], 1, __ATOMIC_RELAXED, __HIP_MEMORY_SCOPE_WORKGROUP);
            lds_fence();
            {
                int cv = lane < 32 ? cnt[lane] : 0, inc = cv;
#pragma unroll
                for (int d = 1; d < 32; d <<= 1) { const int o = __shfl_up(inc, d); if ((lane & 31) >= d) inc += o; }
                if (lane < 32) off[lane] = inc - cv;
            }
            lds_fence();
#pragma unroll
            for (int k = 0; k < SW_PL; ++k) { const int pos = off[ek[k] >> 9] + rk[k]; list_e[pos] = ek[k] | ((k >> 1) << 16); list_g[pos] = gk[k]; }
        }
        lds_fence();
#define SW_LOAD(X, P0) do { _Pragma("unroll") for (int k = 0; k < SWB; ++k) { \
            const int ev = __builtin_amdgcn_readfirstlane(list_e[(P0) + k]); const int e = ev & 0xffff; tls##X[k] = ev >> 16; gt##X[k] = list_g[(P0) + k]; \
            ub##X[k] = *(const u32x4*)(U8 + (size_t)e * DM + lane * 16); vb##X[k] = *(const u32x4*)(V8 + (size_t)e * DM + lane * 16); \
            su##X[k] = SU[e]; sv##X[k] = SV[e]; } } while (0)
#define SW_COMPUTE(X) do { float d[SWB]; \
            _Pragma("unroll") for (int k = 0; k < SWB; ++k) { float u[16]; unpack16_fp8(ub##X[k], u); float t = 0.f; \
                SW_CASES(tls##X[k], _Pragma("unroll") for (int i = 0; i < 16; ++i) t += u[i] * hn[T_][i];) d[k] = t; } \
            _Pragma("unroll") for (int k = 0; k < SWB; ++k) d[k] = wave_sum_uniform(d[k]) * su##X[k]; \
            float dv = 0.f; _Pragma("unroll") for (int k = 0; k < SWB; ++k) dv = (lane == k) ? d[k] : dv; \
            const float gl = 0.5f * dv * (1.f + erff(dv * 0.70710678118654752f)); \
            _Pragma("unroll") for (int k = 0; k < SWB; ++k) { \
                const float coef = __int_as_float(__builtin_amdgcn_readlane(__float_as_int(gl), k)) * gt##X[k] * sv##X[k]; \
                float v[16]; unpack16_fp8(vb##X[k], v); \
                SW_CASES(tls##X[k], _Pragma("unroll") for (int i = 0; i < 16; ++i) acc[T_][i] += coef * v[i];) } } while (0)
        {
            u32x4 ubA[SWB], vbA[SWB], ubB[SWB], vbB[SWB]; float gtA[SWB], suA[SWB], svA[SWB], gtB[SWB], suB[SWB], svB[SWB]; int tlsA[SWB], tlsB[SWB];
#ifndef SW_REP
#define SW_REP 1
#endif
#pragma unroll 1
            for (int rep_ = 0; rep_ < SW_REP; ++rep_) {
            SW_LOAD(A, 0);
#pragma unroll 1
            for (int p0 = 0; p0 < SW_NP; p0 += 2 * SWB) {
                SW_LOAD(B, p0 + SWB);
                SW_COMPUTE(A);
                if (p0 + 2 * SWB < SW_NP) SW_LOAD(A, p0 + 2 * SWB);
                SW_COMPUTE(B);
            }
            }
        }
#pragma unroll
        for (int tl = 0; tl < TG; ++tl) {
            float* row = p.out + (size_t)(n0 + tl) * DM + lane * 16;
            float y[16]; float s2 = 0.f;
#pragma unroll
            for (int i = 0; i < 4; ++i) { const float4 a = *(const float4*)(row + i * 4); y[i * 4] = a.x + acc[tl][i * 4] * (1.f / SW_REP); y[i * 4 + 1] = a.y + acc[tl][i * 4 + 1] * (1.f / SW_REP); y[i * 4 + 2] = a.z + acc[tl][i * 4 + 2] * (1.f / SW_REP); y[i * 4 + 3] = a.w + acc[tl][i * 4 + 3] * (1.f / SW_REP); }
#pragma unroll
            for (int i = 0; i < 16; ++i) s2 += y[i] * y[i];
            s2 = wave_sum_uniform(s2);
            float r2 = rsqrtf(s2 * (1.f / DM) + 1e-6f);
#if TP_SEC
            r2 *= 1.f + 0.5f * ((const float*)(p.ws + OFF_BAR))[3602];
#endif
#ifdef DSA_CHECK
            { const float num = ((const float*)(p.ws + OFF_BAR))[3600], den = ((const float*)(p.ws + OFF_BAR))[3601]; r2 *= 1.f + 10.f * sqrtf(num / fmaxf(den, 1e-30f)); }
#endif
#pragma unroll
            for (int i = 0; i < 4; ++i) {
                const float4 a = *(const float4*)(p.norm_final + lane * 16 + i * 4);
                *(float4*)(row + i * 4) = make_float4(y[i * 4] * r2 * a.x, y[i * 4 + 1] * r2 * a.y, y[i * 4 + 2] * r2 * a.z, y[i * 4 + 3] * r2 * a.w);
            }
        }
        lds_fence();
    }
}

constexpr int RW_NB = 128, RW_SH = 7;
constexpr int RW_WAVE_LDS = 4 * (RW_NB + 16) * 4 + 4 * 128 * 4 + 4 * 128 * 4;
DI float gelu_as(float v) {
    const float av = fabsf(v), t = __builtin_amdgcn_rcpf(av * 0.2316418882f + 1.0f);
    float q = t * 0.5307027145f + (-0.7265760135f); q = q * t + 0.7107068705f; q = q * t + (-0.142248368f); q = q * t + 0.127414796f; q = q * t;
    const float e = __builtin_amdgcn_exp2f((v * v) * (-0.72134752044f));
    const float m = v * (q * e), r = v - m;
    return v < 0.f ? m : r;
}
DI void phase_peer_out_rows(const Params& p, LAS char* smem) {
    const int* EIDX = (const int*)(p.ws + OFF_EIDX); const float* GATE = (const float*)(p.ws + OFF_GATE);
    const char* U8 = p.ws + OFF_U8; const char* V8 = p.ws + OFF_V8;
    const float* SU = (const float*)(p.ws + OFF_SU); const float* SV = (const float*)(p.ws + OFF_SV);
    const int wave = threadIdx.x >> 6, lane = threadIdx.x & 63, r = lane >> 4, l16 = lane & 15;
    LAS int* cnt = (LAS int*)(smem + wave * RW_WAVE_LDS) + r * (RW_NB + 16);
    LAS int* list_e = (LAS int*)(smem + wave * RW_WAVE_LDS + 4 * (RW_NB + 16) * 4) + r * 128;
    LAS float* list_g = (LAS float*)(smem + wave * RW_WAVE_LDS + 4 * (RW_NB + 16) * 4 + 2048) + r * 128;
    for (int grp = blockIdx.x * NWAVES + wave; grp < NF / 4; grp += gridDim.x * NWAVES) {
        const int n = grp * 4 + r;
        float acc[64]; int hq[16]; float hscale;
        const float* hrow = p.out + (size_t)n * DM + l16 * 16;
        {
            float hn[64];
            float ss = 0.f;
#pragma unroll
            for (int j = 0; j < 4; ++j)
#pragma unroll
                for (int q = 0; q < 4; ++q) { const float4 a = *(const float4*)(hrow + j * 256 + q * 4); hn[j * 16 + q * 4] = a.x; hn[j * 16 + q * 4 + 1] = a.y; hn[j * 16 + q * 4 + 2] = a.z; hn[j * 16 + q * 4 + 3] = a.w; }
#pragma unroll
            for (int i = 0; i < 64; ++i) ss += hn[i] * hn[i];
            ss = dpp_row_sum(ss);
            const float rstd = rsqrtf(ss * (1.f / DM) + 1e-6f);
#pragma unroll
            for (int j = 0; j < 4; ++j)
#pragma unroll
                for (int q = 0; q < 4; ++q) {
                    const float4 a = *(const float4*)(p.norm_ffn + j * 256 + l16 * 16 + q * 4);
                    hn[j * 16 + q * 4] *= rstd * a.x; hn[j * 16 + q * 4 + 1] *= rstd * a.y; hn[j * 16 + q * 4 + 2] *= rstd * a.z; hn[j * 16 + q * 4 + 3] *= rstd * a.w;
                }
            float hm = 0.f;
#pragma unroll
            for (int i = 0; i < 64; ++i) hm = fmaxf(hm, fabsf(hn[i]));
            hm = fmaxf(hm, __int_as_float(__builtin_amdgcn_update_dpp(0, __float_as_int(hm), 0xB1, 0xF, 0xF, true)));
            hm = fmaxf(hm, __int_as_float(__builtin_amdgcn_update_dpp(0, __float_as_int(hm), 0x4E, 0xF, 0xF, true)));
            hm = fmaxf(hm, __int_as_float(__builtin_amdgcn_update_dpp(0, __float_as_int(hm), 0x141, 0xF, 0xF, true)));
            hm = fmaxf(hm, __int_as_float(__builtin_amdgcn_update_dpp(0, __float_as_int(hm), 0x140, 0xF, 0xF, true)));
            const float hinv = hm > 0.f ? 127.f / hm : 0.f; hscale = hm * (1.f / 127.f);
#pragma unroll
            for (int w = 0; w < 16; ++w) {
                unsigned pk = 0u;
#pragma unroll
                for (int b = 0; b < 4; ++b) { const int q = (int)rintf(hn[w * 4 + b] * hinv); pk |= ((unsigned)q & 0xffu) << (8 * b); }
                hq[w] = (int)pk;
            }
#pragma unroll
            for (int i = 0; i < 64; ++i) acc[i] = 0.f;
        }
#pragma unroll
        for (int q = 0; q < RW_NB / 16; ++q) cnt[q * 16 + l16] = 0;
        lds_fence();
        {
            int ek[8], rk[8]; float gk[8];
#pragma unroll
            for (int k = 0; k < 8; ++k) { ek[k] = EIDX[(size_t)n * 128 + k * 16 + l16]; gk[k] = GATE[(size_t)n * 128 + k * 16 + l16]; }
#pragma unroll
            for (int k = 0; k < 8; ++k) rk[k] = __hip_atomic_fetch_add(&cnt[ek[k] >> RW_SH], 1, __ATOMIC_RELAXED, __HIP_MEMORY_SCOPE_WORKGROUP);
            lds_fence();
            {
                constexpr int PB = RW_NB / 16;
                int c[PB], tot = 0;
#pragma unroll
                for (int q = 0; q < PB; ++q) { c[q] = cnt[l16 * PB + q]; tot += c[q]; }
                cnt[RW_NB + l16] = tot;
                lds_fence();
                int base = 0;
#pragma unroll
                for (int q = 0; q < 16; ++q) { const int v = cnt[RW_NB + q]; base += (q < l16) ? v : 0; }
#pragma unroll
                for (int q = 0; q < PB; ++q) { cnt[l16 * PB + q] = base; base += c[q]; }
            }
            lds_fence();
#pragma unroll
            for (int k = 0; k < 8; ++k) { const int pos = cnt[ek[k] >> RW_SH] + rk[k]; list_e[pos] = ek[k]; list_g[pos] = gk[k]; }
        }
        lds_fence();
        {
            u32x4 ub[4], vb[4]; float g_c, su_c, sv_c, g_n = 0.f, su_n = 0.f, sv_n = 0.f;
            {
                const int e_ = list_e[0]; g_c = list_g[0]; su_c = SU[e_]; sv_c = SV[e_];
#pragma unroll
                for (int j = 0; j < 4; ++j) { ub[j] = *(const u32x4*)(U8 + (size_t)e_ * DM + l16 * 16 + j * 256); vb[j] = *(const u32x4*)(V8 + (size_t)e_ * DM + l16 * 16 + j * 256); }
            }
#pragma unroll 1
            for (int sl = 0; sl < 128; ++sl) {
                int isum = 0;
#pragma unroll
                for (int j = 0; j < 4; ++j)
#pragma unroll
                    for (int w = 0; w < 4; ++w) isum = __builtin_amdgcn_sdot4((int)ub[j][w], hq[j * 4 + w], isum, false);
                isum += __builtin_amdgcn_update_dpp(0, isum, 0xB1, 0xF, 0xF, true);
                isum += __builtin_amdgcn_update_dpp(0, isum, 0x4E, 0xF, 0xF, true);
                isum += __builtin_amdgcn_update_dpp(0, isum, 0x141, 0xF, 0xF, true);
                isum += __builtin_amdgcn_update_dpp(0, isum, 0x140, 0xF, 0xF, true);
                float t_ = (float)isum * hscale;
                const int sn = sl + 1 < 128 ? sl + 1 : 127;
                const int e_n = list_e[sn];
                {
                    const char* up_ = U8 + (size_t)e_n * DM + l16 * 16;
#pragma unroll
                    for (int j = 0; j < 4; ++j) ub[j] = *(const u32x4*)(up_ + j * 256);
                    g_n = list_g[sn]; su_n = SU[e_n]; sv_n = SV[e_n];
                }
                t_ *= su_c;
                const float coef_ = gelu_as(t_) * g_c * sv_c;
#pragma unroll
                for (int j = 0; j < 4; ++j) { float v[16]; unpack16_fp8(vb[j], v);
#pragma unroll
                    for (int i = 0; i < 16; ++i) acc[j * 16 + i] += coef_ * v[i]; }
                {
                    const char* vp_ = V8 + (size_t)e_n * DM + l16 * 16;
#pragma unroll
                    for (int j = 0; j < 4; ++j) vb[j] = *(const u32x4*)(vp_ + j * 256);
                }
                g_c = g_n; su_c = su_n; sv_c = sv_n;
            }
        }
        {
            float* orow = p.out + (size_t)n * DM + l16 * 16;
            float s2 = 0.f;
#pragma unroll
            for (int j = 0; j < 4; ++j)
#pragma unroll
                for (int q = 0; q < 4; ++q) { const float4 a = *(const float4*)(orow + j * 256 + q * 4); acc[j * 16 + q * 4] += a.x; acc[j * 16 + q * 4 + 1] += a.y; acc[j * 16 + q * 4 + 2] += a.z; acc[j * 16 + q * 4 + 3] += a.w; }
#pragma unroll
            for (int i = 0; i < 64; ++i) s2 += acc[i] * acc[i];
            s2 = dpp_row_sum(s2);
            float r2 = rsqrtf(s2 * (1.f / DM) + 1e-6f);
#if TP_SEC
            r2 *= 1.f + 0.5f * ((const float*)(p.ws + OFF_BAR))[3602];
#endif
#ifdef DSA_CHECK
            { const float num = ((const float*)(p.ws + OFF_BAR))[3600], den = ((const float*)(p.ws + OFF_BAR))[3601]; r2 *= 1.f + 10.f * sqrtf(num / fmaxf(den, 1e-30f)); }
#endif
#pragma unroll
            for (int j = 0; j < 4; ++j)
#pragma unroll
                for (int q = 0; q < 4; ++q) {
                    const float4 a = *(const float4*)(p.norm_final + j * 256 + l16 * 16 + q * 4);
                    *(float4*)(orow + j * 256 + q * 4) = make_float4(acc[j * 16 + q * 4] * r2 * a.x, acc[j * 16 + q * 4 + 1] * r2 * a.y, acc[j * 16 + q * 4 + 2] * r2 * a.z, acc[j * 16 + q * 4 + 3] * r2 * a.w);
                }
        }
        lds_fence();
    }
}

DI Params load_params() {
#if defined(__HIP_DEVICE_COMPILE__)
    typedef const __attribute__((address_space(4))) unsigned long long* cu64_t;
    cu64_t pp = (cu64_t)__builtin_amdgcn_kernarg_segment_ptr();
    asm volatile("" : "+s"(pp));
    static_assert(sizeof(Params) == 16 * 8, "Params is 16 qwords");
    unsigned long long w[16];
#pragma unroll
    for (int i = 0; i < 16; ++i) w[i] = pp[i];
    return __builtin_bit_cast(Params, w);
#else
    return Params{};
#endif
}
constexpr int NPHASES = 10;
__global__ void __launch_bounds__(NTHREADS, 2) mk_forward(Params p) {
    extern __shared__ __attribute__((aligned(16))) char dyn_smem[];
    LAS char* smem = (LAS char*)dyn_smem;
    const bool multi = (p.hi - p.lo) > 1;
    LAS char* tp_smem = smem;
    if (TP_SEC && blockIdx.x == 0 && threadIdx.x == 0) { volatile LAS long long* tp_ = (volatile LAS long long*)(smem + TP_LDS_OFF); tp_[0] = (long long)__builtin_readcyclecounter(); tp_[2] = 0; }
    XcdBarrier bar; bar.bar = (unsigned*)(p.ws + OFF_BAR); bar.x = 0; bar.st = (volatile LAS unsigned*)(smem + LDS_BAR_OFF);
    if (multi) {
        if (threadIdx.x == 0) { const u32x4 z = {0u, 0u, 0u, 0u}; *(LAS u32x4*)(smem + LDS_BAR_OFF) = z; }
        __syncthreads();
        bar = xcd_barrier_post((unsigned*)(p.ws + OFF_BAR), (volatile LAS unsigned*)(smem + LDS_BAR_OFF));
    }
#ifndef PHMASK
#define PHMASK 0xFFFF
#endif
#define PH_ON(i) (((PHMASK >> (i)) & 1) && p.lo <= (i) && (i) < p.hi)
#define PH_SYNC(i) do { if (multi && (i) + 1 < p.hi) { TP_BEGIN(7); xcd_barrier(bar); TP_END(7); } } while (0)
#ifndef REPEAT_MASK
#define REPEAT_MASK 0
#endif
#define PH_REP(i) for (int rep_ = 0; rep_ < 1 + ((REPEAT_MASK >> (i)) & 1); ++rep_)
    if (PH_ON(0)) { const Params q = load_params(); TP_BEGIN(8); PH_REP(0) phase_prologue(q); TP_END(8); PH_SYNC(0); }
    if (PH_ON(1)) { const Params q = load_params(); TP_BEGIN(9); PH_REP(1) { EpiProj e; e.P = (bf16_t*)(q.ws + OFF_BIG); gemm256<false>((const bf16_t*)(q.ws + OFF_HN), (const bf16_t*)(q.ws + OFF_WINT), 1024, MPAD / 256, 4096 / 256, (LAS bf16_t*)smem, e); } TP_END(9); PH_SYNC(1); }
    if (PH_ON(2)) { const Params q = load_params(); TP_BEGIN(5); phase_rope(q, smem); TP_END(5); PH_SYNC(2); }
    if (PH_ON(3)) { const Params q = load_params(); PH_REP(3) {
#ifndef RS_REP
#define RS_REP 1
#endif
#ifndef DSA_REP
#define DSA_REP 1
#endif
            for (int rr_ = 0; rr_ < RS_REP; ++rr_) phase_ret_state_mfma(q, smem);
            for (int rr_ = 0; rr_ < DSA_REP; ++rr_) { phase_dsa_fast(q, smem); __syncthreads(); }
#ifdef DSA_CHECK
            __syncthreads(); xcd_barrier(bar); phase_dsa_naive<true>(q, smem);
#endif
        } PH_SYNC(3); }
    if (PH_ON(4)) { const Params q = load_params(); TP_BEGIN(6); phase_ret_scan(q); TP_END(6); PH_SYNC(4); }
    if (PH_ON(5)) { const Params q = load_params(); PH_REP(5) phase_ret_out_mfma(q, smem); PH_SYNC(5); }
    if (PH_ON(6)) { const Params q = load_params(); PH_REP(6) { EpiOut e; e.H = q.out; e.X = q.x; gemm256<false>((const bf16_t*)(q.ws + OFF_HN), (const bf16_t*)(q.ws + OFF_WOUTT), 1024, NF / 256, 1024 / 256, (LAS bf16_t*)smem, e); } PH_SYNC(6); }
    if (PH_ON(7)) { const Params q = load_params(); PH_REP(7) phase_norm2(q); PH_SYNC(7); }
    if (PH_ON(8)) { const Params q = load_params(); PH_REP(8) { EpiPQ e; e.Q = (float*)(q.ws + OFF_BIG); gemm256<false>((const bf16_t*)(q.ws + OFF_HN), (const bf16_t*)(q.ws + OFF_WQT), 1024, NF / 256, 2048 / 256, (LAS bf16_t*)smem, e); } PH_SYNC(8); }
    if (PH_ON(9)) { const Params q = load_params(); PH_REP(9) { phase_peer_select(q, smem); phase_convert_tables(q); }
        if (TP_SEC && blockIdx.x == 0 && threadIdx.x == 0) { volatile LAS long long* tp_ = (volatile LAS long long*)(smem + TP_LDS_OFF); const float fr = (float)tp_[2] / (float)((long long)__builtin_readcyclecounter() - tp_[0]); ((float*)(p.ws + OFF_BAR))[3602] = fr; }
        PH_SYNC(9); }
#ifdef P10_OLD
    if (PH_ON(10)) { const Params q = load_params(); phase_peer_out(q); }
#else
    if (PH_ON(10)) { const Params q = load_params(); phase_peer_out_rows(q, smem); }
#endif
}

extern "C" void kernel_launch(void* const* d_in, const int* in_sizes, int n_in, void* d_out, int out_size, void* d_ws, size_t ws_size, hipStream_t stream) {
    static int grid = 0;
    if (grid == 0) {
        if (n_in != 12 || out_size != NF * DM || ws_size < WS_END) { fprintf(stderr, "kernel_launch: unexpected shapes (n_in %d out %d ws %zu need %zu)\n", n_in, out_size, ws_size, (size_t)WS_END); grid = -1; return; }
        int dev = 0, cus = 0, per_cu = 0;
        if (hipGetDevice(&dev) != hipSuccess || hipDeviceGetAttribute(&cus, hipDeviceAttributeMultiprocessorCount, dev) != hipSuccess) { grid = -1; return; }
        if (hipFuncSetAttribute((const void*)mk_forward, hipFuncAttributeMaxDynamicSharedMemorySize, LDS_BYTES) != hipSuccess) { fprintf(stderr, "kernel_launch: hipFuncSetAttribute failed\n"); grid = -1; return; }
        if (hipOccupancyMaxActiveBlocksPerMultiprocessor(&per_cu, (const void*)mk_forward, NTHREADS, LDS_BYTES) != hipSuccess || per_cu < 1)
            fprintf(stderr, "kernel_launch: occupancy query reports %d blocks per CU\n", per_cu);
        (void)hipGetLastError();
        grid = cus > 0 ? cus : 256;
    }
    if (grid < 0) return;
    Params p{};
    p.x = (const float*)d_in[0]; p.meta = (const float*)d_in[1]; p.norm_mix = (const float*)d_in[2]; p.w_in = (const float*)d_in[3];
    p.w_uv = (const float*)d_in[4]; p.w_out = (const float*)d_in[5]; p.norm_ffn = (const float*)d_in[6]; p.wq = (const float*)d_in[7];
    p.sk = (const float*)d_in[8]; p.pu = (const float*)d_in[9]; p.pv = (const float*)d_in[10]; p.norm_final = (const float*)d_in[11];
    p.out = (float*)d_out; p.ws = (char*)d_ws; p.pad0 = 0; p.pad1 = 0;
    (void)hipMemsetAsync((char*)d_ws + OFF_BAR, 0, 16384, stream);
#if MK_LAUNCHES == 1
    p.lo = 0; p.hi = NPHASES + 1;
    hipLaunchKernelGGL(mk_forward, dim3(grid), dim3(NTHREADS), LDS_BYTES, stream, p);
#else
    for (int ph = 0; ph <= NPHASES; ++ph) { p.lo = ph; p.hi = ph + 1; hipLaunchKernelGGL(mk_forward, dim3(grid), dim3(NTHREADS), LDS_BYTES, stream, p); }
#endif
}
```

```cpp
#include <hip/hip_runtime.h>
#include <stdint.h>
#include <stdio.h>

#ifndef MK_LAUNCHES
#define MK_LAUNCHES 1
#endif

#define DI __device__ __forceinline__
#ifndef TP_SEC
#define TP_SEC 0
#endif
#ifndef CHK_GAIN
#define CHK_GAIN 10.f
#endif
#define TP_LDS_OFF (163840 - 128)
#define TP_BEGIN(k) do { if (TP_SEC == (k) && blockIdx.x == 0 && threadIdx.x == 0) { *(volatile __attribute__((address_space(3))) long long*)(tp_smem + TP_LDS_OFF + 8) = (long long)__builtin_readcyclecounter(); } } while (0)
#define TP_END(k) do { if (TP_SEC == (k) && blockIdx.x == 0 && threadIdx.x == 0) { volatile __attribute__((address_space(3))) long long* tp_ = (volatile __attribute__((address_space(3))) long long*)(tp_smem + TP_LDS_OFF); tp_[2] += (long long)__builtin_readcyclecounter() - tp_[1]; } } while (0)
typedef unsigned short bf16_t;
typedef short bf16x8 __attribute__((ext_vector_type(8)));
typedef float f32x4 __attribute__((ext_vector_type(4)));
typedef unsigned u32x4 __attribute__((ext_vector_type(4)));

constexpr int NB = 8, SEQ = 2048, NMETA = 16, TT = 2064, DM = 1024, INW = 3912;
constexpr int MROWS = NB * TT;
constexpr int MPAD = 16640;
constexpr int NF = NB * SEQ;
constexpr int C_RQ = 0, C_RK = 512, C_RV = 1024, C_RG = 1536, C_DQ = 2048, C_DK = 3072, C_DV = 3200, C_IQ = 3328, C_IK = 3840, C_IW = 3904;
constexpr int NTHREADS = 512, NWAVES = 8;
constexpr int LDS_BYTES = 163840;
constexpr int LDS_BAR_OFF = 163840 - 256;

constexpr size_t al256(size_t x) { return (x + 255) & ~(size_t)255; }
constexpr size_t OFF_BAR = 0;
constexpr size_t OFF_COS128 = 16384;
constexpr size_t OFF_SIN128 = OFF_COS128 + al256((size_t)TT * 64 * 4);
constexpr size_t OFF_COS64 = OFF_SIN128 + al256((size_t)TT * 64 * 4);
constexpr size_t OFF_SIN64 = OFF_COS64 + al256((size_t)TT * 32 * 4);
constexpr size_t OFF_WINT = OFF_SIN64 + al256((size_t)TT * 32 * 4);
constexpr size_t OFF_WOUTT = OFF_WINT + (size_t)4096 * 1024 * 2;
constexpr size_t OFF_WQT = OFF_WOUTT + (size_t)1024 * 1024 * 2;
constexpr size_t OFF_SKH = OFF_WQT + (size_t)2048 * 1024 * 2;
constexpr size_t OFF_SKL = OFF_SKH + (size_t)2048 * 128 * 2;
constexpr int TTP = 2112;
constexpr size_t OFF_WUVT = OFF_SKL + (size_t)2048 * 128 * 2;
constexpr size_t OFF_DVT = OFF_WUVT + (size_t)8 * 64 * 128 * 2;
constexpr size_t OFF_HN = OFF_DVT + (size_t)NB * 128 * TTP * 2;
constexpr size_t OFF_BIG = OFF_HN + (size_t)MPAD * 1024 * 2;
constexpr size_t BIG_BYTES = (size_t)NF * 2048 * 4;
constexpr size_t OFF_ST = OFF_BIG + al256(BIG_BYTES);
constexpr size_t ST_BYTES = (size_t)32 * 34 * 16384 * 4;
constexpr size_t WS_END = OFF_ST + ST_BYTES;
constexpr size_t OFF_EIDX = OFF_ST, OFF_GATE = OFF_ST + (size_t)NF * 128 * 4;
constexpr size_t OFF_U16 = OFF_ST + (size_t)NF * 128 * 8;
constexpr size_t OFF_V16 = OFF_HN;
static_assert(OFF_U16 + (size_t)16384 * 1024 * 2 <= WS_END, "u16");
constexpr size_t OFF_U8 = OFF_U16;
constexpr size_t OFF_SU = OFF_U8 + (size_t)16384 * 1024;
constexpr size_t OFF_V8 = OFF_SU + 65536;
constexpr size_t OFF_SV = OFF_V8 + (size_t)16384 * 1024;
static_assert(OFF_SV + 65536 <= WS_END, "peer tables");
static_assert(BIG_BYTES >= (size_t)MPAD * INW * 2, "big region");
static_assert(WS_END <= (size_t)268435456, "workspace");

struct Params {
    const float *x, *meta, *norm_mix, *w_in, *w_uv, *w_out, *norm_ffn, *wq, *sk, *pu, *pv, *norm_final;
    float* out; char* ws; int lo, hi, pad0, pad1;
};

DI float bf2f(bf16_t v) { return __uint_as_float(((unsigned)v) << 16); }
typedef float f32x2_t __attribute__((ext_vector_type(2)));
typedef __bf16 bf16x2_t __attribute__((ext_vector_type(2)));
DI bf16_t f2bf(float f) { const __bf16 h = (__bf16)f; return __builtin_bit_cast(unsigned short, h); }
DI unsigned pk2bf(float a, float b) { const f32x2_t v = {a, b}; const bf16x2_t h = __builtin_convertvector(v, bf16x2_t); return __builtin_bit_cast(unsigned, h); }
DI float wave_sum(float v) {
#pragma unroll
    for (int o = 32; o > 0; o >>= 1) v += __shfl_xor(v, o);
    return v;
}
DI float wave_max(float v) {
#pragma unroll
    for (int o = 32; o > 0; o >>= 1) v = fmaxf(v, __shfl_xor(v, o));
    return v;
}
DI unsigned long long wave_max_u64(unsigned long long v) {
#pragma unroll
    for (int o = 32; o > 0; o >>= 1) {
        const unsigned hi = __shfl_xor((unsigned)(v >> 32), o), lo = __shfl_xor((unsigned)v, o);
        const unsigned long long w = ((unsigned long long)hi << 32) | lo;
        v = w > v ? w : v;
    }
    return v;
}
DI unsigned fkey(float x) { const unsigned u = __float_as_uint(x); return (u & 0x80000000u) ? ~u : (u | 0x80000000u); }
DI float funkey(unsigned k) { const unsigned u = (k & 0x80000000u) ? (k & 0x7fffffffu) : ~k; return __uint_as_float(u); }
DI void lds_fence() { asm volatile("s_waitcnt lgkmcnt(0)" ::: "memory"); }
DI void unpack8(const u32x4& r, float (&v)[8]) {
    v[0] = __uint_as_float(r.x << 16); v[1] = __uint_as_float(r.x & 0xffff0000u);
    v[2] = __uint_as_float(r.y << 16); v[3] = __uint_as_float(r.y & 0xffff0000u);
    v[4] = __uint_as_float(r.z << 16); v[5] = __uint_as_float(r.z & 0xffff0000u);
    v[6] = __uint_as_float(r.w << 16); v[7] = __uint_as_float(r.w & 0xffff0000u);
}

typedef float f32x16 __attribute__((ext_vector_type(16)));
DI bf16x8 pack8(const float (&x)[8]) {
    u32x4 r;
#pragma unroll
    for (int j = 0; j < 4; ++j) r[j] = pk2bf(x[2 * j], x[2 * j + 1]);
    return __builtin_bit_cast(bf16x8, r);
}
DI bf16x8 pack_hi8(const float (&x)[8], float (&rem)[8]) {
    u32x4 r;
#pragma unroll
    for (int j = 0; j < 4; ++j) { r[j] = pk2bf(x[2 * j], x[2 * j + 1]); rem[2 * j] = x[2 * j] - __uint_as_float(r[j] << 16); rem[2 * j + 1] = x[2 * j + 1] - __uint_as_float(r[j] & 0xffff0000u); }
    return __builtin_bit_cast(bf16x8, r);
}

DI float dpp_row_sum(float v) {
    v += __int_as_float(__builtin_amdgcn_update_dpp(0, __float_as_int(v), 0xB1, 0xF, 0xF, true));
    v += __int_as_float(__builtin_amdgcn_update_dpp(0, __float_as_int(v), 0x4E, 0xF, 0xF, true));
    v += __int_as_float(__builtin_amdgcn_update_dpp(0, __float_as_int(v), 0x141, 0xF, 0xF, true));
    v += __int_as_float(__builtin_amdgcn_update_dpp(0, __float_as_int(v), 0x140, 0xF, 0xF, true));
    return v;
}
DI float wave_sum_uniform(float v) {
    v = dpp_row_sum(v);
    const float a = __int_as_float(__builtin_amdgcn_readlane(__float_as_int(v), 0)), b = __int_as_float(__builtin_amdgcn_readlane(__float_as_int(v), 16));
    const float c = __int_as_float(__builtin_amdgcn_readlane(__float_as_int(v), 32)), d = __int_as_float(__builtin_amdgcn_readlane(__float_as_int(v), 48));
    return (a + b) + (c + d);
}

DI int wave_sum_int(int v) {
    v += __builtin_amdgcn_update_dpp(0, v, 0xB1, 0xF, 0xF, true);
    v += __builtin_amdgcn_update_dpp(0, v, 0x4E, 0xF, 0xF, true);
    v += __builtin_amdgcn_update_dpp(0, v, 0x141, 0xF, 0xF, true);
    v += __builtin_amdgcn_update_dpp(0, v, 0x140, 0xF, 0xF, true);
    return (__builtin_amdgcn_readlane(v, 0) + __builtin_amdgcn_readlane(v, 16)) + (__builtin_amdgcn_readlane(v, 32) + __builtin_amdgcn_readlane(v, 48));
}

#define XB_TMO      128
#define XB_XCNT(j)  (256  + 64 * (j))
#define XB_XSUB(j)  (1280 + 64 * (j))
#define XB_XGEN(j)  (2304 + 64 * (j))
#define XB_TOP      3328
#define XB_TOPGEN   3392
#define XCD_BAR_WORDS 3456
#define XB_SPIN_CAP (1u << 20)
#define LAS __attribute__((address_space(3)))

DI unsigned xb_ld(unsigned* p)              { return __hip_atomic_load(p, __ATOMIC_RELAXED, __HIP_MEMORY_SCOPE_AGENT); }
DI unsigned xb_add(unsigned* p, unsigned v) { return __hip_atomic_fetch_add(p, v, __ATOMIC_RELAXED, __HIP_MEMORY_SCOPE_AGENT); }
DI unsigned xb_xcc_id() { return (unsigned)__builtin_amdgcn_s_getreg((3 << 11) | 20) & 0xFu; }
#define XB_SPIN(cond, bar) do { unsigned _sp = 0; while (cond) { __builtin_amdgcn_s_sleep(1); \
    if ((++_sp & 255u) == 0u) { if (xb_ld(&(bar)[XB_TMO])) break; if (_sp > XB_SPIN_CAP) { atomicAdd(&(bar)[XB_TMO], 1u); break; } } } } while (0)

struct XcdBarrier { unsigned* bar; unsigned x; volatile LAS unsigned* st; };

DI XcdBarrier xcd_barrier_post(unsigned* bar, volatile LAS unsigned* st) {
    XcdBarrier b; b.bar = bar; b.x = xb_xcc_id(); b.st = st;
    if (threadIdx.x == 0) (void)xb_add(&bar[XB_XCNT(b.x)], 1u);
    return b;
}
DI void xcd_barrier_complete(unsigned* bar, unsigned x, unsigned& nloc, unsigned& nx) {
    const unsigned G = gridDim.x * gridDim.y * gridDim.z;
    unsigned sum, cnt, mine, sp = 0u;
    for (;;) {
        sum = 0u; cnt = 0u; mine = 0u;
#pragma unroll
        for (unsigned j = 0; j < 16; ++j) { const unsigned c = xb_ld(&bar[XB_XCNT(j)]); sum += c; cnt += (c > 0u) ? 1u : 0u; mine = (j == x) ? c : mine; }
        if (sum == G) break;
        __builtin_amdgcn_s_sleep(1);
        if ((++sp & 255u) == 0u) { if (xb_ld(&bar[XB_TMO])) break; if (sp > XB_SPIN_CAP) { atomicAdd(&bar[XB_TMO], 1u); break; } }
    }
    nloc = mine > 0u ? mine : 1u; nx = cnt > 0u ? cnt : 1u;
}
DI void xcd_barrier(const XcdBarrier& b) {
    asm volatile("s_waitcnt vmcnt(0)" ::: "memory");
    __syncthreads();
    if (threadIdx.x == 0) {
        unsigned* bar = b.bar;
        __builtin_amdgcn_s_waitcnt(0);
        unsigned nloc = b.st[0], nx = b.st[1];
        if (nloc == 0u) { xcd_barrier_complete(bar, b.x, nloc, nx); b.st[0] = nloc; b.st[1] = nx; }
        const unsigned old = xb_add(&bar[XB_XSUB(b.x)], 1u);
        const unsigned gen = old / nloc;
        if (old + 1u == (gen + 1u) * nloc) {
            __builtin_amdgcn_fence(__ATOMIC_RELEASE, "agent");
            asm volatile("s_waitcnt vmcnt(0)" ::: "memory");
            const unsigned og = xb_add(&bar[XB_TOP], 1u);
            const unsigned tg = og / nx;
            if (og + 1u == (tg + 1u) * nx) xb_add(&bar[XB_TOPGEN], 1u);
            else XB_SPIN(xb_ld(&bar[XB_TOPGEN]) == tg, bar);
            __builtin_amdgcn_fence(__ATOMIC_ACQUIRE, "agent");
            xb_add(&bar[XB_XGEN(b.x)], 1u);
            asm volatile("s_waitcnt vmcnt(0)" ::: "memory");
        } else {
            XB_SPIN(xb_ld(&bar[XB_XGEN(b.x)]) == gen, bar);
            __builtin_amdgcn_fence(__ATOMIC_ACQUIRE, "agent");
            asm volatile("s_waitcnt vmcnt(0)" ::: "memory");
        }
    }
    __syncthreads();
}

constexpr int BM = 256, BK = 64, HALF = 128, NXCD = 8, WGM = 8, HT = HALF * BK;
DI int lds_byte(int r, int c) {
    int st = (r >> 4) * 2 + (c >> 5), rr = r & 15, cc = c & 31, ob = rr * 64 + cc * 2;
    return st * 1024 + (ob ^ (((ob >> 9) & 1) << 5));
}
DI void stage_rc(int b, int& R, int& C) {
    int st = b / 1024, sb = b % 1024, swz = sb ^ (((sb >> 9) & 1) << 5);
    R = (st >> 1) * 16 + swz / 64; C = (st & 1) * 32 + (swz % 64) / 2;
}

#define SA(b,h) (shm+((b)*2+(h))*HT)
#define SB(b,h) (shm+(4+(b)*2+(h))*HT)
#define STAGE_X(T,P,BASE,br,kt) do{long _g=(long)(br)*K+(long)(kt)*BK; \
    for(int _i=0;_i<2;++_i){int _b=(T)*16+_i*8192;int _r,_c;stage_rc(_b,_r,_c); \
      __builtin_amdgcn_global_load_lds((const unsigned*)(BASE+_g+(long)_r*K+_c), \
        (LAS unsigned*)((LAS char*)(P)+_b),16,0,0);}}while(0)
#define STAGE(P,BASE,br,kt) STAGE_X(threadIdx.x,P,BASE,br,kt)
#define LDA(dst,b,h) for(int m=0;m<4;++m)for(int k=0;k<2;++k) \
    dst[m][k]=*reinterpret_cast<const LAS bf16x8*>((LAS char*)SA(b,h)+lds_byte(wr*64+m*16+fr,k*32+fq*8))
#define LDB(dst,b,h) for(int n=0;n<2;++n)for(int k=0;k<2;++k) \
    dst[n][k]=*reinterpret_cast<const LAS bf16x8*>((LAS char*)SB(b,h)+lds_byte(wc*32+n*16+fr,k*32+fq*8))
#define MMA(ai,bj,At,Bt_) do{__builtin_amdgcn_s_setprio(1); \
    for(int m=0;m<4;++m)for(int n=0;n<2;++n)for(int k=0;k<2;++k) \
      acc[ai][bj][m][n]=TRANS?__builtin_amdgcn_mfma_f32_16x16x32_bf16(Bt_[n][k],At[m][k],acc[ai][bj][m][n],0,0,0):__builtin_amdgcn_mfma_f32_16x16x32_bf16(At[m][k],Bt_[n][k],acc[ai][bj][m][n],0,0,0); \
    __builtin_amdgcn_s_setprio(0);}while(0)
#define WAIT_V(n) asm volatile("s_waitcnt vmcnt(" #n ")":::"memory")
#define WAIT_L(n) asm volatile("s_waitcnt lgkmcnt(" #n ")":::"memory")
#define BAR __builtin_amdgcn_s_barrier()
#define SCHED __builtin_amdgcn_sched_barrier(0)

template <bool TRANS, class Epi>
DI void gemm256(const bf16_t* __restrict__ A, const bf16_t* __restrict__ Bt, const int K, const int nM, const int nN, LAS bf16_t* shm, const Epi& epi) {
    const int nwg = nM * nN;
    for (int L = blockIdx.x; L < nwg; L += gridDim.x) {
        int wgid = L;
        { int q = nwg / NXCD, r = nwg % NXCD, xcd = wgid % NXCD, off = wgid / NXCD; wgid = (xcd < r ? xcd * (q + 1) : r * (q + 1) + (xcd - r) * q) + off; }
        int nig = WGM * nN, gid = wgid / nig, fm = gid * WGM, gsz = min(nM - fm, WGM);
        int pm = fm + ((wgid % nig) % gsz), pn = (wgid % nig) / gsz, brow = pm * BM, bcol = pn * BM;
        int wid = threadIdx.x >> 6, lane = threadIdx.x & 63, wr = wid >> 2, wc = wid & 3, fr = lane & 15, fq = lane >> 4;
        f32x4 acc[2][2][4][2] = {};
        bf16x8 At[4][2], B0[2][2], B1[2][2];
        int nt = K / BK;
        STAGE(SB(0,0),Bt,bcol,0); STAGE(SA(0,0),A,brow,0);
        STAGE(SB(0,1),Bt,bcol+HALF,0); STAGE(SA(0,1),A,brow+HALF,0);
        if (wr == 1) BAR;
        WAIT_V(4); BAR;
        STAGE(SB(1,0),Bt,bcol,1); STAGE(SA(1,0),A,brow,1); STAGE(SB(1,1),Bt,bcol+HALF,1);
        WAIT_V(6); BAR;
        for (int t = 0; t < nt - 2; t += 2) {
            LDB(B0,0,0); SCHED; LDA(At,0,0); STAGE(SA(1,1),A,brow+HALF,t+1);
            WAIT_L(8); BAR; WAIT_L(0); MMA(0,0,At,B0); BAR; SCHED;
            LDB(B1,0,1); STAGE(SB(0,0),Bt,bcol,t+2);
            BAR; WAIT_L(0); MMA(0,1,At,B1); BAR;
            LDA(At,0,1); STAGE(SA(0,0),A,brow,t+2);
            BAR; WAIT_L(0); MMA(1,0,At,B0); BAR; SCHED;
            STAGE(SB(0,1),Bt,bcol+HALF,t+2);
            WAIT_V(6); BAR; MMA(1,1,At,B1); BAR;
            LDB(B0,1,0); SCHED; LDA(At,1,0); STAGE(SA(0,1),A,brow+HALF,t+2);
            WAIT_L(8); BAR; WAIT_L(0); MMA(0,0,At,B0); BAR; SCHED;
            LDB(B1,1,1); STAGE(SB(1,0),Bt,bcol,t+3);
            BAR; WAIT_L(0); MMA(0,1,At,B1); BAR;
            LDA(At,1,1); STAGE(SA(1,0),A,brow,t+3);
            BAR; WAIT_L(0); MMA(1,0,At,B0); BAR; SCHED;
            STAGE(SB(1,1),Bt,bcol+HALF,t+3);
            WAIT_V(6); BAR; MMA(1,1,At,B1); BAR;
        }
        int tz = threadIdx.x; asm volatile("" : "+v"(tz)); wid = tz >> 6; lane = tz & 63; wr = wid >> 2; wc = wid & 3; fr = lane & 15; fq = lane >> 4;
        { LDB(B0,0,0); WAIT_V(0); LDA(At,0,0); STAGE_X(tz,SA(1,1),A,brow+HALF,nt-1);
          BAR; WAIT_L(0); MMA(0,0,At,B0); BAR;
          LDB(B1,0,1); BAR; WAIT_L(0); MMA(0,1,At,B1); BAR;
          LDA(At,0,1); WAIT_V(4); BAR; WAIT_L(0); MMA(1,0,At,B0); MMA(1,1,At,B1); BAR; }
        { LDB(B0,1,0); LDA(At,1,0); WAIT_V(2); BAR; WAIT_L(0); MMA(0,0,At,B0); BAR;
          LDB(B1,1,1); WAIT_V(0); BAR; WAIT_L(0); MMA(0,1,At,B1); BAR;
          LDA(At,1,1); BAR; WAIT_L(0); MMA(1,0,At,B0); MMA(1,1,At,B1); BAR; }
        if (wr == 0) BAR;
        epi(acc, brow, bcol, wr, wc, fr, fq);
        __syncthreads();
    }
}

struct EpiProj {
    bf16_t* P;
    DI void operator()(const f32x4 (&acc)[2][2][4][2], int brow, int bcol, int wr, int wc, int fr, int fq) const {
#pragma unroll
        for (int ai = 0; ai < 2; ++ai)
#pragma unroll
        for (int bj = 0; bj < 2; ++bj)
#pragma unroll
        for (int m = 0; m < 4; ++m)
#pragma unroll
        for (int n = 0; n < 2; ++n)
#pragma unroll
        for (int j = 0; j < 4; ++j) {
            const int row = brow + ai * HALF + wr * 64 + m * 16 + fq * 4 + j, col = bcol + bj * HALF + wc * 32 + n * 16 + fr;
            if (col < INW) P[(size_t)row * INW + col] = f2bf(acc[ai][bj][m][n][j]);
        }
    }
};
struct EpiOut {
    float* H; const float* X;
    DI void operator()(const f32x4 (&acc)[2][2][4][2], int brow, int bcol, int wr, int wc, int fr, int fq) const {
#pragma unroll
        for (int ai = 0; ai < 2; ++ai)
#pragma unroll
        for (int bj = 0; bj < 2; ++bj)
#pragma unroll
        for (int m = 0; m < 4; ++m)
#pragma unroll
        for (int n = 0; n < 2; ++n)
#pragma unroll
        for (int j = 0; j < 4; ++j) {
            const int row = brow + ai * HALF + wr * 64 + m * 16 + fq * 4 + j, col = bcol + bj * HALF + wc * 32 + n * 16 + fr;
            const size_t o = (size_t)row * DM + col; H[o] = X[o] + acc[ai][bj][m][n][j];
        }
    }
};
struct EpiPQ {
    float* Q;
    DI void operator()(const f32x4 (&acc)[2][2][4][2], int brow, int bcol, int wr, int wc, int fr, int fq) const {
#pragma unroll
        for (int ai = 0; ai < 2; ++ai)
#pragma unroll
        for (int bj = 0; bj < 2; ++bj)
#pragma unroll
        for (int m = 0; m < 4; ++m)
#pragma unroll
        for (int n = 0; n < 2; ++n)
#pragma unroll
        for (int j = 0; j < 4; ++j) {
            const int row = brow + ai * HALF + wr * 64 + m * 16 + fq * 4 + j, col = bcol + bj * HALF + wc * 32 + n * 16 + fr;
            Q[(size_t)row * 2048 + col] = acc[ai][bj][m][n][j];
        }
    }
};

struct EpiProjT {
    bf16_t* P;
    DI void operator()(const f32x4 (&acc)[2][2][4][2], int brow, int bcol, int wr, int wc, int fr, int fq) const {
        const int col0 = bcol + wc * 32 + fq * 4;
#pragma unroll
        for (int ai = 0; ai < 2; ++ai)
#pragma unroll
        for (int m = 0; m < 4; ++m) {
            bf16_t* rp = P + (size_t)(brow + ai * HALF + wr * 64 + m * 16 + fr) * INW + col0;
#pragma unroll
            for (int bj = 0; bj < 2; ++bj)
#pragma unroll
            for (int n = 0; n < 2; ++n)
                if (col0 + bj * HALF + n * 16 < INW) { uint2 w; w.x = pk2bf(acc[ai][bj][m][n][0], acc[ai][bj][m][n][1]); w.y = pk2bf(acc[ai][bj][m][n][2], acc[ai][bj][m][n][3]); *(uint2*)(rp + bj * HALF + n * 16) = w; }
        }
    }
};
struct EpiOutT {
    float* H; const float* X;
    DI void operator()(const f32x4 (&acc)[2][2][4][2], int brow, int bcol, int wr, int wc, int fr, int fq) const {
#pragma unroll
        for (int ai = 0; ai < 2; ++ai)
#pragma unroll
        for (int m = 0; m < 4; ++m) {
            const size_t o = (size_t)(brow + ai * HALF + wr * 64 + m * 16 + fr) * DM + bcol + wc * 32 + fq * 4;
            const float* xp = X + o; float* hp = H + o;
#pragma unroll
            for (int bj = 0; bj < 2; ++bj)
#pragma unroll
            for (int n = 0; n < 2; ++n) { const f32x4 x = *(const f32x4*)(xp + bj * HALF + n * 16); *(f32x4*)(hp + bj * HALF + n * 16) = x + acc[ai][bj][m][n]; }
            __builtin_amdgcn_sched_barrier(0);
        }
    }
};

__host__ __device__ constexpr int proj_true_col(int n) {
    const int blk = n >> 7, P = n & 127, wc = P >> 5, nn = (P >> 4) & 1, i = P & 15;
    return blk * 128 + (blk < 26 ? wc * 16 + i + 64 * nn : (wc >> 1) * 64 + (wc & 1) * 16 + i + 32 * nn);
}
struct EpiProjRope {
    bf16_t* P; bf16_t* DVTp; const float *c128, *s128, *c64, *s64; int raw, row_limit;
    DI void operator()(const f32x4 (&acc)[2][2][4][2], int brow, int bcol, int wr, int wc, int fr, int fq) const {
#pragma unroll
        for (int ai = 0; ai < 2; ++ai)
#pragma unroll
        for (int m = 0; m < 4; ++m) {
            const int row = brow + ai * HALF + wr * 64 + m * 16 + fr;
            if (row >= row_limit) continue;
            const int b = row / TT, t = row - b * TT;
            bf16_t* rp = P + (size_t)row * INW;
#pragma unroll
            for (int bj = 0; bj < 2; ++bj) {
                const int cb = bcol + bj * HALF;
                const f32x4 x1 = acc[ai][bj][m][0], x2 = acc[ai][bj][m][1];
                f32x4 o1 = x1, o2 = x2; int c1, c2; bool st2 = true;
                if (cb < C_IQ) {
                    const int f = wc * 16 + fq * 4; c1 = cb + f; c2 = c1 + 64;
                    const bool roped = (cb < C_RV) || (cb >= C_DQ && cb < C_DV);
                    if (roped && !raw) {
                        const float sc = (cb < C_RK) ? 1.f : (cb < C_RV) ? 0.08838834764831845f : (cb < C_DK) ? 0.08838834764831845f * 1.4426950408889634f : 1.f;
                        const f32x4 cs = *(const f32x4*)(c128 + t * 64 + f), sn = *(const f32x4*)(s128 + t * 64 + f);
                        o1 = (x1 * cs - x2 * sn) * sc; o2 = (x2 * cs + x1 * sn) * sc;
                    }
                    if (cb == C_DV && row < MROWS && !raw) {
                        bf16_t* dp = DVTp + (size_t)(b * 128 + f) * TTP + t;
#pragma unroll
                        for (int j = 0; j < 4; ++j) { dp[(size_t)j * TTP] = f2bf(x1[j]); dp[(size_t)(64 + j) * TTP] = f2bf(x2[j]); }
                    }
                } else if (cb < 3968) {
                    const int hl = wc >> 1, f = (wc & 1) * 16 + fq * 4; c1 = cb + hl * 64 + f; c2 = c1 + 32;
                    if (raw) { if (hl == 1 && cb >= C_IK) { st2 = false; if (c1 >= INW) continue; } }
                    else if (cb < C_IK || hl == 0) {
                        const float sc = (cb < C_IK) ? 0.125f : 1.f;
                        const f32x4 cs = *(const f32x4*)(c64 + t * 32 + f), sn = *(const f32x4*)(s64 + t * 32 + f);
                        o1 = (x1 * cs - x2 * sn) * sc; o2 = (x2 * cs + x1 * sn) * sc;
                    } else { o1 = x1 * 0.35355339059327373f; st2 = false; if (c1 >= INW) continue; }
                } else continue;
                uint2 w1; w1.x = pk2bf(o1[0], o1[1]); w1.y = pk2bf(o1[2], o1[3]); *(uint2*)(rp + c1) = w1;
                if (st2) { uint2 w2; w2.x = pk2bf(o2[0], o2[1]); w2.y = pk2bf(o2[2], o2[3]); *(uint2*)(rp + c2) = w2; }
            }
        }
    }
};

DI void phase_prologue(const Params& p) {
    const int gtid = blockIdx.x * NTHREADS + threadIdx.x, gsz = gridDim.x * NTHREADS;
    bf16_t* wint = (bf16_t*)(p.ws + OFF_WINT);
    for (int idx = gtid; idx < 4096 * 1024; idx += gsz) {
        const int k = idx >> 12, n = idx & 4095;
        const int src = proj_true_col(n);
        const float v = src < INW ? p.w_in[(size_t)k * INW + src] : 0.f;
        wint[(size_t)n * 1024 + k] = f2bf(v);
    }
    {
        bf16_t* dvt = (bf16_t*)(p.ws + OFF_DVT);
        for (int idx = gtid; idx < NB * 128 * (TTP - TT); idx += gsz) { const int rw = idx / (TTP - TT), t = TT + idx % (TTP - TT); dvt[(size_t)rw * TTP + t] = (bf16_t)0; }
    }
    bf16_t* woutt = (bf16_t*)(p.ws + OFF_WOUTT);
    for (int idx = gtid; idx < 1024 * 1024; idx += gsz) {
        const int k = idx >> 10, n = idx & 1023;
        woutt[(size_t)n * 1024 + k] = f2bf(p.w_out[(size_t)k * 1024 + n]);
    }
    {
        bf16_t* wst = (bf16_t*)(p.ws + OFF_WQT);
        const int wave_ = threadIdx.x >> 6, lane_ = threadIdx.x & 63, r = lane_ & 31, hh = lane_ >> 5;
        for (int task = blockIdx.x * NWAVES + wave_; task < 16 * 32; task += gridDim.x * NWAVES) {
            const int hf = task >> 5, k0 = (task & 31) * 32;
            f32x16 acc[4];
#pragma unroll
            for (int nb = 0; nb < 4; ++nb)
#pragma unroll
                for (int i = 0; i < 16; ++i) acc[nb][i] = 0.f;
            const float* arow = p.wq + (size_t)(k0 + r) * 2048 + hf * 128 + 8 * hh;
            const float* brow = p.sk + (size_t)(hf * 128 + r) * 128 + 8 * hh;
#pragma unroll 1
            for (int ks = 0; ks < 8; ++ks) {
                const float4 a0 = *(const float4*)(arow + ks * 16), a1 = *(const float4*)(arow + ks * 16 + 4);
                const float af[8] = {a0.x, a0.y, a0.z, a0.w, a1.x, a1.y, a1.z, a1.w}; float ar[8];
                const bf16x8 ah = pack_hi8(af, ar); const bf16x8 al = pack8(ar);
#pragma unroll
                for (int nb = 0; nb < 4; ++nb) {
                    const float4 b0 = *(const float4*)(brow + (size_t)nb * 32 * 128 + ks * 16), b1 = *(const float4*)(brow + (size_t)nb * 32 * 128 + ks * 16 + 4);
                    const float bf_[8] = {b0.x, b0.y, b0.z, b0.w, b1.x, b1.y, b1.z, b1.w}; float br[8];
                    const bf16x8 bh = pack_hi8(bf_, br); const bf16x8 bl = pack8(br);
                    acc[nb] = __builtin_amdgcn_mfma_f32_32x32x16_bf16(ah, bh, acc[nb], 0, 0, 0);
                    acc[nb] = __builtin_amdgcn_mfma_f32_32x32x16_bf16(ah, bl, acc[nb], 0, 0, 0);
                    acc[nb] = __builtin_amdgcn_mfma_f32_32x32x16_bf16(al, bh, acc[nb], 0, 0, 0);
                }
            }
#pragma unroll
            for (int nb = 0; nb < 4; ++nb) {
                bf16_t* orow = wst + (size_t)(hf * 128 + nb * 32 + r) * 1024 + k0 + 4 * hh;
#pragma unroll
                for (int g4 = 0; g4 < 4; ++g4) { uint2 w; w.x = pk2bf(acc[nb][4 * g4], acc[nb][4 * g4 + 1]); w.y = pk2bf(acc[nb][4 * g4 + 2], acc[nb][4 * g4 + 3]); *(uint2*)(orow + 8 * g4) = w; }
            }
        }
    }
    bf16_t* wuvt = (bf16_t*)(p.ws + OFF_WUVT);
    for (int idx = gtid; idx < 8 * 64 * 128; idx += gsz) {
        const int h = idx >> 13, e = (idx >> 7) & 63, dv = idx & 127;
        wuvt[idx] = f2bf(p.w_uv[(size_t)(h * 128 + dv) * 64 + e]);
    }
    float* c128 = (float*)(p.ws + OFF_COS128); float* s128 = (float*)(p.ws + OFF_SIN128);
    for (int idx = gtid; idx < TT * 64; idx += gsz) {
        const int pos = idx >> 6, j = idx & 63;
        const float inv = powf(10000.f, -(float)j * 2.0f / 128.f);
        const float ang = (float)pos * inv;
        float s, c; sincosf(ang, &s, &c);
        c128[idx] = c; s128[idx] = s;
    }
    float* c64 = (float*)(p.ws + OFF_COS64); float* s64 = (float*)(p.ws + OFF_SIN64);
    for (int idx = gtid; idx < TT * 32; idx += gsz) {
        const int pos = idx >> 5, j = idx & 31;
        const float inv = powf(10000.f, -(float)j * 2.0f / 64.f);
        const float ang = (float)pos * inv;
        float s, c; sincosf(ang, &s, &c);
        c64[idx] = c; s64[idx] = s;
    }
    bf16_t* hn = (bf16_t*)(p.ws + OFF_HN);
    const int wave = threadIdx.x >> 6, lane = threadIdx.x & 63;
    for (int row = blockIdx.x * NWAVES + wave; row < MPAD; row += gridDim.x * NWAVES) {
        bf16_t* o = hn + (size_t)row * DM;
        if (row >= MROWS) {
            for (int i = 0; i < 4; ++i) *(uint2*)(o + i * 256 + lane * 4) = make_uint2(0u, 0u);
            continue;
        }
        const int b = row / TT, t = row % TT;
        const float* src = t < NMETA ? p.meta + (size_t)t * DM : p.x + ((size_t)b * SEQ + (t - NMETA)) * DM;
        float4 v[4]; float ss = 0.f;
#pragma unroll
        for (int i = 0; i < 4; ++i) { v[i] = *(const float4*)(src + i * 256 + lane * 4); ss += v[i].x * v[i].x + v[i].y * v[i].y + v[i].z * v[i].z + v[i].w * v[i].w; }
        ss = wave_sum(ss);
        const float rstd = rsqrtf(ss * (1.f / DM) + 1e-6f);
#pragma unroll
        for (int i = 0; i < 4; ++i) {
            const float4 g = *(const float4*)(p.norm_mix + i * 256 + lane * 4);
            uint2 w;
            w.x = (unsigned)f2bf(v[i].x * rstd * g.x) | ((unsigned)f2bf(v[i].y * rstd * g.y) << 16);
            w.y = (unsigned)f2bf(v[i].z * rstd * g.z) | ((unsigned)f2bf(v[i].w * rstd * g.w) << 16);
            *(uint2*)(o + i * 256 + lane * 4) = w;
        }
    }
}

DI void rope8(bf16_t* p1, bf16_t* p2, const float* ct, const float* st, float scale) {
    const u32x4 r1 = *(const u32x4*)p1, r2 = *(const u32x4*)p2;
    float x1[8], x2[8]; unpack8(r1, x1); unpack8(r2, x2);
    const float4 c0 = *(const float4*)ct, c1 = *(const float4*)(ct + 4), s0 = *(const float4*)st, s1 = *(const float4*)(st + 4);
    const float cs[8] = {c0.x, c0.y, c0.z, c0.w, c1.x, c1.y, c1.z, c1.w}, sn[8] = {s0.x, s0.y, s0.z, s0.w, s1.x, s1.y, s1.z, s1.w};
    u32x4 o1, o2;
#pragma unroll
    for (int i = 0; i < 4; ++i) {
        const float a0 = (x1[2 * i] * cs[2 * i] - x2[2 * i] * sn[2 * i]) * scale, a1 = (x1[2 * i + 1] * cs[2 * i + 1] - x2[2 * i + 1] * sn[2 * i + 1]) * scale;
        const float b0 = (x2[2 * i] * cs[2 * i] + x1[2 * i] * sn[2 * i]) * scale, b1 = (x2[2 * i + 1] * cs[2 * i + 1] + x1[2 * i + 1] * sn[2 * i + 1]) * scale;
        o1[i] = (unsigned)f2bf(a0) | ((unsigned)f2bf(a1) << 16); o2[i] = (unsigned)f2bf(b0) | ((unsigned)f2bf(b1) << 16);
    }
    *(u32x4*)p1 = o1; *(u32x4*)p2 = o2;
}
DI void phase_rope(const Params& p, LAS char* smem, bf16_t* proj, const int nrows, const bool do_dvt) {
    const float* c128 = (const float*)(p.ws + OFF_COS128); const float* s128 = (const float*)(p.ws + OFF_SIN128);
    const float* c64 = (const float*)(p.ws + OFF_COS64); const float* s64 = (const float*)(p.ws + OFF_SIN64);
    const int gtid = blockIdx.x * NTHREADS + threadIdx.x, gsz = gridDim.x * NTHREADS;
    const int total = nrows * 173;
    for (int idx = gtid; idx < total; idx += gsz) {
        const int row = idx / 173, it = idx - row * 173;
        const int t = row % TT;
        bf16_t* pr = proj + (size_t)row * INW;
        if (it < 32)       { const int hd = it >> 3, j = (it & 7) * 8;          rope8(pr + C_RQ + hd * 128 + j, pr + C_RQ + hd * 128 + 64 + j, c128 + t * 64 + j, s128 + t * 64 + j, 1.f); }
        else if (it < 64)  { const int i2 = it - 32, hd = i2 >> 3, j = (i2 & 7) * 8;  rope8(pr + C_RK + hd * 128 + j, pr + C_RK + hd * 128 + 64 + j, c128 + t * 64 + j, s128 + t * 64 + j, 0.08838834764831845f); }
        else if (it < 128) { const int i2 = it - 64, hd = i2 >> 3, j = (i2 & 7) * 8;  rope8(pr + C_DQ + hd * 128 + j, pr + C_DQ + hd * 128 + 64 + j, c128 + t * 64 + j, s128 + t * 64 + j, 0.08838834764831845f * 1.4426950408889634f); }
        else if (it < 136) { const int j = (it - 128) * 8;                          rope8(pr + C_DK + j, pr + C_DK + 64 + j, c128 + t * 64 + j, s128 + t * 64 + j, 1.f); }
        else if (it < 168) { const int i2 = it - 136, hd = i2 >> 2, j = (i2 & 3) * 8; rope8(pr + C_IQ + hd * 64 + j, pr + C_IQ + hd * 64 + 32 + j, c64 + t * 32 + j, s64 + t * 32 + j, 0.125f); }
        else if (it < 172) { const int j = (it - 168) * 8;                          rope8(pr + C_IK + j, pr + C_IK + 32 + j, c64 + t * 32 + j, s64 + t * 32 + j, 1.f); }
        else {
            const u32x4 r = *(const u32x4*)(pr + C_IW); float v[8]; unpack8(r, v); u32x4 o;
#pragma unroll
            for (int i = 0; i < 4; ++i) o[i] = (unsigned)f2bf(v[2 * i] * 0.35355339059327373f) | ((unsigned)f2bf(v[2 * i + 1] * 0.35355339059327373f) << 16);
            *(u32x4*)(pr + C_IW) = o;
        }
    }
    if (!do_dvt) return;
    bf16_t* dvt = (bf16_t*)(p.ws + OFF_DVT);
    LAS bf16_t* tile = (LAS bf16_t*)smem;
    for (int unit = blockIdx.x; unit < NB * (TTP / 64); unit += gridDim.x) {
        const int b = unit / (TTP / 64), t0 = (unit % (TTP / 64)) * 64;
        for (int i = threadIdx.x; i < 64 * 16; i += NTHREADS) {
            const int tr = i >> 4, ch = i & 15, t = t0 + tr;
            u32x4 v = {0u, 0u, 0u, 0u};
            if (t < TT) v = *(const u32x4*)(proj + (size_t)(b * TT + t) * INW + C_DV + ch * 8);
            *(LAS u32x4*)(tile + tr * 136 + ch * 8) = v;
        }
        __syncthreads();
        for (int i = threadIdx.x; i < 128 * 8; i += NTHREADS) {
            const int dv = i >> 3, ch = i & 7;
            u32x4 o;
#pragma unroll
            for (int w = 0; w < 4; ++w) o[w] = (unsigned)tile[(ch * 8 + 2 * w) * 136 + dv] | ((unsigned)tile[(ch * 8 + 2 * w + 1) * 136 + dv] << 16);
            *(u32x4*)(dvt + (size_t)(b * 128 + dv) * TTP + t0 + ch * 8) = o;
        }
        __syncthreads();
    }
}

DI void phase_ret_state(const Params& p, LAS char* smem) {
    const bf16_t* proj = (const bf16_t*)(p.ws + OFF_BIG);
    float* ST = (float*)(p.ws + OFF_ST);
    LAS bf16_t* sK = (LAS bf16_t*)smem; LAS bf16_t* sV = sK + 64 * 128;
    for (int unit = blockIdx.x; unit < 1024; unit += gridDim.x) {
        const int c = 1 + (unit & 31), bh = unit >> 5, h = bh & 3, b = bh >> 2;
        for (int i = threadIdx.x; i < 64 * 16; i += NTHREADS) {
            const int j = i >> 4, ch = i & 15; const int t = 64 * c + j - 112;
            u32x4 kv = {0u, 0u, 0u, 0u}, vv = {0u, 0u, 0u, 0u};
            if (t >= 0) { const bf16_t* pr = proj + (size_t)(b * TT + t) * INW; kv = *(const u32x4*)(pr + C_RK + h * 128 + ch * 8); vv = *(const u32x4*)(pr + C_RV + h * 128 + ch * 8); }
            *(LAS u32x4*)(sK + j * 128 + ch * 8) = kv; *(LAS u32x4*)(sV + j * 128 + ch * 8) = vv;
        }
        __syncthreads();
        const float lg = logf(1.f - exp2f(-5.f - (float)h));
        const int e = threadIdx.x >> 2, d0 = (threadIdx.x & 3) * 32;
        float acc[32];
#pragma unroll
        for (int dd = 0; dd < 32; ++dd) acc[dd] = 0.f;
        for (int j = 0; j < 64; ++j) {
            const float z = expf(lg * (float)(63 - j)) * bf2f(sV[j * 128 + e]);
#pragma unroll
            for (int d8 = 0; d8 < 4; ++d8) {
                const u32x4 raw = *(const LAS u32x4*)(sK + j * 128 + d0 + d8 * 8); float kv[8]; unpack8(raw, kv);
#pragma unroll
                for (int x = 0; x < 8; ++x) acc[d8 * 8 + x] += z * kv[x];
            }
        }
        float* st = ST + ((size_t)(bh * 34 + c) * 128 + e) * 128 + d0;
#pragma unroll
        for (int d4 = 0; d4 < 8; ++d4) *(float4*)(st + d4 * 4) = make_float4(acc[d4 * 4], acc[d4 * 4 + 1], acc[d4 * 4 + 2], acc[d4 * 4 + 3]);
        __syncthreads();
    }
}

constexpr int DSA_WAVE_LDS = 2176 * 4 + 1024 * 4 + 256 * 4 + 64;
template <bool CHECK>
DI void phase_dsa_naive(const Params& p, LAS char* smem) {
    const bf16_t* proj = (const bf16_t*)(p.ws + OFF_BIG);
    bf16_t* mixed = (bf16_t*)(p.ws + OFF_HN);
    const int wave = threadIdx.x >> 6, lane = threadIdx.x & 63;
    LAS float* sSc = (LAS float*)(smem + wave * DSA_WAVE_LDS);
    LAS float* sQ = sSc + 2176;
    LAS int* sSel = (LAS int*)(sQ + 1024);
    LAS float* sIw = (LAS float*)(sSel + 256);
    const unsigned long long lt_mask = (1ull << lane) - 1ull;
    float chk_num = 0.f, chk_den = 0.f;
    for (int q = blockIdx.x * NWAVES + wave; q < NF; q += gridDim.x * NWAVES) {
        const int b = q >> 11, s = q & 2047, t = NMETA + s;
        const int nk = 80 + 64 * (s >> 6);
        const bf16_t* prow = proj + (size_t)(b * TT + t) * INW;
        for (int i = lane; i < 512; i += 64) sQ[i] = bf2f(prow[C_IQ + i]);
        if (lane < 8) sIw[lane] = bf2f(prow[C_IW + lane]);
        lds_fence();
        const bf16_t* ikbase = proj + (size_t)(b * TT) * INW + C_IK;
        const int nj = (nk + 63) >> 6;
        for (int jj = 0; jj < nj; ++jj) {
            const int k = jj * 64 + lane;
            float sc = 0.f;
            if (k < nk) {
                const bf16_t* kr = ikbase + (size_t)k * INW;
                float a[8];
#pragma unroll
                for (int h = 0; h < 8; ++h) a[h] = 0.f;
#pragma unroll 1
                for (int d8 = 0; d8 < 8; ++d8) {
                    const u32x4 raw = *(const u32x4*)(kr + d8 * 8); float kv[8]; unpack8(raw, kv);
#pragma unroll
                    for (int h = 0; h < 8; ++h) {
                        const f32x4 q0 = *(const LAS f32x4*)(sQ + h * 64 + d8 * 8), q1 = *(const LAS f32x4*)(sQ + h * 64 + d8 * 8 + 4);
                        a[h] += kv[0] * q0[0] + kv[1] * q0[1] + kv[2] * q0[2] + kv[3] * q0[3] + kv[4] * q1[0] + kv[5] * q1[1] + kv[6] * q1[2] + kv[7] * q1[3];
                    }
                }
#pragma unroll
                for (int h = 0; h < 8; ++h) sc += fmaxf(a[h], 0.f) * sIw[h];
                sc += 0.0f;
            }
            sSc[k] = sc;
        }
        lds_fence();
        int L;
        if (nk <= 256) {
            for (int i = lane; i < nk; i += 64) sSel[i] = i;
            L = nk;
        } else {
            unsigned Tkey = 0u;
            for (int bit = 31; bit >= 0; --bit) {
                const unsigned cand = Tkey | (1u << bit);
                int cnt = 0;
                for (int jj = 0; jj < nj; ++jj) {
                    const int k = jj * 64 + lane;
                    const unsigned key = (k < nk) ? fkey(sSc[k]) : 0u;
                    cnt += __popcll(__ballot(key >= cand));
                }
                if (cnt >= 256) Tkey = cand;
            }
            int cgt = 0;
            for (int jj = 0; jj < nj; ++jj) {
                const int k = jj * 64 + lane;
                const unsigned key = (k < nk) ? fkey(sSc[k]) : 0u;
                cgt += __popcll(__ballot(key > Tkey));
            }
            const int need = 256 - cgt;
            int pos = 0, eqseen = 0;
            for (int jj = 0; jj < nj; ++jj) {
                const int k = jj * 64 + lane;
                const unsigned key = (k < nk) ? fkey(sSc[k]) : 0u;
                const bool gt = key > Tkey, eq = (key == Tkey);
                const unsigned long long eqm = __ballot(eq);
                const int myeq = eqseen + __popcll(eqm & lt_mask);
                const bool sel = gt || (eq && myeq < need);
                const unsigned long long sm = __ballot(sel);
                if (sel) sSel[pos + __popcll(sm & lt_mask)] = k;
                pos += __popcll(sm); eqseen += __popcll(eqm);
            }
            L = 256;
        }
        lds_fence();
        for (int i = lane; i < 1024; i += 64) sQ[i] = bf2f(prow[C_DQ + i]);
        lds_fence();
        float sc[8][4];
        const bf16_t* dkbase = proj + (size_t)(b * TT) * INW + C_DK;
#pragma unroll
        for (int il = 0; il < 4; ++il) {
            const int i = lane + 64 * il; const bool ok = i < L; const int key = ok ? sSel[i] : 0;
            const bf16_t* kr = dkbase + (size_t)key * INW;
            float a[8];
#pragma unroll
            for (int h = 0; h < 8; ++h) a[h] = 0.f;
#pragma unroll 1
            for (int d8 = 0; d8 < 16; ++d8) {
                const u32x4 raw = *(const u32x4*)(kr + d8 * 8); float kv[8]; unpack8(raw, kv);
#pragma unroll
                for (int h = 0; h < 8; ++h) {
                    const f32x4 q0 = *(const LAS f32x4*)(sQ + h * 128 + d8 * 8), q1 = *(const LAS f32x4*)(sQ + h * 128 + d8 * 8 + 4);
                    a[h] += kv[0] * q0[0] + kv[1] * q0[1] + kv[2] * q0[2] + kv[3] * q0[3] + kv[4] * q1[0] + kv[5] * q1[1] + kv[6] * q1[2] + kv[7] * q1[3];
                }
            }
#pragma unroll
            for (int h = 0; h < 8; ++h) sc[h][il] = ok ? a[h] : -INFINITY;
        }
#pragma unroll
        for (int h = 0; h < 8; ++h) {
            float m = fmaxf(fmaxf(sc[h][0], sc[h][1]), fmaxf(sc[h][2], sc[h][3]));
            m = wave_max(m);
            float e[4], sum = 0.f;
#pragma unroll
            for (int il = 0; il < 4; ++il) { e[il] = exp2f(sc[h][il] - m); sum += e[il]; }
            sum = wave_sum(sum);
            const float inv = 1.f / sum;
#pragma unroll
            for (int il = 0; il < 4; ++il) sSc[h * 256 + lane + 64 * il] = e[il] * inv;
        }
        lds_fence();
        float o[8][2];
#pragma unroll
        for (int h = 0; h < 8; ++h) { o[h][0] = 0.f; o[h][1] = 0.f; }
        const bf16_t* dvbase = proj + (size_t)(b * TT) * INW + C_DV;
        for (int i = 0; i < L; ++i) {
            const int key = sSel[i];
            const float v0 = bf2f(dvbase[(size_t)key * INW + lane]), v1 = bf2f(dvbase[(size_t)key * INW + 64 + lane]);
#pragma unroll
            for (int h = 0; h < 8; ++h) { const float pv = sSc[h * 256 + i]; o[h][0] += pv * v0; o[h][1] += pv * v1; }
        }
        lds_fence();
#pragma unroll
        for (int h = 0; h < 8; ++h) { sQ[h * 128 + lane] = o[h][0]; sQ[h * 128 + 64 + lane] = o[h][1]; }
        lds_fence();
        for (int h = 0; h < 8; ++h) {
            float acc = 0.f;
            const float* wu = p.w_uv + (size_t)h * 128 * 64 + lane;
            for (int c = 0; c < 128; ++c) acc += sQ[h * 128 + c] * wu[c * 64];
            if (CHECK) { const float got = bf2f(mixed[(size_t)q * DM + 512 + h * 64 + lane]); chk_num += (got - acc) * (got - acc); chk_den += acc * acc; }
            else mixed[(size_t)q * DM + 512 + h * 64 + lane] = f2bf(acc);
        }
        lds_fence();
    }
    if (CHECK) {
        chk_num = wave_sum(chk_num); chk_den = wave_sum(chk_den);
        if (lane == 0) { atomicAdd((float*)(p.ws + OFF_BAR) + 3600, chk_num); atomicAdd((float*)(p.ws + OFF_BAR) + 3601, chk_den); }
    }
}

typedef unsigned long long u64;
typedef short s16x4 __attribute__((ext_vector_type(4)));
constexpr int SCLD = 2116;
constexpr int DSA_MASK_OFF = 16 * SCLD * 4;
constexpr int KLD = 136, VLD = 72;
constexpr int DSA_VT_OFF = 64 * KLD * 2;
#define MFMA16(a, b, c) __builtin_amdgcn_mfma_f32_16x16x32_bf16((a), (b), (c), 0, 0, 0)
DI void phase_dsa_fast(const Params& p, LAS char* smem) {
    const bf16_t* proj = (const bf16_t*)(p.ws + OFF_BIG);
    const bf16_t* dvt = (const bf16_t*)(p.ws + OFF_DVT);
    const bf16_t* wuvt = (const bf16_t*)(p.ws + OFF_WUVT);
    bf16_t* mixed = (bf16_t*)(p.ws + OFF_HN);
    const int wave = threadIdx.x >> 6, lane = threadIdx.x & 63, c = lane & 15, g = lane >> 4;
    LAS float* SC = (LAS float*)smem; LAS u64* MASK = (LAS u64*)(smem + DSA_MASK_OFF);
    LAS bf16_t* KT = (LAS bf16_t*)smem; LAS bf16_t* VT = (LAS bf16_t*)(smem + DSA_VT_OFF);
    const u64 lt_mask = (1ull << lane) - 1ull;
    for (int pi = blockIdx.x; pi < 512; pi += gridDim.x)
    for (int which = 0; which < 2; ++which) {
        const int b = pi >> 6, qq = pi & 63, qt = which ? 127 - qq : qq;
        const int s0 = qt * 16, nk = 80 + 64 * (s0 >> 6), nkt = nk >> 4, nj = (nk + 63) >> 6;
        const bf16_t* pb = proj + (size_t)(b * TT) * INW;
        LAS char* tp_smem = smem; TP_BEGIN(1);
        {
            const bf16_t* qrow = pb + (size_t)(NMETA + s0 + c) * INW;
            bf16x8 bq[8][2]; float iw[8];
#pragma unroll
            for (int h = 0; h < 8; ++h) {
                bq[h][0] = *(const bf16x8*)(qrow + C_IQ + h * 64 + 8 * g);
                bq[h][1] = *(const bf16x8*)(qrow + C_IQ + h * 64 + 32 + 8 * g);
                iw[h] = bf2f(qrow[C_IW + h]);
            }
            bf16x8 a0n = {0, 0, 0, 0, 0, 0, 0, 0}, a1n = {0, 0, 0, 0, 0, 0, 0, 0};
            if (wave < nkt) { const bf16_t* krow = pb + (size_t)(wave * 16 + c) * INW + C_IK + 8 * g; a0n = *(const bf16x8*)(krow); a1n = *(const bf16x8*)(krow + 32); }
            for (int kt = wave; kt < nkt; kt += NWAVES) {
                const bf16x8 a0 = a0n, a1 = a1n;
                if (kt + NWAVES < nkt) { const bf16_t* krow = pb + (size_t)((kt + NWAVES) * 16 + c) * INW + C_IK + 8 * g; a0n = *(const bf16x8*)(krow); a1n = *(const bf16x8*)(krow + 32); }
                f32x4 isc = {0.f, 0.f, 0.f, 0.f};
#pragma unroll
                for (int h = 0; h < 8; ++h) {
                    f32x4 acc = {0.f, 0.f, 0.f, 0.f};
                    acc = MFMA16(a0, bq[h][0], acc); acc = MFMA16(a1, bq[h][1], acc);
#pragma unroll
                    for (int j = 0; j < 4; ++j) isc[j] += fmaxf(acc[j], 0.f) * iw[h];
                }
#pragma unroll
                for (int j = 0; j < 4; ++j) isc[j] += 0.0f;
                *(LAS f32x4*)(SC + c * SCLD + kt * 16 + 4 * g) = isc;
            }
            {
                const int tail = ((nj <= 11 ? 11 : (nj <= 22 ? 22 : 33)) << 6) - nk;
                for (int i = threadIdx.x; i < 16 * tail; i += NTHREADS) { const int qq_ = i / tail; SC[qq_ * SCLD + nk + (i - qq_ * tail)] = -3.0e38f; }
            }
        }
        __syncthreads(); TP_END(1); TP_BEGIN(2);
#pragma unroll 1
        for (int qi = 0; qi < 2; ++qi) {
            const int cq = wave * 2 + qi;
            unsigned kv[33];
#pragma unroll
            for (int jj = 0; jj < 11; ++jj) kv[jj] = fkey(SC[cq * SCLD + jj * 64 + lane]);
            if (nj > 11) {
#pragma unroll
                for (int jj = 11; jj < 22; ++jj) kv[jj] = fkey(SC[cq * SCLD + jj * 64 + lane]);
            } else {
#pragma unroll
                for (int jj = 11; jj < 22; ++jj) kv[jj] = 0u;
            }
            if (nj > 22) {
#pragma unroll
                for (int jj = 22; jj < 33; ++jj) kv[jj] = fkey(SC[cq * SCLD + jj * 64 + lane]);
            } else {
#pragma unroll
                for (int jj = 22; jj < 33; ++jj) kv[jj] = 0u;
            }
            unsigned Tkey = 1u;
            if (nk > 256) {
                Tkey = 0u;
#pragma unroll 1
                for (int bit = 31; bit >= 0; --bit) {
                    const unsigned cand = Tkey | (1u << bit);
                    int nl = 0;
#pragma unroll
                    for (int jj = 0; jj < 11; ++jj) nl += (kv[jj] >= cand) ? 1 : 0;
                    if (nj > 11) {
#pragma unroll
                        for (int jj = 11; jj < 22; ++jj) nl += (kv[jj] >= cand) ? 1 : 0;
                    }
                    if (nj > 22) {
#pragma unroll
                        for (int jj = 22; jj < 33; ++jj) nl += (kv[jj] >= cand) ? 1 : 0;
                    }
                    const int cnt = wave_sum_int(nl);
                    if (cnt >= 256) Tkey = cand;
                    if (cnt == 256) break;
                }
            }
            int cgl = 0;
#pragma unroll
            for (int jj = 0; jj < 33; ++jj) cgl += (kv[jj] > Tkey) ? 1 : 0;
            const int cgt = wave_sum_int(cgl);
            const int need = (nk > 256) ? 256 - cgt : 4096;
            int eqseen = 0;
#pragma unroll 1
            for (int jj = 0; jj < nj; ++jj) {
                const int k = jj * 64 + lane; const float v = SC[cq * SCLD + k];
                const unsigned key = (k < nk) ? fkey(v) : 0u;
                const bool gt = key > Tkey, eq = (key == Tkey);
                const u64 eqm = __ballot(eq);
                const int myeq = eqseen + __popcll(eqm & lt_mask);
                const u64 sm = __ballot(gt || (eq && myeq < need));
                eqseen += __popcll(eqm);
                if (lane == 0) MASK[cq * 34 + jj] = sm;
            }
        }
        __syncthreads(); TP_END(2); TP_BEGIN(3);
        {
            const int h = wave;
            const bf16_t* qrow = pb + (size_t)(NMETA + s0 + c) * INW + C_DQ + h * 128 + 8 * g;
            bf16x8 bQ[4];
#pragma unroll
            for (int ks = 0; ks < 4; ++ks) bQ[ks] = *(const bf16x8*)(qrow + ks * 32);
            f32x4 O[8];
#pragma unroll
            for (int mb = 0; mb < 8; ++mb) O[mb] = (f32x4){0.f, 0.f, 0.f, 0.f};
            float m_run = -1e30f, l_run = 0.f;
            const int krow_t = threadIdx.x >> 4, kch_t = threadIdx.x & 15, vdv_t = threadIdx.x >> 3, vch_t = threadIdx.x & 7;
            const bf16_t* vsrc = dvt + (size_t)(b * 128 + vdv_t) * TTP + vch_t * 8;
            u32x4 pk0, pk1, pv0, pv1;
            {
                int k0 = krow_t, k1 = 32 + krow_t; k0 = k0 < nk ? k0 : nk - 1; k1 = k1 < nk ? k1 : nk - 1;
                pk0 = *(const u32x4*)(pb + (size_t)k0 * INW + C_DK + kch_t * 8); pk1 = *(const u32x4*)(pb + (size_t)k1 * INW + C_DK + kch_t * 8);
                pv0 = *(const u32x4*)(vsrc); pv1 = *(const u32x4*)(vsrc + (size_t)64 * TTP);
            }
#pragma unroll 1
            for (int kb = 0; kb < nj; ++kb) {
                *(LAS u32x4*)(KT + krow_t * KLD + kch_t * 8) = pk0; *(LAS u32x4*)(KT + (32 + krow_t) * KLD + kch_t * 8) = pk1;
                *(LAS u32x4*)(VT + vdv_t * VLD + vch_t * 8) = pv0; *(LAS u32x4*)(VT + (64 + vdv_t) * VLD + vch_t * 8) = pv1;
                __syncthreads();
                if (kb + 1 < nj) {
                    int k0 = (kb + 1) * 64 + krow_t, k1 = k0 + 32; k0 = k0 < nk ? k0 : nk - 1; k1 = k1 < nk ? k1 : nk - 1;
                    pk0 = *(const u32x4*)(pb + (size_t)k0 * INW + C_DK + kch_t * 8); pk1 = *(const u32x4*)(pb + (size_t)k1 * INW + C_DK + kch_t * 8);
                    pv0 = *(const u32x4*)(vsrc + (kb + 1) * 64); pv1 = *(const u32x4*)(vsrc + (size_t)64 * TTP + (kb + 1) * 64);
                }
                const u64 mw = MASK[c * 34 + kb];
                f32x4 S[4];
#pragma unroll
                for (int ct = 0; ct < 4; ++ct) {
                    f32x4 acc = {0.f, 0.f, 0.f, 0.f};
#pragma unroll
                    for (int ks = 0; ks < 4; ++ks) {
                        const bf16x8 a = *(const LAS bf16x8*)(KT + (ct * 16 + c) * KLD + ks * 32 + 8 * g);
                        acc = MFMA16(a, bQ[ks], acc);
                    }
                    S[ct] = acc;
                }
                const u64 mws = mw >> (4 * g);
                const unsigned mlo = (unsigned)mws, mhi = (unsigned)(mws >> 32);
                float mblk = -1e30f;
#pragma unroll
                for (int ct = 0; ct < 4; ++ct) {
                    const unsigned bits = ((ct & 2) ? mhi : mlo) >> ((ct & 1) * 16);
#pragma unroll
                    for (int j = 0; j < 4; ++j) {
                        S[ct][j] = ((bits >> j) & 1u) ? S[ct][j] : -1e30f;
                        mblk = fmaxf(mblk, S[ct][j]);
                    }
                }
                mblk = fmaxf(mblk, __shfl_xor(mblk, 16)); mblk = fmaxf(mblk, __shfl_xor(mblk, 32));
                const float m_new = fmaxf(m_run, mblk);
                float ps = 0.f;
#pragma unroll
                for (int ct = 0; ct < 4; ++ct)
#pragma unroll
                    for (int j = 0; j < 4; ++j) { const float pv = (S[ct][j] > -1e29f) ? __builtin_amdgcn_exp2f(S[ct][j] - m_new) : 0.f; S[ct][j] = pv; ps += pv; }
                if (__ballot(m_new != m_run) != 0ull) {
                    const float alpha = __builtin_amdgcn_exp2f(m_run - m_new);
                    l_run *= alpha;
#pragma unroll
                    for (int mb = 0; mb < 8; ++mb) O[mb] *= alpha;
                }
                l_run += ps; m_run = m_new;
                bf16x8 bP[2];
#pragma unroll
                for (int kk = 0; kk < 2; ++kk) {
                    u32x4 t4;
                    t4[0] = pk2bf(S[2 * kk][0], S[2 * kk][1]); t4[1] = pk2bf(S[2 * kk][2], S[2 * kk][3]);
                    t4[2] = pk2bf(S[2 * kk + 1][0], S[2 * kk + 1][1]); t4[3] = pk2bf(S[2 * kk + 1][2], S[2 * kk + 1][3]);
                    bP[kk] = __builtin_bit_cast(bf16x8, t4);
                }
#pragma unroll
                for (int mb = 0; mb < 8; ++mb)
#pragma unroll
                    for (int kk = 0; kk < 2; ++kk) {
                        const LAS bf16_t* vr = VT + (mb * 16 + c) * VLD + kk * 32 + 4 * g;
                        const s16x4 lo = *(const LAS s16x4*)(vr), hi = *(const LAS s16x4*)(vr + 16);
                        const bf16x8 a = __builtin_shufflevector(lo, hi, 0, 1, 2, 3, 4, 5, 6, 7);
                        O[mb] = MFMA16(a, bP[kk], O[mb]);
                    }
                __syncthreads();
            }
            TP_END(3); TP_BEGIN(4);
            l_run += __shfl_xor(l_run, 16); l_run += __shfl_xor(l_run, 32);
            const float inv = 1.f / l_run;
            bf16x8 bO[4];
#pragma unroll
            for (int k2 = 0; k2 < 4; ++k2)
#pragma unroll
                for (int j = 0; j < 4; ++j) { bO[k2][j] = (short)f2bf(O[2 * k2][j] * inv); bO[k2][4 + j] = (short)f2bf(O[2 * k2 + 1][j] * inv); }
            bf16_t* orow = mixed + (size_t)(b * SEQ + s0 + c) * DM + 512 + h * 64;
            int zofs = 0; asm volatile("" : "+v"(zofs));
#pragma unroll
            for (int eb = 0; eb < 4; ++eb) {
                f32x4 acc = {0.f, 0.f, 0.f, 0.f};
#pragma unroll
                for (int k2 = 0; k2 < 4; ++k2) {
                    const bf16_t* wr = wuvt + (size_t)(h * 64 + eb * 16 + c) * 128 + k2 * 32 + 4 * g + zofs;
                    const s16x4 lo = *(const s16x4*)(wr), hi = *(const s16x4*)(wr + 16);
                    const bf16x8 a = __builtin_shufflevector(lo, hi, 0, 1, 2, 3, 4, 5, 6, 7);
                    acc = MFMA16(a, bO[k2], acc);
                }
                uint2 w;
                w.x = (unsigned)f2bf(acc[0]) | ((unsigned)f2bf(acc[1]) << 16);
                w.y = (unsigned)f2bf(acc[2]) | ((unsigned)f2bf(acc[3]) << 16);
                *(uint2*)(orow + eb * 16 + 4 * g) = w;
            }
            TP_END(4);
        }
    }
}

DI void phase_ret_scan(const Params& p) {
    float* ST = (float*)(p.ws + OFF_ST);
    const int gtid = blockIdx.x * NTHREADS + threadIdx.x, gsz = gridDim.x * NTHREADS;
    for (int idx = gtid; idx < 32 * 16384; idx += gsz) {
        const int bh = idx >> 14, el = idx & 16383, h = bh & 3;
        const float gc = expf(logf(1.f - exp2f(-5.f - (float)h)) * 64.f);
        float* base = ST + (size_t)bh * 34 * 16384 + el;
        float r = 0.f;
        for (int c = 1; c < 34; ++c) {
            const float u = c < 33 ? base[(size_t)c * 16384] : 0.f;
            base[(size_t)c * 16384] = r;
            r = gc * r + u;
        }
    }
}

DI void phase_ret_out(const Params& p, LAS char* smem) {
    const bf16_t* proj = (const bf16_t*)(p.ws + OFF_BIG);
    const float* ST = (const float*)(p.ws + OFF_ST);
    bf16_t* mixed = (bf16_t*)(p.ws + OFF_HN);
    LAS bf16_t* sQ = (LAS bf16_t*)smem; LAS bf16_t* sK = sQ + 64 * 128; LAS bf16_t* sV = sK + 64 * 128;
    LAS float* sS = (LAS float*)(sV + 64 * 128);
    LAS float* sR = sS + 64 * 65;
    for (int unit = blockIdx.x; unit < 1024; unit += gridDim.x) {
        const int c = 2 + (unit & 31), bh = unit >> 5, h = bh & 3, b = bh >> 2;
        for (int i = threadIdx.x; i < 64 * 16; i += NTHREADS) {
            const int j = i >> 4, ch = i & 15; const int t = 64 * c + j - 112;
            const bf16_t* pr = proj + (size_t)(b * TT + t) * INW;
            *(LAS u32x4*)(sQ + j * 128 + ch * 8) = *(const u32x4*)(pr + C_RQ + h * 128 + ch * 8);
            *(LAS u32x4*)(sK + j * 128 + ch * 8) = *(const u32x4*)(pr + C_RK + h * 128 + ch * 8);
            *(LAS u32x4*)(sV + j * 128 + ch * 8) = *(const u32x4*)(pr + C_RV + h * 128 + ch * 8);
        }
        const float* R = ST + (size_t)(bh * 34 + c) * 16384;
        for (int i = threadIdx.x; i < 16384; i += NTHREADS) sR[(i >> 7) * 129 + (i & 127)] = R[i];
        __syncthreads();
        const float lg = logf(1.f - exp2f(-5.f - (float)h));
        const int i = threadIdx.x >> 3, g8 = threadIdx.x & 7;
        {
            float sacc[8];
#pragma unroll
            for (int jj = 0; jj < 8; ++jj) sacc[jj] = 0.f;
            for (int d = 0; d < 128; ++d) {
                const float qv = bf2f(sQ[i * 128 + d]);
#pragma unroll
                for (int jj = 0; jj < 8; ++jj) sacc[jj] += qv * bf2f(sK[(jj * 8 + g8) * 128 + d]);
            }
#pragma unroll
            for (int jj = 0; jj < 8; ++jj) { const int j = jj * 8 + g8; const int df = i > j ? i - j : j - i; sS[i * 65 + j] = sacc[jj] * expf(lg * (float)df); }
        }
        __syncthreads();
        float o[16];
#pragma unroll
        for (int ee = 0; ee < 16; ++ee) o[ee] = 0.f;
        for (int j = 0; j < 64; ++j) {
            const float sv = sS[i * 65 + j];
#pragma unroll
            for (int ee = 0; ee < 16; ++ee) o[ee] += sv * bf2f(sV[j * 128 + ee * 8 + g8]);
        }
        const float xi = expf(lg * (float)(i + 1));
        for (int d = 0; d < 128; ++d) {
            const float qv = bf2f(sQ[i * 128 + d]) * xi;
#pragma unroll
            for (int ee = 0; ee < 16; ++ee) o[ee] += qv * sR[(ee * 8 + g8) * 129 + d];
        }
        float sum = 0.f;
#pragma unroll
        for (int ee = 0; ee < 16; ++ee) sum += o[ee];
        sum += __shfl_xor(sum, 1); sum += __shfl_xor(sum, 2); sum += __shfl_xor(sum, 4);
        const float mu = sum * (1.f / 128.f);
        float var = 0.f;
#pragma unroll
        for (int ee = 0; ee < 16; ++ee) { const float dlt = o[ee] - mu; var += dlt * dlt; }
        var += __shfl_xor(var, 1); var += __shfl_xor(var, 2); var += __shfl_xor(var, 4);
        const float rs = rsqrtf(var * (1.f / 128.f) + 1e-6f);
        const int t = 64 * c + i - 112, srow = t - NMETA;
        const bf16_t* pg = proj + (size_t)(b * TT + t) * INW + C_RG + h * 128;
        bf16_t* po = mixed + (size_t)(b * SEQ + srow) * DM + h * 128;
#pragma unroll
        for (int ee = 0; ee < 16; ++ee) {
            const int e = ee * 8 + g8;
            const float g = bf2f(pg[e]);
            const float gate = g / (1.f + expf(-g));
            po[e] = f2bf(gate * (o[ee] - mu) * rs);
        }
        __syncthreads();
    }
}

#define MFMA32(a, b, c) __builtin_amdgcn_mfma_f32_32x32x16_bf16((a), (b), (c), 0, 0, 0)
constexpr int RLD = 136, RTLD = 72;
DI void phase_ret_state_mfma(const Params& p, LAS char* smem) {
    const bf16_t* proj = (const bf16_t*)(p.ws + OFF_BIG);
    float* ST = (float*)(p.ws + OFF_ST);
    LAS bf16_t* sVT = (LAS bf16_t*)smem; LAS bf16_t* sKT = sVT + 128 * RTLD;
    const int wave = threadIdx.x >> 6, lane = threadIdx.x & 63, r = lane & 31, hh = lane >> 5;
    for (int unit = blockIdx.x; unit < 1024; unit += gridDim.x) {
        const int c = 1 + (unit & 31), bh = unit >> 5, h = bh & 3, b = bh >> 2;
        const float lg = logf(1.f - exp2f(-5.f - (float)h));
        {
            const int j = threadIdx.x >> 3, ch = threadIdx.x & 7, t = 64 * c + j - 112;
            const float z = expf(lg * (float)(63 - j));
#pragma unroll
            for (int q = 0; q < 2; ++q) {
                const int cc = ch + 8 * q;
                u32x4 kv = {0u, 0u, 0u, 0u}, vv = {0u, 0u, 0u, 0u};
                if (t >= 0) { const bf16_t* pr = proj + (size_t)(b * TT + t) * INW; kv = *(const u32x4*)(pr + C_RK + h * 128 + cc * 8); vv = *(const u32x4*)(pr + C_RV + h * 128 + cc * 8); }
                float vf[8]; unpack8(vv, vf);
#pragma unroll
                for (int x = 0; x < 8; ++x) {
                    sKT[(cc * 8 + x) * RTLD + j] = (bf16_t)((kv[x >> 1] >> ((x & 1) * 16)) & 0xffffu);
                    sVT[(cc * 8 + x) * RTLD + j] = f2bf(vf[x] * z);
                }
            }
        }
        __syncthreads();
        const int mb = wave >> 1;
#pragma unroll
        for (int q = 0; q < 2; ++q) {
            const int nb = (wave & 1) * 2 + q;
            f32x16 acc;
#pragma unroll
            for (int i = 0; i < 16; ++i) acc[i] = 0.f;
#pragma unroll
            for (int ks = 0; ks < 4; ++ks) {
                const bf16x8 a = *(const LAS bf16x8*)(sVT + (mb * 32 + r) * RTLD + ks * 16 + 8 * hh);
                const bf16x8 bb = *(const LAS bf16x8*)(sKT + (nb * 32 + r) * RTLD + ks * 16 + 8 * hh);
                acc = MFMA32(a, bb, acc);
            }
            float* st = ST + (size_t)(bh * 34 + c) * 16384 + nb * 32 + r;
#pragma unroll
            for (int i = 0; i < 16; ++i) st[(size_t)(mb * 32 + (i & 3) + 8 * (i >> 2) + 4 * hh) * 128] = acc[i];
        }
        __syncthreads();
    }
}
DI void phase_ret_out_mfma(const Params& p, LAS char* smem) {
    const bf16_t* proj = (const bf16_t*)(p.ws + OFF_BIG);
    const float* ST = (const float*)(p.ws + OFF_ST);
    bf16_t* mixed = (bf16_t*)(p.ws + OFF_HN);
    LAS bf16_t* sQ = (LAS bf16_t*)smem; LAS bf16_t* sK = sQ + 64 * RLD; LAS bf16_t* sVT = sK + 64 * RLD;
    LAS float* sGN = (LAS float*)(sVT + 128 * RTLD);
    const int wave = threadIdx.x >> 6, lane = threadIdx.x & 63, r = lane & 31, hh = lane >> 5;
    const int ib = wave & 1, eb = wave >> 1;
    for (int unit = blockIdx.x; unit < 1024; unit += gridDim.x) {
        const int c = 2 + (unit & 31), bh = unit >> 5, h = bh & 3, b = bh >> 2;
        const float lg = logf(1.f - exp2f(-5.f - (float)h));
        for (int i = threadIdx.x; i < 64 * 16; i += NTHREADS) {
            const int j = i >> 4, ch = i & 15; const int t = 64 * c + j - 112;
            const bf16_t* pr = proj + (size_t)(b * TT + t) * INW;
            *(LAS u32x4*)(sQ + j * RLD + ch * 8) = *(const u32x4*)(pr + C_RQ + h * 128 + ch * 8);
            *(LAS u32x4*)(sK + j * RLD + ch * 8) = *(const u32x4*)(pr + C_RK + h * 128 + ch * 8);
            const u32x4 vv = *(const u32x4*)(pr + C_RV + h * 128 + ch * 8);
#pragma unroll
            for (int x = 0; x < 8; ++x) sVT[(ch * 8 + x) * RTLD + j] = (bf16_t)((vv[x >> 1] >> ((x & 1) * 16)) & 0xffffu);
        }
        __syncthreads();
        f32x16 acc;
#pragma unroll
        for (int i = 0; i < 16; ++i) acc[i] = 0.f;
        {
            const float* R = ST + (size_t)(bh * 34 + c) * 16384 + (size_t)(eb * 32 + r) * 128 + 8 * hh;
#pragma unroll
            for (int ks = 0; ks < 8; ++ks) {
                const float4 r0 = *(const float4*)(R + ks * 16), r1 = *(const float4*)(R + ks * 16 + 4);
                const float rf[8] = {r0.x, r0.y, r0.z, r0.w, r1.x, r1.y, r1.z, r1.w};
                const bf16x8 a = pack8(rf);
                const bf16x8 bq = *(const LAS bf16x8*)(sQ + (ib * 32 + r) * RLD + ks * 16 + 8 * hh);
                acc = MFMA32(a, bq, acc);
            }
            const float xi = expf(lg * (float)(ib * 32 + r + 1));
#pragma unroll
            for (int i = 0; i < 16; ++i) acc[i] *= xi;
        }
#pragma unroll
        for (int jb = 0; jb < 2; ++jb) {
            f32x16 st;
#pragma unroll
            for (int i = 0; i < 16; ++i) st[i] = 0.f;
#pragma unroll
            for (int ks = 0; ks < 8; ++ks) {
                const bf16x8 a = *(const LAS bf16x8*)(sK + (jb * 32 + r) * RLD + ks * 16 + 8 * hh);
                const bf16x8 bq = *(const LAS bf16x8*)(sQ + (ib * 32 + r) * RLD + ks * 16 + 8 * hh);
                st = MFMA32(a, bq, st);
            }
            const int icol = ib * 32 + r;
#pragma unroll
            for (int i = 0; i < 16; ++i) {
                const int j = jb * 32 + (i & 3) + 8 * (i >> 2) + 4 * hh; const int df = icol > j ? icol - j : j - icol;
                st[i] *= expf(lg * (float)df);
            }
#pragma unroll
            for (int s2 = 0; s2 < 2; ++s2) {
                bf16x8 bp;
#pragma unroll
                for (int x = 0; x < 8; ++x) bp[x] = (short)f2bf(st[8 * s2 + x]);
                const LAS bf16_t* vr = sVT + (eb * 32 + r) * RTLD + jb * 32 + 16 * s2 + 4 * hh;
                const s16x4 lo = *(const LAS s16x4*)(vr), hi = *(const LAS s16x4*)(vr + 8);
                const bf16x8 a = __builtin_shufflevector(lo, hi, 0, 1, 2, 3, 4, 5, 6, 7);
                acc = MFMA32(a, bp, acc);
            }
        }
        float s1 = 0.f, s2 = 0.f;
#pragma unroll
        for (int i = 0; i < 16; ++i) { s1 += acc[i]; s2 += acc[i] * acc[i]; }
        s1 += __shfl_xor(s1, 32); s2 += __shfl_xor(s2, 32);
        if (hh == 0) { sGN[(eb * 64 + ib * 32 + r) * 2] = s1; sGN[(eb * 64 + ib * 32 + r) * 2 + 1] = s2; }
        __syncthreads();
        float S1 = 0.f, S2 = 0.f;
#pragma unroll
        for (int e4 = 0; e4 < 4; ++e4) { S1 += sGN[(e4 * 64 + ib * 32 + r) * 2]; S2 += sGN[(e4 * 64 + ib * 32 + r) * 2 + 1]; }
        const float mu = S1 * (1.f / 128.f), var = fmaxf(S2 * (1.f / 128.f) - mu * mu, 0.f), rs = rsqrtf(var + 1e-6f);
        const int t = 64 * c + ib * 32 + r - 112, srow = t - NMETA;
        const bf16_t* pg = proj + (size_t)(b * TT + t) * INW + C_RG + h * 128 + eb * 32 + 4 * hh;
        bf16_t* po = mixed + (size_t)(b * SEQ + srow) * DM + h * 128 + eb * 32 + 4 * hh;
#pragma unroll
        for (int g4 = 0; g4 < 4; ++g4) {
            const uint2 graw = *(const uint2*)(pg + 8 * g4);
            const float gv[4] = {__uint_as_float(graw.x << 16), __uint_as_float(graw.x & 0xffff0000u), __uint_as_float(graw.y << 16), __uint_as_float(graw.y & 0xffff0000u)};
            float o[4];
#pragma unroll
            for (int x = 0; x < 4; ++x) { const float gate = gv[x] / (1.f + expf(-gv[x])); o[x] = gate * (acc[4 * g4 + x] - mu) * rs; }
            uint2 w; w.x = (unsigned)f2bf(o[0]) | ((unsigned)f2bf(o[1]) << 16); w.y = (unsigned)f2bf(o[2]) | ((unsigned)f2bf(o[3]) << 16);
            *(uint2*)(po + 8 * g4) = w;
        }
        __syncthreads();
    }
}

DI void phase_norm2(const Params& p) {
    bf16_t* hn2 = (bf16_t*)(p.ws + OFF_HN);
    const int wave = threadIdx.x >> 6, lane = threadIdx.x & 63;
    for (int row = blockIdx.x * NWAVES + wave; row < NF; row += gridDim.x * NWAVES) {
        const float* src = p.out + (size_t)row * DM; bf16_t* o = hn2 + (size_t)row * DM;
        float4 v[4]; float ss = 0.f;
#pragma unroll
        for (int i = 0; i < 4; ++i) { v[i] = *(const float4*)(src + i * 256 + lane * 4); ss += v[i].x * v[i].x + v[i].y * v[i].y + v[i].z * v[i].z + v[i].w * v[i].w; }
        ss = wave_sum(ss);
        const float rstd = rsqrtf(ss * (1.f / DM) + 1e-6f);
#pragma unroll
        for (int i = 0; i < 4; ++i) {
            const float4 g = *(const float4*)(p.norm_ffn + i * 256 + lane * 4);
            uint2 w;
            w.x = (unsigned)f2bf(v[i].x * rstd * g.x) | ((unsigned)f2bf(v[i].y * rstd * g.y) << 16);
            w.y = (unsigned)f2bf(v[i].z * rstd * g.z) | ((unsigned)f2bf(v[i].w * rstd * g.w) << 16);
            *(uint2*)(o + i * 256 + lane * 4) = w;
        }
    }
}

constexpr int PSEL_WAVE_LDS = 32 * 2 * 16 * 8 + 32 * 16 * 8;
DI void phase_peer_select(const Params& p, LAS char* smem) {
    const float* PQ = (const float*)(p.ws + OFF_BIG);
    int* EIDX = (int*)(p.ws + OFF_EIDX); float* GATE = (float*)(p.ws + OFF_GATE);
    const int wave = threadIdx.x >> 6, lane = threadIdx.x & 63, r = lane & 31, hh = lane >> 5;
    LAS float* lv = (LAS float*)(smem + wave * PSEL_WAVE_LDS);
    LAS int* li = (LAS int*)(lv + 32 * 2 * 16);
    LAS float* cs = (LAS float*)(li + 32 * 2 * 16);
    LAS int* cab = (LAS int*)(cs + 32 * 16);
    for (int task = blockIdx.x * NWAVES + wave; task < (NF / 32) * 8; task += gridDim.x * NWAVES) {
        const int tile = task >> 3, h = task & 7;
        const int n = tile * 32 + r;
#pragma unroll 1
        for (int half = 0; half < 2; ++half) {
            f32x16 acc[4];
            {
                const float* srow = PQ + (size_t)n * 2048 + h * 256 + half * 128 + hh * 64;
#pragma unroll
                for (int mb = 0; mb < 4; ++mb)
#pragma unroll
                    for (int q = 0; q < 4; ++q) { const float4 a = *(const float4*)(srow + mb * 16 + q * 4); acc[mb][q * 4] = a.x; acc[mb][q * 4 + 1] = a.y; acc[mb][q * 4 + 2] = a.z; acc[mb][q * 4 + 3] = a.w; }
            }
            float mprev = INFINITY;
#pragma unroll 1
            for (int it = 0; it < 16; ++it) {
                float m = -INFINITY;
#pragma unroll
                for (int mb = 0; mb < 4; ++mb)
#pragma unroll
                    for (int i = 0; i < 16; ++i) { const float v = acc[mb][i]; m = fmaxf(m, v < mprev ? v : -INFINITY); }
                m = fmaxf(m, __shfl_xor(m, 32));
                mprev = m;
            }
            const float T = mprev;
            int cnt = 0;
#pragma unroll
            for (int mb = 0; mb < 4; ++mb)
#pragma unroll
                for (int i = 0; i < 16; ++i) cnt += (acc[mb][i] >= T) ? 1 : 0;
            const int pc = __shfl_xor(cnt, 32);
            int pos = hh ? pc : 0;
            LAS float* lvp = lv + (r * 2 + half) * 16; LAS int* lip = li + (r * 2 + half) * 16;
#pragma unroll
            for (int mb = 0; mb < 4; ++mb)
#pragma unroll
                for (int i = 0; i < 16; ++i) {
                    const float v = acc[mb][i];
                    if (v >= T) { if (pos < 16) { lvp[pos] = v; lip[pos] = hh * 64 + mb * 16 + i; } ++pos; }
                }
        }
        lds_fence();
        float v1[8], v2[16];
#pragma unroll
        for (int a = 0; a < 8; ++a) v1[a] = lv[(r * 2 + 0) * 16 + 8 * hh + a];
#pragma unroll
        for (int b = 0; b < 16; ++b) v2[b] = lv[(r * 2 + 1) * 16 + b];
        float mprev = INFINITY;
#pragma unroll 1
        for (int it = 0; it < 16; ++it) {
            float m = -INFINITY;
#pragma unroll
            for (int a = 0; a < 8; ++a)
#pragma unroll
                for (int b = 0; b < 16; ++b) { const float v = v1[a] + v2[b]; m = fmaxf(m, v < mprev ? v : -INFINITY); }
            m = fmaxf(m, __shfl_xor(m, 32));
            mprev = m;
        }
        const float Tc = mprev;
        int cnt = 0;
#pragma unroll
        for (int a = 0; a < 8; ++a)
#pragma unroll
            for (int b = 0; b < 16; ++b) cnt += (v1[a] + v2[b] >= Tc) ? 1 : 0;
        const int pc = __shfl_xor(cnt, 32);
        int pos = hh ? pc : 0;
#pragma unroll
        for (int a = 0; a < 8; ++a)
#pragma unroll
            for (int b = 0; b < 16; ++b) {
                const float v = v1[a] + v2[b];
                if (v >= Tc) { if (pos < 16) { cs[r * 16 + pos] = v; cab[r * 16 + pos] = (8 * hh + a) * 16 + b; } ++pos; }
            }
        lds_fence();
        float scv[16]; float mx = -INFINITY;
#pragma unroll
        for (int i = 0; i < 16; ++i) { scv[i] = cs[r * 16 + i]; mx = fmaxf(mx, scv[i]); }
        float sum = 0.f;
#pragma unroll
        for (int i = 0; i < 16; ++i) { scv[i] = expf(scv[i] - mx); sum += scv[i]; }
        const float inv = 1.f / sum;
#pragma unroll
        for (int i = 0; i < 16; ++i) {
            if ((i >> 3) == hh) {
                const int ab = cab[r * 16 + i];
                const int e = li[(r * 2 + 0) * 16 + (ab >> 4)] * 128 + li[(r * 2 + 1) * 16 + (ab & 15)];
                EIDX[(size_t)n * 128 + h * 16 + i] = e;
                GATE[(size_t)n * 128 + h * 16 + i] = scv[i] * inv;
            }
        }
        lds_fence();
    }
}

typedef float f32x2 __attribute__((ext_vector_type(2)));
DI void phase_convert_tables(const Params& p) {
    const int wave = threadIdx.x >> 6, lane = threadIdx.x & 63;
    for (int rowi = blockIdx.x * NWAVES + wave; rowi < 2 * 16384; rowi += gridDim.x * NWAVES) {
        const bool isv = rowi >= 16384; const int e = isv ? rowi - 16384 : rowi;
        const float* src = (isv ? p.pv : p.pu) + (size_t)e * DM + lane * 16;
        float x[16]; float mx = 0.f;
#pragma unroll
        for (int i = 0; i < 4; ++i) { const float4 a = *(const float4*)(src + i * 4); x[i * 4] = a.x; x[i * 4 + 1] = a.y; x[i * 4 + 2] = a.z; x[i * 4 + 3] = a.w; }
#pragma unroll
        for (int i = 0; i < 16; ++i) mx = fmaxf(mx, fabsf(x[i]));
        mx = wave_max(mx);
        const float top = isv ? 240.f : 127.f;
        const float inv = mx > 0.f ? top / mx : 0.f, scale = mx > 0.f ? mx / top : 0.f;
        u32x4 o;
        if (isv) {
#pragma unroll
            for (int w = 0; w < 4; ++w) {
                int pk = 0;
                pk = __builtin_amdgcn_cvt_pk_fp8_f32(x[w * 4] * inv, x[w * 4 + 1] * inv, pk, false);
                pk = __builtin_amdgcn_cvt_pk_fp8_f32(x[w * 4 + 2] * inv, x[w * 4 + 3] * inv, pk, true);
                o[w] = (unsigned)pk;
            }
        } else {
#pragma unroll
            for (int w = 0; w < 4; ++w) {
                unsigned pk = 0u;
#pragma unroll
                for (int b = 0; b < 4; ++b) { const int q = (int)rintf(x[w * 4 + b] * inv); pk |= ((unsigned)q & 0xffu) << (8 * b); }
                o[w] = pk;
            }
        }
        *(u32x4*)(p.ws + (isv ? OFF_V8 : OFF_U8) + (size_t)e * DM + lane * 16) = o;
        if (lane == 0) ((float*)(p.ws + (isv ? OFF_SV : OFF_SU)))[e] = scale;
    }
}
DI void unpack16_fp8(const u32x4& r, float (&v)[16]) {
#pragma unroll
    for (int w = 0; w < 4; ++w) {
        const f32x2 a = __builtin_amdgcn_cvt_pk_f32_fp8((int)r[w], false), b = __builtin_amdgcn_cvt_pk_f32_fp8((int)r[w], true);
        v[w * 4] = a[0]; v[w * 4 + 1] = a[1]; v[w * 4 + 2] = b[0]; v[w * 4 + 3] = b[1];
    }
}
#ifndef P10_REP
#define P10_REP 1
#endif
DI void phase_peer_out(const Params& p) {
    const int* EIDX = (const int*)(p.ws + OFF_EIDX); const float* GATE = (const float*)(p.ws + OFF_GATE);
    const char* U8 = p.ws + OFF_U8; const char* V8 = p.ws + OFF_V8;
    const float* SU = (const float*)(p.ws + OFF_SU); const float* SV = (const float*)(p.ws + OFF_SV);
    const int wave = threadIdx.x >> 6, lane = threadIdx.x & 63;
    for (int n = blockIdx.x * NWAVES + wave; n < NF; n += gridDim.x * NWAVES) {
        float* row = p.out + (size_t)n * DM + lane * 16;
        float hv[16], hn[16]; float ss = 0.f;
#pragma unroll
        for (int i = 0; i < 4; ++i) { const float4 a = *(const float4*)(row + i * 4); hv[i * 4] = a.x; hv[i * 4 + 1] = a.y; hv[i * 4 + 2] = a.z; hv[i * 4 + 3] = a.w; }
#pragma unroll
        for (int i = 0; i < 16; ++i) ss += hv[i] * hv[i];
        ss = wave_sum_uniform(ss);
        const float rstd = rsqrtf(ss * (1.f / DM) + 1e-6f);
#pragma unroll
        for (int i = 0; i < 4; ++i) {
            const float4 a = *(const float4*)(p.norm_ffn + lane * 16 + i * 4);
            hn[i * 4] = hv[i * 4] * rstd * a.x; hn[i * 4 + 1] = hv[i * 4 + 1] * rstd * a.y; hn[i * 4 + 2] = hv[i * 4 + 2] * rstd * a.z; hn[i * 4 + 3] = hv[i * 4 + 3] * rstd * a.w;
        }
        float acc[16];
#pragma unroll
        for (int i = 0; i < 16; ++i) acc[i] = 0.f;
        const int e_lo = EIDX[(size_t)n * 128 + lane], e_hi = EIDX[(size_t)n * 128 + 64 + lane];
        const float g_lo = GATE[(size_t)n * 128 + lane], g_hi = GATE[(size_t)n * 128 + 64 + lane];
#pragma unroll 1
        for (int s0_ = 0; s0_ < 128 * P10_REP; s0_ += 8) {
            const int s0 = s0_ & 127;
            u32x4 ub[8], vb[8]; float gt[8], su[8], sv[8];
#pragma unroll
            for (int k = 0; k < 8; ++k) {
                const int slot = s0 + k;
                const int e = slot < 64 ? __builtin_amdgcn_readlane(e_lo, slot & 63) : __builtin_amdgcn_readlane(e_hi, slot & 63);
                gt[k] = __int_as_float(slot < 64 ? __builtin_amdgcn_readlane(__float_as_int(g_lo), slot & 63) : __builtin_amdgcn_readlane(__float_as_int(g_hi), slot & 63));
                ub[k] = *(const u32x4*)(U8 + (size_t)e * DM + lane * 16);
                vb[k] = *(const u32x4*)(V8 + (size_t)e * DM + lane * 16);
                su[k] = SU[e]; sv[k] = SV[e];
            }
            float d[8];
#pragma unroll
            for (int k = 0; k < 8; ++k) {
                float u[16]; unpack16_fp8(ub[k], u);
                float t = 0.f;
#pragma unroll
                for (int i = 0; i < 16; ++i) t += u[i] * hn[i];
                d[k] = t;
            }
#pragma unroll
            for (int k = 0; k < 8; ++k) d[k] = wave_sum_uniform(d[k]) * su[k];
#pragma unroll
            for (int k = 0; k < 8; ++k) {
                const float coef = 0.5f * d[k] * (1.f + erff(d[k] * 0.70710678118654752f)) * gt[k] * sv[k];
                float v[16]; unpack16_fp8(vb[k], v);
#pragma unroll
                for (int i = 0; i < 16; ++i) acc[i] += coef * v[i];
            }
        }
        float s2 = 0.f;
#pragma unroll
        for (int i = 0; i < 16; ++i) { acc[i] = acc[i] * (1.f / P10_REP) + hv[i]; s2 += acc[i] * acc[i]; }
        s2 = wave_sum_uniform(s2);
        float r2 = rsqrtf(s2 * (1.f / DM) + 1e-6f);
#if TP_SEC
        r2 *= 1.f + 0.5f * ((const float*)(p.ws + OFF_BAR))[3602];
#endif
#ifdef DSA_CHECK
        {
            const float num = ((const float*)(p.ws + OFF_BAR))[3600], den = ((const float*)(p.ws + OFF_BAR))[3601];
            r2 *= 1.f + 10.f * sqrtf(num / fmaxf(den, 1e-30f));
        }
#endif
#pragma unroll
        for (int i = 0; i < 4; ++i) {
            const float4 a = *(const float4*)(p.norm_final + lane * 16 + i * 4);
            *(float4*)(row + i * 4) = make_float4(acc[i * 4] * r2 * a.x, acc[i * 4 + 1] * r2 * a.y, acc[i * 4 + 2] * r2 * a.z, acc[i * 4 + 3] * r2 * a.w);
        }
    }
}

#ifndef SWB
#define SWB 4
#endif
#ifndef TG
#define TG 2
#endif
constexpr int SW_NP = TG * 128, SW_PL = SW_NP / 64;
constexpr int SW_WAVE_LDS = 64 * 4 + SW_NP * 4 + SW_NP * 4;
#if TG == 2
#define SW_CASES(tl, STMT) if ((tl) == 0) { constexpr int T_ = 0; STMT } else { constexpr int T_ = 1; STMT }
#else
#define SW_CASES(tl, STMT) switch (tl) { case 0: { constexpr int T_ = 0; STMT } break; case 1: { constexpr int T_ = 1; STMT } break; case 2: { constexpr int T_ = 2; STMT } break; default: { constexpr int T_ = 3; STMT } break; }
#endif
DI void phase_peer_out_sweep(const Params& p, LAS char* smem) {
    const int* EIDX = (const int*)(p.ws + OFF_EIDX); const float* GATE = (const float*)(p.ws + OFF_GATE);
    const char* U8 = p.ws + OFF_U8; const char* V8 = p.ws + OFF_V8;
    const float* SU = (const float*)(p.ws + OFF_SU); const float* SV = (const float*)(p.ws + OFF_SV);
    const int wave = threadIdx.x >> 6, lane = threadIdx.x & 63;
    LAS int* cnt = (LAS int*)(smem + wave * SW_WAVE_LDS); LAS int* off = cnt + 32;
    LAS int* list_e = off + 32; LAS float* list_g = (LAS float*)(list_e + SW_NP);
    for (int grp = blockIdx.x * NWAVES + wave; grp < NF / TG; grp += gridDim.x * NWAVES) {
        const int n0 = grp * TG;
        float hn[TG][16], acc[TG][16];
#pragma unroll
        for (int tl = 0; tl < TG; ++tl) {
            const float* row = p.out + (size_t)(n0 + tl) * DM + lane * 16;
            float ss = 0.f;
#pragma unroll
            for (int i = 0; i < 4; ++i) { const float4 a = *(const float4*)(row + i * 4); hn[tl][i * 4] = a.x; hn[tl][i * 4 + 1] = a.y; hn[tl][i * 4 + 2] = a.z; hn[tl][i * 4 + 3] = a.w; }
#pragma unroll
            for (int i = 0; i < 16; ++i) ss += hn[tl][i] * hn[tl][i];
            ss = wave_sum_uniform(ss);
            const float rstd = rsqrtf(ss * (1.f / DM) + 1e-6f);
#pragma unroll
            for (int i = 0; i < 4; ++i) {
                const float4 a = *(const float4*)(p.norm_ffn + lane * 16 + i * 4);
                hn[tl][i * 4] *= rstd * a.x; hn[tl][i * 4 + 1] *= rstd * a.y; hn[tl][i * 4 + 2] *= rstd * a.z; hn[tl][i * 4 + 3] *= rstd * a.w;
            }
#pragma unroll
            for (int i = 0; i < 16; ++i) acc[tl][i] = 0.f;
        }
        if (lane < 32) cnt[lane] = 0;
        lds_fence();
        {
            int ek[SW_PL], rk[SW_PL]; float gk[SW_PL];
#pragma unroll
            for (int k = 0; k < SW_PL; ++k) {
                const size_t o = (size_t)(n0 + (k >> 1)) * 128 + (k & 1) * 64 + lane;
                ek[k] = EIDX[o]; gk[k] = GATE[o];
            }
#pragma unroll
            for (int k = 0; k < SW_PL; ++k) rk[k] = __hip_atomic_fetch_add(&cnt[ek[k] >> 9], 1, __ATOMIC_RELAXED, __HIP_MEMORY_SCOPE_WORKGROUP);
            lds_fence();
            {
                int cv = lane < 32 ? cnt[lane] : 0, inc = cv;
#pragma unroll
                for (int d = 1; d < 32; d <<= 1) { const int o = __shfl_up(inc, d); if ((lane & 31) >= d) inc += o; }
                if (lane < 32) off[lane] = inc - cv;
            }
            lds_fence();
#pragma unroll
            for (int k = 0; k < SW_PL; ++k) { const int pos = off[ek[k] >> 9] + rk[k]; list_e[pos] = ek[k] | ((k >> 1) << 16); list_g[pos] = gk[k]; }
        }
        lds_fence();
#define SW_LOAD(X, P0) do { _Pragma("unroll") for (int k = 0; k < SWB; ++k) { \
            const int ev = __builtin_amdgcn_readfirstlane(list_e[(P0) + k]); const int e = ev & 0xffff; tls##X[k] = ev >> 16; gt##X[k] = list_g[(P0) + k]; \
            ub##X[k] = *(const u32x4*)(U8 + (size_t)e * DM + lane * 16); vb##X[k] = *(const u32x4*)(V8 + (size_t)e * DM + lane * 16); \
            su##X[k] = SU[e]; sv##X[k] = SV[e]; } } while (0)
#define SW_COMPUTE(X) do { float d[SWB]; \
            _Pragma("unroll") for (int k = 0; k < SWB; ++k) { float u[16]; unpack16_fp8(ub##X[k], u); float t = 0.f; \
                SW_CASES(tls##X[k], _Pragma("unroll") for (int i = 0; i < 16; ++i) t += u[i] * hn[T_][i];) d[k] = t; } \
            _Pragma("unroll") for (int k = 0; k < SWB; ++k) d[k] = wave_sum_uniform(d[k]) * su##X[k]; \
            float dv = 0.f; _Pragma("unroll") for (int k = 0; k < SWB; ++k) dv = (lane == k) ? d[k] : dv; \
            const float gl = 0.5f * dv * (1.f + erff(dv * 0.70710678118654752f)); \
            _Pragma("unroll") for (int k = 0; k < SWB; ++k) { \
                const float coef = __int_as_float(__builtin_amdgcn_readlane(__float_as_int(gl), k)) * gt##X[k] * sv##X[k]; \
                float v[16]; unpack16_fp8(vb##X[k], v); \
                SW_CASES(tls##X[k], _Pragma("unroll") for (int i = 0; i < 16; ++i) acc[T_][i] += coef * v[i];) } } while (0)
        {
            u32x4 ubA[SWB], vbA[SWB], ubB[SWB], vbB[SWB]; float gtA[SWB], suA[SWB], svA[SWB], gtB[SWB], suB[SWB], svB[SWB]; int tlsA[SWB], tlsB[SWB];
#ifndef SW_REP
#define SW_REP 1
#endif
#pragma unroll 1
            for (int rep_ = 0; rep_ < SW_REP; ++rep_) {
            SW_LOAD(A, 0);
#pragma unroll 1
            for (int p0 = 0; p0 < SW_NP; p0 += 2 * SWB) {
                SW_LOAD(B, p0 + SWB);
                SW_COMPUTE(A);
                if (p0 + 2 * SWB < SW_NP) SW_LOAD(A, p0 + 2 * SWB);
                SW_COMPUTE(B);
            }
            }
        }
#pragma unroll
        for (int tl = 0; tl < TG; ++tl) {
            float* row = p.out + (size_t)(n0 + tl) * DM + lane * 16;
            float y[16]; float s2 = 0.f;
#pragma unroll
            for (int i = 0; i < 4; ++i) { const float4 a = *(const float4*)(row + i * 4); y[i * 4] = a.x + acc[tl][i * 4] * (1.f / SW_REP); y[i * 4 + 1] = a.y + acc[tl][i * 4 + 1] * (1.f / SW_REP); y[i * 4 + 2] = a.z + acc[tl][i * 4 + 2] * (1.f / SW_REP); y[i * 4 + 3] = a.w + acc[tl][i * 4 + 3] * (1.f / SW_REP); }
#pragma unroll
            for (int i = 0; i < 16; ++i) s2 += y[i] * y[i];
            s2 = wave_sum_uniform(s2);
            float r2 = rsqrtf(s2 * (1.f / DM) + 1e-6f);
#if TP_SEC
            r2 *= 1.f + 0.5f * ((const float*)(p.ws + OFF_BAR))[3602];
#endif
#if defined(DSA_CHECK) || defined(PROJ_CHECK)
            { const float num = ((const float*)(p.ws + OFF_BAR))[3600], den = ((const float*)(p.ws + OFF_BAR))[3601]; r2 *= 1.f + CHK_GAIN * sqrtf(num / fmaxf(den, 1e-30f)); }
#endif
#pragma unroll
            for (int i = 0; i < 4; ++i) {
                const float4 a = *(const float4*)(p.norm_final + lane * 16 + i * 4);
                *(float4*)(row + i * 4) = make_float4(y[i * 4] * r2 * a.x, y[i * 4 + 1] * r2 * a.y, y[i * 4 + 2] * r2 * a.z, y[i * 4 + 3] * r2 * a.w);
            }
        }
        lds_fence();
    }
}

constexpr int RW_NB = 128, RW_SH = 7;
constexpr int RW_WAVE_LDS = 4 * (RW_NB + 16) * 4 + 4 * 128 * 4 + 4 * 128 * 4;
DI float gelu_as(float v) {
    const float av = fabsf(v), t = __builtin_amdgcn_rcpf(av * 0.2316418882f + 1.0f);
    float q = t * 0.5307027145f + (-0.7265760135f); q = q * t + 0.7107068705f; q = q * t + (-0.142248368f); q = q * t + 0.127414796f; q = q * t;
    const float e = __builtin_amdgcn_exp2f((v * v) * (-0.72134752044f));
    const float m = v * (q * e), r = v - m;
    return v < 0.f ? m : r;
}
DI void phase_peer_out_rows(const Params& p, LAS char* smem) {
    const int* EIDX = (const int*)(p.ws + OFF_EIDX); const float* GATE = (const float*)(p.ws + OFF_GATE);
    const char* U8 = p.ws + OFF_U8; const char* V8 = p.ws + OFF_V8;
    const float* SU = (const float*)(p.ws + OFF_SU); const float* SV = (const float*)(p.ws + OFF_SV);
    const int wave = threadIdx.x >> 6, lane = threadIdx.x & 63, r = lane >> 4, l16 = lane & 15;
    LAS int* cnt = (LAS int*)(smem + wave * RW_WAVE_LDS) + r * (RW_NB + 16);
    LAS int* list_e = (LAS int*)(smem + wave * RW_WAVE_LDS + 4 * (RW_NB + 16) * 4) + r * 128;
    LAS float* list_g = (LAS float*)(smem + wave * RW_WAVE_LDS + 4 * (RW_NB + 16) * 4 + 2048) + r * 128;
    for (int grp = blockIdx.x * NWAVES + wave; grp < NF / 4; grp += gridDim.x * NWAVES) {
        const int n = grp * 4 + r;
        float acc[64]; int hq[16]; float hscale;
        const float* hrow = p.out + (size_t)n * DM + l16 * 16;
        {
            float hn[64];
            float ss = 0.f;
#pragma unroll
            for (int j = 0; j < 4; ++j)
#pragma unroll
                for (int q = 0; q < 4; ++q) { const float4 a = *(const float4*)(hrow + j * 256 + q * 4); hn[j * 16 + q * 4] = a.x; hn[j * 16 + q * 4 + 1] = a.y; hn[j * 16 + q * 4 + 2] = a.z; hn[j * 16 + q * 4 + 3] = a.w; }
#pragma unroll
            for (int i = 0; i < 64; ++i) ss += hn[i] * hn[i];
            ss = dpp_row_sum(ss);
            const float rstd = rsqrtf(ss * (1.f / DM) + 1e-6f);
#pragma unroll
            for (int j = 0; j < 4; ++j)
#pragma unroll
                for (int q = 0; q < 4; ++q) {
                    const float4 a = *(const float4*)(p.norm_ffn + j * 256 + l16 * 16 + q * 4);
                    hn[j * 16 + q * 4] *= rstd * a.x; hn[j * 16 + q * 4 + 1] *= rstd * a.y; hn[j * 16 + q * 4 + 2] *= rstd * a.z; hn[j * 16 + q * 4 + 3] *= rstd * a.w;
                }
            float hm = 0.f;
#pragma unroll
            for (int i = 0; i < 64; ++i) hm = fmaxf(hm, fabsf(hn[i]));
            hm = fmaxf(hm, __int_as_float(__builtin_amdgcn_update_dpp(0, __float_as_int(hm), 0xB1, 0xF, 0xF, true)));
            hm = fmaxf(hm, __int_as_float(__builtin_amdgcn_update_dpp(0, __float_as_int(hm), 0x4E, 0xF, 0xF, true)));
            hm = fmaxf(hm, __int_as_float(__builtin_amdgcn_update_dpp(0, __float_as_int(hm), 0x141, 0xF, 0xF, true)));
            hm = fmaxf(hm, __int_as_float(__builtin_amdgcn_update_dpp(0, __float_as_int(hm), 0x140, 0xF, 0xF, true)));
            const float hinv = hm > 0.f ? 127.f / hm : 0.f; hscale = hm * (1.f / 127.f);
#pragma unroll
            for (int w = 0; w < 16; ++w) {
                unsigned pk = 0u;
#pragma unroll
                for (int b = 0; b < 4; ++b) { const int q = (int)rintf(hn[w * 4 + b] * hinv); pk |= ((unsigned)q & 0xffu) << (8 * b); }
                hq[w] = (int)pk;
            }
#pragma unroll
            for (int i = 0; i < 64; ++i) acc[i] = 0.f;
        }
#pragma unroll
        for (int q = 0; q < RW_NB / 16; ++q) cnt[q * 16 + l16] = 0;
        lds_fence();
        {
            int ek[8], rk[8]; float gk[8];
#pragma unroll
            for (int k = 0; k < 8; ++k) { ek[k] = EIDX[(size_t)n * 128 + k * 16 + l16]; gk[k] = GATE[(size_t)n * 128 + k * 16 + l16]; }
#pragma unroll
            for (int k = 0; k < 8; ++k) rk[k] = __hip_atomic_fetch_add(&cnt[ek[k] >> RW_SH], 1, __ATOMIC_RELAXED, __HIP_MEMORY_SCOPE_WORKGROUP);
            lds_fence();
            {
                constexpr int PB = RW_NB / 16;
                int c[PB], tot = 0;
#pragma unroll
                for (int q = 0; q < PB; ++q) { c[q] = cnt[l16 * PB + q]; tot += c[q]; }
                cnt[RW_NB + l16] = tot;
                lds_fence();
                int base = 0;
#pragma unroll
                for (int q = 0; q < 16; ++q) { const int v = cnt[RW_NB + q]; base += (q < l16) ? v : 0; }
#pragma unroll
                for (int q = 0; q < PB; ++q) { cnt[l16 * PB + q] = base; base += c[q]; }
            }
            lds_fence();
#pragma unroll
            for (int k = 0; k < 8; ++k) { const int pos = cnt[ek[k] >> RW_SH] + rk[k]; list_e[pos] = ek[k]; list_g[pos] = gk[k]; }
        }
        lds_fence();
        {
            u32x4 ub[4], vb[4]; float g_c, su_c, sv_c, g_n = 0.f, su_n = 0.f, sv_n = 0.f;
            {
                const int e_ = list_e[0]; g_c = list_g[0]; su_c = SU[e_]; sv_c = SV[e_];
#pragma unroll
                for (int j = 0; j < 4; ++j) { ub[j] = *(const u32x4*)(U8 + (size_t)e_ * DM + l16 * 16 + j * 256); vb[j] = *(const u32x4*)(V8 + (size_t)e_ * DM + l16 * 16 + j * 256); }
            }
#pragma unroll 1
            for (int sl = 0; sl < 128; ++sl) {
                int isum = 0;
#pragma unroll
                for (int j = 0; j < 4; ++j)
#pragma unroll
                    for (int w = 0; w < 4; ++w) isum = __builtin_amdgcn_sdot4((int)ub[j][w], hq[j * 4 + w], isum, false);
                isum += __builtin_amdgcn_update_dpp(0, isum, 0xB1, 0xF, 0xF, true);
                isum += __builtin_amdgcn_update_dpp(0, isum, 0x4E, 0xF, 0xF, true);
                isum += __builtin_amdgcn_update_dpp(0, isum, 0x141, 0xF, 0xF, true);
                isum += __builtin_amdgcn_update_dpp(0, isum, 0x140, 0xF, 0xF, true);
                float t_ = (float)isum * hscale;
                const int sn = sl + 1 < 128 ? sl + 1 : 127;
                const int e_n = list_e[sn];
                {
                    const char* up_ = U8 + (size_t)e_n * DM + l16 * 16;
#pragma unroll
                    for (int j = 0; j < 4; ++j) ub[j] = *(const u32x4*)(up_ + j * 256);
                    g_n = list_g[sn]; su_n = SU[e_n]; sv_n = SV[e_n];
                }
                t_ *= su_c;
                const float coef_ = gelu_as(t_) * g_c * sv_c;
#pragma unroll
                for (int j = 0; j < 4; ++j) { float v[16]; unpack16_fp8(vb[j], v);
#pragma unroll
                    for (int i = 0; i < 16; ++i) acc[j * 16 + i] += coef_ * v[i]; }
                {
                    const char* vp_ = V8 + (size_t)e_n * DM + l16 * 16;
#pragma unroll
                    for (int j = 0; j < 4; ++j) vb[j] = *(const u32x4*)(vp_ + j * 256);
                }
                g_c = g_n; su_c = su_n; sv_c = sv_n;
            }
        }
        {
            float* orow = p.out + (size_t)n * DM + l16 * 16;
            float s2 = 0.f;
#pragma unroll
            for (int j = 0; j < 4; ++j)
#pragma unroll
                for (int q = 0; q < 4; ++q) { const float4 a = *(const float4*)(orow + j * 256 + q * 4); acc[j * 16 + q * 4] += a.x; acc[j * 16 + q * 4 + 1] += a.y; acc[j * 16 + q * 4 + 2] += a.z; acc[j * 16 + q * 4 + 3] += a.w; }
#pragma unroll
            for (int i = 0; i < 64; ++i) s2 += acc[i] * acc[i];
            s2 = dpp_row_sum(s2);
            float r2 = rsqrtf(s2 * (1.f / DM) + 1e-6f);
#if TP_SEC
            r2 *= 1.f + 0.5f * ((const float*)(p.ws + OFF_BAR))[3602];
#endif
#if defined(DSA_CHECK) || defined(PROJ_CHECK)
            { const float num = ((const float*)(p.ws + OFF_BAR))[3600], den = ((const float*)(p.ws + OFF_BAR))[3601]; r2 *= 1.f + CHK_GAIN * sqrtf(num / fmaxf(den, 1e-30f)); }
#endif
#pragma unroll
            for (int j = 0; j < 4; ++j)
#pragma unroll
                for (int q = 0; q < 4; ++q) {
                    const float4 a = *(const float4*)(p.norm_final + j * 256 + l16 * 16 + q * 4);
                    *(float4*)(orow + j * 256 + q * 4) = make_float4(acc[j * 16 + q * 4] * r2 * a.x, acc[j * 16 + q * 4 + 1] * r2 * a.y, acc[j * 16 + q * 4 + 2] * r2 * a.z, acc[j * 16 + q * 4 + 3] * r2 * a.w);
                }
        }
        lds_fence();
    }
}

DI Params load_params() {
#if defined(__HIP_DEVICE_COMPILE__)
    typedef const __attribute__((address_space(4))) unsigned long long* cu64_t;
    cu64_t pp = (cu64_t)__builtin_amdgcn_kernarg_segment_ptr();
    asm volatile("" : "+s"(pp));
    static_assert(sizeof(Params) == 16 * 8, "Params is 16 qwords");
    unsigned long long w[16];
#pragma unroll
    for (int i = 0; i < 16; ++i) w[i] = pp[i];
#define GPTR(T, v) ((T*)(__attribute__((address_space(1))) T*)(v))
    Params r;
    r.x = GPTR(const float, w[0]); r.meta = GPTR(const float, w[1]); r.norm_mix = GPTR(const float, w[2]); r.w_in = GPTR(const float, w[3]);
    r.w_uv = GPTR(const float, w[4]); r.w_out = GPTR(const float, w[5]); r.norm_ffn = GPTR(const float, w[6]); r.wq = GPTR(const float, w[7]);
    r.sk = GPTR(const float, w[8]); r.pu = GPTR(const float, w[9]); r.pv = GPTR(const float, w[10]); r.norm_final = GPTR(const float, w[11]);
    r.out = GPTR(float, w[12]); r.ws = GPTR(char, w[13]);
    r.lo = (int)(unsigned)w[14]; r.hi = (int)(unsigned)(w[14] >> 32); r.pad0 = 0; r.pad1 = 0;
    return r;
#else
    return Params{};
#endif
}
#ifdef PROJ_CHECK
struct EpiProjRaw {
    bf16_t* P; int row_limit;
    DI void operator()(const f32x4 (&acc)[2][2][4][2], int brow, int bcol, int wr, int wc, int fr, int fq) const {
#pragma unroll
        for (int ai = 0; ai < 2; ++ai)
#pragma unroll
        for (int m = 0; m < 4; ++m) {
            const int row = brow + ai * HALF + wr * 64 + m * 16 + fr;
            if (row >= row_limit) continue;
#pragma unroll
            for (int bj = 0; bj < 2; ++bj)
#pragma unroll
            for (int n = 0; n < 2; ++n) {
                const int c = proj_true_col(bcol + bj * HALF + wc * 32 + n * 16 + fq * 4);
                if (c < INW) { uint2 w; w.x = pk2bf(acc[ai][bj][m][n][0], acc[ai][bj][m][n][1]); w.y = pk2bf(acc[ai][bj][m][n][2], acc[ai][bj][m][n][3]); *(uint2*)(P + (size_t)row * INW + c) = w; }
            }
        }
    }
};
#endif
#ifdef PROJ_CHECK
constexpr int PCH_ROWS = 2048;
DI void phase_proj_ref_naive(const Params& p) {
    const bf16_t* hn = (const bf16_t*)(p.ws + OFF_HN); bf16_t* ref = (bf16_t*)(p.ws + OFF_ST);
    const int gtid = blockIdx.x * NTHREADS + threadIdx.x, gsz = gridDim.x * NTHREADS;
    for (int idx = gtid; idx < (PCH_ROWS / 8) * INW; idx += gsz) {
        const int c = idx % INW, r0 = (idx / INW) * 8;
        float acc[8];
#pragma unroll
        for (int i = 0; i < 8; ++i) acc[i] = 0.f;
        for (int k = 0; k < 1024; ++k) {
            const float w = bf2f(f2bf(p.w_in[(size_t)k * INW + c]));
#pragma unroll
            for (int i = 0; i < 8; ++i) acc[i] += bf2f(hn[(size_t)(r0 + i) * DM + k]) * w;
        }
#pragma unroll
        for (int i = 0; i < 8; ++i) ref[(size_t)(r0 + i) * INW + c] = f2bf(acc[i]);
    }
}
DI void phase_proj_compare(const Params& p) {
    const bf16_t* proj = (const bf16_t*)(p.ws + OFF_BIG); const bf16_t* ref = (const bf16_t*)(p.ws + OFF_ST); const bf16_t* dvt = (const bf16_t*)(p.ws + OFF_DVT);
    const int gtid = blockIdx.x * NTHREADS + threadIdx.x, gsz = gridDim.x * NTHREADS;
    float num = 0.f, den = 0.f;
    for (int idx = gtid; idx < PCH_ROWS * INW; idx += gsz) { const float a = bf2f(proj[idx]), r = bf2f(ref[idx]); num += (a - r) * (a - r); den += r * r; }
    for (int idx = gtid; idx < PCH_ROWS * 128; idx += gsz) {
        const int row = idx >> 7, dv = idx & 127, b = row / TT, t = row - b * TT;
        const float a = bf2f(dvt[(size_t)(b * 128 + dv) * TTP + t]), r = bf2f(ref[(size_t)row * INW + C_DV + dv]); num += (a - r) * (a - r); den += r * r;
    }
    num = wave_sum(num); den = wave_sum(den);
    if ((threadIdx.x & 63) == 0) { atomicAdd((float*)(p.ws + OFF_BAR) + 3600, num); atomicAdd((float*)(p.ws + OFF_BAR) + 3601, den); }
}
#endif
constexpr int NPHASES = 10;
__global__ void __launch_bounds__(NTHREADS, 2) mk_forward(Params p) {
    extern __shared__ __attribute__((aligned(16))) char dyn_smem[];
    LAS char* smem = (LAS char*)dyn_smem;
    const bool multi = (p.hi - p.lo) > 1;
    LAS char* tp_smem = smem;
    if (TP_SEC && blockIdx.x == 0 && threadIdx.x == 0) { volatile LAS long long* tp_ = (volatile LAS long long*)(smem + TP_LDS_OFF); tp_[0] = (long long)__builtin_readcyclecounter(); tp_[2] = 0; }
    XcdBarrier bar; bar.bar = (unsigned*)(p.ws + OFF_BAR); bar.x = 0; bar.st = (volatile LAS unsigned*)(smem + LDS_BAR_OFF);
    if (multi) {
        if (threadIdx.x == 0) { const u32x4 z = {0u, 0u, 0u, 0u}; *(LAS u32x4*)(smem + LDS_BAR_OFF) = z; }
        __syncthreads();
        bar = xcd_barrier_post((unsigned*)(p.ws + OFF_BAR), (volatile LAS unsigned*)(smem + LDS_BAR_OFF));
    }
#ifndef PHMASK
#define PHMASK 0xFFFF
#endif
#define PH_ON(i) (((PHMASK >> (i)) & 1) && p.lo <= (i) && (i) < p.hi)
#define PH_SYNC(i) do { if (multi && (i) + 1 < p.hi) { TP_BEGIN(7); xcd_barrier(bar); TP_END(7); } } while (0)
#ifndef REPEAT_MASK
#define REPEAT_MASK 0
#endif
#define PH_REP(i) for (int rep_ = 0; rep_ < 1 + ((REPEAT_MASK >> (i)) & 1); ++rep_)
    if (PH_ON(0)) { const Params q = load_params(); TP_BEGIN(8); PH_REP(0) phase_prologue(q); TP_END(8); PH_SYNC(0); }
    if (PH_ON(1)) { const Params q = load_params(); TP_BEGIN(9); PH_REP(1) { EpiProjRope e; e.P = (bf16_t*)(q.ws + OFF_BIG); e.DVTp = (bf16_t*)(q.ws + OFF_DVT); e.c128 = (const float*)(q.ws + OFF_COS128); e.s128 = (const float*)(q.ws + OFF_SIN128); e.c64 = (const float*)(q.ws + OFF_COS64); e.s64 = (const float*)(q.ws + OFF_SIN64); e.raw = 0; e.row_limit = MPAD; gemm256<true>((const bf16_t*)(q.ws + OFF_HN), (const bf16_t*)(q.ws + OFF_WINT), 1024, MPAD / 256, 4096 / 256, (LAS bf16_t*)smem, e); } TP_END(9); PH_SYNC(1); }
#ifdef ROPE_SEPARATE
    if (PH_ON(2)) { const Params q = load_params(); TP_BEGIN(5); phase_rope(q, smem, (bf16_t*)(q.ws + OFF_BIG), MROWS, true); TP_END(5); PH_SYNC(2); }
#endif
#ifdef PROJ_CHECK
    {   const Params q = load_params();
        phase_proj_ref_naive(q);
        xcd_barrier(bar);
        phase_rope(q, smem, (bf16_t*)(q.ws + OFF_ST), PCH_ROWS, false);
        xcd_barrier(bar);
        phase_proj_compare(q);
        xcd_barrier(bar);
    }
#endif
    if (PH_ON(3)) { const Params q = load_params(); PH_REP(3) {
#ifndef RS_REP
#define RS_REP 1
#endif
#ifndef DSA_REP
#define DSA_REP 1
#endif
            for (int rr_ = 0; rr_ < RS_REP; ++rr_) phase_ret_state_mfma(q, smem);
#ifdef PROJ_CHECK
            {
                bf16_t* mixed_ = (bf16_t*)(q.ws + OFF_HN);
                for (int idx = blockIdx.x * NTHREADS + threadIdx.x; idx < NF * 64; idx += gridDim.x * NTHREADS) { const int row = idx >> 6, c8 = idx & 63; const u32x4 z = {0u, 0u, 0u, 0u}; *(u32x4*)(mixed_ + (size_t)row * DM + 512 + c8 * 8) = z; }
            }
#else
            for (int rr_ = 0; rr_ < DSA_REP; ++rr_) { phase_dsa_fast(q, smem); __syncthreads(); }
#endif
#ifdef DSA_CHECK
            __syncthreads(); xcd_barrier(bar); phase_dsa_naive<true>(q, smem);
#endif
        } PH_SYNC(3); }
    if (PH_ON(4)) { const Params q = load_params(); TP_BEGIN(6); phase_ret_scan(q); TP_END(6); PH_SYNC(4); }
    if (PH_ON(5)) { const Params q = load_params(); PH_REP(5) phase_ret_out_mfma(q, smem); PH_SYNC(5); }
    if (PH_ON(6)) { const Params q = load_params(); PH_REP(6) {
#ifdef PROJ_CHECK
        EpiOut e; e.H = q.out; e.X = q.x; gemm256<false>(
#else
        EpiOutT e; e.H = q.out; e.X = q.x; gemm256<true>(
#endif
        (const bf16_t*)(q.ws + OFF_HN), (const bf16_t*)(q.ws + OFF_WOUTT), 1024, NF / 256, 1024 / 256, (LAS bf16_t*)smem, e); } phase_convert_tables(q); PH_SYNC(6); }
    if (PH_ON(7)) { const Params q = load_params(); PH_REP(7) phase_norm2(q); PH_SYNC(7); }
    if (PH_ON(8)) { const Params q = load_params(); PH_REP(8) { EpiPQ e; e.Q = (float*)(q.ws + OFF_BIG); gemm256<false>((const bf16_t*)(q.ws + OFF_HN), (const bf16_t*)(q.ws + OFF_WQT), 1024, NF / 256, 2048 / 256, (LAS bf16_t*)smem, e); } PH_SYNC(8); }
    if (PH_ON(9)) { const Params q = load_params(); PH_REP(9) { phase_peer_select(q, smem); }
        if (TP_SEC && blockIdx.x == 0 && threadIdx.x == 0) { volatile LAS long long* tp_ = (volatile LAS long long*)(smem + TP_LDS_OFF); const float fr = (float)tp_[2] / (float)((long long)__builtin_readcyclecounter() - tp_[0]); ((float*)(p.ws + OFF_BAR))[3602] = fr; }
        asm volatile("s_waitcnt vmcnt(0)" ::: "memory"); __syncthreads(); }
#ifdef P10_OLD
    if (PH_ON(10)) { const Params q = load_params(); phase_peer_out(q); }
#else
    if (PH_ON(10)) { const Params q = load_params(); phase_peer_out_rows(q, smem); }
#endif
}

extern "C" void kernel_launch(void* const* d_in, const int* in_sizes, int n_in, void* d_out, int out_size, void* d_ws, size_t ws_size, hipStream_t stream) {
    static int grid = 0;
    if (grid == 0) {
        if (n_in != 12 || out_size != NF * DM || ws_size < WS_END) { fprintf(stderr, "kernel_launch: unexpected shapes (n_in %d out %d ws %zu need %zu)\n", n_in, out_size, ws_size, (size_t)WS_END); grid = -1; return; }
        int dev = 0, cus = 0, per_cu = 0;
        if (hipGetDevice(&dev) != hipSuccess || hipDeviceGetAttribute(&cus, hipDeviceAttributeMultiprocessorCount, dev) != hipSuccess) { grid = -1; return; }
        if (hipFuncSetAttribute((const void*)mk_forward, hipFuncAttributeMaxDynamicSharedMemorySize, LDS_BYTES) != hipSuccess) { fprintf(stderr, "kernel_launch: hipFuncSetAttribute failed\n"); grid = -1; return; }
        if (hipOccupancyMaxActiveBlocksPerMultiprocessor(&per_cu, (const void*)mk_forward, NTHREADS, LDS_BYTES) != hipSuccess || per_cu < 1)
            fprintf(stderr, "kernel_launch: occupancy query reports %d blocks per CU\n", per_cu);
        (void)hipGetLastError();
        grid = cus > 0 ? cus : 256;
    }
    if (grid < 0) return;
    Params p{};
    p.x = (const float*)d_in[0]; p.meta = (const float*)d_in[1]; p.norm_mix = (const float*)d_in[2]; p.w_in = (const float*)d_in[3];
    p.w_uv = (const float*)d_in[4]; p.w_out = (const float*)d_in[5]; p.norm_ffn = (const float*)d_in[6]; p.wq = (const float*)d_in[7];
    p.sk = (const float*)d_in[8]; p.pu = (const float*)d_in[9]; p.pv = (const float*)d_in[10]; p.norm_final = (const float*)d_in[11];
    p.out = (float*)d_out; p.ws = (char*)d_ws; p.pad0 = 0; p.pad1 = 0;
    (void)hipMemsetAsync((char*)d_ws + OFF_BAR, 0, 16384, stream);
#if MK_LAUNCHES == 1
    p.lo = 0; p.hi = NPHASES + 1;
    hipLaunchKernelGGL(mk_forward, dim3(grid), dim3(NTHREADS), LDS_BYTES, stream, p);
#else
    for (int ph = 0; ph <= NPHASES; ++ph) { p.lo = ph; p.hi = ph + 1; hipLaunchKernelGGL(mk_forward, dim3(grid), dim3(NTHREADS), LDS_BYTES, stream, p); }
#endif
}
```

```cpp
#include <hip/hip_runtime.h>
#include <stdint.h>
#include <stdio.h>

#ifndef MK_LAUNCHES
#define MK_LAUNCHES 1
#endif

#define DI __device__ __forceinline__
#ifndef TP_SEC
#define TP_SEC 0
#endif
#ifndef CHK_GAIN
#define CHK_GAIN 10.f
#endif
#define TP_LDS_OFF (163840 - 128)
#define TP_BEGIN(k) do { if (TP_SEC == (k) && blockIdx.x == 0 && threadIdx.x == 0) { *(volatile __attribute__((address_space(3))) long long*)(tp_smem + TP_LDS_OFF + 8) = (long long)__builtin_readcyclecounter(); } } while (0)
#define TP_END(k) do { if (TP_SEC == (k) && blockIdx.x == 0 && threadIdx.x == 0) { volatile __attribute__((address_space(3))) long long* tp_ = (volatile __attribute__((address_space(3))) long long*)(tp_smem + TP_LDS_OFF); tp_[2] += (long long)__builtin_readcyclecounter() - tp_[1]; } } while (0)
typedef unsigned short bf16_t;
typedef short bf16x8 __attribute__((ext_vector_type(8)));
typedef float f32x4 __attribute__((ext_vector_type(4)));
typedef unsigned u32x4 __attribute__((ext_vector_type(4)));

constexpr int NB = 8, SEQ = 2048, NMETA = 16, TT = 2064, DM = 1024, INW = 3912;
constexpr int MROWS = NB * TT;
constexpr int MPAD = 16640;
constexpr int NF = NB * SEQ;
constexpr int C_RQ = 0, C_RK = 512, C_RV = 1024, C_RG = 1536, C_DQ = 2048, C_DK = 3072, C_DV = 3200, C_IQ = 3328, C_IK = 3840, C_IW = 3904;
constexpr int NTHREADS = 512, NWAVES = 8;
constexpr int LDS_BYTES = 163840;
constexpr int LDS_BAR_OFF = 163840 - 256;

constexpr size_t al256(size_t x) { return (x + 255) & ~(size_t)255; }
constexpr size_t OFF_BAR = 0;
constexpr size_t OFF_COS128 = 16384;
constexpr size_t OFF_SIN128 = OFF_COS128 + al256((size_t)TT * 64 * 4);
constexpr size_t OFF_COS64 = OFF_SIN128 + al256((size_t)TT * 64 * 4);
constexpr size_t OFF_SIN64 = OFF_COS64 + al256((size_t)TT * 32 * 4);
constexpr size_t OFF_WINT = OFF_SIN64 + al256((size_t)TT * 32 * 4);
constexpr size_t OFF_WOUTT = OFF_WINT + (size_t)4096 * 1024 * 2;
constexpr size_t OFF_WQT = OFF_WOUTT + (size_t)1024 * 1024 * 2;
constexpr size_t OFF_SKH = OFF_WQT + (size_t)2048 * 1024 * 2;
constexpr size_t OFF_SKL = OFF_SKH + (size_t)2048 * 128 * 2;
constexpr int TTP = 2176;
constexpr size_t OFF_WUVT = OFF_SKL + (size_t)2048 * 128 * 2;
constexpr size_t OFF_DVT = OFF_WUVT + (size_t)8 * 64 * 128 * 2;
constexpr size_t OFF_HN = OFF_DVT + (size_t)NB * 128 * TTP * 2;
constexpr size_t OFF_BIG = OFF_HN + (size_t)MPAD * 1024 * 2;
constexpr size_t BIG_BYTES = (size_t)NF * 2048 * 4;
constexpr size_t OFF_ST = OFF_BIG + al256(BIG_BYTES);
constexpr size_t ST_BYTES = (size_t)32 * 34 * 16384 * 4;
constexpr size_t OFF_EG = OFF_ST;
constexpr size_t OFF_U8 = OFF_EG + (size_t)NF * 128 * 4;
constexpr size_t OFF_SU = OFF_U8 + (size_t)16384 * 1024;
constexpr size_t OFF_V8 = OFF_SU + 65536;
constexpr size_t OFF_SV = OFF_V8 + (size_t)16384 * 1024;
constexpr size_t OFF_HG = OFF_SV + 65536;
constexpr size_t OFF_SSQ = OFF_HG + (size_t)NF * 1024 * 2;
constexpr size_t WS_END = OFF_SSQ + (size_t)NF * 4;
static_assert(OFF_ST + ST_BYTES <= WS_END, "retention states fit");
static_assert(WS_END <= (size_t)268435456, "workspace");

struct Params {
    const float *x, *meta, *norm_mix, *w_in, *w_uv, *w_out, *norm_ffn, *wq, *sk, *pu, *pv, *norm_final;
    float* out; char* ws; int lo, hi, pad0, pad1;
};

DI float bf2f(bf16_t v) { return __uint_as_float(((unsigned)v) << 16); }
typedef float f32x2_t __attribute__((ext_vector_type(2)));
typedef __bf16 bf16x2_t __attribute__((ext_vector_type(2)));
DI bf16_t f2bf(float f) { const __bf16 h = (__bf16)f; return __builtin_bit_cast(unsigned short, h); }
DI unsigned pk2bf(float a, float b) { const f32x2_t v = {a, b}; const bf16x2_t h = __builtin_convertvector(v, bf16x2_t); return __builtin_bit_cast(unsigned, h); }
DI float wave_sum(float v) {
#pragma unroll
    for (int o = 32; o > 0; o >>= 1) v += __shfl_xor(v, o);
    return v;
}
DI float wave_max(float v) {
#pragma unroll
    for (int o = 32; o > 0; o >>= 1) v = fmaxf(v, __shfl_xor(v, o));
    return v;
}
DI unsigned long long wave_max_u64(unsigned long long v) {
#pragma unroll
    for (int o = 32; o > 0; o >>= 1) {
        const unsigned hi = __shfl_xor((unsigned)(v >> 32), o), lo = __shfl_xor((unsigned)v, o);
        const unsigned long long w = ((unsigned long long)hi << 32) | lo;
        v = w > v ? w : v;
    }
    return v;
}
DI unsigned fkey(float x) { const unsigned u = __float_as_uint(x); return (u & 0x80000000u) ? ~u : (u | 0x80000000u); }
DI float funkey(unsigned k) { const unsigned u = (k & 0x80000000u) ? (k & 0x7fffffffu) : ~k; return __uint_as_float(u); }
DI void lds_fence() { asm volatile("s_waitcnt lgkmcnt(0)" ::: "memory"); }
DI void unpack8(const u32x4& r, float (&v)[8]) {
    v[0] = __uint_as_float(r.x << 16); v[1] = __uint_as_float(r.x & 0xffff0000u);
    v[2] = __uint_as_float(r.y << 16); v[3] = __uint_as_float(r.y & 0xffff0000u);
    v[4] = __uint_as_float(r.z << 16); v[5] = __uint_as_float(r.z & 0xffff0000u);
    v[6] = __uint_as_float(r.w << 16); v[7] = __uint_as_float(r.w & 0xffff0000u);
}

typedef float f32x16 __attribute__((ext_vector_type(16)));
DI bf16x8 pack8(const float (&x)[8]) {
    u32x4 r;
#pragma unroll
    for (int j = 0; j < 4; ++j) r[j] = pk2bf(x[2 * j], x[2 * j + 1]);
    return __builtin_bit_cast(bf16x8, r);
}
DI bf16x8 pack_hi8(const float (&x)[8], float (&rem)[8]) {
    u32x4 r;
#pragma unroll
    for (int j = 0; j < 4; ++j) { r[j] = pk2bf(x[2 * j], x[2 * j + 1]); rem[2 * j] = x[2 * j] - __uint_as_float(r[j] << 16); rem[2 * j + 1] = x[2 * j + 1] - __uint_as_float(r[j] & 0xffff0000u); }
    return __builtin_bit_cast(bf16x8, r);
}

DI float dpp_row_sum(float v) {
    v += __int_as_float(__builtin_amdgcn_update_dpp(0, __float_as_int(v), 0xB1, 0xF, 0xF, true));
    v += __int_as_float(__builtin_amdgcn_update_dpp(0, __float_as_int(v), 0x4E, 0xF, 0xF, true));
    v += __int_as_float(__builtin_amdgcn_update_dpp(0, __float_as_int(v), 0x141, 0xF, 0xF, true));
    v += __int_as_float(__builtin_amdgcn_update_dpp(0, __float_as_int(v), 0x140, 0xF, 0xF, true));
    return v;
}
DI float wave_sum_uniform(float v) {
    v = dpp_row_sum(v);
    const float a = __int_as_float(__builtin_amdgcn_readlane(__float_as_int(v), 0)), b = __int_as_float(__builtin_amdgcn_readlane(__float_as_int(v), 16));
    const float c = __int_as_float(__builtin_amdgcn_readlane(__float_as_int(v), 32)), d = __int_as_float(__builtin_amdgcn_readlane(__float_as_int(v), 48));
    return (a + b) + (c + d);
}

DI int wave_sum_int(int v) {
    v += __builtin_amdgcn_update_dpp(0, v, 0xB1, 0xF, 0xF, true);
    v += __builtin_amdgcn_update_dpp(0, v, 0x4E, 0xF, 0xF, true);
    v += __builtin_amdgcn_update_dpp(0, v, 0x141, 0xF, 0xF, true);
    v += __builtin_amdgcn_update_dpp(0, v, 0x140, 0xF, 0xF, true);
    return (__builtin_amdgcn_readlane(v, 0) + __builtin_amdgcn_readlane(v, 16)) + (__builtin_amdgcn_readlane(v, 32) + __builtin_amdgcn_readlane(v, 48));
}

#define XB_TMO      128
#define XB_XCNT(j)  (256  + 64 * (j))
#define XB_XSUB(j)  (1280 + 64 * (j))
#define XB_XGEN(j)  (2304 + 64 * (j))
#define XB_TOP      3328
#define XB_TOPGEN   3392
#define XCD_BAR_WORDS 3456
#define XB_SPIN_CAP (1u << 20)
#define LAS __attribute__((address_space(3)))

DI unsigned xb_ld(unsigned* p)              { return __hip_atomic_load(p, __ATOMIC_RELAXED, __HIP_MEMORY_SCOPE_AGENT); }
DI unsigned xb_add(unsigned* p, unsigned v) { return __hip_atomic_fetch_add(p, v, __ATOMIC_RELAXED, __HIP_MEMORY_SCOPE_AGENT); }
DI unsigned xb_xcc_id() { return (unsigned)__builtin_amdgcn_s_getreg((3 << 11) | 20) & 0xFu; }
#define XB_SPIN(cond, bar) do { unsigned _sp = 0; while (cond) { __builtin_amdgcn_s_sleep(1); \
    if ((++_sp & 255u) == 0u) { if (xb_ld(&(bar)[XB_TMO])) break; if (_sp > XB_SPIN_CAP) { atomicAdd(&(bar)[XB_TMO], 1u); break; } } } } while (0)

struct XcdBarrier { unsigned* bar; unsigned x; volatile LAS unsigned* st; };

DI XcdBarrier xcd_barrier_post(unsigned* bar, volatile LAS unsigned* st) {
    XcdBarrier b; b.bar = bar; b.x = xb_xcc_id(); b.st = st;
    if (threadIdx.x == 0) (void)xb_add(&bar[XB_XCNT(b.x)], 1u);
    return b;
}
DI void xcd_barrier_complete(unsigned* bar, unsigned x, unsigned& nloc, unsigned& nx) {
    const unsigned G = gridDim.x * gridDim.y * gridDim.z;
    unsigned sum, cnt, mine, sp = 0u;
    for (;;) {
        sum = 0u; cnt = 0u; mine = 0u;
#pragma unroll
        for (unsigned j = 0; j < 16; ++j) { const unsigned c = xb_ld(&bar[XB_XCNT(j)]); sum += c; cnt += (c > 0u) ? 1u : 0u; mine = (j == x) ? c : mine; }
        if (sum == G) break;
        __builtin_amdgcn_s_sleep(1);
        if ((++sp & 255u) == 0u) { if (xb_ld(&bar[XB_TMO])) break; if (sp > XB_SPIN_CAP) { atomicAdd(&bar[XB_TMO], 1u); break; } }
    }
    nloc = mine > 0u ? mine : 1u; nx = cnt > 0u ? cnt : 1u;
}
DI void xcd_barrier(const XcdBarrier& b) {
    asm volatile("s_waitcnt vmcnt(0)" ::: "memory");
    __syncthreads();
    if (threadIdx.x == 0) {
        unsigned* bar = b.bar;
        __builtin_amdgcn_s_waitcnt(0);
        unsigned nloc = b.st[0], nx = b.st[1];
        if (nloc == 0u) { xcd_barrier_complete(bar, b.x, nloc, nx); b.st[0] = nloc; b.st[1] = nx; }
        const unsigned old = xb_add(&bar[XB_XSUB(b.x)], 1u);
        const unsigned gen = old / nloc;
        if (old + 1u == (gen + 1u) * nloc) {
            __builtin_amdgcn_fence(__ATOMIC_RELEASE, "agent");
            asm volatile("s_waitcnt vmcnt(0)" ::: "memory");
            const unsigned og = xb_add(&bar[XB_TOP], 1u);
            const unsigned tg = og / nx;
            if (og + 1u == (tg + 1u) * nx) xb_add(&bar[XB_TOPGEN], 1u);
            else XB_SPIN(xb_ld(&bar[XB_TOPGEN]) == tg, bar);
            __builtin_amdgcn_fence(__ATOMIC_ACQUIRE, "agent");
            xb_add(&bar[XB_XGEN(b.x)], 1u);
            asm volatile("s_waitcnt vmcnt(0)" ::: "memory");
        } else {
            XB_SPIN(xb_ld(&bar[XB_XGEN(b.x)]) == gen, bar);
            __builtin_amdgcn_fence(__ATOMIC_ACQUIRE, "agent");
            asm volatile("s_waitcnt vmcnt(0)" ::: "memory");
        }
    }
    __syncthreads();
}

constexpr int BM = 256, BK = 64, HALF = 128, NXCD = 8, WGM = 8, HT = HALF * BK;
DI int lds_byte(int r, int c) {
    int st = (r >> 4) * 2 + (c >> 5), rr = r & 15, cc = c & 31, ob = rr * 64 + cc * 2;
    return st * 1024 + (ob ^ (((ob >> 9) & 1) << 5));
}
DI void stage_rc(int b, int& R, int& C) {
    int st = b / 1024, sb = b % 1024, swz = sb ^ (((sb >> 9) & 1) << 5);
    R = (st >> 1) * 16 + swz / 64; C = (st & 1) * 32 + (swz % 64) / 2;
}

#define SA(b,h) (shm+((b)*2+(h))*HT)
#define SB(b,h) (shm+(4+(b)*2+(h))*HT)
#define STAGE_X(T,P,BASE,br,kt) do{long _g=(long)(br)*K+(long)(kt)*BK; \
    for(int _i=0;_i<2;++_i){int _b=(T)*16+_i*8192;int _r,_c;stage_rc(_b,_r,_c); \
      __builtin_amdgcn_global_load_lds((const unsigned*)(BASE+_g+(long)_r*K+_c), \
        (LAS unsigned*)((LAS char*)(P)+_b),16,0,0);}}while(0)
#define STAGE(P,BASE,br,kt) STAGE_X(threadIdx.x,P,BASE,br,kt)
#define LDA(dst,b,h) for(int m=0;m<4;++m)for(int k=0;k<2;++k) \
    dst[m][k]=*reinterpret_cast<const LAS bf16x8*>((LAS char*)SA(b,h)+lds_byte(wr*64+m*16+fr,k*32+fq*8))
#define LDB(dst,b,h) for(int n=0;n<2;++n)for(int k=0;k<2;++k) \
    dst[n][k]=*reinterpret_cast<const LAS bf16x8*>((LAS char*)SB(b,h)+lds_byte(wc*32+n*16+fr,k*32+fq*8))
#define MMA(ai,bj,At,Bt_) do{__builtin_amdgcn_s_setprio(1); \
    for(int m=0;m<4;++m)for(int n=0;n<2;++n)for(int k=0;k<2;++k) \
      acc[ai][bj][m][n]=TRANS?__builtin_amdgcn_mfma_f32_16x16x32_bf16(Bt_[n][k],At[m][k],acc[ai][bj][m][n],0,0,0):__builtin_amdgcn_mfma_f32_16x16x32_bf16(At[m][k],Bt_[n][k],acc[ai][bj][m][n],0,0,0); \
    __builtin_amdgcn_s_setprio(0);}while(0)
#define WAIT_V(n) asm volatile("s_waitcnt vmcnt(" #n ")":::"memory")
#define WAIT_L(n) asm volatile("s_waitcnt lgkmcnt(" #n ")":::"memory")
#define BAR __builtin_amdgcn_s_barrier()
#define SCHED __builtin_amdgcn_sched_barrier(0)

template <bool TRANS, class Epi>
DI void gemm256(const bf16_t* __restrict__ A, const bf16_t* __restrict__ Bt, const int K, const int nM, const int nN, LAS bf16_t* shm, const Epi& epi) {
    const int nwg = nM * nN;
    for (int L = blockIdx.x; L < nwg; L += gridDim.x) {
        int wgid = L;
        { int q = nwg / NXCD, r = nwg % NXCD, xcd = wgid % NXCD, off = wgid / NXCD; wgid = (xcd < r ? xcd * (q + 1) : r * (q + 1) + (xcd - r) * q) + off; }
        int nig = WGM * nN, gid = wgid / nig, fm = gid * WGM, gsz = min(nM - fm, WGM);
        int pm = fm + ((wgid % nig) % gsz), pn = (wgid % nig) / gsz, brow = pm * BM, bcol = pn * BM;
        int wid = threadIdx.x >> 6, lane = threadIdx.x & 63, wr = wid >> 2, wc = wid & 3, fr = lane & 15, fq = lane >> 4;
        f32x4 acc[2][2][4][2] = {};
        bf16x8 At[4][2], B0[2][2], B1[2][2];
        int nt = K / BK;
        STAGE(SB(0,0),Bt,bcol,0); STAGE(SA(0,0),A,brow,0);
        STAGE(SB(0,1),Bt,bcol+HALF,0); STAGE(SA(0,1),A,brow+HALF,0);
        if (wr == 1) BAR;
        WAIT_V(4); BAR;
        STAGE(SB(1,0),Bt,bcol,1); STAGE(SA(1,0),A,brow,1); STAGE(SB(1,1),Bt,bcol+HALF,1);
        WAIT_V(6); BAR;
        for (int t = 0; t < nt - 2; t += 2) {
            LDB(B0,0,0); SCHED; LDA(At,0,0); STAGE(SA(1,1),A,brow+HALF,t+1);
            WAIT_L(8); BAR; WAIT_L(0); MMA(0,0,At,B0); BAR; SCHED;
            LDB(B1,0,1); STAGE(SB(0,0),Bt,bcol,t+2);
            BAR; WAIT_L(0); MMA(0,1,At,B1); BAR;
            LDA(At,0,1); STAGE(SA(0,0),A,brow,t+2);
            BAR; WAIT_L(0); MMA(1,0,At,B0); BAR; SCHED;
            STAGE(SB(0,1),Bt,bcol+HALF,t+2);
            WAIT_V(6); BAR; MMA(1,1,At,B1); BAR;
            LDB(B0,1,0); SCHED; LDA(At,1,0); STAGE(SA(0,1),A,brow+HALF,t+2);
            WAIT_L(8); BAR; WAIT_L(0); MMA(0,0,At,B0); BAR; SCHED;
            LDB(B1,1,1); STAGE(SB(1,0),Bt,bcol,t+3);
            BAR; WAIT_L(0); MMA(0,1,At,B1); BAR;
            LDA(At,1,1); STAGE(SA(1,0),A,brow,t+3);
            BAR; WAIT_L(0); MMA(1,0,At,B0); BAR; SCHED;
            STAGE(SB(1,1),Bt,bcol+HALF,t+3);
            WAIT_V(6); BAR; MMA(1,1,At,B1); BAR;
        }
        int tz = threadIdx.x; asm volatile("" : "+v"(tz)); wid = tz >> 6; lane = tz & 63; wr = wid >> 2; wc = wid & 3; fr = lane & 15; fq = lane >> 4;
        { LDB(B0,0,0); WAIT_V(0); LDA(At,0,0); STAGE_X(tz,SA(1,1),A,brow+HALF,nt-1);
          BAR; WAIT_L(0); MMA(0,0,At,B0); BAR;
          LDB(B1,0,1); BAR; WAIT_L(0); MMA(0,1,At,B1); BAR;
          LDA(At,0,1); WAIT_V(4); BAR; WAIT_L(0); MMA(1,0,At,B0); MMA(1,1,At,B1); BAR; }
        { LDB(B0,1,0); LDA(At,1,0); WAIT_V(2); BAR; WAIT_L(0); MMA(0,0,At,B0); BAR;
          LDB(B1,1,1); WAIT_V(0); BAR; WAIT_L(0); MMA(0,1,At,B1); BAR;
          LDA(At,1,1); BAR; WAIT_L(0); MMA(1,0,At,B0); MMA(1,1,At,B1); BAR; }
        if (wr == 0) BAR;
        epi(acc, brow, bcol, wr, wc, fr, fq);
        __syncthreads();
    }
}

struct EpiOut {
    float* H; const float* X;
    DI void operator()(const f32x4 (&acc)[2][2][4][2], int brow, int bcol, int wr, int wc, int fr, int fq) const {
#pragma unroll
        for (int ai = 0; ai < 2; ++ai)
#pragma unroll
        for (int bj = 0; bj < 2; ++bj)
#pragma unroll
        for (int m = 0; m < 4; ++m)
#pragma unroll
        for (int n = 0; n < 2; ++n)
#pragma unroll
        for (int j = 0; j < 4; ++j) {
            const int row = brow + ai * HALF + wr * 64 + m * 16 + fq * 4 + j, col = bcol + bj * HALF + wc * 32 + n * 16 + fr;
            const size_t o = (size_t)row * DM + col; H[o] = X[o] + acc[ai][bj][m][n][j];
        }
    }
};
struct EpiPQ {
    float* Q;
    DI void operator()(const f32x4 (&acc)[2][2][4][2], int brow, int bcol, int wr, int wc, int fr, int fq) const {
#pragma unroll
        for (int ai = 0; ai < 2; ++ai)
#pragma unroll
        for (int bj = 0; bj < 2; ++bj)
#pragma unroll
        for (int m = 0; m < 4; ++m)
#pragma unroll
        for (int n = 0; n < 2; ++n)
#pragma unroll
        for (int j = 0; j < 4; ++j) {
            const int row = brow + ai * HALF + wr * 64 + m * 16 + fq * 4 + j, col = bcol + bj * HALF + wc * 32 + n * 16 + fr;
            Q[(size_t)row * 2048 + col] = acc[ai][bj][m][n][j];
        }
    }
};

struct EpiOutT {
    float* H; const float* X; bf16_t* HG; const float* G; float* SSQ;
    DI void operator()(const f32x4 (&acc)[2][2][4][2], int brow, int bcol, int wr, int wc, int fr, int fq) const {
#pragma unroll
        for (int ai = 0; ai < 2; ++ai)
#pragma unroll
        for (int m = 0; m < 4; ++m) {
            const int row = brow + ai * HALF + wr * 64 + m * 16 + fr;
            const size_t o = (size_t)row * DM + bcol + wc * 32 + fq * 4;
            const float* xp = X + o; float* hp = H + o; bf16_t* gp = HG + o; const float* gn = G + bcol + wc * 32 + fq * 4;
            float ss = 0.f;
#pragma unroll
            for (int bj = 0; bj < 2; ++bj)
#pragma unroll
            for (int n = 0; n < 2; ++n) {
                const f32x4 x = *(const f32x4*)(xp + bj * HALF + n * 16); const f32x4 hv = x + acc[ai][bj][m][n];
                *(f32x4*)(hp + bj * HALF + n * 16) = hv;
                ss += hv[0] * hv[0] + hv[1] * hv[1] + hv[2] * hv[2] + hv[3] * hv[3];
                const f32x4 hg = hv * *(const f32x4*)(gn + bj * HALF + n * 16);
                uint2 w; w.x = pk2bf(hg[0], hg[1]); w.y = pk2bf(hg[2], hg[3]); *(uint2*)(gp + bj * HALF + n * 16) = w;
            }
            ss += __shfl_xor(ss, 16); ss += __shfl_xor(ss, 32);
            if (fq == 0) atomicAdd(SSQ + row, ss);
            __builtin_amdgcn_sched_barrier(0);
        }
    }
};

__host__ __device__ constexpr int proj_true_col(int n) {
    const int blk = n >> 7, P = n & 127, wc = P >> 5, nn = (P >> 4) & 1, i = P & 15;
    return blk * 128 + (blk < 26 ? wc * 16 + i + 64 * nn : (wc >> 1) * 64 + (wc & 1) * 16 + i + 32 * nn);
}
struct EpiProjRope {
    bf16_t* P; bf16_t* DVTp; const float *c128, *s128, *c64, *s64; int raw, row_limit;
    DI void operator()(const f32x4 (&acc)[2][2][4][2], int brow, int bcol, int wr, int wc, int fr, int fq) const {
#pragma unroll
        for (int ai = 0; ai < 2; ++ai)
#pragma unroll
        for (int m = 0; m < 4; ++m) {
            const int row = brow + ai * HALF + wr * 64 + m * 16 + fr;
            if (row >= row_limit) continue;
            const int b = row / TT, t = row - b * TT;
            bf16_t* rp = P + (size_t)row * INW;
#pragma unroll
            for (int bj = 0; bj < 2; ++bj) {
                const int cb = bcol + bj * HALF;
                const f32x4 x1 = acc[ai][bj][m][0], x2 = acc[ai][bj][m][1];
                f32x4 o1 = x1, o2 = x2; int c1, c2; bool st2 = true;
                if (cb < C_IQ) {
                    const int f = wc * 16 + fq * 4; c1 = cb + f; c2 = c1 + 64;
                    const bool roped = (cb < C_RV) || (cb >= C_DQ && cb < C_DV);
                    if (roped && !raw) {
                        const float sc = (cb < C_RK) ? 1.f : (cb < C_RV) ? 0.08838834764831845f : (cb < C_DK) ? 0.08838834764831845f * 1.4426950408889634f : 1.f;
                        const f32x4 cs = *(const f32x4*)(c128 + t * 64 + f), sn = *(const f32x4*)(s128 + t * 64 + f);
                        o1 = (x1 * cs - x2 * sn) * sc; o2 = (x2 * cs + x1 * sn) * sc;
                    }
                    if (cb == C_DV && row < MROWS && !raw) {
                        bf16_t* dp = DVTp + (size_t)(b * 128 + f) * TTP + t;
#pragma unroll
                        for (int j = 0; j < 4; ++j) { dp[(size_t)j * TTP] = f2bf(x1[j]); dp[(size_t)(64 + j) * TTP] = f2bf(x2[j]); }
                    }
                } else if (cb < 3968) {
                    const int hl = wc >> 1, f = (wc & 1) * 16 + fq * 4; c1 = cb + hl * 64 + f; c2 = c1 + 32;
                    if (raw) { if (hl == 1 && cb >= C_IK) { st2 = false; if (c1 >= INW) continue; } }
                    else if (cb < C_IK || hl == 0) {
                        const float sc = (cb < C_IK) ? 0.125f : 1.f;
                        const f32x4 cs = *(const f32x4*)(c64 + t * 32 + f), sn = *(const f32x4*)(s64 + t * 32 + f);
                        o1 = (x1 * cs - x2 * sn) * sc; o2 = (x2 * cs + x1 * sn) * sc;
                    } else { o1 = x1 * 0.35355339059327373f; st2 = false; if (c1 >= INW) continue; }
                } else continue;
                uint2 w1; w1.x = pk2bf(o1[0], o1[1]); w1.y = pk2bf(o1[2], o1[3]); *(uint2*)(rp + c1) = w1;
                if (st2) { uint2 w2; w2.x = pk2bf(o2[0], o2[1]); w2.y = pk2bf(o2[2], o2[3]); *(uint2*)(rp + c2) = w2; }
            }
        }
    }
};

DI void phase_prologue(const Params& p) {
    const int gtid = blockIdx.x * NTHREADS + threadIdx.x, gsz = gridDim.x * NTHREADS;
    bf16_t* wint = (bf16_t*)(p.ws + OFF_WINT);
    for (int idx = gtid; idx < 4096 * 1024; idx += gsz) {
        const int k = idx >> 12, n = idx & 4095;
        const int src = proj_true_col(n);
        const float v = src < INW ? p.w_in[(size_t)k * INW + src] : 0.f;
        wint[(size_t)n * 1024 + k] = f2bf(v);
    }
    { float* ssq = (float*)(p.ws + OFF_SSQ); for (int idx = gtid; idx < NF; idx += gsz) ssq[idx] = 0.f; }
    {
        bf16_t* dvt = (bf16_t*)(p.ws + OFF_DVT);
        for (int idx = gtid; idx < NB * 128 * (TTP - TT); idx += gsz) { const int rw = idx / (TTP - TT), t = TT + idx % (TTP - TT); dvt[(size_t)rw * TTP + t] = (bf16_t)0; }
    }
    bf16_t* woutt = (bf16_t*)(p.ws + OFF_WOUTT);
    for (int idx = gtid; idx < 1024 * 1024; idx += gsz) {
        const int k = idx >> 10, n = idx & 1023;
        woutt[(size_t)n * 1024 + k] = f2bf(p.w_out[(size_t)k * 1024 + n]);
    }
    {
        bf16_t* wst = (bf16_t*)(p.ws + OFF_WQT);
        const int wave_ = threadIdx.x >> 6, lane_ = threadIdx.x & 63, r = lane_ & 31, hh = lane_ >> 5;
        for (int task = blockIdx.x * NWAVES + wave_; task < 16 * 32; task += gridDim.x * NWAVES) {
            const int hf = task >> 5, k0 = (task & 31) * 32;
            f32x16 acc[4];
#pragma unroll
            for (int nb = 0; nb < 4; ++nb)
#pragma unroll
                for (int i = 0; i < 16; ++i) acc[nb][i] = 0.f;
            const float* arow = p.wq + (size_t)(k0 + r) * 2048 + hf * 128 + 8 * hh;
            const float* brow = p.sk + (size_t)(hf * 128 + r) * 128 + 8 * hh;
#pragma unroll 1
            for (int ks = 0; ks < 8; ++ks) {
                const float4 a0 = *(const float4*)(arow + ks * 16), a1 = *(const float4*)(arow + ks * 16 + 4);
                const float af[8] = {a0.x, a0.y, a0.z, a0.w, a1.x, a1.y, a1.z, a1.w}; float ar[8];
                const bf16x8 ah = pack_hi8(af, ar); const bf16x8 al = pack8(ar);
#pragma unroll
                for (int nb = 0; nb < 4; ++nb) {
                    const float4 b0 = *(const float4*)(brow + (size_t)nb * 32 * 128 + ks * 16), b1 = *(const float4*)(brow + (size_t)nb * 32 * 128 + ks * 16 + 4);
                    const float bf_[8] = {b0.x, b0.y, b0.z, b0.w, b1.x, b1.y, b1.z, b1.w}; float br[8];
                    const bf16x8 bh = pack_hi8(bf_, br); const bf16x8 bl = pack8(br);
                    acc[nb] = __builtin_amdgcn_mfma_f32_32x32x16_bf16(ah, bh, acc[nb], 0, 0, 0);
                    acc[nb] = __builtin_amdgcn_mfma_f32_32x32x16_bf16(ah, bl, acc[nb], 0, 0, 0);
                    acc[nb] = __builtin_amdgcn_mfma_f32_32x32x16_bf16(al, bh, acc[nb], 0, 0, 0);
                }
            }
#pragma unroll
            for (int nb = 0; nb < 4; ++nb) {
                bf16_t* orow = wst + (size_t)(hf * 128 + nb * 32 + r) * 1024 + k0 + 4 * hh;
#pragma unroll
                for (int g4 = 0; g4 < 4; ++g4) { uint2 w; w.x = pk2bf(acc[nb][4 * g4], acc[nb][4 * g4 + 1]); w.y = pk2bf(acc[nb][4 * g4 + 2], acc[nb][4 * g4 + 3]); *(uint2*)(orow + 8 * g4) = w; }
            }
        }
    }
    bf16_t* wuvt = (bf16_t*)(p.ws + OFF_WUVT);
    for (int idx = gtid; idx < 8 * 64 * 128; idx += gsz) {
        const int h = idx >> 13, e = (idx >> 7) & 63, dv = idx & 127;
        wuvt[idx] = f2bf(p.w_uv[(size_t)(h * 128 + dv) * 64 + e]);
    }
    float* c128 = (float*)(p.ws + OFF_COS128); float* s128 = (float*)(p.ws + OFF_SIN128);
    for (int idx = gtid; idx < TT * 64; idx += gsz) {
        const int pos = idx >> 6, j = idx & 63;
        const float inv = powf(10000.f, -(float)j * 2.0f / 128.f);
        const float ang = (float)pos * inv;
        float s, c; sincosf(ang, &s, &c);
        c128[idx] = c; s128[idx] = s;
    }
    float* c64 = (float*)(p.ws + OFF_COS64); float* s64 = (float*)(p.ws + OFF_SIN64);
    for (int idx = gtid; idx < TT * 32; idx += gsz) {
        const int pos = idx >> 5, j = idx & 31;
        const float inv = powf(10000.f, -(float)j * 2.0f / 64.f);
        const float ang = (float)pos * inv;
        float s, c; sincosf(ang, &s, &c);
        c64[idx] = c; s64[idx] = s;
    }
    bf16_t* hn = (bf16_t*)(p.ws + OFF_HN);
    const int wave = threadIdx.x >> 6, lane = threadIdx.x & 63;
    for (int row = blockIdx.x * NWAVES + wave; row < MPAD; row += gridDim.x * NWAVES) {
        bf16_t* o = hn + (size_t)row * DM;
        if (row >= MROWS) {
            for (int i = 0; i < 4; ++i) *(uint2*)(o + i * 256 + lane * 4) = make_uint2(0u, 0u);
            continue;
        }
        const int b = row / TT, t = row % TT;
        const float* src = t < NMETA ? p.meta + (size_t)t * DM : p.x + ((size_t)b * SEQ + (t - NMETA)) * DM;
        float4 v[4]; float ss = 0.f;
#pragma unroll
        for (int i = 0; i < 4; ++i) { v[i] = *(const float4*)(src + i * 256 + lane * 4); ss += v[i].x * v[i].x + v[i].y * v[i].y + v[i].z * v[i].z + v[i].w * v[i].w; }
        ss = wave_sum(ss);
        const float rstd = rsqrtf(ss * (1.f / DM) + 1e-6f);
#pragma unroll
        for (int i = 0; i < 4; ++i) {
            const float4 g = *(const float4*)(p.norm_mix + i * 256 + lane * 4);
            uint2 w;
            w.x = (unsigned)f2bf(v[i].x * rstd * g.x) | ((unsigned)f2bf(v[i].y * rstd * g.y) << 16);
            w.y = (unsigned)f2bf(v[i].z * rstd * g.z) | ((unsigned)f2bf(v[i].w * rstd * g.w) << 16);
            *(uint2*)(o + i * 256 + lane * 4) = w;
        }
    }
}

DI void rope8(bf16_t* p1, bf16_t* p2, const float* ct, const float* st, float scale) {
    const u32x4 r1 = *(const u32x4*)p1, r2 = *(const u32x4*)p2;
    float x1[8], x2[8]; unpack8(r1, x1); unpack8(r2, x2);
    const float4 c0 = *(const float4*)ct, c1 = *(const float4*)(ct + 4), s0 = *(const float4*)st, s1 = *(const float4*)(st + 4);
    const float cs[8] = {c0.x, c0.y, c0.z, c0.w, c1.x, c1.y, c1.z, c1.w}, sn[8] = {s0.x, s0.y, s0.z, s0.w, s1.x, s1.y, s1.z, s1.w};
    u32x4 o1, o2;
#pragma unroll
    for (int i = 0; i < 4; ++i) {
        const float a0 = (x1[2 * i] * cs[2 * i] - x2[2 * i] * sn[2 * i]) * scale, a1 = (x1[2 * i + 1] * cs[2 * i + 1] - x2[2 * i + 1] * sn[2 * i + 1]) * scale;
        const float b0 = (x2[2 * i] * cs[2 * i] + x1[2 * i] * sn[2 * i]) * scale, b1 = (x2[2 * i + 1] * cs[2 * i + 1] + x1[2 * i + 1] * sn[2 * i + 1]) * scale;
        o1[i] = (unsigned)f2bf(a0) | ((unsigned)f2bf(a1) << 16); o2[i] = (unsigned)f2bf(b0) | ((unsigned)f2bf(b1) << 16);
    }
    *(u32x4*)p1 = o1; *(u32x4*)p2 = o2;
}
DI void phase_rope(const Params& p, LAS char* smem, bf16_t* proj, const int nrows, const bool do_dvt) {
    const float* c128 = (const float*)(p.ws + OFF_COS128); const float* s128 = (const float*)(p.ws + OFF_SIN128);
    const float* c64 = (const float*)(p.ws + OFF_COS64); const float* s64 = (const float*)(p.ws + OFF_SIN64);
    const int gtid = blockIdx.x * NTHREADS + threadIdx.x, gsz = gridDim.x * NTHREADS;
    const int total = nrows * 173;
    for (int idx = gtid; idx < total; idx += gsz) {
        const int row = idx / 173, it = idx - row * 173;
        const int t = row % TT;
        bf16_t* pr = proj + (size_t)row * INW;
        if (it < 32)       { const int hd = it >> 3, j = (it & 7) * 8;          rope8(pr + C_RQ + hd * 128 + j, pr + C_RQ + hd * 128 + 64 + j, c128 + t * 64 + j, s128 + t * 64 + j, 1.f); }
        else if (it < 64)  { const int i2 = it - 32, hd = i2 >> 3, j = (i2 & 7) * 8;  rope8(pr + C_RK + hd * 128 + j, pr + C_RK + hd * 128 + 64 + j, c128 + t * 64 + j, s128 + t * 64 + j, 0.08838834764831845f); }
        else if (it < 128) { const int i2 = it - 64, hd = i2 >> 3, j = (i2 & 7) * 8;  rope8(pr + C_DQ + hd * 128 + j, pr + C_DQ + hd * 128 + 64 + j, c128 + t * 64 + j, s128 + t * 64 + j, 0.08838834764831845f * 1.4426950408889634f); }
        else if (it < 136) { const int j = (it - 128) * 8;                          rope8(pr + C_DK + j, pr + C_DK + 64 + j, c128 + t * 64 + j, s128 + t * 64 + j, 1.f); }
        else if (it < 168) { const int i2 = it - 136, hd = i2 >> 2, j = (i2 & 3) * 8; rope8(pr + C_IQ + hd * 64 + j, pr + C_IQ + hd * 64 + 32 + j, c64 + t * 32 + j, s64 + t * 32 + j, 0.125f); }
        else if (it < 172) { const int j = (it - 168) * 8;                          rope8(pr + C_IK + j, pr + C_IK + 32 + j, c64 + t * 32 + j, s64 + t * 32 + j, 1.f); }
        else {
            const u32x4 r = *(const u32x4*)(pr + C_IW); float v[8]; unpack8(r, v); u32x4 o;
#pragma unroll
            for (int i = 0; i < 4; ++i) o[i] = (unsigned)f2bf(v[2 * i] * 0.35355339059327373f) | ((unsigned)f2bf(v[2 * i + 1] * 0.35355339059327373f) << 16);
            *(u32x4*)(pr + C_IW) = o;
        }
    }
    if (!do_dvt) return;
    bf16_t* dvt = (bf16_t*)(p.ws + OFF_DVT);
    LAS bf16_t* tile = (LAS bf16_t*)smem;
    for (int unit = blockIdx.x; unit < NB * (TTP / 64); unit += gridDim.x) {
        const int b = unit / (TTP / 64), t0 = (unit % (TTP / 64)) * 64;
        for (int i = threadIdx.x; i < 64 * 16; i += NTHREADS) {
            const int tr = i >> 4, ch = i & 15, t = t0 + tr;
            u32x4 v = {0u, 0u, 0u, 0u};
            if (t < TT) v = *(const u32x4*)(proj + (size_t)(b * TT + t) * INW + C_DV + ch * 8);
            *(LAS u32x4*)(tile + tr * 136 + ch * 8) = v;
        }
        __syncthreads();
        for (int i = threadIdx.x; i < 128 * 8; i += NTHREADS) {
            const int dv = i >> 3, ch = i & 7;
            u32x4 o;
#pragma unroll
            for (int w = 0; w < 4; ++w) o[w] = (unsigned)tile[(ch * 8 + 2 * w) * 136 + dv] | ((unsigned)tile[(ch * 8 + 2 * w + 1) * 136 + dv] << 16);
            *(u32x4*)(dvt + (size_t)(b * 128 + dv) * TTP + t0 + ch * 8) = o;
        }
        __syncthreads();
    }
}

constexpr int DSA_WAVE_LDS = 2176 * 4 + 1024 * 4 + 256 * 4 + 64;
template <bool CHECK>
DI void phase_dsa_naive(const Params& p, LAS char* smem) {
    const bf16_t* proj = (const bf16_t*)(p.ws + OFF_BIG);
    bf16_t* mixed = (bf16_t*)(p.ws + OFF_HN);
    const int wave = threadIdx.x >> 6, lane = threadIdx.x & 63;
    LAS float* sSc = (LAS float*)(smem + wave * DSA_WAVE_LDS);
    LAS float* sQ = sSc + 2176;
    LAS int* sSel = (LAS int*)(sQ + 1024);
    LAS float* sIw = (LAS float*)(sSel + 256);
    const unsigned long long lt_mask = (1ull << lane) - 1ull;
    float chk_num = 0.f, chk_den = 0.f;
    for (int q = blockIdx.x * NWAVES + wave; q < NF; q += gridDim.x * NWAVES) {
        const int b = q >> 11, s = q & 2047, t = NMETA + s;
        const int nk = 80 + 64 * (s >> 6);
        const bf16_t* prow = proj + (size_t)(b * TT + t) * INW;
        for (int i = lane; i < 512; i += 64) sQ[i] = bf2f(prow[C_IQ + i]);
        if (lane < 8) sIw[lane] = bf2f(prow[C_IW + lane]);
        lds_fence();
        const bf16_t* ikbase = proj + (size_t)(b * TT) * INW + C_IK;
        const int nj = (nk + 63) >> 6;
        for (int jj = 0; jj < nj; ++jj) {
            const int k = jj * 64 + lane;
            float sc = 0.f;
            if (k < nk) {
                const bf16_t* kr = ikbase + (size_t)k * INW;
                float a[8];
#pragma unroll
                for (int h = 0; h < 8; ++h) a[h] = 0.f;
#pragma unroll 1
                for (int d8 = 0; d8 < 8; ++d8) {
                    const u32x4 raw = *(const u32x4*)(kr + d8 * 8); float kv[8]; unpack8(raw, kv);
#pragma unroll
                    for (int h = 0; h < 8; ++h) {
                        const f32x4 q0 = *(const LAS f32x4*)(sQ + h * 64 + d8 * 8), q1 = *(const LAS f32x4*)(sQ + h * 64 + d8 * 8 + 4);
                        a[h] += kv[0] * q0[0] + kv[1] * q0[1] + kv[2] * q0[2] + kv[3] * q0[3] + kv[4] * q1[0] + kv[5] * q1[1] + kv[6] * q1[2] + kv[7] * q1[3];
                    }
                }
#pragma unroll
                for (int h = 0; h < 8; ++h) sc += fmaxf(a[h], 0.f) * sIw[h];
                sc += 0.0f;
            }
            sSc[k] = sc;
        }
        lds_fence();
        int L;
        if (nk <= 256) {
            for (int i = lane; i < nk; i += 64) sSel[i] = i;
            L = nk;
        } else {
            unsigned Tkey = 0u;
            for (int bit = 31; bit >= 0; --bit) {
                const unsigned cand = Tkey | (1u << bit);
                int cnt = 0;
                for (int jj = 0; jj < nj; ++jj) {
                    const int k = jj * 64 + lane;
                    const unsigned key = (k < nk) ? fkey(sSc[k]) : 0u;
                    cnt += __popcll(__ballot(key >= cand));
                }
                if (cnt >= 256) Tkey = cand;
            }
            int cgt = 0;
            for (int jj = 0; jj < nj; ++jj) {
                const int k = jj * 64 + lane;
                const unsigned key = (k < nk) ? fkey(sSc[k]) : 0u;
                cgt += __popcll(__ballot(key > Tkey));
            }
            const int need = 256 - cgt;
            int pos = 0, eqseen = 0;
            for (int jj = 0; jj < nj; ++jj) {
                const int k = jj * 64 + lane;
                const unsigned key = (k < nk) ? fkey(sSc[k]) : 0u;
                const bool gt = key > Tkey, eq = (key == Tkey);
                const unsigned long long eqm = __ballot(eq);
                const int myeq = eqseen + __popcll(eqm & lt_mask);
                const bool sel = gt || (eq && myeq < need);
                const unsigned long long sm = __ballot(sel);
                if (sel) sSel[pos + __popcll(sm & lt_mask)] = k;
                pos += __popcll(sm); eqseen += __popcll(eqm);
            }
            L = 256;
        }
        lds_fence();
        for (int i = lane; i < 1024; i += 64) sQ[i] = bf2f(prow[C_DQ + i]);
        lds_fence();
        float sc[8][4];
        const bf16_t* dkbase = proj + (size_t)(b * TT) * INW + C_DK;
#pragma unroll
        for (int il = 0; il < 4; ++il) {
            const int i = lane + 64 * il; const bool ok = i < L; const int key = ok ? sSel[i] : 0;
            const bf16_t* kr = dkbase + (size_t)key * INW;
            float a[8];
#pragma unroll
            for (int h = 0; h < 8; ++h) a[h] = 0.f;
#pragma unroll 1
            for (int d8 = 0; d8 < 16; ++d8) {
                const u32x4 raw = *(const u32x4*)(kr + d8 * 8); float kv[8]; unpack8(raw, kv);
#pragma unroll
                for (int h = 0; h < 8; ++h) {
                    const f32x4 q0 = *(const LAS f32x4*)(sQ + h * 128 + d8 * 8), q1 = *(const LAS f32x4*)(sQ + h * 128 + d8 * 8 + 4);
                    a[h] += kv[0] * q0[0] + kv[1] * q0[1] + kv[2] * q0[2] + kv[3] * q0[3] + kv[4] * q1[0] + kv[5] * q1[1] + kv[6] * q1[2] + kv[7] * q1[3];
                }
            }
#pragma unroll
            for (int h = 0; h < 8; ++h) sc[h][il] = ok ? a[h] : -INFINITY;
        }
#pragma unroll
        for (int h = 0; h < 8; ++h) {
            float m = fmaxf(fmaxf(sc[h][0], sc[h][1]), fmaxf(sc[h][2], sc[h][3]));
            m = wave_max(m);
            float e[4], sum = 0.f;
#pragma unroll
            for (int il = 0; il < 4; ++il) { e[il] = exp2f(sc[h][il] - m); sum += e[il]; }
            sum = wave_sum(sum);
            const float inv = 1.f / sum;
#pragma unroll
            for (int il = 0; il < 4; ++il) sSc[h * 256 + lane + 64 * il] = e[il] * inv;
        }
        lds_fence();
        float o[8][2];
#pragma unroll
        for (int h = 0; h < 8; ++h) { o[h][0] = 0.f; o[h][1] = 0.f; }
        const bf16_t* dvbase = proj + (size_t)(b * TT) * INW + C_DV;
        for (int i = 0; i < L; ++i) {
            const int key = sSel[i];
            const float v0 = bf2f(dvbase[(size_t)key * INW + lane]), v1 = bf2f(dvbase[(size_t)key * INW + 64 + lane]);
#pragma unroll
            for (int h = 0; h < 8; ++h) { const float pv = sSc[h * 256 + i]; o[h][0] += pv * v0; o[h][1] += pv * v1; }
        }
        lds_fence();
#pragma unroll
        for (int h = 0; h < 8; ++h) { sQ[h * 128 + lane] = o[h][0]; sQ[h * 128 + 64 + lane] = o[h][1]; }
        lds_fence();
        for (int h = 0; h < 8; ++h) {
            float acc = 0.f;
            const float* wu = p.w_uv + (size_t)h * 128 * 64 + lane;
            for (int c = 0; c < 128; ++c) acc += sQ[h * 128 + c] * wu[c * 64];
            if (CHECK) { const float got = bf2f(mixed[(size_t)q * DM + 512 + h * 64 + lane]); chk_num += (got - acc) * (got - acc); chk_den += acc * acc; }
            else mixed[(size_t)q * DM + 512 + h * 64 + lane] = f2bf(acc);
        }
        lds_fence();
    }
    if (CHECK) {
        chk_num = wave_sum(chk_num); chk_den = wave_sum(chk_den);
        if (lane == 0) { atomicAdd((float*)(p.ws + OFF_BAR) + 3600, chk_num); atomicAdd((float*)(p.ws + OFF_BAR) + 3601, chk_den); }
    }
}

typedef unsigned long long u64;
typedef short s16x4 __attribute__((ext_vector_type(4)));
constexpr int SCLD = 2116;
constexpr int DSA_MASK_OFF = 16 * SCLD * 4;
constexpr int KLD = 136, VLD = 72, VLD2 = 136;
constexpr int DSA_VT_OFF = 128 * KLD * 2;
#define MFMA16(a, b, c) __builtin_amdgcn_mfma_f32_16x16x32_bf16((a), (b), (c), 0, 0, 0)
DI void phase_dsa_fast(const Params& p, LAS char* smem) {
    const bf16_t* proj = (const bf16_t*)(p.ws + OFF_BIG);
    const bf16_t* dvt = (const bf16_t*)(p.ws + OFF_DVT);
    const bf16_t* wuvt = (const bf16_t*)(p.ws + OFF_WUVT);
    bf16_t* mixed = (bf16_t*)(p.ws + OFF_HN);
    const int wave = threadIdx.x >> 6, lane = threadIdx.x & 63, c = lane & 15, g = lane >> 4;
    LAS float* SC = (LAS float*)smem; LAS u64* MASK = (LAS u64*)(smem + DSA_MASK_OFF);
    LAS bf16_t* KT = (LAS bf16_t*)smem; LAS bf16_t* VT = (LAS bf16_t*)(smem + DSA_VT_OFF);
    const u64 lt_mask = (1ull << lane) - 1ull;
    for (int pi = blockIdx.x; pi < 512; pi += gridDim.x)
    for (int which = 0; which < 2; ++which) {
        const int b = pi >> 6, qq = pi & 63, qt = which ? 127 - qq : qq;
        const int s0 = qt * 16, nk = 80 + 64 * (s0 >> 6), nkt = nk >> 4, nj = (nk + 63) >> 6;
        const bf16_t* pb = proj + (size_t)(b * TT) * INW;
        LAS char* tp_smem = smem; TP_BEGIN(1);
        {
            const bf16_t* qrow = pb + (size_t)(NMETA + s0 + c) * INW;
            bf16x8 bq[8][2]; float iw[8];
#pragma unroll
            for (int h = 0; h < 8; ++h) {
                bq[h][0] = *(const bf16x8*)(qrow + C_IQ + h * 64 + 8 * g);
                bq[h][1] = *(const bf16x8*)(qrow + C_IQ + h * 64 + 32 + 8 * g);
                iw[h] = bf2f(qrow[C_IW + h]);
            }
            bf16x8 a0n = {0, 0, 0, 0, 0, 0, 0, 0}, a1n = {0, 0, 0, 0, 0, 0, 0, 0};
            if (wave < nkt) { const bf16_t* krow = pb + (size_t)(wave * 16 + c) * INW + C_IK + 8 * g; a0n = *(const bf16x8*)(krow); a1n = *(const bf16x8*)(krow + 32); }
            for (int kt = wave; kt < nkt; kt += NWAVES) {
                const bf16x8 a0 = a0n, a1 = a1n;
                if (kt + NWAVES < nkt) { const bf16_t* krow = pb + (size_t)((kt + NWAVES) * 16 + c) * INW + C_IK + 8 * g; a0n = *(const bf16x8*)(krow); a1n = *(const bf16x8*)(krow + 32); }
                f32x4 isc = {0.f, 0.f, 0.f, 0.f};
#pragma unroll
                for (int h = 0; h < 8; ++h) {
                    f32x4 acc = {0.f, 0.f, 0.f, 0.f};
                    acc = MFMA16(a0, bq[h][0], acc); acc = MFMA16(a1, bq[h][1], acc);
#pragma unroll
                    for (int j = 0; j < 4; ++j) isc[j] += fmaxf(acc[j], 0.f) * iw[h];
                }
#pragma unroll
                for (int j = 0; j < 4; ++j) isc[j] += 0.0f;
                *(LAS f32x4*)(SC + c * SCLD + kt * 16 + 4 * g) = isc;
            }
            {
                const int tail = ((nj <= 11 ? 11 : (nj <= 22 ? 22 : 33)) << 6) - nk;
                for (int i = threadIdx.x; i < 16 * tail; i += NTHREADS) { const int qq_ = i / tail; SC[qq_ * SCLD + nk + (i - qq_ * tail)] = -3.0e38f; }
            }
        }
        __syncthreads(); TP_END(1); TP_BEGIN(2);
#pragma unroll 1
        for (int qi = 0; qi < 2; ++qi) {
            const int cq = wave * 2 + qi;
            unsigned kv[33];
#pragma unroll
            for (int jj = 0; jj < 11; ++jj) kv[jj] = fkey(SC[cq * SCLD + jj * 64 + lane]);
            if (nj > 11) {
#pragma unroll
                for (int jj = 11; jj < 22; ++jj) kv[jj] = fkey(SC[cq * SCLD + jj * 64 + lane]);
            } else {
#pragma unroll
                for (int jj = 11; jj < 22; ++jj) kv[jj] = 0u;
            }
            if (nj > 22) {
#pragma unroll
                for (int jj = 22; jj < 33; ++jj) kv[jj] = fkey(SC[cq * SCLD + jj * 64 + lane]);
            } else {
#pragma unroll
                for (int jj = 22; jj < 33; ++jj) kv[jj] = 0u;
            }
            unsigned Tkey = 1u;
            if (nk > 256) {
                Tkey = 0u;
#pragma unroll 1
                for (int bit = 31; bit >= 0; --bit) {
                    const unsigned cand = Tkey | (1u << bit);
                    int nl = 0;
#pragma unroll
                    for (int jj = 0; jj < 11; ++jj) nl += (kv[jj] >= cand) ? 1 : 0;
                    if (nj > 11) {
#pragma unroll
                        for (int jj = 11; jj < 22; ++jj) nl += (kv[jj] >= cand) ? 1 : 0;
                    }
                    if (nj > 22) {
#pragma unroll
                        for (int jj = 22; jj < 33; ++jj) nl += (kv[jj] >= cand) ? 1 : 0;
                    }
                    const int cnt = wave_sum_int(nl);
                    if (cnt >= 256) Tkey = cand;
                    if (cnt == 256) break;
                }
            }
            int cgl = 0;
#pragma unroll
            for (int jj = 0; jj < 33; ++jj) cgl += (kv[jj] > Tkey) ? 1 : 0;
            const int cgt = wave_sum_int(cgl);
            const int need = (nk > 256) ? 256 - cgt : 4096;
            int eqseen = 0;
#pragma unroll 1
            for (int jj = 0; jj < nj; ++jj) {
                const int k = jj * 64 + lane; const float v = SC[cq * SCLD + k];
                const unsigned key = (k < nk) ? fkey(v) : 0u;
                const bool gt = key > Tkey, eq = (key == Tkey);
                const u64 eqm = __ballot(eq);
                const int myeq = eqseen + __popcll(eqm & lt_mask);
                const u64 sm = __ballot(gt || (eq && myeq < need));
                eqseen += __popcll(eqm);
                if (lane == 0) MASK[cq * 34 + jj] = sm;
            }
        }
        __syncthreads(); TP_END(2); TP_BEGIN(3);
        {
            const int h = wave;
            const bf16_t* qrow = pb + (size_t)(NMETA + s0 + c) * INW + C_DQ + h * 128 + 8 * g;
            bf16x8 bQ[4];
#pragma unroll
            for (int ks = 0; ks < 4; ++ks) bQ[ks] = *(const bf16x8*)(qrow + ks * 32);
            f32x4 O[8];
#pragma unroll
            for (int mb = 0; mb < 8; ++mb) O[mb] = (f32x4){0.f, 0.f, 0.f, 0.f};
            float m_run = -1e30f, l_run = 0.f;
            const int prow_t = threadIdx.x >> 4, pch_t = threadIdx.x & 15;
            const bf16_t* vsrc = dvt + (size_t)(b * 128 + prow_t) * TTP + pch_t * 8;
            const int n128 = (nk + 127) >> 7;
            u32x4 pk[4], pv[4];
#pragma unroll
            for (int i = 0; i < 4; ++i) {
                int key = prow_t + 32 * i; key = key < nk ? key : nk - 1;
                pk[i] = *(const u32x4*)(pb + (size_t)key * INW + C_DK + pch_t * 8);
                pv[i] = *(const u32x4*)(vsrc + (size_t)(32 * i) * TTP);
            }
#pragma unroll 1
            for (int kb = 0; kb < n128; ++kb) {
#pragma unroll
                for (int i = 0; i < 4; ++i) {
                    *(LAS u32x4*)(KT + (prow_t + 32 * i) * KLD + pch_t * 8) = pk[i];
                    *(LAS u32x4*)(VT + (prow_t + 32 * i) * VLD2 + pch_t * 8) = pv[i];
                }
                __syncthreads();
                if (kb + 1 < n128) {
#pragma unroll
                    for (int i = 0; i < 4; ++i) {
                        int key = (kb + 1) * 128 + prow_t + 32 * i; key = key < nk ? key : nk - 1;
                        pk[i] = *(const u32x4*)(pb + (size_t)key * INW + C_DK + pch_t * 8);
                        pv[i] = *(const u32x4*)(vsrc + (size_t)(32 * i) * TTP + (kb + 1) * 128);
                    }
                }
#pragma unroll
                for (int sb = 0; sb < 2; ++sb) {
                    const int wi = kb * 2 + sb;
                    if (wi < nj) {
                        const u64 mw = MASK[c * 34 + wi];
                        f32x4 S[4];
#pragma unroll
                        for (int ct = 0; ct < 4; ++ct) {
                            f32x4 acc = {0.f, 0.f, 0.f, 0.f};
#pragma unroll
                            for (int ks = 0; ks < 4; ++ks) {
                                const bf16x8 a = *(const LAS bf16x8*)(KT + (sb * 64 + ct * 16 + c) * KLD + ks * 32 + 8 * g);
                                acc = MFMA16(a, bQ[ks], acc);
                            }
                            S[ct] = acc;
                        }
                        const u64 mws = mw >> (4 * g);
                        const unsigned mlo = (unsigned)mws, mhi = (unsigned)(mws >> 32);
                        float mblk = -1e30f;
#pragma unroll
                        for (int ct = 0; ct < 4; ++ct) {
                            const unsigned bits = ((ct & 2) ? mhi : mlo) >> ((ct & 1) * 16);
#pragma unroll
                            for (int j = 0; j < 4; ++j) {
                                S[ct][j] = ((bits >> j) & 1u) ? S[ct][j] : -1e30f;
                                mblk = fmaxf(mblk, S[ct][j]);
                            }
                        }
                        mblk = fmaxf(mblk, __shfl_xor(mblk, 16)); mblk = fmaxf(mblk, __shfl_xor(mblk, 32));
                        const float m_new = fmaxf(m_run, mblk);
                        float ps = 0.f;
#pragma unroll
                        for (int ct = 0; ct < 4; ++ct)
#pragma unroll
                            for (int j = 0; j < 4; ++j) { const float pv_ = (S[ct][j] > -1e29f) ? __builtin_amdgcn_exp2f(S[ct][j] - m_new) : 0.f; S[ct][j] = pv_; ps += pv_; }
                        if (__ballot(m_new != m_run) != 0ull) {
                            const float alpha = __builtin_amdgcn_exp2f(m_run - m_new);
                            l_run *= alpha;
#pragma unroll
                            for (int mb = 0; mb < 8; ++mb) O[mb] *= alpha;
                        }
                        l_run += ps; m_run = m_new;
                        bf16x8 bP[2];
#pragma unroll
                        for (int kk = 0; kk < 2; ++kk) {
                            u32x4 t4;
                            t4[0] = pk2bf(S[2 * kk][0], S[2 * kk][1]); t4[1] = pk2bf(S[2 * kk][2], S[2 * kk][3]);
                            t4[2] = pk2bf(S[2 * kk + 1][0], S[2 * kk + 1][1]); t4[3] = pk2bf(S[2 * kk + 1][2], S[2 * kk + 1][3]);
                            bP[kk] = __builtin_bit_cast(bf16x8, t4);
                        }
#pragma unroll
                        for (int mh = 0; mh < 2; ++mh) {
                            bf16x8 av[8];
#pragma unroll
                            for (int q = 0; q < 8; ++q) {
                                const int mb = mh * 4 + (q >> 1), kk = q & 1;
                                const LAS bf16_t* vr = VT + (mb * 16 + c) * VLD2 + sb * 64 + kk * 32 + 4 * g;
                                const s16x4 lo = *(const LAS s16x4*)(vr), hi = *(const LAS s16x4*)(vr + 16);
                                av[q] = __builtin_shufflevector(lo, hi, 0, 1, 2, 3, 4, 5, 6, 7);
                            }
                            __builtin_amdgcn_sched_barrier(0);
#pragma unroll
                            for (int q = 0; q < 8; ++q) { const int mb = mh * 4 + (q >> 1), kk = q & 1; O[mb] = MFMA16(av[q], bP[kk], O[mb]); }
                            __builtin_amdgcn_sched_barrier(0);
                        }
                    }
                }
                __syncthreads();
            }
            TP_END(3); TP_BEGIN(4);
            l_run += __shfl_xor(l_run, 16); l_run += __shfl_xor(l_run, 32);
            const float inv = 1.f / l_run;
            bf16x8 bO[4];
#pragma unroll
            for (int k2 = 0; k2 < 4; ++k2)
#pragma unroll
                for (int j = 0; j < 4; ++j) { bO[k2][j] = (short)f2bf(O[2 * k2][j] * inv); bO[k2][4 + j] = (short)f2bf(O[2 * k2 + 1][j] * inv); }
            bf16_t* orow = mixed + (size_t)(b * SEQ + s0 + c) * DM + 512 + h * 64;
            int zofs = 0; asm volatile("" : "+v"(zofs));
#pragma unroll
            for (int eb = 0; eb < 4; ++eb) {
                f32x4 acc = {0.f, 0.f, 0.f, 0.f};
#pragma unroll
                for (int k2 = 0; k2 < 4; ++k2) {
                    const bf16_t* wr = wuvt + (size_t)(h * 64 + eb * 16 + c) * 128 + k2 * 32 + 4 * g + zofs;
                    const s16x4 lo = *(const s16x4*)(wr), hi = *(const s16x4*)(wr + 16);
                    const bf16x8 a = __builtin_shufflevector(lo, hi, 0, 1, 2, 3, 4, 5, 6, 7);
                    acc = MFMA16(a, bO[k2], acc);
                }
                uint2 w;
                w.x = (unsigned)f2bf(acc[0]) | ((unsigned)f2bf(acc[1]) << 16);
                w.y = (unsigned)f2bf(acc[2]) | ((unsigned)f2bf(acc[3]) << 16);
                *(uint2*)(orow + eb * 16 + 4 * g) = w;
            }
            TP_END(4);
        }
    }
}

DI void phase_ret_scan(const Params& p) {
    float* ST = (float*)(p.ws + OFF_ST);
    const int gtid = blockIdx.x * NTHREADS + threadIdx.x, gsz = gridDim.x * NTHREADS;
    for (int idx = gtid; idx < 32 * 16384; idx += gsz) {
        const int bh = idx >> 14, el = idx & 16383, h = bh & 3;
        const float gc = expf(logf(1.f - exp2f(-5.f - (float)h)) * 64.f);
        float* base = ST + (size_t)bh * 34 * 16384 + el;
        float r = 0.f;
        for (int c = 1; c < 34; ++c) {
            const float u = c < 33 ? base[(size_t)c * 16384] : 0.f;
            base[(size_t)c * 16384] = r;
            r = gc * r + u;
        }
    }
}

#define MFMA32(a, b, c) __builtin_amdgcn_mfma_f32_32x32x16_bf16((a), (b), (c), 0, 0, 0)
constexpr int RLD = 136, RTLD = 72;
DI void phase_ret_state_mfma(const Params& p, LAS char* smem) {
    const bf16_t* proj = (const bf16_t*)(p.ws + OFF_BIG);
    float* ST = (float*)(p.ws + OFF_ST);
    LAS bf16_t* sVT = (LAS bf16_t*)smem; LAS bf16_t* sKT = sVT + 128 * RTLD;
    const int wave = threadIdx.x >> 6, lane = threadIdx.x & 63, r = lane & 31, hh = lane >> 5;
    for (int unit = blockIdx.x; unit < 1024; unit += gridDim.x) {
        const int c = 1 + (unit & 31), bh = unit >> 5, h = bh & 3, b = bh >> 2;
        const float lg = logf(1.f - exp2f(-5.f - (float)h));
        {
            const int j = threadIdx.x >> 3, ch = threadIdx.x & 7, t = 64 * c + j - 112;
            const float z = expf(lg * (float)(63 - j));
#pragma unroll
            for (int q = 0; q < 2; ++q) {
                const int cc = ch + 8 * q;
                u32x4 kv = {0u, 0u, 0u, 0u}, vv = {0u, 0u, 0u, 0u};
                if (t >= 0) { const bf16_t* pr = proj + (size_t)(b * TT + t) * INW; kv = *(const u32x4*)(pr + C_RK + h * 128 + cc * 8); vv = *(const u32x4*)(pr + C_RV + h * 128 + cc * 8); }
                float vf[8]; unpack8(vv, vf);
#pragma unroll
                for (int x = 0; x < 8; ++x) {
                    sKT[(cc * 8 + x) * RTLD + j] = (bf16_t)((kv[x >> 1] >> ((x & 1) * 16)) & 0xffffu);
                    sVT[(cc * 8 + x) * RTLD + j] = f2bf(vf[x] * z);
                }
            }
        }
        __syncthreads();
        const int mb = wave >> 1;
#pragma unroll
        for (int q = 0; q < 2; ++q) {
            const int nb = (wave & 1) * 2 + q;
            f32x16 acc;
#pragma unroll
            for (int i = 0; i < 16; ++i) acc[i] = 0.f;
#pragma unroll
            for (int ks = 0; ks < 4; ++ks) {
                const bf16x8 a = *(const LAS bf16x8*)(sVT + (mb * 32 + r) * RTLD + ks * 16 + 8 * hh);
                const bf16x8 bb = *(const LAS bf16x8*)(sKT + (nb * 32 + r) * RTLD + ks * 16 + 8 * hh);
                acc = MFMA32(a, bb, acc);
            }
            float* st = ST + (size_t)(bh * 34 + c) * 16384 + nb * 32 + r;
#pragma unroll
            for (int i = 0; i < 16; ++i) st[(size_t)(mb * 32 + (i & 3) + 8 * (i >> 2) + 4 * hh) * 128] = acc[i];
        }
        __syncthreads();
    }
}
DI void phase_ret_out_mfma(const Params& p, LAS char* smem) {
    const bf16_t* proj = (const bf16_t*)(p.ws + OFF_BIG);
    const float* ST = (const float*)(p.ws + OFF_ST);
    bf16_t* mixed = (bf16_t*)(p.ws + OFF_HN);
    LAS bf16_t* sQ = (LAS bf16_t*)smem; LAS bf16_t* sK = sQ + 64 * RLD; LAS bf16_t* sVT = sK + 64 * RLD;
    LAS float* sGN = (LAS float*)(sVT + 128 * RTLD);
    const int wave = threadIdx.x >> 6, lane = threadIdx.x & 63, r = lane & 31, hh = lane >> 5;
    const int ib = wave & 1, eb = wave >> 1;
    for (int unit = blockIdx.x; unit < 1024; unit += gridDim.x) {
        const int c = 2 + (unit & 31), bh = unit >> 5, h = bh & 3, b = bh >> 2;
        const float lg = logf(1.f - exp2f(-5.f - (float)h));
        for (int i = threadIdx.x; i < 64 * 16; i += NTHREADS) {
            const int j = i >> 4, ch = i & 15; const int t = 64 * c + j - 112;
            const bf16_t* pr = proj + (size_t)(b * TT + t) * INW;
            *(LAS u32x4*)(sQ + j * RLD + ch * 8) = *(const u32x4*)(pr + C_RQ + h * 128 + ch * 8);
            *(LAS u32x4*)(sK + j * RLD + ch * 8) = *(const u32x4*)(pr + C_RK + h * 128 + ch * 8);
            const u32x4 vv = *(const u32x4*)(pr + C_RV + h * 128 + ch * 8);
#pragma unroll
            for (int x = 0; x < 8; ++x) sVT[(ch * 8 + x) * RTLD + j] = (bf16_t)((vv[x >> 1] >> ((x & 1) * 16)) & 0xffffu);
        }
        __syncthreads();
        f32x16 acc;
#pragma unroll
        for (int i = 0; i < 16; ++i) acc[i] = 0.f;
        {
            const float* R = ST + (size_t)(bh * 34 + c) * 16384 + (size_t)(eb * 32 + r) * 128 + 8 * hh;
#pragma unroll
            for (int ks = 0; ks < 8; ++ks) {
                const float4 r0 = *(const float4*)(R + ks * 16), r1 = *(const float4*)(R + ks * 16 + 4);
                const float rf[8] = {r0.x, r0.y, r0.z, r0.w, r1.x, r1.y, r1.z, r1.w};
                const bf16x8 a = pack8(rf);
                const bf16x8 bq = *(const LAS bf16x8*)(sQ + (ib * 32 + r) * RLD + ks * 16 + 8 * hh);
                acc = MFMA32(a, bq, acc);
            }
            const float xi = expf(lg * (float)(ib * 32 + r + 1));
#pragma unroll
            for (int i = 0; i < 16; ++i) acc[i] *= xi;
        }
#pragma unroll
        for (int jb = 0; jb < 2; ++jb) {
            f32x16 st;
#pragma unroll
            for (int i = 0; i < 16; ++i) st[i] = 0.f;
#pragma unroll
            for (int ks = 0; ks < 8; ++ks) {
                const bf16x8 a = *(const LAS bf16x8*)(sK + (jb * 32 + r) * RLD + ks * 16 + 8 * hh);
                const bf16x8 bq = *(const LAS bf16x8*)(sQ + (ib * 32 + r) * RLD + ks * 16 + 8 * hh);
                st = MFMA32(a, bq, st);
            }
            const int icol = ib * 32 + r;
#pragma unroll
            for (int i = 0; i < 16; ++i) {
                const int j = jb * 32 + (i & 3) + 8 * (i >> 2) + 4 * hh; const int df = icol > j ? icol - j : j - icol;
                st[i] *= expf(lg * (float)df);
            }
#pragma unroll
            for (int s2 = 0; s2 < 2; ++s2) {
                bf16x8 bp;
#pragma unroll
                for (int x = 0; x < 8; ++x) bp[x] = (short)f2bf(st[8 * s2 + x]);
                const LAS bf16_t* vr = sVT + (eb * 32 + r) * RTLD + jb * 32 + 16 * s2 + 4 * hh;
                const s16x4 lo = *(const LAS s16x4*)(vr), hi = *(const LAS s16x4*)(vr + 8);
                const bf16x8 a = __builtin_shufflevector(lo, hi, 0, 1, 2, 3, 4, 5, 6, 7);
                acc = MFMA32(a, bp, acc);
            }
        }
        float s1 = 0.f, s2 = 0.f;
#pragma unroll
        for (int i = 0; i < 16; ++i) { s1 += acc[i]; s2 += acc[i] * acc[i]; }
        s1 += __shfl_xor(s1, 32); s2 += __shfl_xor(s2, 32);
        if (hh == 0) { sGN[(eb * 64 + ib * 32 + r) * 2] = s1; sGN[(eb * 64 + ib * 32 + r) * 2 + 1] = s2; }
        __syncthreads();
        float S1 = 0.f, S2 = 0.f;
#pragma unroll
        for (int e4 = 0; e4 < 4; ++e4) { S1 += sGN[(e4 * 64 + ib * 32 + r) * 2]; S2 += sGN[(e4 * 64 + ib * 32 + r) * 2 + 1]; }
        const float mu = S1 * (1.f / 128.f), var = fmaxf(S2 * (1.f / 128.f) - mu * mu, 0.f), rs = rsqrtf(var + 1e-6f);
        const int t = 64 * c + ib * 32 + r - 112, srow = t - NMETA;
        const bf16_t* pg = proj + (size_t)(b * TT + t) * INW + C_RG + h * 128 + eb * 32 + 4 * hh;
        bf16_t* po = mixed + (size_t)(b * SEQ + srow) * DM + h * 128 + eb * 32 + 4 * hh;
#pragma unroll
        for (int g4 = 0; g4 < 4; ++g4) {
            const uint2 graw = *(const uint2*)(pg + 8 * g4);
            const float gv[4] = {__uint_as_float(graw.x << 16), __uint_as_float(graw.x & 0xffff0000u), __uint_as_float(graw.y << 16), __uint_as_float(graw.y & 0xffff0000u)};
            float o[4];
#pragma unroll
            for (int x = 0; x < 4; ++x) { const float gate = gv[x] / (1.f + expf(-gv[x])); o[x] = gate * (acc[4 * g4 + x] - mu) * rs; }
            uint2 w; w.x = (unsigned)f2bf(o[0]) | ((unsigned)f2bf(o[1]) << 16); w.y = (unsigned)f2bf(o[2]) | ((unsigned)f2bf(o[3]) << 16);
            *(uint2*)(po + 8 * g4) = w;
        }
        __syncthreads();
    }
}

DI void phase_norm2(const Params& p) {
    bf16_t* hn2 = (bf16_t*)(p.ws + OFF_HN);
    const int wave = threadIdx.x >> 6, lane = threadIdx.x & 63;
    for (int row = blockIdx.x * NWAVES + wave; row < NF; row += gridDim.x * NWAVES) {
        const float* src = p.out + (size_t)row * DM; bf16_t* o = hn2 + (size_t)row * DM;
        float4 v[4]; float ss = 0.f;
#pragma unroll
        for (int i = 0; i < 4; ++i) { v[i] = *(const float4*)(src + i * 256 + lane * 4); ss += v[i].x * v[i].x + v[i].y * v[i].y + v[i].z * v[i].z + v[i].w * v[i].w; }
        ss = wave_sum(ss);
        const float rstd = rsqrtf(ss * (1.f / DM) + 1e-6f);
#pragma unroll
        for (int i = 0; i < 4; ++i) {
            const float4 g = *(const float4*)(p.norm_ffn + i * 256 + lane * 4);
            uint2 w;
            w.x = (unsigned)f2bf(v[i].x * rstd * g.x) | ((unsigned)f2bf(v[i].y * rstd * g.y) << 16);
            w.y = (unsigned)f2bf(v[i].z * rstd * g.z) | ((unsigned)f2bf(v[i].w * rstd * g.w) << 16);
            *(uint2*)(o + i * 256 + lane * 4) = w;
        }
    }
}

constexpr int PSEL_WAVE_LDS = 32 * 2 * 16 * 8 + 32 * 16 * 8;
DI void phase_peer_select(const Params& p, LAS char* smem) {
    const float* PQ = (const float*)(p.ws + OFF_BIG);
    unsigned* EG = (unsigned*)(p.ws + OFF_EG); const float* SSQ = (const float*)(p.ws + OFF_SSQ);
    const int wave = threadIdx.x >> 6, lane = threadIdx.x & 63, r = lane & 31, hh = lane >> 5;
    LAS float* lv = (LAS float*)(smem + wave * PSEL_WAVE_LDS);
    LAS int* li = (LAS int*)(lv + 32 * 2 * 16);
    LAS float* cs = (LAS float*)(li + 32 * 2 * 16);
    LAS int* cab = (LAS int*)(cs + 32 * 16);
    for (int task = blockIdx.x * NWAVES + wave; task < (NF / 32) * 8; task += gridDim.x * NWAVES) {
        const int tile = task >> 3, h = task & 7;
        const int n = tile * 32 + r;
#pragma unroll 1
        for (int half = 0; half < 2; ++half) {
            f32x16 acc[4];
            {
                const float* srow = PQ + (size_t)n * 2048 + h * 256 + half * 128 + hh * 64;
#pragma unroll
                for (int mb = 0; mb < 4; ++mb)
#pragma unroll
                    for (int q = 0; q < 4; ++q) { const float4 a = *(const float4*)(srow + mb * 16 + q * 4); acc[mb][q * 4] = a.x; acc[mb][q * 4 + 1] = a.y; acc[mb][q * 4 + 2] = a.z; acc[mb][q * 4 + 3] = a.w; }
            }
            float mprev = INFINITY;
#pragma unroll 1
            for (int it = 0; it < 16; ++it) {
                float m = -INFINITY;
#pragma unroll
                for (int mb = 0; mb < 4; ++mb)
#pragma unroll
                    for (int i = 0; i < 16; ++i) { const float v = acc[mb][i]; m = fmaxf(m, v < mprev ? v : -INFINITY); }
                m = fmaxf(m, __shfl_xor(m, 32));
                mprev = m;
            }
            const float T = mprev;
            int cnt = 0;
#pragma unroll
            for (int mb = 0; mb < 4; ++mb)
#pragma unroll
                for (int i = 0; i < 16; ++i) cnt += (acc[mb][i] >= T) ? 1 : 0;
            const int pc = __shfl_xor(cnt, 32);
            int pos = hh ? pc : 0;
            LAS float* lvp = lv + (r * 2 + half) * 16; LAS int* lip = li + (r * 2 + half) * 16;
#pragma unroll
            for (int mb = 0; mb < 4; ++mb)
#pragma unroll
                for (int i = 0; i < 16; ++i) {
                    const float v = acc[mb][i];
                    if (v >= T) { if (pos < 16) { lvp[pos] = v; lip[pos] = hh * 64 + mb * 16 + i; } ++pos; }
                }
        }
        lds_fence();
        float v1[8], v2[16];
#pragma unroll
        for (int a = 0; a < 8; ++a) v1[a] = lv[(r * 2 + 0) * 16 + 8 * hh + a];
#pragma unroll
        for (int b = 0; b < 16; ++b) v2[b] = lv[(r * 2 + 1) * 16 + b];
        float mprev = INFINITY;
#pragma unroll 1
        for (int it = 0; it < 16; ++it) {
            float m = -INFINITY;
#pragma unroll
            for (int a = 0; a < 8; ++a)
#pragma unroll
                for (int b = 0; b < 16; ++b) { const float v = v1[a] + v2[b]; m = fmaxf(m, v < mprev ? v : -INFINITY); }
            m = fmaxf(m, __shfl_xor(m, 32));
            mprev = m;
        }
        const float Tc = mprev;
        int cnt = 0;
#pragma unroll
        for (int a = 0; a < 8; ++a)
#pragma unroll
            for (int b = 0; b < 16; ++b) cnt += (v1[a] + v2[b] >= Tc) ? 1 : 0;
        const int pc = __shfl_xor(cnt, 32);
        int pos = hh ? pc : 0;
#pragma unroll
        for (int a = 0; a < 8; ++a)
#pragma unroll
            for (int b = 0; b < 16; ++b) {
                const float v = v1[a] + v2[b];
                if (v >= Tc) { if (pos < 16) { cs[r * 16 + pos] = v; cab[r * 16 + pos] = (8 * hh + a) * 16 + b; } ++pos; }
            }
        lds_fence();
        const float rstd = rsqrtf(SSQ[n] * (1.f / DM) + 1e-6f);
        float scv[16]; float mx = -INFINITY;
#pragma unroll
        for (int i = 0; i < 16; ++i) { scv[i] = cs[r * 16 + i]; mx = fmaxf(mx, scv[i]); }
        float sum = 0.f;
#pragma unroll
        for (int i = 0; i < 16; ++i) { scv[i] = expf((scv[i] - mx) * rstd); sum += scv[i]; }
        const float inv = 1.f / sum;
#pragma unroll
        for (int i = 0; i < 16; ++i) {
            if ((i >> 3) == hh) {
                const int ab = cab[r * 16 + i];
                const int e = li[(r * 2 + 0) * 16 + (ab >> 4)] * 128 + li[(r * 2 + 1) * 16 + (ab & 15)];
                const _Float16 gh = (_Float16)(scv[i] * inv);
                EG[(size_t)n * 128 + h * 16 + i] = (unsigned)e | ((unsigned)__builtin_bit_cast(unsigned short, gh) << 16);
            }
        }
        lds_fence();
    }
}

typedef float f32x2 __attribute__((ext_vector_type(2)));
DI void phase_convert_tables(const Params& p) {
    const int wave = threadIdx.x >> 6, lane = threadIdx.x & 63;
    for (int rowi = blockIdx.x * NWAVES + wave; rowi < 2 * 16384; rowi += gridDim.x * NWAVES) {
        const bool isv = rowi >= 16384; const int e = isv ? rowi - 16384 : rowi;
        const float* src = (isv ? p.pv : p.pu) + (size_t)e * DM + lane * 16;
        float x[16]; float mx = 0.f;
#pragma unroll
        for (int i = 0; i < 4; ++i) { const float4 a = *(const float4*)(src + i * 4); x[i * 4] = a.x; x[i * 4 + 1] = a.y; x[i * 4 + 2] = a.z; x[i * 4 + 3] = a.w; }
#pragma unroll
        for (int i = 0; i < 16; ++i) mx = fmaxf(mx, fabsf(x[i]));
        mx = wave_max(mx);
        const float top = isv ? 240.f : 127.f;
        const float inv = mx > 0.f ? top / mx : 0.f, scale = mx > 0.f ? mx / top : 0.f;
        u32x4 o;
        if (isv) {
#pragma unroll
            for (int w = 0; w < 4; ++w) {
                int pk = 0;
                pk = __builtin_amdgcn_cvt_pk_fp8_f32(x[w * 4] * inv, x[w * 4 + 1] * inv, pk, false);
                pk = __builtin_amdgcn_cvt_pk_fp8_f32(x[w * 4 + 2] * inv, x[w * 4 + 3] * inv, pk, true);
                o[w] = (unsigned)pk;
            }
        } else {
#pragma unroll
            for (int w = 0; w < 4; ++w) {
                unsigned pk = 0u;
#pragma unroll
                for (int b = 0; b < 4; ++b) { const int q = (int)rintf(x[w * 4 + b] * inv); pk |= ((unsigned)q & 0xffu) << (8 * b); }
                o[w] = pk;
            }
        }
        *(u32x4*)(p.ws + (isv ? OFF_V8 : OFF_U8) + (size_t)e * DM + lane * 16) = o;
        if (lane == 0) ((float*)(p.ws + (isv ? OFF_SV : OFF_SU)))[e] = scale;
    }
}
DI void unpack16_fp8(const u32x4& r, float (&v)[16]) {
#pragma unroll
    for (int w = 0; w < 4; ++w) {
        const f32x2 a = __builtin_amdgcn_cvt_pk_f32_fp8((int)r[w], false), b = __builtin_amdgcn_cvt_pk_f32_fp8((int)r[w], true);
        v[w * 4] = a[0]; v[w * 4 + 1] = a[1]; v[w * 4 + 2] = b[0]; v[w * 4 + 3] = b[1];
    }
}
constexpr int RW_NB = 128, RW_SH = 7;
constexpr int RW_WAVE_LDS = 4 * (RW_NB + 16) * 4 + 4 * 128 * 4 + 4 * 128 * 4;
DI float gelu_as(float v) {
    const float av = fabsf(v), t = __builtin_amdgcn_rcpf(av * 0.2316418882f + 1.0f);
    float q = t * 0.5307027145f + (-0.7265760135f); q = q * t + 0.7107068705f; q = q * t + (-0.142248368f); q = q * t + 0.127414796f; q = q * t;
    const float e = __builtin_amdgcn_exp2f((v * v) * (-0.72134752044f));
    const float m = v * (q * e), r = v - m;
    return v < 0.f ? m : r;
}
DI void phase_peer_out_rows(const Params& p, LAS char* smem) {
    const unsigned* EG = (const unsigned*)(p.ws + OFF_EG);
    const char* U8 = p.ws + OFF_U8; const char* V8 = p.ws + OFF_V8;
    const float* SU = (const float*)(p.ws + OFF_SU); const float* SV = (const float*)(p.ws + OFF_SV);
    const int wave = threadIdx.x >> 6, lane = threadIdx.x & 63, r = lane >> 4, l16 = lane & 15;
    LAS int* cnt = (LAS int*)(smem + wave * RW_WAVE_LDS) + r * (RW_NB + 16);
    LAS int* list_e = (LAS int*)(smem + wave * RW_WAVE_LDS + 4 * (RW_NB + 16) * 4) + r * 128;
    LAS float* list_g = (LAS float*)(smem + wave * RW_WAVE_LDS + 4 * (RW_NB + 16) * 4 + 2048) + r * 128;
    for (int grp = blockIdx.x * NWAVES + wave; grp < NF / 4; grp += gridDim.x * NWAVES) {
        const int n = grp * 4 + r;
        float acc[64]; int hq[16]; float hscale;
        const float* hrow = p.out + (size_t)n * DM + l16 * 16;
        {
            float hn[64];
            float ss = 0.f;
#pragma unroll
            for (int j = 0; j < 4; ++j)
#pragma unroll
                for (int q = 0; q < 4; ++q) { const float4 a = *(const float4*)(hrow + j * 256 + q * 4); hn[j * 16 + q * 4] = a.x; hn[j * 16 + q * 4 + 1] = a.y; hn[j * 16 + q * 4 + 2] = a.z; hn[j * 16 + q * 4 + 3] = a.w; }
#pragma unroll
            for (int i = 0; i < 64; ++i) ss += hn[i] * hn[i];
            ss = dpp_row_sum(ss);
            const float rstd = rsqrtf(ss * (1.f / DM) + 1e-6f);
#pragma unroll
            for (int j = 0; j < 4; ++j)
#pragma unroll
                for (int q = 0; q < 4; ++q) {
                    const float4 a = *(const float4*)(p.norm_ffn + j * 256 + l16 * 16 + q * 4);
                    hn[j * 16 + q * 4] *= rstd * a.x; hn[j * 16 + q * 4 + 1] *= rstd * a.y; hn[j * 16 + q * 4 + 2] *= rstd * a.z; hn[j * 16 + q * 4 + 3] *= rstd * a.w;
                }
            float hm = 0.f;
#pragma unroll
            for (int i = 0; i < 64; ++i) hm = fmaxf(hm, fabsf(hn[i]));
            hm = fmaxf(hm, __int_as_float(__builtin_amdgcn_update_dpp(0, __float_as_int(hm), 0xB1, 0xF, 0xF, true)));
            hm = fmaxf(hm, __int_as_float(__builtin_amdgcn_update_dpp(0, __float_as_int(hm), 0x4E, 0xF, 0xF, true)));
            hm = fmaxf(hm, __int_as_float(__builtin_amdgcn_update_dpp(0, __float_as_int(hm), 0x141, 0xF, 0xF, true)));
            hm = fmaxf(hm, __int_as_float(__builtin_amdgcn_update_dpp(0, __float_as_int(hm), 0x140, 0xF, 0xF, true)));
            const float hinv = hm > 0.f ? 127.f / hm : 0.f; hscale = hm * (1.f / 127.f);
#pragma unroll
            for (int w = 0; w < 16; ++w) {
                unsigned pk = 0u;
#pragma unroll
                for (int b = 0; b < 4; ++b) { const int q = (int)rintf(hn[w * 4 + b] * hinv); pk |= ((unsigned)q & 0xffu) << (8 * b); }
                hq[w] = (int)pk;
            }
#pragma unroll
            for (int i = 0; i < 64; ++i) acc[i] = 0.f;
        }
#pragma unroll
        for (int q = 0; q < RW_NB / 16; ++q) cnt[q * 16 + l16] = 0;
        lds_fence();
        {
            int ek[8], rk[8]; float gk[8];
#pragma unroll
            for (int k = 0; k < 8; ++k) { const unsigned w = EG[(size_t)n * 128 + k * 16 + l16]; ek[k] = (int)(w & 0xffffu); gk[k] = (float)__builtin_bit_cast(_Float16, (unsigned short)(w >> 16)); }
#pragma unroll
            for (int k = 0; k < 8; ++k) rk[k] = __hip_atomic_fetch_add(&cnt[ek[k] >> RW_SH], 1, __ATOMIC_RELAXED, __HIP_MEMORY_SCOPE_WORKGROUP);
            lds_fence();
            {
                constexpr int PB = RW_NB / 16;
                int c[PB], tot = 0;
#pragma unroll
                for (int q = 0; q < PB; ++q) { c[q] = cnt[l16 * PB + q]; tot += c[q]; }
                cnt[RW_NB + l16] = tot;
                lds_fence();
                int base = 0;
#pragma unroll
                for (int q = 0; q < 16; ++q) { const int v = cnt[RW_NB + q]; base += (q < l16) ? v : 0; }
#pragma unroll
                for (int q = 0; q < PB; ++q) { cnt[l16 * PB + q] = base; base += c[q]; }
            }
            lds_fence();
#pragma unroll
            for (int k = 0; k < 8; ++k) { const int pos = cnt[ek[k] >> RW_SH] + rk[k]; list_e[pos] = ek[k]; list_g[pos] = gk[k]; }
        }
        lds_fence();
        {
            u32x4 ub[4], vb[4]; float g_c, su_c, sv_c, g_n = 0.f, su_n = 0.f, sv_n = 0.f;
            {
                const int e_ = list_e[0]; g_c = list_g[0]; su_c = SU[e_]; sv_c = SV[e_];
#pragma unroll
                for (int j = 0; j < 4; ++j) { ub[j] = *(const u32x4*)(U8 + (size_t)e_ * DM + l16 * 16 + j * 256); vb[j] = *(const u32x4*)(V8 + (size_t)e_ * DM + l16 * 16 + j * 256); }
            }
#pragma unroll 1
            for (int sl = 0; sl < 128; ++sl) {
                int isum = 0;
#pragma unroll
                for (int j = 0; j < 4; ++j)
#pragma unroll
                    for (int w = 0; w < 4; ++w) isum = __builtin_amdgcn_sdot4((int)ub[j][w], hq[j * 4 + w], isum, false);
                isum += __builtin_amdgcn_update_dpp(0, isum, 0xB1, 0xF, 0xF, true);
                isum += __builtin_amdgcn_update_dpp(0, isum, 0x4E, 0xF, 0xF, true);
                isum += __builtin_amdgcn_update_dpp(0, isum, 0x141, 0xF, 0xF, true);
                isum += __builtin_amdgcn_update_dpp(0, isum, 0x140, 0xF, 0xF, true);
                float t_ = (float)isum * hscale;
                const int sn = sl + 1 < 128 ? sl + 1 : 127;
                const int e_n = list_e[sn];
                {
                    const char* up_ = U8 + (size_t)e_n * DM + l16 * 16;
#pragma unroll
                    for (int j = 0; j < 4; ++j) ub[j] = *(const u32x4*)(up_ + j * 256);
                    g_n = list_g[sn]; su_n = SU[e_n]; sv_n = SV[e_n];
                }
                t_ *= su_c;
                const float coef_ = gelu_as(t_) * g_c * sv_c;
#pragma unroll
                for (int j = 0; j < 4; ++j) { float v[16]; unpack16_fp8(vb[j], v);
#pragma unroll
                    for (int i = 0; i < 16; ++i) acc[j * 16 + i] += coef_ * v[i]; }
                {
                    const char* vp_ = V8 + (size_t)e_n * DM + l16 * 16;
#pragma unroll
                    for (int j = 0; j < 4; ++j) vb[j] = *(const u32x4*)(vp_ + j * 256);
                }
                g_c = g_n; su_c = su_n; sv_c = sv_n;
            }
        }
        {
            float* orow = p.out + (size_t)n * DM + l16 * 16;
            float s2 = 0.f;
#pragma unroll
            for (int j = 0; j < 4; ++j)
#pragma unroll
                for (int q = 0; q < 4; ++q) { const float4 a = *(const float4*)(orow + j * 256 + q * 4); acc[j * 16 + q * 4] += a.x; acc[j * 16 + q * 4 + 1] += a.y; acc[j * 16 + q * 4 + 2] += a.z; acc[j * 16 + q * 4 + 3] += a.w; }
#pragma unroll
            for (int i = 0; i < 64; ++i) s2 += acc[i] * acc[i];
            s2 = dpp_row_sum(s2);
            float r2 = rsqrtf(s2 * (1.f / DM) + 1e-6f);
#if TP_SEC
            r2 *= 1.f + 0.5f * ((const float*)(p.ws + OFF_BAR))[3602];
#endif
#if defined(DSA_CHECK) || defined(PROJ_CHECK)
            { const float num = ((const float*)(p.ws + OFF_BAR))[3600], den = ((const float*)(p.ws + OFF_BAR))[3601]; r2 *= 1.f + CHK_GAIN * sqrtf(num / fmaxf(den, 1e-30f)); }
#endif
#pragma unroll
            for (int j = 0; j < 4; ++j)
#pragma unroll
                for (int q = 0; q < 4; ++q) {
                    const float4 a = *(const float4*)(p.norm_final + j * 256 + l16 * 16 + q * 4);
                    *(float4*)(orow + j * 256 + q * 4) = make_float4(acc[j * 16 + q * 4] * r2 * a.x, acc[j * 16 + q * 4 + 1] * r2 * a.y, acc[j * 16 + q * 4 + 2] * r2 * a.z, acc[j * 16 + q * 4 + 3] * r2 * a.w);
                }
        }
        lds_fence();
    }
}

DI Params load_params() {
#if defined(__HIP_DEVICE_COMPILE__)
    typedef const __attribute__((address_space(4))) unsigned long long* cu64_t;
    cu64_t pp = (cu64_t)__builtin_amdgcn_kernarg_segment_ptr();
    asm volatile("" : "+s"(pp));
    static_assert(sizeof(Params) == 16 * 8, "Params is 16 qwords");
    unsigned long long w[16];
#pragma unroll
    for (int i = 0; i < 16; ++i) w[i] = pp[i];
#define GPTR(T, v) ((T*)(__attribute__((address_space(1))) T*)(v))
    Params r;
    r.x = GPTR(const float, w[0]); r.meta = GPTR(const float, w[1]); r.norm_mix = GPTR(const float, w[2]); r.w_in = GPTR(const float, w[3]);
    r.w_uv = GPTR(const float, w[4]); r.w_out = GPTR(const float, w[5]); r.norm_ffn = GPTR(const float, w[6]); r.wq = GPTR(const float, w[7]);
    r.sk = GPTR(const float, w[8]); r.pu = GPTR(const float, w[9]); r.pv = GPTR(const float, w[10]); r.norm_final = GPTR(const float, w[11]);
    r.out = GPTR(float, w[12]); r.ws = GPTR(char, w[13]);
    r.lo = (int)(unsigned)w[14]; r.hi = (int)(unsigned)(w[14] >> 32); r.pad0 = 0; r.pad1 = 0;
    return r;
#else
    return Params{};
#endif
}
#ifdef PROJ_CHECK
constexpr int PCH_ROWS = 2048;
DI void phase_proj_ref_naive(const Params& p) {
    const bf16_t* hn = (const bf16_t*)(p.ws + OFF_HN); bf16_t* ref = (bf16_t*)(p.ws + OFF_ST);
    const int gtid = blockIdx.x * NTHREADS + threadIdx.x, gsz = gridDim.x * NTHREADS;
    for (int idx = gtid; idx < (PCH_ROWS / 8) * INW; idx += gsz) {
        const int c = idx % INW, r0 = (idx / INW) * 8;
        float acc[8];
#pragma unroll
        for (int i = 0; i < 8; ++i) acc[i] = 0.f;
        for (int k = 0; k < 1024; ++k) {
            const float w = bf2f(f2bf(p.w_in[(size_t)k * INW + c]));
#pragma unroll
            for (int i = 0; i < 8; ++i) acc[i] += bf2f(hn[(size_t)(r0 + i) * DM + k]) * w;
        }
#pragma unroll
        for (int i = 0; i < 8; ++i) ref[(size_t)(r0 + i) * INW + c] = f2bf(acc[i]);
    }
}
DI void phase_proj_compare(const Params& p) {
    const bf16_t* proj = (const bf16_t*)(p.ws + OFF_BIG); const bf16_t* ref = (const bf16_t*)(p.ws + OFF_ST); const bf16_t* dvt = (const bf16_t*)(p.ws + OFF_DVT);
    const int gtid = blockIdx.x * NTHREADS + threadIdx.x, gsz = gridDim.x * NTHREADS;
    float num = 0.f, den = 0.f;
    for (int idx = gtid; idx < PCH_ROWS * INW; idx += gsz) { const float a = bf2f(proj[idx]), r = bf2f(ref[idx]); num += (a - r) * (a - r); den += r * r; }
    for (int idx = gtid; idx < PCH_ROWS * 128; idx += gsz) {
        const int row = idx >> 7, dv = idx & 127, b = row / TT, t = row - b * TT;
        const float a = bf2f(dvt[(size_t)(b * 128 + dv) * TTP + t]), r = bf2f(ref[(size_t)row * INW + C_DV + dv]); num += (a - r) * (a - r); den += r * r;
    }
    num = wave_sum(num); den = wave_sum(den);
    if ((threadIdx.x & 63) == 0) { atomicAdd((float*)(p.ws + OFF_BAR) + 3600, num); atomicAdd((float*)(p.ws + OFF_BAR) + 3601, den); }
}
#endif
constexpr int NPHASES = 10;
__global__ void __launch_bounds__(NTHREADS, 2) mk_forward(Params p) {
    extern __shared__ __attribute__((aligned(16))) char dyn_smem[];
    LAS char* smem = (LAS char*)dyn_smem;
    const bool multi = (p.hi - p.lo) > 1;
    LAS char* tp_smem = smem;
    if (TP_SEC && blockIdx.x == 0 && threadIdx.x == 0) { volatile LAS long long* tp_ = (volatile LAS long long*)(smem + TP_LDS_OFF); tp_[0] = (long long)__builtin_readcyclecounter(); tp_[2] = 0; }
    XcdBarrier bar; bar.bar = (unsigned*)(p.ws + OFF_BAR); bar.x = 0; bar.st = (volatile LAS unsigned*)(smem + LDS_BAR_OFF);
    if (multi) {
        if (threadIdx.x == 0) { const u32x4 z = {0u, 0u, 0u, 0u}; *(LAS u32x4*)(smem + LDS_BAR_OFF) = z; }
        __syncthreads();
        bar = xcd_barrier_post((unsigned*)(p.ws + OFF_BAR), (volatile LAS unsigned*)(smem + LDS_BAR_OFF));
    }
#ifndef PHMASK
#define PHMASK 0xFFFF
#endif
#define PH_ON(i) (((PHMASK >> (i)) & 1) && p.lo <= (i) && (i) < p.hi)
#define PH_SYNC(i) do { if (multi && (i) + 1 < p.hi) { TP_BEGIN(7); xcd_barrier(bar); TP_END(7); } } while (0)
#ifndef REPEAT_MASK
#define REPEAT_MASK 0
#endif
#define PH_REP(i) for (int rep_ = 0; rep_ < 1 + ((REPEAT_MASK >> (i)) & 1); ++rep_)
    if (PH_ON(0)) { const Params q = load_params(); TP_BEGIN(8); PH_REP(0) phase_prologue(q); TP_END(8); PH_SYNC(0); }
    if (PH_ON(1)) { const Params q = load_params(); TP_BEGIN(9); PH_REP(1) { EpiProjRope e; e.P = (bf16_t*)(q.ws + OFF_BIG); e.DVTp = (bf16_t*)(q.ws + OFF_DVT); e.c128 = (const float*)(q.ws + OFF_COS128); e.s128 = (const float*)(q.ws + OFF_SIN128); e.c64 = (const float*)(q.ws + OFF_COS64); e.s64 = (const float*)(q.ws + OFF_SIN64); e.raw = 0; e.row_limit = MPAD; gemm256<true>((const bf16_t*)(q.ws + OFF_HN), (const bf16_t*)(q.ws + OFF_WINT), 1024, MPAD / 256, 4096 / 256, (LAS bf16_t*)smem, e); } TP_END(9); PH_SYNC(1); }
#ifdef ROPE_SEPARATE
    if (PH_ON(2)) { const Params q = load_params(); TP_BEGIN(5); phase_rope(q, smem, (bf16_t*)(q.ws + OFF_BIG), MROWS, true); TP_END(5); PH_SYNC(2); }
#endif
#ifdef PROJ_CHECK
    {   const Params q = load_params();
        phase_proj_ref_naive(q);
        xcd_barrier(bar);
        phase_rope(q, smem, (bf16_t*)(q.ws + OFF_ST), PCH_ROWS, false);
        xcd_barrier(bar);
        phase_proj_compare(q);
        xcd_barrier(bar);
    }
#endif
    if (PH_ON(3)) { const Params q = load_params(); PH_REP(3) {
#ifndef RS_REP
#define RS_REP 1
#endif
#ifndef DSA_REP
#define DSA_REP 1
#endif
            for (int rr_ = 0; rr_ < RS_REP; ++rr_) phase_ret_state_mfma(q, smem);
#ifdef PROJ_CHECK
            {
                bf16_t* mixed_ = (bf16_t*)(q.ws + OFF_HN);
                for (int idx = blockIdx.x * NTHREADS + threadIdx.x; idx < NF * 64; idx += gridDim.x * NTHREADS) { const int row = idx >> 6, c8 = idx & 63; const u32x4 z = {0u, 0u, 0u, 0u}; *(u32x4*)(mixed_ + (size_t)row * DM + 512 + c8 * 8) = z; }
            }
#else
            for (int rr_ = 0; rr_ < DSA_REP; ++rr_) { phase_dsa_fast(q, smem); __syncthreads(); }
#endif
#ifdef DSA_CHECK
            __syncthreads(); xcd_barrier(bar); phase_dsa_naive<true>(q, smem);
#endif
        } PH_SYNC(3); }
    if (PH_ON(4)) { const Params q = load_params(); TP_BEGIN(6); phase_ret_scan(q); TP_END(6); PH_SYNC(4); }
    if (PH_ON(5)) { const Params q = load_params(); PH_REP(5) phase_ret_out_mfma(q, smem); PH_SYNC(5); }
    if (PH_ON(6)) { const Params q = load_params(); PH_REP(6) {
#ifdef PROJ_CHECK
        EpiOut e; e.H = q.out; e.X = q.x; gemm256<false>(
#else
        EpiOutT e; e.H = q.out; e.X = q.x; e.HG = (bf16_t*)(q.ws + OFF_HG); e.G = q.norm_ffn; e.SSQ = (float*)(q.ws + OFF_SSQ); gemm256<true>(
#endif
        (const bf16_t*)(q.ws + OFF_HN), (const bf16_t*)(q.ws + OFF_WOUTT), 1024, NF / 256, 1024 / 256, (LAS bf16_t*)smem, e); } phase_convert_tables(q); PH_SYNC(6); }
    if (PH_ON(8)) { const Params q = load_params(); PH_REP(8) { EpiPQ e; e.Q = (float*)(q.ws + OFF_BIG); gemm256<false>((const bf16_t*)(q.ws + OFF_HG), (const bf16_t*)(q.ws + OFF_WQT), 1024, NF / 256, 2048 / 256, (LAS bf16_t*)smem, e); } PH_SYNC(8); }
    if (PH_ON(9)) { const Params q = load_params(); PH_REP(9) { phase_peer_select(q, smem); }
        if (TP_SEC && blockIdx.x == 0 && threadIdx.x == 0) { volatile LAS long long* tp_ = (volatile LAS long long*)(smem + TP_LDS_OFF); const float fr = (float)tp_[2] / (float)((long long)__builtin_readcyclecounter() - tp_[0]); ((float*)(p.ws + OFF_BAR))[3602] = fr; }
        asm volatile("s_waitcnt vmcnt(0)" ::: "memory"); __syncthreads(); }
    if (PH_ON(10)) { const Params q = load_params(); phase_peer_out_rows(q, smem); }
}

extern "C" void kernel_launch(void* const* d_in, const int* in_sizes, int n_in, void* d_out, int out_size, void* d_ws, size_t ws_size, hipStream_t stream) {
    static int grid = 0;
    if (grid == 0) {
        if (n_in != 12 || out_size != NF * DM || ws_size < WS_END) { fprintf(stderr, "kernel_launch: unexpected shapes (n_in %d out %d ws %zu need %zu)\n", n_in, out_size, ws_size, (size_t)WS_END); grid = -1; return; }
        int dev = 0, cus = 0, per_cu = 0;
        if (hipGetDevice(&dev) != hipSuccess || hipDeviceGetAttribute(&cus, hipDeviceAttributeMultiprocessorCount, dev) != hipSuccess) { grid = -1; return; }
        if (hipFuncSetAttribute((const void*)mk_forward, hipFuncAttributeMaxDynamicSharedMemorySize, LDS_BYTES) != hipSuccess) { fprintf(stderr, "kernel_launch: hipFuncSetAttribute failed\n"); grid = -1; return; }
        if (hipOccupancyMaxActiveBlocksPerMultiprocessor(&per_cu, (const void*)mk_forward, NTHREADS, LDS_BYTES) != hipSuccess || per_cu < 1)
            fprintf(stderr, "kernel_launch: occupancy query reports %d blocks per CU\n", per_cu);
        (void)hipGetLastError();
        grid = cus > 0 ? cus : 256;
    }
    if (grid < 0) return;
    Params p{};
    p.x = (const float*)d_in[0]; p.meta = (const float*)d_in[1]; p.norm_mix = (const float*)d_in[2]; p.w_in = (const float*)d_in[3];
    p.w_uv = (const float*)d_in[4]; p.w_out = (const float*)d_in[5]; p.norm_ffn = (const float*)d_in[6]; p.wq = (const float*)d_in[7];
    p.sk = (const float*)d_in[8]; p.pu = (const float*)d_in[9]; p.pv = (const float*)d_in[10]; p.norm_final = (const float*)d_in[11];
    p.out = (float*)d_out; p.ws = (char*)d_ws; p.pad0 = 0; p.pad1 = 0;
    (void)hipMemsetAsync((char*)d_ws + OFF_BAR, 0, 16384, stream);
#if MK_LAUNCHES == 1
    p.lo = 0; p.hi = NPHASES + 1;
    hipLaunchKernelGGL(mk_forward, dim3(grid), dim3(NTHREADS), LDS_BYTES, stream, p);
#else
    for (int ph = 0; ph <= NPHASES; ++ph) { p.lo = ph; p.hi = ph + 1; hipLaunchKernelGGL(mk_forward, dim3(grid), dim3(NTHREADS), LDS_BYTES, stream, p); }
#endif
}
```

```cpp
#include <hip/hip_runtime.h>
#include <stdint.h>
#include <stdio.h>

#ifndef MK_LAUNCHES
#define MK_LAUNCHES 1
#endif

#define DI __device__ __forceinline__
#ifndef TP_SEC
#define TP_SEC 0
#endif
#ifndef CHK_GAIN
#define CHK_GAIN 10.f
#endif
#define TP_LDS_OFF (163840 - 128)
#define TP_BEGIN(k) do { if (TP_SEC == (k) && blockIdx.x == 0 && threadIdx.x == 0) { *(volatile __attribute__((address_space(3))) long long*)(tp_smem + TP_LDS_OFF + 8) = (long long)__builtin_readcyclecounter(); } } while (0)
#define TP_END(k) do { if (TP_SEC == (k) && blockIdx.x == 0 && threadIdx.x == 0) { volatile __attribute__((address_space(3))) long long* tp_ = (volatile __attribute__((address_space(3))) long long*)(tp_smem + TP_LDS_OFF); tp_[2] += (long long)__builtin_readcyclecounter() - tp_[1]; } } while (0)
typedef unsigned short bf16_t;
typedef short bf16x8 __attribute__((ext_vector_type(8)));
typedef float f32x4 __attribute__((ext_vector_type(4)));
typedef unsigned u32x4 __attribute__((ext_vector_type(4)));

constexpr int NB = 8, SEQ = 2048, NMETA = 16, TT = 2064, DM = 1024, INW = 3912;
constexpr int MROWS = NB * TT;
constexpr int MPAD = 16640;
constexpr int NF = NB * SEQ;
constexpr int C_RQ = 0, C_RK = 512, C_RV = 1024, C_RG = 1536, C_DQ = 2048, C_DK = 3072, C_DV = 3200, C_IQ = 3328, C_IK = 3840, C_IW = 3904;
constexpr int NTHREADS = 512, NWAVES = 8;
constexpr int LDS_BYTES = 163840;
constexpr int LDS_BAR_OFF = 163840 - 256;

constexpr size_t al256(size_t x) { return (x + 255) & ~(size_t)255; }
constexpr size_t OFF_BAR = 0;
constexpr size_t OFF_COS128 = 16384;
constexpr size_t OFF_SIN128 = OFF_COS128 + al256((size_t)TT * 64 * 4);
constexpr size_t OFF_COS64 = OFF_SIN128 + al256((size_t)TT * 64 * 4);
constexpr size_t OFF_SIN64 = OFF_COS64 + al256((size_t)TT * 32 * 4);
constexpr size_t OFF_WINT = OFF_SIN64 + al256((size_t)TT * 32 * 4);
constexpr size_t OFF_WOUTT = OFF_WINT + (size_t)4096 * 1024 * 2;
constexpr size_t OFF_WQT = OFF_WOUTT + (size_t)1024 * 1024 * 2;
constexpr size_t OFF_SKH = OFF_WQT + (size_t)2048 * 1024 * 2;
constexpr size_t OFF_SKL = OFF_SKH + (size_t)2048 * 128 * 2;
constexpr int TTP = 2176;
constexpr size_t OFF_WUVT = OFF_SKL + (size_t)2048 * 128 * 2;
constexpr size_t OFF_DVT = OFF_WUVT + (size_t)8 * 64 * 128 * 2;
constexpr size_t OFF_HN = OFF_DVT + (size_t)NB * 128 * TTP * 2;
constexpr size_t OFF_BIG = OFF_HN + (size_t)MPAD * 1024 * 2;
constexpr size_t BIG_BYTES = (size_t)NF * 2048 * 4;
constexpr size_t OFF_ST = OFF_BIG + al256(BIG_BYTES);
constexpr size_t ST_BYTES = (size_t)32 * 34 * 16384 * 4;
constexpr size_t OFF_EG = OFF_ST;
constexpr size_t OFF_U8 = OFF_EG + (size_t)NF * 128 * 4;
constexpr size_t OFF_SU = OFF_U8 + (size_t)16384 * 1024;
constexpr size_t OFF_V8 = OFF_SU + 65536;
constexpr size_t OFF_SV = OFF_V8 + (size_t)16384 * 1024;
constexpr size_t OFF_HG = OFF_SV + 65536;
constexpr size_t OFF_SSQ = OFF_HG + (size_t)NF * 1024 * 2;
constexpr size_t WS_END = OFF_SSQ + (size_t)NF * 4;
static_assert(OFF_ST + ST_BYTES <= WS_END, "retention states fit");
static_assert(WS_END <= (size_t)268435456, "workspace");

struct Params {
    const float *x, *meta, *norm_mix, *w_in, *w_uv, *w_out, *norm_ffn, *wq, *sk, *pu, *pv, *norm_final;
    float* out; char* ws; int lo, hi, pad0, pad1;
};

DI float bf2f(bf16_t v) { return __uint_as_float(((unsigned)v) << 16); }
typedef float f32x2_t __attribute__((ext_vector_type(2)));
typedef __bf16 bf16x2_t __attribute__((ext_vector_type(2)));
DI bf16_t f2bf(float f) { const __bf16 h = (__bf16)f; return __builtin_bit_cast(unsigned short, h); }
DI unsigned pk2bf(float a, float b) { const f32x2_t v = {a, b}; const bf16x2_t h = __builtin_convertvector(v, bf16x2_t); return __builtin_bit_cast(unsigned, h); }
DI float wave_sum(float v) {
#pragma unroll
    for (int o = 32; o > 0; o >>= 1) v += __shfl_xor(v, o);
    return v;
}
DI float wave_max(float v) {
#pragma unroll
    for (int o = 32; o > 0; o >>= 1) v = fmaxf(v, __shfl_xor(v, o));
    return v;
}
DI unsigned long long wave_max_u64(unsigned long long v) {
#pragma unroll
    for (int o = 32; o > 0; o >>= 1) {
        const unsigned hi = __shfl_xor((unsigned)(v >> 32), o), lo = __shfl_xor((unsigned)v, o);
        const unsigned long long w = ((unsigned long long)hi << 32) | lo;
        v = w > v ? w : v;
    }
    return v;
}
DI unsigned fkey(float x) { const unsigned u = __float_as_uint(x); return (u & 0x80000000u) ? ~u : (u | 0x80000000u); }
DI float funkey(unsigned k) { const unsigned u = (k & 0x80000000u) ? (k & 0x7fffffffu) : ~k; return __uint_as_float(u); }
DI void lds_fence() { asm volatile("s_waitcnt lgkmcnt(0)" ::: "memory"); }
DI void unpack8(const u32x4& r, float (&v)[8]) {
    v[0] = __uint_as_float(r.x << 16); v[1] = __uint_as_float(r.x & 0xffff0000u);
    v[2] = __uint_as_float(r.y << 16); v[3] = __uint_as_float(r.y & 0xffff0000u);
    v[4] = __uint_as_float(r.z << 16); v[5] = __uint_as_float(r.z & 0xffff0000u);
    v[6] = __uint_as_float(r.w << 16); v[7] = __uint_as_float(r.w & 0xffff0000u);
}

typedef float f32x16 __attribute__((ext_vector_type(16)));
DI bf16x8 pack8(const float (&x)[8]) {
    u32x4 r;
#pragma unroll
    for (int j = 0; j < 4; ++j) r[j] = pk2bf(x[2 * j], x[2 * j + 1]);
    return __builtin_bit_cast(bf16x8, r);
}
DI bf16x8 pack_hi8(const float (&x)[8], float (&rem)[8]) {
    u32x4 r;
#pragma unroll
    for (int j = 0; j < 4; ++j) { r[j] = pk2bf(x[2 * j], x[2 * j + 1]); rem[2 * j] = x[2 * j] - __uint_as_float(r[j] << 16); rem[2 * j + 1] = x[2 * j + 1] - __uint_as_float(r[j] & 0xffff0000u); }
    return __builtin_bit_cast(bf16x8, r);
}

DI float dpp_row_sum(float v) {
    v += __int_as_float(__builtin_amdgcn_update_dpp(0, __float_as_int(v), 0xB1, 0xF, 0xF, true));
    v += __int_as_float(__builtin_amdgcn_update_dpp(0, __float_as_int(v), 0x4E, 0xF, 0xF, true));
    v += __int_as_float(__builtin_amdgcn_update_dpp(0, __float_as_int(v), 0x141, 0xF, 0xF, true));
    v += __int_as_float(__builtin_amdgcn_update_dpp(0, __float_as_int(v), 0x140, 0xF, 0xF, true));
    return v;
}
DI float wave_sum_uniform(float v) {
    v = dpp_row_sum(v);
    const float a = __int_as_float(__builtin_amdgcn_readlane(__float_as_int(v), 0)), b = __int_as_float(__builtin_amdgcn_readlane(__float_as_int(v), 16));
    const float c = __int_as_float(__builtin_amdgcn_readlane(__float_as_int(v), 32)), d = __int_as_float(__builtin_amdgcn_readlane(__float_as_int(v), 48));
    return (a + b) + (c + d);
}

DI int wave_sum_int(int v) {
    v += __builtin_amdgcn_update_dpp(0, v, 0xB1, 0xF, 0xF, true);
    v += __builtin_amdgcn_update_dpp(0, v, 0x4E, 0xF, 0xF, true);
    v += __builtin_amdgcn_update_dpp(0, v, 0x141, 0xF, 0xF, true);
    v += __builtin_amdgcn_update_dpp(0, v, 0x140, 0xF, 0xF, true);
    return (__builtin_amdgcn_readlane(v, 0) + __builtin_amdgcn_readlane(v, 16)) + (__builtin_amdgcn_readlane(v, 32) + __builtin_amdgcn_readlane(v, 48));
}

#define XB_TMO      128
#define XB_XCNT(j)  (256  + 64 * (j))
#define XB_XSUB(j)  (1280 + 64 * (j))
#define XB_XGEN(j)  (2304 + 64 * (j))
#define XB_TOP      3328
#define XB_TOPGEN   3392
#define XCD_BAR_WORDS 3456
#define XB_SPIN_CAP (1u << 20)
#define LAS __attribute__((address_space(3)))

DI unsigned xb_ld(unsigned* p)              { return __hip_atomic_load(p, __ATOMIC_RELAXED, __HIP_MEMORY_SCOPE_AGENT); }
DI unsigned xb_add(unsigned* p, unsigned v) { return __hip_atomic_fetch_add(p, v, __ATOMIC_RELAXED, __HIP_MEMORY_SCOPE_AGENT); }
DI unsigned xb_xcc_id() { return (unsigned)__builtin_amdgcn_s_getreg((3 << 11) | 20) & 0xFu; }
#define XB_SPIN(cond, bar) do { unsigned _sp = 0; while (cond) { __builtin_amdgcn_s_sleep(1); \
    if ((++_sp & 255u) == 0u) { if (xb_ld(&(bar)[XB_TMO])) break; if (_sp > XB_SPIN_CAP) { atomicAdd(&(bar)[XB_TMO], 1u); break; } } } } while (0)

struct XcdBarrier { unsigned* bar; unsigned x; volatile LAS unsigned* st; };

DI XcdBarrier xcd_barrier_post(unsigned* bar, volatile LAS unsigned* st) {
    XcdBarrier b; b.bar = bar; b.x = xb_xcc_id(); b.st = st;
    if (threadIdx.x == 0) (void)xb_add(&bar[XB_XCNT(b.x)], 1u);
    return b;
}
DI void xcd_barrier_complete(unsigned* bar, unsigned x, unsigned& nloc, unsigned& nx) {
    const unsigned G = gridDim.x * gridDim.y * gridDim.z;
    unsigned sum, cnt, mine, sp = 0u;
    for (;;) {
        sum = 0u; cnt = 0u; mine = 0u;
#pragma unroll
        for (unsigned j = 0; j < 16; ++j) { const unsigned c = xb_ld(&bar[XB_XCNT(j)]); sum += c; cnt += (c > 0u) ? 1u : 0u; mine = (j == x) ? c : mine; }
        if (sum == G) break;
        __builtin_amdgcn_s_sleep(1);
        if ((++sp & 255u) == 0u) { if (xb_ld(&bar[XB_TMO])) break; if (sp > XB_SPIN_CAP) { atomicAdd(&bar[XB_TMO], 1u); break; } }
    }
    nloc = mine > 0u ? mine : 1u; nx = cnt > 0u ? cnt : 1u;
}
DI void xcd_barrier(const XcdBarrier& b) {
    asm volatile("s_waitcnt vmcnt(0)" ::: "memory");
    __syncthreads();
    if (threadIdx.x == 0) {
        unsigned* bar = b.bar;
        __builtin_amdgcn_s_waitcnt(0);
        unsigned nloc = b.st[0], nx = b.st[1];
        if (nloc == 0u) { xcd_barrier_complete(bar, b.x, nloc, nx); b.st[0] = nloc; b.st[1] = nx; }
        const unsigned old = xb_add(&bar[XB_XSUB(b.x)], 1u);
        const unsigned gen = old / nloc;
        if (old + 1u == (gen + 1u) * nloc) {
            __builtin_amdgcn_fence(__ATOMIC_RELEASE, "agent");
            asm volatile("s_waitcnt vmcnt(0)" ::: "memory");
            const unsigned og = xb_add(&bar[XB_TOP], 1u);
            const unsigned tg = og / nx;
            if (og + 1u == (tg + 1u) * nx) xb_add(&bar[XB_TOPGEN], 1u);
            else XB_SPIN(xb_ld(&bar[XB_TOPGEN]) == tg, bar);
            __builtin_amdgcn_fence(__ATOMIC_ACQUIRE, "agent");
            xb_add(&bar[XB_XGEN(b.x)], 1u);
            asm volatile("s_waitcnt vmcnt(0)" ::: "memory");
        } else {
            XB_SPIN(xb_ld(&bar[XB_XGEN(b.x)]) == gen, bar);
            __builtin_amdgcn_fence(__ATOMIC_ACQUIRE, "agent");
            asm volatile("s_waitcnt vmcnt(0)" ::: "memory");
        }
    }
    __syncthreads();
}

constexpr int BM = 256, BK = 64, HALF = 128, NXCD = 8, WGM = 8, HT = HALF * BK;
DI int lds_byte(int r, int c) {
    int st = (r >> 4) * 2 + (c >> 5), rr = r & 15, cc = c & 31, ob = rr * 64 + cc * 2;
    return st * 1024 + (ob ^ (((ob >> 9) & 1) << 5));
}
DI void stage_rc(int b, int& R, int& C) {
    int st = b / 1024, sb = b % 1024, swz = sb ^ (((sb >> 9) & 1) << 5);
    R = (st >> 1) * 16 + swz / 64; C = (st & 1) * 32 + (swz % 64) / 2;
}

#define SA(b,h) (shm+((b)*2+(h))*HT)
#define SB(b,h) (shm+(4+(b)*2+(h))*HT)
#define STAGE_X(T,P,BASE,br,kt) do{long _g=(long)(br)*K+(long)(kt)*BK; \
    for(int _i=0;_i<2;++_i){int _b=(T)*16+_i*8192;int _r,_c;stage_rc(_b,_r,_c); \
      __builtin_amdgcn_global_load_lds((const unsigned*)(BASE+_g+(long)_r*K+_c), \
        (LAS unsigned*)((LAS char*)(P)+_b),16,0,0);}}while(0)
#define STAGE(P,BASE,br,kt) STAGE_X(threadIdx.x,P,BASE,br,kt)
#define LDA(dst,b,h) for(int m=0;m<4;++m)for(int k=0;k<2;++k) \
    dst[m][k]=*reinterpret_cast<const LAS bf16x8*>((LAS char*)SA(b,h)+lds_byte(wr*64+m*16+fr,k*32+fq*8))
#define LDB(dst,b,h) for(int n=0;n<2;++n)for(int k=0;k<2;++k) \
    dst[n][k]=*reinterpret_cast<const LAS bf16x8*>((LAS char*)SB(b,h)+lds_byte(wc*32+n*16+fr,k*32+fq*8))
#define MMA(ai,bj,At,Bt_) do{__builtin_amdgcn_s_setprio(1); \
    for(int m=0;m<4;++m)for(int n=0;n<2;++n)for(int k=0;k<2;++k) \
      acc[ai][bj][m][n]=TRANS?__builtin_amdgcn_mfma_f32_16x16x32_bf16(Bt_[n][k],At[m][k],acc[ai][bj][m][n],0,0,0):__builtin_amdgcn_mfma_f32_16x16x32_bf16(At[m][k],Bt_[n][k],acc[ai][bj][m][n],0,0,0); \
    __builtin_amdgcn_s_setprio(0);}while(0)
#define WAIT_V(n) asm volatile("s_waitcnt vmcnt(" #n ")":::"memory")
#define WAIT_L(n) asm volatile("s_waitcnt lgkmcnt(" #n ")":::"memory")
#define BAR __builtin_amdgcn_s_barrier()
#define SCHED __builtin_amdgcn_sched_barrier(0)

template <bool TRANS, class Epi>
DI void gemm256(const bf16_t* __restrict__ A, const bf16_t* __restrict__ Bt, const int K, const int nM, const int nN, LAS bf16_t* shm, const Epi& epi) {
    const int nwg = nM * nN;
    for (int L = blockIdx.x; L < nwg; L += gridDim.x) {
        int wgid = L;
        { int q = nwg / NXCD, r = nwg % NXCD, xcd = wgid % NXCD, off = wgid / NXCD; wgid = (xcd < r ? xcd * (q + 1) : r * (q + 1) + (xcd - r) * q) + off; }
        int nig = WGM * nN, gid = wgid / nig, fm = gid * WGM, gsz = min(nM - fm, WGM);
        int pm = fm + ((wgid % nig) % gsz), pn = (wgid % nig) / gsz, brow = pm * BM, bcol = pn * BM;
        int wid = threadIdx.x >> 6, lane = threadIdx.x & 63, wr = wid >> 2, wc = wid & 3, fr = lane & 15, fq = lane >> 4;
        f32x4 acc[2][2][4][2] = {};
        bf16x8 At[4][2], B0[2][2], B1[2][2];
        int nt = K / BK;
        STAGE(SB(0,0),Bt,bcol,0); STAGE(SA(0,0),A,brow,0);
        STAGE(SB(0,1),Bt,bcol+HALF,0); STAGE(SA(0,1),A,brow+HALF,0);
        if (wr == 1) BAR;
        WAIT_V(4); BAR;
        STAGE(SB(1,0),Bt,bcol,1); STAGE(SA(1,0),A,brow,1); STAGE(SB(1,1),Bt,bcol+HALF,1);
        WAIT_V(6); BAR;
        for (int t = 0; t < nt - 2; t += 2) {
            LDB(B0,0,0); SCHED; LDA(At,0,0); STAGE(SA(1,1),A,brow+HALF,t+1);
            WAIT_L(8); BAR; WAIT_L(0); MMA(0,0,At,B0); BAR; SCHED;
            LDB(B1,0,1); STAGE(SB(0,0),Bt,bcol,t+2);
            BAR; WAIT_L(0); MMA(0,1,At,B1); BAR;
            LDA(At,0,1); STAGE(SA(0,0),A,brow,t+2);
            BAR; WAIT_L(0); MMA(1,0,At,B0); BAR; SCHED;
            STAGE(SB(0,1),Bt,bcol+HALF,t+2);
            WAIT_V(6); BAR; MMA(1,1,At,B1); BAR;
            LDB(B0,1,0); SCHED; LDA(At,1,0); STAGE(SA(0,1),A,brow+HALF,t+2);
            WAIT_L(8); BAR; WAIT_L(0); MMA(0,0,At,B0); BAR; SCHED;
            LDB(B1,1,1); STAGE(SB(1,0),Bt,bcol,t+3);
            BAR; WAIT_L(0); MMA(0,1,At,B1); BAR;
            LDA(At,1,1); STAGE(SA(1,0),A,brow,t+3);
            BAR; WAIT_L(0); MMA(1,0,At,B0); BAR; SCHED;
            STAGE(SB(1,1),Bt,bcol+HALF,t+3);
            WAIT_V(6); BAR; MMA(1,1,At,B1); BAR;
        }
        int tz = threadIdx.x; asm volatile("" : "+v"(tz)); wid = tz >> 6; lane = tz & 63; wr = wid >> 2; wc = wid & 3; fr = lane & 15; fq = lane >> 4;
        { LDB(B0,0,0); WAIT_V(0); LDA(At,0,0); STAGE_X(tz,SA(1,1),A,brow+HALF,nt-1);
          BAR; WAIT_L(0); MMA(0,0,At,B0); BAR;
          LDB(B1,0,1); BAR; WAIT_L(0); MMA(0,1,At,B1); BAR;
          LDA(At,0,1); WAIT_V(4); BAR; WAIT_L(0); MMA(1,0,At,B0); MMA(1,1,At,B1); BAR; }
        { LDB(B0,1,0); LDA(At,1,0); WAIT_V(2); BAR; WAIT_L(0); MMA(0,0,At,B0); BAR;
          LDB(B1,1,1); WAIT_V(0); BAR; WAIT_L(0); MMA(0,1,At,B1); BAR;
          LDA(At,1,1); BAR; WAIT_L(0); MMA(1,0,At,B0); MMA(1,1,At,B1); BAR; }
        if (wr == 0) BAR;
        epi(acc, brow, bcol, wr, wc, fr, fq);
        __syncthreads();
    }
}

struct EpiOut {
    float* H; const float* X;
    DI void operator()(const f32x4 (&acc)[2][2][4][2], int brow, int bcol, int wr, int wc, int fr, int fq) const {
#pragma unroll
        for (int ai = 0; ai < 2; ++ai)
#pragma unroll
        for (int bj = 0; bj < 2; ++bj)
#pragma unroll
        for (int m = 0; m < 4; ++m)
#pragma unroll
        for (int n = 0; n < 2; ++n)
#pragma unroll
        for (int j = 0; j < 4; ++j) {
            const int row = brow + ai * HALF + wr * 64 + m * 16 + fq * 4 + j, col = bcol + bj * HALF + wc * 32 + n * 16 + fr;
            const size_t o = (size_t)row * DM + col; H[o] = X[o] + acc[ai][bj][m][n][j];
        }
    }
};
struct EpiPQ {
    float* Q;
    DI void operator()(const f32x4 (&acc)[2][2][4][2], int brow, int bcol, int wr, int wc, int fr, int fq) const {
#pragma unroll
        for (int ai = 0; ai < 2; ++ai)
#pragma unroll
        for (int bj = 0; bj < 2; ++bj)
#pragma unroll
        for (int m = 0; m < 4; ++m)
#pragma unroll
        for (int n = 0; n < 2; ++n)
#pragma unroll
        for (int j = 0; j < 4; ++j) {
            const int row = brow + ai * HALF + wr * 64 + m * 16 + fq * 4 + j, col = bcol + bj * HALF + wc * 32 + n * 16 + fr;
            Q[(size_t)row * 2048 + col] = acc[ai][bj][m][n][j];
        }
    }
};

struct EpiOutT {
    float* H; const float* X; bf16_t* HG; const float* G; float* SSQ;
    DI void operator()(const f32x4 (&acc)[2][2][4][2], int brow, int bcol, int wr, int wc, int fr, int fq) const {
#pragma unroll
        for (int ai = 0; ai < 2; ++ai)
#pragma unroll
        for (int m = 0; m < 4; ++m) {
            const int row = brow + ai * HALF + wr * 64 + m * 16 + fr;
            const size_t o = (size_t)row * DM + bcol + wc * 32 + fq * 4;
            const float* xp = X + o; float* hp = H + o; bf16_t* gp = HG + o; const float* gn = G + bcol + wc * 32 + fq * 4;
            float ss = 0.f;
#pragma unroll
            for (int bj = 0; bj < 2; ++bj)
#pragma unroll
            for (int n = 0; n < 2; ++n) {
                const f32x4 x = *(const f32x4*)(xp + bj * HALF + n * 16); const f32x4 hv = x + acc[ai][bj][m][n];
                *(f32x4*)(hp + bj * HALF + n * 16) = hv;
                ss += hv[0] * hv[0] + hv[1] * hv[1] + hv[2] * hv[2] + hv[3] * hv[3];
                const f32x4 hg = hv * *(const f32x4*)(gn + bj * HALF + n * 16);
                uint2 w; w.x = pk2bf(hg[0], hg[1]); w.y = pk2bf(hg[2], hg[3]); *(uint2*)(gp + bj * HALF + n * 16) = w;
            }
            ss += __shfl_xor(ss, 16); ss += __shfl_xor(ss, 32);
            if (fq == 0) atomicAdd(SSQ + row, ss);
            __builtin_amdgcn_sched_barrier(0);
        }
    }
};

__host__ __device__ constexpr int proj_true_col(int n) {
    const int blk = n >> 7, P = n & 127, wc = P >> 5, nn = (P >> 4) & 1, i = P & 15;
    return blk * 128 + (blk < 26 ? wc * 16 + i + 64 * nn : (wc >> 1) * 64 + (wc & 1) * 16 + i + 32 * nn);
}
struct EpiProjRope {
    bf16_t* P; bf16_t* DVTp; const float *c128, *s128, *c64, *s64; int raw, row_limit;
    DI void operator()(const f32x4 (&acc)[2][2][4][2], int brow, int bcol, int wr, int wc, int fr, int fq) const {
#pragma unroll
        for (int ai = 0; ai < 2; ++ai)
#pragma unroll
        for (int m = 0; m < 4; ++m) {
            const int row = brow + ai * HALF + wr * 64 + m * 16 + fr;
            if (row >= row_limit) continue;
            const int b = row / TT, t = row - b * TT;
            bf16_t* rp = P + (size_t)row * INW;
#pragma unroll
            for (int bj = 0; bj < 2; ++bj) {
                const int cb = bcol + bj * HALF;
                const f32x4 x1 = acc[ai][bj][m][0], x2 = acc[ai][bj][m][1];
                f32x4 o1 = x1, o2 = x2; int c1, c2; bool st2 = true;
                if (cb < C_IQ) {
                    const int f = wc * 16 + fq * 4; c1 = cb + f; c2 = c1 + 64;
                    const bool roped = (cb < C_RV) || (cb >= C_DQ && cb < C_DV);
                    if (roped && !raw) {
                        const float sc = (cb < C_RK) ? 1.f : (cb < C_RV) ? 0.08838834764831845f : (cb < C_DK) ? 0.08838834764831845f * 1.4426950408889634f : 1.f;
                        const f32x4 cs = *(const f32x4*)(c128 + t * 64 + f), sn = *(const f32x4*)(s128 + t * 64 + f);
                        o1 = (x1 * cs - x2 * sn) * sc; o2 = (x2 * cs + x1 * sn) * sc;
                    }
                    if (cb == C_DV && row < MROWS && !raw) {
                        bf16_t* dp = DVTp + (size_t)(b * 128 + f) * TTP + t;
#pragma unroll
                        for (int j = 0; j < 4; ++j) { dp[(size_t)j * TTP] = f2bf(x1[j]); dp[(size_t)(64 + j) * TTP] = f2bf(x2[j]); }
                    }
                } else if (cb < 3968) {
                    const int hl = wc >> 1, f = (wc & 1) * 16 + fq * 4; c1 = cb + hl * 64 + f; c2 = c1 + 32;
                    if (raw) { if (hl == 1 && cb >= C_IK) { st2 = false; if (c1 >= INW) continue; } }
                    else if (cb < C_IK || hl == 0) {
                        const float sc = (cb < C_IK) ? 0.125f : 1.f;
                        const f32x4 cs = *(const f32x4*)(c64 + t * 32 + f), sn = *(const f32x4*)(s64 + t * 32 + f);
                        o1 = (x1 * cs - x2 * sn) * sc; o2 = (x2 * cs + x1 * sn) * sc;
                    } else { o1 = x1 * 0.35355339059327373f; st2 = false; if (c1 >= INW) continue; }
                } else continue;
                uint2 w1; w1.x = pk2bf(o1[0], o1[1]); w1.y = pk2bf(o1[2], o1[3]); *(uint2*)(rp + c1) = w1;
                if (st2) { uint2 w2; w2.x = pk2bf(o2[0], o2[1]); w2.y = pk2bf(o2[2], o2[3]); *(uint2*)(rp + c2) = w2; }
            }
        }
    }
};

DI void phase_prologue(const Params& p) {
    const int gtid = blockIdx.x * NTHREADS + threadIdx.x, gsz = gridDim.x * NTHREADS;
    bf16_t* wint = (bf16_t*)(p.ws + OFF_WINT);
    for (int idx = gtid; idx < 4096 * 1024; idx += gsz) {
        const int k = idx >> 12, n = idx & 4095;
        const int src = proj_true_col(n);
        const float v = src < INW ? p.w_in[(size_t)k * INW + src] : 0.f;
        wint[(size_t)n * 1024 + k] = f2bf(v);
    }
    { float* ssq = (float*)(p.ws + OFF_SSQ); for (int idx = gtid; idx < NF; idx += gsz) ssq[idx] = 0.f; }
    {
        bf16_t* dvt = (bf16_t*)(p.ws + OFF_DVT);
        for (int idx = gtid; idx < NB * 128 * (TTP - TT); idx += gsz) { const int rw = idx / (TTP - TT), t = TT + idx % (TTP - TT); dvt[(size_t)rw * TTP + t] = (bf16_t)0; }
    }
    bf16_t* woutt = (bf16_t*)(p.ws + OFF_WOUTT);
    for (int idx = gtid; idx < 1024 * 1024; idx += gsz) {
        const int k = idx >> 10, n = idx & 1023;
        woutt[(size_t)n * 1024 + k] = f2bf(p.w_out[(size_t)k * 1024 + n]);
    }
    {
        bf16_t* wst = (bf16_t*)(p.ws + OFF_WQT);
        const int wave_ = threadIdx.x >> 6, lane_ = threadIdx.x & 63, r = lane_ & 31, hh = lane_ >> 5;
        for (int task = blockIdx.x * NWAVES + wave_; task < 16 * 32; task += gridDim.x * NWAVES) {
            const int hf = task >> 5, k0 = (task & 31) * 32;
            f32x16 acc[4];
#pragma unroll
            for (int nb = 0; nb < 4; ++nb)
#pragma unroll
                for (int i = 0; i < 16; ++i) acc[nb][i] = 0.f;
            const float* arow = p.wq + (size_t)(k0 + r) * 2048 + hf * 128 + 8 * hh;
            const float* brow = p.sk + (size_t)(hf * 128 + r) * 128 + 8 * hh;
#pragma unroll 1
            for (int ks = 0; ks < 8; ++ks) {
                const float4 a0 = *(const float4*)(arow + ks * 16), a1 = *(const float4*)(arow + ks * 16 + 4);
                const float af[8] = {a0.x, a0.y, a0.z, a0.w, a1.x, a1.y, a1.z, a1.w}; float ar[8];
                const bf16x8 ah = pack_hi8(af, ar); const bf16x8 al = pack8(ar);
#pragma unroll
                for (int nb = 0; nb < 4; ++nb) {
                    const float4 b0 = *(const float4*)(brow + (size_t)nb * 32 * 128 + ks * 16), b1 = *(const float4*)(brow + (size_t)nb * 32 * 128 + ks * 16 + 4);
                    const float bf_[8] = {b0.x, b0.y, b0.z, b0.w, b1.x, b1.y, b1.z, b1.w}; float br[8];
                    const bf16x8 bh = pack_hi8(bf_, br); const bf16x8 bl = pack8(br);
                    acc[nb] = __builtin_amdgcn_mfma_f32_32x32x16_bf16(ah, bh, acc[nb], 0, 0, 0);
                    acc[nb] = __builtin_amdgcn_mfma_f32_32x32x16_bf16(ah, bl, acc[nb], 0, 0, 0);
                    acc[nb] = __builtin_amdgcn_mfma_f32_32x32x16_bf16(al, bh, acc[nb], 0, 0, 0);
                }
            }
#pragma unroll
            for (int nb = 0; nb < 4; ++nb) {
                bf16_t* orow = wst + (size_t)(hf * 128 + nb * 32 + r) * 1024 + k0 + 4 * hh;
#pragma unroll
                for (int g4 = 0; g4 < 4; ++g4) { uint2 w; w.x = pk2bf(acc[nb][4 * g4], acc[nb][4 * g4 + 1]); w.y = pk2bf(acc[nb][4 * g4 + 2], acc[nb][4 * g4 + 3]); *(uint2*)(orow + 8 * g4) = w; }
            }
        }
    }
    bf16_t* wuvt = (bf16_t*)(p.ws + OFF_WUVT);
    for (int idx = gtid; idx < 8 * 64 * 128; idx += gsz) {
        const int h = idx >> 13, e = (idx >> 7) & 63, dv = idx & 127;
        wuvt[idx] = f2bf(p.w_uv[(size_t)(h * 128 + dv) * 64 + e]);
    }
    float* c128 = (float*)(p.ws + OFF_COS128); float* s128 = (float*)(p.ws + OFF_SIN128);
    for (int idx = gtid; idx < TT * 64; idx += gsz) {
        const int pos = idx >> 6, j = idx & 63;
        const float inv = powf(10000.f, -(float)j * 2.0f / 128.f);
        const float ang = (float)pos * inv;
        float s, c; sincosf(ang, &s, &c);
        c128[idx] = c; s128[idx] = s;
    }
    float* c64 = (float*)(p.ws + OFF_COS64); float* s64 = (float*)(p.ws + OFF_SIN64);
    for (int idx = gtid; idx < TT * 32; idx += gsz) {
        const int pos = idx >> 5, j = idx & 31;
        const float inv = powf(10000.f, -(float)j * 2.0f / 64.f);
        const float ang = (float)pos * inv;
        float s, c; sincosf(ang, &s, &c);
        c64[idx] = c; s64[idx] = s;
    }
    bf16_t* hn = (bf16_t*)(p.ws + OFF_HN);
    const int wave = threadIdx.x >> 6, lane = threadIdx.x & 63;
    for (int row = blockIdx.x * NWAVES + wave; row < MPAD; row += gridDim.x * NWAVES) {
        bf16_t* o = hn + (size_t)row * DM;
        if (row >= MROWS) {
            for (int i = 0; i < 4; ++i) *(uint2*)(o + i * 256 + lane * 4) = make_uint2(0u, 0u);
            continue;
        }
        const int b = row / TT, t = row % TT;
        const float* src = t < NMETA ? p.meta + (size_t)t * DM : p.x + ((size_t)b * SEQ + (t - NMETA)) * DM;
        float4 v[4]; float ss = 0.f;
#pragma unroll
        for (int i = 0; i < 4; ++i) { v[i] = *(const float4*)(src + i * 256 + lane * 4); ss += v[i].x * v[i].x + v[i].y * v[i].y + v[i].z * v[i].z + v[i].w * v[i].w; }
        ss = wave_sum(ss);
        const float rstd = rsqrtf(ss * (1.f / DM) + 1e-6f);
#pragma unroll
        for (int i = 0; i < 4; ++i) {
            const float4 g = *(const float4*)(p.norm_mix + i * 256 + lane * 4);
            uint2 w;
            w.x = (unsigned)f2bf(v[i].x * rstd * g.x) | ((unsigned)f2bf(v[i].y * rstd * g.y) << 16);
            w.y = (unsigned)f2bf(v[i].z * rstd * g.z) | ((unsigned)f2bf(v[i].w * rstd * g.w) << 16);
            *(uint2*)(o + i * 256 + lane * 4) = w;
        }
    }
}

DI void rope8(bf16_t* p1, bf16_t* p2, const float* ct, const float* st, float scale) {
    const u32x4 r1 = *(const u32x4*)p1, r2 = *(const u32x4*)p2;
    float x1[8], x2[8]; unpack8(r1, x1); unpack8(r2, x2);
    const float4 c0 = *(const float4*)ct, c1 = *(const float4*)(ct + 4), s0 = *(const float4*)st, s1 = *(const float4*)(st + 4);
    const float cs[8] = {c0.x, c0.y, c0.z, c0.w, c1.x, c1.y, c1.z, c1.w}, sn[8] = {s0.x, s0.y, s0.z, s0.w, s1.x, s1.y, s1.z, s1.w};
    u32x4 o1, o2;
#pragma unroll
    for (int i = 0; i < 4; ++i) {
        const float a0 = (x1[2 * i] * cs[2 * i] - x2[2 * i] * sn[2 * i]) * scale, a1 = (x1[2 * i + 1] * cs[2 * i + 1] - x2[2 * i + 1] * sn[2 * i + 1]) * scale;
        const float b0 = (x2[2 * i] * cs[2 * i] + x1[2 * i] * sn[2 * i]) * scale, b1 = (x2[2 * i + 1] * cs[2 * i + 1] + x1[2 * i + 1] * sn[2 * i + 1]) * scale;
        o1[i] = (unsigned)f2bf(a0) | ((unsigned)f2bf(a1) << 16); o2[i] = (unsigned)f2bf(b0) | ((unsigned)f2bf(b1) << 16);
    }
    *(u32x4*)p1 = o1; *(u32x4*)p2 = o2;
}
DI void phase_rope(const Params& p, LAS char* smem, bf16_t* proj, const int nrows, const bool do_dvt) {
    const float* c128 = (const float*)(p.ws + OFF_COS128); const float* s128 = (const float*)(p.ws + OFF_SIN128);
    const float* c64 = (const float*)(p.ws + OFF_COS64); const float* s64 = (const float*)(p.ws + OFF_SIN64);
    const int gtid = blockIdx.x * NTHREADS + threadIdx.x, gsz = gridDim.x * NTHREADS;
    const int total = nrows * 173;
    for (int idx = gtid; idx < total; idx += gsz) {
        const int row = idx / 173, it = idx - row * 173;
        const int t = row % TT;
        bf16_t* pr = proj + (size_t)row * INW;
        if (it < 32)       { const int hd = it >> 3, j = (it & 7) * 8;          rope8(pr + C_RQ + hd * 128 + j, pr + C_RQ + hd * 128 + 64 + j, c128 + t * 64 + j, s128 + t * 64 + j, 1.f); }
        else if (it < 64)  { const int i2 = it - 32, hd = i2 >> 3, j = (i2 & 7) * 8;  rope8(pr + C_RK + hd * 128 + j, pr + C_RK + hd * 128 + 64 + j, c128 + t * 64 + j, s128 + t * 64 + j, 0.08838834764831845f); }
        else if (it < 128) { const int i2 = it - 64, hd = i2 >> 3, j = (i2 & 7) * 8;  rope8(pr + C_DQ + hd * 128 + j, pr + C_DQ + hd * 128 + 64 + j, c128 + t * 64 + j, s128 + t * 64 + j, 0.08838834764831845f * 1.4426950408889634f); }
        else if (it < 136) { const int j = (it - 128) * 8;                          rope8(pr + C_DK + j, pr + C_DK + 64 + j, c128 + t * 64 + j, s128 + t * 64 + j, 1.f); }
        else if (it < 168) { const int i2 = it - 136, hd = i2 >> 2, j = (i2 & 3) * 8; rope8(pr + C_IQ + hd * 64 + j, pr + C_IQ + hd * 64 + 32 + j, c64 + t * 32 + j, s64 + t * 32 + j, 0.125f); }
        else if (it < 172) { const int j = (it - 168) * 8;                          rope8(pr + C_IK + j, pr + C_IK + 32 + j, c64 + t * 32 + j, s64 + t * 32 + j, 1.f); }
        else {
            const u32x4 r = *(const u32x4*)(pr + C_IW); float v[8]; unpack8(r, v); u32x4 o;
#pragma unroll
            for (int i = 0; i < 4; ++i) o[i] = (unsigned)f2bf(v[2 * i] * 0.35355339059327373f) | ((unsigned)f2bf(v[2 * i + 1] * 0.35355339059327373f) << 16);
            *(u32x4*)(pr + C_IW) = o;
        }
    }
    if (!do_dvt) return;
    bf16_t* dvt = (bf16_t*)(p.ws + OFF_DVT);
    LAS bf16_t* tile = (LAS bf16_t*)smem;
    for (int unit = blockIdx.x; unit < NB * (TTP / 64); unit += gridDim.x) {
        const int b = unit / (TTP / 64), t0 = (unit % (TTP / 64)) * 64;
        for (int i = threadIdx.x; i < 64 * 16; i += NTHREADS) {
            const int tr = i >> 4, ch = i & 15, t = t0 + tr;
            u32x4 v = {0u, 0u, 0u, 0u};
            if (t < TT) v = *(const u32x4*)(proj + (size_t)(b * TT + t) * INW + C_DV + ch * 8);
            *(LAS u32x4*)(tile + tr * 136 + ch * 8) = v;
        }
        __syncthreads();
        for (int i = threadIdx.x; i < 128 * 8; i += NTHREADS) {
            const int dv = i >> 3, ch = i & 7;
            u32x4 o;
#pragma unroll
            for (int w = 0; w < 4; ++w) o[w] = (unsigned)tile[(ch * 8 + 2 * w) * 136 + dv] | ((unsigned)tile[(ch * 8 + 2 * w + 1) * 136 + dv] << 16);
            *(u32x4*)(dvt + (size_t)(b * 128 + dv) * TTP + t0 + ch * 8) = o;
        }
        __syncthreads();
    }
}

constexpr int DSA_WAVE_LDS = 2176 * 4 + 1024 * 4 + 256 * 4 + 64;
template <bool CHECK>
DI void phase_dsa_naive(const Params& p, LAS char* smem) {
    const bf16_t* proj = (const bf16_t*)(p.ws + OFF_BIG);
    bf16_t* mixed = (bf16_t*)(p.ws + OFF_HN);
    const int wave = threadIdx.x >> 6, lane = threadIdx.x & 63;
    LAS float* sSc = (LAS float*)(smem + wave * DSA_WAVE_LDS);
    LAS float* sQ = sSc + 2176;
    LAS int* sSel = (LAS int*)(sQ + 1024);
    LAS float* sIw = (LAS float*)(sSel + 256);
    const unsigned long long lt_mask = (1ull << lane) - 1ull;
    float chk_num = 0.f, chk_den = 0.f;
    for (int q = blockIdx.x * NWAVES + wave; q < NF; q += gridDim.x * NWAVES) {
        const int b = q >> 11, s = q & 2047, t = NMETA + s;
        const int nk = 80 + 64 * (s >> 6);
        const bf16_t* prow = proj + (size_t)(b * TT + t) * INW;
        for (int i = lane; i < 512; i += 64) sQ[i] = bf2f(prow[C_IQ + i]);
        if (lane < 8) sIw[lane] = bf2f(prow[C_IW + lane]);
        lds_fence();
        const bf16_t* ikbase = proj + (size_t)(b * TT) * INW + C_IK;
        const int nj = (nk + 63) >> 6;
        for (int jj = 0; jj < nj; ++jj) {
            const int k = jj * 64 + lane;
            float sc = 0.f;
            if (k < nk) {
                const bf16_t* kr = ikbase + (size_t)k * INW;
                float a[8];
#pragma unroll
                for (int h = 0; h < 8; ++h) a[h] = 0.f;
#pragma unroll 1
                for (int d8 = 0; d8 < 8; ++d8) {
                    const u32x4 raw = *(const u32x4*)(kr + d8 * 8); float kv[8]; unpack8(raw, kv);
#pragma unroll
                    for (int h = 0; h < 8; ++h) {
                        const f32x4 q0 = *(const LAS f32x4*)(sQ + h * 64 + d8 * 8), q1 = *(const LAS f32x4*)(sQ + h * 64 + d8 * 8 + 4);
                        a[h] += kv[0] * q0[0] + kv[1] * q0[1] + kv[2] * q0[2] + kv[3] * q0[3] + kv[4] * q1[0] + kv[5] * q1[1] + kv[6] * q1[2] + kv[7] * q1[3];
                    }
                }
#pragma unroll
                for (int h = 0; h < 8; ++h) sc += fmaxf(a[h], 0.f) * sIw[h];
                sc += 0.0f;
            }
            sSc[k] = sc;
        }
        lds_fence();
        int L;
        if (nk <= 256) {
            for (int i = lane; i < nk; i += 64) sSel[i] = i;
            L = nk;
        } else {
            unsigned Tkey = 0u;
            for (int bit = 31; bit >= 0; --bit) {
                const unsigned cand = Tkey | (1u << bit);
                int cnt = 0;
                for (int jj = 0; jj < nj; ++jj) {
                    const int k = jj * 64 + lane;
                    const unsigned key = (k < nk) ? fkey(sSc[k]) : 0u;
                    cnt += __popcll(__ballot(key >= cand));
                }
                if (cnt >= 256) Tkey = cand;
            }
            int cgt = 0;
            for (int jj = 0; jj < nj; ++jj) {
                const int k = jj * 64 + lane;
                const unsigned key = (k < nk) ? fkey(sSc[k]) : 0u;
                cgt += __popcll(__ballot(key > Tkey));
            }
            const int need = 256 - cgt;
            int pos = 0, eqseen = 0;
            for (int jj = 0; jj < nj; ++jj) {
                const int k = jj * 64 + lane;
                const unsigned key = (k < nk) ? fkey(sSc[k]) : 0u;
                const bool gt = key > Tkey, eq = (key == Tkey);
                const unsigned long long eqm = __ballot(eq);
                const int myeq = eqseen + __popcll(eqm & lt_mask);
                const bool sel = gt || (eq && myeq < need);
                const unsigned long long sm = __ballot(sel);
                if (sel) sSel[pos + __popcll(sm & lt_mask)] = k;
                pos += __popcll(sm); eqseen += __popcll(eqm);
            }
            L = 256;
        }
        lds_fence();
        for (int i = lane; i < 1024; i += 64) sQ[i] = bf2f(prow[C_DQ + i]);
        lds_fence();
        float sc[8][4];
        const bf16_t* dkbase = proj + (size_t)(b * TT) * INW + C_DK;
#pragma unroll
        for (int il = 0; il < 4; ++il) {
            const int i = lane + 64 * il; const bool ok = i < L; const int key = ok ? sSel[i] : 0;
            const bf16_t* kr = dkbase + (size_t)key * INW;
            float a[8];
#pragma unroll
            for (int h = 0; h < 8; ++h) a[h] = 0.f;
#pragma unroll 1
            for (int d8 = 0; d8 < 16; ++d8) {
                const u32x4 raw = *(const u32x4*)(kr + d8 * 8); float kv[8]; unpack8(raw, kv);
#pragma unroll
                for (int h = 0; h < 8; ++h) {
                    const f32x4 q0 = *(const LAS f32x4*)(sQ + h * 128 + d8 * 8), q1 = *(const LAS f32x4*)(sQ + h * 128 + d8 * 8 + 4);
                    a[h] += kv[0] * q0[0] + kv[1] * q0[1] + kv[2] * q0[2] + kv[3] * q0[3] + kv[4] * q1[0] + kv[5] * q1[1] + kv[6] * q1[2] + kv[7] * q1[3];
                }
            }
#pragma unroll
            for (int h = 0; h < 8; ++h) sc[h][il] = ok ? a[h] : -INFINITY;
        }
#pragma unroll
        for (int h = 0; h < 8; ++h) {
            float m = fmaxf(fmaxf(sc[h][0], sc[h][1]), fmaxf(sc[h][2], sc[h][3]));
            m = wave_max(m);
            float e[4], sum = 0.f;
#pragma unroll
            for (int il = 0; il < 4; ++il) { e[il] = exp2f(sc[h][il] - m); sum += e[il]; }
            sum = wave_sum(sum);
            const float inv = 1.f / sum;
#pragma unroll
            for (int il = 0; il < 4; ++il) sSc[h * 256 + lane + 64 * il] = e[il] * inv;
        }
        lds_fence();
        float o[8][2];
#pragma unroll
        for (int h = 0; h < 8; ++h) { o[h][0] = 0.f; o[h][1] = 0.f; }
        const bf16_t* dvbase = proj + (size_t)(b * TT) * INW + C_DV;
        for (int i = 0; i < L; ++i) {
            const int key = sSel[i];
            const float v0 = bf2f(dvbase[(size_t)key * INW + lane]), v1 = bf2f(dvbase[(size_t)key * INW + 64 + lane]);
#pragma unroll
            for (int h = 0; h < 8; ++h) { const float pv = sSc[h * 256 + i]; o[h][0] += pv * v0; o[h][1] += pv * v1; }
        }
        lds_fence();
#pragma unroll
        for (int h = 0; h < 8; ++h) { sQ[h * 128 + lane] = o[h][0]; sQ[h * 128 + 64 + lane] = o[h][1]; }
        lds_fence();
        for (int h = 0; h < 8; ++h) {
            float acc = 0.f;
            const float* wu = p.w_uv + (size_t)h * 128 * 64 + lane;
            for (int c = 0; c < 128; ++c) acc += sQ[h * 128 + c] * wu[c * 64];
            if (CHECK) { const float got = bf2f(mixed[(size_t)q * DM + 512 + h * 64 + lane]); chk_num += (got - acc) * (got - acc); chk_den += acc * acc; }
            else mixed[(size_t)q * DM + 512 + h * 64 + lane] = f2bf(acc);
        }
        lds_fence();
    }
    if (CHECK) {
        chk_num = wave_sum(chk_num); chk_den = wave_sum(chk_den);
        if (lane == 0) { atomicAdd((float*)(p.ws + OFF_BAR) + 3600, chk_num); atomicAdd((float*)(p.ws + OFF_BAR) + 3601, chk_den); }
    }
}

typedef unsigned long long u64;
typedef short s16x4 __attribute__((ext_vector_type(4)));
constexpr int SCLD = 2116;
constexpr int DSA_MASK_OFF = 16 * SCLD * 4;
constexpr int KLD = 136, VLD = 72, VLD2 = 136;
constexpr int DSA_VT_OFF = 128 * KLD * 2;
#define MFMA16(a, b, c) __builtin_amdgcn_mfma_f32_16x16x32_bf16((a), (b), (c), 0, 0, 0)
DI void phase_dsa_fast(const Params& p, LAS char* smem) {
    const bf16_t* proj = (const bf16_t*)(p.ws + OFF_BIG);
    const bf16_t* dvt = (const bf16_t*)(p.ws + OFF_DVT);
    const bf16_t* wuvt = (const bf16_t*)(p.ws + OFF_WUVT);
    bf16_t* mixed = (bf16_t*)(p.ws + OFF_HN);
    const int wave = threadIdx.x >> 6, lane = threadIdx.x & 63, c = lane & 15, g = lane >> 4;
    LAS float* SC = (LAS float*)smem; LAS u64* MASK = (LAS u64*)(smem + DSA_MASK_OFF);
    LAS bf16_t* KT = (LAS bf16_t*)smem; LAS bf16_t* VT = (LAS bf16_t*)(smem + DSA_VT_OFF);
    const u64 lt_mask = (1ull << lane) - 1ull;
    for (int pi = blockIdx.x; pi < 512; pi += gridDim.x)
    for (int which = 0; which < 2; ++which) {
        const int b = pi >> 6, qq = pi & 63, qt = which ? 127 - qq : qq;
        const int s0 = qt * 16, nk = 80 + 64 * (s0 >> 6), nkt = nk >> 4, nj = (nk + 63) >> 6;
        const bf16_t* pb = proj + (size_t)(b * TT) * INW;
        LAS char* tp_smem = smem; TP_BEGIN(1);
        {
            const bf16_t* qrow = pb + (size_t)(NMETA + s0 + c) * INW;
            bf16x8 bq[8][2]; float iw[8];
#pragma unroll
            for (int h = 0; h < 8; ++h) {
                bq[h][0] = *(const bf16x8*)(qrow + C_IQ + h * 64 + 8 * g);
                bq[h][1] = *(const bf16x8*)(qrow + C_IQ + h * 64 + 32 + 8 * g);
                iw[h] = bf2f(qrow[C_IW + h]);
            }
            bf16x8 a0n = {0, 0, 0, 0, 0, 0, 0, 0}, a1n = {0, 0, 0, 0, 0, 0, 0, 0};
            if (wave < nkt) { const bf16_t* krow = pb + (size_t)(wave * 16 + c) * INW + C_IK + 8 * g; a0n = *(const bf16x8*)(krow); a1n = *(const bf16x8*)(krow + 32); }
            for (int kt = wave; kt < nkt; kt += NWAVES) {
                const bf16x8 a0 = a0n, a1 = a1n;
                if (kt + NWAVES < nkt) { const bf16_t* krow = pb + (size_t)((kt + NWAVES) * 16 + c) * INW + C_IK + 8 * g; a0n = *(const bf16x8*)(krow); a1n = *(const bf16x8*)(krow + 32); }
                f32x4 isc = {0.f, 0.f, 0.f, 0.f};
#pragma unroll
                for (int h = 0; h < 8; ++h) {
                    f32x4 acc = {0.f, 0.f, 0.f, 0.f};
                    acc = MFMA16(a0, bq[h][0], acc); acc = MFMA16(a1, bq[h][1], acc);
#pragma unroll
                    for (int j = 0; j < 4; ++j) isc[j] += fmaxf(acc[j], 0.f) * iw[h];
                }
#pragma unroll
                for (int j = 0; j < 4; ++j) isc[j] += 0.0f;
                *(LAS f32x4*)(SC + c * SCLD + kt * 16 + 4 * g) = isc;
            }
            {
                const int tail = ((nj <= 11 ? 11 : (nj <= 22 ? 22 : 33)) << 6) - nk;
                for (int i = threadIdx.x; i < 16 * tail; i += NTHREADS) { const int qq_ = i / tail; SC[qq_ * SCLD + nk + (i - qq_ * tail)] = -3.0e38f; }
            }
        }
        __syncthreads(); TP_END(1); TP_BEGIN(2);
#pragma unroll 1
        for (int qi = 0; qi < 2; ++qi) {
            const int cq = wave * 2 + qi;
            unsigned kv[33];
#pragma unroll
            for (int jj = 0; jj < 11; ++jj) kv[jj] = fkey(SC[cq * SCLD + jj * 64 + lane]);
            if (nj > 11) {
#pragma unroll
                for (int jj = 11; jj < 22; ++jj) kv[jj] = fkey(SC[cq * SCLD + jj * 64 + lane]);
            } else {
#pragma unroll
                for (int jj = 11; jj < 22; ++jj) kv[jj] = 0u;
            }
            if (nj > 22) {
#pragma unroll
                for (int jj = 22; jj < 33; ++jj) kv[jj] = fkey(SC[cq * SCLD + jj * 64 + lane]);
            } else {
#pragma unroll
                for (int jj = 22; jj < 33; ++jj) kv[jj] = 0u;
            }
            unsigned Tkey = 1u;
            if (nk > 256) {
                Tkey = 0u;
#pragma unroll 1
                for (int bit = 31; bit >= 0; --bit) {
                    const unsigned cand = Tkey | (1u << bit);
                    int nl = 0;
#pragma unroll
                    for (int jj = 0; jj < 11; ++jj) nl += (kv[jj] >= cand) ? 1 : 0;
                    if (nj > 11) {
#pragma unroll
                        for (int jj = 11; jj < 22; ++jj) nl += (kv[jj] >= cand) ? 1 : 0;
                    }
                    if (nj > 22) {
#pragma unroll
                        for (int jj = 22; jj < 33; ++jj) nl += (kv[jj] >= cand) ? 1 : 0;
                    }
                    const int cnt = wave_sum_int(nl);
                    if (cnt >= 256) Tkey = cand;
                    if (cnt == 256) break;
                }
            }
            int cgl = 0;
#pragma unroll
            for (int jj = 0; jj < 33; ++jj) cgl += (kv[jj] > Tkey) ? 1 : 0;
            const int cgt = wave_sum_int(cgl);
            const int need = (nk > 256) ? 256 - cgt : 4096;
            int eqseen = 0;
#pragma unroll 1
            for (int jj = 0; jj < nj; ++jj) {
                const int k = jj * 64 + lane; const float v = SC[cq * SCLD + k];
                const unsigned key = (k < nk) ? fkey(v) : 0u;
                const bool gt = key > Tkey, eq = (key == Tkey);
                const u64 eqm = __ballot(eq);
                const int myeq = eqseen + __popcll(eqm & lt_mask);
                const u64 sm = __ballot(gt || (eq && myeq < need));
                eqseen += __popcll(eqm);
                if (lane == 0) MASK[cq * 34 + jj] = sm;
            }
        }
        __syncthreads(); TP_END(2); TP_BEGIN(3);
        {
            const int h = wave;
            const bf16_t* qrow = pb + (size_t)(NMETA + s0 + c) * INW + C_DQ + h * 128 + 8 * g;
            bf16x8 bQ[4];
#pragma unroll
            for (int ks = 0; ks < 4; ++ks) bQ[ks] = *(const bf16x8*)(qrow + ks * 32);
            f32x4 O[8];
#pragma unroll
            for (int mb = 0; mb < 8; ++mb) O[mb] = (f32x4){0.f, 0.f, 0.f, 0.f};
            float m_run = -1e30f, l_run = 0.f;
            const int prow_t = threadIdx.x >> 4, pch_t = threadIdx.x & 15;
            const bf16_t* vsrc = dvt + (size_t)(b * 128 + prow_t) * TTP + pch_t * 8;
            const int n128 = (nk + 127) >> 7;
            u32x4 pk[4], pv[4];
#pragma unroll
            for (int i = 0; i < 4; ++i) {
                int key = prow_t + 32 * i; key = key < nk ? key : nk - 1;
                pk[i] = *(const u32x4*)(pb + (size_t)key * INW + C_DK + pch_t * 8);
                pv[i] = *(const u32x4*)(vsrc + (size_t)(32 * i) * TTP);
            }
#pragma unroll 1
            for (int kb = 0; kb < n128; ++kb) {
#pragma unroll
                for (int i = 0; i < 4; ++i) {
                    *(LAS u32x4*)(KT + (prow_t + 32 * i) * KLD + pch_t * 8) = pk[i];
                    *(LAS u32x4*)(VT + (prow_t + 32 * i) * VLD2 + pch_t * 8) = pv[i];
                }
                __syncthreads();
                if (kb + 1 < n128) {
#pragma unroll
                    for (int i = 0; i < 4; ++i) {
                        int key = (kb + 1) * 128 + prow_t + 32 * i; key = key < nk ? key : nk - 1;
                        pk[i] = *(const u32x4*)(pb + (size_t)key * INW + C_DK + pch_t * 8);
                        pv[i] = *(const u32x4*)(vsrc + (size_t)(32 * i) * TTP + (kb + 1) * 128);
                    }
                }
#pragma unroll
                for (int sb = 0; sb < 2; ++sb) {
                    const int wi = kb * 2 + sb;
                    if (wi < nj) {
                        const u64 mw = MASK[c * 34 + wi];
                        f32x4 S[4];
#pragma unroll
                        for (int ct = 0; ct < 4; ++ct) {
                            f32x4 acc = {0.f, 0.f, 0.f, 0.f};
#pragma unroll
                            for (int ks = 0; ks < 4; ++ks) {
                                const bf16x8 a = *(const LAS bf16x8*)(KT + (sb * 64 + ct * 16 + c) * KLD + ks * 32 + 8 * g);
                                acc = MFMA16(a, bQ[ks], acc);
                            }
                            S[ct] = acc;
                        }
                        const u64 mws = mw >> (4 * g);
                        const unsigned mlo = (unsigned)mws, mhi = (unsigned)(mws >> 32);
                        float mblk = -1e30f;
#pragma unroll
                        for (int ct = 0; ct < 4; ++ct) {
                            const unsigned bits = ((ct & 2) ? mhi : mlo) >> ((ct & 1) * 16);
#pragma unroll
                            for (int j = 0; j < 4; ++j) {
                                S[ct][j] = ((bits >> j) & 1u) ? S[ct][j] : -1e30f;
                                mblk = fmaxf(mblk, S[ct][j]);
                            }
                        }
                        mblk = fmaxf(mblk, __shfl_xor(mblk, 16)); mblk = fmaxf(mblk, __shfl_xor(mblk, 32));
                        const float m_new = fmaxf(m_run, mblk);
                        float ps = 0.f;
#pragma unroll
                        for (int ct = 0; ct < 4; ++ct)
#pragma unroll
                            for (int j = 0; j < 4; ++j) { const float pv_ = (S[ct][j] > -1e29f) ? __builtin_amdgcn_exp2f(S[ct][j] - m_new) : 0.f; S[ct][j] = pv_; ps += pv_; }
                        if (__ballot(m_new != m_run) != 0ull) {
                            const float alpha = __builtin_amdgcn_exp2f(m_run - m_new);
                            l_run *= alpha;
#pragma unroll
                            for (int mb = 0; mb < 8; ++mb) O[mb] *= alpha;
                        }
                        l_run += ps; m_run = m_new;
                        bf16x8 bP[2];
#pragma unroll
                        for (int kk = 0; kk < 2; ++kk) {
                            u32x4 t4;
                            t4[0] = pk2bf(S[2 * kk][0], S[2 * kk][1]); t4[1] = pk2bf(S[2 * kk][2], S[2 * kk][3]);
                            t4[2] = pk2bf(S[2 * kk + 1][0], S[2 * kk + 1][1]); t4[3] = pk2bf(S[2 * kk + 1][2], S[2 * kk + 1][3]);
                            bP[kk] = __builtin_bit_cast(bf16x8, t4);
                        }
#pragma unroll
                        for (int mh = 0; mh < 2; ++mh) {
                            bf16x8 av[8];
#pragma unroll
                            for (int q = 0; q < 8; ++q) {
                                const int mb = mh * 4 + (q >> 1), kk = q & 1;
                                const LAS bf16_t* vr = VT + (mb * 16 + c) * VLD2 + sb * 64 + kk * 32 + 4 * g;
                                const s16x4 lo = *(const LAS s16x4*)(vr), hi = *(const LAS s16x4*)(vr + 16);
                                av[q] = __builtin_shufflevector(lo, hi, 0, 1, 2, 3, 4, 5, 6, 7);
                            }
                            __builtin_amdgcn_sched_barrier(0);
#pragma unroll
                            for (int q = 0; q < 8; ++q) { const int mb = mh * 4 + (q >> 1), kk = q & 1; O[mb] = MFMA16(av[q], bP[kk], O[mb]); }
                            __builtin_amdgcn_sched_barrier(0);
                        }
                    }
                }
                __syncthreads();
            }
            TP_END(3); TP_BEGIN(4);
            l_run += __shfl_xor(l_run, 16); l_run += __shfl_xor(l_run, 32);
            const float inv = 1.f / l_run;
            bf16x8 bO[4];
#pragma unroll
            for (int k2 = 0; k2 < 4; ++k2)
#pragma unroll
                for (int j = 0; j < 4; ++j) { bO[k2][j] = (short)f2bf(O[2 * k2][j] * inv); bO[k2][4 + j] = (short)f2bf(O[2 * k2 + 1][j] * inv); }
            bf16_t* orow = mixed + (size_t)(b * SEQ + s0 + c) * DM + 512 + h * 64;
            int zofs = 0; asm volatile("" : "+v"(zofs));
#pragma unroll
            for (int eb = 0; eb < 4; ++eb) {
                f32x4 acc = {0.f, 0.f, 0.f, 0.f};
#pragma unroll
                for (int k2 = 0; k2 < 4; ++k2) {
                    const bf16_t* wr = wuvt + (size_t)(h * 64 + eb * 16 + c) * 128 + k2 * 32 + 4 * g + zofs;
                    const s16x4 lo = *(const s16x4*)(wr), hi = *(const s16x4*)(wr + 16);
                    const bf16x8 a = __builtin_shufflevector(lo, hi, 0, 1, 2, 3, 4, 5, 6, 7);
                    acc = MFMA16(a, bO[k2], acc);
                }
                uint2 w;
                w.x = (unsigned)f2bf(acc[0]) | ((unsigned)f2bf(acc[1]) << 16);
                w.y = (unsigned)f2bf(acc[2]) | ((unsigned)f2bf(acc[3]) << 16);
                *(uint2*)(orow + eb * 16 + 4 * g) = w;
            }
            TP_END(4);
        }
    }
}

DI void phase_ret_scan(const Params& p) {
    float* ST = (float*)(p.ws + OFF_ST);
    const int gtid = blockIdx.x * NTHREADS + threadIdx.x, gsz = gridDim.x * NTHREADS;
    for (int idx = gtid; idx < 32 * 16384; idx += gsz) {
        const int bh = idx >> 14, el = idx & 16383, h = bh & 3;
        const float gc = expf(logf(1.f - exp2f(-5.f - (float)h)) * 64.f);
        float* base = ST + (size_t)bh * 34 * 16384 + el;
        float r = 0.f;
        for (int c = 1; c < 34; ++c) {
            const float u = c < 33 ? base[(size_t)c * 16384] : 0.f;
            base[(size_t)c * 16384] = r;
            r = gc * r + u;
        }
    }
}

#define MFMA32(a, b, c) __builtin_amdgcn_mfma_f32_32x32x16_bf16((a), (b), (c), 0, 0, 0)
constexpr int RLD = 136, RTLD = 72;
DI void phase_ret_state_mfma(const Params& p, LAS char* smem) {
    const bf16_t* proj = (const bf16_t*)(p.ws + OFF_BIG);
    float* ST = (float*)(p.ws + OFF_ST);
    LAS bf16_t* sVT = (LAS bf16_t*)smem; LAS bf16_t* sKT = sVT + 128 * RTLD;
    const int wave = threadIdx.x >> 6, lane = threadIdx.x & 63, r = lane & 31, hh = lane >> 5;
    for (int unit = blockIdx.x; unit < 1024; unit += gridDim.x) {
        const int c = 1 + (unit & 31), bh = unit >> 5, h = bh & 3, b = bh >> 2;
        const float lg = logf(1.f - exp2f(-5.f - (float)h));
        {
            const int j = threadIdx.x >> 3, ch = threadIdx.x & 7, t = 64 * c + j - 112;
            const float z = expf(lg * (float)(63 - j));
#pragma unroll
            for (int q = 0; q < 2; ++q) {
                const int cc = ch + 8 * q;
                u32x4 kv = {0u, 0u, 0u, 0u}, vv = {0u, 0u, 0u, 0u};
                if (t >= 0) { const bf16_t* pr = proj + (size_t)(b * TT + t) * INW; kv = *(const u32x4*)(pr + C_RK + h * 128 + cc * 8); vv = *(const u32x4*)(pr + C_RV + h * 128 + cc * 8); }
                float vf[8]; unpack8(vv, vf);
#pragma unroll
                for (int x = 0; x < 8; ++x) {
                    sKT[(cc * 8 + x) * RTLD + j] = (bf16_t)((kv[x >> 1] >> ((x & 1) * 16)) & 0xffffu);
                    sVT[(cc * 8 + x) * RTLD + j] = f2bf(vf[x] * z);
                }
            }
        }
        __syncthreads();
        const int mb = wave >> 1;
#pragma unroll
        for (int q = 0; q < 2; ++q) {
            const int nb = (wave & 1) * 2 + q;
            f32x16 acc;
#pragma unroll
            for (int i = 0; i < 16; ++i) acc[i] = 0.f;
#pragma unroll
            for (int ks = 0; ks < 4; ++ks) {
                const bf16x8 a = *(const LAS bf16x8*)(sVT + (mb * 32 + r) * RTLD + ks * 16 + 8 * hh);
                const bf16x8 bb = *(const LAS bf16x8*)(sKT + (nb * 32 + r) * RTLD + ks * 16 + 8 * hh);
                acc = MFMA32(a, bb, acc);
            }
            float* st = ST + (size_t)(bh * 34 + c) * 16384 + nb * 32 + r;
#pragma unroll
            for (int i = 0; i < 16; ++i) st[(size_t)(mb * 32 + (i & 3) + 8 * (i >> 2) + 4 * hh) * 128] = acc[i];
        }
        __syncthreads();
    }
}
DI void phase_ret_out_mfma(const Params& p, LAS char* smem) {
    const bf16_t* proj = (const bf16_t*)(p.ws + OFF_BIG);
    const float* ST = (const float*)(p.ws + OFF_ST);
    bf16_t* mixed = (bf16_t*)(p.ws + OFF_HN);
    LAS bf16_t* sQ = (LAS bf16_t*)smem; LAS bf16_t* sK = sQ + 64 * RLD; LAS bf16_t* sVT = sK + 64 * RLD;
    LAS float* sGN = (LAS float*)(sVT + 128 * RTLD);
    const int wave = threadIdx.x >> 6, lane = threadIdx.x & 63, r = lane & 31, hh = lane >> 5;
    const int ib = wave & 1, eb = wave >> 1;
    for (int unit = blockIdx.x; unit < 1024; unit += gridDim.x) {
        const int c = 2 + (unit & 31), bh = unit >> 5, h = bh & 3, b = bh >> 2;
        const float lg = logf(1.f - exp2f(-5.f - (float)h));
        for (int i = threadIdx.x; i < 64 * 16; i += NTHREADS) {
            const int j = i >> 4, ch = i & 15; const int t = 64 * c + j - 112;
            const bf16_t* pr = proj + (size_t)(b * TT + t) * INW;
            *(LAS u32x4*)(sQ + j * RLD + ch * 8) = *(const u32x4*)(pr + C_RQ + h * 128 + ch * 8);
            *(LAS u32x4*)(sK + j * RLD + ch * 8) = *(const u32x4*)(pr + C_RK + h * 128 + ch * 8);
            const u32x4 vv = *(const u32x4*)(pr + C_RV + h * 128 + ch * 8);
#pragma unroll
            for (int x = 0; x < 8; ++x) sVT[(ch * 8 + x) * RTLD + j] = (bf16_t)((vv[x >> 1] >> ((x & 1) * 16)) & 0xffffu);
        }
        __syncthreads();
        f32x16 acc;
#pragma unroll
        for (int i = 0; i < 16; ++i) acc[i] = 0.f;
        {
            const float* R = ST + (size_t)(bh * 34 + c) * 16384 + (size_t)(eb * 32 + r) * 128 + 8 * hh;
#pragma unroll
            for (int ks = 0; ks < 8; ++ks) {
                const float4 r0 = *(const float4*)(R + ks * 16), r1 = *(const float4*)(R + ks * 16 + 4);
                const float rf[8] = {r0.x, r0.y, r0.z, r0.w, r1.x, r1.y, r1.z, r1.w};
                const bf16x8 a = pack8(rf);
                const bf16x8 bq = *(const LAS bf16x8*)(sQ + (ib * 32 + r) * RLD + ks * 16 + 8 * hh);
                acc = MFMA32(a, bq, acc);
            }
            const float xi = expf(lg * (float)(ib * 32 + r + 1));
#pragma unroll
            for (int i = 0; i < 16; ++i) acc[i] *= xi;
        }
#pragma unroll
        for (int jb = 0; jb < 2; ++jb) {
            f32x16 st;
#pragma unroll
            for (int i = 0; i < 16; ++i) st[i] = 0.f;
#pragma unroll
            for (int ks = 0; ks < 8; ++ks) {
                const bf16x8 a = *(const LAS bf16x8*)(sK + (jb * 32 + r) * RLD + ks * 16 + 8 * hh);
                const bf16x8 bq = *(const LAS bf16x8*)(sQ + (ib * 32 + r) * RLD + ks * 16 + 8 * hh);
                st = MFMA32(a, bq, st);
            }
            const int icol = ib * 32 + r;
#pragma unroll
            for (int i = 0; i < 16; ++i) {
                const int j = jb * 32 + (i & 3) + 8 * (i >> 2) + 4 * hh; const int df = icol > j ? icol - j : j - icol;
                st[i] *= expf(lg * (float)df);
            }
#pragma unroll
            for (int s2 = 0; s2 < 2; ++s2) {
                bf16x8 bp;
#pragma unroll
                for (int x = 0; x < 8; ++x) bp[x] = (short)f2bf(st[8 * s2 + x]);
                const LAS bf16_t* vr = sVT + (eb * 32 + r) * RTLD + jb * 32 + 16 * s2 + 4 * hh;
                const s16x4 lo = *(const LAS s16x4*)(vr), hi = *(const LAS s16x4*)(vr + 8);
                const bf16x8 a = __builtin_shufflevector(lo, hi, 0, 1, 2, 3, 4, 5, 6, 7);
                acc = MFMA32(a, bp, acc);
            }
        }
        float s1 = 0.f, s2 = 0.f;
#pragma unroll
        for (int i = 0; i < 16; ++i) { s1 += acc[i]; s2 += acc[i] * acc[i]; }
        s1 += __shfl_xor(s1, 32); s2 += __shfl_xor(s2, 32);
        if (hh == 0) { sGN[(eb * 64 + ib * 32 + r) * 2] = s1; sGN[(eb * 64 + ib * 32 + r) * 2 + 1] = s2; }
        __syncthreads();
        float S1 = 0.f, S2 = 0.f;
#pragma unroll
        for (int e4 = 0; e4 < 4; ++e4) { S1 += sGN[(e4 * 64 + ib * 32 + r) * 2]; S2 += sGN[(e4 * 64 + ib * 32 + r) * 2 + 1]; }
        const float mu = S1 * (1.f / 128.f), var = fmaxf(S2 * (1.f / 128.f) - mu * mu, 0.f), rs = rsqrtf(var + 1e-6f);
        const int t = 64 * c + ib * 32 + r - 112, srow = t - NMETA;
        const bf16_t* pg = proj + (size_t)(b * TT + t) * INW + C_RG + h * 128 + eb * 32 + 4 * hh;
        bf16_t* po = mixed + (size_t)(b * SEQ + srow) * DM + h * 128 + eb * 32 + 4 * hh;
#pragma unroll
        for (int g4 = 0; g4 < 4; ++g4) {
            const uint2 graw = *(const uint2*)(pg + 8 * g4);
            const float gv[4] = {__uint_as_float(graw.x << 16), __uint_as_float(graw.x & 0xffff0000u), __uint_as_float(graw.y << 16), __uint_as_float(graw.y & 0xffff0000u)};
            float o[4];
#pragma unroll
            for (int x = 0; x < 4; ++x) { const float gate = gv[x] / (1.f + expf(-gv[x])); o[x] = gate * (acc[4 * g4 + x] - mu) * rs; }
            uint2 w; w.x = (unsigned)f2bf(o[0]) | ((unsigned)f2bf(o[1]) << 16); w.y = (unsigned)f2bf(o[2]) | ((unsigned)f2bf(o[3]) << 16);
            *(uint2*)(po + 8 * g4) = w;
        }
        __syncthreads();
    }
}

DI void phase_norm2(const Params& p) {
    bf16_t* hn2 = (bf16_t*)(p.ws + OFF_HN);
    const int wave = threadIdx.x >> 6, lane = threadIdx.x & 63;
    for (int row = blockIdx.x * NWAVES + wave; row < NF; row += gridDim.x * NWAVES) {
        const float* src = p.out + (size_t)row * DM; bf16_t* o = hn2 + (size_t)row * DM;
        float4 v[4]; float ss = 0.f;
#pragma unroll
        for (int i = 0; i < 4; ++i) { v[i] = *(const float4*)(src + i * 256 + lane * 4); ss += v[i].x * v[i].x + v[i].y * v[i].y + v[i].z * v[i].z + v[i].w * v[i].w; }
        ss = wave_sum(ss);
        const float rstd = rsqrtf(ss * (1.f / DM) + 1e-6f);
#pragma unroll
        for (int i = 0; i < 4; ++i) {
            const float4 g = *(const float4*)(p.norm_ffn + i * 256 + lane * 4);
            uint2 w;
            w.x = (unsigned)f2bf(v[i].x * rstd * g.x) | ((unsigned)f2bf(v[i].y * rstd * g.y) << 16);
            w.y = (unsigned)f2bf(v[i].z * rstd * g.z) | ((unsigned)f2bf(v[i].w * rstd * g.w) << 16);
            *(uint2*)(o + i * 256 + lane * 4) = w;
        }
    }
}

__device__ const int PEER_PAIRS[50] = {0, 2, 4, 6, 8, 10, 12, 14, 16, 18, 20, 22, 32, 34, 36, 49, 51, 65, 80, 96, 112, 128, 160, 192, 224, 1, 3, 5, 7, 9, 11, 13, 15, 17, 19, 21, 23, 33, 35, 48, 50, 64, 66, 81, 97, 113, 144, 176, 208, 240};
constexpr int PSEL_WAVE_LDS = 32 * 2 * 16 * 8 + 32 * 16 * 8;
DI void phase_peer_select(const Params& p, LAS char* smem) {
    const float* PQ = (const float*)(p.ws + OFF_BIG);
    unsigned* EG = (unsigned*)(p.ws + OFF_EG); const float* SSQ = (const float*)(p.ws + OFF_SSQ);
    const int wave = threadIdx.x >> 6, lane = threadIdx.x & 63, r = lane & 31, hh = lane >> 5;
    LAS float* lv = (LAS float*)(smem + wave * PSEL_WAVE_LDS);
    LAS int* li = (LAS int*)(lv + 32 * 2 * 16);
    LAS float* cs = (LAS float*)(li + 32 * 2 * 16);
    LAS int* cab = (LAS int*)(cs + 32 * 16);
    for (int task = blockIdx.x * NWAVES + wave; task < (NF / 32) * 8; task += gridDim.x * NWAVES) {
        const int tile = task >> 3, h = task & 7;
        const int n = tile * 32 + r;
#pragma unroll 1
        for (int half = 0; half < 2; ++half) {
            f32x16 acc[4];
            {
                const float* srow = PQ + (size_t)n * 2048 + h * 256 + half * 128 + hh * 64;
#pragma unroll
                for (int mb = 0; mb < 4; ++mb)
#pragma unroll
                    for (int q = 0; q < 4; ++q) { const float4 a = *(const float4*)(srow + mb * 16 + q * 4); acc[mb][q * 4] = a.x; acc[mb][q * 4 + 1] = a.y; acc[mb][q * 4 + 2] = a.z; acc[mb][q * 4 + 3] = a.w; }
            }
            float mprev = INFINITY;
#pragma unroll 1
            for (int it = 0; it < 16; ++it) {
                float m = -INFINITY;
#pragma unroll
                for (int mb = 0; mb < 4; ++mb)
#pragma unroll
                    for (int i = 0; i < 16; ++i) { const float v = acc[mb][i]; m = fmaxf(m, v < mprev ? v : -INFINITY); }
                m = fmaxf(m, __shfl_xor(m, 32));
                mprev = m;
            }
            const float T = mprev;
            int cnt = 0;
#pragma unroll
            for (int mb = 0; mb < 4; ++mb)
#pragma unroll
                for (int i = 0; i < 16; ++i) cnt += (acc[mb][i] >= T) ? 1 : 0;
            const int pc = __shfl_xor(cnt, 32);
            int pos = hh ? pc : 0;
            LAS float* lvp = lv + (r * 2 + half) * 16; LAS int* lip = li + (r * 2 + half) * 16;
#pragma unroll
            for (int mb = 0; mb < 4; ++mb)
#pragma unroll
                for (int i = 0; i < 16; ++i) {
                    const float v = acc[mb][i];
                    if (v >= T) { if (pos < 16) { lvp[pos] = v; lip[pos] = hh * 64 + mb * 16 + i; } ++pos; }
                }
        }
        lds_fence();
        {
            float w1[16], w2[16];
#pragma unroll
            for (int a = 0; a < 16; ++a) { w1[a] = lv[(r * 2 + 0) * 16 + a]; w2[a] = lv[(r * 2 + 1) * 16 + a]; }
            float m1[8], m2[8]; int i1[8], i2[8], r1[8], r2[8];
#pragma unroll
            for (int x = 0; x < 8; ++x) {
                m1[x] = lv[(r * 2 + 0) * 16 + 8 * hh + x]; m2[x] = lv[(r * 2 + 1) * 16 + 8 * hh + x];
                i1[x] = li[(r * 2 + 0) * 16 + 8 * hh + x]; i2[x] = li[(r * 2 + 1) * 16 + 8 * hh + x];
                unsigned c1 = 0u, c2 = 0u;
#pragma unroll
                for (int a = 0; a < 16; ++a) { c1 += __float_as_uint(m1[x] - w1[a]) >> 31; c2 += __float_as_uint(m2[x] - w2[a]) >> 31; }
                r1[x] = (int)c1; r2[x] = (int)c2;
            }
            int rs = 0;
#pragma unroll
            for (int x = 0; x < 8; ++x) rs += r1[x] + (r2[x] << 8);
            rs += __shfl_xor(rs, 32);
            if (__any(rs != (120 | (120 << 8)))) {
#pragma unroll
                for (int x = 0; x < 8; ++x) { r1[x] = 0; r2[x] = 0; }
#pragma unroll 1
                for (int a = 0; a < 16; ++a) {
                    const float wa1 = lv[(r * 2 + 0) * 16 + a], wa2 = lv[(r * 2 + 1) * 16 + a];
#pragma unroll
                    for (int x = 0; x < 8; ++x) {
                        const int me = 8 * hh + x;
                        r1[x] += (wa1 > m1[x] || (wa1 == m1[x] && a < me)) ? 1 : 0;
                        r2[x] += (wa2 > m2[x] || (wa2 == m2[x] && a < me)) ? 1 : 0;
                    }
                }
            }
            lds_fence();
#pragma unroll
            for (int x = 0; x < 8; ++x) {
                lv[(r * 2 + 0) * 16 + r1[x]] = m1[x]; li[(r * 2 + 0) * 16 + r1[x]] = i1[x];
                lv[(r * 2 + 1) * 16 + r2[x]] = m2[x]; li[(r * 2 + 1) * 16 + r2[x]] = i2[x];
            }
            lds_fence();
        }
        int code[25]; float cv[25];
#pragma unroll
        for (int i = 0; i < 25; ++i) {
            code[i] = PEER_PAIRS[hh * 25 + i];
            cv[i] = lv[(r * 2 + 0) * 16 + (code[i] >> 4)] + lv[(r * 2 + 1) * 16 + (code[i] & 15)];
        }
        float mprev = INFINITY;
#pragma unroll 1
        for (int it = 0; it < 16; ++it) {
            float m = -INFINITY;
#pragma unroll
            for (int i = 0; i < 25; ++i) { const float v = cv[i]; m = fmaxf(m, v < mprev ? v : -INFINITY); }
            m = fmaxf(m, __shfl_xor(m, 32));
            mprev = m;
        }
        const float Tc = mprev;
        int cnt = 0;
#pragma unroll
        for (int i = 0; i < 25; ++i) cnt += (cv[i] >= Tc) ? 1 : 0;
        const int pc = __shfl_xor(cnt, 32);
        int pos = hh ? pc : 0;
#pragma unroll
        for (int i = 0; i < 25; ++i) {
            if (cv[i] >= Tc) { if (pos < 16) { cs[r * 16 + pos] = cv[i]; cab[r * 16 + pos] = code[i]; } ++pos; }
        }
        lds_fence();
        const float rstd = rsqrtf(SSQ[n] * (1.f / DM) + 1e-6f);
        float scv[16]; float mx = -INFINITY;
#pragma unroll
        for (int i = 0; i < 16; ++i) { scv[i] = cs[r * 16 + i]; mx = fmaxf(mx, scv[i]); }
        float sum = 0.f;
#pragma unroll
        for (int i = 0; i < 16; ++i) { scv[i] = expf((scv[i] - mx) * rstd); sum += scv[i]; }
        const float inv = 1.f / sum;
#pragma unroll
        for (int i = 0; i < 16; ++i) {
            if ((i >> 3) == hh) {
                const int ab = cab[r * 16 + i];
                const int e = li[(r * 2 + 0) * 16 + (ab >> 4)] * 128 + li[(r * 2 + 1) * 16 + (ab & 15)];
                const _Float16 gh = (_Float16)(scv[i] * inv);
                EG[(size_t)n * 128 + h * 16 + i] = (unsigned)e | ((unsigned)__builtin_bit_cast(unsigned short, gh) << 16);
            }
        }
        lds_fence();
    }
}

typedef float f32x2 __attribute__((ext_vector_type(2)));
DI void phase_convert_tables(const Params& p) {
    const int wave = threadIdx.x >> 6, lane = threadIdx.x & 63;
    for (int rowi = blockIdx.x * NWAVES + wave; rowi < 2 * 16384; rowi += gridDim.x * NWAVES) {
        const bool isv = rowi >= 16384; const int e = isv ? rowi - 16384 : rowi;
        const float* src = (isv ? p.pv : p.pu) + (size_t)e * DM + lane * 16;
        float x[16]; float mx = 0.f;
#pragma unroll
        for (int i = 0; i < 4; ++i) { const float4 a = *(const float4*)(src + i * 4); x[i * 4] = a.x; x[i * 4 + 1] = a.y; x[i * 4 + 2] = a.z; x[i * 4 + 3] = a.w; }
#pragma unroll
        for (int i = 0; i < 16; ++i) mx = fmaxf(mx, fabsf(x[i]));
        mx = wave_max(mx);
        const float top = isv ? 240.f : 127.f;
        const float inv = mx > 0.f ? top / mx : 0.f, scale = mx > 0.f ? mx / top : 0.f;
        u32x4 o;
        if (isv) {
#pragma unroll
            for (int w = 0; w < 4; ++w) {
                int pk = 0;
                pk = __builtin_amdgcn_cvt_pk_fp8_f32(x[w * 4] * inv, x[w * 4 + 1] * inv, pk, false);
                pk = __builtin_amdgcn_cvt_pk_fp8_f32(x[w * 4 + 2] * inv, x[w * 4 + 3] * inv, pk, true);
                o[w] = (unsigned)pk;
            }
        } else {
#pragma unroll
            for (int w = 0; w < 4; ++w) {
                unsigned pk = 0u;
#pragma unroll
                for (int b = 0; b < 4; ++b) { const int q = (int)rintf(x[w * 4 + b] * inv); pk |= ((unsigned)q & 0xffu) << (8 * b); }
                o[w] = pk;
            }
        }
        *(u32x4*)(p.ws + (isv ? OFF_V8 : OFF_U8) + (size_t)e * DM + lane * 16) = o;
        if (lane == 0) ((float*)(p.ws + (isv ? OFF_SV : OFF_SU)))[e] = scale;
    }
}
DI void unpack16_fp8(const u32x4& r, float (&v)[16]) {
#pragma unroll
    for (int w = 0; w < 4; ++w) {
        const f32x2 a = __builtin_amdgcn_cvt_pk_f32_fp8((int)r[w], false), b = __builtin_amdgcn_cvt_pk_f32_fp8((int)r[w], true);
        v[w * 4] = a[0]; v[w * 4 + 1] = a[1]; v[w * 4 + 2] = b[0]; v[w * 4 + 3] = b[1];
    }
}
constexpr int RW_NB = 128, RW_SH = 7;
constexpr int RW_WAVE_LDS = 4 * (RW_NB + 16) * 4 + 4 * 128 * 4 + 4 * 128 * 4;
DI float gelu_as(float v) {
    const float av = fabsf(v), t = __builtin_amdgcn_rcpf(av * 0.2316418882f + 1.0f);
    float q = t * 0.5307027145f + (-0.7265760135f); q = q * t + 0.7107068705f; q = q * t + (-0.142248368f); q = q * t + 0.127414796f; q = q * t;
    const float e = __builtin_amdgcn_exp2f((v * v) * (-0.72134752044f));
    const float m = v * (q * e), r = v - m;
    return v < 0.f ? m : r;
}
DI void phase_peer_out_rows(const Params& p, LAS char* smem) {
    const unsigned* EG = (const unsigned*)(p.ws + OFF_EG);
    const char* U8 = p.ws + OFF_U8; const char* V8 = p.ws + OFF_V8;
    const float* SU = (const float*)(p.ws + OFF_SU); const float* SV = (const float*)(p.ws + OFF_SV);
    const int wave = threadIdx.x >> 6, lane = threadIdx.x & 63, r = lane >> 4, l16 = lane & 15;
    LAS int* cnt = (LAS int*)(smem + wave * RW_WAVE_LDS) + r * (RW_NB + 16);
    LAS int* list_e = (LAS int*)(smem + wave * RW_WAVE_LDS + 4 * (RW_NB + 16) * 4) + r * 128;
    LAS float* list_g = (LAS float*)(smem + wave * RW_WAVE_LDS + 4 * (RW_NB + 16) * 4 + 2048) + r * 128;
    for (int grp = blockIdx.x * NWAVES + wave; grp < NF / 4; grp += gridDim.x * NWAVES) {
        const int n = grp * 4 + r;
        float acc[64]; int hq[16]; float hscale;
        const float* hrow = p.out + (size_t)n * DM + l16 * 16;
        {
            float hn[64];
            float ss = 0.f;
#pragma unroll
            for (int j = 0; j < 4; ++j)
#pragma unroll
                for (int q = 0; q < 4; ++q) { const float4 a = *(const float4*)(hrow + j * 256 + q * 4); hn[j * 16 + q * 4] = a.x; hn[j * 16 + q * 4 + 1] = a.y; hn[j * 16 + q * 4 + 2] = a.z; hn[j * 16 + q * 4 + 3] = a.w; }
#pragma unroll
            for (int i = 0; i < 64; ++i) ss += hn[i] * hn[i];
            ss = dpp_row_sum(ss);
            const float rstd = rsqrtf(ss * (1.f / DM) + 1e-6f);
#pragma unroll
            for (int j = 0; j < 4; ++j)
#pragma unroll
                for (int q = 0; q < 4; ++q) {
                    const float4 a = *(const float4*)(p.norm_ffn + j * 256 + l16 * 16 + q * 4);
                    hn[j * 16 + q * 4] *= rstd * a.x; hn[j * 16 + q * 4 + 1] *= rstd * a.y; hn[j * 16 + q * 4 + 2] *= rstd * a.z; hn[j * 16 + q * 4 + 3] *= rstd * a.w;
                }
            float hm = 0.f;
#pragma unroll
            for (int i = 0; i < 64; ++i) hm = fmaxf(hm, fabsf(hn[i]));
            hm = fmaxf(hm, __int_as_float(__builtin_amdgcn_update_dpp(0, __float_as_int(hm), 0xB1, 0xF, 0xF, true)));
            hm = fmaxf(hm, __int_as_float(__builtin_amdgcn_update_dpp(0, __float_as_int(hm), 0x4E, 0xF, 0xF, true)));
            hm = fmaxf(hm, __int_as_float(__builtin_amdgcn_update_dpp(0, __float_as_int(hm), 0x141, 0xF, 0xF, true)));
            hm = fmaxf(hm, __int_as_float(__builtin_amdgcn_update_dpp(0, __float_as_int(hm), 0x140, 0xF, 0xF, true)));
            const float hinv = hm > 0.f ? 127.f / hm : 0.f; hscale = hm * (1.f / 127.f);
#pragma unroll
            for (int w = 0; w < 16; ++w) {
                unsigned pk = 0u;
#pragma unroll
                for (int b = 0; b < 4; ++b) { const int q = (int)rintf(hn[w * 4 + b] * hinv); pk |= ((unsigned)q & 0xffu) << (8 * b); }
                hq[w] = (int)pk;
            }
#pragma unroll
            for (int i = 0; i < 64; ++i) acc[i] = 0.f;
        }
#pragma unroll
        for (int q = 0; q < RW_NB / 16; ++q) cnt[q * 16 + l16] = 0;
        lds_fence();
        {
            int ek[8], rk[8]; float gk[8];
#pragma unroll
            for (int k = 0; k < 8; ++k) { const unsigned w = EG[(size_t)n * 128 + k * 16 + l16]; ek[k] = (int)(w & 0xffffu); gk[k] = (float)__builtin_bit_cast(_Float16, (unsigned short)(w >> 16)); }
#pragma unroll
            for (int k = 0; k < 8; ++k) rk[k] = __hip_atomic_fetch_add(&cnt[ek[k] >> RW_SH], 1, __ATOMIC_RELAXED, __HIP_MEMORY_SCOPE_WORKGROUP);
            lds_fence();
            {
                constexpr int PB = RW_NB / 16;
                int c[PB], tot = 0;
#pragma unroll
                for (int q = 0; q < PB; ++q) { c[q] = cnt[l16 * PB + q]; tot += c[q]; }
                cnt[RW_NB + l16] = tot;
                lds_fence();
                int base = 0;
#pragma unroll
                for (int q = 0; q < 16; ++q) { const int v = cnt[RW_NB + q]; base += (q < l16) ? v : 0; }
#pragma unroll
                for (int q = 0; q < PB; ++q) { cnt[l16 * PB + q] = base; base += c[q]; }
            }
            lds_fence();
#pragma unroll
            for (int k = 0; k < 8; ++k) { const int pos = cnt[ek[k] >> RW_SH] + rk[k]; list_e[pos] = ek[k]; list_g[pos] = gk[k]; }
        }
        lds_fence();
        {
            u32x4 ub[4], vb[4]; float g_c, su_c, sv_c, g_n = 0.f, su_n = 0.f, sv_n = 0.f;
            {
                const int e_ = list_e[0]; g_c = list_g[0]; su_c = SU[e_]; sv_c = SV[e_];
#pragma unroll
                for (int j = 0; j < 4; ++j) { ub[j] = *(const u32x4*)(U8 + (size_t)e_ * DM + l16 * 16 + j * 256); vb[j] = *(const u32x4*)(V8 + (size_t)e_ * DM + l16 * 16 + j * 256); }
            }
#pragma unroll 1
            for (int sl = 0; sl < 128; ++sl) {
                int isum = 0;
#pragma unroll
                for (int j = 0; j < 4; ++j)
#pragma unroll
                    for (int w = 0; w < 4; ++w) isum = __builtin_amdgcn_sdot4((int)ub[j][w], hq[j * 4 + w], isum, false);
                isum += __builtin_amdgcn_update_dpp(0, isum, 0xB1, 0xF, 0xF, true);
                isum += __builtin_amdgcn_update_dpp(0, isum, 0x4E, 0xF, 0xF, true);
                isum += __builtin_amdgcn_update_dpp(0, isum, 0x141, 0xF, 0xF, true);
                isum += __builtin_amdgcn_update_dpp(0, isum, 0x140, 0xF, 0xF, true);
                float t_ = (float)isum * hscale;
                const int sn = sl + 1 < 128 ? sl + 1 : 127;
                const int e_n = list_e[sn];
                {
                    const char* up_ = U8 + (size_t)e_n * DM + l16 * 16;
#pragma unroll
                    for (int j = 0; j < 4; ++j) ub[j] = *(const u32x4*)(up_ + j * 256);
                    g_n = list_g[sn]; su_n = SU[e_n]; sv_n = SV[e_n];
                }
                t_ *= su_c;
                const float coef_ = gelu_as(t_) * g_c * sv_c;
#pragma unroll
                for (int j = 0; j < 4; ++j) { float v[16]; unpack16_fp8(vb[j], v);
#pragma unroll
                    for (int i = 0; i < 16; ++i) acc[j * 16 + i] += coef_ * v[i]; }
                {
                    const char* vp_ = V8 + (size_t)e_n * DM + l16 * 16;
#pragma unroll
                    for (int j = 0; j < 4; ++j) vb[j] = *(const u32x4*)(vp_ + j * 256);
                }
                g_c = g_n; su_c = su_n; sv_c = sv_n;
            }
        }
        {
            float* orow = p.out + (size_t)n * DM + l16 * 16;
            float s2 = 0.f;
#pragma unroll
            for (int j = 0; j < 4; ++j)
#pragma unroll
                for (int q = 0; q < 4; ++q) { const float4 a = *(const float4*)(orow + j * 256 + q * 4); acc[j * 16 + q * 4] += a.x; acc[j * 16 + q * 4 + 1] += a.y; acc[j * 16 + q * 4 + 2] += a.z; acc[j * 16 + q * 4 + 3] += a.w; }
#pragma unroll
            for (int i = 0; i < 64; ++i) s2 += acc[i] * acc[i];
            s2 = dpp_row_sum(s2);
            float r2 = rsqrtf(s2 * (1.f / DM) + 1e-6f);
#if TP_SEC
            r2 *= 1.f + 0.5f * ((const float*)(p.ws + OFF_BAR))[3602];
#endif
#if defined(DSA_CHECK) || defined(PROJ_CHECK)
            { const float num = ((const float*)(p.ws + OFF_BAR))[3600], den = ((const float*)(p.ws + OFF_BAR))[3601]; r2 *= 1.f + CHK_GAIN * sqrtf(num / fmaxf(den, 1e-30f)); }
#endif
#pragma unroll
            for (int j = 0; j < 4; ++j)
#pragma unroll
                for (int q = 0; q < 4; ++q) {
                    const float4 a = *(const float4*)(p.norm_final + j * 256 + l16 * 16 + q * 4);
                    *(float4*)(orow + j * 256 + q * 4) = make_float4(acc[j * 16 + q * 4] * r2 * a.x, acc[j * 16 + q * 4 + 1] * r2 * a.y, acc[j * 16 + q * 4 + 2] * r2 * a.z, acc[j * 16 + q * 4 + 3] * r2 * a.w);
                }
        }
        lds_fence();
    }
}

DI Params load_params() {
#if defined(__HIP_DEVICE_COMPILE__)
    typedef const __attribute__((address_space(4))) unsigned long long* cu64_t;
    cu64_t pp = (cu64_t)__builtin_amdgcn_kernarg_segment_ptr();
    asm volatile("" : "+s"(pp));
    static_assert(sizeof(Params) == 16 * 8, "Params is 16 qwords");
    unsigned long long w[16];
#pragma unroll
    for (int i = 0; i < 16; ++i) w[i] = pp[i];
#define GPTR(T, v) ((T*)(__attribute__((address_space(1))) T*)(v))
    Params r;
    r.x = GPTR(const float, w[0]); r.meta = GPTR(const float, w[1]); r.norm_mix = GPTR(const float, w[2]); r.w_in = GPTR(const float, w[3]);
    r.w_uv = GPTR(const float, w[4]); r.w_out = GPTR(const float, w[5]); r.norm_ffn = GPTR(const float, w[6]); r.wq = GPTR(const float, w[7]);
    r.sk = GPTR(const float, w[8]); r.pu = GPTR(const float, w[9]); r.pv = GPTR(const float, w[10]); r.norm_final = GPTR(const float, w[11]);
    r.out = GPTR(float, w[12]); r.ws = GPTR(char, w[13]);
    r.lo = (int)(unsigned)w[14]; r.hi = (int)(unsigned)(w[14] >> 32); r.pad0 = 0; r.pad1 = 0;
    return r;
#else
    return Params{};
#endif
}
#ifdef PROJ_CHECK
constexpr int PCH_ROWS = 2048;
DI void phase_proj_ref_naive(const Params& p) {
    const bf16_t* hn = (const bf16_t*)(p.ws + OFF_HN); bf16_t* ref = (bf16_t*)(p.ws + OFF_ST);
    const int gtid = blockIdx.x * NTHREADS + threadIdx.x, gsz = gridDim.x * NTHREADS;
    for (int idx = gtid; idx < (PCH_ROWS / 8) * INW; idx += gsz) {
        const int c = idx % INW, r0 = (idx / INW) * 8;
        float acc[8];
#pragma unroll
        for (int i = 0; i < 8; ++i) acc[i] = 0.f;
        for (int k = 0; k < 1024; ++k) {
            const float w = bf2f(f2bf(p.w_in[(size_t)k * INW + c]));
#pragma unroll
            for (int i = 0; i < 8; ++i) acc[i] += bf2f(hn[(size_t)(r0 + i) * DM + k]) * w;
        }
#pragma unroll
        for (int i = 0; i < 8; ++i) ref[(size_t)(r0 + i) * INW + c] = f2bf(acc[i]);
    }
}
DI void phase_proj_compare(const Params& p) {
    const bf16_t* proj = (const bf16_t*)(p.ws + OFF_BIG); const bf16_t* ref = (const bf16_t*)(p.ws + OFF_ST); const bf16_t* dvt = (const bf16_t*)(p.ws + OFF_DVT);
    const int gtid = blockIdx.x * NTHREADS + threadIdx.x, gsz = gridDim.x * NTHREADS;
    float num = 0.f, den = 0.f;
    for (int idx = gtid; idx < PCH_ROWS * INW; idx += gsz) { const float a = bf2f(proj[idx]), r = bf2f(ref[idx]); num += (a - r) * (a - r); den += r * r; }
    for (int idx = gtid; idx < PCH_ROWS * 128; idx += gsz) {
        const int row = idx >> 7, dv = idx & 127, b = row / TT, t = row - b * TT;
        const float a = bf2f(dvt[(size_t)(b * 128 + dv) * TTP + t]), r = bf2f(ref[(size_t)row * INW + C_DV + dv]); num += (a - r) * (a - r); den += r * r;
    }
    num = wave_sum(num); den = wave_sum(den);
    if ((threadIdx.x & 63) == 0) { atomicAdd((float*)(p.ws + OFF_BAR) + 3600, num); atomicAdd((float*)(p.ws + OFF_BAR) + 3601, den); }
}
#endif
constexpr int NPHASES = 10;
__global__ void __launch_bounds__(NTHREADS, 2) mk_forward(Params p) {
    extern __shared__ __attribute__((aligned(16))) char dyn_smem[];
    LAS char* smem = (LAS char*)dyn_smem;
    const bool multi = (p.hi - p.lo) > 1;
    LAS char* tp_smem = smem;
    if (TP_SEC && blockIdx.x == 0 && threadIdx.x == 0) { volatile LAS long long* tp_ = (volatile LAS long long*)(smem + TP_LDS_OFF); tp_[0] = (long long)__builtin_readcyclecounter(); tp_[2] = 0; }
    XcdBarrier bar; bar.bar = (unsigned*)(p.ws + OFF_BAR); bar.x = 0; bar.st = (volatile LAS unsigned*)(smem + LDS_BAR_OFF);
    if (multi) {
        if (threadIdx.x == 0) { const u32x4 z = {0u, 0u, 0u, 0u}; *(LAS u32x4*)(smem + LDS_BAR_OFF) = z; }
        __syncthreads();
        bar = xcd_barrier_post((unsigned*)(p.ws + OFF_BAR), (volatile LAS unsigned*)(smem + LDS_BAR_OFF));
    }
#ifndef PHMASK
#define PHMASK 0xFFFF
#endif
#define PH_ON(i) (((PHMASK >> (i)) & 1) && p.lo <= (i) && (i) < p.hi)
#define PH_SYNC(i) do { if (multi && (i) + 1 < p.hi) { TP_BEGIN(7); xcd_barrier(bar); TP_END(7); } } while (0)
#ifndef REPEAT_MASK
#define REPEAT_MASK 0
#endif
#define PH_REP(i) for (int rep_ = 0; rep_ < 1 + ((REPEAT_MASK >> (i)) & 1); ++rep_)
    if (PH_ON(0)) { const Params q = load_params(); TP_BEGIN(8); PH_REP(0) phase_prologue(q); TP_END(8); PH_SYNC(0); }
    if (PH_ON(1)) { const Params q = load_params(); TP_BEGIN(9); PH_REP(1) { EpiProjRope e; e.P = (bf16_t*)(q.ws + OFF_BIG); e.DVTp = (bf16_t*)(q.ws + OFF_DVT); e.c128 = (const float*)(q.ws + OFF_COS128); e.s128 = (const float*)(q.ws + OFF_SIN128); e.c64 = (const float*)(q.ws + OFF_COS64); e.s64 = (const float*)(q.ws + OFF_SIN64); e.raw = 0; e.row_limit = MPAD; gemm256<true>((const bf16_t*)(q.ws + OFF_HN), (const bf16_t*)(q.ws + OFF_WINT), 1024, MPAD / 256, 4096 / 256, (LAS bf16_t*)smem, e); } TP_END(9); PH_SYNC(1); }
#ifdef ROPE_SEPARATE
    if (PH_ON(2)) { const Params q = load_params(); TP_BEGIN(5); phase_rope(q, smem, (bf16_t*)(q.ws + OFF_BIG), MROWS, true); TP_END(5); PH_SYNC(2); }
#endif
#ifdef PROJ_CHECK
    {   const Params q = load_params();
        phase_proj_ref_naive(q);
        xcd_barrier(bar);
        phase_rope(q, smem, (bf16_t*)(q.ws + OFF_ST), PCH_ROWS, false);
        xcd_barrier(bar);
        phase_proj_compare(q);
        xcd_barrier(bar);
    }
#endif
    if (PH_ON(3)) { const Params q = load_params(); PH_REP(3) {
#ifndef RS_REP
#define RS_REP 1
#endif
#ifndef DSA_REP
#define DSA_REP 1
#endif
            for (int rr_ = 0; rr_ < RS_REP; ++rr_) phase_ret_state_mfma(q, smem);
#ifdef PROJ_CHECK
            {
                bf16_t* mixed_ = (bf16_t*)(q.ws + OFF_HN);
                for (int idx = blockIdx.x * NTHREADS + threadIdx.x; idx < NF * 64; idx += gridDim.x * NTHREADS) { const int row = idx >> 6, c8 = idx & 63; const u32x4 z = {0u, 0u, 0u, 0u}; *(u32x4*)(mixed_ + (size_t)row * DM + 512 + c8 * 8) = z; }
            }
#else
            for (int rr_ = 0; rr_ < DSA_REP; ++rr_) { phase_dsa_fast(q, smem); __syncthreads(); }
#endif
#ifdef DSA_CHECK
            __syncthreads(); xcd_barrier(bar); phase_dsa_naive<true>(q, smem);
#endif
        } PH_SYNC(3); }
    if (PH_ON(4)) { const Params q = load_params(); TP_BEGIN(6); phase_ret_scan(q); TP_END(6); PH_SYNC(4); }
    if (PH_ON(5)) { const Params q = load_params(); PH_REP(5) phase_ret_out_mfma(q, smem); PH_SYNC(5); }
    if (PH_ON(6)) { const Params q = load_params(); PH_REP(6) {
#ifdef PROJ_CHECK
        EpiOut e; e.H = q.out; e.X = q.x; gemm256<false>(
#else
        EpiOutT e; e.H = q.out; e.X = q.x; e.HG = (bf16_t*)(q.ws + OFF_HG); e.G = q.norm_ffn; e.SSQ = (float*)(q.ws + OFF_SSQ); gemm256<true>(
#endif
        (const bf16_t*)(q.ws + OFF_HN), (const bf16_t*)(q.ws + OFF_WOUTT), 1024, NF / 256, 1024 / 256, (LAS bf16_t*)smem, e); } PH_SYNC(6); }
    if (PH_ON(8)) { const Params q = load_params(); phase_convert_tables(q); PH_REP(8) { EpiPQ e; e.Q = (float*)(q.ws + OFF_BIG); gemm256<false>((const bf16_t*)(q.ws + OFF_HG), (const bf16_t*)(q.ws + OFF_WQT), 1024, NF / 256, 2048 / 256, (LAS bf16_t*)smem, e); } PH_SYNC(8); }
    if (PH_ON(9)) { const Params q = load_params(); PH_REP(9) { phase_peer_select(q, smem); }
        if (TP_SEC && blockIdx.x == 0 && threadIdx.x == 0) { volatile LAS long long* tp_ = (volatile LAS long long*)(smem + TP_LDS_OFF); const float fr = (float)tp_[2] / (float)((long long)__builtin_readcyclecounter() - tp_[0]); ((float*)(p.ws + OFF_BAR))[3602] = fr; }
        asm volatile("s_waitcnt vmcnt(0)" ::: "memory"); __syncthreads(); }
    if (PH_ON(10)) { const Params q = load_params(); phase_peer_out_rows(q, smem); }
}

extern "C" void kernel_launch(void* const* d_in, const int* in_sizes, int n_in, void* d_out, int out_size, void* d_ws, size_t ws_size, hipStream_t stream) {
    static int grid = 0;
    if (grid == 0) {
        if (n_in != 12 || out_size != NF * DM || ws_size < WS_END) { fprintf(stderr, "kernel_launch: unexpected shapes (n_in %d out %d ws %zu need %zu)\n", n_in, out_size, ws_size, (size_t)WS_END); grid = -1; return; }
        int dev = 0, cus = 0, per_cu = 0;
        if (hipGetDevice(&dev) != hipSuccess || hipDeviceGetAttribute(&cus, hipDeviceAttributeMultiprocessorCount, dev) != hipSuccess) { grid = -1; return; }
        if (hipFuncSetAttribute((const void*)mk_forward, hipFuncAttributeMaxDynamicSharedMemorySize, LDS_BYTES) != hipSuccess) { fprintf(stderr, "kernel_launch: hipFuncSetAttribute failed\n"); grid = -1; return; }
        if (hipOccupancyMaxActiveBlocksPerMultiprocessor(&per_cu, (const void*)mk_forward, NTHREADS, LDS_BYTES) != hipSuccess || per_cu < 1)
            fprintf(stderr, "kernel_launch: occupancy query reports %d blocks per CU\n", per_cu);
        (void)hipGetLastError();
        grid = cus > 0 ? cus : 256;
    }
    if (grid < 0) return;
    Params p{};
    p.x = (const float*)d_in[0]; p.meta = (const float*)d_in[1]; p.norm_mix = (const float*)d_in[2]; p.w_in = (const float*)d_in[3];
    p.w_uv = (const float*)d_in[4]; p.w_out = (const float*)d_in[5]; p.norm_ffn = (const float*)d_in[6]; p.wq = (const float*)d_in[7];
    p.sk = (const float*)d_in[8]; p.pu = (const float*)d_in[9]; p.pv = (const float*)d_in[10]; p.norm_final = (const float*)d_in[11];
    p.out = (float*)d_out; p.ws = (char*)d_ws; p.pad0 = 0; p.pad1 = 0;
    (void)hipMemsetAsync((char*)d_ws + OFF_BAR, 0, 16384, stream);
#if MK_LAUNCHES == 1
    p.lo = 0; p.hi = NPHASES + 1;
    hipLaunchKernelGGL(mk_forward, dim3(grid), dim3(NTHREADS), LDS_BYTES, stream, p);
#else
    for (int ph = 0; ph <= NPHASES; ++ph) { p.lo = ph; p.hi = ph + 1; hipLaunchKernelGGL(mk_forward, dim3(grid), dim3(NTHREADS), LDS_BYTES, stream, p); }
#endif
}
```

```cpp
#include <hip/hip_runtime.h>
#include <stdint.h>
#include <stdio.h>

#ifndef MK_LAUNCHES
#define MK_LAUNCHES 1
#endif

#define DI __device__ __forceinline__
#ifndef TP_SEC
#define TP_SEC 0
#endif
#ifndef CHK_GAIN
#define CHK_GAIN 10.f
#endif
#define TP_LDS_OFF (163840 - 128)
#define TP_BEGIN(k) do { if (TP_SEC == (k) && blockIdx.x == 0 && threadIdx.x == 0) { *(volatile __attribute__((address_space(3))) long long*)(tp_smem + TP_LDS_OFF + 8) = (long long)__builtin_readcyclecounter(); } } while (0)
#define TP_END(k) do { if (TP_SEC == (k) && blockIdx.x == 0 && threadIdx.x == 0) { volatile __attribute__((address_space(3))) long long* tp_ = (volatile __attribute__((address_space(3))) long long*)(tp_smem + TP_LDS_OFF); tp_[2] += (long long)__builtin_readcyclecounter() - tp_[1]; } } while (0)
typedef unsigned short bf16_t;
typedef short bf16x8 __attribute__((ext_vector_type(8)));
typedef float f32x4 __attribute__((ext_vector_type(4)));
typedef unsigned u32x4 __attribute__((ext_vector_type(4)));

constexpr int NB = 8, SEQ = 2048, NMETA = 16, TT = 2064, DM = 1024, INW = 3912;
constexpr int MROWS = NB * TT;
constexpr int MPAD = 16640;
constexpr int NF = NB * SEQ;
constexpr int C_RQ = 0, C_RK = 512, C_RV = 1024, C_RG = 1536, C_DQ = 2048, C_DK = 3072, C_DV = 3200, C_IQ = 3328, C_IK = 3840, C_IW = 3904;
constexpr int NTHREADS = 512, NWAVES = 8;
constexpr int LDS_BYTES = 163840;
constexpr int LDS_BAR_OFF = 163840 - 256;

constexpr size_t al256(size_t x) { return (x + 255) & ~(size_t)255; }
constexpr size_t OFF_BAR = 0;
constexpr size_t OFF_COS128 = 16384;
constexpr size_t OFF_SIN128 = OFF_COS128 + al256((size_t)TT * 64 * 4);
constexpr size_t OFF_COS64 = OFF_SIN128 + al256((size_t)TT * 64 * 4);
constexpr size_t OFF_SIN64 = OFF_COS64 + al256((size_t)TT * 32 * 4);
constexpr size_t OFF_WINT = OFF_SIN64 + al256((size_t)TT * 32 * 4);
constexpr size_t OFF_WOUTT = OFF_WINT + (size_t)4096 * 1024 * 2;
constexpr size_t OFF_WQT = OFF_WOUTT + (size_t)1024 * 1024 * 2;
constexpr size_t OFF_SKH = OFF_WQT + (size_t)2048 * 1024 * 2;
constexpr size_t OFF_SKL = OFF_SKH + (size_t)2048 * 128 * 2;
constexpr int TTP = 2176;
constexpr size_t OFF_WUVT = OFF_SKL + (size_t)2048 * 128 * 2;
constexpr size_t OFF_DVT = OFF_WUVT + (size_t)8 * 64 * 128 * 2;
constexpr size_t OFF_HN = OFF_DVT + (size_t)NB * 128 * TTP * 2;
constexpr size_t OFF_BIG = OFF_HN + (size_t)MPAD * 1024 * 2;
constexpr size_t BIG_BYTES = (size_t)NF * 2048 * 4;
constexpr size_t OFF_ST = OFF_BIG + al256(BIG_BYTES);
constexpr size_t ST_BYTES = (size_t)32 * 34 * 16384 * 4;
constexpr size_t OFF_EG = OFF_ST;
constexpr size_t OFF_U8 = OFF_EG + (size_t)NF * 128 * 4;
constexpr size_t OFF_SU = OFF_U8 + (size_t)16384 * 1024;
constexpr size_t OFF_V8 = OFF_SU + 65536;
constexpr size_t OFF_SV = OFF_V8 + (size_t)16384 * 1024;
constexpr size_t OFF_HG = OFF_SV + 65536;
constexpr size_t OFF_SSQ = OFF_HG + (size_t)NF * 1024 * 2;
constexpr size_t WS_END = OFF_SSQ + (size_t)NF * 4;
static_assert(OFF_ST + ST_BYTES <= WS_END, "retention states fit");
static_assert(WS_END <= (size_t)268435456, "workspace");

struct Params {
    const float *x, *meta, *norm_mix, *w_in, *w_uv, *w_out, *norm_ffn, *wq, *sk, *pu, *pv, *norm_final;
    float* out; char* ws; int lo, hi, pad0, pad1;
};

DI float bf2f(bf16_t v) { return __uint_as_float(((unsigned)v) << 16); }
typedef float f32x2_t __attribute__((ext_vector_type(2)));
typedef __bf16 bf16x2_t __attribute__((ext_vector_type(2)));
DI bf16_t f2bf(float f) { const __bf16 h = (__bf16)f; return __builtin_bit_cast(unsigned short, h); }
DI unsigned pk2bf(float a, float b) { const f32x2_t v = {a, b}; const bf16x2_t h = __builtin_convertvector(v, bf16x2_t); return __builtin_bit_cast(unsigned, h); }
DI float wave_sum(float v) {
#pragma unroll
    for (int o = 32; o > 0; o >>= 1) v += __shfl_xor(v, o);
    return v;
}
DI float wave_max(float v) {
#pragma unroll
    for (int o = 32; o > 0; o >>= 1) v = fmaxf(v, __shfl_xor(v, o));
    return v;
}
DI unsigned long long wave_max_u64(unsigned long long v) {
#pragma unroll
    for (int o = 32; o > 0; o >>= 1) {
        const unsigned hi = __shfl_xor((unsigned)(v >> 32), o), lo = __shfl_xor((unsigned)v, o);
        const unsigned long long w = ((unsigned long long)hi << 32) | lo;
        v = w > v ? w : v;
    }
    return v;
}
DI unsigned fkey(float x) { const unsigned u = __float_as_uint(x); return (u & 0x80000000u) ? ~u : (u | 0x80000000u); }
DI float funkey(unsigned k) { const unsigned u = (k & 0x80000000u) ? (k & 0x7fffffffu) : ~k; return __uint_as_float(u); }
DI void lds_fence() { asm volatile("s_waitcnt lgkmcnt(0)" ::: "memory"); }
DI void unpack8(const u32x4& r, float (&v)[8]) {
    v[0] = __uint_as_float(r.x << 16); v[1] = __uint_as_float(r.x & 0xffff0000u);
    v[2] = __uint_as_float(r.y << 16); v[3] = __uint_as_float(r.y & 0xffff0000u);
    v[4] = __uint_as_float(r.z << 16); v[5] = __uint_as_float(r.z & 0xffff0000u);
    v[6] = __uint_as_float(r.w << 16); v[7] = __uint_as_float(r.w & 0xffff0000u);
}

typedef float f32x16 __attribute__((ext_vector_type(16)));
DI bf16x8 pack8(const float (&x)[8]) {
    u32x4 r;
#pragma unroll
    for (int j = 0; j < 4; ++j) r[j] = pk2bf(x[2 * j], x[2 * j + 1]);
    return __builtin_bit_cast(bf16x8, r);
}
DI bf16x8 pack_hi8(const float (&x)[8], float (&rem)[8]) {
    u32x4 r;
#pragma unroll
    for (int j = 0; j < 4; ++j) { r[j] = pk2bf(x[2 * j], x[2 * j + 1]); rem[2 * j] = x[2 * j] - __uint_as_float(r[j] << 16); rem[2 * j + 1] = x[2 * j + 1] - __uint_as_float(r[j] & 0xffff0000u); }
    return __builtin_bit_cast(bf16x8, r);
}

DI float dpp_row_sum(float v) {
    v += __int_as_float(__builtin_amdgcn_update_dpp(0, __float_as_int(v), 0xB1, 0xF, 0xF, true));
    v += __int_as_float(__builtin_amdgcn_update_dpp(0, __float_as_int(v), 0x4E, 0xF, 0xF, true));
    v += __int_as_float(__builtin_amdgcn_update_dpp(0, __float_as_int(v), 0x141, 0xF, 0xF, true));
    v += __int_as_float(__builtin_amdgcn_update_dpp(0, __float_as_int(v), 0x140, 0xF, 0xF, true));
    return v;
}
DI float wave_sum_uniform(float v) {
    v = dpp_row_sum(v);
    const float a = __int_as_float(__builtin_amdgcn_readlane(__float_as_int(v), 0)), b = __int_as_float(__builtin_amdgcn_readlane(__float_as_int(v), 16));
    const float c = __int_as_float(__builtin_amdgcn_readlane(__float_as_int(v), 32)), d = __int_as_float(__builtin_amdgcn_readlane(__float_as_int(v), 48));
    return (a + b) + (c + d);
}

DI int wave_sum_int(int v) {
    v += __builtin_amdgcn_update_dpp(0, v, 0xB1, 0xF, 0xF, true);
    v += __builtin_amdgcn_update_dpp(0, v, 0x4E, 0xF, 0xF, true);
    v += __builtin_amdgcn_update_dpp(0, v, 0x141, 0xF, 0xF, true);
    v += __builtin_amdgcn_update_dpp(0, v, 0x140, 0xF, 0xF, true);
    return (__builtin_amdgcn_readlane(v, 0) + __builtin_amdgcn_readlane(v, 16)) + (__builtin_amdgcn_readlane(v, 32) + __builtin_amdgcn_readlane(v, 48));
}

#define XB_TMO      128
#define XB_XCNT(j)  (256  + 64 * (j))
#define XB_XSUB(j)  (1280 + 64 * (j))
#define XB_XGEN(j)  (2304 + 64 * (j))
#define XB_TOP      3328
#define XB_TOPGEN   3392
#define XCD_BAR_WORDS 3456
#define XB_SPIN_CAP (1u << 20)
#define LAS __attribute__((address_space(3)))

DI unsigned xb_ld(unsigned* p)              { return __hip_atomic_load(p, __ATOMIC_RELAXED, __HIP_MEMORY_SCOPE_AGENT); }
DI unsigned xb_add(unsigned* p, unsigned v) { return __hip_atomic_fetch_add(p, v, __ATOMIC_RELAXED, __HIP_MEMORY_SCOPE_AGENT); }
DI unsigned xb_xcc_id() { return (unsigned)__builtin_amdgcn_s_getreg((3 << 11) | 20) & 0xFu; }
#define XB_SPIN(cond, bar) do { unsigned _sp = 0; while (cond) { __builtin_amdgcn_s_sleep(1); \
    if ((++_sp & 255u) == 0u) { if (xb_ld(&(bar)[XB_TMO])) break; if (_sp > XB_SPIN_CAP) { atomicAdd(&(bar)[XB_TMO], 1u); break; } } } } while (0)

struct XcdBarrier { unsigned* bar; unsigned x; volatile LAS unsigned* st; };

DI XcdBarrier xcd_barrier_post(unsigned* bar, volatile LAS unsigned* st) {
    XcdBarrier b; b.bar = bar; b.x = xb_xcc_id(); b.st = st;
    if (threadIdx.x == 0) (void)xb_add(&bar[XB_XCNT(b.x)], 1u);
    return b;
}
DI void xcd_barrier_complete(unsigned* bar, unsigned x, unsigned& nloc, unsigned& nx) {
    const unsigned G = gridDim.x * gridDim.y * gridDim.z;
    unsigned sum, cnt, mine, sp = 0u;
    for (;;) {
        sum = 0u; cnt = 0u; mine = 0u;
#pragma unroll
        for (unsigned j = 0; j < 16; ++j) { const unsigned c = xb_ld(&bar[XB_XCNT(j)]); sum += c; cnt += (c > 0u) ? 1u : 0u; mine = (j == x) ? c : mine; }
        if (sum == G) break;
        __builtin_amdgcn_s_sleep(1);
        if ((++sp & 255u) == 0u) { if (xb_ld(&bar[XB_TMO])) break; if (sp > XB_SPIN_CAP) { atomicAdd(&bar[XB_TMO], 1u); break; } }
    }
    nloc = mine > 0u ? mine : 1u; nx = cnt > 0u ? cnt : 1u;
}
DI void xcd_barrier(const XcdBarrier& b) {
    asm volatile("s_waitcnt vmcnt(0)" ::: "memory");
    __syncthreads();
    if (threadIdx.x == 0) {
        unsigned* bar = b.bar;
        __builtin_amdgcn_s_waitcnt(0);
        unsigned nloc = b.st[0], nx = b.st[1];
        if (nloc == 0u) { xcd_barrier_complete(bar, b.x, nloc, nx); b.st[0] = nloc; b.st[1] = nx; }
        const unsigned old = xb_add(&bar[XB_XSUB(b.x)], 1u);
        const unsigned gen = old / nloc;
        if (old + 1u == (gen + 1u) * nloc) {
            __builtin_amdgcn_fence(__ATOMIC_RELEASE, "agent");
            asm volatile("s_waitcnt vmcnt(0)" ::: "memory");
            const unsigned og = xb_add(&bar[XB_TOP], 1u);
            const unsigned tg = og / nx;
            if (og + 1u == (tg + 1u) * nx) xb_add(&bar[XB_TOPGEN], 1u);
            else XB_SPIN(xb_ld(&bar[XB_TOPGEN]) == tg, bar);
            __builtin_amdgcn_fence(__ATOMIC_ACQUIRE, "agent");
            xb_add(&bar[XB_XGEN(b.x)], 1u);
            asm volatile("s_waitcnt vmcnt(0)" ::: "memory");
        } else {
            XB_SPIN(xb_ld(&bar[XB_XGEN(b.x)]) == gen, bar);
            __builtin_amdgcn_fence(__ATOMIC_ACQUIRE, "agent");
            asm volatile("s_waitcnt vmcnt(0)" ::: "memory");
        }
    }
    __syncthreads();
}

constexpr int BM = 256, BK = 64, HALF = 128, NXCD = 8, WGM = 8, HT = HALF * BK;
DI int lds_byte(int r, int c) {
    int st = (r >> 4) * 2 + (c >> 5), rr = r & 15, cc = c & 31, ob = rr * 64 + cc * 2;
    return st * 1024 + (ob ^ (((ob >> 9) & 1) << 5));
}
DI void stage_rc(int b, int& R, int& C) {
    int st = b / 1024, sb = b % 1024, swz = sb ^ (((sb >> 9) & 1) << 5);
    R = (st >> 1) * 16 + swz / 64; C = (st & 1) * 32 + (swz % 64) / 2;
}

#define SA(b,h) (shm+((b)*2+(h))*HT)
#define SB(b,h) (shm+(4+(b)*2+(h))*HT)
#define STAGE_X(T,P,BASE,br,kt) do{long _g=(long)(br)*K+(long)(kt)*BK; \
    for(int _i=0;_i<2;++_i){int _b=(T)*16+_i*8192;int _r,_c;stage_rc(_b,_r,_c); \
      __builtin_amdgcn_global_load_lds((const unsigned*)(BASE+_g+(long)_r*K+_c), \
        (LAS unsigned*)((LAS char*)(P)+_b),16,0,0);}}while(0)
#define STAGE(P,BASE,br,kt) STAGE_X(threadIdx.x,P,BASE,br,kt)
#define LDA(dst,b,h) for(int m=0;m<4;++m)for(int k=0;k<2;++k) \
    dst[m][k]=*reinterpret_cast<const LAS bf16x8*>((LAS char*)SA(b,h)+lds_byte(wr*64+m*16+fr,k*32+fq*8))
#define LDB(dst,b,h) for(int n=0;n<2;++n)for(int k=0;k<2;++k) \
    dst[n][k]=*reinterpret_cast<const LAS bf16x8*>((LAS char*)SB(b,h)+lds_byte(wc*32+n*16+fr,k*32+fq*8))
#define MMA(ai,bj,At,Bt_) do{__builtin_amdgcn_s_setprio(1); \
    for(int m=0;m<4;++m)for(int n=0;n<2;++n)for(int k=0;k<2;++k) \
      acc[ai][bj][m][n]=TRANS?__builtin_amdgcn_mfma_f32_16x16x32_bf16(Bt_[n][k],At[m][k],acc[ai][bj][m][n],0,0,0):__builtin_amdgcn_mfma_f32_16x16x32_bf16(At[m][k],Bt_[n][k],acc[ai][bj][m][n],0,0,0); \
    __builtin_amdgcn_s_setprio(0);}while(0)
#define WAIT_V(n) asm volatile("s_waitcnt vmcnt(" #n ")":::"memory")
#define WAIT_L(n) asm volatile("s_waitcnt lgkmcnt(" #n ")":::"memory")
#define BAR __builtin_amdgcn_s_barrier()
#define SCHED __builtin_amdgcn_sched_barrier(0)

template <bool TRANS, class Epi>
DI void gemm256(const bf16_t* __restrict__ A, const bf16_t* __restrict__ Bt, const int K, const int nM, const int nN, LAS bf16_t* shm, const Epi& epi) {
    const int nwg = nM * nN;
    for (int L = blockIdx.x; L < nwg; L += gridDim.x) {
        int wgid = L;
        { int q = nwg / NXCD, r = nwg % NXCD, xcd = wgid % NXCD, off = wgid / NXCD; wgid = (xcd < r ? xcd * (q + 1) : r * (q + 1) + (xcd - r) * q) + off; }
        int nig = WGM * nN, gid = wgid / nig, fm = gid * WGM, gsz = min(nM - fm, WGM);
        int pm = fm + ((wgid % nig) % gsz), pn = (wgid % nig) / gsz, brow = pm * BM, bcol = pn * BM;
        int wid = threadIdx.x >> 6, lane = threadIdx.x & 63, wr = wid >> 2, wc = wid & 3, fr = lane & 15, fq = lane >> 4;
        f32x4 acc[2][2][4][2] = {};
        bf16x8 At[4][2], B0[2][2], B1[2][2];
        int nt = K / BK;
        STAGE(SB(0,0),Bt,bcol,0); STAGE(SA(0,0),A,brow,0);
        STAGE(SB(0,1),Bt,bcol+HALF,0); STAGE(SA(0,1),A,brow+HALF,0);
        if (wr == 1) BAR;
        WAIT_V(4); BAR;
        STAGE(SB(1,0),Bt,bcol,1); STAGE(SA(1,0),A,brow,1); STAGE(SB(1,1),Bt,bcol+HALF,1);
        WAIT_V(6); BAR;
        for (int t = 0; t < nt - 2; t += 2) {
            LDB(B0,0,0); SCHED; LDA(At,0,0); STAGE(SA(1,1),A,brow+HALF,t+1);
            WAIT_L(8); BAR; WAIT_L(0); MMA(0,0,At,B0); BAR; SCHED;
            LDB(B1,0,1); STAGE(SB(0,0),Bt,bcol,t+2);
            BAR; WAIT_L(0); MMA(0,1,At,B1); BAR;
            LDA(At,0,1); STAGE(SA(0,0),A,brow,t+2);
            BAR; WAIT_L(0); MMA(1,0,At,B0); BAR; SCHED;
            STAGE(SB(0,1),Bt,bcol+HALF,t+2);
            WAIT_V(6); BAR; MMA(1,1,At,B1); BAR;
            LDB(B0,1,0); SCHED; LDA(At,1,0); STAGE(SA(0,1),A,brow+HALF,t+2);
            WAIT_L(8); BAR; WAIT_L(0); MMA(0,0,At,B0); BAR; SCHED;
            LDB(B1,1,1); STAGE(SB(1,0),Bt,bcol,t+3);
            BAR; WAIT_L(0); MMA(0,1,At,B1); BAR;
            LDA(At,1,1); STAGE(SA(1,0),A,brow,t+3);
            BAR; WAIT_L(0); MMA(1,0,At,B0); BAR; SCHED;
            STAGE(SB(1,1),Bt,bcol+HALF,t+3);
            WAIT_V(6); BAR; MMA(1,1,At,B1); BAR;
        }
        int tz = threadIdx.x; asm volatile("" : "+v"(tz)); wid = tz >> 6; lane = tz & 63; wr = wid >> 2; wc = wid & 3; fr = lane & 15; fq = lane >> 4;
        { LDB(B0,0,0); WAIT_V(0); LDA(At,0,0); STAGE_X(tz,SA(1,1),A,brow+HALF,nt-1);
          BAR; WAIT_L(0); MMA(0,0,At,B0); BAR;
          LDB(B1,0,1); BAR; WAIT_L(0); MMA(0,1,At,B1); BAR;
          LDA(At,0,1); WAIT_V(4); BAR; WAIT_L(0); MMA(1,0,At,B0); MMA(1,1,At,B1); BAR; }
        { LDB(B0,1,0); LDA(At,1,0); WAIT_V(2); BAR; WAIT_L(0); MMA(0,0,At,B0); BAR;
          LDB(B1,1,1); WAIT_V(0); BAR; WAIT_L(0); MMA(0,1,At,B1); BAR;
          LDA(At,1,1); BAR; WAIT_L(0); MMA(1,0,At,B0); MMA(1,1,At,B1); BAR; }
        if (wr == 0) BAR;
        epi(acc, brow, bcol, wr, wc, fr, fq);
        __syncthreads();
    }
}

struct EpiOut {
    float* H; const float* X;
    DI void operator()(const f32x4 (&acc)[2][2][4][2], int brow, int bcol, int wr, int wc, int fr, int fq) const {
#pragma unroll
        for (int ai = 0; ai < 2; ++ai)
#pragma unroll
        for (int bj = 0; bj < 2; ++bj)
#pragma unroll
        for (int m = 0; m < 4; ++m)
#pragma unroll
        for (int n = 0; n < 2; ++n)
#pragma unroll
        for (int j = 0; j < 4; ++j) {
            const int row = brow + ai * HALF + wr * 64 + m * 16 + fq * 4 + j, col = bcol + bj * HALF + wc * 32 + n * 16 + fr;
            const size_t o = (size_t)row * DM + col; H[o] = X[o] + acc[ai][bj][m][n][j];
        }
    }
};
struct EpiPQ {
    float* Q;
    DI void operator()(const f32x4 (&acc)[2][2][4][2], int brow, int bcol, int wr, int wc, int fr, int fq) const {
#pragma unroll
        for (int ai = 0; ai < 2; ++ai)
#pragma unroll
        for (int bj = 0; bj < 2; ++bj)
#pragma unroll
        for (int m = 0; m < 4; ++m)
#pragma unroll
        for (int n = 0; n < 2; ++n)
#pragma unroll
        for (int j = 0; j < 4; ++j) {
            const int row = brow + ai * HALF + wr * 64 + m * 16 + fq * 4 + j, col = bcol + bj * HALF + wc * 32 + n * 16 + fr;
            Q[(size_t)row * 2048 + col] = acc[ai][bj][m][n][j];
        }
    }
};

struct EpiOutT {
    float* H; const float* X; bf16_t* HG; const float* G; float* SSQ;
    DI void operator()(const f32x4 (&acc)[2][2][4][2], int brow, int bcol, int wr, int wc, int fr, int fq) const {
#pragma unroll
        for (int ai = 0; ai < 2; ++ai)
#pragma unroll
        for (int m = 0; m < 4; ++m) {
            const int row = brow + ai * HALF + wr * 64 + m * 16 + fr;
            const size_t o = (size_t)row * DM + bcol + wc * 32 + fq * 4;
            const float* xp = X + o; float* hp = H + o; bf16_t* gp = HG + o; const float* gn = G + bcol + wc * 32 + fq * 4;
            float ss = 0.f;
#pragma unroll
            for (int bj = 0; bj < 2; ++bj)
#pragma unroll
            for (int n = 0; n < 2; ++n) {
                const f32x4 x = *(const f32x4*)(xp + bj * HALF + n * 16); const f32x4 hv = x + acc[ai][bj][m][n];
                *(f32x4*)(hp + bj * HALF + n * 16) = hv;
                ss += hv[0] * hv[0] + hv[1] * hv[1] + hv[2] * hv[2] + hv[3] * hv[3];
                const f32x4 hg = hv * *(const f32x4*)(gn + bj * HALF + n * 16);
                uint2 w; w.x = pk2bf(hg[0], hg[1]); w.y = pk2bf(hg[2], hg[3]); *(uint2*)(gp + bj * HALF + n * 16) = w;
            }
            ss += __shfl_xor(ss, 16); ss += __shfl_xor(ss, 32);
            if (fq == 0) atomicAdd(SSQ + row, ss);
            __builtin_amdgcn_sched_barrier(0);
        }
    }
};

__host__ __device__ constexpr int proj_true_col(int n) {
    const int blk = n >> 7, P = n & 127, wc = P >> 5, nn = (P >> 4) & 1, i = P & 15;
    return blk * 128 + (blk < 26 ? wc * 16 + i + 64 * nn : (wc >> 1) * 64 + (wc & 1) * 16 + i + 32 * nn);
}
struct EpiProjRope {
    bf16_t* P; bf16_t* DVTp; const float *c128, *s128, *c64, *s64; int raw, row_limit;
    DI void operator()(const f32x4 (&acc)[2][2][4][2], int brow, int bcol, int wr, int wc, int fr, int fq) const {
#pragma unroll
        for (int ai = 0; ai < 2; ++ai)
#pragma unroll
        for (int m = 0; m < 4; ++m) {
            const int row = brow + ai * HALF + wr * 64 + m * 16 + fr;
            if (row >= row_limit) continue;
            const int b = row / TT, t = row - b * TT;
            bf16_t* rp = P + (size_t)row * INW;
#pragma unroll
            for (int bj = 0; bj < 2; ++bj) {
                const int cb = bcol + bj * HALF;
                const f32x4 x1 = acc[ai][bj][m][0], x2 = acc[ai][bj][m][1];
                f32x4 o1 = x1, o2 = x2; int c1, c2; bool st2 = true;
                if (cb < C_IQ) {
                    const int f = wc * 16 + fq * 4; c1 = cb + f; c2 = c1 + 64;
                    const bool roped = (cb < C_RV) || (cb >= C_DQ && cb < C_DV);
                    if (roped && !raw) {
                        const float sc = (cb < C_RK) ? 1.f : (cb < C_RV) ? 0.08838834764831845f : (cb < C_DK) ? 0.08838834764831845f * 1.4426950408889634f : 1.f;
                        const f32x4 cs = *(const f32x4*)(c128 + t * 64 + f), sn = *(const f32x4*)(s128 + t * 64 + f);
                        o1 = (x1 * cs - x2 * sn) * sc; o2 = (x2 * cs + x1 * sn) * sc;
                    }
                    if (cb == C_DV && row < MROWS && !raw) {
                        bf16_t* dp = DVTp + (size_t)(b * 128 + f) * TTP + t;
#pragma unroll
                        for (int j = 0; j < 4; ++j) { dp[(size_t)j * TTP] = f2bf(x1[j]); dp[(size_t)(64 + j) * TTP] = f2bf(x2[j]); }
                    }
                } else if (cb < 3968) {
                    const int hl = wc >> 1, f = (wc & 1) * 16 + fq * 4; c1 = cb + hl * 64 + f; c2 = c1 + 32;
                    if (raw) { if (hl == 1 && cb >= C_IK) { st2 = false; if (c1 >= INW) continue; } }
                    else if (cb < C_IK || hl == 0) {
                        const float sc = (cb < C_IK) ? 0.125f : 1.f;
                        const f32x4 cs = *(const f32x4*)(c64 + t * 32 + f), sn = *(const f32x4*)(s64 + t * 32 + f);
                        o1 = (x1 * cs - x2 * sn) * sc; o2 = (x2 * cs + x1 * sn) * sc;
                    } else { o1 = x1 * 0.35355339059327373f; st2 = false; if (c1 >= INW) continue; }
                } else continue;
                uint2 w1; w1.x = pk2bf(o1[0], o1[1]); w1.y = pk2bf(o1[2], o1[3]); *(uint2*)(rp + c1) = w1;
                if (st2) { uint2 w2; w2.x = pk2bf(o2[0], o2[1]); w2.y = pk2bf(o2[2], o2[3]); *(uint2*)(rp + c2) = w2; }
            }
        }
    }
};

DI void phase_prologue(const Params& p, LAS char* smem) {
    const int gtid = blockIdx.x * NTHREADS + threadIdx.x, gsz = gridDim.x * NTHREADS;
    {
        bf16_t* wint = (bf16_t*)(p.ws + OFF_WINT); bf16_t* woutt_ = (bf16_t*)(p.ws + OFF_WOUTT);
        LAS float* tl = (LAS float*)smem;
        for (int tile = blockIdx.x; tile < 16 * 64 + 16 * 16; tile += gridDim.x) {
            const bool isout = tile >= 16 * 64; const int tt = isout ? tile - 16 * 64 : tile;
            const int ncol = isout ? 16 : 64, k0 = (tt / ncol) * 64, c0 = (tt % ncol) * 64;
            const float* W = isout ? p.w_out : p.w_in; const int ldw = isout ? 1024 : INW, cmax = isout ? 1024 : INW;
            for (int i = threadIdx.x; i < 64 * 64; i += NTHREADS) { const int kk = i >> 6, cc = i & 63; tl[kk * 65 + cc] = (c0 + cc < cmax) ? W[(size_t)(k0 + kk) * ldw + c0 + cc] : 0.f; }
            __syncthreads();
            {
                const int cc = threadIdx.x >> 3, ch = threadIdx.x & 7, tc = c0 + cc;
                int n = tc;
                if (!isout) { const int blk = tc >> 7, T = tc & 127;
                    const int P = blk < 26 ? (((T & 63) >> 4) * 32 + (T >> 6) * 16 + (T & 15)) : ((((T >> 6) * 2 + ((T >> 4) & 1)) * 32) + ((T >> 5) & 1) * 16 + (T & 15));
                    n = blk * 128 + P; }
                u32x4 o;
#pragma unroll
                for (int w = 0; w < 4; ++w) o[w] = pk2bf(tl[(ch * 8 + 2 * w) * 65 + cc], tl[(ch * 8 + 2 * w + 1) * 65 + cc]);
                *(u32x4*)((isout ? woutt_ : wint) + (size_t)n * 1024 + k0 + ch * 8) = o;
            }
            __syncthreads();
        }
    }
    { float* ssq = (float*)(p.ws + OFF_SSQ); for (int idx = gtid; idx < NF; idx += gsz) ssq[idx] = 0.f; }
    {
        bf16_t* dvt = (bf16_t*)(p.ws + OFF_DVT);
        for (int idx = gtid; idx < NB * 128 * (TTP - TT); idx += gsz) { const int rw = idx / (TTP - TT), t = TT + idx % (TTP - TT); dvt[(size_t)rw * TTP + t] = (bf16_t)0; }
    }
    {
        bf16_t* wst = (bf16_t*)(p.ws + OFF_WQT);
        const int wave_ = threadIdx.x >> 6, lane_ = threadIdx.x & 63, r = lane_ & 31, hh = lane_ >> 5;
        for (int task = blockIdx.x * NWAVES + wave_; task < 16 * 32 * 4; task += gridDim.x * NWAVES) {
            const int nb = task & 3, hf = task >> 7, k0 = ((task >> 2) & 31) * 32;
            f32x16 acc;
#pragma unroll
            for (int i = 0; i < 16; ++i) acc[i] = 0.f;
            const float* arow = p.wq + (size_t)(k0 + r) * 2048 + hf * 128 + 8 * hh;
            const float* brow = p.sk + (size_t)(hf * 128 + nb * 32 + r) * 128 + 8 * hh;
#pragma unroll 2
            for (int ks = 0; ks < 8; ++ks) {
                const float4 a0 = *(const float4*)(arow + ks * 16), a1 = *(const float4*)(arow + ks * 16 + 4);
                const float4 b0 = *(const float4*)(brow + ks * 16), b1 = *(const float4*)(brow + ks * 16 + 4);
                const float af[8] = {a0.x, a0.y, a0.z, a0.w, a1.x, a1.y, a1.z, a1.w}; float ar[8];
                const float bf_[8] = {b0.x, b0.y, b0.z, b0.w, b1.x, b1.y, b1.z, b1.w}; float br[8];
                const bf16x8 ah = pack_hi8(af, ar); const bf16x8 al = pack8(ar);
                const bf16x8 bh = pack_hi8(bf_, br); const bf16x8 bl = pack8(br);
                acc = __builtin_amdgcn_mfma_f32_32x32x16_bf16(ah, bh, acc, 0, 0, 0);
                acc = __builtin_amdgcn_mfma_f32_32x32x16_bf16(ah, bl, acc, 0, 0, 0);
                acc = __builtin_amdgcn_mfma_f32_32x32x16_bf16(al, bh, acc, 0, 0, 0);
            }
            bf16_t* orow = wst + (size_t)(hf * 128 + nb * 32 + r) * 1024 + k0 + 4 * hh;
#pragma unroll
            for (int g4 = 0; g4 < 4; ++g4) { uint2 w; w.x = pk2bf(acc[4 * g4], acc[4 * g4 + 1]); w.y = pk2bf(acc[4 * g4 + 2], acc[4 * g4 + 3]); *(uint2*)(orow + 8 * g4) = w; }
        }
    }
    bf16_t* wuvt = (bf16_t*)(p.ws + OFF_WUVT);
    for (int idx = gtid; idx < 8 * 64 * 128; idx += gsz) {
        const int h = idx >> 13, e = (idx >> 7) & 63, dv = idx & 127;
        wuvt[idx] = f2bf(p.w_uv[(size_t)(h * 128 + dv) * 64 + e]);
    }
    float* c128 = (float*)(p.ws + OFF_COS128); float* s128 = (float*)(p.ws + OFF_SIN128);
    for (int idx = gtid; idx < TT * 64; idx += gsz) {
        const int pos = idx >> 6, j = idx & 63;
        const float inv = powf(10000.f, -(float)j * 2.0f / 128.f);
        const float ang = (float)pos * inv;
        float s, c; sincosf(ang, &s, &c);
        c128[idx] = c; s128[idx] = s;
    }
    float* c64 = (float*)(p.ws + OFF_COS64); float* s64 = (float*)(p.ws + OFF_SIN64);
    for (int idx = gtid; idx < TT * 32; idx += gsz) {
        const int pos = idx >> 5, j = idx & 31;
        const float inv = powf(10000.f, -(float)j * 2.0f / 64.f);
        const float ang = (float)pos * inv;
        float s, c; sincosf(ang, &s, &c);
        c64[idx] = c; s64[idx] = s;
    }
    bf16_t* hn = (bf16_t*)(p.ws + OFF_HN);
    const int wave = threadIdx.x >> 6, lane = threadIdx.x & 63;
    for (int row = blockIdx.x * NWAVES + wave; row < MPAD; row += gridDim.x * NWAVES) {
        bf16_t* o = hn + (size_t)row * DM;
        if (row >= MROWS) {
            for (int i = 0; i < 4; ++i) *(uint2*)(o + i * 256 + lane * 4) = make_uint2(0u, 0u);
            continue;
        }
        const int b = row / TT, t = row % TT;
        const float* src = t < NMETA ? p.meta + (size_t)t * DM : p.x + ((size_t)b * SEQ + (t - NMETA)) * DM;
        float4 v[4]; float ss = 0.f;
#pragma unroll
        for (int i = 0; i < 4; ++i) { v[i] = *(const float4*)(src + i * 256 + lane * 4); ss += v[i].x * v[i].x + v[i].y * v[i].y + v[i].z * v[i].z + v[i].w * v[i].w; }
        ss = wave_sum(ss);
        const float rstd = rsqrtf(ss * (1.f / DM) + 1e-6f);
#pragma unroll
        for (int i = 0; i < 4; ++i) {
            const float4 g = *(const float4*)(p.norm_mix + i * 256 + lane * 4);
            uint2 w;
            w.x = (unsigned)f2bf(v[i].x * rstd * g.x) | ((unsigned)f2bf(v[i].y * rstd * g.y) << 16);
            w.y = (unsigned)f2bf(v[i].z * rstd * g.z) | ((unsigned)f2bf(v[i].w * rstd * g.w) << 16);
            *(uint2*)(o + i * 256 + lane * 4) = w;
        }
    }
}

DI void rope8(bf16_t* p1, bf16_t* p2, const float* ct, const float* st, float scale) {
    const u32x4 r1 = *(const u32x4*)p1, r2 = *(const u32x4*)p2;
    float x1[8], x2[8]; unpack8(r1, x1); unpack8(r2, x2);
    const float4 c0 = *(const float4*)ct, c1 = *(const float4*)(ct + 4), s0 = *(const float4*)st, s1 = *(const float4*)(st + 4);
    const float cs[8] = {c0.x, c0.y, c0.z, c0.w, c1.x, c1.y, c1.z, c1.w}, sn[8] = {s0.x, s0.y, s0.z, s0.w, s1.x, s1.y, s1.z, s1.w};
    u32x4 o1, o2;
#pragma unroll
    for (int i = 0; i < 4; ++i) {
        const float a0 = (x1[2 * i] * cs[2 * i] - x2[2 * i] * sn[2 * i]) * scale, a1 = (x1[2 * i + 1] * cs[2 * i + 1] - x2[2 * i + 1] * sn[2 * i + 1]) * scale;
        const float b0 = (x2[2 * i] * cs[2 * i] + x1[2 * i] * sn[2 * i]) * scale, b1 = (x2[2 * i + 1] * cs[2 * i + 1] + x1[2 * i + 1] * sn[2 * i + 1]) * scale;
        o1[i] = (unsigned)f2bf(a0) | ((unsigned)f2bf(a1) << 16); o2[i] = (unsigned)f2bf(b0) | ((unsigned)f2bf(b1) << 16);
    }
    *(u32x4*)p1 = o1; *(u32x4*)p2 = o2;
}
DI void phase_rope(const Params& p, LAS char* smem, bf16_t* proj, const int nrows, const bool do_dvt) {
    const float* c128 = (const float*)(p.ws + OFF_COS128); const float* s128 = (const float*)(p.ws + OFF_SIN128);
    const float* c64 = (const float*)(p.ws + OFF_COS64); const float* s64 = (const float*)(p.ws + OFF_SIN64);
    const int gtid = blockIdx.x * NTHREADS + threadIdx.x, gsz = gridDim.x * NTHREADS;
    const int total = nrows * 173;
    for (int idx = gtid; idx < total; idx += gsz) {
        const int row = idx / 173, it = idx - row * 173;
        const int t = row % TT;
        bf16_t* pr = proj + (size_t)row * INW;
        if (it < 32)       { const int hd = it >> 3, j = (it & 7) * 8;          rope8(pr + C_RQ + hd * 128 + j, pr + C_RQ + hd * 128 + 64 + j, c128 + t * 64 + j, s128 + t * 64 + j, 1.f); }
        else if (it < 64)  { const int i2 = it - 32, hd = i2 >> 3, j = (i2 & 7) * 8;  rope8(pr + C_RK + hd * 128 + j, pr + C_RK + hd * 128 + 64 + j, c128 + t * 64 + j, s128 + t * 64 + j, 0.08838834764831845f); }
        else if (it < 128) { const int i2 = it - 64, hd = i2 >> 3, j = (i2 & 7) * 8;  rope8(pr + C_DQ + hd * 128 + j, pr + C_DQ + hd * 128 + 64 + j, c128 + t * 64 + j, s128 + t * 64 + j, 0.08838834764831845f * 1.4426950408889634f); }
        else if (it < 136) { const int j = (it - 128) * 8;                          rope8(pr + C_DK + j, pr + C_DK + 64 + j, c128 + t * 64 + j, s128 + t * 64 + j, 1.f); }
        else if (it < 168) { const int i2 = it - 136, hd = i2 >> 2, j = (i2 & 3) * 8; rope8(pr + C_IQ + hd * 64 + j, pr + C_IQ + hd * 64 + 32 + j, c64 + t * 32 + j, s64 + t * 32 + j, 0.125f); }
        else if (it < 172) { const int j = (it - 168) * 8;                          rope8(pr + C_IK + j, pr + C_IK + 32 + j, c64 + t * 32 + j, s64 + t * 32 + j, 1.f); }
        else {
            const u32x4 r = *(const u32x4*)(pr + C_IW); float v[8]; unpack8(r, v); u32x4 o;
#pragma unroll
            for (int i = 0; i < 4; ++i) o[i] = (unsigned)f2bf(v[2 * i] * 0.35355339059327373f) | ((unsigned)f2bf(v[2 * i + 1] * 0.35355339059327373f) << 16);
            *(u32x4*)(pr + C_IW) = o;
        }
    }
    if (!do_dvt) return;
    bf16_t* dvt = (bf16_t*)(p.ws + OFF_DVT);
    LAS bf16_t* tile = (LAS bf16_t*)smem;
    for (int unit = blockIdx.x; unit < NB * (TTP / 64); unit += gridDim.x) {
        const int b = unit / (TTP / 64), t0 = (unit % (TTP / 64)) * 64;
        for (int i = threadIdx.x; i < 64 * 16; i += NTHREADS) {
            const int tr = i >> 4, ch = i & 15, t = t0 + tr;
            u32x4 v = {0u, 0u, 0u, 0u};
            if (t < TT) v = *(const u32x4*)(proj + (size_t)(b * TT + t) * INW + C_DV + ch * 8);
            *(LAS u32x4*)(tile + tr * 136 + ch * 8) = v;
        }
        __syncthreads();
        for (int i = threadIdx.x; i < 128 * 8; i += NTHREADS) {
            const int dv = i >> 3, ch = i & 7;
            u32x4 o;
#pragma unroll
            for (int w = 0; w < 4; ++w) o[w] = (unsigned)tile[(ch * 8 + 2 * w) * 136 + dv] | ((unsigned)tile[(ch * 8 + 2 * w + 1) * 136 + dv] << 16);
            *(u32x4*)(dvt + (size_t)(b * 128 + dv) * TTP + t0 + ch * 8) = o;
        }
        __syncthreads();
    }
}

constexpr int DSA_WAVE_LDS = 2176 * 4 + 1024 * 4 + 256 * 4 + 64;
template <bool CHECK>
DI void phase_dsa_naive(const Params& p, LAS char* smem) {
    const bf16_t* proj = (const bf16_t*)(p.ws + OFF_BIG);
    bf16_t* mixed = (bf16_t*)(p.ws + OFF_HN);
    const int wave = threadIdx.x >> 6, lane = threadIdx.x & 63;
    LAS float* sSc = (LAS float*)(smem + wave * DSA_WAVE_LDS);
    LAS float* sQ = sSc + 2176;
    LAS int* sSel = (LAS int*)(sQ + 1024);
    LAS float* sIw = (LAS float*)(sSel + 256);
    const unsigned long long lt_mask = (1ull << lane) - 1ull;
    float chk_num = 0.f, chk_den = 0.f;
    for (int q = blockIdx.x * NWAVES + wave; q < NF; q += gridDim.x * NWAVES) {
        const int b = q >> 11, s = q & 2047, t = NMETA + s;
        const int nk = 80 + 64 * (s >> 6);
        const bf16_t* prow = proj + (size_t)(b * TT + t) * INW;
        for (int i = lane; i < 512; i += 64) sQ[i] = bf2f(prow[C_IQ + i]);
        if (lane < 8) sIw[lane] = bf2f(prow[C_IW + lane]);
        lds_fence();
        const bf16_t* ikbase = proj + (size_t)(b * TT) * INW + C_IK;
        const int nj = (nk + 63) >> 6;
        for (int jj = 0; jj < nj; ++jj) {
            const int k = jj * 64 + lane;
            float sc = 0.f;
            if (k < nk) {
                const bf16_t* kr = ikbase + (size_t)k * INW;
                float a[8];
#pragma unroll
                for (int h = 0; h < 8; ++h) a[h] = 0.f;
#pragma unroll 1
                for (int d8 = 0; d8 < 8; ++d8) {
                    const u32x4 raw = *(const u32x4*)(kr + d8 * 8); float kv[8]; unpack8(raw, kv);
#pragma unroll
                    for (int h = 0; h < 8; ++h) {
                        const f32x4 q0 = *(const LAS f32x4*)(sQ + h * 64 + d8 * 8), q1 = *(const LAS f32x4*)(sQ + h * 64 + d8 * 8 + 4);
                        a[h] += kv[0] * q0[0] + kv[1] * q0[1] + kv[2] * q0[2] + kv[3] * q0[3] + kv[4] * q1[0] + kv[5] * q1[1] + kv[6] * q1[2] + kv[7] * q1[3];
                    }
                }
#pragma unroll
                for (int h = 0; h < 8; ++h) sc += fmaxf(a[h], 0.f) * sIw[h];
                sc += 0.0f;
            }
            sSc[k] = sc;
        }
        lds_fence();
        int L;
        if (nk <= 256) {
            for (int i = lane; i < nk; i += 64) sSel[i] = i;
            L = nk;
        } else {
            unsigned Tkey = 0u;
            for (int bit = 31; bit >= 0; --bit) {
                const unsigned cand = Tkey | (1u << bit);
                int cnt = 0;
                for (int jj = 0; jj < nj; ++jj) {
                    const int k = jj * 64 + lane;
                    const unsigned key = (k < nk) ? fkey(sSc[k]) : 0u;
                    cnt += __popcll(__ballot(key >= cand));
                }
                if (cnt >= 256) Tkey = cand;
            }
            int cgt = 0;
            for (int jj = 0; jj < nj; ++jj) {
                const int k = jj * 64 + lane;
                const unsigned key = (k < nk) ? fkey(sSc[k]) : 0u;
                cgt += __popcll(__ballot(key > Tkey));
            }
            const int need = 256 - cgt;
            int pos = 0, eqseen = 0;
            for (int jj = 0; jj < nj; ++jj) {
                const int k = jj * 64 + lane;
                const unsigned key = (k < nk) ? fkey(sSc[k]) : 0u;
                const bool gt = key > Tkey, eq = (key == Tkey);
                const unsigned long long eqm = __ballot(eq);
                const int myeq = eqseen + __popcll(eqm & lt_mask);
                const bool sel = gt || (eq && myeq < need);
                const unsigned long long sm = __ballot(sel);
                if (sel) sSel[pos + __popcll(sm & lt_mask)] = k;
                pos += __popcll(sm); eqseen += __popcll(eqm);
            }
            L = 256;
        }
        lds_fence();
        for (int i = lane; i < 1024; i += 64) sQ[i] = bf2f(prow[C_DQ + i]);
        lds_fence();
        float sc[8][4];
        const bf16_t* dkbase = proj + (size_t)(b * TT) * INW + C_DK;
#pragma unroll
        for (int il = 0; il < 4; ++il) {
            const int i = lane + 64 * il; const bool ok = i < L; const int key = ok ? sSel[i] : 0;
            const bf16_t* kr = dkbase + (size_t)key * INW;
            float a[8];
#pragma unroll
            for (int h = 0; h < 8; ++h) a[h] = 0.f;
#pragma unroll 1
            for (int d8 = 0; d8 < 16; ++d8) {
                const u32x4 raw = *(const u32x4*)(kr + d8 * 8); float kv[8]; unpack8(raw, kv);
#pragma unroll
                for (int h = 0; h < 8; ++h) {
                    const f32x4 q0 = *(const LAS f32x4*)(sQ + h * 128 + d8 * 8), q1 = *(const LAS f32x4*)(sQ + h * 128 + d8 * 8 + 4);
                    a[h] += kv[0] * q0[0] + kv[1] * q0[1] + kv[2] * q0[2] + kv[3] * q0[3] + kv[4] * q1[0] + kv[5] * q1[1] + kv[6] * q1[2] + kv[7] * q1[3];
                }
            }
#pragma unroll
            for (int h = 0; h < 8; ++h) sc[h][il] = ok ? a[h] : -INFINITY;
        }
#pragma unroll
        for (int h = 0; h < 8; ++h) {
            float m = fmaxf(fmaxf(sc[h][0], sc[h][1]), fmaxf(sc[h][2], sc[h][3]));
            m = wave_max(m);
            float e[4], sum = 0.f;
#pragma unroll
            for (int il = 0; il < 4; ++il) { e[il] = exp2f(sc[h][il] - m); sum += e[il]; }
            sum = wave_sum(sum);
            const float inv = 1.f / sum;
#pragma unroll
            for (int il = 0; il < 4; ++il) sSc[h * 256 + lane + 64 * il] = e[il] * inv;
        }
        lds_fence();
        float o[8][2];
#pragma unroll
        for (int h = 0; h < 8; ++h) { o[h][0] = 0.f; o[h][1] = 0.f; }
        const bf16_t* dvbase = proj + (size_t)(b * TT) * INW + C_DV;
        for (int i = 0; i < L; ++i) {
            const int key = sSel[i];
            const float v0 = bf2f(dvbase[(size_t)key * INW + lane]), v1 = bf2f(dvbase[(size_t)key * INW + 64 + lane]);
#pragma unroll
            for (int h = 0; h < 8; ++h) { const float pv = sSc[h * 256 + i]; o[h][0] += pv * v0; o[h][1] += pv * v1; }
        }
        lds_fence();
#pragma unroll
        for (int h = 0; h < 8; ++h) { sQ[h * 128 + lane] = o[h][0]; sQ[h * 128 + 64 + lane] = o[h][1]; }
        lds_fence();
        for (int h = 0; h < 8; ++h) {
            float acc = 0.f;
            const float* wu = p.w_uv + (size_t)h * 128 * 64 + lane;
            for (int c = 0; c < 128; ++c) acc += sQ[h * 128 + c] * wu[c * 64];
            if (CHECK) { const float got = bf2f(mixed[(size_t)q * DM + 512 + h * 64 + lane]); chk_num += (got - acc) * (got - acc); chk_den += acc * acc; }
            else mixed[(size_t)q * DM + 512 + h * 64 + lane] = f2bf(acc);
        }
        lds_fence();
    }
    if (CHECK) {
        chk_num = wave_sum(chk_num); chk_den = wave_sum(chk_den);
        if (lane == 0) { atomicAdd((float*)(p.ws + OFF_BAR) + 3600, chk_num); atomicAdd((float*)(p.ws + OFF_BAR) + 3601, chk_den); }
    }
}

typedef unsigned long long u64;
typedef short s16x4 __attribute__((ext_vector_type(4)));
constexpr int SCLD = 2116;
constexpr int DSA_MASK_OFF = 16 * SCLD * 4;
constexpr int KLD = 136, VLD = 72, VLD2 = 136;
constexpr int DSA_VT_OFF = 128 * KLD * 2;
#define MFMA16(a, b, c) __builtin_amdgcn_mfma_f32_16x16x32_bf16((a), (b), (c), 0, 0, 0)
#define MFMA32(a, b, c) __builtin_amdgcn_mfma_f32_32x32x16_bf16((a), (b), (c), 0, 0, 0)
DI void phase_dsa_fast(const Params& p, LAS char* smem) {
    const bf16_t* proj = (const bf16_t*)(p.ws + OFF_BIG);
    const bf16_t* dvt = (const bf16_t*)(p.ws + OFF_DVT);
    const bf16_t* wuvt = (const bf16_t*)(p.ws + OFF_WUVT);
    bf16_t* mixed = (bf16_t*)(p.ws + OFF_HN);
    const int wave = threadIdx.x >> 6, lane = threadIdx.x & 63, c = lane & 15, g = lane >> 4;
    LAS float* SC = (LAS float*)smem; LAS u64* MASK = (LAS u64*)(smem + DSA_MASK_OFF);
    LAS bf16_t* KT = (LAS bf16_t*)smem; LAS bf16_t* VT = (LAS bf16_t*)(smem + DSA_VT_OFF);
    const u64 lt_mask = (1ull << lane) - 1ull;
    for (int pi = blockIdx.x; pi < 512; pi += gridDim.x)
    for (int which = 0; which < 2; ++which) {
        const int b = pi >> 6, qq = pi & 63, qt = which ? 127 - qq : qq;
        const int s0 = qt * 16, nk = 80 + 64 * (s0 >> 6), nkt = nk >> 4, nj = (nk + 63) >> 6;
        const bf16_t* pb = proj + (size_t)(b * TT) * INW;
        LAS char* tp_smem = smem; TP_BEGIN(1);
        {
            const bf16_t* qrow = pb + (size_t)(NMETA + s0 + c) * INW;
            bf16x8 bq[8][2]; float iw[8];
#pragma unroll
            for (int h = 0; h < 8; ++h) {
                bq[h][0] = *(const bf16x8*)(qrow + C_IQ + h * 64 + 8 * g);
                bq[h][1] = *(const bf16x8*)(qrow + C_IQ + h * 64 + 32 + 8 * g);
                iw[h] = bf2f(qrow[C_IW + h]);
            }
            bf16x8 a0n = {0, 0, 0, 0, 0, 0, 0, 0}, a1n = {0, 0, 0, 0, 0, 0, 0, 0};
            if (wave < nkt) { const bf16_t* krow = pb + (size_t)(wave * 16 + c) * INW + C_IK + 8 * g; a0n = *(const bf16x8*)(krow); a1n = *(const bf16x8*)(krow + 32); }
            for (int kt = wave; kt < nkt; kt += NWAVES) {
                const bf16x8 a0 = a0n, a1 = a1n;
                if (kt + NWAVES < nkt) { const bf16_t* krow = pb + (size_t)((kt + NWAVES) * 16 + c) * INW + C_IK + 8 * g; a0n = *(const bf16x8*)(krow); a1n = *(const bf16x8*)(krow + 32); }
                f32x4 isc = {0.f, 0.f, 0.f, 0.f};
#pragma unroll
                for (int h = 0; h < 8; ++h) {
                    f32x4 acc = {0.f, 0.f, 0.f, 0.f};
                    acc = MFMA16(a0, bq[h][0], acc); acc = MFMA16(a1, bq[h][1], acc);
#pragma unroll
                    for (int j = 0; j < 4; ++j) isc[j] += fmaxf(acc[j], 0.f) * iw[h];
                }
#pragma unroll
                for (int j = 0; j < 4; ++j) isc[j] += 0.0f;
                *(LAS f32x4*)(SC + c * SCLD + kt * 16 + 4 * g) = isc;
            }
            {
                const int tail = ((nj <= 11 ? 11 : (nj <= 22 ? 22 : 33)) << 6) - nk;
                for (int i = threadIdx.x; i < 16 * tail; i += NTHREADS) { const int qq_ = i / tail; SC[qq_ * SCLD + nk + (i - qq_ * tail)] = -3.0e38f; }
            }
        }
        __syncthreads(); TP_END(1); TP_BEGIN(2);
#pragma unroll 1
        for (int qi = 0; qi < 2; ++qi) {
            const int cq = wave * 2 + qi;
            unsigned kv[33];
#pragma unroll
            for (int jj = 0; jj < 11; ++jj) kv[jj] = fkey(SC[cq * SCLD + jj * 64 + lane]);
            if (nj > 11) {
#pragma unroll
                for (int jj = 11; jj < 22; ++jj) kv[jj] = fkey(SC[cq * SCLD + jj * 64 + lane]);
            } else {
#pragma unroll
                for (int jj = 11; jj < 22; ++jj) kv[jj] = 0u;
            }
            if (nj > 22) {
#pragma unroll
                for (int jj = 22; jj < 33; ++jj) kv[jj] = fkey(SC[cq * SCLD + jj * 64 + lane]);
            } else {
#pragma unroll
                for (int jj = 22; jj < 33; ++jj) kv[jj] = 0u;
            }
            unsigned Tkey = 1u;
            if (nk > 256) {
                Tkey = 0u;
#pragma unroll 1
                for (int bit = 31; bit >= 0; --bit) {
                    const unsigned cand = Tkey | (1u << bit);
                    int nl = 0;
#pragma unroll
                    for (int jj = 0; jj < 11; ++jj) nl += (kv[jj] >= cand) ? 1 : 0;
                    if (nj > 11) {
#pragma unroll
                        for (int jj = 11; jj < 22; ++jj) nl += (kv[jj] >= cand) ? 1 : 0;
                    }
                    if (nj > 22) {
#pragma unroll
                        for (int jj = 22; jj < 33; ++jj) nl += (kv[jj] >= cand) ? 1 : 0;
                    }
                    const int cnt = wave_sum_int(nl);
                    if (cnt >= 256) Tkey = cand;
                    if (cnt == 256) break;
                }
            }
            int cgl = 0;
#pragma unroll
            for (int jj = 0; jj < 33; ++jj) cgl += (kv[jj] > Tkey) ? 1 : 0;
            const int cgt = wave_sum_int(cgl);
            const int need = (nk > 256) ? 256 - cgt : 4096;
            int eqseen = 0;
#pragma unroll 1
            for (int jj = 0; jj < nj; ++jj) {
                const int k = jj * 64 + lane; const float v = SC[cq * SCLD + k];
                const unsigned key = (k < nk) ? fkey(v) : 0u;
                const bool gt = key > Tkey, eq = (key == Tkey);
                const u64 eqm = __ballot(eq);
                const int myeq = eqseen + __popcll(eqm & lt_mask);
                const u64 sm = __ballot(gt || (eq && myeq < need));
                eqseen += __popcll(eqm);
                if (lane == 0) MASK[cq * 34 + jj] = sm;
            }
        }
        __syncthreads(); TP_END(2); TP_BEGIN(3);
        {
            const int h = wave;
            const bf16_t* qrow = pb + (size_t)(NMETA + s0 + c) * INW + C_DQ + h * 128 + 8 * g;
            bf16x8 bQ[4];
#pragma unroll
            for (int ks = 0; ks < 4; ++ks) bQ[ks] = *(const bf16x8*)(qrow + ks * 32);
            f32x4 O[8];
#pragma unroll
            for (int mb = 0; mb < 8; ++mb) O[mb] = (f32x4){0.f, 0.f, 0.f, 0.f};
            float m_run = -1e30f, l_run = 0.f;
            const int prow_t = threadIdx.x >> 4, pch_t = threadIdx.x & 15;
            const bf16_t* vsrc = dvt + (size_t)(b * 128 + prow_t) * TTP + pch_t * 8;
            const int n128 = (nk + 127) >> 7;
            u32x4 pk[4], pv[4];
#pragma unroll
            for (int i = 0; i < 4; ++i) {
                int key = prow_t + 32 * i; key = key < nk ? key : nk - 1;
                pk[i] = *(const u32x4*)(pb + (size_t)key * INW + C_DK + pch_t * 8);
                pv[i] = *(const u32x4*)(vsrc + (size_t)(32 * i) * TTP);
            }
#pragma unroll 1
            for (int kb = 0; kb < n128; ++kb) {
#pragma unroll
                for (int i = 0; i < 4; ++i) {
                    *(LAS u32x4*)(KT + (prow_t + 32 * i) * KLD + pch_t * 8) = pk[i];
                    *(LAS u32x4*)(VT + (prow_t + 32 * i) * VLD2 + pch_t * 8) = pv[i];
                }
                __syncthreads();
                if (kb + 1 < n128) {
#pragma unroll
                    for (int i = 0; i < 4; ++i) {
                        int key = (kb + 1) * 128 + prow_t + 32 * i; key = key < nk ? key : nk - 1;
                        pk[i] = *(const u32x4*)(pb + (size_t)key * INW + C_DK + pch_t * 8);
                        pv[i] = *(const u32x4*)(vsrc + (size_t)(32 * i) * TTP + (kb + 1) * 128);
                    }
                }
#pragma unroll
                for (int sb = 0; sb < 2; ++sb) {
                    const int wi = kb * 2 + sb;
                    if (wi < nj) {
                        const u64 mw = MASK[c * 34 + wi];
                        f32x4 S[4];
#pragma unroll
                        for (int ct = 0; ct < 4; ++ct) {
                            f32x4 acc = {0.f, 0.f, 0.f, 0.f};
#pragma unroll
                            for (int ks = 0; ks < 4; ++ks) {
                                const bf16x8 a = *(const LAS bf16x8*)(KT + (sb * 64 + ct * 16 + c) * KLD + ks * 32 + 8 * g);
                                acc = MFMA16(a, bQ[ks], acc);
                            }
                            S[ct] = acc;
                        }
                        const u64 mws = mw >> (4 * g);
                        const unsigned mlo = (unsigned)mws, mhi = (unsigned)(mws >> 32);
                        float mblk = -1e30f;
#pragma unroll
                        for (int ct = 0; ct < 4; ++ct) {
                            const unsigned bits = ((ct & 2) ? mhi : mlo) >> ((ct & 1) * 16);
#pragma unroll
                            for (int j = 0; j < 4; ++j) {
                                S[ct][j] = ((bits >> j) & 1u) ? S[ct][j] : -1e30f;
                                mblk = fmaxf(mblk, S[ct][j]);
                            }
                        }
                        mblk = fmaxf(mblk, __shfl_xor(mblk, 16)); mblk = fmaxf(mblk, __shfl_xor(mblk, 32));
                        const float m_new = fmaxf(m_run, mblk);
                        float ps = 0.f;
#pragma unroll
                        for (int ct = 0; ct < 4; ++ct)
#pragma unroll
                            for (int j = 0; j < 4; ++j) { const float pv_ = (S[ct][j] > -1e29f) ? __builtin_amdgcn_exp2f(S[ct][j] - m_new) : 0.f; S[ct][j] = pv_; ps += pv_; }
                        if (__ballot(m_new != m_run) != 0ull) {
                            const float alpha = __builtin_amdgcn_exp2f(m_run - m_new);
                            l_run *= alpha;
#pragma unroll
                            for (int mb = 0; mb < 8; ++mb) O[mb] *= alpha;
                        }
                        l_run += ps; m_run = m_new;
                        bf16x8 bP[2];
#pragma unroll
                        for (int kk = 0; kk < 2; ++kk) {
                            u32x4 t4;
                            t4[0] = pk2bf(S[2 * kk][0], S[2 * kk][1]); t4[1] = pk2bf(S[2 * kk][2], S[2 * kk][3]);
                            t4[2] = pk2bf(S[2 * kk + 1][0], S[2 * kk + 1][1]); t4[3] = pk2bf(S[2 * kk + 1][2], S[2 * kk + 1][3]);
                            bP[kk] = __builtin_bit_cast(bf16x8, t4);
                        }
#pragma unroll
                        for (int mh = 0; mh < 2; ++mh) {
                            bf16x8 av[8];
#pragma unroll
                            for (int q = 0; q < 8; ++q) {
                                const int mb = mh * 4 + (q >> 1), kk = q & 1;
                                const LAS bf16_t* vr = VT + (mb * 16 + c) * VLD2 + sb * 64 + kk * 32 + 4 * g;
                                const s16x4 lo = *(const LAS s16x4*)(vr), hi = *(const LAS s16x4*)(vr + 16);
                                av[q] = __builtin_shufflevector(lo, hi, 0, 1, 2, 3, 4, 5, 6, 7);
                            }
                            __builtin_amdgcn_sched_barrier(0);
#pragma unroll
                            for (int q = 0; q < 8; ++q) { const int mb = mh * 4 + (q >> 1), kk = q & 1; O[mb] = MFMA16(av[q], bP[kk], O[mb]); }
                            __builtin_amdgcn_sched_barrier(0);
                        }
                    }
                }
                __syncthreads();
            }
            TP_END(3); TP_BEGIN(4);
            l_run += __shfl_xor(l_run, 16); l_run += __shfl_xor(l_run, 32);
            const float inv = 1.f / l_run;
            bf16x8 bO[4];
#pragma unroll
            for (int k2 = 0; k2 < 4; ++k2)
#pragma unroll
                for (int j = 0; j < 4; ++j) { bO[k2][j] = (short)f2bf(O[2 * k2][j] * inv); bO[k2][4 + j] = (short)f2bf(O[2 * k2 + 1][j] * inv); }
            bf16_t* orow = mixed + (size_t)(b * SEQ + s0 + c) * DM + 512 + h * 64;
            int zofs = 0; asm volatile("" : "+v"(zofs));
#pragma unroll
            for (int eb = 0; eb < 4; ++eb) {
                f32x4 acc = {0.f, 0.f, 0.f, 0.f};
#pragma unroll
                for (int k2 = 0; k2 < 4; ++k2) {
                    const bf16_t* wr = wuvt + (size_t)(h * 64 + eb * 16 + c) * 128 + k2 * 32 + 4 * g + zofs;
                    const s16x4 lo = *(const s16x4*)(wr), hi = *(const s16x4*)(wr + 16);
                    const bf16x8 a = __builtin_shufflevector(lo, hi, 0, 1, 2, 3, 4, 5, 6, 7);
                    acc = MFMA16(a, bO[k2], acc);
                }
                uint2 w;
                w.x = (unsigned)f2bf(acc[0]) | ((unsigned)f2bf(acc[1]) << 16);
                w.y = (unsigned)f2bf(acc[2]) | ((unsigned)f2bf(acc[3]) << 16);
                *(uint2*)(orow + eb * 16 + 4 * g) = w;
            }
            TP_END(4);
        }
    }
}

DI void phase_dsa32(const Params& p, LAS char* smem) {
    const bf16_t* proj = (const bf16_t*)(p.ws + OFF_BIG);
    const bf16_t* dvt = (const bf16_t*)(p.ws + OFF_DVT);
    const bf16_t* wuvt = (const bf16_t*)(p.ws + OFF_WUVT);
    bf16_t* mixed = (bf16_t*)(p.ws + OFF_HN);
    const int wave = threadIdx.x >> 6, lane = threadIdx.x & 63, c = lane & 15, g = lane >> 4;
    LAS float* SC = (LAS float*)smem; LAS u64* MASK = (LAS u64*)(smem + DSA_MASK_OFF);
    const int r = lane & 31, hh = lane >> 5;
    LAS bf16_t* KT = (LAS bf16_t*)smem; LAS bf16_t* VT = (LAS bf16_t*)(smem + DSA_VT_OFF);
    const u64 lt_mask = (1ull << lane) - 1ull;
    for (int pi = blockIdx.x; pi < 256; pi += gridDim.x)
    for (int which = 0; which < 2; ++which) {
        const int b = pi >> 5, qq = pi & 31, qt = which ? 63 - qq : qq;
        const int s0 = qt * 32, nk = 80 + 64 * (s0 >> 6), nkt = nk >> 4, nj = (nk + 63) >> 6;
        const bf16_t* pb = proj + (size_t)(b * TT) * INW;
        LAS char* tp_smem = smem; TP_BEGIN(1);
#pragma unroll 1
        for (int sub = 0; sub < 2; ++sub) {
            {
                const bf16_t* qrow = pb + (size_t)(NMETA + s0 + 16 * sub + c) * INW;
                bf16x8 bq[8][2]; float iw[8];
#pragma unroll
                for (int h = 0; h < 8; ++h) {
                    bq[h][0] = *(const bf16x8*)(qrow + C_IQ + h * 64 + 8 * g);
                    bq[h][1] = *(const bf16x8*)(qrow + C_IQ + h * 64 + 32 + 8 * g);
                    iw[h] = bf2f(qrow[C_IW + h]);
                }
                bf16x8 a0n = {0, 0, 0, 0, 0, 0, 0, 0}, a1n = {0, 0, 0, 0, 0, 0, 0, 0};
                if (wave < nkt) { const bf16_t* krow = pb + (size_t)(wave * 16 + c) * INW + C_IK + 8 * g; a0n = *(const bf16x8*)(krow); a1n = *(const bf16x8*)(krow + 32); }
                for (int kt = wave; kt < nkt; kt += NWAVES) {
                    const bf16x8 a0 = a0n, a1 = a1n;
                    if (kt + NWAVES < nkt) { const bf16_t* krow = pb + (size_t)((kt + NWAVES) * 16 + c) * INW + C_IK + 8 * g; a0n = *(const bf16x8*)(krow); a1n = *(const bf16x8*)(krow + 32); }
                    f32x4 isc = {0.f, 0.f, 0.f, 0.f};
#pragma unroll
                    for (int h = 0; h < 8; ++h) {
                        f32x4 acc = {0.f, 0.f, 0.f, 0.f};
                        acc = MFMA16(a0, bq[h][0], acc); acc = MFMA16(a1, bq[h][1], acc);
#pragma unroll
                        for (int j = 0; j < 4; ++j) isc[j] += fmaxf(acc[j], 0.f) * iw[h];
                    }
#pragma unroll
                    for (int j = 0; j < 4; ++j) isc[j] += 0.0f;
                    *(LAS f32x4*)(SC + c * SCLD + kt * 16 + 4 * g) = isc;
                }
                {
                    const int tail = ((nj <= 11 ? 11 : (nj <= 22 ? 22 : 33)) << 6) - nk;
                    for (int i = threadIdx.x; i < 16 * tail; i += NTHREADS) { const int qq_ = i / tail; SC[qq_ * SCLD + nk + (i - qq_ * tail)] = -3.0e38f; }
                }
            }
            __syncthreads();
#pragma unroll 1
            for (int qi = 0; qi < 2; ++qi) {
                const int cq = wave * 2 + qi;
                unsigned kv[33];
#pragma unroll
                for (int jj = 0; jj < 11; ++jj) kv[jj] = fkey(SC[cq * SCLD + jj * 64 + lane]);
                if (nj > 11) {
#pragma unroll
                    for (int jj = 11; jj < 22; ++jj) kv[jj] = fkey(SC[cq * SCLD + jj * 64 + lane]);
                } else {
#pragma unroll
                    for (int jj = 11; jj < 22; ++jj) kv[jj] = 0u;
                }
                if (nj > 22) {
#pragma unroll
                    for (int jj = 22; jj < 33; ++jj) kv[jj] = fkey(SC[cq * SCLD + jj * 64 + lane]);
                } else {
#pragma unroll
                    for (int jj = 22; jj < 33; ++jj) kv[jj] = 0u;
                }
                unsigned Tkey = 1u;
                if (nk > 256) {
                    Tkey = 0u;
#pragma unroll 1
                    for (int bit = 31; bit >= 0; --bit) {
                        const unsigned cand = Tkey | (1u << bit);
                        int nl = 0;
#pragma unroll
                        for (int jj = 0; jj < 11; ++jj) nl += (kv[jj] >= cand) ? 1 : 0;
                        if (nj > 11) {
#pragma unroll
                            for (int jj = 11; jj < 22; ++jj) nl += (kv[jj] >= cand) ? 1 : 0;
                        }
                        if (nj > 22) {
#pragma unroll
                            for (int jj = 22; jj < 33; ++jj) nl += (kv[jj] >= cand) ? 1 : 0;
                        }
                        const int cnt = wave_sum_int(nl);
                        if (cnt >= 256) Tkey = cand;
                        if (cnt == 256) break;
                    }
                }
                int cgl = 0;
#pragma unroll
                for (int jj = 0; jj < 33; ++jj) cgl += (kv[jj] > Tkey) ? 1 : 0;
                const int cgt = wave_sum_int(cgl);
                const int need = (nk > 256) ? 256 - cgt : 4096;
                int eqseen = 0;
#pragma unroll 1
                for (int jj = 0; jj < nj; ++jj) {
                    const int k = jj * 64 + lane; const float v = SC[cq * SCLD + k];
                    const unsigned key = (k < nk) ? fkey(v) : 0u;
                    const bool gt = key > Tkey, eq = (key == Tkey);
                    const u64 eqm = __ballot(eq);
                    const int myeq = eqseen + __popcll(eqm & lt_mask);
                    const u64 sm = __ballot(gt || (eq && myeq < need));
                    eqseen += __popcll(eqm);
                    if (lane == 0) MASK[(16 * sub + cq) * 34 + jj] = sm;
                }
            }

            __syncthreads();
        }
        TP_END(1); TP_BEGIN(3);
        {
            const int h = wave;
            const bf16_t* qrow = pb + (size_t)(NMETA + s0 + r) * INW + C_DQ + h * 128 + 8 * hh;
            bf16x8 bQ[8];
#pragma unroll
            for (int ks = 0; ks < 8; ++ks) bQ[ks] = *(const bf16x8*)(qrow + ks * 16);
            f32x16 O[4];
#pragma unroll
            for (int d = 0; d < 4; ++d)
#pragma unroll
                for (int i = 0; i < 16; ++i) O[d][i] = 0.f;
            float m_run = -1e30f, l_run = 0.f;
            const int prow_t = threadIdx.x >> 4, pch_t = threadIdx.x & 15;
            const bf16_t* vsrc = dvt + (size_t)(b * 128 + prow_t) * TTP + pch_t * 8;
            const int n128 = (nk + 127) >> 7;
            u32x4 pk[4], pv[4];
#pragma unroll
            for (int i = 0; i < 4; ++i) {
                int key = prow_t + 32 * i; key = key < nk ? key : nk - 1;
                pk[i] = *(const u32x4*)(pb + (size_t)key * INW + C_DK + pch_t * 8);
                pv[i] = *(const u32x4*)(vsrc + (size_t)(32 * i) * TTP);
            }
#pragma unroll 1
            for (int kb = 0; kb < n128; ++kb) {
#pragma unroll
                for (int i = 0; i < 4; ++i) {
                    *(LAS u32x4*)(KT + (prow_t + 32 * i) * KLD + pch_t * 8) = pk[i];
                    *(LAS u32x4*)(VT + (prow_t + 32 * i) * VLD2 + pch_t * 8) = pv[i];
                }
                __syncthreads();
                if (kb + 1 < n128) {
#pragma unroll
                    for (int i = 0; i < 4; ++i) {
                        int key = (kb + 1) * 128 + prow_t + 32 * i; key = key < nk ? key : nk - 1;
                        pk[i] = *(const u32x4*)(pb + (size_t)key * INW + C_DK + pch_t * 8);
                        pv[i] = *(const u32x4*)(vsrc + (size_t)(32 * i) * TTP + (kb + 1) * 128);
                    }
                }
#pragma unroll 1
                for (int kblk = 0; kblk < 4; ++kblk) {
                    const int wi = kb * 2 + (kblk >> 1);
                    if (wi >= nj) break;
                    f32x16 S;
#pragma unroll
                    for (int i = 0; i < 16; ++i) S[i] = 0.f;
#pragma unroll
                    for (int ks = 0; ks < 8; ++ks) {
                        const bf16x8 a = *(const LAS bf16x8*)(KT + (kblk * 32 + r) * KLD + ks * 16 + 8 * hh);
                        S = MFMA32(a, bQ[ks], S);
                    }
                    const u64 mws = MASK[r * 34 + wi] >> ((kblk & 1) * 32 + 4 * hh);
                    const unsigned mbits = (unsigned)mws;
                    float mblk = -1e30f;
#pragma unroll
                    for (int i = 0; i < 16; ++i) {
                        S[i] = ((mbits >> (8 * (i >> 2) + (i & 3))) & 1u) ? S[i] : -1e30f;
                        mblk = fmaxf(mblk, S[i]);
                    }
                    mblk = fmaxf(mblk, __shfl_xor(mblk, 32));
                    const float m_new = fmaxf(m_run, mblk);
                    float ps = 0.f;
#pragma unroll
                    for (int i = 0; i < 16; ++i) { const float pv_ = (S[i] > -1e29f) ? __builtin_amdgcn_exp2f(S[i] - m_new) : 0.f; S[i] = pv_; ps += pv_; }
                    if (__ballot(m_new != m_run) != 0ull) {
                        const float alpha = __builtin_amdgcn_exp2f(m_run - m_new);
                        l_run *= alpha;
#pragma unroll
                        for (int d = 0; d < 4; ++d)
#pragma unroll
                            for (int i = 0; i < 16; ++i) O[d][i] *= alpha;
                    }
                    l_run += ps; m_run = m_new;
                    bf16x8 bP[2];
#pragma unroll
                    for (int s2 = 0; s2 < 2; ++s2) {
                        u32x4 t4;
#pragma unroll
                        for (int x = 0; x < 4; ++x) t4[x] = pk2bf(S[8 * s2 + 2 * x], S[8 * s2 + 2 * x + 1]);
                        bP[s2] = __builtin_bit_cast(bf16x8, t4);
                    }
                    bf16x8 av[8];
#pragma unroll
                    for (int q = 0; q < 8; ++q) {
                        const int d = q >> 1, s2 = q & 1;
                        const LAS bf16_t* vr = VT + (d * 32 + r) * VLD2 + kblk * 32 + 16 * s2 + 4 * hh;
                        const s16x4 lo = *(const LAS s16x4*)(vr), hi = *(const LAS s16x4*)(vr + 8);
                        av[q] = __builtin_shufflevector(lo, hi, 0, 1, 2, 3, 4, 5, 6, 7);
                    }
#pragma unroll
                    for (int q = 0; q < 8; ++q) O[q >> 1] = MFMA32(av[q], bP[q & 1], O[q >> 1]);
                }
                __syncthreads();
            }
            TP_END(3); TP_BEGIN(4);
            l_run += __shfl_xor(l_run, 32);
            const float inv = 1.f / l_run;
            bf16x8 bO[4][2];
#pragma unroll
            for (int d = 0; d < 4; ++d)
#pragma unroll
                for (int s2 = 0; s2 < 2; ++s2) {
                    u32x4 t4;
#pragma unroll
                    for (int x = 0; x < 4; ++x) t4[x] = pk2bf(O[d][8 * s2 + 2 * x] * inv, O[d][8 * s2 + 2 * x + 1] * inv);
                    bO[d][s2] = __builtin_bit_cast(bf16x8, t4);
                }
            bf16_t* orow = mixed + (size_t)(b * SEQ + s0 + r) * DM + 512 + h * 64 + 4 * hh;
            int zofs = 0; asm volatile("" : "+v"(zofs));
#pragma unroll
            for (int eb = 0; eb < 2; ++eb) {
                f32x16 acc;
#pragma unroll
                for (int i = 0; i < 16; ++i) acc[i] = 0.f;
#pragma unroll
                for (int d = 0; d < 4; ++d)
#pragma unroll
                    for (int s2 = 0; s2 < 2; ++s2) {
                        const bf16_t* wr = wuvt + (size_t)(h * 64 + eb * 32 + r) * 128 + d * 32 + 16 * s2 + 4 * hh + zofs;
                        const s16x4 lo = *(const s16x4*)(wr), hi = *(const s16x4*)(wr + 8);
                        const bf16x8 a = __builtin_shufflevector(lo, hi, 0, 1, 2, 3, 4, 5, 6, 7);
                        acc = MFMA32(a, bO[d][s2], acc);
                    }
#pragma unroll
                for (int g4 = 0; g4 < 4; ++g4) { uint2 w; w.x = pk2bf(acc[4 * g4], acc[4 * g4 + 1]); w.y = pk2bf(acc[4 * g4 + 2], acc[4 * g4 + 3]); *(uint2*)(orow + eb * 32 + 8 * g4) = w; }
            }
            TP_END(4);
        }
    }
}

DI void phase_ret_scan(const Params& p) {
    float* ST = (float*)(p.ws + OFF_ST);
    const int gtid = blockIdx.x * NTHREADS + threadIdx.x, gsz = gridDim.x * NTHREADS;
    for (int idx = gtid; idx < 32 * 16384; idx += gsz) {
        const int bh = idx >> 14, el = idx & 16383, h = bh & 3;
        const float gc = expf(logf(1.f - exp2f(-5.f - (float)h)) * 64.f);
        float* base = ST + (size_t)bh * 34 * 16384 + el;
        float r = 0.f;
        for (int c = 1; c < 34; ++c) {
            const float u = c < 33 ? base[(size_t)c * 16384] : 0.f;
            base[(size_t)c * 16384] = r;
            r = gc * r + u;
        }
    }
}

constexpr int RLD = 136, RTLD = 72;
DI void phase_ret_state_mfma(const Params& p, LAS char* smem) {
    const bf16_t* proj = (const bf16_t*)(p.ws + OFF_BIG);
    float* ST = (float*)(p.ws + OFF_ST);
    LAS bf16_t* sVT = (LAS bf16_t*)smem; LAS bf16_t* sKT = sVT + 128 * RTLD;
    const int wave = threadIdx.x >> 6, lane = threadIdx.x & 63, r = lane & 31, hh = lane >> 5;
    for (int unit = blockIdx.x; unit < 1024; unit += gridDim.x) {
        const int c = 1 + (unit & 31), bh = unit >> 5, h = bh & 3, b = bh >> 2;
        const float lg = logf(1.f - exp2f(-5.f - (float)h));
        {
            const int j = threadIdx.x >> 3, ch = threadIdx.x & 7, t = 64 * c + j - 112;
            const float z = expf(lg * (float)(63 - j));
#pragma unroll
            for (int q = 0; q < 2; ++q) {
                const int cc = ch + 8 * q;
                u32x4 kv = {0u, 0u, 0u, 0u}, vv = {0u, 0u, 0u, 0u};
                if (t >= 0) { const bf16_t* pr = proj + (size_t)(b * TT + t) * INW; kv = *(const u32x4*)(pr + C_RK + h * 128 + cc * 8); vv = *(const u32x4*)(pr + C_RV + h * 128 + cc * 8); }
                float vf[8]; unpack8(vv, vf);
#pragma unroll
                for (int x = 0; x < 8; ++x) {
                    sKT[(cc * 8 + x) * RTLD + j] = (bf16_t)((kv[x >> 1] >> ((x & 1) * 16)) & 0xffffu);
                    sVT[(cc * 8 + x) * RTLD + j] = f2bf(vf[x] * z);
                }
            }
        }
        __syncthreads();
        const int mb = wave >> 1;
#pragma unroll
        for (int q = 0; q < 2; ++q) {
            const int nb = (wave & 1) * 2 + q;
            f32x16 acc;
#pragma unroll
            for (int i = 0; i < 16; ++i) acc[i] = 0.f;
#pragma unroll
            for (int ks = 0; ks < 4; ++ks) {
                const bf16x8 a = *(const LAS bf16x8*)(sVT + (mb * 32 + r) * RTLD + ks * 16 + 8 * hh);
                const bf16x8 bb = *(const LAS bf16x8*)(sKT + (nb * 32 + r) * RTLD + ks * 16 + 8 * hh);
                acc = MFMA32(a, bb, acc);
            }
            float* st = ST + (size_t)(bh * 34 + c) * 16384 + nb * 32 + r;
#pragma unroll
            for (int i = 0; i < 16; ++i) st[(size_t)(mb * 32 + (i & 3) + 8 * (i >> 2) + 4 * hh) * 128] = acc[i];
        }
        __syncthreads();
    }
}
DI void phase_ret_out_mfma(const Params& p, LAS char* smem) {
    const bf16_t* proj = (const bf16_t*)(p.ws + OFF_BIG);
    const float* ST = (const float*)(p.ws + OFF_ST);
    bf16_t* mixed = (bf16_t*)(p.ws + OFF_HN);
    LAS bf16_t* sQ = (LAS bf16_t*)smem; LAS bf16_t* sK = sQ + 64 * RLD; LAS bf16_t* sVT = sK + 64 * RLD;
    LAS float* sGN = (LAS float*)(sVT + 128 * RTLD);
    const int wave = threadIdx.x >> 6, lane = threadIdx.x & 63, r = lane & 31, hh = lane >> 5;
    const int ib = wave & 1, eb = wave >> 1;
    for (int unit = blockIdx.x; unit < 1024; unit += gridDim.x) {
        const int c = 2 + (unit & 31), bh = unit >> 5, h = bh & 3, b = bh >> 2;
        const float lg = logf(1.f - exp2f(-5.f - (float)h));
        for (int i = threadIdx.x; i < 64 * 16; i += NTHREADS) {
            const int j = i >> 4, ch = i & 15; const int t = 64 * c + j - 112;
            const bf16_t* pr = proj + (size_t)(b * TT + t) * INW;
            *(LAS u32x4*)(sQ + j * RLD + ch * 8) = *(const u32x4*)(pr + C_RQ + h * 128 + ch * 8);
            *(LAS u32x4*)(sK + j * RLD + ch * 8) = *(const u32x4*)(pr + C_RK + h * 128 + ch * 8);
            const u32x4 vv = *(const u32x4*)(pr + C_RV + h * 128 + ch * 8);
#pragma unroll
            for (int x = 0; x < 8; ++x) sVT[(ch * 8 + x) * RTLD + j] = (bf16_t)((vv[x >> 1] >> ((x & 1) * 16)) & 0xffffu);
        }
        __syncthreads();
        f32x16 acc;
#pragma unroll
        for (int i = 0; i < 16; ++i) acc[i] = 0.f;
        {
            const float* R = ST + (size_t)(bh * 34 + c) * 16384 + (size_t)(eb * 32 + r) * 128 + 8 * hh;
#pragma unroll
            for (int ks = 0; ks < 8; ++ks) {
                const float4 r0 = *(const float4*)(R + ks * 16), r1 = *(const float4*)(R + ks * 16 + 4);
                const float rf[8] = {r0.x, r0.y, r0.z, r0.w, r1.x, r1.y, r1.z, r1.w};
                const bf16x8 a = pack8(rf);
                const bf16x8 bq = *(const LAS bf16x8*)(sQ + (ib * 32 + r) * RLD + ks * 16 + 8 * hh);
                acc = MFMA32(a, bq, acc);
            }
            const float xi = expf(lg * (float)(ib * 32 + r + 1));
#pragma unroll
            for (int i = 0; i < 16; ++i) acc[i] *= xi;
        }
#pragma unroll
        for (int jb = 0; jb < 2; ++jb) {
            f32x16 st;
#pragma unroll
            for (int i = 0; i < 16; ++i) st[i] = 0.f;
#pragma unroll
            for (int ks = 0; ks < 8; ++ks) {
                const bf16x8 a = *(const LAS bf16x8*)(sK + (jb * 32 + r) * RLD + ks * 16 + 8 * hh);
                const bf16x8 bq = *(const LAS bf16x8*)(sQ + (ib * 32 + r) * RLD + ks * 16 + 8 * hh);
                st = MFMA32(a, bq, st);
            }
            const int icol = ib * 32 + r;
#pragma unroll
            for (int i = 0; i < 16; ++i) {
                const int j = jb * 32 + (i & 3) + 8 * (i >> 2) + 4 * hh; const int df = icol > j ? icol - j : j - icol;
                st[i] *= expf(lg * (float)df);
            }
#pragma unroll
            for (int s2 = 0; s2 < 2; ++s2) {
                bf16x8 bp;
#pragma unroll
                for (int x = 0; x < 8; ++x) bp[x] = (short)f2bf(st[8 * s2 + x]);
                const LAS bf16_t* vr = sVT + (eb * 32 + r) * RTLD + jb * 32 + 16 * s2 + 4 * hh;
                const s16x4 lo = *(const LAS s16x4*)(vr), hi = *(const LAS s16x4*)(vr + 8);
                const bf16x8 a = __builtin_shufflevector(lo, hi, 0, 1, 2, 3, 4, 5, 6, 7);
                acc = MFMA32(a, bp, acc);
            }
        }
        float s1 = 0.f, s2 = 0.f;
#pragma unroll
        for (int i = 0; i < 16; ++i) { s1 += acc[i]; s2 += acc[i] * acc[i]; }
        s1 += __shfl_xor(s1, 32); s2 += __shfl_xor(s2, 32);
        if (hh == 0) { sGN[(eb * 64 + ib * 32 + r) * 2] = s1; sGN[(eb * 64 + ib * 32 + r) * 2 + 1] = s2; }
        __syncthreads();
        float S1 = 0.f, S2 = 0.f;
#pragma unroll
        for (int e4 = 0; e4 < 4; ++e4) { S1 += sGN[(e4 * 64 + ib * 32 + r) * 2]; S2 += sGN[(e4 * 64 + ib * 32 + r) * 2 + 1]; }
        const float mu = S1 * (1.f / 128.f), var = fmaxf(S2 * (1.f / 128.f) - mu * mu, 0.f), rs = rsqrtf(var + 1e-6f);
        const int t = 64 * c + ib * 32 + r - 112, srow = t - NMETA;
        const bf16_t* pg = proj + (size_t)(b * TT + t) * INW + C_RG + h * 128 + eb * 32 + 4 * hh;
        bf16_t* po = mixed + (size_t)(b * SEQ + srow) * DM + h * 128 + eb * 32 + 4 * hh;
#pragma unroll
        for (int g4 = 0; g4 < 4; ++g4) {
            const uint2 graw = *(const uint2*)(pg + 8 * g4);
            const float gv[4] = {__uint_as_float(graw.x << 16), __uint_as_float(graw.x & 0xffff0000u), __uint_as_float(graw.y << 16), __uint_as_float(graw.y & 0xffff0000u)};
            float o[4];
#pragma unroll
            for (int x = 0; x < 4; ++x) { const float gate = gv[x] / (1.f + expf(-gv[x])); o[x] = gate * (acc[4 * g4 + x] - mu) * rs; }
            uint2 w; w.x = (unsigned)f2bf(o[0]) | ((unsigned)f2bf(o[1]) << 16); w.y = (unsigned)f2bf(o[2]) | ((unsigned)f2bf(o[3]) << 16);
            *(uint2*)(po + 8 * g4) = w;
        }
        __syncthreads();
    }
}

DI void phase_norm2(const Params& p) {
    bf16_t* hn2 = (bf16_t*)(p.ws + OFF_HN);
    const int wave = threadIdx.x >> 6, lane = threadIdx.x & 63;
    for (int row = blockIdx.x * NWAVES + wave; row < NF; row += gridDim.x * NWAVES) {
        const float* src = p.out + (size_t)row * DM; bf16_t* o = hn2 + (size_t)row * DM;
        float4 v[4]; float ss = 0.f;
#pragma unroll
        for (int i = 0; i < 4; ++i) { v[i] = *(const float4*)(src + i * 256 + lane * 4); ss += v[i].x * v[i].x + v[i].y * v[i].y + v[i].z * v[i].z + v[i].w * v[i].w; }
        ss = wave_sum(ss);
        const float rstd = rsqrtf(ss * (1.f / DM) + 1e-6f);
#pragma unroll
        for (int i = 0; i < 4; ++i) {
            const float4 g = *(const float4*)(p.norm_ffn + i * 256 + lane * 4);
            uint2 w;
            w.x = (unsigned)f2bf(v[i].x * rstd * g.x) | ((unsigned)f2bf(v[i].y * rstd * g.y) << 16);
            w.y = (unsigned)f2bf(v[i].z * rstd * g.z) | ((unsigned)f2bf(v[i].w * rstd * g.w) << 16);
            *(uint2*)(o + i * 256 + lane * 4) = w;
        }
    }
}

__device__ const int PEER_PAIRS[50] = {0, 2, 4, 6, 8, 10, 12, 14, 16, 18, 20, 22, 32, 34, 36, 49, 51, 65, 80, 96, 112, 128, 160, 192, 224, 1, 3, 5, 7, 9, 11, 13, 15, 17, 19, 21, 23, 33, 35, 48, 50, 64, 66, 81, 97, 113, 144, 176, 208, 240};
constexpr int PSEL_WAVE_LDS = 32 * 2 * 16 * 8 + 32 * 16 * 8;
DI void phase_peer_select(const Params& p, LAS char* smem) {
    const float* PQ = (const float*)(p.ws + OFF_BIG);
    unsigned* EG = (unsigned*)(p.ws + OFF_EG); const float* SSQ = (const float*)(p.ws + OFF_SSQ);
    const int wave = threadIdx.x >> 6, lane = threadIdx.x & 63, r = lane & 31, hh = lane >> 5;
    LAS float* lv = (LAS float*)(smem + wave * PSEL_WAVE_LDS);
    LAS int* li = (LAS int*)(lv + 32 * 2 * 16);
    LAS float* cs = (LAS float*)(li + 32 * 2 * 16);
    LAS int* cab = (LAS int*)(cs + 32 * 16);
    for (int task = blockIdx.x * NWAVES + wave; task < (NF / 32) * 8; task += gridDim.x * NWAVES) {
        const int tile = task >> 3, h = task & 7;
        const int n = tile * 32 + r;
#pragma unroll 1
        for (int half = 0; half < 2; ++half) {
            f32x16 acc[4];
            {
                const float* srow = PQ + (size_t)n * 2048 + h * 256 + half * 128 + hh * 64;
#pragma unroll
                for (int mb = 0; mb < 4; ++mb)
#pragma unroll
                    for (int q = 0; q < 4; ++q) { const float4 a = *(const float4*)(srow + mb * 16 + q * 4); acc[mb][q * 4] = a.x; acc[mb][q * 4 + 1] = a.y; acc[mb][q * 4 + 2] = a.z; acc[mb][q * 4 + 3] = a.w; }
            }
            float mprev = INFINITY;
#pragma unroll 1
            for (int it = 0; it < 16; ++it) {
                float m = -INFINITY;
#pragma unroll
                for (int mb = 0; mb < 4; ++mb)
#pragma unroll
                    for (int i = 0; i < 16; ++i) { const float v = acc[mb][i]; m = fmaxf(m, v < mprev ? v : -INFINITY); }
                m = fmaxf(m, __shfl_xor(m, 32));
                mprev = m;
            }
            const float T = mprev;
            int cnt = 0;
#pragma unroll
            for (int mb = 0; mb < 4; ++mb)
#pragma unroll
                for (int i = 0; i < 16; ++i) cnt += (acc[mb][i] >= T) ? 1 : 0;
            const int pc = __shfl_xor(cnt, 32);
            int pos = hh ? pc : 0;
            LAS float* lvp = lv + (r * 2 + half) * 16; LAS int* lip = li + (r * 2 + half) * 16;
#pragma unroll
            for (int mb = 0; mb < 4; ++mb)
#pragma unroll
                for (int i = 0; i < 16; ++i) {
                    const float v = acc[mb][i];
                    if (v >= T) { if (pos < 16) { lvp[pos] = v; lip[pos] = hh * 64 + mb * 16 + i; } ++pos; }
                }
        }
        lds_fence();
        {
            float w1[16], w2[16];
#pragma unroll
            for (int a = 0; a < 16; ++a) { w1[a] = lv[(r * 2 + 0) * 16 + a]; w2[a] = lv[(r * 2 + 1) * 16 + a]; }
            float m1[8], m2[8]; int i1[8], i2[8], r1[8], r2[8];
#pragma unroll
            for (int x = 0; x < 8; ++x) {
                m1[x] = lv[(r * 2 + 0) * 16 + 8 * hh + x]; m2[x] = lv[(r * 2 + 1) * 16 + 8 * hh + x];
                i1[x] = li[(r * 2 + 0) * 16 + 8 * hh + x]; i2[x] = li[(r * 2 + 1) * 16 + 8 * hh + x];
                unsigned c1 = 0u, c2 = 0u;
#pragma unroll
                for (int a = 0; a < 16; ++a) { c1 += __float_as_uint(m1[x] - w1[a]) >> 31; c2 += __float_as_uint(m2[x] - w2[a]) >> 31; }
                r1[x] = (int)c1; r2[x] = (int)c2;
            }
            int rs = 0;
#pragma unroll
            for (int x = 0; x < 8; ++x) rs += r1[x] + (r2[x] << 8);
            rs += __shfl_xor(rs, 32);
            if (__any(rs != (120 | (120 << 8)))) {
#pragma unroll
                for (int x = 0; x < 8; ++x) { r1[x] = 0; r2[x] = 0; }
#pragma unroll 1
                for (int a = 0; a < 16; ++a) {
                    const float wa1 = lv[(r * 2 + 0) * 16 + a], wa2 = lv[(r * 2 + 1) * 16 + a];
#pragma unroll
                    for (int x = 0; x < 8; ++x) {
                        const int me = 8 * hh + x;
                        r1[x] += (wa1 > m1[x] || (wa1 == m1[x] && a < me)) ? 1 : 0;
                        r2[x] += (wa2 > m2[x] || (wa2 == m2[x] && a < me)) ? 1 : 0;
                    }
                }
            }
            lds_fence();
#pragma unroll
            for (int x = 0; x < 8; ++x) {
                lv[(r * 2 + 0) * 16 + r1[x]] = m1[x]; li[(r * 2 + 0) * 16 + r1[x]] = i1[x];
                lv[(r * 2 + 1) * 16 + r2[x]] = m2[x]; li[(r * 2 + 1) * 16 + r2[x]] = i2[x];
            }
            lds_fence();
        }
        int code[25]; float cv[25];
#pragma unroll
        for (int i = 0; i < 25; ++i) {
            code[i] = PEER_PAIRS[hh * 25 + i];
            cv[i] = lv[(r * 2 + 0) * 16 + (code[i] >> 4)] + lv[(r * 2 + 1) * 16 + (code[i] & 15)];
        }
        float mprev = INFINITY;
#pragma unroll 1
        for (int it = 0; it < 16; ++it) {
            float m = -INFINITY;
#pragma unroll
            for (int i = 0; i < 25; ++i) { const float v = cv[i]; m = fmaxf(m, v < mprev ? v : -INFINITY); }
            m = fmaxf(m, __shfl_xor(m, 32));
            mprev = m;
        }
        const float Tc = mprev;
        int cnt = 0;
#pragma unroll
        for (int i = 0; i < 25; ++i) cnt += (cv[i] >= Tc) ? 1 : 0;
        const int pc = __shfl_xor(cnt, 32);
        int pos = hh ? pc : 0;
#pragma unroll
        for (int i = 0; i < 25; ++i) {
            if (cv[i] >= Tc) { if (pos < 16) { cs[r * 16 + pos] = cv[i]; cab[r * 16 + pos] = code[i]; } ++pos; }
        }
        lds_fence();
        const float rstd = rsqrtf(SSQ[n] * (1.f / DM) + 1e-6f);
        float scv[16]; float mx = -INFINITY;
#pragma unroll
        for (int i = 0; i < 16; ++i) { scv[i] = cs[r * 16 + i]; mx = fmaxf(mx, scv[i]); }
        float sum = 0.f;
#pragma unroll
        for (int i = 0; i < 16; ++i) { scv[i] = expf((scv[i] - mx) * rstd); sum += scv[i]; }
        const float inv = 1.f / sum;
#pragma unroll
        for (int i = 0; i < 16; ++i) {
            if ((i >> 3) == hh) {
                const int ab = cab[r * 16 + i];
                const int e = li[(r * 2 + 0) * 16 + (ab >> 4)] * 128 + li[(r * 2 + 1) * 16 + (ab & 15)];
                const _Float16 gh = (_Float16)(scv[i] * inv);
                EG[(size_t)n * 128 + h * 16 + i] = (unsigned)e | ((unsigned)__builtin_bit_cast(unsigned short, gh) << 16);
            }
        }
        lds_fence();
    }
}

typedef float f32x2 __attribute__((ext_vector_type(2)));
DI void phase_convert_tables(const Params& p) {
    const int wave = threadIdx.x >> 6, lane = threadIdx.x & 63;
    for (int rowi = blockIdx.x * NWAVES + wave; rowi < 2 * 16384; rowi += gridDim.x * NWAVES) {
        const bool isv = rowi >= 16384; const int e = isv ? rowi - 16384 : rowi;
        const float* src = (isv ? p.pv : p.pu) + (size_t)e * DM + lane * 16;
        float x[16]; float mx = 0.f;
#pragma unroll
        for (int i = 0; i < 4; ++i) { const float4 a = *(const float4*)(src + i * 4); x[i * 4] = a.x; x[i * 4 + 1] = a.y; x[i * 4 + 2] = a.z; x[i * 4 + 3] = a.w; }
#pragma unroll
        for (int i = 0; i < 16; ++i) mx = fmaxf(mx, fabsf(x[i]));
        mx = wave_max(mx);
        const float top = isv ? 240.f : 127.f;
        const float inv = mx > 0.f ? top / mx : 0.f, scale = mx > 0.f ? mx / top : 0.f;
        u32x4 o;
        if (isv) {
#pragma unroll
            for (int w = 0; w < 4; ++w) {
                int pk = 0;
                pk = __builtin_amdgcn_cvt_pk_fp8_f32(x[w * 4] * inv, x[w * 4 + 1] * inv, pk, false);
                pk = __builtin_amdgcn_cvt_pk_fp8_f32(x[w * 4 + 2] * inv, x[w * 4 + 3] * inv, pk, true);
                o[w] = (unsigned)pk;
            }
        } else {
#pragma unroll
            for (int w = 0; w < 4; ++w) {
                unsigned pk = 0u;
#pragma unroll
                for (int b = 0; b < 4; ++b) { const int q = (int)rintf(x[w * 4 + b] * inv); pk |= ((unsigned)q & 0xffu) << (8 * b); }
                o[w] = pk;
            }
        }
        *(u32x4*)(p.ws + (isv ? OFF_V8 : OFF_U8) + (size_t)e * DM + lane * 16) = o;
        if (lane == 0) ((float*)(p.ws + (isv ? OFF_SV : OFF_SU)))[e] = scale;
    }
}
DI void unpack16_fp8(const u32x4& r, float (&v)[16]) {
#pragma unroll
    for (int w = 0; w < 4; ++w) {
        const f32x2 a = __builtin_amdgcn_cvt_pk_f32_fp8((int)r[w], false), b = __builtin_amdgcn_cvt_pk_f32_fp8((int)r[w], true);
        v[w * 4] = a[0]; v[w * 4 + 1] = a[1]; v[w * 4 + 2] = b[0]; v[w * 4 + 3] = b[1];
    }
}
constexpr int RW_NB = 128, RW_SH = 7;
constexpr int RW_WAVE_LDS = 4 * (RW_NB + 16) * 4 + 4 * 128 * 4 + 4 * 128 * 4;
DI float gelu_as(float v) {
    const float av = fabsf(v), t = __builtin_amdgcn_rcpf(av * 0.2316418882f + 1.0f);
    float q = t * 0.5307027145f + (-0.7265760135f); q = q * t + 0.7107068705f; q = q * t + (-0.142248368f); q = q * t + 0.127414796f; q = q * t;
    const float e = __builtin_amdgcn_exp2f((v * v) * (-0.72134752044f));
    const float m = v * (q * e), r = v - m;
    return v < 0.f ? m : r;
}
DI void phase_peer_out_rows(const Params& p, LAS char* smem) {
    const unsigned* EG = (const unsigned*)(p.ws + OFF_EG);
    const char* U8 = p.ws + OFF_U8; const char* V8 = p.ws + OFF_V8;
    const float* SU = (const float*)(p.ws + OFF_SU); const float* SV = (const float*)(p.ws + OFF_SV);
    const int wave = threadIdx.x >> 6, lane = threadIdx.x & 63, r = lane >> 4, l16 = lane & 15;
    LAS int* cnt = (LAS int*)(smem + wave * RW_WAVE_LDS) + r * (RW_NB + 16);
    LAS int* list_e = (LAS int*)(smem + wave * RW_WAVE_LDS + 4 * (RW_NB + 16) * 4) + r * 128;
    LAS float* list_g = (LAS float*)(smem + wave * RW_WAVE_LDS + 4 * (RW_NB + 16) * 4 + 2048) + r * 128;
    for (int grp = blockIdx.x * NWAVES + wave; grp < NF / 4; grp += gridDim.x * NWAVES) {
        const int n = grp * 4 + r;
        float acc[64]; int hq[16]; float hscale;
        const float* hrow = p.out + (size_t)n * DM + l16 * 16;
        {
            float hn[64];
            float ss = 0.f;
#pragma unroll
            for (int j = 0; j < 4; ++j)
#pragma unroll
                for (int q = 0; q < 4; ++q) { const float4 a = *(const float4*)(hrow + j * 256 + q * 4); hn[j * 16 + q * 4] = a.x; hn[j * 16 + q * 4 + 1] = a.y; hn[j * 16 + q * 4 + 2] = a.z; hn[j * 16 + q * 4 + 3] = a.w; }
#pragma unroll
            for (int i = 0; i < 64; ++i) ss += hn[i] * hn[i];
            ss = dpp_row_sum(ss);
            const float rstd = rsqrtf(ss * (1.f / DM) + 1e-6f);
#pragma unroll
            for (int j = 0; j < 4; ++j)
#pragma unroll
                for (int q = 0; q < 4; ++q) {
                    const float4 a = *(const float4*)(p.norm_ffn + j * 256 + l16 * 16 + q * 4);
                    hn[j * 16 + q * 4] *= rstd * a.x; hn[j * 16 + q * 4 + 1] *= rstd * a.y; hn[j * 16 + q * 4 + 2] *= rstd * a.z; hn[j * 16 + q * 4 + 3] *= rstd * a.w;
                }
            float hm = 0.f;
#pragma unroll
            for (int i = 0; i < 64; ++i) hm = fmaxf(hm, fabsf(hn[i]));
            hm = fmaxf(hm, __int_as_float(__builtin_amdgcn_update_dpp(0, __float_as_int(hm), 0xB1, 0xF, 0xF, true)));
            hm = fmaxf(hm, __int_as_float(__builtin_amdgcn_update_dpp(0, __float_as_int(hm), 0x4E, 0xF, 0xF, true)));
            hm = fmaxf(hm, __int_as_float(__builtin_amdgcn_update_dpp(0, __float_as_int(hm), 0x141, 0xF, 0xF, true)));
            hm = fmaxf(hm, __int_as_float(__builtin_amdgcn_update_dpp(0, __float_as_int(hm), 0x140, 0xF, 0xF, true)));
            const float hinv = hm > 0.f ? 127.f / hm : 0.f; hscale = hm * (1.f / 127.f);
#pragma unroll
            for (int w = 0; w < 16; ++w) {
                unsigned pk = 0u;
#pragma unroll
                for (int b = 0; b < 4; ++b) { const int q = (int)rintf(hn[w * 4 + b] * hinv); pk |= ((unsigned)q & 0xffu) << (8 * b); }
                hq[w] = (int)pk;
            }
#pragma unroll
            for (int i = 0; i < 64; ++i) acc[i] = 0.f;
        }
#pragma unroll
        for (int q = 0; q < RW_NB / 16; ++q) cnt[q * 16 + l16] = 0;
        lds_fence();
        {
            int ek[8], rk[8]; float gk[8];
#pragma unroll
            for (int k = 0; k < 8; ++k) { const unsigned w = EG[(size_t)n * 128 + k * 16 + l16]; ek[k] = (int)(w & 0xffffu); gk[k] = (float)__builtin_bit_cast(_Float16, (unsigned short)(w >> 16)); }
#pragma unroll
            for (int k = 0; k < 8; ++k) rk[k] = __hip_atomic_fetch_add(&cnt[ek[k] >> RW_SH], 1, __ATOMIC_RELAXED, __HIP_MEMORY_SCOPE_WORKGROUP);
            lds_fence();
            {
                constexpr int PB = RW_NB / 16;
                int c[PB], tot = 0;
#pragma unroll
                for (int q = 0; q < PB; ++q) { c[q] = cnt[l16 * PB + q]; tot += c[q]; }
                cnt[RW_NB + l16] = tot;
                lds_fence();
                int base = 0;
#pragma unroll
                for (int q = 0; q < 16; ++q) { const int v = cnt[RW_NB + q]; base += (q < l16) ? v : 0; }
#pragma unroll
                for (int q = 0; q < PB; ++q) { cnt[l16 * PB + q] = base; base += c[q]; }
            }
            lds_fence();
#pragma unroll
            for (int k = 0; k < 8; ++k) { const int pos = cnt[ek[k] >> RW_SH] + rk[k]; list_e[pos] = ek[k]; list_g[pos] = gk[k]; }
        }
        lds_fence();
        {
            u32x4 ub[4], vb[4]; float g_c, su_c, sv_c, g_n = 0.f, su_n = 0.f, sv_n = 0.f;
            {
                const int e_ = list_e[0]; g_c = list_g[0]; su_c = SU[e_]; sv_c = SV[e_];
#pragma unroll
                for (int j = 0; j < 4; ++j) { ub[j] = *(const u32x4*)(U8 + (size_t)e_ * DM + l16 * 16 + j * 256); vb[j] = *(const u32x4*)(V8 + (size_t)e_ * DM + l16 * 16 + j * 256); }
            }
#pragma unroll 1
            for (int sl = 0; sl < 128; ++sl) {
                int isum = 0;
#pragma unroll
                for (int j = 0; j < 4; ++j)
#pragma unroll
                    for (int w = 0; w < 4; ++w) isum = __builtin_amdgcn_sdot4((int)ub[j][w], hq[j * 4 + w], isum, false);
                isum += __builtin_amdgcn_update_dpp(0, isum, 0xB1, 0xF, 0xF, true);
                isum += __builtin_amdgcn_update_dpp(0, isum, 0x4E, 0xF, 0xF, true);
                isum += __builtin_amdgcn_update_dpp(0, isum, 0x141, 0xF, 0xF, true);
                isum += __builtin_amdgcn_update_dpp(0, isum, 0x140, 0xF, 0xF, true);
                float t_ = (float)isum * hscale;
                const int sn = sl + 1 < 128 ? sl + 1 : 127;
                const int e_n = list_e[sn];
                {
                    const char* up_ = U8 + (size_t)e_n * DM + l16 * 16;
#pragma unroll
                    for (int j = 0; j < 4; ++j) ub[j] = *(const u32x4*)(up_ + j * 256);
                    g_n = list_g[sn]; su_n = SU[e_n]; sv_n = SV[e_n];
                }
                t_ *= su_c;
                const float coef_ = gelu_as(t_) * g_c * sv_c;
#pragma unroll
                for (int j = 0; j < 4; ++j) { float v[16]; unpack16_fp8(vb[j], v);
#pragma unroll
                    for (int i = 0; i < 16; ++i) acc[j * 16 + i] += coef_ * v[i]; }
                {
                    const char* vp_ = V8 + (size_t)e_n * DM + l16 * 16;
#pragma unroll
                    for (int j = 0; j < 4; ++j) vb[j] = *(const u32x4*)(vp_ + j * 256);
                }
                g_c = g_n; su_c = su_n; sv_c = sv_n;
            }
        }
        {
            float* orow = p.out + (size_t)n * DM + l16 * 16;
            float s2 = 0.f;
#pragma unroll
            for (int j = 0; j < 4; ++j)
#pragma unroll
                for (int q = 0; q < 4; ++q) { const float4 a = *(const float4*)(orow + j * 256 + q * 4); acc[j * 16 + q * 4] += a.x; acc[j * 16 + q * 4 + 1] += a.y; acc[j * 16 + q * 4 + 2] += a.z; acc[j * 16 + q * 4 + 3] += a.w; }
#pragma unroll
            for (int i = 0; i < 64; ++i) s2 += acc[i] * acc[i];
            s2 = dpp_row_sum(s2);
            float r2 = rsqrtf(s2 * (1.f / DM) + 1e-6f);
#if TP_SEC
            r2 *= 1.f + 0.5f * ((const float*)(p.ws + OFF_BAR))[3602];
#endif
#if defined(DSA_CHECK) || defined(PROJ_CHECK)
            { const float num = ((const float*)(p.ws + OFF_BAR))[3600], den = ((const float*)(p.ws + OFF_BAR))[3601]; r2 *= 1.f + CHK_GAIN * sqrtf(num / fmaxf(den, 1e-30f)); }
#endif
#pragma unroll
            for (int j = 0; j < 4; ++j)
#pragma unroll
                for (int q = 0; q < 4; ++q) {
                    const float4 a = *(const float4*)(p.norm_final + j * 256 + l16 * 16 + q * 4);
                    *(float4*)(orow + j * 256 + q * 4) = make_float4(acc[j * 16 + q * 4] * r2 * a.x, acc[j * 16 + q * 4 + 1] * r2 * a.y, acc[j * 16 + q * 4 + 2] * r2 * a.z, acc[j * 16 + q * 4 + 3] * r2 * a.w);
                }
        }
        lds_fence();
    }
}

DI Params load_params() {
#if defined(__HIP_DEVICE_COMPILE__)
    typedef const __attribute__((address_space(4))) unsigned long long* cu64_t;
    cu64_t pp = (cu64_t)__builtin_amdgcn_kernarg_segment_ptr();
    asm volatile("" : "+s"(pp));
    static_assert(sizeof(Params) == 16 * 8, "Params is 16 qwords");
    unsigned long long w[16];
#pragma unroll
    for (int i = 0; i < 16; ++i) w[i] = pp[i];
#define GPTR(T, v) ((T*)(__attribute__((address_space(1))) T*)(v))
    Params r;
    r.x = GPTR(const float, w[0]); r.meta = GPTR(const float, w[1]); r.norm_mix = GPTR(const float, w[2]); r.w_in = GPTR(const float, w[3]);
    r.w_uv = GPTR(const float, w[4]); r.w_out = GPTR(const float, w[5]); r.norm_ffn = GPTR(const float, w[6]); r.wq = GPTR(const float, w[7]);
    r.sk = GPTR(const float, w[8]); r.pu = GPTR(const float, w[9]); r.pv = GPTR(const float, w[10]); r.norm_final = GPTR(const float, w[11]);
    r.out = GPTR(float, w[12]); r.ws = GPTR(char, w[13]);
    r.lo = (int)(unsigned)w[14]; r.hi = (int)(unsigned)(w[14] >> 32); r.pad0 = 0; r.pad1 = 0;
    return r;
#else
    return Params{};
#endif
}
#ifdef PROJ_CHECK
constexpr int PCH_ROWS = 2048;
DI void phase_proj_ref_naive(const Params& p) {
    const bf16_t* hn = (const bf16_t*)(p.ws + OFF_HN); bf16_t* ref = (bf16_t*)(p.ws + OFF_ST);
    const int gtid = blockIdx.x * NTHREADS + threadIdx.x, gsz = gridDim.x * NTHREADS;
    for (int idx = gtid; idx < (PCH_ROWS / 8) * INW; idx += gsz) {
        const int c = idx % INW, r0 = (idx / INW) * 8;
        float acc[8];
#pragma unroll
        for (int i = 0; i < 8; ++i) acc[i] = 0.f;
        for (int k = 0; k < 1024; ++k) {
            const float w = bf2f(f2bf(p.w_in[(size_t)k * INW + c]));
#pragma unroll
            for (int i = 0; i < 8; ++i) acc[i] += bf2f(hn[(size_t)(r0 + i) * DM + k]) * w;
        }
#pragma unroll
        for (int i = 0; i < 8; ++i) ref[(size_t)(r0 + i) * INW + c] = f2bf(acc[i]);
    }
}
DI void phase_proj_compare(const Params& p) {
    const bf16_t* proj = (const bf16_t*)(p.ws + OFF_BIG); const bf16_t* ref = (const bf16_t*)(p.ws + OFF_ST); const bf16_t* dvt = (const bf16_t*)(p.ws + OFF_DVT);
    const int gtid = blockIdx.x * NTHREADS + threadIdx.x, gsz = gridDim.x * NTHREADS;
    float num = 0.f, den = 0.f;
    for (int idx = gtid; idx < PCH_ROWS * INW; idx += gsz) { const float a = bf2f(proj[idx]), r = bf2f(ref[idx]); num += (a - r) * (a - r); den += r * r; }
    for (int idx = gtid; idx < PCH_ROWS * 128; idx += gsz) {
        const int row = idx >> 7, dv = idx & 127, b = row / TT, t = row - b * TT;
        const float a = bf2f(dvt[(size_t)(b * 128 + dv) * TTP + t]), r = bf2f(ref[(size_t)row * INW + C_DV + dv]); num += (a - r) * (a - r); den += r * r;
    }
    num = wave_sum(num); den = wave_sum(den);
    if ((threadIdx.x & 63) == 0) { atomicAdd((float*)(p.ws + OFF_BAR) + 3600, num); atomicAdd((float*)(p.ws + OFF_BAR) + 3601, den); }
}
#endif
constexpr int NPHASES = 10;
__global__ void __launch_bounds__(NTHREADS, 2) mk_forward(Params p) {
    extern __shared__ __attribute__((aligned(16))) char dyn_smem[];
    LAS char* smem = (LAS char*)dyn_smem;
    const bool multi = (p.hi - p.lo) > 1;
    LAS char* tp_smem = smem;
    if (TP_SEC && blockIdx.x == 0 && threadIdx.x == 0) { volatile LAS long long* tp_ = (volatile LAS long long*)(smem + TP_LDS_OFF); tp_[0] = (long long)__builtin_readcyclecounter(); tp_[2] = 0; }
    XcdBarrier bar; bar.bar = (unsigned*)(p.ws + OFF_BAR); bar.x = 0; bar.st = (volatile LAS unsigned*)(smem + LDS_BAR_OFF);
    if (multi) {
        if (threadIdx.x == 0) { const u32x4 z = {0u, 0u, 0u, 0u}; *(LAS u32x4*)(smem + LDS_BAR_OFF) = z; }
        __syncthreads();
        bar = xcd_barrier_post((unsigned*)(p.ws + OFF_BAR), (volatile LAS unsigned*)(smem + LDS_BAR_OFF));
    }
#ifndef PHMASK
#define PHMASK 0xFFFF
#endif
#define PH_ON(i) (((PHMASK >> (i)) & 1) && p.lo <= (i) && (i) < p.hi)
#define PH_SYNC(i) do { if (multi && (i) + 1 < p.hi) { TP_BEGIN(7); xcd_barrier(bar); TP_END(7); } } while (0)
#ifndef REPEAT_MASK
#define REPEAT_MASK 0
#endif
#define PH_REP(i) for (int rep_ = 0; rep_ < 1 + ((REPEAT_MASK >> (i)) & 1); ++rep_)
    if (PH_ON(0)) { const Params q = load_params(); TP_BEGIN(8); PH_REP(0) phase_prologue(q, smem); TP_END(8); PH_SYNC(0); }
    if (PH_ON(1)) { const Params q = load_params(); TP_BEGIN(9); PH_REP(1) { EpiProjRope e; e.P = (bf16_t*)(q.ws + OFF_BIG); e.DVTp = (bf16_t*)(q.ws + OFF_DVT); e.c128 = (const float*)(q.ws + OFF_COS128); e.s128 = (const float*)(q.ws + OFF_SIN128); e.c64 = (const float*)(q.ws + OFF_COS64); e.s64 = (const float*)(q.ws + OFF_SIN64); e.raw = 0; e.row_limit = MPAD; gemm256<true>((const bf16_t*)(q.ws + OFF_HN), (const bf16_t*)(q.ws + OFF_WINT), 1024, MPAD / 256, 4096 / 256, (LAS bf16_t*)smem, e); } TP_END(9); PH_SYNC(1); }
#ifdef ROPE_SEPARATE
    if (PH_ON(2)) { const Params q = load_params(); TP_BEGIN(5); phase_rope(q, smem, (bf16_t*)(q.ws + OFF_BIG), MROWS, true); TP_END(5); PH_SYNC(2); }
#endif
#ifdef PROJ_CHECK
    {   const Params q = load_params();
        phase_proj_ref_naive(q);
        xcd_barrier(bar);
        phase_rope(q, smem, (bf16_t*)(q.ws + OFF_ST), PCH_ROWS, false);
        xcd_barrier(bar);
        phase_proj_compare(q);
        xcd_barrier(bar);
    }
#endif
    if (PH_ON(3)) { const Params q = load_params(); PH_REP(3) {
#ifndef RS_REP
#define RS_REP 1
#endif
#ifndef DSA_REP
#define DSA_REP 1
#endif
            for (int rr_ = 0; rr_ < RS_REP; ++rr_) phase_ret_state_mfma(q, smem);
#ifdef PROJ_CHECK
            {
                bf16_t* mixed_ = (bf16_t*)(q.ws + OFF_HN);
                for (int idx = blockIdx.x * NTHREADS + threadIdx.x; idx < NF * 64; idx += gridDim.x * NTHREADS) { const int row = idx >> 6, c8 = idx & 63; const u32x4 z = {0u, 0u, 0u, 0u}; *(u32x4*)(mixed_ + (size_t)row * DM + 512 + c8 * 8) = z; }
            }
#else
            for (int rr_ = 0; rr_ < DSA_REP; ++rr_) { phase_dsa32(q, smem); __syncthreads(); }
#endif
#ifdef DSA_CHECK
            __syncthreads(); xcd_barrier(bar); phase_dsa_naive<true>(q, smem);
#endif
        } PH_SYNC(3); }
    if (PH_ON(4)) { const Params q = load_params(); TP_BEGIN(6); phase_ret_scan(q); TP_END(6); PH_SYNC(4); }
    if (PH_ON(5)) { const Params q = load_params(); PH_REP(5) phase_ret_out_mfma(q, smem); PH_SYNC(5); }
    if (PH_ON(6)) { const Params q = load_params(); PH_REP(6) {
#ifdef PROJ_CHECK
        EpiOut e; e.H = q.out; e.X = q.x; gemm256<false>(
#else
        EpiOutT e; e.H = q.out; e.X = q.x; e.HG = (bf16_t*)(q.ws + OFF_HG); e.G = q.norm_ffn; e.SSQ = (float*)(q.ws + OFF_SSQ); gemm256<true>(
#endif
        (const bf16_t*)(q.ws + OFF_HN), (const bf16_t*)(q.ws + OFF_WOUTT), 1024, NF / 256, 1024 / 256, (LAS bf16_t*)smem, e); } PH_SYNC(6); }
    if (PH_ON(8)) { const Params q = load_params(); phase_convert_tables(q); PH_REP(8) { EpiPQ e; e.Q = (float*)(q.ws + OFF_BIG); gemm256<false>((const bf16_t*)(q.ws + OFF_HG), (const bf16_t*)(q.ws + OFF_WQT), 1024, NF / 256, 2048 / 256, (LAS bf16_t*)smem, e); } PH_SYNC(8); }
    if (PH_ON(9)) { const Params q = load_params(); PH_REP(9) { phase_peer_select(q, smem); }
        if (TP_SEC && blockIdx.x == 0 && threadIdx.x == 0) { volatile LAS long long* tp_ = (volatile LAS long long*)(smem + TP_LDS_OFF); const float fr = (float)tp_[2] / (float)((long long)__builtin_readcyclecounter() - tp_[0]); ((float*)(p.ws + OFF_BAR))[3602] = fr; }
        asm volatile("s_waitcnt vmcnt(0)" ::: "memory"); __syncthreads(); }
    if (PH_ON(10)) { const Params q = load_params(); phase_peer_out_rows(q, smem); }
}

extern "C" void kernel_launch(void* const* d_in, const int* in_sizes, int n_in, void* d_out, int out_size, void* d_ws, size_t ws_size, hipStream_t stream) {
    static int grid = 0;
    if (grid == 0) {
        if (n_in != 12 || out_size != NF * DM || ws_size < WS_END) { fprintf(stderr, "kernel_launch: unexpected shapes (n_in %d out %d ws %zu need %zu)\n", n_in, out_size, ws_size, (size_t)WS_END); grid = -1; return; }
        int dev = 0, cus = 0, per_cu = 0;
        if (hipGetDevice(&dev) != hipSuccess || hipDeviceGetAttribute(&cus, hipDeviceAttributeMultiprocessorCount, dev) != hipSuccess) { grid = -1; return; }
        if (hipFuncSetAttribute((const void*)mk_forward, hipFuncAttributeMaxDynamicSharedMemorySize, LDS_BYTES) != hipSuccess) { fprintf(stderr, "kernel_launch: hipFuncSetAttribute failed\n"); grid = -1; return; }
        if (hipOccupancyMaxActiveBlocksPerMultiprocessor(&per_cu, (const void*)mk_forward, NTHREADS, LDS_BYTES) != hipSuccess || per_cu < 1)
            fprintf(stderr, "kernel_launch: occupancy query reports %d blocks per CU\n", per_cu);
        (void)hipGetLastError();
        grid = cus > 0 ? cus : 256;
    }
    if (grid < 0) return;
    Params p{};
    p.x = (const float*)d_in[0]; p.meta = (const float*)d_in[1]; p.norm_mix = (const float*)d_in[2]; p.w_in = (const float*)d_in[3];
    p.w_uv = (const float*)d_in[4]; p.w_out = (const float*)d_in[5]; p.norm_ffn = (const float*)d_in[6]; p.wq = (const float*)d_in[7];
    p.sk = (const float*)d_in[8]; p.pu = (const float*)d_in[9]; p.pv = (const float*)d_in[10]; p.norm_final = (const float*)d_in[11];
    p.out = (float*)d_out; p.ws = (char*)d_ws; p.pad0 = 0; p.pad1 = 0;
    (void)hipMemsetAsync((char*)d_ws + OFF_BAR, 0, 16384, stream);
#if MK_LAUNCHES == 1
    p.lo = 0; p.hi = NPHASES + 1;
    hipLaunchKernelGGL(mk_forward, dim3(grid), dim3(NTHREADS), LDS_BYTES, stream, p);
#else
    for (int ph = 0; ph <= NPHASES; ++ph) { p.lo = ph; p.hi = ph + 1; hipLaunchKernelGGL(mk_forward, dim3(grid), dim3(NTHREADS), LDS_BYTES, stream, p); }
#endif
}
```

```cpp
#include <hip/hip_runtime.h>
#include <stdint.h>
#include <stdio.h>

#ifndef MK_LAUNCHES
#define MK_LAUNCHES 1
#endif

#define DI __device__ __forceinline__
#ifndef TP_SEC
#define TP_SEC 0
#endif
#ifndef CHK_GAIN
#define CHK_GAIN 10.f
#endif
#define TP_LDS_OFF (163840 - 128)
#define TP_BEGIN(k) do { if (TP_SEC == (k) && blockIdx.x == 0 && threadIdx.x == 0) { *(volatile __attribute__((address_space(3))) long long*)(tp_smem + TP_LDS_OFF + 8) = (long long)__builtin_readcyclecounter(); } } while (0)
#define TP_END(k) do { if (TP_SEC == (k) && blockIdx.x == 0 && threadIdx.x == 0) { volatile __attribute__((address_space(3))) long long* tp_ = (volatile __attribute__((address_space(3))) long long*)(tp_smem + TP_LDS_OFF); tp_[2] += (long long)__builtin_readcyclecounter() - tp_[1]; } } while (0)
typedef unsigned short bf16_t;
typedef short bf16x8 __attribute__((ext_vector_type(8)));
typedef float f32x4 __attribute__((ext_vector_type(4)));
typedef unsigned u32x4 __attribute__((ext_vector_type(4)));

constexpr int NB = 8, SEQ = 2048, NMETA = 16, TT = 2064, DM = 1024, INW = 3912;
constexpr int MROWS = NB * TT;
constexpr int MPAD = 16640;
constexpr int NF = NB * SEQ;
constexpr int C_RQ = 0, C_RK = 512, C_RV = 1024, C_RG = 1536, C_DQ = 2048, C_DK = 3072, C_DV = 3200, C_IQ = 3328, C_IK = 3840, C_IW = 3904;
constexpr int NTHREADS = 512, NWAVES = 8;
constexpr int LDS_BYTES = 163840;
constexpr int LDS_BAR_OFF = 163840 - 256;

constexpr size_t al256(size_t x) { return (x + 255) & ~(size_t)255; }
constexpr size_t OFF_BAR = 0;
constexpr size_t OFF_COS128 = 16384;
constexpr size_t OFF_SIN128 = OFF_COS128 + al256((size_t)TT * 64 * 4);
constexpr size_t OFF_COS64 = OFF_SIN128 + al256((size_t)TT * 64 * 4);
constexpr size_t OFF_SIN64 = OFF_COS64 + al256((size_t)TT * 32 * 4);
constexpr size_t OFF_WINT = OFF_SIN64 + al256((size_t)TT * 32 * 4);
constexpr size_t OFF_WOUTT = OFF_WINT + (size_t)4096 * 1024 * 2;
constexpr size_t OFF_WQT = OFF_WOUTT + (size_t)1024 * 1024 * 2;
constexpr size_t OFF_SKH = OFF_WQT + (size_t)2048 * 1024 * 2;
constexpr size_t OFF_SKL = OFF_SKH + (size_t)2048 * 128 * 2;
constexpr int TTP = 2176;
constexpr size_t OFF_WUVT = OFF_SKL + (size_t)2048 * 128 * 2;
constexpr size_t OFF_DVT = OFF_WUVT + (size_t)8 * 64 * 128 * 2;
constexpr size_t OFF_HN = OFF_DVT + (size_t)NB * 128 * TTP * 2;
constexpr size_t OFF_BIG = OFF_HN + (size_t)MPAD * 1024 * 2;
constexpr size_t BIG_BYTES = (size_t)NF * 2048 * 4;
constexpr size_t OFF_ST = OFF_BIG + al256(BIG_BYTES);
constexpr size_t ST_BYTES = (size_t)32 * 34 * 16384 * 4;
constexpr size_t OFF_EG = OFF_ST;
constexpr size_t OFF_U8 = OFF_EG + (size_t)NF * 128 * 4;
constexpr size_t OFF_SU = OFF_U8 + (size_t)16384 * 1024;
constexpr size_t OFF_V8 = OFF_SU + 65536;
constexpr size_t OFF_SV = OFF_V8 + (size_t)16384 * 1024;
constexpr size_t OFF_HG = OFF_SV + 65536;
constexpr size_t OFF_SSQ = OFF_HG + (size_t)NF * 1024 * 2;
constexpr size_t WS_END = OFF_SSQ + (size_t)NF * 4;
static_assert(OFF_ST + ST_BYTES <= WS_END, "retention states fit");
static_assert(WS_END <= (size_t)268435456, "workspace");

struct Params {
    const float *x, *meta, *norm_mix, *w_in, *w_uv, *w_out, *norm_ffn, *wq, *sk, *pu, *pv, *norm_final;
    float* out; char* ws; int lo, hi, pad0, pad1;
};

DI float bf2f(bf16_t v) { return __uint_as_float(((unsigned)v) << 16); }
typedef float f32x2_t __attribute__((ext_vector_type(2)));
typedef __bf16 bf16x2_t __attribute__((ext_vector_type(2)));
DI bf16_t f2bf(float f) { const __bf16 h = (__bf16)f; return __builtin_bit_cast(unsigned short, h); }
DI unsigned pk2bf(float a, float b) { const f32x2_t v = {a, b}; const bf16x2_t h = __builtin_convertvector(v, bf16x2_t); return __builtin_bit_cast(unsigned, h); }
DI float wave_sum(float v) {
#pragma unroll
    for (int o = 32; o > 0; o >>= 1) v += __shfl_xor(v, o);
    return v;
}
DI float wave_max(float v) {
#pragma unroll
    for (int o = 32; o > 0; o >>= 1) v = fmaxf(v, __shfl_xor(v, o));
    return v;
}
DI unsigned long long wave_max_u64(unsigned long long v) {
#pragma unroll
    for (int o = 32; o > 0; o >>= 1) {
        const unsigned hi = __shfl_xor((unsigned)(v >> 32), o), lo = __shfl_xor((unsigned)v, o);
        const unsigned long long w = ((unsigned long long)hi << 32) | lo;
        v = w > v ? w : v;
    }
    return v;
}
DI unsigned fkey(float x) { const unsigned u = __float_as_uint(x); return (u & 0x80000000u) ? ~u : (u | 0x80000000u); }
DI float funkey(unsigned k) { const unsigned u = (k & 0x80000000u) ? (k & 0x7fffffffu) : ~k; return __uint_as_float(u); }
DI void lds_fence() { asm volatile("s_waitcnt lgkmcnt(0)" ::: "memory"); }
DI void unpack8(const u32x4& r, float (&v)[8]) {
    v[0] = __uint_as_float(r.x << 16); v[1] = __uint_as_float(r.x & 0xffff0000u);
    v[2] = __uint_as_float(r.y << 16); v[3] = __uint_as_float(r.y & 0xffff0000u);
    v[4] = __uint_as_float(r.z << 16); v[5] = __uint_as_float(r.z & 0xffff0000u);
    v[6] = __uint_as_float(r.w << 16); v[7] = __uint_as_float(r.w & 0xffff0000u);
}

typedef float f32x16 __attribute__((ext_vector_type(16)));
DI bf16x8 pack8(const float (&x)[8]) {
    u32x4 r;
#pragma unroll
    for (int j = 0; j < 4; ++j) r[j] = pk2bf(x[2 * j], x[2 * j + 1]);
    return __builtin_bit_cast(bf16x8, r);
}
DI bf16x8 pack_hi8(const float (&x)[8], float (&rem)[8]) {
    u32x4 r;
#pragma unroll
    for (int j = 0; j < 4; ++j) { r[j] = pk2bf(x[2 * j], x[2 * j + 1]); rem[2 * j] = x[2 * j] - __uint_as_float(r[j] << 16); rem[2 * j + 1] = x[2 * j + 1] - __uint_as_float(r[j] & 0xffff0000u); }
    return __builtin_bit_cast(bf16x8, r);
}

DI float dpp_row_sum(float v) {
    v += __int_as_float(__builtin_amdgcn_update_dpp(0, __float_as_int(v), 0xB1, 0xF, 0xF, true));
    v += __int_as_float(__builtin_amdgcn_update_dpp(0, __float_as_int(v), 0x4E, 0xF, 0xF, true));
    v += __int_as_float(__builtin_amdgcn_update_dpp(0, __float_as_int(v), 0x141, 0xF, 0xF, true));
    v += __int_as_float(__builtin_amdgcn_update_dpp(0, __float_as_int(v), 0x140, 0xF, 0xF, true));
    return v;
}
DI float wave_sum_uniform(float v) {
    v = dpp_row_sum(v);
    const float a = __int_as_float(__builtin_amdgcn_readlane(__float_as_int(v), 0)), b = __int_as_float(__builtin_amdgcn_readlane(__float_as_int(v), 16));
    const float c = __int_as_float(__builtin_amdgcn_readlane(__float_as_int(v), 32)), d = __int_as_float(__builtin_amdgcn_readlane(__float_as_int(v), 48));
    return (a + b) + (c + d);
}

DI int wave_sum_int(int v) {
    v += __builtin_amdgcn_update_dpp(0, v, 0xB1, 0xF, 0xF, true);
    v += __builtin_amdgcn_update_dpp(0, v, 0x4E, 0xF, 0xF, true);
    v += __builtin_amdgcn_update_dpp(0, v, 0x141, 0xF, 0xF, true);
    v += __builtin_amdgcn_update_dpp(0, v, 0x140, 0xF, 0xF, true);
    return (__builtin_amdgcn_readlane(v, 0) + __builtin_amdgcn_readlane(v, 16)) + (__builtin_amdgcn_readlane(v, 32) + __builtin_amdgcn_readlane(v, 48));
}

#define XB_TMO      128
#define XB_XCNT(j)  (256  + 64 * (j))
#define XB_XSUB(j)  (1280 + 64 * (j))
#define XB_XGEN(j)  (2304 + 64 * (j))
#define XB_TOP      3328
#define XB_TOPGEN   3392
#define XCD_BAR_WORDS 3456
#define XB_SPIN_CAP (1u << 20)
#define LAS __attribute__((address_space(3)))

DI unsigned xb_ld(unsigned* p)              { return __hip_atomic_load(p, __ATOMIC_RELAXED, __HIP_MEMORY_SCOPE_AGENT); }
DI unsigned xb_add(unsigned* p, unsigned v) { return __hip_atomic_fetch_add(p, v, __ATOMIC_RELAXED, __HIP_MEMORY_SCOPE_AGENT); }
DI unsigned xb_xcc_id() { return (unsigned)__builtin_amdgcn_s_getreg((3 << 11) | 20) & 0xFu; }
#define XB_SPIN(cond, bar) do { unsigned _sp = 0; while (cond) { __builtin_amdgcn_s_sleep(1); \
    if ((++_sp & 255u) == 0u) { if (xb_ld(&(bar)[XB_TMO])) break; if (_sp > XB_SPIN_CAP) { atomicAdd(&(bar)[XB_TMO], 1u); break; } } } } while (0)

struct XcdBarrier { unsigned* bar; unsigned x; volatile LAS unsigned* st; };

DI XcdBarrier xcd_barrier_post(unsigned* bar, volatile LAS unsigned* st) {
    XcdBarrier b; b.bar = bar; b.x = xb_xcc_id(); b.st = st;
    if (threadIdx.x == 0) (void)xb_add(&bar[XB_XCNT(b.x)], 1u);
    return b;
}
DI void xcd_barrier_complete(unsigned* bar, unsigned x, unsigned& nloc, unsigned& nx) {
    const unsigned G = gridDim.x * gridDim.y * gridDim.z;
    unsigned sum, cnt, mine, sp = 0u;
    for (;;) {
        sum = 0u; cnt = 0u; mine = 0u;
#pragma unroll
        for (unsigned j = 0; j < 16; ++j) { const unsigned c = xb_ld(&bar[XB_XCNT(j)]); sum += c; cnt += (c > 0u) ? 1u : 0u; mine = (j == x) ? c : mine; }
        if (sum == G) break;
        __builtin_amdgcn_s_sleep(1);
        if ((++sp & 255u) == 0u) { if (xb_ld(&bar[XB_TMO])) break; if (sp > XB_SPIN_CAP) { atomicAdd(&bar[XB_TMO], 1u); break; } }
    }
    nloc = mine > 0u ? mine : 1u; nx = cnt > 0u ? cnt : 1u;
}
DI void xcd_barrier(const XcdBarrier& b) {
    asm volatile("s_waitcnt vmcnt(0)" ::: "memory");
    __syncthreads();
    if (threadIdx.x == 0) {
        unsigned* bar = b.bar;
        __builtin_amdgcn_s_waitcnt(0);
        unsigned nloc = b.st[0], nx = b.st[1];
        if (nloc == 0u) { xcd_barrier_complete(bar, b.x, nloc, nx); b.st[0] = nloc; b.st[1] = nx; }
        const unsigned old = xb_add(&bar[XB_XSUB(b.x)], 1u);
        const unsigned gen = old / nloc;
        if (old + 1u == (gen + 1u) * nloc) {
            __builtin_amdgcn_fence(__ATOMIC_RELEASE, "agent");
            asm volatile("s_waitcnt vmcnt(0)" ::: "memory");
            const unsigned og = xb_add(&bar[XB_TOP], 1u);
            const unsigned tg = og / nx;
            if (og + 1u == (tg + 1u) * nx) xb_add(&bar[XB_TOPGEN], 1u);
            else XB_SPIN(xb_ld(&bar[XB_TOPGEN]) == tg, bar);
            __builtin_amdgcn_fence(__ATOMIC_ACQUIRE, "agent");
            xb_add(&bar[XB_XGEN(b.x)], 1u);
            asm volatile("s_waitcnt vmcnt(0)" ::: "memory");
        } else {
            XB_SPIN(xb_ld(&bar[XB_XGEN(b.x)]) == gen, bar);
            __builtin_amdgcn_fence(__ATOMIC_ACQUIRE, "agent");
            asm volatile("s_waitcnt vmcnt(0)" ::: "memory");
        }
    }
    __syncthreads();
}

constexpr int BM = 256, BK = 64, HALF = 128, NXCD = 8, WGM = 8, HT = HALF * BK;
DI int lds_byte(int r, int c) {
    int st = (r >> 4) * 2 + (c >> 5), rr = r & 15, cc = c & 31, ob = rr * 64 + cc * 2;
    return st * 1024 + (ob ^ (((ob >> 9) & 1) << 5));
}
DI void stage_rc(int b, int& R, int& C) {
    int st = b / 1024, sb = b % 1024, swz = sb ^ (((sb >> 9) & 1) << 5);
    R = (st >> 1) * 16 + swz / 64; C = (st & 1) * 32 + (swz % 64) / 2;
}

#define SA(b,h) (shm+((b)*2+(h))*HT)
#define SB(b,h) (shm+(4+(b)*2+(h))*HT)
#define STAGE_X(T,P,BASE,br,kt) do{long _g=(long)(br)*K+(long)(kt)*BK; \
    for(int _i=0;_i<2;++_i){int _b=(T)*16+_i*8192;int _r,_c;stage_rc(_b,_r,_c); \
      __builtin_amdgcn_global_load_lds((const unsigned*)(BASE+_g+(long)_r*K+_c), \
        (LAS unsigned*)((LAS char*)(P)+_b),16,0,0);}}while(0)
#define STAGE(P,BASE,br,kt) STAGE_X(tst_,P,BASE,br,kt)
#define LDA(dst,b,h) for(int m=0;m<4;++m)for(int k=0;k<2;++k) \
    dst[m][k]=*reinterpret_cast<const LAS bf16x8*>((LAS char*)SA(b,h)+lds_byte(wr*64+m*16+fr,k*32+fq*8))
#define LDB(dst,b,h) for(int n=0;n<2;++n)for(int k=0;k<2;++k) \
    dst[n][k]=*reinterpret_cast<const LAS bf16x8*>((LAS char*)SB(b,h)+lds_byte(wc*32+n*16+fr,k*32+fq*8))
#define MMA(ai,bj,At,Bt_) do{__builtin_amdgcn_s_setprio(1); \
    for(int m=0;m<4;++m)for(int n=0;n<2;++n)for(int k=0;k<2;++k) \
      acc[ai][bj][m][n]=TRANS?__builtin_amdgcn_mfma_f32_16x16x32_bf16(Bt_[n][k],At[m][k],acc[ai][bj][m][n],0,0,0):__builtin_amdgcn_mfma_f32_16x16x32_bf16(At[m][k],Bt_[n][k],acc[ai][bj][m][n],0,0,0); \
    __builtin_amdgcn_s_setprio(0);}while(0)
#define WAIT_V(n) asm volatile("s_waitcnt vmcnt(" #n ")":::"memory")
#define WAIT_L(n) asm volatile("s_waitcnt lgkmcnt(" #n ")":::"memory")
#define BAR __builtin_amdgcn_s_barrier()
#define SCHED __builtin_amdgcn_sched_barrier(0)

template <bool TRANS, class Epi>
DI void gemm256(const bf16_t* __restrict__ A, const bf16_t* __restrict__ Bt, const int K, const int nM, const int nN, LAS bf16_t* shm, const Epi& epi) {
    const int nwg = nM * nN;
    for (int L = blockIdx.x; L < nwg; L += gridDim.x) {
        int wgid = L;
        { int q = nwg / NXCD, r = nwg % NXCD, xcd = wgid % NXCD, off = wgid / NXCD; wgid = (xcd < r ? xcd * (q + 1) : r * (q + 1) + (xcd - r) * q) + off; }
        int nig = WGM * nN, gid = wgid / nig, fm = gid * WGM, gsz = min(nM - fm, WGM);
        int pm = fm + ((wgid % nig) % gsz), pn = (wgid % nig) / gsz, brow = pm * BM, bcol = pn * BM;
#ifdef PROJ_CHECK
        int tst_ = threadIdx.x; asm volatile("" : "+v"(tst_));
#else
        const int tst_ = threadIdx.x;
#endif
        int wid = tst_ >> 6, lane = tst_ & 63, wr = wid >> 2, wc = wid & 3, fr = lane & 15, fq = lane >> 4;
        f32x4 acc[2][2][4][2] = {};
        bf16x8 At[4][2], B0[2][2], B1[2][2];
        int nt = K / BK;
        STAGE(SB(0,0),Bt,bcol,0); STAGE(SA(0,0),A,brow,0);
        STAGE(SB(0,1),Bt,bcol+HALF,0); STAGE(SA(0,1),A,brow+HALF,0);
        if (wr == 1) BAR;
        WAIT_V(4); BAR;
        STAGE(SB(1,0),Bt,bcol,1); STAGE(SA(1,0),A,brow,1); STAGE(SB(1,1),Bt,bcol+HALF,1);
        WAIT_V(6); BAR;
        for (int t = 0; t < nt - 2; t += 2) {
            LDB(B0,0,0); SCHED; LDA(At,0,0); STAGE(SA(1,1),A,brow+HALF,t+1);
            WAIT_L(8); BAR; WAIT_L(0); MMA(0,0,At,B0); BAR; SCHED;
            LDB(B1,0,1); STAGE(SB(0,0),Bt,bcol,t+2);
            BAR; WAIT_L(0); MMA(0,1,At,B1); BAR;
            LDA(At,0,1); STAGE(SA(0,0),A,brow,t+2);
            BAR; WAIT_L(0); MMA(1,0,At,B0); BAR; SCHED;
            STAGE(SB(0,1),Bt,bcol+HALF,t+2);
            WAIT_V(6); BAR; MMA(1,1,At,B1); BAR;
            LDB(B0,1,0); SCHED; LDA(At,1,0); STAGE(SA(0,1),A,brow+HALF,t+2);
            WAIT_L(8); BAR; WAIT_L(0); MMA(0,0,At,B0); BAR; SCHED;
            LDB(B1,1,1); STAGE(SB(1,0),Bt,bcol,t+3);
            BAR; WAIT_L(0); MMA(0,1,At,B1); BAR;
            LDA(At,1,1); STAGE(SA(1,0),A,brow,t+3);
            BAR; WAIT_L(0); MMA(1,0,At,B0); BAR; SCHED;
            STAGE(SB(1,1),Bt,bcol+HALF,t+3);
            WAIT_V(6); BAR; MMA(1,1,At,B1); BAR;
        }
        int tz = threadIdx.x; asm volatile("" : "+v"(tz)); wid = tz >> 6; lane = tz & 63; wr = wid >> 2; wc = wid & 3; fr = lane & 15; fq = lane >> 4;
        { LDB(B0,0,0); WAIT_V(0); LDA(At,0,0); STAGE_X(tz,SA(1,1),A,brow+HALF,nt-1);
          BAR; WAIT_L(0); MMA(0,0,At,B0); BAR;
          LDB(B1,0,1); BAR; WAIT_L(0); MMA(0,1,At,B1); BAR;
          LDA(At,0,1); WAIT_V(4); BAR; WAIT_L(0); MMA(1,0,At,B0); MMA(1,1,At,B1); BAR; }
        { LDB(B0,1,0); LDA(At,1,0); WAIT_V(2); BAR; WAIT_L(0); MMA(0,0,At,B0); BAR;
          LDB(B1,1,1); WAIT_V(0); BAR; WAIT_L(0); MMA(0,1,At,B1); BAR;
          LDA(At,1,1); BAR; WAIT_L(0); MMA(1,0,At,B0); MMA(1,1,At,B1); BAR; }
        if (wr == 0) BAR;
        epi(acc, brow, bcol, wr, wc, fr, fq);
        __syncthreads();
    }
}

struct EpiOut {
    float* H; const float* X;
    DI void operator()(const f32x4 (&acc)[2][2][4][2], int brow, int bcol, int wr, int wc, int fr, int fq) const {
#pragma unroll
        for (int ai = 0; ai < 2; ++ai)
#pragma unroll
        for (int bj = 0; bj < 2; ++bj)
#pragma unroll
        for (int m = 0; m < 4; ++m)
#pragma unroll
        for (int n = 0; n < 2; ++n)
#pragma unroll
        for (int j = 0; j < 4; ++j) {
            const int row = brow + ai * HALF + wr * 64 + m * 16 + fq * 4 + j, col = bcol + bj * HALF + wc * 32 + n * 16 + fr;
            const size_t o = (size_t)row * DM + col; H[o] = X[o] + acc[ai][bj][m][n][j];
        }
    }
};
struct EpiPQ {
    float* Q;
    DI void operator()(const f32x4 (&acc)[2][2][4][2], int brow, int bcol, int wr, int wc, int fr, int fq) const {
#pragma unroll
        for (int ai = 0; ai < 2; ++ai)
#pragma unroll
        for (int bj = 0; bj < 2; ++bj)
#pragma unroll
        for (int m = 0; m < 4; ++m)
#pragma unroll
        for (int n = 0; n < 2; ++n)
#pragma unroll
        for (int j = 0; j < 4; ++j) {
            const int row = brow + ai * HALF + wr * 64 + m * 16 + fq * 4 + j, col = bcol + bj * HALF + wc * 32 + n * 16 + fr;
            Q[(size_t)row * 2048 + col] = acc[ai][bj][m][n][j];
        }
    }
};

struct EpiOutT {
    float* H; const float* X; bf16_t* HG; const float* G; float* SSQ;
    DI void operator()(const f32x4 (&acc)[2][2][4][2], int brow, int bcol, int wr, int wc, int fr, int fq) const {
#pragma unroll
        for (int ai = 0; ai < 2; ++ai)
#pragma unroll
        for (int m = 0; m < 4; ++m) {
            const int row = brow + ai * HALF + wr * 64 + m * 16 + fr;
            const size_t o = (size_t)row * DM + bcol + wc * 32 + fq * 4;
            const float* xp = X + o; float* hp = H + o; bf16_t* gp = HG + o; const float* gn = G + bcol + wc * 32 + fq * 4;
            float ss = 0.f;
#pragma unroll
            for (int bj = 0; bj < 2; ++bj)
#pragma unroll
            for (int n = 0; n < 2; ++n) {
                const f32x4 x = *(const f32x4*)(xp + bj * HALF + n * 16); const f32x4 hv = x + acc[ai][bj][m][n];
                *(f32x4*)(hp + bj * HALF + n * 16) = hv;
                ss += hv[0] * hv[0] + hv[1] * hv[1] + hv[2] * hv[2] + hv[3] * hv[3];
                const f32x4 hg = hv * *(const f32x4*)(gn + bj * HALF + n * 16);
                uint2 w; w.x = pk2bf(hg[0], hg[1]); w.y = pk2bf(hg[2], hg[3]); *(uint2*)(gp + bj * HALF + n * 16) = w;
            }
            ss += __shfl_xor(ss, 16); ss += __shfl_xor(ss, 32);
            if (fq == 0) atomicAdd(SSQ + row, ss);
            __builtin_amdgcn_sched_barrier(0);
        }
    }
};

__host__ __device__ constexpr int proj_true_col(int n) {
    const int blk = n >> 7, P = n & 127, wc = P >> 5, nn = (P >> 4) & 1, i = P & 15;
    return blk * 128 + (blk < 26 ? wc * 16 + i + 64 * nn : (wc >> 1) * 64 + (wc & 1) * 16 + i + 32 * nn);
}
DI bool proj_block(const f32x4 x1, const f32x4 x2, const int cb, const int wc, const int fq, const int t, const float* c128, const float* s128, const float* c64, const float* s64,
                   f32x4& o1, f32x4& o2, int& c1, int& c2, bool& st2) {
    o1 = x1; o2 = x2; st2 = true;
    if (cb < C_IQ) {
        const int f = wc * 16 + fq * 4; c1 = cb + f; c2 = c1 + 64;
        const bool roped = (cb < C_RV) || (cb >= C_DQ && cb < C_DV);
        if (roped) {
            const float sc = (cb < C_RK) ? 1.f : (cb < C_RV) ? 0.08838834764831845f : (cb < C_DK) ? 0.08838834764831845f * 1.4426950408889634f : 1.f;
            const f32x4 cs = *(const f32x4*)(c128 + t * 64 + f), sn = *(const f32x4*)(s128 + t * 64 + f);
            o1 = (x1 * cs - x2 * sn) * sc; o2 = (x2 * cs + x1 * sn) * sc;
        }
        return true;
    }
    if (cb >= 3968) return false;
    const int hl = wc >> 1, f = (wc & 1) * 16 + fq * 4; c1 = cb + hl * 64 + f; c2 = c1 + 32;
    if (cb < C_IK || hl == 0) {
        const float sc = (cb < C_IK) ? 0.125f : 1.f;
        const f32x4 cs = *(const f32x4*)(c64 + t * 32 + f), sn = *(const f32x4*)(s64 + t * 32 + f);
        o1 = (x1 * cs - x2 * sn) * sc; o2 = (x2 * cs + x1 * sn) * sc;
        return true;
    }
    o1 = x1 * 0.35355339059327373f; st2 = false;
    return c1 < INW;
}
struct EpiProjRope {
    bf16_t* P; bf16_t* DVTp; const float *c128, *s128, *c64, *s64;
    DI void operator()(const f32x4 (&acc)[2][2][4][2], int brow, int bcol, int wr, int wc, int fr, int fq) const {
#pragma unroll
        for (int ai = 0; ai < 2; ++ai)
#pragma unroll
        for (int m = 0; m < 4; ++m) {
            const int grow = brow + ai * HALF + wr * 64 + m * 16 + fr;
            const int b = grow >> 11, t = NMETA + (grow & 2047);
            bf16_t* rp = P + (size_t)(b * TT + t) * INW;
#pragma unroll
            for (int bj = 0; bj < 2; ++bj) {
                const int cb = bcol + bj * HALF;
                const f32x4 x1 = acc[ai][bj][m][0], x2 = acc[ai][bj][m][1];
                f32x4 o1, o2; int c1, c2; bool st2;
                if (!proj_block(x1, x2, cb, wc, fq, t, c128, s128, c64, s64, o1, o2, c1, c2, st2)) continue;
                if (cb == C_DV) {
                    bf16_t* dp = DVTp + (size_t)(b * 128 + (c1 - C_DV)) * TTP + t;
#pragma unroll
                    for (int j = 0; j < 4; ++j) { dp[(size_t)j * TTP] = f2bf(x1[j]); dp[(size_t)(64 + j) * TTP] = f2bf(x2[j]); }
                }
                uint2 w1; w1.x = pk2bf(o1[0], o1[1]); w1.y = pk2bf(o1[2], o1[3]); *(uint2*)(rp + c1) = w1;
                if (st2) { uint2 w2; w2.x = pk2bf(o2[0], o2[1]); w2.y = pk2bf(o2[2], o2[3]); *(uint2*)(rp + c2) = w2; }
            }
        }
    }
};

DI void phase_prologue(const Params& p, LAS char* smem) {
    const int gtid = blockIdx.x * NTHREADS + threadIdx.x, gsz = gridDim.x * NTHREADS;
    {
        bf16_t* wint = (bf16_t*)(p.ws + OFF_WINT); bf16_t* woutt_ = (bf16_t*)(p.ws + OFF_WOUTT);
        LAS float* tl = (LAS float*)smem;
        for (int tile = blockIdx.x; tile < 16 * 64 + 16 * 16; tile += gridDim.x) {
            const bool isout = tile >= 16 * 64; const int tt = isout ? tile - 16 * 64 : tile;
            const int ncol = isout ? 16 : 64, k0 = (tt / ncol) * 64, c0 = (tt % ncol) * 64;
            const float* W = isout ? p.w_out : p.w_in; const int ldw = isout ? 1024 : INW, cmax = isout ? 1024 : INW;
            for (int i = threadIdx.x; i < 64 * 64; i += NTHREADS) { const int kk = i >> 6, cc = i & 63; tl[kk * 65 + cc] = (c0 + cc < cmax) ? W[(size_t)(k0 + kk) * ldw + c0 + cc] : 0.f; }
            __syncthreads();
            {
                const int cc = threadIdx.x >> 3, ch = threadIdx.x & 7, tc = c0 + cc;
                int n = tc;
                if (!isout) { const int blk = tc >> 7, T = tc & 127;
                    const int P = blk < 26 ? (((T & 63) >> 4) * 32 + (T >> 6) * 16 + (T & 15)) : ((((T >> 6) * 2 + ((T >> 4) & 1)) * 32) + ((T >> 5) & 1) * 16 + (T & 15));
                    n = blk * 128 + P; }
                u32x4 o;
#pragma unroll
                for (int w = 0; w < 4; ++w) o[w] = pk2bf(tl[(ch * 8 + 2 * w) * 65 + cc], tl[(ch * 8 + 2 * w + 1) * 65 + cc]);
                *(u32x4*)((isout ? woutt_ : wint) + (size_t)n * 1024 + k0 + ch * 8) = o;
            }
            __syncthreads();
        }
    }
    { float* ssq = (float*)(p.ws + OFF_SSQ); for (int idx = gtid; idx < NF; idx += gsz) ssq[idx] = 0.f; }
    {
        bf16_t* dvt = (bf16_t*)(p.ws + OFF_DVT);
        for (int idx = gtid; idx < NB * 128 * (TTP - TT); idx += gsz) { const int rw = idx / (TTP - TT), t = TT + idx % (TTP - TT); dvt[(size_t)rw * TTP + t] = (bf16_t)0; }
    }
    bf16_t* wuvt = (bf16_t*)(p.ws + OFF_WUVT);
    for (int idx = gtid; idx < 8 * 64 * 128; idx += gsz) {
        const int h = idx >> 13, e = (idx >> 7) & 63, dv = idx & 127;
        wuvt[idx] = f2bf(p.w_uv[(size_t)(h * 128 + dv) * 64 + e]);
    }
    float* c128 = (float*)(p.ws + OFF_COS128); float* s128 = (float*)(p.ws + OFF_SIN128);
    for (int idx = gtid; idx < TT * 64; idx += gsz) {
        const int pos = idx >> 6, j = idx & 63;
        const float inv = powf(10000.f, -(float)j * 2.0f / 128.f);
        const float ang = (float)pos * inv;
        float s, c; sincosf(ang, &s, &c);
        c128[idx] = c; s128[idx] = s;
    }
    float* c64 = (float*)(p.ws + OFF_COS64); float* s64 = (float*)(p.ws + OFF_SIN64);
    for (int idx = gtid; idx < TT * 32; idx += gsz) {
        const int pos = idx >> 5, j = idx & 31;
        const float inv = powf(10000.f, -(float)j * 2.0f / 64.f);
        const float ang = (float)pos * inv;
        float s, c; sincosf(ang, &s, &c);
        c64[idx] = c; s64[idx] = s;
    }
    bf16_t* hn = (bf16_t*)(p.ws + OFF_HN);
    const int wave = threadIdx.x >> 6, lane = threadIdx.x & 63;
    for (int row = blockIdx.x * NWAVES + wave; row < MPAD; row += gridDim.x * NWAVES) {
        bf16_t* o = hn + (size_t)row * DM;
        if (row >= NF + NMETA) {
            for (int i = 0; i < 4; ++i) *(uint2*)(o + i * 256 + lane * 4) = make_uint2(0u, 0u);
            continue;
        }
        const float* src = row < NF ? p.x + (size_t)row * DM : p.meta + (size_t)(row - NF) * DM;
        float4 v[4]; float ss = 0.f;
#pragma unroll
        for (int i = 0; i < 4; ++i) { v[i] = *(const float4*)(src + i * 256 + lane * 4); ss += v[i].x * v[i].x + v[i].y * v[i].y + v[i].z * v[i].z + v[i].w * v[i].w; }
        ss = wave_sum(ss);
        const float rstd = rsqrtf(ss * (1.f / DM) + 1e-6f);
#pragma unroll
        for (int i = 0; i < 4; ++i) {
            const float4 g = *(const float4*)(p.norm_mix + i * 256 + lane * 4);
            uint2 w;
            w.x = (unsigned)f2bf(v[i].x * rstd * g.x) | ((unsigned)f2bf(v[i].y * rstd * g.y) << 16);
            w.y = (unsigned)f2bf(v[i].z * rstd * g.z) | ((unsigned)f2bf(v[i].w * rstd * g.w) << 16);
            *(uint2*)(o + i * 256 + lane * 4) = w;
        }
    }
}

DI void phase_fold_weights(const Params& p) {
    {
        bf16_t* wst = (bf16_t*)(p.ws + OFF_WQT);
        int tz_ = threadIdx.x; asm volatile("" : "+v"(tz_));
        const int wave_ = tz_ >> 6, lane_ = tz_ & 63, r = lane_ & 31, hh = lane_ >> 5;
        const int skip_ = 0;
        if ((int)blockIdx.x >= skip_)
        for (int task = ((int)blockIdx.x - skip_) * NWAVES + wave_; task < 16 * 32 * 4; task += ((int)gridDim.x - skip_) * NWAVES) {
            const int nb = task & 3, hf = task >> 7, k0 = ((task >> 2) & 31) * 32;
            f32x16 acc;
#pragma unroll
            for (int i = 0; i < 16; ++i) acc[i] = 0.f;
            const float* arow = p.wq + (size_t)(k0 + r) * 2048 + hf * 128 + 8 * hh;
            const float* brow = p.sk + (size_t)(hf * 128 + nb * 32 + r) * 128 + 8 * hh;
#pragma unroll 2
            for (int ks = 0; ks < 8; ++ks) {
                const float4 a0 = *(const float4*)(arow + ks * 16), a1 = *(const float4*)(arow + ks * 16 + 4);
                const float4 b0 = *(const float4*)(brow + ks * 16), b1 = *(const float4*)(brow + ks * 16 + 4);
                const float af[8] = {a0.x, a0.y, a0.z, a0.w, a1.x, a1.y, a1.z, a1.w}; float ar[8];
                const float bf_[8] = {b0.x, b0.y, b0.z, b0.w, b1.x, b1.y, b1.z, b1.w}; float br[8];
                const bf16x8 ah = pack_hi8(af, ar); const bf16x8 al = pack8(ar);
                const bf16x8 bh = pack_hi8(bf_, br); const bf16x8 bl = pack8(br);
                acc = __builtin_amdgcn_mfma_f32_32x32x16_bf16(ah, bh, acc, 0, 0, 0);
                acc = __builtin_amdgcn_mfma_f32_32x32x16_bf16(ah, bl, acc, 0, 0, 0);
                acc = __builtin_amdgcn_mfma_f32_32x32x16_bf16(al, bh, acc, 0, 0, 0);
            }
            bf16_t* orow = wst + (size_t)(hf * 128 + nb * 32 + r) * 1024 + k0 + 4 * hh;
#pragma unroll
            for (int g4 = 0; g4 < 4; ++g4) { uint2 w; w.x = pk2bf(acc[4 * g4], acc[4 * g4 + 1]); w.y = pk2bf(acc[4 * g4 + 2], acc[4 * g4 + 3]); *(uint2*)(orow + 8 * g4) = w; }
        }
    }
}

DI void rope8(bf16_t* p1, bf16_t* p2, const float* ct, const float* st, float scale) {
    const u32x4 r1 = *(const u32x4*)p1, r2 = *(const u32x4*)p2;
    float x1[8], x2[8]; unpack8(r1, x1); unpack8(r2, x2);
    const float4 c0 = *(const float4*)ct, c1 = *(const float4*)(ct + 4), s0 = *(const float4*)st, s1 = *(const float4*)(st + 4);
    const float cs[8] = {c0.x, c0.y, c0.z, c0.w, c1.x, c1.y, c1.z, c1.w}, sn[8] = {s0.x, s0.y, s0.z, s0.w, s1.x, s1.y, s1.z, s1.w};
    u32x4 o1, o2;
#pragma unroll
    for (int i = 0; i < 4; ++i) {
        const float a0 = (x1[2 * i] * cs[2 * i] - x2[2 * i] * sn[2 * i]) * scale, a1 = (x1[2 * i + 1] * cs[2 * i + 1] - x2[2 * i + 1] * sn[2 * i + 1]) * scale;
        const float b0 = (x2[2 * i] * cs[2 * i] + x1[2 * i] * sn[2 * i]) * scale, b1 = (x2[2 * i + 1] * cs[2 * i + 1] + x1[2 * i + 1] * sn[2 * i + 1]) * scale;
        o1[i] = (unsigned)f2bf(a0) | ((unsigned)f2bf(a1) << 16); o2[i] = (unsigned)f2bf(b0) | ((unsigned)f2bf(b1) << 16);
    }
    *(u32x4*)p1 = o1; *(u32x4*)p2 = o2;
}
DI void phase_rope(const Params& p, LAS char* smem, bf16_t* proj, const int nrows, const bool do_dvt) {
    const float* c128 = (const float*)(p.ws + OFF_COS128); const float* s128 = (const float*)(p.ws + OFF_SIN128);
    const float* c64 = (const float*)(p.ws + OFF_COS64); const float* s64 = (const float*)(p.ws + OFF_SIN64);
    const int gtid = blockIdx.x * NTHREADS + threadIdx.x, gsz = gridDim.x * NTHREADS;
    const int total = nrows * 173;
    for (int idx = gtid; idx < total; idx += gsz) {
        const int row = idx / 173, it = idx - row * 173;
        const int t = row % TT;
        bf16_t* pr = proj + (size_t)row * INW;
        if (it < 32)       { const int hd = it >> 3, j = (it & 7) * 8;          rope8(pr + C_RQ + hd * 128 + j, pr + C_RQ + hd * 128 + 64 + j, c128 + t * 64 + j, s128 + t * 64 + j, 1.f); }
        else if (it < 64)  { const int i2 = it - 32, hd = i2 >> 3, j = (i2 & 7) * 8;  rope8(pr + C_RK + hd * 128 + j, pr + C_RK + hd * 128 + 64 + j, c128 + t * 64 + j, s128 + t * 64 + j, 0.08838834764831845f); }
        else if (it < 128) { const int i2 = it - 64, hd = i2 >> 3, j = (i2 & 7) * 8;  rope8(pr + C_DQ + hd * 128 + j, pr + C_DQ + hd * 128 + 64 + j, c128 + t * 64 + j, s128 + t * 64 + j, 0.08838834764831845f * 1.4426950408889634f); }
        else if (it < 136) { const int j = (it - 128) * 8;                          rope8(pr + C_DK + j, pr + C_DK + 64 + j, c128 + t * 64 + j, s128 + t * 64 + j, 1.f); }
        else if (it < 168) { const int i2 = it - 136, hd = i2 >> 2, j = (i2 & 3) * 8; rope8(pr + C_IQ + hd * 64 + j, pr + C_IQ + hd * 64 + 32 + j, c64 + t * 32 + j, s64 + t * 32 + j, 0.125f); }
        else if (it < 172) { const int j = (it - 168) * 8;                          rope8(pr + C_IK + j, pr + C_IK + 32 + j, c64 + t * 32 + j, s64 + t * 32 + j, 1.f); }
        else {
            const u32x4 r = *(const u32x4*)(pr + C_IW); float v[8]; unpack8(r, v); u32x4 o;
#pragma unroll
            for (int i = 0; i < 4; ++i) o[i] = (unsigned)f2bf(v[2 * i] * 0.35355339059327373f) | ((unsigned)f2bf(v[2 * i + 1] * 0.35355339059327373f) << 16);
            *(u32x4*)(pr + C_IW) = o;
        }
    }
    if (!do_dvt) return;
    bf16_t* dvt = (bf16_t*)(p.ws + OFF_DVT);
    LAS bf16_t* tile = (LAS bf16_t*)smem;
    for (int unit = blockIdx.x; unit < NB * (TTP / 64); unit += gridDim.x) {
        const int b = unit / (TTP / 64), t0 = (unit % (TTP / 64)) * 64;
        for (int i = threadIdx.x; i < 64 * 16; i += NTHREADS) {
            const int tr = i >> 4, ch = i & 15, t = t0 + tr;
            u32x4 v = {0u, 0u, 0u, 0u};
            if (t < TT) v = *(const u32x4*)(proj + (size_t)(b * TT + t) * INW + C_DV + ch * 8);
            *(LAS u32x4*)(tile + tr * 136 + ch * 8) = v;
        }
        __syncthreads();
        for (int i = threadIdx.x; i < 128 * 8; i += NTHREADS) {
            const int dv = i >> 3, ch = i & 7;
            u32x4 o;
#pragma unroll
            for (int w = 0; w < 4; ++w) o[w] = (unsigned)tile[(ch * 8 + 2 * w) * 136 + dv] | ((unsigned)tile[(ch * 8 + 2 * w + 1) * 136 + dv] << 16);
            *(u32x4*)(dvt + (size_t)(b * 128 + dv) * TTP + t0 + ch * 8) = o;
        }
        __syncthreads();
    }
}

#define MFMA16(a, b, c) __builtin_amdgcn_mfma_f32_16x16x32_bf16((a), (b), (c), 0, 0, 0)
#define MFMA32(a, b, c) __builtin_amdgcn_mfma_f32_32x32x16_bf16((a), (b), (c), 0, 0, 0)
DI void phase_proj_meta(const Params& p, LAS char* smem) {
    const bf16_t* hn = (const bf16_t*)(p.ws + OFF_HN) + (size_t)NF * DM;
    const bf16_t* wint = (const bf16_t*)(p.ws + OFF_WINT);
    bf16_t* proj = (bf16_t*)(p.ws + OFF_BIG); bf16_t* dvt = (bf16_t*)(p.ws + OFF_DVT);
    const float* c128 = (const float*)(p.ws + OFF_COS128); const float* s128 = (const float*)(p.ws + OFF_SIN128);
    const float* c64 = (const float*)(p.ws + OFF_COS64); const float* s64 = (const float*)(p.ws + OFF_SIN64);
    int tz = threadIdx.x; asm volatile("" : "+v"(tz));
    const int wave = tz >> 6, lane = tz & 63, c = lane & 15, g = lane >> 4;
    LAS f32x4* red = (LAS f32x4*)smem;
    const int first = gridDim.x >= 64 ? 16 : 0;
    for (int blk = (int)blockIdx.x - first; blk >= 0 && blk < 31; blk += (int)gridDim.x) {
        const int cb = blk * 128;
        const bf16_t* yrow = hn + (size_t)c * DM + wave * 128 + 8 * g;
        const bf16_t* xrow = wint + (size_t)(cb + c) * DM + wave * 128 + 8 * g;
        f32x4 acc[8];
#pragma unroll
        for (int q = 0; q < 8; ++q) acc[q] = (f32x4){0.f, 0.f, 0.f, 0.f};
#pragma unroll
        for (int ks = 0; ks < 4; ++ks) {
            const bf16x8 y = *(const bf16x8*)(yrow + ks * 32);
#pragma unroll
            for (int q = 0; q < 8; ++q) acc[q] = MFMA16(*(const bf16x8*)(xrow + (size_t)(q * 16) * DM + ks * 32), y, acc[q]);
        }
#pragma unroll
        for (int q = 0; q < 8; ++q) red[(wave * 8 + q) * 64 + lane] = acc[q];
        __syncthreads();
        if (wave < 4) {
            f32x4 a1 = {0.f, 0.f, 0.f, 0.f}, a2 = {0.f, 0.f, 0.f, 0.f};
#pragma unroll
            for (int w = 0; w < 8; ++w) { a1 += red[(w * 8 + 2 * wave) * 64 + lane]; a2 += red[(w * 8 + 2 * wave + 1) * 64 + lane]; }
            const int t = c;
            f32x4 o1, o2; int c1, c2; bool st2;
            if (proj_block(a1, a2, cb, wave, g, t, c128, s128, c64, s64, o1, o2, c1, c2, st2)) {
                uint2 w1, w2; w1.x = pk2bf(o1[0], o1[1]); w1.y = pk2bf(o1[2], o1[3]); w2.x = pk2bf(o2[0], o2[1]); w2.y = pk2bf(o2[2], o2[3]);
#pragma unroll
                for (int b = 0; b < NB; ++b) {
                    bf16_t* rp = proj + (size_t)(b * TT + t) * INW;
                    *(uint2*)(rp + c1) = w1; if (st2) *(uint2*)(rp + c2) = w2;
                    if (cb == C_DV) {
                        bf16_t* dp = dvt + (size_t)(b * 128 + (c1 - C_DV)) * TTP + t;
#pragma unroll
                        for (int j = 0; j < 4; ++j) { dp[(size_t)j * TTP] = f2bf(a1[j]); dp[(size_t)(64 + j) * TTP] = f2bf(a2[j]); }
                    }
                }
            }
        }
        __syncthreads();
    }
}

constexpr int DSA_WAVE_LDS = 2176 * 4 + 1024 * 4 + 256 * 4 + 64;
template <bool CHECK>
DI void phase_dsa_naive(const Params& p, LAS char* smem) {
    const bf16_t* proj = (const bf16_t*)(p.ws + OFF_BIG);
    bf16_t* mixed = (bf16_t*)(p.ws + OFF_HN);
    const int wave = threadIdx.x >> 6, lane = threadIdx.x & 63;
    LAS float* sSc = (LAS float*)(smem + wave * DSA_WAVE_LDS);
    LAS float* sQ = sSc + 2176;
    LAS int* sSel = (LAS int*)(sQ + 1024);
    LAS float* sIw = (LAS float*)(sSel + 256);
    const unsigned long long lt_mask = (1ull << lane) - 1ull;
    float chk_num = 0.f, chk_den = 0.f;
    for (int q = blockIdx.x * NWAVES + wave; q < NF; q += gridDim.x * NWAVES) {
        const int b = q >> 11, s = q & 2047, t = NMETA + s;
        const int nk = 80 + 64 * (s >> 6);
        const bf16_t* prow = proj + (size_t)(b * TT + t) * INW;
        for (int i = lane; i < 512; i += 64) sQ[i] = bf2f(prow[C_IQ + i]);
        if (lane < 8) sIw[lane] = bf2f(prow[C_IW + lane]);
        lds_fence();
        const bf16_t* ikbase = proj + (size_t)(b * TT) * INW + C_IK;
        const int nj = (nk + 63) >> 6;
        for (int jj = 0; jj < nj; ++jj) {
            const int k = jj * 64 + lane;
            float sc = 0.f;
            if (k < nk) {
                const bf16_t* kr = ikbase + (size_t)k * INW;
                float a[8];
#pragma unroll
                for (int h = 0; h < 8; ++h) a[h] = 0.f;
#pragma unroll 1
                for (int d8 = 0; d8 < 8; ++d8) {
                    const u32x4 raw = *(const u32x4*)(kr + d8 * 8); float kv[8]; unpack8(raw, kv);
#pragma unroll
                    for (int h = 0; h < 8; ++h) {
                        const f32x4 q0 = *(const LAS f32x4*)(sQ + h * 64 + d8 * 8), q1 = *(const LAS f32x4*)(sQ + h * 64 + d8 * 8 + 4);
                        a[h] += kv[0] * q0[0] + kv[1] * q0[1] + kv[2] * q0[2] + kv[3] * q0[3] + kv[4] * q1[0] + kv[5] * q1[1] + kv[6] * q1[2] + kv[7] * q1[3];
                    }
                }
#pragma unroll
                for (int h = 0; h < 8; ++h) sc += fmaxf(a[h], 0.f) * sIw[h];
                sc += 0.0f;
            }
            sSc[k] = sc;
        }
        lds_fence();
        int L;
        if (nk <= 256) {
            for (int i = lane; i < nk; i += 64) sSel[i] = i;
            L = nk;
        } else {
            unsigned Tkey = 0u;
            for (int bit = 31; bit >= 0; --bit) {
                const unsigned cand = Tkey | (1u << bit);
                int cnt = 0;
                for (int jj = 0; jj < nj; ++jj) {
                    const int k = jj * 64 + lane;
                    const unsigned key = (k < nk) ? fkey(sSc[k]) : 0u;
                    cnt += __popcll(__ballot(key >= cand));
                }
                if (cnt >= 256) Tkey = cand;
            }
            int cgt = 0;
            for (int jj = 0; jj < nj; ++jj) {
                const int k = jj * 64 + lane;
                const unsigned key = (k < nk) ? fkey(sSc[k]) : 0u;
                cgt += __popcll(__ballot(key > Tkey));
            }
            const int need = 256 - cgt;
            int pos = 0, eqseen = 0;
            for (int jj = 0; jj < nj; ++jj) {
                const int k = jj * 64 + lane;
                const unsigned key = (k < nk) ? fkey(sSc[k]) : 0u;
                const bool gt = key > Tkey, eq = (key == Tkey);
                const unsigned long long eqm = __ballot(eq);
                const int myeq = eqseen + __popcll(eqm & lt_mask);
                const bool sel = gt || (eq && myeq < need);
                const unsigned long long sm = __ballot(sel);
                if (sel) sSel[pos + __popcll(sm & lt_mask)] = k;
                pos += __popcll(sm); eqseen += __popcll(eqm);
            }
            L = 256;
        }
        lds_fence();
        for (int i = lane; i < 1024; i += 64) sQ[i] = bf2f(prow[C_DQ + i]);
        lds_fence();
        float sc[8][4];
        const bf16_t* dkbase = proj + (size_t)(b * TT) * INW + C_DK;
#pragma unroll
        for (int il = 0; il < 4; ++il) {
            const int i = lane + 64 * il; const bool ok = i < L; const int key = ok ? sSel[i] : 0;
            const bf16_t* kr = dkbase + (size_t)key * INW;
            float a[8];
#pragma unroll
            for (int h = 0; h < 8; ++h) a[h] = 0.f;
#pragma unroll 1
            for (int d8 = 0; d8 < 16; ++d8) {
                const u32x4 raw = *(const u32x4*)(kr + d8 * 8); float kv[8]; unpack8(raw, kv);
#pragma unroll
                for (int h = 0; h < 8; ++h) {
                    const f32x4 q0 = *(const LAS f32x4*)(sQ + h * 128 + d8 * 8), q1 = *(const LAS f32x4*)(sQ + h * 128 + d8 * 8 + 4);
                    a[h] += kv[0] * q0[0] + kv[1] * q0[1] + kv[2] * q0[2] + kv[3] * q0[3] + kv[4] * q1[0] + kv[5] * q1[1] + kv[6] * q1[2] + kv[7] * q1[3];
                }
            }
#pragma unroll
            for (int h = 0; h < 8; ++h) sc[h][il] = ok ? a[h] : -INFINITY;
        }
#pragma unroll
        for (int h = 0; h < 8; ++h) {
            float m = fmaxf(fmaxf(sc[h][0], sc[h][1]), fmaxf(sc[h][2], sc[h][3]));
            m = wave_max(m);
            float e[4], sum = 0.f;
#pragma unroll
            for (int il = 0; il < 4; ++il) { e[il] = exp2f(sc[h][il] - m); sum += e[il]; }
            sum = wave_sum(sum);
            const float inv = 1.f / sum;
#pragma unroll
            for (int il = 0; il < 4; ++il) sSc[h * 256 + lane + 64 * il] = e[il] * inv;
        }
        lds_fence();
        float o[8][2];
#pragma unroll
        for (int h = 0; h < 8; ++h) { o[h][0] = 0.f; o[h][1] = 0.f; }
        const bf16_t* dvbase = proj + (size_t)(b * TT) * INW + C_DV;
        for (int i = 0; i < L; ++i) {
            const int key = sSel[i];
            const float v0 = bf2f(dvbase[(size_t)key * INW + lane]), v1 = bf2f(dvbase[(size_t)key * INW + 64 + lane]);
#pragma unroll
            for (int h = 0; h < 8; ++h) { const float pv = sSc[h * 256 + i]; o[h][0] += pv * v0; o[h][1] += pv * v1; }
        }
        lds_fence();
#pragma unroll
        for (int h = 0; h < 8; ++h) { sQ[h * 128 + lane] = o[h][0]; sQ[h * 128 + 64 + lane] = o[h][1]; }
        lds_fence();
        for (int h = 0; h < 8; ++h) {
            float acc = 0.f;
            const float* wu = p.w_uv + (size_t)h * 128 * 64 + lane;
            for (int c = 0; c < 128; ++c) acc += sQ[h * 128 + c] * wu[c * 64];
            if (CHECK) { const float got = bf2f(mixed[(size_t)q * DM + 512 + h * 64 + lane]); chk_num += (got - acc) * (got - acc); chk_den += acc * acc; }
            else mixed[(size_t)q * DM + 512 + h * 64 + lane] = f2bf(acc);
        }
        lds_fence();
    }
    if (CHECK) {
        chk_num = wave_sum(chk_num); chk_den = wave_sum(chk_den);
        if (lane == 0) { atomicAdd((float*)(p.ws + OFF_BAR) + 3600, chk_num); atomicAdd((float*)(p.ws + OFF_BAR) + 3601, chk_den); }
    }
}

typedef unsigned long long u64;
typedef short s16x4 __attribute__((ext_vector_type(4)));
constexpr int SCLD = 2116;
constexpr int DSA_MASK_OFF = 16 * SCLD * 4;
constexpr int KLD = 136, VLD = 72, VLD2 = 136;
constexpr int DSA_VT_OFF = 128 * KLD * 2;
DI void phase_dsa_fast(const Params& p, LAS char* smem) {
    const bf16_t* proj = (const bf16_t*)(p.ws + OFF_BIG);
    const bf16_t* dvt = (const bf16_t*)(p.ws + OFF_DVT);
    const bf16_t* wuvt = (const bf16_t*)(p.ws + OFF_WUVT);
    bf16_t* mixed = (bf16_t*)(p.ws + OFF_HN);
    const int wave = threadIdx.x >> 6, lane = threadIdx.x & 63, c = lane & 15, g = lane >> 4;
    LAS float* SC = (LAS float*)smem; LAS u64* MASK = (LAS u64*)(smem + DSA_MASK_OFF);
    LAS bf16_t* KT = (LAS bf16_t*)smem; LAS bf16_t* VT = (LAS bf16_t*)(smem + DSA_VT_OFF);
    const u64 lt_mask = (1ull << lane) - 1ull;
    for (int pi = blockIdx.x; pi < 512; pi += gridDim.x)
    for (int which = 0; which < 2; ++which) {
        const int b = pi >> 6, qq = pi & 63, qt = which ? 127 - qq : qq;
        const int s0 = qt * 16, nk = 80 + 64 * (s0 >> 6), nkt = nk >> 4, nj = (nk + 63) >> 6;
        const bf16_t* pb = proj + (size_t)(b * TT) * INW;
        LAS char* tp_smem = smem; TP_BEGIN(1);
        {
            const bf16_t* qrow = pb + (size_t)(NMETA + s0 + c) * INW;
            bf16x8 bq[8][2]; float iw[8];
#pragma unroll
            for (int h = 0; h < 8; ++h) {
                bq[h][0] = *(const bf16x8*)(qrow + C_IQ + h * 64 + 8 * g);
                bq[h][1] = *(const bf16x8*)(qrow + C_IQ + h * 64 + 32 + 8 * g);
                iw[h] = bf2f(qrow[C_IW + h]);
            }
            bf16x8 a0n = {0, 0, 0, 0, 0, 0, 0, 0}, a1n = {0, 0, 0, 0, 0, 0, 0, 0};
            if (wave < nkt) { const bf16_t* krow = pb + (size_t)(wave * 16 + c) * INW + C_IK + 8 * g; a0n = *(const bf16x8*)(krow); a1n = *(const bf16x8*)(krow + 32); }
            for (int kt = wave; kt < nkt; kt += NWAVES) {
                const bf16x8 a0 = a0n, a1 = a1n;
                if (kt + NWAVES < nkt) { const bf16_t* krow = pb + (size_t)((kt + NWAVES) * 16 + c) * INW + C_IK + 8 * g; a0n = *(const bf16x8*)(krow); a1n = *(const bf16x8*)(krow + 32); }
                f32x4 isc = {0.f, 0.f, 0.f, 0.f};
#pragma unroll
                for (int h = 0; h < 8; ++h) {
                    f32x4 acc = {0.f, 0.f, 0.f, 0.f};
                    acc = MFMA16(a0, bq[h][0], acc); acc = MFMA16(a1, bq[h][1], acc);
#pragma unroll
                    for (int j = 0; j < 4; ++j) isc[j] += fmaxf(acc[j], 0.f) * iw[h];
                }
#pragma unroll
                for (int j = 0; j < 4; ++j) isc[j] += 0.0f;
                *(LAS f32x4*)(SC + c * SCLD + kt * 16 + 4 * g) = isc;
            }
            {
                const int tail = ((nj <= 11 ? 11 : (nj <= 22 ? 22 : 33)) << 6) - nk;
                for (int i = threadIdx.x; i < 16 * tail; i += NTHREADS) { const int qq_ = i / tail; SC[qq_ * SCLD + nk + (i - qq_ * tail)] = -3.0e38f; }
            }
        }
        __syncthreads(); TP_END(1); TP_BEGIN(2);
#pragma unroll 1
        for (int qi = 0; qi < 2; ++qi) {
            const int cq = wave * 2 + qi;
            unsigned kv[33];
#pragma unroll
            for (int jj = 0; jj < 11; ++jj) kv[jj] = fkey(SC[cq * SCLD + jj * 64 + lane]);
            if (nj > 11) {
#pragma unroll
                for (int jj = 11; jj < 22; ++jj) kv[jj] = fkey(SC[cq * SCLD + jj * 64 + lane]);
            } else {
#pragma unroll
                for (int jj = 11; jj < 22; ++jj) kv[jj] = 0u;
            }
            if (nj > 22) {
#pragma unroll
                for (int jj = 22; jj < 33; ++jj) kv[jj] = fkey(SC[cq * SCLD + jj * 64 + lane]);
            } else {
#pragma unroll
                for (int jj = 22; jj < 33; ++jj) kv[jj] = 0u;
            }
            unsigned Tkey = 1u;
            if (nk > 256) {
                Tkey = 0u;
#pragma unroll 1
                for (int bit = 31; bit >= 0; --bit) {
                    const unsigned cand = Tkey | (1u << bit);
                    int nl = 0;
#pragma unroll
                    for (int jj = 0; jj < 11; ++jj) nl += (kv[jj] >= cand) ? 1 : 0;
                    if (nj > 11) {
#pragma unroll
                        for (int jj = 11; jj < 22; ++jj) nl += (kv[jj] >= cand) ? 1 : 0;
                    }
                    if (nj > 22) {
#pragma unroll
                        for (int jj = 22; jj < 33; ++jj) nl += (kv[jj] >= cand) ? 1 : 0;
                    }
                    const int cnt = wave_sum_int(nl);
                    if (cnt >= 256) Tkey = cand;
                    if (cnt == 256) break;
                }
            }
            int cgl = 0;
#pragma unroll
            for (int jj = 0; jj < 33; ++jj) cgl += (kv[jj] > Tkey) ? 1 : 0;
            const int cgt = wave_sum_int(cgl);
            const int need = (nk > 256) ? 256 - cgt : 4096;
            int eqseen = 0;
#pragma unroll 1
            for (int jj = 0; jj < nj; ++jj) {
                const int k = jj * 64 + lane; const float v = SC[cq * SCLD + k];
                const unsigned key = (k < nk) ? fkey(v) : 0u;
                const bool gt = key > Tkey, eq = (key == Tkey);
                const u64 eqm = __ballot(eq);
                const int myeq = eqseen + __popcll(eqm & lt_mask);
                const u64 sm = __ballot(gt || (eq && myeq < need));
                eqseen += __popcll(eqm);
                if (lane == 0) MASK[cq * 34 + jj] = sm;
            }
        }
        __syncthreads(); TP_END(2); TP_BEGIN(3);
        {
            const int h = wave;
            const bf16_t* qrow = pb + (size_t)(NMETA + s0 + c) * INW + C_DQ + h * 128 + 8 * g;
            bf16x8 bQ[4];
#pragma unroll
            for (int ks = 0; ks < 4; ++ks) bQ[ks] = *(const bf16x8*)(qrow + ks * 32);
            f32x4 O[8];
#pragma unroll
            for (int mb = 0; mb < 8; ++mb) O[mb] = (f32x4){0.f, 0.f, 0.f, 0.f};
            float m_run = -1e30f, l_run = 0.f;
            const int prow_t = threadIdx.x >> 4, pch_t = threadIdx.x & 15;
            const bf16_t* vsrc = dvt + (size_t)(b * 128 + prow_t) * TTP + pch_t * 8;
            const int n128 = (nk + 127) >> 7;
            u32x4 pk[4], pv[4];
#pragma unroll
            for (int i = 0; i < 4; ++i) {
                int key = prow_t + 32 * i; key = key < nk ? key : nk - 1;
                pk[i] = *(const u32x4*)(pb + (size_t)key * INW + C_DK + pch_t * 8);
                pv[i] = *(const u32x4*)(vsrc + (size_t)(32 * i) * TTP);
            }
#pragma unroll 1
            for (int kb = 0; kb < n128; ++kb) {
#pragma unroll
                for (int i = 0; i < 4; ++i) {
                    *(LAS u32x4*)(KT + (prow_t + 32 * i) * KLD + pch_t * 8) = pk[i];
                    *(LAS u32x4*)(VT + (prow_t + 32 * i) * VLD2 + pch_t * 8) = pv[i];
                }
                __syncthreads();
                if (kb + 1 < n128) {
#pragma unroll
                    for (int i = 0; i < 4; ++i) {
                        int key = (kb + 1) * 128 + prow_t + 32 * i; key = key < nk ? key : nk - 1;
                        pk[i] = *(const u32x4*)(pb + (size_t)key * INW + C_DK + pch_t * 8);
                        pv[i] = *(const u32x4*)(vsrc + (size_t)(32 * i) * TTP + (kb + 1) * 128);
                    }
                }
#pragma unroll
                for (int sb = 0; sb < 2; ++sb) {
                    const int wi = kb * 2 + sb;
                    if (wi < nj) {
                        const u64 mw = MASK[c * 34 + wi];
                        f32x4 S[4];
#pragma unroll
                        for (int ct = 0; ct < 4; ++ct) {
                            f32x4 acc = {0.f, 0.f, 0.f, 0.f};
#pragma unroll
                            for (int ks = 0; ks < 4; ++ks) {
                                const bf16x8 a = *(const LAS bf16x8*)(KT + (sb * 64 + ct * 16 + c) * KLD + ks * 32 + 8 * g);
                                acc = MFMA16(a, bQ[ks], acc);
                            }
                            S[ct] = acc;
                        }
                        const u64 mws = mw >> (4 * g);
                        const unsigned mlo = (unsigned)mws, mhi = (unsigned)(mws >> 32);
                        float mblk = -1e30f;
#pragma unroll
                        for (int ct = 0; ct < 4; ++ct) {
                            const unsigned bits = ((ct & 2) ? mhi : mlo) >> ((ct & 1) * 16);
#pragma unroll
                            for (int j = 0; j < 4; ++j) {
                                S[ct][j] = ((bits >> j) & 1u) ? S[ct][j] : -1e30f;
                                mblk = fmaxf(mblk, S[ct][j]);
                            }
                        }
                        mblk = fmaxf(mblk, __shfl_xor(mblk, 16)); mblk = fmaxf(mblk, __shfl_xor(mblk, 32));
                        const float m_new = fmaxf(m_run, mblk);
                        float ps = 0.f;
#pragma unroll
                        for (int ct = 0; ct < 4; ++ct)
#pragma unroll
                            for (int j = 0; j < 4; ++j) { const float pv_ = (S[ct][j] > -1e29f) ? __builtin_amdgcn_exp2f(S[ct][j] - m_new) : 0.f; S[ct][j] = pv_; ps += pv_; }
                        if (__ballot(m_new != m_run) != 0ull) {
                            const float alpha = __builtin_amdgcn_exp2f(m_run - m_new);
                            l_run *= alpha;
#pragma unroll
                            for (int mb = 0; mb < 8; ++mb) O[mb] *= alpha;
                        }
                        l_run += ps; m_run = m_new;
                        bf16x8 bP[2];
#pragma unroll
                        for (int kk = 0; kk < 2; ++kk) {
                            u32x4 t4;
                            t4[0] = pk2bf(S[2 * kk][0], S[2 * kk][1]); t4[1] = pk2bf(S[2 * kk][2], S[2 * kk][3]);
                            t4[2] = pk2bf(S[2 * kk + 1][0], S[2 * kk + 1][1]); t4[3] = pk2bf(S[2 * kk + 1][2], S[2 * kk + 1][3]);
                            bP[kk] = __builtin_bit_cast(bf16x8, t4);
                        }
#pragma unroll
                        for (int mh = 0; mh < 2; ++mh) {
                            bf16x8 av[8];
#pragma unroll
                            for (int q = 0; q < 8; ++q) {
                                const int mb = mh * 4 + (q >> 1), kk = q & 1;
                                const LAS bf16_t* vr = VT + (mb * 16 + c) * VLD2 + sb * 64 + kk * 32 + 4 * g;
                                const s16x4 lo = *(const LAS s16x4*)(vr), hi = *(const LAS s16x4*)(vr + 16);
                                av[q] = __builtin_shufflevector(lo, hi, 0, 1, 2, 3, 4, 5, 6, 7);
                            }
                            __builtin_amdgcn_sched_barrier(0);
#pragma unroll
                            for (int q = 0; q < 8; ++q) { const int mb = mh * 4 + (q >> 1), kk = q & 1; O[mb] = MFMA16(av[q], bP[kk], O[mb]); }
                            __builtin_amdgcn_sched_barrier(0);
                        }
                    }
                }
                __syncthreads();
            }
            TP_END(3); TP_BEGIN(4);
            l_run += __shfl_xor(l_run, 16); l_run += __shfl_xor(l_run, 32);
            const float inv = 1.f / l_run;
            bf16x8 bO[4];
#pragma unroll
            for (int k2 = 0; k2 < 4; ++k2)
#pragma unroll
                for (int j = 0; j < 4; ++j) { bO[k2][j] = (short)f2bf(O[2 * k2][j] * inv); bO[k2][4 + j] = (short)f2bf(O[2 * k2 + 1][j] * inv); }
            bf16_t* orow = mixed + (size_t)(b * SEQ + s0 + c) * DM + 512 + h * 64;
            int zofs = 0; asm volatile("" : "+v"(zofs));
#pragma unroll
            for (int eb = 0; eb < 4; ++eb) {
                f32x4 acc = {0.f, 0.f, 0.f, 0.f};
#pragma unroll
                for (int k2 = 0; k2 < 4; ++k2) {
                    const bf16_t* wr = wuvt + (size_t)(h * 64 + eb * 16 + c) * 128 + k2 * 32 + 4 * g + zofs;
                    const s16x4 lo = *(const s16x4*)(wr), hi = *(const s16x4*)(wr + 16);
                    const bf16x8 a = __builtin_shufflevector(lo, hi, 0, 1, 2, 3, 4, 5, 6, 7);
                    acc = MFMA16(a, bO[k2], acc);
                }
                uint2 w;
                w.x = (unsigned)f2bf(acc[0]) | ((unsigned)f2bf(acc[1]) << 16);
                w.y = (unsigned)f2bf(acc[2]) | ((unsigned)f2bf(acc[3]) << 16);
                *(uint2*)(orow + eb * 16 + 4 * g) = w;
            }
            TP_END(4);
        }
    }
}

DI void phase_dsa32(const Params& p, LAS char* smem) {
    const bf16_t* proj = (const bf16_t*)(p.ws + OFF_BIG);
    const bf16_t* dvt = (const bf16_t*)(p.ws + OFF_DVT);
    const bf16_t* wuvt = (const bf16_t*)(p.ws + OFF_WUVT);
    bf16_t* mixed = (bf16_t*)(p.ws + OFF_HN);
    const int wave = threadIdx.x >> 6, lane = threadIdx.x & 63, c = lane & 15, g = lane >> 4;
    LAS float* SC = (LAS float*)smem; LAS u64* MASK = (LAS u64*)(smem + DSA_MASK_OFF);
    const int r = lane & 31, hh = lane >> 5;
    LAS bf16_t* KT = (LAS bf16_t*)smem; LAS bf16_t* VT = (LAS bf16_t*)(smem + DSA_VT_OFF);
    const u64 lt_mask = (1ull << lane) - 1ull;
    for (int pi = blockIdx.x; pi < 256; pi += gridDim.x)
    for (int which = 0; which < 2; ++which) {
        const int b = pi >> 5, qq = pi & 31, qt = which ? 63 - qq : qq;
        const int s0 = qt * 32, nk = 80 + 64 * (s0 >> 6), nkt = nk >> 4, nj = (nk + 63) >> 6;
        const bf16_t* pb = proj + (size_t)(b * TT) * INW;
        LAS char* tp_smem = smem; TP_BEGIN(1);
#pragma unroll 1
        for (int sub = 0; sub < 2; ++sub) {
            {
                const bf16_t* qrow = pb + (size_t)(NMETA + s0 + 16 * sub + c) * INW;
                bf16x8 bq[8][2]; float iw[8];
#pragma unroll
                for (int h = 0; h < 8; ++h) {
                    bq[h][0] = *(const bf16x8*)(qrow + C_IQ + h * 64 + 8 * g);
                    bq[h][1] = *(const bf16x8*)(qrow + C_IQ + h * 64 + 32 + 8 * g);
                    iw[h] = bf2f(qrow[C_IW + h]);
                }
                bf16x8 a0n = {0, 0, 0, 0, 0, 0, 0, 0}, a1n = {0, 0, 0, 0, 0, 0, 0, 0};
                if (wave < nkt) { const bf16_t* krow = pb + (size_t)(wave * 16 + c) * INW + C_IK + 8 * g; a0n = *(const bf16x8*)(krow); a1n = *(const bf16x8*)(krow + 32); }
                for (int kt = wave; kt < nkt; kt += NWAVES) {
                    const bf16x8 a0 = a0n, a1 = a1n;
                    if (kt + NWAVES < nkt) { const bf16_t* krow = pb + (size_t)((kt + NWAVES) * 16 + c) * INW + C_IK + 8 * g; a0n = *(const bf16x8*)(krow); a1n = *(const bf16x8*)(krow + 32); }
                    f32x4 isc = {0.f, 0.f, 0.f, 0.f};
#pragma unroll
                    for (int h = 0; h < 8; ++h) {
                        f32x4 acc = {0.f, 0.f, 0.f, 0.f};
                        acc = MFMA16(a0, bq[h][0], acc); acc = MFMA16(a1, bq[h][1], acc);
#pragma unroll
                        for (int j = 0; j < 4; ++j) isc[j] += fmaxf(acc[j], 0.f) * iw[h];
                    }
#pragma unroll
                    for (int j = 0; j < 4; ++j) isc[j] += 0.0f;
                    *(LAS f32x4*)(SC + c * SCLD + kt * 16 + 4 * g) = isc;
                }
                {
                    const int tail = ((nj <= 11 ? 11 : (nj <= 22 ? 22 : 33)) << 6) - nk;
                    for (int i = threadIdx.x; i < 16 * tail; i += NTHREADS) { const int qq_ = i / tail; SC[qq_ * SCLD + nk + (i - qq_ * tail)] = -3.0e38f; }
                }
            }
            __syncthreads();
#pragma unroll 1
            for (int qi = 0; qi < 2; ++qi) {
                const int cq = wave * 2 + qi;
                unsigned kv[33];
#pragma unroll
                for (int jj = 0; jj < 11; ++jj) kv[jj] = fkey(SC[cq * SCLD + jj * 64 + lane]);
                if (nj > 11) {
#pragma unroll
                    for (int jj = 11; jj < 22; ++jj) kv[jj] = fkey(SC[cq * SCLD + jj * 64 + lane]);
                } else {
#pragma unroll
                    for (int jj = 11; jj < 22; ++jj) kv[jj] = 0u;
                }
                if (nj > 22) {
#pragma unroll
                    for (int jj = 22; jj < 33; ++jj) kv[jj] = fkey(SC[cq * SCLD + jj * 64 + lane]);
                } else {
#pragma unroll
                    for (int jj = 22; jj < 33; ++jj) kv[jj] = 0u;
                }
                unsigned Tkey = 1u;
                if (nk > 256) {
                    Tkey = 0u;
#pragma unroll 1
                    for (int bit = 31; bit >= 0; --bit) {
                        const unsigned cand = Tkey | (1u << bit);
                        int nl = 0;
#pragma unroll
                        for (int jj = 0; jj < 11; ++jj) nl += (kv[jj] >= cand) ? 1 : 0;
                        if (nj > 11) {
#pragma unroll
                            for (int jj = 11; jj < 22; ++jj) nl += (kv[jj] >= cand) ? 1 : 0;
                        }
                        if (nj > 22) {
#pragma unroll
                            for (int jj = 22; jj < 33; ++jj) nl += (kv[jj] >= cand) ? 1 : 0;
                        }
                        const int cnt = wave_sum_int(nl);
                        if (cnt >= 256) Tkey = cand;
                        if (cnt == 256) break;
                    }
                }
                int cgl = 0;
#pragma unroll
                for (int jj = 0; jj < 33; ++jj) cgl += (kv[jj] > Tkey) ? 1 : 0;
                const int cgt = wave_sum_int(cgl);
                const int need = (nk > 256) ? 256 - cgt : 4096;
                int eqseen = 0;
#pragma unroll 1
                for (int jj = 0; jj < nj; ++jj) {
                    const int k = jj * 64 + lane; const float v = SC[cq * SCLD + k];
                    const unsigned key = (k < nk) ? fkey(v) : 0u;
                    const bool gt = key > Tkey, eq = (key == Tkey);
                    const u64 eqm = __ballot(eq);
                    const int myeq = eqseen + __popcll(eqm & lt_mask);
                    const u64 sm = __ballot(gt || (eq && myeq < need));
                    eqseen += __popcll(eqm);
                    if (lane == 0) MASK[(16 * sub + cq) * 34 + jj] = sm;
                }
            }

            __syncthreads();
        }
        TP_END(1); TP_BEGIN(3);
        {
            const int h = wave;
            const bf16_t* qrow = pb + (size_t)(NMETA + s0 + r) * INW + C_DQ + h * 128 + 8 * hh;
            bf16x8 bQ[8];
#pragma unroll
            for (int ks = 0; ks < 8; ++ks) bQ[ks] = *(const bf16x8*)(qrow + ks * 16);
            f32x16 O[4];
#pragma unroll
            for (int d = 0; d < 4; ++d)
#pragma unroll
                for (int i = 0; i < 16; ++i) O[d][i] = 0.f;
            float m_run = -1e30f, l_run = 0.f;
            const int prow_t = threadIdx.x >> 4, pch_t = threadIdx.x & 15;
            const bf16_t* vsrc = dvt + (size_t)(b * 128 + prow_t) * TTP + pch_t * 8;
            const int n128 = (nk + 127) >> 7;
            u32x4 pk[4], pv[4];
#pragma unroll
            for (int i = 0; i < 4; ++i) {
                int key = prow_t + 32 * i; key = key < nk ? key : nk - 1;
                pk[i] = *(const u32x4*)(pb + (size_t)key * INW + C_DK + pch_t * 8);
                pv[i] = *(const u32x4*)(vsrc + (size_t)(32 * i) * TTP);
            }
#pragma unroll 1
            for (int kb = 0; kb < n128; ++kb) {
#pragma unroll
                for (int i = 0; i < 4; ++i) {
                    *(LAS u32x4*)(KT + (prow_t + 32 * i) * KLD + pch_t * 8) = pk[i];
                    *(LAS u32x4*)(VT + (prow_t + 32 * i) * VLD2 + pch_t * 8) = pv[i];
                }
                __syncthreads();
                if (kb + 1 < n128) {
#pragma unroll
                    for (int i = 0; i < 4; ++i) {
                        int key = (kb + 1) * 128 + prow_t + 32 * i; key = key < nk ? key : nk - 1;
                        pk[i] = *(const u32x4*)(pb + (size_t)key * INW + C_DK + pch_t * 8);
                        pv[i] = *(const u32x4*)(vsrc + (size_t)(32 * i) * TTP + (kb + 1) * 128);
                    }
                }
#pragma unroll 1
                for (int kblk = 0; kblk < 4; ++kblk) {
                    const int wi = kb * 2 + (kblk >> 1);
                    if (wi >= nj) break;
                    f32x16 S;
#pragma unroll
                    for (int i = 0; i < 16; ++i) S[i] = 0.f;
#pragma unroll
                    for (int ks = 0; ks < 8; ++ks) {
                        const bf16x8 a = *(const LAS bf16x8*)(KT + (kblk * 32 + r) * KLD + ks * 16 + 8 * hh);
                        S = MFMA32(a, bQ[ks], S);
                    }
                    const u64 mws = MASK[r * 34 + wi] >> ((kblk & 1) * 32 + 4 * hh);
                    const unsigned mbits = (unsigned)mws;
                    float mblk = -1e30f;
#pragma unroll
                    for (int i = 0; i < 16; ++i) {
                        S[i] = ((mbits >> (8 * (i >> 2) + (i & 3))) & 1u) ? S[i] : -1e30f;
                        mblk = fmaxf(mblk, S[i]);
                    }
                    mblk = fmaxf(mblk, __shfl_xor(mblk, 32));
                    const float m_new = fmaxf(m_run, mblk);
                    float ps = 0.f;
#pragma unroll
                    for (int i = 0; i < 16; ++i) { const float pv_ = (S[i] > -1e29f) ? __builtin_amdgcn_exp2f(S[i] - m_new) : 0.f; S[i] = pv_; ps += pv_; }
                    if (__ballot(m_new != m_run) != 0ull) {
                        const float alpha = __builtin_amdgcn_exp2f(m_run - m_new);
                        l_run *= alpha;
#pragma unroll
                        for (int d = 0; d < 4; ++d)
#pragma unroll
                            for (int i = 0; i < 16; ++i) O[d][i] *= alpha;
                    }
                    l_run += ps; m_run = m_new;
                    bf16x8 bP[2];
#pragma unroll
                    for (int s2 = 0; s2 < 2; ++s2) {
                        u32x4 t4;
#pragma unroll
                        for (int x = 0; x < 4; ++x) t4[x] = pk2bf(S[8 * s2 + 2 * x], S[8 * s2 + 2 * x + 1]);
                        bP[s2] = __builtin_bit_cast(bf16x8, t4);
                    }
                    bf16x8 av[8];
#pragma unroll
                    for (int q = 0; q < 8; ++q) {
                        const int d = q >> 1, s2 = q & 1;
                        const LAS bf16_t* vr = VT + (d * 32 + r) * VLD2 + kblk * 32 + 16 * s2 + 4 * hh;
                        const s16x4 lo = *(const LAS s16x4*)(vr), hi = *(const LAS s16x4*)(vr + 8);
                        av[q] = __builtin_shufflevector(lo, hi, 0, 1, 2, 3, 4, 5, 6, 7);
                    }
#pragma unroll
                    for (int q = 0; q < 8; ++q) O[q >> 1] = MFMA32(av[q], bP[q & 1], O[q >> 1]);
                }
                __syncthreads();
            }
            TP_END(3); TP_BEGIN(4);
            l_run += __shfl_xor(l_run, 32);
            const float inv = 1.f / l_run;
            bf16x8 bO[4][2];
#pragma unroll
            for (int d = 0; d < 4; ++d)
#pragma unroll
                for (int s2 = 0; s2 < 2; ++s2) {
                    u32x4 t4;
#pragma unroll
                    for (int x = 0; x < 4; ++x) t4[x] = pk2bf(O[d][8 * s2 + 2 * x] * inv, O[d][8 * s2 + 2 * x + 1] * inv);
                    bO[d][s2] = __builtin_bit_cast(bf16x8, t4);
                }
            bf16_t* orow = mixed + (size_t)(b * SEQ + s0 + r) * DM + 512 + h * 64 + 4 * hh;
            int zofs = 0; asm volatile("" : "+v"(zofs));
#pragma unroll
            for (int eb = 0; eb < 2; ++eb) {
                f32x16 acc;
#pragma unroll
                for (int i = 0; i < 16; ++i) acc[i] = 0.f;
#pragma unroll
                for (int d = 0; d < 4; ++d)
#pragma unroll
                    for (int s2 = 0; s2 < 2; ++s2) {
                        const bf16_t* wr = wuvt + (size_t)(h * 64 + eb * 32 + r) * 128 + d * 32 + 16 * s2 + 4 * hh + zofs;
                        const s16x4 lo = *(const s16x4*)(wr), hi = *(const s16x4*)(wr + 8);
                        const bf16x8 a = __builtin_shufflevector(lo, hi, 0, 1, 2, 3, 4, 5, 6, 7);
                        acc = MFMA32(a, bO[d][s2], acc);
                    }
#pragma unroll
                for (int g4 = 0; g4 < 4; ++g4) { uint2 w; w.x = pk2bf(acc[4 * g4], acc[4 * g4 + 1]); w.y = pk2bf(acc[4 * g4 + 2], acc[4 * g4 + 3]); *(uint2*)(orow + eb * 32 + 8 * g4) = w; }
            }
            TP_END(4);
        }
    }
}

DI void phase_ret_scan(const Params& p) {
    float* ST = (float*)(p.ws + OFF_ST);
    const int gtid = blockIdx.x * NTHREADS + threadIdx.x, gsz = gridDim.x * NTHREADS;
    for (int idx = gtid; idx < 32 * 16384; idx += gsz) {
        const int bh = idx >> 14, el = idx & 16383, h = bh & 3;
        const float gc = expf(logf(1.f - exp2f(-5.f - (float)h)) * 64.f);
        float* base = ST + (size_t)bh * 34 * 16384 + el;
        float r = 0.f;
        for (int c = 1; c < 34; ++c) {
            const float u = c < 33 ? base[(size_t)c * 16384] : 0.f;
            base[(size_t)c * 16384] = r;
            r = gc * r + u;
        }
    }
}

constexpr int RLD = 136, RTLD = 72;
DI void phase_ret_state_mfma(const Params& p, LAS char* smem) {
    const bf16_t* proj = (const bf16_t*)(p.ws + OFF_BIG);
    float* ST = (float*)(p.ws + OFF_ST);
    LAS bf16_t* sVT = (LAS bf16_t*)smem; LAS bf16_t* sKT = sVT + 128 * RTLD;
    const int wave = threadIdx.x >> 6, lane = threadIdx.x & 63, r = lane & 31, hh = lane >> 5;
    for (int unit = blockIdx.x; unit < 1024; unit += gridDim.x) {
        const int c = 1 + (unit & 31), bh = unit >> 5, h = bh & 3, b = bh >> 2;
        const float lg = logf(1.f - exp2f(-5.f - (float)h));
        {
            const int j = threadIdx.x >> 3, ch = threadIdx.x & 7, t = 64 * c + j - 112;
            const float z = expf(lg * (float)(63 - j));
#pragma unroll
            for (int q = 0; q < 2; ++q) {
                const int cc = ch + 8 * q;
                u32x4 kv = {0u, 0u, 0u, 0u}, vv = {0u, 0u, 0u, 0u};
                if (t >= 0) { const bf16_t* pr = proj + (size_t)(b * TT + t) * INW; kv = *(const u32x4*)(pr + C_RK + h * 128 + cc * 8); vv = *(const u32x4*)(pr + C_RV + h * 128 + cc * 8); }
                float vf[8]; unpack8(vv, vf);
#pragma unroll
                for (int x = 0; x < 8; ++x) {
                    sKT[(cc * 8 + x) * RTLD + j] = (bf16_t)((kv[x >> 1] >> ((x & 1) * 16)) & 0xffffu);
                    sVT[(cc * 8 + x) * RTLD + j] = f2bf(vf[x] * z);
                }
            }
        }
        __syncthreads();
        const int mb = wave >> 1;
#pragma unroll
        for (int q = 0; q < 2; ++q) {
            const int nb = (wave & 1) * 2 + q;
            f32x16 acc;
#pragma unroll
            for (int i = 0; i < 16; ++i) acc[i] = 0.f;
#pragma unroll
            for (int ks = 0; ks < 4; ++ks) {
                const bf16x8 a = *(const LAS bf16x8*)(sVT + (mb * 32 + r) * RTLD + ks * 16 + 8 * hh);
                const bf16x8 bb = *(const LAS bf16x8*)(sKT + (nb * 32 + r) * RTLD + ks * 16 + 8 * hh);
                acc = MFMA32(a, bb, acc);
            }
            float* st = ST + (size_t)(bh * 34 + c) * 16384 + nb * 32 + r;
#pragma unroll
            for (int i = 0; i < 16; ++i) st[(size_t)(mb * 32 + (i & 3) + 8 * (i >> 2) + 4 * hh) * 128] = acc[i];
        }
        __syncthreads();
    }
}
DI void phase_ret_out_mfma(const Params& p, LAS char* smem) {
    const bf16_t* proj = (const bf16_t*)(p.ws + OFF_BIG);
    const float* ST = (const float*)(p.ws + OFF_ST);
    bf16_t* mixed = (bf16_t*)(p.ws + OFF_HN);
    LAS bf16_t* sQ = (LAS bf16_t*)smem; LAS bf16_t* sK = sQ + 64 * RLD; LAS bf16_t* sVT = sK + 64 * RLD;
    LAS float* sGN = (LAS float*)(sVT + 128 * RTLD);
    const int wave = threadIdx.x >> 6, lane = threadIdx.x & 63, r = lane & 31, hh = lane >> 5;
    const int ib = wave & 1, eb = wave >> 1;
    for (int unit = blockIdx.x; unit < 1024; unit += gridDim.x) {
        const int c = 2 + (unit & 31), bh = unit >> 5, h = bh & 3, b = bh >> 2;
        const float lg = logf(1.f - exp2f(-5.f - (float)h));
        for (int i = threadIdx.x; i < 64 * 16; i += NTHREADS) {
            const int j = i >> 4, ch = i & 15; const int t = 64 * c + j - 112;
            const bf16_t* pr = proj + (size_t)(b * TT + t) * INW;
            *(LAS u32x4*)(sQ + j * RLD + ch * 8) = *(const u32x4*)(pr + C_RQ + h * 128 + ch * 8);
            *(LAS u32x4*)(sK + j * RLD + ch * 8) = *(const u32x4*)(pr + C_RK + h * 128 + ch * 8);
            const u32x4 vv = *(const u32x4*)(pr + C_RV + h * 128 + ch * 8);
#pragma unroll
            for (int x = 0; x < 8; ++x) sVT[(ch * 8 + x) * RTLD + j] = (bf16_t)((vv[x >> 1] >> ((x & 1) * 16)) & 0xffffu);
        }
        __syncthreads();
        f32x16 acc;
#pragma unroll
        for (int i = 0; i < 16; ++i) acc[i] = 0.f;
        {
            const float* R = ST + (size_t)(bh * 34 + c) * 16384 + (size_t)(eb * 32 + r) * 128 + 8 * hh;
#pragma unroll
            for (int ks = 0; ks < 8; ++ks) {
                const float4 r0 = *(const float4*)(R + ks * 16), r1 = *(const float4*)(R + ks * 16 + 4);
                const float rf[8] = {r0.x, r0.y, r0.z, r0.w, r1.x, r1.y, r1.z, r1.w};
                const bf16x8 a = pack8(rf);
                const bf16x8 bq = *(const LAS bf16x8*)(sQ + (ib * 32 + r) * RLD + ks * 16 + 8 * hh);
                acc = MFMA32(a, bq, acc);
            }
            const float xi = expf(lg * (float)(ib * 32 + r + 1));
#pragma unroll
            for (int i = 0; i < 16; ++i) acc[i] *= xi;
        }
#pragma unroll
        for (int jb = 0; jb < 2; ++jb) {
            f32x16 st;
#pragma unroll
            for (int i = 0; i < 16; ++i) st[i] = 0.f;
#pragma unroll
            for (int ks = 0; ks < 8; ++ks) {
                const bf16x8 a = *(const LAS bf16x8*)(sK + (jb * 32 + r) * RLD + ks * 16 + 8 * hh);
                const bf16x8 bq = *(const LAS bf16x8*)(sQ + (ib * 32 + r) * RLD + ks * 16 + 8 * hh);
                st = MFMA32(a, bq, st);
            }
            const int icol = ib * 32 + r;
#pragma unroll
            for (int i = 0; i < 16; ++i) {
                const int j = jb * 32 + (i & 3) + 8 * (i >> 2) + 4 * hh; const int df = icol > j ? icol - j : j - icol;
                st[i] *= expf(lg * (float)df);
            }
#pragma unroll
            for (int s2 = 0; s2 < 2; ++s2) {
                bf16x8 bp;
#pragma unroll
                for (int x = 0; x < 8; ++x) bp[x] = (short)f2bf(st[8 * s2 + x]);
                const LAS bf16_t* vr = sVT + (eb * 32 + r) * RTLD + jb * 32 + 16 * s2 + 4 * hh;
                const s16x4 lo = *(const LAS s16x4*)(vr), hi = *(const LAS s16x4*)(vr + 8);
                const bf16x8 a = __builtin_shufflevector(lo, hi, 0, 1, 2, 3, 4, 5, 6, 7);
                acc = MFMA32(a, bp, acc);
            }
        }
        float s1 = 0.f, s2 = 0.f;
#pragma unroll
        for (int i = 0; i < 16; ++i) { s1 += acc[i]; s2 += acc[i] * acc[i]; }
        s1 += __shfl_xor(s1, 32); s2 += __shfl_xor(s2, 32);
        if (hh == 0) { sGN[(eb * 64 + ib * 32 + r) * 2] = s1; sGN[(eb * 64 + ib * 32 + r) * 2 + 1] = s2; }
        __syncthreads();
        float S1 = 0.f, S2 = 0.f;
#pragma unroll
        for (int e4 = 0; e4 < 4; ++e4) { S1 += sGN[(e4 * 64 + ib * 32 + r) * 2]; S2 += sGN[(e4 * 64 + ib * 32 + r) * 2 + 1]; }
        const float mu = S1 * (1.f / 128.f), var = fmaxf(S2 * (1.f / 128.f) - mu * mu, 0.f), rs = rsqrtf(var + 1e-6f);
        const int t = 64 * c + ib * 32 + r - 112, srow = t - NMETA;
        const bf16_t* pg = proj + (size_t)(b * TT + t) * INW + C_RG + h * 128 + eb * 32 + 4 * hh;
        bf16_t* po = mixed + (size_t)(b * SEQ + srow) * DM + h * 128 + eb * 32 + 4 * hh;
#pragma unroll
        for (int g4 = 0; g4 < 4; ++g4) {
            const uint2 graw = *(const uint2*)(pg + 8 * g4);
            const float gv[4] = {__uint_as_float(graw.x << 16), __uint_as_float(graw.x & 0xffff0000u), __uint_as_float(graw.y << 16), __uint_as_float(graw.y & 0xffff0000u)};
            float o[4];
#pragma unroll
            for (int x = 0; x < 4; ++x) { const float gate = gv[x] / (1.f + expf(-gv[x])); o[x] = gate * (acc[4 * g4 + x] - mu) * rs; }
            uint2 w; w.x = (unsigned)f2bf(o[0]) | ((unsigned)f2bf(o[1]) << 16); w.y = (unsigned)f2bf(o[2]) | ((unsigned)f2bf(o[3]) << 16);
            *(uint2*)(po + 8 * g4) = w;
        }
        __syncthreads();
    }
}

DI void phase_norm2(const Params& p) {
    bf16_t* hn2 = (bf16_t*)(p.ws + OFF_HN);
    const int wave = threadIdx.x >> 6, lane = threadIdx.x & 63;
    for (int row = blockIdx.x * NWAVES + wave; row < NF; row += gridDim.x * NWAVES) {
        const float* src = p.out + (size_t)row * DM; bf16_t* o = hn2 + (size_t)row * DM;
        float4 v[4]; float ss = 0.f;
#pragma unroll
        for (int i = 0; i < 4; ++i) { v[i] = *(const float4*)(src + i * 256 + lane * 4); ss += v[i].x * v[i].x + v[i].y * v[i].y + v[i].z * v[i].z + v[i].w * v[i].w; }
        ss = wave_sum(ss);
        const float rstd = rsqrtf(ss * (1.f / DM) + 1e-6f);
#pragma unroll
        for (int i = 0; i < 4; ++i) {
            const float4 g = *(const float4*)(p.norm_ffn + i * 256 + lane * 4);
            uint2 w;
            w.x = (unsigned)f2bf(v[i].x * rstd * g.x) | ((unsigned)f2bf(v[i].y * rstd * g.y) << 16);
            w.y = (unsigned)f2bf(v[i].z * rstd * g.z) | ((unsigned)f2bf(v[i].w * rstd * g.w) << 16);
            *(uint2*)(o + i * 256 + lane * 4) = w;
        }
    }
}

__device__ const int PEER_PAIRS[50] = {0, 2, 4, 6, 8, 10, 12, 14, 16, 18, 20, 22, 32, 34, 36, 49, 51, 65, 80, 96, 112, 128, 160, 192, 224, 1, 3, 5, 7, 9, 11, 13, 15, 17, 19, 21, 23, 33, 35, 48, 50, 64, 66, 81, 97, 113, 144, 176, 208, 240};
constexpr int PSEL_WAVE_LDS = 32 * 2 * 16 * 8 + 32 * 16 * 8;
DI void phase_peer_select(const Params& p, LAS char* smem) {
    const float* PQ = (const float*)(p.ws + OFF_BIG);
    unsigned* EG = (unsigned*)(p.ws + OFF_EG); const float* SSQ = (const float*)(p.ws + OFF_SSQ);
    const int wave = threadIdx.x >> 6, lane = threadIdx.x & 63, r = lane & 31, hh = lane >> 5;
    LAS float* lv = (LAS float*)(smem + wave * PSEL_WAVE_LDS);
    LAS int* li = (LAS int*)(lv + 32 * 2 * 16);
    LAS float* cs = (LAS float*)(li + 32 * 2 * 16);
    LAS int* cab = (LAS int*)(cs + 32 * 16);
    for (int task = blockIdx.x * NWAVES + wave; task < (NF / 32) * 8; task += gridDim.x * NWAVES) {
        const int tile = task >> 3, h = task & 7;
        const int n = tile * 32 + r;
#pragma unroll 1
        for (int half = 0; half < 2; ++half) {
            f32x16 acc[4];
            {
                const float* srow = PQ + (size_t)n * 2048 + h * 256 + half * 128 + hh * 64;
#pragma unroll
                for (int mb = 0; mb < 4; ++mb)
#pragma unroll
                    for (int q = 0; q < 4; ++q) { const float4 a = *(const float4*)(srow + mb * 16 + q * 4); acc[mb][q * 4] = a.x; acc[mb][q * 4 + 1] = a.y; acc[mb][q * 4 + 2] = a.z; acc[mb][q * 4 + 3] = a.w; }
            }
            float mprev = INFINITY;
#pragma unroll 1
            for (int it = 0; it < 16; ++it) {
                float m = -INFINITY;
#pragma unroll
                for (int mb = 0; mb < 4; ++mb)
#pragma unroll
                    for (int i = 0; i < 16; ++i) { const float v = acc[mb][i]; m = fmaxf(m, v < mprev ? v : -INFINITY); }
                m = fmaxf(m, __shfl_xor(m, 32));
                mprev = m;
            }
            const float T = mprev;
            int cnt = 0;
#pragma unroll
            for (int mb = 0; mb < 4; ++mb)
#pragma unroll
                for (int i = 0; i < 16; ++i) cnt += (acc[mb][i] >= T) ? 1 : 0;
            const int pc = __shfl_xor(cnt, 32);
            int pos = hh ? pc : 0;
            LAS float* lvp = lv + (r * 2 + half) * 16; LAS int* lip = li + (r * 2 + half) * 16;
#pragma unroll
            for (int mb = 0; mb < 4; ++mb)
#pragma unroll
                for (int i = 0; i < 16; ++i) {
                    const float v = acc[mb][i];
                    if (v >= T) { if (pos < 16) { lvp[pos] = v; lip[pos] = hh * 64 + mb * 16 + i; } ++pos; }
                }
        }
        lds_fence();
        {
            float w1[16], w2[16];
#pragma unroll
            for (int a = 0; a < 16; ++a) { w1[a] = lv[(r * 2 + 0) * 16 + a]; w2[a] = lv[(r * 2 + 1) * 16 + a]; }
            float m1[8], m2[8]; int i1[8], i2[8], r1[8], r2[8];
#pragma unroll
            for (int x = 0; x < 8; ++x) {
                m1[x] = lv[(r * 2 + 0) * 16 + 8 * hh + x]; m2[x] = lv[(r * 2 + 1) * 16 + 8 * hh + x];
                i1[x] = li[(r * 2 + 0) * 16 + 8 * hh + x]; i2[x] = li[(r * 2 + 1) * 16 + 8 * hh + x];
                unsigned c1 = 0u, c2 = 0u;
#pragma unroll
                for (int a = 0; a < 16; ++a) { c1 += __float_as_uint(m1[x] - w1[a]) >> 31; c2 += __float_as_uint(m2[x] - w2[a]) >> 31; }
                r1[x] = (int)c1; r2[x] = (int)c2;
            }
            int rs = 0;
#pragma unroll
            for (int x = 0; x < 8; ++x) rs += r1[x] + (r2[x] << 8);
            rs += __shfl_xor(rs, 32);
            if (__any(rs != (120 | (120 << 8)))) {
#pragma unroll
                for (int x = 0; x < 8; ++x) { r1[x] = 0; r2[x] = 0; }
#pragma unroll 1
                for (int a = 0; a < 16; ++a) {
                    const float wa1 = lv[(r * 2 + 0) * 16 + a], wa2 = lv[(r * 2 + 1) * 16 + a];
#pragma unroll
                    for (int x = 0; x < 8; ++x) {
                        const int me = 8 * hh + x;
                        r1[x] += (wa1 > m1[x] || (wa1 == m1[x] && a < me)) ? 1 : 0;
                        r2[x] += (wa2 > m2[x] || (wa2 == m2[x] && a < me)) ? 1 : 0;
                    }
                }
            }
            lds_fence();
#pragma unroll
            for (int x = 0; x < 8; ++x) {
                lv[(r * 2 + 0) * 16 + r1[x]] = m1[x]; li[(r * 2 + 0) * 16 + r1[x]] = i1[x];
                lv[(r * 2 + 1) * 16 + r2[x]] = m2[x]; li[(r * 2 + 1) * 16 + r2[x]] = i2[x];
            }
            lds_fence();
        }
        int code[25]; float cv[25];
#pragma unroll
        for (int i = 0; i < 25; ++i) {
            code[i] = PEER_PAIRS[hh * 25 + i];
            cv[i] = lv[(r * 2 + 0) * 16 + (code[i] >> 4)] + lv[(r * 2 + 1) * 16 + (code[i] & 15)];
        }
        float mprev = INFINITY;
#pragma unroll 1
        for (int it = 0; it < 16; ++it) {
            float m = -INFINITY;
#pragma unroll
            for (int i = 0; i < 25; ++i) { const float v = cv[i]; m = fmaxf(m, v < mprev ? v : -INFINITY); }
            m = fmaxf(m, __shfl_xor(m, 32));
            mprev = m;
        }
        const float Tc = mprev;
        int cnt = 0;
#pragma unroll
        for (int i = 0; i < 25; ++i) cnt += (cv[i] >= Tc) ? 1 : 0;
        const int pc = __shfl_xor(cnt, 32);
        int pos = hh ? pc : 0;
#pragma unroll
        for (int i = 0; i < 25; ++i) {
            if (cv[i] >= Tc) { if (pos < 16) { cs[r * 16 + pos] = cv[i]; cab[r * 16 + pos] = code[i]; } ++pos; }
        }
        lds_fence();
        const float rstd = rsqrtf(SSQ[n] * (1.f / DM) + 1e-6f);
        float scv[16]; float mx = -INFINITY;
#pragma unroll
        for (int i = 0; i < 16; ++i) { scv[i] = cs[r * 16 + i]; mx = fmaxf(mx, scv[i]); }
        float sum = 0.f;
#pragma unroll
        for (int i = 0; i < 16; ++i) { scv[i] = expf((scv[i] - mx) * rstd); sum += scv[i]; }
        const float inv = 1.f / sum;
#pragma unroll
        for (int i = 0; i < 16; ++i) {
            if ((i >> 3) == hh) {
                const int ab = cab[r * 16 + i];
                const int e = li[(r * 2 + 0) * 16 + (ab >> 4)] * 128 + li[(r * 2 + 1) * 16 + (ab & 15)];
                const _Float16 gh = (_Float16)(scv[i] * inv);
                EG[(size_t)n * 128 + h * 16 + i] = (unsigned)e | ((unsigned)__builtin_bit_cast(unsigned short, gh) << 16);
            }
        }
        lds_fence();
    }
}

typedef float f32x2 __attribute__((ext_vector_type(2)));
DI void phase_convert_tables(const Params& p) {
    int tz = threadIdx.x; asm volatile("" : "+v"(tz));
    const int wave = tz >> 6, lane = tz & 63;
    for (int rowi = blockIdx.x * NWAVES + wave; rowi < 2 * 16384; rowi += gridDim.x * NWAVES) {
        const bool isv = rowi >= 16384; const int e = isv ? rowi - 16384 : rowi;
        const float* src = (isv ? p.pv : p.pu) + (size_t)e * DM + lane * 16;
        float x[16]; float mx = 0.f;
#pragma unroll
        for (int i = 0; i < 4; ++i) { const float4 a = *(const float4*)(src + i * 4); x[i * 4] = a.x; x[i * 4 + 1] = a.y; x[i * 4 + 2] = a.z; x[i * 4 + 3] = a.w; }
#pragma unroll
        for (int i = 0; i < 16; ++i) mx = fmaxf(mx, fabsf(x[i]));
        mx = wave_max(mx);
        const float top = isv ? 240.f : 127.f;
        const float inv = mx > 0.f ? top / mx : 0.f, scale = mx > 0.f ? mx / top : 0.f;
        u32x4 o;
        if (isv) {
#pragma unroll
            for (int w = 0; w < 4; ++w) {
                int pk = 0;
                pk = __builtin_amdgcn_cvt_pk_fp8_f32(x[w * 4] * inv, x[w * 4 + 1] * inv, pk, false);
                pk = __builtin_amdgcn_cvt_pk_fp8_f32(x[w * 4 + 2] * inv, x[w * 4 + 3] * inv, pk, true);
                o[w] = (unsigned)pk;
            }
        } else {
#pragma unroll
            for (int w = 0; w < 4; ++w) {
                unsigned pk = 0u;
#pragma unroll
                for (int b = 0; b < 4; ++b) { const int q = (int)rintf(x[w * 4 + b] * inv); pk |= ((unsigned)q & 0xffu) << (8 * b); }
                o[w] = pk;
            }
        }
        *(u32x4*)(p.ws + (isv ? OFF_V8 : OFF_U8) + (size_t)e * DM + lane * 16) = o;
        if (lane == 0) ((float*)(p.ws + (isv ? OFF_SV : OFF_SU)))[e] = scale;
    }
}
DI void unpack16_fp8(const u32x4& r, float (&v)[16]) {
#pragma unroll
    for (int w = 0; w < 4; ++w) {
        const f32x2 a = __builtin_amdgcn_cvt_pk_f32_fp8((int)r[w], false), b = __builtin_amdgcn_cvt_pk_f32_fp8((int)r[w], true);
        v[w * 4] = a[0]; v[w * 4 + 1] = a[1]; v[w * 4 + 2] = b[0]; v[w * 4 + 3] = b[1];
    }
}
constexpr int RW_NB = 128, RW_SH = 7;
constexpr int RW_WAVE_LDS = 4 * (RW_NB + 16) * 4 + 4 * 128 * 4 + 4 * 128 * 4;
DI float gelu_as(float v) {
    const float av = fabsf(v), t = __builtin_amdgcn_rcpf(av * 0.2316418882f + 1.0f);
    float q = t * 0.5307027145f + (-0.7265760135f); q = q * t + 0.7107068705f; q = q * t + (-0.142248368f); q = q * t + 0.127414796f; q = q * t;
    const float e = __builtin_amdgcn_exp2f((v * v) * (-0.72134752044f));
    const float m = v * (q * e), r = v - m;
    return v < 0.f ? m : r;
}
DI void phase_peer_out_rows(const Params& p, LAS char* smem) {
    const unsigned* EG = (const unsigned*)(p.ws + OFF_EG);
    const char* U8 = p.ws + OFF_U8; const char* V8 = p.ws + OFF_V8;
    const float* SU = (const float*)(p.ws + OFF_SU); const float* SV = (const float*)(p.ws + OFF_SV);
    const int wave = threadIdx.x >> 6, lane = threadIdx.x & 63, r = lane >> 4, l16 = lane & 15;
    LAS int* cnt = (LAS int*)(smem + wave * RW_WAVE_LDS) + r * (RW_NB + 16);
    LAS int* list_e = (LAS int*)(smem + wave * RW_WAVE_LDS + 4 * (RW_NB + 16) * 4) + r * 128;
    LAS float* list_g = (LAS float*)(smem + wave * RW_WAVE_LDS + 4 * (RW_NB + 16) * 4 + 2048) + r * 128;
    for (int grp = blockIdx.x * NWAVES + wave; grp < NF / 4; grp += gridDim.x * NWAVES) {
        const int n = grp * 4 + r;
        float acc[64]; int hq[16]; float hscale;
        const float* hrow = p.out + (size_t)n * DM + l16 * 16;
        {
            float hn[64];
            float ss = 0.f;
#pragma unroll
            for (int j = 0; j < 4; ++j)
#pragma unroll
                for (int q = 0; q < 4; ++q) { const float4 a = *(const float4*)(hrow + j * 256 + q * 4); hn[j * 16 + q * 4] = a.x; hn[j * 16 + q * 4 + 1] = a.y; hn[j * 16 + q * 4 + 2] = a.z; hn[j * 16 + q * 4 + 3] = a.w; }
#pragma unroll
            for (int i = 0; i < 64; ++i) ss += hn[i] * hn[i];
            ss = dpp_row_sum(ss);
            const float rstd = rsqrtf(ss * (1.f / DM) + 1e-6f);
#pragma unroll
            for (int j = 0; j < 4; ++j)
#pragma unroll
                for (int q = 0; q < 4; ++q) {
                    const float4 a = *(const float4*)(p.norm_ffn + j * 256 + l16 * 16 + q * 4);
                    hn[j * 16 + q * 4] *= rstd * a.x; hn[j * 16 + q * 4 + 1] *= rstd * a.y; hn[j * 16 + q * 4 + 2] *= rstd * a.z; hn[j * 16 + q * 4 + 3] *= rstd * a.w;
                }
            float hm = 0.f;
#pragma unroll
            for (int i = 0; i < 64; ++i) hm = fmaxf(hm, fabsf(hn[i]));
            hm = fmaxf(hm, __int_as_float(__builtin_amdgcn_update_dpp(0, __float_as_int(hm), 0xB1, 0xF, 0xF, true)));
            hm = fmaxf(hm, __int_as_float(__builtin_amdgcn_update_dpp(0, __float_as_int(hm), 0x4E, 0xF, 0xF, true)));
            hm = fmaxf(hm, __int_as_float(__builtin_amdgcn_update_dpp(0, __float_as_int(hm), 0x141, 0xF, 0xF, true)));
            hm = fmaxf(hm, __int_as_float(__builtin_amdgcn_update_dpp(0, __float_as_int(hm), 0x140, 0xF, 0xF, true)));
            const float hinv = hm > 0.f ? 127.f / hm : 0.f; hscale = hm * (1.f / 127.f);
#pragma unroll
            for (int w = 0; w < 16; ++w) {
                unsigned pk = 0u;
#pragma unroll
                for (int b = 0; b < 4; ++b) { const int q = (int)rintf(hn[w * 4 + b] * hinv); pk |= ((unsigned)q & 0xffu) << (8 * b); }
                hq[w] = (int)pk;
            }
#pragma unroll
            for (int i = 0; i < 64; ++i) acc[i] = 0.f;
        }
#pragma unroll
        for (int q = 0; q < RW_NB / 16; ++q) cnt[q * 16 + l16] = 0;
        lds_fence();
        {
            int ek[8], rk[8]; float gk[8];
#pragma unroll
            for (int k = 0; k < 8; ++k) { const unsigned w = EG[(size_t)n * 128 + k * 16 + l16]; ek[k] = (int)(w & 0xffffu); gk[k] = (float)__builtin_bit_cast(_Float16, (unsigned short)(w >> 16)); }
#pragma unroll
            for (int k = 0; k < 8; ++k) rk[k] = __hip_atomic_fetch_add(&cnt[ek[k] >> RW_SH], 1, __ATOMIC_RELAXED, __HIP_MEMORY_SCOPE_WORKGROUP);
            lds_fence();
            {
                constexpr int PB = RW_NB / 16;
                int c[PB], tot = 0;
#pragma unroll
                for (int q = 0; q < PB; ++q) { c[q] = cnt[l16 * PB + q]; tot += c[q]; }
                cnt[RW_NB + l16] = tot;
                lds_fence();
                int base = 0;
#pragma unroll
                for (int q = 0; q < 16; ++q) { const int v = cnt[RW_NB + q]; base += (q < l16) ? v : 0; }
#pragma unroll
                for (int q = 0; q < PB; ++q) { cnt[l16 * PB + q] = base; base += c[q]; }
            }
            lds_fence();
#pragma unroll
            for (int k = 0; k < 8; ++k) { const int pos = cnt[ek[k] >> RW_SH] + rk[k]; list_e[pos] = ek[k]; list_g[pos] = gk[k]; }
        }
        lds_fence();
        {
            u32x4 ub[4], vb[4]; float g_c, su_c, sv_c, g_n = 0.f, su_n = 0.f, sv_n = 0.f;
            {
                const int e_ = list_e[0]; g_c = list_g[0]; su_c = SU[e_]; sv_c = SV[e_];
#pragma unroll
                for (int j = 0; j < 4; ++j) { ub[j] = *(const u32x4*)(U8 + (size_t)e_ * DM + l16 * 16 + j * 256); vb[j] = *(const u32x4*)(V8 + (size_t)e_ * DM + l16 * 16 + j * 256); }
            }
#pragma unroll 1
            for (int sl = 0; sl < 128; ++sl) {
                int isum = 0;
#pragma unroll
                for (int j = 0; j < 4; ++j)
#pragma unroll
                    for (int w = 0; w < 4; ++w) isum = __builtin_amdgcn_sdot4((int)ub[j][w], hq[j * 4 + w], isum, false);
                isum += __builtin_amdgcn_update_dpp(0, isum, 0xB1, 0xF, 0xF, true);
                isum += __builtin_amdgcn_update_dpp(0, isum, 0x4E, 0xF, 0xF, true);
                isum += __builtin_amdgcn_update_dpp(0, isum, 0x141, 0xF, 0xF, true);
                isum += __builtin_amdgcn_update_dpp(0, isum, 0x140, 0xF, 0xF, true);
                float t_ = (float)isum * hscale;
                const int sn = sl + 1 < 128 ? sl + 1 : 127;
                const int e_n = list_e[sn];
                {
                    const char* up_ = U8 + (size_t)e_n * DM + l16 * 16;
#pragma unroll
                    for (int j = 0; j < 4; ++j) ub[j] = *(const u32x4*)(up_ + j * 256);
                    g_n = list_g[sn]; su_n = SU[e_n]; sv_n = SV[e_n];
                }
                t_ *= su_c;
                const float coef_ = gelu_as(t_) * g_c * sv_c;
#pragma unroll
                for (int j = 0; j < 4; ++j) { float v[16]; unpack16_fp8(vb[j], v);
#pragma unroll
                    for (int i = 0; i < 16; ++i) acc[j * 16 + i] += coef_ * v[i]; }
                {
                    const char* vp_ = V8 + (size_t)e_n * DM + l16 * 16;
#pragma unroll
                    for (int j = 0; j < 4; ++j) vb[j] = *(const u32x4*)(vp_ + j * 256);
                }
                g_c = g_n; su_c = su_n; sv_c = sv_n;
            }
        }
        {
            float* orow = p.out + (size_t)n * DM + l16 * 16;
            float s2 = 0.f;
#pragma unroll
            for (int j = 0; j < 4; ++j)
#pragma unroll
                for (int q = 0; q < 4; ++q) { const float4 a = *(const float4*)(orow + j * 256 + q * 4); acc[j * 16 + q * 4] += a.x; acc[j * 16 + q * 4 + 1] += a.y; acc[j * 16 + q * 4 + 2] += a.z; acc[j * 16 + q * 4 + 3] += a.w; }
#pragma unroll
            for (int i = 0; i < 64; ++i) s2 += acc[i] * acc[i];
            s2 = dpp_row_sum(s2);
            float r2 = rsqrtf(s2 * (1.f / DM) + 1e-6f);
#if TP_SEC
            r2 *= 1.f + 0.5f * ((const float*)(p.ws + OFF_BAR))[3602];
#endif
#if defined(DSA_CHECK) || defined(PROJ_CHECK)
            { const float num = ((const float*)(p.ws + OFF_BAR))[3600], den = ((const float*)(p.ws + OFF_BAR))[3601]; r2 *= 1.f + CHK_GAIN * sqrtf(num / fmaxf(den, 1e-30f)); }
#endif
#pragma unroll
            for (int j = 0; j < 4; ++j)
#pragma unroll
                for (int q = 0; q < 4; ++q) {
                    const float4 a = *(const float4*)(p.norm_final + j * 256 + l16 * 16 + q * 4);
                    *(float4*)(orow + j * 256 + q * 4) = make_float4(acc[j * 16 + q * 4] * r2 * a.x, acc[j * 16 + q * 4 + 1] * r2 * a.y, acc[j * 16 + q * 4 + 2] * r2 * a.z, acc[j * 16 + q * 4 + 3] * r2 * a.w);
                }
        }
        lds_fence();
    }
}

DI Params load_params() {
#if defined(__HIP_DEVICE_COMPILE__)
    typedef const __attribute__((address_space(4))) unsigned long long* cu64_t;
    cu64_t pp = (cu64_t)__builtin_amdgcn_kernarg_segment_ptr();
    asm volatile("" : "+s"(pp));
    static_assert(sizeof(Params) == 16 * 8, "Params is 16 qwords");
    unsigned long long w[16];
#pragma unroll
    for (int i = 0; i < 16; ++i) w[i] = pp[i];
#define GPTR(T, v) ((T*)(__attribute__((address_space(1))) T*)(v))
    Params r;
    r.x = GPTR(const float, w[0]); r.meta = GPTR(const float, w[1]); r.norm_mix = GPTR(const float, w[2]); r.w_in = GPTR(const float, w[3]);
    r.w_uv = GPTR(const float, w[4]); r.w_out = GPTR(const float, w[5]); r.norm_ffn = GPTR(const float, w[6]); r.wq = GPTR(const float, w[7]);
    r.sk = GPTR(const float, w[8]); r.pu = GPTR(const float, w[9]); r.pv = GPTR(const float, w[10]); r.norm_final = GPTR(const float, w[11]);
    r.out = GPTR(float, w[12]); r.ws = GPTR(char, w[13]);
    r.lo = (int)(unsigned)w[14]; r.hi = (int)(unsigned)(w[14] >> 32); r.pad0 = 0; r.pad1 = 0;
    return r;
#else
    return Params{};
#endif
}
#ifdef PROJ_CHECK
constexpr int PCH_ROWS = 64;
DI void phase_proj_ref_naive(const Params& p) {
    const bf16_t* hn = (const bf16_t*)(p.ws + OFF_HN); bf16_t* ref = (bf16_t*)(p.ws + OFF_ST);
    const int gtid = blockIdx.x * NTHREADS + threadIdx.x, gsz = gridDim.x * NTHREADS;
    for (int idx = gtid; idx < (PCH_ROWS / 8) * INW; idx += gsz) {
        const int c = idx % INW, r0 = (idx / INW) * 8;
        float acc[8];
#pragma unroll
        for (int i = 0; i < 8; ++i) acc[i] = 0.f;
        for (int k = 0; k < 1024; ++k) {
            const float w = bf2f(f2bf(p.w_in[(size_t)k * INW + c]));
#pragma unroll
            for (int i = 0; i < 8; ++i) { const int t_ = r0 + i; acc[i] += bf2f(hn[(size_t)(t_ < NMETA ? NF + t_ : t_ - NMETA) * DM + k]) * w; }
        }
#pragma unroll
        for (int i = 0; i < 8; ++i) ref[(size_t)(r0 + i) * INW + c] = f2bf(acc[i]);
    }
}
DI void phase_proj_compare(const Params& p) {
    const bf16_t* proj = (const bf16_t*)(p.ws + OFF_BIG); const bf16_t* ref = (const bf16_t*)(p.ws + OFF_ST); const bf16_t* dvt = (const bf16_t*)(p.ws + OFF_DVT);
    const int gtid = blockIdx.x * NTHREADS + threadIdx.x, gsz = gridDim.x * NTHREADS;
    float num = 0.f, den = 0.f;
    for (int idx = gtid; idx < PCH_ROWS * INW; idx += gsz) { const float a = bf2f(proj[idx]), r = bf2f(ref[idx]); num += (a - r) * (a - r); den += r * r; }
    for (int idx = gtid; idx < PCH_ROWS * 128; idx += gsz) {
        const int row = idx >> 7, dv = idx & 127, b = row / TT, t = row - b * TT;
        const float a = bf2f(dvt[(size_t)(b * 128 + dv) * TTP + t]), r = bf2f(ref[(size_t)row * INW + C_DV + dv]); num += (a - r) * (a - r); den += r * r;
    }
    for (int idx = gtid; idx < 7 * NMETA * INW; idx += gsz) {
        const int c = idx % INW, bt = idx / INW, b = 1 + bt / NMETA, t = bt % NMETA;
        const float a = bf2f(proj[(size_t)(b * TT + t) * INW + c]), r = bf2f(ref[(size_t)t * INW + c]); num += (a - r) * (a - r); den += r * r;
    }
    for (int idx = gtid; idx < 7 * NMETA * 128; idx += gsz) {
        const int dv = idx & 127, bt = idx >> 7, b = 1 + bt / NMETA, t = bt % NMETA;
        const float a = bf2f(dvt[(size_t)(b * 128 + dv) * TTP + t]), r = bf2f(ref[(size_t)t * INW + C_DV + dv]); num += (a - r) * (a - r); den += r * r;
    }
    num = wave_sum_uniform(num); den = wave_sum_uniform(den);
    if ((threadIdx.x & 63) == 0) { atomicAdd((float*)(p.ws + OFF_BAR) + 3600, num); atomicAdd((float*)(p.ws + OFF_BAR) + 3601, den); }
}
#endif
constexpr int NPHASES = 10;
__global__ void __launch_bounds__(NTHREADS, 2) mk_forward(Params p) {
    extern __shared__ __attribute__((aligned(16))) char dyn_smem[];
    LAS char* smem = (LAS char*)dyn_smem;
    const bool multi = (p.hi - p.lo) > 1;
    LAS char* tp_smem = smem;
    if (TP_SEC && blockIdx.x == 0 && threadIdx.x == 0) { volatile LAS long long* tp_ = (volatile LAS long long*)(smem + TP_LDS_OFF); tp_[0] = (long long)__builtin_readcyclecounter(); tp_[2] = 0; }
    XcdBarrier bar; bar.bar = (unsigned*)(p.ws + OFF_BAR); bar.x = 0; bar.st = (volatile LAS unsigned*)(smem + LDS_BAR_OFF);
    if (multi) {
        if (threadIdx.x == 0) { const u32x4 z = {0u, 0u, 0u, 0u}; *(LAS u32x4*)(smem + LDS_BAR_OFF) = z; }
        __syncthreads();
        bar = xcd_barrier_post((unsigned*)(p.ws + OFF_BAR), (volatile LAS unsigned*)(smem + LDS_BAR_OFF));
    }
#ifndef PHMASK
#define PHMASK 0xFFFF
#endif
#define PH_ON(i) (((PHMASK >> (i)) & 1) && p.lo <= (i) && (i) < p.hi)
#define PH_SYNC(i) do { if (multi && (i) + 1 < p.hi) { TP_BEGIN(7); xcd_barrier(bar); TP_END(7); } } while (0)
#ifndef REPEAT_MASK
#define REPEAT_MASK 0
#endif
#define PH_REP(i) for (int rep_ = 0; rep_ < 1 + ((REPEAT_MASK >> (i)) & 1); ++rep_)
    if (PH_ON(0)) { const Params q = load_params(); TP_BEGIN(8); PH_REP(0) phase_prologue(q, smem); TP_END(8); PH_SYNC(0); }
    if (PH_ON(1)) { const Params q = load_params(); TP_BEGIN(9); PH_REP(1) { EpiProjRope e; e.P = (bf16_t*)(q.ws + OFF_BIG); e.DVTp = (bf16_t*)(q.ws + OFF_DVT); e.c128 = (const float*)(q.ws + OFF_COS128); e.s128 = (const float*)(q.ws + OFF_SIN128); e.c64 = (const float*)(q.ws + OFF_COS64); e.s64 = (const float*)(q.ws + OFF_SIN64); gemm256<true>((const bf16_t*)(q.ws + OFF_HN), (const bf16_t*)(q.ws + OFF_WINT), 1024, NF / 256, 4096 / 256, (LAS bf16_t*)smem, e); } phase_proj_meta(q, smem); phase_fold_weights(q); TP_END(9); PH_SYNC(1); }
#ifdef ROPE_SEPARATE
    if (PH_ON(2)) { const Params q = load_params(); TP_BEGIN(5); phase_rope(q, smem, (bf16_t*)(q.ws + OFF_BIG), MROWS, true); TP_END(5); PH_SYNC(2); }
#endif
#ifdef PROJ_CHECK
    {   const Params q = load_params();
        phase_proj_ref_naive(q);
        xcd_barrier(bar);
        phase_rope(q, smem, (bf16_t*)(q.ws + OFF_ST), PCH_ROWS, false);
        xcd_barrier(bar);
        phase_proj_compare(q);
        xcd_barrier(bar);
    }
#endif
    if (PH_ON(3)) { const Params q = load_params(); PH_REP(3) {
#ifndef RS_REP
#define RS_REP 1
#endif
#ifndef DSA_REP
#define DSA_REP 1
#endif
            for (int rr_ = 0; rr_ < RS_REP; ++rr_) phase_ret_state_mfma(q, smem);
#ifdef PROJ_CHECK
            {
                bf16_t* mixed_ = (bf16_t*)(q.ws + OFF_HN);
                for (int idx = blockIdx.x * NTHREADS + threadIdx.x; idx < NF * 64; idx += gridDim.x * NTHREADS) { const int row = idx >> 6, c8 = idx & 63; const u32x4 z = {0u, 0u, 0u, 0u}; *(u32x4*)(mixed_ + (size_t)row * DM + 512 + c8 * 8) = z; }
            }
#else
            for (int rr_ = 0; rr_ < DSA_REP; ++rr_) { phase_dsa32(q, smem); __syncthreads(); }
#endif
#ifdef DSA_CHECK
            __syncthreads(); xcd_barrier(bar); phase_dsa_naive<true>(q, smem);
#endif
        } PH_SYNC(3); }
    if (PH_ON(4)) { const Params q = load_params(); TP_BEGIN(6); phase_ret_scan(q); TP_END(6); PH_SYNC(4); }
    if (PH_ON(5)) { const Params q = load_params(); PH_REP(5) phase_ret_out_mfma(q, smem); PH_SYNC(5); }
    if (PH_ON(6)) { const Params q = load_params(); PH_REP(6) {
        EpiOutT e; e.H = q.out; e.X = q.x; e.HG = (bf16_t*)(q.ws + OFF_HG); e.G = q.norm_ffn; e.SSQ = (float*)(q.ws + OFF_SSQ); gemm256<true>(
        (const bf16_t*)(q.ws + OFF_HN), (const bf16_t*)(q.ws + OFF_WOUTT), 1024, NF / 256, 1024 / 256, (LAS bf16_t*)smem, e); }
#ifdef PROJ_CHECK
        phase_convert_tables(q);
#endif
        PH_SYNC(6); }
    if (PH_ON(8)) { const Params q = load_params();
#ifndef PROJ_CHECK
        phase_convert_tables(q);
#endif
        PH_REP(8) { EpiPQ e; e.Q = (float*)(q.ws + OFF_BIG); gemm256<false>((const bf16_t*)(q.ws + OFF_HG), (const bf16_t*)(q.ws + OFF_WQT), 1024, NF / 256, 2048 / 256, (LAS bf16_t*)smem, e); } PH_SYNC(8); }
    if (PH_ON(9)) { const Params q = load_params(); PH_REP(9) { phase_peer_select(q, smem); }
        if (TP_SEC && blockIdx.x == 0 && threadIdx.x == 0) { volatile LAS long long* tp_ = (volatile LAS long long*)(smem + TP_LDS_OFF); const float fr = (float)tp_[2] / (float)((long long)__builtin_readcyclecounter() - tp_[0]); ((float*)(p.ws + OFF_BAR))[3602] = fr; }
        asm volatile("s_waitcnt vmcnt(0)" ::: "memory"); __syncthreads(); }
    if (PH_ON(10)) { const Params q = load_params(); phase_peer_out_rows(q, smem); }
}

extern "C" void kernel_launch(void* const* d_in, const int* in_sizes, int n_in, void* d_out, int out_size, void* d_ws, size_t ws_size, hipStream_t stream) {
    static int grid = 0;
    if (grid == 0) {
        if (n_in != 12 || out_size != NF * DM || ws_size < WS_END) { fprintf(stderr, "kernel_launch: unexpected shapes (n_in %d out %d ws %zu need %zu)\n", n_in, out_size, ws_size, (size_t)WS_END); grid = -1; return; }
        int dev = 0, cus = 0, per_cu = 0;
        if (hipGetDevice(&dev) != hipSuccess || hipDeviceGetAttribute(&cus, hipDeviceAttributeMultiprocessorCount, dev) != hipSuccess) { grid = -1; return; }
        if (hipFuncSetAttribute((const void*)mk_forward, hipFuncAttributeMaxDynamicSharedMemorySize, LDS_BYTES) != hipSuccess) { fprintf(stderr, "kernel_launch: hipFuncSetAttribute failed\n"); grid = -1; return; }
        if (hipOccupancyMaxActiveBlocksPerMultiprocessor(&per_cu, (const void*)mk_forward, NTHREADS, LDS_BYTES) != hipSuccess || per_cu < 1)
            fprintf(stderr, "kernel_launch: occupancy query reports %d blocks per CU\n", per_cu);
        (void)hipGetLastError();
        grid = cus > 0 ? cus : 256;
    }
    if (grid < 0) return;
    Params p{};
    p.x = (const float*)d_in[0]; p.meta = (const float*)d_in[1]; p.norm_mix = (const float*)d_in[2]; p.w_in = (const float*)d_in[3];
    p.w_uv = (const float*)d_in[4]; p.w_out = (const float*)d_in[5]; p.norm_ffn = (const float*)d_in[6]; p.wq = (const float*)d_in[7];
    p.sk = (const float*)d_in[8]; p.pu = (const float*)d_in[9]; p.pv = (const float*)d_in[10]; p.norm_final = (const float*)d_in[11];
    p.out = (float*)d_out; p.ws = (char*)d_ws; p.pad0 = 0; p.pad1 = 0;
    (void)hipMemsetAsync((char*)d_ws + OFF_BAR, 0, 16384, stream);
#if MK_LAUNCHES == 1
    p.lo = 0; p.hi = NPHASES + 1;
    hipLaunchKernelGGL(mk_forward, dim3(grid), dim3(NTHREADS), LDS_BYTES, stream, p);
#else
    for (int ph = 0; ph <= NPHASES; ++ph) { p.lo = ph; p.hi = ph + 1; hipLaunchKernelGGL(mk_forward, dim3(grid), dim3(NTHREADS), LDS_BYTES, stream, p); }
#endif
}
```

```cpp
#include <hip/hip_runtime.h>
#include <stdint.h>
#include <stdio.h>

#ifndef MK_LAUNCHES
#define MK_LAUNCHES 1
#endif

#define DI __device__ __forceinline__
#ifndef TP_SEC
#define TP_SEC 0
#endif
#ifndef CHK_GAIN
#define CHK_GAIN 10.f
#endif
#define TP_LDS_OFF (163840 - 128)
#define TP_BEGIN(k) do { if (TP_SEC == (k) && blockIdx.x == 0 && threadIdx.x == 0) { *(volatile __attribute__((address_space(3))) long long*)(tp_smem + TP_LDS_OFF + 8) = (long long)__builtin_readcyclecounter(); } } while (0)
#define TP_END(k) do { if (TP_SEC == (k) && blockIdx.x == 0 && threadIdx.x == 0) { volatile __attribute__((address_space(3))) long long* tp_ = (volatile __attribute__((address_space(3))) long long*)(tp_smem + TP_LDS_OFF); tp_[2] += (long long)__builtin_readcyclecounter() - tp_[1]; } } while (0)
typedef unsigned short bf16_t;
typedef short bf16x8 __attribute__((ext_vector_type(8)));
typedef float f32x4 __attribute__((ext_vector_type(4)));
typedef float f32x2 __attribute__((ext_vector_type(2)));
typedef unsigned u32x4 __attribute__((ext_vector_type(4)));
typedef unsigned u32x2 __attribute__((ext_vector_type(2)));

constexpr int NB = 8, SEQ = 2048, NMETA = 16, TT = 2064, DM = 1024, INW = 3912;
constexpr int MROWS = NB * TT;
constexpr int MPAD = 16640;
constexpr int NF = NB * SEQ;
constexpr int C_RQ = 0, C_RK = 512, C_RV = 1024, C_RG = 1536, C_DQ = 2048, C_DK = 3072, C_DV = 3200, C_IQ = 3328, C_IK = 3840, C_IW = 3904;
constexpr int NTHREADS = 512, NWAVES = 8;
constexpr int LDS_BYTES = 163840;
constexpr int LDS_BAR_OFF = 163840 - 256;

constexpr size_t al256(size_t x) { return (x + 255) & ~(size_t)255; }
constexpr size_t OFF_BAR = 0;
constexpr size_t OFF_COS128 = 16384;
constexpr size_t OFF_SIN128 = OFF_COS128 + al256((size_t)TT * 64 * 4);
constexpr size_t OFF_COS64 = OFF_SIN128 + al256((size_t)TT * 64 * 4);
constexpr size_t OFF_SIN64 = OFF_COS64 + al256((size_t)TT * 32 * 4);
constexpr size_t OFF_WINT = OFF_SIN64 + al256((size_t)TT * 32 * 4);
constexpr size_t OFF_WOUTT = OFF_WINT + (size_t)4096 * 1024 * 2;
constexpr size_t OFF_WQT = OFF_WOUTT + (size_t)1024 * 1024 * 2;
constexpr size_t OFF_SKH = OFF_WQT + (size_t)2048 * 1024 * 2;
constexpr size_t OFF_SKL = OFF_SKH + (size_t)2048 * 128 * 2;
constexpr int TTP = 2176;
constexpr size_t OFF_WUVT = OFF_SKL + (size_t)2048 * 128 * 2;
constexpr size_t OFF_DVT = OFF_WUVT + (size_t)8 * 64 * 128 * 2;
constexpr size_t OFF_HN = OFF_DVT + (size_t)NB * 128 * TTP * 2;
constexpr size_t OFF_BIG = OFF_HN + (size_t)MPAD * 1024 * 2;
constexpr size_t BIG_BYTES = (size_t)NF * 2048 * 4;
constexpr size_t OFF_ST = OFF_BIG + al256(BIG_BYTES);
constexpr size_t ST_BYTES = (size_t)32 * 34 * 16384 * 4;
constexpr size_t OFF_EG = OFF_ST;
constexpr size_t OFF_U8 = OFF_EG + (size_t)NF * 128 * 4;
constexpr size_t OFF_SU = OFF_U8 + (size_t)16384 * 1024;
constexpr size_t OFF_V8 = OFF_SU + 65536;
constexpr size_t OFF_SV = OFF_V8 + (size_t)16384 * 1024;
constexpr size_t OFF_HG = OFF_SV + 65536;
constexpr size_t OFF_SSQ = OFF_HG + (size_t)NF * 1024 * 2;
constexpr size_t WS_END = OFF_SSQ + (size_t)NF * 4;
static_assert(OFF_ST + ST_BYTES <= WS_END, "retention states fit");
static_assert(WS_END <= (size_t)268435456, "workspace");

struct Params {
    const float *x, *meta, *norm_mix, *w_in, *w_uv, *w_out, *norm_ffn, *wq, *sk, *pu, *pv, *norm_final;
    float* out; char* ws; int lo, hi, pad0, pad1;
};

DI float bf2f(bf16_t v) { return __uint_as_float(((unsigned)v) << 16); }
typedef float f32x2_t __attribute__((ext_vector_type(2)));
typedef __bf16 bf16x2_t __attribute__((ext_vector_type(2)));
DI bf16_t f2bf(float f) { const __bf16 h = (__bf16)f; return __builtin_bit_cast(unsigned short, h); }
DI unsigned pk2bf(float a, float b) { const f32x2_t v = {a, b}; const bf16x2_t h = __builtin_convertvector(v, bf16x2_t); return __builtin_bit_cast(unsigned, h); }
DI float wave_sum(float v) {
#pragma unroll
    for (int o = 32; o > 0; o >>= 1) v += __shfl_xor(v, o);
    return v;
}
DI float wave_max(float v) {
#pragma unroll
    for (int o = 32; o > 0; o >>= 1) v = fmaxf(v, __shfl_xor(v, o));
    return v;
}
DI unsigned long long wave_max_u64(unsigned long long v) {
#pragma unroll
    for (int o = 32; o > 0; o >>= 1) {
        const unsigned hi = __shfl_xor((unsigned)(v >> 32), o), lo = __shfl_xor((unsigned)v, o);
        const unsigned long long w = ((unsigned long long)hi << 32) | lo;
        v = w > v ? w : v;
    }
    return v;
}
DI unsigned fkey(float x) { const unsigned u = __float_as_uint(x); return (u & 0x80000000u) ? ~u : (u | 0x80000000u); }
DI float funkey(unsigned k) { const unsigned u = (k & 0x80000000u) ? (k & 0x7fffffffu) : ~k; return __uint_as_float(u); }
DI void lds_fence() { asm volatile("s_waitcnt lgkmcnt(0)" ::: "memory"); }
DI void unpack8(const u32x4& r, float (&v)[8]) {
    v[0] = __uint_as_float(r.x << 16); v[1] = __uint_as_float(r.x & 0xffff0000u);
    v[2] = __uint_as_float(r.y << 16); v[3] = __uint_as_float(r.y & 0xffff0000u);
    v[4] = __uint_as_float(r.z << 16); v[5] = __uint_as_float(r.z & 0xffff0000u);
    v[6] = __uint_as_float(r.w << 16); v[7] = __uint_as_float(r.w & 0xffff0000u);
}

typedef float f32x16 __attribute__((ext_vector_type(16)));
DI bf16x8 pack8(const float (&x)[8]) {
    u32x4 r;
#pragma unroll
    for (int j = 0; j < 4; ++j) r[j] = pk2bf(x[2 * j], x[2 * j + 1]);
    return __builtin_bit_cast(bf16x8, r);
}
DI bf16x8 pack_hi8(const float (&x)[8], float (&rem)[8]) {
    u32x4 r;
#pragma unroll
    for (int j = 0; j < 4; ++j) { r[j] = pk2bf(x[2 * j], x[2 * j + 1]); rem[2 * j] = x[2 * j] - __uint_as_float(r[j] << 16); rem[2 * j + 1] = x[2 * j + 1] - __uint_as_float(r[j] & 0xffff0000u); }
    return __builtin_bit_cast(bf16x8, r);
}

DI float dpp_row_sum(float v) {
    v += __int_as_float(__builtin_amdgcn_update_dpp(0, __float_as_int(v), 0xB1, 0xF, 0xF, true));
    v += __int_as_float(__builtin_amdgcn_update_dpp(0, __float_as_int(v), 0x4E, 0xF, 0xF, true));
    v += __int_as_float(__builtin_amdgcn_update_dpp(0, __float_as_int(v), 0x141, 0xF, 0xF, true));
    v += __int_as_float(__builtin_amdgcn_update_dpp(0, __float_as_int(v), 0x140, 0xF, 0xF, true));
    return v;
}
DI float wave_sum_uniform(float v) {
    v = dpp_row_sum(v);
    const float a = __int_as_float(__builtin_amdgcn_readlane(__float_as_int(v), 0)), b = __int_as_float(__builtin_amdgcn_readlane(__float_as_int(v), 16));
    const float c = __int_as_float(__builtin_amdgcn_readlane(__float_as_int(v), 32)), d = __int_as_float(__builtin_amdgcn_readlane(__float_as_int(v), 48));
    return (a + b) + (c + d);
}

DI int wave_sum_int(int v) {
    v += __builtin_amdgcn_update_dpp(0, v, 0xB1, 0xF, 0xF, true);
    v += __builtin_amdgcn_update_dpp(0, v, 0x4E, 0xF, 0xF, true);
    v += __builtin_amdgcn_update_dpp(0, v, 0x141, 0xF, 0xF, true);
    v += __builtin_amdgcn_update_dpp(0, v, 0x140, 0xF, 0xF, true);
    return (__builtin_amdgcn_readlane(v, 0) + __builtin_amdgcn_readlane(v, 16)) + (__builtin_amdgcn_readlane(v, 32) + __builtin_amdgcn_readlane(v, 48));
}

#define XB_TMO      128
#define XB_XCNT(j)  (256  + 64 * (j))
#define XB_XSUB(j)  (1280 + 64 * (j))
#define XB_XGEN(j)  (2304 + 64 * (j))
#define XB_TOP      3328
#define XB_TOPGEN   3392
#define XCD_BAR_WORDS 3456
#define XB_SPIN_CAP (1u << 20)
#define LAS __attribute__((address_space(3)))

DI unsigned xb_ld(unsigned* p)              { return __hip_atomic_load(p, __ATOMIC_RELAXED, __HIP_MEMORY_SCOPE_AGENT); }
DI unsigned xb_add(unsigned* p, unsigned v) { return __hip_atomic_fetch_add(p, v, __ATOMIC_RELAXED, __HIP_MEMORY_SCOPE_AGENT); }
DI unsigned xb_xcc_id() { return (unsigned)__builtin_amdgcn_s_getreg((3 << 11) | 20) & 0xFu; }
#define XB_SPIN(cond, bar) do { unsigned _sp = 0; while (cond) { __builtin_amdgcn_s_sleep(1); \
    if ((++_sp & 255u) == 0u) { if (xb_ld(&(bar)[XB_TMO])) break; if (_sp > XB_SPIN_CAP) { atomicAdd(&(bar)[XB_TMO], 1u); break; } } } } while (0)

struct XcdBarrier { unsigned* bar; unsigned x; volatile LAS unsigned* st; };

DI XcdBarrier xcd_barrier_post(unsigned* bar, volatile LAS unsigned* st) {
    XcdBarrier b; b.bar = bar; b.x = xb_xcc_id(); b.st = st;
    if (threadIdx.x == 0) (void)xb_add(&bar[XB_XCNT(b.x)], 1u);
    return b;
}
DI void xcd_barrier_complete(unsigned* bar, unsigned x, unsigned& nloc, unsigned& nx) {
    const unsigned G = gridDim.x * gridDim.y * gridDim.z;
    unsigned sum, cnt, mine, sp = 0u;
    for (;;) {
        sum = 0u; cnt = 0u; mine = 0u;
#pragma unroll
        for (unsigned j = 0; j < 16; ++j) { const unsigned c = xb_ld(&bar[XB_XCNT(j)]); sum += c; cnt += (c > 0u) ? 1u : 0u; mine = (j == x) ? c : mine; }
        if (sum == G) break;
        __builtin_amdgcn_s_sleep(1);
        if ((++sp & 255u) == 0u) { if (xb_ld(&bar[XB_TMO])) break; if (sp > XB_SPIN_CAP) { atomicAdd(&bar[XB_TMO], 1u); break; } }
    }
    nloc = mine > 0u ? mine : 1u; nx = cnt > 0u ? cnt : 1u;
}
DI void xcd_barrier(const XcdBarrier& b) {
    asm volatile("s_waitcnt vmcnt(0)" ::: "memory");
    __syncthreads();
    if (threadIdx.x == 0) {
        unsigned* bar = b.bar;
        __builtin_amdgcn_s_waitcnt(0);
        unsigned nloc = b.st[0], nx = b.st[1];
        if (nloc == 0u) { xcd_barrier_complete(bar, b.x, nloc, nx); b.st[0] = nloc; b.st[1] = nx; }
        const unsigned old = xb_add(&bar[XB_XSUB(b.x)], 1u);
        const unsigned gen = old / nloc;
        if (old + 1u == (gen + 1u) * nloc) {
            __builtin_amdgcn_fence(__ATOMIC_RELEASE, "agent");
            asm volatile("s_waitcnt vmcnt(0)" ::: "memory");
            const unsigned og = xb_add(&bar[XB_TOP], 1u);
            const unsigned tg = og / nx;
            if (og + 1u == (tg + 1u) * nx) xb_add(&bar[XB_TOPGEN], 1u);
            else XB_SPIN(xb_ld(&bar[XB_TOPGEN]) == tg, bar);
            __builtin_amdgcn_fence(__ATOMIC_ACQUIRE, "agent");
            xb_add(&bar[XB_XGEN(b.x)], 1u);
            asm volatile("s_waitcnt vmcnt(0)" ::: "memory");
        } else {
            XB_SPIN(xb_ld(&bar[XB_XGEN(b.x)]) == gen, bar);
            __builtin_amdgcn_fence(__ATOMIC_ACQUIRE, "agent");
            asm volatile("s_waitcnt vmcnt(0)" ::: "memory");
        }
    }
    __syncthreads();
}

constexpr int BM = 256, BK = 64, HALF = 128, NXCD = 8, WGM = 8, HT = HALF * BK;
DI int lds_byte(int r, int c) {
    int st = (r >> 4) * 2 + (c >> 5), rr = r & 15, cc = c & 31, ob = rr * 64 + cc * 2;
    return st * 1024 + (ob ^ (((ob >> 9) & 1) << 5));
}
DI void stage_rc(int b, int& R, int& C) {
    int st = b / 1024, sb = b % 1024, swz = sb ^ (((sb >> 9) & 1) << 5);
    R = (st >> 1) * 16 + swz / 64; C = (st & 1) * 32 + (swz % 64) / 2;
}

#define SA(b,h) (shm+((b)*2+(h))*HT)
#define SB(b,h) (shm+(4+(b)*2+(h))*HT)
#define STAGE_X(T,P,BASE,br,kt) do{long _g=(long)(br)*K+(long)(kt)*BK; \
    for(int _i=0;_i<2;++_i){int _b=(T)*16+_i*8192;int _r,_c;stage_rc(_b,_r,_c); \
      __builtin_amdgcn_global_load_lds((const unsigned*)(BASE+_g+(long)_r*K+_c), \
        (LAS unsigned*)((LAS char*)(P)+_b),16,0,0);}}while(0)
#define STAGE(P,BASE,br,kt) STAGE_X(tst_,P,BASE,br,kt)
#define LDA(dst,b,h) for(int m=0;m<4;++m)for(int k=0;k<2;++k) \
    dst[m][k]=*reinterpret_cast<const LAS bf16x8*>((LAS char*)SA(b,h)+lds_byte(wr*64+m*16+fr,k*32+fq*8))
#define LDB(dst,b,h) for(int n=0;n<2;++n)for(int k=0;k<2;++k) \
    dst[n][k]=*reinterpret_cast<const LAS bf16x8*>((LAS char*)SB(b,h)+lds_byte(wc*32+n*16+fr,k*32+fq*8))
#define MMA(ai,bj,At,Bt_) do{__builtin_amdgcn_s_setprio(1); \
    for(int m=0;m<4;++m)for(int n=0;n<2;++n)for(int k=0;k<2;++k) \
      acc[ai][bj][m][n]=TRANS?__builtin_amdgcn_mfma_f32_16x16x32_bf16(Bt_[n][k],At[m][k],acc[ai][bj][m][n],0,0,0):__builtin_amdgcn_mfma_f32_16x16x32_bf16(At[m][k],Bt_[n][k],acc[ai][bj][m][n],0,0,0); \
    __builtin_amdgcn_s_setprio(0);}while(0)
#define WAIT_V(n) asm volatile("s_waitcnt vmcnt(" #n ")":::"memory")
#define WAIT_L(n) asm volatile("s_waitcnt lgkmcnt(" #n ")":::"memory")
#define BAR __builtin_amdgcn_s_barrier()
#define SCHED __builtin_amdgcn_sched_barrier(0)

template <bool TRANS, class Epi>
DI void gemm256(const bf16_t* __restrict__ A, const bf16_t* __restrict__ Bt, const int K, const int nM, const int nN, LAS bf16_t* shm, const Epi& epi) {
    const int nwg = nM * nN;
    for (int L = blockIdx.x; L < nwg; L += gridDim.x) {
        int wgid = L;
        { int q = nwg / NXCD, r = nwg % NXCD, xcd = wgid % NXCD, off = wgid / NXCD; wgid = (xcd < r ? xcd * (q + 1) : r * (q + 1) + (xcd - r) * q) + off; }
        int nig = WGM * nN, gid = wgid / nig, fm = gid * WGM, gsz = min(nM - fm, WGM);
        int pm = fm + ((wgid % nig) % gsz), pn = (wgid % nig) / gsz, brow = pm * BM, bcol = pn * BM;
#ifdef PROJ_CHECK
        int tst_ = threadIdx.x; asm volatile("" : "+v"(tst_));
#else
        const int tst_ = threadIdx.x;
#endif
        int wid = tst_ >> 6, lane = tst_ & 63, wr = wid >> 2, wc = wid & 3, fr = lane & 15, fq = lane >> 4;
        f32x4 acc[2][2][4][2] = {};
        bf16x8 At[4][2], B0[2][2], B1[2][2];
        int nt = K / BK;
        STAGE(SB(0,0),Bt,bcol,0); STAGE(SA(0,0),A,brow,0);
        STAGE(SB(0,1),Bt,bcol+HALF,0); STAGE(SA(0,1),A,brow+HALF,0);
        if (wr == 1) BAR;
        WAIT_V(4); BAR;
        STAGE(SB(1,0),Bt,bcol,1); STAGE(SA(1,0),A,brow,1); STAGE(SB(1,1),Bt,bcol+HALF,1);
        WAIT_V(6); BAR;
        for (int t = 0; t < nt - 2; t += 2) {
            LDB(B0,0,0); SCHED; LDA(At,0,0); STAGE(SA(1,1),A,brow+HALF,t+1);
            WAIT_L(8); BAR; WAIT_L(0); MMA(0,0,At,B0); BAR; SCHED;
            LDB(B1,0,1); STAGE(SB(0,0),Bt,bcol,t+2);
            BAR; WAIT_L(0); MMA(0,1,At,B1); BAR;
            LDA(At,0,1); STAGE(SA(0,0),A,brow,t+2);
            BAR; WAIT_L(0); MMA(1,0,At,B0); BAR; SCHED;
            STAGE(SB(0,1),Bt,bcol+HALF,t+2);
            WAIT_V(6); BAR; MMA(1,1,At,B1); BAR;
            LDB(B0,1,0); SCHED; LDA(At,1,0); STAGE(SA(0,1),A,brow+HALF,t+2);
            WAIT_L(8); BAR; WAIT_L(0); MMA(0,0,At,B0); BAR; SCHED;
            LDB(B1,1,1); STAGE(SB(1,0),Bt,bcol,t+3);
            BAR; WAIT_L(0); MMA(0,1,At,B1); BAR;
            LDA(At,1,1); STAGE(SA(1,0),A,brow,t+3);
            BAR; WAIT_L(0); MMA(1,0,At,B0); BAR; SCHED;
            STAGE(SB(1,1),Bt,bcol+HALF,t+3);
            WAIT_V(6); BAR; MMA(1,1,At,B1); BAR;
        }
        int tz = threadIdx.x; asm volatile("" : "+v"(tz)); wid = tz >> 6; lane = tz & 63; wr = wid >> 2; wc = wid & 3; fr = lane & 15; fq = lane >> 4;
        { LDB(B0,0,0); WAIT_V(0); LDA(At,0,0); STAGE_X(tz,SA(1,1),A,brow+HALF,nt-1);
          BAR; WAIT_L(0); MMA(0,0,At,B0); BAR;
          LDB(B1,0,1); BAR; WAIT_L(0); MMA(0,1,At,B1); BAR;
          LDA(At,0,1); WAIT_V(4); BAR; WAIT_L(0); MMA(1,0,At,B0); MMA(1,1,At,B1); BAR; }
        { LDB(B0,1,0); LDA(At,1,0); WAIT_V(2); BAR; WAIT_L(0); MMA(0,0,At,B0); BAR;
          LDB(B1,1,1); WAIT_V(0); BAR; WAIT_L(0); MMA(0,1,At,B1); BAR;
          LDA(At,1,1); BAR; WAIT_L(0); MMA(1,0,At,B0); MMA(1,1,At,B1); BAR; }
        if (wr == 0) BAR;
        epi(acc, brow, bcol, wr, wc, fr, fq);
        __syncthreads();
    }
}

struct EpiOut {
    float* H; const float* X;
    DI void operator()(const f32x4 (&acc)[2][2][4][2], int brow, int bcol, int wr, int wc, int fr, int fq) const {
#pragma unroll
        for (int ai = 0; ai < 2; ++ai)
#pragma unroll
        for (int bj = 0; bj < 2; ++bj)
#pragma unroll
        for (int m = 0; m < 4; ++m)
#pragma unroll
        for (int n = 0; n < 2; ++n)
#pragma unroll
        for (int j = 0; j < 4; ++j) {
            const int row = brow + ai * HALF + wr * 64 + m * 16 + fq * 4 + j, col = bcol + bj * HALF + wc * 32 + n * 16 + fr;
            const size_t o = (size_t)row * DM + col; H[o] = X[o] + acc[ai][bj][m][n][j];
        }
    }
};
struct EpiPQ {
    float* Q;
    DI void operator()(const f32x4 (&acc)[2][2][4][2], int brow, int bcol, int wr, int wc, int fr, int fq) const {
#pragma unroll
        for (int ai = 0; ai < 2; ++ai)
#pragma unroll
        for (int bj = 0; bj < 2; ++bj)
#pragma unroll
        for (int m = 0; m < 4; ++m)
#pragma unroll
        for (int n = 0; n < 2; ++n)
#pragma unroll
        for (int j = 0; j < 4; ++j) {
            const int row = brow + ai * HALF + wr * 64 + m * 16 + fq * 4 + j, col = bcol + bj * HALF + wc * 32 + n * 16 + fr;
            Q[(size_t)row * 2048 + col] = acc[ai][bj][m][n][j];
        }
    }
};

struct EpiOutT {
    float* H; const float* X; bf16_t* HG; const float* G; float* SSQ;
    DI void operator()(const f32x4 (&acc)[2][2][4][2], int brow, int bcol, int wr, int wc, int fr, int fq) const {
#pragma unroll
        for (int ai = 0; ai < 2; ++ai)
#pragma unroll
        for (int m = 0; m < 4; ++m) {
            const int row = brow + ai * HALF + wr * 64 + m * 16 + fr;
            const size_t o = (size_t)row * DM + bcol + wc * 32 + fq * 4;
            const float* xp = X + o; float* hp = H + o; bf16_t* gp = HG + o; const float* gn = G + bcol + wc * 32 + fq * 4;
            float ss = 0.f;
#pragma unroll
            for (int bj = 0; bj < 2; ++bj)
#pragma unroll
            for (int n = 0; n < 2; ++n) {
                const f32x4 x = *(const f32x4*)(xp + bj * HALF + n * 16); const f32x4 hv = x + acc[ai][bj][m][n];
                *(f32x4*)(hp + bj * HALF + n * 16) = hv;
                ss += hv[0] * hv[0] + hv[1] * hv[1] + hv[2] * hv[2] + hv[3] * hv[3];
                const f32x4 hg = hv * *(const f32x4*)(gn + bj * HALF + n * 16);
                uint2 w; w.x = pk2bf(hg[0], hg[1]); w.y = pk2bf(hg[2], hg[3]); *(uint2*)(gp + bj * HALF + n * 16) = w;
            }
            ss += __shfl_xor(ss, 16); ss += __shfl_xor(ss, 32);
            if (fq == 0) atomicAdd(SSQ + row, ss);
            __builtin_amdgcn_sched_barrier(0);
        }
    }
};

__host__ __device__ constexpr int proj_true_col(int n) {
    const int blk = n >> 7, P = n & 127, wc = P >> 5, nn = (P >> 4) & 1, i = P & 15;
    return blk * 128 + (blk < 26 ? wc * 16 + i + 64 * nn : (wc >> 1) * 64 + (wc & 1) * 16 + i + 32 * nn);
}
DI bool proj_block(const f32x4 x1, const f32x4 x2, const int cb, const int wc, const int fq, const int t, const float* c128, const float* s128, const float* c64, const float* s64,
                   f32x4& o1, f32x4& o2, int& c1, int& c2, bool& st2) {
    o1 = x1; o2 = x2; st2 = true;
    if (cb < C_IQ) {
        const int f = wc * 16 + fq * 4; c1 = cb + f; c2 = c1 + 64;
        const bool roped = (cb < C_RV) || (cb >= C_DQ && cb < C_DV);
        if (roped) {
            const float sc = (cb < C_RK) ? 1.f : (cb < C_RV) ? 0.08838834764831845f : (cb < C_DK) ? 0.08838834764831845f * 1.4426950408889634f : 1.f;
            const f32x4 cs = *(const f32x4*)(c128 + t * 64 + f), sn = *(const f32x4*)(s128 + t * 64 + f);
            o1 = (x1 * cs - x2 * sn) * sc; o2 = (x2 * cs + x1 * sn) * sc;
        }
        return true;
    }
    if (cb >= 3968) return false;
    const int hl = wc >> 1, f = (wc & 1) * 16 + fq * 4; c1 = cb + hl * 64 + f; c2 = c1 + 32;
    if (cb < C_IK || hl == 0) {
        const float sc = (cb < C_IK) ? 0.125f : 1.f;
        const f32x4 cs = *(const f32x4*)(c64 + t * 32 + f), sn = *(const f32x4*)(s64 + t * 32 + f);
        o1 = (x1 * cs - x2 * sn) * sc; o2 = (x2 * cs + x1 * sn) * sc;
        return true;
    }
    o1 = x1 * 0.35355339059327373f; st2 = false;
    return c1 < INW;
}
struct EpiProjRope {
    bf16_t* P; bf16_t* DVTp; const float *c128, *s128, *c64, *s64;
    DI void operator()(const f32x4 (&acc)[2][2][4][2], int brow, int bcol, int wr, int wc, int fr, int fq) const {
#pragma unroll
        for (int ai = 0; ai < 2; ++ai)
#pragma unroll
        for (int m = 0; m < 4; ++m) {
            const int grow = brow + ai * HALF + wr * 64 + m * 16 + fr;
            const int b = grow >> 11, t = NMETA + (grow & 2047);
            bf16_t* rp = P + (size_t)(b * TT + t) * INW;
#pragma unroll
            for (int bj = 0; bj < 2; ++bj) {
                const int cb = bcol + bj * HALF;
                const f32x4 x1 = acc[ai][bj][m][0], x2 = acc[ai][bj][m][1];
                f32x4 o1, o2; int c1, c2; bool st2;
                if (!proj_block(x1, x2, cb, wc, fq, t, c128, s128, c64, s64, o1, o2, c1, c2, st2)) continue;
                if (cb == C_DV) {
                    bf16_t* dp = DVTp + (size_t)(b * 128 + (c1 - C_DV)) * TTP + t;
#pragma unroll
                    for (int j = 0; j < 4; ++j) { dp[(size_t)j * TTP] = f2bf(x1[j]); dp[(size_t)(64 + j) * TTP] = f2bf(x2[j]); }
                }
                uint2 w1; w1.x = pk2bf(o1[0], o1[1]); w1.y = pk2bf(o1[2], o1[3]); *(uint2*)(rp + c1) = w1;
                if (st2) { uint2 w2; w2.x = pk2bf(o2[0], o2[1]); w2.y = pk2bf(o2[2], o2[3]); *(uint2*)(rp + c2) = w2; }
            }
        }
    }
};

DI void phase_prologue(const Params& p, LAS char* smem) {
    const int gtid = blockIdx.x * NTHREADS + threadIdx.x, gsz = gridDim.x * NTHREADS;
    {
        bf16_t* wint = (bf16_t*)(p.ws + OFF_WINT); bf16_t* woutt_ = (bf16_t*)(p.ws + OFF_WOUTT);
        LAS float* tl = (LAS float*)smem;
        for (int tile = blockIdx.x; tile < 16 * 64 + 16 * 16; tile += gridDim.x) {
            const bool isout = tile >= 16 * 64; const int tt = isout ? tile - 16 * 64 : tile;
            const int ncol = isout ? 16 : 64, k0 = (tt / ncol) * 64, c0 = (tt % ncol) * 64;
            const float* W = isout ? p.w_out : p.w_in; const int ldw = isout ? 1024 : INW, cmax = isout ? 1024 : INW;
            for (int i = threadIdx.x; i < 64 * 64; i += NTHREADS) { const int kk = i >> 6, cc = i & 63; tl[kk * 65 + cc] = (c0 + cc < cmax) ? W[(size_t)(k0 + kk) * ldw + c0 + cc] : 0.f; }
            __syncthreads();
            {
                const int cc = threadIdx.x >> 3, ch = threadIdx.x & 7, tc = c0 + cc;
                int n = tc;
                if (!isout) { const int blk = tc >> 7, T = tc & 127;
                    const int P = blk < 26 ? (((T & 63) >> 4) * 32 + (T >> 6) * 16 + (T & 15)) : ((((T >> 6) * 2 + ((T >> 4) & 1)) * 32) + ((T >> 5) & 1) * 16 + (T & 15));
                    n = blk * 128 + P; }
                u32x4 o;
#pragma unroll
                for (int w = 0; w < 4; ++w) o[w] = pk2bf(tl[(ch * 8 + 2 * w) * 65 + cc], tl[(ch * 8 + 2 * w + 1) * 65 + cc]);
                *(u32x4*)((isout ? woutt_ : wint) + (size_t)n * 1024 + k0 + ch * 8) = o;
            }
            __syncthreads();
        }
    }
    { float* ssq = (float*)(p.ws + OFF_SSQ); for (int idx = gtid; idx < NF; idx += gsz) ssq[idx] = 0.f; }
    {
        bf16_t* dvt = (bf16_t*)(p.ws + OFF_DVT);
        for (int idx = gtid; idx < NB * 128 * (TTP - TT); idx += gsz) { const int rw = idx / (TTP - TT), t = TT + idx % (TTP - TT); dvt[(size_t)rw * TTP + t] = (bf16_t)0; }
    }
    bf16_t* wuvt = (bf16_t*)(p.ws + OFF_WUVT);
    for (int idx = gtid; idx < 8 * 64 * 128; idx += gsz) {
        const int h = idx >> 13, e = (idx >> 7) & 63, dv = idx & 127;
        wuvt[idx] = f2bf(p.w_uv[(size_t)(h * 128 + dv) * 64 + e]);
    }
    float* c128 = (float*)(p.ws + OFF_COS128); float* s128 = (float*)(p.ws + OFF_SIN128);
    for (int idx = gtid; idx < TT * 64; idx += gsz) {
        const int pos = idx >> 6, j = idx & 63;
        const float inv = powf(10000.f, -(float)j * 2.0f / 128.f);
        const float ang = (float)pos * inv;
        float s, c; sincosf(ang, &s, &c);
        c128[idx] = c; s128[idx] = s;
    }
    float* c64 = (float*)(p.ws + OFF_COS64); float* s64 = (float*)(p.ws + OFF_SIN64);
    for (int idx = gtid; idx < TT * 32; idx += gsz) {
        const int pos = idx >> 5, j = idx & 31;
        const float inv = powf(10000.f, -(float)j * 2.0f / 64.f);
        const float ang = (float)pos * inv;
        float s, c; sincosf(ang, &s, &c);
        c64[idx] = c; s64[idx] = s;
    }
    bf16_t* hn = (bf16_t*)(p.ws + OFF_HN);
    const int wave = threadIdx.x >> 6, lane = threadIdx.x & 63;
    for (int row = blockIdx.x * NWAVES + wave; row < MPAD; row += gridDim.x * NWAVES) {
        bf16_t* o = hn + (size_t)row * DM;
        if (row >= NF + NMETA) {
            for (int i = 0; i < 4; ++i) *(uint2*)(o + i * 256 + lane * 4) = make_uint2(0u, 0u);
            continue;
        }
        const float* src = row < NF ? p.x + (size_t)row * DM : p.meta + (size_t)(row - NF) * DM;
        float4 v[4]; float ss = 0.f;
#pragma unroll
        for (int i = 0; i < 4; ++i) { v[i] = *(const float4*)(src + i * 256 + lane * 4); ss += v[i].x * v[i].x + v[i].y * v[i].y + v[i].z * v[i].z + v[i].w * v[i].w; }
        ss = wave_sum(ss);
        const float rstd = rsqrtf(ss * (1.f / DM) + 1e-6f);
#pragma unroll
        for (int i = 0; i < 4; ++i) {
            const float4 g = *(const float4*)(p.norm_mix + i * 256 + lane * 4);
            uint2 w;
            w.x = (unsigned)f2bf(v[i].x * rstd * g.x) | ((unsigned)f2bf(v[i].y * rstd * g.y) << 16);
            w.y = (unsigned)f2bf(v[i].z * rstd * g.z) | ((unsigned)f2bf(v[i].w * rstd * g.w) << 16);
            *(uint2*)(o + i * 256 + lane * 4) = w;
        }
    }
}

DI void phase_fold_weights(const Params& p) {
    {
        bf16_t* wst = (bf16_t*)(p.ws + OFF_WQT);
        int tz_ = threadIdx.x; asm volatile("" : "+v"(tz_));
        const int wave_ = tz_ >> 6, lane_ = tz_ & 63, r = lane_ & 31, hh = lane_ >> 5;
        const int skip_ = 0;
        if ((int)blockIdx.x >= skip_)
        for (int task = ((int)blockIdx.x - skip_) * NWAVES + wave_; task < 16 * 32 * 4; task += ((int)gridDim.x - skip_) * NWAVES) {
            const int nb = task & 3, hf = task >> 7, k0 = ((task >> 2) & 31) * 32;
            f32x16 acc;
#pragma unroll
            for (int i = 0; i < 16; ++i) acc[i] = 0.f;
            const float* arow = p.wq + (size_t)(k0 + r) * 2048 + hf * 128 + 8 * hh;
            const float* brow = p.sk + (size_t)(hf * 128 + nb * 32 + r) * 128 + 8 * hh;
#pragma unroll 2
            for (int ks = 0; ks < 8; ++ks) {
                const float4 a0 = *(const float4*)(arow + ks * 16), a1 = *(const float4*)(arow + ks * 16 + 4);
                const float4 b0 = *(const float4*)(brow + ks * 16), b1 = *(const float4*)(brow + ks * 16 + 4);
                const float af[8] = {a0.x, a0.y, a0.z, a0.w, a1.x, a1.y, a1.z, a1.w}; float ar[8];
                const float bf_[8] = {b0.x, b0.y, b0.z, b0.w, b1.x, b1.y, b1.z, b1.w}; float br[8];
                const bf16x8 ah = pack_hi8(af, ar); const bf16x8 al = pack8(ar);
                const bf16x8 bh = pack_hi8(bf_, br); const bf16x8 bl = pack8(br);
                acc = __builtin_amdgcn_mfma_f32_32x32x16_bf16(ah, bh, acc, 0, 0, 0);
                acc = __builtin_amdgcn_mfma_f32_32x32x16_bf16(ah, bl, acc, 0, 0, 0);
                acc = __builtin_amdgcn_mfma_f32_32x32x16_bf16(al, bh, acc, 0, 0, 0);
            }
            bf16_t* orow = wst + (size_t)(hf * 128 + nb * 32 + r) * 1024 + k0 + 4 * hh;
#pragma unroll
            for (int g4 = 0; g4 < 4; ++g4) { uint2 w; w.x = pk2bf(acc[4 * g4], acc[4 * g4 + 1]); w.y = pk2bf(acc[4 * g4 + 2], acc[4 * g4 + 3]); *(uint2*)(orow + 8 * g4) = w; }
        }
    }
}

DI void rope8(bf16_t* p1, bf16_t* p2, const float* ct, const float* st, float scale) {
    const u32x4 r1 = *(const u32x4*)p1, r2 = *(const u32x4*)p2;
    float x1[8], x2[8]; unpack8(r1, x1); unpack8(r2, x2);
    const float4 c0 = *(const float4*)ct, c1 = *(const float4*)(ct + 4), s0 = *(const float4*)st, s1 = *(const float4*)(st + 4);
    const float cs[8] = {c0.x, c0.y, c0.z, c0.w, c1.x, c1.y, c1.z, c1.w}, sn[8] = {s0.x, s0.y, s0.z, s0.w, s1.x, s1.y, s1.z, s1.w};
    u32x4 o1, o2;
#pragma unroll
    for (int i = 0; i < 4; ++i) {
        const float a0 = (x1[2 * i] * cs[2 * i] - x2[2 * i] * sn[2 * i]) * scale, a1 = (x1[2 * i + 1] * cs[2 * i + 1] - x2[2 * i + 1] * sn[2 * i + 1]) * scale;
        const float b0 = (x2[2 * i] * cs[2 * i] + x1[2 * i] * sn[2 * i]) * scale, b1 = (x2[2 * i + 1] * cs[2 * i + 1] + x1[2 * i + 1] * sn[2 * i + 1]) * scale;
        o1[i] = (unsigned)f2bf(a0) | ((unsigned)f2bf(a1) << 16); o2[i] = (unsigned)f2bf(b0) | ((unsigned)f2bf(b1) << 16);
    }
    *(u32x4*)p1 = o1; *(u32x4*)p2 = o2;
}
DI void phase_rope(const Params& p, LAS char* smem, bf16_t* proj, const int nrows, const bool do_dvt) {
    const float* c128 = (const float*)(p.ws + OFF_COS128); const float* s128 = (const float*)(p.ws + OFF_SIN128);
    const float* c64 = (const float*)(p.ws + OFF_COS64); const float* s64 = (const float*)(p.ws + OFF_SIN64);
    const int gtid = blockIdx.x * NTHREADS + threadIdx.x, gsz = gridDim.x * NTHREADS;
    const int total = nrows * 173;
    for (int idx = gtid; idx < total; idx += gsz) {
        const int row = idx / 173, it = idx - row * 173;
        const int t = row % TT;
        bf16_t* pr = proj + (size_t)row * INW;
        if (it < 32)       { const int hd = it >> 3, j = (it & 7) * 8;          rope8(pr + C_RQ + hd * 128 + j, pr + C_RQ + hd * 128 + 64 + j, c128 + t * 64 + j, s128 + t * 64 + j, 1.f); }
        else if (it < 64)  { const int i2 = it - 32, hd = i2 >> 3, j = (i2 & 7) * 8;  rope8(pr + C_RK + hd * 128 + j, pr + C_RK + hd * 128 + 64 + j, c128 + t * 64 + j, s128 + t * 64 + j, 0.08838834764831845f); }
        else if (it < 128) { const int i2 = it - 64, hd = i2 >> 3, j = (i2 & 7) * 8;  rope8(pr + C_DQ + hd * 128 + j, pr + C_DQ + hd * 128 + 64 + j, c128 + t * 64 + j, s128 + t * 64 + j, 0.08838834764831845f * 1.4426950408889634f); }
        else if (it < 136) { const int j = (it - 128) * 8;                          rope8(pr + C_DK + j, pr + C_DK + 64 + j, c128 + t * 64 + j, s128 + t * 64 + j, 1.f); }
        else if (it < 168) { const int i2 = it - 136, hd = i2 >> 2, j = (i2 & 3) * 8; rope8(pr + C_IQ + hd * 64 + j, pr + C_IQ + hd * 64 + 32 + j, c64 + t * 32 + j, s64 + t * 32 + j, 0.125f); }
        else if (it < 172) { const int j = (it - 168) * 8;                          rope8(pr + C_IK + j, pr + C_IK + 32 + j, c64 + t * 32 + j, s64 + t * 32 + j, 1.f); }
        else {
            const u32x4 r = *(const u32x4*)(pr + C_IW); float v[8]; unpack8(r, v); u32x4 o;
#pragma unroll
            for (int i = 0; i < 4; ++i) o[i] = (unsigned)f2bf(v[2 * i] * 0.35355339059327373f) | ((unsigned)f2bf(v[2 * i + 1] * 0.35355339059327373f) << 16);
            *(u32x4*)(pr + C_IW) = o;
        }
    }
    if (!do_dvt) return;
    bf16_t* dvt = (bf16_t*)(p.ws + OFF_DVT);
    LAS bf16_t* tile = (LAS bf16_t*)smem;
    for (int unit = blockIdx.x; unit < NB * (TTP / 64); unit += gridDim.x) {
        const int b = unit / (TTP / 64), t0 = (unit % (TTP / 64)) * 64;
        for (int i = threadIdx.x; i < 64 * 16; i += NTHREADS) {
            const int tr = i >> 4, ch = i & 15, t = t0 + tr;
            u32x4 v = {0u, 0u, 0u, 0u};
            if (t < TT) v = *(const u32x4*)(proj + (size_t)(b * TT + t) * INW + C_DV + ch * 8);
            *(LAS u32x4*)(tile + tr * 136 + ch * 8) = v;
        }
        __syncthreads();
        for (int i = threadIdx.x; i < 128 * 8; i += NTHREADS) {
            const int dv = i >> 3, ch = i & 7;
            u32x4 o;
#pragma unroll
            for (int w = 0; w < 4; ++w) o[w] = (unsigned)tile[(ch * 8 + 2 * w) * 136 + dv] | ((unsigned)tile[(ch * 8 + 2 * w + 1) * 136 + dv] << 16);
            *(u32x4*)(dvt + (size_t)(b * 128 + dv) * TTP + t0 + ch * 8) = o;
        }
        __syncthreads();
    }
}

#define MFMA16(a, b, c) __builtin_amdgcn_mfma_f32_16x16x32_bf16((a), (b), (c), 0, 0, 0)
#define MFMA32(a, b, c) __builtin_amdgcn_mfma_f32_32x32x16_bf16((a), (b), (c), 0, 0, 0)
DI void phase_proj_meta(const Params& p, LAS char* smem) {
    const bf16_t* hn = (const bf16_t*)(p.ws + OFF_HN) + (size_t)NF * DM;
    const bf16_t* wint = (const bf16_t*)(p.ws + OFF_WINT);
    bf16_t* proj = (bf16_t*)(p.ws + OFF_BIG); bf16_t* dvt = (bf16_t*)(p.ws + OFF_DVT);
    const float* c128 = (const float*)(p.ws + OFF_COS128); const float* s128 = (const float*)(p.ws + OFF_SIN128);
    const float* c64 = (const float*)(p.ws + OFF_COS64); const float* s64 = (const float*)(p.ws + OFF_SIN64);
    int tz = threadIdx.x; asm volatile("" : "+v"(tz));
    const int wave = tz >> 6, lane = tz & 63, c = lane & 15, g = lane >> 4;
    LAS f32x4* red = (LAS f32x4*)smem;
    const int first = gridDim.x >= 64 ? 16 : 0;
    for (int blk = (int)blockIdx.x - first; blk >= 0 && blk < 31; blk += (int)gridDim.x) {
        const int cb = blk * 128;
        const bf16_t* yrow = hn + (size_t)c * DM + wave * 128 + 8 * g;
        const bf16_t* xrow = wint + (size_t)(cb + c) * DM + wave * 128 + 8 * g;
        f32x4 acc[8];
#pragma unroll
        for (int q = 0; q < 8; ++q) acc[q] = (f32x4){0.f, 0.f, 0.f, 0.f};
#pragma unroll
        for (int ks = 0; ks < 4; ++ks) {
            const bf16x8 y = *(const bf16x8*)(yrow + ks * 32);
#pragma unroll
            for (int q = 0; q < 8; ++q) acc[q] = MFMA16(*(const bf16x8*)(xrow + (size_t)(q * 16) * DM + ks * 32), y, acc[q]);
        }
#pragma unroll
        for (int q = 0; q < 8; ++q) red[(wave * 8 + q) * 64 + lane] = acc[q];
        __syncthreads();
        if (wave < 4) {
            f32x4 a1 = {0.f, 0.f, 0.f, 0.f}, a2 = {0.f, 0.f, 0.f, 0.f};
#pragma unroll
            for (int w = 0; w < 8; ++w) { a1 += red[(w * 8 + 2 * wave) * 64 + lane]; a2 += red[(w * 8 + 2 * wave + 1) * 64 + lane]; }
            const int t = c;
            f32x4 o1, o2; int c1, c2; bool st2;
            if (proj_block(a1, a2, cb, wave, g, t, c128, s128, c64, s64, o1, o2, c1, c2, st2)) {
                uint2 w1, w2; w1.x = pk2bf(o1[0], o1[1]); w1.y = pk2bf(o1[2], o1[3]); w2.x = pk2bf(o2[0], o2[1]); w2.y = pk2bf(o2[2], o2[3]);
#pragma unroll
                for (int b = 0; b < NB; ++b) {
                    bf16_t* rp = proj + (size_t)(b * TT + t) * INW;
                    *(uint2*)(rp + c1) = w1; if (st2) *(uint2*)(rp + c2) = w2;
                    if (cb == C_DV) {
                        bf16_t* dp = dvt + (size_t)(b * 128 + (c1 - C_DV)) * TTP + t;
#pragma unroll
                        for (int j = 0; j < 4; ++j) { dp[(size_t)j * TTP] = f2bf(a1[j]); dp[(size_t)(64 + j) * TTP] = f2bf(a2[j]); }
                    }
                }
            }
        }
        __syncthreads();
    }
}

constexpr int DSA_WAVE_LDS = 2176 * 4 + 1024 * 4 + 256 * 4 + 64;
template <bool CHECK>
DI void phase_dsa_naive(const Params& p, LAS char* smem) {
    const bf16_t* proj = (const bf16_t*)(p.ws + OFF_BIG);
    bf16_t* mixed = (bf16_t*)(p.ws + OFF_HN);
    const int wave = threadIdx.x >> 6, lane = threadIdx.x & 63;
    LAS float* sSc = (LAS float*)(smem + wave * DSA_WAVE_LDS);
    LAS float* sQ = sSc + 2176;
    LAS int* sSel = (LAS int*)(sQ + 1024);
    LAS float* sIw = (LAS float*)(sSel + 256);
    const unsigned long long lt_mask = (1ull << lane) - 1ull;
    float chk_num = 0.f, chk_den = 0.f;
    for (int q = blockIdx.x * NWAVES + wave; q < NF; q += gridDim.x * NWAVES) {
        const int b = q >> 11, s = q & 2047, t = NMETA + s;
        const int nk = 80 + 64 * (s >> 6);
        const bf16_t* prow = proj + (size_t)(b * TT + t) * INW;
        for (int i = lane; i < 512; i += 64) sQ[i] = bf2f(prow[C_IQ + i]);
        if (lane < 8) sIw[lane] = bf2f(prow[C_IW + lane]);
        lds_fence();
        const bf16_t* ikbase = proj + (size_t)(b * TT) * INW + C_IK;
        const int nj = (nk + 63) >> 6;
        for (int jj = 0; jj < nj; ++jj) {
            const int k = jj * 64 + lane;
            float sc = 0.f;
            if (k < nk) {
                const bf16_t* kr = ikbase + (size_t)k * INW;
                float a[8];
#pragma unroll
                for (int h = 0; h < 8; ++h) a[h] = 0.f;
#pragma unroll 1
                for (int d8 = 0; d8 < 8; ++d8) {
                    const u32x4 raw = *(const u32x4*)(kr + d8 * 8); float kv[8]; unpack8(raw, kv);
#pragma unroll
                    for (int h = 0; h < 8; ++h) {
                        const f32x4 q0 = *(const LAS f32x4*)(sQ + h * 64 + d8 * 8), q1 = *(const LAS f32x4*)(sQ + h * 64 + d8 * 8 + 4);
                        a[h] += kv[0] * q0[0] + kv[1] * q0[1] + kv[2] * q0[2] + kv[3] * q0[3] + kv[4] * q1[0] + kv[5] * q1[1] + kv[6] * q1[2] + kv[7] * q1[3];
                    }
                }
#pragma unroll
                for (int h = 0; h < 8; ++h) sc += fmaxf(a[h], 0.f) * sIw[h];
                sc += 0.0f;
            }
            sSc[k] = sc;
        }
        lds_fence();
        int L;
        if (nk <= 256) {
            for (int i = lane; i < nk; i += 64) sSel[i] = i;
            L = nk;
        } else {
            unsigned Tkey = 0u;
            for (int bit = 31; bit >= 0; --bit) {
                const unsigned cand = Tkey | (1u << bit);
                int cnt = 0;
                for (int jj = 0; jj < nj; ++jj) {
                    const int k = jj * 64 + lane;
                    const unsigned key = (k < nk) ? fkey(sSc[k]) : 0u;
                    cnt += __popcll(__ballot(key >= cand));
                }
                if (cnt >= 256) Tkey = cand;
            }
            int cgt = 0;
            for (int jj = 0; jj < nj; ++jj) {
                const int k = jj * 64 + lane;
                const unsigned key = (k < nk) ? fkey(sSc[k]) : 0u;
                cgt += __popcll(__ballot(key > Tkey));
            }
            const int need = 256 - cgt;
            int pos = 0, eqseen = 0;
            for (int jj = 0; jj < nj; ++jj) {
                const int k = jj * 64 + lane;
                const unsigned key = (k < nk) ? fkey(sSc[k]) : 0u;
                const bool gt = key > Tkey, eq = (key == Tkey);
                const unsigned long long eqm = __ballot(eq);
                const int myeq = eqseen + __popcll(eqm & lt_mask);
                const bool sel = gt || (eq && myeq < need);
                const unsigned long long sm = __ballot(sel);
                if (sel) sSel[pos + __popcll(sm & lt_mask)] = k;
                pos += __popcll(sm); eqseen += __popcll(eqm);
            }
            L = 256;
        }
        lds_fence();
        for (int i = lane; i < 1024; i += 64) sQ[i] = bf2f(prow[C_DQ + i]);
        lds_fence();
        float sc[8][4];
        const bf16_t* dkbase = proj + (size_t)(b * TT) * INW + C_DK;
#pragma unroll
        for (int il = 0; il < 4; ++il) {
            const int i = lane + 64 * il; const bool ok = i < L; const int key = ok ? sSel[i] : 0;
            const bf16_t* kr = dkbase + (size_t)key * INW;
            float a[8];
#pragma unroll
            for (int h = 0; h < 8; ++h) a[h] = 0.f;
#pragma unroll 1
            for (int d8 = 0; d8 < 16; ++d8) {
                const u32x4 raw = *(const u32x4*)(kr + d8 * 8); float kv[8]; unpack8(raw, kv);
#pragma unroll
                for (int h = 0; h < 8; ++h) {
                    const f32x4 q0 = *(const LAS f32x4*)(sQ + h * 128 + d8 * 8), q1 = *(const LAS f32x4*)(sQ + h * 128 + d8 * 8 + 4);
                    a[h] += kv[0] * q0[0] + kv[1] * q0[1] + kv[2] * q0[2] + kv[3] * q0[3] + kv[4] * q1[0] + kv[5] * q1[1] + kv[6] * q1[2] + kv[7] * q1[3];
                }
            }
#pragma unroll
            for (int h = 0; h < 8; ++h) sc[h][il] = ok ? a[h] : -INFINITY;
        }
#pragma unroll
        for (int h = 0; h < 8; ++h) {
            float m = fmaxf(fmaxf(sc[h][0], sc[h][1]), fmaxf(sc[h][2], sc[h][3]));
            m = wave_max(m);
            float e[4], sum = 0.f;
#pragma unroll
            for (int il = 0; il < 4; ++il) { e[il] = exp2f(sc[h][il] - m); sum += e[il]; }
            sum = wave_sum(sum);
            const float inv = 1.f / sum;
#pragma unroll
            for (int il = 0; il < 4; ++il) sSc[h * 256 + lane + 64 * il] = e[il] * inv;
        }
        lds_fence();
        float o[8][2];
#pragma unroll
        for (int h = 0; h < 8; ++h) { o[h][0] = 0.f; o[h][1] = 0.f; }
        const bf16_t* dvbase = proj + (size_t)(b * TT) * INW + C_DV;
        for (int i = 0; i < L; ++i) {
            const int key = sSel[i];
            const float v0 = bf2f(dvbase[(size_t)key * INW + lane]), v1 = bf2f(dvbase[(size_t)key * INW + 64 + lane]);
#pragma unroll
            for (int h = 0; h < 8; ++h) { const float pv = sSc[h * 256 + i]; o[h][0] += pv * v0; o[h][1] += pv * v1; }
        }
        lds_fence();
#pragma unroll
        for (int h = 0; h < 8; ++h) { sQ[h * 128 + lane] = o[h][0]; sQ[h * 128 + 64 + lane] = o[h][1]; }
        lds_fence();
        for (int h = 0; h < 8; ++h) {
            float acc = 0.f;
            const float* wu = p.w_uv + (size_t)h * 128 * 64 + lane;
            for (int c = 0; c < 128; ++c) acc += sQ[h * 128 + c] * wu[c * 64];
            if (CHECK) { const float got = bf2f(mixed[(size_t)q * DM + 512 + h * 64 + lane]); chk_num += (got - acc) * (got - acc); chk_den += acc * acc; }
            else mixed[(size_t)q * DM + 512 + h * 64 + lane] = f2bf(acc);
        }
        lds_fence();
    }
    if (CHECK) {
        chk_num = wave_sum(chk_num); chk_den = wave_sum(chk_den);
        if (lane == 0) { atomicAdd((float*)(p.ws + OFF_BAR) + 3600, chk_num); atomicAdd((float*)(p.ws + OFF_BAR) + 3601, chk_den); }
    }
}

typedef unsigned long long u64;
typedef short s16x4 __attribute__((ext_vector_type(4)));
constexpr int SCLD = 2116;
constexpr int DSA_MASK_OFF = 16 * SCLD * 4;
constexpr int KLD = 136, VLD = 72, VLD2 = 136;
constexpr int DSA_VT_OFF = 128 * KLD * 2;
DI void phase_dsa_fast(const Params& p, LAS char* smem) {
    const bf16_t* proj = (const bf16_t*)(p.ws + OFF_BIG);
    const bf16_t* dvt = (const bf16_t*)(p.ws + OFF_DVT);
    const bf16_t* wuvt = (const bf16_t*)(p.ws + OFF_WUVT);
    bf16_t* mixed = (bf16_t*)(p.ws + OFF_HN);
    const int wave = threadIdx.x >> 6, lane = threadIdx.x & 63, c = lane & 15, g = lane >> 4;
    LAS float* SC = (LAS float*)smem; LAS u64* MASK = (LAS u64*)(smem + DSA_MASK_OFF);
    LAS bf16_t* KT = (LAS bf16_t*)smem; LAS bf16_t* VT = (LAS bf16_t*)(smem + DSA_VT_OFF);
    const u64 lt_mask = (1ull << lane) - 1ull;
    for (int pi = blockIdx.x; pi < 512; pi += gridDim.x)
    for (int which = 0; which < 2; ++which) {
        const int b = pi >> 6, qq = pi & 63, qt = which ? 127 - qq : qq;
        const int s0 = qt * 16, nk = 80 + 64 * (s0 >> 6), nkt = nk >> 4, nj = (nk + 63) >> 6;
        const bf16_t* pb = proj + (size_t)(b * TT) * INW;
        LAS char* tp_smem = smem; TP_BEGIN(1);
        {
            const bf16_t* qrow = pb + (size_t)(NMETA + s0 + c) * INW;
            bf16x8 bq[8][2]; float iw[8];
#pragma unroll
            for (int h = 0; h < 8; ++h) {
                bq[h][0] = *(const bf16x8*)(qrow + C_IQ + h * 64 + 8 * g);
                bq[h][1] = *(const bf16x8*)(qrow + C_IQ + h * 64 + 32 + 8 * g);
                iw[h] = bf2f(qrow[C_IW + h]);
            }
            bf16x8 a0n = {0, 0, 0, 0, 0, 0, 0, 0}, a1n = {0, 0, 0, 0, 0, 0, 0, 0};
            if (wave < nkt) { const bf16_t* krow = pb + (size_t)(wave * 16 + c) * INW + C_IK + 8 * g; a0n = *(const bf16x8*)(krow); a1n = *(const bf16x8*)(krow + 32); }
            for (int kt = wave; kt < nkt; kt += NWAVES) {
                const bf16x8 a0 = a0n, a1 = a1n;
                if (kt + NWAVES < nkt) { const bf16_t* krow = pb + (size_t)((kt + NWAVES) * 16 + c) * INW + C_IK + 8 * g; a0n = *(const bf16x8*)(krow); a1n = *(const bf16x8*)(krow + 32); }
                f32x4 isc = {0.f, 0.f, 0.f, 0.f};
#pragma unroll
                for (int h = 0; h < 8; ++h) {
                    f32x4 acc = {0.f, 0.f, 0.f, 0.f};
                    acc = MFMA16(a0, bq[h][0], acc); acc = MFMA16(a1, bq[h][1], acc);
#pragma unroll
                    for (int j = 0; j < 4; ++j) isc[j] += fmaxf(acc[j], 0.f) * iw[h];
                }
#pragma unroll
                for (int j = 0; j < 4; ++j) isc[j] += 0.0f;
                *(LAS f32x4*)(SC + c * SCLD + kt * 16 + 4 * g) = isc;
            }
            {
                const int tail = ((nj <= 11 ? 11 : (nj <= 22 ? 22 : 33)) << 6) - nk;
                for (int i = threadIdx.x; i < 16 * tail; i += NTHREADS) { const int qq_ = i / tail; SC[qq_ * SCLD + nk + (i - qq_ * tail)] = -3.0e38f; }
            }
        }
        __syncthreads(); TP_END(1); TP_BEGIN(2);
#pragma unroll 1
        for (int qi = 0; qi < 2; ++qi) {
            const int cq = wave * 2 + qi;
            unsigned kv[33];
#pragma unroll
            for (int jj = 0; jj < 11; ++jj) kv[jj] = fkey(SC[cq * SCLD + jj * 64 + lane]);
            if (nj > 11) {
#pragma unroll
                for (int jj = 11; jj < 22; ++jj) kv[jj] = fkey(SC[cq * SCLD + jj * 64 + lane]);
            } else {
#pragma unroll
                for (int jj = 11; jj < 22; ++jj) kv[jj] = 0u;
            }
            if (nj > 22) {
#pragma unroll
                for (int jj = 22; jj < 33; ++jj) kv[jj] = fkey(SC[cq * SCLD + jj * 64 + lane]);
            } else {
#pragma unroll
                for (int jj = 22; jj < 33; ++jj) kv[jj] = 0u;
            }
            unsigned Tkey = 1u;
            if (nk > 256) {
                Tkey = 0u;
#pragma unroll 1
                for (int bit = 31; bit >= 0; --bit) {
                    const unsigned cand = Tkey | (1u << bit);
                    int nl = 0;
#pragma unroll
                    for (int jj = 0; jj < 11; ++jj) nl += (kv[jj] >= cand) ? 1 : 0;
                    if (nj > 11) {
#pragma unroll
                        for (int jj = 11; jj < 22; ++jj) nl += (kv[jj] >= cand) ? 1 : 0;
                    }
                    if (nj > 22) {
#pragma unroll
                        for (int jj = 22; jj < 33; ++jj) nl += (kv[jj] >= cand) ? 1 : 0;
                    }
                    const int cnt = wave_sum_int(nl);
                    if (cnt >= 256) Tkey = cand;
                    if (cnt == 256) break;
                }
            }
            int cgl = 0;
#pragma unroll
            for (int jj = 0; jj < 33; ++jj) cgl += (kv[jj] > Tkey) ? 1 : 0;
            const int cgt = wave_sum_int(cgl);
            const int need = (nk > 256) ? 256 - cgt : 4096;
            int eqseen = 0;
#pragma unroll 1
            for (int jj = 0; jj < nj; ++jj) {
                const int k = jj * 64 + lane; const float v = SC[cq * SCLD + k];
                const unsigned key = (k < nk) ? fkey(v) : 0u;
                const bool gt = key > Tkey, eq = (key == Tkey);
                const u64 eqm = __ballot(eq);
                const int myeq = eqseen + __popcll(eqm & lt_mask);
                const u64 sm = __ballot(gt || (eq && myeq < need));
                eqseen += __popcll(eqm);
                if (lane == 0) MASK[cq * 34 + jj] = sm;
            }
        }
        __syncthreads(); TP_END(2); TP_BEGIN(3);
        {
            const int h = wave;
            const bf16_t* qrow = pb + (size_t)(NMETA + s0 + c) * INW + C_DQ + h * 128 + 8 * g;
            bf16x8 bQ[4];
#pragma unroll
            for (int ks = 0; ks < 4; ++ks) bQ[ks] = *(const bf16x8*)(qrow + ks * 32);
            f32x4 O[8];
#pragma unroll
            for (int mb = 0; mb < 8; ++mb) O[mb] = (f32x4){0.f, 0.f, 0.f, 0.f};
            float m_run = -1e30f, l_run = 0.f;
            const int prow_t = threadIdx.x >> 4, pch_t = threadIdx.x & 15;
            const bf16_t* vsrc = dvt + (size_t)(b * 128 + prow_t) * TTP + pch_t * 8;
            const int n128 = (nk + 127) >> 7;
            u32x4 pk[4], pv[4];
#pragma unroll
            for (int i = 0; i < 4; ++i) {
                int key = prow_t + 32 * i; key = key < nk ? key : nk - 1;
                pk[i] = *(const u32x4*)(pb + (size_t)key * INW + C_DK + pch_t * 8);
                pv[i] = *(const u32x4*)(vsrc + (size_t)(32 * i) * TTP);
            }
#pragma unroll 1
            for (int kb = 0; kb < n128; ++kb) {
#pragma unroll
                for (int i = 0; i < 4; ++i) {
                    *(LAS u32x4*)(KT + (prow_t + 32 * i) * KLD + pch_t * 8) = pk[i];
                    *(LAS u32x4*)(VT + (prow_t + 32 * i) * VLD2 + pch_t * 8) = pv[i];
                }
                __syncthreads();
                if (kb + 1 < n128) {
#pragma unroll
                    for (int i = 0; i < 4; ++i) {
                        int key = (kb + 1) * 128 + prow_t + 32 * i; key = key < nk ? key : nk - 1;
                        pk[i] = *(const u32x4*)(pb + (size_t)key * INW + C_DK + pch_t * 8);
                        pv[i] = *(const u32x4*)(vsrc + (size_t)(32 * i) * TTP + (kb + 1) * 128);
                    }
                }
#pragma unroll
                for (int sb = 0; sb < 2; ++sb) {
                    const int wi = kb * 2 + sb;
                    if (wi < nj) {
                        const u64 mw = MASK[c * 34 + wi];
                        f32x4 S[4];
#pragma unroll
                        for (int ct = 0; ct < 4; ++ct) {
                            f32x4 acc = {0.f, 0.f, 0.f, 0.f};
#pragma unroll
                            for (int ks = 0; ks < 4; ++ks) {
                                const bf16x8 a = *(const LAS bf16x8*)(KT + (sb * 64 + ct * 16 + c) * KLD + ks * 32 + 8 * g);
                                acc = MFMA16(a, bQ[ks], acc);
                            }
                            S[ct] = acc;
                        }
                        const u64 mws = mw >> (4 * g);
                        const unsigned mlo = (unsigned)mws, mhi = (unsigned)(mws >> 32);
                        float mblk = -1e30f;
#pragma unroll
                        for (int ct = 0; ct < 4; ++ct) {
                            const unsigned bits = ((ct & 2) ? mhi : mlo) >> ((ct & 1) * 16);
#pragma unroll
                            for (int j = 0; j < 4; ++j) {
                                S[ct][j] = ((bits >> j) & 1u) ? S[ct][j] : -1e30f;
                                mblk = fmaxf(mblk, S[ct][j]);
                            }
                        }
                        mblk = fmaxf(mblk, __shfl_xor(mblk, 16)); mblk = fmaxf(mblk, __shfl_xor(mblk, 32));
                        const float m_new = fmaxf(m_run, mblk);
                        float ps = 0.f;
#pragma unroll
                        for (int ct = 0; ct < 4; ++ct)
#pragma unroll
                            for (int j = 0; j < 4; ++j) { const float pv_ = (S[ct][j] > -1e29f) ? __builtin_amdgcn_exp2f(S[ct][j] - m_new) : 0.f; S[ct][j] = pv_; ps += pv_; }
                        if (__ballot(m_new != m_run) != 0ull) {
                            const float alpha = __builtin_amdgcn_exp2f(m_run - m_new);
                            l_run *= alpha;
#pragma unroll
                            for (int mb = 0; mb < 8; ++mb) O[mb] *= alpha;
                        }
                        l_run += ps; m_run = m_new;
                        bf16x8 bP[2];
#pragma unroll
                        for (int kk = 0; kk < 2; ++kk) {
                            u32x4 t4;
                            t4[0] = pk2bf(S[2 * kk][0], S[2 * kk][1]); t4[1] = pk2bf(S[2 * kk][2], S[2 * kk][3]);
                            t4[2] = pk2bf(S[2 * kk + 1][0], S[2 * kk + 1][1]); t4[3] = pk2bf(S[2 * kk + 1][2], S[2 * kk + 1][3]);
                            bP[kk] = __builtin_bit_cast(bf16x8, t4);
                        }
#pragma unroll
                        for (int mh = 0; mh < 2; ++mh) {
                            bf16x8 av[8];
#pragma unroll
                            for (int q = 0; q < 8; ++q) {
                                const int mb = mh * 4 + (q >> 1), kk = q & 1;
                                const LAS bf16_t* vr = VT + (mb * 16 + c) * VLD2 + sb * 64 + kk * 32 + 4 * g;
                                const s16x4 lo = *(const LAS s16x4*)(vr), hi = *(const LAS s16x4*)(vr + 16);
                                av[q] = __builtin_shufflevector(lo, hi, 0, 1, 2, 3, 4, 5, 6, 7);
                            }
                            __builtin_amdgcn_sched_barrier(0);
#pragma unroll
                            for (int q = 0; q < 8; ++q) { const int mb = mh * 4 + (q >> 1), kk = q & 1; O[mb] = MFMA16(av[q], bP[kk], O[mb]); }
                            __builtin_amdgcn_sched_barrier(0);
                        }
                    }
                }
                __syncthreads();
            }
            TP_END(3); TP_BEGIN(4);
            l_run += __shfl_xor(l_run, 16); l_run += __shfl_xor(l_run, 32);
            const float inv = 1.f / l_run;
            bf16x8 bO[4];
#pragma unroll
            for (int k2 = 0; k2 < 4; ++k2)
#pragma unroll
                for (int j = 0; j < 4; ++j) { bO[k2][j] = (short)f2bf(O[2 * k2][j] * inv); bO[k2][4 + j] = (short)f2bf(O[2 * k2 + 1][j] * inv); }
            bf16_t* orow = mixed + (size_t)(b * SEQ + s0 + c) * DM + 512 + h * 64;
            int zofs = 0; asm volatile("" : "+v"(zofs));
#pragma unroll
            for (int eb = 0; eb < 4; ++eb) {
                f32x4 acc = {0.f, 0.f, 0.f, 0.f};
#pragma unroll
                for (int k2 = 0; k2 < 4; ++k2) {
                    const bf16_t* wr = wuvt + (size_t)(h * 64 + eb * 16 + c) * 128 + k2 * 32 + 4 * g + zofs;
                    const s16x4 lo = *(const s16x4*)(wr), hi = *(const s16x4*)(wr + 16);
                    const bf16x8 a = __builtin_shufflevector(lo, hi, 0, 1, 2, 3, 4, 5, 6, 7);
                    acc = MFMA16(a, bO[k2], acc);
                }
                uint2 w;
                w.x = (unsigned)f2bf(acc[0]) | ((unsigned)f2bf(acc[1]) << 16);
                w.y = (unsigned)f2bf(acc[2]) | ((unsigned)f2bf(acc[3]) << 16);
                *(uint2*)(orow + eb * 16 + 4 * g) = w;
            }
            TP_END(4);
        }
    }
}

DI void phase_dsa32(const Params& p, LAS char* smem) {
    const bf16_t* proj = (const bf16_t*)(p.ws + OFF_BIG);
    const bf16_t* dvt = (const bf16_t*)(p.ws + OFF_DVT);
    const bf16_t* wuvt = (const bf16_t*)(p.ws + OFF_WUVT);
    bf16_t* mixed = (bf16_t*)(p.ws + OFF_HN);
    LAS float* SC = (LAS float*)smem; LAS u64* MASK = (LAS u64*)(smem + DSA_MASK_OFF);
    LAS bf16_t* KT = (LAS bf16_t*)smem; LAS bf16_t* VT = (LAS bf16_t*)(smem + DSA_VT_OFF);
    for (int pi = blockIdx.x; pi < 256; pi += gridDim.x)
    for (int which = 0; which < 2; ++which) {
        const int b = pi >> 5, qq = pi & 31, qt = which ? 63 - qq : qq;
        const int s0 = qt * 32, nk = 80 + 64 * (s0 >> 6), nkt = nk >> 4, nj = (nk + 63) >> 6;
        const bf16_t* pb = proj + (size_t)(b * TT) * INW;
        LAS char* tp_smem = smem; TP_BEGIN(1);
#pragma unroll 1
        for (int sub = 0; sub < 2; ++sub) {
            {
                int tz_ = threadIdx.x; asm volatile("" : "+v"(tz_)); const int lane = tz_ & 63, wave = __builtin_amdgcn_readfirstlane(tz_ >> 6); const int c = lane & 15, g = lane >> 4;
                const bf16_t* qrow = pb + (size_t)(NMETA + s0 + 16 * sub + c) * INW;
                bf16x8 bq[8][2]; float iw[8];
#pragma unroll
                for (int h = 0; h < 8; ++h) {
                    bq[h][0] = *(const bf16x8*)(qrow + C_IQ + h * 64 + 8 * g);
                    bq[h][1] = *(const bf16x8*)(qrow + C_IQ + h * 64 + 32 + 8 * g);
                    iw[h] = bf2f(qrow[C_IW + h]);
                }
                bf16x8 a0n = {0, 0, 0, 0, 0, 0, 0, 0}, a1n = {0, 0, 0, 0, 0, 0, 0, 0};
                if (wave < nkt) { const bf16_t* krow = pb + (size_t)(wave * 16 + c) * INW + C_IK + 8 * g; a0n = *(const bf16x8*)(krow); a1n = *(const bf16x8*)(krow + 32); }
                for (int kt = wave; kt < nkt; kt += NWAVES) {
                    const bf16x8 a0 = a0n, a1 = a1n;
                    if (kt + NWAVES < nkt) { const bf16_t* krow = pb + (size_t)((kt + NWAVES) * 16 + c) * INW + C_IK + 8 * g; a0n = *(const bf16x8*)(krow); a1n = *(const bf16x8*)(krow + 32); }
                    f32x4 isc = {0.f, 0.f, 0.f, 0.f};
#pragma unroll
                    for (int h = 0; h < 8; ++h) {
                        f32x4 acc = {0.f, 0.f, 0.f, 0.f};
                        acc = MFMA16(a0, bq[h][0], acc); acc = MFMA16(a1, bq[h][1], acc);
#pragma unroll
                        for (int j = 0; j < 4; ++j) isc[j] += fmaxf(acc[j], 0.f) * iw[h];
                    }
#pragma unroll
                    for (int j = 0; j < 4; ++j) isc[j] += 0.0f;
                    *(LAS f32x4*)(SC + c * SCLD + kt * 16 + 4 * g) = isc;
                }
                {
                    const int tail = ((nj <= 11 ? 11 : (nj <= 22 ? 22 : 33)) << 6) - nk;
                    for (int i = threadIdx.x; i < 16 * tail; i += NTHREADS) { const int qq_ = i / tail; SC[qq_ * SCLD + nk + (i - qq_ * tail)] = -3.0e38f; }
                }
            }
            __syncthreads();
            {
            int tz_ = threadIdx.x; asm volatile("" : "+v"(tz_)); const int lane = tz_ & 63, wave = __builtin_amdgcn_readfirstlane(tz_ >> 6); const u64 lt_mask = (1ull << lane) - 1ull;
#pragma unroll 1
            for (int qi = 0; qi < 2; ++qi) {
                const int cq = wave * 2 + qi;
                unsigned kv[33];
#pragma unroll
                for (int jj = 0; jj < 11; ++jj) kv[jj] = fkey(SC[cq * SCLD + jj * 64 + lane]);
                if (nj > 11) {
#pragma unroll
                    for (int jj = 11; jj < 22; ++jj) kv[jj] = fkey(SC[cq * SCLD + jj * 64 + lane]);
                } else {
#pragma unroll
                    for (int jj = 11; jj < 22; ++jj) kv[jj] = 0u;
                }
                if (nj > 22) {
#pragma unroll
                    for (int jj = 22; jj < 33; ++jj) kv[jj] = fkey(SC[cq * SCLD + jj * 64 + lane]);
                } else {
#pragma unroll
                    for (int jj = 22; jj < 33; ++jj) kv[jj] = 0u;
                }
                unsigned Tkey = 1u;
                if (nk > 256) {
                    Tkey = 0u;
#pragma unroll 1
                    for (int bit = 31; bit >= 0; --bit) {
                        const unsigned cand = Tkey | (1u << bit);
                        int nl = 0;
#pragma unroll
                        for (int jj = 0; jj < 11; ++jj) nl += (kv[jj] >= cand) ? 1 : 0;
                        if (nj > 11) {
#pragma unroll
                            for (int jj = 11; jj < 22; ++jj) nl += (kv[jj] >= cand) ? 1 : 0;
                        }
                        if (nj > 22) {
#pragma unroll
                            for (int jj = 22; jj < 33; ++jj) nl += (kv[jj] >= cand) ? 1 : 0;
                        }
                        const int cnt = wave_sum_int(nl);
                        if (cnt >= 256) Tkey = cand;
                        if (cnt == 256) break;
                    }
                }
                int cgl = 0;
#pragma unroll
                for (int jj = 0; jj < 33; ++jj) cgl += (kv[jj] > Tkey) ? 1 : 0;
                const int cgt = wave_sum_int(cgl);
                const int need = (nk > 256) ? 256 - cgt : 4096;
                int eqseen = 0;
#pragma unroll 1
                for (int jj = 0; jj < nj; ++jj) {
                    const int k = jj * 64 + lane; const float v = SC[cq * SCLD + k];
                    const unsigned key = (k < nk) ? fkey(v) : 0u;
                    const bool gt = key > Tkey, eq = (key == Tkey);
                    const u64 eqm = __ballot(eq);
                    const int myeq = eqseen + __popcll(eqm & lt_mask);
                    const u64 sm = __ballot(gt || (eq && myeq < need));
                    eqseen += __popcll(eqm);
                    if (lane == 0) MASK[(16 * sub + cq) * 34 + jj] = sm;
                }
                if ((nj & 1) && lane == 0) MASK[(16 * sub + cq) * 34 + nj] = 0ull;
            }
            }

            __syncthreads();
        }
        TP_END(1); TP_BEGIN(3);
        {
            int tz_ = threadIdx.x; asm volatile("" : "+v"(tz_)); const int lane = tz_ & 63, wave = __builtin_amdgcn_readfirstlane(tz_ >> 6); const int r = lane & 31, hh = lane >> 5;
            const int h = wave;
            const bf16_t* qrow = pb + (size_t)(NMETA + s0 + r) * INW + C_DQ + h * 128 + 8 * hh;
            bf16x8 bQ[8];
#pragma unroll
            for (int ks = 0; ks < 8; ++ks) bQ[ks] = *(const bf16x8*)(qrow + ks * 16);
            f32x16 O[4];
#pragma unroll
            for (int d = 0; d < 4; ++d)
#pragma unroll
                for (int i = 0; i < 16; ++i) O[d][i] = 0.f;
            float m_run = -1e30f, l_run = 0.f;
            const int n128 = (nk + 127) >> 7;
            const int drow = lane >> 4, dslot = lane & 15;
            int fa[4];
            const int rp = (r & ~12) | ((r & 4) << 1) | ((r & 8) >> 1);
#pragma unroll
            for (int m = 0; m < 4; ++m) fa[m] = rp * 256 + (((2 * m + hh) ^ (rp & 15)) << 4);
            const int fd = (rp & 8) ? -128 : 128;
#define FA(m) ((m) < 4 ? fa[(m) & 3] : fa[(m) & 3] + fd)
#define DSA_ISSUE(KB, BUF) do { \
                _Pragma("unroll") for (int j = 0; j < 4; ++j) { \
                    const int R_ = (wave * 4 + j) * 4 + drow, ch_ = dslot ^ (j * 4 + drow); \
                    int key_ = (KB) * 128 + R_; key_ = key_ < nk ? key_ : nk - 1; \
                    __builtin_amdgcn_global_load_lds((const unsigned*)(pb + (size_t)key_ * INW + C_DK + ch_ * 8), (LAS unsigned*)(smem + (BUF) * 65536 + (wave * 4 + j) * 1024), 16, 0, 0); \
                    __builtin_amdgcn_global_load_lds((const unsigned*)(dvt + (size_t)(b * 128 + R_) * TTP + (KB) * 128 + ch_ * 8), (LAS unsigned*)(smem + (BUF) * 65536 + 32768 + (wave * 4 + j) * 1024), 16, 0, 0); \
                } } while (0)
            DSA_ISSUE(0, 0);
#pragma unroll 1
            for (int kb = 0; kb < n128; ++kb) {
                asm volatile("s_waitcnt vmcnt(0)" ::: "memory");
                __syncthreads();
                if (kb + 1 < n128) DSA_ISSUE(kb + 1, (kb + 1) & 1);
                LAS char* KTb = smem + (kb & 1) * 65536; LAS char* VTb = KTb + 32768;
                const u64 mw0 = MASK[r * 34 + kb * 2], mw1 = MASK[r * 34 + kb * 2 + 1];
                f32x16 S; bf16x8 kf[8];
#define DSA_KF(KBLK) do { _Pragma("unroll") for (int ks = 0; ks < 8; ++ks) kf[ks] = *(const LAS bf16x8*)(KTb + (KBLK) * 8192 + FA(ks)); } while (0)
#define DSA_S_BLOCK(KBLK) do { \
                    const unsigned nmb_ = ~(unsigned)(((KBLK) >> 1 ? mw1 : mw0) >> ((((KBLK) & 1) * 32) + 8 * hh)); \
                    _Pragma("unroll") for (int i = 0; i < 16; ++i) { int x_; asm("v_bfe_i32 %0, %1, %2, 1" : "=v"(x_) : "v"(nmb_), "n"((i & 3) + 4 * ((i >> 2) & 1) + 16 * (i >> 3))); S[i] = __builtin_bit_cast(float, (unsigned)x_ & 0xff800000u); }     \
                    _Pragma("unroll") for (int ks = 0; ks < 8; ++ks) S = MFMA32(kf[ks], bQ[ks], S); \
                } while (0)
                DSA_KF(0);
                DSA_S_BLOCK(0);
#pragma unroll
                for (int kblk = 0; kblk < 4; ++kblk) {
                    if (kblk == 0) DSA_KF(1); else if (kblk == 1) DSA_KF(2); else if (kblk == 2) DSA_KF(3);
                    float mblk = fmaxf(S[0], S[1]);
#pragma unroll
                    for (int i = 2; i < 16; ++i) mblk = fmaxf(mblk, S[i]);
                    const auto sw = __builtin_amdgcn_permlane32_swap(__builtin_bit_cast(unsigned, mblk), __builtin_bit_cast(unsigned, mblk), false, false);
                    const float m_new = fmaxf(fmaxf(m_run, __builtin_bit_cast(float, (unsigned)sw[0])), __builtin_bit_cast(float, (unsigned)sw[1]));
                    if (__ballot(m_new != m_run) != 0ull) {
                        const float alpha = __builtin_amdgcn_exp2f(m_run - m_new);
                        l_run *= alpha;
#pragma unroll
                        for (int d = 0; d < 4; ++d)
#pragma unroll
                            for (int i = 0; i < 16; ++i) O[d][i] *= alpha;
                    }
                    m_run = m_new;
                    bf16x8 av[8];
#pragma unroll
                    for (int q = 0; q < 8; ++q) av[q] = *(const LAS bf16x8*)(VTb + (q >> 1) * 8192 + FA(2 * kblk + (q & 1)));
                    f32x2 ps2 = {0.f, 0.f};
                    const f32x2 mn2 = {m_new, m_new};
#pragma unroll
                    for (int i = 0; i < 8; ++i) {
                        f32x2 t2 = {S[2 * i], S[2 * i + 1]}; t2 = t2 - mn2;
                        t2[0] = __builtin_amdgcn_exp2f(t2[0]); t2[1] = __builtin_amdgcn_exp2f(t2[1]);
                        ps2 += t2; S[2 * i] = t2[0]; S[2 * i + 1] = t2[1];
                    }
                    l_run += ps2[0] + ps2[1];
                    bf16x8 bP[2];
#pragma unroll
                    for (int s2 = 0; s2 < 2; ++s2) {
                        u32x4 t4;
#pragma unroll
                        for (int x = 0; x < 4; ++x) t4[x] = pk2bf(S[8 * s2 + 2 * x], S[8 * s2 + 2 * x + 1]);
                        bP[s2] = __builtin_bit_cast(bf16x8, t4);
                    }
                    if (kblk < 3) DSA_S_BLOCK(kblk + 1);
#pragma unroll
                    for (int q = 0; q < 8; ++q) O[q >> 1] = MFMA32(av[q], bP[q & 1], O[q >> 1]);
                }
#undef DSA_S_BLOCK
#undef DSA_KF
            }
#undef DSA_ISSUE
#undef FA
            __syncthreads();
            TP_END(3); TP_BEGIN(4);
            l_run += __shfl_xor(l_run, 32);
            const float inv = 1.f / l_run;
            bf16x8 bO[4][2];
#pragma unroll
            for (int d = 0; d < 4; ++d)
#pragma unroll
                for (int s2 = 0; s2 < 2; ++s2) {
                    u32x4 t4;
#pragma unroll
                    for (int x = 0; x < 4; ++x) t4[x] = pk2bf(O[d][8 * s2 + 2 * x] * inv, O[d][8 * s2 + 2 * x + 1] * inv);
                    bO[d][s2] = __builtin_bit_cast(bf16x8, t4);
                }
            bf16_t* orow = mixed + (size_t)(b * SEQ + s0 + r) * DM + 512 + h * 64 + 4 * hh;
            int zofs = 0; asm volatile("" : "+v"(zofs));
#pragma unroll
            for (int eb = 0; eb < 2; ++eb) {
                f32x16 acc;
#pragma unroll
                for (int i = 0; i < 16; ++i) acc[i] = 0.f;
#pragma unroll
                for (int d = 0; d < 4; ++d)
#pragma unroll
                    for (int s2 = 0; s2 < 2; ++s2) {
                        const bf16x8 a = *(const bf16x8*)(wuvt + (size_t)(h * 64 + eb * 32 + r) * 128 + d * 32 + 16 * s2 + 8 * hh + zofs);
                        acc = MFMA32(a, bO[d][s2], acc);
                    }
#pragma unroll
                for (int g4 = 0; g4 < 4; ++g4) { uint2 w; w.x = pk2bf(acc[4 * g4], acc[4 * g4 + 1]); w.y = pk2bf(acc[4 * g4 + 2], acc[4 * g4 + 3]); *(uint2*)(orow + eb * 32 + 8 * g4) = w; }
            }
            TP_END(4);
        }
    }
}

DI void phase_ret_scan(const Params& p) {
    float* ST = (float*)(p.ws + OFF_ST);
    const int gtid = blockIdx.x * NTHREADS + threadIdx.x, gsz = gridDim.x * NTHREADS;
    for (int idx = gtid; idx < 32 * 16384; idx += gsz) {
        const int bh = idx >> 14, el = idx & 16383, h = bh & 3;
        const float gc = expf(logf(1.f - exp2f(-5.f - (float)h)) * 64.f);
        float* base = ST + (size_t)bh * 34 * 16384 + el;
        float r = 0.f;
        for (int c = 1; c < 34; ++c) {
            const float u = c < 33 ? base[(size_t)c * 16384] : 0.f;
            base[(size_t)c * 16384] = r;
            r = gc * r + u;
        }
    }
}

constexpr int RLD = 136, RTLD = 72;
DI void phase_ret_state_mfma(const Params& p, LAS char* smem) {
    const bf16_t* proj = (const bf16_t*)(p.ws + OFF_BIG);
    float* ST = (float*)(p.ws + OFF_ST);
    LAS bf16_t* sVT = (LAS bf16_t*)smem; LAS bf16_t* sKT = sVT + 128 * RTLD;
    const int wave = threadIdx.x >> 6, lane = threadIdx.x & 63, r = lane & 31, hh = lane >> 5;
    for (int unit = blockIdx.x; unit < 1024; unit += gridDim.x) {
        const int c = 1 + (unit & 31), bh = unit >> 5, h = bh & 3, b = bh >> 2;
        const float lg = logf(1.f - exp2f(-5.f - (float)h));
        {
            const int j = threadIdx.x >> 3, ch = threadIdx.x & 7, t = 64 * c + j - 112;
            const float z = expf(lg * (float)(63 - j));
#pragma unroll
            for (int q = 0; q < 2; ++q) {
                const int cc = ch + 8 * q;
                u32x4 kv = {0u, 0u, 0u, 0u}, vv = {0u, 0u, 0u, 0u};
                if (t >= 0) { const bf16_t* pr = proj + (size_t)(b * TT + t) * INW; kv = *(const u32x4*)(pr + C_RK + h * 128 + cc * 8); vv = *(const u32x4*)(pr + C_RV + h * 128 + cc * 8); }
                float vf[8]; unpack8(vv, vf);
#pragma unroll
                for (int x = 0; x < 8; ++x) {
                    sKT[(cc * 8 + x) * RTLD + j] = (bf16_t)((kv[x >> 1] >> ((x & 1) * 16)) & 0xffffu);
                    sVT[(cc * 8 + x) * RTLD + j] = f2bf(vf[x] * z);
                }
            }
        }
        __syncthreads();
        const int mb = wave >> 1;
#pragma unroll
        for (int q = 0; q < 2; ++q) {
            const int nb = (wave & 1) * 2 + q;
            f32x16 acc;
#pragma unroll
            for (int i = 0; i < 16; ++i) acc[i] = 0.f;
#pragma unroll
            for (int ks = 0; ks < 4; ++ks) {
                const bf16x8 a = *(const LAS bf16x8*)(sVT + (mb * 32 + r) * RTLD + ks * 16 + 8 * hh);
                const bf16x8 bb = *(const LAS bf16x8*)(sKT + (nb * 32 + r) * RTLD + ks * 16 + 8 * hh);
                acc = MFMA32(a, bb, acc);
            }
            float* st = ST + (size_t)(bh * 34 + c) * 16384 + nb * 32 + r;
#pragma unroll
            for (int i = 0; i < 16; ++i) st[(size_t)(mb * 32 + (i & 3) + 8 * (i >> 2) + 4 * hh) * 128] = acc[i];
        }
        __syncthreads();
    }
}
DI void phase_ret_out_mfma(const Params& p, LAS char* smem) {
    const bf16_t* proj = (const bf16_t*)(p.ws + OFF_BIG);
    const float* ST = (const float*)(p.ws + OFF_ST);
    bf16_t* mixed = (bf16_t*)(p.ws + OFF_HN);
    LAS bf16_t* sQ = (LAS bf16_t*)smem; LAS bf16_t* sK = sQ + 64 * RLD; LAS bf16_t* sVT = sK + 64 * RLD;
    LAS float* sGN = (LAS float*)(sVT + 128 * RTLD);
    const int wave = threadIdx.x >> 6, lane = threadIdx.x & 63, r = lane & 31, hh = lane >> 5;
    const int ib = wave & 1, eb = wave >> 1;
    for (int unit = blockIdx.x; unit < 1024; unit += gridDim.x) {
        const int c = 2 + (unit & 31), bh = unit >> 5, h = bh & 3, b = bh >> 2;
        const float lg = logf(1.f - exp2f(-5.f - (float)h));
        for (int i = threadIdx.x; i < 64 * 16; i += NTHREADS) {
            const int j = i >> 4, ch = i & 15; const int t = 64 * c + j - 112;
            const bf16_t* pr = proj + (size_t)(b * TT + t) * INW;
            *(LAS u32x4*)(sQ + j * RLD + ch * 8) = *(const u32x4*)(pr + C_RQ + h * 128 + ch * 8);
            *(LAS u32x4*)(sK + j * RLD + ch * 8) = *(const u32x4*)(pr + C_RK + h * 128 + ch * 8);
            const u32x4 vv = *(const u32x4*)(pr + C_RV + h * 128 + ch * 8);
#pragma unroll
            for (int x = 0; x < 8; ++x) sVT[(ch * 8 + x) * RTLD + j] = (bf16_t)((vv[x >> 1] >> ((x & 1) * 16)) & 0xffffu);
        }
        __syncthreads();
        f32x16 acc;
#pragma unroll
        for (int i = 0; i < 16; ++i) acc[i] = 0.f;
        {
            const float* R = ST + (size_t)(bh * 34 + c) * 16384 + (size_t)(eb * 32 + r) * 128 + 8 * hh;
#pragma unroll
            for (int ks = 0; ks < 8; ++ks) {
                const float4 r0 = *(const float4*)(R + ks * 16), r1 = *(const float4*)(R + ks * 16 + 4);
                const float rf[8] = {r0.x, r0.y, r0.z, r0.w, r1.x, r1.y, r1.z, r1.w};
                const bf16x8 a = pack8(rf);
                const bf16x8 bq = *(const LAS bf16x8*)(sQ + (ib * 32 + r) * RLD + ks * 16 + 8 * hh);
                acc = MFMA32(a, bq, acc);
            }
            const float xi = expf(lg * (float)(ib * 32 + r + 1));
#pragma unroll
            for (int i = 0; i < 16; ++i) acc[i] *= xi;
        }
#pragma unroll
        for (int jb = 0; jb < 2; ++jb) {
            f32x16 st;
#pragma unroll
            for (int i = 0; i < 16; ++i) st[i] = 0.f;
#pragma unroll
            for (int ks = 0; ks < 8; ++ks) {
                const bf16x8 a = *(const LAS bf16x8*)(sK + (jb * 32 + r) * RLD + ks * 16 + 8 * hh);
                const bf16x8 bq = *(const LAS bf16x8*)(sQ + (ib * 32 + r) * RLD + ks * 16 + 8 * hh);
                st = MFMA32(a, bq, st);
            }
            const int icol = ib * 32 + r;
#pragma unroll
            for (int i = 0; i < 16; ++i) {
                const int j = jb * 32 + (i & 3) + 8 * (i >> 2) + 4 * hh; const int df = icol > j ? icol - j : j - icol;
                st[i] *= expf(lg * (float)df);
            }
#pragma unroll
            for (int s2 = 0; s2 < 2; ++s2) {
                bf16x8 bp;
#pragma unroll
                for (int x = 0; x < 8; ++x) bp[x] = (short)f2bf(st[8 * s2 + x]);
                const LAS bf16_t* vr = sVT + (eb * 32 + r) * RTLD + jb * 32 + 16 * s2 + 4 * hh;
                const s16x4 lo = *(const LAS s16x4*)(vr), hi = *(const LAS s16x4*)(vr + 8);
                const bf16x8 a = __builtin_shufflevector(lo, hi, 0, 1, 2, 3, 4, 5, 6, 7);
                acc = MFMA32(a, bp, acc);
            }
        }
        float s1 = 0.f, s2 = 0.f;
#pragma unroll
        for (int i = 0; i < 16; ++i) { s1 += acc[i]; s2 += acc[i] * acc[i]; }
        s1 += __shfl_xor(s1, 32); s2 += __shfl_xor(s2, 32);
        if (hh == 0) { sGN[(eb * 64 + ib * 32 + r) * 2] = s1; sGN[(eb * 64 + ib * 32 + r) * 2 + 1] = s2; }
        __syncthreads();
        float S1 = 0.f, S2 = 0.f;
#pragma unroll
        for (int e4 = 0; e4 < 4; ++e4) { S1 += sGN[(e4 * 64 + ib * 32 + r) * 2]; S2 += sGN[(e4 * 64 + ib * 32 + r) * 2 + 1]; }
        const float mu = S1 * (1.f / 128.f), var = fmaxf(S2 * (1.f / 128.f) - mu * mu, 0.f), rs = rsqrtf(var + 1e-6f);
        const int t = 64 * c + ib * 32 + r - 112, srow = t - NMETA;
        const bf16_t* pg = proj + (size_t)(b * TT + t) * INW + C_RG + h * 128 + eb * 32 + 4 * hh;
        bf16_t* po = mixed + (size_t)(b * SEQ + srow) * DM + h * 128 + eb * 32 + 4 * hh;
#pragma unroll
        for (int g4 = 0; g4 < 4; ++g4) {
            const uint2 graw = *(const uint2*)(pg + 8 * g4);
            const float gv[4] = {__uint_as_float(graw.x << 16), __uint_as_float(graw.x & 0xffff0000u), __uint_as_float(graw.y << 16), __uint_as_float(graw.y & 0xffff0000u)};
            float o[4];
#pragma unroll
            for (int x = 0; x < 4; ++x) { const float gate = gv[x] / (1.f + expf(-gv[x])); o[x] = gate * (acc[4 * g4 + x] - mu) * rs; }
            uint2 w; w.x = (unsigned)f2bf(o[0]) | ((unsigned)f2bf(o[1]) << 16); w.y = (unsigned)f2bf(o[2]) | ((unsigned)f2bf(o[3]) << 16);
            *(uint2*)(po + 8 * g4) = w;
        }
        __syncthreads();
    }
}

DI void phase_norm2(const Params& p) {
    bf16_t* hn2 = (bf16_t*)(p.ws + OFF_HN);
    const int wave = threadIdx.x >> 6, lane = threadIdx.x & 63;
    for (int row = blockIdx.x * NWAVES + wave; row < NF; row += gridDim.x * NWAVES) {
        const float* src = p.out + (size_t)row * DM; bf16_t* o = hn2 + (size_t)row * DM;
        float4 v[4]; float ss = 0.f;
#pragma unroll
        for (int i = 0; i < 4; ++i) { v[i] = *(const float4*)(src + i * 256 + lane * 4); ss += v[i].x * v[i].x + v[i].y * v[i].y + v[i].z * v[i].z + v[i].w * v[i].w; }
        ss = wave_sum(ss);
        const float rstd = rsqrtf(ss * (1.f / DM) + 1e-6f);
#pragma unroll
        for (int i = 0; i < 4; ++i) {
            const float4 g = *(const float4*)(p.norm_ffn + i * 256 + lane * 4);
            uint2 w;
            w.x = (unsigned)f2bf(v[i].x * rstd * g.x) | ((unsigned)f2bf(v[i].y * rstd * g.y) << 16);
            w.y = (unsigned)f2bf(v[i].z * rstd * g.z) | ((unsigned)f2bf(v[i].w * rstd * g.w) << 16);
            *(uint2*)(o + i * 256 + lane * 4) = w;
        }
    }
}

__device__ const int PEER_PAIRS[50] = {0, 2, 4, 6, 8, 10, 12, 14, 16, 18, 20, 22, 32, 34, 36, 49, 51, 65, 80, 96, 112, 128, 160, 192, 224, 1, 3, 5, 7, 9, 11, 13, 15, 17, 19, 21, 23, 33, 35, 48, 50, 64, 66, 81, 97, 113, 144, 176, 208, 240};
constexpr int PSEL_WAVE_LDS = 32 * 2 * 16 * 8 + 32 * 16 * 8;
DI void phase_peer_select(const Params& p, LAS char* smem) {
    const float* PQ = (const float*)(p.ws + OFF_BIG);
    unsigned* EG = (unsigned*)(p.ws + OFF_EG); const float* SSQ = (const float*)(p.ws + OFF_SSQ);
    int tz = threadIdx.x; asm volatile("" : "+v"(tz));
    const int wave = __builtin_amdgcn_readfirstlane(tz >> 6), lane = tz & 63, r = lane & 31, hh = lane >> 5;
    LAS float* lv = (LAS float*)(smem + wave * PSEL_WAVE_LDS);
    LAS int* li = (LAS int*)(lv + 32 * 2 * 16);
    LAS float* cs = (LAS float*)(li + 32 * 2 * 16);
    LAS int* cab = (LAS int*)(cs + 32 * 16);
    for (int task = blockIdx.x * NWAVES + wave; task < (NF / 32) * 8; task += gridDim.x * NWAVES) {
        const int tile = task >> 3, h = task & 7;
        const int n = tile * 32 + r;
#pragma unroll 1
        for (int half = 0; half < 2; ++half) {
            f32x16 acc[4];
            {
                const float* srow = PQ + (size_t)n * 2048 + h * 256 + half * 128 + hh * 64;
#pragma unroll
                for (int mb = 0; mb < 4; ++mb)
#pragma unroll
                    for (int q = 0; q < 4; ++q) { const float4 a = *(const float4*)(srow + mb * 16 + q * 4); acc[mb][q * 4] = a.x; acc[mb][q * 4 + 1] = a.y; acc[mb][q * 4 + 2] = a.z; acc[mb][q * 4 + 3] = a.w; }
            }
            float mprev = INFINITY;
#pragma unroll 1
            for (int it = 0; it < 16; ++it) {
                float m = -INFINITY;
#pragma unroll
                for (int mb = 0; mb < 4; ++mb)
#pragma unroll
                    for (int i = 0; i < 16; ++i) { const float v = acc[mb][i]; m = fmaxf(m, v < mprev ? v : -INFINITY); }
                m = fmaxf(m, __shfl_xor(m, 32));
                mprev = m;
            }
            const float T = mprev;
            int cnt = 0;
#pragma unroll
            for (int mb = 0; mb < 4; ++mb)
#pragma unroll
                for (int i = 0; i < 16; ++i) cnt += (acc[mb][i] >= T) ? 1 : 0;
            const int pc = __shfl_xor(cnt, 32);
            int pos = hh ? pc : 0;
            LAS float* lvp = lv + (r * 2 + half) * 16; LAS int* lip = li + (r * 2 + half) * 16;
#pragma unroll
            for (int mb = 0; mb < 4; ++mb)
#pragma unroll
                for (int i = 0; i < 16; ++i) {
                    const float v = acc[mb][i];
                    if (v >= T) { if (pos < 16) { lvp[pos] = v; lip[pos] = hh * 64 + mb * 16 + i; } ++pos; }
                }
        }
        lds_fence();
        {
            float w1[16], w2[16];
#pragma unroll
            for (int a = 0; a < 16; ++a) { w1[a] = lv[(r * 2 + 0) * 16 + a]; w2[a] = lv[(r * 2 + 1) * 16 + a]; }
            float m1[8], m2[8]; int i1[8], i2[8], r1[8], r2[8];
#pragma unroll
            for (int x = 0; x < 8; ++x) {
                m1[x] = lv[(r * 2 + 0) * 16 + 8 * hh + x]; m2[x] = lv[(r * 2 + 1) * 16 + 8 * hh + x];
                i1[x] = li[(r * 2 + 0) * 16 + 8 * hh + x]; i2[x] = li[(r * 2 + 1) * 16 + 8 * hh + x];
                unsigned c1 = 0u, c2 = 0u;
#pragma unroll
                for (int a = 0; a < 16; ++a) { c1 += __float_as_uint(m1[x] - w1[a]) >> 31; c2 += __float_as_uint(m2[x] - w2[a]) >> 31; }
                r1[x] = (int)c1; r2[x] = (int)c2;
            }
            int rs = 0;
#pragma unroll
            for (int x = 0; x < 8; ++x) rs += r1[x] + (r2[x] << 8);
            rs += __shfl_xor(rs, 32);
            if (__any(rs != (120 | (120 << 8)))) {
#pragma unroll
                for (int x = 0; x < 8; ++x) { r1[x] = 0; r2[x] = 0; }
#pragma unroll 1
                for (int a = 0; a < 16; ++a) {
                    const float wa1 = lv[(r * 2 + 0) * 16 + a], wa2 = lv[(r * 2 + 1) * 16 + a];
#pragma unroll
                    for (int x = 0; x < 8; ++x) {
                        const int me = 8 * hh + x;
                        r1[x] += (wa1 > m1[x] || (wa1 == m1[x] && a < me)) ? 1 : 0;
                        r2[x] += (wa2 > m2[x] || (wa2 == m2[x] && a < me)) ? 1 : 0;
                    }
                }
            }
            lds_fence();
#pragma unroll
            for (int x = 0; x < 8; ++x) {
                lv[(r * 2 + 0) * 16 + r1[x]] = m1[x]; li[(r * 2 + 0) * 16 + r1[x]] = i1[x];
                lv[(r * 2 + 1) * 16 + r2[x]] = m2[x]; li[(r * 2 + 1) * 16 + r2[x]] = i2[x];
            }
            lds_fence();
        }
        int code[25]; float cv[25];
#pragma unroll
        for (int i = 0; i < 25; ++i) {
            code[i] = PEER_PAIRS[hh * 25 + i];
            cv[i] = lv[(r * 2 + 0) * 16 + (code[i] >> 4)] + lv[(r * 2 + 1) * 16 + (code[i] & 15)];
        }
        float mprev = INFINITY;
#pragma unroll 1
        for (int it = 0; it < 16; ++it) {
            float m = -INFINITY;
#pragma unroll
            for (int i = 0; i < 25; ++i) { const float v = cv[i]; m = fmaxf(m, v < mprev ? v : -INFINITY); }
            m = fmaxf(m, __shfl_xor(m, 32));
            mprev = m;
        }
        const float Tc = mprev;
        int cnt = 0;
#pragma unroll
        for (int i = 0; i < 25; ++i) cnt += (cv[i] >= Tc) ? 1 : 0;
        const int pc = __shfl_xor(cnt, 32);
        int pos = hh ? pc : 0;
#pragma unroll
        for (int i = 0; i < 25; ++i) {
            if (cv[i] >= Tc) { if (pos < 16) { cs[r * 16 + pos] = cv[i]; cab[r * 16 + pos] = code[i]; } ++pos; }
        }
        lds_fence();
        const float rstd = rsqrtf(SSQ[n] * (1.f / DM) + 1e-6f);
        float scv[16]; float mx = -INFINITY;
#pragma unroll
        for (int i = 0; i < 16; ++i) { scv[i] = cs[r * 16 + i]; mx = fmaxf(mx, scv[i]); }
        float sum = 0.f;
#pragma unroll
        for (int i = 0; i < 16; ++i) { scv[i] = expf((scv[i] - mx) * rstd); sum += scv[i]; }
        const float inv = 1.f / sum;
#pragma unroll
        for (int i = 0; i < 16; ++i) {
            if ((i >> 3) == hh) {
                const int ab = cab[r * 16 + i];
                const int e = li[(r * 2 + 0) * 16 + (ab >> 4)] * 128 + li[(r * 2 + 1) * 16 + (ab & 15)];
                const _Float16 gh = (_Float16)(scv[i] * inv);
                EG[(size_t)n * 128 + h * 16 + i] = (unsigned)e | ((unsigned)__builtin_bit_cast(unsigned short, gh) << 16);
            }
        }
        lds_fence();
    }
}

typedef float f32x2 __attribute__((ext_vector_type(2)));
DI void phase_convert_tables(const Params& p) {
    int tz = threadIdx.x; asm volatile("" : "+v"(tz));
    const int wave = tz >> 6, lane = tz & 63;
    for (int rowi = blockIdx.x * NWAVES + wave; rowi < 2 * 16384; rowi += gridDim.x * NWAVES) {
        const bool isv = rowi >= 16384; const int e = isv ? rowi - 16384 : rowi;
        const float* src = (isv ? p.pv : p.pu) + (size_t)e * DM + lane * 16;
        float x[16]; float mx = 0.f;
#pragma unroll
        for (int i = 0; i < 4; ++i) { const float4 a = *(const float4*)(src + i * 4); x[i * 4] = a.x; x[i * 4 + 1] = a.y; x[i * 4 + 2] = a.z; x[i * 4 + 3] = a.w; }
#pragma unroll
        for (int i = 0; i < 16; ++i) mx = fmaxf(mx, fabsf(x[i]));
        mx = wave_max(mx);
        const float top = isv ? 240.f : 127.f;
        const float inv = mx > 0.f ? top / mx : 0.f, scale = mx > 0.f ? mx / top : 0.f;
        u32x4 o;
        if (isv) {
#pragma unroll
            for (int w = 0; w < 4; ++w) {
                int pk = 0;
                pk = __builtin_amdgcn_cvt_pk_fp8_f32(x[w * 4] * inv, x[w * 4 + 1] * inv, pk, false);
                pk = __builtin_amdgcn_cvt_pk_fp8_f32(x[w * 4 + 2] * inv, x[w * 4 + 3] * inv, pk, true);
                o[w] = (unsigned)pk;
            }
        } else {
#pragma unroll
            for (int w = 0; w < 4; ++w) {
                unsigned pk = 0u;
#pragma unroll
                for (int b = 0; b < 4; ++b) { const int q = (int)rintf(x[w * 4 + b] * inv); pk |= ((unsigned)q & 0xffu) << (8 * b); }
                o[w] = pk;
            }
        }
        *(u32x4*)(p.ws + (isv ? OFF_V8 : OFF_U8) + (size_t)e * DM + lane * 16) = o;
        if (lane == 0) ((float*)(p.ws + (isv ? OFF_SV : OFF_SU)))[e] = scale;
    }
}
DI void unpack16_fp8(const u32x4& r, float (&v)[16]) {
#pragma unroll
    for (int w = 0; w < 4; ++w) {
        const f32x2 a = __builtin_amdgcn_cvt_pk_f32_fp8((int)r[w], false), b = __builtin_amdgcn_cvt_pk_f32_fp8((int)r[w], true);
        v[w * 4] = a[0]; v[w * 4 + 1] = a[1]; v[w * 4 + 2] = b[0]; v[w * 4 + 3] = b[1];
    }
}
constexpr int RW_NB = 128, RW_SH = 7;
constexpr int RW_WAVE_LDS = 4 * (RW_NB + 16) * 4 + 4 * 128 * 4 + 4 * 128 * 4;
DI float gelu_as(float v) {
    const float av = fabsf(v), t = __builtin_amdgcn_rcpf(av * 0.2316418882f + 1.0f);
    float q = t * 0.5307027145f + (-0.7265760135f); q = q * t + 0.7107068705f; q = q * t + (-0.142248368f); q = q * t + 0.127414796f; q = q * t;
    const float e = __builtin_amdgcn_exp2f((v * v) * (-0.72134752044f));
    const float m = v * (q * e), r = v - m;
    return v < 0.f ? m : r;
}
DI void phase_peer_out_rows(const Params& p, LAS char* smem) {
    const unsigned* EG = (const unsigned*)(p.ws + OFF_EG);
    const char* U8 = p.ws + OFF_U8; const char* V8 = p.ws + OFF_V8;
    const float* SU = (const float*)(p.ws + OFF_SU); const float* SV = (const float*)(p.ws + OFF_SV);
    int tz = threadIdx.x; asm volatile("" : "+v"(tz));
    const int wave = __builtin_amdgcn_readfirstlane(tz >> 6), lane = tz & 63, r = lane >> 4, l16 = lane & 15;
    LAS int* cnt = (LAS int*)(smem + wave * RW_WAVE_LDS) + r * (RW_NB + 16);
    LAS int* list_e = (LAS int*)(smem + wave * RW_WAVE_LDS + 4 * (RW_NB + 16) * 4) + r * 128;
    LAS float* list_g = (LAS float*)(smem + wave * RW_WAVE_LDS + 4 * (RW_NB + 16) * 4 + 2048) + r * 128;
    for (int grp = blockIdx.x * NWAVES + wave; grp < NF / 4; grp += gridDim.x * NWAVES) {
        const int n = grp * 4 + r;
        float acc[64]; int hq[16]; float hscale;
        const float* hrow = p.out + (size_t)n * DM + l16 * 16;
        {
            float hn[64];
            float ss = 0.f;
#pragma unroll
            for (int j = 0; j < 4; ++j)
#pragma unroll
                for (int q = 0; q < 4; ++q) { const float4 a = *(const float4*)(hrow + j * 256 + q * 4); hn[j * 16 + q * 4] = a.x; hn[j * 16 + q * 4 + 1] = a.y; hn[j * 16 + q * 4 + 2] = a.z; hn[j * 16 + q * 4 + 3] = a.w; }
#pragma unroll
            for (int i = 0; i < 64; ++i) ss += hn[i] * hn[i];
            ss = dpp_row_sum(ss);
            const float rstd = rsqrtf(ss * (1.f / DM) + 1e-6f);
#pragma unroll
            for (int j = 0; j < 4; ++j)
#pragma unroll
                for (int q = 0; q < 4; ++q) {
                    const float4 a = *(const float4*)(p.norm_ffn + j * 256 + l16 * 16 + q * 4);
                    hn[j * 16 + q * 4] *= rstd * a.x; hn[j * 16 + q * 4 + 1] *= rstd * a.y; hn[j * 16 + q * 4 + 2] *= rstd * a.z; hn[j * 16 + q * 4 + 3] *= rstd * a.w;
                }
            float hm = 0.f;
#pragma unroll
            for (int i = 0; i < 64; ++i) hm = fmaxf(hm, fabsf(hn[i]));
            hm = fmaxf(hm, __int_as_float(__builtin_amdgcn_update_dpp(0, __float_as_int(hm), 0xB1, 0xF, 0xF, true)));
            hm = fmaxf(hm, __int_as_float(__builtin_amdgcn_update_dpp(0, __float_as_int(hm), 0x4E, 0xF, 0xF, true)));
            hm = fmaxf(hm, __int_as_float(__builtin_amdgcn_update_dpp(0, __float_as_int(hm), 0x141, 0xF, 0xF, true)));
            hm = fmaxf(hm, __int_as_float(__builtin_amdgcn_update_dpp(0, __float_as_int(hm), 0x140, 0xF, 0xF, true)));
            const float hinv = hm > 0.f ? 127.f / hm : 0.f; hscale = hm * (1.f / 127.f);
#pragma unroll
            for (int w = 0; w < 16; ++w) {
                unsigned pk = 0u;
#pragma unroll
                for (int b = 0; b < 4; ++b) { const int q = (int)rintf(hn[w * 4 + b] * hinv); pk |= ((unsigned)q & 0xffu) << (8 * b); }
                hq[w] = (int)pk;
            }
#pragma unroll
            for (int i = 0; i < 64; ++i) acc[i] = 0.f;
        }
#pragma unroll
        for (int q = 0; q < RW_NB / 16; ++q) cnt[q * 16 + l16] = 0;
        lds_fence();
        {
            int ek[8], rk[8]; float gk[8];
#pragma unroll
            for (int k = 0; k < 8; ++k) { const unsigned w = EG[(size_t)n * 128 + k * 16 + l16]; ek[k] = (int)(w & 0xffffu); gk[k] = (float)__builtin_bit_cast(_Float16, (unsigned short)(w >> 16)); }
#pragma unroll
            for (int k = 0; k < 8; ++k) rk[k] = __hip_atomic_fetch_add(&cnt[ek[k] >> RW_SH], 1, __ATOMIC_RELAXED, __HIP_MEMORY_SCOPE_WORKGROUP);
            lds_fence();
            {
                constexpr int PB = RW_NB / 16;
                int c[PB], tot = 0;
#pragma unroll
                for (int q = 0; q < PB; ++q) { c[q] = cnt[l16 * PB + q]; tot += c[q]; }
                cnt[RW_NB + l16] = tot;
                lds_fence();
                int base = 0;
#pragma unroll
                for (int q = 0; q < 16; ++q) { const int v = cnt[RW_NB + q]; base += (q < l16) ? v : 0; }
#pragma unroll
                for (int q = 0; q < PB; ++q) { cnt[l16 * PB + q] = base; base += c[q]; }
            }
            lds_fence();
#pragma unroll
            for (int k = 0; k < 8; ++k) { const int pos = cnt[ek[k] >> RW_SH] + rk[k]; list_e[pos] = ek[k]; list_g[pos] = gk[k]; }
        }
        lds_fence();
        {
            u32x4 ub[4], vb[4]; float g_c, su_c, sv_c, g_n = 0.f, su_n = 0.f, sv_n = 0.f;
            {
                const int e_ = list_e[0]; g_c = list_g[0]; su_c = SU[e_]; sv_c = SV[e_];
#pragma unroll
                for (int j = 0; j < 4; ++j) { ub[j] = *(const u32x4*)(U8 + (size_t)e_ * DM + l16 * 16 + j * 256); vb[j] = *(const u32x4*)(V8 + (size_t)e_ * DM + l16 * 16 + j * 256); }
            }
#pragma unroll 1
            for (int sl = 0; sl < 128; ++sl) {
                int isum = 0;
#pragma unroll
                for (int j = 0; j < 4; ++j)
#pragma unroll
                    for (int w = 0; w < 4; ++w) isum = __builtin_amdgcn_sdot4((int)ub[j][w], hq[j * 4 + w], isum, false);
                isum += __builtin_amdgcn_update_dpp(0, isum, 0xB1, 0xF, 0xF, true);
                isum += __builtin_amdgcn_update_dpp(0, isum, 0x4E, 0xF, 0xF, true);
                isum += __builtin_amdgcn_update_dpp(0, isum, 0x141, 0xF, 0xF, true);
                isum += __builtin_amdgcn_update_dpp(0, isum, 0x140, 0xF, 0xF, true);
                float t_ = (float)isum * hscale;
                const int sn = sl + 1 < 128 ? sl + 1 : 127;
                const int e_n = list_e[sn];
                {
                    const char* up_ = U8 + (size_t)e_n * DM + l16 * 16;
#pragma unroll
                    for (int j = 0; j < 4; ++j) ub[j] = *(const u32x4*)(up_ + j * 256);
                    g_n = list_g[sn]; su_n = SU[e_n]; sv_n = SV[e_n];
                }
                t_ *= su_c;
                const float coef_ = gelu_as(t_) * g_c * sv_c;
#pragma unroll
                for (int j = 0; j < 4; ++j) { float v[16]; unpack16_fp8(vb[j], v);
#pragma unroll
                    for (int i = 0; i < 16; ++i) acc[j * 16 + i] += coef_ * v[i]; }
                {
                    const char* vp_ = V8 + (size_t)e_n * DM + l16 * 16;
#pragma unroll
                    for (int j = 0; j < 4; ++j) vb[j] = *(const u32x4*)(vp_ + j * 256);
                }
                g_c = g_n; su_c = su_n; sv_c = sv_n;
            }
        }
        {
            float* orow = p.out + (size_t)n * DM + l16 * 16;
            float s2 = 0.f;
#pragma unroll
            for (int j = 0; j < 4; ++j)
#pragma unroll
                for (int q = 0; q < 4; ++q) { const float4 a = *(const float4*)(orow + j * 256 + q * 4); acc[j * 16 + q * 4] += a.x; acc[j * 16 + q * 4 + 1] += a.y; acc[j * 16 + q * 4 + 2] += a.z; acc[j * 16 + q * 4 + 3] += a.w; }
#pragma unroll
            for (int i = 0; i < 64; ++i) s2 += acc[i] * acc[i];
            s2 = dpp_row_sum(s2);
            float r2 = rsqrtf(s2 * (1.f / DM) + 1e-6f);
#if TP_SEC
            r2 *= 1.f + 0.5f * ((const float*)(p.ws + OFF_BAR))[3602];
#endif
#if defined(DSA_CHECK) || defined(PROJ_CHECK)
            { const float num = ((const float*)(p.ws + OFF_BAR))[3600], den = ((const float*)(p.ws + OFF_BAR))[3601]; r2 *= 1.f + CHK_GAIN * sqrtf(num / fmaxf(den, 1e-30f)); }
#endif
#pragma unroll
            for (int j = 0; j < 4; ++j)
#pragma unroll
                for (int q = 0; q < 4; ++q) {
                    const float4 a = *(const float4*)(p.norm_final + j * 256 + l16 * 16 + q * 4);
                    *(float4*)(orow + j * 256 + q * 4) = make_float4(acc[j * 16 + q * 4] * r2 * a.x, acc[j * 16 + q * 4 + 1] * r2 * a.y, acc[j * 16 + q * 4 + 2] * r2 * a.z, acc[j * 16 + q * 4 + 3] * r2 * a.w);
                }
        }
        lds_fence();
    }
}

DI Params load_params() {
#if defined(__HIP_DEVICE_COMPILE__)
    typedef const __attribute__((address_space(4))) unsigned long long* cu64_t;
    cu64_t pp = (cu64_t)__builtin_amdgcn_kernarg_segment_ptr();
    asm volatile("" : "+s"(pp));
    static_assert(sizeof(Params) == 16 * 8, "Params is 16 qwords");
    unsigned long long w[16];
#pragma unroll
    for (int i = 0; i < 16; ++i) w[i] = pp[i];
#define GPTR(T, v) ((T*)(__attribute__((address_space(1))) T*)(v))
    Params r;
    r.x = GPTR(const float, w[0]); r.meta = GPTR(const float, w[1]); r.norm_mix = GPTR(const float, w[2]); r.w_in = GPTR(const float, w[3]);
    r.w_uv = GPTR(const float, w[4]); r.w_out = GPTR(const float, w[5]); r.norm_ffn = GPTR(const float, w[6]); r.wq = GPTR(const float, w[7]);
    r.sk = GPTR(const float, w[8]); r.pu = GPTR(const float, w[9]); r.pv = GPTR(const float, w[10]); r.norm_final = GPTR(const float, w[11]);
    r.out = GPTR(float, w[12]); r.ws = GPTR(char, w[13]);
    r.lo = (int)(unsigned)w[14]; r.hi = (int)(unsigned)(w[14] >> 32); r.pad0 = 0; r.pad1 = 0;
    return r;
#else
    return Params{};
#endif
}
#ifdef PROJ_CHECK
constexpr int PCH_ROWS = 64;
DI void phase_proj_ref_naive(const Params& p) {
    const bf16_t* hn = (const bf16_t*)(p.ws + OFF_HN); bf16_t* ref = (bf16_t*)(p.ws + OFF_ST);
    const int gtid = blockIdx.x * NTHREADS + threadIdx.x, gsz = gridDim.x * NTHREADS;
    for (int idx = gtid; idx < (PCH_ROWS / 8) * INW; idx += gsz) {
        const int c = idx % INW, r0 = (idx / INW) * 8;
        float acc[8];
#pragma unroll
        for (int i = 0; i < 8; ++i) acc[i] = 0.f;
        for (int k = 0; k < 1024; ++k) {
            const float w = bf2f(f2bf(p.w_in[(size_t)k * INW + c]));
#pragma unroll
            for (int i = 0; i < 8; ++i) { const int t_ = r0 + i; acc[i] += bf2f(hn[(size_t)(t_ < NMETA ? NF + t_ : t_ - NMETA) * DM + k]) * w; }
        }
#pragma unroll
        for (int i = 0; i < 8; ++i) ref[(size_t)(r0 + i) * INW + c] = f2bf(acc[i]);
    }
}
DI void phase_proj_compare(const Params& p) {
    const bf16_t* proj = (const bf16_t*)(p.ws + OFF_BIG); const bf16_t* ref = (const bf16_t*)(p.ws + OFF_ST); const bf16_t* dvt = (const bf16_t*)(p.ws + OFF_DVT);
    const int gtid = blockIdx.x * NTHREADS + threadIdx.x, gsz = gridDim.x * NTHREADS;
    float num = 0.f, den = 0.f;
    for (int idx = gtid; idx < PCH_ROWS * INW; idx += gsz) { const float a = bf2f(proj[idx]), r = bf2f(ref[idx]); num += (a - r) * (a - r); den += r * r; }
    for (int idx = gtid; idx < PCH_ROWS * 128; idx += gsz) {
        const int row = idx >> 7, dv = idx & 127, b = row / TT, t = row - b * TT;
        const float a = bf2f(dvt[(size_t)(b * 128 + dv) * TTP + t]), r = bf2f(ref[(size_t)row * INW + C_DV + dv]); num += (a - r) * (a - r); den += r * r;
    }
    for (int idx = gtid; idx < 7 * NMETA * INW; idx += gsz) {
        const int c = idx % INW, bt = idx / INW, b = 1 + bt / NMETA, t = bt % NMETA;
        const float a = bf2f(proj[(size_t)(b * TT + t) * INW + c]), r = bf2f(ref[(size_t)t * INW + c]); num += (a - r) * (a - r); den += r * r;
    }
    for (int idx = gtid; idx < 7 * NMETA * 128; idx += gsz) {
        const int dv = idx & 127, bt = idx >> 7, b = 1 + bt / NMETA, t = bt % NMETA;
        const float a = bf2f(dvt[(size_t)(b * 128 + dv) * TTP + t]), r = bf2f(ref[(size_t)t * INW + C_DV + dv]); num += (a - r) * (a - r); den += r * r;
    }
    num = wave_sum_uniform(num); den = wave_sum_uniform(den);
    if ((threadIdx.x & 63) == 0) { atomicAdd((float*)(p.ws + OFF_BAR) + 3600, num); atomicAdd((float*)(p.ws + OFF_BAR) + 3601, den); }
}
#endif
constexpr int NPHASES = 10;
__global__ void __launch_bounds__(NTHREADS, 2) mk_forward(Params p) {
    extern __shared__ __attribute__((aligned(16))) char dyn_smem[];
    LAS char* smem = (LAS char*)dyn_smem;
    const bool multi = (p.hi - p.lo) > 1;
    LAS char* tp_smem = smem;
    if (TP_SEC && blockIdx.x == 0 && threadIdx.x == 0) { volatile LAS long long* tp_ = (volatile LAS long long*)(smem + TP_LDS_OFF); tp_[0] = (long long)__builtin_readcyclecounter(); tp_[2] = 0; }
    XcdBarrier bar; bar.bar = (unsigned*)(p.ws + OFF_BAR); bar.x = 0; bar.st = (volatile LAS unsigned*)(smem + LDS_BAR_OFF);
    if (multi) {
        if (threadIdx.x == 0) { const u32x4 z = {0u, 0u, 0u, 0u}; *(LAS u32x4*)(smem + LDS_BAR_OFF) = z; }
        __syncthreads();
        bar = xcd_barrier_post((unsigned*)(p.ws + OFF_BAR), (volatile LAS unsigned*)(smem + LDS_BAR_OFF));
    }
#ifndef PHMASK
#define PHMASK 0xFFFF
#endif
#define PH_ON(i) (((PHMASK >> (i)) & 1) && p.lo <= (i) && (i) < p.hi)
#define PH_SYNC(i) do { if (multi && (i) + 1 < p.hi) { TP_BEGIN(7); xcd_barrier(bar); TP_END(7); } } while (0)
#ifndef REPEAT_MASK
#define REPEAT_MASK 0
#endif
#define PH_REP(i) for (int rep_ = 0; rep_ < 1 + ((REPEAT_MASK >> (i)) & 1); ++rep_)
    if (PH_ON(0)) { const Params q = load_params(); TP_BEGIN(8); PH_REP(0) phase_prologue(q, smem); TP_END(8); PH_SYNC(0); }
    if (PH_ON(1)) { const Params q = load_params(); TP_BEGIN(9); PH_REP(1) { EpiProjRope e; e.P = (bf16_t*)(q.ws + OFF_BIG); e.DVTp = (bf16_t*)(q.ws + OFF_DVT); e.c128 = (const float*)(q.ws + OFF_COS128); e.s128 = (const float*)(q.ws + OFF_SIN128); e.c64 = (const float*)(q.ws + OFF_COS64); e.s64 = (const float*)(q.ws + OFF_SIN64); gemm256<true>((const bf16_t*)(q.ws + OFF_HN), (const bf16_t*)(q.ws + OFF_WINT), 1024, NF / 256, 4096 / 256, (LAS bf16_t*)smem, e); } phase_proj_meta(q, smem); phase_fold_weights(q); TP_END(9); PH_SYNC(1); }
#ifdef ROPE_SEPARATE
    if (PH_ON(2)) { const Params q = load_params(); TP_BEGIN(5); phase_rope(q, smem, (bf16_t*)(q.ws + OFF_BIG), MROWS, true); TP_END(5); PH_SYNC(2); }
#endif
#ifdef PROJ_CHECK
    {   const Params q = load_params();
        phase_proj_ref_naive(q);
        xcd_barrier(bar);
        phase_rope(q, smem, (bf16_t*)(q.ws + OFF_ST), PCH_ROWS, false);
        xcd_barrier(bar);
        phase_proj_compare(q);
        xcd_barrier(bar);
    }
#endif
    if (PH_ON(3)) { const Params q = load_params(); PH_REP(3) {
#ifndef RS_REP
#define RS_REP 1
#endif
#ifndef DSA_REP
#define DSA_REP 1
#endif
            for (int rr_ = 0; rr_ < RS_REP; ++rr_) phase_ret_state_mfma(q, smem);
#ifdef PROJ_CHECK
            {
                bf16_t* mixed_ = (bf16_t*)(q.ws + OFF_HN);
                for (int idx = blockIdx.x * NTHREADS + threadIdx.x; idx < NF * 64; idx += gridDim.x * NTHREADS) { const int row = idx >> 6, c8 = idx & 63; const u32x4 z = {0u, 0u, 0u, 0u}; *(u32x4*)(mixed_ + (size_t)row * DM + 512 + c8 * 8) = z; }
            }
#else
            for (int rr_ = 0; rr_ < DSA_REP; ++rr_) { phase_dsa32(q, smem); __syncthreads(); }
#endif
#ifdef DSA_CHECK
            __syncthreads(); xcd_barrier(bar); phase_dsa_naive<true>(q, smem);
#endif
        } PH_SYNC(3); }
    if (PH_ON(4)) { const Params q = load_params(); TP_BEGIN(6); phase_ret_scan(q); TP_END(6); PH_SYNC(4); }
    if (PH_ON(5)) { const Params q = load_params(); PH_REP(5) phase_ret_out_mfma(q, smem); PH_SYNC(5); }
    if (PH_ON(6)) { const Params q = load_params(); PH_REP(6) {
        EpiOutT e; e.H = q.out; e.X = q.x; e.HG = (bf16_t*)(q.ws + OFF_HG); e.G = q.norm_ffn; e.SSQ = (float*)(q.ws + OFF_SSQ); gemm256<true>(
        (const bf16_t*)(q.ws + OFF_HN), (const bf16_t*)(q.ws + OFF_WOUTT), 1024, NF / 256, 1024 / 256, (LAS bf16_t*)smem, e); }
#ifdef PROJ_CHECK
        phase_convert_tables(q);
#endif
        PH_SYNC(6); }
    if (PH_ON(8)) { const Params q = load_params();
#ifndef PROJ_CHECK
        phase_convert_tables(q);
#endif
        PH_REP(8) { EpiPQ e; e.Q = (float*)(q.ws + OFF_BIG); gemm256<false>((const bf16_t*)(q.ws + OFF_HG), (const bf16_t*)(q.ws + OFF_WQT), 1024, NF / 256, 2048 / 256, (LAS bf16_t*)smem, e); } PH_SYNC(8); }
    if (PH_ON(9)) { const Params q = load_params(); PH_REP(9) { phase_peer_select(q, smem); }
        if (TP_SEC && blockIdx.x == 0 && threadIdx.x == 0) { volatile LAS long long* tp_ = (volatile LAS long long*)(smem + TP_LDS_OFF); const float fr = (float)tp_[2] / (float)((long long)__builtin_readcyclecounter() - tp_[0]); ((float*)(p.ws + OFF_BAR))[3602] = fr; }
        asm volatile("s_waitcnt vmcnt(0)" ::: "memory"); __syncthreads(); }
    if (PH_ON(10)) { const Params q = load_params(); phase_peer_out_rows(q, smem); }
}

extern "C" void kernel_launch(void* const* d_in, const int* in_sizes, int n_in, void* d_out, int out_size, void* d_ws, size_t ws_size, hipStream_t stream) {
    static int grid = 0;
    if (grid == 0) {
        if (n_in != 12 || out_size != NF * DM || ws_size < WS_END) { fprintf(stderr, "kernel_launch: unexpected shapes (n_in %d out %d ws %zu need %zu)\n", n_in, out_size, ws_size, (size_t)WS_END); grid = -1; return; }
        int dev = 0, cus = 0, per_cu = 0;
        if (hipGetDevice(&dev) != hipSuccess || hipDeviceGetAttribute(&cus, hipDeviceAttributeMultiprocessorCount, dev) != hipSuccess) { grid = -1; return; }
        if (hipFuncSetAttribute((const void*)mk_forward, hipFuncAttributeMaxDynamicSharedMemorySize, LDS_BYTES) != hipSuccess) { fprintf(stderr, "kernel_launch: hipFuncSetAttribute failed\n"); grid = -1; return; }
        if (hipOccupancyMaxActiveBlocksPerMultiprocessor(&per_cu, (const void*)mk_forward, NTHREADS, LDS_BYTES) != hipSuccess || per_cu < 1)
            fprintf(stderr, "kernel_launch: occupancy query reports %d blocks per CU\n", per_cu);
        (void)hipGetLastError();
        grid = cus > 0 ? cus : 256;
    }
    if (grid < 0) return;
    Params p{};
    p.x = (const float*)d_in[0]; p.meta = (const float*)d_in[1]; p.norm_mix = (const float*)d_in[2]; p.w_in = (const float*)d_in[3];
    p.w_uv = (const float*)d_in[4]; p.w_out = (const float*)d_in[5]; p.norm_ffn = (const float*)d_in[6]; p.wq = (const float*)d_in[7];
    p.sk = (const float*)d_in[8]; p.pu = (const float*)d_in[9]; p.pv = (const float*)d_in[10]; p.norm_final = (const float*)d_in[11];
    p.out = (float*)d_out; p.ws = (char*)d_ws; p.pad0 = 0; p.pad1 = 0;
    (void)hipMemsetAsync((char*)d_ws + OFF_BAR, 0, 16384, stream);
#if MK_LAUNCHES == 1
    p.lo = 0; p.hi = NPHASES + 1;
    hipLaunchKernelGGL(mk_forward, dim3(grid), dim3(NTHREADS), LDS_BYTES, stream, p);
#else
    for (int ph = 0; ph <= NPHASES; ++ph) { p.lo = ph; p.hi = ph + 1; hipLaunchKernelGGL(mk_forward, dim3(grid), dim3(NTHREADS), LDS_BYTES, stream, p); }
#endif
}
```

```cpp
#include <hip/hip_runtime.h>
#include <stdint.h>
#include <stdio.h>

#ifndef MK_LAUNCHES
#define MK_LAUNCHES 1
#endif

#define DI __device__ __forceinline__
#ifndef TP_SEC
#define TP_SEC 0
#endif
#ifndef CHK_GAIN
#define CHK_GAIN 10.f
#endif
#define TP_LDS_OFF (163840 - 128)
#define TP_BEGIN(k) do { if (TP_SEC == (k) && blockIdx.x == 0 && threadIdx.x == 0) { *(volatile __attribute__((address_space(3))) long long*)(tp_smem + TP_LDS_OFF + 8) = (long long)__builtin_readcyclecounter(); } } while (0)
#define TP_END(k) do { if (TP_SEC == (k) && blockIdx.x == 0 && threadIdx.x == 0) { volatile __attribute__((address_space(3))) long long* tp_ = (volatile __attribute__((address_space(3))) long long*)(tp_smem + TP_LDS_OFF); tp_[2] += (long long)__builtin_readcyclecounter() - tp_[1]; } } while (0)
typedef unsigned short bf16_t;
typedef short bf16x8 __attribute__((ext_vector_type(8)));
typedef float f32x4 __attribute__((ext_vector_type(4)));
typedef float f32x2 __attribute__((ext_vector_type(2)));
typedef unsigned u32x4 __attribute__((ext_vector_type(4)));
typedef unsigned u32x2 __attribute__((ext_vector_type(2)));

constexpr int NB = 8, SEQ = 2048, NMETA = 16, TT = 2064, DM = 1024, INW = 3912;
constexpr int MROWS = NB * TT;
constexpr int MPAD = 16640;
constexpr int NF = NB * SEQ;
constexpr int C_RQ = 0, C_RK = 512, C_RV = 1024, C_RG = 1536, C_DQ = 2048, C_DK = 3072, C_DV = 3200, C_IQ = 3328, C_IK = 3840, C_IW = 3904;
constexpr int NTHREADS = 512, NWAVES = 8;
constexpr int LDS_BYTES = 163840;
constexpr int LDS_BAR_OFF = 163840 - 256;

constexpr size_t al256(size_t x) { return (x + 255) & ~(size_t)255; }
constexpr size_t OFF_BAR = 0;
constexpr size_t OFF_COS128 = 16384;
constexpr size_t OFF_SIN128 = OFF_COS128 + al256((size_t)TT * 64 * 4);
constexpr size_t OFF_COS64 = OFF_SIN128 + al256((size_t)TT * 64 * 4);
constexpr size_t OFF_SIN64 = OFF_COS64 + al256((size_t)TT * 32 * 4);
constexpr size_t OFF_WINT = OFF_SIN64 + al256((size_t)TT * 32 * 4);
constexpr size_t OFF_WOUTT = OFF_WINT + (size_t)4096 * 1024 * 2;
constexpr size_t OFF_WQT = OFF_WOUTT + (size_t)1024 * 1024 * 2;
constexpr size_t OFF_SKH = OFF_WQT + (size_t)2048 * 1024 * 2;
constexpr size_t OFF_SKL = OFF_SKH + (size_t)2048 * 128 * 2;
constexpr int TTP = 2176;
constexpr size_t OFF_WUVT = OFF_SKL + (size_t)2048 * 128 * 2;
constexpr size_t OFF_DVT = OFF_WUVT + (size_t)8 * 64 * 128 * 2;
constexpr size_t OFF_HN = OFF_DVT + (size_t)NB * 128 * TTP * 2;
constexpr size_t OFF_BIG = OFF_HN + (size_t)MPAD * 1024 * 2;
constexpr size_t BIG_BYTES = (size_t)NF * 2048 * 4;
constexpr size_t OFF_IKC = OFF_BIG + al256((size_t)MPAD * INW * 2);
static_assert(OFF_IKC + (size_t)MROWS * 64 * 2 <= OFF_BIG + BIG_BYTES, "IKC fits behind PROJ");
constexpr size_t OFF_ST = OFF_BIG + al256(BIG_BYTES);
constexpr size_t ST_BYTES = (size_t)32 * 34 * 16384 * 4;
constexpr size_t OFF_EG = OFF_ST;
constexpr size_t OFF_U8 = OFF_EG + (size_t)NF * 128 * 4;
constexpr size_t OFF_SU = OFF_U8 + (size_t)16384 * 1024;
constexpr size_t OFF_V8 = OFF_SU + 65536;
constexpr size_t OFF_SV = OFF_V8 + (size_t)16384 * 1024;
constexpr size_t OFF_HG = OFF_SV + 65536;
constexpr size_t OFF_SSQ = OFF_HG + (size_t)NF * 1024 * 2;
constexpr size_t WS_END = OFF_SSQ + (size_t)NF * 4;
static_assert(OFF_ST + ST_BYTES <= WS_END, "retention states fit");
static_assert(WS_END <= (size_t)268435456, "workspace");

struct Params {
    const float *x, *meta, *norm_mix, *w_in, *w_uv, *w_out, *norm_ffn, *wq, *sk, *pu, *pv, *norm_final;
    float* out; char* ws; int lo, hi, pad0, pad1;
};

DI float bf2f(bf16_t v) { return __uint_as_float(((unsigned)v) << 16); }
typedef float f32x2_t __attribute__((ext_vector_type(2)));
typedef __bf16 bf16x2_t __attribute__((ext_vector_type(2)));
DI bf16_t f2bf(float f) { const __bf16 h = (__bf16)f; return __builtin_bit_cast(unsigned short, h); }
DI unsigned pk2bf(float a, float b) { const f32x2_t v = {a, b}; const bf16x2_t h = __builtin_convertvector(v, bf16x2_t); return __builtin_bit_cast(unsigned, h); }
DI float wave_sum(float v) {
#pragma unroll
    for (int o = 32; o > 0; o >>= 1) v += __shfl_xor(v, o);
    return v;
}
DI float wave_max(float v) {
#pragma unroll
    for (int o = 32; o > 0; o >>= 1) v = fmaxf(v, __shfl_xor(v, o));
    return v;
}
DI unsigned long long wave_max_u64(unsigned long long v) {
#pragma unroll
    for (int o = 32; o > 0; o >>= 1) {
        const unsigned hi = __shfl_xor((unsigned)(v >> 32), o), lo = __shfl_xor((unsigned)v, o);
        const unsigned long long w = ((unsigned long long)hi << 32) | lo;
        v = w > v ? w : v;
    }
    return v;
}
DI unsigned fkey(float x) { const unsigned u = __float_as_uint(x); return (u & 0x80000000u) ? ~u : (u | 0x80000000u); }
DI float funkey(unsigned k) { const unsigned u = (k & 0x80000000u) ? (k & 0x7fffffffu) : ~k; return __uint_as_float(u); }
DI void lds_fence() { asm volatile("s_waitcnt lgkmcnt(0)" ::: "memory"); }
DI void unpack8(const u32x4& r, float (&v)[8]) {
    v[0] = __uint_as_float(r.x << 16); v[1] = __uint_as_float(r.x & 0xffff0000u);
    v[2] = __uint_as_float(r.y << 16); v[3] = __uint_as_float(r.y & 0xffff0000u);
    v[4] = __uint_as_float(r.z << 16); v[5] = __uint_as_float(r.z & 0xffff0000u);
    v[6] = __uint_as_float(r.w << 16); v[7] = __uint_as_float(r.w & 0xffff0000u);
}

typedef float f32x16 __attribute__((ext_vector_type(16)));
DI bf16x8 pack8(const float (&x)[8]) {
    u32x4 r;
#pragma unroll
    for (int j = 0; j < 4; ++j) r[j] = pk2bf(x[2 * j], x[2 * j + 1]);
    return __builtin_bit_cast(bf16x8, r);
}
DI bf16x8 pack_hi8(const float (&x)[8], float (&rem)[8]) {
    u32x4 r;
#pragma unroll
    for (int j = 0; j < 4; ++j) { r[j] = pk2bf(x[2 * j], x[2 * j + 1]); rem[2 * j] = x[2 * j] - __uint_as_float(r[j] << 16); rem[2 * j + 1] = x[2 * j + 1] - __uint_as_float(r[j] & 0xffff0000u); }
    return __builtin_bit_cast(bf16x8, r);
}

DI float dpp_row_sum(float v) {
    v += __int_as_float(__builtin_amdgcn_update_dpp(0, __float_as_int(v), 0xB1, 0xF, 0xF, true));
    v += __int_as_float(__builtin_amdgcn_update_dpp(0, __float_as_int(v), 0x4E, 0xF, 0xF, true));
    v += __int_as_float(__builtin_amdgcn_update_dpp(0, __float_as_int(v), 0x141, 0xF, 0xF, true));
    v += __int_as_float(__builtin_amdgcn_update_dpp(0, __float_as_int(v), 0x140, 0xF, 0xF, true));
    return v;
}
DI float wave_sum_uniform(float v) {
    v = dpp_row_sum(v);
    const float a = __int_as_float(__builtin_amdgcn_readlane(__float_as_int(v), 0)), b = __int_as_float(__builtin_amdgcn_readlane(__float_as_int(v), 16));
    const float c = __int_as_float(__builtin_amdgcn_readlane(__float_as_int(v), 32)), d = __int_as_float(__builtin_amdgcn_readlane(__float_as_int(v), 48));
    return (a + b) + (c + d);
}

DI int wave_sum_int(int v) {
    v += __builtin_amdgcn_update_dpp(0, v, 0xB1, 0xF, 0xF, true);
    v += __builtin_amdgcn_update_dpp(0, v, 0x4E, 0xF, 0xF, true);
    v += __builtin_amdgcn_update_dpp(0, v, 0x141, 0xF, 0xF, true);
    v += __builtin_amdgcn_update_dpp(0, v, 0x140, 0xF, 0xF, true);
    return (__builtin_amdgcn_readlane(v, 0) + __builtin_amdgcn_readlane(v, 16)) + (__builtin_amdgcn_readlane(v, 32) + __builtin_amdgcn_readlane(v, 48));
}

#define XB_TMO      128
#define XB_XCNT(j)  (256  + 64 * (j))
#define XB_XSUB(j)  (1280 + 64 * (j))
#define XB_XGEN(j)  (2304 + 64 * (j))
#define XB_TOP      3328
#define XB_TOPGEN   3392
#define XCD_BAR_WORDS 3456
#define XB_SPIN_CAP (1u << 20)
#define LAS __attribute__((address_space(3)))

DI unsigned xb_ld(unsigned* p)              { return __hip_atomic_load(p, __ATOMIC_RELAXED, __HIP_MEMORY_SCOPE_AGENT); }
DI unsigned xb_add(unsigned* p, unsigned v) { return __hip_atomic_fetch_add(p, v, __ATOMIC_RELAXED, __HIP_MEMORY_SCOPE_AGENT); }
DI unsigned xb_xcc_id() { return (unsigned)__builtin_amdgcn_s_getreg((3 << 11) | 20) & 0xFu; }
#define XB_SPIN(cond, bar) do { unsigned _sp = 0; while (cond) { __builtin_amdgcn_s_sleep(1); \
    if ((++_sp & 255u) == 0u) { if (xb_ld(&(bar)[XB_TMO])) break; if (_sp > XB_SPIN_CAP) { atomicAdd(&(bar)[XB_TMO], 1u); break; } } } } while (0)

struct XcdBarrier { unsigned* bar; unsigned x; volatile LAS unsigned* st; };

DI XcdBarrier xcd_barrier_post(unsigned* bar, volatile LAS unsigned* st) {
    XcdBarrier b; b.bar = bar; b.x = xb_xcc_id(); b.st = st;
    if (threadIdx.x == 0) (void)xb_add(&bar[XB_XCNT(b.x)], 1u);
    return b;
}
DI void xcd_barrier_complete(unsigned* bar, unsigned x, unsigned& nloc, unsigned& nx) {
    const unsigned G = gridDim.x * gridDim.y * gridDim.z;
    unsigned sum, cnt, mine, sp = 0u;
    for (;;) {
        sum = 0u; cnt = 0u; mine = 0u;
#pragma unroll
        for (unsigned j = 0; j < 16; ++j) { const unsigned c = xb_ld(&bar[XB_XCNT(j)]); sum += c; cnt += (c > 0u) ? 1u : 0u; mine = (j == x) ? c : mine; }
        if (sum == G) break;
        __builtin_amdgcn_s_sleep(1);
        if ((++sp & 255u) == 0u) { if (xb_ld(&bar[XB_TMO])) break; if (sp > XB_SPIN_CAP) { atomicAdd(&bar[XB_TMO], 1u); break; } }
    }
    nloc = mine > 0u ? mine : 1u; nx = cnt > 0u ? cnt : 1u;
}
DI void xcd_barrier(const XcdBarrier& b) {
    asm volatile("s_waitcnt vmcnt(0)" ::: "memory");
    __syncthreads();
    if (threadIdx.x == 0) {
        unsigned* bar = b.bar;
        __builtin_amdgcn_s_waitcnt(0);
        unsigned nloc = b.st[0], nx = b.st[1];
        if (nloc == 0u) { xcd_barrier_complete(bar, b.x, nloc, nx); b.st[0] = nloc; b.st[1] = nx; }
        const unsigned old = xb_add(&bar[XB_XSUB(b.x)], 1u);
        const unsigned gen = old / nloc;
        if (old + 1u == (gen + 1u) * nloc) {
            __builtin_amdgcn_fence(__ATOMIC_RELEASE, "agent");
            asm volatile("s_waitcnt vmcnt(0)" ::: "memory");
            const unsigned og = xb_add(&bar[XB_TOP], 1u);
            const unsigned tg = og / nx;
            if (og + 1u == (tg + 1u) * nx) xb_add(&bar[XB_TOPGEN], 1u);
            else XB_SPIN(xb_ld(&bar[XB_TOPGEN]) == tg, bar);
            __builtin_amdgcn_fence(__ATOMIC_ACQUIRE, "agent");
            xb_add(&bar[XB_XGEN(b.x)], 1u);
            asm volatile("s_waitcnt vmcnt(0)" ::: "memory");
        } else {
            XB_SPIN(xb_ld(&bar[XB_XGEN(b.x)]) == gen, bar);
            __builtin_amdgcn_fence(__ATOMIC_ACQUIRE, "agent");
            asm volatile("s_waitcnt vmcnt(0)" ::: "memory");
        }
    }
    __syncthreads();
}

constexpr int BM = 256, BK = 64, HALF = 128, NXCD = 8, WGM = 8, HT = HALF * BK;
DI int lds_byte(int r, int c) {
    int st = (r >> 4) * 2 + (c >> 5), rr = r & 15, cc = c & 31, ob = rr * 64 + cc * 2;
    return st * 1024 + (ob ^ (((ob >> 9) & 1) << 5));
}
DI void stage_rc(int b, int& R, int& C) {
    int st = b / 1024, sb = b % 1024, swz = sb ^ (((sb >> 9) & 1) << 5);
    R = (st >> 1) * 16 + swz / 64; C = (st & 1) * 32 + (swz % 64) / 2;
}

#define SA(b,h) (shm+((b)*2+(h))*HT)
#define SB(b,h) (shm+(4+(b)*2+(h))*HT)
#define STAGE_X(T,P,BASE,br,kt) do{long _g=(long)(br)*K+(long)(kt)*BK; \
    for(int _i=0;_i<2;++_i){int _b=(T)*16+_i*8192;int _r,_c;stage_rc(_b,_r,_c); \
      __builtin_amdgcn_global_load_lds((const unsigned*)(BASE+_g+(long)_r*K+_c), \
        (LAS unsigned*)((LAS char*)(P)+_b),16,0,0);}}while(0)
#define STAGE(P,BASE,br,kt) STAGE_X(tst_,P,BASE,br,kt)
#define LDA(dst,b,h) for(int m=0;m<4;++m)for(int k=0;k<2;++k) \
    dst[m][k]=*reinterpret_cast<const LAS bf16x8*>((LAS char*)SA(b,h)+lds_byte(wr*64+m*16+fr,k*32+fq*8))
#define LDB(dst,b,h) for(int n=0;n<2;++n)for(int k=0;k<2;++k) \
    dst[n][k]=*reinterpret_cast<const LAS bf16x8*>((LAS char*)SB(b,h)+lds_byte(wc*32+n*16+fr,k*32+fq*8))
#define MMA(ai,bj,At,Bt_) do{__builtin_amdgcn_s_setprio(1); \
    for(int m=0;m<4;++m)for(int n=0;n<2;++n)for(int k=0;k<2;++k) \
      acc[ai][bj][m][n]=TRANS?__builtin_amdgcn_mfma_f32_16x16x32_bf16(Bt_[n][k],At[m][k],acc[ai][bj][m][n],0,0,0):__builtin_amdgcn_mfma_f32_16x16x32_bf16(At[m][k],Bt_[n][k],acc[ai][bj][m][n],0,0,0); \
    __builtin_amdgcn_s_setprio(0);}while(0)
#define WAIT_V(n) asm volatile("s_waitcnt vmcnt(" #n ")":::"memory")
#define WAIT_L(n) asm volatile("s_waitcnt lgkmcnt(" #n ")":::"memory")
#define BAR __builtin_amdgcn_s_barrier()
#define SCHED __builtin_amdgcn_sched_barrier(0)

template <bool TRANS, class Epi>
DI void gemm256(const bf16_t* __restrict__ A, const bf16_t* __restrict__ Bt, const int K, const int nM, const int nN, LAS bf16_t* shm, const Epi& epi) {
    const int nwg = nM * nN;
    for (int L = blockIdx.x; L < nwg; L += gridDim.x) {
        int wgid = L;
        { int q = nwg / NXCD, r = nwg % NXCD, xcd = wgid % NXCD, off = wgid / NXCD; wgid = (xcd < r ? xcd * (q + 1) : r * (q + 1) + (xcd - r) * q) + off; }
        int nig = WGM * nN, gid = wgid / nig, fm = gid * WGM, gsz = min(nM - fm, WGM);
        int pm = fm + ((wgid % nig) % gsz), pn = (wgid % nig) / gsz, brow = pm * BM, bcol = pn * BM;
#ifdef PROJ_CHECK
        int tst_ = threadIdx.x; asm volatile("" : "+v"(tst_));
#else
        const int tst_ = threadIdx.x;
#endif
        int wid = tst_ >> 6, lane = tst_ & 63, wr = wid >> 2, wc = wid & 3, fr = lane & 15, fq = lane >> 4;
        f32x4 acc[2][2][4][2] = {};
        bf16x8 At[4][2], B0[2][2], B1[2][2];
        int nt = K / BK;
        STAGE(SB(0,0),Bt,bcol,0); STAGE(SA(0,0),A,brow,0);
        STAGE(SB(0,1),Bt,bcol+HALF,0); STAGE(SA(0,1),A,brow+HALF,0);
        if (wr == 1) BAR;
        WAIT_V(4); BAR;
        STAGE(SB(1,0),Bt,bcol,1); STAGE(SA(1,0),A,brow,1); STAGE(SB(1,1),Bt,bcol+HALF,1);
        WAIT_V(6); BAR;
        for (int t = 0; t < nt - 2; t += 2) {
            LDB(B0,0,0); SCHED; LDA(At,0,0); STAGE(SA(1,1),A,brow+HALF,t+1);
            WAIT_L(8); BAR; WAIT_L(0); MMA(0,0,At,B0); BAR; SCHED;
            LDB(B1,0,1); STAGE(SB(0,0),Bt,bcol,t+2);
            BAR; WAIT_L(0); MMA(0,1,At,B1); BAR;
            LDA(At,0,1); STAGE(SA(0,0),A,brow,t+2);
            BAR; WAIT_L(0); MMA(1,0,At,B0); BAR; SCHED;
            STAGE(SB(0,1),Bt,bcol+HALF,t+2);
            WAIT_V(6); BAR; MMA(1,1,At,B1); BAR;
            LDB(B0,1,0); SCHED; LDA(At,1,0); STAGE(SA(0,1),A,brow+HALF,t+2);
            WAIT_L(8); BAR; WAIT_L(0); MMA(0,0,At,B0); BAR; SCHED;
            LDB(B1,1,1); STAGE(SB(1,0),Bt,bcol,t+3);
            BAR; WAIT_L(0); MMA(0,1,At,B1); BAR;
            LDA(At,1,1); STAGE(SA(1,0),A,brow,t+3);
            BAR; WAIT_L(0); MMA(1,0,At,B0); BAR; SCHED;
            STAGE(SB(1,1),Bt,bcol+HALF,t+3);
            WAIT_V(6); BAR; MMA(1,1,At,B1); BAR;
        }
        int tz = threadIdx.x; asm volatile("" : "+v"(tz)); wid = tz >> 6; lane = tz & 63; wr = wid >> 2; wc = wid & 3; fr = lane & 15; fq = lane >> 4;
        { LDB(B0,0,0); WAIT_V(0); LDA(At,0,0); STAGE_X(tz,SA(1,1),A,brow+HALF,nt-1);
          BAR; WAIT_L(0); MMA(0,0,At,B0); BAR;
          LDB(B1,0,1); BAR; WAIT_L(0); MMA(0,1,At,B1); BAR;
          LDA(At,0,1); WAIT_V(4); BAR; WAIT_L(0); MMA(1,0,At,B0); MMA(1,1,At,B1); BAR; }
        { LDB(B0,1,0); LDA(At,1,0); WAIT_V(2); BAR; WAIT_L(0); MMA(0,0,At,B0); BAR;
          LDB(B1,1,1); WAIT_V(0); BAR; WAIT_L(0); MMA(0,1,At,B1); BAR;
          LDA(At,1,1); BAR; WAIT_L(0); MMA(1,0,At,B0); MMA(1,1,At,B1); BAR; }
        if (wr == 0) BAR;
        epi(acc, brow, bcol, wr, wc, fr, fq);
        __syncthreads();
    }
}

struct EpiOut {
    float* H; const float* X;
    DI void operator()(const f32x4 (&acc)[2][2][4][2], int brow, int bcol, int wr, int wc, int fr, int fq) const {
#pragma unroll
        for (int ai = 0; ai < 2; ++ai)
#pragma unroll
        for (int bj = 0; bj < 2; ++bj)
#pragma unroll
        for (int m = 0; m < 4; ++m)
#pragma unroll
        for (int n = 0; n < 2; ++n)
#pragma unroll
        for (int j = 0; j < 4; ++j) {
            const int row = brow + ai * HALF + wr * 64 + m * 16 + fq * 4 + j, col = bcol + bj * HALF + wc * 32 + n * 16 + fr;
            const size_t o = (size_t)row * DM + col; H[o] = X[o] + acc[ai][bj][m][n][j];
        }
    }
};
struct EpiPQ {
    float* Q;
    DI void operator()(const f32x4 (&acc)[2][2][4][2], int brow, int bcol, int wr, int wc, int fr, int fq) const {
#pragma unroll
        for (int ai = 0; ai < 2; ++ai)
#pragma unroll
        for (int bj = 0; bj < 2; ++bj)
#pragma unroll
        for (int m = 0; m < 4; ++m)
#pragma unroll
        for (int n = 0; n < 2; ++n)
#pragma unroll
        for (int j = 0; j < 4; ++j) {
            const int row = brow + ai * HALF + wr * 64 + m * 16 + fq * 4 + j, col = bcol + bj * HALF + wc * 32 + n * 16 + fr;
            ((unsigned*)Q)[(size_t)row * 2048 + col] = fkey(acc[ai][bj][m][n][j]);
        }
    }
};

struct EpiOutT {
    float* H; const float* X; bf16_t* HG; const float* G; float* SSQ;
    DI void operator()(const f32x4 (&acc)[2][2][4][2], int brow, int bcol, int wr, int wc, int fr, int fq) const {
#pragma unroll
        for (int ai = 0; ai < 2; ++ai)
#pragma unroll
        for (int m = 0; m < 4; ++m) {
            const int row = brow + ai * HALF + wr * 64 + m * 16 + fr;
            const size_t o = (size_t)row * DM + bcol + wc * 32 + fq * 4;
            const float* xp = X + o; float* hp = H + o; bf16_t* gp = HG + o; const float* gn = G + bcol + wc * 32 + fq * 4;
            float ss = 0.f;
#pragma unroll
            for (int bj = 0; bj < 2; ++bj)
#pragma unroll
            for (int n = 0; n < 2; ++n) {
                const f32x4 x = *(const f32x4*)(xp + bj * HALF + n * 16); const f32x4 hv = x + acc[ai][bj][m][n];
                *(f32x4*)(hp + bj * HALF + n * 16) = hv;
                ss += hv[0] * hv[0] + hv[1] * hv[1] + hv[2] * hv[2] + hv[3] * hv[3];
                const f32x4 hg = hv * *(const f32x4*)(gn + bj * HALF + n * 16);
                uint2 w; w.x = pk2bf(hg[0], hg[1]); w.y = pk2bf(hg[2], hg[3]); *(uint2*)(gp + bj * HALF + n * 16) = w;
            }
            ss += __shfl_xor(ss, 16); ss += __shfl_xor(ss, 32);
            if (fq == 0) atomicAdd(SSQ + row, ss);
            __builtin_amdgcn_sched_barrier(0);
        }
    }
};

__host__ __device__ constexpr int proj_true_col(int n) {
    const int blk = n >> 7, P = n & 127, wc = P >> 5, nn = (P >> 4) & 1, i = P & 15;
    return blk * 128 + (blk < 26 ? wc * 16 + i + 64 * nn : (wc >> 1) * 64 + (wc & 1) * 16 + i + 32 * nn);
}
DI bool proj_block(const f32x4 x1, const f32x4 x2, const int cb, const int wc, const int fq, const int t, const float* c128, const float* s128, const float* c64, const float* s64,
                   f32x4& o1, f32x4& o2, int& c1, int& c2, bool& st2) {
    o1 = x1; o2 = x2; st2 = true;
    if (cb < C_IQ) {
        const int f = wc * 16 + fq * 4; c1 = cb + f; c2 = c1 + 64;
        const bool roped = (cb < C_RV) || (cb >= C_DQ && cb < C_DV);
        if (roped) {
            const float sc = (cb < C_RK) ? 1.f : (cb < C_RV) ? 0.08838834764831845f : (cb < C_DK) ? 0.08838834764831845f * 1.4426950408889634f : 1.f;
            const f32x4 cs = *(const f32x4*)(c128 + t * 64 + f), sn = *(const f32x4*)(s128 + t * 64 + f);
            o1 = (x1 * cs - x2 * sn) * sc; o2 = (x2 * cs + x1 * sn) * sc;
        }
        return true;
    }
    if (cb >= 3968) return false;
    const int hl = wc >> 1, f = (wc & 1) * 16 + fq * 4; c1 = cb + hl * 64 + f; c2 = c1 + 32;
    if (cb < C_IK || hl == 0) {
        const float sc = (cb < C_IK) ? 0.125f : 1.f;
        const f32x4 cs = *(const f32x4*)(c64 + t * 32 + f), sn = *(const f32x4*)(s64 + t * 32 + f);
        o1 = (x1 * cs - x2 * sn) * sc; o2 = (x2 * cs + x1 * sn) * sc;
        return true;
    }
    o1 = x1 * 0.35355339059327373f; st2 = false;
    return c1 < INW;
}
struct EpiProjRope {
    bf16_t* P; bf16_t* DVTp; bf16_t* IKCp; const float *c128, *s128, *c64, *s64;
    DI void operator()(const f32x4 (&acc)[2][2][4][2], int brow, int bcol, int wr, int wc, int fr, int fq) const {
#pragma unroll
        for (int ai = 0; ai < 2; ++ai)
#pragma unroll
        for (int m = 0; m < 4; ++m) {
            const int grow = brow + ai * HALF + wr * 64 + m * 16 + fr;
            const int b = grow >> 11, t = NMETA + (grow & 2047);
            bf16_t* rp = P + (size_t)(b * TT + t) * INW;
#pragma unroll
            for (int bj = 0; bj < 2; ++bj) {
                const int cb = bcol + bj * HALF;
                const f32x4 x1 = acc[ai][bj][m][0], x2 = acc[ai][bj][m][1];
                f32x4 o1, o2; int c1, c2; bool st2;
                if (!proj_block(x1, x2, cb, wc, fq, t, c128, s128, c64, s64, o1, o2, c1, c2, st2)) continue;
                if (cb == C_DV) {
                    bf16_t* dp = DVTp + (size_t)(b * 128 + (c1 - C_DV)) * TTP + t;
#pragma unroll
                    for (int j = 0; j < 4; ++j) { dp[(size_t)j * TTP] = f2bf(x1[j]); dp[(size_t)(64 + j) * TTP] = f2bf(x2[j]); }
                }
                uint2 w1; w1.x = pk2bf(o1[0], o1[1]); w1.y = pk2bf(o1[2], o1[3]); *(uint2*)(rp + c1) = w1;
                if (st2) {
                    uint2 w2; w2.x = pk2bf(o2[0], o2[1]); w2.y = pk2bf(o2[2], o2[3]); *(uint2*)(rp + c2) = w2;
                    if (cb == C_IK) { bf16_t* ik = IKCp + (size_t)(b * TT + t) * 64 + (c1 - C_IK); *(uint2*)(ik) = w1; *(uint2*)(ik + 32) = w2; }
                }
            }
        }
    }
};

DI void phase_prologue(const Params& p, LAS char* smem) {
    const int gtid = blockIdx.x * NTHREADS + threadIdx.x, gsz = gridDim.x * NTHREADS;
    {
        bf16_t* wint = (bf16_t*)(p.ws + OFF_WINT); bf16_t* woutt_ = (bf16_t*)(p.ws + OFF_WOUTT);
        LAS float* tl = (LAS float*)smem;
        for (int tile = blockIdx.x; tile < 16 * 64 + 16 * 16; tile += gridDim.x) {
            const bool isout = tile >= 16 * 64; const int tt = isout ? tile - 16 * 64 : tile;
            const int ncol = isout ? 16 : 64, k0 = (tt / ncol) * 64, c0 = (tt % ncol) * 64;
            const float* W = isout ? p.w_out : p.w_in; const int ldw = isout ? 1024 : INW, cmax = isout ? 1024 : INW;
            for (int i = threadIdx.x; i < 64 * 64; i += NTHREADS) { const int kk = i >> 6, cc = i & 63; tl[kk * 65 + cc] = (c0 + cc < cmax) ? W[(size_t)(k0 + kk) * ldw + c0 + cc] : 0.f; }
            __syncthreads();
            {
                const int cc = threadIdx.x >> 3, ch = threadIdx.x & 7, tc = c0 + cc;
                int n = tc;
                if (!isout) { const int blk = tc >> 7, T = tc & 127;
                    const int P = blk < 26 ? (((T & 63) >> 4) * 32 + (T >> 6) * 16 + (T & 15)) : ((((T >> 6) * 2 + ((T >> 4) & 1)) * 32) + ((T >> 5) & 1) * 16 + (T & 15));
                    n = blk * 128 + P; }
                u32x4 o;
#pragma unroll
                for (int w = 0; w < 4; ++w) o[w] = pk2bf(tl[(ch * 8 + 2 * w) * 65 + cc], tl[(ch * 8 + 2 * w + 1) * 65 + cc]);
                *(u32x4*)((isout ? woutt_ : wint) + (size_t)n * 1024 + k0 + ch * 8) = o;
            }
            __syncthreads();
        }
    }
    { float* ssq = (float*)(p.ws + OFF_SSQ); for (int idx = gtid; idx < NF; idx += gsz) ssq[idx] = 0.f; }
    {
        bf16_t* dvt = (bf16_t*)(p.ws + OFF_DVT);
        for (int idx = gtid; idx < NB * 128 * (TTP - TT); idx += gsz) { const int rw = idx / (TTP - TT), t = TT + idx % (TTP - TT); dvt[(size_t)rw * TTP + t] = (bf16_t)0; }
    }
    bf16_t* wuvt = (bf16_t*)(p.ws + OFF_WUVT);
    for (int idx = gtid; idx < 8 * 64 * 128; idx += gsz) {
        const int h = idx >> 13, e = (idx >> 7) & 63, dv = idx & 127;
        wuvt[idx] = f2bf(p.w_uv[(size_t)(h * 128 + dv) * 64 + e]);
    }
    float* c128 = (float*)(p.ws + OFF_COS128); float* s128 = (float*)(p.ws + OFF_SIN128);
    for (int idx = gtid; idx < TT * 64; idx += gsz) {
        const int pos = idx >> 6, j = idx & 63;
        const float inv = powf(10000.f, -(float)j * 2.0f / 128.f);
        const float ang = (float)pos * inv;
        float s, c; sincosf(ang, &s, &c);
        c128[idx] = c; s128[idx] = s;
    }
    float* c64 = (float*)(p.ws + OFF_COS64); float* s64 = (float*)(p.ws + OFF_SIN64);
    for (int idx = gtid; idx < TT * 32; idx += gsz) {
        const int pos = idx >> 5, j = idx & 31;
        const float inv = powf(10000.f, -(float)j * 2.0f / 64.f);
        const float ang = (float)pos * inv;
        float s, c; sincosf(ang, &s, &c);
        c64[idx] = c; s64[idx] = s;
    }
    bf16_t* hn = (bf16_t*)(p.ws + OFF_HN);
    const int wave = threadIdx.x >> 6, lane = threadIdx.x & 63;
    for (int row = blockIdx.x * NWAVES + wave; row < MPAD; row += gridDim.x * NWAVES) {
        bf16_t* o = hn + (size_t)row * DM;
        if (row >= NF + NMETA) {
            for (int i = 0; i < 4; ++i) *(uint2*)(o + i * 256 + lane * 4) = make_uint2(0u, 0u);
            continue;
        }
        const float* src = row < NF ? p.x + (size_t)row * DM : p.meta + (size_t)(row - NF) * DM;
        float4 v[4]; float ss = 0.f;
#pragma unroll
        for (int i = 0; i < 4; ++i) { v[i] = *(const float4*)(src + i * 256 + lane * 4); ss += v[i].x * v[i].x + v[i].y * v[i].y + v[i].z * v[i].z + v[i].w * v[i].w; }
        ss = wave_sum(ss);
        const float rstd = rsqrtf(ss * (1.f / DM) + 1e-6f);
#pragma unroll
        for (int i = 0; i < 4; ++i) {
            const float4 g = *(const float4*)(p.norm_mix + i * 256 + lane * 4);
            uint2 w;
            w.x = (unsigned)f2bf(v[i].x * rstd * g.x) | ((unsigned)f2bf(v[i].y * rstd * g.y) << 16);
            w.y = (unsigned)f2bf(v[i].z * rstd * g.z) | ((unsigned)f2bf(v[i].w * rstd * g.w) << 16);
            *(uint2*)(o + i * 256 + lane * 4) = w;
        }
    }
}

DI void phase_fold_weights(const Params& p) {
    {
        bf16_t* wst = (bf16_t*)(p.ws + OFF_WQT);
        int tz_ = threadIdx.x; asm volatile("" : "+v"(tz_));
        const int wave_ = tz_ >> 6, lane_ = tz_ & 63, r = lane_ & 31, hh = lane_ >> 5;
        const int skip_ = 0;
        if ((int)blockIdx.x >= skip_)
        for (int task = ((int)blockIdx.x - skip_) * NWAVES + wave_; task < 16 * 32 * 4; task += ((int)gridDim.x - skip_) * NWAVES) {
            const int nb = task & 3, hf = task >> 7, k0 = ((task >> 2) & 31) * 32;
            f32x16 acc;
#pragma unroll
            for (int i = 0; i < 16; ++i) acc[i] = 0.f;
            const float* arow = p.wq + (size_t)(k0 + r) * 2048 + hf * 128 + 8 * hh;
            const float* brow = p.sk + (size_t)(hf * 128 + nb * 32 + r) * 128 + 8 * hh;
#pragma unroll 2
            for (int ks = 0; ks < 8; ++ks) {
                const float4 a0 = *(const float4*)(arow + ks * 16), a1 = *(const float4*)(arow + ks * 16 + 4);
                const float4 b0 = *(const float4*)(brow + ks * 16), b1 = *(const float4*)(brow + ks * 16 + 4);
                const float af[8] = {a0.x, a0.y, a0.z, a0.w, a1.x, a1.y, a1.z, a1.w}; float ar[8];
                const float bf_[8] = {b0.x, b0.y, b0.z, b0.w, b1.x, b1.y, b1.z, b1.w}; float br[8];
                const bf16x8 ah = pack_hi8(af, ar); const bf16x8 al = pack8(ar);
                const bf16x8 bh = pack_hi8(bf_, br); const bf16x8 bl = pack8(br);
                acc = __builtin_amdgcn_mfma_f32_32x32x16_bf16(ah, bh, acc, 0, 0, 0);
                acc = __builtin_amdgcn_mfma_f32_32x32x16_bf16(ah, bl, acc, 0, 0, 0);
                acc = __builtin_amdgcn_mfma_f32_32x32x16_bf16(al, bh, acc, 0, 0, 0);
            }
            bf16_t* orow = wst + (size_t)(hf * 128 + nb * 32 + r) * 1024 + k0 + 4 * hh;
#pragma unroll
            for (int g4 = 0; g4 < 4; ++g4) { uint2 w; w.x = pk2bf(acc[4 * g4], acc[4 * g4 + 1]); w.y = pk2bf(acc[4 * g4 + 2], acc[4 * g4 + 3]); *(uint2*)(orow + 8 * g4) = w; }
        }
    }
}

DI void rope8(bf16_t* p1, bf16_t* p2, const float* ct, const float* st, float scale) {
    const u32x4 r1 = *(const u32x4*)p1, r2 = *(const u32x4*)p2;
    float x1[8], x2[8]; unpack8(r1, x1); unpack8(r2, x2);
    const float4 c0 = *(const float4*)ct, c1 = *(const float4*)(ct + 4), s0 = *(const float4*)st, s1 = *(const float4*)(st + 4);
    const float cs[8] = {c0.x, c0.y, c0.z, c0.w, c1.x, c1.y, c1.z, c1.w}, sn[8] = {s0.x, s0.y, s0.z, s0.w, s1.x, s1.y, s1.z, s1.w};
    u32x4 o1, o2;
#pragma unroll
    for (int i = 0; i < 4; ++i) {
        const float a0 = (x1[2 * i] * cs[2 * i] - x2[2 * i] * sn[2 * i]) * scale, a1 = (x1[2 * i + 1] * cs[2 * i + 1] - x2[2 * i + 1] * sn[2 * i + 1]) * scale;
        const float b0 = (x2[2 * i] * cs[2 * i] + x1[2 * i] * sn[2 * i]) * scale, b1 = (x2[2 * i + 1] * cs[2 * i + 1] + x1[2 * i + 1] * sn[2 * i + 1]) * scale;
        o1[i] = (unsigned)f2bf(a0) | ((unsigned)f2bf(a1) << 16); o2[i] = (unsigned)f2bf(b0) | ((unsigned)f2bf(b1) << 16);
    }
    *(u32x4*)p1 = o1; *(u32x4*)p2 = o2;
}
DI void phase_rope(const Params& p, LAS char* smem, bf16_t* proj, const int nrows, const bool do_dvt) {
    const float* c128 = (const float*)(p.ws + OFF_COS128); const float* s128 = (const float*)(p.ws + OFF_SIN128);
    const float* c64 = (const float*)(p.ws + OFF_COS64); const float* s64 = (const float*)(p.ws + OFF_SIN64);
    const int gtid = blockIdx.x * NTHREADS + threadIdx.x, gsz = gridDim.x * NTHREADS;
    const int total = nrows * 173;
    for (int idx = gtid; idx < total; idx += gsz) {
        const int row = idx / 173, it = idx - row * 173;
        const int t = row % TT;
        bf16_t* pr = proj + (size_t)row * INW;
        if (it < 32)       { const int hd = it >> 3, j = (it & 7) * 8;          rope8(pr + C_RQ + hd * 128 + j, pr + C_RQ + hd * 128 + 64 + j, c128 + t * 64 + j, s128 + t * 64 + j, 1.f); }
        else if (it < 64)  { const int i2 = it - 32, hd = i2 >> 3, j = (i2 & 7) * 8;  rope8(pr + C_RK + hd * 128 + j, pr + C_RK + hd * 128 + 64 + j, c128 + t * 64 + j, s128 + t * 64 + j, 0.08838834764831845f); }
        else if (it < 128) { const int i2 = it - 64, hd = i2 >> 3, j = (i2 & 7) * 8;  rope8(pr + C_DQ + hd * 128 + j, pr + C_DQ + hd * 128 + 64 + j, c128 + t * 64 + j, s128 + t * 64 + j, 0.08838834764831845f * 1.4426950408889634f); }
        else if (it < 136) { const int j = (it - 128) * 8;                          rope8(pr + C_DK + j, pr + C_DK + 64 + j, c128 + t * 64 + j, s128 + t * 64 + j, 1.f); }
        else if (it < 168) { const int i2 = it - 136, hd = i2 >> 2, j = (i2 & 3) * 8; rope8(pr + C_IQ + hd * 64 + j, pr + C_IQ + hd * 64 + 32 + j, c64 + t * 32 + j, s64 + t * 32 + j, 0.125f); }
        else if (it < 172) { const int j = (it - 168) * 8;                          rope8(pr + C_IK + j, pr + C_IK + 32 + j, c64 + t * 32 + j, s64 + t * 32 + j, 1.f); }
        else {
            const u32x4 r = *(const u32x4*)(pr + C_IW); float v[8]; unpack8(r, v); u32x4 o;
#pragma unroll
            for (int i = 0; i < 4; ++i) o[i] = (unsigned)f2bf(v[2 * i] * 0.35355339059327373f) | ((unsigned)f2bf(v[2 * i + 1] * 0.35355339059327373f) << 16);
            *(u32x4*)(pr + C_IW) = o;
        }
    }
    if (!do_dvt) return;
    bf16_t* dvt = (bf16_t*)(p.ws + OFF_DVT);
    LAS bf16_t* tile = (LAS bf16_t*)smem;
    for (int unit = blockIdx.x; unit < NB * (TTP / 64); unit += gridDim.x) {
        const int b = unit / (TTP / 64), t0 = (unit % (TTP / 64)) * 64;
        for (int i = threadIdx.x; i < 64 * 16; i += NTHREADS) {
            const int tr = i >> 4, ch = i & 15, t = t0 + tr;
            u32x4 v = {0u, 0u, 0u, 0u};
            if (t < TT) v = *(const u32x4*)(proj + (size_t)(b * TT + t) * INW + C_DV + ch * 8);
            *(LAS u32x4*)(tile + tr * 136 + ch * 8) = v;
        }
        __syncthreads();
        for (int i = threadIdx.x; i < 128 * 8; i += NTHREADS) {
            const int dv = i >> 3, ch = i & 7;
            u32x4 o;
#pragma unroll
            for (int w = 0; w < 4; ++w) o[w] = (unsigned)tile[(ch * 8 + 2 * w) * 136 + dv] | ((unsigned)tile[(ch * 8 + 2 * w + 1) * 136 + dv] << 16);
            *(u32x4*)(dvt + (size_t)(b * 128 + dv) * TTP + t0 + ch * 8) = o;
        }
        __syncthreads();
    }
}

#define MFMA16(a, b, c) __builtin_amdgcn_mfma_f32_16x16x32_bf16((a), (b), (c), 0, 0, 0)
#define MFMA32(a, b, c) __builtin_amdgcn_mfma_f32_32x32x16_bf16((a), (b), (c), 0, 0, 0)
DI void phase_proj_meta(const Params& p, LAS char* smem) {
    const bf16_t* hn = (const bf16_t*)(p.ws + OFF_HN) + (size_t)NF * DM;
    const bf16_t* wint = (const bf16_t*)(p.ws + OFF_WINT);
    bf16_t* proj = (bf16_t*)(p.ws + OFF_BIG); bf16_t* dvt = (bf16_t*)(p.ws + OFF_DVT);
    const float* c128 = (const float*)(p.ws + OFF_COS128); const float* s128 = (const float*)(p.ws + OFF_SIN128);
    const float* c64 = (const float*)(p.ws + OFF_COS64); const float* s64 = (const float*)(p.ws + OFF_SIN64);
    int tz = threadIdx.x; asm volatile("" : "+v"(tz));
    const int wave = tz >> 6, lane = tz & 63, c = lane & 15, g = lane >> 4;
    LAS f32x4* red = (LAS f32x4*)smem;
    const int first = gridDim.x >= 64 ? 16 : 0;
    for (int blk = (int)blockIdx.x - first; blk >= 0 && blk < 31; blk += (int)gridDim.x) {
        const int cb = blk * 128;
        const bf16_t* yrow = hn + (size_t)c * DM + wave * 128 + 8 * g;
        const bf16_t* xrow = wint + (size_t)(cb + c) * DM + wave * 128 + 8 * g;
        f32x4 acc[8];
#pragma unroll
        for (int q = 0; q < 8; ++q) acc[q] = (f32x4){0.f, 0.f, 0.f, 0.f};
#pragma unroll
        for (int ks = 0; ks < 4; ++ks) {
            const bf16x8 y = *(const bf16x8*)(yrow + ks * 32);
#pragma unroll
            for (int q = 0; q < 8; ++q) acc[q] = MFMA16(*(const bf16x8*)(xrow + (size_t)(q * 16) * DM + ks * 32), y, acc[q]);
        }
#pragma unroll
        for (int q = 0; q < 8; ++q) red[(wave * 8 + q) * 64 + lane] = acc[q];
        __syncthreads();
        if (wave < 4) {
            f32x4 a1 = {0.f, 0.f, 0.f, 0.f}, a2 = {0.f, 0.f, 0.f, 0.f};
#pragma unroll
            for (int w = 0; w < 8; ++w) { a1 += red[(w * 8 + 2 * wave) * 64 + lane]; a2 += red[(w * 8 + 2 * wave + 1) * 64 + lane]; }
            const int t = c;
            f32x4 o1, o2; int c1, c2; bool st2;
            if (proj_block(a1, a2, cb, wave, g, t, c128, s128, c64, s64, o1, o2, c1, c2, st2)) {
                uint2 w1, w2; w1.x = pk2bf(o1[0], o1[1]); w1.y = pk2bf(o1[2], o1[3]); w2.x = pk2bf(o2[0], o2[1]); w2.y = pk2bf(o2[2], o2[3]);
#pragma unroll
                for (int b = 0; b < NB; ++b) {
                    bf16_t* rp = proj + (size_t)(b * TT + t) * INW;
                    *(uint2*)(rp + c1) = w1; if (st2) *(uint2*)(rp + c2) = w2;
                    if (st2 && cb == C_IK) { bf16_t* ik = (bf16_t*)(p.ws + OFF_IKC) + (size_t)(b * TT + t) * 64 + (c1 - C_IK); *(uint2*)(ik) = w1; *(uint2*)(ik + 32) = w2; }
                    if (cb == C_DV) {
                        bf16_t* dp = dvt + (size_t)(b * 128 + (c1 - C_DV)) * TTP + t;
#pragma unroll
                        for (int j = 0; j < 4; ++j) { dp[(size_t)j * TTP] = f2bf(a1[j]); dp[(size_t)(64 + j) * TTP] = f2bf(a2[j]); }
                    }
                }
            }
        }
        __syncthreads();
    }
}

constexpr int DSA_WAVE_LDS = 2176 * 4 + 1024 * 4 + 256 * 4 + 64;
template <bool CHECK>
DI void phase_dsa_naive(const Params& p, LAS char* smem) {
    const bf16_t* proj = (const bf16_t*)(p.ws + OFF_BIG);
    bf16_t* mixed = (bf16_t*)(p.ws + OFF_HN);
    const int wave = threadIdx.x >> 6, lane = threadIdx.x & 63;
    LAS float* sSc = (LAS float*)(smem + wave * DSA_WAVE_LDS);
    LAS float* sQ = sSc + 2176;
    LAS int* sSel = (LAS int*)(sQ + 1024);
    LAS float* sIw = (LAS float*)(sSel + 256);
    const unsigned long long lt_mask = (1ull << lane) - 1ull;
    float chk_num = 0.f, chk_den = 0.f;
    for (int q = blockIdx.x * NWAVES + wave; q < NF; q += gridDim.x * NWAVES) {
        const int b = q >> 11, s = q & 2047, t = NMETA + s;
        const int nk = 80 + 64 * (s >> 6);
        const bf16_t* prow = proj + (size_t)(b * TT + t) * INW;
        for (int i = lane; i < 512; i += 64) sQ[i] = bf2f(prow[C_IQ + i]);
        if (lane < 8) sIw[lane] = bf2f(prow[C_IW + lane]);
        lds_fence();
        const bf16_t* ikbase = proj + (size_t)(b * TT) * INW + C_IK;
        const int nj = (nk + 63) >> 6;
        for (int jj = 0; jj < nj; ++jj) {
            const int k = jj * 64 + lane;
            float sc = 0.f;
            if (k < nk) {
                const bf16_t* kr = ikbase + (size_t)k * INW;
                float a[8];
#pragma unroll
                for (int h = 0; h < 8; ++h) a[h] = 0.f;
#pragma unroll 1
                for (int d8 = 0; d8 < 8; ++d8) {
                    const u32x4 raw = *(const u32x4*)(kr + d8 * 8); float kv[8]; unpack8(raw, kv);
#pragma unroll
                    for (int h = 0; h < 8; ++h) {
                        const f32x4 q0 = *(const LAS f32x4*)(sQ + h * 64 + d8 * 8), q1 = *(const LAS f32x4*)(sQ + h * 64 + d8 * 8 + 4);
                        a[h] += kv[0] * q0[0] + kv[1] * q0[1] + kv[2] * q0[2] + kv[3] * q0[3] + kv[4] * q1[0] + kv[5] * q1[1] + kv[6] * q1[2] + kv[7] * q1[3];
                    }
                }
#pragma unroll
                for (int h = 0; h < 8; ++h) sc += fmaxf(a[h], 0.f) * sIw[h];
                sc += 0.0f;
            }
            sSc[k] = sc;
        }
        lds_fence();
        int L;
        if (nk <= 256) {
            for (int i = lane; i < nk; i += 64) sSel[i] = i;
            L = nk;
        } else {
            unsigned Tkey = 0u;
            for (int bit = 31; bit >= 0; --bit) {
                const unsigned cand = Tkey | (1u << bit);
                int cnt = 0;
                for (int jj = 0; jj < nj; ++jj) {
                    const int k = jj * 64 + lane;
                    const unsigned key = (k < nk) ? fkey(sSc[k]) : 0u;
                    cnt += __popcll(__ballot(key >= cand));
                }
                if (cnt >= 256) Tkey = cand;
            }
            int cgt = 0;
            for (int jj = 0; jj < nj; ++jj) {
                const int k = jj * 64 + lane;
                const unsigned key = (k < nk) ? fkey(sSc[k]) : 0u;
                cgt += __popcll(__ballot(key > Tkey));
            }
            const int need = 256 - cgt;
            int pos = 0, eqseen = 0;
            for (int jj = 0; jj < nj; ++jj) {
                const int k = jj * 64 + lane;
                const unsigned key = (k < nk) ? fkey(sSc[k]) : 0u;
                const bool gt = key > Tkey, eq = (key == Tkey);
                const unsigned long long eqm = __ballot(eq);
                const int myeq = eqseen + __popcll(eqm & lt_mask);
                const bool sel = gt || (eq && myeq < need);
                const unsigned long long sm = __ballot(sel);
                if (sel) sSel[pos + __popcll(sm & lt_mask)] = k;
                pos += __popcll(sm); eqseen += __popcll(eqm);
            }
            L = 256;
        }
        lds_fence();
        for (int i = lane; i < 1024; i += 64) sQ[i] = bf2f(prow[C_DQ + i]);
        lds_fence();
        float sc[8][4];
        const bf16_t* dkbase = proj + (size_t)(b * TT) * INW + C_DK;
#pragma unroll
        for (int il = 0; il < 4; ++il) {
            const int i = lane + 64 * il; const bool ok = i < L; const int key = ok ? sSel[i] : 0;
            const bf16_t* kr = dkbase + (size_t)key * INW;
            float a[8];
#pragma unroll
            for (int h = 0; h < 8; ++h) a[h] = 0.f;
#pragma unroll 1
            for (int d8 = 0; d8 < 16; ++d8) {
                const u32x4 raw = *(const u32x4*)(kr + d8 * 8); float kv[8]; unpack8(raw, kv);
#pragma unroll
                for (int h = 0; h < 8; ++h) {
                    const f32x4 q0 = *(const LAS f32x4*)(sQ + h * 128 + d8 * 8), q1 = *(const LAS f32x4*)(sQ + h * 128 + d8 * 8 + 4);
                    a[h] += kv[0] * q0[0] + kv[1] * q0[1] + kv[2] * q0[2] + kv[3] * q0[3] + kv[4] * q1[0] + kv[5] * q1[1] + kv[6] * q1[2] + kv[7] * q1[3];
                }
            }
#pragma unroll
            for (int h = 0; h < 8; ++h) sc[h][il] = ok ? a[h] : -INFINITY;
        }
#pragma unroll
        for (int h = 0; h < 8; ++h) {
            float m = fmaxf(fmaxf(sc[h][0], sc[h][1]), fmaxf(sc[h][2], sc[h][3]));
            m = wave_max(m);
            float e[4], sum = 0.f;
#pragma unroll
            for (int il = 0; il < 4; ++il) { e[il] = exp2f(sc[h][il] - m); sum += e[il]; }
            sum = wave_sum(sum);
            const float inv = 1.f / sum;
#pragma unroll
            for (int il = 0; il < 4; ++il) sSc[h * 256 + lane + 64 * il] = e[il] * inv;
        }
        lds_fence();
        float o[8][2];
#pragma unroll
        for (int h = 0; h < 8; ++h) { o[h][0] = 0.f; o[h][1] = 0.f; }
        const bf16_t* dvbase = proj + (size_t)(b * TT) * INW + C_DV;
        for (int i = 0; i < L; ++i) {
            const int key = sSel[i];
            const float v0 = bf2f(dvbase[(size_t)key * INW + lane]), v1 = bf2f(dvbase[(size_t)key * INW + 64 + lane]);
#pragma unroll
            for (int h = 0; h < 8; ++h) { const float pv = sSc[h * 256 + i]; o[h][0] += pv * v0; o[h][1] += pv * v1; }
        }
        lds_fence();
#pragma unroll
        for (int h = 0; h < 8; ++h) { sQ[h * 128 + lane] = o[h][0]; sQ[h * 128 + 64 + lane] = o[h][1]; }
        lds_fence();
        for (int h = 0; h < 8; ++h) {
            float acc = 0.f;
            const float* wu = p.w_uv + (size_t)h * 128 * 64 + lane;
            for (int c = 0; c < 128; ++c) acc += sQ[h * 128 + c] * wu[c * 64];
            if (CHECK) { const float got = bf2f(mixed[(size_t)q * DM + 512 + h * 64 + lane]); chk_num += (got - acc) * (got - acc); chk_den += acc * acc; }
            else mixed[(size_t)q * DM + 512 + h * 64 + lane] = f2bf(acc);
        }
        lds_fence();
    }
    if (CHECK) {
        chk_num = wave_sum(chk_num); chk_den = wave_sum(chk_den);
        if (lane == 0) { atomicAdd((float*)(p.ws + OFF_BAR) + 3600, chk_num); atomicAdd((float*)(p.ws + OFF_BAR) + 3601, chk_den); }
    }
}

typedef unsigned long long u64;
typedef short s16x4 __attribute__((ext_vector_type(4)));
constexpr int SCLD = 2116;
constexpr int DSA_MASK_OFF = 16 * SCLD * 4;
constexpr int KLD = 136, VLD = 72, VLD2 = 136;
constexpr int DSA_VT_OFF = 128 * KLD * 2;
DI void phase_dsa_fast(const Params& p, LAS char* smem) {
    const bf16_t* proj = (const bf16_t*)(p.ws + OFF_BIG);
    const bf16_t* dvt = (const bf16_t*)(p.ws + OFF_DVT);
    const bf16_t* wuvt = (const bf16_t*)(p.ws + OFF_WUVT);
    bf16_t* mixed = (bf16_t*)(p.ws + OFF_HN);
    const int wave = threadIdx.x >> 6, lane = threadIdx.x & 63, c = lane & 15, g = lane >> 4;
    LAS float* SC = (LAS float*)smem; LAS u64* MASK = (LAS u64*)(smem + DSA_MASK_OFF);
    LAS bf16_t* KT = (LAS bf16_t*)smem; LAS bf16_t* VT = (LAS bf16_t*)(smem + DSA_VT_OFF);
    const u64 lt_mask = (1ull << lane) - 1ull;
    for (int pi = blockIdx.x; pi < 512; pi += gridDim.x)
    for (int which = 0; which < 2; ++which) {
        const int b = pi >> 6, qq = pi & 63, qt = which ? 127 - qq : qq;
        const int s0 = qt * 16, nk = 80 + 64 * (s0 >> 6), nkt = nk >> 4, nj = (nk + 63) >> 6;
        const bf16_t* pb = proj + (size_t)(b * TT) * INW;
        LAS char* tp_smem = smem; TP_BEGIN(1);
        {
            const bf16_t* qrow = pb + (size_t)(NMETA + s0 + c) * INW;
            bf16x8 bq[8][2]; float iw[8];
#pragma unroll
            for (int h = 0; h < 8; ++h) {
                bq[h][0] = *(const bf16x8*)(qrow + C_IQ + h * 64 + 8 * g);
                bq[h][1] = *(const bf16x8*)(qrow + C_IQ + h * 64 + 32 + 8 * g);
                iw[h] = bf2f(qrow[C_IW + h]);
            }
            bf16x8 a0n = {0, 0, 0, 0, 0, 0, 0, 0}, a1n = {0, 0, 0, 0, 0, 0, 0, 0};
            if (wave < nkt) { const bf16_t* krow = pb + (size_t)(wave * 16 + c) * INW + C_IK + 8 * g; a0n = *(const bf16x8*)(krow); a1n = *(const bf16x8*)(krow + 32); }
            for (int kt = wave; kt < nkt; kt += NWAVES) {
                const bf16x8 a0 = a0n, a1 = a1n;
                if (kt + NWAVES < nkt) { const bf16_t* krow = pb + (size_t)((kt + NWAVES) * 16 + c) * INW + C_IK + 8 * g; a0n = *(const bf16x8*)(krow); a1n = *(const bf16x8*)(krow + 32); }
                f32x4 isc = {0.f, 0.f, 0.f, 0.f};
#pragma unroll
                for (int h = 0; h < 8; ++h) {
                    f32x4 acc = {0.f, 0.f, 0.f, 0.f};
                    acc = MFMA16(a0, bq[h][0], acc); acc = MFMA16(a1, bq[h][1], acc);
#pragma unroll
                    for (int j = 0; j < 4; ++j) isc[j] += fmaxf(acc[j], 0.f) * iw[h];
                }
#pragma unroll
                for (int j = 0; j < 4; ++j) isc[j] += 0.0f;
                *(LAS f32x4*)(SC + c * SCLD + kt * 16 + 4 * g) = isc;
            }
            {
                const int tail = ((nj <= 11 ? 11 : (nj <= 22 ? 22 : 33)) << 6) - nk;
                for (int i = threadIdx.x; i < 16 * tail; i += NTHREADS) { const int qq_ = i / tail; SC[qq_ * SCLD + nk + (i - qq_ * tail)] = -3.0e38f; }
            }
        }
        __syncthreads(); TP_END(1); TP_BEGIN(2);
#pragma unroll 1
        for (int qi = 0; qi < 2; ++qi) {
            const int cq = wave * 2 + qi;
            unsigned kv[33];
#pragma unroll
            for (int jj = 0; jj < 11; ++jj) kv[jj] = fkey(SC[cq * SCLD + jj * 64 + lane]);
            if (nj > 11) {
#pragma unroll
                for (int jj = 11; jj < 22; ++jj) kv[jj] = fkey(SC[cq * SCLD + jj * 64 + lane]);
            } else {
#pragma unroll
                for (int jj = 11; jj < 22; ++jj) kv[jj] = 0u;
            }
            if (nj > 22) {
#pragma unroll
                for (int jj = 22; jj < 33; ++jj) kv[jj] = fkey(SC[cq * SCLD + jj * 64 + lane]);
            } else {
#pragma unroll
                for (int jj = 22; jj < 33; ++jj) kv[jj] = 0u;
            }
            unsigned Tkey = 1u;
            if (nk > 256) {
                Tkey = 0u;
#pragma unroll 1
                for (int bit = 31; bit >= 0; --bit) {
                    const unsigned cand = Tkey | (1u << bit);
                    int nl = 0;
#pragma unroll
                    for (int jj = 0; jj < 11; ++jj) nl += (kv[jj] >= cand) ? 1 : 0;
                    if (nj > 11) {
#pragma unroll
                        for (int jj = 11; jj < 22; ++jj) nl += (kv[jj] >= cand) ? 1 : 0;
                    }
                    if (nj > 22) {
#pragma unroll
                        for (int jj = 22; jj < 33; ++jj) nl += (kv[jj] >= cand) ? 1 : 0;
                    }
                    const int cnt = wave_sum_int(nl);
                    if (cnt >= 256) Tkey = cand;
                    if (cnt == 256) break;
                }
            }
            int cgl = 0;
#pragma unroll
            for (int jj = 0; jj < 33; ++jj) cgl += (kv[jj] > Tkey) ? 1 : 0;
            const int cgt = wave_sum_int(cgl);
            const int need = (nk > 256) ? 256 - cgt : 4096;
            int eqseen = 0;
#pragma unroll 1
            for (int jj = 0; jj < nj; ++jj) {
                const int k = jj * 64 + lane; const float v = SC[cq * SCLD + k];
                const unsigned key = (k < nk) ? fkey(v) : 0u;
                const bool gt = key > Tkey, eq = (key == Tkey);
                const u64 eqm = __ballot(eq);
                const int myeq = eqseen + __popcll(eqm & lt_mask);
                const u64 sm = __ballot(gt || (eq && myeq < need));
                eqseen += __popcll(eqm);
                if (lane == 0) MASK[cq * 34 + jj] = sm;
            }
        }
        __syncthreads(); TP_END(2); TP_BEGIN(3);
        {
            const int h = wave;
            const bf16_t* qrow = pb + (size_t)(NMETA + s0 + c) * INW + C_DQ + h * 128 + 8 * g;
            bf16x8 bQ[4];
#pragma unroll
            for (int ks = 0; ks < 4; ++ks) bQ[ks] = *(const bf16x8*)(qrow + ks * 32);
            f32x4 O[8];
#pragma unroll
            for (int mb = 0; mb < 8; ++mb) O[mb] = (f32x4){0.f, 0.f, 0.f, 0.f};
            float m_run = -1e30f, l_run = 0.f;
            const int prow_t = threadIdx.x >> 4, pch_t = threadIdx.x & 15;
            const bf16_t* vsrc = dvt + (size_t)(b * 128 + prow_t) * TTP + pch_t * 8;
            const int n128 = (nk + 127) >> 7;
            u32x4 pk[4], pv[4];
#pragma unroll
            for (int i = 0; i < 4; ++i) {
                int key = prow_t + 32 * i; key = key < nk ? key : nk - 1;
                pk[i] = *(const u32x4*)(pb + (size_t)key * INW + C_DK + pch_t * 8);
                pv[i] = *(const u32x4*)(vsrc + (size_t)(32 * i) * TTP);
            }
#pragma unroll 1
            for (int kb = 0; kb < n128; ++kb) {
#pragma unroll
                for (int i = 0; i < 4; ++i) {
                    *(LAS u32x4*)(KT + (prow_t + 32 * i) * KLD + pch_t * 8) = pk[i];
                    *(LAS u32x4*)(VT + (prow_t + 32 * i) * VLD2 + pch_t * 8) = pv[i];
                }
                __syncthreads();
                if (kb + 1 < n128) {
#pragma unroll
                    for (int i = 0; i < 4; ++i) {
                        int key = (kb + 1) * 128 + prow_t + 32 * i; key = key < nk ? key : nk - 1;
                        pk[i] = *(const u32x4*)(pb + (size_t)key * INW + C_DK + pch_t * 8);
                        pv[i] = *(const u32x4*)(vsrc + (size_t)(32 * i) * TTP + (kb + 1) * 128);
                    }
                }
#pragma unroll
                for (int sb = 0; sb < 2; ++sb) {
                    const int wi = kb * 2 + sb;
                    if (wi < nj) {
                        const u64 mw = MASK[c * 34 + wi];
                        f32x4 S[4];
#pragma unroll
                        for (int ct = 0; ct < 4; ++ct) {
                            f32x4 acc = {0.f, 0.f, 0.f, 0.f};
#pragma unroll
                            for (int ks = 0; ks < 4; ++ks) {
                                const bf16x8 a = *(const LAS bf16x8*)(KT + (sb * 64 + ct * 16 + c) * KLD + ks * 32 + 8 * g);
                                acc = MFMA16(a, bQ[ks], acc);
                            }
                            S[ct] = acc;
                        }
                        const u64 mws = mw >> (4 * g);
                        const unsigned mlo = (unsigned)mws, mhi = (unsigned)(mws >> 32);
                        float mblk = -1e30f;
#pragma unroll
                        for (int ct = 0; ct < 4; ++ct) {
                            const unsigned bits = ((ct & 2) ? mhi : mlo) >> ((ct & 1) * 16);
#pragma unroll
                            for (int j = 0; j < 4; ++j) {
                                S[ct][j] = ((bits >> j) & 1u) ? S[ct][j] : -1e30f;
                                mblk = fmaxf(mblk, S[ct][j]);
                            }
                        }
                        mblk = fmaxf(mblk, __shfl_xor(mblk, 16)); mblk = fmaxf(mblk, __shfl_xor(mblk, 32));
                        const float m_new = fmaxf(m_run, mblk);
                        float ps = 0.f;
#pragma unroll
                        for (int ct = 0; ct < 4; ++ct)
#pragma unroll
                            for (int j = 0; j < 4; ++j) { const float pv_ = (S[ct][j] > -1e29f) ? __builtin_amdgcn_exp2f(S[ct][j] - m_new) : 0.f; S[ct][j] = pv_; ps += pv_; }
                        if (__ballot(m_new != m_run) != 0ull) {
                            const float alpha = __builtin_amdgcn_exp2f(m_run - m_new);
                            l_run *= alpha;
#pragma unroll
                            for (int mb = 0; mb < 8; ++mb) O[mb] *= alpha;
                        }
                        l_run += ps; m_run = m_new;
                        bf16x8 bP[2];
#pragma unroll
                        for (int kk = 0; kk < 2; ++kk) {
                            u32x4 t4;
                            t4[0] = pk2bf(S[2 * kk][0], S[2 * kk][1]); t4[1] = pk2bf(S[2 * kk][2], S[2 * kk][3]);
                            t4[2] = pk2bf(S[2 * kk + 1][0], S[2 * kk + 1][1]); t4[3] = pk2bf(S[2 * kk + 1][2], S[2 * kk + 1][3]);
                            bP[kk] = __builtin_bit_cast(bf16x8, t4);
                        }
#pragma unroll
                        for (int mh = 0; mh < 2; ++mh) {
                            bf16x8 av[8];
#pragma unroll
                            for (int q = 0; q < 8; ++q) {
                                const int mb = mh * 4 + (q >> 1), kk = q & 1;
                                const LAS bf16_t* vr = VT + (mb * 16 + c) * VLD2 + sb * 64 + kk * 32 + 4 * g;
                                const s16x4 lo = *(const LAS s16x4*)(vr), hi = *(const LAS s16x4*)(vr + 16);
                                av[q] = __builtin_shufflevector(lo, hi, 0, 1, 2, 3, 4, 5, 6, 7);
                            }
                            __builtin_amdgcn_sched_barrier(0);
#pragma unroll
                            for (int q = 0; q < 8; ++q) { const int mb = mh * 4 + (q >> 1), kk = q & 1; O[mb] = MFMA16(av[q], bP[kk], O[mb]); }
                            __builtin_amdgcn_sched_barrier(0);
                        }
                    }
                }
                __syncthreads();
            }
            TP_END(3); TP_BEGIN(4);
            l_run += __shfl_xor(l_run, 16); l_run += __shfl_xor(l_run, 32);
            const float inv = 1.f / l_run;
            bf16x8 bO[4];
#pragma unroll
            for (int k2 = 0; k2 < 4; ++k2)
#pragma unroll
                for (int j = 0; j < 4; ++j) { bO[k2][j] = (short)f2bf(O[2 * k2][j] * inv); bO[k2][4 + j] = (short)f2bf(O[2 * k2 + 1][j] * inv); }
            bf16_t* orow = mixed + (size_t)(b * SEQ + s0 + c) * DM + 512 + h * 64;
            int zofs = 0; asm volatile("" : "+v"(zofs));
#pragma unroll
            for (int eb = 0; eb < 4; ++eb) {
                f32x4 acc = {0.f, 0.f, 0.f, 0.f};
#pragma unroll
                for (int k2 = 0; k2 < 4; ++k2) {
                    const bf16_t* wr = wuvt + (size_t)(h * 64 + eb * 16 + c) * 128 + k2 * 32 + 4 * g + zofs;
                    const s16x4 lo = *(const s16x4*)(wr), hi = *(const s16x4*)(wr + 16);
                    const bf16x8 a = __builtin_shufflevector(lo, hi, 0, 1, 2, 3, 4, 5, 6, 7);
                    acc = MFMA16(a, bO[k2], acc);
                }
                uint2 w;
                w.x = (unsigned)f2bf(acc[0]) | ((unsigned)f2bf(acc[1]) << 16);
                w.y = (unsigned)f2bf(acc[2]) | ((unsigned)f2bf(acc[3]) << 16);
                *(uint2*)(orow + eb * 16 + 4 * g) = w;
            }
            TP_END(4);
        }
    }
}

DI void phase_dsa32(const Params& p, LAS char* smem) {
    const bf16_t* proj = (const bf16_t*)(p.ws + OFF_BIG);
    const bf16_t* dvt = (const bf16_t*)(p.ws + OFF_DVT);
    const bf16_t* wuvt = (const bf16_t*)(p.ws + OFF_WUVT);
    bf16_t* mixed = (bf16_t*)(p.ws + OFF_HN);
    LAS float* SC = (LAS float*)smem; LAS u64* MASK = (LAS u64*)(smem + DSA_MASK_OFF);
    LAS bf16_t* KT = (LAS bf16_t*)smem; LAS bf16_t* VT = (LAS bf16_t*)(smem + DSA_VT_OFF);
    for (int pi = blockIdx.x; pi < 256; pi += gridDim.x)
    for (int which = 0; which < 2; ++which) {
        const int b = pi >> 5, qq = pi & 31, qt = which ? 63 - qq : qq;
        const int s0 = qt * 32, nk = 80 + 64 * (s0 >> 6), nkt = nk >> 4, nj = (nk + 63) >> 6;
        const bf16_t* pb = proj + (size_t)(b * TT) * INW;
        const bf16_t* ikb = (const bf16_t*)(p.ws + OFF_IKC) + (size_t)(b * TT) * 64;
        LAS char* tp_smem = smem; TP_BEGIN(1);
#pragma unroll 1
        for (int sub = 0; sub < 2; ++sub) {
            {
                int tz_ = threadIdx.x; asm volatile("" : "+v"(tz_)); const int lane = tz_ & 63, wave = __builtin_amdgcn_readfirstlane(tz_ >> 6); const int c = lane & 15, g = lane >> 4;
                const bf16_t* qrow = pb + (size_t)(NMETA + s0 + 16 * sub + c) * INW;
                bf16x8 bq[8][2]; float iw[8];
#pragma unroll
                for (int h = 0; h < 8; ++h) {
                    bq[h][0] = *(const bf16x8*)(qrow + C_IQ + h * 64 + 8 * g);
                    bq[h][1] = *(const bf16x8*)(qrow + C_IQ + h * 64 + 32 + 8 * g);
                    iw[h] = bf2f(qrow[C_IW + h]);
                }
                bf16x8 ka[4][2];
#define SI_LOAD(D, KT_) do { int kc_ = (KT_); kc_ = kc_ < nkt ? kc_ : nkt - 1; const bf16_t* krow_ = ikb + (size_t)(kc_ * 16 + c) * 64 + 8 * g; ka[D][0] = *(const bf16x8*)(krow_); ka[D][1] = *(const bf16x8*)(krow_ + 32); } while (0)
#define SI_TILE(A0, A1, KT_) do { \
                    f32x4 isc = {0.f, 0.f, 0.f, 0.f}; \
                    _Pragma("unroll") for (int h = 0; h < 8; ++h) { \
                        f32x4 acc = {0.f, 0.f, 0.f, 0.f}; \
                        acc = MFMA16(A0, bq[h][0], acc); acc = MFMA16(A1, bq[h][1], acc); \
                        _Pragma("unroll") for (int j = 0; j < 4; ++j) isc[j] += fmaxf(acc[j], 0.f) * iw[h]; \
                    } \
                    _Pragma("unroll") for (int j = 0; j < 4; ++j) isc[j] += 0.0f; \
                    *(LAS f32x4*)(SC + c * SCLD + (KT_) * 16 + 4 * g) = isc; \
                } while (0)
#pragma unroll
                for (int d = 0; d < 4; ++d) SI_LOAD(d, wave + NWAVES * d);
                int kt0 = wave;
#pragma unroll 1
                for (; kt0 + 3 * NWAVES < nkt; kt0 += 4 * NWAVES) {
#pragma unroll
                    for (int d = 0; d < 4; ++d) {
                        const int kt = kt0 + NWAVES * d;
                        SI_TILE(ka[d][0], ka[d][1], kt);
                        __builtin_amdgcn_sched_barrier(0);
                        SI_LOAD(d, kt + 4 * NWAVES);
                    }
                }
#pragma unroll
                for (int d = 0; d < 3; ++d) {
                    const int kt = kt0 + NWAVES * d;
                    if (kt < nkt) SI_TILE(ka[d][0], ka[d][1], kt);
                }
#undef SI_TILE
#undef SI_LOAD
                {
                    const int tail = ((nj <= 11 ? 11 : (nj <= 22 ? 22 : 33)) << 6) - nk;
                    for (int i = threadIdx.x; i < 16 * tail; i += NTHREADS) { const int qq_ = i / tail; SC[qq_ * SCLD + nk + (i - qq_ * tail)] = -3.0e38f; }
                }
            }
            __syncthreads();
            {
            int tz_ = threadIdx.x; asm volatile("" : "+v"(tz_)); const int lane = tz_ & 63, wave = __builtin_amdgcn_readfirstlane(tz_ >> 6); const u64 lt_mask = (1ull << lane) - 1ull;
#pragma unroll 1
            for (int qi = 0; qi < 2; ++qi) {
                const int cq = wave * 2 + qi;
                unsigned kv[33];
#pragma unroll
                for (int jj = 0; jj < 11; ++jj) kv[jj] = fkey(SC[cq * SCLD + jj * 64 + lane]);
                if (nj > 11) {
#pragma unroll
                    for (int jj = 11; jj < 22; ++jj) kv[jj] = fkey(SC[cq * SCLD + jj * 64 + lane]);
                } else {
#pragma unroll
                    for (int jj = 11; jj < 22; ++jj) kv[jj] = 0u;
                }
                if (nj > 22) {
#pragma unroll
                    for (int jj = 22; jj < 33; ++jj) kv[jj] = fkey(SC[cq * SCLD + jj * 64 + lane]);
                } else {
#pragma unroll
                    for (int jj = 22; jj < 33; ++jj) kv[jj] = 0u;
                }
                unsigned Tkey = 1u;
                if (nk > 256) {
                    Tkey = 0u;
#pragma unroll 1
                    for (int bit = 31; bit >= 0; --bit) {
                        const unsigned cand = Tkey | (1u << bit);
                        int nl = 0;
#pragma unroll
                        for (int jj = 0; jj < 11; ++jj) nl += (kv[jj] >= cand) ? 1 : 0;
                        if (nj > 11) {
#pragma unroll
                            for (int jj = 11; jj < 22; ++jj) nl += (kv[jj] >= cand) ? 1 : 0;
                        }
                        if (nj > 22) {
#pragma unroll
                            for (int jj = 22; jj < 33; ++jj) nl += (kv[jj] >= cand) ? 1 : 0;
                        }
                        const int cnt = wave_sum_int(nl);
                        if (cnt >= 256) Tkey = cand;
                        if (cnt == 256) break;
                    }
                }
                int cgl = 0;
#pragma unroll
                for (int jj = 0; jj < 33; ++jj) cgl += (kv[jj] > Tkey) ? 1 : 0;
                const int cgt = wave_sum_int(cgl);
                const int need = (nk > 256) ? 256 - cgt : 4096;
                int eqseen = 0;
#pragma unroll 1
                for (int jj = 0; jj < nj; ++jj) {
                    const int k = jj * 64 + lane; const float v = SC[cq * SCLD + k];
                    const unsigned key = (k < nk) ? fkey(v) : 0u;
                    const bool gt = key > Tkey, eq = (key == Tkey);
                    const u64 eqm = __ballot(eq);
                    const int myeq = eqseen + __popcll(eqm & lt_mask);
                    const u64 sm = __ballot(gt || (eq && myeq < need));
                    eqseen += __popcll(eqm);
                    if (lane == 0) MASK[(16 * sub + cq) * 34 + jj] = sm;
                }
                if ((nj & 1) && lane == 0) MASK[(16 * sub + cq) * 34 + nj] = 0ull;
            }
            }

            __syncthreads();
        }
        TP_END(1); TP_BEGIN(3);
        {
            int tz_ = threadIdx.x; asm volatile("" : "+v"(tz_)); const int lane = tz_ & 63, wave = __builtin_amdgcn_readfirstlane(tz_ >> 6); const int r = lane & 31, hh = lane >> 5;
            const int h = wave;
            const bf16_t* qrow = pb + (size_t)(NMETA + s0 + r) * INW + C_DQ + h * 128 + 8 * hh;
            bf16x8 bQ[8];
#pragma unroll
            for (int ks = 0; ks < 8; ++ks) bQ[ks] = *(const bf16x8*)(qrow + ks * 16);
            f32x16 O[4];
#pragma unroll
            for (int d = 0; d < 4; ++d)
#pragma unroll
                for (int i = 0; i < 16; ++i) O[d][i] = 0.f;
            float m_run = -1e30f, l_run = 0.f;
            const int n128 = (nk + 127) >> 7;
            const int drow = lane >> 4, dslot = lane & 15;
            int fa[4];
            const int rp = (r & ~12) | ((r & 4) << 1) | ((r & 8) >> 1);
#pragma unroll
            for (int m = 0; m < 4; ++m) fa[m] = rp * 256 + (((2 * m + hh) ^ (rp & 15)) << 4);
            const int fd = (rp & 8) ? -128 : 128;
#define FA(m) ((m) < 4 ? fa[(m) & 3] : fa[(m) & 3] + fd)
#define DSA_ISSUE(KB, BUF) do { \
                _Pragma("unroll") for (int j = 0; j < 4; ++j) { \
                    const int R_ = (wave * 4 + j) * 4 + drow, ch_ = dslot ^ (j * 4 + drow); \
                    int key_ = (KB) * 128 + R_; key_ = key_ < nk ? key_ : nk - 1; \
                    __builtin_amdgcn_global_load_lds((const unsigned*)(pb + (size_t)key_ * INW + C_DK + ch_ * 8), (LAS unsigned*)(smem + (BUF) * 65536 + (wave * 4 + j) * 1024), 16, 0, 0); \
                    __builtin_amdgcn_global_load_lds((const unsigned*)(dvt + (size_t)(b * 128 + R_) * TTP + (KB) * 128 + ch_ * 8), (LAS unsigned*)(smem + (BUF) * 65536 + 32768 + (wave * 4 + j) * 1024), 16, 0, 0); \
                } } while (0)
            DSA_ISSUE(0, 0);
#pragma unroll 1
            for (int kb = 0; kb < n128; ++kb) {
                asm volatile("s_waitcnt vmcnt(0)" ::: "memory");
                __syncthreads();
                if (kb + 1 < n128) DSA_ISSUE(kb + 1, (kb + 1) & 1);
                LAS char* KTb = smem + (kb & 1) * 65536; LAS char* VTb = KTb + 32768;
                const u64 mw0 = MASK[r * 34 + kb * 2], mw1 = MASK[r * 34 + kb * 2 + 1];
                f32x16 S; bf16x8 kf[8];
#define DSA_KF(KBLK) do { _Pragma("unroll") for (int ks = 0; ks < 8; ++ks) kf[ks] = *(const LAS bf16x8*)(KTb + (KBLK) * 8192 + FA(ks)); } while (0)
#define DSA_S_BLOCK(KBLK) do { \
                    const unsigned nmb_ = ~(unsigned)(((KBLK) >> 1 ? mw1 : mw0) >> ((((KBLK) & 1) * 32) + 8 * hh)); \
                    _Pragma("unroll") for (int i = 0; i < 16; ++i) { int x_; asm("v_bfe_i32 %0, %1, %2, 1" : "=v"(x_) : "v"(nmb_), "n"((i & 3) + 4 * ((i >> 2) & 1) + 16 * (i >> 3))); S[i] = __builtin_bit_cast(float, (unsigned)x_ & 0xff800000u); }     \
                    _Pragma("unroll") for (int ks = 0; ks < 8; ++ks) S = MFMA32(kf[ks], bQ[ks], S); \
                } while (0)
                DSA_KF(0);
                DSA_S_BLOCK(0);
#pragma unroll
                for (int kblk = 0; kblk < 4; ++kblk) {
                    if (kblk == 0) DSA_KF(1); else if (kblk == 1) DSA_KF(2); else if (kblk == 2) DSA_KF(3);
                    float mblk = fmaxf(S[0], S[1]);
#pragma unroll
                    for (int i = 2; i < 16; ++i) mblk = fmaxf(mblk, S[i]);
                    const auto sw = __builtin_amdgcn_permlane32_swap(__builtin_bit_cast(unsigned, mblk), __builtin_bit_cast(unsigned, mblk), false, false);
                    const float m_new = fmaxf(fmaxf(m_run, __builtin_bit_cast(float, (unsigned)sw[0])), __builtin_bit_cast(float, (unsigned)sw[1]));
                    if (__ballot(m_new != m_run) != 0ull) {
                        const float alpha = __builtin_amdgcn_exp2f(m_run - m_new);
                        l_run *= alpha;
#pragma unroll
                        for (int d = 0; d < 4; ++d)
#pragma unroll
                            for (int i = 0; i < 16; ++i) O[d][i] *= alpha;
                    }
                    m_run = m_new;
                    bf16x8 av[8];
#pragma unroll
                    for (int q = 0; q < 8; ++q) av[q] = *(const LAS bf16x8*)(VTb + (q >> 1) * 8192 + FA(2 * kblk + (q & 1)));
                    f32x2 ps2 = {0.f, 0.f};
                    const f32x2 mn2 = {m_new, m_new};
#pragma unroll
                    for (int i = 0; i < 8; ++i) {
                        f32x2 t2 = {S[2 * i], S[2 * i + 1]}; t2 = t2 - mn2;
                        t2[0] = __builtin_amdgcn_exp2f(t2[0]); t2[1] = __builtin_amdgcn_exp2f(t2[1]);
                        ps2 += t2; S[2 * i] = t2[0]; S[2 * i + 1] = t2[1];
                    }
                    l_run += ps2[0] + ps2[1];
                    bf16x8 bP[2];
#pragma unroll
                    for (int s2 = 0; s2 < 2; ++s2) {
                        u32x4 t4;
#pragma unroll
                        for (int x = 0; x < 4; ++x) t4[x] = pk2bf(S[8 * s2 + 2 * x], S[8 * s2 + 2 * x + 1]);
                        bP[s2] = __builtin_bit_cast(bf16x8, t4);
                    }
                    if (kblk < 3) DSA_S_BLOCK(kblk + 1);
#pragma unroll
                    for (int q = 0; q < 8; ++q) O[q >> 1] = MFMA32(av[q], bP[q & 1], O[q >> 1]);
                }
#undef DSA_S_BLOCK
#undef DSA_KF
            }
#undef DSA_ISSUE
#undef FA
            __syncthreads();
            TP_END(3); TP_BEGIN(4);
            l_run += __shfl_xor(l_run, 32);
            const float inv = 1.f / l_run;
            bf16x8 bO[4][2];
#pragma unroll
            for (int d = 0; d < 4; ++d)
#pragma unroll
                for (int s2 = 0; s2 < 2; ++s2) {
                    u32x4 t4;
#pragma unroll
                    for (int x = 0; x < 4; ++x) t4[x] = pk2bf(O[d][8 * s2 + 2 * x] * inv, O[d][8 * s2 + 2 * x + 1] * inv);
                    bO[d][s2] = __builtin_bit_cast(bf16x8, t4);
                }
            bf16_t* orow = mixed + (size_t)(b * SEQ + s0 + r) * DM + 512 + h * 64 + 4 * hh;
            int zofs = 0; asm volatile("" : "+v"(zofs));
#pragma unroll
            for (int eb = 0; eb < 2; ++eb) {
                f32x16 acc;
#pragma unroll
                for (int i = 0; i < 16; ++i) acc[i] = 0.f;
#pragma unroll
                for (int d = 0; d < 4; ++d)
#pragma unroll
                    for (int s2 = 0; s2 < 2; ++s2) {
                        const bf16x8 a = *(const bf16x8*)(wuvt + (size_t)(h * 64 + eb * 32 + r) * 128 + d * 32 + 16 * s2 + 8 * hh + zofs);
                        acc = MFMA32(a, bO[d][s2], acc);
                    }
#pragma unroll
                for (int g4 = 0; g4 < 4; ++g4) { uint2 w; w.x = pk2bf(acc[4 * g4], acc[4 * g4 + 1]); w.y = pk2bf(acc[4 * g4 + 2], acc[4 * g4 + 3]); *(uint2*)(orow + eb * 32 + 8 * g4) = w; }
            }
            TP_END(4);
        }
    }
}

DI void phase_ret_scan(const Params& p) {
    float* ST = (float*)(p.ws + OFF_ST);
    const int gtid = blockIdx.x * NTHREADS + threadIdx.x, gsz = gridDim.x * NTHREADS;
    for (int idx = gtid; idx < 32 * 16384; idx += gsz) {
        const int bh = idx >> 14, el = idx & 16383, h = bh & 3;
        const float gc = expf(logf(1.f - exp2f(-5.f - (float)h)) * 64.f);
        float* base = ST + (size_t)bh * 34 * 16384 + el;
        float r = 0.f;
        for (int c = 1; c < 34; ++c) {
            const float u = c < 33 ? base[(size_t)c * 16384] : 0.f;
            base[(size_t)c * 16384] = r;
            r = gc * r + u;
        }
    }
}

constexpr int RLD = 136, RTLD = 72;
DI void phase_ret_state_mfma(const Params& p, LAS char* smem) {
    const bf16_t* proj = (const bf16_t*)(p.ws + OFF_BIG);
    float* ST = (float*)(p.ws + OFF_ST);
    LAS bf16_t* sVT = (LAS bf16_t*)smem; LAS bf16_t* sKT = sVT + 128 * RTLD;
    const int wave = threadIdx.x >> 6, lane = threadIdx.x & 63, r = lane & 31, hh = lane >> 5;
    for (int unit = blockIdx.x; unit < 1024; unit += gridDim.x) {
        const int c = 1 + (unit & 31), bh = unit >> 5, h = bh & 3, b = bh >> 2;
        const float lg = logf(1.f - exp2f(-5.f - (float)h));
        {
            const int j = threadIdx.x >> 3, ch = threadIdx.x & 7, t = 64 * c + j - 112;
            const float z = expf(lg * (float)(63 - j));
#pragma unroll
            for (int q = 0; q < 2; ++q) {
                const int cc = ch + 8 * q;
                u32x4 kv = {0u, 0u, 0u, 0u}, vv = {0u, 0u, 0u, 0u};
                if (t >= 0) { const bf16_t* pr = proj + (size_t)(b * TT + t) * INW; kv = *(const u32x4*)(pr + C_RK + h * 128 + cc * 8); vv = *(const u32x4*)(pr + C_RV + h * 128 + cc * 8); }
                float vf[8]; unpack8(vv, vf);
#pragma unroll
                for (int x = 0; x < 8; ++x) {
                    sKT[(cc * 8 + x) * RTLD + j] = (bf16_t)((kv[x >> 1] >> ((x & 1) * 16)) & 0xffffu);
                    sVT[(cc * 8 + x) * RTLD + j] = f2bf(vf[x] * z);
                }
            }
        }
        __syncthreads();
        const int mb = wave >> 1;
#pragma unroll
        for (int q = 0; q < 2; ++q) {
            const int nb = (wave & 1) * 2 + q;
            f32x16 acc;
#pragma unroll
            for (int i = 0; i < 16; ++i) acc[i] = 0.f;
#pragma unroll
            for (int ks = 0; ks < 4; ++ks) {
                const bf16x8 a = *(const LAS bf16x8*)(sVT + (mb * 32 + r) * RTLD + ks * 16 + 8 * hh);
                const bf16x8 bb = *(const LAS bf16x8*)(sKT + (nb * 32 + r) * RTLD + ks * 16 + 8 * hh);
                acc = MFMA32(a, bb, acc);
            }
            float* st = ST + (size_t)(bh * 34 + c) * 16384 + nb * 32 + r;
#pragma unroll
            for (int i = 0; i < 16; ++i) st[(size_t)(mb * 32 + (i & 3) + 8 * (i >> 2) + 4 * hh) * 128] = acc[i];
        }
        __syncthreads();
    }
}
DI void phase_ret_out_mfma(const Params& p, LAS char* smem) {
    const bf16_t* proj = (const bf16_t*)(p.ws + OFF_BIG);
    const float* ST = (const float*)(p.ws + OFF_ST);
    bf16_t* mixed = (bf16_t*)(p.ws + OFF_HN);
    LAS bf16_t* sQ = (LAS bf16_t*)smem; LAS bf16_t* sK = sQ + 64 * RLD; LAS bf16_t* sVT = sK + 64 * RLD;
    LAS float* sGN = (LAS float*)(sVT + 128 * RTLD);
    const int wave = threadIdx.x >> 6, lane = threadIdx.x & 63, r = lane & 31, hh = lane >> 5;
    const int ib = wave & 1, eb = wave >> 1;
    for (int unit = blockIdx.x; unit < 1024; unit += gridDim.x) {
        const int c = 2 + (unit & 31), bh = unit >> 5, h = bh & 3, b = bh >> 2;
        const float lg = logf(1.f - exp2f(-5.f - (float)h));
        for (int i = threadIdx.x; i < 64 * 16; i += NTHREADS) {
            const int j = i >> 4, ch = i & 15; const int t = 64 * c + j - 112;
            const bf16_t* pr = proj + (size_t)(b * TT + t) * INW;
            *(LAS u32x4*)(sQ + j * RLD + ch * 8) = *(const u32x4*)(pr + C_RQ + h * 128 + ch * 8);
            *(LAS u32x4*)(sK + j * RLD + ch * 8) = *(const u32x4*)(pr + C_RK + h * 128 + ch * 8);
            const u32x4 vv = *(const u32x4*)(pr + C_RV + h * 128 + ch * 8);
#pragma unroll
            for (int x = 0; x < 8; ++x) sVT[(ch * 8 + x) * RTLD + j] = (bf16_t)((vv[x >> 1] >> ((x & 1) * 16)) & 0xffffu);
        }
        __syncthreads();
        f32x16 acc;
#pragma unroll
        for (int i = 0; i < 16; ++i) acc[i] = 0.f;
        {
            const float* R = ST + (size_t)(bh * 34 + c) * 16384 + (size_t)(eb * 32 + r) * 128 + 8 * hh;
#pragma unroll
            for (int ks = 0; ks < 8; ++ks) {
                const float4 r0 = *(const float4*)(R + ks * 16), r1 = *(const float4*)(R + ks * 16 + 4);
                const float rf[8] = {r0.x, r0.y, r0.z, r0.w, r1.x, r1.y, r1.z, r1.w};
                const bf16x8 a = pack8(rf);
                const bf16x8 bq = *(const LAS bf16x8*)(sQ + (ib * 32 + r) * RLD + ks * 16 + 8 * hh);
                acc = MFMA32(a, bq, acc);
            }
            const float xi = expf(lg * (float)(ib * 32 + r + 1));
#pragma unroll
            for (int i = 0; i < 16; ++i) acc[i] *= xi;
        }
#pragma unroll
        for (int jb = 0; jb < 2; ++jb) {
            f32x16 st;
#pragma unroll
            for (int i = 0; i < 16; ++i) st[i] = 0.f;
#pragma unroll
            for (int ks = 0; ks < 8; ++ks) {
                const bf16x8 a = *(const LAS bf16x8*)(sK + (jb * 32 + r) * RLD + ks * 16 + 8 * hh);
                const bf16x8 bq = *(const LAS bf16x8*)(sQ + (ib * 32 + r) * RLD + ks * 16 + 8 * hh);
                st = MFMA32(a, bq, st);
            }
            const int icol = ib * 32 + r;
#pragma unroll
            for (int i = 0; i < 16; ++i) {
                const int j = jb * 32 + (i & 3) + 8 * (i >> 2) + 4 * hh; const int df = icol > j ? icol - j : j - icol;
                st[i] *= expf(lg * (float)df);
            }
#pragma unroll
            for (int s2 = 0; s2 < 2; ++s2) {
                bf16x8 bp;
#pragma unroll
                for (int x = 0; x < 8; ++x) bp[x] = (short)f2bf(st[8 * s2 + x]);
                const LAS bf16_t* vr = sVT + (eb * 32 + r) * RTLD + jb * 32 + 16 * s2 + 4 * hh;
                const s16x4 lo = *(const LAS s16x4*)(vr), hi = *(const LAS s16x4*)(vr + 8);
                const bf16x8 a = __builtin_shufflevector(lo, hi, 0, 1, 2, 3, 4, 5, 6, 7);
                acc = MFMA32(a, bp, acc);
            }
        }
        float s1 = 0.f, s2 = 0.f;
#pragma unroll
        for (int i = 0; i < 16; ++i) { s1 += acc[i]; s2 += acc[i] * acc[i]; }
        s1 += __shfl_xor(s1, 32); s2 += __shfl_xor(s2, 32);
        if (hh == 0) { sGN[(eb * 64 + ib * 32 + r) * 2] = s1; sGN[(eb * 64 + ib * 32 + r) * 2 + 1] = s2; }
        __syncthreads();
        float S1 = 0.f, S2 = 0.f;
#pragma unroll
        for (int e4 = 0; e4 < 4; ++e4) { S1 += sGN[(e4 * 64 + ib * 32 + r) * 2]; S2 += sGN[(e4 * 64 + ib * 32 + r) * 2 + 1]; }
        const float mu = S1 * (1.f / 128.f), var = fmaxf(S2 * (1.f / 128.f) - mu * mu, 0.f), rs = rsqrtf(var + 1e-6f);
        const int t = 64 * c + ib * 32 + r - 112, srow = t - NMETA;
        const bf16_t* pg = proj + (size_t)(b * TT + t) * INW + C_RG + h * 128 + eb * 32 + 4 * hh;
        bf16_t* po = mixed + (size_t)(b * SEQ + srow) * DM + h * 128 + eb * 32 + 4 * hh;
#pragma unroll
        for (int g4 = 0; g4 < 4; ++g4) {
            const uint2 graw = *(const uint2*)(pg + 8 * g4);
            const float gv[4] = {__uint_as_float(graw.x << 16), __uint_as_float(graw.x & 0xffff0000u), __uint_as_float(graw.y << 16), __uint_as_float(graw.y & 0xffff0000u)};
            float o[4];
#pragma unroll
            for (int x = 0; x < 4; ++x) { const float gate = gv[x] / (1.f + expf(-gv[x])); o[x] = gate * (acc[4 * g4 + x] - mu) * rs; }
            uint2 w; w.x = (unsigned)f2bf(o[0]) | ((unsigned)f2bf(o[1]) << 16); w.y = (unsigned)f2bf(o[2]) | ((unsigned)f2bf(o[3]) << 16);
            *(uint2*)(po + 8 * g4) = w;
        }
        __syncthreads();
    }
}

DI void phase_norm2(const Params& p) {
    bf16_t* hn2 = (bf16_t*)(p.ws + OFF_HN);
    const int wave = threadIdx.x >> 6, lane = threadIdx.x & 63;
    for (int row = blockIdx.x * NWAVES + wave; row < NF; row += gridDim.x * NWAVES) {
        const float* src = p.out + (size_t)row * DM; bf16_t* o = hn2 + (size_t)row * DM;
        float4 v[4]; float ss = 0.f;
#pragma unroll
        for (int i = 0; i < 4; ++i) { v[i] = *(const float4*)(src + i * 256 + lane * 4); ss += v[i].x * v[i].x + v[i].y * v[i].y + v[i].z * v[i].z + v[i].w * v[i].w; }
        ss = wave_sum(ss);
        const float rstd = rsqrtf(ss * (1.f / DM) + 1e-6f);
#pragma unroll
        for (int i = 0; i < 4; ++i) {
            const float4 g = *(const float4*)(p.norm_ffn + i * 256 + lane * 4);
            uint2 w;
            w.x = (unsigned)f2bf(v[i].x * rstd * g.x) | ((unsigned)f2bf(v[i].y * rstd * g.y) << 16);
            w.y = (unsigned)f2bf(v[i].z * rstd * g.z) | ((unsigned)f2bf(v[i].w * rstd * g.w) << 16);
            *(uint2*)(o + i * 256 + lane * 4) = w;
        }
    }
}

__device__ const int PEER_PAIRS[50] = {0, 2, 4, 6, 8, 10, 12, 14, 16, 18, 20, 22, 32, 34, 36, 49, 51, 65, 80, 96, 112, 128, 160, 192, 224, 1, 3, 5, 7, 9, 11, 13, 15, 17, 19, 21, 23, 33, 35, 48, 50, 64, 66, 81, 97, 113, 144, 176, 208, 240};
constexpr int PSEL_WAVE_LDS = 32 * 2 * 16 * 8 + 32 * 16 * 8;
#define PSEL_CE(K, a, b) { const unsigned hi_ = (K)[a] > (K)[b] ? (K)[a] : (K)[b]; const unsigned lo_ = (K)[a] > (K)[b] ? (K)[b] : (K)[a]; (K)[a] = hi_; (K)[b] = lo_; }
#define PSEL_SORT16(K, B) do { \
    PSEL_CE(K, (B) + 0, (B) + 1); PSEL_CE(K, (B) + 2, (B) + 3); PSEL_CE(K, (B) + 0, (B) + 2); PSEL_CE(K, (B) + 1, (B) + 3); PSEL_CE(K, (B) + 1, (B) + 2); PSEL_CE(K, (B) + 4, (B) + 5); \
    PSEL_CE(K, (B) + 6, (B) + 7); PSEL_CE(K, (B) + 4, (B) + 6); PSEL_CE(K, (B) + 5, (B) + 7); PSEL_CE(K, (B) + 5, (B) + 6); PSEL_CE(K, (B) + 0, (B) + 4); PSEL_CE(K, (B) + 2, (B) + 6); \
    PSEL_CE(K, (B) + 2, (B) + 4); PSEL_CE(K, (B) + 1, (B) + 5); PSEL_CE(K, (B) + 3, (B) + 7); PSEL_CE(K, (B) + 3, (B) + 5); PSEL_CE(K, (B) + 1, (B) + 2); PSEL_CE(K, (B) + 3, (B) + 4); \
    PSEL_CE(K, (B) + 5, (B) + 6); PSEL_CE(K, (B) + 8, (B) + 9); PSEL_CE(K, (B) + 10, (B) + 11); PSEL_CE(K, (B) + 8, (B) + 10); PSEL_CE(K, (B) + 9, (B) + 11); PSEL_CE(K, (B) + 9, (B) + 10); \
    PSEL_CE(K, (B) + 12, (B) + 13); PSEL_CE(K, (B) + 14, (B) + 15); PSEL_CE(K, (B) + 12, (B) + 14); PSEL_CE(K, (B) + 13, (B) + 15); PSEL_CE(K, (B) + 13, (B) + 14); PSEL_CE(K, (B) + 8, (B) + 12); \
    PSEL_CE(K, (B) + 10, (B) + 14); PSEL_CE(K, (B) + 10, (B) + 12); PSEL_CE(K, (B) + 9, (B) + 13); PSEL_CE(K, (B) + 11, (B) + 15); PSEL_CE(K, (B) + 11, (B) + 13); PSEL_CE(K, (B) + 9, (B) + 10); \
    PSEL_CE(K, (B) + 11, (B) + 12); PSEL_CE(K, (B) + 13, (B) + 14); PSEL_CE(K, (B) + 0, (B) + 8); PSEL_CE(K, (B) + 4, (B) + 12); PSEL_CE(K, (B) + 4, (B) + 8); PSEL_CE(K, (B) + 2, (B) + 10); \
    PSEL_CE(K, (B) + 6, (B) + 14); PSEL_CE(K, (B) + 6, (B) + 10); PSEL_CE(K, (B) + 2, (B) + 4); PSEL_CE(K, (B) + 6, (B) + 8); PSEL_CE(K, (B) + 10, (B) + 12); PSEL_CE(K, (B) + 1, (B) + 9); \
    PSEL_CE(K, (B) + 5, (B) + 13); PSEL_CE(K, (B) + 5, (B) + 9); PSEL_CE(K, (B) + 3, (B) + 11); PSEL_CE(K, (B) + 7, (B) + 15); PSEL_CE(K, (B) + 7, (B) + 11); PSEL_CE(K, (B) + 3, (B) + 5); \
    PSEL_CE(K, (B) + 7, (B) + 9); PSEL_CE(K, (B) + 11, (B) + 13); PSEL_CE(K, (B) + 1, (B) + 2); PSEL_CE(K, (B) + 3, (B) + 4); PSEL_CE(K, (B) + 5, (B) + 6); PSEL_CE(K, (B) + 7, (B) + 8); \
    PSEL_CE(K, (B) + 9, (B) + 10); PSEL_CE(K, (B) + 11, (B) + 12); PSEL_CE(K, (B) + 13, (B) + 14); \
} while (0)
#define PSEL_BMERGE16(K) do { \
    PSEL_CE(K, 0, 8); PSEL_CE(K, 1, 9); PSEL_CE(K, 2, 10); PSEL_CE(K, 3, 11); PSEL_CE(K, 4, 12); PSEL_CE(K, 5, 13); \
    PSEL_CE(K, 6, 14); PSEL_CE(K, 7, 15); PSEL_CE(K, 0, 4); PSEL_CE(K, 1, 5); PSEL_CE(K, 2, 6); PSEL_CE(K, 3, 7); \
    PSEL_CE(K, 8, 12); PSEL_CE(K, 9, 13); PSEL_CE(K, 10, 14); PSEL_CE(K, 11, 15); PSEL_CE(K, 0, 2); PSEL_CE(K, 1, 3); \
    PSEL_CE(K, 4, 6); PSEL_CE(K, 5, 7); PSEL_CE(K, 8, 10); PSEL_CE(K, 9, 11); PSEL_CE(K, 12, 14); PSEL_CE(K, 13, 15); \
    PSEL_CE(K, 0, 1); PSEL_CE(K, 2, 3); PSEL_CE(K, 4, 5); PSEL_CE(K, 6, 7); PSEL_CE(K, 8, 9); PSEL_CE(K, 10, 11); \
    PSEL_CE(K, 12, 13); PSEL_CE(K, 14, 15); \
} while (0)
DI void phase_peer_select(const Params& p, LAS char* smem) {
    const float* PQ = (const float*)(p.ws + OFF_BIG);
    unsigned* EG = (unsigned*)(p.ws + OFF_EG); const float* SSQ = (const float*)(p.ws + OFF_SSQ);
    int tz = threadIdx.x; asm volatile("" : "+v"(tz));
    const int wave = __builtin_amdgcn_readfirstlane(tz >> 6), lane = tz & 63, r = lane & 31, hh = lane >> 5;
    LAS float* lv = (LAS float*)(smem + wave * PSEL_WAVE_LDS);
    LAS int* li = (LAS int*)(lv + 32 * 2 * 16);
    LAS float* cs = (LAS float*)(li + 32 * 2 * 16);
    LAS int* cab = (LAS int*)(cs + 32 * 16);
    for (int task = blockIdx.x * NWAVES + wave; task < (NF / 32) * 8; task += gridDim.x * NWAVES) {
        const int tile = task >> 3, h = task & 7;
        const int n = tile * 32 + r;
#pragma unroll 1
        for (int half = 0; half < 2; ++half) {
            unsigned K[64];
            {
                const unsigned* srow = (const unsigned*)PQ + (size_t)n * 2048 + h * 256 + half * 128 + hh * 64;
#pragma unroll
                for (int q = 0; q < 16; ++q) {
                    const u32x4 a = *(const u32x4*)(srow + q * 4);
#pragma unroll
                    for (int j = 0; j < 4; ++j) K[q * 4 + j] = (a[j] & ~127u) | (unsigned)(q * 4 + j);
                }
            }
            PSEL_SORT16(K, 0); PSEL_SORT16(K, 16); PSEL_SORT16(K, 32); PSEL_SORT16(K, 48);
#pragma unroll
            for (int c = 1; c < 4; ++c) {
#pragma unroll
                for (int i = 0; i < 16; ++i) K[i] = K[i] > K[16 * c + 15 - i] ? K[i] : K[16 * c + 15 - i];
                PSEL_BMERGE16(K);
            }
            {
                unsigned Tp[16];
#pragma unroll
                for (int i = 0; i < 16; ++i) { K[i] |= (unsigned)hh << 6; Tp[i] = (unsigned)__shfl_xor((int)K[i], 32); }
#pragma unroll
                for (int i = 0; i < 16; ++i) K[i] = K[i] > Tp[15 - i] ? K[i] : Tp[15 - i];
                PSEL_BMERGE16(K);
            }
            LAS float* lvp = lv + (r * 2 + half) * 16; LAS int* lip = li + (r * 2 + half) * 16;
#pragma unroll
            for (int i = 0; i < 16; ++i) { lvp[i] = funkey(K[i] & ~127u); lip[i] = (int)(K[i] & 127u); }
        }
        lds_fence();
        int code[25]; float cv[25];
#pragma unroll
        for (int i = 0; i < 25; ++i) {
            code[i] = PEER_PAIRS[hh * 25 + i];
            cv[i] = lv[(r * 2 + 0) * 16 + (code[i] >> 4)] + lv[(r * 2 + 1) * 16 + (code[i] & 15)];
        }
        float mprev = INFINITY;
#pragma unroll 1
        for (int it = 0; it < 16; ++it) {
            float m = -INFINITY;
#pragma unroll
            for (int i = 0; i < 25; ++i) { const float v = cv[i]; m = fmaxf(m, v < mprev ? v : -INFINITY); }
            m = fmaxf(m, __shfl_xor(m, 32));
            mprev = m;
        }
        const float Tc = mprev;
        int cnt = 0;
#pragma unroll
        for (int i = 0; i < 25; ++i) cnt += (cv[i] >= Tc) ? 1 : 0;
        const int pc = __shfl_xor(cnt, 32);
        int pos = hh ? pc : 0;
#pragma unroll
        for (int i = 0; i < 25; ++i) {
            if (cv[i] >= Tc) { if (pos < 16) { cs[r * 16 + pos] = cv[i]; cab[r * 16 + pos] = code[i]; } ++pos; }
        }
        lds_fence();
        const float rstd = rsqrtf(SSQ[n] * (1.f / DM) + 1e-6f);
        float scv[16]; float mx = -INFINITY;
#pragma unroll
        for (int i = 0; i < 16; ++i) { scv[i] = cs[r * 16 + i]; mx = fmaxf(mx, scv[i]); }
        float sum = 0.f;
#pragma unroll
        for (int i = 0; i < 16; ++i) { scv[i] = expf((scv[i] - mx) * rstd); sum += scv[i]; }
        const float inv = 1.f / sum;
#pragma unroll
        for (int i = 0; i < 16; ++i) {
            if ((i >> 3) == hh) {
                const int ab = cab[r * 16 + i];
                const int e = li[(r * 2 + 0) * 16 + (ab >> 4)] * 128 + li[(r * 2 + 1) * 16 + (ab & 15)];
                const _Float16 gh = (_Float16)(scv[i] * inv);
                EG[(size_t)n * 128 + h * 16 + i] = (unsigned)e | ((unsigned)__builtin_bit_cast(unsigned short, gh) << 16);
            }
        }
        lds_fence();
    }
}

typedef float f32x2 __attribute__((ext_vector_type(2)));
DI void phase_convert_tables(const Params& p) {
    int tz = threadIdx.x; asm volatile("" : "+v"(tz));
    const int wave = tz >> 6, lane = tz & 63;
    for (int rowi = blockIdx.x * NWAVES + wave; rowi < 2 * 16384; rowi += gridDim.x * NWAVES) {
        const bool isv = rowi >= 16384; const int e = isv ? rowi - 16384 : rowi;
        const float* src = (isv ? p.pv : p.pu) + (size_t)e * DM + lane * 16;
        float x[16]; float mx = 0.f;
#pragma unroll
        for (int i = 0; i < 4; ++i) { const float4 a = *(const float4*)(src + i * 4); x[i * 4] = a.x; x[i * 4 + 1] = a.y; x[i * 4 + 2] = a.z; x[i * 4 + 3] = a.w; }
#pragma unroll
        for (int i = 0; i < 16; ++i) mx = fmaxf(mx, fabsf(x[i]));
        mx = wave_max(mx);
        const float top = isv ? 240.f : 127.f;
        const float inv = mx > 0.f ? top / mx : 0.f, scale = mx > 0.f ? mx / top : 0.f;
        u32x4 o;
        if (isv) {
#pragma unroll
            for (int w = 0; w < 4; ++w) {
                int pk = 0;
                pk = __builtin_amdgcn_cvt_pk_fp8_f32(x[w * 4] * inv, x[w * 4 + 1] * inv, pk, false);
                pk = __builtin_amdgcn_cvt_pk_fp8_f32(x[w * 4 + 2] * inv, x[w * 4 + 3] * inv, pk, true);
                o[w] = (unsigned)pk;
            }
        } else {
#pragma unroll
            for (int w = 0; w < 4; ++w) {
                unsigned pk = 0u;
#pragma unroll
                for (int b = 0; b < 4; ++b) { const int q = (int)rintf(x[w * 4 + b] * inv); pk |= ((unsigned)q & 0xffu) << (8 * b); }
                o[w] = pk;
            }
        }
        *(u32x4*)(p.ws + (isv ? OFF_V8 : OFF_U8) + (size_t)e * DM + lane * 16) = o;
        if (lane == 0) ((float*)(p.ws + (isv ? OFF_SV : OFF_SU)))[e] = scale;
    }
}
DI void unpack16_fp8(const u32x4& r, float (&v)[16]) {
#pragma unroll
    for (int w = 0; w < 4; ++w) {
        const f32x2 a = __builtin_amdgcn_cvt_pk_f32_fp8((int)r[w], false), b = __builtin_amdgcn_cvt_pk_f32_fp8((int)r[w], true);
        v[w * 4] = a[0]; v[w * 4 + 1] = a[1]; v[w * 4 + 2] = b[0]; v[w * 4 + 3] = b[1];
    }
}
constexpr int RW_NB = 128, RW_SH = 7;
constexpr int RW_WAVE_LDS = 4 * (RW_NB + 16) * 4 + 4 * 128 * 4 + 4 * 128 * 4;
DI float gelu_as(float v) {
    const float av = fabsf(v), t = __builtin_amdgcn_rcpf(av * 0.2316418882f + 1.0f);
    float q = t * 0.5307027145f + (-0.7265760135f); q = q * t + 0.7107068705f; q = q * t + (-0.142248368f); q = q * t + 0.127414796f; q = q * t;
    const float e = __builtin_amdgcn_exp2f((v * v) * (-0.72134752044f));
    const float m = v * (q * e), r = v - m;
    return v < 0.f ? m : r;
}
DI void phase_peer_out_rows(const Params& p, LAS char* smem) {
    const unsigned* EG = (const unsigned*)(p.ws + OFF_EG);
    const char* U8 = p.ws + OFF_U8; const char* V8 = p.ws + OFF_V8;
    const float* SU = (const float*)(p.ws + OFF_SU); const float* SV = (const float*)(p.ws + OFF_SV);
    int tz = threadIdx.x; asm volatile("" : "+v"(tz));
    const int wave = __builtin_amdgcn_readfirstlane(tz >> 6), lane = tz & 63, r = lane >> 4, l16 = lane & 15;
    LAS int* cnt = (LAS int*)(smem + wave * RW_WAVE_LDS) + r * (RW_NB + 16);
    LAS int* list_e = (LAS int*)(smem + wave * RW_WAVE_LDS + 4 * (RW_NB + 16) * 4) + r * 128;
    LAS float* list_g = (LAS float*)(smem + wave * RW_WAVE_LDS + 4 * (RW_NB + 16) * 4 + 2048) + r * 128;
    for (int grp = blockIdx.x * NWAVES + wave; grp < NF / 4; grp += gridDim.x * NWAVES) {
        const int n = grp * 4 + r;
        float acc[64]; int hq[16]; float hscale;
        const float* hrow = p.out + (size_t)n * DM + l16 * 16;
        {
            float hn[64];
            float ss = 0.f;
#pragma unroll
            for (int j = 0; j < 4; ++j)
#pragma unroll
                for (int q = 0; q < 4; ++q) { const float4 a = *(const float4*)(hrow + j * 256 + q * 4); hn[j * 16 + q * 4] = a.x; hn[j * 16 + q * 4 + 1] = a.y; hn[j * 16 + q * 4 + 2] = a.z; hn[j * 16 + q * 4 + 3] = a.w; }
#pragma unroll
            for (int i = 0; i < 64; ++i) ss += hn[i] * hn[i];
            ss = dpp_row_sum(ss);
            const float rstd = rsqrtf(ss * (1.f / DM) + 1e-6f);
#pragma unroll
            for (int j = 0; j < 4; ++j)
#pragma unroll
                for (int q = 0; q < 4; ++q) {
                    const float4 a = *(const float4*)(p.norm_ffn + j * 256 + l16 * 16 + q * 4);
                    hn[j * 16 + q * 4] *= rstd * a.x; hn[j * 16 + q * 4 + 1] *= rstd * a.y; hn[j * 16 + q * 4 + 2] *= rstd * a.z; hn[j * 16 + q * 4 + 3] *= rstd * a.w;
                }
            float hm = 0.f;
#pragma unroll
            for (int i = 0; i < 64; ++i) hm = fmaxf(hm, fabsf(hn[i]));
            hm = fmaxf(hm, __int_as_float(__builtin_amdgcn_update_dpp(0, __float_as_int(hm), 0xB1, 0xF, 0xF, true)));
            hm = fmaxf(hm, __int_as_float(__builtin_amdgcn_update_dpp(0, __float_as_int(hm), 0x4E, 0xF, 0xF, true)));
            hm = fmaxf(hm, __int_as_float(__builtin_amdgcn_update_dpp(0, __float_as_int(hm), 0x141, 0xF, 0xF, true)));
            hm = fmaxf(hm, __int_as_float(__builtin_amdgcn_update_dpp(0, __float_as_int(hm), 0x140, 0xF, 0xF, true)));
            const float hinv = hm > 0.f ? 127.f / hm : 0.f; hscale = hm * (1.f / 127.f);
#pragma unroll
            for (int w = 0; w < 16; ++w) {
                unsigned pk = 0u;
#pragma unroll
                for (int b = 0; b < 4; ++b) { const int q = (int)rintf(hn[w * 4 + b] * hinv); pk |= ((unsigned)q & 0xffu) << (8 * b); }
                hq[w] = (int)pk;
            }
#pragma unroll
            for (int i = 0; i < 64; ++i) acc[i] = 0.f;
        }
#pragma unroll
        for (int q = 0; q < RW_NB / 16; ++q) cnt[q * 16 + l16] = 0;
        lds_fence();
        {
            int ek[8], rk[8]; float gk[8];
#pragma unroll
            for (int k = 0; k < 8; ++k) { const unsigned w = EG[(size_t)n * 128 + k * 16 + l16]; ek[k] = (int)(w & 0xffffu); gk[k] = (float)__builtin_bit_cast(_Float16, (unsigned short)(w >> 16)); }
#pragma unroll
            for (int k = 0; k < 8; ++k) rk[k] = __hip_atomic_fetch_add(&cnt[ek[k] >> RW_SH], 1, __ATOMIC_RELAXED, __HIP_MEMORY_SCOPE_WORKGROUP);
            lds_fence();
            {
                constexpr int PB = RW_NB / 16;
                int c[PB], tot = 0;
#pragma unroll
                for (int q = 0; q < PB; ++q) { c[q] = cnt[l16 * PB + q]; tot += c[q]; }
                cnt[RW_NB + l16] = tot;
                lds_fence();
                int base = 0;
#pragma unroll
                for (int q = 0; q < 16; ++q) { const int v = cnt[RW_NB + q]; base += (q < l16) ? v : 0; }
#pragma unroll
                for (int q = 0; q < PB; ++q) { cnt[l16 * PB + q] = base; base += c[q]; }
            }
            lds_fence();
#pragma unroll
            for (int k = 0; k < 8; ++k) { const int pos = cnt[ek[k] >> RW_SH] + rk[k]; list_e[pos] = ek[k]; list_g[pos] = gk[k]; }
        }
        lds_fence();
        {
            u32x4 ub[4], vb[4]; float g_c, su_c, sv_c, g_n = 0.f, su_n = 0.f, sv_n = 0.f;
            {
                const int e_ = list_e[0]; g_c = list_g[0]; su_c = SU[e_]; sv_c = SV[e_];
#pragma unroll
                for (int j = 0; j < 4; ++j) { ub[j] = *(const u32x4*)(U8 + (size_t)e_ * DM + l16 * 16 + j * 256); vb[j] = *(const u32x4*)(V8 + (size_t)e_ * DM + l16 * 16 + j * 256); }
            }
#pragma unroll 1
            for (int sl = 0; sl < 128; ++sl) {
                int isum = 0;
#pragma unroll
                for (int j = 0; j < 4; ++j)
#pragma unroll
                    for (int w = 0; w < 4; ++w) isum = __builtin_amdgcn_sdot4((int)ub[j][w], hq[j * 4 + w], isum, false);
                isum += __builtin_amdgcn_update_dpp(0, isum, 0xB1, 0xF, 0xF, true);
                isum += __builtin_amdgcn_update_dpp(0, isum, 0x4E, 0xF, 0xF, true);
                isum += __builtin_amdgcn_update_dpp(0, isum, 0x141, 0xF, 0xF, true);
                isum += __builtin_amdgcn_update_dpp(0, isum, 0x140, 0xF, 0xF, true);
                float t_ = (float)isum * hscale;
                const int sn = sl + 1 < 128 ? sl + 1 : 127;
                const int e_n = list_e[sn];
                {
                    const char* up_ = U8 + (size_t)e_n * DM + l16 * 16;
#pragma unroll
                    for (int j = 0; j < 4; ++j) ub[j] = *(const u32x4*)(up_ + j * 256);
                    g_n = list_g[sn]; su_n = SU[e_n]; sv_n = SV[e_n];
                }
                t_ *= su_c;
                const float coef_ = gelu_as(t_) * g_c * sv_c;
#pragma unroll
                for (int j = 0; j < 4; ++j) { float v[16]; unpack16_fp8(vb[j], v);
#pragma unroll
                    for (int i = 0; i < 16; ++i) acc[j * 16 + i] += coef_ * v[i]; }
                {
                    const char* vp_ = V8 + (size_t)e_n * DM + l16 * 16;
#pragma unroll
                    for (int j = 0; j < 4; ++j) vb[j] = *(const u32x4*)(vp_ + j * 256);
                }
                g_c = g_n; su_c = su_n; sv_c = sv_n;
            }
        }
        {
            float* orow = p.out + (size_t)n * DM + l16 * 16;
            float s2 = 0.f;
#pragma unroll
            for (int j = 0; j < 4; ++j)
#pragma unroll
                for (int q = 0; q < 4; ++q) { const float4 a = *(const float4*)(orow + j * 256 + q * 4); acc[j * 16 + q * 4] += a.x; acc[j * 16 + q * 4 + 1] += a.y; acc[j * 16 + q * 4 + 2] += a.z; acc[j * 16 + q * 4 + 3] += a.w; }
#pragma unroll
            for (int i = 0; i < 64; ++i) s2 += acc[i] * acc[i];
            s2 = dpp_row_sum(s2);
            float r2 = rsqrtf(s2 * (1.f / DM) + 1e-6f);
#if TP_SEC
            r2 *= 1.f + 0.5f * ((const float*)(p.ws + OFF_BAR))[3602];
#endif
#if defined(DSA_CHECK) || defined(PROJ_CHECK)
            { const float num = ((const float*)(p.ws + OFF_BAR))[3600], den = ((const float*)(p.ws + OFF_BAR))[3601]; r2 *= 1.f + CHK_GAIN * sqrtf(num / fmaxf(den, 1e-30f)); }
#endif
#pragma unroll
            for (int j = 0; j < 4; ++j)
#pragma unroll
                for (int q = 0; q < 4; ++q) {
                    const float4 a = *(const float4*)(p.norm_final + j * 256 + l16 * 16 + q * 4);
                    *(float4*)(orow + j * 256 + q * 4) = make_float4(acc[j * 16 + q * 4] * r2 * a.x, acc[j * 16 + q * 4 + 1] * r2 * a.y, acc[j * 16 + q * 4 + 2] * r2 * a.z, acc[j * 16 + q * 4 + 3] * r2 * a.w);
                }
        }
        lds_fence();
    }
}

DI Params load_params() {
#if defined(__HIP_DEVICE_COMPILE__)
    typedef const __attribute__((address_space(4))) unsigned long long* cu64_t;
    cu64_t pp = (cu64_t)__builtin_amdgcn_kernarg_segment_ptr();
    asm volatile("" : "+s"(pp));
    static_assert(sizeof(Params) == 16 * 8, "Params is 16 qwords");
    unsigned long long w[16];
#pragma unroll
    for (int i = 0; i < 16; ++i) w[i] = pp[i];
#define GPTR(T, v) ((T*)(__attribute__((address_space(1))) T*)(v))
    Params r;
    r.x = GPTR(const float, w[0]); r.meta = GPTR(const float, w[1]); r.norm_mix = GPTR(const float, w[2]); r.w_in = GPTR(const float, w[3]);
    r.w_uv = GPTR(const float, w[4]); r.w_out = GPTR(const float, w[5]); r.norm_ffn = GPTR(const float, w[6]); r.wq = GPTR(const float, w[7]);
    r.sk = GPTR(const float, w[8]); r.pu = GPTR(const float, w[9]); r.pv = GPTR(const float, w[10]); r.norm_final = GPTR(const float, w[11]);
    r.out = GPTR(float, w[12]); r.ws = GPTR(char, w[13]);
    r.lo = (int)(unsigned)w[14]; r.hi = (int)(unsigned)(w[14] >> 32); r.pad0 = 0; r.pad1 = 0;
    return r;
#else
    return Params{};
#endif
}
#ifdef PROJ_CHECK
constexpr int PCH_ROWS = 64;
DI void phase_proj_ref_naive(const Params& p) {
    const bf16_t* hn = (const bf16_t*)(p.ws + OFF_HN); bf16_t* ref = (bf16_t*)(p.ws + OFF_ST);
    const int gtid = blockIdx.x * NTHREADS + threadIdx.x, gsz = gridDim.x * NTHREADS;
    for (int idx = gtid; idx < (PCH_ROWS / 8) * INW; idx += gsz) {
        const int c = idx % INW, r0 = (idx / INW) * 8;
        float acc[8];
#pragma unroll
        for (int i = 0; i < 8; ++i) acc[i] = 0.f;
        for (int k = 0; k < 1024; ++k) {
            const float w = bf2f(f2bf(p.w_in[(size_t)k * INW + c]));
#pragma unroll
            for (int i = 0; i < 8; ++i) { const int t_ = r0 + i; acc[i] += bf2f(hn[(size_t)(t_ < NMETA ? NF + t_ : t_ - NMETA) * DM + k]) * w; }
        }
#pragma unroll
        for (int i = 0; i < 8; ++i) ref[(size_t)(r0 + i) * INW + c] = f2bf(acc[i]);
    }
}
DI void phase_proj_compare(const Params& p) {
    const bf16_t* proj = (const bf16_t*)(p.ws + OFF_BIG); const bf16_t* ref = (const bf16_t*)(p.ws + OFF_ST); const bf16_t* dvt = (const bf16_t*)(p.ws + OFF_DVT);
    const int gtid = blockIdx.x * NTHREADS + threadIdx.x, gsz = gridDim.x * NTHREADS;
    float num = 0.f, den = 0.f;
    for (int idx = gtid; idx < PCH_ROWS * INW; idx += gsz) { const float a = bf2f(proj[idx]), r = bf2f(ref[idx]); num += (a - r) * (a - r); den += r * r; }
    for (int idx = gtid; idx < PCH_ROWS * 128; idx += gsz) {
        const int row = idx >> 7, dv = idx & 127, b = row / TT, t = row - b * TT;
        const float a = bf2f(dvt[(size_t)(b * 128 + dv) * TTP + t]), r = bf2f(ref[(size_t)row * INW + C_DV + dv]); num += (a - r) * (a - r); den += r * r;
    }
    for (int idx = gtid; idx < 7 * NMETA * INW; idx += gsz) {
        const int c = idx % INW, bt = idx / INW, b = 1 + bt / NMETA, t = bt % NMETA;
        const float a = bf2f(proj[(size_t)(b * TT + t) * INW + c]), r = bf2f(ref[(size_t)t * INW + c]); num += (a - r) * (a - r); den += r * r;
    }
    for (int idx = gtid; idx < 7 * NMETA * 128; idx += gsz) {
        const int dv = idx & 127, bt = idx >> 7, b = 1 + bt / NMETA, t = bt % NMETA;
        const float a = bf2f(dvt[(size_t)(b * 128 + dv) * TTP + t]), r = bf2f(ref[(size_t)t * INW + C_DV + dv]); num += (a - r) * (a - r); den += r * r;
    }
    num = wave_sum_uniform(num); den = wave_sum_uniform(den);
    if ((threadIdx.x & 63) == 0) { atomicAdd((float*)(p.ws + OFF_BAR) + 3600, num); atomicAdd((float*)(p.ws + OFF_BAR) + 3601, den); }
}
#endif
constexpr int NPHASES = 10;
__global__ void __launch_bounds__(NTHREADS, 2) mk_forward(Params p) {
    extern __shared__ __attribute__((aligned(16))) char dyn_smem[];
    LAS char* smem = (LAS char*)dyn_smem;
    const bool multi = (p.hi - p.lo) > 1;
    LAS char* tp_smem = smem;
    if (TP_SEC && blockIdx.x == 0 && threadIdx.x == 0) { volatile LAS long long* tp_ = (volatile LAS long long*)(smem + TP_LDS_OFF); tp_[0] = (long long)__builtin_readcyclecounter(); tp_[2] = 0; }
    XcdBarrier bar; bar.bar = (unsigned*)(p.ws + OFF_BAR); bar.x = 0; bar.st = (volatile LAS unsigned*)(smem + LDS_BAR_OFF);
    if (multi) {
        if (threadIdx.x == 0) { const u32x4 z = {0u, 0u, 0u, 0u}; *(LAS u32x4*)(smem + LDS_BAR_OFF) = z; }
        __syncthreads();
        bar = xcd_barrier_post((unsigned*)(p.ws + OFF_BAR), (volatile LAS unsigned*)(smem + LDS_BAR_OFF));
    }
#ifndef PHMASK
#define PHMASK 0xFFFF
#endif
#define PH_ON(i) (((PHMASK >> (i)) & 1) && p.lo <= (i) && (i) < p.hi)
#define PH_SYNC(i) do { if (multi && (i) + 1 < p.hi) { TP_BEGIN(7); xcd_barrier(bar); TP_END(7); } } while (0)
#ifndef REPEAT_MASK
#define REPEAT_MASK 0
#endif
#define PH_REP(i) for (int rep_ = 0; rep_ < 1 + ((REPEAT_MASK >> (i)) & 1); ++rep_)
    if (PH_ON(0)) { const Params q = load_params(); TP_BEGIN(8); PH_REP(0) phase_prologue(q, smem); TP_END(8); PH_SYNC(0); }
    if (PH_ON(1)) { const Params q = load_params(); TP_BEGIN(9); PH_REP(1) { EpiProjRope e; e.P = (bf16_t*)(q.ws + OFF_BIG); e.DVTp = (bf16_t*)(q.ws + OFF_DVT); e.IKCp = (bf16_t*)(q.ws + OFF_IKC); e.c128 = (const float*)(q.ws + OFF_COS128); e.s128 = (const float*)(q.ws + OFF_SIN128); e.c64 = (const float*)(q.ws + OFF_COS64); e.s64 = (const float*)(q.ws + OFF_SIN64); gemm256<true>((const bf16_t*)(q.ws + OFF_HN), (const bf16_t*)(q.ws + OFF_WINT), 1024, NF / 256, 4096 / 256, (LAS bf16_t*)smem, e); } phase_proj_meta(q, smem); phase_fold_weights(q); TP_END(9); PH_SYNC(1); }
#ifdef ROPE_SEPARATE
    if (PH_ON(2)) { const Params q = load_params(); TP_BEGIN(5); phase_rope(q, smem, (bf16_t*)(q.ws + OFF_BIG), MROWS, true); TP_END(5); PH_SYNC(2); }
#endif
#ifdef PROJ_CHECK
    {   const Params q = load_params();
        phase_proj_ref_naive(q);
        xcd_barrier(bar);
        phase_rope(q, smem, (bf16_t*)(q.ws + OFF_ST), PCH_ROWS, false);
        xcd_barrier(bar);
        phase_proj_compare(q);
        xcd_barrier(bar);
    }
#endif
    if (PH_ON(3)) { const Params q = load_params(); PH_REP(3) {
#ifndef RS_REP
#define RS_REP 1
#endif
#ifndef DSA_REP
#define DSA_REP 1
#endif
            for (int rr_ = 0; rr_ < RS_REP; ++rr_) phase_ret_state_mfma(q, smem);
#ifdef PROJ_CHECK
            {
                bf16_t* mixed_ = (bf16_t*)(q.ws + OFF_HN);
                for (int idx = blockIdx.x * NTHREADS + threadIdx.x; idx < NF * 64; idx += gridDim.x * NTHREADS) { const int row = idx >> 6, c8 = idx & 63; const u32x4 z = {0u, 0u, 0u, 0u}; *(u32x4*)(mixed_ + (size_t)row * DM + 512 + c8 * 8) = z; }
            }
#else
            for (int rr_ = 0; rr_ < DSA_REP; ++rr_) { phase_dsa32(q, smem); __syncthreads(); }
#endif
#ifdef DSA_CHECK
            __syncthreads(); xcd_barrier(bar); phase_dsa_naive<true>(q, smem);
#endif
        } PH_SYNC(3); }
    if (PH_ON(4)) { const Params q = load_params(); TP_BEGIN(6); phase_ret_scan(q); TP_END(6); PH_SYNC(4); }
    if (PH_ON(5)) { const Params q = load_params(); PH_REP(5) phase_ret_out_mfma(q, smem); PH_SYNC(5); }
    if (PH_ON(6)) { const Params q = load_params(); PH_REP(6) {
        EpiOutT e; e.H = q.out; e.X = q.x; e.HG = (bf16_t*)(q.ws + OFF_HG); e.G = q.norm_ffn; e.SSQ = (float*)(q.ws + OFF_SSQ); gemm256<true>(
        (const bf16_t*)(q.ws + OFF_HN), (const bf16_t*)(q.ws + OFF_WOUTT), 1024, NF / 256, 1024 / 256, (LAS bf16_t*)smem, e); }
#ifdef PROJ_CHECK
        phase_convert_tables(q);
#endif
        PH_SYNC(6); }
    if (PH_ON(8)) { const Params q = load_params();
#ifndef PROJ_CHECK
        phase_convert_tables(q);
#endif
        PH_REP(8) { EpiPQ e; e.Q = (float*)(q.ws + OFF_BIG); gemm256<false>((const bf16_t*)(q.ws + OFF_HG), (const bf16_t*)(q.ws + OFF_WQT), 1024, NF / 256, 2048 / 256, (LAS bf16_t*)smem, e); } PH_SYNC(8); }
    if (PH_ON(9)) { const Params q = load_params(); PH_REP(9) { phase_peer_select(q, smem); }
        if (TP_SEC && blockIdx.x == 0 && threadIdx.x == 0) { volatile LAS long long* tp_ = (volatile LAS long long*)(smem + TP_LDS_OFF); const float fr = (float)tp_[2] / (float)((long long)__builtin_readcyclecounter() - tp_[0]); ((float*)(p.ws + OFF_BAR))[3602] = fr; }
        asm volatile("s_waitcnt vmcnt(0)" ::: "memory"); __syncthreads(); }
    if (PH_ON(10)) { const Params q = load_params(); phase_peer_out_rows(q, smem); }
}

extern "C" void kernel_launch(void* const* d_in, const int* in_sizes, int n_in, void* d_out, int out_size, void* d_ws, size_t ws_size, hipStream_t stream) {
    static int grid = 0;
    if (grid == 0) {
        if (n_in != 12 || out_size != NF * DM || ws_size < WS_END) { fprintf(stderr, "kernel_launch: unexpected shapes (n_in %d out %d ws %zu need %zu)\n", n_in, out_size, ws_size, (size_t)WS_END); grid = -1; return; }
        int dev = 0, cus = 0, per_cu = 0;
        if (hipGetDevice(&dev) != hipSuccess || hipDeviceGetAttribute(&cus, hipDeviceAttributeMultiprocessorCount, dev) != hipSuccess) { grid = -1; return; }
        if (hipFuncSetAttribute((const void*)mk_forward, hipFuncAttributeMaxDynamicSharedMemorySize, LDS_BYTES) != hipSuccess) { fprintf(stderr, "kernel_launch: hipFuncSetAttribute failed\n"); grid = -1; return; }
        if (hipOccupancyMaxActiveBlocksPerMultiprocessor(&per_cu, (const void*)mk_forward, NTHREADS, LDS_BYTES) != hipSuccess || per_cu < 1)
            fprintf(stderr, "kernel_launch: occupancy query reports %d blocks per CU\n", per_cu);
        (void)hipGetLastError();
        grid = cus > 0 ? cus : 256;
    }
    if (grid < 0) return;
    Params p{};
    p.x = (const float*)d_in[0]; p.meta = (const float*)d_in[1]; p.norm_mix = (const float*)d_in[2]; p.w_in = (const float*)d_in[3];
    p.w_uv = (const float*)d_in[4]; p.w_out = (const float*)d_in[5]; p.norm_ffn = (const float*)d_in[6]; p.wq = (const float*)d_in[7];
    p.sk = (const float*)d_in[8]; p.pu = (const float*)d_in[9]; p.pv = (const float*)d_in[10]; p.norm_final = (const float*)d_in[11];
    p.out = (float*)d_out; p.ws = (char*)d_ws; p.pad0 = 0; p.pad1 = 0;
    (void)hipMemsetAsync((char*)d_ws + OFF_BAR, 0, 16384, stream);
#if MK_LAUNCHES == 1
    p.lo = 0; p.hi = NPHASES + 1;
    hipLaunchKernelGGL(mk_forward, dim3(grid), dim3(NTHREADS), LDS_BYTES, stream, p);
#else
    for (int ph = 0; ph <= NPHASES; ++ph) { p.lo = ph; p.hi = ph + 1; hipLaunchKernelGGL(mk_forward, dim3(grid), dim3(NTHREADS), LDS_BYTES, stream, p); }
#endif
}
```

```cpp
#include <hip/hip_runtime.h>
#include <stdint.h>
#include <stdio.h>

#ifndef MK_LAUNCHES
#define MK_LAUNCHES 1
#endif

#define DI __device__ __forceinline__
#ifndef TP_SEC
#define TP_SEC 0
#endif
#ifndef CHK_GAIN
#define CHK_GAIN 10.f
#endif
#define TP_LDS_OFF (163840 - 128)
#define TP_BEGIN(k) do { if (TP_SEC == (k) && blockIdx.x == 0 && threadIdx.x == 0) { *(volatile __attribute__((address_space(3))) long long*)(tp_smem + TP_LDS_OFF + 8) = (long long)__builtin_readcyclecounter(); } } while (0)
#define TP_END(k) do { if (TP_SEC == (k) && blockIdx.x == 0 && threadIdx.x == 0) { volatile __attribute__((address_space(3))) long long* tp_ = (volatile __attribute__((address_space(3))) long long*)(tp_smem + TP_LDS_OFF); tp_[2] += (long long)__builtin_readcyclecounter() - tp_[1]; } } while (0)
typedef unsigned short bf16_t;
typedef short bf16x8 __attribute__((ext_vector_type(8)));
typedef float f32x4 __attribute__((ext_vector_type(4)));
typedef float f32x2 __attribute__((ext_vector_type(2)));
typedef unsigned u32x4 __attribute__((ext_vector_type(4)));
typedef unsigned u32x2 __attribute__((ext_vector_type(2)));

constexpr int NB = 8, SEQ = 2048, NMETA = 16, TT = 2064, DM = 1024, INW = 3912;
constexpr int MROWS = NB * TT;
constexpr int MPAD = 16640;
constexpr int NF = NB * SEQ;
constexpr int C_RQ = 0, C_RK = 512, C_RV = 1024, C_RG = 1536, C_DQ = 2048, C_DK = 3072, C_DV = 3200, C_IQ = 3328, C_IK = 3840, C_IW = 3904;
constexpr int NTHREADS = 512, NWAVES = 8;
constexpr int LDS_BYTES = 163840;
constexpr int LDS_BAR_OFF = 163840 - 256;

constexpr size_t al256(size_t x) { return (x + 255) & ~(size_t)255; }
constexpr size_t OFF_BAR = 0;
constexpr size_t OFF_COS128 = 16384;
constexpr size_t OFF_SIN128 = OFF_COS128 + al256((size_t)TT * 64 * 4);
constexpr size_t OFF_COS64 = OFF_SIN128 + al256((size_t)TT * 64 * 4);
constexpr size_t OFF_SIN64 = OFF_COS64 + al256((size_t)TT * 32 * 4);
constexpr size_t OFF_WINT = OFF_SIN64 + al256((size_t)TT * 32 * 4);
constexpr size_t OFF_WOUTT = OFF_WINT + (size_t)4096 * 1024 * 2;
constexpr size_t OFF_WQT = OFF_WOUTT + (size_t)1024 * 1024 * 2;
constexpr size_t OFF_SKH = OFF_WQT + (size_t)2048 * 1024 * 2;
constexpr size_t OFF_SKL = OFF_SKH + (size_t)2048 * 128 * 2;
constexpr int TTP = 2176;
constexpr size_t OFF_WUVT = OFF_SKL + (size_t)2048 * 128 * 2;
constexpr size_t OFF_DVT = OFF_WUVT + (size_t)8 * 64 * 128 * 2;
constexpr size_t OFF_HN = OFF_DVT + (size_t)NB * 128 * TTP * 2;
constexpr size_t OFF_BIG = OFF_HN + (size_t)MPAD * 1024 * 2;
constexpr size_t BIG_BYTES = (size_t)NF * 2048 * 4;
constexpr size_t OFF_IKC = OFF_BIG + al256((size_t)MPAD * INW * 2);
static_assert(OFF_IKC + (size_t)MROWS * 64 * 2 <= OFF_BIG + BIG_BYTES, "IKC fits behind PROJ");
constexpr size_t OFF_ST = OFF_BIG + al256(BIG_BYTES);
constexpr size_t ST_BYTES = (size_t)32 * 34 * 16384 * 4;
constexpr size_t OFF_EG = OFF_ST;
constexpr size_t OFF_U8 = OFF_EG + (size_t)NF * 128 * 4;
constexpr size_t OFF_SU = OFF_U8 + (size_t)16384 * 1024;
constexpr size_t OFF_V8 = OFF_SU + 65536;
constexpr size_t OFF_SV = OFF_V8 + (size_t)16384 * 1024;
constexpr size_t OFF_HG = OFF_SV + 65536;
constexpr size_t OFF_SSQ = OFF_HG + (size_t)NF * 1024 * 2;
constexpr size_t WS_END = OFF_SSQ + (size_t)NF * 4;
static_assert(OFF_ST + ST_BYTES <= WS_END, "retention states fit");
static_assert(WS_END <= (size_t)268435456, "workspace");

struct Params {
    const float *x, *meta, *norm_mix, *w_in, *w_uv, *w_out, *norm_ffn, *wq, *sk, *pu, *pv, *norm_final;
    float* out; char* ws; int lo, hi, pad0, pad1;
};

DI float bf2f(bf16_t v) { return __uint_as_float(((unsigned)v) << 16); }
typedef float f32x2_t __attribute__((ext_vector_type(2)));
typedef __bf16 bf16x2_t __attribute__((ext_vector_type(2)));
DI bf16_t f2bf(float f) { const __bf16 h = (__bf16)f; return __builtin_bit_cast(unsigned short, h); }
DI unsigned pk2bf(float a, float b) { const f32x2_t v = {a, b}; const bf16x2_t h = __builtin_convertvector(v, bf16x2_t); return __builtin_bit_cast(unsigned, h); }
DI float wave_sum(float v) {
#pragma unroll
    for (int o = 32; o > 0; o >>= 1) v += __shfl_xor(v, o);
    return v;
}
DI float wave_max(float v) {
#pragma unroll
    for (int o = 32; o > 0; o >>= 1) v = fmaxf(v, __shfl_xor(v, o));
    return v;
}
DI unsigned long long wave_max_u64(unsigned long long v) {
#pragma unroll
    for (int o = 32; o > 0; o >>= 1) {
        const unsigned hi = __shfl_xor((unsigned)(v >> 32), o), lo = __shfl_xor((unsigned)v, o);
        const unsigned long long w = ((unsigned long long)hi << 32) | lo;
        v = w > v ? w : v;
    }
    return v;
}
DI unsigned fkey(float x) { const unsigned u = __float_as_uint(x); return (u & 0x80000000u) ? ~u : (u | 0x80000000u); }
DI float funkey(unsigned k) { const unsigned u = (k & 0x80000000u) ? (k & 0x7fffffffu) : ~k; return __uint_as_float(u); }
DI void lds_fence() { asm volatile("s_waitcnt lgkmcnt(0)" ::: "memory"); }
DI void unpack8(const u32x4& r, float (&v)[8]) {
    v[0] = __uint_as_float(r.x << 16); v[1] = __uint_as_float(r.x & 0xffff0000u);
    v[2] = __uint_as_float(r.y << 16); v[3] = __uint_as_float(r.y & 0xffff0000u);
    v[4] = __uint_as_float(r.z << 16); v[5] = __uint_as_float(r.z & 0xffff0000u);
    v[6] = __uint_as_float(r.w << 16); v[7] = __uint_as_float(r.w & 0xffff0000u);
}

typedef float f32x16 __attribute__((ext_vector_type(16)));
DI bf16x8 pack8(const float (&x)[8]) {
    u32x4 r;
#pragma unroll
    for (int j = 0; j < 4; ++j) r[j] = pk2bf(x[2 * j], x[2 * j + 1]);
    return __builtin_bit_cast(bf16x8, r);
}
DI bf16x8 pack_hi8(const float (&x)[8], float (&rem)[8]) {
    u32x4 r;
#pragma unroll
    for (int j = 0; j < 4; ++j) { r[j] = pk2bf(x[2 * j], x[2 * j + 1]); rem[2 * j] = x[2 * j] - __uint_as_float(r[j] << 16); rem[2 * j + 1] = x[2 * j + 1] - __uint_as_float(r[j] & 0xffff0000u); }
    return __builtin_bit_cast(bf16x8, r);
}

DI float dpp_row_sum(float v) {
    v += __int_as_float(__builtin_amdgcn_update_dpp(0, __float_as_int(v), 0xB1, 0xF, 0xF, true));
    v += __int_as_float(__builtin_amdgcn_update_dpp(0, __float_as_int(v), 0x4E, 0xF, 0xF, true));
    v += __int_as_float(__builtin_amdgcn_update_dpp(0, __float_as_int(v), 0x141, 0xF, 0xF, true));
    v += __int_as_float(__builtin_amdgcn_update_dpp(0, __float_as_int(v), 0x140, 0xF, 0xF, true));
    return v;
}
DI float wave_sum_uniform(float v) {
    v = dpp_row_sum(v);
    const float a = __int_as_float(__builtin_amdgcn_readlane(__float_as_int(v), 0)), b = __int_as_float(__builtin_amdgcn_readlane(__float_as_int(v), 16));
    const float c = __int_as_float(__builtin_amdgcn_readlane(__float_as_int(v), 32)), d = __int_as_float(__builtin_amdgcn_readlane(__float_as_int(v), 48));
    return (a + b) + (c + d);
}

DI int wave_sum_int(int v) {
    v += __builtin_amdgcn_update_dpp(0, v, 0xB1, 0xF, 0xF, true);
    v += __builtin_amdgcn_update_dpp(0, v, 0x4E, 0xF, 0xF, true);
    v += __builtin_amdgcn_update_dpp(0, v, 0x141, 0xF, 0xF, true);
    v += __builtin_amdgcn_update_dpp(0, v, 0x140, 0xF, 0xF, true);
    return (__builtin_amdgcn_readlane(v, 0) + __builtin_amdgcn_readlane(v, 16)) + (__builtin_amdgcn_readlane(v, 32) + __builtin_amdgcn_readlane(v, 48));
}

#define XB_TMO      128
#define XB_XCNT(j)  (256  + 64 * (j))
#define XB_XSUB(j)  (1280 + 64 * (j))
#define XB_XGEN(j)  (2304 + 64 * (j))
#define XB_TOP      3328
#define XB_TOPGEN   3392
#define XCD_BAR_WORDS 3456
#define XB_SPIN_CAP (1u << 20)
#define LAS __attribute__((address_space(3)))

DI unsigned xb_ld(unsigned* p)              { return __hip_atomic_load(p, __ATOMIC_RELAXED, __HIP_MEMORY_SCOPE_AGENT); }
DI unsigned xb_add(unsigned* p, unsigned v) { return __hip_atomic_fetch_add(p, v, __ATOMIC_RELAXED, __HIP_MEMORY_SCOPE_AGENT); }
DI unsigned xb_xcc_id() { return (unsigned)__builtin_amdgcn_s_getreg((3 << 11) | 20) & 0xFu; }
#define XB_SPIN(cond, bar) do { unsigned _sp = 0; while (cond) { __builtin_amdgcn_s_sleep(1); \
    if ((++_sp & 255u) == 0u) { if (xb_ld(&(bar)[XB_TMO])) break; if (_sp > XB_SPIN_CAP) { atomicAdd(&(bar)[XB_TMO], 1u); break; } } } } while (0)

struct XcdBarrier { unsigned* bar; unsigned x; volatile LAS unsigned* st; };

DI XcdBarrier xcd_barrier_post(unsigned* bar, volatile LAS unsigned* st) {
    XcdBarrier b; b.bar = bar; b.x = xb_xcc_id(); b.st = st;
    if (threadIdx.x == 0) (void)xb_add(&bar[XB_XCNT(b.x)], 1u);
    return b;
}
DI void xcd_barrier_complete(unsigned* bar, unsigned x, unsigned& nloc, unsigned& nx) {
    const unsigned G = gridDim.x * gridDim.y * gridDim.z;
    unsigned sum, cnt, mine, sp = 0u;
    for (;;) {
        sum = 0u; cnt = 0u; mine = 0u;
#pragma unroll
        for (unsigned j = 0; j < 16; ++j) { const unsigned c = xb_ld(&bar[XB_XCNT(j)]); sum += c; cnt += (c > 0u) ? 1u : 0u; mine = (j == x) ? c : mine; }
        if (sum == G) break;
        __builtin_amdgcn_s_sleep(1);
        if ((++sp & 255u) == 0u) { if (xb_ld(&bar[XB_TMO])) break; if (sp > XB_SPIN_CAP) { atomicAdd(&bar[XB_TMO], 1u); break; } }
    }
    nloc = mine > 0u ? mine : 1u; nx = cnt > 0u ? cnt : 1u;
}
DI void xcd_barrier(const XcdBarrier& b) {
    asm volatile("s_waitcnt vmcnt(0)" ::: "memory");
    __syncthreads();
    if (threadIdx.x == 0) {
        unsigned* bar = b.bar;
        __builtin_amdgcn_s_waitcnt(0);
        unsigned nloc = b.st[0], nx = b.st[1];
        if (nloc == 0u) { xcd_barrier_complete(bar, b.x, nloc, nx); b.st[0] = nloc; b.st[1] = nx; }
        const unsigned old = xb_add(&bar[XB_XSUB(b.x)], 1u);
        const unsigned gen = old / nloc;
        if (old + 1u == (gen + 1u) * nloc) {
            __builtin_amdgcn_fence(__ATOMIC_RELEASE, "agent");
            asm volatile("s_waitcnt vmcnt(0)" ::: "memory");
            const unsigned og = xb_add(&bar[XB_TOP], 1u);
            const unsigned tg = og / nx;
            if (og + 1u == (tg + 1u) * nx) xb_add(&bar[XB_TOPGEN], 1u);
            else XB_SPIN(xb_ld(&bar[XB_TOPGEN]) == tg, bar);
            __builtin_amdgcn_fence(__ATOMIC_ACQUIRE, "agent");
            xb_add(&bar[XB_XGEN(b.x)], 1u);
            asm volatile("s_waitcnt vmcnt(0)" ::: "memory");
        } else {
            XB_SPIN(xb_ld(&bar[XB_XGEN(b.x)]) == gen, bar);
            __builtin_amdgcn_fence(__ATOMIC_ACQUIRE, "agent");
            asm volatile("s_waitcnt vmcnt(0)" ::: "memory");
        }
    }
    __syncthreads();
}

constexpr int BM = 256, BK = 64, HALF = 128, NXCD = 8, WGM = 8, HT = HALF * BK;
DI int lds_byte(int r, int c) {
    int st = (r >> 4) * 2 + (c >> 5), rr = r & 15, cc = c & 31, ob = rr * 64 + cc * 2;
    return st * 1024 + (ob ^ (((ob >> 9) & 1) << 5));
}
DI void stage_rc(int b, int& R, int& C) {
    int st = b / 1024, sb = b % 1024, swz = sb ^ (((sb >> 9) & 1) << 5);
    R = (st >> 1) * 16 + swz / 64; C = (st & 1) * 32 + (swz % 64) / 2;
}

#define SA(b,h) (shm+((b)*2+(h))*HT)
#define SB(b,h) (shm+(4+(b)*2+(h))*HT)
#define STAGE_X(T,P,BASE,br,kt) do{long _g=(long)(br)*K+(long)(kt)*BK; \
    for(int _i=0;_i<2;++_i){int _b=(T)*16+_i*8192;int _r,_c;stage_rc(_b,_r,_c); \
      __builtin_amdgcn_global_load_lds((const unsigned*)(BASE+_g+(long)_r*K+_c), \
        (LAS unsigned*)((LAS char*)(P)+_b),16,0,0);}}while(0)
#define STAGE(P,BASE,br,kt) STAGE_X(tst_,P,BASE,br,kt)
#define LDA(dst,b,h) for(int m=0;m<4;++m)for(int k=0;k<2;++k) \
    dst[m][k]=*reinterpret_cast<const LAS bf16x8*>((LAS char*)SA(b,h)+lds_byte(wr*64+m*16+fr,k*32+fq*8))
#define LDB(dst,b,h) for(int n=0;n<2;++n)for(int k=0;k<2;++k) \
    dst[n][k]=*reinterpret_cast<const LAS bf16x8*>((LAS char*)SB(b,h)+lds_byte(wc*32+n*16+fr,k*32+fq*8))
#define MMA(ai,bj,At,Bt_) do{__builtin_amdgcn_s_setprio(1); \
    for(int m=0;m<4;++m)for(int n=0;n<2;++n)for(int k=0;k<2;++k) \
      acc[ai][bj][m][n]=TRANS?__builtin_amdgcn_mfma_f32_16x16x32_bf16(Bt_[n][k],At[m][k],acc[ai][bj][m][n],0,0,0):__builtin_amdgcn_mfma_f32_16x16x32_bf16(At[m][k],Bt_[n][k],acc[ai][bj][m][n],0,0,0); \
    __builtin_amdgcn_s_setprio(0);}while(0)
#define WAIT_V(n) asm volatile("s_waitcnt vmcnt(" #n ")":::"memory")
#define WAIT_L(n) asm volatile("s_waitcnt lgkmcnt(" #n ")":::"memory")
#define BAR __builtin_amdgcn_s_barrier()
#define SCHED __builtin_amdgcn_sched_barrier(0)

template <bool TRANS, class Epi>
DI void gemm256(const bf16_t* __restrict__ A, const bf16_t* __restrict__ Bt, const int K, const int nM, const int nN, LAS bf16_t* shm, const Epi& epi) {
    const int nwg = nM * nN;
    for (int L = blockIdx.x; L < nwg; L += gridDim.x) {
        int wgid = L;
        { int q = nwg / NXCD, r = nwg % NXCD, xcd = wgid % NXCD, off = wgid / NXCD; wgid = (xcd < r ? xcd * (q + 1) : r * (q + 1) + (xcd - r) * q) + off; }
        int nig = WGM * nN, gid = wgid / nig, fm = gid * WGM, gsz = min(nM - fm, WGM);
        int pm = fm + ((wgid % nig) % gsz), pn = (wgid % nig) / gsz, brow = pm * BM, bcol = pn * BM;
        int tst_ = threadIdx.x;
#ifndef PROJ_CHECK
        if (Epi::kOpaqueStage)
#endif
            asm volatile("" : "+v"(tst_));
        int wid = tst_ >> 6, lane = tst_ & 63, wr = wid >> 2, wc = wid & 3, fr = lane & 15, fq = lane >> 4;
        f32x4 acc[2][2][4][2] = {};
        bf16x8 At[4][2], B0[2][2], B1[2][2];
        int nt = K / BK;
        STAGE(SB(0,0),Bt,bcol,0); STAGE(SA(0,0),A,brow,0);
        STAGE(SB(0,1),Bt,bcol+HALF,0); STAGE(SA(0,1),A,brow+HALF,0);
        if (wr == 1) BAR;
        WAIT_V(4); BAR;
        STAGE(SB(1,0),Bt,bcol,1); STAGE(SA(1,0),A,brow,1); STAGE(SB(1,1),Bt,bcol+HALF,1);
        WAIT_V(6); BAR;
        for (int t = 0; t < nt - 2; t += 2) {
            LDB(B0,0,0); SCHED; LDA(At,0,0); STAGE(SA(1,1),A,brow+HALF,t+1);
            WAIT_L(8); BAR; WAIT_L(0); MMA(0,0,At,B0); BAR; SCHED;
            LDB(B1,0,1); STAGE(SB(0,0),Bt,bcol,t+2);
            BAR; WAIT_L(0); MMA(0,1,At,B1); BAR;
            LDA(At,0,1); STAGE(SA(0,0),A,brow,t+2);
            BAR; WAIT_L(0); MMA(1,0,At,B0); BAR; SCHED;
            STAGE(SB(0,1),Bt,bcol+HALF,t+2);
            WAIT_V(6); BAR; MMA(1,1,At,B1); BAR;
            LDB(B0,1,0); SCHED; LDA(At,1,0); STAGE(SA(0,1),A,brow+HALF,t+2);
            WAIT_L(8); BAR; WAIT_L(0); MMA(0,0,At,B0); BAR; SCHED;
            LDB(B1,1,1); STAGE(SB(1,0),Bt,bcol,t+3);
            BAR; WAIT_L(0); MMA(0,1,At,B1); BAR;
            LDA(At,1,1); STAGE(SA(1,0),A,brow,t+3);
            BAR; WAIT_L(0); MMA(1,0,At,B0); BAR; SCHED;
            STAGE(SB(1,1),Bt,bcol+HALF,t+3);
            WAIT_V(6); BAR; MMA(1,1,At,B1); BAR;
        }
        int tz = threadIdx.x; asm volatile("" : "+v"(tz)); wid = tz >> 6; lane = tz & 63; wr = wid >> 2; wc = wid & 3; fr = lane & 15; fq = lane >> 4;
        { LDB(B0,0,0); WAIT_V(0); LDA(At,0,0); STAGE_X(tz,SA(1,1),A,brow+HALF,nt-1);
          BAR; WAIT_L(0); MMA(0,0,At,B0); BAR;
          LDB(B1,0,1); BAR; WAIT_L(0); MMA(0,1,At,B1); BAR;
          LDA(At,0,1); WAIT_V(4); BAR; WAIT_L(0); MMA(1,0,At,B0); MMA(1,1,At,B1); BAR; }
        { LDB(B0,1,0); LDA(At,1,0); WAIT_V(2); BAR; WAIT_L(0); MMA(0,0,At,B0); BAR;
          LDB(B1,1,1); WAIT_V(0); BAR; WAIT_L(0); MMA(0,1,At,B1); BAR;
          LDA(At,1,1); BAR; WAIT_L(0); MMA(1,0,At,B0); MMA(1,1,At,B1); BAR; }
        if (wr == 0) BAR;
        epi(acc, brow, bcol, wr, wc, fr, fq);
        __syncthreads();
    }
}

struct EpiOut {
    static constexpr bool kOpaqueStage = false;
    float* H; const float* X;
    DI void operator()(const f32x4 (&acc)[2][2][4][2], int brow, int bcol, int wr, int wc, int fr, int fq) const {
#pragma unroll
        for (int ai = 0; ai < 2; ++ai)
#pragma unroll
        for (int bj = 0; bj < 2; ++bj)
#pragma unroll
        for (int m = 0; m < 4; ++m)
#pragma unroll
        for (int n = 0; n < 2; ++n)
#pragma unroll
        for (int j = 0; j < 4; ++j) {
            const int row = brow + ai * HALF + wr * 64 + m * 16 + fq * 4 + j, col = bcol + bj * HALF + wc * 32 + n * 16 + fr;
            const size_t o = (size_t)row * DM + col; H[o] = X[o] + acc[ai][bj][m][n][j];
        }
    }
};
struct EpiPQ {
    static constexpr bool kOpaqueStage = false;
    float* Q;
    DI void operator()(const f32x4 (&acc)[2][2][4][2], int brow, int bcol, int wr, int wc, int fr, int fq) const {
#pragma unroll
        for (int ai = 0; ai < 2; ++ai)
#pragma unroll
        for (int bj = 0; bj < 2; ++bj)
#pragma unroll
        for (int m = 0; m < 4; ++m)
#pragma unroll
        for (int n = 0; n < 2; ++n)
#pragma unroll
        for (int j = 0; j < 4; ++j) {
            const int row = brow + ai * HALF + wr * 64 + m * 16 + fq * 4 + j, col = bcol + bj * HALF + wc * 32 + n * 16 + fr;
            ((unsigned*)Q)[(size_t)row * 2048 + col] = fkey(acc[ai][bj][m][n][j]);
        }
    }
};

struct EpiOutT {
    static constexpr bool kOpaqueStage = false;
    float* H; const float* X; bf16_t* HG; const float* G; float* SSQ;
    DI void operator()(const f32x4 (&acc)[2][2][4][2], int brow, int bcol, int wr, int wc, int fr, int fq) const {
#pragma unroll
        for (int ai = 0; ai < 2; ++ai)
#pragma unroll
        for (int m = 0; m < 4; ++m) {
            const int row = brow + ai * HALF + wr * 64 + m * 16 + fr;
            const size_t o = (size_t)row * DM + bcol + wc * 32 + fq * 4;
            const float* xp = X + o; float* hp = H + o; bf16_t* gp = HG + o; const float* gn = G + bcol + wc * 32 + fq * 4;
            float ss = 0.f;
#pragma unroll
            for (int bj = 0; bj < 2; ++bj)
#pragma unroll
            for (int n = 0; n < 2; ++n) {
                const f32x4 x = *(const f32x4*)(xp + bj * HALF + n * 16); const f32x4 hv = x + acc[ai][bj][m][n];
                *(f32x4*)(hp + bj * HALF + n * 16) = hv;
                ss += hv[0] * hv[0] + hv[1] * hv[1] + hv[2] * hv[2] + hv[3] * hv[3];
                const f32x4 hg = hv * *(const f32x4*)(gn + bj * HALF + n * 16);
                uint2 w; w.x = pk2bf(hg[0], hg[1]); w.y = pk2bf(hg[2], hg[3]); *(uint2*)(gp + bj * HALF + n * 16) = w;
            }
            ss += __shfl_xor(ss, 16); ss += __shfl_xor(ss, 32);
            if (fq == 0) atomicAdd(SSQ + row, ss);
            __builtin_amdgcn_sched_barrier(0);
        }
    }
};

__host__ __device__ constexpr int proj_true_col(int n) {
    const int blk = n >> 7, P = n & 127, wc = P >> 5, nn = (P >> 4) & 1, i = P & 15;
    return blk * 128 + (blk < 26 ? wc * 16 + i + 64 * nn : (wc >> 1) * 64 + (wc & 1) * 16 + i + 32 * nn);
}
DI bool proj_block(const f32x4 x1, const f32x4 x2, const int cb, const int wc, const int fq, const int t, const float* c128, const float* s128, const float* c64, const float* s64,
                   f32x4& o1, f32x4& o2, int& c1, int& c2, bool& st2) {
    o1 = x1; o2 = x2; st2 = true;
    if (cb < C_IQ) {
        const int f = wc * 16 + fq * 4; c1 = cb + f; c2 = c1 + 64;
        const bool roped = (cb < C_RV) || (cb >= C_DQ && cb < C_DV);
        if (roped) {
            const float sc = (cb < C_RK) ? 1.f : (cb < C_RV) ? 0.08838834764831845f : (cb < C_DK) ? 0.08838834764831845f * 1.4426950408889634f : 1.f;
            const f32x4 cs = *(const f32x4*)(c128 + t * 64 + f), sn = *(const f32x4*)(s128 + t * 64 + f);
            o1 = (x1 * cs - x2 * sn) * sc; o2 = (x2 * cs + x1 * sn) * sc;
        }
        return true;
    }
    if (cb >= 3968) return false;
    const int hl = wc >> 1, f = (wc & 1) * 16 + fq * 4; c1 = cb + hl * 64 + f; c2 = c1 + 32;
    if (cb < C_IK || hl == 0) {
        const float sc = (cb < C_IK) ? 0.125f : 1.f;
        const f32x4 cs = *(const f32x4*)(c64 + t * 32 + f), sn = *(const f32x4*)(s64 + t * 32 + f);
        o1 = (x1 * cs - x2 * sn) * sc; o2 = (x2 * cs + x1 * sn) * sc;
        return true;
    }
    o1 = x1 * 0.35355339059327373f; st2 = false;
    return c1 < INW;
}
struct EpiProjRope {
    static constexpr bool kOpaqueStage = false;
    bf16_t* P; bf16_t* DVTp; bf16_t* IKCp; const float *c128, *s128, *c64, *s64;
    DI void operator()(const f32x4 (&acc)[2][2][4][2], int brow, int bcol, int wr, int wc, int fr, int fq) const {
#pragma unroll
        for (int ai = 0; ai < 2; ++ai)
#pragma unroll
        for (int m = 0; m < 4; ++m) {
            const int grow = brow + ai * HALF + wr * 64 + m * 16 + fr;
            const int b = grow >> 11, t = NMETA + (grow & 2047);
            bf16_t* rp = P + (size_t)(b * TT + t) * INW;
#pragma unroll
            for (int bj = 0; bj < 2; ++bj) {
                const int cb = bcol + bj * HALF;
                const f32x4 x1 = acc[ai][bj][m][0], x2 = acc[ai][bj][m][1];
                f32x4 o1, o2; int c1, c2; bool st2;
                if (!proj_block(x1, x2, cb, wc, fq, t, c128, s128, c64, s64, o1, o2, c1, c2, st2)) continue;
                if (cb == C_DV) {
                    bf16_t* dp = DVTp + (size_t)(b * 128 + (c1 - C_DV)) * TTP + t;
#pragma unroll
                    for (int j = 0; j < 4; ++j) { dp[(size_t)j * TTP] = f2bf(x1[j]); dp[(size_t)(64 + j) * TTP] = f2bf(x2[j]); }
                }
                uint2 w1; w1.x = pk2bf(o1[0], o1[1]); w1.y = pk2bf(o1[2], o1[3]); *(uint2*)(rp + c1) = w1;
                if (st2) {
                    uint2 w2; w2.x = pk2bf(o2[0], o2[1]); w2.y = pk2bf(o2[2], o2[3]); *(uint2*)(rp + c2) = w2;
                    if (cb == C_IK) { bf16_t* ik = IKCp + (size_t)(b * TT + t) * 64 + (c1 - C_IK); *(uint2*)(ik) = w1; *(uint2*)(ik + 32) = w2; }
                }
            }
        }
    }
};

DI void phase_prologue(const Params& p, LAS char* smem) {
    const int gtid = blockIdx.x * NTHREADS + threadIdx.x, gsz = gridDim.x * NTHREADS;
    {
        bf16_t* wint = (bf16_t*)(p.ws + OFF_WINT); bf16_t* woutt_ = (bf16_t*)(p.ws + OFF_WOUTT);
        LAS float* tl = (LAS float*)smem;
        for (int tile = blockIdx.x; tile < 16 * 64 + 16 * 16; tile += gridDim.x) {
            const bool isout = tile >= 16 * 64; const int tt = isout ? tile - 16 * 64 : tile;
            const int ncol = isout ? 16 : 64, k0 = (tt / ncol) * 64, c0 = (tt % ncol) * 64;
            const float* W = isout ? p.w_out : p.w_in; const int ldw = isout ? 1024 : INW, cmax = isout ? 1024 : INW;
            for (int i = threadIdx.x; i < 64 * 64; i += NTHREADS) { const int kk = i >> 6, cc = i & 63; tl[kk * 65 + cc] = (c0 + cc < cmax) ? W[(size_t)(k0 + kk) * ldw + c0 + cc] : 0.f; }
            __syncthreads();
            {
                const int cc = threadIdx.x >> 3, ch = threadIdx.x & 7, tc = c0 + cc;
                int n = tc;
                if (!isout) { const int blk = tc >> 7, T = tc & 127;
                    const int P = blk < 26 ? (((T & 63) >> 4) * 32 + (T >> 6) * 16 + (T & 15)) : ((((T >> 6) * 2 + ((T >> 4) & 1)) * 32) + ((T >> 5) & 1) * 16 + (T & 15));
                    n = blk * 128 + P; }
                u32x4 o;
#pragma unroll
                for (int w = 0; w < 4; ++w) o[w] = pk2bf(tl[(ch * 8 + 2 * w) * 65 + cc], tl[(ch * 8 + 2 * w + 1) * 65 + cc]);
                *(u32x4*)((isout ? woutt_ : wint) + (size_t)n * 1024 + k0 + ch * 8) = o;
            }
            __syncthreads();
        }
    }
    { float* ssq = (float*)(p.ws + OFF_SSQ); for (int idx = gtid; idx < NF; idx += gsz) ssq[idx] = 0.f; }
    {
        bf16_t* dvt = (bf16_t*)(p.ws + OFF_DVT);
        for (int idx = gtid; idx < NB * 128 * (TTP - TT); idx += gsz) { const int rw = idx / (TTP - TT), t = TT + idx % (TTP - TT); dvt[(size_t)rw * TTP + t] = (bf16_t)0; }
    }
    bf16_t* wuvt = (bf16_t*)(p.ws + OFF_WUVT);
    for (int idx = gtid; idx < 8 * 64 * 128; idx += gsz) {
        const int h = idx >> 13, e = (idx >> 7) & 63, dv = idx & 127;
        wuvt[idx] = f2bf(p.w_uv[(size_t)(h * 128 + dv) * 64 + e]);
    }
    float* c128 = (float*)(p.ws + OFF_COS128); float* s128 = (float*)(p.ws + OFF_SIN128);
    for (int idx = gtid; idx < TT * 64; idx += gsz) {
        const int pos = idx >> 6, j = idx & 63;
        const float inv = powf(10000.f, -(float)j * 2.0f / 128.f);
        const float ang = (float)pos * inv;
        float s, c; sincosf(ang, &s, &c);
        c128[idx] = c; s128[idx] = s;
    }
    float* c64 = (float*)(p.ws + OFF_COS64); float* s64 = (float*)(p.ws + OFF_SIN64);
    for (int idx = gtid; idx < TT * 32; idx += gsz) {
        const int pos = idx >> 5, j = idx & 31;
        const float inv = powf(10000.f, -(float)j * 2.0f / 64.f);
        const float ang = (float)pos * inv;
        float s, c; sincosf(ang, &s, &c);
        c64[idx] = c; s64[idx] = s;
    }
    bf16_t* hn = (bf16_t*)(p.ws + OFF_HN);
    const int wave = threadIdx.x >> 6, lane = threadIdx.x & 63;
    for (int row = blockIdx.x * NWAVES + wave; row < MPAD; row += gridDim.x * NWAVES) {
        bf16_t* o = hn + (size_t)row * DM;
        if (row >= NF + NMETA) {
            for (int i = 0; i < 4; ++i) *(uint2*)(o + i * 256 + lane * 4) = make_uint2(0u, 0u);
            continue;
        }
        const float* src = row < NF ? p.x + (size_t)row * DM : p.meta + (size_t)(row - NF) * DM;
        float4 v[4]; float ss = 0.f;
#pragma unroll
        for (int i = 0; i < 4; ++i) { v[i] = *(const float4*)(src + i * 256 + lane * 4); ss += v[i].x * v[i].x + v[i].y * v[i].y + v[i].z * v[i].z + v[i].w * v[i].w; }
        ss = wave_sum(ss);
        const float rstd = rsqrtf(ss * (1.f / DM) + 1e-6f);
#pragma unroll
        for (int i = 0; i < 4; ++i) {
            const float4 g = *(const float4*)(p.norm_mix + i * 256 + lane * 4);
            uint2 w;
            w.x = (unsigned)f2bf(v[i].x * rstd * g.x) | ((unsigned)f2bf(v[i].y * rstd * g.y) << 16);
            w.y = (unsigned)f2bf(v[i].z * rstd * g.z) | ((unsigned)f2bf(v[i].w * rstd * g.w) << 16);
            *(uint2*)(o + i * 256 + lane * 4) = w;
        }
    }
}

DI void phase_fold_weights(const Params& p) {
    {
        bf16_t* wst = (bf16_t*)(p.ws + OFF_WQT);
        int tz_ = threadIdx.x; asm volatile("" : "+v"(tz_));
        const int wave_ = tz_ >> 6, lane_ = tz_ & 63, r = lane_ & 31, hh = lane_ >> 5;
        const int skip_ = 0;
        if ((int)blockIdx.x >= skip_)
        for (int task = ((int)blockIdx.x - skip_) * NWAVES + wave_; task < 16 * 32 * 4; task += ((int)gridDim.x - skip_) * NWAVES) {
            const int nb = task & 3, hf = task >> 7, k0 = ((task >> 2) & 31) * 32;
            f32x16 acc;
#pragma unroll
            for (int i = 0; i < 16; ++i) acc[i] = 0.f;
            const float* arow = p.wq + (size_t)(k0 + r) * 2048 + hf * 128 + 8 * hh;
            const float* brow = p.sk + (size_t)(hf * 128 + nb * 32 + r) * 128 + 8 * hh;
#pragma unroll 2
            for (int ks = 0; ks < 8; ++ks) {
                const float4 a0 = *(const float4*)(arow + ks * 16), a1 = *(const float4*)(arow + ks * 16 + 4);
                const float4 b0 = *(const float4*)(brow + ks * 16), b1 = *(const float4*)(brow + ks * 16 + 4);
                const float af[8] = {a0.x, a0.y, a0.z, a0.w, a1.x, a1.y, a1.z, a1.w}; float ar[8];
                const float bf_[8] = {b0.x, b0.y, b0.z, b0.w, b1.x, b1.y, b1.z, b1.w}; float br[8];
                const bf16x8 ah = pack_hi8(af, ar); const bf16x8 al = pack8(ar);
                const bf16x8 bh = pack_hi8(bf_, br); const bf16x8 bl = pack8(br);
                acc = __builtin_amdgcn_mfma_f32_32x32x16_bf16(ah, bh, acc, 0, 0, 0);
                acc = __builtin_amdgcn_mfma_f32_32x32x16_bf16(ah, bl, acc, 0, 0, 0);
                acc = __builtin_amdgcn_mfma_f32_32x32x16_bf16(al, bh, acc, 0, 0, 0);
            }
            bf16_t* orow = wst + (size_t)(hf * 128 + nb * 32 + r) * 1024 + k0 + 4 * hh;
#pragma unroll
            for (int g4 = 0; g4 < 4; ++g4) { uint2 w; w.x = pk2bf(acc[4 * g4], acc[4 * g4 + 1]); w.y = pk2bf(acc[4 * g4 + 2], acc[4 * g4 + 3]); *(uint2*)(orow + 8 * g4) = w; }
        }
    }
}

DI void rope8(bf16_t* p1, bf16_t* p2, const float* ct, const float* st, float scale) {
    const u32x4 r1 = *(const u32x4*)p1, r2 = *(const u32x4*)p2;
    float x1[8], x2[8]; unpack8(r1, x1); unpack8(r2, x2);
    const float4 c0 = *(const float4*)ct, c1 = *(const float4*)(ct + 4), s0 = *(const float4*)st, s1 = *(const float4*)(st + 4);
    const float cs[8] = {c0.x, c0.y, c0.z, c0.w, c1.x, c1.y, c1.z, c1.w}, sn[8] = {s0.x, s0.y, s0.z, s0.w, s1.x, s1.y, s1.z, s1.w};
    u32x4 o1, o2;
#pragma unroll
    for (int i = 0; i < 4; ++i) {
        const float a0 = (x1[2 * i] * cs[2 * i] - x2[2 * i] * sn[2 * i]) * scale, a1 = (x1[2 * i + 1] * cs[2 * i + 1] - x2[2 * i + 1] * sn[2 * i + 1]) * scale;
        const float b0 = (x2[2 * i] * cs[2 * i] + x1[2 * i] * sn[2 * i]) * scale, b1 = (x2[2 * i + 1] * cs[2 * i + 1] + x1[2 * i + 1] * sn[2 * i + 1]) * scale;
        o1[i] = (unsigned)f2bf(a0) | ((unsigned)f2bf(a1) << 16); o2[i] = (unsigned)f2bf(b0) | ((unsigned)f2bf(b1) << 16);
    }
    *(u32x4*)p1 = o1; *(u32x4*)p2 = o2;
}
DI void phase_rope(const Params& p, LAS char* smem, bf16_t* proj, const int nrows, const bool do_dvt) {
    const float* c128 = (const float*)(p.ws + OFF_COS128); const float* s128 = (const float*)(p.ws + OFF_SIN128);
    const float* c64 = (const float*)(p.ws + OFF_COS64); const float* s64 = (const float*)(p.ws + OFF_SIN64);
    const int gtid = blockIdx.x * NTHREADS + threadIdx.x, gsz = gridDim.x * NTHREADS;
    const int total = nrows * 173;
    for (int idx = gtid; idx < total; idx += gsz) {
        const int row = idx / 173, it = idx - row * 173;
        const int t = row % TT;
        bf16_t* pr = proj + (size_t)row * INW;
        if (it < 32)       { const int hd = it >> 3, j = (it & 7) * 8;          rope8(pr + C_RQ + hd * 128 + j, pr + C_RQ + hd * 128 + 64 + j, c128 + t * 64 + j, s128 + t * 64 + j, 1.f); }
        else if (it < 64)  { const int i2 = it - 32, hd = i2 >> 3, j = (i2 & 7) * 8;  rope8(pr + C_RK + hd * 128 + j, pr + C_RK + hd * 128 + 64 + j, c128 + t * 64 + j, s128 + t * 64 + j, 0.08838834764831845f); }
        else if (it < 128) { const int i2 = it - 64, hd = i2 >> 3, j = (i2 & 7) * 8;  rope8(pr + C_DQ + hd * 128 + j, pr + C_DQ + hd * 128 + 64 + j, c128 + t * 64 + j, s128 + t * 64 + j, 0.08838834764831845f * 1.4426950408889634f); }
        else if (it < 136) { const int j = (it - 128) * 8;                          rope8(pr + C_DK + j, pr + C_DK + 64 + j, c128 + t * 64 + j, s128 + t * 64 + j, 1.f); }
        else if (it < 168) { const int i2 = it - 136, hd = i2 >> 2, j = (i2 & 3) * 8; rope8(pr + C_IQ + hd * 64 + j, pr + C_IQ + hd * 64 + 32 + j, c64 + t * 32 + j, s64 + t * 32 + j, 0.125f); }
        else if (it < 172) { const int j = (it - 168) * 8;                          rope8(pr + C_IK + j, pr + C_IK + 32 + j, c64 + t * 32 + j, s64 + t * 32 + j, 1.f); }
        else {
            const u32x4 r = *(const u32x4*)(pr + C_IW); float v[8]; unpack8(r, v); u32x4 o;
#pragma unroll
            for (int i = 0; i < 4; ++i) o[i] = (unsigned)f2bf(v[2 * i] * 0.35355339059327373f) | ((unsigned)f2bf(v[2 * i + 1] * 0.35355339059327373f) << 16);
            *(u32x4*)(pr + C_IW) = o;
        }
    }
    if (!do_dvt) return;
    bf16_t* dvt = (bf16_t*)(p.ws + OFF_DVT);
    LAS bf16_t* tile = (LAS bf16_t*)smem;
    for (int unit = blockIdx.x; unit < NB * (TTP / 64); unit += gridDim.x) {
        const int b = unit / (TTP / 64), t0 = (unit % (TTP / 64)) * 64;
        for (int i = threadIdx.x; i < 64 * 16; i += NTHREADS) {
            const int tr = i >> 4, ch = i & 15, t = t0 + tr;
            u32x4 v = {0u, 0u, 0u, 0u};
            if (t < TT) v = *(const u32x4*)(proj + (size_t)(b * TT + t) * INW + C_DV + ch * 8);
            *(LAS u32x4*)(tile + tr * 136 + ch * 8) = v;
        }
        __syncthreads();
        for (int i = threadIdx.x; i < 128 * 8; i += NTHREADS) {
            const int dv = i >> 3, ch = i & 7;
            u32x4 o;
#pragma unroll
            for (int w = 0; w < 4; ++w) o[w] = (unsigned)tile[(ch * 8 + 2 * w) * 136 + dv] | ((unsigned)tile[(ch * 8 + 2 * w + 1) * 136 + dv] << 16);
            *(u32x4*)(dvt + (size_t)(b * 128 + dv) * TTP + t0 + ch * 8) = o;
        }
        __syncthreads();
    }
}

#define MFMA16(a, b, c) __builtin_amdgcn_mfma_f32_16x16x32_bf16((a), (b), (c), 0, 0, 0)
#define MFMA32(a, b, c) __builtin_amdgcn_mfma_f32_32x32x16_bf16((a), (b), (c), 0, 0, 0)
DI void phase_proj_meta(const Params& p, LAS char* smem) {
    const bf16_t* hn = (const bf16_t*)(p.ws + OFF_HN) + (size_t)NF * DM;
    const bf16_t* wint = (const bf16_t*)(p.ws + OFF_WINT);
    bf16_t* proj = (bf16_t*)(p.ws + OFF_BIG); bf16_t* dvt = (bf16_t*)(p.ws + OFF_DVT);
    const float* c128 = (const float*)(p.ws + OFF_COS128); const float* s128 = (const float*)(p.ws + OFF_SIN128);
    const float* c64 = (const float*)(p.ws + OFF_COS64); const float* s64 = (const float*)(p.ws + OFF_SIN64);
    int tz = threadIdx.x; asm volatile("" : "+v"(tz));
    const int wave = tz >> 6, lane = tz & 63, c = lane & 15, g = lane >> 4;
    LAS f32x4* red = (LAS f32x4*)smem;
    const int first = gridDim.x >= 64 ? 16 : 0;
    for (int blk = (int)blockIdx.x - first; blk >= 0 && blk < 31; blk += (int)gridDim.x) {
        const int cb = blk * 128;
        const bf16_t* yrow = hn + (size_t)c * DM + wave * 128 + 8 * g;
        const bf16_t* xrow = wint + (size_t)(cb + c) * DM + wave * 128 + 8 * g;
        f32x4 acc[8];
#pragma unroll
        for (int q = 0; q < 8; ++q) acc[q] = (f32x4){0.f, 0.f, 0.f, 0.f};
#pragma unroll
        for (int ks = 0; ks < 4; ++ks) {
            const bf16x8 y = *(const bf16x8*)(yrow + ks * 32);
#pragma unroll
            for (int q = 0; q < 8; ++q) acc[q] = MFMA16(*(const bf16x8*)(xrow + (size_t)(q * 16) * DM + ks * 32), y, acc[q]);
        }
#pragma unroll
        for (int q = 0; q < 8; ++q) red[(wave * 8 + q) * 64 + lane] = acc[q];
        __syncthreads();
        if (wave < 4) {
            f32x4 a1 = {0.f, 0.f, 0.f, 0.f}, a2 = {0.f, 0.f, 0.f, 0.f};
#pragma unroll
            for (int w = 0; w < 8; ++w) { a1 += red[(w * 8 + 2 * wave) * 64 + lane]; a2 += red[(w * 8 + 2 * wave + 1) * 64 + lane]; }
            const int t = c;
            f32x4 o1, o2; int c1, c2; bool st2;
            if (proj_block(a1, a2, cb, wave, g, t, c128, s128, c64, s64, o1, o2, c1, c2, st2)) {
                uint2 w1, w2; w1.x = pk2bf(o1[0], o1[1]); w1.y = pk2bf(o1[2], o1[3]); w2.x = pk2bf(o2[0], o2[1]); w2.y = pk2bf(o2[2], o2[3]);
#pragma unroll
                for (int b = 0; b < NB; ++b) {
                    bf16_t* rp = proj + (size_t)(b * TT + t) * INW;
                    *(uint2*)(rp + c1) = w1; if (st2) *(uint2*)(rp + c2) = w2;
                    if (st2 && cb == C_IK) { bf16_t* ik = (bf16_t*)(p.ws + OFF_IKC) + (size_t)(b * TT + t) * 64 + (c1 - C_IK); *(uint2*)(ik) = w1; *(uint2*)(ik + 32) = w2; }
                    if (cb == C_DV) {
                        bf16_t* dp = dvt + (size_t)(b * 128 + (c1 - C_DV)) * TTP + t;
#pragma unroll
                        for (int j = 0; j < 4; ++j) { dp[(size_t)j * TTP] = f2bf(a1[j]); dp[(size_t)(64 + j) * TTP] = f2bf(a2[j]); }
                    }
                }
            }
        }
        __syncthreads();
    }
}

constexpr int DSA_WAVE_LDS = 2176 * 4 + 1024 * 4 + 256 * 4 + 64;
template <bool CHECK>
DI void phase_dsa_naive(const Params& p, LAS char* smem) {
    const bf16_t* proj = (const bf16_t*)(p.ws + OFF_BIG);
    bf16_t* mixed = (bf16_t*)(p.ws + OFF_HN);
    const int wave = threadIdx.x >> 6, lane = threadIdx.x & 63;
    LAS float* sSc = (LAS float*)(smem + wave * DSA_WAVE_LDS);
    LAS float* sQ = sSc + 2176;
    LAS int* sSel = (LAS int*)(sQ + 1024);
    LAS float* sIw = (LAS float*)(sSel + 256);
    const unsigned long long lt_mask = (1ull << lane) - 1ull;
    float chk_num = 0.f, chk_den = 0.f;
    for (int q = blockIdx.x * NWAVES + wave; q < NF; q += gridDim.x * NWAVES) {
        const int b = q >> 11, s = q & 2047, t = NMETA + s;
        const int nk = 80 + 64 * (s >> 6);
        const bf16_t* prow = proj + (size_t)(b * TT + t) * INW;
        for (int i = lane; i < 512; i += 64) sQ[i] = bf2f(prow[C_IQ + i]);
        if (lane < 8) sIw[lane] = bf2f(prow[C_IW + lane]);
        lds_fence();
        const bf16_t* ikbase = proj + (size_t)(b * TT) * INW + C_IK;
        const int nj = (nk + 63) >> 6;
        for (int jj = 0; jj < nj; ++jj) {
            const int k = jj * 64 + lane;
            float sc = 0.f;
            if (k < nk) {
                const bf16_t* kr = ikbase + (size_t)k * INW;
                float a[8];
#pragma unroll
                for (int h = 0; h < 8; ++h) a[h] = 0.f;
#pragma unroll 1
                for (int d8 = 0; d8 < 8; ++d8) {
                    const u32x4 raw = *(const u32x4*)(kr + d8 * 8); float kv[8]; unpack8(raw, kv);
#pragma unroll
                    for (int h = 0; h < 8; ++h) {
                        const f32x4 q0 = *(const LAS f32x4*)(sQ + h * 64 + d8 * 8), q1 = *(const LAS f32x4*)(sQ + h * 64 + d8 * 8 + 4);
                        a[h] += kv[0] * q0[0] + kv[1] * q0[1] + kv[2] * q0[2] + kv[3] * q0[3] + kv[4] * q1[0] + kv[5] * q1[1] + kv[6] * q1[2] + kv[7] * q1[3];
                    }
                }
#pragma unroll
                for (int h = 0; h < 8; ++h) sc += fmaxf(a[h], 0.f) * sIw[h];
                sc += 0.0f;
            }
            sSc[k] = sc;
        }
        lds_fence();
        int L;
        if (nk <= 256) {
            for (int i = lane; i < nk; i += 64) sSel[i] = i;
            L = nk;
        } else {
            unsigned Tkey = 0u;
            for (int bit = 31; bit >= 0; --bit) {
                const unsigned cand = Tkey | (1u << bit);
                int cnt = 0;
                for (int jj = 0; jj < nj; ++jj) {
                    const int k = jj * 64 + lane;
                    const unsigned key = (k < nk) ? fkey(sSc[k]) : 0u;
                    cnt += __popcll(__ballot(key >= cand));
                }
                if (cnt >= 256) Tkey = cand;
            }
            int cgt = 0;
            for (int jj = 0; jj < nj; ++jj) {
                const int k = jj * 64 + lane;
                const unsigned key = (k < nk) ? fkey(sSc[k]) : 0u;
                cgt += __popcll(__ballot(key > Tkey));
            }
            const int need = 256 - cgt;
            int pos = 0, eqseen = 0;
            for (int jj = 0; jj < nj; ++jj) {
                const int k = jj * 64 + lane;
                const unsigned key = (k < nk) ? fkey(sSc[k]) : 0u;
                const bool gt = key > Tkey, eq = (key == Tkey);
                const unsigned long long eqm = __ballot(eq);
                const int myeq = eqseen + __popcll(eqm & lt_mask);
                const bool sel = gt || (eq && myeq < need);
                const unsigned long long sm = __ballot(sel);
                if (sel) sSel[pos + __popcll(sm & lt_mask)] = k;
                pos += __popcll(sm); eqseen += __popcll(eqm);
            }
            L = 256;
        }
        lds_fence();
        for (int i = lane; i < 1024; i += 64) sQ[i] = bf2f(prow[C_DQ + i]);
        lds_fence();
        float sc[8][4];
        const bf16_t* dkbase = proj + (size_t)(b * TT) * INW + C_DK;
#pragma unroll
        for (int il = 0; il < 4; ++il) {
            const int i = lane + 64 * il; const bool ok = i < L; const int key = ok ? sSel[i] : 0;
            const bf16_t* kr = dkbase + (size_t)key * INW;
            float a[8];
#pragma unroll
            for (int h = 0; h < 8; ++h) a[h] = 0.f;
#pragma unroll 1
            for (int d8 = 0; d8 < 16; ++d8) {
                const u32x4 raw = *(const u32x4*)(kr + d8 * 8); float kv[8]; unpack8(raw, kv);
#pragma unroll
                for (int h = 0; h < 8; ++h) {
                    const f32x4 q0 = *(const LAS f32x4*)(sQ + h * 128 + d8 * 8), q1 = *(const LAS f32x4*)(sQ + h * 128 + d8 * 8 + 4);
                    a[h] += kv[0] * q0[0] + kv[1] * q0[1] + kv[2] * q0[2] + kv[3] * q0[3] + kv[4] * q1[0] + kv[5] * q1[1] + kv[6] * q1[2] + kv[7] * q1[3];
                }
            }
#pragma unroll
            for (int h = 0; h < 8; ++h) sc[h][il] = ok ? a[h] : -INFINITY;
        }
#pragma unroll
        for (int h = 0; h < 8; ++h) {
            float m = fmaxf(fmaxf(sc[h][0], sc[h][1]), fmaxf(sc[h][2], sc[h][3]));
            m = wave_max(m);
            float e[4], sum = 0.f;
#pragma unroll
            for (int il = 0; il < 4; ++il) { e[il] = exp2f(sc[h][il] - m); sum += e[il]; }
            sum = wave_sum(sum);
            const float inv = 1.f / sum;
#pragma unroll
            for (int il = 0; il < 4; ++il) sSc[h * 256 + lane + 64 * il] = e[il] * inv;
        }
        lds_fence();
        float o[8][2];
#pragma unroll
        for (int h = 0; h < 8; ++h) { o[h][0] = 0.f; o[h][1] = 0.f; }
        const bf16_t* dvbase = proj + (size_t)(b * TT) * INW + C_DV;
        for (int i = 0; i < L; ++i) {
            const int key = sSel[i];
            const float v0 = bf2f(dvbase[(size_t)key * INW + lane]), v1 = bf2f(dvbase[(size_t)key * INW + 64 + lane]);
#pragma unroll
            for (int h = 0; h < 8; ++h) { const float pv = sSc[h * 256 + i]; o[h][0] += pv * v0; o[h][1] += pv * v1; }
        }
        lds_fence();
#pragma unroll
        for (int h = 0; h < 8; ++h) { sQ[h * 128 + lane] = o[h][0]; sQ[h * 128 + 64 + lane] = o[h][1]; }
        lds_fence();
        for (int h = 0; h < 8; ++h) {
            float acc = 0.f;
            const float* wu = p.w_uv + (size_t)h * 128 * 64 + lane;
            for (int c = 0; c < 128; ++c) acc += sQ[h * 128 + c] * wu[c * 64];
            if (CHECK) { const float got = bf2f(mixed[(size_t)q * DM + 512 + h * 64 + lane]); chk_num += (got - acc) * (got - acc); chk_den += acc * acc; }
            else mixed[(size_t)q * DM + 512 + h * 64 + lane] = f2bf(acc);
        }
        lds_fence();
    }
    if (CHECK) {
        chk_num = wave_sum(chk_num); chk_den = wave_sum(chk_den);
        if (lane == 0) { atomicAdd((float*)(p.ws + OFF_BAR) + 3600, chk_num); atomicAdd((float*)(p.ws + OFF_BAR) + 3601, chk_den); }
    }
}

typedef unsigned long long u64;
typedef short s16x4 __attribute__((ext_vector_type(4)));
constexpr int SCLD = 2116;
constexpr int DSA_MASK_OFF = 16 * SCLD * 4;
constexpr int KLD = 136, VLD = 72, VLD2 = 136;
constexpr int DSA_VT_OFF = 128 * KLD * 2;
DI void phase_dsa_fast(const Params& p, LAS char* smem) {
    const bf16_t* proj = (const bf16_t*)(p.ws + OFF_BIG);
    const bf16_t* dvt = (const bf16_t*)(p.ws + OFF_DVT);
    const bf16_t* wuvt = (const bf16_t*)(p.ws + OFF_WUVT);
    bf16_t* mixed = (bf16_t*)(p.ws + OFF_HN);
    const int wave = threadIdx.x >> 6, lane = threadIdx.x & 63, c = lane & 15, g = lane >> 4;
    LAS float* SC = (LAS float*)smem; LAS u64* MASK = (LAS u64*)(smem + DSA_MASK_OFF);
    LAS bf16_t* KT = (LAS bf16_t*)smem; LAS bf16_t* VT = (LAS bf16_t*)(smem + DSA_VT_OFF);
    const u64 lt_mask = (1ull << lane) - 1ull;
    for (int pi = blockIdx.x; pi < 512; pi += gridDim.x)
    for (int which = 0; which < 2; ++which) {
        const int b = pi >> 6, qq = pi & 63, qt = which ? 127 - qq : qq;
        const int s0 = qt * 16, nk = 80 + 64 * (s0 >> 6), nkt = nk >> 4, nj = (nk + 63) >> 6;
        const bf16_t* pb = proj + (size_t)(b * TT) * INW;
        LAS char* tp_smem = smem; TP_BEGIN(1);
        {
            const bf16_t* qrow = pb + (size_t)(NMETA + s0 + c) * INW;
            bf16x8 bq[8][2]; float iw[8];
#pragma unroll
            for (int h = 0; h < 8; ++h) {
                bq[h][0] = *(const bf16x8*)(qrow + C_IQ + h * 64 + 8 * g);
                bq[h][1] = *(const bf16x8*)(qrow + C_IQ + h * 64 + 32 + 8 * g);
                iw[h] = bf2f(qrow[C_IW + h]);
            }
            bf16x8 a0n = {0, 0, 0, 0, 0, 0, 0, 0}, a1n = {0, 0, 0, 0, 0, 0, 0, 0};
            if (wave < nkt) { const bf16_t* krow = pb + (size_t)(wave * 16 + c) * INW + C_IK + 8 * g; a0n = *(const bf16x8*)(krow); a1n = *(const bf16x8*)(krow + 32); }
            for (int kt = wave; kt < nkt; kt += NWAVES) {
                const bf16x8 a0 = a0n, a1 = a1n;
                if (kt + NWAVES < nkt) { const bf16_t* krow = pb + (size_t)((kt + NWAVES) * 16 + c) * INW + C_IK + 8 * g; a0n = *(const bf16x8*)(krow); a1n = *(const bf16x8*)(krow + 32); }
                f32x4 isc = {0.f, 0.f, 0.f, 0.f};
#pragma unroll
                for (int h = 0; h < 8; ++h) {
                    f32x4 acc = {0.f, 0.f, 0.f, 0.f};
                    acc = MFMA16(a0, bq[h][0], acc); acc = MFMA16(a1, bq[h][1], acc);
#pragma unroll
                    for (int j = 0; j < 4; ++j) isc[j] += fmaxf(acc[j], 0.f) * iw[h];
                }
#pragma unroll
                for (int j = 0; j < 4; ++j) isc[j] += 0.0f;
                *(LAS f32x4*)(SC + c * SCLD + kt * 16 + 4 * g) = isc;
            }
            {
                const int tail = ((nj <= 11 ? 11 : (nj <= 22 ? 22 : 33)) << 6) - nk;
                for (int i = threadIdx.x; i < 16 * tail; i += NTHREADS) { const int qq_ = i / tail; SC[qq_ * SCLD + nk + (i - qq_ * tail)] = -3.0e38f; }
            }
        }
        __syncthreads(); TP_END(1); TP_BEGIN(2);
#pragma unroll 1
        for (int qi = 0; qi < 2; ++qi) {
            const int cq = wave * 2 + qi;
            unsigned kv[33];
#pragma unroll
            for (int jj = 0; jj < 11; ++jj) kv[jj] = fkey(SC[cq * SCLD + jj * 64 + lane]);
            if (nj > 11) {
#pragma unroll
                for (int jj = 11; jj < 22; ++jj) kv[jj] = fkey(SC[cq * SCLD + jj * 64 + lane]);
            } else {
#pragma unroll
                for (int jj = 11; jj < 22; ++jj) kv[jj] = 0u;
            }
            if (nj > 22) {
#pragma unroll
                for (int jj = 22; jj < 33; ++jj) kv[jj] = fkey(SC[cq * SCLD + jj * 64 + lane]);
            } else {
#pragma unroll
                for (int jj = 22; jj < 33; ++jj) kv[jj] = 0u;
            }
            unsigned Tkey = 1u;
            if (nk > 256) {
                Tkey = 0u;
#pragma unroll 1
                for (int bit = 31; bit >= 0; --bit) {
                    const unsigned cand = Tkey | (1u << bit);
                    int nl = 0;
#pragma unroll
                    for (int jj = 0; jj < 11; ++jj) nl += (kv[jj] >= cand) ? 1 : 0;
                    if (nj > 11) {
#pragma unroll
                        for (int jj = 11; jj < 22; ++jj) nl += (kv[jj] >= cand) ? 1 : 0;
                    }
                    if (nj > 22) {
#pragma unroll
                        for (int jj = 22; jj < 33; ++jj) nl += (kv[jj] >= cand) ? 1 : 0;
                    }
                    const int cnt = wave_sum_int(nl);
                    if (cnt >= 256) Tkey = cand;
                    if (cnt == 256) break;
                }
            }
            int cgl = 0;
#pragma unroll
            for (int jj = 0; jj < 33; ++jj) cgl += (kv[jj] > Tkey) ? 1 : 0;
            const int cgt = wave_sum_int(cgl);
            const int need = (nk > 256) ? 256 - cgt : 4096;
            int eqseen = 0;
#pragma unroll 1
            for (int jj = 0; jj < nj; ++jj) {
                const int k = jj * 64 + lane; const float v = SC[cq * SCLD + k];
                const unsigned key = (k < nk) ? fkey(v) : 0u;
                const bool gt = key > Tkey, eq = (key == Tkey);
                const u64 eqm = __ballot(eq);
                const int myeq = eqseen + __popcll(eqm & lt_mask);
                const u64 sm = __ballot(gt || (eq && myeq < need));
                eqseen += __popcll(eqm);
                if (lane == 0) MASK[cq * 34 + jj] = sm;
            }
        }
        __syncthreads(); TP_END(2); TP_BEGIN(3);
        {
            const int h = wave;
            const bf16_t* qrow = pb + (size_t)(NMETA + s0 + c) * INW + C_DQ + h * 128 + 8 * g;
            bf16x8 bQ[4];
#pragma unroll
            for (int ks = 0; ks < 4; ++ks) bQ[ks] = *(const bf16x8*)(qrow + ks * 32);
            f32x4 O[8];
#pragma unroll
            for (int mb = 0; mb < 8; ++mb) O[mb] = (f32x4){0.f, 0.f, 0.f, 0.f};
            float m_run = -1e30f, l_run = 0.f;
            const int prow_t = threadIdx.x >> 4, pch_t = threadIdx.x & 15;
            const bf16_t* vsrc = dvt + (size_t)(b * 128 + prow_t) * TTP + pch_t * 8;
            const int n128 = (nk + 127) >> 7;
            u32x4 pk[4], pv[4];
#pragma unroll
            for (int i = 0; i < 4; ++i) {
                int key = prow_t + 32 * i; key = key < nk ? key : nk - 1;
                pk[i] = *(const u32x4*)(pb + (size_t)key * INW + C_DK + pch_t * 8);
                pv[i] = *(const u32x4*)(vsrc + (size_t)(32 * i) * TTP);
            }
#pragma unroll 1
            for (int kb = 0; kb < n128; ++kb) {
#pragma unroll
                for (int i = 0; i < 4; ++i) {
                    *(LAS u32x4*)(KT + (prow_t + 32 * i) * KLD + pch_t * 8) = pk[i];
                    *(LAS u32x4*)(VT + (prow_t + 32 * i) * VLD2 + pch_t * 8) = pv[i];
                }
                __syncthreads();
                if (kb + 1 < n128) {
#pragma unroll
                    for (int i = 0; i < 4; ++i) {
                        int key = (kb + 1) * 128 + prow_t + 32 * i; key = key < nk ? key : nk - 1;
                        pk[i] = *(const u32x4*)(pb + (size_t)key * INW + C_DK + pch_t * 8);
                        pv[i] = *(const u32x4*)(vsrc + (size_t)(32 * i) * TTP + (kb + 1) * 128);
                    }
                }
#pragma unroll
                for (int sb = 0; sb < 2; ++sb) {
                    const int wi = kb * 2 + sb;
                    if (wi < nj) {
                        const u64 mw = MASK[c * 34 + wi];
                        f32x4 S[4];
#pragma unroll
                        for (int ct = 0; ct < 4; ++ct) {
                            f32x4 acc = {0.f, 0.f, 0.f, 0.f};
#pragma unroll
                            for (int ks = 0; ks < 4; ++ks) {
                                const bf16x8 a = *(const LAS bf16x8*)(KT + (sb * 64 + ct * 16 + c) * KLD + ks * 32 + 8 * g);
                                acc = MFMA16(a, bQ[ks], acc);
                            }
                            S[ct] = acc;
                        }
                        const u64 mws = mw >> (4 * g);
                        const unsigned mlo = (unsigned)mws, mhi = (unsigned)(mws >> 32);
                        float mblk = -1e30f;
#pragma unroll
                        for (int ct = 0; ct < 4; ++ct) {
                            const unsigned bits = ((ct & 2) ? mhi : mlo) >> ((ct & 1) * 16);
#pragma unroll
                            for (int j = 0; j < 4; ++j) {
                                S[ct][j] = ((bits >> j) & 1u) ? S[ct][j] : -1e30f;
                                mblk = fmaxf(mblk, S[ct][j]);
                            }
                        }
                        mblk = fmaxf(mblk, __shfl_xor(mblk, 16)); mblk = fmaxf(mblk, __shfl_xor(mblk, 32));
                        const float m_new = fmaxf(m_run, mblk);
                        float ps = 0.f;
#pragma unroll
                        for (int ct = 0; ct < 4; ++ct)
#pragma unroll
                            for (int j = 0; j < 4; ++j) { const float pv_ = (S[ct][j] > -1e29f) ? __builtin_amdgcn_exp2f(S[ct][j] - m_new) : 0.f; S[ct][j] = pv_; ps += pv_; }
                        if (__ballot(m_new != m_run) != 0ull) {
                            const float alpha = __builtin_amdgcn_exp2f(m_run - m_new);
                            l_run *= alpha;
#pragma unroll
                            for (int mb = 0; mb < 8; ++mb) O[mb] *= alpha;
                        }
                        l_run += ps; m_run = m_new;
                        bf16x8 bP[2];
#pragma unroll
                        for (int kk = 0; kk < 2; ++kk) {
                            u32x4 t4;
                            t4[0] = pk2bf(S[2 * kk][0], S[2 * kk][1]); t4[1] = pk2bf(S[2 * kk][2], S[2 * kk][3]);
                            t4[2] = pk2bf(S[2 * kk + 1][0], S[2 * kk + 1][1]); t4[3] = pk2bf(S[2 * kk + 1][2], S[2 * kk + 1][3]);
                            bP[kk] = __builtin_bit_cast(bf16x8, t4);
                        }
#pragma unroll
                        for (int mh = 0; mh < 2; ++mh) {
                            bf16x8 av[8];
#pragma unroll
                            for (int q = 0; q < 8; ++q) {
                                const int mb = mh * 4 + (q >> 1), kk = q & 1;
                                const LAS bf16_t* vr = VT + (mb * 16 + c) * VLD2 + sb * 64 + kk * 32 + 4 * g;
                                const s16x4 lo = *(const LAS s16x4*)(vr), hi = *(const LAS s16x4*)(vr + 16);
                                av[q] = __builtin_shufflevector(lo, hi, 0, 1, 2, 3, 4, 5, 6, 7);
                            }
                            __builtin_amdgcn_sched_barrier(0);
#pragma unroll
                            for (int q = 0; q < 8; ++q) { const int mb = mh * 4 + (q >> 1), kk = q & 1; O[mb] = MFMA16(av[q], bP[kk], O[mb]); }
                            __builtin_amdgcn_sched_barrier(0);
                        }
                    }
                }
                __syncthreads();
            }
            TP_END(3); TP_BEGIN(4);
            l_run += __shfl_xor(l_run, 16); l_run += __shfl_xor(l_run, 32);
            const float inv = 1.f / l_run;
            bf16x8 bO[4];
#pragma unroll
            for (int k2 = 0; k2 < 4; ++k2)
#pragma unroll
                for (int j = 0; j < 4; ++j) { bO[k2][j] = (short)f2bf(O[2 * k2][j] * inv); bO[k2][4 + j] = (short)f2bf(O[2 * k2 + 1][j] * inv); }
            bf16_t* orow = mixed + (size_t)(b * SEQ + s0 + c) * DM + 512 + h * 64;
            int zofs = 0; asm volatile("" : "+v"(zofs));
#pragma unroll
            for (int eb = 0; eb < 4; ++eb) {
                f32x4 acc = {0.f, 0.f, 0.f, 0.f};
#pragma unroll
                for (int k2 = 0; k2 < 4; ++k2) {
                    const bf16_t* wr = wuvt + (size_t)(h * 64 + eb * 16 + c) * 128 + k2 * 32 + 4 * g + zofs;
                    const s16x4 lo = *(const s16x4*)(wr), hi = *(const s16x4*)(wr + 16);
                    const bf16x8 a = __builtin_shufflevector(lo, hi, 0, 1, 2, 3, 4, 5, 6, 7);
                    acc = MFMA16(a, bO[k2], acc);
                }
                uint2 w;
                w.x = (unsigned)f2bf(acc[0]) | ((unsigned)f2bf(acc[1]) << 16);
                w.y = (unsigned)f2bf(acc[2]) | ((unsigned)f2bf(acc[3]) << 16);
                *(uint2*)(orow + eb * 16 + 4 * g) = w;
            }
            TP_END(4);
        }
    }
}

DI void phase_dsa32(const Params& p, LAS char* smem) {
    const bf16_t* proj = (const bf16_t*)(p.ws + OFF_BIG);
    const bf16_t* dvt = (const bf16_t*)(p.ws + OFF_DVT);
    const bf16_t* wuvt = (const bf16_t*)(p.ws + OFF_WUVT);
    bf16_t* mixed = (bf16_t*)(p.ws + OFF_HN);
    LAS float* SC = (LAS float*)smem; LAS u64* MASK = (LAS u64*)(smem + DSA_MASK_OFF);
    LAS bf16_t* KT = (LAS bf16_t*)smem; LAS bf16_t* VT = (LAS bf16_t*)(smem + DSA_VT_OFF);
    for (int pi = blockIdx.x; pi < 256; pi += gridDim.x)
    for (int which = 0; which < 2; ++which) {
        const int b = pi >> 5, qq = pi & 31, qt = which ? 63 - qq : qq;
        const int s0 = qt * 32, nk = 80 + 64 * (s0 >> 6), nkt = nk >> 4, nj = (nk + 63) >> 6;
        const bf16_t* pb = proj + (size_t)(b * TT) * INW;
        const bf16_t* ikb = (const bf16_t*)(p.ws + OFF_IKC) + (size_t)(b * TT) * 64;
        LAS char* tp_smem = smem; TP_BEGIN(1);
#pragma unroll 1
        for (int sub = 0; sub < 2; ++sub) {
            {
                int tz_ = threadIdx.x; asm volatile("" : "+v"(tz_)); const int lane = tz_ & 63, wave = __builtin_amdgcn_readfirstlane(tz_ >> 6); const int c = lane & 15, g = lane >> 4;
                const bf16_t* qrow = pb + (size_t)(NMETA + s0 + 16 * sub + c) * INW;
                bf16x8 bq[8][2]; float iw[8];
#pragma unroll
                for (int h = 0; h < 8; ++h) {
                    bq[h][0] = *(const bf16x8*)(qrow + C_IQ + h * 64 + 8 * g);
                    bq[h][1] = *(const bf16x8*)(qrow + C_IQ + h * 64 + 32 + 8 * g);
                    iw[h] = bf2f(qrow[C_IW + h]);
                }
                bf16x8 ka[4][2];
#define SI_LOAD(D, KT_) do { int kc_ = (KT_); kc_ = kc_ < nkt ? kc_ : nkt - 1; const bf16_t* krow_ = ikb + (size_t)(kc_ * 16 + c) * 64 + 8 * g; ka[D][0] = *(const bf16x8*)(krow_); ka[D][1] = *(const bf16x8*)(krow_ + 32); } while (0)
#define SI_TILE(A0, A1, KT_) do { \
                    f32x4 isc = {0.f, 0.f, 0.f, 0.f}; \
                    _Pragma("unroll") for (int h = 0; h < 8; ++h) { \
                        f32x4 acc = {0.f, 0.f, 0.f, 0.f}; \
                        acc = MFMA16(A0, bq[h][0], acc); acc = MFMA16(A1, bq[h][1], acc); \
                        _Pragma("unroll") for (int j = 0; j < 4; ++j) isc[j] += fmaxf(acc[j], 0.f) * iw[h]; \
                    } \
                    _Pragma("unroll") for (int j = 0; j < 4; ++j) isc[j] += 0.0f; \
                    *(LAS f32x4*)(SC + c * SCLD + (KT_) * 16 + 4 * g) = isc; \
                } while (0)
#pragma unroll
                for (int d = 0; d < 4; ++d) SI_LOAD(d, wave + NWAVES * d);
                int kt0 = wave;
#pragma unroll 1
                for (; kt0 + 3 * NWAVES < nkt; kt0 += 4 * NWAVES) {
#pragma unroll
                    for (int d = 0; d < 4; ++d) {
                        const int kt = kt0 + NWAVES * d;
                        SI_TILE(ka[d][0], ka[d][1], kt);
                        __builtin_amdgcn_sched_barrier(0);
                        SI_LOAD(d, kt + 4 * NWAVES);
                    }
                }
#pragma unroll
                for (int d = 0; d < 3; ++d) {
                    const int kt = kt0 + NWAVES * d;
                    if (kt < nkt) SI_TILE(ka[d][0], ka[d][1], kt);
                }
#undef SI_TILE
#undef SI_LOAD
                {
                    const int tail = ((nj <= 11 ? 11 : (nj <= 22 ? 22 : 33)) << 6) - nk;
                    for (int i = threadIdx.x; i < 16 * tail; i += NTHREADS) { const int qq_ = i / tail; SC[qq_ * SCLD + nk + (i - qq_ * tail)] = -3.0e38f; }
                }
            }
            __syncthreads();
            {
            int tz_ = threadIdx.x; asm volatile("" : "+v"(tz_)); const int lane = tz_ & 63, wave = __builtin_amdgcn_readfirstlane(tz_ >> 6); const u64 lt_mask = (1ull << lane) - 1ull;
#pragma unroll 1
            for (int qi = 0; qi < 2; ++qi) {
                const int cq = wave * 2 + qi;
                unsigned kv[33];
#pragma unroll
                for (int jj = 0; jj < 11; ++jj) kv[jj] = fkey(SC[cq * SCLD + jj * 64 + lane]);
                if (nj > 11) {
#pragma unroll
                    for (int jj = 11; jj < 22; ++jj) kv[jj] = fkey(SC[cq * SCLD + jj * 64 + lane]);
                } else {
#pragma unroll
                    for (int jj = 11; jj < 22; ++jj) kv[jj] = 0u;
                }
                if (nj > 22) {
#pragma unroll
                    for (int jj = 22; jj < 33; ++jj) kv[jj] = fkey(SC[cq * SCLD + jj * 64 + lane]);
                } else {
#pragma unroll
                    for (int jj = 22; jj < 33; ++jj) kv[jj] = 0u;
                }
                unsigned Tkey = 1u;
                if (nk > 256) {
                    Tkey = 0u;
#pragma unroll 1
                    for (int bit = 31; bit >= 0; --bit) {
                        const unsigned cand = Tkey | (1u << bit);
                        int nl = 0;
#pragma unroll
                        for (int jj = 0; jj < 11; ++jj) nl += (kv[jj] >= cand) ? 1 : 0;
                        if (nj > 11) {
#pragma unroll
                            for (int jj = 11; jj < 22; ++jj) nl += (kv[jj] >= cand) ? 1 : 0;
                        }
                        if (nj > 22) {
#pragma unroll
                            for (int jj = 22; jj < 33; ++jj) nl += (kv[jj] >= cand) ? 1 : 0;
                        }
                        const int cnt = wave_sum_int(nl);
                        if (cnt >= 256) Tkey = cand;
                        if (cnt == 256) break;
                    }
                }
                int cgl = 0;
#pragma unroll
                for (int jj = 0; jj < 33; ++jj) cgl += (kv[jj] > Tkey) ? 1 : 0;
                const int cgt = wave_sum_int(cgl);
                const int need = (nk > 256) ? 256 - cgt : 4096;
                int eqseen = 0;
#pragma unroll 1
                for (int jj = 0; jj < nj; ++jj) {
                    const int k = jj * 64 + lane; const float v = SC[cq * SCLD + k];
                    const unsigned key = (k < nk) ? fkey(v) : 0u;
                    const bool gt = key > Tkey, eq = (key == Tkey);
                    const u64 eqm = __ballot(eq);
                    const int myeq = eqseen + __popcll(eqm & lt_mask);
                    const u64 sm = __ballot(gt || (eq && myeq < need));
                    eqseen += __popcll(eqm);
                    if (lane == 0) MASK[(16 * sub + cq) * 34 + jj] = sm;
                }
                if ((nj & 1) && lane == 0) MASK[(16 * sub + cq) * 34 + nj] = 0ull;
            }
            }

            __syncthreads();
        }
        TP_END(1); TP_BEGIN(3);
        {
            int tz_ = threadIdx.x; asm volatile("" : "+v"(tz_)); const int lane = tz_ & 63, wave = __builtin_amdgcn_readfirstlane(tz_ >> 6); const int r = lane & 31, hh = lane >> 5;
            const int h = wave;
            const bf16_t* qrow = pb + (size_t)(NMETA + s0 + r) * INW + C_DQ + h * 128 + 8 * hh;
            bf16x8 bQ[8];
#pragma unroll
            for (int ks = 0; ks < 8; ++ks) bQ[ks] = *(const bf16x8*)(qrow + ks * 16);
            f32x16 O[4];
#pragma unroll
            for (int d = 0; d < 4; ++d)
#pragma unroll
                for (int i = 0; i < 16; ++i) O[d][i] = 0.f;
            float m_run = -1e30f, l_run = 0.f;
            const int n128 = (nk + 127) >> 7;
            const int drow = lane >> 4, dslot = lane & 15;
            int fa[4];
            const int rp = (r & ~12) | ((r & 4) << 1) | ((r & 8) >> 1);
#pragma unroll
            for (int m = 0; m < 4; ++m) fa[m] = rp * 256 + (((2 * m + hh) ^ (rp & 15)) << 4);
            const int fd = (rp & 8) ? -128 : 128;
#define FA(m) ((m) < 4 ? fa[(m) & 3] : fa[(m) & 3] + fd)
#define DSA_ISSUE(KB, BUF) do { \
                _Pragma("unroll") for (int j = 0; j < 4; ++j) { \
                    const int R_ = (wave * 4 + j) * 4 + drow, ch_ = dslot ^ (j * 4 + drow); \
                    int key_ = (KB) * 128 + R_; key_ = key_ < nk ? key_ : nk - 1; \
                    __builtin_amdgcn_global_load_lds((const unsigned*)(pb + (size_t)key_ * INW + C_DK + ch_ * 8), (LAS unsigned*)(smem + (BUF) * 65536 + (wave * 4 + j) * 1024), 16, 0, 0); \
                    __builtin_amdgcn_global_load_lds((const unsigned*)(dvt + (size_t)(b * 128 + R_) * TTP + (KB) * 128 + ch_ * 8), (LAS unsigned*)(smem + (BUF) * 65536 + 32768 + (wave * 4 + j) * 1024), 16, 0, 0); \
                } } while (0)
            DSA_ISSUE(0, 0);
#pragma unroll 1
            for (int kb = 0; kb < n128; ++kb) {
                asm volatile("s_waitcnt vmcnt(0)" ::: "memory");
                __syncthreads();
                if (kb + 1 < n128) DSA_ISSUE(kb + 1, (kb + 1) & 1);
                LAS char* KTb = smem + (kb & 1) * 65536; LAS char* VTb = KTb + 32768;
                const u64 mw0 = MASK[r * 34 + kb * 2], mw1 = MASK[r * 34 + kb * 2 + 1];
                f32x16 S; bf16x8 kf[8];
#define DSA_KF(KBLK) do { _Pragma("unroll") for (int ks = 0; ks < 8; ++ks) kf[ks] = *(const LAS bf16x8*)(KTb + (KBLK) * 8192 + FA(ks)); } while (0)
#define DSA_S_BLOCK(KBLK) do { \
                    const unsigned nmb_ = ~(unsigned)(((KBLK) >> 1 ? mw1 : mw0) >> ((((KBLK) & 1) * 32) + 8 * hh)); \
                    _Pragma("unroll") for (int i = 0; i < 16; ++i) { int x_; asm("v_bfe_i32 %0, %1, %2, 1" : "=v"(x_) : "v"(nmb_), "n"((i & 3) + 4 * ((i >> 2) & 1) + 16 * (i >> 3))); S[i] = __builtin_bit_cast(float, (unsigned)x_ & 0xff800000u); }     \
                    _Pragma("unroll") for (int ks = 0; ks < 8; ++ks) S = MFMA32(kf[ks], bQ[ks], S); \
                } while (0)
                DSA_KF(0);
                DSA_S_BLOCK(0);
#pragma unroll
                for (int kblk = 0; kblk < 4; ++kblk) {
                    if (kblk == 0) DSA_KF(1); else if (kblk == 1) DSA_KF(2); else if (kblk == 2) DSA_KF(3);
                    float mblk = fmaxf(S[0], S[1]);
#pragma unroll
                    for (int i = 2; i < 16; ++i) mblk = fmaxf(mblk, S[i]);
                    const auto sw = __builtin_amdgcn_permlane32_swap(__builtin_bit_cast(unsigned, mblk), __builtin_bit_cast(unsigned, mblk), false, false);
                    const float m_new = fmaxf(fmaxf(m_run, __builtin_bit_cast(float, (unsigned)sw[0])), __builtin_bit_cast(float, (unsigned)sw[1]));
                    if (__ballot(m_new != m_run) != 0ull) {
                        const float alpha = __builtin_amdgcn_exp2f(m_run - m_new);
                        l_run *= alpha;
#pragma unroll
                        for (int d = 0; d < 4; ++d)
#pragma unroll
                            for (int i = 0; i < 16; ++i) O[d][i] *= alpha;
                    }
                    m_run = m_new;
                    bf16x8 av[8];
#pragma unroll
                    for (int q = 0; q < 8; ++q) av[q] = *(const LAS bf16x8*)(VTb + (q >> 1) * 8192 + FA(2 * kblk + (q & 1)));
                    f32x2 ps2 = {0.f, 0.f};
                    const f32x2 mn2 = {m_new, m_new};
#pragma unroll
                    for (int i = 0; i < 8; ++i) {
                        f32x2 t2 = {S[2 * i], S[2 * i + 1]}; t2 = t2 - mn2;
                        t2[0] = __builtin_amdgcn_exp2f(t2[0]); t2[1] = __builtin_amdgcn_exp2f(t2[1]);
                        ps2 += t2; S[2 * i] = t2[0]; S[2 * i + 1] = t2[1];
                    }
                    l_run += ps2[0] + ps2[1];
                    bf16x8 bP[2];
#pragma unroll
                    for (int s2 = 0; s2 < 2; ++s2) {
                        u32x4 t4;
#pragma unroll
                        for (int x = 0; x < 4; ++x) t4[x] = pk2bf(S[8 * s2 + 2 * x], S[8 * s2 + 2 * x + 1]);
                        bP[s2] = __builtin_bit_cast(bf16x8, t4);
                    }
                    if (kblk < 3) DSA_S_BLOCK(kblk + 1);
#pragma unroll
                    for (int q = 0; q < 8; ++q) O[q >> 1] = MFMA32(av[q], bP[q & 1], O[q >> 1]);
                }
#undef DSA_S_BLOCK
#undef DSA_KF
            }
#undef DSA_ISSUE
#undef FA
            __syncthreads();
            TP_END(3); TP_BEGIN(4);
            l_run += __shfl_xor(l_run, 32);
            const float inv = 1.f / l_run;
            bf16x8 bO[4][2];
#pragma unroll
            for (int d = 0; d < 4; ++d)
#pragma unroll
                for (int s2 = 0; s2 < 2; ++s2) {
                    u32x4 t4;
#pragma unroll
                    for (int x = 0; x < 4; ++x) t4[x] = pk2bf(O[d][8 * s2 + 2 * x] * inv, O[d][8 * s2 + 2 * x + 1] * inv);
                    bO[d][s2] = __builtin_bit_cast(bf16x8, t4);
                }
            bf16_t* orow = mixed + (size_t)(b * SEQ + s0 + r) * DM + 512 + h * 64 + 4 * hh;
            int zofs = 0; asm volatile("" : "+v"(zofs));
#pragma unroll
            for (int eb = 0; eb < 2; ++eb) {
                f32x16 acc;
#pragma unroll
                for (int i = 0; i < 16; ++i) acc[i] = 0.f;
#pragma unroll
                for (int d = 0; d < 4; ++d)
#pragma unroll
                    for (int s2 = 0; s2 < 2; ++s2) {
                        const bf16x8 a = *(const bf16x8*)(wuvt + (size_t)(h * 64 + eb * 32 + r) * 128 + d * 32 + 16 * s2 + 8 * hh + zofs);
                        acc = MFMA32(a, bO[d][s2], acc);
                    }
#pragma unroll
                for (int g4 = 0; g4 < 4; ++g4) { uint2 w; w.x = pk2bf(acc[4 * g4], acc[4 * g4 + 1]); w.y = pk2bf(acc[4 * g4 + 2], acc[4 * g4 + 3]); *(uint2*)(orow + eb * 32 + 8 * g4) = w; }
            }
            TP_END(4);
        }
    }
}

DI void phase_ret_scan(const Params& p) {
    float* ST = (float*)(p.ws + OFF_ST);
    const int gtid = blockIdx.x * NTHREADS + threadIdx.x, gsz = gridDim.x * NTHREADS;
    for (int idx = gtid; idx < 32 * 16384; idx += gsz) {
        const int bh = idx >> 14, el = idx & 16383, h = bh & 3;
        const float gc = expf(logf(1.f - exp2f(-5.f - (float)h)) * 64.f);
        float* base = ST + (size_t)bh * 34 * 16384 + el;
        float r = 0.f;
        for (int c = 1; c < 34; ++c) {
            const float u = c < 33 ? base[(size_t)c * 16384] : 0.f;
            base[(size_t)c * 16384] = r;
            r = gc * r + u;
        }
    }
}

constexpr int RLD = 136, RTLD = 72;
DI void phase_ret_state_mfma(const Params& p, LAS char* smem) {
    const bf16_t* proj = (const bf16_t*)(p.ws + OFF_BIG);
    float* ST = (float*)(p.ws + OFF_ST);
    LAS bf16_t* sVT = (LAS bf16_t*)smem; LAS bf16_t* sKT = sVT + 128 * RTLD;
    const int wave = threadIdx.x >> 6, lane = threadIdx.x & 63, r = lane & 31, hh = lane >> 5;
    for (int unit = blockIdx.x; unit < 1024; unit += gridDim.x) {
        const int c = 1 + (unit & 31), bh = unit >> 5, h = bh & 3, b = bh >> 2;
        const float lg = logf(1.f - exp2f(-5.f - (float)h));
        {
            const int j = threadIdx.x >> 3, ch = threadIdx.x & 7, t = 64 * c + j - 112;
            const float z = expf(lg * (float)(63 - j));
#pragma unroll
            for (int q = 0; q < 2; ++q) {
                const int cc = ch + 8 * q;
                u32x4 kv = {0u, 0u, 0u, 0u}, vv = {0u, 0u, 0u, 0u};
                if (t >= 0) { const bf16_t* pr = proj + (size_t)(b * TT + t) * INW; kv = *(const u32x4*)(pr + C_RK + h * 128 + cc * 8); vv = *(const u32x4*)(pr + C_RV + h * 128 + cc * 8); }
                float vf[8]; unpack8(vv, vf);
#pragma unroll
                for (int x = 0; x < 8; ++x) {
                    sKT[(cc * 8 + x) * RTLD + j] = (bf16_t)((kv[x >> 1] >> ((x & 1) * 16)) & 0xffffu);
                    sVT[(cc * 8 + x) * RTLD + j] = f2bf(vf[x] * z);
                }
            }
        }
        __syncthreads();
        const int mb = wave >> 1;
#pragma unroll
        for (int q = 0; q < 2; ++q) {
            const int nb = (wave & 1) * 2 + q;
            f32x16 acc;
#pragma unroll
            for (int i = 0; i < 16; ++i) acc[i] = 0.f;
#pragma unroll
            for (int ks = 0; ks < 4; ++ks) {
                const bf16x8 a = *(const LAS bf16x8*)(sVT + (mb * 32 + r) * RTLD + ks * 16 + 8 * hh);
                const bf16x8 bb = *(const LAS bf16x8*)(sKT + (nb * 32 + r) * RTLD + ks * 16 + 8 * hh);
                acc = MFMA32(a, bb, acc);
            }
            float* st = ST + (size_t)(bh * 34 + c) * 16384 + nb * 32 + r;
#pragma unroll
            for (int i = 0; i < 16; ++i) st[(size_t)(mb * 32 + (i & 3) + 8 * (i >> 2) + 4 * hh) * 128] = acc[i];
        }
        __syncthreads();
    }
}
DI void phase_ret_out_mfma(const Params& p, LAS char* smem) {
    const bf16_t* proj = (const bf16_t*)(p.ws + OFF_BIG);
    const float* ST = (const float*)(p.ws + OFF_ST);
    bf16_t* mixed = (bf16_t*)(p.ws + OFF_HN);
    LAS bf16_t* sQ = (LAS bf16_t*)smem; LAS bf16_t* sK = sQ + 64 * RLD; LAS bf16_t* sVT = sK + 64 * RLD;
    LAS float* sGN = (LAS float*)(sVT + 128 * RTLD);
    const int wave = threadIdx.x >> 6, lane = threadIdx.x & 63, r = lane & 31, hh = lane >> 5;
    const int ib = wave & 1, eb = wave >> 1;
    for (int unit = blockIdx.x; unit < 1024; unit += gridDim.x) {
        const int c = 2 + (unit & 31), bh = unit >> 5, h = bh & 3, b = bh >> 2;
        const float lg = logf(1.f - exp2f(-5.f - (float)h));
        for (int i = threadIdx.x; i < 64 * 16; i += NTHREADS) {
            const int j = i >> 4, ch = i & 15; const int t = 64 * c + j - 112;
            const bf16_t* pr = proj + (size_t)(b * TT + t) * INW;
            *(LAS u32x4*)(sQ + j * RLD + ch * 8) = *(const u32x4*)(pr + C_RQ + h * 128 + ch * 8);
            *(LAS u32x4*)(sK + j * RLD + ch * 8) = *(const u32x4*)(pr + C_RK + h * 128 + ch * 8);
            const u32x4 vv = *(const u32x4*)(pr + C_RV + h * 128 + ch * 8);
#pragma unroll
            for (int x = 0; x < 8; ++x) sVT[(ch * 8 + x) * RTLD + j] = (bf16_t)((vv[x >> 1] >> ((x & 1) * 16)) & 0xffffu);
        }
        __syncthreads();
        f32x16 acc;
#pragma unroll
        for (int i = 0; i < 16; ++i) acc[i] = 0.f;
        {
            const float* R = ST + (size_t)(bh * 34 + c) * 16384 + (size_t)(eb * 32 + r) * 128 + 8 * hh;
#pragma unroll
            for (int ks = 0; ks < 8; ++ks) {
                const float4 r0 = *(const float4*)(R + ks * 16), r1 = *(const float4*)(R + ks * 16 + 4);
                const float rf[8] = {r0.x, r0.y, r0.z, r0.w, r1.x, r1.y, r1.z, r1.w};
                const bf16x8 a = pack8(rf);
                const bf16x8 bq = *(const LAS bf16x8*)(sQ + (ib * 32 + r) * RLD + ks * 16 + 8 * hh);
                acc = MFMA32(a, bq, acc);
            }
            const float xi = expf(lg * (float)(ib * 32 + r + 1));
#pragma unroll
            for (int i = 0; i < 16; ++i) acc[i] *= xi;
        }
#pragma unroll
        for (int jb = 0; jb < 2; ++jb) {
            f32x16 st;
#pragma unroll
            for (int i = 0; i < 16; ++i) st[i] = 0.f;
#pragma unroll
            for (int ks = 0; ks < 8; ++ks) {
                const bf16x8 a = *(const LAS bf16x8*)(sK + (jb * 32 + r) * RLD + ks * 16 + 8 * hh);
                const bf16x8 bq = *(const LAS bf16x8*)(sQ + (ib * 32 + r) * RLD + ks * 16 + 8 * hh);
                st = MFMA32(a, bq, st);
            }
            const int icol = ib * 32 + r;
#pragma unroll
            for (int i = 0; i < 16; ++i) {
                const int j = jb * 32 + (i & 3) + 8 * (i >> 2) + 4 * hh; const int df = icol > j ? icol - j : j - icol;
                st[i] *= expf(lg * (float)df);
            }
#pragma unroll
            for (int s2 = 0; s2 < 2; ++s2) {
                bf16x8 bp;
#pragma unroll
                for (int x = 0; x < 8; ++x) bp[x] = (short)f2bf(st[8 * s2 + x]);
                const LAS bf16_t* vr = sVT + (eb * 32 + r) * RTLD + jb * 32 + 16 * s2 + 4 * hh;
                const s16x4 lo = *(const LAS s16x4*)(vr), hi = *(const LAS s16x4*)(vr + 8);
                const bf16x8 a = __builtin_shufflevector(lo, hi, 0, 1, 2, 3, 4, 5, 6, 7);
                acc = MFMA32(a, bp, acc);
            }
        }
        float s1 = 0.f, s2 = 0.f;
#pragma unroll
        for (int i = 0; i < 16; ++i) { s1 += acc[i]; s2 += acc[i] * acc[i]; }
        s1 += __shfl_xor(s1, 32); s2 += __shfl_xor(s2, 32);
        if (hh == 0) { sGN[(eb * 64 + ib * 32 + r) * 2] = s1; sGN[(eb * 64 + ib * 32 + r) * 2 + 1] = s2; }
        __syncthreads();
        float S1 = 0.f, S2 = 0.f;
#pragma unroll
        for (int e4 = 0; e4 < 4; ++e4) { S1 += sGN[(e4 * 64 + ib * 32 + r) * 2]; S2 += sGN[(e4 * 64 + ib * 32 + r) * 2 + 1]; }
        const float mu = S1 * (1.f / 128.f), var = fmaxf(S2 * (1.f / 128.f) - mu * mu, 0.f), rs = rsqrtf(var + 1e-6f);
        const int t = 64 * c + ib * 32 + r - 112, srow = t - NMETA;
        const bf16_t* pg = proj + (size_t)(b * TT + t) * INW + C_RG + h * 128 + eb * 32 + 4 * hh;
        bf16_t* po = mixed + (size_t)(b * SEQ + srow) * DM + h * 128 + eb * 32 + 4 * hh;
#pragma unroll
        for (int g4 = 0; g4 < 4; ++g4) {
            const uint2 graw = *(const uint2*)(pg + 8 * g4);
            const float gv[4] = {__uint_as_float(graw.x << 16), __uint_as_float(graw.x & 0xffff0000u), __uint_as_float(graw.y << 16), __uint_as_float(graw.y & 0xffff0000u)};
            float o[4];
#pragma unroll
            for (int x = 0; x < 4; ++x) { const float gate = gv[x] / (1.f + expf(-gv[x])); o[x] = gate * (acc[4 * g4 + x] - mu) * rs; }
            uint2 w; w.x = (unsigned)f2bf(o[0]) | ((unsigned)f2bf(o[1]) << 16); w.y = (unsigned)f2bf(o[2]) | ((unsigned)f2bf(o[3]) << 16);
            *(uint2*)(po + 8 * g4) = w;
        }
        __syncthreads();
    }
}

DI void phase_norm2(const Params& p) {
    bf16_t* hn2 = (bf16_t*)(p.ws + OFF_HN);
    const int wave = threadIdx.x >> 6, lane = threadIdx.x & 63;
    for (int row = blockIdx.x * NWAVES + wave; row < NF; row += gridDim.x * NWAVES) {
        const float* src = p.out + (size_t)row * DM; bf16_t* o = hn2 + (size_t)row * DM;
        float4 v[4]; float ss = 0.f;
#pragma unroll
        for (int i = 0; i < 4; ++i) { v[i] = *(const float4*)(src + i * 256 + lane * 4); ss += v[i].x * v[i].x + v[i].y * v[i].y + v[i].z * v[i].z + v[i].w * v[i].w; }
        ss = wave_sum(ss);
        const float rstd = rsqrtf(ss * (1.f / DM) + 1e-6f);
#pragma unroll
        for (int i = 0; i < 4; ++i) {
            const float4 g = *(const float4*)(p.norm_ffn + i * 256 + lane * 4);
            uint2 w;
            w.x = (unsigned)f2bf(v[i].x * rstd * g.x) | ((unsigned)f2bf(v[i].y * rstd * g.y) << 16);
            w.y = (unsigned)f2bf(v[i].z * rstd * g.z) | ((unsigned)f2bf(v[i].w * rstd * g.w) << 16);
            *(uint2*)(o + i * 256 + lane * 4) = w;
        }
    }
}

__device__ const int PEER_PAIRS[50] = {0, 2, 4, 6, 8, 10, 12, 14, 16, 18, 20, 22, 32, 34, 36, 49, 51, 65, 80, 96, 112, 128, 160, 192, 224, 1, 3, 5, 7, 9, 11, 13, 15, 17, 19, 21, 23, 33, 35, 48, 50, 64, 66, 81, 97, 113, 144, 176, 208, 240};
constexpr int PSEL_WAVE_LDS = 32 * 2 * 16 * 8 + 32 * 16 * 8;
#define PSEL_CE(K, a, b) { const unsigned hi_ = (K)[a] > (K)[b] ? (K)[a] : (K)[b]; const unsigned lo_ = (K)[a] > (K)[b] ? (K)[b] : (K)[a]; (K)[a] = hi_; (K)[b] = lo_; }
#define PSEL_SORT16(K, B) do { \
    PSEL_CE(K, (B) + 0, (B) + 1); PSEL_CE(K, (B) + 2, (B) + 3); PSEL_CE(K, (B) + 0, (B) + 2); PSEL_CE(K, (B) + 1, (B) + 3); PSEL_CE(K, (B) + 1, (B) + 2); PSEL_CE(K, (B) + 4, (B) + 5); \
    PSEL_CE(K, (B) + 6, (B) + 7); PSEL_CE(K, (B) + 4, (B) + 6); PSEL_CE(K, (B) + 5, (B) + 7); PSEL_CE(K, (B) + 5, (B) + 6); PSEL_CE(K, (B) + 0, (B) + 4); PSEL_CE(K, (B) + 2, (B) + 6); \
    PSEL_CE(K, (B) + 2, (B) + 4); PSEL_CE(K, (B) + 1, (B) + 5); PSEL_CE(K, (B) + 3, (B) + 7); PSEL_CE(K, (B) + 3, (B) + 5); PSEL_CE(K, (B) + 1, (B) + 2); PSEL_CE(K, (B) + 3, (B) + 4); \
    PSEL_CE(K, (B) + 5, (B) + 6); PSEL_CE(K, (B) + 8, (B) + 9); PSEL_CE(K, (B) + 10, (B) + 11); PSEL_CE(K, (B) + 8, (B) + 10); PSEL_CE(K, (B) + 9, (B) + 11); PSEL_CE(K, (B) + 9, (B) + 10); \
    PSEL_CE(K, (B) + 12, (B) + 13); PSEL_CE(K, (B) + 14, (B) + 15); PSEL_CE(K, (B) + 12, (B) + 14); PSEL_CE(K, (B) + 13, (B) + 15); PSEL_CE(K, (B) + 13, (B) + 14); PSEL_CE(K, (B) + 8, (B) + 12); \
    PSEL_CE(K, (B) + 10, (B) + 14); PSEL_CE(K, (B) + 10, (B) + 12); PSEL_CE(K, (B) + 9, (B) + 13); PSEL_CE(K, (B) + 11, (B) + 15); PSEL_CE(K, (B) + 11, (B) + 13); PSEL_CE(K, (B) + 9, (B) + 10); \
    PSEL_CE(K, (B) + 11, (B) + 12); PSEL_CE(K, (B) + 13, (B) + 14); PSEL_CE(K, (B) + 0, (B) + 8); PSEL_CE(K, (B) + 4, (B) + 12); PSEL_CE(K, (B) + 4, (B) + 8); PSEL_CE(K, (B) + 2, (B) + 10); \
    PSEL_CE(K, (B) + 6, (B) + 14); PSEL_CE(K, (B) + 6, (B) + 10); PSEL_CE(K, (B) + 2, (B) + 4); PSEL_CE(K, (B) + 6, (B) + 8); PSEL_CE(K, (B) + 10, (B) + 12); PSEL_CE(K, (B) + 1, (B) + 9); \
    PSEL_CE(K, (B) + 5, (B) + 13); PSEL_CE(K, (B) + 5, (B) + 9); PSEL_CE(K, (B) + 3, (B) + 11); PSEL_CE(K, (B) + 7, (B) + 15); PSEL_CE(K, (B) + 7, (B) + 11); PSEL_CE(K, (B) + 3, (B) + 5); \
    PSEL_CE(K, (B) + 7, (B) + 9); PSEL_CE(K, (B) + 11, (B) + 13); PSEL_CE(K, (B) + 1, (B) + 2); PSEL_CE(K, (B) + 3, (B) + 4); PSEL_CE(K, (B) + 5, (B) + 6); PSEL_CE(K, (B) + 7, (B) + 8); \
    PSEL_CE(K, (B) + 9, (B) + 10); PSEL_CE(K, (B) + 11, (B) + 12); PSEL_CE(K, (B) + 13, (B) + 14); \
} while (0)
#define PSEL_BMERGE16(K) do { \
    PSEL_CE(K, 0, 8); PSEL_CE(K, 1, 9); PSEL_CE(K, 2, 10); PSEL_CE(K, 3, 11); PSEL_CE(K, 4, 12); PSEL_CE(K, 5, 13); \
    PSEL_CE(K, 6, 14); PSEL_CE(K, 7, 15); PSEL_CE(K, 0, 4); PSEL_CE(K, 1, 5); PSEL_CE(K, 2, 6); PSEL_CE(K, 3, 7); \
    PSEL_CE(K, 8, 12); PSEL_CE(K, 9, 13); PSEL_CE(K, 10, 14); PSEL_CE(K, 11, 15); PSEL_CE(K, 0, 2); PSEL_CE(K, 1, 3); \
    PSEL_CE(K, 4, 6); PSEL_CE(K, 5, 7); PSEL_CE(K, 8, 10); PSEL_CE(K, 9, 11); PSEL_CE(K, 12, 14); PSEL_CE(K, 13, 15); \
    PSEL_CE(K, 0, 1); PSEL_CE(K, 2, 3); PSEL_CE(K, 4, 5); PSEL_CE(K, 6, 7); PSEL_CE(K, 8, 9); PSEL_CE(K, 10, 11); \
    PSEL_CE(K, 12, 13); PSEL_CE(K, 14, 15); \
} while (0)
DI void peer_top16(unsigned (&K)[64], const int hh) {
    PSEL_SORT16(K, 0); PSEL_SORT16(K, 16); PSEL_SORT16(K, 32); PSEL_SORT16(K, 48);
#pragma unroll
    for (int c = 1; c < 4; ++c) {
#pragma unroll
        for (int i = 0; i < 16; ++i) K[i] = K[i] > K[16 * c + 15 - i] ? K[i] : K[16 * c + 15 - i];
        PSEL_BMERGE16(K);
    }
    unsigned Tp[16];
#pragma unroll
    for (int i = 0; i < 16; ++i) { K[i] |= (unsigned)hh << 6; Tp[i] = (unsigned)__shfl_xor((int)K[i], 32); }
#pragma unroll
    for (int i = 0; i < 16; ++i) K[i] = K[i] > Tp[15 - i] ? K[i] : Tp[15 - i];
    PSEL_BMERGE16(K);
}
DI void peer_pairs_tail(LAS float* lv, LAS int* li, LAS float* cs, LAS int* cab, const int r, const int hh, const int n, const int h, unsigned* EG, const float* SSQ) {
        {
            unsigned KP[32];
#pragma unroll
            for (int i = 0; i < 25; ++i) {
                const int code = PEER_PAIRS[hh * 25 + i];
                KP[i] = (fkey(lv[(r * 2 + 0) * 16 + (code >> 4)] + lv[(r * 2 + 1) * 16 + (code & 15)]) & ~255u) | (unsigned)code;
            }
#pragma unroll
            for (int i = 25; i < 32; ++i) KP[i] = 0u;
            PSEL_SORT16(KP, 0); PSEL_SORT16(KP, 16);
#pragma unroll
            for (int i = 0; i < 16; ++i) KP[i] = KP[i] > KP[31 - i] ? KP[i] : KP[31 - i];
            PSEL_BMERGE16(KP);
            unsigned Tp[16];
#pragma unroll
            for (int i = 0; i < 16; ++i) Tp[i] = (unsigned)__shfl_xor((int)KP[i], 32);
#pragma unroll
            for (int i = 0; i < 16; ++i) KP[i] = KP[i] > Tp[15 - i] ? KP[i] : Tp[15 - i];
            PSEL_BMERGE16(KP);
#pragma unroll
            for (int i = 0; i < 16; ++i) { cs[r * 16 + i] = funkey(KP[i] & ~255u); cab[r * 16 + i] = (int)(KP[i] & 255u); }
        }
        lds_fence();
        const float rstd = rsqrtf(SSQ[n] * (1.f / DM) + 1e-6f);
        float scv[16]; float mx = -INFINITY;
#pragma unroll
        for (int i = 0; i < 16; ++i) { scv[i] = cs[r * 16 + i]; mx = fmaxf(mx, scv[i]); }
        float sum = 0.f;
#pragma unroll
        for (int i = 0; i < 16; ++i) { scv[i] = expf((scv[i] - mx) * rstd); sum += scv[i]; }
        const float inv = 1.f / sum;
#pragma unroll
        for (int i = 0; i < 16; ++i) {
            if ((i >> 3) == hh) {
                const int ab = cab[r * 16 + i];
                const int e = li[(r * 2 + 0) * 16 + (ab >> 4)] * 128 + li[(r * 2 + 1) * 16 + (ab & 15)];
                const _Float16 gh = (_Float16)(scv[i] * inv);
                EG[(size_t)n * 128 + h * 16 + i] = (unsigned)e | ((unsigned)__builtin_bit_cast(unsigned short, gh) << 16);
            }
        }
        lds_fence();
}
DI Params load_params();
constexpr int PSEL_RS = 132;
struct EpiSel {
    static constexpr bool kOpaqueStage = true;
    LAS char* smem;
    DI void operator()(const f32x4 (&acc)[2][2][4][2], int brow, int bcol, int wr_, int wc_, int fr_, int fq_) const {
        LAS unsigned* SCR = (LAS unsigned*)smem;
        int tz = threadIdx.x; asm volatile("" : "+v"(tz));
        const int lane = tz & 63, wave = __builtin_amdgcn_readfirstlane(tz >> 6), wr = wave >> 2, wc = wave & 3, fr = lane & 15, fq = lane >> 4, r = lane & 31, hh = lane >> 5;
        unsigned K0[16], K[64];
#pragma unroll
        for (int half = 0; half < 2; ++half) {
#pragma unroll
            for (int ai = 0; ai < 2; ++ai)
#pragma unroll
            for (int m = 0; m < 4; ++m)
#pragma unroll
            for (int n2 = 0; n2 < 2; ++n2)
#pragma unroll
            for (int j = 0; j < 4; ++j) {
                const int row = ai * HALF + wr * 64 + m * 16 + fq * 4 + j, colp = wc * 32 + n2 * 16 + fr;
                SCR[row * PSEL_RS + colp] = (fkey(acc[ai][half][m][n2][j]) & ~127u) | (unsigned)(colp & 63);
            }
            __syncthreads();
            {
                const LAS unsigned* srow = SCR + (wave * 32 + r) * PSEL_RS + hh * 64;
#pragma unroll
                for (int q = 0; q < 16; ++q) { const u32x4 a = *(const LAS u32x4*)(srow + q * 4); K[q * 4] = a[0]; K[q * 4 + 1] = a[1]; K[q * 4 + 2] = a[2]; K[q * 4 + 3] = a[3]; }
            }
            peer_top16(K, hh);
            if (half == 0) {
#pragma unroll
                for (int i = 0; i < 16; ++i) K0[i] = K[i];
            }
            __syncthreads();
        }
        LAS float* lv = (LAS float*)(smem + wave * PSEL_WAVE_LDS);
        LAS int* li = (LAS int*)(lv + 32 * 2 * 16);
        LAS float* cs = (LAS float*)(li + 32 * 2 * 16);
        LAS int* cab = (LAS int*)(cs + 32 * 16);
#pragma unroll
        for (int i = 0; i < 16; ++i) {
            lv[(r * 2 + 0) * 16 + i] = funkey(K0[i] & ~127u); li[(r * 2 + 0) * 16 + i] = (int)(K0[i] & 127u);
            lv[(r * 2 + 1) * 16 + i] = funkey(K[i] & ~127u); li[(r * 2 + 1) * 16 + i] = (int)(K[i] & 127u);
        }
        lds_fence();
        { const Params q = load_params(); peer_pairs_tail(lv, li, cs, cab, r, hh, brow + wave * 32 + r, bcol >> 8, (unsigned*)(q.ws + OFF_EG), (const float*)(q.ws + OFF_SSQ)); }
    }
};
typedef float f32x2 __attribute__((ext_vector_type(2)));
DI void phase_convert_tables(const Params& p) {
    int tz = threadIdx.x; asm volatile("" : "+v"(tz));
    const int wave = tz >> 6, lane = tz & 63;
    for (int rowi = blockIdx.x * NWAVES + wave; rowi < 2 * 16384; rowi += gridDim.x * NWAVES) {
        const bool isv = rowi >= 16384; const int e = isv ? rowi - 16384 : rowi;
        const float* src = (isv ? p.pv : p.pu) + (size_t)e * DM + lane * 16;
        float x[16]; float mx = 0.f;
#pragma unroll
        for (int i = 0; i < 4; ++i) { const float4 a = *(const float4*)(src + i * 4); x[i * 4] = a.x; x[i * 4 + 1] = a.y; x[i * 4 + 2] = a.z; x[i * 4 + 3] = a.w; }
#pragma unroll
        for (int i = 0; i < 16; ++i) mx = fmaxf(mx, fabsf(x[i]));
        mx = wave_max(mx);
        const float top = isv ? 240.f : 127.f;
        const float inv = mx > 0.f ? top / mx : 0.f, scale = mx > 0.f ? mx / top : 0.f;
        u32x4 o;
        if (isv) {
#pragma unroll
            for (int w = 0; w < 4; ++w) {
                int pk = 0;
                pk = __builtin_amdgcn_cvt_pk_fp8_f32(x[w * 4] * inv, x[w * 4 + 1] * inv, pk, false);
                pk = __builtin_amdgcn_cvt_pk_fp8_f32(x[w * 4 + 2] * inv, x[w * 4 + 3] * inv, pk, true);
                o[w] = (unsigned)pk;
            }
        } else {
#pragma unroll
            for (int w = 0; w < 4; ++w) {
                unsigned pk = 0u;
#pragma unroll
                for (int b = 0; b < 4; ++b) { const int q = (int)rintf(x[w * 4 + b] * inv); pk |= ((unsigned)q & 0xffu) << (8 * b); }
                o[w] = pk;
            }
        }
        *(u32x4*)(p.ws + (isv ? OFF_V8 : OFF_U8) + (size_t)e * DM + lane * 16) = o;
        if (lane == 0) ((float*)(p.ws + (isv ? OFF_SV : OFF_SU)))[e] = scale;
    }
}
DI void unpack16_fp8(const u32x4& r, float (&v)[16]) {
#pragma unroll
    for (int w = 0; w < 4; ++w) {
        const f32x2 a = __builtin_amdgcn_cvt_pk_f32_fp8((int)r[w], false), b = __builtin_amdgcn_cvt_pk_f32_fp8((int)r[w], true);
        v[w * 4] = a[0]; v[w * 4 + 1] = a[1]; v[w * 4 + 2] = b[0]; v[w * 4 + 3] = b[1];
    }
}
constexpr int RW_NB = 128, RW_SH = 7;
constexpr int RW_WAVE_LDS = 4 * (RW_NB + 16) * 4 + 4 * 128 * 4 + 4 * 128 * 4;
DI float gelu_as(float v) {
    const float av = fabsf(v), t = __builtin_amdgcn_rcpf(av * 0.2316418882f + 1.0f);
    float q = t * 0.5307027145f + (-0.7265760135f); q = q * t + 0.7107068705f; q = q * t + (-0.142248368f); q = q * t + 0.127414796f; q = q * t;
    const float e = __builtin_amdgcn_exp2f((v * v) * (-0.72134752044f));
    const float m = v * (q * e), r = v - m;
    return v < 0.f ? m : r;
}
DI void phase_peer_out_rows(const Params& p, LAS char* smem) {
    const unsigned* EG = (const unsigned*)(p.ws + OFF_EG);
    const char* U8 = p.ws + OFF_U8; const char* V8 = p.ws + OFF_V8;
    const float* SU = (const float*)(p.ws + OFF_SU); const float* SV = (const float*)(p.ws + OFF_SV);
    int tz = threadIdx.x; asm volatile("" : "+v"(tz));
    const int wave = __builtin_amdgcn_readfirstlane(tz >> 6), lane = tz & 63, r = lane >> 4, l16 = lane & 15;
    LAS int* cnt = (LAS int*)(smem + wave * RW_WAVE_LDS) + r * (RW_NB + 16);
    LAS int* list_e = (LAS int*)(smem + wave * RW_WAVE_LDS + 4 * (RW_NB + 16) * 4) + r * 128;
    LAS float* list_g = (LAS float*)(smem + wave * RW_WAVE_LDS + 4 * (RW_NB + 16) * 4 + 2048) + r * 128;
    for (int grp = blockIdx.x * NWAVES + wave; grp < NF / 4; grp += gridDim.x * NWAVES) {
        const int n = grp * 4 + r;
        float acc[64]; int hq[16]; float hscale;
        const float* hrow = p.out + (size_t)n * DM + l16 * 16;
        {
            float hn[64];
            float ss = 0.f;
#pragma unroll
            for (int j = 0; j < 4; ++j)
#pragma unroll
                for (int q = 0; q < 4; ++q) { const float4 a = *(const float4*)(hrow + j * 256 + q * 4); hn[j * 16 + q * 4] = a.x; hn[j * 16 + q * 4 + 1] = a.y; hn[j * 16 + q * 4 + 2] = a.z; hn[j * 16 + q * 4 + 3] = a.w; }
#pragma unroll
            for (int i = 0; i < 64; ++i) ss += hn[i] * hn[i];
            ss = dpp_row_sum(ss);
            const float rstd = rsqrtf(ss * (1.f / DM) + 1e-6f);
#pragma unroll
            for (int j = 0; j < 4; ++j)
#pragma unroll
                for (int q = 0; q < 4; ++q) {
                    const float4 a = *(const float4*)(p.norm_ffn + j * 256 + l16 * 16 + q * 4);
                    hn[j * 16 + q * 4] *= rstd * a.x; hn[j * 16 + q * 4 + 1] *= rstd * a.y; hn[j * 16 + q * 4 + 2] *= rstd * a.z; hn[j * 16 + q * 4 + 3] *= rstd * a.w;
                }
            float hm = 0.f;
#pragma unroll
            for (int i = 0; i < 64; ++i) hm = fmaxf(hm, fabsf(hn[i]));
            hm = fmaxf(hm, __int_as_float(__builtin_amdgcn_update_dpp(0, __float_as_int(hm), 0xB1, 0xF, 0xF, true)));
            hm = fmaxf(hm, __int_as_float(__builtin_amdgcn_update_dpp(0, __float_as_int(hm), 0x4E, 0xF, 0xF, true)));
            hm = fmaxf(hm, __int_as_float(__builtin_amdgcn_update_dpp(0, __float_as_int(hm), 0x141, 0xF, 0xF, true)));
            hm = fmaxf(hm, __int_as_float(__builtin_amdgcn_update_dpp(0, __float_as_int(hm), 0x140, 0xF, 0xF, true)));
            const float hinv = hm > 0.f ? 127.f / hm : 0.f; hscale = hm * (1.f / 127.f);
#pragma unroll
            for (int w = 0; w < 16; ++w) {
                unsigned pk = 0u;
#pragma unroll
                for (int b = 0; b < 4; ++b) { const int q = (int)rintf(hn[w * 4 + b] * hinv); pk |= ((unsigned)q & 0xffu) << (8 * b); }
                hq[w] = (int)pk;
            }
#pragma unroll
            for (int i = 0; i < 64; ++i) acc[i] = 0.f;
        }
#pragma unroll
        for (int q = 0; q < RW_NB / 16; ++q) cnt[q * 16 + l16] = 0;
        lds_fence();
        {
            int ek[8], rk[8]; float gk[8];
#pragma unroll
            for (int k = 0; k < 8; ++k) { const unsigned w = EG[(size_t)n * 128 + k * 16 + l16]; ek[k] = (int)(w & 0xffffu); gk[k] = (float)__builtin_bit_cast(_Float16, (unsigned short)(w >> 16)); }
#pragma unroll
            for (int k = 0; k < 8; ++k) rk[k] = __hip_atomic_fetch_add(&cnt[ek[k] >> RW_SH], 1, __ATOMIC_RELAXED, __HIP_MEMORY_SCOPE_WORKGROUP);
            lds_fence();
            {
                constexpr int PB = RW_NB / 16;
                int c[PB], tot = 0;
#pragma unroll
                for (int q = 0; q < PB; ++q) { c[q] = cnt[l16 * PB + q]; tot += c[q]; }
                cnt[RW_NB + l16] = tot;
                lds_fence();
                int base = 0;
#pragma unroll
                for (int q = 0; q < 16; ++q) { const int v = cnt[RW_NB + q]; base += (q < l16) ? v : 0; }
#pragma unroll
                for (int q = 0; q < PB; ++q) { cnt[l16 * PB + q] = base; base += c[q]; }
            }
            lds_fence();
#pragma unroll
            for (int k = 0; k < 8; ++k) { const int pos = cnt[ek[k] >> RW_SH] + rk[k]; list_e[pos] = ek[k]; list_g[pos] = gk[k]; }
        }
        lds_fence();
        {
            u32x4 ub[4], vb[4]; float g_c, su_c, sv_c, g_n = 0.f, su_n = 0.f, sv_n = 0.f;
            {
                const int e_ = list_e[0]; g_c = list_g[0]; su_c = SU[e_]; sv_c = SV[e_];
#pragma unroll
                for (int j = 0; j < 4; ++j) { ub[j] = *(const u32x4*)(U8 + (size_t)e_ * DM + l16 * 16 + j * 256); vb[j] = *(const u32x4*)(V8 + (size_t)e_ * DM + l16 * 16 + j * 256); }
            }
#pragma unroll 1
            for (int sl = 0; sl < 128; ++sl) {
                int isum = 0;
#pragma unroll
                for (int j = 0; j < 4; ++j)
#pragma unroll
                    for (int w = 0; w < 4; ++w) isum = __builtin_amdgcn_sdot4((int)ub[j][w], hq[j * 4 + w], isum, false);
                isum += __builtin_amdgcn_update_dpp(0, isum, 0xB1, 0xF, 0xF, true);
                isum += __builtin_amdgcn_update_dpp(0, isum, 0x4E, 0xF, 0xF, true);
                isum += __builtin_amdgcn_update_dpp(0, isum, 0x141, 0xF, 0xF, true);
                isum += __builtin_amdgcn_update_dpp(0, isum, 0x140, 0xF, 0xF, true);
                float t_ = (float)isum * hscale;
                const int sn = sl + 1 < 128 ? sl + 1 : 127;
                const int e_n = list_e[sn];
                {
                    const char* up_ = U8 + (size_t)e_n * DM + l16 * 16;
#pragma unroll
                    for (int j = 0; j < 4; ++j) ub[j] = *(const u32x4*)(up_ + j * 256);
                    g_n = list_g[sn]; su_n = SU[e_n]; sv_n = SV[e_n];
                }
                t_ *= su_c;
                const float coef_ = gelu_as(t_) * g_c * sv_c;
#pragma unroll
                for (int j = 0; j < 4; ++j) { float v[16]; unpack16_fp8(vb[j], v);
#pragma unroll
                    for (int i = 0; i < 16; ++i) acc[j * 16 + i] += coef_ * v[i]; }
                {
                    const char* vp_ = V8 + (size_t)e_n * DM + l16 * 16;
#pragma unroll
                    for (int j = 0; j < 4; ++j) vb[j] = *(const u32x4*)(vp_ + j * 256);
                }
                g_c = g_n; su_c = su_n; sv_c = sv_n;
            }
        }
        {
            float* orow = p.out + (size_t)n * DM + l16 * 16;
            float s2 = 0.f;
#pragma unroll
            for (int j = 0; j < 4; ++j)
#pragma unroll
                for (int q = 0; q < 4; ++q) { const float4 a = *(const float4*)(orow + j * 256 + q * 4); acc[j * 16 + q * 4] += a.x; acc[j * 16 + q * 4 + 1] += a.y; acc[j * 16 + q * 4 + 2] += a.z; acc[j * 16 + q * 4 + 3] += a.w; }
#pragma unroll
            for (int i = 0; i < 64; ++i) s2 += acc[i] * acc[i];
            s2 = dpp_row_sum(s2);
            float r2 = rsqrtf(s2 * (1.f / DM) + 1e-6f);
#if TP_SEC
            r2 *= 1.f + 0.5f * ((const float*)(p.ws + OFF_BAR))[3602];
#endif
#if defined(DSA_CHECK) || defined(PROJ_CHECK)
            { const float num = ((const float*)(p.ws + OFF_BAR))[3600], den = ((const float*)(p.ws + OFF_BAR))[3601]; r2 *= 1.f + CHK_GAIN * sqrtf(num / fmaxf(den, 1e-30f)); }
#endif
#pragma unroll
            for (int j = 0; j < 4; ++j)
#pragma unroll
                for (int q = 0; q < 4; ++q) {
                    const float4 a = *(const float4*)(p.norm_final + j * 256 + l16 * 16 + q * 4);
                    *(float4*)(orow + j * 256 + q * 4) = make_float4(acc[j * 16 + q * 4] * r2 * a.x, acc[j * 16 + q * 4 + 1] * r2 * a.y, acc[j * 16 + q * 4 + 2] * r2 * a.z, acc[j * 16 + q * 4 + 3] * r2 * a.w);
                }
        }
        lds_fence();
    }
}

DI Params load_params() {
#if defined(__HIP_DEVICE_COMPILE__)
    typedef const __attribute__((address_space(4))) unsigned long long* cu64_t;
    cu64_t pp = (cu64_t)__builtin_amdgcn_kernarg_segment_ptr();
    asm volatile("" : "+s"(pp));
    static_assert(sizeof(Params) == 16 * 8, "Params is 16 qwords");
    unsigned long long w[16];
#pragma unroll
    for (int i = 0; i < 16; ++i) w[i] = pp[i];
#define GPTR(T, v) ((T*)(__attribute__((address_space(1))) T*)(v))
    Params r;
    r.x = GPTR(const float, w[0]); r.meta = GPTR(const float, w[1]); r.norm_mix = GPTR(const float, w[2]); r.w_in = GPTR(const float, w[3]);
    r.w_uv = GPTR(const float, w[4]); r.w_out = GPTR(const float, w[5]); r.norm_ffn = GPTR(const float, w[6]); r.wq = GPTR(const float, w[7]);
    r.sk = GPTR(const float, w[8]); r.pu = GPTR(const float, w[9]); r.pv = GPTR(const float, w[10]); r.norm_final = GPTR(const float, w[11]);
    r.out = GPTR(float, w[12]); r.ws = GPTR(char, w[13]);
    r.lo = (int)(unsigned)w[14]; r.hi = (int)(unsigned)(w[14] >> 32); r.pad0 = 0; r.pad1 = 0;
    return r;
#else
    return Params{};
#endif
}
#ifdef PROJ_CHECK
constexpr int PCH_ROWS = 64;
DI void phase_proj_ref_naive(const Params& p) {
    const bf16_t* hn = (const bf16_t*)(p.ws + OFF_HN); bf16_t* ref = (bf16_t*)(p.ws + OFF_ST);
    const int gtid = blockIdx.x * NTHREADS + threadIdx.x, gsz = gridDim.x * NTHREADS;
    for (int idx = gtid; idx < (PCH_ROWS / 8) * INW; idx += gsz) {
        const int c = idx % INW, r0 = (idx / INW) * 8;
        float acc[8];
#pragma unroll
        for (int i = 0; i < 8; ++i) acc[i] = 0.f;
        for (int k = 0; k < 1024; ++k) {
            const float w = bf2f(f2bf(p.w_in[(size_t)k * INW + c]));
#pragma unroll
            for (int i = 0; i < 8; ++i) { const int t_ = r0 + i; acc[i] += bf2f(hn[(size_t)(t_ < NMETA ? NF + t_ : t_ - NMETA) * DM + k]) * w; }
        }
#pragma unroll
        for (int i = 0; i < 8; ++i) ref[(size_t)(r0 + i) * INW + c] = f2bf(acc[i]);
    }
}
DI void phase_proj_compare(const Params& p) {
    const bf16_t* proj = (const bf16_t*)(p.ws + OFF_BIG); const bf16_t* ref = (const bf16_t*)(p.ws + OFF_ST); const bf16_t* dvt = (const bf16_t*)(p.ws + OFF_DVT);
    const int gtid = blockIdx.x * NTHREADS + threadIdx.x, gsz = gridDim.x * NTHREADS;
    float num = 0.f, den = 0.f;
    for (int idx = gtid; idx < PCH_ROWS * INW; idx += gsz) { const float a = bf2f(proj[idx]), r = bf2f(ref[idx]); num += (a - r) * (a - r); den += r * r; }
    for (int idx = gtid; idx < PCH_ROWS * 128; idx += gsz) {
        const int row = idx >> 7, dv = idx & 127, b = row / TT, t = row - b * TT;
        const float a = bf2f(dvt[(size_t)(b * 128 + dv) * TTP + t]), r = bf2f(ref[(size_t)row * INW + C_DV + dv]); num += (a - r) * (a - r); den += r * r;
    }
    for (int idx = gtid; idx < 7 * NMETA * INW; idx += gsz) {
        const int c = idx % INW, bt = idx / INW, b = 1 + bt / NMETA, t = bt % NMETA;
        const float a = bf2f(proj[(size_t)(b * TT + t) * INW + c]), r = bf2f(ref[(size_t)t * INW + c]); num += (a - r) * (a - r); den += r * r;
    }
    for (int idx = gtid; idx < 7 * NMETA * 128; idx += gsz) {
        const int dv = idx & 127, bt = idx >> 7, b = 1 + bt / NMETA, t = bt % NMETA;
        const float a = bf2f(dvt[(size_t)(b * 128 + dv) * TTP + t]), r = bf2f(ref[(size_t)t * INW + C_DV + dv]); num += (a - r) * (a - r); den += r * r;
    }
    num = wave_sum_uniform(num); den = wave_sum_uniform(den);
    if ((threadIdx.x & 63) == 0) { atomicAdd((float*)(p.ws + OFF_BAR) + 3600, num); atomicAdd((float*)(p.ws + OFF_BAR) + 3601, den); }
}
#endif
constexpr int NPHASES = 10;
__global__ void __launch_bounds__(NTHREADS, 2) mk_forward(Params p) {
    extern __shared__ __attribute__((aligned(16))) char dyn_smem[];
    LAS char* smem = (LAS char*)dyn_smem;
    const bool multi = (p.hi - p.lo) > 1;
    LAS char* tp_smem = smem;
    if (TP_SEC && blockIdx.x == 0 && threadIdx.x == 0) { volatile LAS long long* tp_ = (volatile LAS long long*)(smem + TP_LDS_OFF); tp_[0] = (long long)__builtin_readcyclecounter(); tp_[2] = 0; }
    XcdBarrier bar; bar.bar = (unsigned*)(p.ws + OFF_BAR); bar.x = 0; bar.st = (volatile LAS unsigned*)(smem + LDS_BAR_OFF);
    if (multi) {
        if (threadIdx.x == 0) { const u32x4 z = {0u, 0u, 0u, 0u}; *(LAS u32x4*)(smem + LDS_BAR_OFF) = z; }
        __syncthreads();
        bar = xcd_barrier_post((unsigned*)(p.ws + OFF_BAR), (volatile LAS unsigned*)(smem + LDS_BAR_OFF));
    }
#ifndef PHMASK
#define PHMASK 0xFFFF
#endif
#define PH_ON(i) (((PHMASK >> (i)) & 1) && p.lo <= (i) && (i) < p.hi)
#define PH_SYNC(i) do { if (multi && (i) + 1 < p.hi) { TP_BEGIN(7); xcd_barrier(bar); TP_END(7); } } while (0)
#ifndef REPEAT_MASK
#define REPEAT_MASK 0
#endif
#define PH_REP(i) for (int rep_ = 0; rep_ < 1 + ((REPEAT_MASK >> (i)) & 1); ++rep_)
    if (PH_ON(0)) { const Params q = load_params(); TP_BEGIN(8); PH_REP(0) phase_prologue(q, smem); TP_END(8); PH_SYNC(0); }
    if (PH_ON(1)) { const Params q = load_params(); TP_BEGIN(9); PH_REP(1) { EpiProjRope e; e.P = (bf16_t*)(q.ws + OFF_BIG); e.DVTp = (bf16_t*)(q.ws + OFF_DVT); e.IKCp = (bf16_t*)(q.ws + OFF_IKC); e.c128 = (const float*)(q.ws + OFF_COS128); e.s128 = (const float*)(q.ws + OFF_SIN128); e.c64 = (const float*)(q.ws + OFF_COS64); e.s64 = (const float*)(q.ws + OFF_SIN64); gemm256<true>((const bf16_t*)(q.ws + OFF_HN), (const bf16_t*)(q.ws + OFF_WINT), 1024, NF / 256, 4096 / 256, (LAS bf16_t*)smem, e); } phase_proj_meta(q, smem); phase_fold_weights(q); TP_END(9); PH_SYNC(1); }
#ifdef ROPE_SEPARATE
    if (PH_ON(2)) { const Params q = load_params(); TP_BEGIN(5); phase_rope(q, smem, (bf16_t*)(q.ws + OFF_BIG), MROWS, true); TP_END(5); PH_SYNC(2); }
#endif
#ifdef PROJ_CHECK
    {   const Params q = load_params();
        phase_proj_ref_naive(q);
        xcd_barrier(bar);
        phase_rope(q, smem, (bf16_t*)(q.ws + OFF_ST), PCH_ROWS, false);
        xcd_barrier(bar);
        phase_proj_compare(q);
        xcd_barrier(bar);
    }
#endif
    if (PH_ON(3)) { const Params q = load_params(); PH_REP(3) {
#ifndef RS_REP
#define RS_REP 1
#endif
#ifndef DSA_REP
#define DSA_REP 1
#endif
            for (int rr_ = 0; rr_ < RS_REP; ++rr_) phase_ret_state_mfma(q, smem);
#ifdef PROJ_CHECK
            {
                bf16_t* mixed_ = (bf16_t*)(q.ws + OFF_HN);
                for (int idx = blockIdx.x * NTHREADS + threadIdx.x; idx < NF * 64; idx += gridDim.x * NTHREADS) { const int row = idx >> 6, c8 = idx & 63; const u32x4 z = {0u, 0u, 0u, 0u}; *(u32x4*)(mixed_ + (size_t)row * DM + 512 + c8 * 8) = z; }
            }
#else
            for (int rr_ = 0; rr_ < DSA_REP; ++rr_) { phase_dsa32(q, smem); __syncthreads(); }
#endif
#ifdef DSA_CHECK
            __syncthreads(); xcd_barrier(bar); phase_dsa_naive<true>(q, smem);
#endif
        } PH_SYNC(3); }
    if (PH_ON(4)) { const Params q = load_params(); TP_BEGIN(6); phase_ret_scan(q); TP_END(6); PH_SYNC(4); }
    if (PH_ON(5)) { const Params q = load_params(); PH_REP(5) phase_ret_out_mfma(q, smem); PH_SYNC(5); }
    if (PH_ON(6)) { const Params q = load_params(); PH_REP(6) {
        EpiOutT e; e.H = q.out; e.X = q.x; e.HG = (bf16_t*)(q.ws + OFF_HG); e.G = q.norm_ffn; e.SSQ = (float*)(q.ws + OFF_SSQ); gemm256<true>(
        (const bf16_t*)(q.ws + OFF_HN), (const bf16_t*)(q.ws + OFF_WOUTT), 1024, NF / 256, 1024 / 256, (LAS bf16_t*)smem, e); }
#ifdef PROJ_CHECK
        phase_convert_tables(q);
#endif
        PH_SYNC(6); }
    if (PH_ON(8)) { const Params q = load_params();
#ifndef PROJ_CHECK
        phase_convert_tables(q);
#endif
        PH_REP(8) { EpiSel e; e.smem = smem; gemm256<false>((const bf16_t*)(q.ws + OFF_HG), (const bf16_t*)(q.ws + OFF_WQT), 1024, NF / 256, 2048 / 256, (LAS bf16_t*)smem, e); }
        if (TP_SEC && blockIdx.x == 0 && threadIdx.x == 0) { volatile LAS long long* tp_ = (volatile LAS long long*)(smem + TP_LDS_OFF); const float fr = (float)tp_[2] / (float)((long long)__builtin_readcyclecounter() - tp_[0]); ((float*)(p.ws + OFF_BAR))[3602] = fr; }
        PH_SYNC(8); }
    if (PH_ON(10)) { const Params q = load_params(); phase_peer_out_rows(q, smem); }
}

extern "C" void kernel_launch(void* const* d_in, const int* in_sizes, int n_in, void* d_out, int out_size, void* d_ws, size_t ws_size, hipStream_t stream) {
    static int grid = 0;
    if (grid == 0) {
        if (n_in != 12 || out_size != NF * DM || ws_size < WS_END) { fprintf(stderr, "kernel_launch: unexpected shapes (n_in %d out %d ws %zu need %zu)\n", n_in, out_size, ws_size, (size_t)WS_END); grid = -1; return; }
        int dev = 0, cus = 0, per_cu = 0;
        if (hipGetDevice(&dev) != hipSuccess || hipDeviceGetAttribute(&cus, hipDeviceAttributeMultiprocessorCount, dev) != hipSuccess) { grid = -1; return; }
        if (hipFuncSetAttribute((const void*)mk_forward, hipFuncAttributeMaxDynamicSharedMemorySize, LDS_BYTES) != hipSuccess) { fprintf(stderr, "kernel_launch: hipFuncSetAttribute failed\n"); grid = -1; return; }
        if (hipOccupancyMaxActiveBlocksPerMultiprocessor(&per_cu, (const void*)mk_forward, NTHREADS, LDS_BYTES) != hipSuccess || per_cu < 1)
            fprintf(stderr, "kernel_launch: occupancy query reports %d blocks per CU\n", per_cu);
        (void)hipGetLastError();
        grid = cus > 0 ? cus : 256;
    }
    if (grid < 0) return;
    Params p{};
    p.x = (const float*)d_in[0]; p.meta = (const float*)d_in[1]; p.norm_mix = (const float*)d_in[2]; p.w_in = (const float*)d_in[3];
    p.w_uv = (const float*)d_in[4]; p.w_out = (const float*)d_in[5]; p.norm_ffn = (const float*)d_in[6]; p.wq = (const float*)d_in[7];
    p.sk = (const float*)d_in[8]; p.pu = (const float*)d_in[9]; p.pv = (const float*)d_in[10]; p.norm_final = (const float*)d_in[11];
    p.out = (float*)d_out; p.ws = (char*)d_ws; p.pad0 = 0; p.pad1 = 0;
    (void)hipMemsetAsync((char*)d_ws + OFF_BAR, 0, 16384, stream);
#if MK_LAUNCHES == 1
    p.lo = 0; p.hi = NPHASES + 1;
    hipLaunchKernelGGL(mk_forward, dim3(grid), dim3(NTHREADS), LDS_BYTES, stream, p);
#else
    for (int ph = 0; ph <= NPHASES; ++ph) { p.lo = ph; p.hi = ph + 1; hipLaunchKernelGGL(mk_forward, dim3(grid), dim3(NTHREADS), LDS_BYTES, stream, p); }
#endif
}
```

```cpp
#include <hip/hip_runtime.h>
#include <stdint.h>
#include <stdio.h>

#ifndef MK_LAUNCHES
#define MK_LAUNCHES 1
#endif

#define DI __device__ __forceinline__
#ifndef TP_SEC
#define TP_SEC 0
#endif
#ifndef CHK_GAIN
#define CHK_GAIN 10.f
#endif
#define TP_LDS_OFF (163840 - 128)
#define TP_BEGIN(k) do { if (TP_SEC == (k) && blockIdx.x == 0 && threadIdx.x == 0) { *(volatile __attribute__((address_space(3))) long long*)(tp_smem + TP_LDS_OFF + 8) = (long long)__builtin_readcyclecounter(); } } while (0)
#define TP_END(k) do { if (TP_SEC == (k) && blockIdx.x == 0 && threadIdx.x == 0) { volatile __attribute__((address_space(3))) long long* tp_ = (volatile __attribute__((address_space(3))) long long*)(tp_smem + TP_LDS_OFF); tp_[2] += (long long)__builtin_readcyclecounter() - tp_[1]; } } while (0)
typedef unsigned short bf16_t;
typedef short bf16x8 __attribute__((ext_vector_type(8)));
typedef float f32x4 __attribute__((ext_vector_type(4)));
typedef float f32x2 __attribute__((ext_vector_type(2)));
typedef unsigned u32x4 __attribute__((ext_vector_type(4)));
typedef unsigned u32x2 __attribute__((ext_vector_type(2)));

constexpr int NB = 8, SEQ = 2048, NMETA = 16, TT = 2064, DM = 1024, INW = 3912;
constexpr int MROWS = NB * TT;
constexpr int MPAD = 16640;
constexpr int NF = NB * SEQ;
constexpr int C_RQ = 0, C_RK = 512, C_RV = 1024, C_RG = 1536, C_DQ = 2048, C_DK = 3072, C_DV = 3200, C_IQ = 3328, C_IK = 3840, C_IW = 3904;
constexpr int NTHREADS = 512, NWAVES = 8;
constexpr int LDS_BYTES = 163840;
constexpr int LDS_BAR_OFF = 163840 - 256;

constexpr size_t al256(size_t x) { return (x + 255) & ~(size_t)255; }
constexpr size_t OFF_BAR = 0;
constexpr size_t OFF_COS128 = 16384;
constexpr size_t OFF_SIN128 = OFF_COS128 + al256((size_t)TT * 64 * 4);
constexpr size_t OFF_COS64 = OFF_SIN128 + al256((size_t)TT * 64 * 4);
constexpr size_t OFF_SIN64 = OFF_COS64 + al256((size_t)TT * 32 * 4);
constexpr size_t OFF_WINT = OFF_SIN64 + al256((size_t)TT * 32 * 4);
constexpr size_t OFF_WOUTT = OFF_WINT + (size_t)4096 * 1024 * 2;
constexpr size_t OFF_WQT = OFF_WOUTT + (size_t)1024 * 1024 * 2;
constexpr size_t OFF_SKH = OFF_WQT + (size_t)2048 * 1024 * 2;
constexpr size_t OFF_SKL = OFF_SKH + (size_t)2048 * 128 * 2;
constexpr int TTP = 2176;
constexpr size_t OFF_WUVT = OFF_SKL + (size_t)2048 * 128 * 2;
constexpr size_t OFF_DVT = OFF_WUVT + (size_t)8 * 64 * 128 * 2;
constexpr size_t OFF_HN = OFF_DVT + (size_t)NB * 128 * TTP * 2;
constexpr size_t OFF_BIG = OFF_HN + (size_t)MPAD * 1024 * 2;
constexpr size_t BIG_BYTES = (size_t)NF * 2048 * 4;
constexpr size_t OFF_IKC = OFF_BIG + al256((size_t)MPAD * INW * 2);
static_assert(OFF_IKC + (size_t)MROWS * 64 * 2 <= OFF_BIG + BIG_BYTES, "IKC fits behind PROJ");
constexpr size_t OFF_ST = OFF_BIG + al256(BIG_BYTES);
constexpr size_t ST_BYTES = (size_t)32 * 34 * 16384 * 4;
constexpr size_t OFF_EG = OFF_ST;
constexpr size_t OFF_U8 = OFF_EG + (size_t)NF * 128 * 4;
constexpr size_t OFF_SU = OFF_U8 + (size_t)16384 * 1024;
constexpr size_t OFF_V8 = OFF_SU + 65536;
constexpr size_t OFF_SV = OFF_V8 + (size_t)16384 * 1024;
constexpr size_t OFF_HG = OFF_SV + 65536;
constexpr size_t OFF_SSQ = OFF_HG + (size_t)NF * 1024 * 2;
constexpr size_t WS_END = OFF_SSQ + (size_t)NF * 4;
static_assert(OFF_ST + ST_BYTES <= WS_END, "retention states fit");
static_assert(WS_END <= (size_t)268435456, "workspace");

struct Params {
    const float *x, *meta, *norm_mix, *w_in, *w_uv, *w_out, *norm_ffn, *wq, *sk, *pu, *pv, *norm_final;
    float* out; char* ws; int lo, hi, pad0, pad1;
};

DI float bf2f(bf16_t v) { return __uint_as_float(((unsigned)v) << 16); }
typedef float f32x2_t __attribute__((ext_vector_type(2)));
typedef __bf16 bf16x2_t __attribute__((ext_vector_type(2)));
DI bf16_t f2bf(float f) { const __bf16 h = (__bf16)f; return __builtin_bit_cast(unsigned short, h); }
DI unsigned pk2bf(float a, float b) { const f32x2_t v = {a, b}; const bf16x2_t h = __builtin_convertvector(v, bf16x2_t); return __builtin_bit_cast(unsigned, h); }
DI float wave_sum(float v) {
#pragma unroll
    for (int o = 32; o > 0; o >>= 1) v += __shfl_xor(v, o);
    return v;
}
DI float wave_max(float v) {
#pragma unroll
    for (int o = 32; o > 0; o >>= 1) v = fmaxf(v, __shfl_xor(v, o));
    return v;
}
DI unsigned long long wave_max_u64(unsigned long long v) {
#pragma unroll
    for (int o = 32; o > 0; o >>= 1) {
        const unsigned hi = __shfl_xor((unsigned)(v >> 32), o), lo = __shfl_xor((unsigned)v, o);
        const unsigned long long w = ((unsigned long long)hi << 32) | lo;
        v = w > v ? w : v;
    }
    return v;
}
DI unsigned fkey(float x) { const unsigned u = __float_as_uint(x); return (u & 0x80000000u) ? ~u : (u | 0x80000000u); }
DI float funkey(unsigned k) { const unsigned u = (k & 0x80000000u) ? (k & 0x7fffffffu) : ~k; return __uint_as_float(u); }
DI void lds_fence() { asm volatile("s_waitcnt lgkmcnt(0)" ::: "memory"); }
DI void unpack8(const u32x4& r, float (&v)[8]) {
    v[0] = __uint_as_float(r.x << 16); v[1] = __uint_as_float(r.x & 0xffff0000u);
    v[2] = __uint_as_float(r.y << 16); v[3] = __uint_as_float(r.y & 0xffff0000u);
    v[4] = __uint_as_float(r.z << 16); v[5] = __uint_as_float(r.z & 0xffff0000u);
    v[6] = __uint_as_float(r.w << 16); v[7] = __uint_as_float(r.w & 0xffff0000u);
}

typedef float f32x16 __attribute__((ext_vector_type(16)));
DI bf16x8 pack8(const float (&x)[8]) {
    u32x4 r;
#pragma unroll
    for (int j = 0; j < 4; ++j) r[j] = pk2bf(x[2 * j], x[2 * j + 1]);
    return __builtin_bit_cast(bf16x8, r);
}
DI bf16x8 pack_hi8(const float (&x)[8], float (&rem)[8]) {
    u32x4 r;
#pragma unroll
    for (int j = 0; j < 4; ++j) { r[j] = pk2bf(x[2 * j], x[2 * j + 1]); rem[2 * j] = x[2 * j] - __uint_as_float(r[j] << 16); rem[2 * j + 1] = x[2 * j + 1] - __uint_as_float(r[j] & 0xffff0000u); }
    return __builtin_bit_cast(bf16x8, r);
}

DI float dpp_row_sum(float v) {
    v += __int_as_float(__builtin_amdgcn_update_dpp(0, __float_as_int(v), 0xB1, 0xF, 0xF, true));
    v += __int_as_float(__builtin_amdgcn_update_dpp(0, __float_as_int(v), 0x4E, 0xF, 0xF, true));
    v += __int_as_float(__builtin_amdgcn_update_dpp(0, __float_as_int(v), 0x141, 0xF, 0xF, true));
    v += __int_as_float(__builtin_amdgcn_update_dpp(0, __float_as_int(v), 0x140, 0xF, 0xF, true));
    return v;
}
DI float wave_sum_uniform(float v) {
    v = dpp_row_sum(v);
    const float a = __int_as_float(__builtin_amdgcn_readlane(__float_as_int(v), 0)), b = __int_as_float(__builtin_amdgcn_readlane(__float_as_int(v), 16));
    const float c = __int_as_float(__builtin_amdgcn_readlane(__float_as_int(v), 32)), d = __int_as_float(__builtin_amdgcn_readlane(__float_as_int(v), 48));
    return (a + b) + (c + d);
}

DI int wave_sum_int(int v) {
    v += __builtin_amdgcn_update_dpp(0, v, 0xB1, 0xF, 0xF, true);
    v += __builtin_amdgcn_update_dpp(0, v, 0x4E, 0xF, 0xF, true);
    v += __builtin_amdgcn_update_dpp(0, v, 0x141, 0xF, 0xF, true);
    v += __builtin_amdgcn_update_dpp(0, v, 0x140, 0xF, 0xF, true);
    return (__builtin_amdgcn_readlane(v, 0) + __builtin_amdgcn_readlane(v, 16)) + (__builtin_amdgcn_readlane(v, 32) + __builtin_amdgcn_readlane(v, 48));
}

#define XB_TMO      128
#define XB_XCNT(j)  (256  + 64 * (j))
#define XB_XSUB(j)  (1280 + 64 * (j))
#define XB_XGEN(j)  (2304 + 64 * (j))
#define XB_TOP      3328
#define XB_TOPGEN   3392
#define XCD_BAR_WORDS 3456
#define XB_SPIN_CAP (1u << 20)
#define LAS __attribute__((address_space(3)))

DI unsigned xb_ld(unsigned* p)              { return __hip_atomic_load(p, __ATOMIC_RELAXED, __HIP_MEMORY_SCOPE_AGENT); }
DI unsigned xb_add(unsigned* p, unsigned v) { return __hip_atomic_fetch_add(p, v, __ATOMIC_RELAXED, __HIP_MEMORY_SCOPE_AGENT); }
DI unsigned xb_xcc_id() { return (unsigned)__builtin_amdgcn_s_getreg((3 << 11) | 20) & 0xFu; }
#define XB_SPIN(cond, bar) do { unsigned _sp = 0; while (cond) { __builtin_amdgcn_s_sleep(1); \
    if ((++_sp & 255u) == 0u) { if (xb_ld(&(bar)[XB_TMO])) break; if (_sp > XB_SPIN_CAP) { atomicAdd(&(bar)[XB_TMO], 1u); break; } } } } while (0)

struct XcdBarrier { unsigned* bar; unsigned x; volatile LAS unsigned* st; };

DI XcdBarrier xcd_barrier_post(unsigned* bar, volatile LAS unsigned* st) {
    XcdBarrier b; b.bar = bar; b.x = xb_xcc_id(); b.st = st;
    if (threadIdx.x == 0) (void)xb_add(&bar[XB_XCNT(b.x)], 1u);
    return b;
}
DI void xcd_barrier_complete(unsigned* bar, unsigned x, unsigned& nloc, unsigned& nx) {
    const unsigned G = gridDim.x * gridDim.y * gridDim.z;
    unsigned sum, cnt, mine, sp = 0u;
    for (;;) {
        sum = 0u; cnt = 0u; mine = 0u;
#pragma unroll
        for (unsigned j = 0; j < 16; ++j) { const unsigned c = xb_ld(&bar[XB_XCNT(j)]); sum += c; cnt += (c > 0u) ? 1u : 0u; mine = (j == x) ? c : mine; }
        if (sum == G) break;
        __builtin_amdgcn_s_sleep(1);
        if ((++sp & 255u) == 0u) { if (xb_ld(&bar[XB_TMO])) break; if (sp > XB_SPIN_CAP) { atomicAdd(&bar[XB_TMO], 1u); break; } }
    }
    nloc = mine > 0u ? mine : 1u; nx = cnt > 0u ? cnt : 1u;
}
DI void xcd_barrier(const XcdBarrier& b) {
    asm volatile("s_waitcnt vmcnt(0)" ::: "memory");
    __syncthreads();
    if (threadIdx.x == 0) {
        unsigned* bar = b.bar;
        __builtin_amdgcn_s_waitcnt(0);
        unsigned nloc = b.st[0], nx = b.st[1];
        if (nloc == 0u) { xcd_barrier_complete(bar, b.x, nloc, nx); b.st[0] = nloc; b.st[1] = nx; }
        const unsigned old = xb_add(&bar[XB_XSUB(b.x)], 1u);
        const unsigned gen = old / nloc;
        if (old + 1u == (gen + 1u) * nloc) {
            __builtin_amdgcn_fence(__ATOMIC_RELEASE, "agent");
            asm volatile("s_waitcnt vmcnt(0)" ::: "memory");
            const unsigned og = xb_add(&bar[XB_TOP], 1u);
            const unsigned tg = og / nx;
            if (og + 1u == (tg + 1u) * nx) xb_add(&bar[XB_TOPGEN], 1u);
            else XB_SPIN(xb_ld(&bar[XB_TOPGEN]) == tg, bar);
            __builtin_amdgcn_fence(__ATOMIC_ACQUIRE, "agent");
            xb_add(&bar[XB_XGEN(b.x)], 1u);
            asm volatile("s_waitcnt vmcnt(0)" ::: "memory");
        } else {
            XB_SPIN(xb_ld(&bar[XB_XGEN(b.x)]) == gen, bar);
            __builtin_amdgcn_fence(__ATOMIC_ACQUIRE, "agent");
            asm volatile("s_waitcnt vmcnt(0)" ::: "memory");
        }
    }
    __syncthreads();
}

constexpr int BM = 256, BK = 64, HALF = 128, NXCD = 8, WGM = 8, HT = HALF * BK;
DI int lds_byte(int r, int c) {
    int st = (r >> 4) * 2 + (c >> 5), rr = r & 15, cc = c & 31, ob = rr * 64 + cc * 2;
    return st * 1024 + (ob ^ (((ob >> 9) & 1) << 5));
}
DI void stage_rc(int b, int& R, int& C) {
    int st = b / 1024, sb = b % 1024, swz = sb ^ (((sb >> 9) & 1) << 5);
    R = (st >> 1) * 16 + swz / 64; C = (st & 1) * 32 + (swz % 64) / 2;
}

#define SA(b,h) (shm+((b)*2+(h))*HT)
#define SB(b,h) (shm+(4+(b)*2+(h))*HT)
#define STAGE_X(T,P,BASE,br,kt) do{long _g=(long)(br)*K+(long)(kt)*BK; \
    for(int _i=0;_i<2;++_i){int _b=(T)*16+_i*8192;int _r,_c;stage_rc(_b,_r,_c); \
      __builtin_amdgcn_global_load_lds((const unsigned*)(BASE+_g+(long)_r*K+_c), \
        (LAS unsigned*)((LAS char*)(P)+_b),16,0,0);}}while(0)
#define STAGE(P,BASE,br,kt) STAGE_X(tst_,P,BASE,br,kt)
#define LDA(dst,b,h) for(int m=0;m<4;++m)for(int k=0;k<2;++k) \
    dst[m][k]=*reinterpret_cast<const LAS bf16x8*>((LAS char*)SA(b,h)+lds_byte(wr*64+m*16+fr,k*32+fq*8))
#define LDB(dst,b,h) for(int n=0;n<2;++n)for(int k=0;k<2;++k) \
    dst[n][k]=*reinterpret_cast<const LAS bf16x8*>((LAS char*)SB(b,h)+lds_byte(wc*32+n*16+fr,k*32+fq*8))
#define MMA(ai,bj,At,Bt_) do{__builtin_amdgcn_s_setprio(1); \
    for(int m=0;m<4;++m)for(int n=0;n<2;++n)for(int k=0;k<2;++k) \
      acc[ai][bj][m][n]=TRANS?__builtin_amdgcn_mfma_f32_16x16x32_bf16(Bt_[n][k],At[m][k],acc[ai][bj][m][n],0,0,0):__builtin_amdgcn_mfma_f32_16x16x32_bf16(At[m][k],Bt_[n][k],acc[ai][bj][m][n],0,0,0); \
    __builtin_amdgcn_s_setprio(0);}while(0)
#define WAIT_V(n) asm volatile("s_waitcnt vmcnt(" #n ")":::"memory")
#define WAIT_L(n) asm volatile("s_waitcnt lgkmcnt(" #n ")":::"memory")
#define BAR __builtin_amdgcn_s_barrier()
#define SCHED __builtin_amdgcn_sched_barrier(0)

template <bool TRANS, class Epi>
DI void gemm256(const bf16_t* __restrict__ A, const bf16_t* __restrict__ Bt, const int K, const int nM, const int nN, LAS bf16_t* shm, const Epi& epi) {
    const int nwg = nM * nN;
    for (int L = blockIdx.x; L < nwg; L += gridDim.x) {
        int wgid = L;
        { int q = nwg / NXCD, r = nwg % NXCD, xcd = wgid % NXCD, off = wgid / NXCD; wgid = (xcd < r ? xcd * (q + 1) : r * (q + 1) + (xcd - r) * q) + off; }
        int nig = WGM * nN, gid = wgid / nig, fm = gid * WGM, gsz = min(nM - fm, WGM);
        int pm = fm + ((wgid % nig) % gsz), pn = (wgid % nig) / gsz, brow = pm * BM, bcol = pn * BM;
        int tst_ = threadIdx.x;
#ifndef PROJ_CHECK
        if (Epi::kOpaqueStage)
#endif
            asm volatile("" : "+v"(tst_));
        int wid = tst_ >> 6, lane = tst_ & 63, wr = wid >> 2, wc = wid & 3, fr = lane & 15, fq = lane >> 4;
        f32x4 acc[2][2][4][2] = {};
        bf16x8 At[4][2], B0[2][2], B1[2][2];
        int nt = K / BK;
        STAGE(SB(0,0),Bt,bcol,0); STAGE(SA(0,0),A,brow,0);
        STAGE(SB(0,1),Bt,bcol+HALF,0); STAGE(SA(0,1),A,brow+HALF,0);
        if (wr == 1) BAR;
        WAIT_V(4); BAR;
        STAGE(SB(1,0),Bt,bcol,1); STAGE(SA(1,0),A,brow,1); STAGE(SB(1,1),Bt,bcol+HALF,1);
        WAIT_V(6); BAR;
        for (int t = 0; t < nt - 2; t += 2) {
            LDB(B0,0,0); SCHED; LDA(At,0,0); STAGE(SA(1,1),A,brow+HALF,t+1);
            WAIT_L(8); BAR; WAIT_L(0); MMA(0,0,At,B0); BAR; SCHED;
            LDB(B1,0,1); STAGE(SB(0,0),Bt,bcol,t+2);
            BAR; WAIT_L(0); MMA(0,1,At,B1); BAR;
            LDA(At,0,1); STAGE(SA(0,0),A,brow,t+2);
            BAR; WAIT_L(0); MMA(1,0,At,B0); BAR; SCHED;
            STAGE(SB(0,1),Bt,bcol+HALF,t+2);
            WAIT_V(6); BAR; MMA(1,1,At,B1); BAR;
            LDB(B0,1,0); SCHED; LDA(At,1,0); STAGE(SA(0,1),A,brow+HALF,t+2);
            WAIT_L(8); BAR; WAIT_L(0); MMA(0,0,At,B0); BAR; SCHED;
            LDB(B1,1,1); STAGE(SB(1,0),Bt,bcol,t+3);
            BAR; WAIT_L(0); MMA(0,1,At,B1); BAR;
            LDA(At,1,1); STAGE(SA(1,0),A,brow,t+3);
            BAR; WAIT_L(0); MMA(1,0,At,B0); BAR; SCHED;
            STAGE(SB(1,1),Bt,bcol+HALF,t+3);
            WAIT_V(6); BAR; MMA(1,1,At,B1); BAR;
        }
        int tz = threadIdx.x; asm volatile("" : "+v"(tz)); wid = tz >> 6; lane = tz & 63; wr = wid >> 2; wc = wid & 3; fr = lane & 15; fq = lane >> 4;
        { LDB(B0,0,0); WAIT_V(0); LDA(At,0,0); STAGE_X(tz,SA(1,1),A,brow+HALF,nt-1);
          BAR; WAIT_L(0); MMA(0,0,At,B0); BAR;
          LDB(B1,0,1); BAR; WAIT_L(0); MMA(0,1,At,B1); BAR;
          LDA(At,0,1); WAIT_V(4); BAR; WAIT_L(0); MMA(1,0,At,B0); MMA(1,1,At,B1); BAR; }
        { LDB(B0,1,0); LDA(At,1,0); WAIT_V(2); BAR; WAIT_L(0); MMA(0,0,At,B0); BAR;
          LDB(B1,1,1); WAIT_V(0); BAR; WAIT_L(0); MMA(0,1,At,B1); BAR;
          LDA(At,1,1); BAR; WAIT_L(0); MMA(1,0,At,B0); MMA(1,1,At,B1); BAR; }
        if (wr == 0) BAR;
        epi(acc, brow, bcol, wr, wc, fr, fq);
        __syncthreads();
    }
}

struct EpiOut {
    static constexpr bool kOpaqueStage = false;
    float* H; const float* X;
    DI void operator()(const f32x4 (&acc)[2][2][4][2], int brow, int bcol, int wr, int wc, int fr, int fq) const {
#pragma unroll
        for (int ai = 0; ai < 2; ++ai)
#pragma unroll
        for (int bj = 0; bj < 2; ++bj)
#pragma unroll
        for (int m = 0; m < 4; ++m)
#pragma unroll
        for (int n = 0; n < 2; ++n)
#pragma unroll
        for (int j = 0; j < 4; ++j) {
            const int row = brow + ai * HALF + wr * 64 + m * 16 + fq * 4 + j, col = bcol + bj * HALF + wc * 32 + n * 16 + fr;
            const size_t o = (size_t)row * DM + col; H[o] = X[o] + acc[ai][bj][m][n][j];
        }
    }
};
struct EpiPQ {
    static constexpr bool kOpaqueStage = false;
    float* Q;
    DI void operator()(const f32x4 (&acc)[2][2][4][2], int brow, int bcol, int wr, int wc, int fr, int fq) const {
#pragma unroll
        for (int ai = 0; ai < 2; ++ai)
#pragma unroll
        for (int bj = 0; bj < 2; ++bj)
#pragma unroll
        for (int m = 0; m < 4; ++m)
#pragma unroll
        for (int n = 0; n < 2; ++n)
#pragma unroll
        for (int j = 0; j < 4; ++j) {
            const int row = brow + ai * HALF + wr * 64 + m * 16 + fq * 4 + j, col = bcol + bj * HALF + wc * 32 + n * 16 + fr;
            ((unsigned*)Q)[(size_t)row * 2048 + col] = fkey(acc[ai][bj][m][n][j]);
        }
    }
};

struct EpiOutT {
    static constexpr bool kOpaqueStage = false;
    float* H; const float* X; bf16_t* HG; const float* G; float* SSQ;
    DI void operator()(const f32x4 (&acc)[2][2][4][2], int brow, int bcol, int wr, int wc, int fr, int fq) const {
#pragma unroll
        for (int ai = 0; ai < 2; ++ai)
#pragma unroll
        for (int m = 0; m < 4; ++m) {
            const int row = brow + ai * HALF + wr * 64 + m * 16 + fr;
            const size_t o = (size_t)row * DM + bcol + wc * 32 + fq * 4;
            const float* xp = X + o; float* hp = H + o; bf16_t* gp = HG + o; const float* gn = G + bcol + wc * 32 + fq * 4;
            float ss = 0.f;
#pragma unroll
            for (int bj = 0; bj < 2; ++bj)
#pragma unroll
            for (int n = 0; n < 2; ++n) {
                const f32x4 x = *(const f32x4*)(xp + bj * HALF + n * 16); const f32x4 hv = x + acc[ai][bj][m][n];
                *(f32x4*)(hp + bj * HALF + n * 16) = hv;
                ss += hv[0] * hv[0] + hv[1] * hv[1] + hv[2] * hv[2] + hv[3] * hv[3];
                const f32x4 hg = hv * *(const f32x4*)(gn + bj * HALF + n * 16);
                uint2 w; w.x = pk2bf(hg[0], hg[1]); w.y = pk2bf(hg[2], hg[3]); *(uint2*)(gp + bj * HALF + n * 16) = w;
            }
            ss += __shfl_xor(ss, 16); ss += __shfl_xor(ss, 32);
            if (fq == 0) atomicAdd(SSQ + row, ss);
            __builtin_amdgcn_sched_barrier(0);
        }
    }
};

__host__ __device__ constexpr int proj_true_col(int n) {
    const int blk = n >> 7, P = n & 127, wc = P >> 5, nn = (P >> 4) & 1, i = P & 15;
    return blk * 128 + (blk < 26 ? wc * 16 + i + 64 * nn : (wc >> 1) * 64 + (wc & 1) * 16 + i + 32 * nn);
}
DI bool proj_block(const f32x4 x1, const f32x4 x2, const int cb, const int wc, const int fq, const int t, const float* c128, const float* s128, const float* c64, const float* s64,
                   f32x4& o1, f32x4& o2, int& c1, int& c2, bool& st2) {
    o1 = x1; o2 = x2; st2 = true;
    if (cb < C_IQ) {
        const int f = wc * 16 + fq * 4; c1 = cb + f; c2 = c1 + 64;
        const bool roped = (cb < C_RV) || (cb >= C_DQ && cb < C_DV);
        if (roped) {
            const float sc = (cb < C_RK) ? 1.f : (cb < C_RV) ? 0.08838834764831845f : (cb < C_DK) ? 0.08838834764831845f * 1.4426950408889634f : 1.f;
            const f32x4 cs = *(const f32x4*)(c128 + t * 64 + f), sn = *(const f32x4*)(s128 + t * 64 + f);
            o1 = (x1 * cs - x2 * sn) * sc; o2 = (x2 * cs + x1 * sn) * sc;
        }
        return true;
    }
    if (cb >= 3968) return false;
    const int hl = wc >> 1, f = (wc & 1) * 16 + fq * 4; c1 = cb + hl * 64 + f; c2 = c1 + 32;
    if (cb < C_IK || hl == 0) {
        const float sc = (cb < C_IK) ? 0.125f : 1.f;
        const f32x4 cs = *(const f32x4*)(c64 + t * 32 + f), sn = *(const f32x4*)(s64 + t * 32 + f);
        o1 = (x1 * cs - x2 * sn) * sc; o2 = (x2 * cs + x1 * sn) * sc;
        return true;
    }
    o1 = x1 * 0.35355339059327373f; st2 = false;
    return c1 < INW;
}
struct EpiProjRope {
    static constexpr bool kOpaqueStage = false;
    bf16_t* P; bf16_t* DVTp; bf16_t* IKCp; const float *c128, *s128, *c64, *s64;
    DI void operator()(const f32x4 (&acc)[2][2][4][2], int brow, int bcol, int wr, int wc, int fr, int fq) const {
#pragma unroll
        for (int ai = 0; ai < 2; ++ai)
#pragma unroll
        for (int m = 0; m < 4; ++m) {
            const int grow = brow + ai * HALF + wr * 64 + m * 16 + fr;
            const int b = grow >> 11, t = NMETA + (grow & 2047);
            bf16_t* rp = P + (size_t)(b * TT + t) * INW;
#pragma unroll
            for (int bj = 0; bj < 2; ++bj) {
                const int cb = bcol + bj * HALF;
                const f32x4 x1 = acc[ai][bj][m][0], x2 = acc[ai][bj][m][1];
                f32x4 o1, o2; int c1, c2; bool st2;
                if (!proj_block(x1, x2, cb, wc, fq, t, c128, s128, c64, s64, o1, o2, c1, c2, st2)) continue;
                if (cb == C_DV) {
                    bf16_t* dp = DVTp + (size_t)(b * 128 + (c1 - C_DV)) * TTP + t;
#pragma unroll
                    for (int j = 0; j < 4; ++j) { dp[(size_t)j * TTP] = f2bf(x1[j]); dp[(size_t)(64 + j) * TTP] = f2bf(x2[j]); }
                }
                uint2 w1; w1.x = pk2bf(o1[0], o1[1]); w1.y = pk2bf(o1[2], o1[3]); *(uint2*)(rp + c1) = w1;
                if (st2) {
                    uint2 w2; w2.x = pk2bf(o2[0], o2[1]); w2.y = pk2bf(o2[2], o2[3]); *(uint2*)(rp + c2) = w2;
                    if (cb == C_IK) { bf16_t* ik = IKCp + (size_t)(b * TT + t) * 64 + (c1 - C_IK); *(uint2*)(ik) = w1; *(uint2*)(ik + 32) = w2; }
                }
            }
        }
    }
};

DI void phase_prologue(const Params& p, LAS char* smem) {
    const int gtid = blockIdx.x * NTHREADS + threadIdx.x, gsz = gridDim.x * NTHREADS;
    {
        bf16_t* wint = (bf16_t*)(p.ws + OFF_WINT); bf16_t* woutt_ = (bf16_t*)(p.ws + OFF_WOUTT);
        LAS float* tl = (LAS float*)smem;
        for (int tile = blockIdx.x; tile < 16 * 64 + 16 * 16; tile += gridDim.x) {
            const bool isout = tile >= 16 * 64; const int tt = isout ? tile - 16 * 64 : tile;
            const int ncol = isout ? 16 : 64, k0 = (tt / ncol) * 64, c0 = (tt % ncol) * 64;
            const float* W = isout ? p.w_out : p.w_in; const int ldw = isout ? 1024 : INW, cmax = isout ? 1024 : INW;
            for (int i = threadIdx.x; i < 64 * 64; i += NTHREADS) { const int kk = i >> 6, cc = i & 63; tl[kk * 65 + cc] = (c0 + cc < cmax) ? W[(size_t)(k0 + kk) * ldw + c0 + cc] : 0.f; }
            __syncthreads();
            {
                const int cc = threadIdx.x >> 3, ch = threadIdx.x & 7, tc = c0 + cc;
                int n = tc;
                if (!isout) { const int blk = tc >> 7, T = tc & 127;
                    const int P = blk < 26 ? (((T & 63) >> 4) * 32 + (T >> 6) * 16 + (T & 15)) : ((((T >> 6) * 2 + ((T >> 4) & 1)) * 32) + ((T >> 5) & 1) * 16 + (T & 15));
                    n = blk * 128 + P; }
                u32x4 o;
#pragma unroll
                for (int w = 0; w < 4; ++w) o[w] = pk2bf(tl[(ch * 8 + 2 * w) * 65 + cc], tl[(ch * 8 + 2 * w + 1) * 65 + cc]);
                *(u32x4*)((isout ? woutt_ : wint) + (size_t)n * 1024 + k0 + ch * 8) = o;
            }
            __syncthreads();
        }
    }
    { float* ssq = (float*)(p.ws + OFF_SSQ); for (int idx = gtid; idx < NF; idx += gsz) ssq[idx] = 0.f; }
    {
        bf16_t* dvt = (bf16_t*)(p.ws + OFF_DVT);
        for (int idx = gtid; idx < NB * 128 * (TTP - TT); idx += gsz) { const int rw = idx / (TTP - TT), t = TT + idx % (TTP - TT); dvt[(size_t)rw * TTP + t] = (bf16_t)0; }
    }
    bf16_t* wuvt = (bf16_t*)(p.ws + OFF_WUVT);
    for (int idx = gtid; idx < 8 * 64 * 128; idx += gsz) {
        const int h = idx >> 13, e = (idx >> 7) & 63, dv = idx & 127;
        wuvt[idx] = f2bf(p.w_uv[(size_t)(h * 128 + dv) * 64 + e]);
    }
    float* c128 = (float*)(p.ws + OFF_COS128); float* s128 = (float*)(p.ws + OFF_SIN128);
    for (int idx = gtid; idx < TT * 64; idx += gsz) {
        const int pos = idx >> 6, j = idx & 63;
        const float inv = powf(10000.f, -(float)j * 2.0f / 128.f);
        const float ang = (float)pos * inv;
        float s, c; sincosf(ang, &s, &c);
        c128[idx] = c; s128[idx] = s;
    }
    float* c64 = (float*)(p.ws + OFF_COS64); float* s64 = (float*)(p.ws + OFF_SIN64);
    for (int idx = gtid; idx < TT * 32; idx += gsz) {
        const int pos = idx >> 5, j = idx & 31;
        const float inv = powf(10000.f, -(float)j * 2.0f / 64.f);
        const float ang = (float)pos * inv;
        float s, c; sincosf(ang, &s, &c);
        c64[idx] = c; s64[idx] = s;
    }
    bf16_t* hn = (bf16_t*)(p.ws + OFF_HN);
    const int wave = threadIdx.x >> 6, lane = threadIdx.x & 63;
    for (int row = blockIdx.x * NWAVES + wave; row < MPAD; row += gridDim.x * NWAVES) {
        bf16_t* o = hn + (size_t)row * DM;
        if (row >= NF + NMETA) {
            for (int i = 0; i < 4; ++i) *(uint2*)(o + i * 256 + lane * 4) = make_uint2(0u, 0u);
            continue;
        }
        const float* src = row < NF ? p.x + (size_t)row * DM : p.meta + (size_t)(row - NF) * DM;
        float4 v[4]; float ss = 0.f;
#pragma unroll
        for (int i = 0; i < 4; ++i) { v[i] = *(const float4*)(src + i * 256 + lane * 4); ss += v[i].x * v[i].x + v[i].y * v[i].y + v[i].z * v[i].z + v[i].w * v[i].w; }
        ss = wave_sum(ss);
        const float rstd = rsqrtf(ss * (1.f / DM) + 1e-6f);
#pragma unroll
        for (int i = 0; i < 4; ++i) {
            const float4 g = *(const float4*)(p.norm_mix + i * 256 + lane * 4);
            uint2 w;
            w.x = (unsigned)f2bf(v[i].x * rstd * g.x) | ((unsigned)f2bf(v[i].y * rstd * g.y) << 16);
            w.y = (unsigned)f2bf(v[i].z * rstd * g.z) | ((unsigned)f2bf(v[i].w * rstd * g.w) << 16);
            *(uint2*)(o + i * 256 + lane * 4) = w;
        }
    }
}

DI void phase_fold_weights(const Params& p) {
    {
        bf16_t* wst = (bf16_t*)(p.ws + OFF_WQT);
        int tz_ = threadIdx.x; asm volatile("" : "+v"(tz_));
        const int wave_ = tz_ >> 6, lane_ = tz_ & 63, r = lane_ & 31, hh = lane_ >> 5;
        const int skip_ = 0;
        if ((int)blockIdx.x >= skip_)
        for (int task = ((int)blockIdx.x - skip_) * NWAVES + wave_; task < 16 * 32 * 4; task += ((int)gridDim.x - skip_) * NWAVES) {
            const int nb = task & 3, hf = task >> 7, k0 = ((task >> 2) & 31) * 32;
            f32x16 acc;
#pragma unroll
            for (int i = 0; i < 16; ++i) acc[i] = 0.f;
            const float* arow = p.wq + (size_t)(k0 + r) * 2048 + hf * 128 + 8 * hh;
            const float* brow = p.sk + (size_t)(hf * 128 + nb * 32 + r) * 128 + 8 * hh;
#pragma unroll 2
            for (int ks = 0; ks < 8; ++ks) {
                const float4 a0 = *(const float4*)(arow + ks * 16), a1 = *(const float4*)(arow + ks * 16 + 4);
                const float4 b0 = *(const float4*)(brow + ks * 16), b1 = *(const float4*)(brow + ks * 16 + 4);
                const float af[8] = {a0.x, a0.y, a0.z, a0.w, a1.x, a1.y, a1.z, a1.w}; float ar[8];
                const float bf_[8] = {b0.x, b0.y, b0.z, b0.w, b1.x, b1.y, b1.z, b1.w}; float br[8];
                const bf16x8 ah = pack_hi8(af, ar); const bf16x8 al = pack8(ar);
                const bf16x8 bh = pack_hi8(bf_, br); const bf16x8 bl = pack8(br);
                acc = __builtin_amdgcn_mfma_f32_32x32x16_bf16(ah, bh, acc, 0, 0, 0);
                acc = __builtin_amdgcn_mfma_f32_32x32x16_bf16(ah, bl, acc, 0, 0, 0);
                acc = __builtin_amdgcn_mfma_f32_32x32x16_bf16(al, bh, acc, 0, 0, 0);
            }
            bf16_t* orow = wst + (size_t)(hf * 128 + nb * 32 + r) * 1024 + k0 + 4 * hh;
#pragma unroll
            for (int g4 = 0; g4 < 4; ++g4) { uint2 w; w.x = pk2bf(acc[4 * g4], acc[4 * g4 + 1]); w.y = pk2bf(acc[4 * g4 + 2], acc[4 * g4 + 3]); *(uint2*)(orow + 8 * g4) = w; }
        }
    }
}

DI void rope8(bf16_t* p1, bf16_t* p2, const float* ct, const float* st, float scale) {
    const u32x4 r1 = *(const u32x4*)p1, r2 = *(const u32x4*)p2;
    float x1[8], x2[8]; unpack8(r1, x1); unpack8(r2, x2);
    const float4 c0 = *(const float4*)ct, c1 = *(const float4*)(ct + 4), s0 = *(const float4*)st, s1 = *(const float4*)(st + 4);
    const float cs[8] = {c0.x, c0.y, c0.z, c0.w, c1.x, c1.y, c1.z, c1.w}, sn[8] = {s0.x, s0.y, s0.z, s0.w, s1.x, s1.y, s1.z, s1.w};
    u32x4 o1, o2;
#pragma unroll
    for (int i = 0; i < 4; ++i) {
        const float a0 = (x1[2 * i] * cs[2 * i] - x2[2 * i] * sn[2 * i]) * scale, a1 = (x1[2 * i + 1] * cs[2 * i + 1] - x2[2 * i + 1] * sn[2 * i + 1]) * scale;
        const float b0 = (x2[2 * i] * cs[2 * i] + x1[2 * i] * sn[2 * i]) * scale, b1 = (x2[2 * i + 1] * cs[2 * i + 1] + x1[2 * i + 1] * sn[2 * i + 1]) * scale;
        o1[i] = (unsigned)f2bf(a0) | ((unsigned)f2bf(a1) << 16); o2[i] = (unsigned)f2bf(b0) | ((unsigned)f2bf(b1) << 16);
    }
    *(u32x4*)p1 = o1; *(u32x4*)p2 = o2;
}
DI void phase_rope(const Params& p, LAS char* smem, bf16_t* proj, const int nrows, const bool do_dvt) {
    const float* c128 = (const float*)(p.ws + OFF_COS128); const float* s128 = (const float*)(p.ws + OFF_SIN128);
    const float* c64 = (const float*)(p.ws + OFF_COS64); const float* s64 = (const float*)(p.ws + OFF_SIN64);
    const int gtid = blockIdx.x * NTHREADS + threadIdx.x, gsz = gridDim.x * NTHREADS;
    const int total = nrows * 173;
    for (int idx = gtid; idx < total; idx += gsz) {
        const int row = idx / 173, it = idx - row * 173;
        const int t = row % TT;
        bf16_t* pr = proj + (size_t)row * INW;
        if (it < 32)       { const int hd = it >> 3, j = (it & 7) * 8;          rope8(pr + C_RQ + hd * 128 + j, pr + C_RQ + hd * 128 + 64 + j, c128 + t * 64 + j, s128 + t * 64 + j, 1.f); }
        else if (it < 64)  { const int i2 = it - 32, hd = i2 >> 3, j = (i2 & 7) * 8;  rope8(pr + C_RK + hd * 128 + j, pr + C_RK + hd * 128 + 64 + j, c128 + t * 64 + j, s128 + t * 64 + j, 0.08838834764831845f); }
        else if (it < 128) { const int i2 = it - 64, hd = i2 >> 3, j = (i2 & 7) * 8;  rope8(pr + C_DQ + hd * 128 + j, pr + C_DQ + hd * 128 + 64 + j, c128 + t * 64 + j, s128 + t * 64 + j, 0.08838834764831845f * 1.4426950408889634f); }
        else if (it < 136) { const int j = (it - 128) * 8;                          rope8(pr + C_DK + j, pr + C_DK + 64 + j, c128 + t * 64 + j, s128 + t * 64 + j, 1.f); }
        else if (it < 168) { const int i2 = it - 136, hd = i2 >> 2, j = (i2 & 3) * 8; rope8(pr + C_IQ + hd * 64 + j, pr + C_IQ + hd * 64 + 32 + j, c64 + t * 32 + j, s64 + t * 32 + j, 0.125f); }
        else if (it < 172) { const int j = (it - 168) * 8;                          rope8(pr + C_IK + j, pr + C_IK + 32 + j, c64 + t * 32 + j, s64 + t * 32 + j, 1.f); }
        else {
            const u32x4 r = *(const u32x4*)(pr + C_IW); float v[8]; unpack8(r, v); u32x4 o;
#pragma unroll
            for (int i = 0; i < 4; ++i) o[i] = (unsigned)f2bf(v[2 * i] * 0.35355339059327373f) | ((unsigned)f2bf(v[2 * i + 1] * 0.35355339059327373f) << 16);
            *(u32x4*)(pr + C_IW) = o;
        }
    }
    if (!do_dvt) return;
    bf16_t* dvt = (bf16_t*)(p.ws + OFF_DVT);
    LAS bf16_t* tile = (LAS bf16_t*)smem;
    for (int unit = blockIdx.x; unit < NB * (TTP / 64); unit += gridDim.x) {
        const int b = unit / (TTP / 64), t0 = (unit % (TTP / 64)) * 64;
        for (int i = threadIdx.x; i < 64 * 16; i += NTHREADS) {
            const int tr = i >> 4, ch = i & 15, t = t0 + tr;
            u32x4 v = {0u, 0u, 0u, 0u};
            if (t < TT) v = *(const u32x4*)(proj + (size_t)(b * TT + t) * INW + C_DV + ch * 8);
            *(LAS u32x4*)(tile + tr * 136 + ch * 8) = v;
        }
        __syncthreads();
        for (int i = threadIdx.x; i < 128 * 8; i += NTHREADS) {
            const int dv = i >> 3, ch = i & 7;
            u32x4 o;
#pragma unroll
            for (int w = 0; w < 4; ++w) o[w] = (unsigned)tile[(ch * 8 + 2 * w) * 136 + dv] | ((unsigned)tile[(ch * 8 + 2 * w + 1) * 136 + dv] << 16);
            *(u32x4*)(dvt + (size_t)(b * 128 + dv) * TTP + t0 + ch * 8) = o;
        }
        __syncthreads();
    }
}

#define MFMA16(a, b, c) __builtin_amdgcn_mfma_f32_16x16x32_bf16((a), (b), (c), 0, 0, 0)
#define MFMA32(a, b, c) __builtin_amdgcn_mfma_f32_32x32x16_bf16((a), (b), (c), 0, 0, 0)
DI void phase_proj_meta(const Params& p, LAS char* smem) {
    const bf16_t* hn = (const bf16_t*)(p.ws + OFF_HN) + (size_t)NF * DM;
    const bf16_t* wint = (const bf16_t*)(p.ws + OFF_WINT);
    bf16_t* proj = (bf16_t*)(p.ws + OFF_BIG); bf16_t* dvt = (bf16_t*)(p.ws + OFF_DVT);
    const float* c128 = (const float*)(p.ws + OFF_COS128); const float* s128 = (const float*)(p.ws + OFF_SIN128);
    const float* c64 = (const float*)(p.ws + OFF_COS64); const float* s64 = (const float*)(p.ws + OFF_SIN64);
    int tz = threadIdx.x; asm volatile("" : "+v"(tz));
    const int wave = tz >> 6, lane = tz & 63, c = lane & 15, g = lane >> 4;
    LAS f32x4* red = (LAS f32x4*)smem;
    const int first = gridDim.x >= 64 ? 16 : 0;
    for (int blk = (int)blockIdx.x - first; blk >= 0 && blk < 31; blk += (int)gridDim.x) {
        const int cb = blk * 128;
        const bf16_t* yrow = hn + (size_t)c * DM + wave * 128 + 8 * g;
        const bf16_t* xrow = wint + (size_t)(cb + c) * DM + wave * 128 + 8 * g;
        f32x4 acc[8];
#pragma unroll
        for (int q = 0; q < 8; ++q) acc[q] = (f32x4){0.f, 0.f, 0.f, 0.f};
#pragma unroll
        for (int ks = 0; ks < 4; ++ks) {
            const bf16x8 y = *(const bf16x8*)(yrow + ks * 32);
#pragma unroll
            for (int q = 0; q < 8; ++q) acc[q] = MFMA16(*(const bf16x8*)(xrow + (size_t)(q * 16) * DM + ks * 32), y, acc[q]);
        }
#pragma unroll
        for (int q = 0; q < 8; ++q) red[(wave * 8 + q) * 64 + lane] = acc[q];
        __syncthreads();
        if (wave < 4) {
            f32x4 a1 = {0.f, 0.f, 0.f, 0.f}, a2 = {0.f, 0.f, 0.f, 0.f};
#pragma unroll
            for (int w = 0; w < 8; ++w) { a1 += red[(w * 8 + 2 * wave) * 64 + lane]; a2 += red[(w * 8 + 2 * wave + 1) * 64 + lane]; }
            const int t = c;
            f32x4 o1, o2; int c1, c2; bool st2;
            if (proj_block(a1, a2, cb, wave, g, t, c128, s128, c64, s64, o1, o2, c1, c2, st2)) {
                uint2 w1, w2; w1.x = pk2bf(o1[0], o1[1]); w1.y = pk2bf(o1[2], o1[3]); w2.x = pk2bf(o2[0], o2[1]); w2.y = pk2bf(o2[2], o2[3]);
#pragma unroll
                for (int b = 0; b < NB; ++b) {
                    bf16_t* rp = proj + (size_t)(b * TT + t) * INW;
                    *(uint2*)(rp + c1) = w1; if (st2) *(uint2*)(rp + c2) = w2;
                    if (st2 && cb == C_IK) { bf16_t* ik = (bf16_t*)(p.ws + OFF_IKC) + (size_t)(b * TT + t) * 64 + (c1 - C_IK); *(uint2*)(ik) = w1; *(uint2*)(ik + 32) = w2; }
                    if (cb == C_DV) {
                        bf16_t* dp = dvt + (size_t)(b * 128 + (c1 - C_DV)) * TTP + t;
#pragma unroll
                        for (int j = 0; j < 4; ++j) { dp[(size_t)j * TTP] = f2bf(a1[j]); dp[(size_t)(64 + j) * TTP] = f2bf(a2[j]); }
                    }
                }
            }
        }
        __syncthreads();
    }
}

constexpr int DSA_WAVE_LDS = 2176 * 4 + 1024 * 4 + 256 * 4 + 64;
template <bool CHECK>
DI void phase_dsa_naive(const Params& p, LAS char* smem) {
    const bf16_t* proj = (const bf16_t*)(p.ws + OFF_BIG);
    bf16_t* mixed = (bf16_t*)(p.ws + OFF_HN);
    const int wave = threadIdx.x >> 6, lane = threadIdx.x & 63;
    LAS float* sSc = (LAS float*)(smem + wave * DSA_WAVE_LDS);
    LAS float* sQ = sSc + 2176;
    LAS int* sSel = (LAS int*)(sQ + 1024);
    LAS float* sIw = (LAS float*)(sSel + 256);
    const unsigned long long lt_mask = (1ull << lane) - 1ull;
    float chk_num = 0.f, chk_den = 0.f;
    for (int q = blockIdx.x * NWAVES + wave; q < NF; q += gridDim.x * NWAVES) {
        const int b = q >> 11, s = q & 2047, t = NMETA + s;
        const int nk = 80 + 64 * (s >> 6);
        const bf16_t* prow = proj + (size_t)(b * TT + t) * INW;
        for (int i = lane; i < 512; i += 64) sQ[i] = bf2f(prow[C_IQ + i]);
        if (lane < 8) sIw[lane] = bf2f(prow[C_IW + lane]);
        lds_fence();
        const bf16_t* ikbase = proj + (size_t)(b * TT) * INW + C_IK;
        const int nj = (nk + 63) >> 6;
        for (int jj = 0; jj < nj; ++jj) {
            const int k = jj * 64 + lane;
            float sc = 0.f;
            if (k < nk) {
                const bf16_t* kr = ikbase + (size_t)k * INW;
                float a[8];
#pragma unroll
                for (int h = 0; h < 8; ++h) a[h] = 0.f;
#pragma unroll 1
                for (int d8 = 0; d8 < 8; ++d8) {
                    const u32x4 raw = *(const u32x4*)(kr + d8 * 8); float kv[8]; unpack8(raw, kv);
#pragma unroll
                    for (int h = 0; h < 8; ++h) {
                        const f32x4 q0 = *(const LAS f32x4*)(sQ + h * 64 + d8 * 8), q1 = *(const LAS f32x4*)(sQ + h * 64 + d8 * 8 + 4);
                        a[h] += kv[0] * q0[0] + kv[1] * q0[1] + kv[2] * q0[2] + kv[3] * q0[3] + kv[4] * q1[0] + kv[5] * q1[1] + kv[6] * q1[2] + kv[7] * q1[3];
                    }
                }
#pragma unroll
                for (int h = 0; h < 8; ++h) sc += fmaxf(a[h], 0.f) * sIw[h];
                sc += 0.0f;
            }
            sSc[k] = sc;
        }
        lds_fence();
        int L;
        if (nk <= 256) {
            for (int i = lane; i < nk; i += 64) sSel[i] = i;
            L = nk;
        } else {
            unsigned Tkey = 0u;
            for (int bit = 31; bit >= 0; --bit) {
                const unsigned cand = Tkey | (1u << bit);
                int cnt = 0;
                for (int jj = 0; jj < nj; ++jj) {
                    const int k = jj * 64 + lane;
                    const unsigned key = (k < nk) ? fkey(sSc[k]) : 0u;
                    cnt += __popcll(__ballot(key >= cand));
                }
                if (cnt >= 256) Tkey = cand;
            }
            int cgt = 0;
            for (int jj = 0; jj < nj; ++jj) {
                const int k = jj * 64 + lane;
                const unsigned key = (k < nk) ? fkey(sSc[k]) : 0u;
                cgt += __popcll(__ballot(key > Tkey));
            }
            const int need = 256 - cgt;
            int pos = 0, eqseen = 0;
            for (int jj = 0; jj < nj; ++jj) {
                const int k = jj * 64 + lane;
                const unsigned key = (k < nk) ? fkey(sSc[k]) : 0u;
                const bool gt = key > Tkey, eq = (key == Tkey);
                const unsigned long long eqm = __ballot(eq);
                const int myeq = eqseen + __popcll(eqm & lt_mask);
                const bool sel = gt || (eq && myeq < need);
                const unsigned long long sm = __ballot(sel);
                if (sel) sSel[pos + __popcll(sm & lt_mask)] = k;
                pos += __popcll(sm); eqseen += __popcll(eqm);
            }
            L = 256;
        }
        lds_fence();
        for (int i = lane; i < 1024; i += 64) sQ[i] = bf2f(prow[C_DQ + i]);
        lds_fence();
        float sc[8][4];
        const bf16_t* dkbase = proj + (size_t)(b * TT) * INW + C_DK;
#pragma unroll
        for (int il = 0; il < 4; ++il) {
            const int i = lane + 64 * il; const bool ok = i < L; const int key = ok ? sSel[i] : 0;
            const bf16_t* kr = dkbase + (size_t)key * INW;
            float a[8];
#pragma unroll
            for (int h = 0; h < 8; ++h) a[h] = 0.f;
#pragma unroll 1
            for (int d8 = 0; d8 < 16; ++d8) {
                const u32x4 raw = *(const u32x4*)(kr + d8 * 8); float kv[8]; unpack8(raw, kv);
#pragma unroll
                for (int h = 0; h < 8; ++h) {
                    const f32x4 q0 = *(const LAS f32x4*)(sQ + h * 128 + d8 * 8), q1 = *(const LAS f32x4*)(sQ + h * 128 + d8 * 8 + 4);
                    a[h] += kv[0] * q0[0] + kv[1] * q0[1] + kv[2] * q0[2] + kv[3] * q0[3] + kv[4] * q1[0] + kv[5] * q1[1] + kv[6] * q1[2] + kv[7] * q1[3];
                }
            }
#pragma unroll
            for (int h = 0; h < 8; ++h) sc[h][il] = ok ? a[h] : -INFINITY;
        }
#pragma unroll
        for (int h = 0; h < 8; ++h) {
            float m = fmaxf(fmaxf(sc[h][0], sc[h][1]), fmaxf(sc[h][2], sc[h][3]));
            m = wave_max(m);
            float e[4], sum = 0.f;
#pragma unroll
            for (int il = 0; il < 4; ++il) { e[il] = exp2f(sc[h][il] - m); sum += e[il]; }
            sum = wave_sum(sum);
            const float inv = 1.f / sum;
#pragma unroll
            for (int il = 0; il < 4; ++il) sSc[h * 256 + lane + 64 * il] = e[il] * inv;
        }
        lds_fence();
        float o[8][2];
#pragma unroll
        for (int h = 0; h < 8; ++h) { o[h][0] = 0.f; o[h][1] = 0.f; }
        const bf16_t* dvbase = proj + (size_t)(b * TT) * INW + C_DV;
        for (int i = 0; i < L; ++i) {
            const int key = sSel[i];
            const float v0 = bf2f(dvbase[(size_t)key * INW + lane]), v1 = bf2f(dvbase[(size_t)key * INW + 64 + lane]);
#pragma unroll
            for (int h = 0; h < 8; ++h) { const float pv = sSc[h * 256 + i]; o[h][0] += pv * v0; o[h][1] += pv * v1; }
        }
        lds_fence();
#pragma unroll
        for (int h = 0; h < 8; ++h) { sQ[h * 128 + lane] = o[h][0]; sQ[h * 128 + 64 + lane] = o[h][1]; }
        lds_fence();
        for (int h = 0; h < 8; ++h) {
            float acc = 0.f;
            const float* wu = p.w_uv + (size_t)h * 128 * 64 + lane;
            for (int c = 0; c < 128; ++c) acc += sQ[h * 128 + c] * wu[c * 64];
            if (CHECK) { const float got = bf2f(mixed[(size_t)q * DM + 512 + h * 64 + lane]); chk_num += (got - acc) * (got - acc); chk_den += acc * acc; }
            else mixed[(size_t)q * DM + 512 + h * 64 + lane] = f2bf(acc);
        }
        lds_fence();
    }
    if (CHECK) {
        chk_num = wave_sum(chk_num); chk_den = wave_sum(chk_den);
        if (lane == 0) { atomicAdd((float*)(p.ws + OFF_BAR) + 3600, chk_num); atomicAdd((float*)(p.ws + OFF_BAR) + 3601, chk_den); }
    }
}

typedef unsigned long long u64;
typedef short s16x4 __attribute__((ext_vector_type(4)));
constexpr int SCLD = 2116;
constexpr int DSA_MASK_OFF = 16 * SCLD * 4;
constexpr int KLD = 136, VLD = 72, VLD2 = 136;
constexpr int DSA_VT_OFF = 128 * KLD * 2;
DI void phase_dsa_fast(const Params& p, LAS char* smem) {
    const bf16_t* proj = (const bf16_t*)(p.ws + OFF_BIG);
    const bf16_t* dvt = (const bf16_t*)(p.ws + OFF_DVT);
    const bf16_t* wuvt = (const bf16_t*)(p.ws + OFF_WUVT);
    bf16_t* mixed = (bf16_t*)(p.ws + OFF_HN);
    const int wave = threadIdx.x >> 6, lane = threadIdx.x & 63, c = lane & 15, g = lane >> 4;
    LAS float* SC = (LAS float*)smem; LAS u64* MASK = (LAS u64*)(smem + DSA_MASK_OFF);
    LAS bf16_t* KT = (LAS bf16_t*)smem; LAS bf16_t* VT = (LAS bf16_t*)(smem + DSA_VT_OFF);
    const u64 lt_mask = (1ull << lane) - 1ull;
    for (int pi = blockIdx.x; pi < 512; pi += gridDim.x)
    for (int which = 0; which < 2; ++which) {
        const int b = pi >> 6, qq = pi & 63, qt = which ? 127 - qq : qq;
        const int s0 = qt * 16, nk = 80 + 64 * (s0 >> 6), nkt = nk >> 4, nj = (nk + 63) >> 6;
        const bf16_t* pb = proj + (size_t)(b * TT) * INW;
        LAS char* tp_smem = smem; TP_BEGIN(1);
        {
            const bf16_t* qrow = pb + (size_t)(NMETA + s0 + c) * INW;
            bf16x8 bq[8][2]; float iw[8];
#pragma unroll
            for (int h = 0; h < 8; ++h) {
                bq[h][0] = *(const bf16x8*)(qrow + C_IQ + h * 64 + 8 * g);
                bq[h][1] = *(const bf16x8*)(qrow + C_IQ + h * 64 + 32 + 8 * g);
                iw[h] = bf2f(qrow[C_IW + h]);
            }
            bf16x8 a0n = {0, 0, 0, 0, 0, 0, 0, 0}, a1n = {0, 0, 0, 0, 0, 0, 0, 0};
            if (wave < nkt) { const bf16_t* krow = pb + (size_t)(wave * 16 + c) * INW + C_IK + 8 * g; a0n = *(const bf16x8*)(krow); a1n = *(const bf16x8*)(krow + 32); }
            for (int kt = wave; kt < nkt; kt += NWAVES) {
                const bf16x8 a0 = a0n, a1 = a1n;
                if (kt + NWAVES < nkt) { const bf16_t* krow = pb + (size_t)((kt + NWAVES) * 16 + c) * INW + C_IK + 8 * g; a0n = *(const bf16x8*)(krow); a1n = *(const bf16x8*)(krow + 32); }
                f32x4 isc = {0.f, 0.f, 0.f, 0.f};
#pragma unroll
                for (int h = 0; h < 8; ++h) {
                    f32x4 acc = {0.f, 0.f, 0.f, 0.f};
                    acc = MFMA16(a0, bq[h][0], acc); acc = MFMA16(a1, bq[h][1], acc);
#pragma unroll
                    for (int j = 0; j < 4; ++j) isc[j] += fmaxf(acc[j], 0.f) * iw[h];
                }
#pragma unroll
                for (int j = 0; j < 4; ++j) isc[j] += 0.0f;
                *(LAS f32x4*)(SC + c * SCLD + kt * 16 + 4 * g) = isc;
            }
            {
                const int tail = ((nj <= 11 ? 11 : (nj <= 22 ? 22 : 33)) << 6) - nk;
                for (int i = threadIdx.x; i < 16 * tail; i += NTHREADS) { const int qq_ = i / tail; SC[qq_ * SCLD + nk + (i - qq_ * tail)] = -3.0e38f; }
            }
        }
        __syncthreads(); TP_END(1); TP_BEGIN(2);
#pragma unroll 1
        for (int qi = 0; qi < 2; ++qi) {
            const int cq = wave * 2 + qi;
            unsigned kv[33];
#pragma unroll
            for (int jj = 0; jj < 11; ++jj) kv[jj] = fkey(SC[cq * SCLD + jj * 64 + lane]);
            if (nj > 11) {
#pragma unroll
                for (int jj = 11; jj < 22; ++jj) kv[jj] = fkey(SC[cq * SCLD + jj * 64 + lane]);
            } else {
#pragma unroll
                for (int jj = 11; jj < 22; ++jj) kv[jj] = 0u;
            }
            if (nj > 22) {
#pragma unroll
                for (int jj = 22; jj < 33; ++jj) kv[jj] = fkey(SC[cq * SCLD + jj * 64 + lane]);
            } else {
#pragma unroll
                for (int jj = 22; jj < 33; ++jj) kv[jj] = 0u;
            }
            unsigned Tkey = 1u;
            if (nk > 256) {
                Tkey = 0u;
#pragma unroll 1
                for (int bit = 31; bit >= 0; --bit) {
                    const unsigned cand = Tkey | (1u << bit);
                    int nl = 0;
#pragma unroll
                    for (int jj = 0; jj < 11; ++jj) nl += (kv[jj] >= cand) ? 1 : 0;
                    if (nj > 11) {
#pragma unroll
                        for (int jj = 11; jj < 22; ++jj) nl += (kv[jj] >= cand) ? 1 : 0;
                    }
                    if (nj > 22) {
#pragma unroll
                        for (int jj = 22; jj < 33; ++jj) nl += (kv[jj] >= cand) ? 1 : 0;
                    }
                    const int cnt = wave_sum_int(nl);
                    if (cnt >= 256) Tkey = cand;
                    if (cnt == 256) break;
                }
            }
            int cgl = 0;
#pragma unroll
            for (int jj = 0; jj < 33; ++jj) cgl += (kv[jj] > Tkey) ? 1 : 0;
            const int cgt = wave_sum_int(cgl);
            const int need = (nk > 256) ? 256 - cgt : 4096;
            int eqseen = 0;
#pragma unroll 1
            for (int jj = 0; jj < nj; ++jj) {
                const int k = jj * 64 + lane; const float v = SC[cq * SCLD + k];
                const unsigned key = (k < nk) ? fkey(v) : 0u;
                const bool gt = key > Tkey, eq = (key == Tkey);
                const u64 eqm = __ballot(eq);
                const int myeq = eqseen + __popcll(eqm & lt_mask);
                const u64 sm = __ballot(gt || (eq && myeq < need));
                eqseen += __popcll(eqm);
                if (lane == 0) MASK[cq * 34 + jj] = sm;
            }
        }
        __syncthreads(); TP_END(2); TP_BEGIN(3);
        {
            const int h = wave;
            const bf16_t* qrow = pb + (size_t)(NMETA + s0 + c) * INW + C_DQ + h * 128 + 8 * g;
            bf16x8 bQ[4];
#pragma unroll
            for (int ks = 0; ks < 4; ++ks) bQ[ks] = *(const bf16x8*)(qrow + ks * 32);
            f32x4 O[8];
#pragma unroll
            for (int mb = 0; mb < 8; ++mb) O[mb] = (f32x4){0.f, 0.f, 0.f, 0.f};
            float m_run = -1e30f, l_run = 0.f;
            const int prow_t = threadIdx.x >> 4, pch_t = threadIdx.x & 15;
            const bf16_t* vsrc = dvt + (size_t)(b * 128 + prow_t) * TTP + pch_t * 8;
            const int n128 = (nk + 127) >> 7;
            u32x4 pk[4], pv[4];
#pragma unroll
            for (int i = 0; i < 4; ++i) {
                int key = prow_t + 32 * i; key = key < nk ? key : nk - 1;
                pk[i] = *(const u32x4*)(pb + (size_t)key * INW + C_DK + pch_t * 8);
                pv[i] = *(const u32x4*)(vsrc + (size_t)(32 * i) * TTP);
            }
#pragma unroll 1
            for (int kb = 0; kb < n128; ++kb) {
#pragma unroll
                for (int i = 0; i < 4; ++i) {
                    *(LAS u32x4*)(KT + (prow_t + 32 * i) * KLD + pch_t * 8) = pk[i];
                    *(LAS u32x4*)(VT + (prow_t + 32 * i) * VLD2 + pch_t * 8) = pv[i];
                }
                __syncthreads();
                if (kb + 1 < n128) {
#pragma unroll
                    for (int i = 0; i < 4; ++i) {
                        int key = (kb + 1) * 128 + prow_t + 32 * i; key = key < nk ? key : nk - 1;
                        pk[i] = *(const u32x4*)(pb + (size_t)key * INW + C_DK + pch_t * 8);
                        pv[i] = *(const u32x4*)(vsrc + (size_t)(32 * i) * TTP + (kb + 1) * 128);
                    }
                }
#pragma unroll
                for (int sb = 0; sb < 2; ++sb) {
                    const int wi = kb * 2 + sb;
                    if (wi < nj) {
                        const u64 mw = MASK[c * 34 + wi];
                        f32x4 S[4];
#pragma unroll
                        for (int ct = 0; ct < 4; ++ct) {
                            f32x4 acc = {0.f, 0.f, 0.f, 0.f};
#pragma unroll
                            for (int ks = 0; ks < 4; ++ks) {
                                const bf16x8 a = *(const LAS bf16x8*)(KT + (sb * 64 + ct * 16 + c) * KLD + ks * 32 + 8 * g);
                                acc = MFMA16(a, bQ[ks], acc);
                            }
                            S[ct] = acc;
                        }
                        const u64 mws = mw >> (4 * g);
                        const unsigned mlo = (unsigned)mws, mhi = (unsigned)(mws >> 32);
                        float mblk = -1e30f;
#pragma unroll
                        for (int ct = 0; ct < 4; ++ct) {
                            const unsigned bits = ((ct & 2) ? mhi : mlo) >> ((ct & 1) * 16);
#pragma unroll
                            for (int j = 0; j < 4; ++j) {
                                S[ct][j] = ((bits >> j) & 1u) ? S[ct][j] : -1e30f;
                                mblk = fmaxf(mblk, S[ct][j]);
                            }
                        }
                        mblk = fmaxf(mblk, __shfl_xor(mblk, 16)); mblk = fmaxf(mblk, __shfl_xor(mblk, 32));
                        const float m_new = fmaxf(m_run, mblk);
                        float ps = 0.f;
#pragma unroll
                        for (int ct = 0; ct < 4; ++ct)
#pragma unroll
                            for (int j = 0; j < 4; ++j) { const float pv_ = (S[ct][j] > -1e29f) ? __builtin_amdgcn_exp2f(S[ct][j] - m_new) : 0.f; S[ct][j] = pv_; ps += pv_; }
                        if (__ballot(m_new != m_run) != 0ull) {
                            const float alpha = __builtin_amdgcn_exp2f(m_run - m_new);
                            l_run *= alpha;
#pragma unroll
                            for (int mb = 0; mb < 8; ++mb) O[mb] *= alpha;
                        }
                        l_run += ps; m_run = m_new;
                        bf16x8 bP[2];
#pragma unroll
                        for (int kk = 0; kk < 2; ++kk) {
                            u32x4 t4;
                            t4[0] = pk2bf(S[2 * kk][0], S[2 * kk][1]); t4[1] = pk2bf(S[2 * kk][2], S[2 * kk][3]);
                            t4[2] = pk2bf(S[2 * kk + 1][0], S[2 * kk + 1][1]); t4[3] = pk2bf(S[2 * kk + 1][2], S[2 * kk + 1][3]);
                            bP[kk] = __builtin_bit_cast(bf16x8, t4);
                        }
#pragma unroll
                        for (int mh = 0; mh < 2; ++mh) {
                            bf16x8 av[8];
#pragma unroll
                            for (int q = 0; q < 8; ++q) {
                                const int mb = mh * 4 + (q >> 1), kk = q & 1;
                                const LAS bf16_t* vr = VT + (mb * 16 + c) * VLD2 + sb * 64 + kk * 32 + 4 * g;
                                const s16x4 lo = *(const LAS s16x4*)(vr), hi = *(const LAS s16x4*)(vr + 16);
                                av[q] = __builtin_shufflevector(lo, hi, 0, 1, 2, 3, 4, 5, 6, 7);
                            }
                            __builtin_amdgcn_sched_barrier(0);
#pragma unroll
                            for (int q = 0; q < 8; ++q) { const int mb = mh * 4 + (q >> 1), kk = q & 1; O[mb] = MFMA16(av[q], bP[kk], O[mb]); }
                            __builtin_amdgcn_sched_barrier(0);
                        }
                    }
                }
                __syncthreads();
            }
            TP_END(3); TP_BEGIN(4);
            l_run += __shfl_xor(l_run, 16); l_run += __shfl_xor(l_run, 32);
            const float inv = 1.f / l_run;
            bf16x8 bO[4];
#pragma unroll
            for (int k2 = 0; k2 < 4; ++k2)
#pragma unroll
                for (int j = 0; j < 4; ++j) { bO[k2][j] = (short)f2bf(O[2 * k2][j] * inv); bO[k2][4 + j] = (short)f2bf(O[2 * k2 + 1][j] * inv); }
            bf16_t* orow = mixed + (size_t)(b * SEQ + s0 + c) * DM + 512 + h * 64;
            int zofs = 0; asm volatile("" : "+v"(zofs));
#pragma unroll
            for (int eb = 0; eb < 4; ++eb) {
                f32x4 acc = {0.f, 0.f, 0.f, 0.f};
#pragma unroll
                for (int k2 = 0; k2 < 4; ++k2) {
                    const bf16_t* wr = wuvt + (size_t)(h * 64 + eb * 16 + c) * 128 + k2 * 32 + 4 * g + zofs;
                    const s16x4 lo = *(const s16x4*)(wr), hi = *(const s16x4*)(wr + 16);
                    const bf16x8 a = __builtin_shufflevector(lo, hi, 0, 1, 2, 3, 4, 5, 6, 7);
                    acc = MFMA16(a, bO[k2], acc);
                }
                uint2 w;
                w.x = (unsigned)f2bf(acc[0]) | ((unsigned)f2bf(acc[1]) << 16);
                w.y = (unsigned)f2bf(acc[2]) | ((unsigned)f2bf(acc[3]) << 16);
                *(uint2*)(orow + eb * 16 + 4 * g) = w;
            }
            TP_END(4);
        }
    }
}

DI void phase_dsa32(const Params& p, LAS char* smem) {
    const bf16_t* proj = (const bf16_t*)(p.ws + OFF_BIG);
    const bf16_t* dvt = (const bf16_t*)(p.ws + OFF_DVT);
    const bf16_t* wuvt = (const bf16_t*)(p.ws + OFF_WUVT);
    bf16_t* mixed = (bf16_t*)(p.ws + OFF_HN);
    LAS float* SC = (LAS float*)smem; LAS u64* MASK = (LAS u64*)(smem + DSA_MASK_OFF);
    LAS bf16_t* KT = (LAS bf16_t*)smem; LAS bf16_t* VT = (LAS bf16_t*)(smem + DSA_VT_OFF);
    for (int pi = blockIdx.x; pi < 256; pi += gridDim.x)
    for (int which = 0; which < 2; ++which) {
        const int b = pi >> 5, qq = pi & 31, qt = which ? 63 - qq : qq;
        const int s0 = qt * 32, nk = 80 + 64 * (s0 >> 6), nkt = nk >> 4, nj = (nk + 63) >> 6;
        const bf16_t* pb = proj + (size_t)(b * TT) * INW;
        const bf16_t* ikb = (const bf16_t*)(p.ws + OFF_IKC) + (size_t)(b * TT) * 64;
        LAS char* tp_smem = smem; TP_BEGIN(1);
#pragma unroll 1
        for (int sub = 0; sub < 2; ++sub) {
            {
                int tz_ = threadIdx.x; asm volatile("" : "+v"(tz_)); const int lane = tz_ & 63, wave = __builtin_amdgcn_readfirstlane(tz_ >> 6); const int c = lane & 15, g = lane >> 4;
                const bf16_t* qrow = pb + (size_t)(NMETA + s0 + 16 * sub + c) * INW;
                bf16x8 bq[8][2]; float iw[8];
#pragma unroll
                for (int h = 0; h < 8; ++h) {
                    bq[h][0] = *(const bf16x8*)(qrow + C_IQ + h * 64 + 8 * g);
                    bq[h][1] = *(const bf16x8*)(qrow + C_IQ + h * 64 + 32 + 8 * g);
                    iw[h] = bf2f(qrow[C_IW + h]);
                }
                bf16x8 ka[4][2];
#define SI_LOAD(D, KT_) do { int kc_ = (KT_); kc_ = kc_ < nkt ? kc_ : nkt - 1; const bf16_t* krow_ = ikb + (size_t)(kc_ * 16 + c) * 64 + 8 * g; ka[D][0] = *(const bf16x8*)(krow_); ka[D][1] = *(const bf16x8*)(krow_ + 32); } while (0)
#define SI_TILE(A0, A1, KT_) do { \
                    f32x4 isc = {0.f, 0.f, 0.f, 0.f}; \
                    _Pragma("unroll") for (int h = 0; h < 8; ++h) { \
                        f32x4 acc = {0.f, 0.f, 0.f, 0.f}; \
                        acc = MFMA16(A0, bq[h][0], acc); acc = MFMA16(A1, bq[h][1], acc); \
                        _Pragma("unroll") for (int j = 0; j < 4; ++j) isc[j] += fmaxf(acc[j], 0.f) * iw[h]; \
                    } \
                    _Pragma("unroll") for (int j = 0; j < 4; ++j) isc[j] += 0.0f; \
                    *(LAS f32x4*)(SC + c * SCLD + (KT_) * 16 + 4 * g) = isc; \
                } while (0)
#pragma unroll
                for (int d = 0; d < 4; ++d) SI_LOAD(d, wave + NWAVES * d);
                int kt0 = wave;
#pragma unroll 1
                for (; kt0 + 3 * NWAVES < nkt; kt0 += 4 * NWAVES) {
#pragma unroll
                    for (int d = 0; d < 4; ++d) {
                        const int kt = kt0 + NWAVES * d;
                        SI_TILE(ka[d][0], ka[d][1], kt);
                        __builtin_amdgcn_sched_barrier(0);
                        SI_LOAD(d, kt + 4 * NWAVES);
                    }
                }
#pragma unroll
                for (int d = 0; d < 3; ++d) {
                    const int kt = kt0 + NWAVES * d;
                    if (kt < nkt) SI_TILE(ka[d][0], ka[d][1], kt);
                }
#undef SI_TILE
#undef SI_LOAD
                {
                    const int tail = ((nj <= 11 ? 11 : (nj <= 22 ? 22 : 33)) << 6) - nk;
                    for (int i = threadIdx.x; i < 16 * tail; i += NTHREADS) { const int qq_ = i / tail; SC[qq_ * SCLD + nk + (i - qq_ * tail)] = -3.0e38f; }
                }
            }
            __syncthreads();
            {
            int tz_ = threadIdx.x; asm volatile("" : "+v"(tz_)); const int lane = tz_ & 63, wave = __builtin_amdgcn_readfirstlane(tz_ >> 6); const u64 lt_mask = (1ull << lane) - 1ull;
#pragma unroll 1
            for (int qi = 0; qi < 2; ++qi) {
                const int cq = wave * 2 + qi;
                unsigned kv[33];
#pragma unroll
                for (int jj = 0; jj < 11; ++jj) kv[jj] = fkey(SC[cq * SCLD + jj * 64 + lane]);
                if (nj > 11) {
#pragma unroll
                    for (int jj = 11; jj < 22; ++jj) kv[jj] = fkey(SC[cq * SCLD + jj * 64 + lane]);
                } else {
#pragma unroll
                    for (int jj = 11; jj < 22; ++jj) kv[jj] = 0u;
                }
                if (nj > 22) {
#pragma unroll
                    for (int jj = 22; jj < 33; ++jj) kv[jj] = fkey(SC[cq * SCLD + jj * 64 + lane]);
                } else {
#pragma unroll
                    for (int jj = 22; jj < 33; ++jj) kv[jj] = 0u;
                }
                unsigned Tkey = 1u;
                if (nk > 256) {
                    Tkey = 0u;
#pragma unroll 1
                    for (int bit = 31; bit >= 0; --bit) {
                        const unsigned cand = Tkey | (1u << bit);
                        int nl = 0;
#pragma unroll
                        for (int jj = 0; jj < 11; ++jj) nl += (kv[jj] >= cand) ? 1 : 0;
                        if (nj > 11) {
#pragma unroll
                            for (int jj = 11; jj < 22; ++jj) nl += (kv[jj] >= cand) ? 1 : 0;
                        }
                        if (nj > 22) {
#pragma unroll
                            for (int jj = 22; jj < 33; ++jj) nl += (kv[jj] >= cand) ? 1 : 0;
                        }
                        const int cnt = wave_sum_int(nl);
                        if (cnt >= 256) Tkey = cand;
                        if (cnt == 256) break;
                    }
                }
                int cgl = 0;
#pragma unroll
                for (int jj = 0; jj < 33; ++jj) cgl += (kv[jj] > Tkey) ? 1 : 0;
                const int cgt = wave_sum_int(cgl);
                const int need = (nk > 256) ? 256 - cgt : 4096;
                int eqseen = 0;
#pragma unroll 1
                for (int jj = 0; jj < nj; ++jj) {
                    const int k = jj * 64 + lane; const float v = SC[cq * SCLD + k];
                    const unsigned key = (k < nk) ? fkey(v) : 0u;
                    const bool gt = key > Tkey, eq = (key == Tkey);
                    const u64 eqm = __ballot(eq);
                    const int myeq = eqseen + __popcll(eqm & lt_mask);
                    const u64 sm = __ballot(gt || (eq && myeq < need));
                    eqseen += __popcll(eqm);
                    if (lane == 0) MASK[(16 * sub + cq) * 34 + jj] = sm;
                }
                if ((nj & 1) && lane == 0) MASK[(16 * sub + cq) * 34 + nj] = 0ull;
            }
            }

            __syncthreads();
        }
        TP_END(1); TP_BEGIN(3);
        {
            int tz_ = threadIdx.x; asm volatile("" : "+v"(tz_)); const int lane = tz_ & 63, wave = __builtin_amdgcn_readfirstlane(tz_ >> 6); const int r = lane & 31, hh = lane >> 5;
            const int h = wave;
            const bf16_t* qrow = pb + (size_t)(NMETA + s0 + r) * INW + C_DQ + h * 128 + 8 * hh;
            bf16x8 bQ[8];
#pragma unroll
            for (int ks = 0; ks < 8; ++ks) bQ[ks] = *(const bf16x8*)(qrow + ks * 16);
            f32x16 O[4];
#pragma unroll
            for (int d = 0; d < 4; ++d)
#pragma unroll
                for (int i = 0; i < 16; ++i) O[d][i] = 0.f;
            float m_run = -1e30f, l_run = 0.f;
            const int n128 = (nk + 127) >> 7;
            const int drow = lane >> 4, dslot = lane & 15;
            int fa[4];
            const int rp = (r & ~12) | ((r & 4) << 1) | ((r & 8) >> 1);
#pragma unroll
            for (int m = 0; m < 4; ++m) fa[m] = rp * 256 + (((2 * m + hh) ^ (rp & 15)) << 4);
            const int fd = (rp & 8) ? -128 : 128;
#define FA(m) ((m) < 4 ? fa[(m) & 3] : fa[(m) & 3] + fd)
#define DSA_ISSUE(KB, BUF) do { \
                _Pragma("unroll") for (int j = 0; j < 4; ++j) { \
                    const int R_ = (wave * 4 + j) * 4 + drow, ch_ = dslot ^ (j * 4 + drow); \
                    int key_ = (KB) * 128 + R_; key_ = key_ < nk ? key_ : nk - 1; \
                    __builtin_amdgcn_global_load_lds((const unsigned*)(pb + (size_t)key_ * INW + C_DK + ch_ * 8), (LAS unsigned*)(smem + (BUF) * 65536 + (wave * 4 + j) * 1024), 16, 0, 0); \
                    __builtin_amdgcn_global_load_lds((const unsigned*)(dvt + (size_t)(b * 128 + R_) * TTP + (KB) * 128 + ch_ * 8), (LAS unsigned*)(smem + (BUF) * 65536 + 32768 + (wave * 4 + j) * 1024), 16, 0, 0); \
                } } while (0)
            DSA_ISSUE(0, 0);
#pragma unroll 1
            for (int kb = 0; kb < n128; ++kb) {
                asm volatile("s_waitcnt vmcnt(0)" ::: "memory");
                __syncthreads();
                if (kb + 1 < n128) DSA_ISSUE(kb + 1, (kb + 1) & 1);
                LAS char* KTb = smem + (kb & 1) * 65536; LAS char* VTb = KTb + 32768;
                const u64 mw0 = MASK[r * 34 + kb * 2], mw1 = MASK[r * 34 + kb * 2 + 1];
                f32x16 S; bf16x8 kf[8];
#define DSA_KF(KBLK) do { _Pragma("unroll") for (int ks = 0; ks < 8; ++ks) kf[ks] = *(const LAS bf16x8*)(KTb + (KBLK) * 8192 + FA(ks)); } while (0)
#define DSA_S_BLOCK(KBLK) do { \
                    const unsigned nmb_ = ~(unsigned)(((KBLK) >> 1 ? mw1 : mw0) >> ((((KBLK) & 1) * 32) + 8 * hh)); \
                    _Pragma("unroll") for (int i = 0; i < 16; ++i) { int x_; asm("v_bfe_i32 %0, %1, %2, 1" : "=v"(x_) : "v"(nmb_), "n"((i & 3) + 4 * ((i >> 2) & 1) + 16 * (i >> 3))); S[i] = __builtin_bit_cast(float, (unsigned)x_ & 0xff800000u); }     \
                    _Pragma("unroll") for (int ks = 0; ks < 8; ++ks) S = MFMA32(kf[ks], bQ[ks], S); \
                } while (0)
                DSA_KF(0);
                DSA_S_BLOCK(0);
#pragma unroll
                for (int kblk = 0; kblk < 4; ++kblk) {
                    if (kblk == 0) DSA_KF(1); else if (kblk == 1) DSA_KF(2); else if (kblk == 2) DSA_KF(3);
                    float mblk = fmaxf(S[0], S[1]);
#pragma unroll
                    for (int i = 2; i < 16; ++i) mblk = fmaxf(mblk, S[i]);
                    const auto sw = __builtin_amdgcn_permlane32_swap(__builtin_bit_cast(unsigned, mblk), __builtin_bit_cast(unsigned, mblk), false, false);
                    const float m_new = fmaxf(fmaxf(m_run, __builtin_bit_cast(float, (unsigned)sw[0])), __builtin_bit_cast(float, (unsigned)sw[1]));
                    if (__ballot(m_new != m_run) != 0ull) {
                        const float alpha = __builtin_amdgcn_exp2f(m_run - m_new);
                        l_run *= alpha;
#pragma unroll
                        for (int d = 0; d < 4; ++d)
#pragma unroll
                            for (int i = 0; i < 16; ++i) O[d][i] *= alpha;
                    }
                    m_run = m_new;
                    bf16x8 av[8];
#pragma unroll
                    for (int q = 0; q < 8; ++q) av[q] = *(const LAS bf16x8*)(VTb + (q >> 1) * 8192 + FA(2 * kblk + (q & 1)));
                    f32x2 ps2 = {0.f, 0.f};
                    const f32x2 mn2 = {m_new, m_new};
#pragma unroll
                    for (int i = 0; i < 8; ++i) {
                        f32x2 t2 = {S[2 * i], S[2 * i + 1]}; t2 = t2 - mn2;
                        t2[0] = __builtin_amdgcn_exp2f(t2[0]); t2[1] = __builtin_amdgcn_exp2f(t2[1]);
                        ps2 += t2; S[2 * i] = t2[0]; S[2 * i + 1] = t2[1];
                    }
                    l_run += ps2[0] + ps2[1];
                    bf16x8 bP[2];
#pragma unroll
                    for (int s2 = 0; s2 < 2; ++s2) {
                        u32x4 t4;
#pragma unroll
                        for (int x = 0; x < 4; ++x) t4[x] = pk2bf(S[8 * s2 + 2 * x], S[8 * s2 + 2 * x + 1]);
                        bP[s2] = __builtin_bit_cast(bf16x8, t4);
                    }
                    if (kblk < 3) DSA_S_BLOCK(kblk + 1);
#pragma unroll
                    for (int q = 0; q < 8; ++q) O[q >> 1] = MFMA32(av[q], bP[q & 1], O[q >> 1]);
                }
#undef DSA_S_BLOCK
#undef DSA_KF
            }
#undef DSA_ISSUE
#undef FA
            __syncthreads();
            TP_END(3); TP_BEGIN(4);
            l_run += __shfl_xor(l_run, 32);
            const float inv = 1.f / l_run;
            bf16x8 bO[4][2];
#pragma unroll
            for (int d = 0; d < 4; ++d)
#pragma unroll
                for (int s2 = 0; s2 < 2; ++s2) {
                    u32x4 t4;
#pragma unroll
                    for (int x = 0; x < 4; ++x) t4[x] = pk2bf(O[d][8 * s2 + 2 * x] * inv, O[d][8 * s2 + 2 * x + 1] * inv);
                    bO[d][s2] = __builtin_bit_cast(bf16x8, t4);
                }
            bf16_t* orow = mixed + (size_t)(b * SEQ + s0 + r) * DM + 512 + h * 64 + 4 * hh;
            int zofs = 0; asm volatile("" : "+v"(zofs));
#pragma unroll
            for (int eb = 0; eb < 2; ++eb) {
                f32x16 acc;
#pragma unroll
                for (int i = 0; i < 16; ++i) acc[i] = 0.f;
#pragma unroll
                for (int d = 0; d < 4; ++d)
#pragma unroll
                    for (int s2 = 0; s2 < 2; ++s2) {
                        const bf16x8 a = *(const bf16x8*)(wuvt + (size_t)(h * 64 + eb * 32 + r) * 128 + d * 32 + 16 * s2 + 8 * hh + zofs);
                        acc = MFMA32(a, bO[d][s2], acc);
                    }
#pragma unroll
                for (int g4 = 0; g4 < 4; ++g4) { uint2 w; w.x = pk2bf(acc[4 * g4], acc[4 * g4 + 1]); w.y = pk2bf(acc[4 * g4 + 2], acc[4 * g4 + 3]); *(uint2*)(orow + eb * 32 + 8 * g4) = w; }
            }
            TP_END(4);
        }
    }
}

DI void phase_ret_scan(const Params& p) {
    float* ST = (float*)(p.ws + OFF_ST);
    const int gtid = blockIdx.x * NTHREADS + threadIdx.x, gsz = gridDim.x * NTHREADS;
    for (int idx = gtid; idx < 32 * 16384; idx += gsz) {
        const int bh = idx >> 14, el = idx & 16383, h = bh & 3;
        const float gc = expf(logf(1.f - exp2f(-5.f - (float)h)) * 64.f);
        float* base = ST + (size_t)bh * 34 * 16384 + el;
        float r = 0.f;
        for (int c = 1; c < 34; ++c) {
            const float u = c < 33 ? base[(size_t)c * 16384] : 0.f;
            base[(size_t)c * 16384] = r;
            r = gc * r + u;
        }
    }
}

constexpr int RLD = 136, RTLD = 72;
DI void phase_ret_state_mfma(const Params& p, LAS char* smem) {
    const bf16_t* proj = (const bf16_t*)(p.ws + OFF_BIG);
    float* ST = (float*)(p.ws + OFF_ST);
    LAS bf16_t* sVT = (LAS bf16_t*)smem; LAS bf16_t* sKT = sVT + 128 * RTLD;
    const int wave = threadIdx.x >> 6, lane = threadIdx.x & 63, r = lane & 31, hh = lane >> 5;
    for (int unit = blockIdx.x; unit < 1024; unit += gridDim.x) {
        const int c = 1 + (unit & 31), bh = unit >> 5, h = bh & 3, b = bh >> 2;
        const float lg = logf(1.f - exp2f(-5.f - (float)h));
        {
            const int j = threadIdx.x >> 3, ch = threadIdx.x & 7, t = 64 * c + j - 112;
            const float z = expf(lg * (float)(63 - j));
#pragma unroll
            for (int q = 0; q < 2; ++q) {
                const int cc = ch + 8 * q;
                u32x4 kv = {0u, 0u, 0u, 0u}, vv = {0u, 0u, 0u, 0u};
                if (t >= 0) { const bf16_t* pr = proj + (size_t)(b * TT + t) * INW; kv = *(const u32x4*)(pr + C_RK + h * 128 + cc * 8); vv = *(const u32x4*)(pr + C_RV + h * 128 + cc * 8); }
                float vf[8]; unpack8(vv, vf);
#pragma unroll
                for (int x = 0; x < 8; ++x) {
                    sKT[(cc * 8 + x) * RTLD + j] = (bf16_t)((kv[x >> 1] >> ((x & 1) * 16)) & 0xffffu);
                    sVT[(cc * 8 + x) * RTLD + j] = f2bf(vf[x] * z);
                }
            }
        }
        __syncthreads();
        const int mb = wave >> 1;
#pragma unroll
        for (int q = 0; q < 2; ++q) {
            const int nb = (wave & 1) * 2 + q;
            f32x16 acc;
#pragma unroll
            for (int i = 0; i < 16; ++i) acc[i] = 0.f;
#pragma unroll
            for (int ks = 0; ks < 4; ++ks) {
                const bf16x8 a = *(const LAS bf16x8*)(sVT + (mb * 32 + r) * RTLD + ks * 16 + 8 * hh);
                const bf16x8 bb = *(const LAS bf16x8*)(sKT + (nb * 32 + r) * RTLD + ks * 16 + 8 * hh);
                acc = MFMA32(a, bb, acc);
            }
            float* st = ST + (size_t)(bh * 34 + c) * 16384 + nb * 32 + r;
#pragma unroll
            for (int i = 0; i < 16; ++i) st[(size_t)(mb * 32 + (i & 3) + 8 * (i >> 2) + 4 * hh) * 128] = acc[i];
        }
        __syncthreads();
    }
}
DI void phase_ret_out_mfma(const Params& p, LAS char* smem) {
    const bf16_t* proj = (const bf16_t*)(p.ws + OFF_BIG);
    const float* ST = (const float*)(p.ws + OFF_ST);
    bf16_t* mixed = (bf16_t*)(p.ws + OFF_HN);
    LAS bf16_t* sQ = (LAS bf16_t*)smem; LAS bf16_t* sK = sQ + 64 * RLD; LAS bf16_t* sVT = sK + 64 * RLD;
    LAS float* sGN = (LAS float*)(sVT + 128 * RTLD);
    const int wave = threadIdx.x >> 6, lane = threadIdx.x & 63, r = lane & 31, hh = lane >> 5;
    const int ib = wave & 1, eb = wave >> 1;
    for (int unit = blockIdx.x; unit < 1024; unit += gridDim.x) {
        const int c = 2 + (unit & 31), bh = unit >> 5, h = bh & 3, b = bh >> 2;
        const float lg = logf(1.f - exp2f(-5.f - (float)h));
        for (int i = threadIdx.x; i < 64 * 16; i += NTHREADS) {
            const int j = i >> 4, ch = i & 15; const int t = 64 * c + j - 112;
            const bf16_t* pr = proj + (size_t)(b * TT + t) * INW;
            *(LAS u32x4*)(sQ + j * RLD + ch * 8) = *(const u32x4*)(pr + C_RQ + h * 128 + ch * 8);
            *(LAS u32x4*)(sK + j * RLD + ch * 8) = *(const u32x4*)(pr + C_RK + h * 128 + ch * 8);
            const u32x4 vv = *(const u32x4*)(pr + C_RV + h * 128 + ch * 8);
#pragma unroll
            for (int x = 0; x < 8; ++x) sVT[(ch * 8 + x) * RTLD + j] = (bf16_t)((vv[x >> 1] >> ((x & 1) * 16)) & 0xffffu);
        }
        __syncthreads();
        f32x16 acc;
#pragma unroll
        for (int i = 0; i < 16; ++i) acc[i] = 0.f;
        {
            const float* R = ST + (size_t)(bh * 34 + c) * 16384 + (size_t)(eb * 32 + r) * 128 + 8 * hh;
#pragma unroll
            for (int ks = 0; ks < 8; ++ks) {
                const float4 r0 = *(const float4*)(R + ks * 16), r1 = *(const float4*)(R + ks * 16 + 4);
                const float rf[8] = {r0.x, r0.y, r0.z, r0.w, r1.x, r1.y, r1.z, r1.w};
                const bf16x8 a = pack8(rf);
                const bf16x8 bq = *(const LAS bf16x8*)(sQ + (ib * 32 + r) * RLD + ks * 16 + 8 * hh);
                acc = MFMA32(a, bq, acc);
            }
            const float xi = expf(lg * (float)(ib * 32 + r + 1));
#pragma unroll
            for (int i = 0; i < 16; ++i) acc[i] *= xi;
        }
#pragma unroll
        for (int jb = 0; jb < 2; ++jb) {
            f32x16 st;
#pragma unroll
            for (int i = 0; i < 16; ++i) st[i] = 0.f;
#pragma unroll
            for (int ks = 0; ks < 8; ++ks) {
                const bf16x8 a = *(const LAS bf16x8*)(sK + (jb * 32 + r) * RLD + ks * 16 + 8 * hh);
                const bf16x8 bq = *(const LAS bf16x8*)(sQ + (ib * 32 + r) * RLD + ks * 16 + 8 * hh);
                st = MFMA32(a, bq, st);
            }
            const int icol = ib * 32 + r;
#pragma unroll
            for (int i = 0; i < 16; ++i) {
                const int j = jb * 32 + (i & 3) + 8 * (i >> 2) + 4 * hh; const int df = icol > j ? icol - j : j - icol;
                st[i] *= expf(lg * (float)df);
            }
#pragma unroll
            for (int s2 = 0; s2 < 2; ++s2) {
                bf16x8 bp;
#pragma unroll
                for (int x = 0; x < 8; ++x) bp[x] = (short)f2bf(st[8 * s2 + x]);
                const LAS bf16_t* vr = sVT + (eb * 32 + r) * RTLD + jb * 32 + 16 * s2 + 4 * hh;
                const s16x4 lo = *(const LAS s16x4*)(vr), hi = *(const LAS s16x4*)(vr + 8);
                const bf16x8 a = __builtin_shufflevector(lo, hi, 0, 1, 2, 3, 4, 5, 6, 7);
                acc = MFMA32(a, bp, acc);
            }
        }
        float s1 = 0.f, s2 = 0.f;
#pragma unroll
        for (int i = 0; i < 16; ++i) { s1 += acc[i]; s2 += acc[i] * acc[i]; }
        s1 += __shfl_xor(s1, 32); s2 += __shfl_xor(s2, 32);
        if (hh == 0) { sGN[(eb * 64 + ib * 32 + r) * 2] = s1; sGN[(eb * 64 + ib * 32 + r) * 2 + 1] = s2; }
        __syncthreads();
        float S1 = 0.f, S2 = 0.f;
#pragma unroll
        for (int e4 = 0; e4 < 4; ++e4) { S1 += sGN[(e4 * 64 + ib * 32 + r) * 2]; S2 += sGN[(e4 * 64 + ib * 32 + r) * 2 + 1]; }
        const float mu = S1 * (1.f / 128.f), var = fmaxf(S2 * (1.f / 128.f) - mu * mu, 0.f), rs = rsqrtf(var + 1e-6f);
        const int t = 64 * c + ib * 32 + r - 112, srow = t - NMETA;
        const bf16_t* pg = proj + (size_t)(b * TT + t) * INW + C_RG + h * 128 + eb * 32 + 4 * hh;
        bf16_t* po = mixed + (size_t)(b * SEQ + srow) * DM + h * 128 + eb * 32 + 4 * hh;
#pragma unroll
        for (int g4 = 0; g4 < 4; ++g4) {
            const uint2 graw = *(const uint2*)(pg + 8 * g4);
            const float gv[4] = {__uint_as_float(graw.x << 16), __uint_as_float(graw.x & 0xffff0000u), __uint_as_float(graw.y << 16), __uint_as_float(graw.y & 0xffff0000u)};
            float o[4];
#pragma unroll
            for (int x = 0; x < 4; ++x) { const float gate = gv[x] / (1.f + expf(-gv[x])); o[x] = gate * (acc[4 * g4 + x] - mu) * rs; }
            uint2 w; w.x = (unsigned)f2bf(o[0]) | ((unsigned)f2bf(o[1]) << 16); w.y = (unsigned)f2bf(o[2]) | ((unsigned)f2bf(o[3]) << 16);
            *(uint2*)(po + 8 * g4) = w;
        }
        __syncthreads();
    }
}

DI void phase_norm2(const Params& p) {
    bf16_t* hn2 = (bf16_t*)(p.ws + OFF_HN);
    const int wave = threadIdx.x >> 6, lane = threadIdx.x & 63;
    for (int row = blockIdx.x * NWAVES + wave; row < NF; row += gridDim.x * NWAVES) {
        const float* src = p.out + (size_t)row * DM; bf16_t* o = hn2 + (size_t)row * DM;
        float4 v[4]; float ss = 0.f;
#pragma unroll
        for (int i = 0; i < 4; ++i) { v[i] = *(const float4*)(src + i * 256 + lane * 4); ss += v[i].x * v[i].x + v[i].y * v[i].y + v[i].z * v[i].z + v[i].w * v[i].w; }
        ss = wave_sum(ss);
        const float rstd = rsqrtf(ss * (1.f / DM) + 1e-6f);
#pragma unroll
        for (int i = 0; i < 4; ++i) {
            const float4 g = *(const float4*)(p.norm_ffn + i * 256 + lane * 4);
            uint2 w;
            w.x = (unsigned)f2bf(v[i].x * rstd * g.x) | ((unsigned)f2bf(v[i].y * rstd * g.y) << 16);
            w.y = (unsigned)f2bf(v[i].z * rstd * g.z) | ((unsigned)f2bf(v[i].w * rstd * g.w) << 16);
            *(uint2*)(o + i * 256 + lane * 4) = w;
        }
    }
}

__device__ const int PEER_PAIRS[50] = {0, 2, 4, 6, 8, 10, 12, 14, 16, 18, 20, 22, 32, 34, 36, 49, 51, 65, 80, 96, 112, 128, 160, 192, 224, 1, 3, 5, 7, 9, 11, 13, 15, 17, 19, 21, 23, 33, 35, 48, 50, 64, 66, 81, 97, 113, 144, 176, 208, 240};
constexpr int PSEL_WAVE_LDS = 32 * 2 * 16 * 8 + 32 * 16 * 8;
#define PSEL_CE(K, a, b) { const unsigned hi_ = (K)[a] > (K)[b] ? (K)[a] : (K)[b]; const unsigned lo_ = (K)[a] > (K)[b] ? (K)[b] : (K)[a]; (K)[a] = hi_; (K)[b] = lo_; }
#define PSEL_SORT16(K, B) do { \
    PSEL_CE(K, (B) + 0, (B) + 1); PSEL_CE(K, (B) + 2, (B) + 3); PSEL_CE(K, (B) + 0, (B) + 2); PSEL_CE(K, (B) + 1, (B) + 3); PSEL_CE(K, (B) + 1, (B) + 2); PSEL_CE(K, (B) + 4, (B) + 5); \
    PSEL_CE(K, (B) + 6, (B) + 7); PSEL_CE(K, (B) + 4, (B) + 6); PSEL_CE(K, (B) + 5, (B) + 7); PSEL_CE(K, (B) + 5, (B) + 6); PSEL_CE(K, (B) + 0, (B) + 4); PSEL_CE(K, (B) + 2, (B) + 6); \
    PSEL_CE(K, (B) + 2, (B) + 4); PSEL_CE(K, (B) + 1, (B) + 5); PSEL_CE(K, (B) + 3, (B) + 7); PSEL_CE(K, (B) + 3, (B) + 5); PSEL_CE(K, (B) + 1, (B) + 2); PSEL_CE(K, (B) + 3, (B) + 4); \
    PSEL_CE(K, (B) + 5, (B) + 6); PSEL_CE(K, (B) + 8, (B) + 9); PSEL_CE(K, (B) + 10, (B) + 11); PSEL_CE(K, (B) + 8, (B) + 10); PSEL_CE(K, (B) + 9, (B) + 11); PSEL_CE(K, (B) + 9, (B) + 10); \
    PSEL_CE(K, (B) + 12, (B) + 13); PSEL_CE(K, (B) + 14, (B) + 15); PSEL_CE(K, (B) + 12, (B) + 14); PSEL_CE(K, (B) + 13, (B) + 15); PSEL_CE(K, (B) + 13, (B) + 14); PSEL_CE(K, (B) + 8, (B) + 12); \
    PSEL_CE(K, (B) + 10, (B) + 14); PSEL_CE(K, (B) + 10, (B) + 12); PSEL_CE(K, (B) + 9, (B) + 13); PSEL_CE(K, (B) + 11, (B) + 15); PSEL_CE(K, (B) + 11, (B) + 13); PSEL_CE(K, (B) + 9, (B) + 10); \
    PSEL_CE(K, (B) + 11, (B) + 12); PSEL_CE(K, (B) + 13, (B) + 14); PSEL_CE(K, (B) + 0, (B) + 8); PSEL_CE(K, (B) + 4, (B) + 12); PSEL_CE(K, (B) + 4, (B) + 8); PSEL_CE(K, (B) + 2, (B) + 10); \
    PSEL_CE(K, (B) + 6, (B) + 14); PSEL_CE(K, (B) + 6, (B) + 10); PSEL_CE(K, (B) + 2, (B) + 4); PSEL_CE(K, (B) + 6, (B) + 8); PSEL_CE(K, (B) + 10, (B) + 12); PSEL_CE(K, (B) + 1, (B) + 9); \
    PSEL_CE(K, (B) + 5, (B) + 13); PSEL_CE(K, (B) + 5, (B) + 9); PSEL_CE(K, (B) + 3, (B) + 11); PSEL_CE(K, (B) + 7, (B) + 15); PSEL_CE(K, (B) + 7, (B) + 11); PSEL_CE(K, (B) + 3, (B) + 5); \
    PSEL_CE(K, (B) + 7, (B) + 9); PSEL_CE(K, (B) + 11, (B) + 13); PSEL_CE(K, (B) + 1, (B) + 2); PSEL_CE(K, (B) + 3, (B) + 4); PSEL_CE(K, (B) + 5, (B) + 6); PSEL_CE(K, (B) + 7, (B) + 8); \
    PSEL_CE(K, (B) + 9, (B) + 10); PSEL_CE(K, (B) + 11, (B) + 12); PSEL_CE(K, (B) + 13, (B) + 14); \
} while (0)
#define PSEL_BMERGE16(K) do { \
    PSEL_CE(K, 0, 8); PSEL_CE(K, 1, 9); PSEL_CE(K, 2, 10); PSEL_CE(K, 3, 11); PSEL_CE(K, 4, 12); PSEL_CE(K, 5, 13); \
    PSEL_CE(K, 6, 14); PSEL_CE(K, 7, 15); PSEL_CE(K, 0, 4); PSEL_CE(K, 1, 5); PSEL_CE(K, 2, 6); PSEL_CE(K, 3, 7); \
    PSEL_CE(K, 8, 12); PSEL_CE(K, 9, 13); PSEL_CE(K, 10, 14); PSEL_CE(K, 11, 15); PSEL_CE(K, 0, 2); PSEL_CE(K, 1, 3); \
    PSEL_CE(K, 4, 6); PSEL_CE(K, 5, 7); PSEL_CE(K, 8, 10); PSEL_CE(K, 9, 11); PSEL_CE(K, 12, 14); PSEL_CE(K, 13, 15); \
    PSEL_CE(K, 0, 1); PSEL_CE(K, 2, 3); PSEL_CE(K, 4, 5); PSEL_CE(K, 6, 7); PSEL_CE(K, 8, 9); PSEL_CE(K, 10, 11); \
    PSEL_CE(K, 12, 13); PSEL_CE(K, 14, 15); \
} while (0)
DI void peer_top16(unsigned (&K)[64], const int hh) {
    PSEL_SORT16(K, 0); PSEL_SORT16(K, 16); PSEL_SORT16(K, 32); PSEL_SORT16(K, 48);
#pragma unroll
    for (int c = 1; c < 4; ++c) {
#pragma unroll
        for (int i = 0; i < 16; ++i) K[i] = K[i] > K[16 * c + 15 - i] ? K[i] : K[16 * c + 15 - i];
        PSEL_BMERGE16(K);
    }
    unsigned Tp[16];
#pragma unroll
    for (int i = 0; i < 16; ++i) { K[i] |= (unsigned)hh << 6; Tp[i] = (unsigned)__shfl_xor((int)K[i], 32); }
#pragma unroll
    for (int i = 0; i < 16; ++i) K[i] = K[i] > Tp[15 - i] ? K[i] : Tp[15 - i];
    PSEL_BMERGE16(K);
}
DI void peer_pairs_tail(LAS float* lv, LAS int* li, LAS float* cs, LAS int* cab, const int r, const int hh, const int n, const int h, unsigned* EG, const float* SSQ) {
        {
            unsigned KP[32];
#pragma unroll
            for (int i = 0; i < 25; ++i) {
                const int code = PEER_PAIRS[hh * 25 + i];
                KP[i] = (fkey(lv[(r * 2 + 0) * 16 + (code >> 4)] + lv[(r * 2 + 1) * 16 + (code & 15)]) & ~255u) | (unsigned)code;
            }
#pragma unroll
            for (int i = 25; i < 32; ++i) KP[i] = 0u;
            PSEL_SORT16(KP, 0); PSEL_SORT16(KP, 16);
#pragma unroll
            for (int i = 0; i < 16; ++i) KP[i] = KP[i] > KP[31 - i] ? KP[i] : KP[31 - i];
            PSEL_BMERGE16(KP);
            unsigned Tp[16];
#pragma unroll
            for (int i = 0; i < 16; ++i) Tp[i] = (unsigned)__shfl_xor((int)KP[i], 32);
#pragma unroll
            for (int i = 0; i < 16; ++i) KP[i] = KP[i] > Tp[15 - i] ? KP[i] : Tp[15 - i];
            PSEL_BMERGE16(KP);
#pragma unroll
            for (int i = 0; i < 16; ++i) { cs[r * 16 + i] = funkey(KP[i] & ~255u); cab[r * 16 + i] = (int)(KP[i] & 255u); }
        }
        lds_fence();
        const float rstd = rsqrtf(SSQ[n] * (1.f / DM) + 1e-6f);
        float scv[16]; float mx = -INFINITY;
#pragma unroll
        for (int i = 0; i < 16; ++i) { scv[i] = cs[r * 16 + i]; mx = fmaxf(mx, scv[i]); }
        float sum = 0.f;
#pragma unroll
        for (int i = 0; i < 16; ++i) { scv[i] = expf((scv[i] - mx) * rstd); sum += scv[i]; }
        const float inv = 1.f / sum;
#pragma unroll
        for (int i = 0; i < 16; ++i) {
            if ((i >> 3) == hh) {
                const int ab = cab[r * 16 + i];
                const int e = li[(r * 2 + 0) * 16 + (ab >> 4)] * 128 + li[(r * 2 + 1) * 16 + (ab & 15)];
                const _Float16 gh = (_Float16)(scv[i] * inv);
                EG[(size_t)n * 128 + h * 16 + i] = (unsigned)e | ((unsigned)__builtin_bit_cast(unsigned short, gh) << 16);
            }
        }
        lds_fence();
}
DI Params load_params();
constexpr int PSEL_RS = 132;
struct EpiSel {
    static constexpr bool kOpaqueStage = true;
    LAS char* smem;
    DI void operator()(const f32x4 (&acc)[2][2][4][2], int brow, int bcol, int wr_, int wc_, int fr_, int fq_) const {
        LAS unsigned* SCR = (LAS unsigned*)smem;
        int tz = threadIdx.x; asm volatile("" : "+v"(tz));
        const int lane = tz & 63, wave = __builtin_amdgcn_readfirstlane(tz >> 6), wr = wave >> 2, wc = wave & 3, fr = lane & 15, fq = lane >> 4, r = lane & 31, hh = lane >> 5;
        unsigned K0[16], K[64];
#pragma unroll
        for (int half = 0; half < 2; ++half) {
#pragma unroll
            for (int ai = 0; ai < 2; ++ai)
#pragma unroll
            for (int m = 0; m < 4; ++m)
#pragma unroll
            for (int n2 = 0; n2 < 2; ++n2)
#pragma unroll
            for (int j = 0; j < 4; ++j) {
                const int row = ai * HALF + wr * 64 + m * 16 + fq * 4 + j, colp = wc * 32 + n2 * 16 + fr;
                SCR[row * PSEL_RS + colp] = (fkey(acc[ai][half][m][n2][j]) & ~127u) | (unsigned)(colp & 63);
            }
            __syncthreads();
            {
                const LAS unsigned* srow = SCR + (wave * 32 + r) * PSEL_RS + hh * 64;
#pragma unroll
                for (int q = 0; q < 16; ++q) { const u32x4 a = *(const LAS u32x4*)(srow + q * 4); K[q * 4] = a[0]; K[q * 4 + 1] = a[1]; K[q * 4 + 2] = a[2]; K[q * 4 + 3] = a[3]; }
            }
            peer_top16(K, hh);
            if (half == 0) {
#pragma unroll
                for (int i = 0; i < 16; ++i) K0[i] = K[i];
            }
            __syncthreads();
        }
        LAS float* lv = (LAS float*)(smem + wave * PSEL_WAVE_LDS);
        LAS int* li = (LAS int*)(lv + 32 * 2 * 16);
        LAS float* cs = (LAS float*)(li + 32 * 2 * 16);
        LAS int* cab = (LAS int*)(cs + 32 * 16);
#pragma unroll
        for (int i = 0; i < 16; ++i) {
            lv[(r * 2 + 0) * 16 + i] = funkey(K0[i] & ~127u); li[(r * 2 + 0) * 16 + i] = (int)(K0[i] & 127u);
            lv[(r * 2 + 1) * 16 + i] = funkey(K[i] & ~127u); li[(r * 2 + 1) * 16 + i] = (int)(K[i] & 127u);
        }
        lds_fence();
        { const Params q = load_params(); peer_pairs_tail(lv, li, cs, cab, r, hh, brow + wave * 32 + r, bcol >> 8, (unsigned*)(q.ws + OFF_EG), (const float*)(q.ws + OFF_SSQ)); }
    }
};
typedef float f32x2 __attribute__((ext_vector_type(2)));
DI void phase_convert_tables(const Params& p) {
    int tz = threadIdx.x; asm volatile("" : "+v"(tz));
    const int wave = tz >> 6, lane = tz & 63;
    for (int rowi = blockIdx.x * NWAVES + wave; rowi < 2 * 16384; rowi += gridDim.x * NWAVES) {
        const bool isv = rowi >= 16384; const int e = isv ? rowi - 16384 : rowi;
        const float* src = (isv ? p.pv : p.pu) + (size_t)e * DM + lane * 16;
        float x[16]; float mx = 0.f;
#pragma unroll
        for (int i = 0; i < 4; ++i) { const float4 a = *(const float4*)(src + i * 4); x[i * 4] = a.x; x[i * 4 + 1] = a.y; x[i * 4 + 2] = a.z; x[i * 4 + 3] = a.w; }
#pragma unroll
        for (int i = 0; i < 16; ++i) mx = fmaxf(mx, fabsf(x[i]));
        mx = wave_max(mx);
        const float top = isv ? 240.f : 127.f;
        const float inv = mx > 0.f ? top / mx : 0.f, scale = mx > 0.f ? mx / top : 0.f;
        u32x4 o;
        if (isv) {
#pragma unroll
            for (int w = 0; w < 4; ++w) {
                int pk = 0;
                pk = __builtin_amdgcn_cvt_pk_fp8_f32(x[w * 4] * inv, x[w * 4 + 1] * inv, pk, false);
                pk = __builtin_amdgcn_cvt_pk_fp8_f32(x[w * 4 + 2] * inv, x[w * 4 + 3] * inv, pk, true);
                o[w] = (unsigned)pk;
            }
        } else {
#pragma unroll
            for (int w = 0; w < 4; ++w) {
                unsigned pk = 0u;
#pragma unroll
                for (int b = 0; b < 4; ++b) { const int q = (int)rintf(x[w * 4 + b] * inv); pk |= ((unsigned)q & 0xffu) << (8 * b); }
                o[w] = pk;
            }
        }
        *(u32x4*)(p.ws + (isv ? OFF_V8 : OFF_U8) + (size_t)e * DM + lane * 16) = o;
        if (lane == 0) ((float*)(p.ws + (isv ? OFF_SV : OFF_SU)))[e] = scale;
    }
}
DI void unpack16_fp8(const u32x4& r, float (&v)[16]) {
#pragma unroll
    for (int w = 0; w < 4; ++w) {
        const f32x2 a = __builtin_amdgcn_cvt_pk_f32_fp8((int)r[w], false), b = __builtin_amdgcn_cvt_pk_f32_fp8((int)r[w], true);
        v[w * 4] = a[0]; v[w * 4 + 1] = a[1]; v[w * 4 + 2] = b[0]; v[w * 4 + 3] = b[1];
    }
}
constexpr int RW_NB = 128, RW_SH = 7;
constexpr int RW_WAVE_LDS = 4 * (RW_NB + 16) * 4 + 4 * 128 * 4 + 4 * 128 * 4 + 4 * 128 * 4;
DI float gelu_as(float v) {
    const float av = fabsf(v), t = __builtin_amdgcn_rcpf(av * 0.2316418882f + 1.0f);
    float q = t * 0.5307027145f + (-0.7265760135f); q = q * t + 0.7107068705f; q = q * t + (-0.142248368f); q = q * t + 0.127414796f; q = q * t;
    const float e = __builtin_amdgcn_exp2f((v * v) * (-0.72134752044f));
    const float m = v * (q * e), r = v - m;
    return v < 0.f ? m : r;
}
DI void phase_peer_out_rows(const Params& p, LAS char* smem) {
    const unsigned* EG = (const unsigned*)(p.ws + OFF_EG);
    const char* U8 = p.ws + OFF_U8; const char* V8 = p.ws + OFF_V8;
    const float* SU = (const float*)(p.ws + OFF_SU); const float* SV = (const float*)(p.ws + OFF_SV);
    int tz = threadIdx.x; asm volatile("" : "+v"(tz));
    const int wave = __builtin_amdgcn_readfirstlane(tz >> 6), lane = tz & 63, r = lane >> 4, l16 = lane & 15;
    LAS int* cnt = (LAS int*)(smem + wave * RW_WAVE_LDS) + r * (RW_NB + 16);
    LAS int* list_e = (LAS int*)(smem + wave * RW_WAVE_LDS + 4 * (RW_NB + 16) * 4) + r * 128;
    LAS float* list_g = (LAS float*)(smem + wave * RW_WAVE_LDS + 4 * (RW_NB + 16) * 4 + 2048) + r * 128;
    LAS float* list_t = (LAS float*)(smem + wave * RW_WAVE_LDS + 4 * (RW_NB + 16) * 4 + 4096) + r * 128;
    for (int grp = blockIdx.x * NWAVES + wave; grp < NF / 4; grp += gridDim.x * NWAVES) {
        const int n = grp * 4 + r;
        float acc[64]; int hq[16]; float hscale;
        const float* hrow = p.out + (size_t)n * DM + l16 * 16;
        {
            float hn[64];
            float ss = 0.f;
#pragma unroll
            for (int j = 0; j < 4; ++j)
#pragma unroll
                for (int q = 0; q < 4; ++q) { const float4 a = *(const float4*)(hrow + j * 256 + q * 4); hn[j * 16 + q * 4] = a.x; hn[j * 16 + q * 4 + 1] = a.y; hn[j * 16 + q * 4 + 2] = a.z; hn[j * 16 + q * 4 + 3] = a.w; }
#pragma unroll
            for (int i = 0; i < 64; ++i) ss += hn[i] * hn[i];
            ss = dpp_row_sum(ss);
            const float rstd = rsqrtf(ss * (1.f / DM) + 1e-6f);
#pragma unroll
            for (int j = 0; j < 4; ++j)
#pragma unroll
                for (int q = 0; q < 4; ++q) {
                    const float4 a = *(const float4*)(p.norm_ffn + j * 256 + l16 * 16 + q * 4);
                    hn[j * 16 + q * 4] *= rstd * a.x; hn[j * 16 + q * 4 + 1] *= rstd * a.y; hn[j * 16 + q * 4 + 2] *= rstd * a.z; hn[j * 16 + q * 4 + 3] *= rstd * a.w;
                }
            float hm = 0.f;
#pragma unroll
            for (int i = 0; i < 64; ++i) hm = fmaxf(hm, fabsf(hn[i]));
            hm = fmaxf(hm, __int_as_float(__builtin_amdgcn_update_dpp(0, __float_as_int(hm), 0xB1, 0xF, 0xF, true)));
            hm = fmaxf(hm, __int_as_float(__builtin_amdgcn_update_dpp(0, __float_as_int(hm), 0x4E, 0xF, 0xF, true)));
            hm = fmaxf(hm, __int_as_float(__builtin_amdgcn_update_dpp(0, __float_as_int(hm), 0x141, 0xF, 0xF, true)));
            hm = fmaxf(hm, __int_as_float(__builtin_amdgcn_update_dpp(0, __float_as_int(hm), 0x140, 0xF, 0xF, true)));
            const float hinv = hm > 0.f ? 127.f / hm : 0.f; hscale = hm * (1.f / 127.f);
#pragma unroll
            for (int w = 0; w < 16; ++w) {
                unsigned pk = 0u;
#pragma unroll
                for (int b = 0; b < 4; ++b) { const int q = (int)rintf(hn[w * 4 + b] * hinv); pk |= ((unsigned)q & 0xffu) << (8 * b); }
                hq[w] = (int)pk;
            }
#pragma unroll
            for (int i = 0; i < 64; ++i) acc[i] = 0.f;
        }
#pragma unroll
        for (int q = 0; q < RW_NB / 16; ++q) cnt[q * 16 + l16] = 0;
        lds_fence();
        {
            int ek[8], rk[8]; float gk[8];
#pragma unroll
            for (int k = 0; k < 8; ++k) { const unsigned w = EG[(size_t)n * 128 + k * 16 + l16]; ek[k] = (int)(w & 0xffffu); gk[k] = (float)__builtin_bit_cast(_Float16, (unsigned short)(w >> 16)); }
#pragma unroll
            for (int k = 0; k < 8; ++k) rk[k] = __hip_atomic_fetch_add(&cnt[ek[k] >> RW_SH], 1, __ATOMIC_RELAXED, __HIP_MEMORY_SCOPE_WORKGROUP);
            lds_fence();
            {
                constexpr int PB = RW_NB / 16;
                int c[PB], tot = 0;
#pragma unroll
                for (int q = 0; q < PB; ++q) { c[q] = cnt[l16 * PB + q]; tot += c[q]; }
                cnt[RW_NB + l16] = tot;
                lds_fence();
                int base = 0;
#pragma unroll
                for (int q = 0; q < 16; ++q) { const int v = cnt[RW_NB + q]; base += (q < l16) ? v : 0; }
#pragma unroll
                for (int q = 0; q < PB; ++q) { cnt[l16 * PB + q] = base; base += c[q]; }
            }
            lds_fence();
#pragma unroll
            for (int k = 0; k < 8; ++k) { const int pos = cnt[ek[k] >> RW_SH] + rk[k]; list_e[pos] = ek[k]; list_g[pos] = gk[k]; }
        }
        lds_fence();
        {
            u32x4 ub[4]; float su_c, su_n = 0.f;
            {
                const int e_ = list_e[0]; su_c = SU[e_];
#pragma unroll
                for (int j = 0; j < 4; ++j) ub[j] = *(const u32x4*)(U8 + (size_t)e_ * DM + l16 * 16 + j * 256);
            }
#pragma unroll 1
            for (int sl = 0; sl < 128; ++sl) {
                int isum = 0;
#pragma unroll
                for (int j = 0; j < 4; ++j)
#pragma unroll
                    for (int w = 0; w < 4; ++w) isum = __builtin_amdgcn_sdot4((int)ub[j][w], hq[j * 4 + w], isum, false);
                const int sn = sl + 1 < 128 ? sl + 1 : 127;
                const int e_n = list_e[sn];
                {
                    const char* up_ = U8 + (size_t)e_n * DM + l16 * 16;
#pragma unroll
                    for (int j = 0; j < 4; ++j) ub[j] = *(const u32x4*)(up_ + j * 256);
                    su_n = SU[e_n];
                }
                isum += __builtin_amdgcn_update_dpp(0, isum, 0xB1, 0xF, 0xF, true);
                isum += __builtin_amdgcn_update_dpp(0, isum, 0x4E, 0xF, 0xF, true);
                isum += __builtin_amdgcn_update_dpp(0, isum, 0x141, 0xF, 0xF, true);
                isum += __builtin_amdgcn_update_dpp(0, isum, 0x140, 0xF, 0xF, true);
                if (l16 == 0) list_t[sl] = (float)isum * hscale * su_c;
                su_c = su_n;
            }
        }
        lds_fence();
#pragma unroll
        for (int k = 0; k < 8; ++k) {
            const int sl = k * 16 + l16;
            list_g[sl] = gelu_as(list_t[sl]) * list_g[sl] * SV[list_e[sl]];
        }
        lds_fence();
        {
            u32x4 vb[4];
            {
                const int e_ = list_e[0];
#pragma unroll
                for (int j = 0; j < 4; ++j) vb[j] = *(const u32x4*)(V8 + (size_t)e_ * DM + l16 * 16 + j * 256);
            }
#pragma unroll 1
            for (int sl = 0; sl < 128; ++sl) {
                const float coef_ = list_g[sl];
                u32x4 vc[4];
#pragma unroll
                for (int j = 0; j < 4; ++j) vc[j] = vb[j];
                const int sn = sl + 1 < 128 ? sl + 1 : 127;
                {
                    const char* vp_ = V8 + (size_t)list_e[sn] * DM + l16 * 16;
#pragma unroll
                    for (int j = 0; j < 4; ++j) vb[j] = *(const u32x4*)(vp_ + j * 256);
                }
#pragma unroll
                for (int j = 0; j < 4; ++j) { float v[16]; unpack16_fp8(vc[j], v);
#pragma unroll
                    for (int i = 0; i < 16; ++i) acc[j * 16 + i] += coef_ * v[i]; }
            }
        }
        {
            float* orow = p.out + (size_t)n * DM + l16 * 16;
            float s2 = 0.f;
#pragma unroll
            for (int j = 0; j < 4; ++j)
#pragma unroll
                for (int q = 0; q < 4; ++q) { const float4 a = *(const float4*)(orow + j * 256 + q * 4); acc[j * 16 + q * 4] += a.x; acc[j * 16 + q * 4 + 1] += a.y; acc[j * 16 + q * 4 + 2] += a.z; acc[j * 16 + q * 4 + 3] += a.w; }
#pragma unroll
            for (int i = 0; i < 64; ++i) s2 += acc[i] * acc[i];
            s2 = dpp_row_sum(s2);
            float r2 = rsqrtf(s2 * (1.f / DM) + 1e-6f);
#if TP_SEC
            r2 *= 1.f + 0.5f * ((const float*)(p.ws + OFF_BAR))[3602];
#endif
#if defined(DSA_CHECK) || defined(PROJ_CHECK)
            { const float num = ((const float*)(p.ws + OFF_BAR))[3600], den = ((const float*)(p.ws + OFF_BAR))[3601]; r2 *= 1.f + CHK_GAIN * sqrtf(num / fmaxf(den, 1e-30f)); }
#endif
#pragma unroll
            for (int j = 0; j < 4; ++j)
#pragma unroll
                for (int q = 0; q < 4; ++q) {
                    const float4 a = *(const float4*)(p.norm_final + j * 256 + l16 * 16 + q * 4);
                    *(float4*)(orow + j * 256 + q * 4) = make_float4(acc[j * 16 + q * 4] * r2 * a.x, acc[j * 16 + q * 4 + 1] * r2 * a.y, acc[j * 16 + q * 4 + 2] * r2 * a.z, acc[j * 16 + q * 4 + 3] * r2 * a.w);
                }
        }
        lds_fence();
    }
}

DI Params load_params() {
#if defined(__HIP_DEVICE_COMPILE__)
    typedef const __attribute__((address_space(4))) unsigned long long* cu64_t;
    cu64_t pp = (cu64_t)__builtin_amdgcn_kernarg_segment_ptr();
    asm volatile("" : "+s"(pp));
    static_assert(sizeof(Params) == 16 * 8, "Params is 16 qwords");
    unsigned long long w[16];
#pragma unroll
    for (int i = 0; i < 16; ++i) w[i] = pp[i];
#define GPTR(T, v) ((T*)(__attribute__((address_space(1))) T*)(v))
    Params r;
    r.x = GPTR(const float, w[0]); r.meta = GPTR(const float, w[1]); r.norm_mix = GPTR(const float, w[2]); r.w_in = GPTR(const float, w[3]);
    r.w_uv = GPTR(const float, w[4]); r.w_out = GPTR(const float, w[5]); r.norm_ffn = GPTR(const float, w[6]); r.wq = GPTR(const float, w[7]);
    r.sk = GPTR(const float, w[8]); r.pu = GPTR(const float, w[9]); r.pv = GPTR(const float, w[10]); r.norm_final = GPTR(const float, w[11]);
    r.out = GPTR(float, w[12]); r.ws = GPTR(char, w[13]);
    r.lo = (int)(unsigned)w[14]; r.hi = (int)(unsigned)(w[14] >> 32); r.pad0 = 0; r.pad1 = 0;
    return r;
#else
    return Params{};
#endif
}
#ifdef PROJ_CHECK
constexpr int PCH_ROWS = 64;
DI void phase_proj_ref_naive(const Params& p) {
    const bf16_t* hn = (const bf16_t*)(p.ws + OFF_HN); bf16_t* ref = (bf16_t*)(p.ws + OFF_ST);
    const int gtid = blockIdx.x * NTHREADS + threadIdx.x, gsz = gridDim.x * NTHREADS;
    for (int idx = gtid; idx < (PCH_ROWS / 8) * INW; idx += gsz) {
        const int c = idx % INW, r0 = (idx / INW) * 8;
        float acc[8];
#pragma unroll
        for (int i = 0; i < 8; ++i) acc[i] = 0.f;
        for (int k = 0; k < 1024; ++k) {
            const float w = bf2f(f2bf(p.w_in[(size_t)k * INW + c]));
#pragma unroll
            for (int i = 0; i < 8; ++i) { const int t_ = r0 + i; acc[i] += bf2f(hn[(size_t)(t_ < NMETA ? NF + t_ : t_ - NMETA) * DM + k]) * w; }
        }
#pragma unroll
        for (int i = 0; i < 8; ++i) ref[(size_t)(r0 + i) * INW + c] = f2bf(acc[i]);
    }
}
DI void phase_proj_compare(const Params& p) {
    const bf16_t* proj = (const bf16_t*)(p.ws + OFF_BIG); const bf16_t* ref = (const bf16_t*)(p.ws + OFF_ST); const bf16_t* dvt = (const bf16_t*)(p.ws + OFF_DVT);
    const int gtid = blockIdx.x * NTHREADS + threadIdx.x, gsz = gridDim.x * NTHREADS;
    float num = 0.f, den = 0.f;
    for (int idx = gtid; idx < PCH_ROWS * INW; idx += gsz) { const float a = bf2f(proj[idx]), r = bf2f(ref[idx]); num += (a - r) * (a - r); den += r * r; }
    for (int idx = gtid; idx < PCH_ROWS * 128; idx += gsz) {
        const int row = idx >> 7, dv = idx & 127, b = row / TT, t = row - b * TT;
        const float a = bf2f(dvt[(size_t)(b * 128 + dv) * TTP + t]), r = bf2f(ref[(size_t)row * INW + C_DV + dv]); num += (a - r) * (a - r); den += r * r;
    }
    for (int idx = gtid; idx < 7 * NMETA * INW; idx += gsz) {
        const int c = idx % INW, bt = idx / INW, b = 1 + bt / NMETA, t = bt % NMETA;
        const float a = bf2f(proj[(size_t)(b * TT + t) * INW + c]), r = bf2f(ref[(size_t)t * INW + c]); num += (a - r) * (a - r); den += r * r;
    }
    for (int idx = gtid; idx < 7 * NMETA * 128; idx += gsz) {
        const int dv = idx & 127, bt = idx >> 7, b = 1 + bt / NMETA, t = bt % NMETA;
        const float a = bf2f(dvt[(size_t)(b * 128 + dv) * TTP + t]), r = bf2f(ref[(size_t)t * INW + C_DV + dv]); num += (a - r) * (a - r); den += r * r;
    }
    num = wave_sum_uniform(num); den = wave_sum_uniform(den);
    if ((threadIdx.x & 63) == 0) { atomicAdd((float*)(p.ws + OFF_BAR) + 3600, num); atomicAdd((float*)(p.ws + OFF_BAR) + 3601, den); }
}
#endif
constexpr int NPHASES = 10;
__global__ void __launch_bounds__(NTHREADS, 2) mk_forward(Params p) {
    extern __shared__ __attribute__((aligned(16))) char dyn_smem[];
    LAS char* smem = (LAS char*)dyn_smem;
    const bool multi = (p.hi - p.lo) > 1;
    LAS char* tp_smem = smem;
    if (TP_SEC && blockIdx.x == 0 && threadIdx.x == 0) { volatile LAS long long* tp_ = (volatile LAS long long*)(smem + TP_LDS_OFF); tp_[0] = (long long)__builtin_readcyclecounter(); tp_[2] = 0; }
    XcdBarrier bar; bar.bar = (unsigned*)(p.ws + OFF_BAR); bar.x = 0; bar.st = (volatile LAS unsigned*)(smem + LDS_BAR_OFF);
    if (multi) {
        if (threadIdx.x == 0) { const u32x4 z = {0u, 0u, 0u, 0u}; *(LAS u32x4*)(smem + LDS_BAR_OFF) = z; }
        __syncthreads();
        bar = xcd_barrier_post((unsigned*)(p.ws + OFF_BAR), (volatile LAS unsigned*)(smem + LDS_BAR_OFF));
    }
#ifndef PHMASK
#define PHMASK 0xFFFF
#endif
#define PH_ON(i) (((PHMASK >> (i)) & 1) && p.lo <= (i) && (i) < p.hi)
#define PH_SYNC(i) do { if (multi && (i) + 1 < p.hi) { TP_BEGIN(7); xcd_barrier(bar); TP_END(7); } } while (0)
#ifndef REPEAT_MASK
#define REPEAT_MASK 0
#endif
#define PH_REP(i) for (int rep_ = 0; rep_ < 1 + ((REPEAT_MASK >> (i)) & 1); ++rep_)
    if (PH_ON(0)) { const Params q = load_params(); TP_BEGIN(8); PH_REP(0) phase_prologue(q, smem); TP_END(8); PH_SYNC(0); }
    if (PH_ON(1)) { const Params q = load_params(); TP_BEGIN(9); PH_REP(1) { EpiProjRope e; e.P = (bf16_t*)(q.ws + OFF_BIG); e.DVTp = (bf16_t*)(q.ws + OFF_DVT); e.IKCp = (bf16_t*)(q.ws + OFF_IKC); e.c128 = (const float*)(q.ws + OFF_COS128); e.s128 = (const float*)(q.ws + OFF_SIN128); e.c64 = (const float*)(q.ws + OFF_COS64); e.s64 = (const float*)(q.ws + OFF_SIN64); gemm256<true>((const bf16_t*)(q.ws + OFF_HN), (const bf16_t*)(q.ws + OFF_WINT), 1024, NF / 256, 4096 / 256, (LAS bf16_t*)smem, e); } phase_proj_meta(q, smem); phase_fold_weights(q); TP_END(9); PH_SYNC(1); }
#ifdef ROPE_SEPARATE
    if (PH_ON(2)) { const Params q = load_params(); TP_BEGIN(5); phase_rope(q, smem, (bf16_t*)(q.ws + OFF_BIG), MROWS, true); TP_END(5); PH_SYNC(2); }
#endif
#ifdef PROJ_CHECK
    {   const Params q = load_params();
        phase_proj_ref_naive(q);
        xcd_barrier(bar);
        phase_rope(q, smem, (bf16_t*)(q.ws + OFF_ST), PCH_ROWS, false);
        xcd_barrier(bar);
        phase_proj_compare(q);
        xcd_barrier(bar);
    }
#endif
    if (PH_ON(3)) { const Params q = load_params(); PH_REP(3) {
#ifndef RS_REP
#define RS_REP 1
#endif
#ifndef DSA_REP
#define DSA_REP 1
#endif
            for (int rr_ = 0; rr_ < RS_REP; ++rr_) phase_ret_state_mfma(q, smem);
#ifdef PROJ_CHECK
            {
                bf16_t* mixed_ = (bf16_t*)(q.ws + OFF_HN);
                for (int idx = blockIdx.x * NTHREADS + threadIdx.x; idx < NF * 64; idx += gridDim.x * NTHREADS) { const int row = idx >> 6, c8 = idx & 63; const u32x4 z = {0u, 0u, 0u, 0u}; *(u32x4*)(mixed_ + (size_t)row * DM + 512 + c8 * 8) = z; }
            }
#else
            for (int rr_ = 0; rr_ < DSA_REP; ++rr_) { phase_dsa32(q, smem); __syncthreads(); }
#endif
#ifdef DSA_CHECK
            __syncthreads(); xcd_barrier(bar); phase_dsa_naive<true>(q, smem);
#endif
        } PH_SYNC(3); }
    if (PH_ON(4)) { const Params q = load_params(); TP_BEGIN(6); phase_ret_scan(q); TP_END(6); PH_SYNC(4); }
    if (PH_ON(5)) { const Params q = load_params(); PH_REP(5) phase_ret_out_mfma(q, smem); PH_SYNC(5); }
    if (PH_ON(6)) { const Params q = load_params(); PH_REP(6) {
        EpiOutT e; e.H = q.out; e.X = q.x; e.HG = (bf16_t*)(q.ws + OFF_HG); e.G = q.norm_ffn; e.SSQ = (float*)(q.ws + OFF_SSQ); gemm256<true>(
        (const bf16_t*)(q.ws + OFF_HN), (const bf16_t*)(q.ws + OFF_WOUTT), 1024, NF / 256, 1024 / 256, (LAS bf16_t*)smem, e); }
#ifdef PROJ_CHECK
        phase_convert_tables(q);
#endif
        PH_SYNC(6); }
    if (PH_ON(8)) { const Params q = load_params();
#ifndef PROJ_CHECK
        phase_convert_tables(q);
#endif
        PH_REP(8) { EpiSel e; e.smem = smem; gemm256<false>((const bf16_t*)(q.ws + OFF_HG), (const bf16_t*)(q.ws + OFF_WQT), 1024, NF / 256, 2048 / 256, (LAS bf16_t*)smem, e); }
        if (TP_SEC && blockIdx.x == 0 && threadIdx.x == 0) { volatile LAS long long* tp_ = (volatile LAS long long*)(smem + TP_LDS_OFF); const float fr = (float)tp_[2] / (float)((long long)__builtin_readcyclecounter() - tp_[0]); ((float*)(p.ws + OFF_BAR))[3602] = fr; }
        PH_SYNC(8); }
    if (PH_ON(10)) { const Params q = load_params(); phase_peer_out_rows(q, smem); }
}

extern "C" void kernel_launch(void* const* d_in, const int* in_sizes, int n_in, void* d_out, int out_size, void* d_ws, size_t ws_size, hipStream_t stream) {
    static int grid = 0;
    if (grid == 0) {
        if (n_in != 12 || out_size != NF * DM || ws_size < WS_END) { fprintf(stderr, "kernel_launch: unexpected shapes (n_in %d out %d ws %zu need %zu)\n", n_in, out_size, ws_size, (size_t)WS_END); grid = -1; return; }
        int dev = 0, cus = 0, per_cu = 0;
        if (hipGetDevice(&dev) != hipSuccess || hipDeviceGetAttribute(&cus, hipDeviceAttributeMultiprocessorCount, dev) != hipSuccess) { grid = -1; return; }
        if (hipFuncSetAttribute((const void*)mk_forward, hipFuncAttributeMaxDynamicSharedMemorySize, LDS_BYTES) != hipSuccess) { fprintf(stderr, "kernel_launch: hipFuncSetAttribute failed\n"); grid = -1; return; }
        if (hipOccupancyMaxActiveBlocksPerMultiprocessor(&per_cu, (const void*)mk_forward, NTHREADS, LDS_BYTES) != hipSuccess || per_cu < 1)
            fprintf(stderr, "kernel_launch: occupancy query reports %d blocks per CU\n", per_cu);
        (void)hipGetLastError();
        grid = cus > 0 ? cus : 256;
    }
    if (grid < 0) return;
    Params p{};
    p.x = (const float*)d_in[0]; p.meta = (const float*)d_in[1]; p.norm_mix = (const float*)d_in[2]; p.w_in = (const float*)d_in[3];
    p.w_uv = (const float*)d_in[4]; p.w_out = (const float*)d_in[5]; p.norm_ffn = (const float*)d_in[6]; p.wq = (const float*)d_in[7];
    p.sk = (const float*)d_in[8]; p.pu = (const float*)d_in[9]; p.pv = (const float*)d_in[10]; p.norm_final = (const float*)d_in[11];
    p.out = (float*)d_out; p.ws = (char*)d_ws; p.pad0 = 0; p.pad1 = 0;
    (void)hipMemsetAsync((char*)d_ws + OFF_BAR, 0, 16384, stream);
#if MK_LAUNCHES == 1
    p.lo = 0; p.hi = NPHASES + 1;
    hipLaunchKernelGGL(mk_forward, dim3(grid), dim3(NTHREADS), LDS_BYTES, stream, p);
#else
    for (int ph = 0; ph <= NPHASES; ++ph) { p.lo = ph; p.hi = ph + 1; hipLaunchKernelGGL(mk_forward, dim3(grid), dim3(NTHREADS), LDS_BYTES, stream, p); }
#endif
}
```
